# Optimizing an MI355X kernel written in HIP

```python
import math
import jax
import jax.numpy as jnp
from jax import lax
import numpy as np


D_MODEL = 1024
BATCH = 2
SEQ = 16384
DEPTH = 4

GRID_W = 64
CTX_LEN = 256
N_MIXERS = 3
D_FF = 4 * D_MODEL
NORM_EPS = 1e-6

DN_K_HEADS = 8
DN_V_HEADS = 16
DN_HEAD_K = 128
DN_HEAD_V = 128
DN_GROUP = DN_V_HEADS // DN_K_HEADS
DN_K_DIM = DN_K_HEADS * DN_HEAD_K
DN_V_DIM = DN_V_HEADS * DN_HEAD_V
DN_QKV_DIM = 2 * DN_K_DIM + DN_V_DIM
DN_IN_DIM = DN_QKV_DIM + DN_V_DIM + 4 * DN_V_HEADS
SHORT_CONV = 5
DN_CHUNK = 64

GLA_HEADS = 4
GLA_K_DIM = D_MODEL // 2
GLA_V_DIM = D_MODEL
GLA_HEAD_K = GLA_K_DIM // GLA_HEADS
GLA_HEAD_V = GLA_V_DIM // GLA_HEADS
GLA_GATE_RANK = 16
GLA_GATE_NORMALIZER = 16.0
GLA_IN_DIM = 2 * GLA_K_DIM + 2 * GLA_V_DIM + 2 * GLA_GATE_RANK
GLA_CHUNK = 64

ATTN_Q_HEADS = 8
ATTN_KV_HEADS = 2
ATTN_HEAD_DIM = 128
ATTN_GROUP = ATTN_Q_HEADS // ATTN_KV_HEADS
ATTN_Q_DIM = ATTN_Q_HEADS * ATTN_HEAD_DIM
ATTN_KV_DIM = ATTN_KV_HEADS * ATTN_HEAD_DIM
ATTN_IN_DIM = ATTN_Q_DIM + 2 * ATTN_KV_DIM
Q_BLOCK = 128
ROPE_THETA = 10000.0

kernel_name = 'hybrid_dit_deltanet_gla_gqa'

F32 = jnp.float32


def rms_norm(x, g):
    xf = x.astype(F32)
    y = xf * lax.rsqrt(jnp.mean(xf * xf, axis=-1, keepdims=True) + NORM_EPS)
    return (y * g.astype(F32)).astype(x.dtype)


def l2_normalize(x):
    xf = x.astype(F32)
    return xf * lax.rsqrt(jnp.sum(xf * xf, axis=-1, keepdims=True) + NORM_EPS)


def modulate(h, shift, scale):
    return h * (1.0 + scale) + shift


def squared_relu_ffn(h, w1, w2):
    return jnp.square(jax.nn.relu(h @ w1)) @ w2


def short_conv(u, w):
    n = u.shape[1]
    pad = SHORT_CONV // 2
    up = jnp.pad(u, ((0, 0), (pad, pad), (0, 0)))
    out = up[:, 0:n] * w[:, 0]
    for tap in range(1, SHORT_CONV):
        out = out + up[:, tap:tap + n] * w[:, tap]
    return out


def to_chunks(t, chunk):
    b, h, n = t.shape[:3]
    t = t.reshape((b, h, n // chunk, chunk) + t.shape[3:])
    return jnp.moveaxis(t, 2, 0)


def from_chunks(t):
    t = jnp.moveaxis(t, 0, 2)
    b, h, nc, chunk = t.shape[:4]
    return t.reshape((b, h, nc * chunk) + t.shape[4:])


def time_flip(t):
    return jnp.flip(t, axis=2)


def identity(t):
    return t


def axial_rope_tables(n_rows):
    row = jnp.repeat(jnp.arange(n_rows), GRID_W).astype(F32)
    col = jnp.tile(jnp.arange(GRID_W), n_rows).astype(F32)
    axis_dim = ATTN_HEAD_DIM // 2
    inv_freq = jnp.power(ROPE_THETA, -jnp.arange(0, axis_dim, 2, dtype=F32) / axis_dim)
    ang_row = row[:, None] * inv_freq
    ang_col = col[:, None] * inv_freq
    return jnp.cos(ang_row), jnp.sin(ang_row), jnp.cos(ang_col), jnp.sin(ang_col)


def rotate_pairs(x, cos, sin):
    x1, x2 = jnp.split(x, 2, axis=-1)
    cs, sn = cos[:, None, :], sin[:, None, :]
    return jnp.concatenate([x1 * cs - x2 * sn, x1 * sn + x2 * cs], axis=-1)


def apply_axial_rope(x, tables):
    cos_r, sin_r, cos_c, sin_c = tables
    xf = x.astype(F32)
    half = ATTN_HEAD_DIM // 2
    y = jnp.concatenate([rotate_pairs(xf[..., :half], cos_r, sin_r),
                         rotate_pairs(xf[..., half:], cos_c, sin_c)], axis=-1)
    return y.astype(x.dtype)


def gated_delta_rule(q, k, v, g, beta, state):
    c = DN_CHUNK
    tri = jnp.tril(jnp.ones((c, c), dtype=bool))
    strict = jnp.tril(jnp.ones((c, c), dtype=bool), -1)
    eye = jnp.eye(c, dtype=F32)

    def step(s, xs):
        qc, kc, vc, gc, bc = xs
        qc = jnp.repeat(qc, DN_GROUP, axis=1)
        kc = jnp.repeat(kc, DN_GROUP, axis=1)
        gcum = jnp.cumsum(gc, axis=-1)
        decay = jnp.exp(jnp.where(tri, gcum[..., :, None] - gcum[..., None, :], -jnp.inf))
        kk = jnp.einsum('bhid,bhjd->bhij', kc, kc)
        m = jnp.where(strict, bc[..., :, None] * kk * decay, 0.0)
        rhs = jnp.concatenate([vc * bc[..., None], kc * (bc * jnp.exp(gcum))[..., None]], axis=-1)
        sol = lax.linalg.triangular_solve(eye + m, rhs, left_side=True, lower=True, unit_diagonal=True)
        u, w = sol[..., :DN_HEAD_V], sol[..., DN_HEAD_V:]
        v_new = u - jnp.einsum('bhid,bhdv->bhiv', w, s)
        a_qk = jnp.einsum('bhid,bhjd->bhij', qc, kc) * decay
        o = (jnp.einsum('bhid,bhdv->bhiv', qc * jnp.exp(gcum)[..., None], s)
             + jnp.einsum('bhij,bhjv->bhiv', a_qk, v_new))
        tail = jnp.exp(gcum[..., -1:] - gcum)
        s = (s * jnp.exp(gcum[..., -1])[..., None, None]
             + jnp.einsum('bhjd,bhjv->bhdv', kc * tail[..., None], v_new))
        return s, o

    xs = (to_chunks(q, c), to_chunks(k, c), to_chunks(v, c), to_chunks(g, c), to_chunks(beta, c))
    state, o = lax.scan(step, state, xs)
    return from_chunks(o), state


def gla_rule(q, k, v, gk, state):
    c = GLA_CHUNK
    tri = jnp.tril(jnp.ones((c, c), dtype=bool))[:, :, None]

    def step(s, xs):
        qc, kc, vc, gc = xs
        bcum = jnp.cumsum(gc, axis=-2)
        rel = jnp.exp(jnp.where(tri, bcum[..., :, None, :] - bcum[..., None, :, :], -jnp.inf))
        a_qk = jnp.einsum('bhid,bhjd,bhijd->bhij', qc, kc, rel)
        o = (jnp.einsum('bhij,bhjv->bhiv', a_qk, vc)
             + jnp.einsum('bhid,bhdv->bhiv', qc * jnp.exp(bcum), s))
        last = bcum[..., -1:, :]
        s = (s * jnp.exp(last[..., 0, :])[..., None]
             + jnp.einsum('bhjd,bhjv->bhdv', kc * jnp.exp(last - bcum), vc))
        return s, o

    xs = (to_chunks(q, c), to_chunks(k, c), to_chunks(v, c), to_chunks(gk, c))
    state, o = lax.scan(step, state, xs)
    return from_chunks(o), state


def deltanet_mixer(hx, hc, w_in, conv_w, a_log, dt_bias, norm_g, w_out, with_ctx_out):
    def project(h):
        bsz, n, _ = h.shape
        p = h @ w_in
        qkv = jax.nn.silu(short_conv(p[..., :DN_QKV_DIM], conv_w))
        z = p[..., DN_QKV_DIM:DN_QKV_DIM + DN_V_DIM]
        ab = p[..., DN_QKV_DIM + DN_V_DIM:].astype(F32)
        q = l2_normalize(qkv[..., :DN_K_DIM].reshape(bsz, n, DN_K_HEADS, DN_HEAD_K)) * DN_HEAD_K ** -0.5
        k = l2_normalize(qkv[..., DN_K_DIM:2 * DN_K_DIM].reshape(bsz, n, DN_K_HEADS, DN_HEAD_K))
        v = qkv[..., 2 * DN_K_DIM:].reshape(bsz, n, DN_V_HEADS, DN_HEAD_V).astype(F32)
        a = ab[..., :2 * DN_V_HEADS].reshape(bsz, n, 2, DN_V_HEADS)
        b = ab[..., 2 * DN_V_HEADS:].reshape(bsz, n, 2, DN_V_HEADS)
        g = -jnp.exp(a_log.astype(F32)) * jax.nn.softplus(a + dt_bias.astype(F32))
        beta = jax.nn.sigmoid(b)
        return (jnp.swapaxes(q, 1, 2), jnp.swapaxes(k, 1, 2), jnp.swapaxes(v, 1, 2),
                jnp.moveaxis(g, 1, -1), jnp.moveaxis(beta, 1, -1), z)

    qx, kx, vx, gx, bx, zx = project(hx)
    qc, kc, vc, gc, bc, zc = project(hc)
    bsz = hx.shape[0]
    out_x, out_c = [], []
    for d in range(2):
        flip = time_flip if d == 1 else identity
        state0 = jnp.zeros((bsz, DN_V_HEADS, DN_HEAD_K, DN_HEAD_V), F32)
        oc, state_c = gated_delta_rule(flip(qc), flip(kc), flip(vc), flip(gc[:, d]), flip(bc[:, d]), state0)
        ox, _ = gated_delta_rule(flip(qx), flip(kx), flip(vx), flip(gx[:, d]), flip(bx[:, d]), state_c)
        out_x.append(flip(ox))
        out_c.append(flip(oc))

    def readout(o, z):
        bsz_, n = z.shape[:2]
        o = rms_norm(jnp.swapaxes(o, 1, 2), norm_g)
        o = o * jax.nn.silu(z.reshape(bsz_, n, DN_V_HEADS, DN_HEAD_V).astype(F32))
        return o.reshape(bsz_, n, DN_V_DIM).astype(z.dtype) @ w_out

    yx = readout(out_x[0] + out_x[1], zx)
    yc = readout(out_c[0] + out_c[1], zc) if with_ctx_out else None
    return yx, yc


def gla_mixer(hx, hc, w_in, gate_w2, gate_b2, norm_g, w_out, with_ctx_out):
    def project(h):
        bsz, n, _ = h.shape
        p = h @ w_in
        q = p[..., :GLA_K_DIM].reshape(bsz, n, GLA_HEADS, GLA_HEAD_K).astype(F32) * GLA_HEAD_K ** -0.5
        k = p[..., GLA_K_DIM:2 * GLA_K_DIM].reshape(bsz, n, GLA_HEADS, GLA_HEAD_K).astype(F32)
        v = p[..., 2 * GLA_K_DIM:2 * GLA_K_DIM + GLA_V_DIM].reshape(bsz, n, GLA_HEADS, GLA_HEAD_V).astype(F32)
        gate = p[..., 2 * GLA_K_DIM + GLA_V_DIM:2 * GLA_K_DIM + 2 * GLA_V_DIM]
        low = p[..., 2 * GLA_K_DIM + 2 * GLA_V_DIM:].reshape(bsz, n, 2, GLA_GATE_RANK)
        logits = jnp.einsum('btdr,drk->btdk', low, gate_w2) + gate_b2
        gk = jax.nn.log_sigmoid(logits.astype(F32)) / GLA_GATE_NORMALIZER
        gk = gk.reshape(bsz, n, 2, GLA_HEADS, GLA_HEAD_K).transpose(0, 2, 3, 1, 4)
        return jnp.swapaxes(q, 1, 2), jnp.swapaxes(k, 1, 2), jnp.swapaxes(v, 1, 2), gk, gate

    qx, kx, vx, gx, zx = project(hx)
    qc, kc, vc, gc, zc = project(hc)
    bsz = hx.shape[0]
    out_x, out_c = [], []
    for d in range(2):
        flip = time_flip if d == 1 else identity
        state0 = jnp.zeros((bsz, GLA_HEADS, GLA_HEAD_K, GLA_HEAD_V), F32)
        oc, state_c = gla_rule(flip(qc), flip(kc), flip(vc), flip(gc[:, d]), state0)
        ox, _ = gla_rule(flip(qx), flip(kx), flip(vx), flip(gx[:, d]), state_c)
        out_x.append(flip(ox))
        out_c.append(flip(oc))

    def readout(o, z):
        bsz_, n = z.shape[:2]
        o = rms_norm(jnp.swapaxes(o, 1, 2), norm_g)
        o = o * jax.nn.silu(z.reshape(bsz_, n, GLA_HEADS, GLA_HEAD_V).astype(F32))
        return o.reshape(bsz_, n, GLA_V_DIM).astype(z.dtype) @ w_out

    yx = readout(out_x[0] + out_x[1], zx)
    yc = readout(out_c[0] + out_c[1], zc) if with_ctx_out else None
    return yx, yc


def attention_mixer(hx, hc, w_in, q_norm_g, k_norm_g, w_out, rope, with_ctx_out):
    def project(h):
        bsz, n, _ = h.shape
        p = h @ w_in
        q = p[..., :ATTN_Q_DIM].reshape(bsz, n, ATTN_Q_HEADS, ATTN_HEAD_DIM)
        k = p[..., ATTN_Q_DIM:ATTN_Q_DIM + ATTN_KV_DIM].reshape(bsz, n, ATTN_KV_HEADS, ATTN_HEAD_DIM)
        v = p[..., ATTN_Q_DIM + ATTN_KV_DIM:].reshape(bsz, n, ATTN_KV_HEADS, ATTN_HEAD_DIM)
        return rms_norm(q, q_norm_g), rms_norm(k, k_norm_g), v

    qx, kx, vx = project(hx)
    qc, kc, vc = project(hc)
    qx = apply_axial_rope(qx, rope)
    kx = apply_axial_rope(kx, rope)
    bsz, n = hx.shape[:2]
    scale = ATTN_HEAD_DIM ** -0.5

    def attend(q_blk, keys, values):
        s = jnp.einsum('bkgqd,bksd->bkgqs', q_blk, keys).astype(F32) * scale
        p = jax.nn.softmax(s, axis=-1).astype(values.dtype)
        return jnp.einsum('bkgqs,bksd->bkgqd', p, values)

    k_all = jnp.concatenate([kx, kc], axis=1).transpose(0, 2, 1, 3)
    v_all = jnp.concatenate([vx, vc], axis=1).transpose(0, 2, 1, 3)
    n_blk = n // Q_BLOCK
    q_blocks = qx.reshape(bsz, n_blk, Q_BLOCK, ATTN_KV_HEADS, ATTN_GROUP, ATTN_HEAD_DIM).transpose(1, 0, 3, 4, 2, 5)
    o = lax.map(lambda qb: attend(qb, k_all, v_all), q_blocks)
    yx = o.transpose(1, 0, 4, 2, 3, 5).reshape(bsz, n, ATTN_Q_DIM) @ w_out
    yc = None
    if with_ctx_out:
        lc = hc.shape[1]
        q_ctx = qc.reshape(bsz, lc, ATTN_KV_HEADS, ATTN_GROUP, ATTN_HEAD_DIM).transpose(0, 2, 3, 1, 4)
        oc = attend(q_ctx, kc.transpose(0, 2, 1, 3), vc.transpose(0, 2, 1, 3))
        yc = oc.transpose(0, 3, 1, 2, 4).reshape(bsz, lc, ATTN_Q_DIM) @ w_out
    return yx, yc


def setup_inputs(seed: int = 0) -> dict:
    key = jax.random.key(seed)
    ks = jax.random.split(key, 32)
    n_a = len(range(0, DEPTH, N_MIXERS))
    n_b = len(range(1, DEPTH, N_MIXERS))
    n_c = len(range(2, DEPTH, N_MIXERS))

    def normal(k, shape, scale):
        return jax.random.normal(k, shape, F32) * scale

    def gain(k, shape):
        return 1.0 + normal(k, shape, 0.02)

    dt = jnp.exp(jax.random.uniform(ks[12], (n_a, 2, DN_V_HEADS), F32, math.log(1e-3), math.log(1e-1)))
    return {
        'x': normal(ks[0], (BATCH, SEQ, D_MODEL), 1.0),
        'c': normal(ks[1], (BATCH, D_MODEL), 1.0),
        'ctx': normal(ks[2], (BATCH, CTX_LEN, D_MODEL), 1.0),
        'c_ctx': normal(ks[3], (D_MODEL,), 1.0),
        'ada_w': normal(ks[4], (DEPTH, D_MODEL, 6 * D_MODEL), 0.5 * D_MODEL ** -0.5),
        'ada_b': normal(ks[5], (DEPTH, 6 * D_MODEL), 0.01),
        'norm_mix_g': gain(ks[6], (DEPTH, D_MODEL)),
        'norm_ffn_g': gain(ks[7], (DEPTH, D_MODEL)),
        'ffn_w1': normal(ks[8], (DEPTH, D_MODEL, D_FF), D_MODEL ** -0.5),
        'ffn_w2': normal(ks[9], (DEPTH, D_FF, D_MODEL), D_FF ** -0.5),
        'dn_w_in': normal(ks[10], (n_a, D_MODEL, DN_IN_DIM), D_MODEL ** -0.5),
        'dn_conv_w': normal(ks[11], (n_a, DN_QKV_DIM, SHORT_CONV), SHORT_CONV ** -0.5),
        'dn_a_log': jnp.log(jax.random.uniform(ks[13], (n_a, 2, DN_V_HEADS), F32, 1.0, 16.0)),
        'dn_dt_bias': dt + jnp.log(-jnp.expm1(-dt)),
        'dn_norm_g': gain(ks[14], (n_a, DN_HEAD_V)),
        'dn_w_out': normal(ks[15], (n_a, DN_V_DIM, D_MODEL), DN_V_DIM ** -0.5),
        'gla_w_in': normal(ks[16], (n_b, D_MODEL, GLA_IN_DIM), D_MODEL ** -0.5),
        'gla_gate_w2': normal(ks[17], (n_b, 2, GLA_GATE_RANK, GLA_K_DIM), GLA_GATE_RANK ** -0.5),
        'gla_gate_b2': normal(ks[18], (n_b, 2, GLA_K_DIM), 0.1),
        'gla_norm_g': gain(ks[19], (n_b, GLA_HEAD_V)),
        'gla_w_out': normal(ks[20], (n_b, GLA_V_DIM, D_MODEL), GLA_V_DIM ** -0.5),
        'attn_w_in': normal(ks[21], (n_c, D_MODEL, ATTN_IN_DIM), D_MODEL ** -0.5),
        'attn_q_norm_g': gain(ks[22], (n_c, ATTN_HEAD_DIM)),
        'attn_k_norm_g': gain(ks[23], (n_c, ATTN_HEAD_DIM)),
        'attn_w_out': normal(ks[24], (n_c, ATTN_Q_DIM, D_MODEL), ATTN_Q_DIM ** -0.5),
    }


def reference(x, c, ctx, c_ctx, ada_w, ada_b, norm_mix_g, norm_ffn_g, ffn_w1, ffn_w2,
              dn_w_in, dn_conv_w, dn_a_log, dn_dt_bias, dn_norm_g, dn_w_out,
              gla_w_in, gla_gate_w2, gla_gate_b2, gla_norm_g, gla_w_out,
              attn_w_in, attn_q_norm_g, attn_k_norm_g, attn_w_out):
    n_tok = x.shape[1]
    ROWS = n_tok // GRID_W
    rope = axial_rope_tables(ROWS)
    for i in range(DEPTH):
        with_ctx_out = i < DEPTH - 1
        mix, slot = i % N_MIXERS, i // N_MIXERS
        mod_x = jnp.split((jax.nn.silu(c) @ ada_w[i] + ada_b[i])[:, None, :], 6, axis=-1)
        mod_c = jnp.split(jax.nn.silu(c_ctx) @ ada_w[i] + ada_b[i], 6, axis=-1)
        hx = modulate(rms_norm(x, norm_mix_g[i]), mod_x[0], mod_x[1])
        hc = modulate(rms_norm(ctx, norm_mix_g[i]), mod_c[0], mod_c[1])
        if mix == 0:
            yx, yc = deltanet_mixer(hx, hc, dn_w_in[slot], dn_conv_w[slot], dn_a_log[slot], dn_dt_bias[slot],
                                    dn_norm_g[slot], dn_w_out[slot], with_ctx_out)
        elif mix == 1:
            yx, yc = gla_mixer(hx, hc, gla_w_in[slot], gla_gate_w2[slot], gla_gate_b2[slot],
                               gla_norm_g[slot], gla_w_out[slot], with_ctx_out)
        else:
            yx, yc = attention_mixer(hx, hc, attn_w_in[slot], attn_q_norm_g[slot], attn_k_norm_g[slot],
                                     attn_w_out[slot], rope, with_ctx_out)
        x = x + mod_x[2] * yx
        hx = modulate(rms_norm(x, norm_ffn_g[i]), mod_x[3], mod_x[4])
        x = x + mod_x[5] * squared_relu_ffn(hx, ffn_w1[i], ffn_w2[i])
        if with_ctx_out:
            ctx = ctx + mod_c[2] * yc
            hc = modulate(rms_norm(ctx, norm_ffn_g[i]), mod_c[3], mod_c[4])
            ctx = ctx + mod_c[5] * squared_relu_ffn(hc, ffn_w1[i], ffn_w2[i])
    return x
```

```cpp
#include <hip/hip_runtime.h>
#include <hip/hip_bf16.h>
#include <hip/hip_cooperative_groups.h>
#include <cstdio>
#include <cstdint>
namespace cg = cooperative_groups;
__device__ __forceinline__ int opaque_tid() { int t = threadIdx.x; asm volatile("" : "+v"(t)); return t; }
namespace pg8 {
#define PG8_LAS __attribute__((address_space(3)))
typedef unsigned short bf16_t;
typedef short bf16x8 __attribute__((ext_vector_type(8)));
typedef float f32x4 __attribute__((ext_vector_type(4)));
typedef unsigned u32x4 __attribute__((ext_vector_type(4)));
constexpr int BM = 256, BK = 64, HALF = 128, HTB = HALF * BK * 2  , STAGE_BYTES = 8 * HTB, NXCD = 8, WGM = 8;

__host__ __device__ __forceinline__ int lds_byte(int r, int c) { const int st = (r >> 4) * 2 + (c >> 5), rr = r & 15, cc = c & 31, ob = rr * 64 + cc * 2; return st * 1024 + (ob ^ (((ob >> 9) & 1) << 5)); }
__host__ __device__ __forceinline__ void stage_rc(int b, int& R, int& C) { const int st = b / 1024, sb = b % 1024, swz = sb ^ (((sb >> 9) & 1) << 5); R = (st >> 1) * 16 + swz / 64; C = (st & 1) * 32 + (swz % 64) / 2; }
__host__ __device__ __forceinline__ int perm32(int rho) { const int n = rho >> 4, i = rho & 15; return 8 * (i >> 2) + 4 * n + (i & 3); }

struct Unit { int pm, pn; };
struct Gemm { const bf16_t* A; const bf16_t* Bt; int M, N, K; };

struct StaticOrder {
    int nM, nN, nwg, G, c;
    __host__ __device__ void init(int M, int N, int G_, int c_) { nM = M / BM; nN = N / BM; nwg = nM * nN; G = G_; c = c_; }
    __host__ __device__ bool next(int i, Unit& u) const {
        const long L = (long)i * G + c; if (L >= nwg) return false;
        int wgid = (int)L; { const int q = nwg / NXCD, r = nwg % NXCD, xcd = wgid % NXCD, off = wgid / NXCD; wgid = (xcd < r ? xcd * (q + 1) : r * (q + 1) + (xcd - r) * q) + off; }
        const int nig = WGM * nN, gid = wgid / nig, fm = gid * WGM, gsz = (nM - fm) < WGM ? (nM - fm) : WGM;
        u.pm = fm + ((wgid % nig) % gsz); u.pn = (wgid % nig) / gsz; return true;
    }
    __device__ __forceinline__ void a_ready(const Unit&) const {}
    __device__ __forceinline__ void done(const Unit&) const {}
};

__device__ __forceinline__ unsigned cvt_pk_bf16(float lo, float hi) { unsigned r; asm volatile("v_cvt_pk_bf16_f32 %0, %1, %2" : "=v"(r) : "v"(lo), "v"(hi)); return r; }
typedef float f32x2 __attribute__((ext_vector_type(2)));
typedef float f32x2_t __attribute__((ext_vector_type(2))); typedef __bf16 bf16x2_t __attribute__((ext_vector_type(2)));
__device__ __forceinline__ unsigned cvtpk_s(float lo, float hi) { f32x2_t v = {lo, hi}; bf16x2_t b = __builtin_convertvector(v, bf16x2_t); return __builtin_bit_cast(unsigned, b); }
__device__ __forceinline__ float bf_lo(unsigned w) { return __builtin_bit_cast(float, w << 16); }
__device__ __forceinline__ float bf_hi(unsigned w) { return __builtin_bit_cast(float, w & 0xffff0000u); }
__device__ __forceinline__ float silu_f(float z) { return z / (1.f + __expf(-z)); }
struct Epi {
    static constexpr bool PERM = true, AFTER_DRAIN = false;
    int mode;
    bf16_t* O; int ldc;
    int tail_pn; float* F; int ldf, nf;
    const float* rstd; const float* ng;
    const float* src_lat; const float* src_ctx; float* dst_lat; float* dst_ctx; const float* mod; int gidx;
    __device__ __forceinline__ void operator()(const f32x4 (&acc)[2][2][4][2], const Unit& u, int wr, int wc, int fr, int fq) const {
        const int row0 = u.pm * BM + wr * 64 + fr; const int col0 = u.pn * BM + wc * 32 + 8 * fq;
        if (mode <= 1) {
            if (u.pn == tail_pn) {
                const int c0 = wc * 32 + 8 * fq;
#pragma unroll
                for (int ai = 0; ai < 2; ++ai)
#pragma unroll
                    for (int m = 0; m < 4; ++m)
#pragma unroll
                        for (int bj = 0; bj < 2; ++bj) { const int cc = c0 + bj * HALF;
                            if (cc < nf) { float* p = F + (size_t)(row0 + ai * HALF + m * 16) * ldf + cc; *(f32x4*)p = acc[ai][bj][m][0]; *(f32x4*)(p + 4) = acc[ai][bj][m][1]; } }
            } else {
#pragma unroll
                for (int ai = 0; ai < 2; ++ai)
#pragma unroll
                    for (int m = 0; m < 4; ++m) { bf16_t* rowp = O + (size_t)(row0 + ai * HALF + m * 16) * ldc + col0;
#pragma unroll
                        for (int bj = 0; bj < 2; ++bj) { f32x4 v0 = acc[ai][bj][m][0], v1 = acc[ai][bj][m][1];
                            if (mode == 1) {
#pragma unroll
                                for (int e = 0; e < 4; ++e) { float a = fmaxf(v0[e], 0.f), b = fmaxf(v1[e], 0.f); v0[e] = a * a; v1[e] = b * b; } }
                            u32x4 w; w.x = cvtpk_s(v0[0], v0[1]); w.y = cvtpk_s(v0[2], v0[3]); w.z = cvtpk_s(v1[0], v1[1]); w.w = cvtpk_s(v1[2], v1[3]);
                            *(u32x4*)(rowp + bj * HALF) = w; } }
            }
        } else if (mode == 2) {
            const f32x4 g0 = *(const f32x4*)(ng + (col0 & 127)), g1 = *(const f32x4*)(ng + (col0 & 127) + 4);
#pragma unroll
            for (int ai = 0; ai < 2; ++ai)
#pragma unroll
                for (int m = 0; m < 4; ++m) { const int row = row0 + ai * HALF + m * 16; bf16_t* rowp = O + (size_t)row * ldc + col0;
#pragma unroll
                    for (int bj = 0; bj < 2; ++bj) { const float rs = rstd[(size_t)row * 16 + ((col0 + bj * HALF) >> 7)];
                        const u32x4 ov = *(const u32x4*)(rowp + bj * HALF); const f32x4 z0 = acc[ai][bj][m][0], z1 = acc[ai][bj][m][1];
                        float r[8];
                        r[0] = bf_lo(ov.x) * rs * g0[0] * silu_f(z0[0]); r[1] = bf_hi(ov.x) * rs * g0[1] * silu_f(z0[1]);
                        r[2] = bf_lo(ov.y) * rs * g0[2] * silu_f(z0[2]); r[3] = bf_hi(ov.y) * rs * g0[3] * silu_f(z0[3]);
                        r[4] = bf_lo(ov.z) * rs * g1[0] * silu_f(z1[0]); r[5] = bf_hi(ov.z) * rs * g1[1] * silu_f(z1[1]);
                        r[6] = bf_lo(ov.w) * rs * g1[2] * silu_f(z1[2]); r[7] = bf_hi(ov.w) * rs * g1[3] * silu_f(z1[3]);
                        u32x4 w; w.x = cvtpk_s(r[0], r[1]); w.y = cvtpk_s(r[2], r[3]); w.z = cvtpk_s(r[4], r[5]); w.w = cvtpk_s(r[6], r[7]);
                        *(u32x4*)(rowp + bj * HALF) = w; } }
        } else {
            const int mi = u.pm < 64 ? 0 : (u.pm < 128 ? 1 : 2);
            const float* gate = mod + (size_t)mi * 6144 + (size_t)gidx * 1024;
            const bool lat = u.pm < 128;
            const float* sb = lat ? src_lat : src_ctx - (size_t)32768 * 1024; float* db = lat ? dst_lat : dst_ctx - (size_t)32768 * 1024;
#pragma unroll
            for (int bj = 0; bj < 2; ++bj)
#pragma unroll
                for (int n = 0; n < 2; ++n) { const int c = col0 + bj * HALF + 4 * n; const f32x4 gv = *(const f32x4*)(gate + c);
#pragma unroll
                    for (int ai = 0; ai < 2; ++ai)
#pragma unroll
                        for (int m = 0; m < 4; ++m) { const size_t off = (size_t)(row0 + ai * HALF + m * 16) * 1024 + c;
                            const f32x4 s = *(const f32x4*)(sb + off); *(f32x4*)(db + off) = s + gv * acc[ai][bj][m][n]; } }
        }
    }
};
template <class Epi, class Sched, bool ALIGN_EPI = false, bool SP2 = false>
__device__ __forceinline__ void gemm_phase(PG8_LAS unsigned char* lds, const Gemm g, const Sched& S, const Epi& E) {
    const int tid = opaque_tid(), wid = __builtin_amdgcn_readfirstlane(tid >> 6), lane = tid & 63, wr = wid >> 2, wc = wid & 3, fr = lane & 15, fq = lane >> 4;
    const int K = g.K, nt = K / BK;
    unsigned voffA[2], voffB[2];
#pragma unroll
    for (int i = 0; i < 2; ++i) { int R, C; stage_rc(tid * 16 + i * 8192, R, C); const int Rb = Epi::PERM ? ((R & ~31) + perm32(R & 31)) : R;
        voffA[i] = (unsigned)(R * K + C) * 2u; voffB[i] = (unsigned)(Rb * K + C) * 2u; }
    const size_t kstep = (size_t)(BK * 2);
    const size_t hstep = (size_t)HALF * K * 2;
    const size_t tstep = 2 * hstep;
    const unsigned ldsw = (unsigned)wid * 1024u;
    const int aoff = lds_byte(wr * 64 + fr, fq * 8), boff = lds_byte(wc * 32 + fr, fq * 8);
#define PG8_SA(b, h) (((b) * 2 + (h)) * HTB)
#define PG8_SB(b, h) ((4 + (b) * 2 + (h)) * HTB)
#define PG8_STAGE(bufoff, gbase, voff) do { _Pragma("unroll") for (int _i = 0; _i < 2; ++_i) \
        __builtin_amdgcn_global_load_lds((const unsigned*)((const char*)(gbase) + (voff)[_i]), (PG8_LAS unsigned*)(lds + (bufoff) + ldsw + _i * 8192), 16, 0, 0); } while (0)
#define PG8_LDA(dst, b, h) do { _Pragma("unroll") for (int m = 0; m < 4; ++m) _Pragma("unroll") for (int k = 0; k < 2; ++k) dst[m][k] = *(const PG8_LAS bf16x8*)(lds + PG8_SA(b, h) + aoff + m * 2048 + k * 1024); } while (0)
#define PG8_LDB(dst, b, h) do { _Pragma("unroll") for (int n = 0; n < 2; ++n) _Pragma("unroll") for (int k = 0; k < 2; ++k) dst[n][k] = *(const PG8_LAS bf16x8*)(lds + PG8_SB(b, h) + boff + n * 2048 + k * 1024); } while (0)
#define PG8_MMA(ai, bj, At, Bt) do { __builtin_amdgcn_s_setprio(1); _Pragma("unroll") for (int m = 0; m < 4; ++m) _Pragma("unroll") for (int n = 0; n < 2; ++n) _Pragma("unroll") for (int k = 0; k < 2; ++k) \
        acc[ai][bj][m][n] = __builtin_amdgcn_mfma_f32_16x16x32_bf16(Bt[n][k], At[m][k], acc[ai][bj][m][n], 0, 0, 0); __builtin_amdgcn_s_setprio(0); } while (0)
#define PG8_WAIT_V(n) asm volatile("s_waitcnt vmcnt(" #n ")" ::: "memory")
#define PG8_WAIT_L(n) asm volatile("s_waitcnt lgkmcnt(" #n ")" ::: "memory")
#define PG8_BAR __builtin_amdgcn_s_barrier()
#define PG8_SCHED __builtin_amdgcn_sched_barrier(0)
    Unit cur, nxt; int ui = 0;
    if (!S.next(0, cur)) return;
    f32x4 acc[2][2][4][2];
#pragma unroll
    for (int a = 0; a < 2; ++a)
#pragma unroll
        for (int b = 0; b < 2; ++b)
#pragma unroll
            for (int m = 0; m < 4; ++m)
#pragma unroll
                for (int n = 0; n < 2; ++n) acc[a][b][m][n] = (f32x4){0.f, 0.f, 0.f, 0.f};
    bf16x8 At[4][2], B0[2][2], B1[2][2];
    const char* cA = (const char*)g.A + (size_t)cur.pm * tstep; const char* cB = (const char*)g.Bt + (size_t)cur.pn * tstep;
    S.a_ready(cur);
    if constexpr (SP2) {
        PG8_STAGE(PG8_SB(0, 0), cB, voffB); PG8_STAGE(PG8_SB(0, 1), cB + hstep, voffB); PG8_STAGE(PG8_SA(0, 0), cA, voffA); PG8_STAGE(PG8_SA(0, 1), cA + hstep, voffA);
        if (wr == 1) PG8_BAR;
        PG8_WAIT_V(2); PG8_BAR;
        PG8_STAGE(PG8_SB(1, 0), cB + kstep, voffB); PG8_STAGE(PG8_SA(1, 0), cA + kstep, voffA); PG8_STAGE(PG8_SB(1, 1), cB + hstep + kstep, voffB);
        PG8_WAIT_V(6); PG8_BAR;
    } else {
        PG8_STAGE(PG8_SB(0, 0), cB, voffB); PG8_STAGE(PG8_SA(0, 0), cA, voffA); PG8_STAGE(PG8_SB(0, 1), cB + hstep, voffB); PG8_STAGE(PG8_SA(0, 1), cA + hstep, voffA);
        if (wr == 1) PG8_BAR;
        PG8_WAIT_V(4); PG8_BAR;
        PG8_STAGE(PG8_SB(1, 0), cB + kstep, voffB); PG8_STAGE(PG8_SA(1, 0), cA + kstep, voffA); PG8_STAGE(PG8_SB(1, 1), cB + hstep + kstep, voffB);
        PG8_WAIT_V(6); PG8_BAR;
    }
    for (;;) {
        const bool has_next = S.next(ui + 1, nxt);
        const char* nA = has_next ? (const char*)g.A + (size_t)nxt.pm * tstep : cA; const char* nB = has_next ? (const char*)g.Bt + (size_t)nxt.pn * tstep : cB;
        for (int t = 0; t < nt; t += 2) {
            const bool last = (t == nt - 2);
            const char* a1 = cA + (size_t)(t + 1) * kstep;
            const char* a2 = last ? nA : cA + (size_t)(t + 2) * kstep; const char* b2 = last ? nB : cB + (size_t)(t + 2) * kstep;
            const char* a3 = a2 + kstep; const char* b3 = b2 + kstep;
            if (last && has_next) S.a_ready(nxt);
            if constexpr (SP2) {
            PG8_LDB(B0, 0, 0); PG8_LDB(B1, 0, 1); PG8_SCHED; PG8_LDA(At, 0, 0); PG8_STAGE(PG8_SA(1, 1), a1 + hstep, voffA);
            PG8_WAIT_V(8); PG8_WAIT_L(0); PG8_BAR; PG8_MMA(0, 0, At, B0); PG8_MMA(0, 1, At, B1); PG8_BAR; PG8_SCHED;
            PG8_LDA(At, 0, 1); PG8_STAGE(PG8_SB(0, 0), b2, voffB); PG8_STAGE(PG8_SB(0, 1), b2 + hstep, voffB); PG8_STAGE(PG8_SA(0, 0), a2, voffA);
            PG8_WAIT_V(8); PG8_WAIT_L(0); PG8_BAR; PG8_MMA(1, 0, At, B0); PG8_MMA(1, 1, At, B1); PG8_BAR; PG8_SCHED;
            PG8_LDB(B0, 1, 0); PG8_LDB(B1, 1, 1); PG8_SCHED; PG8_LDA(At, 1, 0); PG8_STAGE(PG8_SA(0, 1), a2 + hstep, voffA);
            PG8_WAIT_V(8); PG8_WAIT_L(0); PG8_BAR; PG8_MMA(0, 0, At, B0); PG8_MMA(0, 1, At, B1); PG8_BAR; PG8_SCHED;
            PG8_LDA(At, 1, 1); PG8_STAGE(PG8_SB(1, 0), b3, voffB); PG8_STAGE(PG8_SB(1, 1), b3 + hstep, voffB); PG8_STAGE(PG8_SA(1, 0), a3, voffA);
            PG8_WAIT_V(8); PG8_WAIT_L(0); PG8_BAR; PG8_MMA(1, 0, At, B0); PG8_MMA(1, 1, At, B1); PG8_BAR; PG8_SCHED;
            } else {
            PG8_LDB(B0, 0, 0); PG8_SCHED; PG8_LDA(At, 0, 0); PG8_STAGE(PG8_SA(1, 1), a1 + hstep, voffA);
            PG8_WAIT_L(8); PG8_BAR; PG8_WAIT_L(0); PG8_MMA(0, 0, At, B0); PG8_BAR; PG8_SCHED;
            PG8_LDB(B1, 0, 1); PG8_STAGE(PG8_SB(0, 0), b2, voffB);
            PG8_BAR; PG8_WAIT_L(0); PG8_MMA(0, 1, At, B1); PG8_BAR;
            PG8_LDA(At, 0, 1); PG8_STAGE(PG8_SA(0, 0), a2, voffA);
            PG8_BAR; PG8_WAIT_L(0); PG8_MMA(1, 0, At, B0); PG8_BAR; PG8_SCHED;
            PG8_STAGE(PG8_SB(0, 1), b2 + hstep, voffB);
            PG8_WAIT_V(6); PG8_BAR; PG8_MMA(1, 1, At, B1); PG8_BAR;
            PG8_LDB(B0, 1, 0); PG8_SCHED; PG8_LDA(At, 1, 0); PG8_STAGE(PG8_SA(0, 1), a2 + hstep, voffA);
            PG8_WAIT_L(8); PG8_BAR; PG8_WAIT_L(0); PG8_MMA(0, 0, At, B0); PG8_BAR; PG8_SCHED;
            PG8_LDB(B1, 1, 1); PG8_STAGE(PG8_SB(1, 0), b3, voffB);
            PG8_BAR; PG8_WAIT_L(0); PG8_MMA(0, 1, At, B1); PG8_BAR;
            PG8_LDA(At, 1, 1); PG8_STAGE(PG8_SA(1, 0), a3, voffA);
            PG8_BAR; PG8_WAIT_L(0); PG8_MMA(1, 0, At, B0); PG8_BAR; PG8_SCHED;
            PG8_STAGE(PG8_SB(1, 1), b3 + hstep, voffB);
            PG8_WAIT_V(6); PG8_BAR; PG8_MMA(1, 1, At, B1); PG8_BAR;
            }
        }
        if constexpr (ALIGN_EPI) { if (wr == 0) PG8_BAR; }
        if constexpr (!Epi::AFTER_DRAIN) { E(acc, cur, wr, wc, fr, fq); S.done(cur); }
        if (!has_next) break;
#pragma unroll
        for (int a = 0; a < 2; ++a)
#pragma unroll
            for (int b = 0; b < 2; ++b)
#pragma unroll
                for (int m = 0; m < 4; ++m)
#pragma unroll
                    for (int n = 0; n < 2; ++n) acc[a][b][m][n] = (f32x4){0.f, 0.f, 0.f, 0.f};
        cur = nxt; cA = nA; cB = nB; ++ui;
        if constexpr (ALIGN_EPI) { if (wr == 1) PG8_BAR; }
    }
    PG8_WAIT_V(0);
    if constexpr (!ALIGN_EPI) { if (wr == 0) PG8_BAR; }
    PG8_BAR;
    if constexpr (Epi::AFTER_DRAIN) { E.fused(acc, cur, wr, wc, fr, fq, lds, wid, lane); S.done(cur); }
#undef PG8_SA
#undef PG8_SB
#undef PG8_STAGE
#undef PG8_LDA
#undef PG8_LDB
#undef PG8_MMA
#undef PG8_WAIT_V
#undef PG8_WAIT_L
#undef PG8_BAR
#undef PG8_SCHED
}
}
namespace attn {
using bf16 = __hip_bfloat16;
constexpr int   D = 128, NW = 8, QBLK = 32, KVBLK = 64;
constexpr float SCALE = 0.088388347648318440f;
constexpr float THR = 8.f;
constexpr int SDEPTH = 2;
constexpr int LDQ = 1024, LDK = 128, LDO = 1024;
constexpr size_t SHM_V = KVBLK * D * 2, SHM_K = KVBLK * D * 2, SHM_ATTN = 2 * SHM_V + 2 * SHM_K + NW * 64 * 4;
using bf16x8 = __attribute__((ext_vector_type(8))) short;
using s16x4  = __attribute__((ext_vector_type(4))) short;
using f32x16 = __attribute__((ext_vector_type(16))) float;
using f32x8  = __attribute__((ext_vector_type(8))) float;
using u32x4  = __attribute__((ext_vector_type(4))) unsigned;
#define KSWZ(row, colB) ((row) * 256 + ((colB) ^ (((row) & 7) << 4)))
#define SBAR() __builtin_amdgcn_sched_barrier(0)
__device__ __forceinline__ int crow(int r, int hi) { return (r & 3) + 8 * (r >> 2) + 4 * hi; }
__device__ __forceinline__ unsigned cvtpk(float lo, float hi) {
  unsigned r; asm volatile("v_cvt_pk_bf16_f32 %0, %1, %2" : "=v"(r) : "v"(lo), "v"(hi)); return r;
}
template <typename TIn> struct Stage;
template <> struct Stage<bf16>  { using T = bf16x8;
  __device__ static __forceinline__ T ld8(const bf16* p) { return *reinterpret_cast<const bf16x8*>(p); }
  __device__ static __forceinline__ bf16x8 tobf(T x) { return x; } };
template <> struct Stage<float> { using T = f32x8;
  __device__ static __forceinline__ T ld8(const float* p) { return *reinterpret_cast<const f32x8*>(p); }
  __device__ static __forceinline__ bf16x8 tobf(T x) {
    u32x4 w = {cvtpk(x[0], x[1]), cvtpk(x[2], x[3]), cvtpk(x[4], x[5]), cvtpk(x[6], x[7])}; return *reinterpret_cast<bf16x8*>(&w); } };

__device__ __forceinline__ void partialSM(f32x16& p0, f32x16& p1, float& m_reg, float& mn, float& alpha) {
  constexpr float C = SCALE * 1.4426950408889634f;
  float pmax = p0[0]; for (int r = 1; r < 16; ++r) pmax = fmaxf(pmax, p0[r]); for (int r = 0; r < 16; ++r) pmax = fmaxf(pmax, p1[r]);
  { auto rr = __builtin_amdgcn_permlane32_swap(__float_as_uint(pmax), __float_as_uint(pmax), false, false);
    pmax = fmaxf(__uint_as_float(rr[0]), __uint_as_float(rr[1])); }
  if (__builtin_expect(__all(pmax - m_reg <= THR / SCALE), 1)) { mn = m_reg; alpha = 1.f; }
  else { mn = fmaxf(m_reg, pmax); alpha = __builtin_amdgcn_exp2f((m_reg - mn) * C); m_reg = mn; }
  float mnC = -mn * C;
  for (int r = 0; r < 16; ++r) p0[r] = fmaf(p0[r], C, mnC); for (int r = 0; r < 16; ++r) p1[r] = fmaf(p1[r], C, mnC);
  for (int r = 0; r < 16; ++r) p0[r] = __builtin_amdgcn_exp2f(p0[r]);
}
__device__ __forceinline__ void finishSM(f32x16& p0, f32x16& p1, float alpha, float& l_reg, bf16x8& pa0, bf16x8& pa1, bf16x8& pa2, bf16x8& pa3) {
  for (int r = 0; r < 16; ++r) p1[r] = __builtin_amdgcn_exp2f(p1[r]);
  float ps = 0; for (int r = 0; r < 16; ++r) ps += p0[r]; for (int r = 0; r < 16; ++r) ps += p1[r];
  { auto rr = __builtin_amdgcn_permlane32_swap(__float_as_uint(ps), __float_as_uint(ps), false, false);
    ps = __uint_as_float(rr[0]) + __uint_as_float(rr[1]); }
  l_reg = l_reg * alpha + ps;
#define PK4(P, BASE, OUT) do { unsigned a0 = cvtpk(P[BASE + 0], P[BASE + 1]), a1 = cvtpk(P[BASE + 2], P[BASE + 3]);   \
    unsigned b0 = cvtpk(P[BASE + 4], P[BASE + 5]), b1 = cvtpk(P[BASE + 6], P[BASE + 7]);                              \
    auto r0 = __builtin_amdgcn_permlane32_swap(a0, b0, false, false); auto r1 = __builtin_amdgcn_permlane32_swap(a1, b1, false, false); \
    u32x4 w = {r0[0], r1[0], r0[1], r1[1]}; OUT = *reinterpret_cast<bf16x8*>(&w); } while (0)
  PK4(p0, 0, pa0); PK4(p0, 8, pa1); PK4(p1, 0, pa2); PK4(p1, 8, pa3);
#undef PK4
}
__device__ __forceinline__ void qkt(f32x16& p0, f32x16& p1, const bf16* Ks, const bf16x8* qr, int r32, int hi) {
  p0 = f32x16{}; p1 = f32x16{};
  for (int d0 = 0; d0 < 8; ++d0) { int cb = (d0 * 16 + hi * 8) * 2;
    bf16x8 b0 = *reinterpret_cast<const bf16x8*>((const char*)Ks + KSWZ(r32, cb));
    bf16x8 b1 = *reinterpret_cast<const bf16x8*>((const char*)Ks + KSWZ(32 + r32, cb));
    p0 = __builtin_amdgcn_mfma_f32_32x32x16_bf16(b0, qr[d0], p0, 0, 0, 0);
    p1 = __builtin_amdgcn_mfma_f32_32x32x16_bf16(b1, qr[d0], p1, 0, 0, 0); }
}
__device__ __forceinline__ int v_st(int k, int c) { const int kk = (k & ~0xC) | ((k & 4) << 1) | ((k & 8) >> 1); return ((kk >> 3) * 4 + (c >> 5)) * 512 + ((kk & 7) * 32 + (c & 31)) * 2; }
__device__ __forceinline__ int v_rd_base(int lane) { return ((lane & 3) << 3) | (((lane >> 2) & 3) << 6) | (((lane >> 4) & 1) << 5) | (((lane >> 5) & 1) << 8); }
constexpr int v_rd_off(int d0, int ks, int half) { return d0 * 512 + ks * 4096 + half * 2048; }
template <int OFF> __device__ __forceinline__ s16x4 tr_read(int vb) {
  s16x4 r; asm volatile("ds_read_b64_tr_b16 %0, %1 offset:%2" : "=&v"(r) : "v"(vb), "i"(OFF) : "memory"); return r;
}
template <int D0> __device__ __forceinline__ void pv_one(f32x16& od, int vb, bf16x8 pa0, bf16x8 pa1, bf16x8 pa2, bf16x8 pa3) {
  const s16x4 l0 = tr_read<v_rd_off(D0, 0, 0)>(vb), h0 = tr_read<v_rd_off(D0, 0, 1)>(vb), l1 = tr_read<v_rd_off(D0, 1, 0)>(vb), h1 = tr_read<v_rd_off(D0, 1, 1)>(vb);
  const s16x4 l2 = tr_read<v_rd_off(D0, 2, 0)>(vb), h2 = tr_read<v_rd_off(D0, 2, 1)>(vb), l3 = tr_read<v_rd_off(D0, 3, 0)>(vb), h3 = tr_read<v_rd_off(D0, 3, 1)>(vb);
  asm volatile("s_waitcnt lgkmcnt(0)" ::: "memory"); SBAR();
#define PK(L, H) (bf16x8){L[0], L[1], L[2], L[3], H[0], H[1], H[2], H[3]}
  od = __builtin_amdgcn_mfma_f32_32x32x16_bf16(pa0, PK(l0, h0), od, 0, 0, 0);
  od = __builtin_amdgcn_mfma_f32_32x32x16_bf16(pa1, PK(l1, h1), od, 0, 0, 0);
  od = __builtin_amdgcn_mfma_f32_32x32x16_bf16(pa2, PK(l2, h2), od, 0, 0, 0);
  od = __builtin_amdgcn_mfma_f32_32x32x16_bf16(pa3, PK(l3, h3), od, 0, 0, 0);
#undef PK
}
__device__ __forceinline__ void pv_d0(f32x16* o, int vb, bf16x8 pa0, bf16x8 pa1, bf16x8 pa2, bf16x8 pa3) {
  pv_one<0>(o[0], vb, pa0, pa1, pa2, pa3); pv_one<1>(o[1], vb, pa0, pa1, pa2, pa3); pv_one<2>(o[2], vb, pa0, pa1, pa2, pa3); pv_one<3>(o[3], vb, pa0, pa1, pa2, pa3);
}

template <typename TQ>
__device__ __forceinline__ void attn_dense_body(const TQ* __restrict__ Qb, const bf16* __restrict__ Kh, const bf16* __restrict__ Vh,
                                                bf16* __restrict__ Ob, int seq, char* lds) {
  using St = Stage<bf16>; using SQ = Stage<TQ>;
  const int tid = opaque_tid(), wid = tid >> 6, lane = tid & 63, r32 = lane & 31, hi = lane >> 5;
  bf16* V_lds = (bf16*)lds; bf16* K_lds = (bf16*)(lds + 2 * SHM_V);
  float* ws = (float*)(lds + 2 * SHM_V + 2 * SHM_K) + wid * 64; float* li_l = ws; float* al_l = ws + 32;
  float m_reg = -1e30f, l_reg = 0; f32x16 o[4] = {}; bf16x8 qr[8];
  const TQ* Qw = Qb + (long)(wid * QBLK + r32) * LDQ + hi * 8;
#pragma unroll
  for (int d0 = 0; d0 < 8; ++d0) qr[d0] = SQ::tobf(SQ::ld8(Qw + d0 * 16));
  const int sr = tid >> 4, sc = (tid & 15) * 8, vst0 = v_st(sr, sc), vst1 = v_st(32 + sr, sc);
  const int vb0 = (int)(uintptr_t)V_lds + v_rd_base(lane);
  struct { typename St::T vs0, vs1, ks0, ks1; } sr_[SDEPTH];
#define SLOAD(i, k0) do { sr_[i].vs0 = St::ld8(&Vh[(long)((k0) + sr) * LDK + sc]); sr_[i].vs1 = St::ld8(&Vh[(long)((k0) + 32 + sr) * LDK + sc]); \
    sr_[i].ks0 = St::ld8(&Kh[(long)((k0) + sr) * LDK + sc]); sr_[i].ks1 = St::ld8(&Kh[(long)((k0) + 32 + sr) * LDK + sc]); } while (0)
#define SWRITE(b, i) do { *(bf16x8*)((char*)V_lds + (b) * SHM_V + vst0) = St::tobf(sr_[i].vs0);          \
    *(bf16x8*)((char*)V_lds + (b) * SHM_V + vst1) = St::tobf(sr_[i].vs1); int kc = sc * 2;               \
    *(bf16x8*)((char*)K_lds + (b) * SHM_K + KSWZ(sr, kc)) = St::tobf(sr_[i].ks0);                       \
    *(bf16x8*)((char*)K_lds + (b) * SHM_K + KSWZ(32 + sr, kc)) = St::tobf(sr_[i].ks1); } while (0)
#define SWAIT() do { if constexpr (SDEPTH == 2) asm volatile("s_waitcnt vmcnt(4)" ::: "memory"); else asm volatile("s_waitcnt vmcnt(0)" ::: "memory"); } while (0)
#define RESC(a) do { if (__any((a) < 1.f)) { if (hi == 0) al_l[r32] = (a); asm volatile("s_waitcnt lgkmcnt(0)" ::: "memory"); \
    for (int d = 0; d < 4; ++d) for (int r = 0; r < 16; ++r) o[d][r] *= al_l[crow(r, hi)]; } } while (0)
  f32x16 pA0, pA1, pB0, pB1; float mnA, mnB, alA, alB; bf16x8 pa0, pa1, pa2, pa3; const int NT = seq / KVBLK;
  constexpr int SE = 0, SO = SDEPTH - 1;
  SLOAD(SE, 0); asm volatile("s_waitcnt vmcnt(0)" ::: "memory"); SWRITE(0, SE); __syncthreads();
  qkt(pA0, pA1, K_lds, qr, r32, hi); partialSM(pA0, pA1, m_reg, mnA, alA);
  SLOAD(SO, KVBLK); if constexpr (SDEPTH == 2) { if (2 < NT) SLOAD(SE, 2 * KVBLK); }
  SWAIT(); SWRITE(1, SO); __syncthreads();
  for (int j = 1; j + 1 < NT; j += 2) {
    SBAR(); qkt(pB0, pB1, (bf16*)((char*)K_lds + SHM_K), qr, r32, hi);
    finishSM(pA0, pA1, alA, l_reg, pa0, pa1, pa2, pa3); SBAR();
    SLOAD(SO, (j + SDEPTH) * KVBLK); SBAR();
    pv_d0(o, vb0, pa0, pa1, pa2, pa3); partialSM(pB0, pB1, m_reg, mnB, alB);
    __syncthreads(); SWAIT(); SWRITE(0, SE);
    RESC(alB); __syncthreads();
    SBAR(); qkt(pA0, pA1, K_lds, qr, r32, hi);
    finishSM(pB0, pB1, alB, l_reg, pa0, pa1, pa2, pa3); SBAR();
    if (SDEPTH == 1 || j + 3 < NT) SLOAD(SE, (j + 1 + SDEPTH) * KVBLK); SBAR();
    pv_d0(o, vb0 + (int)SHM_V, pa0, pa1, pa2, pa3); partialSM(pA0, pA1, m_reg, mnA, alA);
    __syncthreads(); SWAIT(); SWRITE(1, SO);
    RESC(alA); __syncthreads();
  }
  SBAR(); qkt(pB0, pB1, (bf16*)((char*)K_lds + SHM_K), qr, r32, hi);
  finishSM(pA0, pA1, alA, l_reg, pa0, pa1, pa2, pa3); SBAR();
  pv_d0(o, vb0, pa0, pa1, pa2, pa3); partialSM(pB0, pB1, m_reg, mnB, alB);
  __syncthreads(); RESC(alB);
  finishSM(pB0, pB1, alB, l_reg, pa0, pa1, pa2, pa3); SBAR();
  pv_d0(o, vb0 + (int)SHM_V, pa0, pa1, pa2, pa3);
  if (hi == 0) li_l[r32] = l_reg; asm volatile("s_waitcnt lgkmcnt(0)" ::: "memory");
  float rli[16];
#pragma unroll
  for (int r = 0; r < 16; ++r) rli[r] = __builtin_amdgcn_rcpf(li_l[crow(r, hi)]);
  bf16* Ow = Ob + (long)(wid * QBLK) * LDO;
#pragma unroll
  for (int r = 0; r < 16; ++r) { int orow = crow(r, hi);
    for (int d0 = 0; d0 < 4; ++d0) Ow[(long)orow * LDO + d0 * 32 + r32] = __float2bfloat16(o[d0][r] * rli[r]); }
#undef SLOAD
#undef SWRITE
#undef SWAIT
#undef RESC
}

}
#define LAS __attribute__((address_space(3)))
typedef unsigned short bf16_t;
typedef short bf16x8 __attribute__((ext_vector_type(8)));
typedef short s16x4 __attribute__((ext_vector_type(4)));
typedef float f32x4 __attribute__((ext_vector_type(4)));
typedef float f32x16 __attribute__((ext_vector_type(16)));
typedef unsigned u32x4 __attribute__((ext_vector_type(4)));
typedef unsigned u32x2 __attribute__((ext_vector_type(2)));
using pg8::cvtpk_s; using pg8::bf_lo; using pg8::bf_hi; using pg8::silu_f;

constexpr int DM = 1024, SEQ = 16384, CTXL = 256, NLAT = 2 * SEQ, MROWS = NLAT + 2 * CTXL, DFF = 4096;
constexpr float EPS = 1e-6f;
constexpr size_t MiB = 1u << 20;
constexpr size_t WS_MOD = 0, WS_CTX = 1 * MiB, WS_WT = 4 * MiB, WS_H = 41 * MiB, WS_AB = 106 * MiB, WS_RSTD = 115 * MiB, WS_P = 118 * MiB, WS_O = 378 * MiB, WS_END = 508 * MiB;
constexpr size_t WT_A = WS_WT, WT_Z = WS_WT + 9 * MiB, WT_O = WS_WT + 13 * MiB, WT_1 = WS_WT + 17 * MiB, WT_2 = WS_WT + 25 * MiB;
constexpr size_t WS_GK = 313 * MiB, WS_OGLA = 443 * MiB;
constexpr size_t WS_QR = 216 * MiB, WS_KR = 281 * MiB, WS_VR = 298 * MiB;
constexpr int SKV = SEQ + CTXL;
constexpr int LDS_BYTES = 155648;
constexpr int NPHASE = 36;
enum { OP_MOD, OP_PREP, OP_GEMM_IN, OP_DNSCAN, OP_DNRSTD, OP_GEMM_Z, OP_GEMM_OUT, OP_NORM2, OP_FFN1, OP_FFN2, OP_GK, OP_GLASCAN, OP_GLAGATE, OP_QKROPE, OP_ATTN };

struct Args { const float* in[25]; float* out; unsigned char* ws; int ph_lo, ph_hi; };

__device__ __forceinline__ float wave_sum(float v) {
#pragma unroll
    for (int o = 1; o < 64; o <<= 1) v += __shfl_xor(v, o);
    return v;
}
__device__ __forceinline__ float softplus_f(float x) { return x > 20.f ? x : log1pf(__expf(x)); }
__device__ __forceinline__ float logsigmoid_f(float x) { return fminf(x, 0.f) - log1pf(__expf(-fabsf(x))); }
__device__ __forceinline__ bf16_t f2bf(float f) { return (bf16_t)(cvtpk_s(f, 0.f) & 0xffffu); }
__device__ __forceinline__ float bf2f(bf16_t v) { return __builtin_bit_cast(float, (unsigned)v << 16); }

__device__ __forceinline__ void transpose_item(const float* W, int ldw, int c0, int ncols, int K, bf16_t* WT, int row_off, LAS float* scr, int item, int lane) {
    const int nblk = ncols / 32, kb = item / nblk, nb = item % nblk, k0 = 64 * kb, n0 = 32 * nb;
#pragma unroll 8
    for (int i = 0; i < 32; ++i) { const int kk = 2 * i + (lane >> 5); scr[kk * 33 + (lane & 31)] = W[(size_t)(k0 + kk) * ldw + c0 + n0 + (lane & 31)]; }
    asm volatile("s_waitcnt lgkmcnt(0)" ::: "memory");
    const int c = lane & 7;
#pragma unroll
    for (int j = 0; j < 4; ++j) { const int n = (lane >> 3) + 8 * j; const LAS float* s = scr + (8 * c) * 33 + n;
        u32x4 o; o.x = cvtpk_s(s[0 * 33], s[1 * 33]); o.y = cvtpk_s(s[2 * 33], s[3 * 33]); o.z = cvtpk_s(s[4 * 33], s[5 * 33]); o.w = cvtpk_s(s[6 * 33], s[7 * 33]);
        *(u32x4*)(WT + (size_t)(row_off + n0 + n) * K + k0 + 8 * c) = o; }
    asm volatile("s_waitcnt lgkmcnt(0)" ::: "memory");
}
__device__ __forceinline__ void transpose_mat(const float* W, int ldw, int c0, int ncols, int K, bf16_t* WT, int row_off, LAS float* scr, int gw, int NGW, int lane) {
    const int nitems = (K / 64) * (ncols / 32);
    for (int it = gw; it < nitems; it += NGW) transpose_item(W, ldw, c0, ncols, K, WT, row_off, scr, it, lane);
}
__device__ __forceinline__ void normmod_rows(const float* xl, const float* xc, const float* g, const float* modl, int sidx, bf16_t* H, int gw, int NGW, int lane) {
    for (int row = gw; row < MROWS; row += NGW) {
        const float* xr = row < NLAT ? xl + (size_t)row * DM : xc + (size_t)(row - NLAT) * DM;
        const int mi = row < SEQ ? 0 : (row < NLAT ? 1 : 2);
        const float* sh = modl + (size_t)mi * 6144 + (size_t)sidx * 1024; const float* sc = sh + 1024;
        f32x4 v[4]; float ss = 0.f;
#pragma unroll
        for (int j = 0; j < 4; ++j) { v[j] = *(const f32x4*)(xr + 4 * lane + 256 * j); ss += (v[j][0] * v[j][0] + v[j][1] * v[j][1]) + (v[j][2] * v[j][2] + v[j][3] * v[j][3]); }
        const float rinv = rsqrtf(wave_sum(ss) * (1.f / DM) + EPS);
#pragma unroll
        for (int j = 0; j < 4; ++j) { const int c = 4 * lane + 256 * j; const f32x4 gg = *(const f32x4*)(g + c), s1 = *(const f32x4*)(sc + c), s0 = *(const f32x4*)(sh + c);
            f32x4 y;
#pragma unroll
            for (int e = 0; e < 4; ++e) y[e] = v[j][e] * rinv * gg[e] * (1.f + s1[e]) + s0[e];
            u32x2 w; w.x = cvtpk_s(y[0], y[1]); w.y = cvtpk_s(y[2], y[3]); *(u32x2*)(H + (size_t)row * DM + c) = w; }
    }
}
__device__ __forceinline__ int crow(int x, int h) { return (x & 3) + 8 * (x >> 2) + 4 * h; }
#define MFMA32(a, b, c) __builtin_amdgcn_mfma_f32_32x32x16_bf16((a), (b), (c), 0, 0, 0)
__device__ __forceinline__ bf16x8 frag_nat(const LAS bf16_t* img, int LD, int row, int ks, int h) { return *(const LAS bf16x8*)(img + row * LD + 16 * ks + 8 * h); }
__device__ __forceinline__ bf16x8 frag_perm(const LAS bf16_t* img, int LD, int row, int ks, int h) {
    const s16x4 lo = *(const LAS s16x4*)(img + row * LD + 16 * ks + 4 * h), hi = *(const LAS s16x4*)(img + row * LD + 16 * ks + 8 + 4 * h);
    return __builtin_shufflevector(lo, hi, 0, 1, 2, 3, 4, 5, 6, 7);
}
__device__ __forceinline__ s16x4 tr4(const LAS bf16_t* p) { return __builtin_bit_cast(s16x4, __builtin_amdgcn_ds_read_tr16_b64_v4i16((LAS s16x4*)p)); }
__device__ __forceinline__ bf16x8 frag_tr(const LAS bf16_t* img, int LD, int m0, int ks, int lane) {
    const int i16 = lane & 15, q = i16 >> 2, p = i16 & 3, blk = (lane >> 4) & 1, h = lane >> 5;
    const LAS bf16_t* a = img + (16 * ks + 4 * h + q) * LD + m0 + 16 * blk + 4 * p;
    const s16x4 lo = tr4(a), hi = tr4(a + 8 * LD);
    return __builtin_shufflevector(lo, hi, 0, 1, 2, 3, 4, 5, 6, 7);
}
__device__ __forceinline__ bf16x8 pack_step(const f32x16& x, int s) {
    u32x4 p; p.x = cvtpk_s(x[8 * s + 0], x[8 * s + 1]); p.y = cvtpk_s(x[8 * s + 2], x[8 * s + 3]); p.z = cvtpk_s(x[8 * s + 4], x[8 * s + 5]); p.w = cvtpk_s(x[8 * s + 6], x[8 * s + 7]);
    return __builtin_bit_cast(bf16x8, p);
}
constexpr int DN_KB = 0, DN_QB = 17408, DN_VB = 34816, DN_R = 51200, DN_SC = 69632, DN_DIR = 71168, DN_CW = 142336;
template <int W> __device__ __forceinline__ void dn_solve(const LAS float* Mf, float (&t)[16], int lane) {
    const int j = 16 * W + (lane >> 2), q = lane & 3;
#pragma unroll
    for (int s = 0; s < 16; ++s) t[s] = 0.f;
#pragma unroll
    for (int i = 16 * W; i < 64; ++i) {
        float acc = 0.f;
#pragma unroll
        for (int s = 4 * W; s <= (i - 1) / 4 && i > 16 * W; ++s) acc += Mf[i * 64 + 4 * s + q] * t[s];
        acc += __shfl_xor(acc, 1); acc += __shfl_xor(acc, 2);
        const float val = (i == j ? 1.f : 0.f) - acc;
        if (q == (i & 3)) t[i >> 2] = val;
        asm volatile("" : "+v"(t[0]), "+v"(t[1]), "+v"(t[2]), "+v"(t[3]), "+v"(t[4]), "+v"(t[5]), "+v"(t[6]), "+v"(t[7]), "+v"(t[8]), "+v"(t[9]), "+v"(t[10]), "+v"(t[11]), "+v"(t[12]), "+v"(t[13]), "+v"(t[14]), "+v"(t[15]));
    }
}
__device__ __forceinline__ void dn_conv32(const bf16_t* P, int grow, int seq_lo, int seq_hi, int col, const LAS float* cw  , int ch0, float (&acc)[32]) {
#pragma unroll
    for (int c = 0; c < 32; ++c) acc[c] = 0.f;
#pragma unroll
    for (int tap = 0; tap < 5; ++tap) {
        const int rr = grow + tap - 2;
        if (rr >= seq_lo && rr < seq_hi) {
            const u32x4* src = (const u32x4*)(P + (size_t)rr * 4096 + col);
#pragma unroll
            for (int v = 0; v < 4; ++v) { const u32x4 x = src[v];
                const int c = 8 * v;
                acc[c + 0] += bf_lo(x.x) * cw[(ch0 + c + 0) * 5 + tap]; acc[c + 1] += bf_hi(x.x) * cw[(ch0 + c + 1) * 5 + tap];
                acc[c + 2] += bf_lo(x.y) * cw[(ch0 + c + 2) * 5 + tap]; acc[c + 3] += bf_hi(x.y) * cw[(ch0 + c + 3) * 5 + tap];
                acc[c + 4] += bf_lo(x.z) * cw[(ch0 + c + 4) * 5 + tap]; acc[c + 5] += bf_hi(x.z) * cw[(ch0 + c + 5) * 5 + tap];
                acc[c + 6] += bf_lo(x.w) * cw[(ch0 + c + 6) * 5 + tap]; acc[c + 7] += bf_hi(x.w) * cw[(ch0 + c + 7) * 5 + tap]; }
        }
    }
#pragma unroll
    for (int c = 0; c < 32; ++c) acc[c] = silu_f(acc[c]);
}
__device__ __forceinline__ void store32_bf16(LAS bf16_t* dst, const float (&a)[32], float s) {
#pragma unroll
    for (int v = 0; v < 4; ++v) { u32x4 w; w.x = cvtpk_s(a[8 * v] * s, a[8 * v + 1] * s); w.y = cvtpk_s(a[8 * v + 2] * s, a[8 * v + 3] * s); w.z = cvtpk_s(a[8 * v + 4] * s, a[8 * v + 5] * s); w.w = cvtpk_s(a[8 * v + 6] * s, a[8 * v + 7] * s);
        *(LAS u32x4*)(dst + 8 * v) = w; }
}
__device__ __forceinline__ void dn_scan(LAS unsigned char* lds, const bf16_t* P, const float* AB, bf16_t* OB, const float* conv_w, const float* a_log, const float* dt_bias) {
    const int tid = opaque_tid(), dir = __builtin_amdgcn_readfirstlane(tid >> 8);
    LAS float* cw = (LAS float*)(lds + DN_CW);
    for (int unit = blockIdx.x; unit < 32; unit += gridDim.x) {
        const int b = unit >> 4, vh = unit & 15, kh = vh >> 1;
        __syncthreads();
        for (int e = tid; e < 3 * 640; e += 512) { const int which = e / 640, rem = e % 640; const int chbase = which == 0 ? kh * 128 : (which == 1 ? 1024 + kh * 128 : 2048 + vh * 128);
            cw[e] = conv_w[(size_t)chbase * 5 + rem]; }
        const float na = -__expf(a_log[dir * 16 + vh]), dtb = dt_bias[dir * 16 + vh];
        f32x16 S[4];
#pragma unroll
        for (int kt = 0; kt < 4; ++kt)
#pragma unroll
            for (int x = 0; x < 16; ++x) S[kt][x] = 0.f;
        __syncthreads();
        for (int step = 0; step < 260; ++step) {
            const int tq = opaque_tid(), t = tq & 255, w = __builtin_amdgcn_readfirstlane((tq >> 6) & 3), lane = tq & 63, r = lane & 31, h = lane >> 5;
            LAS unsigned char* base = lds + dir * DN_DIR;
            LAS bf16_t* Kb = (LAS bf16_t*)(base + DN_KB); LAS bf16_t* Qb = (LAS bf16_t*)(base + DN_QB); LAS bf16_t* Vb = (LAS bf16_t*)(base + DN_VB);
            LAS float* Mf = (LAS float*)(base + DN_R); LAS bf16_t* Tb = (LAS bf16_t*)(base + DN_R); LAS bf16_t* Ab = (LAS bf16_t*)(base + DN_R + 9216);
            LAS float* sc_beta = (LAS float*)(base + DN_SC); LAS float* sc_gc = sc_beta + 64; LAS float* sc_eg = sc_beta + 128; LAS float* sc_tail = sc_beta + 192; LAS float* sc_dl = sc_beta + 256;
            int cidx, row_base, seq_lo, seq_hi; bool first;
            if (step < 4) { cidx = dir ? 3 - step : step; seq_lo = NLAT + b * CTXL; seq_hi = seq_lo + CTXL; row_base = seq_lo + cidx * 64; first = step < 2; }
            else { const int c = step - 4; cidx = dir ? 255 - c : c; seq_lo = b * SEQ; seq_hi = seq_lo + SEQ; row_base = seq_lo + cidx * 64; first = c < 128; }
            {
                const int tq_ = opaque_tid(), t = tq_ & 255, lane = tq_ & 63, r = lane & 31, h = lane >> 5; (void)t; (void)r; (void)h;
                const int i = t >> 2, ch0 = 32 * (t & 3), ip = dir ? 63 - i : i, grow = row_base + i;
                float a[32];
                dn_conv32(P, grow, seq_lo, seq_hi, 1024 + kh * 128 + ch0, cw + 640, ch0, a);
                float ss = 0.f;
#pragma unroll
                for (int c = 0; c < 32; ++c) ss += a[c] * a[c];
                ss += __shfl_xor(ss, 1); ss += __shfl_xor(ss, 2);
                store32_bf16(Kb + ip * 136 + ch0, a, rsqrtf(ss + EPS));
                __builtin_amdgcn_sched_barrier(0);
                dn_conv32(P, grow, seq_lo, seq_hi, kh * 128 + ch0, cw, ch0, a);
                ss = 0.f;
#pragma unroll
                for (int c = 0; c < 32; ++c) ss += a[c] * a[c];
                ss += __shfl_xor(ss, 1); ss += __shfl_xor(ss, 2);
                store32_bf16(Qb + ip * 136 + ch0, a, rsqrtf(ss + EPS) * 0.08838834764831845f);
                __builtin_amdgcn_sched_barrier(0);
                dn_conv32(P, grow, seq_lo, seq_hi, 2048 + vh * 128 + ch0, cw + 1280, ch0, a);
                store32_bf16(Vb + ip * 128 + ch0, a, 1.f);
                __builtin_amdgcn_sched_barrier(0);
                if (t < 64) {
                    const int ti = dir ? 63 - t : t; const size_t gr = (size_t)(row_base + ti) * 64;
                    const float av = AB[gr + dir * 16 + vh], bv = AB[gr + 32 + dir * 16 + vh];
                    const float g = na * softplus_f(av + dtb), beta = 1.f / (1.f + __expf(-bv));
                    float gc = g;
#pragma unroll
                    for (int o = 1; o < 64; o <<= 1) { const float up = __shfl_up(gc, o); if (t >= o) gc += up; }
                    const float gl = __shfl(gc, 63);
                    sc_beta[t] = beta; sc_gc[t] = gc; sc_eg[t] = __expf(gc); sc_tail[t] = __expf(gl - gc); if (t == 0) sc_dl[0] = __expf(gl);
                }
            }
            __syncthreads();
            const int ti = w >> 1, tj = w & 1;
            {
                const int tq_ = opaque_tid(), t = tq_ & 255, lane = tq_ & 63, r = lane & 31, h = lane >> 5; (void)t; (void)r; (void)h;
                f32x16 acc;
#pragma unroll
                for (int x = 0; x < 16; ++x) acc[x] = 0.f;
                if (!(ti == 0 && tj == 1)) {
#pragma unroll
                    for (int ks = 0; ks < 8; ++ks) acc = MFMA32(frag_nat(Kb, 136, 32 * ti + r, ks, h), frag_nat(Kb, 136, 32 * tj + r, ks, h), acc);
                }
                const int j = 32 * tj + r; const float gj = sc_gc[j];
#pragma unroll
                for (int x = 0; x < 16; ++x) { const int i = 32 * ti + crow(x, h);
                    Mf[i * 64 + j] = (i > j) ? sc_beta[i] * acc[x] * __expf(sc_gc[i] - gj) : 0.f; }
            }
            __syncthreads();
            __builtin_amdgcn_sched_barrier(0);
            float tc[16];
            if (w == 0) dn_solve<0>(Mf, tc, lane); else if (w == 1) dn_solve<1>(Mf, tc, lane); else if (w == 2) dn_solve<2>(Mf, tc, lane); else dn_solve<3>(Mf, tc, lane);
            __builtin_amdgcn_sched_barrier(0);
            f32x16 qk;
#pragma unroll
            for (int x = 0; x < 16; ++x) qk[x] = 0.f;
            if (!(ti == 0 && tj == 1)) {
#pragma unroll
                for (int ks = 0; ks < 8; ++ks) qk = MFMA32(frag_nat(Qb, 136, 32 * ti + r, ks, h), frag_nat(Kb, 136, 32 * tj + r, ks, h), qk);
            }
            __syncthreads();
            {
                const int tq_ = opaque_tid(), t = tq_ & 255, lane = tq_ & 63, r = lane & 31, h = lane >> 5; (void)t; (void)r; (void)h;
                const int j = 16 * w + (lane >> 2), q = lane & 3;
#pragma unroll
                for (int s = 0; s < 16; ++s) Tb[(4 * s + q) * 72 + j] = f2bf(tc[s]);
                const int jj = 32 * tj + r; const float gj = sc_gc[jj];
#pragma unroll
                for (int x = 0; x < 16; ++x) { const int i = 32 * ti + crow(x, h);
                    Ab[i * 72 + jj] = f2bf((i >= jj) ? qk[x] * __expf(sc_gc[i] - gj) : 0.f); }
            }
            __syncthreads();
            {
                const int tq_ = opaque_tid(), t = tq_ & 255, lane = tq_ & 63, r = lane & 31, h = lane >> 5; (void)t; (void)r; (void)h;
                bf16x8 Sp[8];
#pragma unroll
                for (int ks = 0; ks < 8; ++ks) Sp[ks] = pack_step(S[ks >> 1], ks & 1);
                f32x16 KS[2], QS[2];
#pragma unroll
                for (int mt = 0; mt < 2; ++mt) {
#pragma unroll
                    for (int x = 0; x < 16; ++x) { KS[mt][x] = 0.f; QS[mt][x] = 0.f; }
#pragma unroll
                    for (int ks = 0; ks < 8; ++ks) { KS[mt] = MFMA32(frag_perm(Kb, 136, 32 * mt + r, ks, h), Sp[ks], KS[mt]); QS[mt] = MFMA32(frag_perm(Qb, 136, 32 * mt + r, ks, h), Sp[ks], QS[mt]); }
                    __builtin_amdgcn_sched_barrier(0);
                }
                __builtin_amdgcn_sched_barrier(0);
#pragma unroll
                for (int mt = 0; mt < 2; ++mt)
#pragma unroll
                    for (int x = 0; x < 16; ++x) { const int i = 32 * mt + crow(x, h);
                        KS[mt][x] = sc_beta[i] * (bf2f(Vb[i * 128 + 32 * w + r]) - sc_eg[i] * KS[mt][x]); }
                __builtin_amdgcn_sched_barrier(0);
                bf16x8 Xp[4];
#pragma unroll
                for (int ks = 0; ks < 4; ++ks) Xp[ks] = pack_step(KS[ks >> 1], ks & 1);
                __builtin_amdgcn_sched_barrier(0);
                f32x16 VN[2];
#pragma unroll
                for (int mt = 0; mt < 2; ++mt) {
#pragma unroll
                    for (int x = 0; x < 16; ++x) VN[mt][x] = 0.f;
#pragma unroll
                    for (int ks = 0; ks < 4; ++ks) VN[mt] = MFMA32(frag_perm(Tb, 72, 32 * mt + r, ks, h), Xp[ks], VN[mt]);
                }
                __builtin_amdgcn_sched_barrier(0);
                bf16x8 VNp[4];
#pragma unroll
                for (int ks = 0; ks < 4; ++ks) VNp[ks] = pack_step(VN[ks >> 1], ks & 1);
                __builtin_amdgcn_sched_barrier(0);
#pragma unroll
                for (int mt = 0; mt < 2; ++mt) {
#pragma unroll
                    for (int x = 0; x < 16; ++x) QS[mt][x] *= sc_eg[32 * mt + crow(x, h)];
#pragma unroll
                    for (int ks = 0; ks < 4; ++ks) QS[mt] = MFMA32(frag_perm(Ab, 72, 32 * mt + r, ks, h), VNp[ks], QS[mt]);
                }
                __builtin_amdgcn_sched_barrier(0);
#pragma unroll
                for (int mt = 0; mt < 2; ++mt)
#pragma unroll
                    for (int x = 0; x < 16; ++x) Vb[(32 * mt + crow(x, h)) * 128 + 32 * w + r] = f2bf(QS[mt][x]);
                __builtin_amdgcn_sched_barrier(0);
#pragma unroll
                for (int mt = 0; mt < 2; ++mt)
#pragma unroll
                    for (int x = 0; x < 16; ++x) VN[mt][x] *= sc_tail[32 * mt + crow(x, h)];
#pragma unroll
                for (int ks = 0; ks < 4; ++ks) VNp[ks] = pack_step(VN[ks >> 1], ks & 1);
                __builtin_amdgcn_sched_barrier(0);
                const float dl = sc_dl[0];
#pragma unroll
                for (int kt = 0; kt < 4; ++kt) {
#pragma unroll
                    for (int x = 0; x < 16; ++x) S[kt][x] *= dl;
#pragma unroll
                    for (int ks = 0; ks < 4; ++ks) S[kt] = MFMA32(frag_tr(Kb, 136, 32 * kt, ks, lane), VNp[ks], S[kt]);
                    __builtin_amdgcn_sched_barrier(0);
                }
            }
            __syncthreads();
            {
                const int tq_ = opaque_tid(), t = tq_ & 255, lane = tq_ & 63, r = lane & 31, h = lane >> 5; (void)t; (void)r; (void)h;
                const int i = t >> 2, ch0 = 32 * (t & 3), ip = dir ? 63 - i : i;
                u32x4* gp = (u32x4*)(OB + (size_t)(row_base + i) * 2048 + vh * 128 + ch0);
#pragma unroll
                for (int v = 0; v < 4; ++v) { u32x4 o = *(const LAS u32x4*)(Vb + ip * 128 + ch0 + 8 * v);
                    if (!first) { const u32x4 e = gp[v];
                        o.x = cvtpk_s(bf_lo(o.x) + bf_lo(e.x), bf_hi(o.x) + bf_hi(e.x)); o.y = cvtpk_s(bf_lo(o.y) + bf_lo(e.y), bf_hi(o.y) + bf_hi(e.y));
                        o.z = cvtpk_s(bf_lo(o.z) + bf_lo(e.z), bf_hi(o.z) + bf_hi(e.z)); o.w = cvtpk_s(bf_lo(o.w) + bf_lo(e.w), bf_hi(o.w) + bf_hi(e.w)); }
                    gp[v] = o; }
            }
            __syncthreads();
        }
    }
}
constexpr int GL_QM = 0, GL_KM = 17408, GL_VB = 34816, GL_AB = 52224, GL_EL = 61440, GL_TOT = 61952, GL_DIR = 62976;
__device__ __forceinline__ void gla_scan(LAS unsigned char* lds, const bf16_t* P  , const float* GK  , bf16_t* OB  ) {
    const int tid = opaque_tid(), dir = __builtin_amdgcn_readfirstlane(tid >> 8);
    for (int unit = blockIdx.x; unit < 16; unit += gridDim.x) {
        const int b = unit >> 3, head = (unit >> 1) & 3, hf = unit & 1;
        f32x16 S[4];
#pragma unroll
        for (int kt = 0; kt < 4; ++kt)
#pragma unroll
            for (int x = 0; x < 16; ++x) S[kt][x] = 0.f;
        __syncthreads();
        for (int step = 0; step < 260; ++step) {
            const int tq = opaque_tid(), t = tq & 255, w = __builtin_amdgcn_readfirstlane((tq >> 6) & 3), lane = tq & 63, r = lane & 31, h = lane >> 5;
            LAS unsigned char* base = lds + dir * GL_DIR;
            LAS bf16_t* Qm = (LAS bf16_t*)(base + GL_QM); LAS bf16_t* Km = (LAS bf16_t*)(base + GL_KM); LAS bf16_t* Vb = (LAS bf16_t*)(base + GL_VB); LAS bf16_t* Ab = (LAS bf16_t*)(base + GL_AB);
            LAS float* el = (LAS float*)(base + GL_EL); LAS float* tot = (LAS float*)(base + GL_TOT);
            int cidx, row_base; bool first;
            if (step < 4) { cidx = dir ? 3 - step : step; row_base = NLAT + b * CTXL + cidx * 64; first = step < 2; }
            else { const int c = step - 4; cidx = dir ? 255 - c : c; row_base = b * SEQ + cidx * 64; first = c < 128; }
            const int dk = t & 127, half = t >> 7;
            const long gstep = dir ? -1024 : 1024, pstep = dir ? -3072 : 3072;
            const int i0 = dir ? 63 - 32 * half : 32 * half;
            const float* gk0 = GK + (size_t)(row_base + i0) * 1024 + dir * 512 + head * 128 + dk;
            {
                float run = 0.f; const float* gp = gk0;
#pragma unroll 4
                for (int n = 0; n < 32; ++n) { run += *gp; gp += gstep; }
                tot[half * 128 + dk] = run;
            }
            {
                const int i = t >> 2, ch0 = 32 * (t & 3), ip = dir ? 63 - i : i;
                const u32x4* src = (const u32x4*)(P + (size_t)(row_base + i) * 3072 + 1024 + head * 256 + hf * 128 + ch0);
#pragma unroll
                for (int v = 0; v < 4; ++v) *(LAS u32x4*)(Vb + ip * 136 + ch0 + 8 * v) = src[v];
            }
            __syncthreads();
            {
                const float t0 = tot[dk], last = t0 + tot[128 + dk];
                if (half == 0) el[dk] = last;
                float run = half ? t0 : 0.f; const float* gp = gk0; const bf16_t* pp = P + (size_t)(row_base + i0) * 3072 + head * 128 + dk;
#pragma unroll 4
                for (int n = 0; n < 32; ++n) { const int ip = 32 * half + n; run += *gp; gp += gstep;
                    const float qv = bf2f(pp[0]), kv = bf2f(pp[512]); pp += pstep;
                    Qm[ip * 136 + dk] = f2bf(qv * 0.08838834764831845f * __expf(run - last));
                    Km[ip * 136 + dk] = f2bf(kv * __expf(last - run)); }
            }
            __syncthreads();
            {
                const int ti = w >> 1, tj = w & 1;
                f32x16 acc;
#pragma unroll
                for (int x = 0; x < 16; ++x) acc[x] = 0.f;
                if (!(ti == 0 && tj == 1)) {
#pragma unroll
                    for (int ks = 0; ks < 8; ++ks) acc = MFMA32(frag_nat(Qm, 136, 32 * ti + r, ks, h), frag_nat(Km, 136, 32 * tj + r, ks, h), acc);
                }
                const int j = 32 * tj + r;
#pragma unroll
                for (int x = 0; x < 16; ++x) { const int i = 32 * ti + crow(x, h); Ab[i * 72 + j] = f2bf(i >= j ? acc[x] : 0.f); }
            }
            __syncthreads();
            {
#pragma unroll
                for (int kt = 0; kt < 4; ++kt)
#pragma unroll
                    for (int x = 0; x < 16; ++x) S[kt][x] *= __expf(el[32 * kt + crow(x, h)]);
                bf16x8 Sp[8];
#pragma unroll
                for (int ks = 0; ks < 8; ++ks) Sp[ks] = pack_step(S[ks >> 1], ks & 1);
                bf16x8 Vf[4];
#pragma unroll
                for (int ks = 0; ks < 4; ++ks) Vf[ks] = frag_tr(Vb, 136, 32 * w, ks, lane);
                f32x16 O[2];
#pragma unroll
                for (int mt = 0; mt < 2; ++mt) {
#pragma unroll
                    for (int x = 0; x < 16; ++x) O[mt][x] = 0.f;
#pragma unroll
                    for (int ks = 0; ks < 8; ++ks) O[mt] = MFMA32(frag_perm(Qm, 136, 32 * mt + r, ks, h), Sp[ks], O[mt]);
#pragma unroll
                    for (int ks = 0; ks < 4; ++ks) O[mt] = MFMA32(frag_perm(Ab, 72, 32 * mt + r, ks, h), Vf[ks], O[mt]);
                }
#pragma unroll
                for (int mt = 0; mt < 2; ++mt)
#pragma unroll
                    for (int x = 0; x < 16; ++x) Vb[(32 * mt + crow(x, h)) * 136 + 32 * w + r] = f2bf(O[mt][x]);
#pragma unroll
                for (int kt = 0; kt < 4; ++kt)
#pragma unroll
                    for (int ks = 0; ks < 4; ++ks) S[kt] = MFMA32(frag_tr(Km, 136, 32 * kt, ks, lane), Vf[ks], S[kt]);
            }
            __syncthreads();
            {
                const int i = t >> 2, ch0 = 32 * (t & 3), ip = dir ? 63 - i : i;
                u32x4* gp = (u32x4*)(OB + (size_t)(row_base + i) * 1024 + head * 256 + hf * 128 + ch0);
#pragma unroll
                for (int v = 0; v < 4; ++v) { u32x4 o = *(const LAS u32x4*)(Vb + ip * 136 + ch0 + 8 * v);
                    if (!first) { const u32x4 e = gp[v];
                        o.x = cvtpk_s(bf_lo(o.x) + bf_lo(e.x), bf_hi(o.x) + bf_hi(e.x)); o.y = cvtpk_s(bf_lo(o.y) + bf_lo(e.y), bf_hi(o.y) + bf_hi(e.y));
                        o.z = cvtpk_s(bf_lo(o.z) + bf_lo(e.z), bf_hi(o.z) + bf_hi(e.z)); o.w = cvtpk_s(bf_lo(o.w) + bf_lo(e.w), bf_hi(o.w) + bf_hi(e.w)); }
                    gp[v] = o; }
            }
            __syncthreads();
        }
    }
}
__device__ __forceinline__ void decode_phase(int ph, int& layer, int& op) {
    constexpr unsigned long long DN = (unsigned long long)OP_PREP | ((unsigned long long)OP_GEMM_IN << 4) | ((unsigned long long)OP_DNSCAN << 8) | ((unsigned long long)OP_DNRSTD << 12) | ((unsigned long long)OP_GEMM_Z << 16) | ((unsigned long long)OP_GEMM_OUT << 20) | ((unsigned long long)OP_NORM2 << 24) | ((unsigned long long)OP_FFN1 << 28) | ((unsigned long long)OP_FFN2 << 32);
    constexpr unsigned long long GL = (unsigned long long)OP_PREP | ((unsigned long long)OP_GEMM_IN << 4) | ((unsigned long long)OP_GK << 8) | ((unsigned long long)OP_GLASCAN << 12) | ((unsigned long long)OP_GLAGATE << 16) | ((unsigned long long)OP_GEMM_OUT << 20) | ((unsigned long long)OP_NORM2 << 24) | ((unsigned long long)OP_FFN1 << 28) | ((unsigned long long)OP_FFN2 << 32);
    constexpr unsigned long long AT = (unsigned long long)OP_PREP | ((unsigned long long)OP_GEMM_IN << 4) | ((unsigned long long)OP_QKROPE << 8) | ((unsigned long long)OP_ATTN << 12) | ((unsigned long long)OP_GEMM_OUT << 16) | ((unsigned long long)OP_NORM2 << 20) | ((unsigned long long)OP_FFN1 << 24) | ((unsigned long long)OP_FFN2 << 28);
    if (ph == 0) { layer = 0; op = OP_MOD; return; }
    int p = ph - 1;
    if (p < 9) { layer = 0; op = (int)((DN >> (4 * p)) & 15ull); return; } p -= 9;
    if (p < 9) { layer = 1; op = (int)((GL >> (4 * p)) & 15ull); return; } p -= 9;
    if (p < 8) { layer = 2; op = (int)((AT >> (4 * p)) & 15ull); return; } p -= 8;
    layer = 3; op = (int)((DN >> (4 * p)) & 15ull);
}

__global__ void __launch_bounds__(512, 2) mega(Args args) {
    extern __shared__ __attribute__((aligned(16))) unsigned char lds_raw[];
    LAS unsigned char* lds = (LAS unsigned char*)lds_raw;
    cg::grid_group grid = cg::this_grid();
    const int G = gridDim.x, NGW = G * 8;
    unsigned char* ws = args.ws;
    const float* x_in = args.in[0]; const float* c_in = args.in[1]; const float* ctx_in = args.in[2]; const float* cctx_in = args.in[3];
    const float* ada_w = args.in[4]; const float* ada_b = args.in[5]; const float* norm_mix_g = args.in[6]; const float* norm_ffn_g = args.in[7];
    const float* ffn_w1 = args.in[8]; const float* ffn_w2 = args.in[9];
    float* MOD = (float*)(ws + WS_MOD); float* CTXC = (float*)(ws + WS_CTX); bf16_t* H = (bf16_t*)(ws + WS_H); float* ABF = (float*)(ws + WS_AB); float* RSTD = (float*)(ws + WS_RSTD);
    bf16_t* PB = (bf16_t*)(ws + WS_P); float* out = args.out;

    for (int ph = args.ph_lo; ph < args.ph_hi; ++ph) {
        int layer, op; decode_phase(ph, layer, op);
        const int tid = opaque_tid(), lane = tid & 63, wave = __builtin_amdgcn_readfirstlane(tid >> 6); const int gw = blockIdx.x * 8 + wave;
        const int mix = layer % 3, slot = layer / 3;
        const float* modl = MOD + (size_t)layer * 3 * 6144;
        const float* xl = layer == 0 ? x_in : out; const float* xc = layer == 0 ? ctx_in : CTXC;
        if (op == OP_MOD) {
            LAS float* sl = (LAS float*)lds; LAS float* red = sl + 3 * 1024;
            for (int e = tid; e < 3 * 1024; e += 512) { const float v = e < 2048 ? c_in[e] : cctx_in[e - 2048]; sl[e] = silu_f(v); }
            __syncthreads();
            for (int item = blockIdx.x; item < 4 * 96; item += G) {
                const int ly = item / 96, col = (item % 96) * 64 + lane;
                const float* wp = ada_w + ((size_t)ly * 1024 + 128 * wave) * 6144 + col;
                float a0 = 0.f, a1 = 0.f, a2 = 0.f;
#pragma unroll 8
                for (int k = 0; k < 128; ++k) { const float wv = wp[(size_t)k * 6144]; const int kk = 128 * wave + k; a0 += sl[kk] * wv; a1 += sl[1024 + kk] * wv; a2 += sl[2048 + kk] * wv; }
                red[(wave * 3 + 0) * 64 + lane] = a0; red[(wave * 3 + 1) * 64 + lane] = a1; red[(wave * 3 + 2) * 64 + lane] = a2;
                __syncthreads();
                if (tid < 192) { const int m = tid >> 6; float s = ada_b[(size_t)ly * 6144 + col];
#pragma unroll
                    for (int w2 = 0; w2 < 8; ++w2) s += red[(w2 * 3 + m) * 64 + lane];
                    MOD[((size_t)ly * 3 + m) * 6144 + col] = s; }
                __syncthreads();
            }
        } else if (op == OP_PREP) {
            LAS float* scr = (LAS float*)(lds + wave * 16384);
            bf16_t* wtA = (bf16_t*)(ws + WT_A); bf16_t* wtZ = (bf16_t*)(ws + WT_Z); bf16_t* wtO = (bf16_t*)(ws + WT_O); bf16_t* wt1 = (bf16_t*)(ws + WT_1); bf16_t* wt2 = (bf16_t*)(ws + WT_2);
            if (mix == 0) {
                const float* w_in = args.in[10] + (size_t)slot * 1024 * 6208; const float* w_out = args.in[15] + (size_t)slot * 2048 * 1024;
                transpose_mat(w_in, 6208, 0, 4096, 1024, wtA, 0, scr, gw, NGW, lane);
                transpose_mat(w_in, 6208, 6144, 64, 1024, wtA, 4096, scr, gw, NGW, lane);
                for (size_t e = (size_t)blockIdx.x * 512 + tid; e < (size_t)192 * 1024 * 2 / 16; e += (size_t)G * 512) ((u32x4*)(wtA + (size_t)4160 * 1024))[e] = (u32x4){0u, 0u, 0u, 0u};
                transpose_mat(w_in, 6208, 4096, 2048, 1024, wtZ, 0, scr, gw, NGW, lane);
                transpose_mat(w_out, 1024, 0, 1024, 2048, wtO, 0, scr, gw, NGW, lane);
            } else if (mix == 1) {
                const float* w_in = args.in[16]; const float* w_out = args.in[20];
                transpose_mat(w_in, 3104, 0, 3104, 1024, wtA, 0, scr, gw, NGW, lane);
                for (size_t e = (size_t)blockIdx.x * 512 + tid; e < (size_t)224 * 1024 * 2 / 16; e += (size_t)G * 512) ((u32x4*)(wtA + (size_t)3104 * 1024))[e] = (u32x4){0u, 0u, 0u, 0u};
                transpose_mat(w_out, 1024, 0, 1024, 1024, wtO, 0, scr, gw, NGW, lane);
            } else {
                const float* w_in = args.in[21]; const float* w_out = args.in[24];
                transpose_mat(w_in, 1536, 0, 1536, 1024, wtA, 0, scr, gw, NGW, lane);
                transpose_mat(w_out, 1024, 0, 1024, 1024, wtO, 0, scr, gw, NGW, lane);
            }
            transpose_mat(ffn_w1 + (size_t)layer * 1024 * 4096, 4096, 0, 4096, 1024, wt1, 0, scr, gw, NGW, lane);
            transpose_mat(ffn_w2 + (size_t)layer * 4096 * 1024, 1024, 0, 1024, 4096, wt2, 0, scr, gw, NGW, lane);
            normmod_rows(xl, xc, norm_mix_g + (size_t)layer * 1024, modl, 0, H, gw, NGW, lane);
        } else if (op == OP_NORM2) {
            normmod_rows(out, CTXC, norm_ffn_g + (size_t)layer * 1024, modl, 3, H, gw, NGW, lane);
        } else if (op == OP_GEMM_IN || op == OP_GEMM_Z || op == OP_GEMM_OUT || op == OP_FFN1 || op == OP_FFN2) {
            pg8::Gemm g; pg8::Epi E;
            E.mode = 0; E.O = PB; E.ldc = 4096; E.tail_pn = -1; E.F = ABF; E.ldf = 64; E.nf = 64; E.rstd = RSTD; E.ng = args.in[14] + (size_t)slot * 128;
            E.src_lat = xl; E.src_ctx = xc; E.dst_lat = out; E.dst_ctx = CTXC; E.mod = modl; E.gidx = 2;
            g.M = MROWS; g.A = H; g.K = 1024;
            bf16_t* OBUF = (bf16_t*)(ws + (mix == 1 ? WS_OGLA : WS_O));
            if (op == OP_GEMM_IN) {
                g.Bt = (const bf16_t*)(ws + WT_A);
                if (mix == 0) { g.N = 4352; E.ldc = 4096; E.tail_pn = 16; E.ldf = 64; E.nf = 64; }
                else if (mix == 1) { g.N = 3328; E.ldc = 3072; E.tail_pn = 12; E.ldf = 32; E.nf = 32; }
                else { g.N = 1536; E.ldc = 1536; }
            } else if (op == OP_GEMM_Z) {
                g.Bt = (const bf16_t*)(ws + WT_Z); g.N = 2048; E.mode = 2; E.O = OBUF; E.ldc = 2048;
            } else if (op == OP_GEMM_OUT) {
                g.A = OBUF; g.K = mix == 0 ? 2048 : 1024; g.Bt = (const bf16_t*)(ws + WT_O); g.N = 1024; E.mode = 3; E.gidx = 2;
            } else if (op == OP_FFN1) {
                g.Bt = (const bf16_t*)(ws + WT_1); g.N = 4096; E.mode = 1; E.ldc = 4096;
            } else {
                g.A = PB; g.K = 4096; g.Bt = (const bf16_t*)(ws + WT_2); g.N = 1024; E.mode = 3; E.gidx = 5; E.src_lat = out; E.src_ctx = CTXC;
            }
            pg8::StaticOrder S; S.init(g.M, g.N, G, (int)blockIdx.x);
#ifndef NO_GEMM
            pg8::gemm_phase<pg8::Epi, pg8::StaticOrder, true, true>(lds, g, S, E);
#endif
        } else if (op == OP_DNSCAN) {
#ifndef NO_DN
            dn_scan(lds, PB, ABF, (bf16_t*)(ws + WS_O), args.in[11] + (size_t)slot * 4096 * 5, args.in[12] + (size_t)slot * 32, args.in[13] + (size_t)slot * 32);
#endif
        } else if (op == OP_DNRSTD) {
            const bf16_t* OB = (const bf16_t*)(ws + WS_O);
            for (int row = gw; row < MROWS; row += NGW) {
                const u32x4* p = (const u32x4*)(OB + (size_t)row * 2048 + 32 * lane); float ss = 0.f;
#pragma unroll
                for (int v = 0; v < 4; ++v) { const u32x4 q = p[v]; const float a0 = bf_lo(q.x), a1 = bf_hi(q.x), a2 = bf_lo(q.y), a3 = bf_hi(q.y), a4 = bf_lo(q.z), a5 = bf_hi(q.z), a6 = bf_lo(q.w), a7 = bf_hi(q.w);
                    ss += (a0 * a0 + a1 * a1) + (a2 * a2 + a3 * a3) + (a4 * a4 + a5 * a5) + (a6 * a6 + a7 * a7); }
                ss += __shfl_xor(ss, 1); ss += __shfl_xor(ss, 2);
                if ((lane & 3) == 0) RSTD[(size_t)row * 16 + (lane >> 2)] = rsqrtf(ss * (1.f / 128.f) + EPS);
            }
        } else if (op == OP_GK) {
            LAS float* w2 = (LAS float*)lds;
            const float* gw2 = args.in[17]; const float* gb2 = args.in[18]; float* GK = (float*)(ws + WS_GK);
            for (int e = tid; e < 2 * 16 * 512; e += 512) w2[e] = gw2[e];
            __syncthreads();
            for (int row = gw; row < MROWS; row += NGW) {
                const float lowv = ABF[(size_t)row * 32 + (lane & 31)];
#pragma unroll 1
                for (int jj = 0; jj < 16; ++jj) { const int idx = lane + 64 * jj, d = idx >> 9, c = idx & 511; float s = gb2[idx];
#pragma unroll
                    for (int rr = 0; rr < 16; ++rr) s += __shfl(lowv, d * 16 + rr) * w2[(d * 16 + rr) * 512 + c];
                    GK[(size_t)row * 1024 + idx] = logsigmoid_f(s) * (1.f / 16.f); }
            }
        } else if (op == OP_GLASCAN) {
#ifndef NO_GLA
            gla_scan(lds, PB, (const float*)(ws + WS_GK), (bf16_t*)(ws + WS_OGLA));
#endif
        } else if (op == OP_GLAGATE) {
            bf16_t* OB = (bf16_t*)(ws + WS_OGLA); const float* ng = args.in[19];
            for (int row = gw; row < MROWS; row += NGW) {
                u32x4* p = (u32x4*)(OB + (size_t)row * 1024 + 16 * lane); const u32x4* gp = (const u32x4*)(PB + (size_t)row * 3072 + 2048 + 16 * lane);
                float o[16], z[16]; float ss = 0.f;
#pragma unroll
                for (int v = 0; v < 2; ++v) { const u32x4 q = p[v], gq = gp[v];
                    o[8 * v + 0] = bf_lo(q.x); o[8 * v + 1] = bf_hi(q.x); o[8 * v + 2] = bf_lo(q.y); o[8 * v + 3] = bf_hi(q.y); o[8 * v + 4] = bf_lo(q.z); o[8 * v + 5] = bf_hi(q.z); o[8 * v + 6] = bf_lo(q.w); o[8 * v + 7] = bf_hi(q.w);
                    z[8 * v + 0] = bf_lo(gq.x); z[8 * v + 1] = bf_hi(gq.x); z[8 * v + 2] = bf_lo(gq.y); z[8 * v + 3] = bf_hi(gq.y); z[8 * v + 4] = bf_lo(gq.z); z[8 * v + 5] = bf_hi(gq.z); z[8 * v + 6] = bf_lo(gq.w); z[8 * v + 7] = bf_hi(gq.w); }
#pragma unroll
                for (int e = 0; e < 16; ++e) ss += o[e] * o[e];
                ss += __shfl_xor(ss, 1); ss += __shfl_xor(ss, 2); ss += __shfl_xor(ss, 4); ss += __shfl_xor(ss, 8);
                const float rs = rsqrtf(ss * (1.f / 256.f) + EPS); const int cb = (16 * lane) & 255;
#pragma unroll
                for (int v = 0; v < 2; ++v) { float rr[8];
#pragma unroll
                    for (int e = 0; e < 8; ++e) rr[e] = o[8 * v + e] * rs * ng[cb + 8 * v + e] * silu_f(z[8 * v + e]);
                    u32x4 wv; wv.x = cvtpk_s(rr[0], rr[1]); wv.y = cvtpk_s(rr[2], rr[3]); wv.z = cvtpk_s(rr[4], rr[5]); wv.w = cvtpk_s(rr[6], rr[7]); p[v] = wv; }
            }
        } else if (op == OP_QKROPE) {
            bf16_t* QR = (bf16_t*)(ws + WS_QR); bf16_t* KR = (bf16_t*)(ws + WS_KR); bf16_t* VR = (bf16_t*)(ws + WS_VR);
            const float* qg = args.in[22]; const float* kg = args.in[23];
            const int hf = lane >> 5, j = lane & 31, e1 = 64 * hf + j, e2 = e1 + 32;
            const float inv_freq = exp2f(-(float)(2 * j) * (1.f / 64.f) * 13.287712379549449f);
            const float gq1 = qg[e1], gq2 = qg[e2], gk1 = kg[e1], gk2 = kg[e2];
            for (int row = gw; row < MROWS; row += NGW) {
                const bool lat = row < NLAT; const int b = lat ? row / SEQ : (row - NLAT) / CTXL; const int tpos = lat ? row % SEQ : (row - NLAT) % CTXL;
                float cs = 1.f, sn = 0.f;
                if (lat) { const float pos = (float)(hf == 0 ? tpos / 64 : tpos % 64); const float ang = pos * inv_freq; sn = sinf(ang); cs = cosf(ang); }
                const bf16_t* pr = PB + (size_t)row * 1536; const int kpos = lat ? tpos : SEQ + tpos;
#pragma unroll
                for (int hd = 0; hd < 10; ++hd) {
                    const float x1 = bf2f(pr[hd * 128 + e1]), x2 = bf2f(pr[hd * 128 + e2]);
                    const float rinv = rsqrtf(wave_sum(x1 * x1 + x2 * x2) * (1.f / 128.f) + EPS);
                    const float y1 = x1 * rinv * (hd < 8 ? gq1 : gk1), y2 = x2 * rinv * (hd < 8 ? gq2 : gk2);
                    const float o1 = y1 * cs - y2 * sn, o2 = y1 * sn + y2 * cs;
                    bf16_t* dst = hd < 8 ? QR + (size_t)row * 1024 + hd * 128 : KR + ((size_t)(b * 2 + (hd - 8)) * SKV + kpos) * 128;
                    dst[e1] = f2bf(o1); dst[e2] = f2bf(o2);
                }
#pragma unroll
                for (int kv = 0; kv < 2; ++kv) { bf16_t* dst = VR + ((size_t)(b * 2 + kv) * SKV + kpos) * 128; dst[e1] = pr[1280 + kv * 128 + e1]; dst[e2] = pr[1280 + kv * 128 + e2]; }
            }
        } else if (op == OP_ATTN) {
            const attn::bf16* QR = (const attn::bf16*)(ws + WS_QR); const attn::bf16* KR = (const attn::bf16*)(ws + WS_KR); const attn::bf16* VR = (const attn::bf16*)(ws + WS_VR);
            attn::bf16* OB = (attn::bf16*)(ws + WS_O);
            for (int u = blockIdx.x; u < 1024 + 16; u += G) {
                size_t qoff, koff; int seq;
                if (u < 1024) { const int pair = u >> 8, b = pair >> 1, kvh = pair & 1, hh = (u >> 6) & 3, qb = u & 63, head = kvh * 4 + hh;
                    qoff = ((size_t)b * SEQ + (size_t)qb * 256) * 1024 + head * 128; koff = (size_t)(b * 2 + kvh) * SKV * 128; seq = SKV; }
                else { const int jx = u - 1024, b = jx >> 3, head = jx & 7, kvh = head >> 2;
                    qoff = ((size_t)NLAT + (size_t)b * CTXL) * 1024 + head * 128; koff = ((size_t)(b * 2 + kvh) * SKV + SEQ) * 128; seq = CTXL; }
                __syncthreads();
#ifndef NO_ATT
                attn::attn_dense_body<attn::bf16>(QR + qoff, KR + koff, VR + koff, OB + qoff, seq, (char*)lds_raw);
#endif
            }
        }
        if (ph + 1 < args.ph_hi) grid.sync();
    }
}

#ifndef MK_MULTI
#define MK_MULTI 0
#endif
extern "C" void kernel_launch(void* const* d_in, const int* in_sizes, int n_in, void* d_out, int out_size, void* d_ws, size_t ws_size, hipStream_t stream) {
    static int grid = 0;
    if (grid == 0) {
        if (n_in != 25 || ws_size < WS_END) { fprintf(stderr, "kernel_launch: unexpected n_in %d / ws_size %zu (need %zu)\n", n_in, ws_size, (size_t)WS_END); grid = -1; return; }
        int dev = 0, cus = 0, per_cu = 0;
        hipGetDevice(&dev); hipDeviceGetAttribute(&cus, hipDeviceAttributeMultiprocessorCount, dev);
        if (hipFuncSetAttribute((const void*)mega, hipFuncAttributeMaxDynamicSharedMemorySize, LDS_BYTES) != hipSuccess) { fprintf(stderr, "kernel_launch: hipFuncSetAttribute failed\n"); grid = -1; return; }
        if (hipOccupancyMaxActiveBlocksPerMultiprocessor(&per_cu, (const void*)mega, 512, LDS_BYTES) != hipSuccess || per_cu < 1) { fprintf(stderr, "kernel_launch: occupancy query says %d\n", per_cu); per_cu = 1; }
        (void)hipGetLastError();
        grid = cus * 1;
    }
    if (grid < 0) return;
    Args a{};
    for (int i = 0; i < 25; ++i) a.in[i] = (const float*)d_in[i];
    a.out = (float*)d_out; a.ws = (unsigned char*)d_ws;
#if MK_MULTI
    for (int ph = 0; ph < NPHASE; ++ph) { a.ph_lo = ph; a.ph_hi = ph + 1; hipLaunchKernelGGL(mega, dim3(grid), dim3(512), LDS_BYTES, stream, a); }
#else
    a.ph_lo = 0; a.ph_hi = NPHASE;
    void* kargs[] = {&a};
    hipError_t e = hipLaunchCooperativeKernel((const void*)mega, dim3(grid), dim3(512), kargs, LDS_BYTES, stream);
    if (e != hipSuccess) fprintf(stderr, "cooperative launch failed: %s (grid %d)\n", hipGetErrorString(e), grid);
#endif
}
```

```cpp
#include <hip/hip_runtime.h>
#include <hip/hip_bf16.h>
#include <hip/hip_cooperative_groups.h>
#include <cstdio>
#include <cstdint>
namespace cg = cooperative_groups;
__device__ __forceinline__ int opaque_tid() { int t = threadIdx.x; asm volatile("" : "+v"(t)); return t; }
namespace pg8 {
#define PG8_LAS __attribute__((address_space(3)))
typedef unsigned short bf16_t;
typedef short bf16x8 __attribute__((ext_vector_type(8)));
typedef float f32x4 __attribute__((ext_vector_type(4)));
typedef unsigned u32x4 __attribute__((ext_vector_type(4)));
constexpr int BM = 256, BK = 64, HALF = 128, HTB = HALF * BK * 2  , STAGE_BYTES = 8 * HTB, NXCD = 8, WGM = 8;

__host__ __device__ __forceinline__ int lds_byte(int r, int c) { const int st = (r >> 4) * 2 + (c >> 5), rr = r & 15, cc = c & 31, ob = rr * 64 + cc * 2; return st * 1024 + (ob ^ (((ob >> 9) & 1) << 5)); }
__host__ __device__ __forceinline__ void stage_rc(int b, int& R, int& C) { const int st = b / 1024, sb = b % 1024, swz = sb ^ (((sb >> 9) & 1) << 5); R = (st >> 1) * 16 + swz / 64; C = (st & 1) * 32 + (swz % 64) / 2; }
__host__ __device__ __forceinline__ int perm32(int rho) { const int n = rho >> 4, i = rho & 15; return 8 * (i >> 2) + 4 * n + (i & 3); }

struct Unit { int pm, pn; };
struct Gemm { const bf16_t* A; const bf16_t* Bt; int M, N, K; };

struct StaticOrder {
    int nM, nN, nwg, G, c;
    __host__ __device__ void init(int M, int N, int G_, int c_) { nM = M / BM; nN = N / BM; nwg = nM * nN; G = G_; c = c_; }
    __host__ __device__ bool next(int i, Unit& u) const {
        const long L = (long)i * G + c; if (L >= nwg) return false;
        int wgid = (int)L; { const int q = nwg / NXCD, r = nwg % NXCD, xcd = wgid % NXCD, off = wgid / NXCD; wgid = (xcd < r ? xcd * (q + 1) : r * (q + 1) + (xcd - r) * q) + off; }
        const int nig = WGM * nN, gid = wgid / nig, fm = gid * WGM, gsz = (nM - fm) < WGM ? (nM - fm) : WGM;
        u.pm = fm + ((wgid % nig) % gsz); u.pn = (wgid % nig) / gsz; return true;
    }
    __device__ __forceinline__ void a_ready(const Unit&) const {}
    __device__ __forceinline__ void done(const Unit&) const {}
};

__device__ __forceinline__ unsigned cvt_pk_bf16(float lo, float hi) { unsigned r; asm volatile("v_cvt_pk_bf16_f32 %0, %1, %2" : "=v"(r) : "v"(lo), "v"(hi)); return r; }
typedef float f32x2 __attribute__((ext_vector_type(2)));
typedef float f32x2_t __attribute__((ext_vector_type(2))); typedef __bf16 bf16x2_t __attribute__((ext_vector_type(2)));
__device__ __forceinline__ unsigned cvtpk_s(float lo, float hi) { f32x2_t v = {lo, hi}; bf16x2_t b = __builtin_convertvector(v, bf16x2_t); return __builtin_bit_cast(unsigned, b); }
__device__ __forceinline__ float bf_lo(unsigned w) { return __builtin_bit_cast(float, w << 16); }
__device__ __forceinline__ float bf_hi(unsigned w) { return __builtin_bit_cast(float, w & 0xffff0000u); }
__device__ __forceinline__ float silu_f(float z) { return z / (1.f + __expf(-z)); }
struct Epi {
    static constexpr bool PERM = true, AFTER_DRAIN = false;
    int mode;
    bf16_t* O; int ldc;
    int tail_pn; float* F; int ldf, nf;
    const float* rstd; const float* ng;
    const float* src_lat; const float* src_ctx; float* dst_lat; float* dst_ctx; const float* mod; int gidx;
    __device__ __forceinline__ void operator()(const f32x4 (&acc)[2][2][4][2], const Unit& u, int wr, int wc, int fr, int fq) const {
        const int row0 = u.pm * BM + wr * 64 + fr; const int col0 = u.pn * BM + wc * 32 + 8 * fq;
        if (mode <= 1) {
            if (u.pn == tail_pn) {
                const int c0 = wc * 32 + 8 * fq;
#pragma unroll
                for (int ai = 0; ai < 2; ++ai)
#pragma unroll
                    for (int m = 0; m < 4; ++m)
#pragma unroll
                        for (int bj = 0; bj < 2; ++bj) { const int cc = c0 + bj * HALF;
                            if (cc < nf) { float* p = F + (size_t)(row0 + ai * HALF + m * 16) * ldf + cc; *(f32x4*)p = acc[ai][bj][m][0]; *(f32x4*)(p + 4) = acc[ai][bj][m][1]; } }
            } else {
#pragma unroll
                for (int ai = 0; ai < 2; ++ai)
#pragma unroll
                    for (int m = 0; m < 4; ++m) { bf16_t* rowp = O + (size_t)(row0 + ai * HALF + m * 16) * ldc + col0;
#pragma unroll
                        for (int bj = 0; bj < 2; ++bj) { f32x4 v0 = acc[ai][bj][m][0], v1 = acc[ai][bj][m][1];
                            if (mode == 1) {
#pragma unroll
                                for (int e = 0; e < 4; ++e) { float a = fmaxf(v0[e], 0.f), b = fmaxf(v1[e], 0.f); v0[e] = a * a; v1[e] = b * b; } }
                            u32x4 w; w.x = cvtpk_s(v0[0], v0[1]); w.y = cvtpk_s(v0[2], v0[3]); w.z = cvtpk_s(v1[0], v1[1]); w.w = cvtpk_s(v1[2], v1[3]);
                            *(u32x4*)(rowp + bj * HALF) = w; } }
            }
        } else if (mode == 2) {
            const f32x4 g0 = *(const f32x4*)(ng + (col0 & 127)), g1 = *(const f32x4*)(ng + (col0 & 127) + 4);
#pragma unroll
            for (int ai = 0; ai < 2; ++ai)
#pragma unroll
                for (int m = 0; m < 4; ++m) { const int row = row0 + ai * HALF + m * 16; bf16_t* rowp = O + (size_t)row * ldc + col0;
#pragma unroll
                    for (int bj = 0; bj < 2; ++bj) { const float rs = rstd[(size_t)row * 16 + ((col0 + bj * HALF) >> 7)];
                        const u32x4 ov = *(const u32x4*)(rowp + bj * HALF); const f32x4 z0 = acc[ai][bj][m][0], z1 = acc[ai][bj][m][1];
                        float r[8];
                        r[0] = bf_lo(ov.x) * rs * g0[0] * silu_f(z0[0]); r[1] = bf_hi(ov.x) * rs * g0[1] * silu_f(z0[1]);
                        r[2] = bf_lo(ov.y) * rs * g0[2] * silu_f(z0[2]); r[3] = bf_hi(ov.y) * rs * g0[3] * silu_f(z0[3]);
                        r[4] = bf_lo(ov.z) * rs * g1[0] * silu_f(z1[0]); r[5] = bf_hi(ov.z) * rs * g1[1] * silu_f(z1[1]);
                        r[6] = bf_lo(ov.w) * rs * g1[2] * silu_f(z1[2]); r[7] = bf_hi(ov.w) * rs * g1[3] * silu_f(z1[3]);
                        u32x4 w; w.x = cvtpk_s(r[0], r[1]); w.y = cvtpk_s(r[2], r[3]); w.z = cvtpk_s(r[4], r[5]); w.w = cvtpk_s(r[6], r[7]);
                        *(u32x4*)(rowp + bj * HALF) = w; } }
        } else {
            const int mi = u.pm < 64 ? 0 : (u.pm < 128 ? 1 : 2);
            const float* gate = mod + (size_t)mi * 6144 + (size_t)gidx * 1024;
            const bool lat = u.pm < 128;
            const float* sb = lat ? src_lat : src_ctx - (size_t)32768 * 1024; float* db = lat ? dst_lat : dst_ctx - (size_t)32768 * 1024;
#pragma unroll
            for (int bj = 0; bj < 2; ++bj)
#pragma unroll
                for (int n = 0; n < 2; ++n) { const int c = col0 + bj * HALF + 4 * n; const f32x4 gv = *(const f32x4*)(gate + c);
#pragma unroll
                    for (int ai = 0; ai < 2; ++ai)
#pragma unroll
                        for (int m = 0; m < 4; ++m) { const size_t off = (size_t)(row0 + ai * HALF + m * 16) * 1024 + c;
                            const f32x4 s = *(const f32x4*)(sb + off); *(f32x4*)(db + off) = s + gv * acc[ai][bj][m][n]; } }
        }
    }
};
template <class Epi, class Sched, bool ALIGN_EPI = false, bool SP2 = false>
__device__ __forceinline__ void gemm_phase(PG8_LAS unsigned char* lds, const Gemm g, const Sched& S, const Epi& E) {
    const int tid = opaque_tid(), wid = __builtin_amdgcn_readfirstlane(tid >> 6), lane = tid & 63, wr = wid >> 2, wc = wid & 3, fr = lane & 15, fq = lane >> 4;
    const int K = g.K, nt = K / BK;
    unsigned voffA[2], voffB[2];
#pragma unroll
    for (int i = 0; i < 2; ++i) { int R, C; stage_rc(tid * 16 + i * 8192, R, C); const int Rb = Epi::PERM ? ((R & ~31) + perm32(R & 31)) : R;
        voffA[i] = (unsigned)(R * K + C) * 2u; voffB[i] = (unsigned)(Rb * K + C) * 2u; }
    const size_t kstep = (size_t)(BK * 2);
    const size_t hstep = (size_t)HALF * K * 2;
    const size_t tstep = 2 * hstep;
    const unsigned ldsw = (unsigned)wid * 1024u;
    const int aoff = lds_byte(wr * 64 + fr, fq * 8), boff = lds_byte(wc * 32 + fr, fq * 8);
#define PG8_SA(b, h) (((b) * 2 + (h)) * HTB)
#define PG8_SB(b, h) ((4 + (b) * 2 + (h)) * HTB)
#define PG8_STAGE(bufoff, gbase, voff) do { _Pragma("unroll") for (int _i = 0; _i < 2; ++_i) \
        __builtin_amdgcn_global_load_lds((const unsigned*)((const char*)(gbase) + (voff)[_i]), (PG8_LAS unsigned*)(lds + (bufoff) + ldsw + _i * 8192), 16, 0, 0); } while (0)
#define PG8_LDA(dst, b, h) do { _Pragma("unroll") for (int m = 0; m < 4; ++m) _Pragma("unroll") for (int k = 0; k < 2; ++k) dst[m][k] = *(const PG8_LAS bf16x8*)(lds + PG8_SA(b, h) + aoff + m * 2048 + k * 1024); } while (0)
#define PG8_LDB(dst, b, h) do { _Pragma("unroll") for (int n = 0; n < 2; ++n) _Pragma("unroll") for (int k = 0; k < 2; ++k) dst[n][k] = *(const PG8_LAS bf16x8*)(lds + PG8_SB(b, h) + boff + n * 2048 + k * 1024); } while (0)
#define PG8_MMA(ai, bj, At, Bt) do { __builtin_amdgcn_s_setprio(1); _Pragma("unroll") for (int m = 0; m < 4; ++m) _Pragma("unroll") for (int n = 0; n < 2; ++n) _Pragma("unroll") for (int k = 0; k < 2; ++k) \
        acc[ai][bj][m][n] = __builtin_amdgcn_mfma_f32_16x16x32_bf16(Bt[n][k], At[m][k], acc[ai][bj][m][n], 0, 0, 0); __builtin_amdgcn_s_setprio(0); } while (0)
#define PG8_WAIT_V(n) asm volatile("s_waitcnt vmcnt(" #n ")" ::: "memory")
#define PG8_WAIT_L(n) asm volatile("s_waitcnt lgkmcnt(" #n ")" ::: "memory")
#define PG8_BAR __builtin_amdgcn_s_barrier()
#define PG8_SCHED __builtin_amdgcn_sched_barrier(0)
    Unit cur, nxt; int ui = 0;
    if (!S.next(0, cur)) return;
    f32x4 acc[2][2][4][2];
#pragma unroll
    for (int a = 0; a < 2; ++a)
#pragma unroll
        for (int b = 0; b < 2; ++b)
#pragma unroll
            for (int m = 0; m < 4; ++m)
#pragma unroll
                for (int n = 0; n < 2; ++n) acc[a][b][m][n] = (f32x4){0.f, 0.f, 0.f, 0.f};
    bf16x8 At[4][2], B0[2][2], B1[2][2];
    const char* cA = (const char*)g.A + (size_t)cur.pm * tstep; const char* cB = (const char*)g.Bt + (size_t)cur.pn * tstep;
    S.a_ready(cur);
    if constexpr (SP2) {
        PG8_STAGE(PG8_SB(0, 0), cB, voffB); PG8_STAGE(PG8_SB(0, 1), cB + hstep, voffB); PG8_STAGE(PG8_SA(0, 0), cA, voffA); PG8_STAGE(PG8_SA(0, 1), cA + hstep, voffA);
        if (wr == 1) PG8_BAR;
        PG8_WAIT_V(2); PG8_BAR;
        PG8_STAGE(PG8_SB(1, 0), cB + kstep, voffB); PG8_STAGE(PG8_SA(1, 0), cA + kstep, voffA); PG8_STAGE(PG8_SB(1, 1), cB + hstep + kstep, voffB);
        PG8_WAIT_V(6); PG8_BAR;
    } else {
        PG8_STAGE(PG8_SB(0, 0), cB, voffB); PG8_STAGE(PG8_SA(0, 0), cA, voffA); PG8_STAGE(PG8_SB(0, 1), cB + hstep, voffB); PG8_STAGE(PG8_SA(0, 1), cA + hstep, voffA);
        if (wr == 1) PG8_BAR;
        PG8_WAIT_V(4); PG8_BAR;
        PG8_STAGE(PG8_SB(1, 0), cB + kstep, voffB); PG8_STAGE(PG8_SA(1, 0), cA + kstep, voffA); PG8_STAGE(PG8_SB(1, 1), cB + hstep + kstep, voffB);
        PG8_WAIT_V(6); PG8_BAR;
    }
    for (;;) {
        const bool has_next = S.next(ui + 1, nxt);
        const char* nA = has_next ? (const char*)g.A + (size_t)nxt.pm * tstep : cA; const char* nB = has_next ? (const char*)g.Bt + (size_t)nxt.pn * tstep : cB;
        for (int t = 0; t < nt; t += 2) {
            const bool last = (t == nt - 2);
            const char* a1 = cA + (size_t)(t + 1) * kstep;
            const char* a2 = last ? nA : cA + (size_t)(t + 2) * kstep; const char* b2 = last ? nB : cB + (size_t)(t + 2) * kstep;
            const char* a3 = a2 + kstep; const char* b3 = b2 + kstep;
            if (last && has_next) S.a_ready(nxt);
            if constexpr (SP2) {
            PG8_LDB(B0, 0, 0); PG8_LDB(B1, 0, 1); PG8_SCHED; PG8_LDA(At, 0, 0); PG8_STAGE(PG8_SA(1, 1), a1 + hstep, voffA);
            PG8_WAIT_V(8); PG8_WAIT_L(0); PG8_BAR; PG8_MMA(0, 0, At, B0); PG8_MMA(0, 1, At, B1); PG8_BAR; PG8_SCHED;
            PG8_LDA(At, 0, 1); PG8_STAGE(PG8_SB(0, 0), b2, voffB); PG8_STAGE(PG8_SB(0, 1), b2 + hstep, voffB); PG8_STAGE(PG8_SA(0, 0), a2, voffA);
            PG8_WAIT_V(8); PG8_WAIT_L(0); PG8_BAR; PG8_MMA(1, 0, At, B0); PG8_MMA(1, 1, At, B1); PG8_BAR; PG8_SCHED;
            PG8_LDB(B0, 1, 0); PG8_LDB(B1, 1, 1); PG8_SCHED; PG8_LDA(At, 1, 0); PG8_STAGE(PG8_SA(0, 1), a2 + hstep, voffA);
            PG8_WAIT_V(8); PG8_WAIT_L(0); PG8_BAR; PG8_MMA(0, 0, At, B0); PG8_MMA(0, 1, At, B1); PG8_BAR; PG8_SCHED;
            PG8_LDA(At, 1, 1); PG8_STAGE(PG8_SB(1, 0), b3, voffB); PG8_STAGE(PG8_SB(1, 1), b3 + hstep, voffB); PG8_STAGE(PG8_SA(1, 0), a3, voffA);
            PG8_WAIT_V(8); PG8_WAIT_L(0); PG8_BAR; PG8_MMA(1, 0, At, B0); PG8_MMA(1, 1, At, B1); PG8_BAR; PG8_SCHED;
            } else {
            PG8_LDB(B0, 0, 0); PG8_SCHED; PG8_LDA(At, 0, 0); PG8_STAGE(PG8_SA(1, 1), a1 + hstep, voffA);
            PG8_WAIT_L(8); PG8_BAR; PG8_WAIT_L(0); PG8_MMA(0, 0, At, B0); PG8_BAR; PG8_SCHED;
            PG8_LDB(B1, 0, 1); PG8_STAGE(PG8_SB(0, 0), b2, voffB);
            PG8_BAR; PG8_WAIT_L(0); PG8_MMA(0, 1, At, B1); PG8_BAR;
            PG8_LDA(At, 0, 1); PG8_STAGE(PG8_SA(0, 0), a2, voffA);
            PG8_BAR; PG8_WAIT_L(0); PG8_MMA(1, 0, At, B0); PG8_BAR; PG8_SCHED;
            PG8_STAGE(PG8_SB(0, 1), b2 + hstep, voffB);
            PG8_WAIT_V(6); PG8_BAR; PG8_MMA(1, 1, At, B1); PG8_BAR;
            PG8_LDB(B0, 1, 0); PG8_SCHED; PG8_LDA(At, 1, 0); PG8_STAGE(PG8_SA(0, 1), a2 + hstep, voffA);
            PG8_WAIT_L(8); PG8_BAR; PG8_WAIT_L(0); PG8_MMA(0, 0, At, B0); PG8_BAR; PG8_SCHED;
            PG8_LDB(B1, 1, 1); PG8_STAGE(PG8_SB(1, 0), b3, voffB);
            PG8_BAR; PG8_WAIT_L(0); PG8_MMA(0, 1, At, B1); PG8_BAR;
            PG8_LDA(At, 1, 1); PG8_STAGE(PG8_SA(1, 0), a3, voffA);
            PG8_BAR; PG8_WAIT_L(0); PG8_MMA(1, 0, At, B0); PG8_BAR; PG8_SCHED;
            PG8_STAGE(PG8_SB(1, 1), b3 + hstep, voffB);
            PG8_WAIT_V(6); PG8_BAR; PG8_MMA(1, 1, At, B1); PG8_BAR;
            }
        }
        if constexpr (ALIGN_EPI) { if (wr == 0) PG8_BAR; }
        if constexpr (!Epi::AFTER_DRAIN) { E(acc, cur, wr, wc, fr, fq); S.done(cur); }
        if (!has_next) break;
#pragma unroll
        for (int a = 0; a < 2; ++a)
#pragma unroll
            for (int b = 0; b < 2; ++b)
#pragma unroll
                for (int m = 0; m < 4; ++m)
#pragma unroll
                    for (int n = 0; n < 2; ++n) acc[a][b][m][n] = (f32x4){0.f, 0.f, 0.f, 0.f};
        cur = nxt; cA = nA; cB = nB; ++ui;
        if constexpr (ALIGN_EPI) { if (wr == 1) PG8_BAR; }
    }
    PG8_WAIT_V(0);
    if constexpr (!ALIGN_EPI) { if (wr == 0) PG8_BAR; }
    PG8_BAR;
    if constexpr (Epi::AFTER_DRAIN) { E.fused(acc, cur, wr, wc, fr, fq, lds, wid, lane); S.done(cur); }
#undef PG8_SA
#undef PG8_SB
#undef PG8_STAGE
#undef PG8_LDA
#undef PG8_LDB
#undef PG8_MMA
#undef PG8_WAIT_V
#undef PG8_WAIT_L
#undef PG8_BAR
#undef PG8_SCHED
}
}
namespace attn {
using bf16 = __hip_bfloat16;
constexpr int   D = 128, NW = 8, QBLK = 32, KVBLK = 64;
constexpr float SCALE = 0.088388347648318440f;
constexpr float THR = 8.f;
constexpr int SDEPTH = 2;
constexpr int LDQ = 1024, LDK = 128, LDO = 1024;
constexpr size_t SHM_V = KVBLK * D * 2, SHM_K = KVBLK * D * 2, SHM_ATTN = 2 * SHM_V + 2 * SHM_K + NW * 64 * 4;
using bf16x8 = __attribute__((ext_vector_type(8))) short;
using s16x4  = __attribute__((ext_vector_type(4))) short;
using f32x16 = __attribute__((ext_vector_type(16))) float;
using f32x8  = __attribute__((ext_vector_type(8))) float;
using u32x4  = __attribute__((ext_vector_type(4))) unsigned;
#define KSWZ(row, colB) ((row) * 256 + ((colB) ^ (((row) & 7) << 4)))
#define SBAR() __builtin_amdgcn_sched_barrier(0)
__device__ __forceinline__ int crow(int r, int hi) { return (r & 3) + 8 * (r >> 2) + 4 * hi; }
__device__ __forceinline__ unsigned cvtpk(float lo, float hi) {
  unsigned r; asm volatile("v_cvt_pk_bf16_f32 %0, %1, %2" : "=v"(r) : "v"(lo), "v"(hi)); return r;
}
template <typename TIn> struct Stage;
template <> struct Stage<bf16>  { using T = bf16x8;
  __device__ static __forceinline__ T ld8(const bf16* p) { return *reinterpret_cast<const bf16x8*>(p); }
  __device__ static __forceinline__ bf16x8 tobf(T x) { return x; } };
template <> struct Stage<float> { using T = f32x8;
  __device__ static __forceinline__ T ld8(const float* p) { return *reinterpret_cast<const f32x8*>(p); }
  __device__ static __forceinline__ bf16x8 tobf(T x) {
    u32x4 w = {cvtpk(x[0], x[1]), cvtpk(x[2], x[3]), cvtpk(x[4], x[5]), cvtpk(x[6], x[7])}; return *reinterpret_cast<bf16x8*>(&w); } };

__device__ __forceinline__ void partialSM(f32x16& p0, f32x16& p1, float& m_reg, float& mn, float& alpha) {
  constexpr float C = SCALE * 1.4426950408889634f;
  float pmax = p0[0]; for (int r = 1; r < 16; ++r) pmax = fmaxf(pmax, p0[r]); for (int r = 0; r < 16; ++r) pmax = fmaxf(pmax, p1[r]);
  { auto rr = __builtin_amdgcn_permlane32_swap(__float_as_uint(pmax), __float_as_uint(pmax), false, false);
    pmax = fmaxf(__uint_as_float(rr[0]), __uint_as_float(rr[1])); }
  if (__builtin_expect(__all(pmax - m_reg <= THR / SCALE), 1)) { mn = m_reg; alpha = 1.f; }
  else { mn = fmaxf(m_reg, pmax); alpha = __builtin_amdgcn_exp2f((m_reg - mn) * C); m_reg = mn; }
  float mnC = -mn * C;
  for (int r = 0; r < 16; ++r) p0[r] = fmaf(p0[r], C, mnC); for (int r = 0; r < 16; ++r) p1[r] = fmaf(p1[r], C, mnC);
  for (int r = 0; r < 16; ++r) p0[r] = __builtin_amdgcn_exp2f(p0[r]);
}
__device__ __forceinline__ void finishSM(f32x16& p0, f32x16& p1, float alpha, float& l_reg, bf16x8& pa0, bf16x8& pa1, bf16x8& pa2, bf16x8& pa3) {
  for (int r = 0; r < 16; ++r) p1[r] = __builtin_amdgcn_exp2f(p1[r]);
  float ps = 0; for (int r = 0; r < 16; ++r) ps += p0[r]; for (int r = 0; r < 16; ++r) ps += p1[r];
  { auto rr = __builtin_amdgcn_permlane32_swap(__float_as_uint(ps), __float_as_uint(ps), false, false);
    ps = __uint_as_float(rr[0]) + __uint_as_float(rr[1]); }
  l_reg = l_reg * alpha + ps;
#define PK4(P, BASE, OUT) do { unsigned a0 = cvtpk(P[BASE + 0], P[BASE + 1]), a1 = cvtpk(P[BASE + 2], P[BASE + 3]);   \
    unsigned b0 = cvtpk(P[BASE + 4], P[BASE + 5]), b1 = cvtpk(P[BASE + 6], P[BASE + 7]);                              \
    auto r0 = __builtin_amdgcn_permlane32_swap(a0, b0, false, false); auto r1 = __builtin_amdgcn_permlane32_swap(a1, b1, false, false); \
    u32x4 w = {r0[0], r1[0], r0[1], r1[1]}; OUT = *reinterpret_cast<bf16x8*>(&w); } while (0)
  PK4(p0, 0, pa0); PK4(p0, 8, pa1); PK4(p1, 0, pa2); PK4(p1, 8, pa3);
#undef PK4
}
__device__ __forceinline__ void qkt(f32x16& p0, f32x16& p1, const bf16* Ks, const bf16x8* qr, int r32, int hi) {
  p0 = f32x16{}; p1 = f32x16{};
  for (int d0 = 0; d0 < 8; ++d0) { int cb = (d0 * 16 + hi * 8) * 2;
    bf16x8 b0 = *reinterpret_cast<const bf16x8*>((const char*)Ks + KSWZ(r32, cb));
    bf16x8 b1 = *reinterpret_cast<const bf16x8*>((const char*)Ks + KSWZ(32 + r32, cb));
    p0 = __builtin_amdgcn_mfma_f32_32x32x16_bf16(b0, qr[d0], p0, 0, 0, 0);
    p1 = __builtin_amdgcn_mfma_f32_32x32x16_bf16(b1, qr[d0], p1, 0, 0, 0); }
}
__device__ __forceinline__ int v_st(int k, int c) { const int kk = (k & ~0xC) | ((k & 4) << 1) | ((k & 8) >> 1); return ((kk >> 3) * 4 + (c >> 5)) * 512 + ((kk & 7) * 32 + (c & 31)) * 2; }
__device__ __forceinline__ int v_rd_base(int lane) { return ((lane & 3) << 3) | (((lane >> 2) & 3) << 6) | (((lane >> 4) & 1) << 5) | (((lane >> 5) & 1) << 8); }
constexpr int v_rd_off(int d0, int ks, int half) { return d0 * 512 + ks * 4096 + half * 2048; }
template <int OFF> __device__ __forceinline__ s16x4 tr_read(int vb) {
  s16x4 r; asm volatile("ds_read_b64_tr_b16 %0, %1 offset:%2" : "=&v"(r) : "v"(vb), "i"(OFF) : "memory"); return r;
}
template <int D0> __device__ __forceinline__ void pv_one(f32x16& od, int vb, bf16x8 pa0, bf16x8 pa1, bf16x8 pa2, bf16x8 pa3) {
  const s16x4 l0 = tr_read<v_rd_off(D0, 0, 0)>(vb), h0 = tr_read<v_rd_off(D0, 0, 1)>(vb), l1 = tr_read<v_rd_off(D0, 1, 0)>(vb), h1 = tr_read<v_rd_off(D0, 1, 1)>(vb);
  const s16x4 l2 = tr_read<v_rd_off(D0, 2, 0)>(vb), h2 = tr_read<v_rd_off(D0, 2, 1)>(vb), l3 = tr_read<v_rd_off(D0, 3, 0)>(vb), h3 = tr_read<v_rd_off(D0, 3, 1)>(vb);
  asm volatile("s_waitcnt lgkmcnt(0)" ::: "memory"); SBAR();
#define PK(L, H) (bf16x8){L[0], L[1], L[2], L[3], H[0], H[1], H[2], H[3]}
  od = __builtin_amdgcn_mfma_f32_32x32x16_bf16(pa0, PK(l0, h0), od, 0, 0, 0);
  od = __builtin_amdgcn_mfma_f32_32x32x16_bf16(pa1, PK(l1, h1), od, 0, 0, 0);
  od = __builtin_amdgcn_mfma_f32_32x32x16_bf16(pa2, PK(l2, h2), od, 0, 0, 0);
  od = __builtin_amdgcn_mfma_f32_32x32x16_bf16(pa3, PK(l3, h3), od, 0, 0, 0);
#undef PK
}
__device__ __forceinline__ void pv_d0(f32x16* o, int vb, bf16x8 pa0, bf16x8 pa1, bf16x8 pa2, bf16x8 pa3) {
  pv_one<0>(o[0], vb, pa0, pa1, pa2, pa3); pv_one<1>(o[1], vb, pa0, pa1, pa2, pa3); pv_one<2>(o[2], vb, pa0, pa1, pa2, pa3); pv_one<3>(o[3], vb, pa0, pa1, pa2, pa3);
}

template <typename TQ>
__device__ __forceinline__ void attn_dense_body(const TQ* __restrict__ Qb, const bf16* __restrict__ Kh, const bf16* __restrict__ Vh,
                                                bf16* __restrict__ Ob, int seq, char* lds) {
  using St = Stage<bf16>; using SQ = Stage<TQ>;
  const int tid = opaque_tid(), wid = tid >> 6, lane = tid & 63, r32 = lane & 31, hi = lane >> 5;
  bf16* V_lds = (bf16*)lds; bf16* K_lds = (bf16*)(lds + 2 * SHM_V);
  float* ws = (float*)(lds + 2 * SHM_V + 2 * SHM_K) + wid * 64; float* li_l = ws; float* al_l = ws + 32;
  float m_reg = -1e30f, l_reg = 0; f32x16 o[4] = {}; bf16x8 qr[8];
  const TQ* Qw = Qb + (long)(wid * QBLK + r32) * LDQ + hi * 8;
#pragma unroll
  for (int d0 = 0; d0 < 8; ++d0) qr[d0] = SQ::tobf(SQ::ld8(Qw + d0 * 16));
  const int sr = tid >> 4, sc = (tid & 15) * 8, vst0 = v_st(sr, sc), vst1 = v_st(32 + sr, sc);
  const int vb0 = (int)(uintptr_t)V_lds + v_rd_base(lane);
  struct { typename St::T vs0, vs1, ks0, ks1; } sr_[SDEPTH];
#define SLOAD(i, k0) do { sr_[i].vs0 = St::ld8(&Vh[(long)((k0) + sr) * LDK + sc]); sr_[i].vs1 = St::ld8(&Vh[(long)((k0) + 32 + sr) * LDK + sc]); \
    sr_[i].ks0 = St::ld8(&Kh[(long)((k0) + sr) * LDK + sc]); sr_[i].ks1 = St::ld8(&Kh[(long)((k0) + 32 + sr) * LDK + sc]); } while (0)
#define SWRITE(b, i) do { *(bf16x8*)((char*)V_lds + (b) * SHM_V + vst0) = St::tobf(sr_[i].vs0);          \
    *(bf16x8*)((char*)V_lds + (b) * SHM_V + vst1) = St::tobf(sr_[i].vs1); int kc = sc * 2;               \
    *(bf16x8*)((char*)K_lds + (b) * SHM_K + KSWZ(sr, kc)) = St::tobf(sr_[i].ks0);                       \
    *(bf16x8*)((char*)K_lds + (b) * SHM_K + KSWZ(32 + sr, kc)) = St::tobf(sr_[i].ks1); } while (0)
#define SWAIT() do { if constexpr (SDEPTH == 2) asm volatile("s_waitcnt vmcnt(4)" ::: "memory"); else asm volatile("s_waitcnt vmcnt(0)" ::: "memory"); } while (0)
#define RESC(a) do { if (__any((a) < 1.f)) { if (hi == 0) al_l[r32] = (a); asm volatile("s_waitcnt lgkmcnt(0)" ::: "memory"); \
    for (int d = 0; d < 4; ++d) for (int r = 0; r < 16; ++r) o[d][r] *= al_l[crow(r, hi)]; } } while (0)
  f32x16 pA0, pA1, pB0, pB1; float mnA, mnB, alA, alB; bf16x8 pa0, pa1, pa2, pa3; const int NT = seq / KVBLK;
  constexpr int SE = 0, SO = SDEPTH - 1;
  SLOAD(SE, 0); asm volatile("s_waitcnt vmcnt(0)" ::: "memory"); SWRITE(0, SE); __syncthreads();
  qkt(pA0, pA1, K_lds, qr, r32, hi); partialSM(pA0, pA1, m_reg, mnA, alA);
  SLOAD(SO, KVBLK); if constexpr (SDEPTH == 2) { if (2 < NT) SLOAD(SE, 2 * KVBLK); }
  SWAIT(); SWRITE(1, SO); __syncthreads();
  for (int j = 1; j + 1 < NT; j += 2) {
    SBAR(); qkt(pB0, pB1, (bf16*)((char*)K_lds + SHM_K), qr, r32, hi);
    finishSM(pA0, pA1, alA, l_reg, pa0, pa1, pa2, pa3); SBAR();
    SLOAD(SO, (j + SDEPTH) * KVBLK); SBAR();
    pv_d0(o, vb0, pa0, pa1, pa2, pa3); partialSM(pB0, pB1, m_reg, mnB, alB);
    __syncthreads(); SWAIT(); SWRITE(0, SE);
    RESC(alB); __syncthreads();
    SBAR(); qkt(pA0, pA1, K_lds, qr, r32, hi);
    finishSM(pB0, pB1, alB, l_reg, pa0, pa1, pa2, pa3); SBAR();
    if (SDEPTH == 1 || j + 3 < NT) SLOAD(SE, (j + 1 + SDEPTH) * KVBLK); SBAR();
    pv_d0(o, vb0 + (int)SHM_V, pa0, pa1, pa2, pa3); partialSM(pA0, pA1, m_reg, mnA, alA);
    __syncthreads(); SWAIT(); SWRITE(1, SO);
    RESC(alA); __syncthreads();
  }
  SBAR(); qkt(pB0, pB1, (bf16*)((char*)K_lds + SHM_K), qr, r32, hi);
  finishSM(pA0, pA1, alA, l_reg, pa0, pa1, pa2, pa3); SBAR();
  pv_d0(o, vb0, pa0, pa1, pa2, pa3); partialSM(pB0, pB1, m_reg, mnB, alB);
  __syncthreads(); RESC(alB);
  finishSM(pB0, pB1, alB, l_reg, pa0, pa1, pa2, pa3); SBAR();
  pv_d0(o, vb0 + (int)SHM_V, pa0, pa1, pa2, pa3);
  if (hi == 0) li_l[r32] = l_reg; asm volatile("s_waitcnt lgkmcnt(0)" ::: "memory");
  float rli[16];
#pragma unroll
  for (int r = 0; r < 16; ++r) rli[r] = __builtin_amdgcn_rcpf(li_l[crow(r, hi)]);
  bf16* Ow = Ob + (long)(wid * QBLK) * LDO;
#pragma unroll
  for (int r = 0; r < 16; ++r) { int orow = crow(r, hi);
    for (int d0 = 0; d0 < 4; ++d0) Ow[(long)orow * LDO + d0 * 32 + r32] = __float2bfloat16(o[d0][r] * rli[r]); }
#undef SLOAD
#undef SWRITE
#undef SWAIT
#undef RESC
}

}
#define LAS __attribute__((address_space(3)))
typedef unsigned short bf16_t;
typedef short bf16x8 __attribute__((ext_vector_type(8)));
typedef short s16x4 __attribute__((ext_vector_type(4)));
typedef float f32x4 __attribute__((ext_vector_type(4)));
typedef float f32x16 __attribute__((ext_vector_type(16)));
typedef unsigned u32x4 __attribute__((ext_vector_type(4)));
typedef unsigned u32x2 __attribute__((ext_vector_type(2)));
using pg8::cvtpk_s; using pg8::bf_lo; using pg8::bf_hi; using pg8::silu_f;

constexpr int DM = 1024, SEQ = 16384, CTXL = 256, NLAT = 2 * SEQ, MROWS = NLAT + 2 * CTXL, DFF = 4096;
constexpr float EPS = 1e-6f;
constexpr size_t MiB = 1u << 20;
constexpr size_t WS_MOD = 0, WS_CTX = 1 * MiB, WS_WT = 4 * MiB, WS_H = 41 * MiB, WS_AB = 106 * MiB, WS_RSTD = 115 * MiB, WS_P = 118 * MiB, WS_O = 378 * MiB, WS_END = 508 * MiB;
constexpr size_t WT_A = WS_WT, WT_Z = WS_WT + 9 * MiB, WT_O = WS_WT + 13 * MiB, WT_1 = WS_WT + 17 * MiB, WT_2 = WS_WT + 25 * MiB;
constexpr size_t WS_QM = 313 * MiB, WS_KM = 378 * MiB, WS_OGLA = 443 * MiB, WS_AQ = 41 * MiB, WS_EL = 74 * MiB;
constexpr size_t WS_TP = 4 * MiB, WS_HALO = 378 * MiB;
constexpr size_t WS_QR = 216 * MiB, WS_KR = 281 * MiB, WS_VR = 298 * MiB;
constexpr int SKV = SEQ + CTXL;
constexpr int LDS_BYTES = 155648;
enum { OP_MOD, OP_PREP, OP_GEMM_IN, OP_DNSCAN, OP_DNREDO, OP_GEMM_Z, OP_GEMM_OUT, OP_NORM2, OP_FFN1, OP_FFN2, OP_GLAPREP, OP_GLASCAN, OP_GLAGATE, OP_QKROPE, OP_ATTN, OP_DNHALO, OP_DNCONV, OP_DNT };

struct Args { const float* in[25]; float* out; unsigned char* ws; int ph_lo, ph_hi; };

__device__ __forceinline__ float wave_sum(float v) {
#pragma unroll
    for (int o = 1; o < 64; o <<= 1) v += __shfl_xor(v, o);
    return v;
}
__device__ __forceinline__ float softplus_f(float x) { return x > 20.f ? x : log1pf(__expf(x)); }
__device__ __forceinline__ float logsigmoid_f(float x) { return fminf(x, 0.f) - log1pf(__expf(-fabsf(x))); }
__device__ __forceinline__ bf16_t f2bf(float f) { return (bf16_t)(cvtpk_s(f, 0.f) & 0xffffu); }
__device__ __forceinline__ float bf2f(bf16_t v) { return __builtin_bit_cast(float, (unsigned)v << 16); }

__device__ __forceinline__ void transpose_item(const float* W, int ldw, int c0, int ncols, int K, bf16_t* WT, int row_off, LAS float* scr, int item, int lane) {
    const int nblk = ncols / 32, kb = item / nblk, nb = item % nblk, k0 = 64 * kb, n0 = 32 * nb;
#pragma unroll 8
    for (int i = 0; i < 32; ++i) { const int kk = 2 * i + (lane >> 5); scr[kk * 33 + (lane & 31)] = W[(size_t)(k0 + kk) * ldw + c0 + n0 + (lane & 31)]; }
    asm volatile("s_waitcnt lgkmcnt(0)" ::: "memory");
    const int c = lane & 7;
#pragma unroll
    for (int j = 0; j < 4; ++j) { const int n = (lane >> 3) + 8 * j; const LAS float* s = scr + (8 * c) * 33 + n;
        u32x4 o; o.x = cvtpk_s(s[0 * 33], s[1 * 33]); o.y = cvtpk_s(s[2 * 33], s[3 * 33]); o.z = cvtpk_s(s[4 * 33], s[5 * 33]); o.w = cvtpk_s(s[6 * 33], s[7 * 33]);
        *(u32x4*)(WT + (size_t)(row_off + n0 + n) * K + k0 + 8 * c) = o; }
    asm volatile("s_waitcnt lgkmcnt(0)" ::: "memory");
}
__device__ __forceinline__ void transpose_mat(const float* W, int ldw, int c0, int ncols, int K, bf16_t* WT, int row_off, LAS float* scr, int gw, int NGW, int lane) {
    const int nitems = (K / 64) * (ncols / 32);
    for (int it = gw; it < nitems; it += NGW) transpose_item(W, ldw, c0, ncols, K, WT, row_off, scr, it, lane);
}
__device__ __forceinline__ void normmod_rows(const float* xl, const float* xc, const float* g, const float* modl, int sidx, bf16_t* H, int gw, int NGW, int lane) {
    for (int row = gw; row < MROWS; row += NGW) {
        const float* xr = row < NLAT ? xl + (size_t)row * DM : xc + (size_t)(row - NLAT) * DM;
        const int mi = row < SEQ ? 0 : (row < NLAT ? 1 : 2);
        const float* sh = modl + (size_t)mi * 6144 + (size_t)sidx * 1024; const float* sc = sh + 1024;
        f32x4 v[4]; float ss = 0.f;
#pragma unroll
        for (int j = 0; j < 4; ++j) { v[j] = *(const f32x4*)(xr + 4 * lane + 256 * j); ss += (v[j][0] * v[j][0] + v[j][1] * v[j][1]) + (v[j][2] * v[j][2] + v[j][3] * v[j][3]); }
        const float rinv = rsqrtf(wave_sum(ss) * (1.f / DM) + EPS);
#pragma unroll
        for (int j = 0; j < 4; ++j) { const int c = 4 * lane + 256 * j; const f32x4 gg = *(const f32x4*)(g + c), s1 = *(const f32x4*)(sc + c), s0 = *(const f32x4*)(sh + c);
            f32x4 y;
#pragma unroll
            for (int e = 0; e < 4; ++e) y[e] = v[j][e] * rinv * gg[e] * (1.f + s1[e]) + s0[e];
            u32x2 w; w.x = cvtpk_s(y[0], y[1]); w.y = cvtpk_s(y[2], y[3]); *(u32x2*)(H + (size_t)row * DM + c) = w; }
    }
}
__device__ __forceinline__ int crow(int x, int h) { return (x & 3) + 8 * (x >> 2) + 4 * h; }
#define MFMA32(a, b, c) __builtin_amdgcn_mfma_f32_32x32x16_bf16((a), (b), (c), 0, 0, 0)
__device__ __forceinline__ bf16x8 frag_nat(const LAS bf16_t* img, int LD, int row, int ks, int h) { return *(const LAS bf16x8*)(img + row * LD + 16 * ks + 8 * h); }
__device__ __forceinline__ bf16x8 frag_perm(const LAS bf16_t* img, int LD, int row, int ks, int h) {
    const s16x4 lo = *(const LAS s16x4*)(img + row * LD + 16 * ks + 4 * h), hi = *(const LAS s16x4*)(img + row * LD + 16 * ks + 8 + 4 * h);
    return __builtin_shufflevector(lo, hi, 0, 1, 2, 3, 4, 5, 6, 7);
}
__device__ __forceinline__ s16x4 tr4(const LAS bf16_t* p) { return __builtin_bit_cast(s16x4, __builtin_amdgcn_ds_read_tr16_b64_v4i16((LAS s16x4*)p)); }
__device__ __forceinline__ bf16x8 frag_tr(const LAS bf16_t* img, int LD, int m0, int ks, int lane) {
    const int i16 = lane & 15, q = i16 >> 2, p = i16 & 3, blk = (lane >> 4) & 1, h = lane >> 5;
    const LAS bf16_t* a = img + (16 * ks + 4 * h + q) * LD + m0 + 16 * blk + 4 * p;
    const s16x4 lo = tr4(a), hi = tr4(a + 8 * LD);
    return __builtin_shufflevector(lo, hi, 0, 1, 2, 3, 4, 5, 6, 7);
}
__device__ __forceinline__ bf16x8 pack_step(const f32x16& x, int s) {
    u32x4 p; p.x = cvtpk_s(x[8 * s + 0], x[8 * s + 1]); p.y = cvtpk_s(x[8 * s + 2], x[8 * s + 3]); p.z = cvtpk_s(x[8 * s + 4], x[8 * s + 5]); p.w = cvtpk_s(x[8 * s + 6], x[8 * s + 7]);
    return __builtin_bit_cast(bf16x8, p);
}
__device__ __forceinline__ void dn_halo_phase(const bf16_t* P, bf16_t* HALO, int G) {
    const int tid = opaque_tid();
    for (size_t e = (size_t)blockIdx.x * 512 + tid; e < (size_t)520 * 4 * 512; e += (size_t)G * 512) {
        const int c = (int)(e & 511), j = (int)((e >> 9) & 3), rb = (int)(e >> 11);
        const int row = rb * 64 + (j < 2 ? j : 60 + j);
        ((u32x4*)(HALO + ((size_t)rb * 4 + j) * 4096))[c] = ((const u32x4*)(P + (size_t)row * 4096))[c];
    }
}
__device__ __forceinline__ void unpack8(const u32x4 v, float (&f)[8]) { f[0] = bf_lo(v.x); f[1] = bf_hi(v.x); f[2] = bf_lo(v.y); f[3] = bf_hi(v.y); f[4] = bf_lo(v.z); f[5] = bf_hi(v.z); f[6] = bf_lo(v.w); f[7] = bf_hi(v.w); }
__device__ __forceinline__ void dn_conv_phase(bf16_t* P, const bf16_t* HALO, const float* conv_w, int G) {
    const int tid = opaque_tid(), col0 = 8 * tid;
    float cw[8][5];
#pragma unroll
    for (int c = 0; c < 8; ++c)
#pragma unroll
        for (int tap = 0; tap < 5; ++tap) cw[c][tap] = conv_w[(size_t)(col0 + c) * 5 + tap];
    const int kind = col0 < 1024 ? 0 : (col0 < 2048 ? 1 : 2);
    for (int rb = blockIdx.x; rb < 520; rb += G) {
        const int cs = rb < 512 ? (rb & 255) : ((rb - 512) & 3); const bool sfirst = cs == 0, slast = rb < 512 ? cs == 255 : cs == 3;
        const u32x4 zero = (u32x4){0u, 0u, 0u, 0u};
        bf16_t* base = P + (size_t)rb * 64 * 4096 + col0;
        u32x4 w0 = sfirst ? zero : *(const u32x4*)(HALO + ((size_t)(rb - 1) * 4 + 2) * 4096 + col0);
        u32x4 w1 = sfirst ? zero : *(const u32x4*)(HALO + ((size_t)(rb - 1) * 4 + 3) * 4096 + col0);
        u32x4 w2 = *(const u32x4*)(base), w3 = *(const u32x4*)(base + 4096);
#pragma unroll 4
        for (int rr = 0; rr < 64; ++rr) {
            u32x4 w4;
            if (rr + 2 < 64) w4 = *(const u32x4*)(base + (size_t)(rr + 2) * 4096);
            else w4 = slast ? zero : *(const u32x4*)(HALO + ((size_t)(rb + 1) * 4 + (rr + 2 - 64)) * 4096 + col0);
            float x0[8], x1[8], x2[8], x3[8], x4[8], y[8];
            unpack8(w0, x0); unpack8(w1, x1); unpack8(w2, x2); unpack8(w3, x3); unpack8(w4, x4);
            float ss = 0.f;
#pragma unroll
            for (int c = 0; c < 8; ++c) { const float a = x0[c] * cw[c][0] + x1[c] * cw[c][1] + x2[c] * cw[c][2] + x3[c] * cw[c][3] + x4[c] * cw[c][4]; y[c] = silu_f(a); ss += y[c] * y[c]; }
            float sc = 1.f;
            if (kind < 2) { ss += __shfl_xor(ss, 1); ss += __shfl_xor(ss, 2); ss += __shfl_xor(ss, 4); ss += __shfl_xor(ss, 8); sc = rsqrtf(ss + EPS) * (kind == 0 ? 0.08838834764831845f : 1.f); }
            u32x4 o; o.x = cvtpk_s(y[0] * sc, y[1] * sc); o.y = cvtpk_s(y[2] * sc, y[3] * sc); o.z = cvtpk_s(y[4] * sc, y[5] * sc); o.w = cvtpk_s(y[6] * sc, y[7] * sc);
            *(u32x4*)(base + (size_t)rr * 4096) = o;
            w0 = w1; w1 = w2; w2 = w3; w3 = w4;
        }
    }
}
constexpr int DT_KB = 0, DT_R = 17408, DT_SC = 33792, DT_DIR = 34816;
template <int W> __device__ __forceinline__ void dn_solve(const LAS float* Mf, float (&t)[16], int lane) {
    const int j = 16 * W + (lane >> 2), q = lane & 3;
#pragma unroll
    for (int s = 0; s < 16; ++s) t[s] = 0.f;
#pragma unroll
    for (int i = 16 * W; i < 64; ++i) {
        float acc = 0.f;
#pragma unroll
        for (int s = 4 * W; s <= (i - 1) / 4 && i > 16 * W; ++s) acc += Mf[i * 64 + 4 * s + q] * t[s];
        acc += __shfl_xor(acc, 1); acc += __shfl_xor(acc, 2);
        const float val = (i == j ? 1.f : 0.f) - acc;
        if (q == (i & 3)) t[i >> 2] = val;
        asm volatile("" : "+v"(t[0]), "+v"(t[1]), "+v"(t[2]), "+v"(t[3]), "+v"(t[4]), "+v"(t[5]), "+v"(t[6]), "+v"(t[7]), "+v"(t[8]), "+v"(t[9]), "+v"(t[10]), "+v"(t[11]), "+v"(t[12]), "+v"(t[13]), "+v"(t[14]), "+v"(t[15]));
    }
}
__device__ __forceinline__ void dn_t_phase(LAS unsigned char* lds, const bf16_t* P, float* AB, bf16_t* TP, const float* a_log, const float* dt_bias, int G) {
    const int tid0 = opaque_tid(), hb = __builtin_amdgcn_readfirstlane(tid0 >> 8);
    for (int itb = blockIdx.x * 2; itb < 16640; itb += 2 * G) {
        const int it = itb + hb, dir = it & 1, vh = (it >> 1) & 15, rb = it >> 5, kh = vh >> 1;
        const int tq = opaque_tid(), t = tq & 255, w = __builtin_amdgcn_readfirstlane((tq >> 6) & 3), lane = tq & 63, r = lane & 31, h = lane >> 5;
        LAS unsigned char* base = lds + hb * DT_DIR;
        LAS bf16_t* Kb = (LAS bf16_t*)(base + DT_KB); LAS float* Mf = (LAS float*)(base + DT_R); LAS bf16_t* Tb = (LAS bf16_t*)(base + DT_R);
        LAS float* sc_beta = (LAS float*)(base + DT_SC); LAS float* sc_gc = sc_beta + 64;
        {
            const int i = t >> 2, ch0 = 32 * (t & 3), ip = dir ? 63 - i : i;
            const u32x4* src = (const u32x4*)(P + (size_t)(rb * 64 + i) * 4096 + 1024 + kh * 128 + ch0);
#pragma unroll
            for (int v = 0; v < 4; ++v) *(LAS u32x4*)(Kb + ip * 136 + ch0 + 8 * v) = src[v];
            if (t < 64) {
                const int ti = dir ? 63 - t : t; float* ab = AB + (size_t)(rb * 64 + ti) * 64;
                const float av = ab[dir * 16 + vh], bv = ab[32 + dir * 16 + vh];
                const float g = -__expf(a_log[dir * 16 + vh]) * softplus_f(av + dt_bias[dir * 16 + vh]), beta = 1.f / (1.f + __expf(-bv));
                float gc = g;
#pragma unroll
                for (int o = 1; o < 64; o <<= 1) { const float up = __shfl_up(gc, o); if (t >= o) gc += up; }
                sc_beta[t] = beta; sc_gc[t] = gc;
                ab[dir * 16 + vh] = gc; ab[32 + dir * 16 + vh] = beta;
            }
        }
        __syncthreads();
        const int ti = w >> 1, tj = w & 1;
        {
            f32x16 acc;
#pragma unroll
            for (int x = 0; x < 16; ++x) acc[x] = 0.f;
            if (!(ti == 0 && tj == 1)) {
#pragma unroll
                for (int ks = 0; ks < 8; ++ks) acc = MFMA32(frag_nat(Kb, 136, 32 * ti + r, ks, h), frag_nat(Kb, 136, 32 * tj + r, ks, h), acc);
            }
            const int j = 32 * tj + r; const float gj = sc_gc[j];
#pragma unroll
            for (int x = 0; x < 16; ++x) { const int i = 32 * ti + crow(x, h);
                Mf[i * 64 + j] = (i > j) ? sc_beta[i] * acc[x] * __expf(sc_gc[i] - gj) : 0.f; }
        }
        __syncthreads();
        float tc[16];
        if (w == 0) dn_solve<0>(Mf, tc, lane); else if (w == 1) dn_solve<1>(Mf, tc, lane); else if (w == 2) dn_solve<2>(Mf, tc, lane); else dn_solve<3>(Mf, tc, lane);
        __syncthreads();
        {
            const int j = 16 * w + (lane >> 2), q = lane & 3;
#pragma unroll
            for (int s = 0; s < 16; ++s) Tb[(4 * s + q) * 72 + j] = f2bf(tc[s]);
        }
        __syncthreads();
        {
            bf16_t* dst = TP + (size_t)it * 3072;
#pragma unroll
            for (int k2 = 0; k2 < 2; ++k2) { const int c = t + 256 * k2;
                if (c < 384) { const int blk = c >> 7, rowc = (c & 127) >> 2, cc = c & 3, br = blk ? 1 : 0, bc = blk == 2 ? 1 : 0;
                    *(u32x4*)(dst + c * 8) = *(const LAS u32x4*)(Tb + (32 * br + rowc) * 72 + 32 * bc + 8 * cc); } }
        }
        __syncthreads();
    }
}
constexpr int DN_KB = 0, DN_QB = 17408, DN_VB = 34816, DN_TB = 51200, DN_AB = 60416, DN_SC = 69632, DN_DIR = 71168;
__device__ __forceinline__ void dn_scan(LAS unsigned char* lds, const bf16_t* P, const float* AB, const bf16_t* TP, bf16_t* OB) {
    const int tid = opaque_tid(), dir = __builtin_amdgcn_readfirstlane(tid >> 8);
    for (int unit = blockIdx.x; unit < 32; unit += gridDim.x) {
        const int b = unit >> 4, vh = unit & 15, kh = vh >> 1;
        f32x16 S[4];
#pragma unroll
        for (int kt = 0; kt < 4; ++kt)
#pragma unroll
            for (int x = 0; x < 16; ++x) S[kt][x] = 0.f;
        __syncthreads();
        for (int step = 0; step < 260; ++step) {
            const int w = __builtin_amdgcn_readfirstlane((opaque_tid() >> 6) & 3);
            LAS unsigned char* base = lds + dir * DN_DIR;
            LAS bf16_t* Kb = (LAS bf16_t*)(base + DN_KB); LAS bf16_t* Qb = (LAS bf16_t*)(base + DN_QB); LAS bf16_t* Vb = (LAS bf16_t*)(base + DN_VB);
            LAS bf16_t* Tb = (LAS bf16_t*)(base + DN_TB); LAS bf16_t* Ab = (LAS bf16_t*)(base + DN_AB);
            LAS float* sc_beta = (LAS float*)(base + DN_SC); LAS float* sc_gc = sc_beta + 64; LAS float* sc_eg = sc_beta + 128; LAS float* sc_tail = sc_beta + 192; LAS float* sc_dl = sc_beta + 256;
            int cidx, rb; bool first;
            if (step < 4) { cidx = dir ? 3 - step : step; rb = 512 + b * 4 + cidx; first = step < 2; }
            else { const int c = step - 4; cidx = dir ? 255 - c : c; rb = b * 256 + cidx; first = c < 128; }
            const int row_base = rb * 64;
            {
                const int tq_ = opaque_tid(), t = tq_ & 255;
                const int i = t >> 2, ch0 = 32 * (t & 3), ip = dir ? 63 - i : i;
                const bf16_t* prow = P + (size_t)(row_base + i) * 4096;
                const u32x4* sk = (const u32x4*)(prow + 1024 + kh * 128 + ch0); const u32x4* sq = (const u32x4*)(prow + kh * 128 + ch0); const u32x4* sv = (const u32x4*)(prow + 2048 + vh * 128 + ch0);
                const bf16_t* tp = TP + (size_t)((rb * 16 + vh) * 2 + dir) * 3072;
                u32x4 k4[4], q4[4], v4[4], t0, t1 = (u32x4){0u, 0u, 0u, 0u};
#pragma unroll
                for (int v = 0; v < 4; ++v) { k4[v] = sk[v]; q4[v] = sq[v]; v4[v] = sv[v]; }
                t0 = *(const u32x4*)(tp + t * 8); if (t < 128) t1 = *(const u32x4*)(tp + (256 + t) * 8);
                float gc = 0.f, beta = 0.f;
                if (t < 64) { const int ti = dir ? 63 - t : t; const float* ab = AB + (size_t)(row_base + ti) * 64; gc = ab[dir * 16 + vh]; beta = ab[32 + dir * 16 + vh]; }
#pragma unroll
                for (int v = 0; v < 4; ++v) { *(LAS u32x4*)(Kb + ip * 136 + ch0 + 8 * v) = k4[v]; *(LAS u32x4*)(Qb + ip * 136 + ch0 + 8 * v) = q4[v]; *(LAS u32x4*)(Vb + ip * 128 + ch0 + 8 * v) = v4[v]; }
                { const int c = t, blk = c >> 7, rowc = (c & 127) >> 2, cc = c & 3, br = blk ? 1 : 0; *(LAS u32x4*)(Tb + (32 * br + rowc) * 72 + 8 * cc) = t0; }
                if (t < 128) { const int rowc = t >> 2, cc = t & 3; *(LAS u32x4*)(Tb + (32 + rowc) * 72 + 32 + 8 * cc) = t1; }
                if (t < 64) { const float gl = __shfl(gc, 63); sc_beta[t] = beta; sc_gc[t] = gc; sc_eg[t] = __expf(gc); sc_tail[t] = __expf(gl - gc); if (t == 0) sc_dl[0] = __expf(gl); }
            }
            __syncthreads();
            {
                const int tq_ = opaque_tid(), lane = tq_ & 63, r = lane & 31, h = lane >> 5;
                const int ti = w >> 1, tj = w & 1;
                if (!(ti == 0 && tj == 1)) {
                    f32x16 qk;
#pragma unroll
                    for (int x = 0; x < 16; ++x) qk[x] = 0.f;
#pragma unroll
                    for (int ks = 0; ks < 8; ++ks) qk = MFMA32(frag_nat(Qb, 136, 32 * ti + r, ks, h), frag_nat(Kb, 136, 32 * tj + r, ks, h), qk);
                    const int jj = 32 * tj + r; const float gj = sc_gc[jj];
#pragma unroll
                    for (int x = 0; x < 16; ++x) { const int i = 32 * ti + crow(x, h);
                        Ab[i * 72 + jj] = f2bf((i >= jj) ? qk[x] * __expf(sc_gc[i] - gj) : 0.f); }
                }
            }
            __syncthreads();
            {
                const int tq_ = opaque_tid(), lane = tq_ & 63, r = lane & 31, h = lane >> 5;
                bf16x8 Sp[8];
#pragma unroll
                for (int ks = 0; ks < 8; ++ks) Sp[ks] = pack_step(S[ks >> 1], ks & 1);
                f32x16 KS[2], QS[2];
#pragma unroll
                for (int mt = 0; mt < 2; ++mt) {
#pragma unroll
                    for (int x = 0; x < 16; ++x) { KS[mt][x] = 0.f; QS[mt][x] = 0.f; }
#pragma unroll
                    for (int ks = 0; ks < 8; ++ks) { KS[mt] = MFMA32(frag_perm(Kb, 136, 32 * mt + r, ks, h), Sp[ks], KS[mt]); QS[mt] = MFMA32(frag_perm(Qb, 136, 32 * mt + r, ks, h), Sp[ks], QS[mt]); }
                    __builtin_amdgcn_sched_barrier(0);
                }
#pragma unroll
                for (int mt = 0; mt < 2; ++mt)
#pragma unroll
                    for (int x = 0; x < 16; ++x) { const int i = 32 * mt + crow(x, h);
                        KS[mt][x] = sc_beta[i] * (bf2f(Vb[i * 128 + 32 * w + r]) - sc_eg[i] * KS[mt][x]); }
                __builtin_amdgcn_sched_barrier(0);
                bf16x8 Xp[4];
#pragma unroll
                for (int ks = 0; ks < 4; ++ks) Xp[ks] = pack_step(KS[ks >> 1], ks & 1);
                f32x16 VN[2];
#pragma unroll
                for (int mt = 0; mt < 2; ++mt) {
#pragma unroll
                    for (int x = 0; x < 16; ++x) VN[mt][x] = 0.f;
#pragma unroll
                    for (int ks = 0; ks < 4; ++ks) if (ks < 2 * mt + 2) VN[mt] = MFMA32(frag_perm(Tb, 72, 32 * mt + r, ks, h), Xp[ks], VN[mt]);
                }
                __builtin_amdgcn_sched_barrier(0);
                bf16x8 VNp[4];
#pragma unroll
                for (int ks = 0; ks < 4; ++ks) VNp[ks] = pack_step(VN[ks >> 1], ks & 1);
#pragma unroll
                for (int mt = 0; mt < 2; ++mt) {
#pragma unroll
                    for (int x = 0; x < 16; ++x) QS[mt][x] *= sc_eg[32 * mt + crow(x, h)];
#pragma unroll
                    for (int ks = 0; ks < 4; ++ks) if (ks < 2 * mt + 2) QS[mt] = MFMA32(frag_perm(Ab, 72, 32 * mt + r, ks, h), VNp[ks], QS[mt]);
                }
                __builtin_amdgcn_sched_barrier(0);
#pragma unroll
                for (int mt = 0; mt < 2; ++mt)
#pragma unroll
                    for (int x = 0; x < 16; ++x) Vb[(32 * mt + crow(x, h)) * 128 + 32 * w + r] = f2bf(QS[mt][x]);
                __builtin_amdgcn_sched_barrier(0);
#pragma unroll
                for (int mt = 0; mt < 2; ++mt)
#pragma unroll
                    for (int x = 0; x < 16; ++x) VN[mt][x] *= sc_tail[32 * mt + crow(x, h)];
#pragma unroll
                for (int ks = 0; ks < 4; ++ks) VNp[ks] = pack_step(VN[ks >> 1], ks & 1);
                __builtin_amdgcn_sched_barrier(0);
                const float dl = sc_dl[0];
#pragma unroll
                for (int kt = 0; kt < 4; ++kt) {
#pragma unroll
                    for (int x = 0; x < 16; ++x) S[kt][x] *= dl;
#pragma unroll
                    for (int ks = 0; ks < 4; ++ks) S[kt] = MFMA32(frag_tr(Kb, 136, 32 * kt, ks, lane), VNp[ks], S[kt]);
                    __builtin_amdgcn_sched_barrier(0);
                }
            }
            __syncthreads();
            {
                const int tq_ = opaque_tid(), t = tq_ & 255;
                const int i = t >> 2, ch0 = 32 * (t & 3), ip = dir ? 63 - i : i;
                u32x4* gp = (u32x4*)(OB + (size_t)(row_base + i) * 2048 + vh * 128 + ch0);
#pragma unroll
                for (int v = 0; v < 4; ++v) { u32x4 o = *(const LAS u32x4*)(Vb + ip * 128 + ch0 + 8 * v);
                    if (!first) { const u32x4 e = gp[v];
                        o.x = cvtpk_s(bf_lo(o.x) + bf_lo(e.x), bf_hi(o.x) + bf_hi(e.x)); o.y = cvtpk_s(bf_lo(o.y) + bf_lo(e.y), bf_hi(o.y) + bf_hi(e.y));
                        o.z = cvtpk_s(bf_lo(o.z) + bf_lo(e.z), bf_hi(o.z) + bf_hi(e.z)); o.w = cvtpk_s(bf_lo(o.w) + bf_lo(e.w), bf_hi(o.w) + bf_hi(e.w)); }
                    gp[v] = o; }
            }
            __syncthreads();
        }
    }
}
constexpr int GP_QM = 0, GP_KM = 17408, GP_AB = 34816, GP_LOW = 44032, GP_TOT = 48128, GP_DIR = 49152;
__device__ __forceinline__ void gla_prep_phase(LAS unsigned char* lds, const bf16_t* P, const float* LOW, const float* gw2, const float* gb2, bf16_t* QM, bf16_t* KM, bf16_t* AQ, float* EL, int G) {
    const int tid0 = opaque_tid(), hb = __builtin_amdgcn_readfirstlane(tid0 >> 8);
    for (int itb = blockIdx.x * 2; itb < 4160; itb += 2 * G) {
        const int it = itb + hb, dir = it & 1, head = (it >> 1) & 3, rb = it >> 3;
        const int tq = opaque_tid(), t = tq & 255, w = __builtin_amdgcn_readfirstlane((tq >> 6) & 3), lane = tq & 63, r = lane & 31, h = lane >> 5;
        LAS unsigned char* base = lds + hb * GP_DIR;
        LAS bf16_t* Qm = (LAS bf16_t*)(base + GP_QM); LAS bf16_t* Km = (LAS bf16_t*)(base + GP_KM); LAS bf16_t* Ab = (LAS bf16_t*)(base + GP_AB);
        LAS float* lowS = (LAS float*)(base + GP_LOW); LAS float* tot = (LAS float*)(base + GP_TOT);
        *(LAS f32x4*)(lowS + 4 * t) = *(const f32x4*)(LOW + (size_t)(rb * 64 + (t >> 2)) * 32 + dir * 16 + 4 * (t & 3));
        const int dk = t & 127, half = t >> 7, col = head * 128 + dk;
        float w2c[16];
#pragma unroll
        for (int rr = 0; rr < 16; ++rr) w2c[rr] = gw2[(size_t)(dir * 16 + rr) * 512 + col];
        const float b2 = gb2[dir * 512 + col];
        __syncthreads();
        float bc[32]; float run = 0.f;
#pragma unroll
        for (int n = 0; n < 32; ++n) { const int ip = 32 * half + n, i = dir ? 63 - ip : ip; float s = b2;
#pragma unroll
            for (int rr = 0; rr < 16; ++rr) s += lowS[i * 16 + rr] * w2c[rr];
            run += logsigmoid_f(s) * (1.f / 16.f); bc[n] = run; }
        tot[half * 128 + dk] = run;
        __syncthreads();
        const float t0 = tot[dk], last = t0 + tot[128 + dk], off = half ? t0 : 0.f;
        if (half == 0) EL[(size_t)(dir * 520 + rb) * 512 + col] = last;
        {
            const int i0 = dir ? 63 - 32 * half : 32 * half; const long pstep = dir ? -3072 : 3072;
            const bf16_t* pp = P + (size_t)(rb * 64 + i0) * 3072 + col;
#pragma unroll
            for (int n = 0; n < 32; ++n) { const int ip = 32 * half + n; const float bcv = bc[n] + off;
                const float qv = bf2f(pp[0]), kv = bf2f(pp[512]); pp += pstep;
                Qm[ip * 136 + dk] = f2bf(qv * 0.08838834764831845f * __expf(bcv - last));
                Km[ip * 136 + dk] = f2bf(kv * __expf(last - bcv)); }
        }
        __syncthreads();
        {
            const int ti = w >> 1, tj = w & 1;
            f32x16 acc;
#pragma unroll
            for (int x = 0; x < 16; ++x) acc[x] = 0.f;
            if (!(ti == 0 && tj == 1)) {
#pragma unroll
                for (int ks = 0; ks < 8; ++ks) acc = MFMA32(frag_nat(Qm, 136, 32 * ti + r, ks, h), frag_nat(Km, 136, 32 * tj + r, ks, h), acc);
            }
            const int j = 32 * tj + r;
#pragma unroll
            for (int x = 0; x < 16; ++x) { const int i = 32 * ti + crow(x, h); Ab[i * 72 + j] = f2bf(i >= j ? acc[x] : 0.f); }
            const int row = t >> 2, ch0 = 32 * (t & 3);
            u32x4* dq = (u32x4*)(QM + ((size_t)dir * MROWS + rb * 64 + row) * 512 + head * 128 + ch0); u32x4* dkk = (u32x4*)(KM + ((size_t)dir * MROWS + rb * 64 + row) * 512 + head * 128 + ch0);
#pragma unroll
            for (int v = 0; v < 4; ++v) { dq[v] = *(const LAS u32x4*)(Qm + row * 136 + ch0 + 8 * v); dkk[v] = *(const LAS u32x4*)(Km + row * 136 + ch0 + 8 * v); }
        }
        __syncthreads();
        {
            bf16_t* dst = AQ + (size_t)it * 4096;
#pragma unroll
            for (int k2 = 0; k2 < 2; ++k2) { const int c = t + 256 * k2, row = c >> 3, cc = c & 7; *(u32x4*)(dst + c * 8) = *(const LAS u32x4*)(Ab + row * 72 + 8 * cc); }
        }
        __syncthreads();
    }
}
constexpr int GL_QM = 0, GL_KM = 17408, GL_VB = 34816, GL_AB = 52224, GL_EL = 61440, GL_DIR = 61952;
__device__ __forceinline__ void gla_scan(LAS unsigned char* lds, const bf16_t* P  , const bf16_t* QM, const bf16_t* KM, const bf16_t* AQ, const float* EL, bf16_t* OB  ) {
    const int tid = opaque_tid(), dir = __builtin_amdgcn_readfirstlane(tid >> 8);
    for (int unit = blockIdx.x; unit < 16; unit += gridDim.x) {
        const int b = unit >> 3, head = (unit >> 1) & 3, hf = unit & 1;
        f32x16 S[4];
#pragma unroll
        for (int kt = 0; kt < 4; ++kt)
#pragma unroll
            for (int x = 0; x < 16; ++x) S[kt][x] = 0.f;
        __syncthreads();
        for (int step = 0; step < 260; ++step) {
            const int w = __builtin_amdgcn_readfirstlane((opaque_tid() >> 6) & 3);
            LAS unsigned char* base = lds + dir * GL_DIR;
            LAS bf16_t* Qm = (LAS bf16_t*)(base + GL_QM); LAS bf16_t* Km = (LAS bf16_t*)(base + GL_KM); LAS bf16_t* Vb = (LAS bf16_t*)(base + GL_VB); LAS bf16_t* Ab = (LAS bf16_t*)(base + GL_AB);
            LAS float* el = (LAS float*)(base + GL_EL);
            int cidx, rb; bool first;
            if (step < 4) { cidx = dir ? 3 - step : step; rb = 512 + b * 4 + cidx; first = step < 2; }
            else { const int c = step - 4; cidx = dir ? 255 - c : c; rb = b * 256 + cidx; first = c < 128; }
            const int row_base = rb * 64;
            {
                const int tq_ = opaque_tid(), t = tq_ & 255;
                const int i = t >> 2, ch0 = 32 * (t & 3), ip = dir ? 63 - i : i;
                const u32x4* sq = (const u32x4*)(QM + ((size_t)dir * MROWS + row_base + i) * 512 + head * 128 + ch0);
                const u32x4* sk = (const u32x4*)(KM + ((size_t)dir * MROWS + row_base + i) * 512 + head * 128 + ch0);
                const u32x4* sv = (const u32x4*)(P + (size_t)(row_base + i) * 3072 + 1024 + head * 256 + hf * 128 + ch0);
                const bf16_t* aq = AQ + (size_t)((rb * 4 + head) * 2 + dir) * 4096;
                u32x4 q4[4], k4[4], v4[4], a0, a1;
#pragma unroll
                for (int v = 0; v < 4; ++v) { q4[v] = sq[v]; k4[v] = sk[v]; v4[v] = sv[v]; }
                a0 = *(const u32x4*)(aq + t * 8); a1 = *(const u32x4*)(aq + (256 + t) * 8);
                float elv = 0.f; if (t < 128) elv = EL[(size_t)(dir * 520 + rb) * 512 + head * 128 + t];
#pragma unroll
                for (int v = 0; v < 4; ++v) { *(LAS u32x4*)(Qm + i * 136 + ch0 + 8 * v) = q4[v]; *(LAS u32x4*)(Km + i * 136 + ch0 + 8 * v) = k4[v]; *(LAS u32x4*)(Vb + ip * 136 + ch0 + 8 * v) = v4[v]; }
                { const int c = t, row = c >> 3, cc = c & 7; *(LAS u32x4*)(Ab + row * 72 + 8 * cc) = a0; }
                { const int c = 256 + t, row = c >> 3, cc = c & 7; *(LAS u32x4*)(Ab + row * 72 + 8 * cc) = a1; }
                if (t < 128) el[t] = __expf(elv);
            }
            __syncthreads();
            {
                const int tq_ = opaque_tid(), lane = tq_ & 63, r = lane & 31, h = lane >> 5;
#pragma unroll
                for (int kt = 0; kt < 4; ++kt)
#pragma unroll
                    for (int x = 0; x < 16; ++x) S[kt][x] *= el[32 * kt + crow(x, h)];
                bf16x8 Sp[8];
#pragma unroll
                for (int ks = 0; ks < 8; ++ks) Sp[ks] = pack_step(S[ks >> 1], ks & 1);
                bf16x8 Vf[4];
#pragma unroll
                for (int ks = 0; ks < 4; ++ks) Vf[ks] = frag_tr(Vb, 136, 32 * w, ks, lane);
                f32x16 O[2];
#pragma unroll
                for (int mt = 0; mt < 2; ++mt) {
#pragma unroll
                    for (int x = 0; x < 16; ++x) O[mt][x] = 0.f;
#pragma unroll
                    for (int ks = 0; ks < 8; ++ks) O[mt] = MFMA32(frag_perm(Qm, 136, 32 * mt + r, ks, h), Sp[ks], O[mt]);
#pragma unroll
                    for (int ks = 0; ks < 4; ++ks) if (ks < 2 * mt + 2) O[mt] = MFMA32(frag_perm(Ab, 72, 32 * mt + r, ks, h), Vf[ks], O[mt]);
                    __builtin_amdgcn_sched_barrier(0);
                }
#pragma unroll
                for (int mt = 0; mt < 2; ++mt)
#pragma unroll
                    for (int x = 0; x < 16; ++x) Vb[(32 * mt + crow(x, h)) * 136 + 32 * w + r] = f2bf(O[mt][x]);
                __builtin_amdgcn_sched_barrier(0);
#pragma unroll
                for (int kt = 0; kt < 4; ++kt) {
#pragma unroll
                    for (int ks = 0; ks < 4; ++ks) S[kt] = MFMA32(frag_tr(Km, 136, 32 * kt, ks, lane), Vf[ks], S[kt]);
                    __builtin_amdgcn_sched_barrier(0);
                }
            }
            __syncthreads();
            {
                const int tq_ = opaque_tid(), t = tq_ & 255;
                const int i = t >> 2, ch0 = 32 * (t & 3), ip = dir ? 63 - i : i;
                u32x4* gp = (u32x4*)(OB + (size_t)(row_base + i) * 1024 + head * 256 + hf * 128 + ch0);
#pragma unroll
                for (int v = 0; v < 4; ++v) { u32x4 o = *(const LAS u32x4*)(Vb + ip * 136 + ch0 + 8 * v);
                    if (!first) { const u32x4 e = gp[v];
                        o.x = cvtpk_s(bf_lo(o.x) + bf_lo(e.x), bf_hi(o.x) + bf_hi(e.x)); o.y = cvtpk_s(bf_lo(o.y) + bf_lo(e.y), bf_hi(o.y) + bf_hi(e.y));
                        o.z = cvtpk_s(bf_lo(o.z) + bf_lo(e.z), bf_hi(o.z) + bf_hi(e.z)); o.w = cvtpk_s(bf_lo(o.w) + bf_lo(e.w), bf_hi(o.w) + bf_hi(e.w)); }
                    gp[v] = o; }
            }
            __syncthreads();
        }
    }
}
#define DUP_DN 0
#define DUP_GLA 0
#define DUP_ATT 0
#define DUP_GIN 0
#define DUP_FFN1 0
constexpr unsigned long long pack_ops(const int* ops, int n) { unsigned long long v = 0; for (int i = 0; i < n; ++i) v |= (unsigned long long)ops[i] << (5 * i); return v; }
struct OpList { unsigned long long code; int n; };
constexpr OpList make_list(int mix) {
    int ops[16] = {}; int n = 0;
    ops[n++] = OP_PREP; ops[n++] = OP_GEMM_IN; if (DUP_GIN) ops[n++] = OP_GEMM_IN;
    if (mix == 0) { ops[n++] = OP_DNHALO; ops[n++] = OP_DNCONV; ops[n++] = OP_DNT; ops[n++] = OP_DNSCAN; if (DUP_DN) ops[n++] = OP_DNSCAN; ops[n++] = OP_DNREDO; ops[n++] = OP_GEMM_Z; }
    else if (mix == 1) { ops[n++] = OP_GLAPREP; ops[n++] = OP_GLASCAN; if (DUP_GLA) ops[n++] = OP_GLASCAN; ops[n++] = OP_GLAGATE; }
    else { ops[n++] = OP_QKROPE; ops[n++] = OP_ATTN; if (DUP_ATT) ops[n++] = OP_ATTN; }
    ops[n++] = OP_GEMM_OUT; ops[n++] = OP_NORM2; ops[n++] = OP_FFN1; if (DUP_FFN1) ops[n++] = OP_FFN1; ops[n++] = OP_FFN2;
    return OpList{pack_ops(ops, n), n};
}
constexpr OpList L_DN = make_list(0), L_GL = make_list(1), L_AT = make_list(2);
constexpr int NPHASE = 1 + 2 * L_DN.n + L_GL.n + L_AT.n;
__device__ __forceinline__ void decode_phase(int ph, int& layer, int& op) {
    if (ph == 0) { layer = 0; op = OP_MOD; return; }
    int p = ph - 1;
    if (p < L_DN.n) { layer = 0; op = (int)((L_DN.code >> (5 * p)) & 31ull); return; } p -= L_DN.n;
    if (p < L_GL.n) { layer = 1; op = (int)((L_GL.code >> (5 * p)) & 31ull); return; } p -= L_GL.n;
    if (p < L_AT.n) { layer = 2; op = (int)((L_AT.code >> (5 * p)) & 31ull); return; } p -= L_AT.n;
    layer = 3; op = (int)((L_DN.code >> (5 * p)) & 31ull);
}

__global__ void __launch_bounds__(512, 2) mega(Args args) {
    extern __shared__ __attribute__((aligned(16))) unsigned char lds_raw[];
    LAS unsigned char* lds = (LAS unsigned char*)lds_raw;
    cg::grid_group grid = cg::this_grid();
    const int G = gridDim.x, NGW = G * 8;
    unsigned char* ws = args.ws;
    const float* x_in = args.in[0]; const float* c_in = args.in[1]; const float* ctx_in = args.in[2]; const float* cctx_in = args.in[3];
    const float* ada_w = args.in[4]; const float* ada_b = args.in[5]; const float* norm_mix_g = args.in[6]; const float* norm_ffn_g = args.in[7];
    const float* ffn_w1 = args.in[8]; const float* ffn_w2 = args.in[9];
    float* MOD = (float*)(ws + WS_MOD); float* CTXC = (float*)(ws + WS_CTX); bf16_t* H = (bf16_t*)(ws + WS_H); float* ABF = (float*)(ws + WS_AB); float* RSTD = (float*)(ws + WS_RSTD);
    bf16_t* PB = (bf16_t*)(ws + WS_P); float* out = args.out;

    for (int ph = args.ph_lo; ph < args.ph_hi; ++ph) {
        int layer, op; decode_phase(ph, layer, op);
        const int tid = opaque_tid(), lane = tid & 63, wave = __builtin_amdgcn_readfirstlane(tid >> 6); const int gw = blockIdx.x * 8 + wave;
        const int mix = layer % 3, slot = layer / 3;
        const float* modl = MOD + (size_t)layer * 3 * 6144;
        const float* xl = layer == 0 ? x_in : out; const float* xc = layer == 0 ? ctx_in : CTXC;
        if (op == OP_MOD) {
            LAS float* sl = (LAS float*)lds; LAS float* red = sl + 3 * 1024;
            for (int e = tid; e < 3 * 1024; e += 512) { const float v = e < 2048 ? c_in[e] : cctx_in[e - 2048]; sl[e] = silu_f(v); }
            __syncthreads();
            for (int item = blockIdx.x; item < 4 * 96; item += G) {
                const int ly = item / 96, col = (item % 96) * 64 + lane;
                const float* wp = ada_w + ((size_t)ly * 1024 + 128 * wave) * 6144 + col;
                float a0 = 0.f, a1 = 0.f, a2 = 0.f;
#pragma unroll 8
                for (int k = 0; k < 128; ++k) { const float wv = wp[(size_t)k * 6144]; const int kk = 128 * wave + k; a0 += sl[kk] * wv; a1 += sl[1024 + kk] * wv; a2 += sl[2048 + kk] * wv; }
                red[(wave * 3 + 0) * 64 + lane] = a0; red[(wave * 3 + 1) * 64 + lane] = a1; red[(wave * 3 + 2) * 64 + lane] = a2;
                __syncthreads();
                if (tid < 192) { const int m = tid >> 6; float s = ada_b[(size_t)ly * 6144 + col];
#pragma unroll
                    for (int w2 = 0; w2 < 8; ++w2) s += red[(w2 * 3 + m) * 64 + lane];
                    MOD[((size_t)ly * 3 + m) * 6144 + col] = s; }
                __syncthreads();
            }
        } else if (op == OP_PREP) {
            LAS float* scr = (LAS float*)(lds + wave * 16384);
            bf16_t* wtA = (bf16_t*)(ws + WT_A); bf16_t* wtZ = (bf16_t*)(ws + WT_Z); bf16_t* wtO = (bf16_t*)(ws + WT_O); bf16_t* wt1 = (bf16_t*)(ws + WT_1); bf16_t* wt2 = (bf16_t*)(ws + WT_2);
            if (mix == 0) {
                const float* w_in = args.in[10] + (size_t)slot * 1024 * 6208; const float* w_out = args.in[15] + (size_t)slot * 2048 * 1024;
                transpose_mat(w_in, 6208, 0, 4096, 1024, wtA, 0, scr, gw, NGW, lane);
                transpose_mat(w_in, 6208, 6144, 64, 1024, wtA, 4096, scr, gw, NGW, lane);
                for (size_t e = (size_t)blockIdx.x * 512 + tid; e < (size_t)192 * 1024 * 2 / 16; e += (size_t)G * 512) ((u32x4*)(wtA + (size_t)4160 * 1024))[e] = (u32x4){0u, 0u, 0u, 0u};
            } else if (mix == 1) {
                const float* w_in = args.in[16]; const float* w_out = args.in[20];
                transpose_mat(w_in, 3104, 0, 3104, 1024, wtA, 0, scr, gw, NGW, lane);
                for (size_t e = (size_t)blockIdx.x * 512 + tid; e < (size_t)224 * 1024 * 2 / 16; e += (size_t)G * 512) ((u32x4*)(wtA + (size_t)3104 * 1024))[e] = (u32x4){0u, 0u, 0u, 0u};
                transpose_mat(w_out, 1024, 0, 1024, 1024, wtO, 0, scr, gw, NGW, lane);
            } else {
                const float* w_in = args.in[21]; const float* w_out = args.in[24];
                transpose_mat(w_in, 1536, 0, 1536, 1024, wtA, 0, scr, gw, NGW, lane);
                transpose_mat(w_out, 1024, 0, 1024, 1024, wtO, 0, scr, gw, NGW, lane);
            }
            if (mix != 0) {
                transpose_mat(ffn_w1 + (size_t)layer * 1024 * 4096, 4096, 0, 4096, 1024, wt1, 0, scr, gw, NGW, lane);
                transpose_mat(ffn_w2 + (size_t)layer * 4096 * 1024, 1024, 0, 1024, 4096, wt2, 0, scr, gw, NGW, lane);
            }
            normmod_rows(xl, xc, norm_mix_g + (size_t)layer * 1024, modl, 0, H, gw, NGW, lane);
        } else if (op == OP_DNREDO) {
            LAS float* scr = (LAS float*)(lds + wave * 16384);
            const float* w_in = args.in[10] + (size_t)slot * 1024 * 6208; const float* w_out = args.in[15] + (size_t)slot * 2048 * 1024;
            transpose_mat(w_in, 6208, 4096, 2048, 1024, (bf16_t*)(ws + WT_Z), 0, scr, gw, NGW, lane);
            transpose_mat(w_out, 1024, 0, 1024, 2048, (bf16_t*)(ws + WT_O), 0, scr, gw, NGW, lane);
            transpose_mat(ffn_w1 + (size_t)layer * 1024 * 4096, 4096, 0, 4096, 1024, (bf16_t*)(ws + WT_1), 0, scr, gw, NGW, lane);
            transpose_mat(ffn_w2 + (size_t)layer * 4096 * 1024, 1024, 0, 1024, 4096, (bf16_t*)(ws + WT_2), 0, scr, gw, NGW, lane);
            normmod_rows(xl, xc, norm_mix_g + (size_t)layer * 1024, modl, 0, H, gw, NGW, lane);
            const bf16_t* OB = (const bf16_t*)(ws + WS_O);
            for (int row = gw; row < MROWS; row += NGW) {
                const u32x4* p = (const u32x4*)(OB + (size_t)row * 2048 + 32 * lane); float ss = 0.f;
#pragma unroll
                for (int v = 0; v < 4; ++v) { const u32x4 q = p[v]; const float a0 = bf_lo(q.x), a1 = bf_hi(q.x), a2 = bf_lo(q.y), a3 = bf_hi(q.y), a4 = bf_lo(q.z), a5 = bf_hi(q.z), a6 = bf_lo(q.w), a7 = bf_hi(q.w);
                    ss += (a0 * a0 + a1 * a1) + (a2 * a2 + a3 * a3) + (a4 * a4 + a5 * a5) + (a6 * a6 + a7 * a7); }
                ss += __shfl_xor(ss, 1); ss += __shfl_xor(ss, 2);
                if ((lane & 3) == 0) RSTD[(size_t)row * 16 + (lane >> 2)] = rsqrtf(ss * (1.f / 128.f) + EPS);
            }
        } else if (op == OP_DNHALO) {
            dn_halo_phase(PB, (bf16_t*)(ws + WS_HALO), G);
        } else if (op == OP_DNCONV) {
            dn_conv_phase(PB, (const bf16_t*)(ws + WS_HALO), args.in[11] + (size_t)slot * 4096 * 5, G);
        } else if (op == OP_DNT) {
            dn_t_phase(lds, PB, ABF, (bf16_t*)(ws + WS_TP), args.in[12] + (size_t)slot * 32, args.in[13] + (size_t)slot * 32, G);
        } else if (op == OP_NORM2) {
            normmod_rows(out, CTXC, norm_ffn_g + (size_t)layer * 1024, modl, 3, H, gw, NGW, lane);
        } else if (op == OP_GEMM_IN || op == OP_GEMM_Z || op == OP_GEMM_OUT || op == OP_FFN1 || op == OP_FFN2) {
            pg8::Gemm g; pg8::Epi E;
            E.mode = 0; E.O = PB; E.ldc = 4096; E.tail_pn = -1; E.F = ABF; E.ldf = 64; E.nf = 64; E.rstd = RSTD; E.ng = args.in[14] + (size_t)slot * 128;
            E.src_lat = xl; E.src_ctx = xc; E.dst_lat = out; E.dst_ctx = CTXC; E.mod = modl; E.gidx = 2;
            g.M = MROWS; g.A = H; g.K = 1024;
            bf16_t* OBUF = (bf16_t*)(ws + (mix == 1 ? WS_OGLA : WS_O));
            if (op == OP_GEMM_IN) {
                g.Bt = (const bf16_t*)(ws + WT_A);
                if (mix == 0) { g.N = 4352; E.ldc = 4096; E.tail_pn = 16; E.ldf = 64; E.nf = 64; }
                else if (mix == 1) { g.N = 3328; E.ldc = 3072; E.tail_pn = 12; E.ldf = 32; E.nf = 32; }
                else { g.N = 1536; E.ldc = 1536; }
            } else if (op == OP_GEMM_Z) {
                g.Bt = (const bf16_t*)(ws + WT_Z); g.N = 2048; E.mode = 2; E.O = OBUF; E.ldc = 2048;
            } else if (op == OP_GEMM_OUT) {
                g.A = OBUF; g.K = mix == 0 ? 2048 : 1024; g.Bt = (const bf16_t*)(ws + WT_O); g.N = 1024; E.mode = 3; E.gidx = 2;
            } else if (op == OP_FFN1) {
                g.Bt = (const bf16_t*)(ws + WT_1); g.N = 4096; E.mode = 1; E.ldc = 4096;
            } else {
                g.A = PB; g.K = 4096; g.Bt = (const bf16_t*)(ws + WT_2); g.N = 1024; E.mode = 3; E.gidx = 5; E.src_lat = out; E.src_ctx = CTXC;
            }
            pg8::StaticOrder S; S.init(g.M, g.N, G, (int)blockIdx.x);
#ifndef NO_GEMM
            pg8::gemm_phase<pg8::Epi, pg8::StaticOrder, true, true>(lds, g, S, E);
#endif
        } else if (op == OP_DNSCAN) {
#ifndef NO_DN
            dn_scan(lds, PB, ABF, (const bf16_t*)(ws + WS_TP), (bf16_t*)(ws + WS_O));
#endif
        } else if (op == OP_GLAPREP) {
            gla_prep_phase(lds, PB, ABF, args.in[17], args.in[18], (bf16_t*)(ws + WS_QM), (bf16_t*)(ws + WS_KM), (bf16_t*)(ws + WS_AQ), (float*)(ws + WS_EL), G);
        } else if (op == OP_GLASCAN) {
#ifndef NO_GLA
            gla_scan(lds, PB, (const bf16_t*)(ws + WS_QM), (const bf16_t*)(ws + WS_KM), (const bf16_t*)(ws + WS_AQ), (const float*)(ws + WS_EL), (bf16_t*)(ws + WS_OGLA));
#endif
        } else if (op == OP_GLAGATE) {
            bf16_t* OB = (bf16_t*)(ws + WS_OGLA); const float* ng = args.in[19];
            for (int row = gw; row < MROWS; row += NGW) {
                u32x4* p = (u32x4*)(OB + (size_t)row * 1024 + 16 * lane); const u32x4* gp = (const u32x4*)(PB + (size_t)row * 3072 + 2048 + 16 * lane);
                float o[16], z[16]; float ss = 0.f;
#pragma unroll
                for (int v = 0; v < 2; ++v) { const u32x4 q = p[v], gq = gp[v];
                    o[8 * v + 0] = bf_lo(q.x); o[8 * v + 1] = bf_hi(q.x); o[8 * v + 2] = bf_lo(q.y); o[8 * v + 3] = bf_hi(q.y); o[8 * v + 4] = bf_lo(q.z); o[8 * v + 5] = bf_hi(q.z); o[8 * v + 6] = bf_lo(q.w); o[8 * v + 7] = bf_hi(q.w);
                    z[8 * v + 0] = bf_lo(gq.x); z[8 * v + 1] = bf_hi(gq.x); z[8 * v + 2] = bf_lo(gq.y); z[8 * v + 3] = bf_hi(gq.y); z[8 * v + 4] = bf_lo(gq.z); z[8 * v + 5] = bf_hi(gq.z); z[8 * v + 6] = bf_lo(gq.w); z[8 * v + 7] = bf_hi(gq.w); }
#pragma unroll
                for (int e = 0; e < 16; ++e) ss += o[e] * o[e];
                ss += __shfl_xor(ss, 1); ss += __shfl_xor(ss, 2); ss += __shfl_xor(ss, 4); ss += __shfl_xor(ss, 8);
                const float rs = rsqrtf(ss * (1.f / 256.f) + EPS); const int cb = (16 * lane) & 255;
#pragma unroll
                for (int v = 0; v < 2; ++v) { float rr[8];
#pragma unroll
                    for (int e = 0; e < 8; ++e) rr[e] = o[8 * v + e] * rs * ng[cb + 8 * v + e] * silu_f(z[8 * v + e]);
                    u32x4 wv; wv.x = cvtpk_s(rr[0], rr[1]); wv.y = cvtpk_s(rr[2], rr[3]); wv.z = cvtpk_s(rr[4], rr[5]); wv.w = cvtpk_s(rr[6], rr[7]); p[v] = wv; }
            }
        } else if (op == OP_QKROPE) {
            bf16_t* QR = (bf16_t*)(ws + WS_QR); bf16_t* KR = (bf16_t*)(ws + WS_KR); bf16_t* VR = (bf16_t*)(ws + WS_VR);
            const float* qg = args.in[22]; const float* kg = args.in[23];
            const int hf = lane >> 5, j = lane & 31, e1 = 64 * hf + j, e2 = e1 + 32;
            const float inv_freq = exp2f(-(float)(2 * j) * (1.f / 64.f) * 13.287712379549449f);
            const float gq1 = qg[e1], gq2 = qg[e2], gk1 = kg[e1], gk2 = kg[e2];
            for (int row = gw; row < MROWS; row += NGW) {
                const bool lat = row < NLAT; const int b = lat ? row / SEQ : (row - NLAT) / CTXL; const int tpos = lat ? row % SEQ : (row - NLAT) % CTXL;
                float cs = 1.f, sn = 0.f;
                if (lat) { const float pos = (float)(hf == 0 ? tpos / 64 : tpos % 64); const float ang = pos * inv_freq; sn = sinf(ang); cs = cosf(ang); }
                const bf16_t* pr = PB + (size_t)row * 1536; const int kpos = lat ? tpos : SEQ + tpos;
#pragma unroll
                for (int hd = 0; hd < 10; ++hd) {
                    const float x1 = bf2f(pr[hd * 128 + e1]), x2 = bf2f(pr[hd * 128 + e2]);
                    const float rinv = rsqrtf(wave_sum(x1 * x1 + x2 * x2) * (1.f / 128.f) + EPS);
                    const float y1 = x1 * rinv * (hd < 8 ? gq1 : gk1), y2 = x2 * rinv * (hd < 8 ? gq2 : gk2);
                    const float o1 = y1 * cs - y2 * sn, o2 = y1 * sn + y2 * cs;
                    bf16_t* dst = hd < 8 ? QR + (size_t)row * 1024 + hd * 128 : KR + ((size_t)(b * 2 + (hd - 8)) * SKV + kpos) * 128;
                    dst[e1] = f2bf(o1); dst[e2] = f2bf(o2);
                }
#pragma unroll
                for (int kv = 0; kv < 2; ++kv) { bf16_t* dst = VR + ((size_t)(b * 2 + kv) * SKV + kpos) * 128; dst[e1] = pr[1280 + kv * 128 + e1]; dst[e2] = pr[1280 + kv * 128 + e2]; }
            }
        } else if (op == OP_ATTN) {
            const attn::bf16* QR = (const attn::bf16*)(ws + WS_QR); const attn::bf16* KR = (const attn::bf16*)(ws + WS_KR); const attn::bf16* VR = (const attn::bf16*)(ws + WS_VR);
            attn::bf16* OB = (attn::bf16*)(ws + WS_O);
            for (int u = blockIdx.x; u < 1024 + 16; u += G) {
                size_t qoff, koff; int seq;
                if (u < 1024) { const int pair = u >> 8, b = pair >> 1, kvh = pair & 1, hh = (u >> 6) & 3, qb = u & 63, head = kvh * 4 + hh;
                    qoff = ((size_t)b * SEQ + (size_t)qb * 256) * 1024 + head * 128; koff = (size_t)(b * 2 + kvh) * SKV * 128; seq = SKV; }
                else { const int jx = u - 1024, b = jx >> 3, head = jx & 7, kvh = head >> 2;
                    qoff = ((size_t)NLAT + (size_t)b * CTXL) * 1024 + head * 128; koff = ((size_t)(b * 2 + kvh) * SKV + SEQ) * 128; seq = CTXL; }
                __syncthreads();
#ifndef NO_ATT
                attn::attn_dense_body<attn::bf16>(QR + qoff, KR + koff, VR + koff, OB + qoff, seq, (char*)lds_raw);
#endif
            }
        }
        if (ph + 1 < args.ph_hi) grid.sync();
    }
}

#ifndef MK_MULTI
#define MK_MULTI 0
#endif
extern "C" void kernel_launch(void* const* d_in, const int* in_sizes, int n_in, void* d_out, int out_size, void* d_ws, size_t ws_size, hipStream_t stream) {
    static int grid = 0;
    if (grid == 0) {
        if (n_in != 25 || ws_size < WS_END) { fprintf(stderr, "kernel_launch: unexpected n_in %d / ws_size %zu (need %zu)\n", n_in, ws_size, (size_t)WS_END); grid = -1; return; }
        int dev = 0, cus = 0, per_cu = 0;
        hipGetDevice(&dev); hipDeviceGetAttribute(&cus, hipDeviceAttributeMultiprocessorCount, dev);
        if (hipFuncSetAttribute((const void*)mega, hipFuncAttributeMaxDynamicSharedMemorySize, LDS_BYTES) != hipSuccess) { fprintf(stderr, "kernel_launch: hipFuncSetAttribute failed\n"); grid = -1; return; }
        if (hipOccupancyMaxActiveBlocksPerMultiprocessor(&per_cu, (const void*)mega, 512, LDS_BYTES) != hipSuccess || per_cu < 1) { fprintf(stderr, "kernel_launch: occupancy query says %d\n", per_cu); per_cu = 1; }
        (void)hipGetLastError();
        grid = cus * 1;
    }
    if (grid < 0) return;
    Args a{};
    for (int i = 0; i < 25; ++i) a.in[i] = (const float*)d_in[i];
    a.out = (float*)d_out; a.ws = (unsigned char*)d_ws;
#if MK_MULTI
    for (int ph = 0; ph < NPHASE; ++ph) { a.ph_lo = ph; a.ph_hi = ph + 1; hipLaunchKernelGGL(mega, dim3(grid), dim3(512), LDS_BYTES, stream, a); }
#else
    a.ph_lo = 0; a.ph_hi = NPHASE;
    void* kargs[] = {&a};
    hipError_t e = hipLaunchCooperativeKernel((const void*)mega, dim3(grid), dim3(512), kargs, LDS_BYTES, stream);
    if (e != hipSuccess) fprintf(stderr, "cooperative launch failed: %s (grid %d)\n", hipGetErrorString(e), grid);
#endif
}
```

```cpp
#include <hip/hip_runtime.h>
#include <hip/hip_bf16.h>
#include <hip/hip_cooperative_groups.h>
#include <cstdio>
#include <cstdint>
namespace cg = cooperative_groups;
__device__ __forceinline__ int opaque_tid() { int t = threadIdx.x; asm volatile("" : "+v"(t)); return t; }
namespace pg8 {
#define PG8_LAS __attribute__((address_space(3)))
typedef unsigned short bf16_t;
typedef short bf16x8 __attribute__((ext_vector_type(8)));
typedef float f32x4 __attribute__((ext_vector_type(4)));
typedef unsigned u32x4 __attribute__((ext_vector_type(4)));
constexpr int BM = 256, BK = 64, HALF = 128, HTB = HALF * BK * 2  , STAGE_BYTES = 8 * HTB, NXCD = 8, WGM = 8;

__host__ __device__ __forceinline__ int lds_byte(int r, int c) { const int st = (r >> 4) * 2 + (c >> 5), rr = r & 15, cc = c & 31, ob = rr * 64 + cc * 2; return st * 1024 + (ob ^ (((ob >> 9) & 1) << 5)); }
__host__ __device__ __forceinline__ void stage_rc(int b, int& R, int& C) { const int st = b / 1024, sb = b % 1024, swz = sb ^ (((sb >> 9) & 1) << 5); R = (st >> 1) * 16 + swz / 64; C = (st & 1) * 32 + (swz % 64) / 2; }
__host__ __device__ __forceinline__ int perm32(int rho) { const int n = rho >> 4, i = rho & 15; return 8 * (i >> 2) + 4 * n + (i & 3); }

struct Unit { int pm, pn; };
struct Gemm { const bf16_t* A; const bf16_t* Bt; int M, N, K; };

struct StaticOrder {
    int nM, nN, nwg, G, c;
    __host__ __device__ void init(int M, int N, int G_, int c_) { nM = M / BM; nN = N / BM; nwg = nM * nN; G = G_; c = c_; }
    __host__ __device__ bool next(int i, Unit& u) const {
        const long L = (long)i * G + c; if (L >= nwg) return false;
        int wgid = (int)L; { const int q = nwg / NXCD, r = nwg % NXCD, xcd = wgid % NXCD, off = wgid / NXCD; wgid = (xcd < r ? xcd * (q + 1) : r * (q + 1) + (xcd - r) * q) + off; }
        const int nig = WGM * nN, gid = wgid / nig, fm = gid * WGM, gsz = (nM - fm) < WGM ? (nM - fm) : WGM;
        u.pm = fm + ((wgid % nig) % gsz); u.pn = (wgid % nig) / gsz; return true;
    }
    __device__ __forceinline__ void a_ready(const Unit&) const {}
    __device__ __forceinline__ void done(const Unit&) const {}
};

__device__ __forceinline__ unsigned cvt_pk_bf16(float lo, float hi) { unsigned r; asm volatile("v_cvt_pk_bf16_f32 %0, %1, %2" : "=v"(r) : "v"(lo), "v"(hi)); return r; }
typedef float f32x2 __attribute__((ext_vector_type(2)));
typedef float f32x2_t __attribute__((ext_vector_type(2))); typedef __bf16 bf16x2_t __attribute__((ext_vector_type(2)));
__device__ __forceinline__ unsigned cvtpk_s(float lo, float hi) { f32x2_t v = {lo, hi}; bf16x2_t b = __builtin_convertvector(v, bf16x2_t); return __builtin_bit_cast(unsigned, b); }
__device__ __forceinline__ float bf_lo(unsigned w) { return __builtin_bit_cast(float, w << 16); }
__device__ __forceinline__ float bf_hi(unsigned w) { return __builtin_bit_cast(float, w & 0xffff0000u); }
__device__ __forceinline__ float silu_f(float z) { return z / (1.f + __expf(-z)); }
struct Epi {
    static constexpr bool PERM = true, AFTER_DRAIN = false;
    int mode;
    bf16_t* O; int ldc;
    int tail_pn; float* F; int ldf, nf;
    const float* rstd; const float* ng;
    const float* src_lat; const float* src_ctx; float* dst_lat; float* dst_ctx; const float* mod; int gidx;
    __device__ __forceinline__ void operator()(const f32x4 (&acc)[2][2][4][2], const Unit& u, int wr, int wc, int fr, int fq) const {
        const int row0 = u.pm * BM + wr * 64 + fr; const int col0 = u.pn * BM + wc * 32 + 8 * fq;
        if (mode <= 1) {
            if (u.pn == tail_pn) {
                const int c0 = wc * 32 + 8 * fq;
#pragma unroll
                for (int ai = 0; ai < 2; ++ai)
#pragma unroll
                    for (int m = 0; m < 4; ++m)
#pragma unroll
                        for (int bj = 0; bj < 2; ++bj) { const int cc = c0 + bj * HALF;
                            if (cc < nf) { float* p = F + (size_t)(row0 + ai * HALF + m * 16) * ldf + cc; *(f32x4*)p = acc[ai][bj][m][0]; *(f32x4*)(p + 4) = acc[ai][bj][m][1]; } }
            } else {
#pragma unroll
                for (int ai = 0; ai < 2; ++ai)
#pragma unroll
                    for (int m = 0; m < 4; ++m) { bf16_t* rowp = O + (size_t)(row0 + ai * HALF + m * 16) * ldc + col0;
#pragma unroll
                        for (int bj = 0; bj < 2; ++bj) { f32x4 v0 = acc[ai][bj][m][0], v1 = acc[ai][bj][m][1];
                            if (mode == 1) {
#pragma unroll
                                for (int e = 0; e < 4; ++e) { float a = fmaxf(v0[e], 0.f), b = fmaxf(v1[e], 0.f); v0[e] = a * a; v1[e] = b * b; } }
                            u32x4 w; w.x = cvtpk_s(v0[0], v0[1]); w.y = cvtpk_s(v0[2], v0[3]); w.z = cvtpk_s(v1[0], v1[1]); w.w = cvtpk_s(v1[2], v1[3]);
                            *(u32x4*)(rowp + bj * HALF) = w; } }
            }
        } else if (mode == 2) {
            const f32x4 g0 = *(const f32x4*)(ng + (col0 & 127)), g1 = *(const f32x4*)(ng + (col0 & 127) + 4);
#pragma unroll
            for (int ai = 0; ai < 2; ++ai)
#pragma unroll
                for (int m = 0; m < 4; ++m) { const int row = row0 + ai * HALF + m * 16; bf16_t* rowp = O + (size_t)row * ldc + col0;
#pragma unroll
                    for (int bj = 0; bj < 2; ++bj) { const float rs = rstd[(size_t)row * 16 + ((col0 + bj * HALF) >> 7)];
                        const u32x4 ov = *(const u32x4*)(rowp + bj * HALF); const f32x4 z0 = acc[ai][bj][m][0], z1 = acc[ai][bj][m][1];
                        float r[8];
                        r[0] = bf_lo(ov.x) * rs * g0[0] * silu_f(z0[0]); r[1] = bf_hi(ov.x) * rs * g0[1] * silu_f(z0[1]);
                        r[2] = bf_lo(ov.y) * rs * g0[2] * silu_f(z0[2]); r[3] = bf_hi(ov.y) * rs * g0[3] * silu_f(z0[3]);
                        r[4] = bf_lo(ov.z) * rs * g1[0] * silu_f(z1[0]); r[5] = bf_hi(ov.z) * rs * g1[1] * silu_f(z1[1]);
                        r[6] = bf_lo(ov.w) * rs * g1[2] * silu_f(z1[2]); r[7] = bf_hi(ov.w) * rs * g1[3] * silu_f(z1[3]);
                        u32x4 w; w.x = cvtpk_s(r[0], r[1]); w.y = cvtpk_s(r[2], r[3]); w.z = cvtpk_s(r[4], r[5]); w.w = cvtpk_s(r[6], r[7]);
                        *(u32x4*)(rowp + bj * HALF) = w; } }
        } else {
            const int mi = u.pm < 64 ? 0 : (u.pm < 128 ? 1 : 2);
            const float* gate = mod + (size_t)mi * 6144 + (size_t)gidx * 1024;
            const bool lat = u.pm < 128;
            const float* sb = lat ? src_lat : src_ctx - (size_t)32768 * 1024; float* db = lat ? dst_lat : dst_ctx - (size_t)32768 * 1024;
#pragma unroll
            for (int bj = 0; bj < 2; ++bj)
#pragma unroll
                for (int n = 0; n < 2; ++n) { const int c = col0 + bj * HALF + 4 * n; const f32x4 gv = *(const f32x4*)(gate + c);
#pragma unroll
                    for (int ai = 0; ai < 2; ++ai)
#pragma unroll
                        for (int m = 0; m < 4; ++m) { const size_t off = (size_t)(row0 + ai * HALF + m * 16) * 1024 + c;
                            const f32x4 s = *(const f32x4*)(sb + off); *(f32x4*)(db + off) = s + gv * acc[ai][bj][m][n]; } }
        }
    }
};
template <class Epi, class Sched, bool ALIGN_EPI = false, bool SP2 = false>
__device__ __forceinline__ void gemm_phase(PG8_LAS unsigned char* lds, const Gemm g, const Sched& S, const Epi& E) {
    const int tid = opaque_tid(), wid = __builtin_amdgcn_readfirstlane(tid >> 6), lane = tid & 63, wr = wid >> 2, wc = wid & 3, fr = lane & 15, fq = lane >> 4;
    const int K = g.K, nt = K / BK;
    unsigned voffA[2], voffB[2];
#pragma unroll
    for (int i = 0; i < 2; ++i) { int R, C; stage_rc(tid * 16 + i * 8192, R, C); const int Rb = Epi::PERM ? ((R & ~31) + perm32(R & 31)) : R;
        voffA[i] = (unsigned)(R * K + C) * 2u; voffB[i] = (unsigned)(Rb * K + C) * 2u; }
    const size_t kstep = (size_t)(BK * 2);
    const size_t hstep = (size_t)HALF * K * 2;
    const size_t tstep = 2 * hstep;
    const unsigned ldsw = (unsigned)wid * 1024u;
    const int aoff = lds_byte(wr * 64 + fr, fq * 8), boff = lds_byte(wc * 32 + fr, fq * 8);
#define PG8_SA(b, h) (((b) * 2 + (h)) * HTB)
#define PG8_SB(b, h) ((4 + (b) * 2 + (h)) * HTB)
#define PG8_STAGE(bufoff, gbase, voff) do { _Pragma("unroll") for (int _i = 0; _i < 2; ++_i) \
        __builtin_amdgcn_global_load_lds((const unsigned*)((const char*)(gbase) + (voff)[_i]), (PG8_LAS unsigned*)(lds + (bufoff) + ldsw + _i * 8192), 16, 0, 0); } while (0)
#define PG8_LDA(dst, b, h) do { _Pragma("unroll") for (int m = 0; m < 4; ++m) _Pragma("unroll") for (int k = 0; k < 2; ++k) dst[m][k] = *(const PG8_LAS bf16x8*)(lds + PG8_SA(b, h) + aoff + m * 2048 + k * 1024); } while (0)
#define PG8_LDB(dst, b, h) do { _Pragma("unroll") for (int n = 0; n < 2; ++n) _Pragma("unroll") for (int k = 0; k < 2; ++k) dst[n][k] = *(const PG8_LAS bf16x8*)(lds + PG8_SB(b, h) + boff + n * 2048 + k * 1024); } while (0)
#define PG8_MMA(ai, bj, At, Bt) do { __builtin_amdgcn_s_setprio(1); _Pragma("unroll") for (int m = 0; m < 4; ++m) _Pragma("unroll") for (int n = 0; n < 2; ++n) _Pragma("unroll") for (int k = 0; k < 2; ++k) \
        acc[ai][bj][m][n] = __builtin_amdgcn_mfma_f32_16x16x32_bf16(Bt[n][k], At[m][k], acc[ai][bj][m][n], 0, 0, 0); __builtin_amdgcn_s_setprio(0); } while (0)
#define PG8_WAIT_V(n) asm volatile("s_waitcnt vmcnt(" #n ")" ::: "memory")
#define PG8_WAIT_L(n) asm volatile("s_waitcnt lgkmcnt(" #n ")" ::: "memory")
#define PG8_BAR __builtin_amdgcn_s_barrier()
#define PG8_SCHED __builtin_amdgcn_sched_barrier(0)
    Unit cur, nxt; int ui = 0;
    if (!S.next(0, cur)) return;
    f32x4 acc[2][2][4][2];
#pragma unroll
    for (int a = 0; a < 2; ++a)
#pragma unroll
        for (int b = 0; b < 2; ++b)
#pragma unroll
            for (int m = 0; m < 4; ++m)
#pragma unroll
                for (int n = 0; n < 2; ++n) acc[a][b][m][n] = (f32x4){0.f, 0.f, 0.f, 0.f};
    bf16x8 At[4][2], B0[2][2], B1[2][2];
    const char* cA = (const char*)g.A + (size_t)cur.pm * tstep; const char* cB = (const char*)g.Bt + (size_t)cur.pn * tstep;
    S.a_ready(cur);
    if constexpr (SP2) {
        PG8_STAGE(PG8_SB(0, 0), cB, voffB); PG8_STAGE(PG8_SB(0, 1), cB + hstep, voffB); PG8_STAGE(PG8_SA(0, 0), cA, voffA); PG8_STAGE(PG8_SA(0, 1), cA + hstep, voffA);
        if (wr == 1) PG8_BAR;
        PG8_WAIT_V(2); PG8_BAR;
        PG8_STAGE(PG8_SB(1, 0), cB + kstep, voffB); PG8_STAGE(PG8_SA(1, 0), cA + kstep, voffA); PG8_STAGE(PG8_SB(1, 1), cB + hstep + kstep, voffB);
        PG8_WAIT_V(6); PG8_BAR;
    } else {
        PG8_STAGE(PG8_SB(0, 0), cB, voffB); PG8_STAGE(PG8_SA(0, 0), cA, voffA); PG8_STAGE(PG8_SB(0, 1), cB + hstep, voffB); PG8_STAGE(PG8_SA(0, 1), cA + hstep, voffA);
        if (wr == 1) PG8_BAR;
        PG8_WAIT_V(4); PG8_BAR;
        PG8_STAGE(PG8_SB(1, 0), cB + kstep, voffB); PG8_STAGE(PG8_SA(1, 0), cA + kstep, voffA); PG8_STAGE(PG8_SB(1, 1), cB + hstep + kstep, voffB);
        PG8_WAIT_V(6); PG8_BAR;
    }
    for (;;) {
        const bool has_next = S.next(ui + 1, nxt);
        const char* nA = has_next ? (const char*)g.A + (size_t)nxt.pm * tstep : cA; const char* nB = has_next ? (const char*)g.Bt + (size_t)nxt.pn * tstep : cB;
        for (int t = 0; t < nt; t += 2) {
            const bool last = (t == nt - 2);
            const char* a1 = cA + (size_t)(t + 1) * kstep;
            const char* a2 = last ? nA : cA + (size_t)(t + 2) * kstep; const char* b2 = last ? nB : cB + (size_t)(t + 2) * kstep;
            const char* a3 = a2 + kstep; const char* b3 = b2 + kstep;
            if (last && has_next) S.a_ready(nxt);
            if constexpr (SP2) {
            PG8_LDB(B0, 0, 0); PG8_LDB(B1, 0, 1); PG8_SCHED; PG8_LDA(At, 0, 0); PG8_STAGE(PG8_SA(1, 1), a1 + hstep, voffA);
            PG8_WAIT_V(8); PG8_WAIT_L(0); PG8_BAR; PG8_MMA(0, 0, At, B0); PG8_MMA(0, 1, At, B1); PG8_BAR; PG8_SCHED;
            PG8_LDA(At, 0, 1); PG8_STAGE(PG8_SB(0, 0), b2, voffB); PG8_STAGE(PG8_SB(0, 1), b2 + hstep, voffB); PG8_STAGE(PG8_SA(0, 0), a2, voffA);
            PG8_WAIT_V(8); PG8_WAIT_L(0); PG8_BAR; PG8_MMA(1, 0, At, B0); PG8_MMA(1, 1, At, B1); PG8_BAR; PG8_SCHED;
            PG8_LDB(B0, 1, 0); PG8_LDB(B1, 1, 1); PG8_SCHED; PG8_LDA(At, 1, 0); PG8_STAGE(PG8_SA(0, 1), a2 + hstep, voffA);
            PG8_WAIT_V(8); PG8_WAIT_L(0); PG8_BAR; PG8_MMA(0, 0, At, B0); PG8_MMA(0, 1, At, B1); PG8_BAR; PG8_SCHED;
            PG8_LDA(At, 1, 1); PG8_STAGE(PG8_SB(1, 0), b3, voffB); PG8_STAGE(PG8_SB(1, 1), b3 + hstep, voffB); PG8_STAGE(PG8_SA(1, 0), a3, voffA);
            PG8_WAIT_V(8); PG8_WAIT_L(0); PG8_BAR; PG8_MMA(1, 0, At, B0); PG8_MMA(1, 1, At, B1); PG8_BAR; PG8_SCHED;
            } else {
            PG8_LDB(B0, 0, 0); PG8_SCHED; PG8_LDA(At, 0, 0); PG8_STAGE(PG8_SA(1, 1), a1 + hstep, voffA);
            PG8_WAIT_L(8); PG8_BAR; PG8_WAIT_L(0); PG8_MMA(0, 0, At, B0); PG8_BAR; PG8_SCHED;
            PG8_LDB(B1, 0, 1); PG8_STAGE(PG8_SB(0, 0), b2, voffB);
            PG8_BAR; PG8_WAIT_L(0); PG8_MMA(0, 1, At, B1); PG8_BAR;
            PG8_LDA(At, 0, 1); PG8_STAGE(PG8_SA(0, 0), a2, voffA);
            PG8_BAR; PG8_WAIT_L(0); PG8_MMA(1, 0, At, B0); PG8_BAR; PG8_SCHED;
            PG8_STAGE(PG8_SB(0, 1), b2 + hstep, voffB);
            PG8_WAIT_V(6); PG8_BAR; PG8_MMA(1, 1, At, B1); PG8_BAR;
            PG8_LDB(B0, 1, 0); PG8_SCHED; PG8_LDA(At, 1, 0); PG8_STAGE(PG8_SA(0, 1), a2 + hstep, voffA);
            PG8_WAIT_L(8); PG8_BAR; PG8_WAIT_L(0); PG8_MMA(0, 0, At, B0); PG8_BAR; PG8_SCHED;
            PG8_LDB(B1, 1, 1); PG8_STAGE(PG8_SB(1, 0), b3, voffB);
            PG8_BAR; PG8_WAIT_L(0); PG8_MMA(0, 1, At, B1); PG8_BAR;
            PG8_LDA(At, 1, 1); PG8_STAGE(PG8_SA(1, 0), a3, voffA);
            PG8_BAR; PG8_WAIT_L(0); PG8_MMA(1, 0, At, B0); PG8_BAR; PG8_SCHED;
            PG8_STAGE(PG8_SB(1, 1), b3 + hstep, voffB);
            PG8_WAIT_V(6); PG8_BAR; PG8_MMA(1, 1, At, B1); PG8_BAR;
            }
        }
        if constexpr (ALIGN_EPI) { if (wr == 0) PG8_BAR; }
        if constexpr (!Epi::AFTER_DRAIN) { E(acc, cur, wr, wc, fr, fq); S.done(cur); }
        if (!has_next) break;
#pragma unroll
        for (int a = 0; a < 2; ++a)
#pragma unroll
            for (int b = 0; b < 2; ++b)
#pragma unroll
                for (int m = 0; m < 4; ++m)
#pragma unroll
                    for (int n = 0; n < 2; ++n) acc[a][b][m][n] = (f32x4){0.f, 0.f, 0.f, 0.f};
        cur = nxt; cA = nA; cB = nB; ++ui;
        if constexpr (ALIGN_EPI) { if (wr == 1) PG8_BAR; }
    }
    PG8_WAIT_V(0);
    if constexpr (!ALIGN_EPI) { if (wr == 0) PG8_BAR; }
    PG8_BAR;
    if constexpr (Epi::AFTER_DRAIN) { E.fused(acc, cur, wr, wc, fr, fq, lds, wid, lane); S.done(cur); }
#undef PG8_SA
#undef PG8_SB
#undef PG8_STAGE
#undef PG8_LDA
#undef PG8_LDB
#undef PG8_MMA
#undef PG8_WAIT_V
#undef PG8_WAIT_L
#undef PG8_BAR
#undef PG8_SCHED
}
}
namespace attn {
using bf16 = __hip_bfloat16;
constexpr int   D = 128, NW = 8, QBLK = 32, KVBLK = 64;
constexpr float SCALE = 0.088388347648318440f;
constexpr float THR = 8.f;
constexpr int SDEPTH = 2;
constexpr int LDQ = 1024, LDK = 128, LDO = 1024;
constexpr size_t SHM_V = KVBLK * D * 2, SHM_K = KVBLK * D * 2, SHM_ATTN = 2 * SHM_V + 2 * SHM_K + NW * 64 * 4;
using bf16x8 = __attribute__((ext_vector_type(8))) short;
using s16x4  = __attribute__((ext_vector_type(4))) short;
using f32x16 = __attribute__((ext_vector_type(16))) float;
using f32x8  = __attribute__((ext_vector_type(8))) float;
using u32x4  = __attribute__((ext_vector_type(4))) unsigned;
#define KSWZ(row, colB) ((row) * 256 + ((colB) ^ (((row) & 7) << 4)))
#define SBAR() __builtin_amdgcn_sched_barrier(0)
__device__ __forceinline__ int crow(int r, int hi) { return (r & 3) + 8 * (r >> 2) + 4 * hi; }
__device__ __forceinline__ unsigned cvtpk(float lo, float hi) {
  unsigned r; asm volatile("v_cvt_pk_bf16_f32 %0, %1, %2" : "=v"(r) : "v"(lo), "v"(hi)); return r;
}
template <typename TIn> struct Stage;
template <> struct Stage<bf16>  { using T = bf16x8;
  __device__ static __forceinline__ T ld8(const bf16* p) { return *reinterpret_cast<const bf16x8*>(p); }
  __device__ static __forceinline__ bf16x8 tobf(T x) { return x; } };
template <> struct Stage<float> { using T = f32x8;
  __device__ static __forceinline__ T ld8(const float* p) { return *reinterpret_cast<const f32x8*>(p); }
  __device__ static __forceinline__ bf16x8 tobf(T x) {
    u32x4 w = {cvtpk(x[0], x[1]), cvtpk(x[2], x[3]), cvtpk(x[4], x[5]), cvtpk(x[6], x[7])}; return *reinterpret_cast<bf16x8*>(&w); } };

__device__ __forceinline__ void partialSM(f32x16& p0, f32x16& p1, float& m_reg, float& mn, float& alpha) {
  constexpr float C = SCALE * 1.4426950408889634f;
  float pmax = p0[0]; for (int r = 1; r < 16; ++r) pmax = fmaxf(pmax, p0[r]); for (int r = 0; r < 16; ++r) pmax = fmaxf(pmax, p1[r]);
  { auto rr = __builtin_amdgcn_permlane32_swap(__float_as_uint(pmax), __float_as_uint(pmax), false, false);
    pmax = fmaxf(__uint_as_float(rr[0]), __uint_as_float(rr[1])); }
  if (__builtin_expect(__all(pmax - m_reg <= THR / SCALE), 1)) { mn = m_reg; alpha = 1.f; }
  else { mn = fmaxf(m_reg, pmax); alpha = __builtin_amdgcn_exp2f((m_reg - mn) * C); m_reg = mn; }
  float mnC = -mn * C;
  for (int r = 0; r < 16; ++r) p0[r] = fmaf(p0[r], C, mnC); for (int r = 0; r < 16; ++r) p1[r] = fmaf(p1[r], C, mnC);
  for (int r = 0; r < 16; ++r) p0[r] = __builtin_amdgcn_exp2f(p0[r]);
}
__device__ __forceinline__ void finishSM(f32x16& p0, f32x16& p1, float alpha, float& l_reg, bf16x8& pa0, bf16x8& pa1, bf16x8& pa2, bf16x8& pa3) {
  for (int r = 0; r < 16; ++r) p1[r] = __builtin_amdgcn_exp2f(p1[r]);
  float ps = 0; for (int r = 0; r < 16; ++r) ps += p0[r]; for (int r = 0; r < 16; ++r) ps += p1[r];
  { auto rr = __builtin_amdgcn_permlane32_swap(__float_as_uint(ps), __float_as_uint(ps), false, false);
    ps = __uint_as_float(rr[0]) + __uint_as_float(rr[1]); }
  l_reg = l_reg * alpha + ps;
#define PK4(P, BASE, OUT) do { unsigned a0 = cvtpk(P[BASE + 0], P[BASE + 1]), a1 = cvtpk(P[BASE + 2], P[BASE + 3]);   \
    unsigned b0 = cvtpk(P[BASE + 4], P[BASE + 5]), b1 = cvtpk(P[BASE + 6], P[BASE + 7]);                              \
    auto r0 = __builtin_amdgcn_permlane32_swap(a0, b0, false, false); auto r1 = __builtin_amdgcn_permlane32_swap(a1, b1, false, false); \
    u32x4 w = {r0[0], r1[0], r0[1], r1[1]}; OUT = *reinterpret_cast<bf16x8*>(&w); } while (0)
  PK4(p0, 0, pa0); PK4(p0, 8, pa1); PK4(p1, 0, pa2); PK4(p1, 8, pa3);
#undef PK4
}
__device__ __forceinline__ void qkt(f32x16& p0, f32x16& p1, const bf16* Ks, const bf16x8* qr, int r32, int hi) {
  p0 = f32x16{}; p1 = f32x16{};
  for (int d0 = 0; d0 < 8; ++d0) { int cb = (d0 * 16 + hi * 8) * 2;
    bf16x8 b0 = *reinterpret_cast<const bf16x8*>((const char*)Ks + KSWZ(r32, cb));
    bf16x8 b1 = *reinterpret_cast<const bf16x8*>((const char*)Ks + KSWZ(32 + r32, cb));
    p0 = __builtin_amdgcn_mfma_f32_32x32x16_bf16(b0, qr[d0], p0, 0, 0, 0);
    p1 = __builtin_amdgcn_mfma_f32_32x32x16_bf16(b1, qr[d0], p1, 0, 0, 0); }
}
__device__ __forceinline__ int v_st(int k, int c) { const int kk = (k & ~0xC) | ((k & 4) << 1) | ((k & 8) >> 1); return ((kk >> 3) * 4 + (c >> 5)) * 512 + ((kk & 7) * 32 + (c & 31)) * 2; }
__device__ __forceinline__ int v_rd_base(int lane) { return ((lane & 3) << 3) | (((lane >> 2) & 3) << 6) | (((lane >> 4) & 1) << 5) | (((lane >> 5) & 1) << 8); }
constexpr int v_rd_off(int d0, int ks, int half) { return d0 * 512 + ks * 4096 + half * 2048; }
template <int OFF> __device__ __forceinline__ s16x4 tr_read(int vb) {
  s16x4 r; asm volatile("ds_read_b64_tr_b16 %0, %1 offset:%2" : "=&v"(r) : "v"(vb), "i"(OFF) : "memory"); return r;
}
template <int D0> __device__ __forceinline__ void pv_one(f32x16& od, int vb, bf16x8 pa0, bf16x8 pa1, bf16x8 pa2, bf16x8 pa3) {
  const s16x4 l0 = tr_read<v_rd_off(D0, 0, 0)>(vb), h0 = tr_read<v_rd_off(D0, 0, 1)>(vb), l1 = tr_read<v_rd_off(D0, 1, 0)>(vb), h1 = tr_read<v_rd_off(D0, 1, 1)>(vb);
  const s16x4 l2 = tr_read<v_rd_off(D0, 2, 0)>(vb), h2 = tr_read<v_rd_off(D0, 2, 1)>(vb), l3 = tr_read<v_rd_off(D0, 3, 0)>(vb), h3 = tr_read<v_rd_off(D0, 3, 1)>(vb);
  asm volatile("s_waitcnt lgkmcnt(0)" ::: "memory"); SBAR();
#define PK(L, H) (bf16x8){L[0], L[1], L[2], L[3], H[0], H[1], H[2], H[3]}
  od = __builtin_amdgcn_mfma_f32_32x32x16_bf16(pa0, PK(l0, h0), od, 0, 0, 0);
  od = __builtin_amdgcn_mfma_f32_32x32x16_bf16(pa1, PK(l1, h1), od, 0, 0, 0);
  od = __builtin_amdgcn_mfma_f32_32x32x16_bf16(pa2, PK(l2, h2), od, 0, 0, 0);
  od = __builtin_amdgcn_mfma_f32_32x32x16_bf16(pa3, PK(l3, h3), od, 0, 0, 0);
#undef PK
}
__device__ __forceinline__ void pv_d0(f32x16* o, int vb, bf16x8 pa0, bf16x8 pa1, bf16x8 pa2, bf16x8 pa3) {
  pv_one<0>(o[0], vb, pa0, pa1, pa2, pa3); pv_one<1>(o[1], vb, pa0, pa1, pa2, pa3); pv_one<2>(o[2], vb, pa0, pa1, pa2, pa3); pv_one<3>(o[3], vb, pa0, pa1, pa2, pa3);
}

template <typename TQ>
__device__ __forceinline__ void attn_dense_body(const TQ* __restrict__ Qb, const bf16* __restrict__ Kh, const bf16* __restrict__ Vh,
                                                bf16* __restrict__ Ob, int seq, char* lds) {
  using St = Stage<bf16>; using SQ = Stage<TQ>;
  const int tid = opaque_tid(), wid = tid >> 6, lane = tid & 63, r32 = lane & 31, hi = lane >> 5;
  bf16* V_lds = (bf16*)lds; bf16* K_lds = (bf16*)(lds + 2 * SHM_V);
  float* ws = (float*)(lds + 2 * SHM_V + 2 * SHM_K) + wid * 64; float* li_l = ws; float* al_l = ws + 32;
  float m_reg = -1e30f, l_reg = 0; f32x16 o[4] = {}; bf16x8 qr[8];
  const TQ* Qw = Qb + (long)(wid * QBLK + r32) * LDQ + hi * 8;
#pragma unroll
  for (int d0 = 0; d0 < 8; ++d0) qr[d0] = SQ::tobf(SQ::ld8(Qw + d0 * 16));
  const int sr = tid >> 4, sc = (tid & 15) * 8, vst0 = v_st(sr, sc), vst1 = v_st(32 + sr, sc);
  const int vb0 = (int)(uintptr_t)V_lds + v_rd_base(lane);
  struct { typename St::T vs0, vs1, ks0, ks1; } sr_[SDEPTH];
#define SLOAD(i, k0) do { sr_[i].vs0 = St::ld8(&Vh[(long)((k0) + sr) * LDK + sc]); sr_[i].vs1 = St::ld8(&Vh[(long)((k0) + 32 + sr) * LDK + sc]); \
    sr_[i].ks0 = St::ld8(&Kh[(long)((k0) + sr) * LDK + sc]); sr_[i].ks1 = St::ld8(&Kh[(long)((k0) + 32 + sr) * LDK + sc]); } while (0)
#define SWRITE(b, i) do { *(bf16x8*)((char*)V_lds + (b) * SHM_V + vst0) = St::tobf(sr_[i].vs0);          \
    *(bf16x8*)((char*)V_lds + (b) * SHM_V + vst1) = St::tobf(sr_[i].vs1); int kc = sc * 2;               \
    *(bf16x8*)((char*)K_lds + (b) * SHM_K + KSWZ(sr, kc)) = St::tobf(sr_[i].ks0);                       \
    *(bf16x8*)((char*)K_lds + (b) * SHM_K + KSWZ(32 + sr, kc)) = St::tobf(sr_[i].ks1); } while (0)
#define SWAIT() do { if constexpr (SDEPTH == 2) asm volatile("s_waitcnt vmcnt(4)" ::: "memory"); else asm volatile("s_waitcnt vmcnt(0)" ::: "memory"); } while (0)
#define RESC(a) do { if (__any((a) < 1.f)) { if (hi == 0) al_l[r32] = (a); asm volatile("s_waitcnt lgkmcnt(0)" ::: "memory"); \
    for (int d = 0; d < 4; ++d) for (int r = 0; r < 16; ++r) o[d][r] *= al_l[crow(r, hi)]; } } while (0)
  f32x16 pA0, pA1, pB0, pB1; float mnA, mnB, alA, alB; bf16x8 pa0, pa1, pa2, pa3; const int NT = seq / KVBLK;
  constexpr int SE = 0, SO = SDEPTH - 1;
  SLOAD(SE, 0); asm volatile("s_waitcnt vmcnt(0)" ::: "memory"); SWRITE(0, SE); __syncthreads();
  qkt(pA0, pA1, K_lds, qr, r32, hi); partialSM(pA0, pA1, m_reg, mnA, alA);
  SLOAD(SO, KVBLK); if constexpr (SDEPTH == 2) { if (2 < NT) SLOAD(SE, 2 * KVBLK); }
  SWAIT(); SWRITE(1, SO); __syncthreads();
  for (int j = 1; j + 1 < NT; j += 2) {
    SBAR(); qkt(pB0, pB1, (bf16*)((char*)K_lds + SHM_K), qr, r32, hi);
    finishSM(pA0, pA1, alA, l_reg, pa0, pa1, pa2, pa3); SBAR();
    SLOAD(SO, (j + SDEPTH) * KVBLK); SBAR();
    pv_d0(o, vb0, pa0, pa1, pa2, pa3); partialSM(pB0, pB1, m_reg, mnB, alB);
    __syncthreads(); SWAIT(); SWRITE(0, SE);
    RESC(alB); __syncthreads();
    SBAR(); qkt(pA0, pA1, K_lds, qr, r32, hi);
    finishSM(pB0, pB1, alB, l_reg, pa0, pa1, pa2, pa3); SBAR();
    if (SDEPTH == 1 || j + 3 < NT) SLOAD(SE, (j + 1 + SDEPTH) * KVBLK); SBAR();
    pv_d0(o, vb0 + (int)SHM_V, pa0, pa1, pa2, pa3); partialSM(pA0, pA1, m_reg, mnA, alA);
    __syncthreads(); SWAIT(); SWRITE(1, SO);
    RESC(alA); __syncthreads();
  }
  SBAR(); qkt(pB0, pB1, (bf16*)((char*)K_lds + SHM_K), qr, r32, hi);
  finishSM(pA0, pA1, alA, l_reg, pa0, pa1, pa2, pa3); SBAR();
  pv_d0(o, vb0, pa0, pa1, pa2, pa3); partialSM(pB0, pB1, m_reg, mnB, alB);
  __syncthreads(); RESC(alB);
  finishSM(pB0, pB1, alB, l_reg, pa0, pa1, pa2, pa3); SBAR();
  pv_d0(o, vb0 + (int)SHM_V, pa0, pa1, pa2, pa3);
  if (hi == 0) li_l[r32] = l_reg; asm volatile("s_waitcnt lgkmcnt(0)" ::: "memory");
  float rli[16];
#pragma unroll
  for (int r = 0; r < 16; ++r) rli[r] = __builtin_amdgcn_rcpf(li_l[crow(r, hi)]);
  bf16* Ow = Ob + (long)(wid * QBLK) * LDO;
#pragma unroll
  for (int r = 0; r < 16; ++r) { int orow = crow(r, hi);
    for (int d0 = 0; d0 < 4; ++d0) Ow[(long)orow * LDO + d0 * 32 + r32] = __float2bfloat16(o[d0][r] * rli[r]); }
#undef SLOAD
#undef SWRITE
#undef SWAIT
#undef RESC
}

}
#define LAS __attribute__((address_space(3)))
typedef unsigned short bf16_t;
typedef short bf16x8 __attribute__((ext_vector_type(8)));
typedef short s16x4 __attribute__((ext_vector_type(4)));
typedef float f32x4 __attribute__((ext_vector_type(4)));
typedef float f32x16 __attribute__((ext_vector_type(16)));
typedef unsigned u32x4 __attribute__((ext_vector_type(4)));
typedef unsigned u32x2 __attribute__((ext_vector_type(2)));
using pg8::cvtpk_s; using pg8::bf_lo; using pg8::bf_hi; using pg8::silu_f;

constexpr int DM = 1024, SEQ = 16384, CTXL = 256, NLAT = 2 * SEQ, MROWS = NLAT + 2 * CTXL, DFF = 4096;
constexpr float EPS = 1e-6f;
constexpr size_t MiB = 1u << 20;
constexpr size_t WS_MOD = 0, WS_CTX = 1 * MiB, WS_WT = 4 * MiB, WS_H = 41 * MiB, WS_AB = 106 * MiB, WS_RSTD = 115 * MiB, WS_P = 118 * MiB, WS_O = 378 * MiB, WS_END = 508 * MiB;
constexpr size_t WT_A = WS_WT, WT_Z = WS_WT + 9 * MiB, WT_O = WS_WT + 13 * MiB, WT_1 = WS_WT + 17 * MiB, WT_2 = WS_WT + 25 * MiB;
constexpr size_t WS_QM = 313 * MiB, WS_KM = 378 * MiB, WS_OGLA = 443 * MiB, WS_AQ = 41 * MiB, WS_EL = 74 * MiB;
constexpr size_t WS_TP = 4 * MiB, WS_HALO = 378 * MiB;
constexpr size_t WS_QR = 216 * MiB, WS_KR = 281 * MiB, WS_VR = 298 * MiB;
constexpr int SKV = SEQ + CTXL;
constexpr int LDS_BYTES = 155648;
enum { OP_MOD, OP_PREP, OP_GEMM_IN, OP_DNSCAN, OP_DNREDO, OP_GEMM_Z, OP_GEMM_OUT, OP_NORM2, OP_FFN1, OP_FFN2, OP_GLAPREP, OP_GLASCAN, OP_GLAGATE, OP_QKROPE, OP_ATTN, OP_DNHALO, OP_DNCONV, OP_DNT };

struct Args { const float* in[25]; float* out; unsigned char* ws; int ph_lo, ph_hi; };

__device__ __forceinline__ float wave_sum(float v) {
#pragma unroll
    for (int o = 1; o < 64; o <<= 1) v += __shfl_xor(v, o);
    return v;
}
__device__ __forceinline__ float softplus_f(float x) { return x > 20.f ? x : log1pf(__expf(x)); }
__device__ __forceinline__ float logsigmoid_f(float x) { return fminf(x, 0.f) - log1pf(__expf(-fabsf(x))); }
__device__ __forceinline__ bf16_t f2bf(float f) { return (bf16_t)(cvtpk_s(f, 0.f) & 0xffffu); }
__device__ __forceinline__ float bf2f(bf16_t v) { return __builtin_bit_cast(float, (unsigned)v << 16); }

__device__ __forceinline__ void transpose_item(const float* W, int ldw, int c0, int ncols, int K, bf16_t* WT, int row_off, LAS float* scr, int item, int lane) {
    const int nblk = ncols / 32, kb = item / nblk, nb = item % nblk, k0 = 64 * kb, n0 = 32 * nb;
#pragma unroll 8
    for (int i = 0; i < 32; ++i) { const int kk = 2 * i + (lane >> 5); scr[kk * 33 + (lane & 31)] = W[(size_t)(k0 + kk) * ldw + c0 + n0 + (lane & 31)]; }
    asm volatile("s_waitcnt lgkmcnt(0)" ::: "memory");
    const int c = lane & 7;
#pragma unroll
    for (int j = 0; j < 4; ++j) { const int n = (lane >> 3) + 8 * j; const LAS float* s = scr + (8 * c) * 33 + n;
        u32x4 o; o.x = cvtpk_s(s[0 * 33], s[1 * 33]); o.y = cvtpk_s(s[2 * 33], s[3 * 33]); o.z = cvtpk_s(s[4 * 33], s[5 * 33]); o.w = cvtpk_s(s[6 * 33], s[7 * 33]);
        *(u32x4*)(WT + (size_t)(row_off + n0 + n) * K + k0 + 8 * c) = o; }
    asm volatile("s_waitcnt lgkmcnt(0)" ::: "memory");
}
__device__ __forceinline__ void transpose_mat(const float* W, int ldw, int c0, int ncols, int K, bf16_t* WT, int row_off, LAS float* scr, int gw, int NGW, int lane) {
    const int nitems = (K / 64) * (ncols / 32);
    for (int it = gw; it < nitems; it += NGW) transpose_item(W, ldw, c0, ncols, K, WT, row_off, scr, it, lane);
}
__device__ __forceinline__ void normmod_rows(const float* xl, const float* xc, const float* g, const float* modl, int sidx, bf16_t* H, int gw, int NGW, int lane) {
    for (int row = gw; row < MROWS; row += NGW) {
        const float* xr = row < NLAT ? xl + (size_t)row * DM : xc + (size_t)(row - NLAT) * DM;
        const int mi = row < SEQ ? 0 : (row < NLAT ? 1 : 2);
        const float* sh = modl + (size_t)mi * 6144 + (size_t)sidx * 1024; const float* sc = sh + 1024;
        f32x4 v[4]; float ss = 0.f;
#pragma unroll
        for (int j = 0; j < 4; ++j) { v[j] = *(const f32x4*)(xr + 4 * lane + 256 * j); ss += (v[j][0] * v[j][0] + v[j][1] * v[j][1]) + (v[j][2] * v[j][2] + v[j][3] * v[j][3]); }
        const float rinv = rsqrtf(wave_sum(ss) * (1.f / DM) + EPS);
#pragma unroll
        for (int j = 0; j < 4; ++j) { const int c = 4 * lane + 256 * j; const f32x4 gg = *(const f32x4*)(g + c), s1 = *(const f32x4*)(sc + c), s0 = *(const f32x4*)(sh + c);
            f32x4 y;
#pragma unroll
            for (int e = 0; e < 4; ++e) y[e] = v[j][e] * rinv * gg[e] * (1.f + s1[e]) + s0[e];
            u32x2 w; w.x = cvtpk_s(y[0], y[1]); w.y = cvtpk_s(y[2], y[3]); *(u32x2*)(H + (size_t)row * DM + c) = w; }
    }
}
__device__ __forceinline__ int crow(int x, int h) { return (x & 3) + 8 * (x >> 2) + 4 * h; }
#define MFMA32(a, b, c) __builtin_amdgcn_mfma_f32_32x32x16_bf16((a), (b), (c), 0, 0, 0)
__device__ __forceinline__ bf16x8 frag_nat(const LAS bf16_t* img, int LD, int row, int ks, int h) { return *(const LAS bf16x8*)(img + row * LD + 16 * ks + 8 * h); }
__device__ __forceinline__ bf16x8 frag_perm(const LAS bf16_t* img, int LD, int row, int ks, int h) {
    const s16x4 lo = *(const LAS s16x4*)(img + row * LD + 16 * ks + 4 * h), hi = *(const LAS s16x4*)(img + row * LD + 16 * ks + 8 + 4 * h);
    return __builtin_shufflevector(lo, hi, 0, 1, 2, 3, 4, 5, 6, 7);
}
__device__ __forceinline__ s16x4 tr4(const LAS bf16_t* p) { return __builtin_bit_cast(s16x4, __builtin_amdgcn_ds_read_tr16_b64_v4i16((LAS s16x4*)p)); }
__device__ __forceinline__ bf16x8 frag_tr(const LAS bf16_t* img, int LD, int m0, int ks, int lane) {
    const int i16 = lane & 15, q = i16 >> 2, p = i16 & 3, blk = (lane >> 4) & 1, h = lane >> 5;
    const LAS bf16_t* a = img + (16 * ks + 4 * h + q) * LD + m0 + 16 * blk + 4 * p;
    const s16x4 lo = tr4(a), hi = tr4(a + 8 * LD);
    return __builtin_shufflevector(lo, hi, 0, 1, 2, 3, 4, 5, 6, 7);
}
__device__ __forceinline__ bf16x8 pack_step(const f32x16& x, int s) {
    u32x4 p; p.x = cvtpk_s(x[8 * s + 0], x[8 * s + 1]); p.y = cvtpk_s(x[8 * s + 2], x[8 * s + 3]); p.z = cvtpk_s(x[8 * s + 4], x[8 * s + 5]); p.w = cvtpk_s(x[8 * s + 6], x[8 * s + 7]);
    return __builtin_bit_cast(bf16x8, p);
}
__device__ __forceinline__ void dn_halo_phase(const bf16_t* P, bf16_t* HALO, int G) {
    const int tid = opaque_tid();
    for (size_t e = (size_t)blockIdx.x * 512 + tid; e < (size_t)520 * 4 * 512; e += (size_t)G * 512) {
        const int c = (int)(e & 511), j = (int)((e >> 9) & 3), rb = (int)(e >> 11);
        const int row = rb * 64 + (j < 2 ? j : 60 + j);
        ((u32x4*)(HALO + ((size_t)rb * 4 + j) * 4096))[c] = ((const u32x4*)(P + (size_t)row * 4096))[c];
    }
}
__device__ __forceinline__ void unpack8(const u32x4 v, float (&f)[8]) { f[0] = bf_lo(v.x); f[1] = bf_hi(v.x); f[2] = bf_lo(v.y); f[3] = bf_hi(v.y); f[4] = bf_lo(v.z); f[5] = bf_hi(v.z); f[6] = bf_lo(v.w); f[7] = bf_hi(v.w); }
__device__ __forceinline__ void dn_conv_phase(bf16_t* P, const bf16_t* HALO, const float* conv_w, int G) {
    const int tid = opaque_tid(), col0 = 8 * tid;
    float cw[8][5];
#pragma unroll
    for (int c = 0; c < 8; ++c)
#pragma unroll
        for (int tap = 0; tap < 5; ++tap) cw[c][tap] = conv_w[(size_t)(col0 + c) * 5 + tap];
    const int kind = col0 < 1024 ? 0 : (col0 < 2048 ? 1 : 2);
    for (int rb = blockIdx.x; rb < 520; rb += G) {
        const int cs = rb < 512 ? (rb & 255) : ((rb - 512) & 3); const bool sfirst = cs == 0, slast = rb < 512 ? cs == 255 : cs == 3;
        const u32x4 zero = (u32x4){0u, 0u, 0u, 0u};
        bf16_t* base = P + (size_t)rb * 64 * 4096 + col0;
        u32x4 w0 = sfirst ? zero : *(const u32x4*)(HALO + ((size_t)(rb - 1) * 4 + 2) * 4096 + col0);
        u32x4 w1 = sfirst ? zero : *(const u32x4*)(HALO + ((size_t)(rb - 1) * 4 + 3) * 4096 + col0);
        u32x4 w2 = *(const u32x4*)(base), w3 = *(const u32x4*)(base + 4096);
#pragma unroll 4
        for (int rr = 0; rr < 64; ++rr) {
            u32x4 w4;
            if (rr + 2 < 64) w4 = *(const u32x4*)(base + (size_t)(rr + 2) * 4096);
            else w4 = slast ? zero : *(const u32x4*)(HALO + ((size_t)(rb + 1) * 4 + (rr + 2 - 64)) * 4096 + col0);
            float x0[8], x1[8], x2[8], x3[8], x4[8], y[8];
            unpack8(w0, x0); unpack8(w1, x1); unpack8(w2, x2); unpack8(w3, x3); unpack8(w4, x4);
            float ss = 0.f;
#pragma unroll
            for (int c = 0; c < 8; ++c) { const float a = x0[c] * cw[c][0] + x1[c] * cw[c][1] + x2[c] * cw[c][2] + x3[c] * cw[c][3] + x4[c] * cw[c][4]; y[c] = silu_f(a); ss += y[c] * y[c]; }
            float sc = 1.f;
            if (kind < 2) { ss += __shfl_xor(ss, 1); ss += __shfl_xor(ss, 2); ss += __shfl_xor(ss, 4); ss += __shfl_xor(ss, 8); sc = rsqrtf(ss + EPS) * (kind == 0 ? 0.08838834764831845f : 1.f); }
            u32x4 o; o.x = cvtpk_s(y[0] * sc, y[1] * sc); o.y = cvtpk_s(y[2] * sc, y[3] * sc); o.z = cvtpk_s(y[4] * sc, y[5] * sc); o.w = cvtpk_s(y[6] * sc, y[7] * sc);
            *(u32x4*)(base + (size_t)rr * 4096) = o;
            w0 = w1; w1 = w2; w2 = w3; w3 = w4;
        }
    }
}
constexpr int DT_KB = 0, DT_R = 17408, DT_SC = 33792, DT_DIR = 34816;
template <int W> __device__ __forceinline__ void dn_solve(const LAS float* Mf, float (&t)[16], int lane) {
    const int j = 16 * W + (lane >> 2), q = lane & 3;
#pragma unroll
    for (int s = 0; s < 16; ++s) t[s] = 0.f;
#pragma unroll
    for (int i = 16 * W; i < 64; ++i) {
        float acc = 0.f;
#pragma unroll
        for (int s = 4 * W; s <= (i - 1) / 4 && i > 16 * W; ++s) acc += Mf[i * 64 + 4 * s + q] * t[s];
        acc += __shfl_xor(acc, 1); acc += __shfl_xor(acc, 2);
        const float val = (i == j ? 1.f : 0.f) - acc;
        if (q == (i & 3)) t[i >> 2] = val;
        asm volatile("" : "+v"(t[0]), "+v"(t[1]), "+v"(t[2]), "+v"(t[3]), "+v"(t[4]), "+v"(t[5]), "+v"(t[6]), "+v"(t[7]), "+v"(t[8]), "+v"(t[9]), "+v"(t[10]), "+v"(t[11]), "+v"(t[12]), "+v"(t[13]), "+v"(t[14]), "+v"(t[15]));
    }
}
__device__ __forceinline__ void dn_t_phase(LAS unsigned char* lds, const bf16_t* P, float* AB, bf16_t* TP, const float* a_log, const float* dt_bias, int G) {
    const int tid0 = opaque_tid(), hb = __builtin_amdgcn_readfirstlane(tid0 >> 8);
    for (int itb = blockIdx.x * 2; itb < 16640; itb += 2 * G) {
        const int it = itb + hb, dir = it & 1, vh = (it >> 1) & 15, rb = it >> 5, kh = vh >> 1;
        const int tq = opaque_tid(), t = tq & 255, w = __builtin_amdgcn_readfirstlane((tq >> 6) & 3), lane = tq & 63, r = lane & 31, h = lane >> 5;
        LAS unsigned char* base = lds + hb * DT_DIR;
        LAS bf16_t* Kb = (LAS bf16_t*)(base + DT_KB); LAS float* Mf = (LAS float*)(base + DT_R); LAS bf16_t* Tb = (LAS bf16_t*)(base + DT_R);
        LAS float* sc_beta = (LAS float*)(base + DT_SC); LAS float* sc_gc = sc_beta + 64;
        {
            const int i = t >> 2, ch0 = 32 * (t & 3), ip = dir ? 63 - i : i;
            const u32x4* src = (const u32x4*)(P + (size_t)(rb * 64 + i) * 4096 + 1024 + kh * 128 + ch0);
#pragma unroll
            for (int v = 0; v < 4; ++v) *(LAS u32x4*)(Kb + ip * 136 + ch0 + 8 * v) = src[v];
            if (t < 64) {
                const int ti = dir ? 63 - t : t; float* ab = AB + (size_t)(rb * 64 + ti) * 64;
                const float av = ab[dir * 16 + vh], bv = ab[32 + dir * 16 + vh];
                const float g = -__expf(a_log[dir * 16 + vh]) * softplus_f(av + dt_bias[dir * 16 + vh]), beta = 1.f / (1.f + __expf(-bv));
                float gc = g;
#pragma unroll
                for (int o = 1; o < 64; o <<= 1) { const float up = __shfl_up(gc, o); if (t >= o) gc += up; }
                sc_beta[t] = beta; sc_gc[t] = gc;
                ab[dir * 16 + vh] = gc; ab[32 + dir * 16 + vh] = beta;
            }
        }
        __syncthreads();
        const int ti = w >> 1, tj = w & 1;
        {
            f32x16 acc;
#pragma unroll
            for (int x = 0; x < 16; ++x) acc[x] = 0.f;
            if (!(ti == 0 && tj == 1)) {
#pragma unroll
                for (int ks = 0; ks < 8; ++ks) acc = MFMA32(frag_nat(Kb, 136, 32 * ti + r, ks, h), frag_nat(Kb, 136, 32 * tj + r, ks, h), acc);
            }
            const int j = 32 * tj + r; const float gj = sc_gc[j];
#pragma unroll
            for (int x = 0; x < 16; ++x) { const int i = 32 * ti + crow(x, h);
                Mf[i * 64 + j] = (i > j) ? sc_beta[i] * acc[x] * __expf(sc_gc[i] - gj) : 0.f; }
        }
        __syncthreads();
        float tc[16];
        if (w == 0) dn_solve<0>(Mf, tc, lane); else if (w == 1) dn_solve<1>(Mf, tc, lane); else if (w == 2) dn_solve<2>(Mf, tc, lane); else dn_solve<3>(Mf, tc, lane);
        __syncthreads();
        {
            const int j = 16 * w + (lane >> 2), q = lane & 3;
#pragma unroll
            for (int s = 0; s < 16; ++s) Tb[(4 * s + q) * 72 + j] = f2bf(tc[s]);
        }
        __syncthreads();
        {
            bf16_t* dst = TP + (size_t)it * 3072;
#pragma unroll
            for (int k2 = 0; k2 < 2; ++k2) { const int c = t + 256 * k2;
                if (c < 384) { const int blk = c >> 7, rowc = (c & 127) >> 2, cc = c & 3, br = blk ? 1 : 0, bc = blk == 2 ? 1 : 0;
                    *(u32x4*)(dst + c * 8) = *(const LAS u32x4*)(Tb + (32 * br + rowc) * 72 + 32 * bc + 8 * cc); } }
        }
        __syncthreads();
    }
}
constexpr int DN_KB = 0, DN_QB = 17408, DN_VB = 34816, DN_TB = 51200, DN_AB = 60416, DN_SC = 69632, DN_DIR = 71168;
__device__ __forceinline__ void dn_step_rb(int step, int dir, int b, int& rb, bool& first) {
    if (step < 4) { const int cidx = dir ? 3 - step : step; rb = 512 + b * 4 + cidx; first = step < 2; }
    else { const int c = step - 4; const int cidx = dir ? 255 - c : c; rb = b * 256 + cidx; first = c < 128; }
}
struct DnPre { u32x4 k4[4], q4[4], v4[4], t0, t1; float gc, beta; };
__device__ __forceinline__ void dn_prefetch(DnPre& p, const bf16_t* P, const float* AB, const bf16_t* TP, int rb, int dir, int vh, int kh, int t, int part) {
    const int i = t >> 2, ch0 = 32 * (t & 3);
    const bf16_t* prow = P + (size_t)(rb * 64 + i) * 4096;
    const u32x4* sk = (const u32x4*)(prow + 1024 + kh * 128 + ch0); const u32x4* sq = (const u32x4*)(prow + kh * 128 + ch0); const u32x4* sv = (const u32x4*)(prow + 2048 + vh * 128 + ch0);
    const bf16_t* tp = TP + (size_t)((rb * 16 + vh) * 2 + dir) * 3072;
    if (part & 1) {
#pragma unroll
        for (int v = 0; v < 4; ++v) { p.k4[v] = sk[v]; p.q4[v] = sq[v]; p.v4[v] = sv[v]; }
    }
    if (part & 2) {
        p.t0 = *(const u32x4*)(tp + t * 8); p.t1 = *(const u32x4*)(tp + (256 + (t & 127)) * 8);
        const int ti = dir ? 63 - (t & 63) : (t & 63); const float* ab = AB + (size_t)(rb * 64 + ti) * 64; p.gc = ab[dir * 16 + vh]; p.beta = ab[32 + dir * 16 + vh];
    }
}
__device__ __forceinline__ void dn_scan(LAS unsigned char* lds, const bf16_t* P, const float* AB, const bf16_t* TP, bf16_t* OB) {
    const int tid = opaque_tid(), dir = __builtin_amdgcn_readfirstlane(tid >> 8);
    for (int unit = blockIdx.x; unit < 32; unit += gridDim.x) {
        const int b = unit >> 4, vh = unit & 15, kh = vh >> 1;
        f32x16 S[4];
#pragma unroll
        for (int kt = 0; kt < 4; ++kt)
#pragma unroll
            for (int x = 0; x < 16; ++x) S[kt][x] = 0.f;
        DnPre pre;
        { int rb0; bool f0; dn_step_rb(0, dir, b, rb0, f0); dn_prefetch(pre, P, AB, TP, rb0, dir, vh, kh, tid & 255, 3); }
        __syncthreads();
        for (int step = 0; step < 260; ++step) {
            const int w = __builtin_amdgcn_readfirstlane((opaque_tid() >> 6) & 3);
            LAS unsigned char* base = lds + dir * DN_DIR;
            LAS bf16_t* Kb = (LAS bf16_t*)(base + DN_KB); LAS bf16_t* Qb = (LAS bf16_t*)(base + DN_QB); LAS bf16_t* Vb = (LAS bf16_t*)(base + DN_VB);
            LAS bf16_t* Tb = (LAS bf16_t*)(base + DN_TB); LAS bf16_t* Ab = (LAS bf16_t*)(base + DN_AB);
            LAS float* sc_beta = (LAS float*)(base + DN_SC); LAS float* sc_gc = sc_beta + 64; LAS float* sc_eg = sc_beta + 128; LAS float* sc_tail = sc_beta + 192; LAS float* sc_dl = sc_beta + 256;
            int rb; bool first; dn_step_rb(step, dir, b, rb, first);
            const int row_base = rb * 64;
            {
                const int tq_ = opaque_tid(), t = tq_ & 255;
                const int i = t >> 2, ch0 = 32 * (t & 3), ip = dir ? 63 - i : i;
#pragma unroll
                for (int v = 0; v < 4; ++v) { *(LAS u32x4*)(Kb + ip * 136 + ch0 + 8 * v) = pre.k4[v]; *(LAS u32x4*)(Qb + ip * 136 + ch0 + 8 * v) = pre.q4[v]; *(LAS u32x4*)(Vb + ip * 128 + ch0 + 8 * v) = pre.v4[v]; }
                { const int c = t, blk = c >> 7, rowc = (c & 127) >> 2, cc = c & 3, br = blk ? 1 : 0; *(LAS u32x4*)(Tb + (32 * br + rowc) * 72 + 8 * cc) = pre.t0; }
                if (t < 128) { const int rowc = t >> 2, cc = t & 3; *(LAS u32x4*)(Tb + (32 + rowc) * 72 + 32 + 8 * cc) = pre.t1; }
                if (t < 64) { const float gc = pre.gc, gl = __shfl(gc, 63); sc_beta[t] = pre.beta; sc_gc[t] = gc; sc_eg[t] = __expf(gc); sc_tail[t] = __expf(gl - gc); if (t == 0) sc_dl[0] = __expf(gl); }
            }
            __syncthreads();
            {
                const int tq_ = opaque_tid(), lane = tq_ & 63, r = lane & 31, h = lane >> 5;
                const int ti = w >> 1, tj = w & 1;
                if (!(ti == 0 && tj == 1)) {
                    f32x16 qk;
#pragma unroll
                    for (int x = 0; x < 16; ++x) qk[x] = 0.f;
#pragma unroll
                    for (int ks = 0; ks < 8; ++ks) qk = MFMA32(frag_nat(Qb, 136, 32 * ti + r, ks, h), frag_nat(Kb, 136, 32 * tj + r, ks, h), qk);
                    const int jj = 32 * tj + r; const float gj = sc_gc[jj];
#pragma unroll
                    for (int x = 0; x < 16; ++x) { const int i = 32 * ti + crow(x, h);
                        Ab[i * 72 + jj] = f2bf((i >= jj) ? qk[x] * __expf(sc_gc[i] - gj) : 0.f); }
                }
            }
            __syncthreads();
            if (step + 1 < 260) { int rbn; bool fn; dn_step_rb(step + 1, dir, b, rbn, fn); dn_prefetch(pre, P, AB, TP, rbn, dir, vh, kh, opaque_tid() & 255, 1); }
            __builtin_amdgcn_sched_barrier(0);
            {
                const int tq_ = opaque_tid(), lane = tq_ & 63, r = lane & 31, h = lane >> 5;
                f32x16 KS[2], QS[2];
#pragma unroll
                for (int mt = 0; mt < 2; ++mt)
#pragma unroll
                    for (int x = 0; x < 16; ++x) { KS[mt][x] = 0.f; QS[mt][x] = 0.f; }
#pragma unroll
                for (int ks = 0; ks < 8; ++ks) {
                    const bf16x8 sp = pack_step(S[ks >> 1], ks & 1);
#pragma unroll
                    for (int mt = 0; mt < 2; ++mt) { KS[mt] = MFMA32(frag_perm(Kb, 136, 32 * mt + r, ks, h), sp, KS[mt]); QS[mt] = MFMA32(frag_perm(Qb, 136, 32 * mt + r, ks, h), sp, QS[mt]); }
                    if (ks & 1) __builtin_amdgcn_sched_barrier(0);
                }
#pragma unroll
                for (int mt = 0; mt < 2; ++mt)
#pragma unroll
                    for (int x = 0; x < 16; ++x) { const int i = 32 * mt + crow(x, h);
                        KS[mt][x] = sc_beta[i] * (bf2f(Vb[i * 128 + 32 * w + r]) - sc_eg[i] * KS[mt][x]); }
                __builtin_amdgcn_sched_barrier(0);
                bf16x8 Xp[4];
#pragma unroll
                for (int ks = 0; ks < 4; ++ks) Xp[ks] = pack_step(KS[ks >> 1], ks & 1);
                f32x16 VN[2];
#pragma unroll
                for (int mt = 0; mt < 2; ++mt) {
#pragma unroll
                    for (int x = 0; x < 16; ++x) VN[mt][x] = 0.f;
#pragma unroll
                    for (int ks = 0; ks < 4; ++ks) if (ks < 2 * mt + 2) VN[mt] = MFMA32(frag_perm(Tb, 72, 32 * mt + r, ks, h), Xp[ks], VN[mt]);
                }
                __builtin_amdgcn_sched_barrier(0);
                if (step + 1 < 260) { int rbn; bool fn; dn_step_rb(step + 1, dir, b, rbn, fn); dn_prefetch(pre, P, AB, TP, rbn, dir, vh, kh, opaque_tid() & 255, 2); }
                __builtin_amdgcn_sched_barrier(0);
                bf16x8 VNp[4];
#pragma unroll
                for (int ks = 0; ks < 4; ++ks) VNp[ks] = pack_step(VN[ks >> 1], ks & 1);
#pragma unroll
                for (int mt = 0; mt < 2; ++mt) {
#pragma unroll
                    for (int x = 0; x < 16; ++x) QS[mt][x] *= sc_eg[32 * mt + crow(x, h)];
#pragma unroll
                    for (int ks = 0; ks < 4; ++ks) if (ks < 2 * mt + 2) QS[mt] = MFMA32(frag_perm(Ab, 72, 32 * mt + r, ks, h), VNp[ks], QS[mt]);
                }
                __builtin_amdgcn_sched_barrier(0);
#pragma unroll
                for (int mt = 0; mt < 2; ++mt)
#pragma unroll
                    for (int x = 0; x < 16; ++x) Vb[(32 * mt + crow(x, h)) * 128 + 32 * w + r] = f2bf(QS[mt][x]);
                __builtin_amdgcn_sched_barrier(0);
#pragma unroll
                for (int mt = 0; mt < 2; ++mt)
#pragma unroll
                    for (int x = 0; x < 16; ++x) VN[mt][x] *= sc_tail[32 * mt + crow(x, h)];
#pragma unroll
                for (int ks = 0; ks < 4; ++ks) VNp[ks] = pack_step(VN[ks >> 1], ks & 1);
                __builtin_amdgcn_sched_barrier(0);
                const float dl = sc_dl[0];
#pragma unroll
                for (int kt = 0; kt < 4; ++kt)
#pragma unroll
                    for (int x = 0; x < 16; ++x) S[kt][x] *= dl;
#pragma unroll
                for (int ks = 0; ks < 4; ++ks) {
#pragma unroll
                    for (int kt = 0; kt < 4; ++kt) S[kt] = MFMA32(frag_tr(Kb, 136, 32 * kt, ks, lane), VNp[ks], S[kt]);
                    __builtin_amdgcn_sched_barrier(0);
                }
            }
            __syncthreads();
            {
                const int tq_ = opaque_tid(), t = tq_ & 255;
                const int i = t >> 2, ch0 = 32 * (t & 3), ip = dir ? 63 - i : i;
                u32x4* gp = (u32x4*)(OB + (size_t)(row_base + i) * 2048 + vh * 128 + ch0);
#pragma unroll
                for (int v = 0; v < 4; ++v) { u32x4 o = *(const LAS u32x4*)(Vb + ip * 128 + ch0 + 8 * v);
                    if (!first) { const u32x4 e = gp[v];
                        o.x = cvtpk_s(bf_lo(o.x) + bf_lo(e.x), bf_hi(o.x) + bf_hi(e.x)); o.y = cvtpk_s(bf_lo(o.y) + bf_lo(e.y), bf_hi(o.y) + bf_hi(e.y));
                        o.z = cvtpk_s(bf_lo(o.z) + bf_lo(e.z), bf_hi(o.z) + bf_hi(e.z)); o.w = cvtpk_s(bf_lo(o.w) + bf_lo(e.w), bf_hi(o.w) + bf_hi(e.w)); }
                    gp[v] = o; }
            }
            __syncthreads();
        }
    }
}
constexpr int GP_QM = 0, GP_KM = 17408, GP_AB = 34816, GP_LOW = 44032, GP_TOT = 48128, GP_DIR = 49152;
__device__ __forceinline__ void gla_prep_phase(LAS unsigned char* lds, const bf16_t* P, const float* LOW, const float* gw2, const float* gb2, bf16_t* QM, bf16_t* KM, bf16_t* AQ, float* EL, int G) {
    const int tid0 = opaque_tid(), hb = __builtin_amdgcn_readfirstlane(tid0 >> 8);
    for (int itb = blockIdx.x * 2; itb < 4160; itb += 2 * G) {
        const int it = itb + hb, dir = it & 1, head = (it >> 1) & 3, rb = it >> 3;
        const int tq = opaque_tid(), t = tq & 255, w = __builtin_amdgcn_readfirstlane((tq >> 6) & 3), lane = tq & 63, r = lane & 31, h = lane >> 5;
        LAS unsigned char* base = lds + hb * GP_DIR;
        LAS bf16_t* Qm = (LAS bf16_t*)(base + GP_QM); LAS bf16_t* Km = (LAS bf16_t*)(base + GP_KM); LAS bf16_t* Ab = (LAS bf16_t*)(base + GP_AB);
        LAS float* lowS = (LAS float*)(base + GP_LOW); LAS float* tot = (LAS float*)(base + GP_TOT);
        *(LAS f32x4*)(lowS + 4 * t) = *(const f32x4*)(LOW + (size_t)(rb * 64 + (t >> 2)) * 32 + dir * 16 + 4 * (t & 3));
        const int dk = t & 127, half = t >> 7, col = head * 128 + dk;
        float w2c[16];
#pragma unroll
        for (int rr = 0; rr < 16; ++rr) w2c[rr] = gw2[(size_t)(dir * 16 + rr) * 512 + col];
        const float b2 = gb2[dir * 512 + col];
        __syncthreads();
        float bc[32]; float run = 0.f;
#pragma unroll
        for (int n = 0; n < 32; ++n) { const int ip = 32 * half + n, i = dir ? 63 - ip : ip; float s = b2;
#pragma unroll
            for (int rr = 0; rr < 16; ++rr) s += lowS[i * 16 + rr] * w2c[rr];
            run += logsigmoid_f(s) * (1.f / 16.f); bc[n] = run; }
        tot[half * 128 + dk] = run;
        __syncthreads();
        const float t0 = tot[dk], last = t0 + tot[128 + dk], off = half ? t0 : 0.f;
        if (half == 0) EL[(size_t)(dir * 520 + rb) * 512 + col] = last;
        {
            const int i0 = dir ? 63 - 32 * half : 32 * half; const long pstep = dir ? -3072 : 3072;
            const bf16_t* pp = P + (size_t)(rb * 64 + i0) * 3072 + col;
#pragma unroll
            for (int n = 0; n < 32; ++n) { const int ip = 32 * half + n; const float bcv = bc[n] + off;
                const float qv = bf2f(pp[0]), kv = bf2f(pp[512]); pp += pstep;
                Qm[ip * 136 + dk] = f2bf(qv * 0.08838834764831845f * __expf(bcv - last));
                Km[ip * 136 + dk] = f2bf(kv * __expf(last - bcv)); }
        }
        __syncthreads();
        {
            const int ti = w >> 1, tj = w & 1;
            f32x16 acc;
#pragma unroll
            for (int x = 0; x < 16; ++x) acc[x] = 0.f;
            if (!(ti == 0 && tj == 1)) {
#pragma unroll
                for (int ks = 0; ks < 8; ++ks) acc = MFMA32(frag_nat(Qm, 136, 32 * ti + r, ks, h), frag_nat(Km, 136, 32 * tj + r, ks, h), acc);
            }
            const int j = 32 * tj + r;
#pragma unroll
            for (int x = 0; x < 16; ++x) { const int i = 32 * ti + crow(x, h); Ab[i * 72 + j] = f2bf(i >= j ? acc[x] : 0.f); }
            const int row = t >> 2, ch0 = 32 * (t & 3);
            u32x4* dq = (u32x4*)(QM + ((size_t)dir * MROWS + rb * 64 + row) * 512 + head * 128 + ch0); u32x4* dkk = (u32x4*)(KM + ((size_t)dir * MROWS + rb * 64 + row) * 512 + head * 128 + ch0);
#pragma unroll
            for (int v = 0; v < 4; ++v) { dq[v] = *(const LAS u32x4*)(Qm + row * 136 + ch0 + 8 * v); dkk[v] = *(const LAS u32x4*)(Km + row * 136 + ch0 + 8 * v); }
        }
        __syncthreads();
        {
            bf16_t* dst = AQ + (size_t)it * 4096;
#pragma unroll
            for (int k2 = 0; k2 < 2; ++k2) { const int c = t + 256 * k2, row = c >> 3, cc = c & 7; *(u32x4*)(dst + c * 8) = *(const LAS u32x4*)(Ab + row * 72 + 8 * cc); }
        }
        __syncthreads();
    }
}
constexpr int GL_QM = 0, GL_KM = 17408, GL_VB = 34816, GL_AB = 52224, GL_EL = 61440, GL_DIR = 61952;
struct GlPre { u32x4 q4[4], k4[4], v4[4], a0, a1; float elv; };
__device__ __forceinline__ void gl_prefetch(GlPre& p, const bf16_t* P, const bf16_t* QM, const bf16_t* KM, const bf16_t* AQ, const float* EL, int rb, int dir, int head, int hf, int t) {
    const int i = t >> 2, ch0 = 32 * (t & 3);
    const u32x4* sq = (const u32x4*)(QM + ((size_t)dir * MROWS + rb * 64 + i) * 512 + head * 128 + ch0);
    const u32x4* sk = (const u32x4*)(KM + ((size_t)dir * MROWS + rb * 64 + i) * 512 + head * 128 + ch0);
    const u32x4* sv = (const u32x4*)(P + (size_t)(rb * 64 + i) * 3072 + 1024 + head * 256 + hf * 128 + ch0);
    const bf16_t* aq = AQ + (size_t)((rb * 4 + head) * 2 + dir) * 4096;
#pragma unroll
    for (int v = 0; v < 4; ++v) { p.q4[v] = sq[v]; p.k4[v] = sk[v]; p.v4[v] = sv[v]; }
    p.a0 = *(const u32x4*)(aq + t * 8); p.a1 = *(const u32x4*)(aq + (256 + t) * 8);
    p.elv = EL[(size_t)(dir * 520 + rb) * 512 + head * 128 + (t & 127)];
}
__device__ __forceinline__ void gla_scan(LAS unsigned char* lds, const bf16_t* P  , const bf16_t* QM, const bf16_t* KM, const bf16_t* AQ, const float* EL, bf16_t* OB  ) {
    const int tid = opaque_tid(), dir = __builtin_amdgcn_readfirstlane(tid >> 8);
    for (int unit = blockIdx.x; unit < 16; unit += gridDim.x) {
        const int b = unit >> 3, head = (unit >> 1) & 3, hf = unit & 1;
        f32x16 S[4];
#pragma unroll
        for (int kt = 0; kt < 4; ++kt)
#pragma unroll
            for (int x = 0; x < 16; ++x) S[kt][x] = 0.f;
        GlPre pre;
        { int rb0; bool f0; dn_step_rb(0, dir, b, rb0, f0); gl_prefetch(pre, P, QM, KM, AQ, EL, rb0, dir, head, hf, tid & 255); }
        __syncthreads();
        for (int step = 0; step < 260; ++step) {
            const int w = __builtin_amdgcn_readfirstlane((opaque_tid() >> 6) & 3);
            LAS unsigned char* base = lds + dir * GL_DIR;
            LAS bf16_t* Qm = (LAS bf16_t*)(base + GL_QM); LAS bf16_t* Km = (LAS bf16_t*)(base + GL_KM); LAS bf16_t* Vb = (LAS bf16_t*)(base + GL_VB); LAS bf16_t* Ab = (LAS bf16_t*)(base + GL_AB);
            LAS float* el = (LAS float*)(base + GL_EL);
            int rb; bool first; dn_step_rb(step, dir, b, rb, first);
            const int row_base = rb * 64;
            {
                const int tq_ = opaque_tid(), t = tq_ & 255;
                const int i = t >> 2, ch0 = 32 * (t & 3), ip = dir ? 63 - i : i;
#pragma unroll
                for (int v = 0; v < 4; ++v) { *(LAS u32x4*)(Qm + i * 136 + ch0 + 8 * v) = pre.q4[v]; *(LAS u32x4*)(Km + i * 136 + ch0 + 8 * v) = pre.k4[v]; *(LAS u32x4*)(Vb + ip * 136 + ch0 + 8 * v) = pre.v4[v]; }
                { const int c = t, row = c >> 3, cc = c & 7; *(LAS u32x4*)(Ab + row * 72 + 8 * cc) = pre.a0; }
                { const int c = 256 + t, row = c >> 3, cc = c & 7; *(LAS u32x4*)(Ab + row * 72 + 8 * cc) = pre.a1; }
                if (t < 128) el[t] = __expf(pre.elv);
            }
            __syncthreads();
            if (step + 1 < 260) { int rbn; bool fn; dn_step_rb(step + 1, dir, b, rbn, fn); gl_prefetch(pre, P, QM, KM, AQ, EL, rbn, dir, head, hf, opaque_tid() & 255); }
            __builtin_amdgcn_sched_barrier(0);
            {
                const int tq_ = opaque_tid(), lane = tq_ & 63, r = lane & 31, h = lane >> 5;
#pragma unroll
                for (int kt = 0; kt < 4; ++kt)
#pragma unroll
                    for (int x = 0; x < 16; ++x) S[kt][x] *= el[32 * kt + crow(x, h)];
                bf16x8 Vf[4];
#pragma unroll
                for (int ks = 0; ks < 4; ++ks) Vf[ks] = frag_tr(Vb, 136, 32 * w, ks, lane);
                f32x16 O[2];
#pragma unroll
                for (int mt = 0; mt < 2; ++mt) {
#pragma unroll
                    for (int x = 0; x < 16; ++x) O[mt][x] = 0.f;
#pragma unroll
                    for (int ks = 0; ks < 4; ++ks) if (ks < 2 * mt + 2) O[mt] = MFMA32(frag_perm(Ab, 72, 32 * mt + r, ks, h), Vf[ks], O[mt]);
                }
                __builtin_amdgcn_sched_barrier(0);
#pragma unroll
                for (int ks = 0; ks < 8; ++ks) {
                    const bf16x8 sp = pack_step(S[ks >> 1], ks & 1);
#pragma unroll
                    for (int mt = 0; mt < 2; ++mt) O[mt] = MFMA32(frag_perm(Qm, 136, 32 * mt + r, ks, h), sp, O[mt]);
                    if (ks & 1) __builtin_amdgcn_sched_barrier(0);
                }
#pragma unroll
                for (int mt = 0; mt < 2; ++mt)
#pragma unroll
                    for (int x = 0; x < 16; ++x) Vb[(32 * mt + crow(x, h)) * 136 + 32 * w + r] = f2bf(O[mt][x]);
                __builtin_amdgcn_sched_barrier(0);
#pragma unroll
                for (int ks = 0; ks < 4; ++ks) {
#pragma unroll
                    for (int kt = 0; kt < 4; ++kt) S[kt] = MFMA32(frag_tr(Km, 136, 32 * kt, ks, lane), Vf[ks], S[kt]);
                    __builtin_amdgcn_sched_barrier(0);
                }
            }
            __syncthreads();
            {
                const int tq_ = opaque_tid(), t = tq_ & 255;
                const int i = t >> 2, ch0 = 32 * (t & 3), ip = dir ? 63 - i : i;
                u32x4* gp = (u32x4*)(OB + (size_t)(row_base + i) * 1024 + head * 256 + hf * 128 + ch0);
#pragma unroll
                for (int v = 0; v < 4; ++v) { u32x4 o = *(const LAS u32x4*)(Vb + ip * 136 + ch0 + 8 * v);
                    if (!first) { const u32x4 e = gp[v];
                        o.x = cvtpk_s(bf_lo(o.x) + bf_lo(e.x), bf_hi(o.x) + bf_hi(e.x)); o.y = cvtpk_s(bf_lo(o.y) + bf_lo(e.y), bf_hi(o.y) + bf_hi(e.y));
                        o.z = cvtpk_s(bf_lo(o.z) + bf_lo(e.z), bf_hi(o.z) + bf_hi(e.z)); o.w = cvtpk_s(bf_lo(o.w) + bf_lo(e.w), bf_hi(o.w) + bf_hi(e.w)); }
                    gp[v] = o; }
            }
            __syncthreads();
        }
    }
}
#define DUP_DN 0
#define DUP_GLA 0
#define DUP_ATT 0
#define DUP_GIN 0
#define DUP_FFN1 0
constexpr unsigned long long pack_ops(const int* ops, int n) { unsigned long long v = 0; for (int i = 0; i < n; ++i) v |= (unsigned long long)ops[i] << (5 * i); return v; }
struct OpList { unsigned long long code; int n; };
constexpr OpList make_list(int mix) {
    int ops[16] = {}; int n = 0;
    ops[n++] = OP_PREP; ops[n++] = OP_GEMM_IN; if (DUP_GIN) ops[n++] = OP_GEMM_IN;
    if (mix == 0) { ops[n++] = OP_DNHALO; ops[n++] = OP_DNCONV; ops[n++] = OP_DNT; ops[n++] = OP_DNSCAN; if (DUP_DN) ops[n++] = OP_DNSCAN; ops[n++] = OP_DNREDO; ops[n++] = OP_GEMM_Z; }
    else if (mix == 1) { ops[n++] = OP_GLAPREP; ops[n++] = OP_GLASCAN; if (DUP_GLA) ops[n++] = OP_GLASCAN; ops[n++] = OP_GLAGATE; }
    else { ops[n++] = OP_QKROPE; ops[n++] = OP_ATTN; if (DUP_ATT) ops[n++] = OP_ATTN; }
    ops[n++] = OP_GEMM_OUT; ops[n++] = OP_NORM2; ops[n++] = OP_FFN1; if (DUP_FFN1) ops[n++] = OP_FFN1; ops[n++] = OP_FFN2;
    return OpList{pack_ops(ops, n), n};
}
constexpr OpList L_DN = make_list(0), L_GL = make_list(1), L_AT = make_list(2);
constexpr int NPHASE = 1 + 2 * L_DN.n + L_GL.n + L_AT.n;
__device__ __forceinline__ void decode_phase(int ph, int& layer, int& op) {
    if (ph == 0) { layer = 0; op = OP_MOD; return; }
    int p = ph - 1;
    if (p < L_DN.n) { layer = 0; op = (int)((L_DN.code >> (5 * p)) & 31ull); return; } p -= L_DN.n;
    if (p < L_GL.n) { layer = 1; op = (int)((L_GL.code >> (5 * p)) & 31ull); return; } p -= L_GL.n;
    if (p < L_AT.n) { layer = 2; op = (int)((L_AT.code >> (5 * p)) & 31ull); return; } p -= L_AT.n;
    layer = 3; op = (int)((L_DN.code >> (5 * p)) & 31ull);
}

__global__ void __launch_bounds__(512, 2) mega(Args args) {
    extern __shared__ __attribute__((aligned(16))) unsigned char lds_raw[];
    LAS unsigned char* lds = (LAS unsigned char*)lds_raw;
    cg::grid_group grid = cg::this_grid();
    const int G = gridDim.x, NGW = G * 8;
    unsigned char* ws = args.ws;
    const float* x_in = args.in[0]; const float* c_in = args.in[1]; const float* ctx_in = args.in[2]; const float* cctx_in = args.in[3];
    const float* ada_w = args.in[4]; const float* ada_b = args.in[5]; const float* norm_mix_g = args.in[6]; const float* norm_ffn_g = args.in[7];
    const float* ffn_w1 = args.in[8]; const float* ffn_w2 = args.in[9];
    float* MOD = (float*)(ws + WS_MOD); float* CTXC = (float*)(ws + WS_CTX); bf16_t* H = (bf16_t*)(ws + WS_H); float* ABF = (float*)(ws + WS_AB); float* RSTD = (float*)(ws + WS_RSTD);
    bf16_t* PB = (bf16_t*)(ws + WS_P); float* out = args.out;

    for (int ph = args.ph_lo; ph < args.ph_hi; ++ph) {
        int layer, op; decode_phase(ph, layer, op);
        const int tid = opaque_tid(), lane = tid & 63, wave = __builtin_amdgcn_readfirstlane(tid >> 6); const int gw = blockIdx.x * 8 + wave;
        const int mix = layer % 3, slot = layer / 3;
        const float* modl = MOD + (size_t)layer * 3 * 6144;
        const float* xl = layer == 0 ? x_in : out; const float* xc = layer == 0 ? ctx_in : CTXC;
        if (op == OP_MOD) {
            LAS float* sl = (LAS float*)lds; LAS float* red = sl + 3 * 1024;
            for (int e = tid; e < 3 * 1024; e += 512) { const float v = e < 2048 ? c_in[e] : cctx_in[e - 2048]; sl[e] = silu_f(v); }
            __syncthreads();
            for (int item = blockIdx.x; item < 4 * 96; item += G) {
                const int ly = item / 96, col = (item % 96) * 64 + lane;
                const float* wp = ada_w + ((size_t)ly * 1024 + 128 * wave) * 6144 + col;
                float a0 = 0.f, a1 = 0.f, a2 = 0.f;
#pragma unroll 8
                for (int k = 0; k < 128; ++k) { const float wv = wp[(size_t)k * 6144]; const int kk = 128 * wave + k; a0 += sl[kk] * wv; a1 += sl[1024 + kk] * wv; a2 += sl[2048 + kk] * wv; }
                red[(wave * 3 + 0) * 64 + lane] = a0; red[(wave * 3 + 1) * 64 + lane] = a1; red[(wave * 3 + 2) * 64 + lane] = a2;
                __syncthreads();
                if (tid < 192) { const int m = tid >> 6; float s = ada_b[(size_t)ly * 6144 + col];
#pragma unroll
                    for (int w2 = 0; w2 < 8; ++w2) s += red[(w2 * 3 + m) * 64 + lane];
                    MOD[((size_t)ly * 3 + m) * 6144 + col] = s; }
                __syncthreads();
            }
        } else if (op == OP_PREP) {
            LAS float* scr = (LAS float*)(lds + wave * 16384);
            unsigned z0 = 0u; asm volatile("" : "+v"(z0)); const u32x4 zv = (u32x4){z0, z0, z0, z0};
            bf16_t* wtA = (bf16_t*)(ws + WT_A); bf16_t* wtZ = (bf16_t*)(ws + WT_Z); bf16_t* wtO = (bf16_t*)(ws + WT_O); bf16_t* wt1 = (bf16_t*)(ws + WT_1); bf16_t* wt2 = (bf16_t*)(ws + WT_2);
            if (mix == 0) {
                const float* w_in = args.in[10] + (size_t)slot * 1024 * 6208; const float* w_out = args.in[15] + (size_t)slot * 2048 * 1024;
                transpose_mat(w_in, 6208, 0, 4096, 1024, wtA, 0, scr, gw, NGW, lane);
                transpose_mat(w_in, 6208, 6144, 64, 1024, wtA, 4096, scr, gw, NGW, lane);
                for (size_t e = (size_t)blockIdx.x * 512 + tid; e < (size_t)192 * 1024 * 2 / 16; e += (size_t)G * 512) ((u32x4*)(wtA + (size_t)4160 * 1024))[e] = zv;
            } else if (mix == 1) {
                const float* w_in = args.in[16]; const float* w_out = args.in[20];
                transpose_mat(w_in, 3104, 0, 3104, 1024, wtA, 0, scr, gw, NGW, lane);
                for (size_t e = (size_t)blockIdx.x * 512 + tid; e < (size_t)224 * 1024 * 2 / 16; e += (size_t)G * 512) ((u32x4*)(wtA + (size_t)3104 * 1024))[e] = zv;
                transpose_mat(w_out, 1024, 0, 1024, 1024, wtO, 0, scr, gw, NGW, lane);
            } else {
                const float* w_in = args.in[21]; const float* w_out = args.in[24];
                transpose_mat(w_in, 1536, 0, 1536, 1024, wtA, 0, scr, gw, NGW, lane);
                transpose_mat(w_out, 1024, 0, 1024, 1024, wtO, 0, scr, gw, NGW, lane);
            }
            if (mix != 0) {
                transpose_mat(ffn_w1 + (size_t)layer * 1024 * 4096, 4096, 0, 4096, 1024, wt1, 0, scr, gw, NGW, lane);
                transpose_mat(ffn_w2 + (size_t)layer * 4096 * 1024, 1024, 0, 1024, 4096, wt2, 0, scr, gw, NGW, lane);
            }
            normmod_rows(xl, xc, norm_mix_g + (size_t)layer * 1024, modl, 0, H, gw, NGW, lane);
        } else if (op == OP_DNREDO) {
            LAS float* scr = (LAS float*)(lds + wave * 16384);
            const float* w_in = args.in[10] + (size_t)slot * 1024 * 6208; const float* w_out = args.in[15] + (size_t)slot * 2048 * 1024;
            transpose_mat(w_in, 6208, 4096, 2048, 1024, (bf16_t*)(ws + WT_Z), 0, scr, gw, NGW, lane);
            transpose_mat(w_out, 1024, 0, 1024, 2048, (bf16_t*)(ws + WT_O), 0, scr, gw, NGW, lane);
            transpose_mat(ffn_w1 + (size_t)layer * 1024 * 4096, 4096, 0, 4096, 1024, (bf16_t*)(ws + WT_1), 0, scr, gw, NGW, lane);
            transpose_mat(ffn_w2 + (size_t)layer * 4096 * 1024, 1024, 0, 1024, 4096, (bf16_t*)(ws + WT_2), 0, scr, gw, NGW, lane);
            normmod_rows(xl, xc, norm_mix_g + (size_t)layer * 1024, modl, 0, H, gw, NGW, lane);
            const bf16_t* OB = (const bf16_t*)(ws + WS_O);
            for (int row = gw; row < MROWS; row += NGW) {
                const u32x4* p = (const u32x4*)(OB + (size_t)row * 2048 + 32 * lane); float ss = 0.f;
#pragma unroll
                for (int v = 0; v < 4; ++v) { const u32x4 q = p[v]; const float a0 = bf_lo(q.x), a1 = bf_hi(q.x), a2 = bf_lo(q.y), a3 = bf_hi(q.y), a4 = bf_lo(q.z), a5 = bf_hi(q.z), a6 = bf_lo(q.w), a7 = bf_hi(q.w);
                    ss += (a0 * a0 + a1 * a1) + (a2 * a2 + a3 * a3) + (a4 * a4 + a5 * a5) + (a6 * a6 + a7 * a7); }
                ss += __shfl_xor(ss, 1); ss += __shfl_xor(ss, 2);
                if ((lane & 3) == 0) RSTD[(size_t)row * 16 + (lane >> 2)] = rsqrtf(ss * (1.f / 128.f) + EPS);
            }
        } else if (op == OP_DNHALO) {
            dn_halo_phase(PB, (bf16_t*)(ws + WS_HALO), G);
        } else if (op == OP_DNCONV) {
            dn_conv_phase(PB, (const bf16_t*)(ws + WS_HALO), args.in[11] + (size_t)slot * 4096 * 5, G);
        } else if (op == OP_DNT) {
            dn_t_phase(lds, PB, ABF, (bf16_t*)(ws + WS_TP), args.in[12] + (size_t)slot * 32, args.in[13] + (size_t)slot * 32, G);
        } else if (op == OP_NORM2) {
            normmod_rows(out, CTXC, norm_ffn_g + (size_t)layer * 1024, modl, 3, H, gw, NGW, lane);
        } else if (op == OP_GEMM_IN || op == OP_GEMM_Z || op == OP_GEMM_OUT || op == OP_FFN1 || op == OP_FFN2) {
            pg8::Gemm g; pg8::Epi E;
            E.mode = 0; E.O = PB; E.ldc = 4096; E.tail_pn = -1; E.F = ABF; E.ldf = 64; E.nf = 64; E.rstd = RSTD; E.ng = args.in[14] + (size_t)slot * 128;
            E.src_lat = xl; E.src_ctx = xc; E.dst_lat = out; E.dst_ctx = CTXC; E.mod = modl; E.gidx = 2;
            g.M = MROWS; g.A = H; g.K = 1024;
            bf16_t* OBUF = (bf16_t*)(ws + (mix == 1 ? WS_OGLA : WS_O));
            if (op == OP_GEMM_IN) {
                g.Bt = (const bf16_t*)(ws + WT_A);
                if (mix == 0) { g.N = 4352; E.ldc = 4096; E.tail_pn = 16; E.ldf = 64; E.nf = 64; }
                else if (mix == 1) { g.N = 3328; E.ldc = 3072; E.tail_pn = 12; E.ldf = 32; E.nf = 32; }
                else { g.N = 1536; E.ldc = 1536; }
            } else if (op == OP_GEMM_Z) {
                g.Bt = (const bf16_t*)(ws + WT_Z); g.N = 2048; E.mode = 2; E.O = OBUF; E.ldc = 2048;
            } else if (op == OP_GEMM_OUT) {
                g.A = OBUF; g.K = mix == 0 ? 2048 : 1024; g.Bt = (const bf16_t*)(ws + WT_O); g.N = 1024; E.mode = 3; E.gidx = 2;
            } else if (op == OP_FFN1) {
                g.Bt = (const bf16_t*)(ws + WT_1); g.N = 4096; E.mode = 1; E.ldc = 4096;
            } else {
                g.A = PB; g.K = 4096; g.Bt = (const bf16_t*)(ws + WT_2); g.N = 1024; E.mode = 3; E.gidx = 5; E.src_lat = out; E.src_ctx = CTXC;
            }
            pg8::StaticOrder S; S.init(g.M, g.N, G, (int)blockIdx.x);
#ifndef NO_GEMM
            pg8::gemm_phase<pg8::Epi, pg8::StaticOrder, true, true>(lds, g, S, E);
#endif
        } else if (op == OP_DNSCAN) {
#ifndef NO_DN
            dn_scan(lds, PB, ABF, (const bf16_t*)(ws + WS_TP), (bf16_t*)(ws + WS_O));
#endif
        } else if (op == OP_GLAPREP) {
            gla_prep_phase(lds, PB, ABF, args.in[17], args.in[18], (bf16_t*)(ws + WS_QM), (bf16_t*)(ws + WS_KM), (bf16_t*)(ws + WS_AQ), (float*)(ws + WS_EL), G);
        } else if (op == OP_GLASCAN) {
#ifndef NO_GLA
            gla_scan(lds, PB, (const bf16_t*)(ws + WS_QM), (const bf16_t*)(ws + WS_KM), (const bf16_t*)(ws + WS_AQ), (const float*)(ws + WS_EL), (bf16_t*)(ws + WS_OGLA));
#endif
        } else if (op == OP_GLAGATE) {
            bf16_t* OB = (bf16_t*)(ws + WS_OGLA); const float* ng = args.in[19];
            for (int row = gw; row < MROWS; row += NGW) {
                u32x4* p = (u32x4*)(OB + (size_t)row * 1024 + 16 * lane); const u32x4* gp = (const u32x4*)(PB + (size_t)row * 3072 + 2048 + 16 * lane);
                float o[16], z[16]; float ss = 0.f;
#pragma unroll
                for (int v = 0; v < 2; ++v) { const u32x4 q = p[v], gq = gp[v];
                    o[8 * v + 0] = bf_lo(q.x); o[8 * v + 1] = bf_hi(q.x); o[8 * v + 2] = bf_lo(q.y); o[8 * v + 3] = bf_hi(q.y); o[8 * v + 4] = bf_lo(q.z); o[8 * v + 5] = bf_hi(q.z); o[8 * v + 6] = bf_lo(q.w); o[8 * v + 7] = bf_hi(q.w);
                    z[8 * v + 0] = bf_lo(gq.x); z[8 * v + 1] = bf_hi(gq.x); z[8 * v + 2] = bf_lo(gq.y); z[8 * v + 3] = bf_hi(gq.y); z[8 * v + 4] = bf_lo(gq.z); z[8 * v + 5] = bf_hi(gq.z); z[8 * v + 6] = bf_lo(gq.w); z[8 * v + 7] = bf_hi(gq.w); }
#pragma unroll
                for (int e = 0; e < 16; ++e) ss += o[e] * o[e];
                ss += __shfl_xor(ss, 1); ss += __shfl_xor(ss, 2); ss += __shfl_xor(ss, 4); ss += __shfl_xor(ss, 8);
                const float rs = rsqrtf(ss * (1.f / 256.f) + EPS); const int cb = (16 * lane) & 255;
#pragma unroll
                for (int v = 0; v < 2; ++v) { float rr[8];
#pragma unroll
                    for (int e = 0; e < 8; ++e) rr[e] = o[8 * v + e] * rs * ng[cb + 8 * v + e] * silu_f(z[8 * v + e]);
                    u32x4 wv; wv.x = cvtpk_s(rr[0], rr[1]); wv.y = cvtpk_s(rr[2], rr[3]); wv.z = cvtpk_s(rr[4], rr[5]); wv.w = cvtpk_s(rr[6], rr[7]); p[v] = wv; }
            }
        } else if (op == OP_QKROPE) {
            bf16_t* QR = (bf16_t*)(ws + WS_QR); bf16_t* KR = (bf16_t*)(ws + WS_KR); bf16_t* VR = (bf16_t*)(ws + WS_VR);
            const float* qg = args.in[22]; const float* kg = args.in[23];
            const int hf = lane >> 5, j = lane & 31, e1 = 64 * hf + j, e2 = e1 + 32;
            const float inv_freq = exp2f(-(float)(2 * j) * (1.f / 64.f) * 13.287712379549449f);
            const float gq1 = qg[e1], gq2 = qg[e2], gk1 = kg[e1], gk2 = kg[e2];
            for (int row = gw; row < MROWS; row += NGW) {
                const bool lat = row < NLAT; const int b = lat ? row / SEQ : (row - NLAT) / CTXL; const int tpos = lat ? row % SEQ : (row - NLAT) % CTXL;
                float cs = 1.f, sn = 0.f;
                if (lat) { const float pos = (float)(hf == 0 ? tpos / 64 : tpos % 64); const float ang = pos * inv_freq; sn = sinf(ang); cs = cosf(ang); }
                const bf16_t* pr = PB + (size_t)row * 1536; const int kpos = lat ? tpos : SEQ + tpos;
#pragma unroll
                for (int hd = 0; hd < 10; ++hd) {
                    const float x1 = bf2f(pr[hd * 128 + e1]), x2 = bf2f(pr[hd * 128 + e2]);
                    const float rinv = rsqrtf(wave_sum(x1 * x1 + x2 * x2) * (1.f / 128.f) + EPS);
                    const float y1 = x1 * rinv * (hd < 8 ? gq1 : gk1), y2 = x2 * rinv * (hd < 8 ? gq2 : gk2);
                    const float o1 = y1 * cs - y2 * sn, o2 = y1 * sn + y2 * cs;
                    bf16_t* dst = hd < 8 ? QR + (size_t)row * 1024 + hd * 128 : KR + ((size_t)(b * 2 + (hd - 8)) * SKV + kpos) * 128;
                    dst[e1] = f2bf(o1); dst[e2] = f2bf(o2);
                }
#pragma unroll
                for (int kv = 0; kv < 2; ++kv) { bf16_t* dst = VR + ((size_t)(b * 2 + kv) * SKV + kpos) * 128; dst[e1] = pr[1280 + kv * 128 + e1]; dst[e2] = pr[1280 + kv * 128 + e2]; }
            }
        } else if (op == OP_ATTN) {
            const attn::bf16* QR = (const attn::bf16*)(ws + WS_QR); const attn::bf16* KR = (const attn::bf16*)(ws + WS_KR); const attn::bf16* VR = (const attn::bf16*)(ws + WS_VR);
            attn::bf16* OB = (attn::bf16*)(ws + WS_O);
            for (int u = blockIdx.x; u < 1024 + 16; u += G) {
                size_t qoff, koff; int seq;
                if (u < 1024) { const int pair = u >> 8, b = pair >> 1, kvh = pair & 1, hh = (u >> 6) & 3, qb = u & 63, head = kvh * 4 + hh;
                    qoff = ((size_t)b * SEQ + (size_t)qb * 256) * 1024 + head * 128; koff = (size_t)(b * 2 + kvh) * SKV * 128; seq = SKV; }
                else { const int jx = u - 1024, b = jx >> 3, head = jx & 7, kvh = head >> 2;
                    qoff = ((size_t)NLAT + (size_t)b * CTXL) * 1024 + head * 128; koff = ((size_t)(b * 2 + kvh) * SKV + SEQ) * 128; seq = CTXL; }
                __syncthreads();
#ifndef NO_ATT
                attn::attn_dense_body<attn::bf16>(QR + qoff, KR + koff, VR + koff, OB + qoff, seq, (char*)lds_raw);
#endif
            }
        }
        if (ph + 1 < args.ph_hi) grid.sync();
    }
}

#ifndef MK_MULTI
#define MK_MULTI 0
#endif
extern "C" void kernel_launch(void* const* d_in, const int* in_sizes, int n_in, void* d_out, int out_size, void* d_ws, size_t ws_size, hipStream_t stream) {
    static int grid = 0;
    if (grid == 0) {
        if (n_in != 25 || ws_size < WS_END) { fprintf(stderr, "kernel_launch: unexpected n_in %d / ws_size %zu (need %zu)\n", n_in, ws_size, (size_t)WS_END); grid = -1; return; }
        int dev = 0, cus = 0, per_cu = 0;
        hipGetDevice(&dev); hipDeviceGetAttribute(&cus, hipDeviceAttributeMultiprocessorCount, dev);
        if (hipFuncSetAttribute((const void*)mega, hipFuncAttributeMaxDynamicSharedMemorySize, LDS_BYTES) != hipSuccess) { fprintf(stderr, "kernel_launch: hipFuncSetAttribute failed\n"); grid = -1; return; }
        if (hipOccupancyMaxActiveBlocksPerMultiprocessor(&per_cu, (const void*)mega, 512, LDS_BYTES) != hipSuccess || per_cu < 1) { fprintf(stderr, "kernel_launch: occupancy query says %d\n", per_cu); per_cu = 1; }
        (void)hipGetLastError();
        grid = cus * 1;
    }
    if (grid < 0) return;
    Args a{};
    for (int i = 0; i < 25; ++i) a.in[i] = (const float*)d_in[i];
    a.out = (float*)d_out; a.ws = (unsigned char*)d_ws;
#if MK_MULTI
    for (int ph = 0; ph < NPHASE; ++ph) { a.ph_lo = ph; a.ph_hi = ph + 1; hipLaunchKernelGGL(mega, dim3(grid), dim3(512), LDS_BYTES, stream, a); }
#else
    a.ph_lo = 0; a.ph_hi = NPHASE;
    void* kargs[] = {&a};
    hipError_t e = hipLaunchCooperativeKernel((const void*)mega, dim3(grid), dim3(512), kargs, LDS_BYTES, stream);
    if (e != hipSuccess) fprintf(stderr, "cooperative launch failed: %s (grid %d)\n", hipGetErrorString(e), grid);
#endif
}
```

```cpp
#include <hip/hip_runtime.h>
#include <hip/hip_bf16.h>
#include <hip/hip_cooperative_groups.h>
#include <cstdio>
#include <cstdint>
namespace cg = cooperative_groups;
__device__ __forceinline__ int opaque_tid() { int t = threadIdx.x; asm volatile("" : "+v"(t)); return t; }
namespace pg8 {
#define PG8_LAS __attribute__((address_space(3)))
typedef unsigned short bf16_t;
typedef short bf16x8 __attribute__((ext_vector_type(8)));
typedef float f32x4 __attribute__((ext_vector_type(4)));
typedef unsigned u32x4 __attribute__((ext_vector_type(4)));
constexpr int BM = 256, BK = 64, HALF = 128, HTB = HALF * BK * 2  , STAGE_BYTES = 8 * HTB, NXCD = 8, WGM = 8;

__host__ __device__ __forceinline__ int lds_byte(int r, int c) { const int st = (r >> 4) * 2 + (c >> 5), rr = r & 15, cc = c & 31, ob = rr * 64 + cc * 2; return st * 1024 + (ob ^ (((ob >> 9) & 1) << 5)); }
__host__ __device__ __forceinline__ void stage_rc(int b, int& R, int& C) { const int st = b / 1024, sb = b % 1024, swz = sb ^ (((sb >> 9) & 1) << 5); R = (st >> 1) * 16 + swz / 64; C = (st & 1) * 32 + (swz % 64) / 2; }
__host__ __device__ __forceinline__ int perm32(int rho) { const int n = rho >> 4, i = rho & 15; return 8 * (i >> 2) + 4 * n + (i & 3); }

struct Unit { int pm, pn; };
struct Gemm { const bf16_t* A; const bf16_t* Bt; int M, N, K; };

struct StaticOrder {
    int nM, nN, nwg, G, c;
    __host__ __device__ void init(int M, int N, int G_, int c_) { nM = M / BM; nN = N / BM; nwg = nM * nN; G = G_; c = c_; }
    __host__ __device__ bool next(int i, Unit& u) const {
        const long L = (long)i * G + c; if (L >= nwg) return false;
        int wgid = (int)L; { const int q = nwg / NXCD, r = nwg % NXCD, xcd = wgid % NXCD, off = wgid / NXCD; wgid = (xcd < r ? xcd * (q + 1) : r * (q + 1) + (xcd - r) * q) + off; }
        const int nig = WGM * nN, gid = wgid / nig, fm = gid * WGM, gsz = (nM - fm) < WGM ? (nM - fm) : WGM;
        u.pm = fm + ((wgid % nig) % gsz); u.pn = (wgid % nig) / gsz; return true;
    }
    __device__ __forceinline__ void a_ready(const Unit&) const {}
    __device__ __forceinline__ void done(const Unit&) const {}
};

__device__ __forceinline__ unsigned cvt_pk_bf16(float lo, float hi) { unsigned r; asm volatile("v_cvt_pk_bf16_f32 %0, %1, %2" : "=v"(r) : "v"(lo), "v"(hi)); return r; }
typedef float f32x2 __attribute__((ext_vector_type(2)));
typedef float f32x2_t __attribute__((ext_vector_type(2))); typedef __bf16 bf16x2_t __attribute__((ext_vector_type(2)));
__device__ __forceinline__ unsigned cvtpk_s(float lo, float hi) { f32x2_t v = {lo, hi}; bf16x2_t b = __builtin_convertvector(v, bf16x2_t); return __builtin_bit_cast(unsigned, b); }
__device__ __forceinline__ float bf_lo(unsigned w) { return __builtin_bit_cast(float, w << 16); }
__device__ __forceinline__ float bf_hi(unsigned w) { return __builtin_bit_cast(float, w & 0xffff0000u); }
__device__ __forceinline__ float silu_f(float z) { return z / (1.f + __expf(-z)); }
struct Epi {
    static constexpr bool PERM = true, AFTER_DRAIN = false;
    int mode;
    bf16_t* O; int ldc;
    int tail_pn; float* F; int ldf, nf;
    const float* rstd; const float* ng;
    const float* src_lat; const float* src_ctx; float* dst_lat; float* dst_ctx; const float* mod; int gidx;
    __device__ __forceinline__ void operator()(const f32x4 (&acc)[2][2][4][2], const Unit& u, int wr, int wc, int fr, int fq) const {
        const int row0 = u.pm * BM + wr * 64 + fr; const int col0 = u.pn * BM + wc * 32 + 8 * fq;
        if (mode <= 1) {
            if (u.pn == tail_pn) {
                const int c0 = wc * 32 + 8 * fq;
#pragma unroll
                for (int ai = 0; ai < 2; ++ai)
#pragma unroll
                    for (int m = 0; m < 4; ++m)
#pragma unroll
                        for (int bj = 0; bj < 2; ++bj) { const int cc = c0 + bj * HALF;
                            if (cc < nf) { float* p = F + (size_t)(row0 + ai * HALF + m * 16) * ldf + cc; *(f32x4*)p = acc[ai][bj][m][0]; *(f32x4*)(p + 4) = acc[ai][bj][m][1]; } }
            } else {
#pragma unroll
                for (int ai = 0; ai < 2; ++ai)
#pragma unroll
                    for (int m = 0; m < 4; ++m) { bf16_t* rowp = O + (size_t)(row0 + ai * HALF + m * 16) * ldc + col0;
#pragma unroll
                        for (int bj = 0; bj < 2; ++bj) { f32x4 v0 = acc[ai][bj][m][0], v1 = acc[ai][bj][m][1];
                            if (mode == 1) {
#pragma unroll
                                for (int e = 0; e < 4; ++e) { float a = fmaxf(v0[e], 0.f), b = fmaxf(v1[e], 0.f); v0[e] = a * a; v1[e] = b * b; } }
                            u32x4 w; w.x = cvtpk_s(v0[0], v0[1]); w.y = cvtpk_s(v0[2], v0[3]); w.z = cvtpk_s(v1[0], v1[1]); w.w = cvtpk_s(v1[2], v1[3]);
                            *(u32x4*)(rowp + bj * HALF) = w; } }
            }
        } else if (mode == 2) {
            const f32x4 g0 = *(const f32x4*)(ng + (col0 & 127)), g1 = *(const f32x4*)(ng + (col0 & 127) + 4);
#pragma unroll
            for (int ai = 0; ai < 2; ++ai)
#pragma unroll
                for (int m = 0; m < 4; ++m) { const int row = row0 + ai * HALF + m * 16; bf16_t* rowp = O + (size_t)row * ldc + col0;
#pragma unroll
                    for (int bj = 0; bj < 2; ++bj) { const float rs = rstd[(size_t)row * 16 + ((col0 + bj * HALF) >> 7)];
                        const u32x4 ov = *(const u32x4*)(rowp + bj * HALF); const f32x4 z0 = acc[ai][bj][m][0], z1 = acc[ai][bj][m][1];
                        float r[8];
                        r[0] = bf_lo(ov.x) * rs * g0[0] * silu_f(z0[0]); r[1] = bf_hi(ov.x) * rs * g0[1] * silu_f(z0[1]);
                        r[2] = bf_lo(ov.y) * rs * g0[2] * silu_f(z0[2]); r[3] = bf_hi(ov.y) * rs * g0[3] * silu_f(z0[3]);
                        r[4] = bf_lo(ov.z) * rs * g1[0] * silu_f(z1[0]); r[5] = bf_hi(ov.z) * rs * g1[1] * silu_f(z1[1]);
                        r[6] = bf_lo(ov.w) * rs * g1[2] * silu_f(z1[2]); r[7] = bf_hi(ov.w) * rs * g1[3] * silu_f(z1[3]);
                        u32x4 w; w.x = cvtpk_s(r[0], r[1]); w.y = cvtpk_s(r[2], r[3]); w.z = cvtpk_s(r[4], r[5]); w.w = cvtpk_s(r[6], r[7]);
                        *(u32x4*)(rowp + bj * HALF) = w; } }
        } else {
            const int mi = u.pm < 64 ? 0 : (u.pm < 128 ? 1 : 2);
            const float* gate = mod + (size_t)mi * 6144 + (size_t)gidx * 1024;
            const bool lat = u.pm < 128;
            const float* sb = lat ? src_lat : src_ctx - (size_t)32768 * 1024; float* db = lat ? dst_lat : dst_ctx - (size_t)32768 * 1024;
#pragma unroll
            for (int bj = 0; bj < 2; ++bj)
#pragma unroll
                for (int n = 0; n < 2; ++n) { const int c = col0 + bj * HALF + 4 * n; const f32x4 gv = *(const f32x4*)(gate + c);
#pragma unroll
                    for (int ai = 0; ai < 2; ++ai)
#pragma unroll
                        for (int m = 0; m < 4; ++m) { const size_t off = (size_t)(row0 + ai * HALF + m * 16) * 1024 + c;
                            const f32x4 s = *(const f32x4*)(sb + off); *(f32x4*)(db + off) = s + gv * acc[ai][bj][m][n]; } }
        }
    }
};
template <class Epi, class Sched, bool ALIGN_EPI = false, bool SP2 = false>
__device__ __forceinline__ void gemm_phase(PG8_LAS unsigned char* lds, const Gemm g, const Sched& S, const Epi& E) {
    const int tid = opaque_tid(), wid = __builtin_amdgcn_readfirstlane(tid >> 6), lane = tid & 63, wr = wid >> 2, wc = wid & 3, fr = lane & 15, fq = lane >> 4;
    const int K = g.K, nt = K / BK;
    unsigned voffA[2], voffB[2];
#pragma unroll
    for (int i = 0; i < 2; ++i) { int R, C; stage_rc(tid * 16 + i * 8192, R, C); const int Rb = Epi::PERM ? ((R & ~31) + perm32(R & 31)) : R;
        voffA[i] = (unsigned)(R * K + C) * 2u; voffB[i] = (unsigned)(Rb * K + C) * 2u; }
    const size_t kstep = (size_t)(BK * 2);
    const size_t hstep = (size_t)HALF * K * 2;
    const size_t tstep = 2 * hstep;
    const unsigned ldsw = (unsigned)wid * 1024u;
    const int aoff = lds_byte(wr * 64 + fr, fq * 8), boff = lds_byte(wc * 32 + fr, fq * 8);
#define PG8_SA(b, h) (((b) * 2 + (h)) * HTB)
#define PG8_SB(b, h) ((4 + (b) * 2 + (h)) * HTB)
#define PG8_STAGE(bufoff, gbase, voff) do { _Pragma("unroll") for (int _i = 0; _i < 2; ++_i) \
        __builtin_amdgcn_global_load_lds((const unsigned*)((const char*)(gbase) + (voff)[_i]), (PG8_LAS unsigned*)(lds + (bufoff) + ldsw + _i * 8192), 16, 0, 0); } while (0)
#define PG8_LDA(dst, b, h) do { _Pragma("unroll") for (int m = 0; m < 4; ++m) _Pragma("unroll") for (int k = 0; k < 2; ++k) dst[m][k] = *(const PG8_LAS bf16x8*)(lds + PG8_SA(b, h) + aoff + m * 2048 + k * 1024); } while (0)
#define PG8_LDB(dst, b, h) do { _Pragma("unroll") for (int n = 0; n < 2; ++n) _Pragma("unroll") for (int k = 0; k < 2; ++k) dst[n][k] = *(const PG8_LAS bf16x8*)(lds + PG8_SB(b, h) + boff + n * 2048 + k * 1024); } while (0)
#define PG8_MMA(ai, bj, At, Bt) do { __builtin_amdgcn_s_setprio(1); _Pragma("unroll") for (int m = 0; m < 4; ++m) _Pragma("unroll") for (int n = 0; n < 2; ++n) _Pragma("unroll") for (int k = 0; k < 2; ++k) \
        acc[ai][bj][m][n] = __builtin_amdgcn_mfma_f32_16x16x32_bf16(Bt[n][k], At[m][k], acc[ai][bj][m][n], 0, 0, 0); __builtin_amdgcn_s_setprio(0); } while (0)
#define PG8_WAIT_V(n) asm volatile("s_waitcnt vmcnt(" #n ")" ::: "memory")
#define PG8_WAIT_L(n) asm volatile("s_waitcnt lgkmcnt(" #n ")" ::: "memory")
#define PG8_BAR __builtin_amdgcn_s_barrier()
#define PG8_SCHED __builtin_amdgcn_sched_barrier(0)
    Unit cur, nxt; int ui = 0;
    if (!S.next(0, cur)) return;
    f32x4 acc[2][2][4][2];
#pragma unroll
    for (int a = 0; a < 2; ++a)
#pragma unroll
        for (int b = 0; b < 2; ++b)
#pragma unroll
            for (int m = 0; m < 4; ++m)
#pragma unroll
                for (int n = 0; n < 2; ++n) acc[a][b][m][n] = (f32x4){0.f, 0.f, 0.f, 0.f};
    bf16x8 At[4][2], B0[2][2], B1[2][2];
    const char* cA = (const char*)g.A + (size_t)cur.pm * tstep; const char* cB = (const char*)g.Bt + (size_t)cur.pn * tstep;
    S.a_ready(cur);
    if constexpr (SP2) {
        PG8_STAGE(PG8_SB(0, 0), cB, voffB); PG8_STAGE(PG8_SB(0, 1), cB + hstep, voffB); PG8_STAGE(PG8_SA(0, 0), cA, voffA); PG8_STAGE(PG8_SA(0, 1), cA + hstep, voffA);
        if (wr == 1) PG8_BAR;
        PG8_WAIT_V(2); PG8_BAR;
        PG8_STAGE(PG8_SB(1, 0), cB + kstep, voffB); PG8_STAGE(PG8_SA(1, 0), cA + kstep, voffA); PG8_STAGE(PG8_SB(1, 1), cB + hstep + kstep, voffB);
        PG8_WAIT_V(6); PG8_BAR;
    } else {
        PG8_STAGE(PG8_SB(0, 0), cB, voffB); PG8_STAGE(PG8_SA(0, 0), cA, voffA); PG8_STAGE(PG8_SB(0, 1), cB + hstep, voffB); PG8_STAGE(PG8_SA(0, 1), cA + hstep, voffA);
        if (wr == 1) PG8_BAR;
        PG8_WAIT_V(4); PG8_BAR;
        PG8_STAGE(PG8_SB(1, 0), cB + kstep, voffB); PG8_STAGE(PG8_SA(1, 0), cA + kstep, voffA); PG8_STAGE(PG8_SB(1, 1), cB + hstep + kstep, voffB);
        PG8_WAIT_V(6); PG8_BAR;
    }
    for (;;) {
        const bool has_next = S.next(ui + 1, nxt);
        const char* nA = has_next ? (const char*)g.A + (size_t)nxt.pm * tstep : cA; const char* nB = has_next ? (const char*)g.Bt + (size_t)nxt.pn * tstep : cB;
        for (int t = 0; t < nt; t += 2) {
            const bool last = (t == nt - 2);
            const char* a1 = cA + (size_t)(t + 1) * kstep;
            const char* a2 = last ? nA : cA + (size_t)(t + 2) * kstep; const char* b2 = last ? nB : cB + (size_t)(t + 2) * kstep;
            const char* a3 = a2 + kstep; const char* b3 = b2 + kstep;
            if (last && has_next) S.a_ready(nxt);
            if constexpr (SP2) {
            PG8_LDB(B0, 0, 0); PG8_LDB(B1, 0, 1); PG8_SCHED; PG8_LDA(At, 0, 0); PG8_STAGE(PG8_SA(1, 1), a1 + hstep, voffA);
            PG8_WAIT_V(8); PG8_WAIT_L(0); PG8_BAR; PG8_MMA(0, 0, At, B0); PG8_MMA(0, 1, At, B1); PG8_BAR; PG8_SCHED;
            PG8_LDA(At, 0, 1); PG8_STAGE(PG8_SB(0, 0), b2, voffB); PG8_STAGE(PG8_SB(0, 1), b2 + hstep, voffB); PG8_STAGE(PG8_SA(0, 0), a2, voffA);
            PG8_WAIT_V(8); PG8_WAIT_L(0); PG8_BAR; PG8_MMA(1, 0, At, B0); PG8_MMA(1, 1, At, B1); PG8_BAR; PG8_SCHED;
            PG8_LDB(B0, 1, 0); PG8_LDB(B1, 1, 1); PG8_SCHED; PG8_LDA(At, 1, 0); PG8_STAGE(PG8_SA(0, 1), a2 + hstep, voffA);
            PG8_WAIT_V(8); PG8_WAIT_L(0); PG8_BAR; PG8_MMA(0, 0, At, B0); PG8_MMA(0, 1, At, B1); PG8_BAR; PG8_SCHED;
            PG8_LDA(At, 1, 1); PG8_STAGE(PG8_SB(1, 0), b3, voffB); PG8_STAGE(PG8_SB(1, 1), b3 + hstep, voffB); PG8_STAGE(PG8_SA(1, 0), a3, voffA);
            PG8_WAIT_V(8); PG8_WAIT_L(0); PG8_BAR; PG8_MMA(1, 0, At, B0); PG8_MMA(1, 1, At, B1); PG8_BAR; PG8_SCHED;
            } else {
            PG8_LDB(B0, 0, 0); PG8_SCHED; PG8_LDA(At, 0, 0); PG8_STAGE(PG8_SA(1, 1), a1 + hstep, voffA);
            PG8_WAIT_L(8); PG8_BAR; PG8_WAIT_L(0); PG8_MMA(0, 0, At, B0); PG8_BAR; PG8_SCHED;
            PG8_LDB(B1, 0, 1); PG8_STAGE(PG8_SB(0, 0), b2, voffB);
            PG8_BAR; PG8_WAIT_L(0); PG8_MMA(0, 1, At, B1); PG8_BAR;
            PG8_LDA(At, 0, 1); PG8_STAGE(PG8_SA(0, 0), a2, voffA);
            PG8_BAR; PG8_WAIT_L(0); PG8_MMA(1, 0, At, B0); PG8_BAR; PG8_SCHED;
            PG8_STAGE(PG8_SB(0, 1), b2 + hstep, voffB);
            PG8_WAIT_V(6); PG8_BAR; PG8_MMA(1, 1, At, B1); PG8_BAR;
            PG8_LDB(B0, 1, 0); PG8_SCHED; PG8_LDA(At, 1, 0); PG8_STAGE(PG8_SA(0, 1), a2 + hstep, voffA);
            PG8_WAIT_L(8); PG8_BAR; PG8_WAIT_L(0); PG8_MMA(0, 0, At, B0); PG8_BAR; PG8_SCHED;
            PG8_LDB(B1, 1, 1); PG8_STAGE(PG8_SB(1, 0), b3, voffB);
            PG8_BAR; PG8_WAIT_L(0); PG8_MMA(0, 1, At, B1); PG8_BAR;
            PG8_LDA(At, 1, 1); PG8_STAGE(PG8_SA(1, 0), a3, voffA);
            PG8_BAR; PG8_WAIT_L(0); PG8_MMA(1, 0, At, B0); PG8_BAR; PG8_SCHED;
            PG8_STAGE(PG8_SB(1, 1), b3 + hstep, voffB);
            PG8_WAIT_V(6); PG8_BAR; PG8_MMA(1, 1, At, B1); PG8_BAR;
            }
        }
        if constexpr (ALIGN_EPI) { if (wr == 0) PG8_BAR; }
        if constexpr (!Epi::AFTER_DRAIN) { E(acc, cur, wr, wc, fr, fq); S.done(cur); }
        if (!has_next) break;
#pragma unroll
        for (int a = 0; a < 2; ++a)
#pragma unroll
            for (int b = 0; b < 2; ++b)
#pragma unroll
                for (int m = 0; m < 4; ++m)
#pragma unroll
                    for (int n = 0; n < 2; ++n) acc[a][b][m][n] = (f32x4){0.f, 0.f, 0.f, 0.f};
        cur = nxt; cA = nA; cB = nB; ++ui;
        if constexpr (ALIGN_EPI) { if (wr == 1) PG8_BAR; }
    }
    PG8_WAIT_V(0);
    if constexpr (!ALIGN_EPI) { if (wr == 0) PG8_BAR; }
    PG8_BAR;
    if constexpr (Epi::AFTER_DRAIN) { E.fused(acc, cur, wr, wc, fr, fq, lds, wid, lane); S.done(cur); }
#undef PG8_SA
#undef PG8_SB
#undef PG8_STAGE
#undef PG8_LDA
#undef PG8_LDB
#undef PG8_MMA
#undef PG8_WAIT_V
#undef PG8_WAIT_L
#undef PG8_BAR
#undef PG8_SCHED
}
}
namespace attn {
using bf16 = __hip_bfloat16;
constexpr int   D = 128, NW = 8, QBLK = 32, KVBLK = 64;
constexpr float SCALE = 0.088388347648318440f;
constexpr float THR = 8.f;
constexpr int SDEPTH = 2;
constexpr int LDQ = 1024, LDK = 128, LDO = 1024;
constexpr size_t SHM_V = KVBLK * D * 2, SHM_K = KVBLK * D * 2, SHM_ATTN = 2 * SHM_V + 2 * SHM_K + NW * 64 * 4;
using bf16x8 = __attribute__((ext_vector_type(8))) short;
using s16x4  = __attribute__((ext_vector_type(4))) short;
using f32x16 = __attribute__((ext_vector_type(16))) float;
using f32x8  = __attribute__((ext_vector_type(8))) float;
using u32x4  = __attribute__((ext_vector_type(4))) unsigned;
#define KSWZ(row, colB) ((row) * 256 + ((colB) ^ (((row) & 7) << 4)))
#define SBAR() __builtin_amdgcn_sched_barrier(0)
__device__ __forceinline__ int crow(int r, int hi) { return (r & 3) + 8 * (r >> 2) + 4 * hi; }
__device__ __forceinline__ unsigned cvtpk(float lo, float hi) {
  unsigned r; asm volatile("v_cvt_pk_bf16_f32 %0, %1, %2" : "=v"(r) : "v"(lo), "v"(hi)); return r;
}
template <typename TIn> struct Stage;
template <> struct Stage<bf16>  { using T = bf16x8;
  __device__ static __forceinline__ T ld8(const bf16* p) { return *reinterpret_cast<const bf16x8*>(p); }
  __device__ static __forceinline__ bf16x8 tobf(T x) { return x; } };
template <> struct Stage<float> { using T = f32x8;
  __device__ static __forceinline__ T ld8(const float* p) { return *reinterpret_cast<const f32x8*>(p); }
  __device__ static __forceinline__ bf16x8 tobf(T x) {
    u32x4 w = {cvtpk(x[0], x[1]), cvtpk(x[2], x[3]), cvtpk(x[4], x[5]), cvtpk(x[6], x[7])}; return *reinterpret_cast<bf16x8*>(&w); } };

__device__ __forceinline__ void partialSM(f32x16& p0, f32x16& p1, float& m_reg, float& mn, float& alpha) {
  constexpr float C = SCALE * 1.4426950408889634f;
  float pmax = p0[0]; for (int r = 1; r < 16; ++r) pmax = fmaxf(pmax, p0[r]); for (int r = 0; r < 16; ++r) pmax = fmaxf(pmax, p1[r]);
  { auto rr = __builtin_amdgcn_permlane32_swap(__float_as_uint(pmax), __float_as_uint(pmax), false, false);
    pmax = fmaxf(__uint_as_float(rr[0]), __uint_as_float(rr[1])); }
  if (__builtin_expect(__all(pmax - m_reg <= THR / SCALE), 1)) { mn = m_reg; alpha = 1.f; }
  else { mn = fmaxf(m_reg, pmax); alpha = __builtin_amdgcn_exp2f((m_reg - mn) * C); m_reg = mn; }
  float mnC = -mn * C;
  for (int r = 0; r < 16; ++r) p0[r] = fmaf(p0[r], C, mnC); for (int r = 0; r < 16; ++r) p1[r] = fmaf(p1[r], C, mnC);
  for (int r = 0; r < 16; ++r) p0[r] = __builtin_amdgcn_exp2f(p0[r]);
}
__device__ __forceinline__ void finishSM(f32x16& p0, f32x16& p1, float alpha, float& l_reg, bf16x8& pa0, bf16x8& pa1, bf16x8& pa2, bf16x8& pa3) {
  for (int r = 0; r < 16; ++r) p1[r] = __builtin_amdgcn_exp2f(p1[r]);
  float ps = 0; for (int r = 0; r < 16; ++r) ps += p0[r]; for (int r = 0; r < 16; ++r) ps += p1[r];
  { auto rr = __builtin_amdgcn_permlane32_swap(__float_as_uint(ps), __float_as_uint(ps), false, false);
    ps = __uint_as_float(rr[0]) + __uint_as_float(rr[1]); }
  l_reg = l_reg * alpha + ps;
#define PK4(P, BASE, OUT) do { unsigned a0 = cvtpk(P[BASE + 0], P[BASE + 1]), a1 = cvtpk(P[BASE + 2], P[BASE + 3]);   \
    unsigned b0 = cvtpk(P[BASE + 4], P[BASE + 5]), b1 = cvtpk(P[BASE + 6], P[BASE + 7]);                              \
    auto r0 = __builtin_amdgcn_permlane32_swap(a0, b0, false, false); auto r1 = __builtin_amdgcn_permlane32_swap(a1, b1, false, false); \
    u32x4 w = {r0[0], r1[0], r0[1], r1[1]}; OUT = *reinterpret_cast<bf16x8*>(&w); } while (0)
  PK4(p0, 0, pa0); PK4(p0, 8, pa1); PK4(p1, 0, pa2); PK4(p1, 8, pa3);
#undef PK4
}
__device__ __forceinline__ void qkt(f32x16& p0, f32x16& p1, const bf16* Ks, const bf16x8* qr, int r32, int hi) {
  p0 = f32x16{}; p1 = f32x16{};
  for (int d0 = 0; d0 < 8; ++d0) { int cb = (d0 * 16 + hi * 8) * 2;
    bf16x8 b0 = *reinterpret_cast<const bf16x8*>((const char*)Ks + KSWZ(r32, cb));
    bf16x8 b1 = *reinterpret_cast<const bf16x8*>((const char*)Ks + KSWZ(32 + r32, cb));
    p0 = __builtin_amdgcn_mfma_f32_32x32x16_bf16(b0, qr[d0], p0, 0, 0, 0);
    p1 = __builtin_amdgcn_mfma_f32_32x32x16_bf16(b1, qr[d0], p1, 0, 0, 0); }
}
__device__ __forceinline__ int v_st(int k, int c) { const int kk = (k & ~0xC) | ((k & 4) << 1) | ((k & 8) >> 1); return ((kk >> 3) * 4 + (c >> 5)) * 512 + ((kk & 7) * 32 + (c & 31)) * 2; }
__device__ __forceinline__ int v_rd_base(int lane) { return ((lane & 3) << 3) | (((lane >> 2) & 3) << 6) | (((lane >> 4) & 1) << 5) | (((lane >> 5) & 1) << 8); }
constexpr int v_rd_off(int d0, int ks, int half) { return d0 * 512 + ks * 4096 + half * 2048; }
template <int OFF> __device__ __forceinline__ s16x4 tr_read(int vb) {
  s16x4 r; asm volatile("ds_read_b64_tr_b16 %0, %1 offset:%2" : "=&v"(r) : "v"(vb), "i"(OFF) : "memory"); return r;
}
template <int D0> __device__ __forceinline__ void pv_one(f32x16& od, int vb, bf16x8 pa0, bf16x8 pa1, bf16x8 pa2, bf16x8 pa3) {
  const s16x4 l0 = tr_read<v_rd_off(D0, 0, 0)>(vb), h0 = tr_read<v_rd_off(D0, 0, 1)>(vb), l1 = tr_read<v_rd_off(D0, 1, 0)>(vb), h1 = tr_read<v_rd_off(D0, 1, 1)>(vb);
  const s16x4 l2 = tr_read<v_rd_off(D0, 2, 0)>(vb), h2 = tr_read<v_rd_off(D0, 2, 1)>(vb), l3 = tr_read<v_rd_off(D0, 3, 0)>(vb), h3 = tr_read<v_rd_off(D0, 3, 1)>(vb);
  asm volatile("s_waitcnt lgkmcnt(0)" ::: "memory"); SBAR();
#define PK(L, H) (bf16x8){L[0], L[1], L[2], L[3], H[0], H[1], H[2], H[3]}
  od = __builtin_amdgcn_mfma_f32_32x32x16_bf16(pa0, PK(l0, h0), od, 0, 0, 0);
  od = __builtin_amdgcn_mfma_f32_32x32x16_bf16(pa1, PK(l1, h1), od, 0, 0, 0);
  od = __builtin_amdgcn_mfma_f32_32x32x16_bf16(pa2, PK(l2, h2), od, 0, 0, 0);
  od = __builtin_amdgcn_mfma_f32_32x32x16_bf16(pa3, PK(l3, h3), od, 0, 0, 0);
#undef PK
}
__device__ __forceinline__ void pv_d0(f32x16* o, int vb, bf16x8 pa0, bf16x8 pa1, bf16x8 pa2, bf16x8 pa3) {
  pv_one<0>(o[0], vb, pa0, pa1, pa2, pa3); pv_one<1>(o[1], vb, pa0, pa1, pa2, pa3); pv_one<2>(o[2], vb, pa0, pa1, pa2, pa3); pv_one<3>(o[3], vb, pa0, pa1, pa2, pa3);
}

template <typename TQ>
__device__ __forceinline__ void attn_dense_body(const TQ* __restrict__ Qb, const bf16* __restrict__ Kh, const bf16* __restrict__ Vh,
                                                bf16* __restrict__ Ob, int seq, char* lds) {
  using St = Stage<bf16>; using SQ = Stage<TQ>;
  const int tid = opaque_tid(), wid = tid >> 6, lane = tid & 63, r32 = lane & 31, hi = lane >> 5;
  bf16* V_lds = (bf16*)lds; bf16* K_lds = (bf16*)(lds + 2 * SHM_V);
  float* ws = (float*)(lds + 2 * SHM_V + 2 * SHM_K) + wid * 64; float* li_l = ws; float* al_l = ws + 32;
  float m_reg = -1e30f, l_reg = 0; f32x16 o[4] = {}; bf16x8 qr[8];
  const TQ* Qw = Qb + (long)(wid * QBLK + r32) * LDQ + hi * 8;
#pragma unroll
  for (int d0 = 0; d0 < 8; ++d0) qr[d0] = SQ::tobf(SQ::ld8(Qw + d0 * 16));
  const int sr = tid >> 4, sc = (tid & 15) * 8, vst0 = v_st(sr, sc), vst1 = v_st(32 + sr, sc);
  const int vb0 = (int)(uintptr_t)V_lds + v_rd_base(lane);
  struct { typename St::T vs0, vs1, ks0, ks1; } sr_[SDEPTH];
#define SLOAD(i, k0) do { sr_[i].vs0 = St::ld8(&Vh[(long)((k0) + sr) * LDK + sc]); sr_[i].vs1 = St::ld8(&Vh[(long)((k0) + 32 + sr) * LDK + sc]); \
    sr_[i].ks0 = St::ld8(&Kh[(long)((k0) + sr) * LDK + sc]); sr_[i].ks1 = St::ld8(&Kh[(long)((k0) + 32 + sr) * LDK + sc]); } while (0)
#define SWRITE(b, i) do { *(bf16x8*)((char*)V_lds + (b) * SHM_V + vst0) = St::tobf(sr_[i].vs0);          \
    *(bf16x8*)((char*)V_lds + (b) * SHM_V + vst1) = St::tobf(sr_[i].vs1); int kc = sc * 2;               \
    *(bf16x8*)((char*)K_lds + (b) * SHM_K + KSWZ(sr, kc)) = St::tobf(sr_[i].ks0);                       \
    *(bf16x8*)((char*)K_lds + (b) * SHM_K + KSWZ(32 + sr, kc)) = St::tobf(sr_[i].ks1); } while (0)
#define SWAIT() do { if constexpr (SDEPTH == 2) asm volatile("s_waitcnt vmcnt(4)" ::: "memory"); else asm volatile("s_waitcnt vmcnt(0)" ::: "memory"); } while (0)
#define RESC(a) do { if (__any((a) < 1.f)) { if (hi == 0) al_l[r32] = (a); asm volatile("s_waitcnt lgkmcnt(0)" ::: "memory"); \
    for (int d = 0; d < 4; ++d) for (int r = 0; r < 16; ++r) o[d][r] *= al_l[crow(r, hi)]; } } while (0)
  f32x16 pA0, pA1, pB0, pB1; float mnA, mnB, alA, alB; bf16x8 pa0, pa1, pa2, pa3; const int NT = seq / KVBLK;
  constexpr int SE = 0, SO = SDEPTH - 1;
  SLOAD(SE, 0); asm volatile("s_waitcnt vmcnt(0)" ::: "memory"); SWRITE(0, SE); __syncthreads();
  qkt(pA0, pA1, K_lds, qr, r32, hi); partialSM(pA0, pA1, m_reg, mnA, alA);
  SLOAD(SO, KVBLK); if constexpr (SDEPTH == 2) { if (2 < NT) SLOAD(SE, 2 * KVBLK); }
  SWAIT(); SWRITE(1, SO); __syncthreads();
  for (int j = 1; j + 1 < NT; j += 2) {
    SBAR(); qkt(pB0, pB1, (bf16*)((char*)K_lds + SHM_K), qr, r32, hi);
    finishSM(pA0, pA1, alA, l_reg, pa0, pa1, pa2, pa3); SBAR();
    SLOAD(SO, (j + SDEPTH) * KVBLK); SBAR();
    pv_d0(o, vb0, pa0, pa1, pa2, pa3); partialSM(pB0, pB1, m_reg, mnB, alB);
    __syncthreads(); SWAIT(); SWRITE(0, SE);
    RESC(alB); __syncthreads();
    SBAR(); qkt(pA0, pA1, K_lds, qr, r32, hi);
    finishSM(pB0, pB1, alB, l_reg, pa0, pa1, pa2, pa3); SBAR();
    if (SDEPTH == 1 || j + 3 < NT) SLOAD(SE, (j + 1 + SDEPTH) * KVBLK); SBAR();
    pv_d0(o, vb0 + (int)SHM_V, pa0, pa1, pa2, pa3); partialSM(pA0, pA1, m_reg, mnA, alA);
    __syncthreads(); SWAIT(); SWRITE(1, SO);
    RESC(alA); __syncthreads();
  }
  SBAR(); qkt(pB0, pB1, (bf16*)((char*)K_lds + SHM_K), qr, r32, hi);
  finishSM(pA0, pA1, alA, l_reg, pa0, pa1, pa2, pa3); SBAR();
  pv_d0(o, vb0, pa0, pa1, pa2, pa3); partialSM(pB0, pB1, m_reg, mnB, alB);
  __syncthreads(); RESC(alB);
  finishSM(pB0, pB1, alB, l_reg, pa0, pa1, pa2, pa3); SBAR();
  pv_d0(o, vb0 + (int)SHM_V, pa0, pa1, pa2, pa3);
  if (hi == 0) li_l[r32] = l_reg; asm volatile("s_waitcnt lgkmcnt(0)" ::: "memory");
  float rli[16];
#pragma unroll
  for (int r = 0; r < 16; ++r) rli[r] = __builtin_amdgcn_rcpf(li_l[crow(r, hi)]);
  bf16* Ow = Ob + (long)(wid * QBLK) * LDO;
#pragma unroll
  for (int r = 0; r < 16; ++r) { int orow = crow(r, hi);
    for (int d0 = 0; d0 < 4; ++d0) Ow[(long)orow * LDO + d0 * 32 + r32] = __float2bfloat16(o[d0][r] * rli[r]); }
#undef SLOAD
#undef SWRITE
#undef SWAIT
#undef RESC
}

}
#define LAS __attribute__((address_space(3)))
typedef unsigned short bf16_t;
typedef short bf16x8 __attribute__((ext_vector_type(8)));
typedef short s16x4 __attribute__((ext_vector_type(4)));
typedef float f32x4 __attribute__((ext_vector_type(4)));
typedef float f32x16 __attribute__((ext_vector_type(16)));
typedef unsigned u32x4 __attribute__((ext_vector_type(4)));
typedef unsigned u32x2 __attribute__((ext_vector_type(2)));
using pg8::cvtpk_s; using pg8::bf_lo; using pg8::bf_hi; using pg8::silu_f;

constexpr int DM = 1024, SEQ = 16384, CTXL = 256, NLAT = 2 * SEQ, MROWS = NLAT + 2 * CTXL, DFF = 4096;
constexpr float EPS = 1e-6f;
constexpr size_t MiB = 1u << 20;
constexpr size_t WS_MOD = 0, WS_CTX = 1 * MiB, WS_WT = 4 * MiB, WS_H = 41 * MiB, WS_AB = 106 * MiB, WS_RSTD = 115 * MiB, WS_P = 118 * MiB, WS_O = 378 * MiB, WS_END = 508 * MiB;
constexpr size_t WT_A = WS_WT, WT_Z = WS_WT + 9 * MiB, WT_O = WS_WT + 13 * MiB, WT_1 = WS_WT + 17 * MiB, WT_2 = WS_WT + 25 * MiB;
constexpr size_t WS_QM = 313 * MiB, WS_KM = 378 * MiB, WS_OGLA = 443 * MiB, WS_AQ = 41 * MiB, WS_EL = 74 * MiB;
constexpr size_t WS_TP = 4 * MiB, WS_HALO = 378 * MiB;
constexpr size_t WS_QR = 216 * MiB, WS_KR = 281 * MiB, WS_VR = 298 * MiB;
constexpr int SKV = SEQ + CTXL;
constexpr int LDS_BYTES = 155648;
enum { OP_MOD, OP_PREP, OP_GEMM_IN, OP_DNSCAN, OP_DNREDO, OP_GEMM_Z, OP_GEMM_OUT, OP_NORM2, OP_FFN1, OP_FFN2, OP_GLAPREP, OP_GLASCAN, OP_GLAGATE, OP_QKROPE, OP_ATTN, OP_DNHALO, OP_DNCONV, OP_DNT };

struct Args { const float* in[25]; float* out; unsigned char* ws; int ph_lo, ph_hi; };

__device__ __forceinline__ float wave_sum(float v) {
#pragma unroll
    for (int o = 1; o < 64; o <<= 1) v += __shfl_xor(v, o);
    return v;
}
__device__ __forceinline__ float softplus_f(float x) { return x > 20.f ? x : log1pf(__expf(x)); }
__device__ __forceinline__ float logsigmoid_f(float x) { return fminf(x, 0.f) - log1pf(__expf(-fabsf(x))); }
__device__ __forceinline__ bf16_t f2bf(float f) { return (bf16_t)(cvtpk_s(f, 0.f) & 0xffffu); }
__device__ __forceinline__ float bf2f(bf16_t v) { return __builtin_bit_cast(float, (unsigned)v << 16); }

__device__ __forceinline__ void transpose_item(const float* W, int ldw, int c0, int ncols, int K, bf16_t* WT, int row_off, LAS float* scr, int item, int lane) {
    const int nblk = ncols / 32, kb = item / nblk, nb = item % nblk, k0 = 64 * kb, n0 = 32 * nb;
#pragma unroll 8
    for (int i = 0; i < 32; ++i) { const int kk = 2 * i + (lane >> 5); scr[kk * 33 + (lane & 31)] = W[(size_t)(k0 + kk) * ldw + c0 + n0 + (lane & 31)]; }
    asm volatile("s_waitcnt lgkmcnt(0)" ::: "memory");
    const int c = lane & 7;
#pragma unroll
    for (int j = 0; j < 4; ++j) { const int n = (lane >> 3) + 8 * j; const LAS float* s = scr + (8 * c) * 33 + n;
        u32x4 o; o.x = cvtpk_s(s[0 * 33], s[1 * 33]); o.y = cvtpk_s(s[2 * 33], s[3 * 33]); o.z = cvtpk_s(s[4 * 33], s[5 * 33]); o.w = cvtpk_s(s[6 * 33], s[7 * 33]);
        *(u32x4*)(WT + (size_t)(row_off + n0 + n) * K + k0 + 8 * c) = o; }
    asm volatile("s_waitcnt lgkmcnt(0)" ::: "memory");
}
__device__ __forceinline__ void transpose_mat(const float* W, int ldw, int c0, int ncols, int K, bf16_t* WT, int row_off, LAS float* scr, int gw, int NGW, int lane) {
    const int nitems = (K / 64) * (ncols / 32);
    for (int it = gw; it < nitems; it += NGW) transpose_item(W, ldw, c0, ncols, K, WT, row_off, scr, it, lane);
}
__device__ __forceinline__ void normmod_rows(const float* xl, const float* xc, const float* g, const float* modl, int sidx, bf16_t* H, int gw, int NGW, int lane) {
    for (int row = gw; row < MROWS; row += NGW) {
        const float* xr = row < NLAT ? xl + (size_t)row * DM : xc + (size_t)(row - NLAT) * DM;
        const int mi = row < SEQ ? 0 : (row < NLAT ? 1 : 2);
        const float* sh = modl + (size_t)mi * 6144 + (size_t)sidx * 1024; const float* sc = sh + 1024;
        f32x4 v[4]; float ss = 0.f;
#pragma unroll
        for (int j = 0; j < 4; ++j) { v[j] = *(const f32x4*)(xr + 4 * lane + 256 * j); ss += (v[j][0] * v[j][0] + v[j][1] * v[j][1]) + (v[j][2] * v[j][2] + v[j][3] * v[j][3]); }
        const float rinv = rsqrtf(wave_sum(ss) * (1.f / DM) + EPS);
#pragma unroll
        for (int j = 0; j < 4; ++j) { const int c = 4 * lane + 256 * j; const f32x4 gg = *(const f32x4*)(g + c), s1 = *(const f32x4*)(sc + c), s0 = *(const f32x4*)(sh + c);
            f32x4 y;
#pragma unroll
            for (int e = 0; e < 4; ++e) y[e] = v[j][e] * rinv * gg[e] * (1.f + s1[e]) + s0[e];
            u32x2 w; w.x = cvtpk_s(y[0], y[1]); w.y = cvtpk_s(y[2], y[3]); *(u32x2*)(H + (size_t)row * DM + c) = w; }
    }
}
#define BAR_LDS() do { asm volatile("s_waitcnt lgkmcnt(0)" ::: "memory"); __builtin_amdgcn_s_barrier(); asm volatile("" ::: "memory"); } while (0)
__device__ __forceinline__ int crow(int x, int h) { return (x & 3) + 8 * (x >> 2) + 4 * h; }
#define MFMA32(a, b, c) __builtin_amdgcn_mfma_f32_32x32x16_bf16((a), (b), (c), 0, 0, 0)
__device__ __forceinline__ bf16x8 frag_nat(const LAS bf16_t* img, int LD, int row, int ks, int h) { return *(const LAS bf16x8*)(img + row * LD + 16 * ks + 8 * h); }
__device__ __forceinline__ bf16x8 frag_perm(const LAS bf16_t* img, int LD, int row, int ks, int h) {
    const s16x4 lo = *(const LAS s16x4*)(img + row * LD + 16 * ks + 4 * h), hi = *(const LAS s16x4*)(img + row * LD + 16 * ks + 8 + 4 * h);
    return __builtin_shufflevector(lo, hi, 0, 1, 2, 3, 4, 5, 6, 7);
}
__device__ __forceinline__ s16x4 tr4(const LAS bf16_t* p) { return __builtin_bit_cast(s16x4, __builtin_amdgcn_ds_read_tr16_b64_v4i16((LAS s16x4*)p)); }
__device__ __forceinline__ bf16x8 frag_tr(const LAS bf16_t* img, int LD, int m0, int ks, int lane) {
    const int i16 = lane & 15, q = i16 >> 2, p = i16 & 3, blk = (lane >> 4) & 1, h = lane >> 5;
    const LAS bf16_t* a = img + (16 * ks + 4 * h + q) * LD + m0 + 16 * blk + 4 * p;
    const s16x4 lo = tr4(a), hi = tr4(a + 8 * LD);
    return __builtin_shufflevector(lo, hi, 0, 1, 2, 3, 4, 5, 6, 7);
}
__device__ __forceinline__ bf16x8 pack_step(const f32x16& x, int s) {
    u32x4 p; p.x = cvtpk_s(x[8 * s + 0], x[8 * s + 1]); p.y = cvtpk_s(x[8 * s + 2], x[8 * s + 3]); p.z = cvtpk_s(x[8 * s + 4], x[8 * s + 5]); p.w = cvtpk_s(x[8 * s + 6], x[8 * s + 7]);
    return __builtin_bit_cast(bf16x8, p);
}
__device__ __forceinline__ void dn_halo_phase(const bf16_t* P, bf16_t* HALO, int G) {
    const int tid = opaque_tid();
    for (size_t e = (size_t)blockIdx.x * 512 + tid; e < (size_t)520 * 4 * 512; e += (size_t)G * 512) {
        const int c = (int)(e & 511), j = (int)((e >> 9) & 3), rb = (int)(e >> 11);
        const int row = rb * 64 + (j < 2 ? j : 60 + j);
        ((u32x4*)(HALO + ((size_t)rb * 4 + j) * 4096))[c] = ((const u32x4*)(P + (size_t)row * 4096))[c];
    }
}
__device__ __forceinline__ void unpack8(const u32x4 v, float (&f)[8]) { f[0] = bf_lo(v.x); f[1] = bf_hi(v.x); f[2] = bf_lo(v.y); f[3] = bf_hi(v.y); f[4] = bf_lo(v.z); f[5] = bf_hi(v.z); f[6] = bf_lo(v.w); f[7] = bf_hi(v.w); }
__device__ __forceinline__ void dn_conv_phase(bf16_t* P, const bf16_t* HALO, const float* conv_w, int G) {
    const int tid = opaque_tid(), col0 = 8 * tid;
    float cw[8][5];
#pragma unroll
    for (int c = 0; c < 8; ++c)
#pragma unroll
        for (int tap = 0; tap < 5; ++tap) cw[c][tap] = conv_w[(size_t)(col0 + c) * 5 + tap];
    const int kind = col0 < 1024 ? 0 : (col0 < 2048 ? 1 : 2);
    for (int rb = blockIdx.x; rb < 520; rb += G) {
        const int cs = rb < 512 ? (rb & 255) : ((rb - 512) & 3); const bool sfirst = cs == 0, slast = rb < 512 ? cs == 255 : cs == 3;
        const u32x4 zero = (u32x4){0u, 0u, 0u, 0u};
        bf16_t* base = P + (size_t)rb * 64 * 4096 + col0;
        u32x4 w0 = sfirst ? zero : *(const u32x4*)(HALO + ((size_t)(rb - 1) * 4 + 2) * 4096 + col0);
        u32x4 w1 = sfirst ? zero : *(const u32x4*)(HALO + ((size_t)(rb - 1) * 4 + 3) * 4096 + col0);
        u32x4 w2 = *(const u32x4*)(base), w3 = *(const u32x4*)(base + 4096);
#pragma unroll 4
        for (int rr = 0; rr < 64; ++rr) {
            u32x4 w4;
            if (rr + 2 < 64) w4 = *(const u32x4*)(base + (size_t)(rr + 2) * 4096);
            else w4 = slast ? zero : *(const u32x4*)(HALO + ((size_t)(rb + 1) * 4 + (rr + 2 - 64)) * 4096 + col0);
            float x0[8], x1[8], x2[8], x3[8], x4[8], y[8];
            unpack8(w0, x0); unpack8(w1, x1); unpack8(w2, x2); unpack8(w3, x3); unpack8(w4, x4);
            float ss = 0.f;
#pragma unroll
            for (int c = 0; c < 8; ++c) { const float a = x0[c] * cw[c][0] + x1[c] * cw[c][1] + x2[c] * cw[c][2] + x3[c] * cw[c][3] + x4[c] * cw[c][4]; y[c] = silu_f(a); ss += y[c] * y[c]; }
            float sc = 1.f;
            if (kind < 2) { ss += __shfl_xor(ss, 1); ss += __shfl_xor(ss, 2); ss += __shfl_xor(ss, 4); ss += __shfl_xor(ss, 8); sc = rsqrtf(ss + EPS) * (kind == 0 ? 0.08838834764831845f : 1.f); }
            u32x4 o; o.x = cvtpk_s(y[0] * sc, y[1] * sc); o.y = cvtpk_s(y[2] * sc, y[3] * sc); o.z = cvtpk_s(y[4] * sc, y[5] * sc); o.w = cvtpk_s(y[6] * sc, y[7] * sc);
            *(u32x4*)(base + (size_t)rr * 4096) = o;
            w0 = w1; w1 = w2; w2 = w3; w3 = w4;
        }
    }
}
constexpr int DT_KB = 0, DT_R = 17408, DT_SC = 33792, DT_DIR = 34816;
template <int W> __device__ __forceinline__ void dn_solve(const LAS float* Mf, float (&t)[16], int lane) {
    const int j = 16 * W + (lane >> 2), q = lane & 3;
#pragma unroll
    for (int s = 0; s < 16; ++s) t[s] = 0.f;
#pragma unroll
    for (int i = 16 * W; i < 64; ++i) {
        float acc = 0.f;
#pragma unroll
        for (int s = 4 * W; s <= (i - 1) / 4 && i > 16 * W; ++s) acc += Mf[i * 64 + 4 * s + q] * t[s];
        acc += __shfl_xor(acc, 1); acc += __shfl_xor(acc, 2);
        const float val = (i == j ? 1.f : 0.f) - acc;
        if (q == (i & 3)) t[i >> 2] = val;
        asm volatile("" : "+v"(t[0]), "+v"(t[1]), "+v"(t[2]), "+v"(t[3]), "+v"(t[4]), "+v"(t[5]), "+v"(t[6]), "+v"(t[7]), "+v"(t[8]), "+v"(t[9]), "+v"(t[10]), "+v"(t[11]), "+v"(t[12]), "+v"(t[13]), "+v"(t[14]), "+v"(t[15]));
    }
}
__device__ __forceinline__ void dn_t_phase(LAS unsigned char* lds, const bf16_t* P, float* AB, bf16_t* TP, const float* a_log, const float* dt_bias, int G) {
    const int tid0 = opaque_tid(), hb = __builtin_amdgcn_readfirstlane(tid0 >> 8);
    for (int itb = blockIdx.x * 2; itb < 16640; itb += 2 * G) {
        const int it = itb + hb, dir = it & 1, vh = (it >> 1) & 15, rb = it >> 5, kh = vh >> 1;
        const int tq = opaque_tid(), t = tq & 255, w = __builtin_amdgcn_readfirstlane((tq >> 6) & 3), lane = tq & 63, r = lane & 31, h = lane >> 5;
        LAS unsigned char* base = lds + hb * DT_DIR;
        LAS bf16_t* Kb = (LAS bf16_t*)(base + DT_KB); LAS float* Mf = (LAS float*)(base + DT_R); LAS bf16_t* Tb = (LAS bf16_t*)(base + DT_R);
        LAS float* sc_beta = (LAS float*)(base + DT_SC); LAS float* sc_gc = sc_beta + 64;
        {
            const int i = t >> 2, ch0 = 32 * (t & 3), ip = dir ? 63 - i : i;
            const u32x4* src = (const u32x4*)(P + (size_t)(rb * 64 + i) * 4096 + 1024 + kh * 128 + ch0);
#pragma unroll
            for (int v = 0; v < 4; ++v) *(LAS u32x4*)(Kb + ip * 136 + ch0 + 8 * v) = src[v];
            if (t < 64) {
                const int ti = dir ? 63 - t : t; float* ab = AB + (size_t)(rb * 64 + ti) * 64;
                const float av = ab[dir * 16 + vh], bv = ab[32 + dir * 16 + vh];
                const float g = -__expf(a_log[dir * 16 + vh]) * softplus_f(av + dt_bias[dir * 16 + vh]), beta = 1.f / (1.f + __expf(-bv));
                float gc = g;
#pragma unroll
                for (int o = 1; o < 64; o <<= 1) { const float up = __shfl_up(gc, o); if (t >= o) gc += up; }
                sc_beta[t] = beta; sc_gc[t] = gc;
                ab[dir * 16 + vh] = gc; ab[32 + dir * 16 + vh] = beta;
            }
        }
        __syncthreads();
        const int ti = w >> 1, tj = w & 1;
        {
            f32x16 acc;
#pragma unroll
            for (int x = 0; x < 16; ++x) acc[x] = 0.f;
            if (!(ti == 0 && tj == 1)) {
#pragma unroll
                for (int ks = 0; ks < 8; ++ks) acc = MFMA32(frag_nat(Kb, 136, 32 * ti + r, ks, h), frag_nat(Kb, 136, 32 * tj + r, ks, h), acc);
            }
            const int j = 32 * tj + r; const float gj = sc_gc[j];
#pragma unroll
            for (int x = 0; x < 16; ++x) { const int i = 32 * ti + crow(x, h);
                Mf[i * 64 + j] = (i > j) ? sc_beta[i] * acc[x] * __expf(sc_gc[i] - gj) : 0.f; }
        }
        __syncthreads();
        float tc[16];
        if (w == 0) dn_solve<0>(Mf, tc, lane); else if (w == 1) dn_solve<1>(Mf, tc, lane); else if (w == 2) dn_solve<2>(Mf, tc, lane); else dn_solve<3>(Mf, tc, lane);
        __syncthreads();
        {
            const int j = 16 * w + (lane >> 2), q = lane & 3;
#pragma unroll
            for (int s = 0; s < 16; ++s) Tb[(4 * s + q) * 72 + j] = f2bf(tc[s]);
        }
        __syncthreads();
        {
            bf16_t* dst = TP + (size_t)it * 3072;
#pragma unroll
            for (int k2 = 0; k2 < 2; ++k2) { const int c = t + 256 * k2;
                if (c < 384) { const int blk = c >> 7, rowc = (c & 127) >> 2, cc = c & 3, br = blk ? 1 : 0, bc = blk == 2 ? 1 : 0;
                    *(u32x4*)(dst + c * 8) = *(const LAS u32x4*)(Tb + (32 * br + rowc) * 72 + 32 * bc + 8 * cc); } }
        }
        __syncthreads();
    }
}
constexpr int DN_KB = 0, DN_QB = 17408, DN_VB = 34816, DN_TB = 51200, DN_AB = 60416, DN_SC = 69632, DN_DIR = 71168;
__device__ __forceinline__ void dn_step_rb(int step, int dir, int b, int& rb, bool& first) {
    if (step < 4) { const int cidx = dir ? 3 - step : step; rb = 512 + b * 4 + cidx; first = step < 2; }
    else { const int c = step - 4; const int cidx = dir ? 255 - c : c; rb = b * 256 + cidx; first = c < 128; }
}
struct DnPre { u32x4 k4[4], q4[4], v4[4], t0, t1; float gc, beta; };
__device__ __forceinline__ void dn_prefetch(DnPre& p, const bf16_t* P, const float* AB, const bf16_t* TP, int rb, int dir, int vh, int kh, int t, int part) {
    const int i = t >> 2, ch0 = 32 * (t & 3);
    const bf16_t* prow = P + (size_t)(rb * 64 + i) * 4096;
    const u32x4* sk = (const u32x4*)(prow + 1024 + kh * 128 + ch0); const u32x4* sq = (const u32x4*)(prow + kh * 128 + ch0); const u32x4* sv = (const u32x4*)(prow + 2048 + vh * 128 + ch0);
    const bf16_t* tp = TP + (size_t)((rb * 16 + vh) * 2 + dir) * 3072;
    if (part & 1) {
#pragma unroll
        for (int v = 0; v < 4; ++v) { p.k4[v] = sk[v]; p.q4[v] = sq[v]; p.v4[v] = sv[v]; }
    }
    if (part & 2) {
        p.t0 = *(const u32x4*)(tp + t * 8); p.t1 = *(const u32x4*)(tp + (256 + (t & 127)) * 8);
        const int ti = dir ? 63 - (t & 63) : (t & 63); const float* ab = AB + (size_t)(rb * 64 + ti) * 64; p.gc = ab[dir * 16 + vh]; p.beta = ab[32 + dir * 16 + vh];
    }
}
__device__ __forceinline__ void dn_scan(LAS unsigned char* lds, const bf16_t* P, const float* AB, const bf16_t* TP, bf16_t* OB) {
    const int tid = opaque_tid(), dir = __builtin_amdgcn_readfirstlane(tid >> 8);
    for (int unit = blockIdx.x; unit < 32; unit += gridDim.x) {
        const int b = unit >> 4, vh = unit & 15, kh = vh >> 1;
        f32x16 S[4];
#pragma unroll
        for (int kt = 0; kt < 4; ++kt)
#pragma unroll
            for (int x = 0; x < 16; ++x) S[kt][x] = 0.f;
        DnPre pre;
        { int rb0; bool f0; dn_step_rb(0, dir, b, rb0, f0); dn_prefetch(pre, P, AB, TP, rb0, dir, vh, kh, tid & 255, 3); }
        __syncthreads();
        for (int step = 0; step < 260; ++step) {
            const int w = __builtin_amdgcn_readfirstlane((opaque_tid() >> 6) & 3);
            LAS unsigned char* base = lds + dir * DN_DIR;
            LAS bf16_t* Kb = (LAS bf16_t*)(base + DN_KB); LAS bf16_t* Qb = (LAS bf16_t*)(base + DN_QB); LAS bf16_t* Vb = (LAS bf16_t*)(base + DN_VB);
            LAS bf16_t* Tb = (LAS bf16_t*)(base + DN_TB); LAS bf16_t* Ab = (LAS bf16_t*)(base + DN_AB);
            LAS float* sc_beta = (LAS float*)(base + DN_SC); LAS float* sc_gc = sc_beta + 64; LAS float* sc_eg = sc_beta + 128; LAS float* sc_tail = sc_beta + 192; LAS float* sc_dl = sc_beta + 256;
            int rb; bool first; dn_step_rb(step, dir, b, rb, first);
            const int row_base = rb * 64;
            {
                const int tq_ = opaque_tid(), t = tq_ & 255;
                const int i = t >> 2, ch0 = 32 * (t & 3), ip = dir ? 63 - i : i;
#pragma unroll
                for (int v = 0; v < 4; ++v) { *(LAS u32x4*)(Kb + ip * 136 + ch0 + 8 * v) = pre.k4[v]; *(LAS u32x4*)(Qb + ip * 136 + ch0 + 8 * v) = pre.q4[v]; *(LAS u32x4*)(Vb + ip * 128 + ch0 + 8 * v) = pre.v4[v]; }
                { const int c = t, blk = c >> 7, rowc = (c & 127) >> 2, cc = c & 3, br = blk ? 1 : 0; *(LAS u32x4*)(Tb + (32 * br + rowc) * 72 + 8 * cc) = pre.t0; }
                if (t < 128) { const int rowc = t >> 2, cc = t & 3; *(LAS u32x4*)(Tb + (32 + rowc) * 72 + 32 + 8 * cc) = pre.t1; }
                if (t < 64) { const float gc = pre.gc, gl = __shfl(gc, 63); sc_beta[t] = pre.beta; sc_gc[t] = gc; sc_eg[t] = __expf(gc); sc_tail[t] = __expf(gl - gc); if (t == 0) sc_dl[0] = __expf(gl); }
            }
            BAR_LDS();
            {
                const int tq_ = opaque_tid(), lane = tq_ & 63, r = lane & 31, h = lane >> 5;
                const int ti = w >> 1, tj = w & 1;
                if (!(ti == 0 && tj == 1)) {
                    f32x16 qk;
#pragma unroll
                    for (int x = 0; x < 16; ++x) qk[x] = 0.f;
#pragma unroll
                    for (int ks = 0; ks < 8; ++ks) qk = MFMA32(frag_nat(Qb, 136, 32 * ti + r, ks, h), frag_nat(Kb, 136, 32 * tj + r, ks, h), qk);
                    const int jj = 32 * tj + r; const float gj = sc_gc[jj];
#pragma unroll
                    for (int x = 0; x < 16; ++x) { const int i = 32 * ti + crow(x, h);
                        Ab[i * 72 + jj] = f2bf((i >= jj) ? qk[x] * __expf(sc_gc[i] - gj) : 0.f); }
                }
            }
            BAR_LDS();
            if (step + 1 < 260) { int rbn; bool fn; dn_step_rb(step + 1, dir, b, rbn, fn); dn_prefetch(pre, P, AB, TP, rbn, dir, vh, kh, opaque_tid() & 255, 1); }
            __builtin_amdgcn_sched_barrier(0);
            {
                const int tq_ = opaque_tid(), lane = tq_ & 63, r = lane & 31, h = lane >> 5;
                f32x16 KS[2], QS[2];
#pragma unroll
                for (int mt = 0; mt < 2; ++mt)
#pragma unroll
                    for (int x = 0; x < 16; ++x) { KS[mt][x] = 0.f; QS[mt][x] = 0.f; }
#pragma unroll
                for (int ks = 0; ks < 8; ++ks) {
                    const bf16x8 sp = pack_step(S[ks >> 1], ks & 1);
#pragma unroll
                    for (int mt = 0; mt < 2; ++mt) { KS[mt] = MFMA32(frag_perm(Kb, 136, 32 * mt + r, ks, h), sp, KS[mt]); QS[mt] = MFMA32(frag_perm(Qb, 136, 32 * mt + r, ks, h), sp, QS[mt]); }
                    if (ks & 1) __builtin_amdgcn_sched_barrier(0);
                }
#pragma unroll
                for (int mt = 0; mt < 2; ++mt)
#pragma unroll
                    for (int x = 0; x < 16; ++x) { const int i = 32 * mt + crow(x, h);
                        KS[mt][x] = sc_beta[i] * (bf2f(Vb[i * 128 + 32 * w + r]) - sc_eg[i] * KS[mt][x]); }
                __builtin_amdgcn_sched_barrier(0);
                bf16x8 Xp[4];
#pragma unroll
                for (int ks = 0; ks < 4; ++ks) Xp[ks] = pack_step(KS[ks >> 1], ks & 1);
                f32x16 VN[2];
#pragma unroll
                for (int mt = 0; mt < 2; ++mt) {
#pragma unroll
                    for (int x = 0; x < 16; ++x) VN[mt][x] = 0.f;
#pragma unroll
                    for (int ks = 0; ks < 4; ++ks) if (ks < 2 * mt + 2) VN[mt] = MFMA32(frag_perm(Tb, 72, 32 * mt + r, ks, h), Xp[ks], VN[mt]);
                }
                __builtin_amdgcn_sched_barrier(0);
                if (step + 1 < 260) { int rbn; bool fn; dn_step_rb(step + 1, dir, b, rbn, fn); dn_prefetch(pre, P, AB, TP, rbn, dir, vh, kh, opaque_tid() & 255, 2); }
                __builtin_amdgcn_sched_barrier(0);
                bf16x8 VNp[4];
#pragma unroll
                for (int ks = 0; ks < 4; ++ks) VNp[ks] = pack_step(VN[ks >> 1], ks & 1);
#pragma unroll
                for (int mt = 0; mt < 2; ++mt) {
#pragma unroll
                    for (int x = 0; x < 16; ++x) QS[mt][x] *= sc_eg[32 * mt + crow(x, h)];
#pragma unroll
                    for (int ks = 0; ks < 4; ++ks) if (ks < 2 * mt + 2) QS[mt] = MFMA32(frag_perm(Ab, 72, 32 * mt + r, ks, h), VNp[ks], QS[mt]);
                }
                __builtin_amdgcn_sched_barrier(0);
#pragma unroll
                for (int mt = 0; mt < 2; ++mt)
#pragma unroll
                    for (int x = 0; x < 16; ++x) Vb[(32 * mt + crow(x, h)) * 128 + 32 * w + r] = f2bf(QS[mt][x]);
                __builtin_amdgcn_sched_barrier(0);
#pragma unroll
                for (int mt = 0; mt < 2; ++mt)
#pragma unroll
                    for (int x = 0; x < 16; ++x) VN[mt][x] *= sc_tail[32 * mt + crow(x, h)];
#pragma unroll
                for (int ks = 0; ks < 4; ++ks) VNp[ks] = pack_step(VN[ks >> 1], ks & 1);
                __builtin_amdgcn_sched_barrier(0);
                const float dl = sc_dl[0];
#pragma unroll
                for (int kt = 0; kt < 4; ++kt)
#pragma unroll
                    for (int x = 0; x < 16; ++x) S[kt][x] *= dl;
#pragma unroll
                for (int ks = 0; ks < 4; ++ks) {
#pragma unroll
                    for (int kt = 0; kt < 4; ++kt) S[kt] = MFMA32(frag_tr(Kb, 136, 32 * kt, ks, lane), VNp[ks], S[kt]);
                    __builtin_amdgcn_sched_barrier(0);
                }
                {
                    const int i_ = dir ? 63 - lane : lane;
                    u32x4* gp_ = (u32x4*)(OB + (size_t)(row_base + i_) * 2048 + vh * 128 + 32 * w);
#pragma unroll
                    for (int v = 0; v < 4; ++v) { u32x4 o = *(const LAS u32x4*)(Vb + lane * 128 + 32 * w + 8 * v);
                        if (!first) { const u32x4 e = gp_[v];
                            o.x = cvtpk_s(bf_lo(o.x) + bf_lo(e.x), bf_hi(o.x) + bf_hi(e.x)); o.y = cvtpk_s(bf_lo(o.y) + bf_lo(e.y), bf_hi(o.y) + bf_hi(e.y));
                            o.z = cvtpk_s(bf_lo(o.z) + bf_lo(e.z), bf_hi(o.z) + bf_hi(e.z)); o.w = cvtpk_s(bf_lo(o.w) + bf_lo(e.w), bf_hi(o.w) + bf_hi(e.w)); }
                        gp_[v] = o; }
                }
            }
            if (step == 1 || step == 131) asm volatile("s_waitcnt vmcnt(0)" ::: "memory");
            BAR_LDS();
        }
    }
}
constexpr int GP_QM = 0, GP_KM = 17408, GP_AB = 34816, GP_LOW = 44032, GP_TOT = 48128, GP_DIR = 49152;
__device__ __forceinline__ void gla_prep_phase(LAS unsigned char* lds, const bf16_t* P, const float* LOW, const float* gw2, const float* gb2, bf16_t* QM, bf16_t* KM, bf16_t* AQ, float* EL, int G) {
    const int tid0 = opaque_tid(), hb = __builtin_amdgcn_readfirstlane(tid0 >> 8);
    for (int itb = blockIdx.x * 2; itb < 4160; itb += 2 * G) {
        const int it = itb + hb, dir = it & 1, head = (it >> 1) & 3, rb = it >> 3;
        const int tq = opaque_tid(), t = tq & 255, w = __builtin_amdgcn_readfirstlane((tq >> 6) & 3), lane = tq & 63, r = lane & 31, h = lane >> 5;
        LAS unsigned char* base = lds + hb * GP_DIR;
        LAS bf16_t* Qm = (LAS bf16_t*)(base + GP_QM); LAS bf16_t* Km = (LAS bf16_t*)(base + GP_KM); LAS bf16_t* Ab = (LAS bf16_t*)(base + GP_AB);
        LAS float* lowS = (LAS float*)(base + GP_LOW); LAS float* tot = (LAS float*)(base + GP_TOT);
        *(LAS f32x4*)(lowS + 4 * t) = *(const f32x4*)(LOW + (size_t)(rb * 64 + (t >> 2)) * 32 + dir * 16 + 4 * (t & 3));
        const int dk = t & 127, half = t >> 7, col = head * 128 + dk;
        float w2c[16];
#pragma unroll
        for (int rr = 0; rr < 16; ++rr) w2c[rr] = gw2[(size_t)(dir * 16 + rr) * 512 + col];
        const float b2 = gb2[dir * 512 + col];
        __syncthreads();
        float bc[32]; float run = 0.f;
#pragma unroll
        for (int n = 0; n < 32; ++n) { const int ip = 32 * half + n, i = dir ? 63 - ip : ip; float s = b2;
#pragma unroll
            for (int rr = 0; rr < 16; ++rr) s += lowS[i * 16 + rr] * w2c[rr];
            run += logsigmoid_f(s) * (1.f / 16.f); bc[n] = run; }
        tot[half * 128 + dk] = run;
        __syncthreads();
        const float t0 = tot[dk], last = t0 + tot[128 + dk], off = half ? t0 : 0.f;
        if (half == 0) EL[(size_t)(dir * 520 + rb) * 512 + col] = last;
        {
            const int i0 = dir ? 63 - 32 * half : 32 * half; const long pstep = dir ? -3072 : 3072;
            const bf16_t* pp = P + (size_t)(rb * 64 + i0) * 3072 + col;
#pragma unroll
            for (int n = 0; n < 32; ++n) { const int ip = 32 * half + n; const float bcv = bc[n] + off;
                const float qv = bf2f(pp[0]), kv = bf2f(pp[512]); pp += pstep;
                Qm[ip * 136 + dk] = f2bf(qv * 0.08838834764831845f * __expf(bcv - last));
                Km[ip * 136 + dk] = f2bf(kv * __expf(last - bcv)); }
        }
        __syncthreads();
        {
            const int ti = w >> 1, tj = w & 1;
            f32x16 acc;
#pragma unroll
            for (int x = 0; x < 16; ++x) acc[x] = 0.f;
            if (!(ti == 0 && tj == 1)) {
#pragma unroll
                for (int ks = 0; ks < 8; ++ks) acc = MFMA32(frag_nat(Qm, 136, 32 * ti + r, ks, h), frag_nat(Km, 136, 32 * tj + r, ks, h), acc);
            }
            const int j = 32 * tj + r;
#pragma unroll
            for (int x = 0; x < 16; ++x) { const int i = 32 * ti + crow(x, h); Ab[i * 72 + j] = f2bf(i >= j ? acc[x] : 0.f); }
            const int row = t >> 2, ch0 = 32 * (t & 3);
            u32x4* dq = (u32x4*)(QM + ((size_t)dir * MROWS + rb * 64 + row) * 512 + head * 128 + ch0); u32x4* dkk = (u32x4*)(KM + ((size_t)dir * MROWS + rb * 64 + row) * 512 + head * 128 + ch0);
#pragma unroll
            for (int v = 0; v < 4; ++v) { dq[v] = *(const LAS u32x4*)(Qm + row * 136 + ch0 + 8 * v); dkk[v] = *(const LAS u32x4*)(Km + row * 136 + ch0 + 8 * v); }
        }
        __syncthreads();
        {
            bf16_t* dst = AQ + (size_t)it * 4096;
#pragma unroll
            for (int k2 = 0; k2 < 2; ++k2) { const int c = t + 256 * k2, row = c >> 3, cc = c & 7; *(u32x4*)(dst + c * 8) = *(const LAS u32x4*)(Ab + row * 72 + 8 * cc); }
        }
        __syncthreads();
    }
}
constexpr int GL_QM = 0, GL_KM = 17408, GL_VB = 34816, GL_AB = 52224, GL_EL = 61440, GL_DIR = 61952;
struct GlPre { u32x4 q4[4], k4[4], v4[4], a0, a1; float elv; };
__device__ __forceinline__ void gl_prefetch(GlPre& p, const bf16_t* P, const bf16_t* QM, const bf16_t* KM, const bf16_t* AQ, const float* EL, int rb, int dir, int head, int hf, int t) {
    const int i = t >> 2, ch0 = 32 * (t & 3);
    const u32x4* sq = (const u32x4*)(QM + ((size_t)dir * MROWS + rb * 64 + i) * 512 + head * 128 + ch0);
    const u32x4* sk = (const u32x4*)(KM + ((size_t)dir * MROWS + rb * 64 + i) * 512 + head * 128 + ch0);
    const u32x4* sv = (const u32x4*)(P + (size_t)(rb * 64 + i) * 3072 + 1024 + head * 256 + hf * 128 + ch0);
    const bf16_t* aq = AQ + (size_t)((rb * 4 + head) * 2 + dir) * 4096;
#pragma unroll
    for (int v = 0; v < 4; ++v) { p.q4[v] = sq[v]; p.k4[v] = sk[v]; p.v4[v] = sv[v]; }
    p.a0 = *(const u32x4*)(aq + t * 8); p.a1 = *(const u32x4*)(aq + (256 + t) * 8);
    p.elv = EL[(size_t)(dir * 520 + rb) * 512 + head * 128 + (t & 127)];
}
__device__ __forceinline__ void gla_scan(LAS unsigned char* lds, const bf16_t* P  , const bf16_t* QM, const bf16_t* KM, const bf16_t* AQ, const float* EL, bf16_t* OB  ) {
    const int tid = opaque_tid(), dir = __builtin_amdgcn_readfirstlane(tid >> 8);
    for (int unit = blockIdx.x; unit < 16; unit += gridDim.x) {
        const int b = unit >> 3, head = (unit >> 1) & 3, hf = unit & 1;
        f32x16 S[4];
#pragma unroll
        for (int kt = 0; kt < 4; ++kt)
#pragma unroll
            for (int x = 0; x < 16; ++x) S[kt][x] = 0.f;
        GlPre pre;
        { int rb0; bool f0; dn_step_rb(0, dir, b, rb0, f0); gl_prefetch(pre, P, QM, KM, AQ, EL, rb0, dir, head, hf, tid & 255); }
        __syncthreads();
        for (int step = 0; step < 260; ++step) {
            const int w = __builtin_amdgcn_readfirstlane((opaque_tid() >> 6) & 3);
            LAS unsigned char* base = lds + dir * GL_DIR;
            LAS bf16_t* Qm = (LAS bf16_t*)(base + GL_QM); LAS bf16_t* Km = (LAS bf16_t*)(base + GL_KM); LAS bf16_t* Vb = (LAS bf16_t*)(base + GL_VB); LAS bf16_t* Ab = (LAS bf16_t*)(base + GL_AB);
            LAS float* el = (LAS float*)(base + GL_EL);
            int rb; bool first; dn_step_rb(step, dir, b, rb, first);
            const int row_base = rb * 64;
            {
                const int tq_ = opaque_tid(), t = tq_ & 255;
                const int i = t >> 2, ch0 = 32 * (t & 3), ip = dir ? 63 - i : i;
#pragma unroll
                for (int v = 0; v < 4; ++v) { *(LAS u32x4*)(Qm + i * 136 + ch0 + 8 * v) = pre.q4[v]; *(LAS u32x4*)(Km + i * 136 + ch0 + 8 * v) = pre.k4[v]; *(LAS u32x4*)(Vb + ip * 136 + ch0 + 8 * v) = pre.v4[v]; }
                { const int c = t, row = c >> 3, cc = c & 7; *(LAS u32x4*)(Ab + row * 72 + 8 * cc) = pre.a0; }
                { const int c = 256 + t, row = c >> 3, cc = c & 7; *(LAS u32x4*)(Ab + row * 72 + 8 * cc) = pre.a1; }
                if (t < 128) el[t] = __expf(pre.elv);
            }
            BAR_LDS();
            if (step + 1 < 260) { int rbn; bool fn; dn_step_rb(step + 1, dir, b, rbn, fn); gl_prefetch(pre, P, QM, KM, AQ, EL, rbn, dir, head, hf, opaque_tid() & 255); }
            __builtin_amdgcn_sched_barrier(0);
            {
                const int tq_ = opaque_tid(), lane = tq_ & 63, r = lane & 31, h = lane >> 5;
#pragma unroll
                for (int kt = 0; kt < 4; ++kt)
#pragma unroll
                    for (int x = 0; x < 16; ++x) S[kt][x] *= el[32 * kt + crow(x, h)];
                bf16x8 Vf[4];
#pragma unroll
                for (int ks = 0; ks < 4; ++ks) Vf[ks] = frag_tr(Vb, 136, 32 * w, ks, lane);
                u32x4 eo[4];
                {
                    const int i_ = dir ? 63 - lane : lane;
                    const u32x4* gp_ = (const u32x4*)(OB + (size_t)(row_base + i_) * 1024 + head * 256 + hf * 128 + 32 * w);
                    if (!first) {
#pragma unroll
                        for (int v = 0; v < 4; ++v) eo[v] = gp_[v];
                    } else {
                        unsigned z0 = 0u; asm volatile("" : "+v"(z0));
#pragma unroll
                        for (int v = 0; v < 4; ++v) eo[v] = (u32x4){z0, z0, z0, z0};
                    }
                }
                f32x16 O[2];
#pragma unroll
                for (int mt = 0; mt < 2; ++mt) {
#pragma unroll
                    for (int x = 0; x < 16; ++x) O[mt][x] = 0.f;
#pragma unroll
                    for (int ks = 0; ks < 4; ++ks) if (ks < 2 * mt + 2) O[mt] = MFMA32(frag_perm(Ab, 72, 32 * mt + r, ks, h), Vf[ks], O[mt]);
                }
                __builtin_amdgcn_sched_barrier(0);
#pragma unroll
                for (int ks = 0; ks < 8; ++ks) {
                    const bf16x8 sp = pack_step(S[ks >> 1], ks & 1);
#pragma unroll
                    for (int mt = 0; mt < 2; ++mt) O[mt] = MFMA32(frag_perm(Qm, 136, 32 * mt + r, ks, h), sp, O[mt]);
                    if (ks & 1) __builtin_amdgcn_sched_barrier(0);
                }
#pragma unroll
                for (int mt = 0; mt < 2; ++mt)
#pragma unroll
                    for (int x = 0; x < 16; ++x) Vb[(32 * mt + crow(x, h)) * 136 + 32 * w + r] = f2bf(O[mt][x]);
                __builtin_amdgcn_sched_barrier(0);
#pragma unroll
                for (int ks = 0; ks < 4; ++ks) {
#pragma unroll
                    for (int kt = 0; kt < 4; ++kt) S[kt] = MFMA32(frag_tr(Km, 136, 32 * kt, ks, lane), Vf[ks], S[kt]);
                    __builtin_amdgcn_sched_barrier(0);
                }
                {
                    const int i_ = dir ? 63 - lane : lane;
                    u32x4* gp_ = (u32x4*)(OB + (size_t)(row_base + i_) * 1024 + head * 256 + hf * 128 + 32 * w);
#pragma unroll
                    for (int v = 0; v < 4; ++v) { u32x4 o = *(const LAS u32x4*)(Vb + lane * 136 + 32 * w + 8 * v); const u32x4 e = eo[v];
                        if (!first) {
                            o.x = cvtpk_s(bf_lo(o.x) + bf_lo(e.x), bf_hi(o.x) + bf_hi(e.x)); o.y = cvtpk_s(bf_lo(o.y) + bf_lo(e.y), bf_hi(o.y) + bf_hi(e.y));
                            o.z = cvtpk_s(bf_lo(o.z) + bf_lo(e.z), bf_hi(o.z) + bf_hi(e.z)); o.w = cvtpk_s(bf_lo(o.w) + bf_lo(e.w), bf_hi(o.w) + bf_hi(e.w)); }
                        gp_[v] = o; }
                }
            }
            if (step == 1 || step == 131) asm volatile("s_waitcnt vmcnt(0)" ::: "memory");
            BAR_LDS();
        }
    }
}
#define DUP_DN 0
#define DUP_GLA 0
#define DUP_ATT 0
#define DUP_GIN 0
#define DUP_FFN1 0
constexpr unsigned long long pack_ops(const int* ops, int n) { unsigned long long v = 0; for (int i = 0; i < n; ++i) v |= (unsigned long long)ops[i] << (5 * i); return v; }
struct OpList { unsigned long long code; int n; };
constexpr OpList make_list(int mix) {
    int ops[16] = {}; int n = 0;
    ops[n++] = OP_PREP; ops[n++] = OP_GEMM_IN; if (DUP_GIN) ops[n++] = OP_GEMM_IN;
    if (mix == 0) { ops[n++] = OP_DNHALO; ops[n++] = OP_DNCONV; ops[n++] = OP_DNT; ops[n++] = OP_DNSCAN; if (DUP_DN) ops[n++] = OP_DNSCAN; ops[n++] = OP_DNREDO; ops[n++] = OP_GEMM_Z; }
    else if (mix == 1) { ops[n++] = OP_GLAPREP; ops[n++] = OP_GLASCAN; if (DUP_GLA) ops[n++] = OP_GLASCAN; ops[n++] = OP_GLAGATE; }
    else { ops[n++] = OP_QKROPE; ops[n++] = OP_ATTN; if (DUP_ATT) ops[n++] = OP_ATTN; }
    ops[n++] = OP_GEMM_OUT; ops[n++] = OP_NORM2; ops[n++] = OP_FFN1; if (DUP_FFN1) ops[n++] = OP_FFN1; ops[n++] = OP_FFN2;
    return OpList{pack_ops(ops, n), n};
}
constexpr OpList L_DN = make_list(0), L_GL = make_list(1), L_AT = make_list(2);
constexpr int NPHASE = 1 + 2 * L_DN.n + L_GL.n + L_AT.n;
__device__ __forceinline__ void decode_phase(int ph, int& layer, int& op) {
    if (ph == 0) { layer = 0; op = OP_MOD; return; }
    int p = ph - 1;
    if (p < L_DN.n) { layer = 0; op = (int)((L_DN.code >> (5 * p)) & 31ull); return; } p -= L_DN.n;
    if (p < L_GL.n) { layer = 1; op = (int)((L_GL.code >> (5 * p)) & 31ull); return; } p -= L_GL.n;
    if (p < L_AT.n) { layer = 2; op = (int)((L_AT.code >> (5 * p)) & 31ull); return; } p -= L_AT.n;
    layer = 3; op = (int)((L_DN.code >> (5 * p)) & 31ull);
}

__global__ void __launch_bounds__(512, 2) mega(Args args) {
    extern __shared__ __attribute__((aligned(16))) unsigned char lds_raw[];
    LAS unsigned char* lds = (LAS unsigned char*)lds_raw;
    cg::grid_group grid = cg::this_grid();
    const int G = gridDim.x, NGW = G * 8;
    unsigned char* ws = args.ws;
    const float* x_in = args.in[0]; const float* c_in = args.in[1]; const float* ctx_in = args.in[2]; const float* cctx_in = args.in[3];
    const float* ada_w = args.in[4]; const float* ada_b = args.in[5]; const float* norm_mix_g = args.in[6]; const float* norm_ffn_g = args.in[7];
    const float* ffn_w1 = args.in[8]; const float* ffn_w2 = args.in[9];
    float* MOD = (float*)(ws + WS_MOD); float* CTXC = (float*)(ws + WS_CTX); bf16_t* H = (bf16_t*)(ws + WS_H); float* ABF = (float*)(ws + WS_AB); float* RSTD = (float*)(ws + WS_RSTD);
    bf16_t* PB = (bf16_t*)(ws + WS_P); float* out = args.out;

    for (int ph = args.ph_lo; ph < args.ph_hi; ++ph) {
        int layer, op; decode_phase(ph, layer, op);
        const int mix = layer % 3, slot = layer / 3;
        const float* modl = MOD + (size_t)layer * 3 * 6144;
        const float* xl = layer == 0 ? x_in : out; const float* xc = layer == 0 ? ctx_in : CTXC;
        if (op == OP_MOD) {
            const int tid = opaque_tid(), lane = tid & 63, wave = __builtin_amdgcn_readfirstlane(tid >> 6); const int gw = blockIdx.x * 8 + wave; (void)lane; (void)gw; (void)tid;
            LAS float* sl = (LAS float*)lds; LAS float* red = sl + 3 * 1024;
            for (int e = tid; e < 3 * 1024; e += 512) { const float v = e < 2048 ? c_in[e] : cctx_in[e - 2048]; sl[e] = silu_f(v); }
            __syncthreads();
            for (int item = blockIdx.x; item < 4 * 96; item += G) {
                const int ly = item / 96, col = (item % 96) * 64 + lane;
                const float* wp = ada_w + ((size_t)ly * 1024 + 128 * wave) * 6144 + col;
                float a0 = 0.f, a1 = 0.f, a2 = 0.f;
#pragma unroll 8
                for (int k = 0; k < 128; ++k) { const float wv = wp[(size_t)k * 6144]; const int kk = 128 * wave + k; a0 += sl[kk] * wv; a1 += sl[1024 + kk] * wv; a2 += sl[2048 + kk] * wv; }
                red[(wave * 3 + 0) * 64 + lane] = a0; red[(wave * 3 + 1) * 64 + lane] = a1; red[(wave * 3 + 2) * 64 + lane] = a2;
                __syncthreads();
                if (tid < 192) { const int m = tid >> 6; float s = ada_b[(size_t)ly * 6144 + col];
#pragma unroll
                    for (int w2 = 0; w2 < 8; ++w2) s += red[(w2 * 3 + m) * 64 + lane];
                    MOD[((size_t)ly * 3 + m) * 6144 + col] = s; }
                __syncthreads();
            }
        } else if (op == OP_PREP) {
            const int tid = opaque_tid(), lane = tid & 63, wave = __builtin_amdgcn_readfirstlane(tid >> 6); const int gw = blockIdx.x * 8 + wave; (void)lane; (void)gw; (void)tid;
            LAS float* scr = (LAS float*)(lds + wave * 16384);
            unsigned z0 = 0u; asm volatile("" : "+v"(z0)); const u32x4 zv = (u32x4){z0, z0, z0, z0};
            bf16_t* wtA = (bf16_t*)(ws + WT_A); bf16_t* wtZ = (bf16_t*)(ws + WT_Z); bf16_t* wtO = (bf16_t*)(ws + WT_O); bf16_t* wt1 = (bf16_t*)(ws + WT_1); bf16_t* wt2 = (bf16_t*)(ws + WT_2);
            if (mix == 0) {
                const float* w_in = args.in[10] + (size_t)slot * 1024 * 6208; const float* w_out = args.in[15] + (size_t)slot * 2048 * 1024;
                transpose_mat(w_in, 6208, 0, 4096, 1024, wtA, 0, scr, gw, NGW, lane);
                transpose_mat(w_in, 6208, 6144, 64, 1024, wtA, 4096, scr, gw, NGW, lane);
                for (size_t e = (size_t)blockIdx.x * 512 + tid; e < (size_t)192 * 1024 * 2 / 16; e += (size_t)G * 512) ((u32x4*)(wtA + (size_t)4160 * 1024))[e] = zv;
            } else if (mix == 1) {
                const float* w_in = args.in[16]; const float* w_out = args.in[20];
                transpose_mat(w_in, 3104, 0, 3104, 1024, wtA, 0, scr, gw, NGW, lane);
                for (size_t e = (size_t)blockIdx.x * 512 + tid; e < (size_t)224 * 1024 * 2 / 16; e += (size_t)G * 512) ((u32x4*)(wtA + (size_t)3104 * 1024))[e] = zv;
                transpose_mat(w_out, 1024, 0, 1024, 1024, wtO, 0, scr, gw, NGW, lane);
            } else {
                const float* w_in = args.in[21]; const float* w_out = args.in[24];
                transpose_mat(w_in, 1536, 0, 1536, 1024, wtA, 0, scr, gw, NGW, lane);
                transpose_mat(w_out, 1024, 0, 1024, 1024, wtO, 0, scr, gw, NGW, lane);
            }
            if (mix != 0) {
                transpose_mat(ffn_w1 + (size_t)layer * 1024 * 4096, 4096, 0, 4096, 1024, wt1, 0, scr, gw, NGW, lane);
                transpose_mat(ffn_w2 + (size_t)layer * 4096 * 1024, 1024, 0, 1024, 4096, wt2, 0, scr, gw, NGW, lane);
            }
            normmod_rows(xl, xc, norm_mix_g + (size_t)layer * 1024, modl, 0, H, gw, NGW, lane);
        } else if (op == OP_DNREDO) {
            const int tid = opaque_tid(), lane = tid & 63, wave = __builtin_amdgcn_readfirstlane(tid >> 6); const int gw = blockIdx.x * 8 + wave; (void)lane; (void)gw; (void)tid;
            LAS float* scr = (LAS float*)(lds + wave * 16384);
            const float* w_in = args.in[10] + (size_t)slot * 1024 * 6208; const float* w_out = args.in[15] + (size_t)slot * 2048 * 1024;
            transpose_mat(w_in, 6208, 4096, 2048, 1024, (bf16_t*)(ws + WT_Z), 0, scr, gw, NGW, lane);
            transpose_mat(w_out, 1024, 0, 1024, 2048, (bf16_t*)(ws + WT_O), 0, scr, gw, NGW, lane);
            transpose_mat(ffn_w1 + (size_t)layer * 1024 * 4096, 4096, 0, 4096, 1024, (bf16_t*)(ws + WT_1), 0, scr, gw, NGW, lane);
            transpose_mat(ffn_w2 + (size_t)layer * 4096 * 1024, 1024, 0, 1024, 4096, (bf16_t*)(ws + WT_2), 0, scr, gw, NGW, lane);
            normmod_rows(xl, xc, norm_mix_g + (size_t)layer * 1024, modl, 0, H, gw, NGW, lane);
            const bf16_t* OB = (const bf16_t*)(ws + WS_O);
            for (int row = gw; row < MROWS; row += NGW) {
                const u32x4* p = (const u32x4*)(OB + (size_t)row * 2048 + 32 * lane); float ss = 0.f;
#pragma unroll
                for (int v = 0; v < 4; ++v) { const u32x4 q = p[v]; const float a0 = bf_lo(q.x), a1 = bf_hi(q.x), a2 = bf_lo(q.y), a3 = bf_hi(q.y), a4 = bf_lo(q.z), a5 = bf_hi(q.z), a6 = bf_lo(q.w), a7 = bf_hi(q.w);
                    ss += (a0 * a0 + a1 * a1) + (a2 * a2 + a3 * a3) + (a4 * a4 + a5 * a5) + (a6 * a6 + a7 * a7); }
                ss += __shfl_xor(ss, 1); ss += __shfl_xor(ss, 2);
                if ((lane & 3) == 0) RSTD[(size_t)row * 16 + (lane >> 2)] = rsqrtf(ss * (1.f / 128.f) + EPS);
            }
        } else if (op == OP_DNHALO) {
            dn_halo_phase(PB, (bf16_t*)(ws + WS_HALO), G);
        } else if (op == OP_DNCONV) {
            dn_conv_phase(PB, (const bf16_t*)(ws + WS_HALO), args.in[11] + (size_t)slot * 4096 * 5, G);
        } else if (op == OP_DNT) {
            dn_t_phase(lds, PB, ABF, (bf16_t*)(ws + WS_TP), args.in[12] + (size_t)slot * 32, args.in[13] + (size_t)slot * 32, G);
        } else if (op == OP_NORM2) {
            const int tid = opaque_tid(), lane = tid & 63, wave = __builtin_amdgcn_readfirstlane(tid >> 6); const int gw = blockIdx.x * 8 + wave; (void)lane; (void)gw; (void)tid;
            normmod_rows(out, CTXC, norm_ffn_g + (size_t)layer * 1024, modl, 3, H, gw, NGW, lane);
        } else if (op == OP_GEMM_IN || op == OP_GEMM_Z || op == OP_GEMM_OUT || op == OP_FFN1 || op == OP_FFN2) {
            pg8::Gemm g; pg8::Epi E;
            E.mode = 0; E.O = PB; E.ldc = 4096; E.tail_pn = -1; E.F = ABF; E.ldf = 64; E.nf = 64; E.rstd = RSTD; E.ng = args.in[14] + (size_t)slot * 128;
            E.src_lat = xl; E.src_ctx = xc; E.dst_lat = out; E.dst_ctx = CTXC; E.mod = modl; E.gidx = 2;
            g.M = MROWS; g.A = H; g.K = 1024;
            bf16_t* OBUF = (bf16_t*)(ws + (mix == 1 ? WS_OGLA : WS_O));
            if (op == OP_GEMM_IN) {
                g.Bt = (const bf16_t*)(ws + WT_A);
                if (mix == 0) { g.N = 4352; E.ldc = 4096; E.tail_pn = 16; E.ldf = 64; E.nf = 64; }
                else if (mix == 1) { g.N = 3328; E.ldc = 3072; E.tail_pn = 12; E.ldf = 32; E.nf = 32; }
                else { g.N = 1536; E.ldc = 1536; }
            } else if (op == OP_GEMM_Z) {
                g.Bt = (const bf16_t*)(ws + WT_Z); g.N = 2048; E.mode = 2; E.O = OBUF; E.ldc = 2048;
            } else if (op == OP_GEMM_OUT) {
                g.A = OBUF; g.K = mix == 0 ? 2048 : 1024; g.Bt = (const bf16_t*)(ws + WT_O); g.N = 1024; E.mode = 3; E.gidx = 2;
            } else if (op == OP_FFN1) {
                g.Bt = (const bf16_t*)(ws + WT_1); g.N = 4096; E.mode = 1; E.ldc = 4096;
            } else {
                g.A = PB; g.K = 4096; g.Bt = (const bf16_t*)(ws + WT_2); g.N = 1024; E.mode = 3; E.gidx = 5; E.src_lat = out; E.src_ctx = CTXC;
            }
            pg8::StaticOrder S; S.init(g.M, g.N, G, (int)blockIdx.x);
#ifndef NO_GEMM
            pg8::gemm_phase<pg8::Epi, pg8::StaticOrder, true, true>(lds, g, S, E);
#endif
        } else if (op == OP_DNSCAN) {
#ifndef NO_DN
            dn_scan(lds, PB, ABF, (const bf16_t*)(ws + WS_TP), (bf16_t*)(ws + WS_O));
#endif
        } else if (op == OP_GLAPREP) {
            gla_prep_phase(lds, PB, ABF, args.in[17], args.in[18], (bf16_t*)(ws + WS_QM), (bf16_t*)(ws + WS_KM), (bf16_t*)(ws + WS_AQ), (float*)(ws + WS_EL), G);
        } else if (op == OP_GLASCAN) {
#ifndef NO_GLA
            gla_scan(lds, PB, (const bf16_t*)(ws + WS_QM), (const bf16_t*)(ws + WS_KM), (const bf16_t*)(ws + WS_AQ), (const float*)(ws + WS_EL), (bf16_t*)(ws + WS_OGLA));
#endif
        } else if (op == OP_GLAGATE) {
            const int tid = opaque_tid(), lane = tid & 63, wave = __builtin_amdgcn_readfirstlane(tid >> 6); const int gw = blockIdx.x * 8 + wave; (void)lane; (void)gw; (void)tid;
            bf16_t* OB = (bf16_t*)(ws + WS_OGLA); const float* ng = args.in[19];
            for (int row = gw; row < MROWS; row += NGW) {
                u32x4* p = (u32x4*)(OB + (size_t)row * 1024 + 16 * lane); const u32x4* gp = (const u32x4*)(PB + (size_t)row * 3072 + 2048 + 16 * lane);
                float o[16], z[16]; float ss = 0.f;
#pragma unroll
                for (int v = 0; v < 2; ++v) { const u32x4 q = p[v], gq = gp[v];
                    o[8 * v + 0] = bf_lo(q.x); o[8 * v + 1] = bf_hi(q.x); o[8 * v + 2] = bf_lo(q.y); o[8 * v + 3] = bf_hi(q.y); o[8 * v + 4] = bf_lo(q.z); o[8 * v + 5] = bf_hi(q.z); o[8 * v + 6] = bf_lo(q.w); o[8 * v + 7] = bf_hi(q.w);
                    z[8 * v + 0] = bf_lo(gq.x); z[8 * v + 1] = bf_hi(gq.x); z[8 * v + 2] = bf_lo(gq.y); z[8 * v + 3] = bf_hi(gq.y); z[8 * v + 4] = bf_lo(gq.z); z[8 * v + 5] = bf_hi(gq.z); z[8 * v + 6] = bf_lo(gq.w); z[8 * v + 7] = bf_hi(gq.w); }
#pragma unroll
                for (int e = 0; e < 16; ++e) ss += o[e] * o[e];
                ss += __shfl_xor(ss, 1); ss += __shfl_xor(ss, 2); ss += __shfl_xor(ss, 4); ss += __shfl_xor(ss, 8);
                const float rs = rsqrtf(ss * (1.f / 256.f) + EPS); const int cb = (16 * lane) & 255;
#pragma unroll
                for (int v = 0; v < 2; ++v) { float rr[8];
#pragma unroll
                    for (int e = 0; e < 8; ++e) rr[e] = o[8 * v + e] * rs * ng[cb + 8 * v + e] * silu_f(z[8 * v + e]);
                    u32x4 wv; wv.x = cvtpk_s(rr[0], rr[1]); wv.y = cvtpk_s(rr[2], rr[3]); wv.z = cvtpk_s(rr[4], rr[5]); wv.w = cvtpk_s(rr[6], rr[7]); p[v] = wv; }
            }
        } else if (op == OP_QKROPE) {
            const int tid = opaque_tid(), lane = tid & 63, wave = __builtin_amdgcn_readfirstlane(tid >> 6); const int gw = blockIdx.x * 8 + wave; (void)lane; (void)gw; (void)tid;
            bf16_t* QR = (bf16_t*)(ws + WS_QR); bf16_t* KR = (bf16_t*)(ws + WS_KR); bf16_t* VR = (bf16_t*)(ws + WS_VR);
            const float* qg = args.in[22]; const float* kg = args.in[23];
            const int hf = lane >> 5, j = lane & 31, e1 = 64 * hf + j, e2 = e1 + 32;
            const float inv_freq = exp2f(-(float)(2 * j) * (1.f / 64.f) * 13.287712379549449f);
            const float gq1 = qg[e1], gq2 = qg[e2], gk1 = kg[e1], gk2 = kg[e2];
            for (int row = gw; row < MROWS; row += NGW) {
                const bool lat = row < NLAT; const int b = lat ? row / SEQ : (row - NLAT) / CTXL; const int tpos = lat ? row % SEQ : (row - NLAT) % CTXL;
                float cs = 1.f, sn = 0.f;
                if (lat) { const float pos = (float)(hf == 0 ? tpos / 64 : tpos % 64); const float ang = pos * inv_freq; sn = sinf(ang); cs = cosf(ang); }
                const bf16_t* pr = PB + (size_t)row * 1536; const int kpos = lat ? tpos : SEQ + tpos;
#pragma unroll
                for (int hd = 0; hd < 10; ++hd) {
                    const float x1 = bf2f(pr[hd * 128 + e1]), x2 = bf2f(pr[hd * 128 + e2]);
                    const float rinv = rsqrtf(wave_sum(x1 * x1 + x2 * x2) * (1.f / 128.f) + EPS);
                    const float y1 = x1 * rinv * (hd < 8 ? gq1 : gk1), y2 = x2 * rinv * (hd < 8 ? gq2 : gk2);
                    const float o1 = y1 * cs - y2 * sn, o2 = y1 * sn + y2 * cs;
                    bf16_t* dst = hd < 8 ? QR + (size_t)row * 1024 + hd * 128 : KR + ((size_t)(b * 2 + (hd - 8)) * SKV + kpos) * 128;
                    dst[e1] = f2bf(o1); dst[e2] = f2bf(o2);
                }
#pragma unroll
                for (int kv = 0; kv < 2; ++kv) { bf16_t* dst = VR + ((size_t)(b * 2 + kv) * SKV + kpos) * 128; dst[e1] = pr[1280 + kv * 128 + e1]; dst[e2] = pr[1280 + kv * 128 + e2]; }
            }
        } else if (op == OP_ATTN) {
            const attn::bf16* QR = (const attn::bf16*)(ws + WS_QR); const attn::bf16* KR = (const attn::bf16*)(ws + WS_KR); const attn::bf16* VR = (const attn::bf16*)(ws + WS_VR);
            attn::bf16* OB = (attn::bf16*)(ws + WS_O);
            for (int u = blockIdx.x; u < 1024 + 16; u += G) {
                size_t qoff, koff; int seq;
                if (u < 1024) { const int pair = u >> 8, b = pair >> 1, kvh = pair & 1, hh = (u >> 6) & 3, qb = u & 63, head = kvh * 4 + hh;
                    qoff = ((size_t)b * SEQ + (size_t)qb * 256) * 1024 + head * 128; koff = (size_t)(b * 2 + kvh) * SKV * 128; seq = SKV; }
                else { const int jx = u - 1024, b = jx >> 3, head = jx & 7, kvh = head >> 2;
                    qoff = ((size_t)NLAT + (size_t)b * CTXL) * 1024 + head * 128; koff = ((size_t)(b * 2 + kvh) * SKV + SEQ) * 128; seq = CTXL; }
                __syncthreads();
#ifndef NO_ATT
                attn::attn_dense_body<attn::bf16>(QR + qoff, KR + koff, VR + koff, OB + qoff, seq, (char*)lds_raw);
#endif
            }
        }
        if (ph + 1 < args.ph_hi) grid.sync();
    }
}

#ifndef MK_MULTI
#define MK_MULTI 0
#endif
extern "C" void kernel_launch(void* const* d_in, const int* in_sizes, int n_in, void* d_out, int out_size, void* d_ws, size_t ws_size, hipStream_t stream) {
    static int grid = 0;
    if (grid == 0) {
        if (n_in != 25 || ws_size < WS_END) { fprintf(stderr, "kernel_launch: unexpected n_in %d / ws_size %zu (need %zu)\n", n_in, ws_size, (size_t)WS_END); grid = -1; return; }
        int dev = 0, cus = 0, per_cu = 0;
        hipGetDevice(&dev); hipDeviceGetAttribute(&cus, hipDeviceAttributeMultiprocessorCount, dev);
        if (hipFuncSetAttribute((const void*)mega, hipFuncAttributeMaxDynamicSharedMemorySize, LDS_BYTES) != hipSuccess) { fprintf(stderr, "kernel_launch: hipFuncSetAttribute failed\n"); grid = -1; return; }
        if (hipOccupancyMaxActiveBlocksPerMultiprocessor(&per_cu, (const void*)mega, 512, LDS_BYTES) != hipSuccess || per_cu < 1) { fprintf(stderr, "kernel_launch: occupancy query says %d\n", per_cu); per_cu = 1; }
        (void)hipGetLastError();
        grid = cus * 1;
    }
    if (grid < 0) return;
    Args a{};
    for (int i = 0; i < 25; ++i) a.in[i] = (const float*)d_in[i];
    a.out = (float*)d_out; a.ws = (unsigned char*)d_ws;
#if MK_MULTI
    for (int ph = 0; ph < NPHASE; ++ph) { a.ph_lo = ph; a.ph_hi = ph + 1; hipLaunchKernelGGL(mega, dim3(grid), dim3(512), LDS_BYTES, stream, a); }
#else
    a.ph_lo = 0; a.ph_hi = NPHASE;
    void* kargs[] = {&a};
    hipError_t e = hipLaunchCooperativeKernel((const void*)mega, dim3(grid), dim3(512), kargs, LDS_BYTES, stream);
    if (e != hipSuccess) fprintf(stderr, "cooperative launch failed: %s (grid %d)\n", hipGetErrorString(e), grid);
#endif
}
```

```cpp
#include <hip/hip_runtime.h>
#include <hip/hip_bf16.h>
#include <hip/hip_cooperative_groups.h>
#include <cstdio>
#include <cstdint>
namespace cg = cooperative_groups;
__device__ __forceinline__ int opaque_tid() { int t = threadIdx.x; asm volatile("" : "+v"(t)); return t; }
namespace pg8 {
#define PG8_LAS __attribute__((address_space(3)))
typedef unsigned short bf16_t;
typedef short bf16x8 __attribute__((ext_vector_type(8)));
typedef float f32x4 __attribute__((ext_vector_type(4)));
typedef unsigned u32x4 __attribute__((ext_vector_type(4)));
constexpr int BM = 256, BK = 64, HALF = 128, HTB = HALF * BK * 2  , STAGE_BYTES = 8 * HTB, NXCD = 8, WGM = 8;

__host__ __device__ __forceinline__ int lds_byte(int r, int c) { const int st = (r >> 4) * 2 + (c >> 5), rr = r & 15, cc = c & 31, ob = rr * 64 + cc * 2; return st * 1024 + (ob ^ (((ob >> 9) & 1) << 5)); }
__host__ __device__ __forceinline__ void stage_rc(int b, int& R, int& C) { const int st = b / 1024, sb = b % 1024, swz = sb ^ (((sb >> 9) & 1) << 5); R = (st >> 1) * 16 + swz / 64; C = (st & 1) * 32 + (swz % 64) / 2; }
__host__ __device__ __forceinline__ int perm32(int rho) { const int n = rho >> 4, i = rho & 15; return 8 * (i >> 2) + 4 * n + (i & 3); }

struct Unit { int pm, pn; };
struct Gemm { const bf16_t* A; const bf16_t* Bt; int M, N, K; };

struct StaticOrder {
    int nM, nN, nwg, G, c;
    __host__ __device__ void init(int M, int N, int G_, int c_) { nM = M / BM; nN = N / BM; nwg = nM * nN; G = G_; c = c_; }
    __host__ __device__ bool next(int i, Unit& u) const {
        const long L = (long)i * G + c; if (L >= nwg) return false;
        int wgid = (int)L; { const int q = nwg / NXCD, r = nwg % NXCD, xcd = wgid % NXCD, off = wgid / NXCD; wgid = (xcd < r ? xcd * (q + 1) : r * (q + 1) + (xcd - r) * q) + off; }
        const int nig = WGM * nN, gid = wgid / nig, fm = gid * WGM, gsz = (nM - fm) < WGM ? (nM - fm) : WGM;
        u.pm = fm + ((wgid % nig) % gsz); u.pn = (wgid % nig) / gsz; return true;
    }
    __device__ __forceinline__ void a_ready(const Unit&) const {}
    __device__ __forceinline__ void done(const Unit&) const {}
};

__device__ __forceinline__ unsigned cvt_pk_bf16(float lo, float hi) { unsigned r; asm volatile("v_cvt_pk_bf16_f32 %0, %1, %2" : "=v"(r) : "v"(lo), "v"(hi)); return r; }
typedef float f32x2 __attribute__((ext_vector_type(2)));
typedef float f32x2_t __attribute__((ext_vector_type(2))); typedef __bf16 bf16x2_t __attribute__((ext_vector_type(2)));
__device__ __forceinline__ unsigned cvtpk_s(float lo, float hi) { f32x2_t v = {lo, hi}; bf16x2_t b = __builtin_convertvector(v, bf16x2_t); return __builtin_bit_cast(unsigned, b); }
__device__ __forceinline__ float bf_lo(unsigned w) { return __builtin_bit_cast(float, w << 16); }
__device__ __forceinline__ float bf_hi(unsigned w) { return __builtin_bit_cast(float, w & 0xffff0000u); }
__device__ __forceinline__ float silu_f(float z) { return z / (1.f + __expf(-z)); }
struct Epi {
    static constexpr bool PERM = true, AFTER_DRAIN = false;
    int mode;
    bf16_t* O; int ldc;
    int tail_pn; float* F; int ldf, nf;
    const float* rstd; const float* ng;
    const float* src_lat; const float* src_ctx; float* dst_lat; float* dst_ctx; const float* mod; int gidx;
    __device__ __forceinline__ void operator()(const f32x4 (&acc)[2][2][4][2], const Unit& u, int wr, int wc, int fr, int fq) const {
        const int row0 = u.pm * BM + wr * 64 + fr; const int col0 = u.pn * BM + wc * 32 + 8 * fq;
        if (mode <= 1) {
            if (u.pn == tail_pn) {
                const int c0 = wc * 32 + 8 * fq;
#pragma unroll
                for (int ai = 0; ai < 2; ++ai)
#pragma unroll
                    for (int m = 0; m < 4; ++m)
#pragma unroll
                        for (int bj = 0; bj < 2; ++bj) { const int cc = c0 + bj * HALF;
                            if (cc < nf) { float* p = F + (size_t)(row0 + ai * HALF + m * 16) * ldf + cc; *(f32x4*)p = acc[ai][bj][m][0]; *(f32x4*)(p + 4) = acc[ai][bj][m][1]; } }
            } else {
#pragma unroll
                for (int ai = 0; ai < 2; ++ai)
#pragma unroll
                    for (int m = 0; m < 4; ++m) { bf16_t* rowp = O + (size_t)(row0 + ai * HALF + m * 16) * ldc + col0;
#pragma unroll
                        for (int bj = 0; bj < 2; ++bj) { f32x4 v0 = acc[ai][bj][m][0], v1 = acc[ai][bj][m][1];
                            if (mode == 1) {
#pragma unroll
                                for (int e = 0; e < 4; ++e) { float a = fmaxf(v0[e], 0.f), b = fmaxf(v1[e], 0.f); v0[e] = a * a; v1[e] = b * b; } }
                            u32x4 w; w.x = cvtpk_s(v0[0], v0[1]); w.y = cvtpk_s(v0[2], v0[3]); w.z = cvtpk_s(v1[0], v1[1]); w.w = cvtpk_s(v1[2], v1[3]);
                            *(u32x4*)(rowp + bj * HALF) = w; } }
            }
        } else if (mode == 2) {
            const f32x4 g0 = *(const f32x4*)(ng + (col0 & 127)), g1 = *(const f32x4*)(ng + (col0 & 127) + 4);
#pragma unroll
            for (int ai = 0; ai < 2; ++ai)
#pragma unroll
                for (int m = 0; m < 4; ++m) { const int row = row0 + ai * HALF + m * 16; bf16_t* rowp = O + (size_t)row * ldc + col0;
#pragma unroll
                    for (int bj = 0; bj < 2; ++bj) { const float rs = rstd[(size_t)row * 16 + ((col0 + bj * HALF) >> 7)];
                        const u32x4 ov = *(const u32x4*)(rowp + bj * HALF); const f32x4 z0 = acc[ai][bj][m][0], z1 = acc[ai][bj][m][1];
                        float r[8];
                        r[0] = bf_lo(ov.x) * rs * g0[0] * silu_f(z0[0]); r[1] = bf_hi(ov.x) * rs * g0[1] * silu_f(z0[1]);
                        r[2] = bf_lo(ov.y) * rs * g0[2] * silu_f(z0[2]); r[3] = bf_hi(ov.y) * rs * g0[3] * silu_f(z0[3]);
                        r[4] = bf_lo(ov.z) * rs * g1[0] * silu_f(z1[0]); r[5] = bf_hi(ov.z) * rs * g1[1] * silu_f(z1[1]);
                        r[6] = bf_lo(ov.w) * rs * g1[2] * silu_f(z1[2]); r[7] = bf_hi(ov.w) * rs * g1[3] * silu_f(z1[3]);
                        u32x4 w; w.x = cvtpk_s(r[0], r[1]); w.y = cvtpk_s(r[2], r[3]); w.z = cvtpk_s(r[4], r[5]); w.w = cvtpk_s(r[6], r[7]);
                        *(u32x4*)(rowp + bj * HALF) = w; } }
        } else {
            const int mi = u.pm < 64 ? 0 : (u.pm < 128 ? 1 : 2);
            const float* gate = mod + (size_t)mi * 6144 + (size_t)gidx * 1024;
            const bool lat = u.pm < 128;
            const float* sb = lat ? src_lat : src_ctx - (size_t)32768 * 1024; float* db = lat ? dst_lat : dst_ctx - (size_t)32768 * 1024;
#pragma unroll
            for (int bj = 0; bj < 2; ++bj)
#pragma unroll
                for (int n = 0; n < 2; ++n) { const int c = col0 + bj * HALF + 4 * n; const f32x4 gv = *(const f32x4*)(gate + c);
#pragma unroll
                    for (int ai = 0; ai < 2; ++ai)
#pragma unroll
                        for (int m = 0; m < 4; ++m) { const size_t off = (size_t)(row0 + ai * HALF + m * 16) * 1024 + c;
                            const f32x4 s = *(const f32x4*)(sb + off); *(f32x4*)(db + off) = s + gv * acc[ai][bj][m][n]; } }
        }
    }
};
template <class Epi, class Sched, bool ALIGN_EPI = false, bool SP2 = false>
__device__ __forceinline__ void gemm_phase(PG8_LAS unsigned char* lds, const Gemm g, const Sched& S, const Epi& E) {
    const int tid = opaque_tid(), wid = __builtin_amdgcn_readfirstlane(tid >> 6), lane = tid & 63, wr = wid >> 2, wc = wid & 3, fr = lane & 15, fq = lane >> 4;
    const int K = g.K, nt = K / BK;
    unsigned voffA[2], voffB[2];
#pragma unroll
    for (int i = 0; i < 2; ++i) { int R, C; stage_rc(tid * 16 + i * 8192, R, C); const int Rb = Epi::PERM ? ((R & ~31) + perm32(R & 31)) : R;
        voffA[i] = (unsigned)(R * K + C) * 2u; voffB[i] = (unsigned)(Rb * K + C) * 2u; }
    const size_t kstep = (size_t)(BK * 2);
    const size_t hstep = (size_t)HALF * K * 2;
    const size_t tstep = 2 * hstep;
    const unsigned ldsw = (unsigned)wid * 1024u;
    const int aoff = lds_byte(wr * 64 + fr, fq * 8), boff = lds_byte(wc * 32 + fr, fq * 8);
#define PG8_SA(b, h) (((b) * 2 + (h)) * HTB)
#define PG8_SB(b, h) ((4 + (b) * 2 + (h)) * HTB)
#define PG8_STAGE(bufoff, gbase, voff) do { _Pragma("unroll") for (int _i = 0; _i < 2; ++_i) \
        __builtin_amdgcn_global_load_lds((const unsigned*)((const char*)(gbase) + (voff)[_i]), (PG8_LAS unsigned*)(lds + (bufoff) + ldsw + _i * 8192), 16, 0, 0); } while (0)
#define PG8_LDA(dst, b, h) do { _Pragma("unroll") for (int m = 0; m < 4; ++m) _Pragma("unroll") for (int k = 0; k < 2; ++k) dst[m][k] = *(const PG8_LAS bf16x8*)(lds + PG8_SA(b, h) + aoff + m * 2048 + k * 1024); } while (0)
#define PG8_LDB(dst, b, h) do { _Pragma("unroll") for (int n = 0; n < 2; ++n) _Pragma("unroll") for (int k = 0; k < 2; ++k) dst[n][k] = *(const PG8_LAS bf16x8*)(lds + PG8_SB(b, h) + boff + n * 2048 + k * 1024); } while (0)
#define PG8_MMA(ai, bj, At, Bt) do { __builtin_amdgcn_s_setprio(1); _Pragma("unroll") for (int m = 0; m < 4; ++m) _Pragma("unroll") for (int n = 0; n < 2; ++n) _Pragma("unroll") for (int k = 0; k < 2; ++k) \
        acc[ai][bj][m][n] = __builtin_amdgcn_mfma_f32_16x16x32_bf16(Bt[n][k], At[m][k], acc[ai][bj][m][n], 0, 0, 0); __builtin_amdgcn_s_setprio(0); } while (0)
#define PG8_WAIT_V(n) asm volatile("s_waitcnt vmcnt(" #n ")" ::: "memory")
#define PG8_WAIT_L(n) asm volatile("s_waitcnt lgkmcnt(" #n ")" ::: "memory")
#define PG8_BAR __builtin_amdgcn_s_barrier()
#define PG8_SCHED __builtin_amdgcn_sched_barrier(0)
    Unit cur, nxt; int ui = 0;
    if (!S.next(0, cur)) return;
    f32x4 acc[2][2][4][2];
#pragma unroll
    for (int a = 0; a < 2; ++a)
#pragma unroll
        for (int b = 0; b < 2; ++b)
#pragma unroll
            for (int m = 0; m < 4; ++m)
#pragma unroll
                for (int n = 0; n < 2; ++n) acc[a][b][m][n] = (f32x4){0.f, 0.f, 0.f, 0.f};
    bf16x8 At[4][2], B0[2][2], B1[2][2];
    const char* cA = (const char*)g.A + (size_t)cur.pm * tstep; const char* cB = (const char*)g.Bt + (size_t)cur.pn * tstep;
    S.a_ready(cur);
    if constexpr (SP2) {
        PG8_STAGE(PG8_SB(0, 0), cB, voffB); PG8_STAGE(PG8_SB(0, 1), cB + hstep, voffB); PG8_STAGE(PG8_SA(0, 0), cA, voffA); PG8_STAGE(PG8_SA(0, 1), cA + hstep, voffA);
        if (wr == 1) PG8_BAR;
        PG8_WAIT_V(2); PG8_BAR;
        PG8_STAGE(PG8_SB(1, 0), cB + kstep, voffB); PG8_STAGE(PG8_SA(1, 0), cA + kstep, voffA); PG8_STAGE(PG8_SB(1, 1), cB + hstep + kstep, voffB);
        PG8_WAIT_V(6); PG8_BAR;
    } else {
        PG8_STAGE(PG8_SB(0, 0), cB, voffB); PG8_STAGE(PG8_SA(0, 0), cA, voffA); PG8_STAGE(PG8_SB(0, 1), cB + hstep, voffB); PG8_STAGE(PG8_SA(0, 1), cA + hstep, voffA);
        if (wr == 1) PG8_BAR;
        PG8_WAIT_V(4); PG8_BAR;
        PG8_STAGE(PG8_SB(1, 0), cB + kstep, voffB); PG8_STAGE(PG8_SA(1, 0), cA + kstep, voffA); PG8_STAGE(PG8_SB(1, 1), cB + hstep + kstep, voffB);
        PG8_WAIT_V(6); PG8_BAR;
    }
    for (;;) {
        const bool has_next = S.next(ui + 1, nxt);
        const char* nA = has_next ? (const char*)g.A + (size_t)nxt.pm * tstep : cA; const char* nB = has_next ? (const char*)g.Bt + (size_t)nxt.pn * tstep : cB;
        for (int t = 0; t < nt; t += 2) {
            const bool last = (t == nt - 2);
            const char* a1 = cA + (size_t)(t + 1) * kstep;
            const char* a2 = last ? nA : cA + (size_t)(t + 2) * kstep; const char* b2 = last ? nB : cB + (size_t)(t + 2) * kstep;
            const char* a3 = a2 + kstep; const char* b3 = b2 + kstep;
            if (last && has_next) S.a_ready(nxt);
            if constexpr (SP2) {
            PG8_LDB(B0, 0, 0); PG8_LDB(B1, 0, 1); PG8_SCHED; PG8_LDA(At, 0, 0); PG8_STAGE(PG8_SA(1, 1), a1 + hstep, voffA);
            PG8_WAIT_V(8); PG8_WAIT_L(0); PG8_BAR; PG8_MMA(0, 0, At, B0); PG8_MMA(0, 1, At, B1); PG8_BAR; PG8_SCHED;
            PG8_LDA(At, 0, 1); PG8_STAGE(PG8_SB(0, 0), b2, voffB); PG8_STAGE(PG8_SB(0, 1), b2 + hstep, voffB); PG8_STAGE(PG8_SA(0, 0), a2, voffA);
            PG8_WAIT_V(8); PG8_WAIT_L(0); PG8_BAR; PG8_MMA(1, 0, At, B0); PG8_MMA(1, 1, At, B1); PG8_BAR; PG8_SCHED;
            PG8_LDB(B0, 1, 0); PG8_LDB(B1, 1, 1); PG8_SCHED; PG8_LDA(At, 1, 0); PG8_STAGE(PG8_SA(0, 1), a2 + hstep, voffA);
            PG8_WAIT_V(8); PG8_WAIT_L(0); PG8_BAR; PG8_MMA(0, 0, At, B0); PG8_MMA(0, 1, At, B1); PG8_BAR; PG8_SCHED;
            PG8_LDA(At, 1, 1); PG8_STAGE(PG8_SB(1, 0), b3, voffB); PG8_STAGE(PG8_SB(1, 1), b3 + hstep, voffB); PG8_STAGE(PG8_SA(1, 0), a3, voffA);
            PG8_WAIT_V(8); PG8_WAIT_L(0); PG8_BAR; PG8_MMA(1, 0, At, B0); PG8_MMA(1, 1, At, B1); PG8_BAR; PG8_SCHED;
            } else {
            PG8_LDB(B0, 0, 0); PG8_SCHED; PG8_LDA(At, 0, 0); PG8_STAGE(PG8_SA(1, 1), a1 + hstep, voffA);
            PG8_WAIT_L(8); PG8_BAR; PG8_WAIT_L(0); PG8_MMA(0, 0, At, B0); PG8_BAR; PG8_SCHED;
            PG8_LDB(B1, 0, 1); PG8_STAGE(PG8_SB(0, 0), b2, voffB);
            PG8_BAR; PG8_WAIT_L(0); PG8_MMA(0, 1, At, B1); PG8_BAR;
            PG8_LDA(At, 0, 1); PG8_STAGE(PG8_SA(0, 0), a2, voffA);
            PG8_BAR; PG8_WAIT_L(0); PG8_MMA(1, 0, At, B0); PG8_BAR; PG8_SCHED;
            PG8_STAGE(PG8_SB(0, 1), b2 + hstep, voffB);
            PG8_WAIT_V(6); PG8_BAR; PG8_MMA(1, 1, At, B1); PG8_BAR;
            PG8_LDB(B0, 1, 0); PG8_SCHED; PG8_LDA(At, 1, 0); PG8_STAGE(PG8_SA(0, 1), a2 + hstep, voffA);
            PG8_WAIT_L(8); PG8_BAR; PG8_WAIT_L(0); PG8_MMA(0, 0, At, B0); PG8_BAR; PG8_SCHED;
            PG8_LDB(B1, 1, 1); PG8_STAGE(PG8_SB(1, 0), b3, voffB);
            PG8_BAR; PG8_WAIT_L(0); PG8_MMA(0, 1, At, B1); PG8_BAR;
            PG8_LDA(At, 1, 1); PG8_STAGE(PG8_SA(1, 0), a3, voffA);
            PG8_BAR; PG8_WAIT_L(0); PG8_MMA(1, 0, At, B0); PG8_BAR; PG8_SCHED;
            PG8_STAGE(PG8_SB(1, 1), b3 + hstep, voffB);
            PG8_WAIT_V(6); PG8_BAR; PG8_MMA(1, 1, At, B1); PG8_BAR;
            }
        }
        if constexpr (ALIGN_EPI) { if (wr == 0) PG8_BAR; }
        if constexpr (!Epi::AFTER_DRAIN) { E(acc, cur, wr, wc, fr, fq); S.done(cur); }
        if (!has_next) break;
#pragma unroll
        for (int a = 0; a < 2; ++a)
#pragma unroll
            for (int b = 0; b < 2; ++b)
#pragma unroll
                for (int m = 0; m < 4; ++m)
#pragma unroll
                    for (int n = 0; n < 2; ++n) acc[a][b][m][n] = (f32x4){0.f, 0.f, 0.f, 0.f};
        cur = nxt; cA = nA; cB = nB; ++ui;
        if constexpr (ALIGN_EPI) { if (wr == 1) PG8_BAR; }
    }
    PG8_WAIT_V(0);
    if constexpr (!ALIGN_EPI) { if (wr == 0) PG8_BAR; }
    PG8_BAR;
    if constexpr (Epi::AFTER_DRAIN) { E.fused(acc, cur, wr, wc, fr, fq, lds, wid, lane); S.done(cur); }
#undef PG8_SA
#undef PG8_SB
#undef PG8_STAGE
#undef PG8_LDA
#undef PG8_LDB
#undef PG8_MMA
#undef PG8_WAIT_V
#undef PG8_WAIT_L
#undef PG8_BAR
#undef PG8_SCHED
}
}
namespace attn {
using bf16 = __hip_bfloat16;
constexpr int   D = 128, NW = 8, QBLK = 32, KVBLK = 64;
constexpr float SCALE = 0.088388347648318440f;
constexpr float THR = 8.f;
constexpr int SDEPTH = 2;
constexpr int LDQ = 1024, LDK = 128, LDO = 1024;
constexpr size_t SHM_V = KVBLK * D * 2, SHM_K = KVBLK * D * 2, SHM_ATTN = 2 * SHM_V + 2 * SHM_K + NW * 64 * 4;
using bf16x8 = __attribute__((ext_vector_type(8))) short;
using s16x4  = __attribute__((ext_vector_type(4))) short;
using f32x16 = __attribute__((ext_vector_type(16))) float;
using f32x8  = __attribute__((ext_vector_type(8))) float;
using u32x4  = __attribute__((ext_vector_type(4))) unsigned;
#define KSWZ(row, colB) ((row) * 256 + ((colB) ^ (((row) & 7) << 4)))
#define SBAR() __builtin_amdgcn_sched_barrier(0)
__device__ __forceinline__ int crow(int r, int hi) { return (r & 3) + 8 * (r >> 2) + 4 * hi; }
__device__ __forceinline__ unsigned cvtpk(float lo, float hi) {
  unsigned r; asm volatile("v_cvt_pk_bf16_f32 %0, %1, %2" : "=v"(r) : "v"(lo), "v"(hi)); return r;
}
template <typename TIn> struct Stage;
template <> struct Stage<bf16>  { using T = bf16x8;
  __device__ static __forceinline__ T ld8(const bf16* p) { return *reinterpret_cast<const bf16x8*>(p); }
  __device__ static __forceinline__ bf16x8 tobf(T x) { return x; } };
template <> struct Stage<float> { using T = f32x8;
  __device__ static __forceinline__ T ld8(const float* p) { return *reinterpret_cast<const f32x8*>(p); }
  __device__ static __forceinline__ bf16x8 tobf(T x) {
    u32x4 w = {cvtpk(x[0], x[1]), cvtpk(x[2], x[3]), cvtpk(x[4], x[5]), cvtpk(x[6], x[7])}; return *reinterpret_cast<bf16x8*>(&w); } };

__device__ __forceinline__ void partialSM(f32x16& p0, f32x16& p1, float& m_reg, float& mn, float& alpha) {
  constexpr float C = SCALE * 1.4426950408889634f;
  float pmax = p0[0]; for (int r = 1; r < 16; ++r) pmax = fmaxf(pmax, p0[r]); for (int r = 0; r < 16; ++r) pmax = fmaxf(pmax, p1[r]);
  { auto rr = __builtin_amdgcn_permlane32_swap(__float_as_uint(pmax), __float_as_uint(pmax), false, false);
    pmax = fmaxf(__uint_as_float(rr[0]), __uint_as_float(rr[1])); }
  if (__builtin_expect(__all(pmax - m_reg <= THR / SCALE), 1)) { mn = m_reg; alpha = 1.f; }
  else { mn = fmaxf(m_reg, pmax); alpha = __builtin_amdgcn_exp2f((m_reg - mn) * C); m_reg = mn; }
  float mnC = -mn * C;
  for (int r = 0; r < 16; ++r) p0[r] = fmaf(p0[r], C, mnC); for (int r = 0; r < 16; ++r) p1[r] = fmaf(p1[r], C, mnC);
  for (int r = 0; r < 16; ++r) p0[r] = __builtin_amdgcn_exp2f(p0[r]);
}
__device__ __forceinline__ void finishSM(f32x16& p0, f32x16& p1, float alpha, float& l_reg, bf16x8& pa0, bf16x8& pa1, bf16x8& pa2, bf16x8& pa3) {
  for (int r = 0; r < 16; ++r) p1[r] = __builtin_amdgcn_exp2f(p1[r]);
  float ps = 0; for (int r = 0; r < 16; ++r) ps += p0[r]; for (int r = 0; r < 16; ++r) ps += p1[r];
  { auto rr = __builtin_amdgcn_permlane32_swap(__float_as_uint(ps), __float_as_uint(ps), false, false);
    ps = __uint_as_float(rr[0]) + __uint_as_float(rr[1]); }
  l_reg = l_reg * alpha + ps;
#define PK4(P, BASE, OUT) do { unsigned a0 = cvtpk(P[BASE + 0], P[BASE + 1]), a1 = cvtpk(P[BASE + 2], P[BASE + 3]);   \
    unsigned b0 = cvtpk(P[BASE + 4], P[BASE + 5]), b1 = cvtpk(P[BASE + 6], P[BASE + 7]);                              \
    auto r0 = __builtin_amdgcn_permlane32_swap(a0, b0, false, false); auto r1 = __builtin_amdgcn_permlane32_swap(a1, b1, false, false); \
    u32x4 w = {r0[0], r1[0], r0[1], r1[1]}; OUT = *reinterpret_cast<bf16x8*>(&w); } while (0)
  PK4(p0, 0, pa0); PK4(p0, 8, pa1); PK4(p1, 0, pa2); PK4(p1, 8, pa3);
#undef PK4
}
__device__ __forceinline__ void qkt(f32x16& p0, f32x16& p1, const bf16* Ks, const bf16x8* qr, int r32, int hi) {
  p0 = f32x16{}; p1 = f32x16{};
  for (int d0 = 0; d0 < 8; ++d0) { int cb = (d0 * 16 + hi * 8) * 2;
    bf16x8 b0 = *reinterpret_cast<const bf16x8*>((const char*)Ks + KSWZ(r32, cb));
    bf16x8 b1 = *reinterpret_cast<const bf16x8*>((const char*)Ks + KSWZ(32 + r32, cb));
    p0 = __builtin_amdgcn_mfma_f32_32x32x16_bf16(b0, qr[d0], p0, 0, 0, 0);
    p1 = __builtin_amdgcn_mfma_f32_32x32x16_bf16(b1, qr[d0], p1, 0, 0, 0); }
}
__device__ __forceinline__ int v_st(int k, int c) { const int kk = (k & ~0xC) | ((k & 4) << 1) | ((k & 8) >> 1); return ((kk >> 3) * 4 + (c >> 5)) * 512 + ((kk & 7) * 32 + (c & 31)) * 2; }
__device__ __forceinline__ int v_rd_base(int lane) { return ((lane & 3) << 3) | (((lane >> 2) & 3) << 6) | (((lane >> 4) & 1) << 5) | (((lane >> 5) & 1) << 8); }
constexpr int v_rd_off(int d0, int ks, int half) { return d0 * 512 + ks * 4096 + half * 2048; }
template <int OFF> __device__ __forceinline__ s16x4 tr_read(int vb) {
  s16x4 r; asm volatile("ds_read_b64_tr_b16 %0, %1 offset:%2" : "=&v"(r) : "v"(vb), "i"(OFF) : "memory"); return r;
}
template <int D0> __device__ __forceinline__ void pv_one(f32x16& od, int vb, bf16x8 pa0, bf16x8 pa1, bf16x8 pa2, bf16x8 pa3) {
  const s16x4 l0 = tr_read<v_rd_off(D0, 0, 0)>(vb), h0 = tr_read<v_rd_off(D0, 0, 1)>(vb), l1 = tr_read<v_rd_off(D0, 1, 0)>(vb), h1 = tr_read<v_rd_off(D0, 1, 1)>(vb);
  const s16x4 l2 = tr_read<v_rd_off(D0, 2, 0)>(vb), h2 = tr_read<v_rd_off(D0, 2, 1)>(vb), l3 = tr_read<v_rd_off(D0, 3, 0)>(vb), h3 = tr_read<v_rd_off(D0, 3, 1)>(vb);
  asm volatile("s_waitcnt lgkmcnt(0)" ::: "memory"); SBAR();
#define PK(L, H) (bf16x8){L[0], L[1], L[2], L[3], H[0], H[1], H[2], H[3]}
  od = __builtin_amdgcn_mfma_f32_32x32x16_bf16(pa0, PK(l0, h0), od, 0, 0, 0);
  od = __builtin_amdgcn_mfma_f32_32x32x16_bf16(pa1, PK(l1, h1), od, 0, 0, 0);
  od = __builtin_amdgcn_mfma_f32_32x32x16_bf16(pa2, PK(l2, h2), od, 0, 0, 0);
  od = __builtin_amdgcn_mfma_f32_32x32x16_bf16(pa3, PK(l3, h3), od, 0, 0, 0);
#undef PK
}
__device__ __forceinline__ void pv_d0(f32x16* o, int vb, bf16x8 pa0, bf16x8 pa1, bf16x8 pa2, bf16x8 pa3) {
  pv_one<0>(o[0], vb, pa0, pa1, pa2, pa3); pv_one<1>(o[1], vb, pa0, pa1, pa2, pa3); pv_one<2>(o[2], vb, pa0, pa1, pa2, pa3); pv_one<3>(o[3], vb, pa0, pa1, pa2, pa3);
}

template <typename TQ>
__device__ __forceinline__ void attn_dense_body(const TQ* __restrict__ Qb, const bf16* __restrict__ Kh, const bf16* __restrict__ Vh,
                                                bf16* __restrict__ Ob, int seq, char* lds) {
  using St = Stage<bf16>; using SQ = Stage<TQ>;
  const int tid = opaque_tid(), wid = tid >> 6, lane = tid & 63, r32 = lane & 31, hi = lane >> 5;
  bf16* V_lds = (bf16*)lds; bf16* K_lds = (bf16*)(lds + 2 * SHM_V);
  float* ws = (float*)(lds + 2 * SHM_V + 2 * SHM_K) + wid * 64; float* li_l = ws; float* al_l = ws + 32;
  float m_reg = -1e30f, l_reg = 0; f32x16 o[4] = {}; bf16x8 qr[8];
  const TQ* Qw = Qb + (long)(wid * QBLK + r32) * LDQ + hi * 8;
#pragma unroll
  for (int d0 = 0; d0 < 8; ++d0) qr[d0] = SQ::tobf(SQ::ld8(Qw + d0 * 16));
  const int sr = tid >> 4, sc = (tid & 15) * 8, vst0 = v_st(sr, sc), vst1 = v_st(32 + sr, sc);
  const int vb0 = (int)(uintptr_t)V_lds + v_rd_base(lane);
  struct { typename St::T vs0, vs1, ks0, ks1; } sr_[SDEPTH];
#define SLOAD(i, k0) do { sr_[i].vs0 = St::ld8(&Vh[(long)((k0) + sr) * LDK + sc]); sr_[i].vs1 = St::ld8(&Vh[(long)((k0) + 32 + sr) * LDK + sc]); \
    sr_[i].ks0 = St::ld8(&Kh[(long)((k0) + sr) * LDK + sc]); sr_[i].ks1 = St::ld8(&Kh[(long)((k0) + 32 + sr) * LDK + sc]); } while (0)
#define SWRITE(b, i) do { *(bf16x8*)((char*)V_lds + (b) * SHM_V + vst0) = St::tobf(sr_[i].vs0);          \
    *(bf16x8*)((char*)V_lds + (b) * SHM_V + vst1) = St::tobf(sr_[i].vs1); int kc = sc * 2;               \
    *(bf16x8*)((char*)K_lds + (b) * SHM_K + KSWZ(sr, kc)) = St::tobf(sr_[i].ks0);                       \
    *(bf16x8*)((char*)K_lds + (b) * SHM_K + KSWZ(32 + sr, kc)) = St::tobf(sr_[i].ks1); } while (0)
#define SWAIT() do { if constexpr (SDEPTH == 2) asm volatile("s_waitcnt vmcnt(4)" ::: "memory"); else asm volatile("s_waitcnt vmcnt(0)" ::: "memory"); } while (0)
#define RESC(a) do { if (__any((a) < 1.f)) { if (hi == 0) al_l[r32] = (a); asm volatile("s_waitcnt lgkmcnt(0)" ::: "memory"); \
    for (int d = 0; d < 4; ++d) for (int r = 0; r < 16; ++r) o[d][r] *= al_l[crow(r, hi)]; } } while (0)
  f32x16 pA0, pA1, pB0, pB1; float mnA, mnB, alA, alB; bf16x8 pa0, pa1, pa2, pa3; const int NT = seq / KVBLK;
  constexpr int SE = 0, SO = SDEPTH - 1;
  SLOAD(SE, 0); asm volatile("s_waitcnt vmcnt(0)" ::: "memory"); SWRITE(0, SE); __syncthreads();
  qkt(pA0, pA1, K_lds, qr, r32, hi); partialSM(pA0, pA1, m_reg, mnA, alA);
  SLOAD(SO, KVBLK); if constexpr (SDEPTH == 2) { if (2 < NT) SLOAD(SE, 2 * KVBLK); }
  SWAIT(); SWRITE(1, SO); __syncthreads();
  for (int j = 1; j + 1 < NT; j += 2) {
    SBAR(); qkt(pB0, pB1, (bf16*)((char*)K_lds + SHM_K), qr, r32, hi);
    finishSM(pA0, pA1, alA, l_reg, pa0, pa1, pa2, pa3); SBAR();
    SLOAD(SO, (j + SDEPTH) * KVBLK); SBAR();
    pv_d0(o, vb0, pa0, pa1, pa2, pa3); partialSM(pB0, pB1, m_reg, mnB, alB);
    __syncthreads(); SWAIT(); SWRITE(0, SE);
    RESC(alB); __syncthreads();
    SBAR(); qkt(pA0, pA1, K_lds, qr, r32, hi);
    finishSM(pB0, pB1, alB, l_reg, pa0, pa1, pa2, pa3); SBAR();
    if (SDEPTH == 1 || j + 3 < NT) SLOAD(SE, (j + 1 + SDEPTH) * KVBLK); SBAR();
    pv_d0(o, vb0 + (int)SHM_V, pa0, pa1, pa2, pa3); partialSM(pA0, pA1, m_reg, mnA, alA);
    __syncthreads(); SWAIT(); SWRITE(1, SO);
    RESC(alA); __syncthreads();
  }
  SBAR(); qkt(pB0, pB1, (bf16*)((char*)K_lds + SHM_K), qr, r32, hi);
  finishSM(pA0, pA1, alA, l_reg, pa0, pa1, pa2, pa3); SBAR();
  pv_d0(o, vb0, pa0, pa1, pa2, pa3); partialSM(pB0, pB1, m_reg, mnB, alB);
  __syncthreads(); RESC(alB);
  finishSM(pB0, pB1, alB, l_reg, pa0, pa1, pa2, pa3); SBAR();
  pv_d0(o, vb0 + (int)SHM_V, pa0, pa1, pa2, pa3);
  if (hi == 0) li_l[r32] = l_reg; asm volatile("s_waitcnt lgkmcnt(0)" ::: "memory");
  float rli[16];
#pragma unroll
  for (int r = 0; r < 16; ++r) rli[r] = __builtin_amdgcn_rcpf(li_l[crow(r, hi)]);
  bf16* Ow = Ob + (long)(wid * QBLK) * LDO;
#pragma unroll
  for (int r = 0; r < 16; ++r) { int orow = crow(r, hi);
    for (int d0 = 0; d0 < 4; ++d0) Ow[(long)orow * LDO + d0 * 32 + r32] = __float2bfloat16(o[d0][r] * rli[r]); }
#undef SLOAD
#undef SWRITE
#undef SWAIT
#undef RESC
}

}
#define LAS __attribute__((address_space(3)))
typedef unsigned short bf16_t;
typedef short bf16x8 __attribute__((ext_vector_type(8)));
typedef short s16x4 __attribute__((ext_vector_type(4)));
typedef float f32x4 __attribute__((ext_vector_type(4)));
typedef float f32x16 __attribute__((ext_vector_type(16)));
typedef unsigned u32x4 __attribute__((ext_vector_type(4)));
typedef unsigned u32x2 __attribute__((ext_vector_type(2)));
using pg8::cvtpk_s; using pg8::bf_lo; using pg8::bf_hi; using pg8::silu_f;

constexpr int DM = 1024, SEQ = 16384, CTXL = 256, NLAT = 2 * SEQ, MROWS = NLAT + 2 * CTXL, DFF = 4096;
constexpr float EPS = 1e-6f;
constexpr size_t MiB = 1u << 20;
constexpr size_t WS_MOD = 0, WS_CTX = 1 * MiB, WS_WT = 4 * MiB, WS_H = 41 * MiB, WS_AB = 106 * MiB, WS_RSTD = 115 * MiB, WS_P = 118 * MiB, WS_O = 378 * MiB, WS_END = 508 * MiB;
constexpr size_t WT_A = WS_WT, WT_Z = WS_WT + 9 * MiB, WT_O = WS_WT + 13 * MiB, WT_1 = WS_WT + 17 * MiB, WT_2 = WS_WT + 25 * MiB;
constexpr size_t WS_QM = 313 * MiB, WS_KM = 378 * MiB, WS_OGLA = 443 * MiB, WS_AQ = 41 * MiB, WS_EL = 74 * MiB;
constexpr size_t WS_TP = 4 * MiB, WS_HALO = 378 * MiB;
constexpr size_t WS_QR = 216 * MiB, WS_KR = 281 * MiB, WS_VR = 298 * MiB;
constexpr int SKV = SEQ + CTXL;
constexpr int LDS_BYTES = 155648;
enum { OP_MOD, OP_PREP, OP_GEMM_IN, OP_DNSCAN, OP_DNREDO, OP_GEMM_Z, OP_GEMM_OUT, OP_NORM2, OP_FFN1, OP_FFN2, OP_GLAPREP, OP_GLASCAN, OP_GLAGATE, OP_QKROPE, OP_ATTN, OP_DNHALO, OP_DNCONV, OP_DNT };

struct Args { const float* in[25]; float* out; unsigned char* ws; int ph_lo, ph_hi; };

__device__ __forceinline__ float wave_sum(float v) {
#pragma unroll
    for (int o = 1; o < 64; o <<= 1) v += __shfl_xor(v, o);
    return v;
}
__device__ __forceinline__ float softplus_f(float x) { return x > 20.f ? x : log1pf(__expf(x)); }
__device__ __forceinline__ float logsigmoid_f(float x) { return fminf(x, 0.f) - log1pf(__expf(-fabsf(x))); }
__device__ __forceinline__ bf16_t f2bf(float f) { return (bf16_t)(cvtpk_s(f, 0.f) & 0xffffu); }
__device__ __forceinline__ float bf2f(bf16_t v) { return __builtin_bit_cast(float, (unsigned)v << 16); }

__device__ __forceinline__ void transpose_item(const float* W, int ldw, int c0, int ncols, int K, bf16_t* WT, int row_off, LAS float* scr, int item, int lane) {
    const int nblk = ncols / 32, kb = item / nblk, nb = item % nblk, k0 = 64 * kb, n0 = 32 * nb;
#pragma unroll 8
    for (int i = 0; i < 32; ++i) { const int kk = 2 * i + (lane >> 5); scr[kk * 33 + (lane & 31)] = W[(size_t)(k0 + kk) * ldw + c0 + n0 + (lane & 31)]; }
    asm volatile("s_waitcnt lgkmcnt(0)" ::: "memory");
    const int c = lane & 7;
#pragma unroll
    for (int j = 0; j < 4; ++j) { const int n = (lane >> 3) + 8 * j; const LAS float* s = scr + (8 * c) * 33 + n;
        u32x4 o; o.x = cvtpk_s(s[0 * 33], s[1 * 33]); o.y = cvtpk_s(s[2 * 33], s[3 * 33]); o.z = cvtpk_s(s[4 * 33], s[5 * 33]); o.w = cvtpk_s(s[6 * 33], s[7 * 33]);
        *(u32x4*)(WT + (size_t)(row_off + n0 + n) * K + k0 + 8 * c) = o; }
    asm volatile("s_waitcnt lgkmcnt(0)" ::: "memory");
}
__device__ __forceinline__ void transpose_mat(const float* W, int ldw, int c0, int ncols, int K, bf16_t* WT, int row_off, LAS float* scr, int gw, int NGW, int lane) {
    const int nitems = (K / 64) * (ncols / 32);
    for (int it = gw; it < nitems; it += NGW) transpose_item(W, ldw, c0, ncols, K, WT, row_off, scr, it, lane);
}
__device__ __forceinline__ void normmod_rows(const float* xl, const float* xc, const float* g, const float* modl, int sidx, bf16_t* H, int gw, int NGW, int lane) {
    for (int row = gw; row < MROWS; row += NGW) {
        const float* xr = row < NLAT ? xl + (size_t)row * DM : xc + (size_t)(row - NLAT) * DM;
        const int mi = row < SEQ ? 0 : (row < NLAT ? 1 : 2);
        const float* sh = modl + (size_t)mi * 6144 + (size_t)sidx * 1024; const float* sc = sh + 1024;
        f32x4 v[4]; float ss = 0.f;
#pragma unroll
        for (int j = 0; j < 4; ++j) { v[j] = *(const f32x4*)(xr + 4 * lane + 256 * j); ss += (v[j][0] * v[j][0] + v[j][1] * v[j][1]) + (v[j][2] * v[j][2] + v[j][3] * v[j][3]); }
        const float rinv = rsqrtf(wave_sum(ss) * (1.f / DM) + EPS);
#pragma unroll
        for (int j = 0; j < 4; ++j) { const int c = 4 * lane + 256 * j; const f32x4 gg = *(const f32x4*)(g + c), s1 = *(const f32x4*)(sc + c), s0 = *(const f32x4*)(sh + c);
            f32x4 y;
#pragma unroll
            for (int e = 0; e < 4; ++e) y[e] = v[j][e] * rinv * gg[e] * (1.f + s1[e]) + s0[e];
            u32x2 w; w.x = cvtpk_s(y[0], y[1]); w.y = cvtpk_s(y[2], y[3]); *(u32x2*)(H + (size_t)row * DM + c) = w; }
    }
}
#define BAR_LDS() do { asm volatile("s_waitcnt lgkmcnt(0)" ::: "memory"); __builtin_amdgcn_s_barrier(); asm volatile("" ::: "memory"); } while (0)
__device__ __forceinline__ int crow(int x, int h) { return (x & 3) + 8 * (x >> 2) + 4 * h; }
#define MFMA32(a, b, c) __builtin_amdgcn_mfma_f32_32x32x16_bf16((a), (b), (c), 0, 0, 0)
__device__ __forceinline__ bf16x8 frag_nat(const LAS bf16_t* img, int LD, int row, int ks, int h) { return *(const LAS bf16x8*)(img + row * LD + 16 * ks + 8 * h); }
__device__ __forceinline__ bf16x8 frag_perm(const LAS bf16_t* img, int LD, int row, int ks, int h) {
    const s16x4 lo = *(const LAS s16x4*)(img + row * LD + 16 * ks + 4 * h), hi = *(const LAS s16x4*)(img + row * LD + 16 * ks + 8 + 4 * h);
    return __builtin_shufflevector(lo, hi, 0, 1, 2, 3, 4, 5, 6, 7);
}
__device__ __forceinline__ s16x4 tr4(const LAS bf16_t* p) { return __builtin_bit_cast(s16x4, __builtin_amdgcn_ds_read_tr16_b64_v4i16((LAS s16x4*)p)); }
__device__ __forceinline__ bf16x8 frag_tr(const LAS bf16_t* img, int LD, int m0, int ks, int lane) {
    const int i16 = lane & 15, q = i16 >> 2, p = i16 & 3, blk = (lane >> 4) & 1, h = lane >> 5;
    const LAS bf16_t* a = img + (16 * ks + 4 * h + q) * LD + m0 + 16 * blk + 4 * p;
    const s16x4 lo = tr4(a), hi = tr4(a + 8 * LD);
    return __builtin_shufflevector(lo, hi, 0, 1, 2, 3, 4, 5, 6, 7);
}
__device__ __forceinline__ bf16x8 pack_step(const f32x16& x, int s) {
    u32x4 p; p.x = cvtpk_s(x[8 * s + 0], x[8 * s + 1]); p.y = cvtpk_s(x[8 * s + 2], x[8 * s + 3]); p.z = cvtpk_s(x[8 * s + 4], x[8 * s + 5]); p.w = cvtpk_s(x[8 * s + 6], x[8 * s + 7]);
    return __builtin_bit_cast(bf16x8, p);
}
__device__ __forceinline__ void dn_halo_phase(const bf16_t* P, bf16_t* HALO, int G) {
    const int tid = opaque_tid();
    for (size_t e = (size_t)blockIdx.x * 512 + tid; e < (size_t)520 * 4 * 512; e += (size_t)G * 512) {
        const int c = (int)(e & 511), j = (int)((e >> 9) & 3), rb = (int)(e >> 11);
        const int row = rb * 64 + (j < 2 ? j : 60 + j);
        ((u32x4*)(HALO + ((size_t)rb * 4 + j) * 4096))[c] = ((const u32x4*)(P + (size_t)row * 4096))[c];
    }
}
__device__ __forceinline__ void unpack8(const u32x4 v, float (&f)[8]) { f[0] = bf_lo(v.x); f[1] = bf_hi(v.x); f[2] = bf_lo(v.y); f[3] = bf_hi(v.y); f[4] = bf_lo(v.z); f[5] = bf_hi(v.z); f[6] = bf_lo(v.w); f[7] = bf_hi(v.w); }
__device__ __forceinline__ void dn_conv_phase(bf16_t* P, const bf16_t* HALO, const float* conv_w, int G) {
    const int tid = opaque_tid(), col0 = 8 * tid;
    float cw[8][5];
#pragma unroll
    for (int c = 0; c < 8; ++c)
#pragma unroll
        for (int tap = 0; tap < 5; ++tap) cw[c][tap] = conv_w[(size_t)(col0 + c) * 5 + tap];
    const int kind = col0 < 1024 ? 0 : (col0 < 2048 ? 1 : 2);
    for (int rb = blockIdx.x; rb < 520; rb += G) {
        const int cs = rb < 512 ? (rb & 255) : ((rb - 512) & 3); const bool sfirst = cs == 0, slast = rb < 512 ? cs == 255 : cs == 3;
        const u32x4 zero = (u32x4){0u, 0u, 0u, 0u};
        bf16_t* base = P + (size_t)rb * 64 * 4096 + col0;
        u32x4 w0 = sfirst ? zero : *(const u32x4*)(HALO + ((size_t)(rb - 1) * 4 + 2) * 4096 + col0);
        u32x4 w1 = sfirst ? zero : *(const u32x4*)(HALO + ((size_t)(rb - 1) * 4 + 3) * 4096 + col0);
        u32x4 w2 = *(const u32x4*)(base), w3 = *(const u32x4*)(base + 4096);
#pragma unroll 4
        for (int rr = 0; rr < 64; ++rr) {
            u32x4 w4;
            if (rr + 2 < 64) w4 = *(const u32x4*)(base + (size_t)(rr + 2) * 4096);
            else w4 = slast ? zero : *(const u32x4*)(HALO + ((size_t)(rb + 1) * 4 + (rr + 2 - 64)) * 4096 + col0);
            float x0[8], x1[8], x2[8], x3[8], x4[8], y[8];
            unpack8(w0, x0); unpack8(w1, x1); unpack8(w2, x2); unpack8(w3, x3); unpack8(w4, x4);
            float ss = 0.f;
#pragma unroll
            for (int c = 0; c < 8; ++c) { const float a = x0[c] * cw[c][0] + x1[c] * cw[c][1] + x2[c] * cw[c][2] + x3[c] * cw[c][3] + x4[c] * cw[c][4]; y[c] = silu_f(a); ss += y[c] * y[c]; }
            float sc = 1.f;
            if (kind < 2) { ss += __shfl_xor(ss, 1); ss += __shfl_xor(ss, 2); ss += __shfl_xor(ss, 4); ss += __shfl_xor(ss, 8); sc = rsqrtf(ss + EPS) * (kind == 0 ? 0.08838834764831845f : 1.f); }
            u32x4 o; o.x = cvtpk_s(y[0] * sc, y[1] * sc); o.y = cvtpk_s(y[2] * sc, y[3] * sc); o.z = cvtpk_s(y[4] * sc, y[5] * sc); o.w = cvtpk_s(y[6] * sc, y[7] * sc);
            *(u32x4*)(base + (size_t)rr * 4096) = o;
            w0 = w1; w1 = w2; w2 = w3; w3 = w4;
        }
    }
}
constexpr int DT_KB = 0, DT_R = 17408, DT_SC = 33792, DT_DIR = 34816;
template <int W> __device__ __forceinline__ void dn_solve(const LAS float* Mf, float (&t)[16], int lane) {
    const int j = 16 * W + (lane >> 2), q = lane & 3;
#pragma unroll
    for (int s = 0; s < 16; ++s) t[s] = 0.f;
#pragma unroll
    for (int i = 16 * W; i < 64; ++i) {
        float acc = 0.f;
#pragma unroll
        for (int s = 4 * W; s <= (i - 1) / 4 && i > 16 * W; ++s) acc += Mf[i * 64 + 4 * s + q] * t[s];
        acc += __shfl_xor(acc, 1); acc += __shfl_xor(acc, 2);
        const float val = (i == j ? 1.f : 0.f) - acc;
        if (q == (i & 3)) t[i >> 2] = val;
        asm volatile("" : "+v"(t[0]), "+v"(t[1]), "+v"(t[2]), "+v"(t[3]), "+v"(t[4]), "+v"(t[5]), "+v"(t[6]), "+v"(t[7]), "+v"(t[8]), "+v"(t[9]), "+v"(t[10]), "+v"(t[11]), "+v"(t[12]), "+v"(t[13]), "+v"(t[14]), "+v"(t[15]));
    }
}
__device__ __forceinline__ void dn_t_phase(LAS unsigned char* lds, const bf16_t* P, float* AB, bf16_t* TP, const float* a_log, const float* dt_bias, int G) {
    const int tid0 = opaque_tid(), hb = __builtin_amdgcn_readfirstlane(tid0 >> 8);
    for (int itb = blockIdx.x * 2; itb < 16640; itb += 2 * G) {
        const int it = itb + hb, dir = it & 1, vh = (it >> 1) & 15, rb = it >> 5, kh = vh >> 1;
        const int tq = opaque_tid(), t = tq & 255, w = __builtin_amdgcn_readfirstlane((tq >> 6) & 3), lane = tq & 63, r = lane & 31, h = lane >> 5;
        LAS unsigned char* base = lds + hb * DT_DIR;
        LAS bf16_t* Kb = (LAS bf16_t*)(base + DT_KB); LAS float* Mf = (LAS float*)(base + DT_R); LAS bf16_t* Tb = (LAS bf16_t*)(base + DT_R);
        LAS float* sc_beta = (LAS float*)(base + DT_SC); LAS float* sc_gc = sc_beta + 64;
        {
            const int r0 = t >> 4, c8 = 8 * (t & 15);
#pragma unroll
            for (int v = 0; v < 4; ++v) { const int i = r0 + 16 * v, ip = dir ? 63 - i : i;
                *(LAS u32x4*)(Kb + ip * 136 + c8) = *(const u32x4*)(P + (size_t)(rb * 64 + i) * 4096 + 1024 + kh * 128 + c8); }
            if (t < 64) {
                const int ti = dir ? 63 - t : t; float* ab = AB + (size_t)(rb * 64 + ti) * 64;
                const float av = ab[dir * 16 + vh], bv = ab[32 + dir * 16 + vh];
                const float g = -__expf(a_log[dir * 16 + vh]) * softplus_f(av + dt_bias[dir * 16 + vh]), beta = 1.f / (1.f + __expf(-bv));
                float gc = g;
#pragma unroll
                for (int o = 1; o < 64; o <<= 1) { const float up = __shfl_up(gc, o); if (t >= o) gc += up; }
                sc_beta[t] = beta; sc_gc[t] = gc;
                ab[dir * 16 + vh] = gc; ab[32 + dir * 16 + vh] = beta;
            }
        }
        __syncthreads();
        const int ti = w >> 1, tj = w & 1;
        {
            f32x16 acc;
#pragma unroll
            for (int x = 0; x < 16; ++x) acc[x] = 0.f;
            if (!(ti == 0 && tj == 1)) {
#pragma unroll
                for (int ks = 0; ks < 8; ++ks) acc = MFMA32(frag_nat(Kb, 136, 32 * ti + r, ks, h), frag_nat(Kb, 136, 32 * tj + r, ks, h), acc);
            }
            const int j = 32 * tj + r; const float gj = sc_gc[j];
#pragma unroll
            for (int x = 0; x < 16; ++x) { const int i = 32 * ti + crow(x, h);
                Mf[i * 64 + j] = (i > j) ? sc_beta[i] * acc[x] * __expf(sc_gc[i] - gj) : 0.f; }
        }
        __syncthreads();
        float tc[16];
        if (w == 0) dn_solve<0>(Mf, tc, lane); else if (w == 1) dn_solve<1>(Mf, tc, lane); else if (w == 2) dn_solve<2>(Mf, tc, lane); else dn_solve<3>(Mf, tc, lane);
        __syncthreads();
        {
            const int j = 16 * w + (lane >> 2), q = lane & 3;
#pragma unroll
            for (int s = 0; s < 16; ++s) Tb[(4 * s + q) * 72 + j] = f2bf(tc[s]);
        }
        __syncthreads();
        {
            bf16_t* dst = TP + (size_t)it * 3072;
#pragma unroll
            for (int k2 = 0; k2 < 2; ++k2) { const int c = t + 256 * k2;
                if (c < 384) { const int blk = c >> 7, rowc = (c & 127) >> 2, cc = c & 3, br = blk ? 1 : 0, bc = blk == 2 ? 1 : 0;
                    *(u32x4*)(dst + c * 8) = *(const LAS u32x4*)(Tb + (32 * br + rowc) * 72 + 32 * bc + 8 * cc); } }
        }
        __syncthreads();
    }
}
constexpr int DN_KB = 0, DN_QB = 17408, DN_VB = 34816, DN_TB = 51200, DN_AB = 60416, DN_SC = 69632, DN_DIR = 71168;
__device__ __forceinline__ void dn_step_rb(int step, int dir, int b, int& rb, bool& first) {
    if (step < 4) { const int cidx = dir ? 3 - step : step; rb = 512 + b * 4 + cidx; first = step < 2; }
    else { const int c = step - 4; const int cidx = dir ? 255 - c : c; rb = b * 256 + cidx; first = c < 128; }
}
struct DnPre { u32x4 k4[4], q4[4], v4[4], t0, t1; float gc, beta; };
__device__ __forceinline__ void dn_prefetch(DnPre& p, const bf16_t* P, const float* AB, const bf16_t* TP, int rb, int dir, int vh, int kh, int t, int part) {
    const int r0 = t >> 4, c8 = 8 * (t & 15);
    const bf16_t* prow = P + (size_t)(rb * 64 + r0) * 4096 + c8;
    const bf16_t* tp = TP + (size_t)((rb * 16 + vh) * 2 + dir) * 3072;
    if (part & 1) {
#pragma unroll
        for (int v = 0; v < 4; ++v) { const bf16_t* pr = prow + (size_t)(16 * v) * 4096;
            p.k4[v] = *(const u32x4*)(pr + 1024 + kh * 128); p.q4[v] = *(const u32x4*)(pr + kh * 128); p.v4[v] = *(const u32x4*)(pr + 2048 + vh * 128); }
    }
    if (part & 2) {
        p.t0 = *(const u32x4*)(tp + t * 8); p.t1 = *(const u32x4*)(tp + (256 + (t & 127)) * 8);
        const int ti = dir ? 63 - (t & 63) : (t & 63); const float* ab = AB + (size_t)(rb * 64 + ti) * 64; p.gc = ab[dir * 16 + vh]; p.beta = ab[32 + dir * 16 + vh];
    }
}
template <int VAR> __device__ __forceinline__ void dn_scan(LAS unsigned char* lds, const bf16_t* P, const float* AB, const bf16_t* TP, bf16_t* OB) {
    const int tid = opaque_tid(), dir = __builtin_amdgcn_readfirstlane(tid >> 8);
    for (int unit = blockIdx.x; unit < 32; unit += gridDim.x) {
        const int b = unit >> 4, vh = unit & 15, kh = vh >> 1;
        f32x16 S[4];
#pragma unroll
        for (int kt = 0; kt < 4; ++kt)
#pragma unroll
            for (int x = 0; x < 16; ++x) S[kt][x] = 0.f;
        DnPre pre;
        { int rb0; bool f0; dn_step_rb(0, dir, b, rb0, f0); dn_prefetch(pre, P, AB, TP, rb0, dir, vh, kh, tid & 255, 3); }
        __syncthreads();
        for (int step = 0; step < 260; ++step) {
            const int w = __builtin_amdgcn_readfirstlane((opaque_tid() >> 6) & 3);
            LAS unsigned char* base = lds + dir * DN_DIR;
            LAS bf16_t* Kb = (LAS bf16_t*)(base + DN_KB); LAS bf16_t* Qb = (LAS bf16_t*)(base + DN_QB); LAS bf16_t* Vb = (LAS bf16_t*)(base + DN_VB);
            LAS bf16_t* Tb = (LAS bf16_t*)(base + DN_TB); LAS bf16_t* Ab = (LAS bf16_t*)(base + DN_AB);
            LAS float* sc_beta = (LAS float*)(base + DN_SC); LAS float* sc_gc = sc_beta + 64; LAS float* sc_eg = sc_beta + 128; LAS float* sc_tail = sc_beta + 192; LAS float* sc_dl = sc_beta + 256;
            int rb; bool first; dn_step_rb(step, dir, b, rb, first);
            const int row_base = rb * 64;
            {
                const int tq_ = opaque_tid(), t = tq_ & 255;
                const int r0 = t >> 4, c8 = 8 * (t & 15);
#pragma unroll
                for (int v = 0; v < 4; ++v) { const int i = r0 + 16 * v, ip = dir ? 63 - i : i;
                    *(LAS u32x4*)(Kb + ip * 136 + c8) = pre.k4[v]; *(LAS u32x4*)(Qb + ip * 136 + c8) = pre.q4[v]; *(LAS u32x4*)(Vb + ip * 128 + c8) = pre.v4[v]; }
                { const int c = t, blk = c >> 7, rowc = (c & 127) >> 2, cc = c & 3, br = blk ? 1 : 0; *(LAS u32x4*)(Tb + (32 * br + rowc) * 72 + 8 * cc) = pre.t0; }
                if (t < 128) { const int rowc = t >> 2, cc = t & 3; *(LAS u32x4*)(Tb + (32 + rowc) * 72 + 32 + 8 * cc) = pre.t1; }
                if (t < 64) { const float gc = pre.gc, gl = __shfl(gc, 63); sc_beta[t] = pre.beta; sc_gc[t] = gc; sc_eg[t] = __expf(gc); sc_tail[t] = __expf(gl - gc); if (t == 0) sc_dl[0] = __expf(gl); }
            }
            BAR_LDS();
            {
                const int tq_ = opaque_tid(), lane = tq_ & 63, r = lane & 31, h = lane >> 5;
                const int ti = w >> 1, tj = w & 1;
                if (!(ti == 0 && tj == 1)) {
                    f32x16 qk;
#pragma unroll
                    for (int x = 0; x < 16; ++x) qk[x] = 0.f;
#pragma unroll
                    for (int ks = 0; ks < 8; ++ks) qk = MFMA32(frag_nat(Qb, 136, 32 * ti + r, ks, h), frag_nat(Kb, 136, 32 * tj + r, ks, h), qk);
                    const int jj = 32 * tj + r; const float gj = sc_gc[jj];
#pragma unroll
                    for (int x = 0; x < 16; ++x) { const int i = 32 * ti + crow(x, h);
                        Ab[i * 72 + jj] = f2bf((i >= jj) ? qk[x] * __expf(sc_gc[i] - gj) : 0.f); }
                }
            }
            BAR_LDS();
            if (VAR != 2 && step + 1 < 260) { int rbn; bool fn; dn_step_rb(step + 1, dir, b, rbn, fn); dn_prefetch(pre, P, AB, TP, rbn, dir, vh, kh, opaque_tid() & 255, 1); }
            __builtin_amdgcn_sched_barrier(0);
            if (VAR != 1) {
                const int tq_ = opaque_tid(), lane = tq_ & 63, r = lane & 31, h = lane >> 5;
                f32x16 KS[2], QS[2];
#pragma unroll
                for (int mt = 0; mt < 2; ++mt)
#pragma unroll
                    for (int x = 0; x < 16; ++x) { KS[mt][x] = 0.f; QS[mt][x] = 0.f; }
#pragma unroll
                for (int ks = 0; ks < 8; ++ks) {
                    const bf16x8 sp = pack_step(S[ks >> 1], ks & 1);
#pragma unroll
                    for (int mt = 0; mt < 2; ++mt) { KS[mt] = MFMA32(frag_perm(Kb, 136, 32 * mt + r, ks, h), sp, KS[mt]); QS[mt] = MFMA32(frag_perm(Qb, 136, 32 * mt + r, ks, h), sp, QS[mt]); }
                    if (ks & 1) __builtin_amdgcn_sched_barrier(0);
                }
#pragma unroll
                for (int mt = 0; mt < 2; ++mt)
#pragma unroll
                    for (int x = 0; x < 16; ++x) { const int i = 32 * mt + crow(x, h);
                        KS[mt][x] = sc_beta[i] * (bf2f(Vb[i * 128 + 32 * w + r]) - sc_eg[i] * KS[mt][x]); }
                __builtin_amdgcn_sched_barrier(0);
                bf16x8 Xp[4];
#pragma unroll
                for (int ks = 0; ks < 4; ++ks) Xp[ks] = pack_step(KS[ks >> 1], ks & 1);
                f32x16 VN[2];
#pragma unroll
                for (int mt = 0; mt < 2; ++mt) {
#pragma unroll
                    for (int x = 0; x < 16; ++x) VN[mt][x] = 0.f;
#pragma unroll
                    for (int ks = 0; ks < 4; ++ks) if (ks < 2 * mt + 2) VN[mt] = MFMA32(frag_perm(Tb, 72, 32 * mt + r, ks, h), Xp[ks], VN[mt]);
                }
                __builtin_amdgcn_sched_barrier(0);
                if (VAR != 2 && step + 1 < 260) { int rbn; bool fn; dn_step_rb(step + 1, dir, b, rbn, fn); dn_prefetch(pre, P, AB, TP, rbn, dir, vh, kh, opaque_tid() & 255, 2); }
                __builtin_amdgcn_sched_barrier(0);
                bf16x8 VNp[4];
#pragma unroll
                for (int ks = 0; ks < 4; ++ks) VNp[ks] = pack_step(VN[ks >> 1], ks & 1);
#pragma unroll
                for (int mt = 0; mt < 2; ++mt) {
#pragma unroll
                    for (int x = 0; x < 16; ++x) QS[mt][x] *= sc_eg[32 * mt + crow(x, h)];
#pragma unroll
                    for (int ks = 0; ks < 4; ++ks) if (ks < 2 * mt + 2) QS[mt] = MFMA32(frag_perm(Ab, 72, 32 * mt + r, ks, h), VNp[ks], QS[mt]);
                }
                __builtin_amdgcn_sched_barrier(0);
#pragma unroll
                for (int mt = 0; mt < 2; ++mt)
#pragma unroll
                    for (int x = 0; x < 16; ++x) Vb[(32 * mt + crow(x, h)) * 128 + 32 * w + r] = f2bf(QS[mt][x]);
                __builtin_amdgcn_sched_barrier(0);
#pragma unroll
                for (int mt = 0; mt < 2; ++mt)
#pragma unroll
                    for (int x = 0; x < 16; ++x) VN[mt][x] *= sc_tail[32 * mt + crow(x, h)];
#pragma unroll
                for (int ks = 0; ks < 4; ++ks) VNp[ks] = pack_step(VN[ks >> 1], ks & 1);
                __builtin_amdgcn_sched_barrier(0);
                const float dl = sc_dl[0];
#pragma unroll
                for (int kt = 0; kt < 4; ++kt)
#pragma unroll
                    for (int x = 0; x < 16; ++x) S[kt][x] *= dl;
#pragma unroll
                for (int ks = 0; ks < 4; ++ks) {
#pragma unroll
                    for (int kt = 0; kt < 4; ++kt) S[kt] = MFMA32(frag_tr(Kb, 136, 32 * kt, ks, lane), VNp[ks], S[kt]);
                    __builtin_amdgcn_sched_barrier(0);
                }
                if (VAR != 2) {
                    const int rr_ = lane >> 2, c8_ = 8 * (lane & 3);
#pragma unroll
                    for (int v = 0; v < 4; ++v) { const int ip_ = rr_ + 16 * v, i_ = dir ? 63 - ip_ : ip_;
                        u32x4* gp_ = (u32x4*)(OB + (size_t)(row_base + i_) * 2048 + vh * 128 + 32 * w + c8_);
                        u32x4 o = *(const LAS u32x4*)(Vb + ip_ * 128 + 32 * w + c8_);
                        if (!first) { const u32x4 e = gp_[0];
                            o.x = cvtpk_s(bf_lo(o.x) + bf_lo(e.x), bf_hi(o.x) + bf_hi(e.x)); o.y = cvtpk_s(bf_lo(o.y) + bf_lo(e.y), bf_hi(o.y) + bf_hi(e.y));
                            o.z = cvtpk_s(bf_lo(o.z) + bf_lo(e.z), bf_hi(o.z) + bf_hi(e.z)); o.w = cvtpk_s(bf_lo(o.w) + bf_lo(e.w), bf_hi(o.w) + bf_hi(e.w)); }
                        gp_[0] = o; }
                }
            }
            if (step == 1 || step == 131) asm volatile("s_waitcnt vmcnt(0)" ::: "memory");
            BAR_LDS();
        }
    }
}
constexpr int GP_QM = 0, GP_KM = 17408, GP_AB = 34816, GP_LOW = 44032, GP_TOT = 48128, GP_DIR = 49152;
__device__ __forceinline__ void gla_prep_phase(LAS unsigned char* lds, const bf16_t* P, const float* LOW, const float* gw2, const float* gb2, bf16_t* QM, bf16_t* KM, bf16_t* AQ, float* EL, int G) {
    const int tid0 = opaque_tid(), hb = __builtin_amdgcn_readfirstlane(tid0 >> 8);
    for (int itb = blockIdx.x * 2; itb < 4160; itb += 2 * G) {
        const int it = itb + hb, dir = it & 1, head = (it >> 1) & 3, rb = it >> 3;
        const int tq = opaque_tid(), t = tq & 255, w = __builtin_amdgcn_readfirstlane((tq >> 6) & 3), lane = tq & 63, r = lane & 31, h = lane >> 5;
        LAS unsigned char* base = lds + hb * GP_DIR;
        LAS bf16_t* Qm = (LAS bf16_t*)(base + GP_QM); LAS bf16_t* Km = (LAS bf16_t*)(base + GP_KM); LAS bf16_t* Ab = (LAS bf16_t*)(base + GP_AB);
        LAS float* lowS = (LAS float*)(base + GP_LOW); LAS float* tot = (LAS float*)(base + GP_TOT);
        *(LAS f32x4*)(lowS + 4 * t) = *(const f32x4*)(LOW + (size_t)(rb * 64 + (t >> 2)) * 32 + dir * 16 + 4 * (t & 3));
        const int dk = t & 127, half = t >> 7, col = head * 128 + dk;
        float w2c[16];
#pragma unroll
        for (int rr = 0; rr < 16; ++rr) w2c[rr] = gw2[(size_t)(dir * 16 + rr) * 512 + col];
        const float b2 = gb2[dir * 512 + col];
        __syncthreads();
        float bc[32]; float run = 0.f;
#pragma unroll
        for (int n = 0; n < 32; ++n) { const int ip = 32 * half + n, i = dir ? 63 - ip : ip; float s = b2;
#pragma unroll
            for (int rr = 0; rr < 16; ++rr) s += lowS[i * 16 + rr] * w2c[rr];
            run += logsigmoid_f(s) * (1.f / 16.f); bc[n] = run; }
        tot[half * 128 + dk] = run;
        __syncthreads();
        const float t0 = tot[dk], last = t0 + tot[128 + dk], off = half ? t0 : 0.f;
        if (half == 0) EL[(size_t)(dir * 520 + rb) * 512 + col] = last;
        {
            const int i0 = dir ? 63 - 32 * half : 32 * half; const long pstep = dir ? -3072 : 3072;
            const bf16_t* pp = P + (size_t)(rb * 64 + i0) * 3072 + col;
#pragma unroll
            for (int n = 0; n < 32; ++n) { const int ip = 32 * half + n; const float bcv = bc[n] + off;
                const float qv = bf2f(pp[0]), kv = bf2f(pp[512]); pp += pstep;
                Qm[ip * 136 + dk] = f2bf(qv * 0.08838834764831845f * __expf(bcv - last));
                Km[ip * 136 + dk] = f2bf(kv * __expf(last - bcv)); }
        }
        __syncthreads();
        {
            const int ti = w >> 1, tj = w & 1;
            f32x16 acc;
#pragma unroll
            for (int x = 0; x < 16; ++x) acc[x] = 0.f;
            if (!(ti == 0 && tj == 1)) {
#pragma unroll
                for (int ks = 0; ks < 8; ++ks) acc = MFMA32(frag_nat(Qm, 136, 32 * ti + r, ks, h), frag_nat(Km, 136, 32 * tj + r, ks, h), acc);
            }
            const int j = 32 * tj + r;
#pragma unroll
            for (int x = 0; x < 16; ++x) { const int i = 32 * ti + crow(x, h); Ab[i * 72 + j] = f2bf(i >= j ? acc[x] : 0.f); }
            const int r0 = t >> 4, c8 = 8 * (t & 15);
#pragma unroll
            for (int v = 0; v < 4; ++v) { const int row = r0 + 16 * v; const size_t go = ((size_t)dir * MROWS + rb * 64 + row) * 512 + head * 128 + c8;
                *(u32x4*)(QM + go) = *(const LAS u32x4*)(Qm + row * 136 + c8); *(u32x4*)(KM + go) = *(const LAS u32x4*)(Km + row * 136 + c8); }
        }
        __syncthreads();
        {
            bf16_t* dst = AQ + (size_t)it * 4096;
#pragma unroll
            for (int k2 = 0; k2 < 2; ++k2) { const int c = t + 256 * k2, row = c >> 3, cc = c & 7; *(u32x4*)(dst + c * 8) = *(const LAS u32x4*)(Ab + row * 72 + 8 * cc); }
        }
        __syncthreads();
    }
}
constexpr int GL_QM = 0, GL_KM = 17408, GL_VB = 34816, GL_AB = 52224, GL_EL = 61440, GL_DIR = 61952;
struct GlPre { u32x4 q4[4], k4[4], v4[4], a0, a1; float elv; };
__device__ __forceinline__ void gl_prefetch(GlPre& p, const bf16_t* P, const bf16_t* QM, const bf16_t* KM, const bf16_t* AQ, const float* EL, int rb, int dir, int head, int hf, int t) {
    const int r0 = t >> 4, c8 = 8 * (t & 15);
    const bf16_t* aq = AQ + (size_t)((rb * 4 + head) * 2 + dir) * 4096;
#pragma unroll
    for (int v = 0; v < 4; ++v) { const size_t row = (size_t)(rb * 64 + r0 + 16 * v);
        p.q4[v] = *(const u32x4*)(QM + ((size_t)dir * MROWS + row) * 512 + head * 128 + c8);
        p.k4[v] = *(const u32x4*)(KM + ((size_t)dir * MROWS + row) * 512 + head * 128 + c8);
        p.v4[v] = *(const u32x4*)(P + row * 3072 + 1024 + head * 256 + hf * 128 + c8); }
    p.a0 = *(const u32x4*)(aq + t * 8); p.a1 = *(const u32x4*)(aq + (256 + t) * 8);
    p.elv = EL[(size_t)(dir * 520 + rb) * 512 + head * 128 + (t & 127)];
}
__device__ __forceinline__ void gla_scan(LAS unsigned char* lds, const bf16_t* P  , const bf16_t* QM, const bf16_t* KM, const bf16_t* AQ, const float* EL, bf16_t* OB  ) {
    const int tid = opaque_tid(), dir = __builtin_amdgcn_readfirstlane(tid >> 8);
    for (int unit = blockIdx.x; unit < 16; unit += gridDim.x) {
        const int b = unit >> 3, head = (unit >> 1) & 3, hf = unit & 1;
        f32x16 S[4];
#pragma unroll
        for (int kt = 0; kt < 4; ++kt)
#pragma unroll
            for (int x = 0; x < 16; ++x) S[kt][x] = 0.f;
        GlPre pre;
        { int rb0; bool f0; dn_step_rb(0, dir, b, rb0, f0); gl_prefetch(pre, P, QM, KM, AQ, EL, rb0, dir, head, hf, tid & 255); }
        __syncthreads();
        for (int step = 0; step < 260; ++step) {
            const int w = __builtin_amdgcn_readfirstlane((opaque_tid() >> 6) & 3);
            LAS unsigned char* base = lds + dir * GL_DIR;
            LAS bf16_t* Qm = (LAS bf16_t*)(base + GL_QM); LAS bf16_t* Km = (LAS bf16_t*)(base + GL_KM); LAS bf16_t* Vb = (LAS bf16_t*)(base + GL_VB); LAS bf16_t* Ab = (LAS bf16_t*)(base + GL_AB);
            LAS float* el = (LAS float*)(base + GL_EL);
            int rb; bool first; dn_step_rb(step, dir, b, rb, first);
            const int row_base = rb * 64;
            {
                const int tq_ = opaque_tid(), t = tq_ & 255;
                const int r0 = t >> 4, c8 = 8 * (t & 15);
#pragma unroll
                for (int v = 0; v < 4; ++v) { const int i = r0 + 16 * v, ip = dir ? 63 - i : i;
                    *(LAS u32x4*)(Qm + i * 136 + c8) = pre.q4[v]; *(LAS u32x4*)(Km + i * 136 + c8) = pre.k4[v]; *(LAS u32x4*)(Vb + ip * 136 + c8) = pre.v4[v]; }
                { const int c = t, row = c >> 3, cc = c & 7; *(LAS u32x4*)(Ab + row * 72 + 8 * cc) = pre.a0; }
                { const int c = 256 + t, row = c >> 3, cc = c & 7; *(LAS u32x4*)(Ab + row * 72 + 8 * cc) = pre.a1; }
                if (t < 128) el[t] = __expf(pre.elv);
            }
            BAR_LDS();
            if (step + 1 < 260) { int rbn; bool fn; dn_step_rb(step + 1, dir, b, rbn, fn); gl_prefetch(pre, P, QM, KM, AQ, EL, rbn, dir, head, hf, opaque_tid() & 255); }
            __builtin_amdgcn_sched_barrier(0);
            {
                const int tq_ = opaque_tid(), lane = tq_ & 63, r = lane & 31, h = lane >> 5;
#pragma unroll
                for (int kt = 0; kt < 4; ++kt)
#pragma unroll
                    for (int x = 0; x < 16; ++x) S[kt][x] *= el[32 * kt + crow(x, h)];
                bf16x8 Vf[4];
#pragma unroll
                for (int ks = 0; ks < 4; ++ks) Vf[ks] = frag_tr(Vb, 136, 32 * w, ks, lane);
                u32x4 eo[4];
                {
                    const int rr_ = lane >> 2, c8_ = 8 * (lane & 3);
                    if (!first) {
#pragma unroll
                        for (int v = 0; v < 4; ++v) { const int ip_ = rr_ + 16 * v, i_ = dir ? 63 - ip_ : ip_;
                            eo[v] = *(const u32x4*)(OB + (size_t)(row_base + i_) * 1024 + head * 256 + hf * 128 + 32 * w + c8_); }
                    } else {
                        unsigned z0 = 0u; asm volatile("" : "+v"(z0));
#pragma unroll
                        for (int v = 0; v < 4; ++v) eo[v] = (u32x4){z0, z0, z0, z0};
                    }
                }
                f32x16 O[2];
#pragma unroll
                for (int mt = 0; mt < 2; ++mt) {
#pragma unroll
                    for (int x = 0; x < 16; ++x) O[mt][x] = 0.f;
#pragma unroll
                    for (int ks = 0; ks < 4; ++ks) if (ks < 2 * mt + 2) O[mt] = MFMA32(frag_perm(Ab, 72, 32 * mt + r, ks, h), Vf[ks], O[mt]);
                }
                __builtin_amdgcn_sched_barrier(0);
#pragma unroll
                for (int ks = 0; ks < 8; ++ks) {
                    const bf16x8 sp = pack_step(S[ks >> 1], ks & 1);
#pragma unroll
                    for (int mt = 0; mt < 2; ++mt) O[mt] = MFMA32(frag_perm(Qm, 136, 32 * mt + r, ks, h), sp, O[mt]);
                    if (ks & 1) __builtin_amdgcn_sched_barrier(0);
                }
#pragma unroll
                for (int mt = 0; mt < 2; ++mt)
#pragma unroll
                    for (int x = 0; x < 16; ++x) Vb[(32 * mt + crow(x, h)) * 136 + 32 * w + r] = f2bf(O[mt][x]);
                __builtin_amdgcn_sched_barrier(0);
#pragma unroll
                for (int ks = 0; ks < 4; ++ks) {
#pragma unroll
                    for (int kt = 0; kt < 4; ++kt) S[kt] = MFMA32(frag_tr(Km, 136, 32 * kt, ks, lane), Vf[ks], S[kt]);
                    __builtin_amdgcn_sched_barrier(0);
                }
                {
                    const int rr_ = lane >> 2, c8_ = 8 * (lane & 3);
#pragma unroll
                    for (int v = 0; v < 4; ++v) { const int ip_ = rr_ + 16 * v, i_ = dir ? 63 - ip_ : ip_;
                        u32x4* gp_ = (u32x4*)(OB + (size_t)(row_base + i_) * 1024 + head * 256 + hf * 128 + 32 * w + c8_);
                        u32x4 o = *(const LAS u32x4*)(Vb + ip_ * 136 + 32 * w + c8_); const u32x4 e = eo[v];
                        if (!first) {
                            o.x = cvtpk_s(bf_lo(o.x) + bf_lo(e.x), bf_hi(o.x) + bf_hi(e.x)); o.y = cvtpk_s(bf_lo(o.y) + bf_lo(e.y), bf_hi(o.y) + bf_hi(e.y));
                            o.z = cvtpk_s(bf_lo(o.z) + bf_lo(e.z), bf_hi(o.z) + bf_hi(e.z)); o.w = cvtpk_s(bf_lo(o.w) + bf_lo(e.w), bf_hi(o.w) + bf_hi(e.w)); }
                        gp_[0] = o; }
                }
            }
            if (step == 1 || step == 131) asm volatile("s_waitcnt vmcnt(0)" ::: "memory");
            BAR_LDS();
        }
    }
}
#define DUP_DN 0
#define DN_VARIANT 0
#define DN_VAR_PARITY0 0
#define DUP_GLA 0
#define DUP_ATT 0
#define DUP_GIN 0
#define DUP_FFN1 0
constexpr unsigned long long pack_ops(const int* ops, int n) { unsigned long long v = 0; for (int i = 0; i < n; ++i) v |= (unsigned long long)ops[i] << (5 * i); return v; }
struct OpList { unsigned long long code; int n; };
constexpr OpList make_list(int mix) {
    int ops[16] = {}; int n = 0;
    ops[n++] = OP_PREP; ops[n++] = OP_GEMM_IN; if (DUP_GIN && mix != 0) ops[n++] = OP_GEMM_IN;
    if (mix == 0) { ops[n++] = OP_DNHALO; ops[n++] = OP_DNCONV; ops[n++] = OP_DNT; ops[n++] = OP_DNSCAN; if (DUP_DN) ops[n++] = OP_DNSCAN; ops[n++] = OP_DNREDO; ops[n++] = OP_GEMM_Z; }
    else if (mix == 1) { ops[n++] = OP_GLAPREP; ops[n++] = OP_GLASCAN; if (DUP_GLA) ops[n++] = OP_GLASCAN; ops[n++] = OP_GLAGATE; }
    else { ops[n++] = OP_QKROPE; ops[n++] = OP_ATTN; if (DUP_ATT) ops[n++] = OP_ATTN; }
    ops[n++] = OP_GEMM_OUT; ops[n++] = OP_NORM2; ops[n++] = OP_FFN1; if (DUP_FFN1 && mix != 0) ops[n++] = OP_FFN1; ops[n++] = OP_FFN2;
    return OpList{pack_ops(ops, n), n};
}
constexpr OpList L_DN = make_list(0), L_GL = make_list(1), L_AT = make_list(2);
constexpr int NPHASE = 1 + 2 * L_DN.n + L_GL.n + L_AT.n;
__device__ __forceinline__ void decode_phase(int ph, int& layer, int& op) {
    if (ph == 0) { layer = 0; op = OP_MOD; return; }
    int p = ph - 1;
    if (p < L_DN.n) { layer = 0; op = (int)((L_DN.code >> (5 * p)) & 31ull); return; } p -= L_DN.n;
    if (p < L_GL.n) { layer = 1; op = (int)((L_GL.code >> (5 * p)) & 31ull); return; } p -= L_GL.n;
    if (p < L_AT.n) { layer = 2; op = (int)((L_AT.code >> (5 * p)) & 31ull); return; } p -= L_AT.n;
    layer = 3; op = (int)((L_DN.code >> (5 * p)) & 31ull);
}

__global__ void __launch_bounds__(512, 2) mega(Args args) {
    extern __shared__ __attribute__((aligned(16))) unsigned char lds_raw[];
    LAS unsigned char* lds = (LAS unsigned char*)lds_raw;
    cg::grid_group grid = cg::this_grid();
    const int G = gridDim.x, NGW = G * 8;
    unsigned char* ws = args.ws;
    const float* x_in = args.in[0]; const float* c_in = args.in[1]; const float* ctx_in = args.in[2]; const float* cctx_in = args.in[3];
    const float* ada_w = args.in[4]; const float* ada_b = args.in[5]; const float* norm_mix_g = args.in[6]; const float* norm_ffn_g = args.in[7];
    const float* ffn_w1 = args.in[8]; const float* ffn_w2 = args.in[9];
    float* MOD = (float*)(ws + WS_MOD); float* CTXC = (float*)(ws + WS_CTX); bf16_t* H = (bf16_t*)(ws + WS_H); float* ABF = (float*)(ws + WS_AB); float* RSTD = (float*)(ws + WS_RSTD);
    bf16_t* PB = (bf16_t*)(ws + WS_P); float* out = args.out;

    for (int ph = args.ph_lo; ph < args.ph_hi; ++ph) {
        int layer, op; decode_phase(ph, layer, op);
        const int mix = layer % 3, slot = layer / 3;
        const float* modl = MOD + (size_t)layer * 3 * 6144;
        const float* xl = layer == 0 ? x_in : out; const float* xc = layer == 0 ? ctx_in : CTXC;
        if (op == OP_MOD) {
            const int tid = opaque_tid(), lane = tid & 63, wave = __builtin_amdgcn_readfirstlane(tid >> 6); const int gw = blockIdx.x * 8 + wave; (void)lane; (void)gw; (void)tid;
            LAS float* sl = (LAS float*)lds; LAS float* red = sl + 3 * 1024;
            for (int e = tid; e < 3 * 1024; e += 512) { const float v = e < 2048 ? c_in[e] : cctx_in[e - 2048]; sl[e] = silu_f(v); }
            __syncthreads();
            for (int item = blockIdx.x; item < 4 * 96; item += G) {
                const int ly = item / 96, col = (item % 96) * 64 + lane;
                const float* wp = ada_w + ((size_t)ly * 1024 + 128 * wave) * 6144 + col;
                float a0 = 0.f, a1 = 0.f, a2 = 0.f;
#pragma unroll 8
                for (int k = 0; k < 128; ++k) { const float wv = wp[(size_t)k * 6144]; const int kk = 128 * wave + k; a0 += sl[kk] * wv; a1 += sl[1024 + kk] * wv; a2 += sl[2048 + kk] * wv; }
                red[(wave * 3 + 0) * 64 + lane] = a0; red[(wave * 3 + 1) * 64 + lane] = a1; red[(wave * 3 + 2) * 64 + lane] = a2;
                __syncthreads();
                if (tid < 192) { const int m = tid >> 6; float s = ada_b[(size_t)ly * 6144 + col];
#pragma unroll
                    for (int w2 = 0; w2 < 8; ++w2) s += red[(w2 * 3 + m) * 64 + lane];
                    MOD[((size_t)ly * 3 + m) * 6144 + col] = s; }
                __syncthreads();
            }
        } else if (op == OP_PREP) {
            const int tid = opaque_tid(), lane = tid & 63, wave = __builtin_amdgcn_readfirstlane(tid >> 6); const int gw = blockIdx.x * 8 + wave; (void)lane; (void)gw; (void)tid;
            LAS float* scr = (LAS float*)(lds + wave * 16384);
            unsigned z0 = 0u; asm volatile("" : "+v"(z0)); const u32x4 zv = (u32x4){z0, z0, z0, z0};
            bf16_t* wtA = (bf16_t*)(ws + WT_A); bf16_t* wtZ = (bf16_t*)(ws + WT_Z); bf16_t* wtO = (bf16_t*)(ws + WT_O); bf16_t* wt1 = (bf16_t*)(ws + WT_1); bf16_t* wt2 = (bf16_t*)(ws + WT_2);
            if (mix == 0) {
                const float* w_in = args.in[10] + (size_t)slot * 1024 * 6208; const float* w_out = args.in[15] + (size_t)slot * 2048 * 1024;
                transpose_mat(w_in, 6208, 0, 4096, 1024, wtA, 0, scr, gw, NGW, lane);
                transpose_mat(w_in, 6208, 6144, 64, 1024, wtA, 4096, scr, gw, NGW, lane);
                for (size_t e = (size_t)blockIdx.x * 512 + tid; e < (size_t)192 * 1024 * 2 / 16; e += (size_t)G * 512) ((u32x4*)(wtA + (size_t)4160 * 1024))[e] = zv;
            } else if (mix == 1) {
                const float* w_in = args.in[16]; const float* w_out = args.in[20];
                transpose_mat(w_in, 3104, 0, 3104, 1024, wtA, 0, scr, gw, NGW, lane);
                for (size_t e = (size_t)blockIdx.x * 512 + tid; e < (size_t)224 * 1024 * 2 / 16; e += (size_t)G * 512) ((u32x4*)(wtA + (size_t)3104 * 1024))[e] = zv;
                transpose_mat(w_out, 1024, 0, 1024, 1024, wtO, 0, scr, gw, NGW, lane);
            } else {
                const float* w_in = args.in[21]; const float* w_out = args.in[24];
                transpose_mat(w_in, 1536, 0, 1536, 1024, wtA, 0, scr, gw, NGW, lane);
                transpose_mat(w_out, 1024, 0, 1024, 1024, wtO, 0, scr, gw, NGW, lane);
            }
            if (mix != 0) {
                transpose_mat(ffn_w1 + (size_t)layer * 1024 * 4096, 4096, 0, 4096, 1024, wt1, 0, scr, gw, NGW, lane);
                transpose_mat(ffn_w2 + (size_t)layer * 4096 * 1024, 1024, 0, 1024, 4096, wt2, 0, scr, gw, NGW, lane);
            }
            normmod_rows(xl, xc, norm_mix_g + (size_t)layer * 1024, modl, 0, H, gw, NGW, lane);
        } else if (op == OP_DNREDO) {
            const int tid = opaque_tid(), lane = tid & 63, wave = __builtin_amdgcn_readfirstlane(tid >> 6); const int gw = blockIdx.x * 8 + wave; (void)lane; (void)gw; (void)tid;
            LAS float* scr = (LAS float*)(lds + wave * 16384);
            const float* w_in = args.in[10] + (size_t)slot * 1024 * 6208; const float* w_out = args.in[15] + (size_t)slot * 2048 * 1024;
            transpose_mat(w_in, 6208, 4096, 2048, 1024, (bf16_t*)(ws + WT_Z), 0, scr, gw, NGW, lane);
            transpose_mat(w_out, 1024, 0, 1024, 2048, (bf16_t*)(ws + WT_O), 0, scr, gw, NGW, lane);
            transpose_mat(ffn_w1 + (size_t)layer * 1024 * 4096, 4096, 0, 4096, 1024, (bf16_t*)(ws + WT_1), 0, scr, gw, NGW, lane);
            transpose_mat(ffn_w2 + (size_t)layer * 4096 * 1024, 1024, 0, 1024, 4096, (bf16_t*)(ws + WT_2), 0, scr, gw, NGW, lane);
            normmod_rows(xl, xc, norm_mix_g + (size_t)layer * 1024, modl, 0, H, gw, NGW, lane);
            const bf16_t* OB = (const bf16_t*)(ws + WS_O);
            for (int row = gw; row < MROWS; row += NGW) {
                const u32x4* p = (const u32x4*)(OB + (size_t)row * 2048 + 32 * lane); float ss = 0.f;
#pragma unroll
                for (int v = 0; v < 4; ++v) { const u32x4 q = p[v]; const float a0 = bf_lo(q.x), a1 = bf_hi(q.x), a2 = bf_lo(q.y), a3 = bf_hi(q.y), a4 = bf_lo(q.z), a5 = bf_hi(q.z), a6 = bf_lo(q.w), a7 = bf_hi(q.w);
                    ss += (a0 * a0 + a1 * a1) + (a2 * a2 + a3 * a3) + (a4 * a4 + a5 * a5) + (a6 * a6 + a7 * a7); }
                ss += __shfl_xor(ss, 1); ss += __shfl_xor(ss, 2);
                if ((lane & 3) == 0) RSTD[(size_t)row * 16 + (lane >> 2)] = rsqrtf(ss * (1.f / 128.f) + EPS);
            }
        } else if (op == OP_DNHALO) {
            dn_halo_phase(PB, (bf16_t*)(ws + WS_HALO), G);
        } else if (op == OP_DNCONV) {
            dn_conv_phase(PB, (const bf16_t*)(ws + WS_HALO), args.in[11] + (size_t)slot * 4096 * 5, G);
        } else if (op == OP_DNT) {
            dn_t_phase(lds, PB, ABF, (bf16_t*)(ws + WS_TP), args.in[12] + (size_t)slot * 32, args.in[13] + (size_t)slot * 32, G);
        } else if (op == OP_NORM2) {
            const int tid = opaque_tid(), lane = tid & 63, wave = __builtin_amdgcn_readfirstlane(tid >> 6); const int gw = blockIdx.x * 8 + wave; (void)lane; (void)gw; (void)tid;
            normmod_rows(out, CTXC, norm_ffn_g + (size_t)layer * 1024, modl, 3, H, gw, NGW, lane);
        } else if (op == OP_GEMM_IN || op == OP_GEMM_Z || op == OP_GEMM_OUT || op == OP_FFN1 || op == OP_FFN2) {
            pg8::Gemm g; pg8::Epi E;
            E.mode = 0; E.O = PB; E.ldc = 4096; E.tail_pn = -1; E.F = ABF; E.ldf = 64; E.nf = 64; E.rstd = RSTD; E.ng = args.in[14] + (size_t)slot * 128;
            E.src_lat = xl; E.src_ctx = xc; E.dst_lat = out; E.dst_ctx = CTXC; E.mod = modl; E.gidx = 2;
            g.M = MROWS; g.A = H; g.K = 1024;
            bf16_t* OBUF = (bf16_t*)(ws + (mix == 1 ? WS_OGLA : WS_O));
            if (op == OP_GEMM_IN) {
                g.Bt = (const bf16_t*)(ws + WT_A);
                if (mix == 0) { g.N = 4352; E.ldc = 4096; E.tail_pn = 16; E.ldf = 64; E.nf = 64; }
                else if (mix == 1) { g.N = 3328; E.ldc = 3072; E.tail_pn = 12; E.ldf = 32; E.nf = 32; }
                else { g.N = 1536; E.ldc = 1536; }
            } else if (op == OP_GEMM_Z) {
                g.Bt = (const bf16_t*)(ws + WT_Z); g.N = 2048; E.mode = 2; E.O = OBUF; E.ldc = 2048;
            } else if (op == OP_GEMM_OUT) {
                g.A = OBUF; g.K = mix == 0 ? 2048 : 1024; g.Bt = (const bf16_t*)(ws + WT_O); g.N = 1024; E.mode = 3; E.gidx = 2;
            } else if (op == OP_FFN1) {
                g.Bt = (const bf16_t*)(ws + WT_1); g.N = 4096; E.mode = 1; E.ldc = 4096;
            } else {
                g.A = PB; g.K = 4096; g.Bt = (const bf16_t*)(ws + WT_2); g.N = 1024; E.mode = 3; E.gidx = 5; E.src_lat = out; E.src_ctx = CTXC;
            }
            pg8::StaticOrder S; S.init(g.M, g.N, G, (int)blockIdx.x);
#ifndef NO_GEMM
            pg8::gemm_phase<pg8::Epi, pg8::StaticOrder, true, true>(lds, g, S, E);
#endif
        } else if (op == OP_DNSCAN) {
#ifndef NO_DN
            if (DN_VARIANT && (ph & 1) == DN_VAR_PARITY0 ) dn_scan<DN_VARIANT>(lds, PB, ABF, (const bf16_t*)(ws + WS_TP), (bf16_t*)(ws + WS_O)); else dn_scan<0>(lds, PB, ABF, (const bf16_t*)(ws + WS_TP), (bf16_t*)(ws + WS_O));
#endif
        } else if (op == OP_GLAPREP) {
            gla_prep_phase(lds, PB, ABF, args.in[17], args.in[18], (bf16_t*)(ws + WS_QM), (bf16_t*)(ws + WS_KM), (bf16_t*)(ws + WS_AQ), (float*)(ws + WS_EL), G);
        } else if (op == OP_GLASCAN) {
#ifndef NO_GLA
            gla_scan(lds, PB, (const bf16_t*)(ws + WS_QM), (const bf16_t*)(ws + WS_KM), (const bf16_t*)(ws + WS_AQ), (const float*)(ws + WS_EL), (bf16_t*)(ws + WS_OGLA));
#endif
        } else if (op == OP_GLAGATE) {
            const int tid = opaque_tid(), lane = tid & 63, wave = __builtin_amdgcn_readfirstlane(tid >> 6); const int gw = blockIdx.x * 8 + wave; (void)lane; (void)gw; (void)tid;
            bf16_t* OB = (bf16_t*)(ws + WS_OGLA); const float* ng = args.in[19];
            for (int row = gw; row < MROWS; row += NGW) {
                u32x4* p = (u32x4*)(OB + (size_t)row * 1024 + 16 * lane); const u32x4* gp = (const u32x4*)(PB + (size_t)row * 3072 + 2048 + 16 * lane);
                float o[16], z[16]; float ss = 0.f;
#pragma unroll
                for (int v = 0; v < 2; ++v) { const u32x4 q = p[v], gq = gp[v];
                    o[8 * v + 0] = bf_lo(q.x); o[8 * v + 1] = bf_hi(q.x); o[8 * v + 2] = bf_lo(q.y); o[8 * v + 3] = bf_hi(q.y); o[8 * v + 4] = bf_lo(q.z); o[8 * v + 5] = bf_hi(q.z); o[8 * v + 6] = bf_lo(q.w); o[8 * v + 7] = bf_hi(q.w);
                    z[8 * v + 0] = bf_lo(gq.x); z[8 * v + 1] = bf_hi(gq.x); z[8 * v + 2] = bf_lo(gq.y); z[8 * v + 3] = bf_hi(gq.y); z[8 * v + 4] = bf_lo(gq.z); z[8 * v + 5] = bf_hi(gq.z); z[8 * v + 6] = bf_lo(gq.w); z[8 * v + 7] = bf_hi(gq.w); }
#pragma unroll
                for (int e = 0; e < 16; ++e) ss += o[e] * o[e];
                ss += __shfl_xor(ss, 1); ss += __shfl_xor(ss, 2); ss += __shfl_xor(ss, 4); ss += __shfl_xor(ss, 8);
                const float rs = rsqrtf(ss * (1.f / 256.f) + EPS); const int cb = (16 * lane) & 255;
#pragma unroll
                for (int v = 0; v < 2; ++v) { float rr[8];
#pragma unroll
                    for (int e = 0; e < 8; ++e) rr[e] = o[8 * v + e] * rs * ng[cb + 8 * v + e] * silu_f(z[8 * v + e]);
                    u32x4 wv; wv.x = cvtpk_s(rr[0], rr[1]); wv.y = cvtpk_s(rr[2], rr[3]); wv.z = cvtpk_s(rr[4], rr[5]); wv.w = cvtpk_s(rr[6], rr[7]); p[v] = wv; }
            }
        } else if (op == OP_QKROPE) {
            const int tid = opaque_tid(), lane = tid & 63, wave = __builtin_amdgcn_readfirstlane(tid >> 6); const int gw = blockIdx.x * 8 + wave; (void)lane; (void)gw; (void)tid;
            bf16_t* QR = (bf16_t*)(ws + WS_QR); bf16_t* KR = (bf16_t*)(ws + WS_KR); bf16_t* VR = (bf16_t*)(ws + WS_VR);
            const float* qg = args.in[22]; const float* kg = args.in[23];
            const int hf = lane >> 5, j = lane & 31, e1 = 64 * hf + j, e2 = e1 + 32;
            const float inv_freq = exp2f(-(float)(2 * j) * (1.f / 64.f) * 13.287712379549449f);
            const float gq1 = qg[e1], gq2 = qg[e2], gk1 = kg[e1], gk2 = kg[e2];
            for (int row = gw; row < MROWS; row += NGW) {
                const bool lat = row < NLAT; const int b = lat ? row / SEQ : (row - NLAT) / CTXL; const int tpos = lat ? row % SEQ : (row - NLAT) % CTXL;
                float cs = 1.f, sn = 0.f;
                if (lat) { const float pos = (float)(hf == 0 ? tpos / 64 : tpos % 64); const float ang = pos * inv_freq; sn = sinf(ang); cs = cosf(ang); }
                const bf16_t* pr = PB + (size_t)row * 1536; const int kpos = lat ? tpos : SEQ + tpos;
#pragma unroll
                for (int hd = 0; hd < 10; ++hd) {
                    const float x1 = bf2f(pr[hd * 128 + e1]), x2 = bf2f(pr[hd * 128 + e2]);
                    const float rinv = rsqrtf(wave_sum(x1 * x1 + x2 * x2) * (1.f / 128.f) + EPS);
                    const float y1 = x1 * rinv * (hd < 8 ? gq1 : gk1), y2 = x2 * rinv * (hd < 8 ? gq2 : gk2);
                    const float o1 = y1 * cs - y2 * sn, o2 = y1 * sn + y2 * cs;
                    bf16_t* dst = hd < 8 ? QR + (size_t)row * 1024 + hd * 128 : KR + ((size_t)(b * 2 + (hd - 8)) * SKV + kpos) * 128;
                    dst[e1] = f2bf(o1); dst[e2] = f2bf(o2);
                }
#pragma unroll
                for (int kv = 0; kv < 2; ++kv) { bf16_t* dst = VR + ((size_t)(b * 2 + kv) * SKV + kpos) * 128; dst[e1] = pr[1280 + kv * 128 + e1]; dst[e2] = pr[1280 + kv * 128 + e2]; }
            }
        } else if (op == OP_ATTN) {
            const attn::bf16* QR = (const attn::bf16*)(ws + WS_QR); const attn::bf16* KR = (const attn::bf16*)(ws + WS_KR); const attn::bf16* VR = (const attn::bf16*)(ws + WS_VR);
            attn::bf16* OB = (attn::bf16*)(ws + WS_O);
            for (int u = blockIdx.x; u < 1024 + 16; u += G) {
                size_t qoff, koff; int seq;
                if (u < 1024) { const int pair = u >> 8, b = pair >> 1, kvh = pair & 1, hh = (u >> 6) & 3, qb = u & 63, head = kvh * 4 + hh;
                    qoff = ((size_t)b * SEQ + (size_t)qb * 256) * 1024 + head * 128; koff = (size_t)(b * 2 + kvh) * SKV * 128; seq = SKV; }
                else { const int jx = u - 1024, b = jx >> 3, head = jx & 7, kvh = head >> 2;
                    qoff = ((size_t)NLAT + (size_t)b * CTXL) * 1024 + head * 128; koff = ((size_t)(b * 2 + kvh) * SKV + SEQ) * 128; seq = CTXL; }
                __syncthreads();
#ifndef NO_ATT
                attn::attn_dense_body<attn::bf16>(QR + qoff, KR + koff, VR + koff, OB + qoff, seq, (char*)lds_raw);
#endif
            }
        }
        if (ph + 1 < args.ph_hi) grid.sync();
    }
}

#ifndef MK_MULTI
#define MK_MULTI 0
#endif
extern "C" void kernel_launch(void* const* d_in, const int* in_sizes, int n_in, void* d_out, int out_size, void* d_ws, size_t ws_size, hipStream_t stream) {
    static int grid = 0;
    if (grid == 0) {
        if (n_in != 25 || ws_size < WS_END) { fprintf(stderr, "kernel_launch: unexpected n_in %d / ws_size %zu (need %zu)\n", n_in, ws_size, (size_t)WS_END); grid = -1; return; }
        int dev = 0, cus = 0, per_cu = 0;
        hipGetDevice(&dev); hipDeviceGetAttribute(&cus, hipDeviceAttributeMultiprocessorCount, dev);
        if (hipFuncSetAttribute((const void*)mega, hipFuncAttributeMaxDynamicSharedMemorySize, LDS_BYTES) != hipSuccess) { fprintf(stderr, "kernel_launch: hipFuncSetAttribute failed\n"); grid = -1; return; }
        if (hipOccupancyMaxActiveBlocksPerMultiprocessor(&per_cu, (const void*)mega, 512, LDS_BYTES) != hipSuccess || per_cu < 1) { fprintf(stderr, "kernel_launch: occupancy query says %d\n", per_cu); per_cu = 1; }
        (void)hipGetLastError();
        grid = cus * 1;
    }
    if (grid < 0) return;
    Args a{};
    for (int i = 0; i < 25; ++i) a.in[i] = (const float*)d_in[i];
    a.out = (float*)d_out; a.ws = (unsigned char*)d_ws;
#if MK_MULTI
    for (int ph = 0; ph < NPHASE; ++ph) { a.ph_lo = ph; a.ph_hi = ph + 1; hipLaunchKernelGGL(mega, dim3(grid), dim3(512), LDS_BYTES, stream, a); }
#else
    a.ph_lo = 0; a.ph_hi = NPHASE;
    void* kargs[] = {&a};
    hipError_t e = hipLaunchCooperativeKernel((const void*)mega, dim3(grid), dim3(512), kargs, LDS_BYTES, stream);
    if (e != hipSuccess) fprintf(stderr, "cooperative launch failed: %s (grid %d)\n", hipGetErrorString(e), grid);
#endif
}
```

```cpp
#include <hip/hip_runtime.h>
#include <hip/hip_bf16.h>
#include <hip/hip_cooperative_groups.h>
#include <cstdio>
#include <cstdint>
namespace cg = cooperative_groups;
__device__ __forceinline__ int opaque_tid() { int t = threadIdx.x; asm volatile("" : "+v"(t)); return t; }
namespace pg8 {
#define PG8_LAS __attribute__((address_space(3)))
typedef unsigned short bf16_t;
typedef short bf16x8 __attribute__((ext_vector_type(8)));
typedef float f32x4 __attribute__((ext_vector_type(4)));
typedef unsigned u32x4 __attribute__((ext_vector_type(4)));
constexpr int BM = 256, BK = 64, HALF = 128, HTB = HALF * BK * 2  , STAGE_BYTES = 8 * HTB, NXCD = 8, WGM = 8;

__host__ __device__ __forceinline__ int lds_byte(int r, int c) { const int st = (r >> 4) * 2 + (c >> 5), rr = r & 15, cc = c & 31, ob = rr * 64 + cc * 2; return st * 1024 + (ob ^ (((ob >> 9) & 1) << 5)); }
__host__ __device__ __forceinline__ void stage_rc(int b, int& R, int& C) { const int st = b / 1024, sb = b % 1024, swz = sb ^ (((sb >> 9) & 1) << 5); R = (st >> 1) * 16 + swz / 64; C = (st & 1) * 32 + (swz % 64) / 2; }
__host__ __device__ __forceinline__ int perm32(int rho) { const int n = rho >> 4, i = rho & 15; return 8 * (i >> 2) + 4 * n + (i & 3); }

struct Unit { int pm, pn; };
struct Gemm { const bf16_t* A; const bf16_t* Bt; int M, N, K; };

struct StaticOrder {
    int nM, nN, nwg, G, c;
    __host__ __device__ void init(int M, int N, int G_, int c_) { nM = M / BM; nN = N / BM; nwg = nM * nN; G = G_; c = c_; }
    __host__ __device__ bool next(int i, Unit& u) const {
        const long L = (long)i * G + c; if (L >= nwg) return false;
        int wgid = (int)L; { const int q = nwg / NXCD, r = nwg % NXCD, xcd = wgid % NXCD, off = wgid / NXCD; wgid = (xcd < r ? xcd * (q + 1) : r * (q + 1) + (xcd - r) * q) + off; }
        const int nig = WGM * nN, gid = wgid / nig, fm = gid * WGM, gsz = (nM - fm) < WGM ? (nM - fm) : WGM;
        u.pm = fm + ((wgid % nig) % gsz); u.pn = (wgid % nig) / gsz; return true;
    }
    __device__ __forceinline__ void a_ready(const Unit&) const {}
    __device__ __forceinline__ void done(const Unit&) const {}
};

__device__ __forceinline__ unsigned cvt_pk_bf16(float lo, float hi) { unsigned r; asm volatile("v_cvt_pk_bf16_f32 %0, %1, %2" : "=v"(r) : "v"(lo), "v"(hi)); return r; }
typedef float f32x2 __attribute__((ext_vector_type(2)));
typedef float f32x2_t __attribute__((ext_vector_type(2))); typedef __bf16 bf16x2_t __attribute__((ext_vector_type(2)));
__device__ __forceinline__ unsigned cvtpk_s(float lo, float hi) { f32x2_t v = {lo, hi}; bf16x2_t b = __builtin_convertvector(v, bf16x2_t); return __builtin_bit_cast(unsigned, b); }
__device__ __forceinline__ float bf_lo(unsigned w) { return __builtin_bit_cast(float, w << 16); }
__device__ __forceinline__ float bf_hi(unsigned w) { return __builtin_bit_cast(float, w & 0xffff0000u); }
__device__ __forceinline__ float silu_f(float z) { return z / (1.f + __expf(-z)); }
struct Epi {
    static constexpr bool PERM = true, AFTER_DRAIN = false;
    int mode;
    bf16_t* O; int ldc;
    int tail_pn; float* F; int ldf, nf;
    const float* rstd; const float* ng;
    const float* src_lat; const float* src_ctx; float* dst_lat; float* dst_ctx; const float* mod; int gidx;
    __device__ __forceinline__ void operator()(const f32x4 (&acc)[2][2][4][2], const Unit& u, int wr, int wc, int fr, int fq) const {
        const int row0 = u.pm * BM + wr * 64 + fr; const int col0 = u.pn * BM + wc * 32 + 8 * fq;
        if (mode <= 1) {
            if (u.pn == tail_pn) {
                const int c0 = wc * 32 + 8 * fq;
#pragma unroll
                for (int ai = 0; ai < 2; ++ai)
#pragma unroll
                    for (int m = 0; m < 4; ++m)
#pragma unroll
                        for (int bj = 0; bj < 2; ++bj) { const int cc = c0 + bj * HALF;
                            if (cc < nf) { float* p = F + (size_t)(row0 + ai * HALF + m * 16) * ldf + cc; *(f32x4*)p = acc[ai][bj][m][0]; *(f32x4*)(p + 4) = acc[ai][bj][m][1]; } }
            } else {
#pragma unroll
                for (int ai = 0; ai < 2; ++ai)
#pragma unroll
                    for (int m = 0; m < 4; ++m) { bf16_t* rowp = O + (size_t)(row0 + ai * HALF + m * 16) * ldc + col0;
#pragma unroll
                        for (int bj = 0; bj < 2; ++bj) { f32x4 v0 = acc[ai][bj][m][0], v1 = acc[ai][bj][m][1];
                            if (mode == 1) {
#pragma unroll
                                for (int e = 0; e < 4; ++e) { float a = fmaxf(v0[e], 0.f), b = fmaxf(v1[e], 0.f); v0[e] = a * a; v1[e] = b * b; } }
                            u32x4 w; w.x = cvtpk_s(v0[0], v0[1]); w.y = cvtpk_s(v0[2], v0[3]); w.z = cvtpk_s(v1[0], v1[1]); w.w = cvtpk_s(v1[2], v1[3]);
                            *(u32x4*)(rowp + bj * HALF) = w; } }
            }
        } else if (mode == 2) {
            const f32x4 g0 = *(const f32x4*)(ng + (col0 & 127)), g1 = *(const f32x4*)(ng + (col0 & 127) + 4);
#pragma unroll
            for (int ai = 0; ai < 2; ++ai)
#pragma unroll
                for (int m = 0; m < 4; ++m) { const int row = row0 + ai * HALF + m * 16; bf16_t* rowp = O + (size_t)row * ldc + col0;
#pragma unroll
                    for (int bj = 0; bj < 2; ++bj) { const float rs = rstd[(size_t)row * 16 + ((col0 + bj * HALF) >> 7)];
                        const u32x4 ov = *(const u32x4*)(rowp + bj * HALF); const f32x4 z0 = acc[ai][bj][m][0], z1 = acc[ai][bj][m][1];
                        float r[8];
                        r[0] = bf_lo(ov.x) * rs * g0[0] * silu_f(z0[0]); r[1] = bf_hi(ov.x) * rs * g0[1] * silu_f(z0[1]);
                        r[2] = bf_lo(ov.y) * rs * g0[2] * silu_f(z0[2]); r[3] = bf_hi(ov.y) * rs * g0[3] * silu_f(z0[3]);
                        r[4] = bf_lo(ov.z) * rs * g1[0] * silu_f(z1[0]); r[5] = bf_hi(ov.z) * rs * g1[1] * silu_f(z1[1]);
                        r[6] = bf_lo(ov.w) * rs * g1[2] * silu_f(z1[2]); r[7] = bf_hi(ov.w) * rs * g1[3] * silu_f(z1[3]);
                        u32x4 w; w.x = cvtpk_s(r[0], r[1]); w.y = cvtpk_s(r[2], r[3]); w.z = cvtpk_s(r[4], r[5]); w.w = cvtpk_s(r[6], r[7]);
                        *(u32x4*)(rowp + bj * HALF) = w; } }
        } else {
            const int mi = u.pm < 64 ? 0 : (u.pm < 128 ? 1 : 2);
            const float* gate = mod + (size_t)mi * 6144 + (size_t)gidx * 1024;
            const bool lat = u.pm < 128;
            const float* sb = lat ? src_lat : src_ctx - (size_t)32768 * 1024; float* db = lat ? dst_lat : dst_ctx - (size_t)32768 * 1024;
#pragma unroll
            for (int bj = 0; bj < 2; ++bj)
#pragma unroll
                for (int n = 0; n < 2; ++n) { const int c = col0 + bj * HALF + 4 * n; const f32x4 gv = *(const f32x4*)(gate + c);
#pragma unroll
                    for (int ai = 0; ai < 2; ++ai)
#pragma unroll
                        for (int m = 0; m < 4; ++m) { const size_t off = (size_t)(row0 + ai * HALF + m * 16) * 1024 + c;
                            const f32x4 s = *(const f32x4*)(sb + off); *(f32x4*)(db + off) = s + gv * acc[ai][bj][m][n]; } }
        }
    }
};
template <class Epi, class Sched, bool ALIGN_EPI = false, bool SP2 = false>
__device__ __forceinline__ void gemm_phase(PG8_LAS unsigned char* lds, const Gemm g, const Sched& S, const Epi& E) {
    const int tid = opaque_tid(), wid = __builtin_amdgcn_readfirstlane(tid >> 6), lane = tid & 63, wr = wid >> 2, wc = wid & 3, fr = lane & 15, fq = lane >> 4;
    const int K = g.K, nt = K / BK;
    unsigned voffA[2], voffB[2];
#pragma unroll
    for (int i = 0; i < 2; ++i) { int R, C; stage_rc(tid * 16 + i * 8192, R, C); const int Rb = Epi::PERM ? ((R & ~31) + perm32(R & 31)) : R;
        voffA[i] = (unsigned)(R * K + C) * 2u; voffB[i] = (unsigned)(Rb * K + C) * 2u; }
    const size_t kstep = (size_t)(BK * 2);
    const size_t hstep = (size_t)HALF * K * 2;
    const size_t tstep = 2 * hstep;
    const unsigned ldsw = (unsigned)wid * 1024u;
    const int aoff = lds_byte(wr * 64 + fr, fq * 8), boff = lds_byte(wc * 32 + fr, fq * 8);
#define PG8_SA(b, h) (((b) * 2 + (h)) * HTB)
#define PG8_SB(b, h) ((4 + (b) * 2 + (h)) * HTB)
#define PG8_STAGE(bufoff, gbase, voff) do { _Pragma("unroll") for (int _i = 0; _i < 2; ++_i) \
        __builtin_amdgcn_global_load_lds((const unsigned*)((const char*)(gbase) + (voff)[_i]), (PG8_LAS unsigned*)(lds + (bufoff) + ldsw + _i * 8192), 16, 0, 0); } while (0)
#define PG8_LDA(dst, b, h) do { _Pragma("unroll") for (int m = 0; m < 4; ++m) _Pragma("unroll") for (int k = 0; k < 2; ++k) dst[m][k] = *(const PG8_LAS bf16x8*)(lds + PG8_SA(b, h) + aoff + m * 2048 + k * 1024); } while (0)
#define PG8_LDB(dst, b, h) do { _Pragma("unroll") for (int n = 0; n < 2; ++n) _Pragma("unroll") for (int k = 0; k < 2; ++k) dst[n][k] = *(const PG8_LAS bf16x8*)(lds + PG8_SB(b, h) + boff + n * 2048 + k * 1024); } while (0)
#define PG8_MMA(ai, bj, At, Bt) do { __builtin_amdgcn_s_setprio(1); _Pragma("unroll") for (int m = 0; m < 4; ++m) _Pragma("unroll") for (int n = 0; n < 2; ++n) _Pragma("unroll") for (int k = 0; k < 2; ++k) \
        acc[ai][bj][m][n] = __builtin_amdgcn_mfma_f32_16x16x32_bf16(Bt[n][k], At[m][k], acc[ai][bj][m][n], 0, 0, 0); __builtin_amdgcn_s_setprio(0); } while (0)
#define PG8_WAIT_V(n) asm volatile("s_waitcnt vmcnt(" #n ")" ::: "memory")
#define PG8_WAIT_L(n) asm volatile("s_waitcnt lgkmcnt(" #n ")" ::: "memory")
#define PG8_BAR __builtin_amdgcn_s_barrier()
#define PG8_SCHED __builtin_amdgcn_sched_barrier(0)
    Unit cur, nxt; int ui = 0;
    if (!S.next(0, cur)) return;
    f32x4 acc[2][2][4][2];
#pragma unroll
    for (int a = 0; a < 2; ++a)
#pragma unroll
        for (int b = 0; b < 2; ++b)
#pragma unroll
            for (int m = 0; m < 4; ++m)
#pragma unroll
                for (int n = 0; n < 2; ++n) acc[a][b][m][n] = (f32x4){0.f, 0.f, 0.f, 0.f};
    bf16x8 At[4][2], B0[2][2], B1[2][2];
    const char* cA = (const char*)g.A + (size_t)cur.pm * tstep; const char* cB = (const char*)g.Bt + (size_t)cur.pn * tstep;
    S.a_ready(cur);
    if constexpr (SP2) {
        PG8_STAGE(PG8_SB(0, 0), cB, voffB); PG8_STAGE(PG8_SB(0, 1), cB + hstep, voffB); PG8_STAGE(PG8_SA(0, 0), cA, voffA); PG8_STAGE(PG8_SA(0, 1), cA + hstep, voffA);
        if (wr == 1) PG8_BAR;
        PG8_WAIT_V(2); PG8_BAR;
        PG8_STAGE(PG8_SB(1, 0), cB + kstep, voffB); PG8_STAGE(PG8_SA(1, 0), cA + kstep, voffA); PG8_STAGE(PG8_SB(1, 1), cB + hstep + kstep, voffB);
        PG8_WAIT_V(6); PG8_BAR;
    } else {
        PG8_STAGE(PG8_SB(0, 0), cB, voffB); PG8_STAGE(PG8_SA(0, 0), cA, voffA); PG8_STAGE(PG8_SB(0, 1), cB + hstep, voffB); PG8_STAGE(PG8_SA(0, 1), cA + hstep, voffA);
        if (wr == 1) PG8_BAR;
        PG8_WAIT_V(4); PG8_BAR;
        PG8_STAGE(PG8_SB(1, 0), cB + kstep, voffB); PG8_STAGE(PG8_SA(1, 0), cA + kstep, voffA); PG8_STAGE(PG8_SB(1, 1), cB + hstep + kstep, voffB);
        PG8_WAIT_V(6); PG8_BAR;
    }
    for (;;) {
        const bool has_next = S.next(ui + 1, nxt);
        const char* nA = has_next ? (const char*)g.A + (size_t)nxt.pm * tstep : cA; const char* nB = has_next ? (const char*)g.Bt + (size_t)nxt.pn * tstep : cB;
        for (int t = 0; t < nt; t += 2) {
            const bool last = (t == nt - 2);
            const char* a1 = cA + (size_t)(t + 1) * kstep;
            const char* a2 = last ? nA : cA + (size_t)(t + 2) * kstep; const char* b2 = last ? nB : cB + (size_t)(t + 2) * kstep;
            const char* a3 = a2 + kstep; const char* b3 = b2 + kstep;
            if (last && has_next) S.a_ready(nxt);
            if constexpr (SP2) {
            PG8_LDB(B0, 0, 0); PG8_LDB(B1, 0, 1); PG8_SCHED; PG8_LDA(At, 0, 0); PG8_STAGE(PG8_SA(1, 1), a1 + hstep, voffA);
            PG8_WAIT_V(8); PG8_WAIT_L(0); PG8_BAR; PG8_MMA(0, 0, At, B0); PG8_MMA(0, 1, At, B1); PG8_BAR; PG8_SCHED;
            PG8_LDA(At, 0, 1); PG8_STAGE(PG8_SB(0, 0), b2, voffB); PG8_STAGE(PG8_SB(0, 1), b2 + hstep, voffB); PG8_STAGE(PG8_SA(0, 0), a2, voffA);
            PG8_WAIT_V(8); PG8_WAIT_L(0); PG8_BAR; PG8_MMA(1, 0, At, B0); PG8_MMA(1, 1, At, B1); PG8_BAR; PG8_SCHED;
            PG8_LDB(B0, 1, 0); PG8_LDB(B1, 1, 1); PG8_SCHED; PG8_LDA(At, 1, 0); PG8_STAGE(PG8_SA(0, 1), a2 + hstep, voffA);
            PG8_WAIT_V(8); PG8_WAIT_L(0); PG8_BAR; PG8_MMA(0, 0, At, B0); PG8_MMA(0, 1, At, B1); PG8_BAR; PG8_SCHED;
            PG8_LDA(At, 1, 1); PG8_STAGE(PG8_SB(1, 0), b3, voffB); PG8_STAGE(PG8_SB(1, 1), b3 + hstep, voffB); PG8_STAGE(PG8_SA(1, 0), a3, voffA);
            PG8_WAIT_V(8); PG8_WAIT_L(0); PG8_BAR; PG8_MMA(1, 0, At, B0); PG8_MMA(1, 1, At, B1); PG8_BAR; PG8_SCHED;
            } else {
            PG8_LDB(B0, 0, 0); PG8_SCHED; PG8_LDA(At, 0, 0); PG8_STAGE(PG8_SA(1, 1), a1 + hstep, voffA);
            PG8_WAIT_L(8); PG8_BAR; PG8_WAIT_L(0); PG8_MMA(0, 0, At, B0); PG8_BAR; PG8_SCHED;
            PG8_LDB(B1, 0, 1); PG8_STAGE(PG8_SB(0, 0), b2, voffB);
            PG8_BAR; PG8_WAIT_L(0); PG8_MMA(0, 1, At, B1); PG8_BAR;
            PG8_LDA(At, 0, 1); PG8_STAGE(PG8_SA(0, 0), a2, voffA);
            PG8_BAR; PG8_WAIT_L(0); PG8_MMA(1, 0, At, B0); PG8_BAR; PG8_SCHED;
            PG8_STAGE(PG8_SB(0, 1), b2 + hstep, voffB);
            PG8_WAIT_V(6); PG8_BAR; PG8_MMA(1, 1, At, B1); PG8_BAR;
            PG8_LDB(B0, 1, 0); PG8_SCHED; PG8_LDA(At, 1, 0); PG8_STAGE(PG8_SA(0, 1), a2 + hstep, voffA);
            PG8_WAIT_L(8); PG8_BAR; PG8_WAIT_L(0); PG8_MMA(0, 0, At, B0); PG8_BAR; PG8_SCHED;
            PG8_LDB(B1, 1, 1); PG8_STAGE(PG8_SB(1, 0), b3, voffB);
            PG8_BAR; PG8_WAIT_L(0); PG8_MMA(0, 1, At, B1); PG8_BAR;
            PG8_LDA(At, 1, 1); PG8_STAGE(PG8_SA(1, 0), a3, voffA);
            PG8_BAR; PG8_WAIT_L(0); PG8_MMA(1, 0, At, B0); PG8_BAR; PG8_SCHED;
            PG8_STAGE(PG8_SB(1, 1), b3 + hstep, voffB);
            PG8_WAIT_V(6); PG8_BAR; PG8_MMA(1, 1, At, B1); PG8_BAR;
            }
        }
        if constexpr (ALIGN_EPI) { if (wr == 0) PG8_BAR; }
        if constexpr (!Epi::AFTER_DRAIN) { E(acc, cur, wr, wc, fr, fq); S.done(cur); }
        if (!has_next) break;
#pragma unroll
        for (int a = 0; a < 2; ++a)
#pragma unroll
            for (int b = 0; b < 2; ++b)
#pragma unroll
                for (int m = 0; m < 4; ++m)
#pragma unroll
                    for (int n = 0; n < 2; ++n) acc[a][b][m][n] = (f32x4){0.f, 0.f, 0.f, 0.f};
        cur = nxt; cA = nA; cB = nB; ++ui;
        if constexpr (ALIGN_EPI) { if (wr == 1) PG8_BAR; }
    }
    PG8_WAIT_V(0);
    if constexpr (!ALIGN_EPI) { if (wr == 0) PG8_BAR; }
    PG8_BAR;
    if constexpr (Epi::AFTER_DRAIN) { E.fused(acc, cur, wr, wc, fr, fq, lds, wid, lane); S.done(cur); }
#undef PG8_SA
#undef PG8_SB
#undef PG8_STAGE
#undef PG8_LDA
#undef PG8_LDB
#undef PG8_MMA
#undef PG8_WAIT_V
#undef PG8_WAIT_L
#undef PG8_BAR
#undef PG8_SCHED
}
}
namespace attn {
using bf16 = __hip_bfloat16;
constexpr int   D = 128, NW = 8, QBLK = 32, KVBLK = 64;
constexpr float SCALE = 0.088388347648318440f;
constexpr float THR = 8.f;
constexpr int SDEPTH = 2;
constexpr int LDQ = 1024, LDK = 128, LDO = 1024;
constexpr size_t SHM_V = KVBLK * D * 2, SHM_K = KVBLK * D * 2, SHM_ATTN = 2 * SHM_V + 2 * SHM_K + NW * 64 * 4;
using bf16x8 = __attribute__((ext_vector_type(8))) short;
using s16x4  = __attribute__((ext_vector_type(4))) short;
using f32x16 = __attribute__((ext_vector_type(16))) float;
using f32x8  = __attribute__((ext_vector_type(8))) float;
using u32x4  = __attribute__((ext_vector_type(4))) unsigned;
#define KSWZ(row, colB) ((row) * 256 + ((colB) ^ (((row) & 7) << 4)))
#define SBAR() __builtin_amdgcn_sched_barrier(0)
__device__ __forceinline__ int crow(int r, int hi) { return (r & 3) + 8 * (r >> 2) + 4 * hi; }
__device__ __forceinline__ unsigned cvtpk(float lo, float hi) {
  unsigned r; asm volatile("v_cvt_pk_bf16_f32 %0, %1, %2" : "=v"(r) : "v"(lo), "v"(hi)); return r;
}
template <typename TIn> struct Stage;
template <> struct Stage<bf16>  { using T = bf16x8;
  __device__ static __forceinline__ T ld8(const bf16* p) { return *reinterpret_cast<const bf16x8*>(p); }
  __device__ static __forceinline__ bf16x8 tobf(T x) { return x; } };
template <> struct Stage<float> { using T = f32x8;
  __device__ static __forceinline__ T ld8(const float* p) { return *reinterpret_cast<const f32x8*>(p); }
  __device__ static __forceinline__ bf16x8 tobf(T x) {
    u32x4 w = {cvtpk(x[0], x[1]), cvtpk(x[2], x[3]), cvtpk(x[4], x[5]), cvtpk(x[6], x[7])}; return *reinterpret_cast<bf16x8*>(&w); } };

__device__ __forceinline__ void partialSM(f32x16& p0, f32x16& p1, float& m_reg, float& mn, float& alpha) {
  constexpr float C = SCALE * 1.4426950408889634f;
  float pmax = p0[0]; for (int r = 1; r < 16; ++r) pmax = fmaxf(pmax, p0[r]); for (int r = 0; r < 16; ++r) pmax = fmaxf(pmax, p1[r]);
  { auto rr = __builtin_amdgcn_permlane32_swap(__float_as_uint(pmax), __float_as_uint(pmax), false, false);
    pmax = fmaxf(__uint_as_float(rr[0]), __uint_as_float(rr[1])); }
  if (__builtin_expect(__all(pmax - m_reg <= THR / SCALE), 1)) { mn = m_reg; alpha = 1.f; }
  else { mn = fmaxf(m_reg, pmax); alpha = __builtin_amdgcn_exp2f((m_reg - mn) * C); m_reg = mn; }
  float mnC = -mn * C;
  for (int r = 0; r < 16; ++r) p0[r] = fmaf(p0[r], C, mnC); for (int r = 0; r < 16; ++r) p1[r] = fmaf(p1[r], C, mnC);
  for (int r = 0; r < 16; ++r) p0[r] = __builtin_amdgcn_exp2f(p0[r]);
}
__device__ __forceinline__ void finishSM(f32x16& p0, f32x16& p1, float alpha, float& l_reg, bf16x8& pa0, bf16x8& pa1, bf16x8& pa2, bf16x8& pa3) {
  for (int r = 0; r < 16; ++r) p1[r] = __builtin_amdgcn_exp2f(p1[r]);
  float ps = 0; for (int r = 0; r < 16; ++r) ps += p0[r]; for (int r = 0; r < 16; ++r) ps += p1[r];
  { auto rr = __builtin_amdgcn_permlane32_swap(__float_as_uint(ps), __float_as_uint(ps), false, false);
    ps = __uint_as_float(rr[0]) + __uint_as_float(rr[1]); }
  l_reg = l_reg * alpha + ps;
#define PK4(P, BASE, OUT) do { unsigned a0 = cvtpk(P[BASE + 0], P[BASE + 1]), a1 = cvtpk(P[BASE + 2], P[BASE + 3]);   \
    unsigned b0 = cvtpk(P[BASE + 4], P[BASE + 5]), b1 = cvtpk(P[BASE + 6], P[BASE + 7]);                              \
    auto r0 = __builtin_amdgcn_permlane32_swap(a0, b0, false, false); auto r1 = __builtin_amdgcn_permlane32_swap(a1, b1, false, false); \
    u32x4 w = {r0[0], r1[0], r0[1], r1[1]}; OUT = *reinterpret_cast<bf16x8*>(&w); } while (0)
  PK4(p0, 0, pa0); PK4(p0, 8, pa1); PK4(p1, 0, pa2); PK4(p1, 8, pa3);
#undef PK4
}
__device__ __forceinline__ void qkt(f32x16& p0, f32x16& p1, const bf16* Ks, const bf16x8* qr, int r32, int hi) {
  p0 = f32x16{}; p1 = f32x16{};
  for (int d0 = 0; d0 < 8; ++d0) { int cb = (d0 * 16 + hi * 8) * 2;
    bf16x8 b0 = *reinterpret_cast<const bf16x8*>((const char*)Ks + KSWZ(r32, cb));
    bf16x8 b1 = *reinterpret_cast<const bf16x8*>((const char*)Ks + KSWZ(32 + r32, cb));
    p0 = __builtin_amdgcn_mfma_f32_32x32x16_bf16(b0, qr[d0], p0, 0, 0, 0);
    p1 = __builtin_amdgcn_mfma_f32_32x32x16_bf16(b1, qr[d0], p1, 0, 0, 0); }
}
__device__ __forceinline__ int v_st(int k, int c) { const int kk = (k & ~0xC) | ((k & 4) << 1) | ((k & 8) >> 1); return ((kk >> 3) * 4 + (c >> 5)) * 512 + ((kk & 7) * 32 + (c & 31)) * 2; }
__device__ __forceinline__ int v_rd_base(int lane) { return ((lane & 3) << 3) | (((lane >> 2) & 3) << 6) | (((lane >> 4) & 1) << 5) | (((lane >> 5) & 1) << 8); }
constexpr int v_rd_off(int d0, int ks, int half) { return d0 * 512 + ks * 4096 + half * 2048; }
template <int OFF> __device__ __forceinline__ s16x4 tr_read(int vb) {
  s16x4 r; asm volatile("ds_read_b64_tr_b16 %0, %1 offset:%2" : "=&v"(r) : "v"(vb), "i"(OFF) : "memory"); return r;
}
template <int D0> __device__ __forceinline__ void pv_one(f32x16& od, int vb, bf16x8 pa0, bf16x8 pa1, bf16x8 pa2, bf16x8 pa3) {
  const s16x4 l0 = tr_read<v_rd_off(D0, 0, 0)>(vb), h0 = tr_read<v_rd_off(D0, 0, 1)>(vb), l1 = tr_read<v_rd_off(D0, 1, 0)>(vb), h1 = tr_read<v_rd_off(D0, 1, 1)>(vb);
  const s16x4 l2 = tr_read<v_rd_off(D0, 2, 0)>(vb), h2 = tr_read<v_rd_off(D0, 2, 1)>(vb), l3 = tr_read<v_rd_off(D0, 3, 0)>(vb), h3 = tr_read<v_rd_off(D0, 3, 1)>(vb);
  asm volatile("s_waitcnt lgkmcnt(0)" ::: "memory"); SBAR();
#define PK(L, H) (bf16x8){L[0], L[1], L[2], L[3], H[0], H[1], H[2], H[3]}
  od = __builtin_amdgcn_mfma_f32_32x32x16_bf16(pa0, PK(l0, h0), od, 0, 0, 0);
  od = __builtin_amdgcn_mfma_f32_32x32x16_bf16(pa1, PK(l1, h1), od, 0, 0, 0);
  od = __builtin_amdgcn_mfma_f32_32x32x16_bf16(pa2, PK(l2, h2), od, 0, 0, 0);
  od = __builtin_amdgcn_mfma_f32_32x32x16_bf16(pa3, PK(l3, h3), od, 0, 0, 0);
#undef PK
}
__device__ __forceinline__ void pv_d0(f32x16* o, int vb, bf16x8 pa0, bf16x8 pa1, bf16x8 pa2, bf16x8 pa3) {
  pv_one<0>(o[0], vb, pa0, pa1, pa2, pa3); pv_one<1>(o[1], vb, pa0, pa1, pa2, pa3); pv_one<2>(o[2], vb, pa0, pa1, pa2, pa3); pv_one<3>(o[3], vb, pa0, pa1, pa2, pa3);
}

template <typename TQ>
__device__ __forceinline__ void attn_dense_body(const TQ* __restrict__ Qb, const bf16* __restrict__ Kh, const bf16* __restrict__ Vh,
                                                bf16* __restrict__ Ob, int seq, char* lds) {
  using St = Stage<bf16>; using SQ = Stage<TQ>;
  const int tid = opaque_tid(), wid = tid >> 6, lane = tid & 63, r32 = lane & 31, hi = lane >> 5;
  bf16* V_lds = (bf16*)lds; bf16* K_lds = (bf16*)(lds + 2 * SHM_V);
  float* ws = (float*)(lds + 2 * SHM_V + 2 * SHM_K) + wid * 64; float* li_l = ws; float* al_l = ws + 32;
  float m_reg = -1e30f, l_reg = 0; f32x16 o[4] = {}; bf16x8 qr[8];
  const TQ* Qw = Qb + (long)(wid * QBLK + r32) * LDQ + hi * 8;
#pragma unroll
  for (int d0 = 0; d0 < 8; ++d0) qr[d0] = SQ::tobf(SQ::ld8(Qw + d0 * 16));
  const int sr = tid >> 4, sc = (tid & 15) * 8, vst0 = v_st(sr, sc), vst1 = v_st(32 + sr, sc);
  const int vb0 = (int)(uintptr_t)V_lds + v_rd_base(lane);
  struct { typename St::T vs0, vs1, ks0, ks1; } sr_[SDEPTH];
#define SLOAD(i, k0) do { sr_[i].vs0 = St::ld8(&Vh[(long)((k0) + sr) * LDK + sc]); sr_[i].vs1 = St::ld8(&Vh[(long)((k0) + 32 + sr) * LDK + sc]); \
    sr_[i].ks0 = St::ld8(&Kh[(long)((k0) + sr) * LDK + sc]); sr_[i].ks1 = St::ld8(&Kh[(long)((k0) + 32 + sr) * LDK + sc]); } while (0)
#define SWRITE(b, i) do { *(bf16x8*)((char*)V_lds + (b) * SHM_V + vst0) = St::tobf(sr_[i].vs0);          \
    *(bf16x8*)((char*)V_lds + (b) * SHM_V + vst1) = St::tobf(sr_[i].vs1); int kc = sc * 2;               \
    *(bf16x8*)((char*)K_lds + (b) * SHM_K + KSWZ(sr, kc)) = St::tobf(sr_[i].ks0);                       \
    *(bf16x8*)((char*)K_lds + (b) * SHM_K + KSWZ(32 + sr, kc)) = St::tobf(sr_[i].ks1); } while (0)
#define SWAIT() do { if constexpr (SDEPTH == 2) asm volatile("s_waitcnt vmcnt(4)" ::: "memory"); else asm volatile("s_waitcnt vmcnt(0)" ::: "memory"); } while (0)
#define RESC(a) do { if (__any((a) < 1.f)) { if (hi == 0) al_l[r32] = (a); asm volatile("s_waitcnt lgkmcnt(0)" ::: "memory"); \
    for (int d = 0; d < 4; ++d) for (int r = 0; r < 16; ++r) o[d][r] *= al_l[crow(r, hi)]; } } while (0)
  f32x16 pA0, pA1, pB0, pB1; float mnA, mnB, alA, alB; bf16x8 pa0, pa1, pa2, pa3; const int NT = seq / KVBLK;
  constexpr int SE = 0, SO = SDEPTH - 1;
  SLOAD(SE, 0); asm volatile("s_waitcnt vmcnt(0)" ::: "memory"); SWRITE(0, SE); __syncthreads();
  qkt(pA0, pA1, K_lds, qr, r32, hi); partialSM(pA0, pA1, m_reg, mnA, alA);
  SLOAD(SO, KVBLK); if constexpr (SDEPTH == 2) { if (2 < NT) SLOAD(SE, 2 * KVBLK); }
  SWAIT(); SWRITE(1, SO); __syncthreads();
  for (int j = 1; j + 1 < NT; j += 2) {
    SBAR(); qkt(pB0, pB1, (bf16*)((char*)K_lds + SHM_K), qr, r32, hi);
    finishSM(pA0, pA1, alA, l_reg, pa0, pa1, pa2, pa3); SBAR();
    SLOAD(SO, (j + SDEPTH) * KVBLK); SBAR();
    pv_d0(o, vb0, pa0, pa1, pa2, pa3); partialSM(pB0, pB1, m_reg, mnB, alB);
    __syncthreads(); SWAIT(); SWRITE(0, SE);
    RESC(alB); __syncthreads();
    SBAR(); qkt(pA0, pA1, K_lds, qr, r32, hi);
    finishSM(pB0, pB1, alB, l_reg, pa0, pa1, pa2, pa3); SBAR();
    if (SDEPTH == 1 || j + 3 < NT) SLOAD(SE, (j + 1 + SDEPTH) * KVBLK); SBAR();
    pv_d0(o, vb0 + (int)SHM_V, pa0, pa1, pa2, pa3); partialSM(pA0, pA1, m_reg, mnA, alA);
    __syncthreads(); SWAIT(); SWRITE(1, SO);
    RESC(alA); __syncthreads();
  }
  SBAR(); qkt(pB0, pB1, (bf16*)((char*)K_lds + SHM_K), qr, r32, hi);
  finishSM(pA0, pA1, alA, l_reg, pa0, pa1, pa2, pa3); SBAR();
  pv_d0(o, vb0, pa0, pa1, pa2, pa3); partialSM(pB0, pB1, m_reg, mnB, alB);
  __syncthreads(); RESC(alB);
  finishSM(pB0, pB1, alB, l_reg, pa0, pa1, pa2, pa3); SBAR();
  pv_d0(o, vb0 + (int)SHM_V, pa0, pa1, pa2, pa3);
  if (hi == 0) li_l[r32] = l_reg; asm volatile("s_waitcnt lgkmcnt(0)" ::: "memory");
  float rli[16];
#pragma unroll
  for (int r = 0; r < 16; ++r) rli[r] = __builtin_amdgcn_rcpf(li_l[crow(r, hi)]);
  bf16* Ow = Ob + (long)(wid * QBLK) * LDO;
#pragma unroll
  for (int r = 0; r < 16; ++r) { int orow = crow(r, hi);
    for (int d0 = 0; d0 < 4; ++d0) Ow[(long)orow * LDO + d0 * 32 + r32] = __float2bfloat16(o[d0][r] * rli[r]); }
#undef SLOAD
#undef SWRITE
#undef SWAIT
#undef RESC
}

}
#define LAS __attribute__((address_space(3)))
typedef unsigned short bf16_t;
typedef short bf16x8 __attribute__((ext_vector_type(8)));
typedef short s16x4 __attribute__((ext_vector_type(4)));
typedef float f32x4 __attribute__((ext_vector_type(4)));
typedef float f32x16 __attribute__((ext_vector_type(16)));
typedef unsigned u32x4 __attribute__((ext_vector_type(4)));
typedef unsigned u32x2 __attribute__((ext_vector_type(2)));
using pg8::cvtpk_s; using pg8::bf_lo; using pg8::bf_hi; using pg8::silu_f;

constexpr int DM = 1024, SEQ = 16384, CTXL = 256, NLAT = 2 * SEQ, MROWS = NLAT + 2 * CTXL, DFF = 4096;
constexpr float EPS = 1e-6f;
constexpr size_t MiB = 1u << 20;
constexpr size_t WS_MOD = 0, WS_CTX = 1 * MiB, WS_WT = 4 * MiB, WS_H = 41 * MiB, WS_AB = 106 * MiB, WS_RSTD = 115 * MiB, WS_P = 118 * MiB, WS_O = 378 * MiB, WS_END = 508 * MiB;
constexpr size_t WT_A = WS_WT, WT_Z = WS_WT + 9 * MiB, WT_O = WS_WT + 13 * MiB, WT_1 = WS_WT + 17 * MiB, WT_2 = WS_WT + 25 * MiB;
constexpr size_t WS_QM = 313 * MiB, WS_KM = 378 * MiB, WS_OGLA = 443 * MiB, WS_AQ = 41 * MiB, WS_EL = 74 * MiB;
constexpr size_t WS_TP = 4 * MiB, WS_HALO = 378 * MiB;
constexpr size_t WS_QR = 216 * MiB, WS_KR = 281 * MiB, WS_VR = 298 * MiB;
constexpr int SKV = SEQ + CTXL;
constexpr int LDS_BYTES = 155648;
enum { OP_MOD, OP_PREP, OP_GEMM_IN, OP_DNSCAN, OP_DNREDO, OP_GEMM_Z, OP_GEMM_OUT, OP_NORM2, OP_FFN1, OP_FFN2, OP_GLAPREP, OP_GLASCAN, OP_GLAGATE, OP_QKROPE, OP_ATTN, OP_DNHALO, OP_DNCONV, OP_DNT };

struct Args { const float* in[25]; float* out; unsigned char* ws; int ph_lo, ph_hi; };

__device__ __forceinline__ float wave_sum(float v) {
#pragma unroll
    for (int o = 1; o < 64; o <<= 1) v += __shfl_xor(v, o);
    return v;
}
__device__ __forceinline__ float softplus_f(float x) { return x > 20.f ? x : log1pf(__expf(x)); }
__device__ __forceinline__ float logsigmoid_f(float x) { return fminf(x, 0.f) - log1pf(__expf(-fabsf(x))); }
__device__ __forceinline__ bf16_t f2bf(float f) { return (bf16_t)(cvtpk_s(f, 0.f) & 0xffffu); }
__device__ __forceinline__ float bf2f(bf16_t v) { return __builtin_bit_cast(float, (unsigned)v << 16); }

__device__ __forceinline__ void transpose_item(const float* W, int ldw, int c0, int ncols, int K, bf16_t* WT, int row_off, LAS float* scr, int item, int lane) {
    const int nblk = ncols / 32, kb = item / nblk, nb = item % nblk, k0 = 64 * kb, n0 = 32 * nb;
#pragma unroll 8
    for (int i = 0; i < 32; ++i) { const int kk = 2 * i + (lane >> 5); scr[kk * 33 + (lane & 31)] = W[(size_t)(k0 + kk) * ldw + c0 + n0 + (lane & 31)]; }
    asm volatile("s_waitcnt lgkmcnt(0)" ::: "memory");
    const int c = lane & 7;
#pragma unroll
    for (int j = 0; j < 4; ++j) { const int n = (lane >> 3) + 8 * j; const LAS float* s = scr + (8 * c) * 33 + n;
        u32x4 o; o.x = cvtpk_s(s[0 * 33], s[1 * 33]); o.y = cvtpk_s(s[2 * 33], s[3 * 33]); o.z = cvtpk_s(s[4 * 33], s[5 * 33]); o.w = cvtpk_s(s[6 * 33], s[7 * 33]);
        *(u32x4*)(WT + (size_t)(row_off + n0 + n) * K + k0 + 8 * c) = o; }
    asm volatile("s_waitcnt lgkmcnt(0)" ::: "memory");
}
__device__ __forceinline__ void transpose_mat(const float* W, int ldw, int c0, int ncols, int K, bf16_t* WT, int row_off, LAS float* scr, int gw, int NGW, int lane) {
    const int nitems = (K / 64) * (ncols / 32);
    for (int it = gw; it < nitems; it += NGW) transpose_item(W, ldw, c0, ncols, K, WT, row_off, scr, it, lane);
}
__device__ __forceinline__ void normmod_rows(const float* xl, const float* xc, const float* g, const float* modl, int sidx, bf16_t* H, int gw, int NGW, int lane) {
    for (int row = gw; row < MROWS; row += NGW) {
        const float* xr = row < NLAT ? xl + (size_t)row * DM : xc + (size_t)(row - NLAT) * DM;
        const int mi = row < SEQ ? 0 : (row < NLAT ? 1 : 2);
        const float* sh = modl + (size_t)mi * 6144 + (size_t)sidx * 1024; const float* sc = sh + 1024;
        f32x4 v[4]; float ss = 0.f;
#pragma unroll
        for (int j = 0; j < 4; ++j) { v[j] = *(const f32x4*)(xr + 4 * lane + 256 * j); ss += (v[j][0] * v[j][0] + v[j][1] * v[j][1]) + (v[j][2] * v[j][2] + v[j][3] * v[j][3]); }
        const float rinv = rsqrtf(wave_sum(ss) * (1.f / DM) + EPS);
#pragma unroll
        for (int j = 0; j < 4; ++j) { const int c = 4 * lane + 256 * j; const f32x4 gg = *(const f32x4*)(g + c), s1 = *(const f32x4*)(sc + c), s0 = *(const f32x4*)(sh + c);
            f32x4 y;
#pragma unroll
            for (int e = 0; e < 4; ++e) y[e] = v[j][e] * rinv * gg[e] * (1.f + s1[e]) + s0[e];
            u32x2 w; w.x = cvtpk_s(y[0], y[1]); w.y = cvtpk_s(y[2], y[3]); *(u32x2*)(H + (size_t)row * DM + c) = w; }
    }
}
#define BAR_LDS() do { asm volatile("s_waitcnt lgkmcnt(0)" ::: "memory"); __builtin_amdgcn_s_barrier(); asm volatile("" ::: "memory"); } while (0)
__device__ __forceinline__ int crow(int x, int h) { return (x & 3) + 8 * (x >> 2) + 4 * h; }
#define MFMA32(a, b, c) __builtin_amdgcn_mfma_f32_32x32x16_bf16((a), (b), (c), 0, 0, 0)
__device__ __forceinline__ bf16x8 frag_nat(const LAS bf16_t* img, int LD, int row, int ks, int h) { return *(const LAS bf16x8*)(img + row * LD + 16 * ks + 8 * h); }
__device__ __forceinline__ bf16x8 frag_perm(const LAS bf16_t* img, int LD, int row, int ks, int h) {
    const s16x4 lo = *(const LAS s16x4*)(img + row * LD + 16 * ks + 4 * h), hi = *(const LAS s16x4*)(img + row * LD + 16 * ks + 8 + 4 * h);
    return __builtin_shufflevector(lo, hi, 0, 1, 2, 3, 4, 5, 6, 7);
}
__device__ __forceinline__ s16x4 tr4(const LAS bf16_t* p) { return __builtin_bit_cast(s16x4, __builtin_amdgcn_ds_read_tr16_b64_v4i16((LAS s16x4*)p)); }
__device__ __forceinline__ bf16x8 frag_tr(const LAS bf16_t* img, int LD, int m0, int ks, int lane) {
    const int i16 = lane & 15, q = i16 >> 2, p = i16 & 3, blk = (lane >> 4) & 1, h = lane >> 5;
    const LAS bf16_t* a = img + (16 * ks + 4 * h + q) * LD + m0 + 16 * blk + 4 * p;
    const s16x4 lo = tr4(a), hi = tr4(a + 8 * LD);
    return __builtin_shufflevector(lo, hi, 0, 1, 2, 3, 4, 5, 6, 7);
}
__device__ __forceinline__ bf16x8 pack_step(const f32x16& x, int s) {
    u32x4 p; p.x = cvtpk_s(x[8 * s + 0], x[8 * s + 1]); p.y = cvtpk_s(x[8 * s + 2], x[8 * s + 3]); p.z = cvtpk_s(x[8 * s + 4], x[8 * s + 5]); p.w = cvtpk_s(x[8 * s + 6], x[8 * s + 7]);
    return __builtin_bit_cast(bf16x8, p);
}
__device__ __forceinline__ void dn_halo_phase(const bf16_t* P, bf16_t* HALO, int G) {
    const int tid = opaque_tid();
    for (size_t e = (size_t)blockIdx.x * 512 + tid; e < (size_t)520 * 4 * 512; e += (size_t)G * 512) {
        const int c = (int)(e & 511), j = (int)((e >> 9) & 3), rb = (int)(e >> 11);
        const int row = rb * 64 + (j < 2 ? j : 60 + j);
        ((u32x4*)(HALO + ((size_t)rb * 4 + j) * 4096))[c] = ((const u32x4*)(P + (size_t)row * 4096))[c];
    }
}
__device__ __forceinline__ void unpack8(const u32x4 v, float (&f)[8]) { f[0] = bf_lo(v.x); f[1] = bf_hi(v.x); f[2] = bf_lo(v.y); f[3] = bf_hi(v.y); f[4] = bf_lo(v.z); f[5] = bf_hi(v.z); f[6] = bf_lo(v.w); f[7] = bf_hi(v.w); }
__device__ __forceinline__ void dn_conv_phase(bf16_t* P, const bf16_t* HALO, const float* conv_w, int G) {
    const int tid = opaque_tid(), col0 = 8 * tid;
    float cw[8][5];
#pragma unroll
    for (int c = 0; c < 8; ++c)
#pragma unroll
        for (int tap = 0; tap < 5; ++tap) cw[c][tap] = conv_w[(size_t)(col0 + c) * 5 + tap];
    const int kind = col0 < 1024 ? 0 : (col0 < 2048 ? 1 : 2);
    for (int rb = blockIdx.x; rb < 520; rb += G) {
        const int cs = rb < 512 ? (rb & 255) : ((rb - 512) & 3); const bool sfirst = cs == 0, slast = rb < 512 ? cs == 255 : cs == 3;
        const u32x4 zero = (u32x4){0u, 0u, 0u, 0u};
        bf16_t* base = P + (size_t)rb * 64 * 4096 + col0;
        u32x4 w0 = sfirst ? zero : *(const u32x4*)(HALO + ((size_t)(rb - 1) * 4 + 2) * 4096 + col0);
        u32x4 w1 = sfirst ? zero : *(const u32x4*)(HALO + ((size_t)(rb - 1) * 4 + 3) * 4096 + col0);
        u32x4 w2 = *(const u32x4*)(base), w3 = *(const u32x4*)(base + 4096);
#pragma unroll 4
        for (int rr = 0; rr < 64; ++rr) {
            u32x4 w4;
            if (rr + 2 < 64) w4 = *(const u32x4*)(base + (size_t)(rr + 2) * 4096);
            else w4 = slast ? zero : *(const u32x4*)(HALO + ((size_t)(rb + 1) * 4 + (rr + 2 - 64)) * 4096 + col0);
            float x0[8], x1[8], x2[8], x3[8], x4[8], y[8];
            unpack8(w0, x0); unpack8(w1, x1); unpack8(w2, x2); unpack8(w3, x3); unpack8(w4, x4);
            float ss = 0.f;
#pragma unroll
            for (int c = 0; c < 8; ++c) { const float a = x0[c] * cw[c][0] + x1[c] * cw[c][1] + x2[c] * cw[c][2] + x3[c] * cw[c][3] + x4[c] * cw[c][4]; y[c] = silu_f(a); ss += y[c] * y[c]; }
            float sc = 1.f;
            if (kind < 2) { ss += __shfl_xor(ss, 1); ss += __shfl_xor(ss, 2); ss += __shfl_xor(ss, 4); ss += __shfl_xor(ss, 8); sc = rsqrtf(ss + EPS) * (kind == 0 ? 0.08838834764831845f : 1.f); }
            u32x4 o; o.x = cvtpk_s(y[0] * sc, y[1] * sc); o.y = cvtpk_s(y[2] * sc, y[3] * sc); o.z = cvtpk_s(y[4] * sc, y[5] * sc); o.w = cvtpk_s(y[6] * sc, y[7] * sc);
            *(u32x4*)(base + (size_t)rr * 4096) = o;
            w0 = w1; w1 = w2; w2 = w3; w3 = w4;
        }
    }
}
constexpr int DT_KB = 0, DT_R = 17408, DT_SC = 33792, DT_DIR = 34816;
template <int W> __device__ __forceinline__ void dn_solve(const LAS float* Mf, float (&t)[16], int lane) {
    const int j = 16 * W + (lane >> 2), q = lane & 3;
#pragma unroll
    for (int s = 0; s < 16; ++s) t[s] = 0.f;
#pragma unroll
    for (int i = 16 * W; i < 64; ++i) {
        float acc = 0.f;
#pragma unroll
        for (int s = 4 * W; s <= (i - 1) / 4 && i > 16 * W; ++s) acc += Mf[i * 64 + 4 * s + q] * t[s];
        acc += __shfl_xor(acc, 1); acc += __shfl_xor(acc, 2);
        const float val = (i == j ? 1.f : 0.f) - acc;
        if (q == (i & 3)) t[i >> 2] = val;
        asm volatile("" : "+v"(t[0]), "+v"(t[1]), "+v"(t[2]), "+v"(t[3]), "+v"(t[4]), "+v"(t[5]), "+v"(t[6]), "+v"(t[7]), "+v"(t[8]), "+v"(t[9]), "+v"(t[10]), "+v"(t[11]), "+v"(t[12]), "+v"(t[13]), "+v"(t[14]), "+v"(t[15]));
    }
}
__device__ __forceinline__ void dn_t_phase(LAS unsigned char* lds, const bf16_t* P, float* AB, bf16_t* TP, const float* a_log, const float* dt_bias, int G) {
    const int tid0 = opaque_tid(), hb = __builtin_amdgcn_readfirstlane(tid0 >> 8);
    for (int itb = blockIdx.x * 2; itb < 16640; itb += 2 * G) {
        const int it = itb + hb, dir = it & 1, vh = (it >> 1) & 15, rb = it >> 5, kh = vh >> 1;
        const int tq = opaque_tid(), t = tq & 255, w = __builtin_amdgcn_readfirstlane((tq >> 6) & 3), lane = tq & 63, r = lane & 31, h = lane >> 5;
        LAS unsigned char* base = lds + hb * DT_DIR;
        LAS bf16_t* Kb = (LAS bf16_t*)(base + DT_KB); LAS float* Mf = (LAS float*)(base + DT_R); LAS bf16_t* Tb = (LAS bf16_t*)(base + DT_R);
        LAS float* sc_beta = (LAS float*)(base + DT_SC); LAS float* sc_gc = sc_beta + 64;
        {
            const int r0 = t >> 4, c8 = 8 * (t & 15);
#pragma unroll
            for (int v = 0; v < 4; ++v) { const int i = r0 + 16 * v, ip = dir ? 63 - i : i;
                *(LAS u32x4*)(Kb + ip * 136 + c8) = *(const u32x4*)(P + (size_t)(rb * 64 + i) * 4096 + 1024 + kh * 128 + c8); }
            if (t < 64) {
                const int ti = dir ? 63 - t : t; float* ab = AB + (size_t)(rb * 64 + ti) * 64;
                const float av = ab[dir * 16 + vh], bv = ab[32 + dir * 16 + vh];
                const float g = -__expf(a_log[dir * 16 + vh]) * softplus_f(av + dt_bias[dir * 16 + vh]), beta = 1.f / (1.f + __expf(-bv));
                float gc = g;
#pragma unroll
                for (int o = 1; o < 64; o <<= 1) { const float up = __shfl_up(gc, o); if (t >= o) gc += up; }
                sc_beta[t] = beta; sc_gc[t] = gc;
                ab[dir * 16 + vh] = gc; ab[32 + dir * 16 + vh] = beta;
            }
        }
        __syncthreads();
        const int ti = w >> 1, tj = w & 1;
        {
            f32x16 acc;
#pragma unroll
            for (int x = 0; x < 16; ++x) acc[x] = 0.f;
            if (!(ti == 0 && tj == 1)) {
#pragma unroll
                for (int ks = 0; ks < 8; ++ks) acc = MFMA32(frag_nat(Kb, 136, 32 * ti + r, ks, h), frag_nat(Kb, 136, 32 * tj + r, ks, h), acc);
            }
            const int j = 32 * tj + r; const float gj = sc_gc[j];
#pragma unroll
            for (int x = 0; x < 16; ++x) { const int i = 32 * ti + crow(x, h);
                Mf[i * 64 + j] = (i > j) ? sc_beta[i] * acc[x] * __expf(sc_gc[i] - gj) : 0.f; }
        }
        __syncthreads();
        float tc[16];
        if (w == 0) dn_solve<0>(Mf, tc, lane); else if (w == 1) dn_solve<1>(Mf, tc, lane); else if (w == 2) dn_solve<2>(Mf, tc, lane); else dn_solve<3>(Mf, tc, lane);
        __syncthreads();
        {
            const int j = 16 * w + (lane >> 2), q = lane & 3;
#pragma unroll
            for (int s = 0; s < 16; ++s) Tb[(4 * s + q) * 72 + j] = f2bf(tc[s]);
        }
        __syncthreads();
        {
            bf16_t* dst = TP + (size_t)it * 3072;
#pragma unroll
            for (int k2 = 0; k2 < 2; ++k2) { const int c = t + 256 * k2;
                if (c < 384) { const int blk = c >> 7, rowc = (c & 127) >> 2, cc = c & 3, br = blk ? 1 : 0, bc = blk == 2 ? 1 : 0;
                    *(u32x4*)(dst + c * 8) = *(const LAS u32x4*)(Tb + (32 * br + rowc) * 72 + 32 * bc + 8 * cc); } }
        }
        __syncthreads();
    }
}
constexpr int DN_KB = 0, DN_QB = 17408, DN_VB = 34816, DN_TB = 51200, DN_AB = 60416, DN_SC = 69632, DN_DIR = 71168;
__device__ __forceinline__ void dn_step_rb(int step, int dir, int b, int& rb, bool& first) {
    if (step < 4) { const int cidx = dir ? 3 - step : step; rb = 512 + b * 4 + cidx; first = step < 2; }
    else { const int c = step - 4; const int cidx = dir ? 255 - c : c; rb = b * 256 + cidx; first = c < 128; }
}
struct DnPre { u32x4 k4[4], q4[4], v4[4], t0, t1; float gc, beta; };
__device__ __forceinline__ void dn_prefetch(DnPre& p, const bf16_t* P, const float* AB, const bf16_t* TP, int rb, int dir, int vh, int kh, int t, int part) {
    const int r0 = t >> 4, c8 = 8 * (t & 15);
    const bf16_t* prow = P + (size_t)(rb * 64 + r0) * 4096 + c8;
    const bf16_t* tp = TP + (size_t)((rb * 16 + vh) * 2 + dir) * 3072;
    if (part & 1) {
#pragma unroll
        for (int v = 0; v < 4; ++v) { const bf16_t* pr = prow + (size_t)(16 * v) * 4096;
            p.k4[v] = *(const u32x4*)(pr + 1024 + kh * 128); p.q4[v] = *(const u32x4*)(pr + kh * 128); p.v4[v] = *(const u32x4*)(pr + 2048 + vh * 128); }
    }
    if (part & 2) {
        p.t0 = *(const u32x4*)(tp + t * 8); p.t1 = *(const u32x4*)(tp + (256 + (t & 127)) * 8);
        const int ti = dir ? 63 - (t & 63) : (t & 63); const float* ab = AB + (size_t)(rb * 64 + ti) * 64; p.gc = ab[dir * 16 + vh]; p.beta = ab[32 + dir * 16 + vh];
    }
}
template <int VAR> __device__ __forceinline__ void dn_scan(LAS unsigned char* lds, const bf16_t* P, const float* AB, const bf16_t* TP, bf16_t* OB) {
    const int tid = opaque_tid(), dir = __builtin_amdgcn_readfirstlane(tid >> 8);
    for (int unit = blockIdx.x; unit < 32; unit += gridDim.x) {
        const int b = unit >> 4, vh = unit & 15, kh = vh >> 1;
        f32x16 S[4];
#pragma unroll
        for (int kt = 0; kt < 4; ++kt)
#pragma unroll
            for (int x = 0; x < 16; ++x) S[kt][x] = 0.f;
        DnPre pre;
        { int rb0; bool f0; dn_step_rb(0, dir, b, rb0, f0); dn_prefetch(pre, P, AB, TP, rb0, dir, vh, kh, tid & 255, 3); }
        __syncthreads();
        for (int step = 0; step < 260; ++step) {
            const int w = __builtin_amdgcn_readfirstlane((opaque_tid() >> 6) & 3);
            LAS unsigned char* base = lds + dir * DN_DIR;
            LAS bf16_t* Kb = (LAS bf16_t*)(base + DN_KB); LAS bf16_t* Qb = (LAS bf16_t*)(base + DN_QB); LAS bf16_t* Vb = (LAS bf16_t*)(base + DN_VB);
            LAS bf16_t* Tb = (LAS bf16_t*)(base + DN_TB); LAS bf16_t* Ab = (LAS bf16_t*)(base + DN_AB);
            LAS float* sc_beta = (LAS float*)(base + DN_SC); LAS float* sc_gc = sc_beta + 64; LAS float* sc_eg = sc_beta + 128; LAS float* sc_tail = sc_beta + 192; LAS float* sc_dl = sc_beta + 256;
            int rb; bool first; dn_step_rb(step, dir, b, rb, first);
            const int row_base = rb * 64;
            {
                const int tq_ = opaque_tid(), t = tq_ & 255;
                const int r0 = t >> 4, c8 = 8 * (t & 15);
#pragma unroll
                for (int v = 0; v < 4; ++v) { const int i = r0 + 16 * v, ip = dir ? 63 - i : i;
                    *(LAS u32x4*)(Kb + ip * 136 + c8) = pre.k4[v]; *(LAS u32x4*)(Qb + ip * 136 + c8) = pre.q4[v]; *(LAS u32x4*)(Vb + ip * 128 + c8) = pre.v4[v]; }
                { const int c = t, blk = c >> 7, rowc = (c & 127) >> 2, cc = c & 3, br = blk ? 1 : 0; *(LAS u32x4*)(Tb + (32 * br + rowc) * 72 + 8 * cc) = pre.t0; }
                if (t < 128) { const int rowc = t >> 2, cc = t & 3; *(LAS u32x4*)(Tb + (32 + rowc) * 72 + 32 + 8 * cc) = pre.t1; }
                if (t < 64) { const float gc = pre.gc, gl = __shfl(gc, 63); sc_beta[t] = pre.beta; sc_gc[t] = gc; sc_eg[t] = __expf(gc); sc_tail[t] = __expf(gl - gc); if (t == 0) sc_dl[0] = __expf(gl); }
            }
            BAR_LDS();
            {
                const int tq_ = opaque_tid(), lane = tq_ & 63, r = lane & 31, h = lane >> 5;
                const int ti = w >> 1, tj = w & 1;
                if (!(ti == 0 && tj == 1)) {
                    f32x16 qk;
#pragma unroll
                    for (int x = 0; x < 16; ++x) qk[x] = 0.f;
#pragma unroll
                    for (int ks = 0; ks < 8; ++ks) qk = MFMA32(frag_nat(Qb, 136, 32 * ti + r, ks, h), frag_nat(Kb, 136, 32 * tj + r, ks, h), qk);
                    const int jj = 32 * tj + r; const float gj = sc_gc[jj];
#pragma unroll
                    for (int x = 0; x < 16; ++x) { const int i = 32 * ti + crow(x, h);
                        Ab[i * 72 + jj] = f2bf((i >= jj) ? qk[x] * __expf(sc_gc[i] - gj) : 0.f); }
                }
            }
            BAR_LDS();
            if (VAR != 2 && step + 1 < 260) { int rbn; bool fn; dn_step_rb(step + 1, dir, b, rbn, fn); dn_prefetch(pre, P, AB, TP, rbn, dir, vh, kh, opaque_tid() & 255, 1); }
            __builtin_amdgcn_sched_barrier(0);
            if (VAR != 1) {
                const int tq_ = opaque_tid(), lane = tq_ & 63, r = lane & 31, h = lane >> 5;
                f32x16 KS[2], QS[2];
#pragma unroll
                for (int mt = 0; mt < 2; ++mt)
#pragma unroll
                    for (int x = 0; x < 16; ++x) { KS[mt][x] = 0.f; QS[mt][x] = 0.f; }
#pragma unroll
                for (int ks = 0; ks < 8; ++ks) {
                    const bf16x8 sp = pack_step(S[ks >> 1], ks & 1);
#pragma unroll
                    for (int mt = 0; mt < 2; ++mt) { KS[mt] = MFMA32(frag_perm(Kb, 136, 32 * mt + r, ks, h), sp, KS[mt]); QS[mt] = MFMA32(frag_perm(Qb, 136, 32 * mt + r, ks, h), sp, QS[mt]); }
                    if (ks & 1) __builtin_amdgcn_sched_barrier(0);
                }
#pragma unroll
                for (int mt = 0; mt < 2; ++mt)
#pragma unroll
                    for (int x = 0; x < 16; ++x) { const int i = 32 * mt + crow(x, h);
                        KS[mt][x] = sc_beta[i] * (bf2f(Vb[i * 128 + 32 * w + r]) - sc_eg[i] * KS[mt][x]); }
                __builtin_amdgcn_sched_barrier(0);
                bf16x8 Xp[4];
#pragma unroll
                for (int ks = 0; ks < 4; ++ks) Xp[ks] = pack_step(KS[ks >> 1], ks & 1);
                f32x16 VN[2];
#pragma unroll
                for (int mt = 0; mt < 2; ++mt) {
#pragma unroll
                    for (int x = 0; x < 16; ++x) VN[mt][x] = 0.f;
#pragma unroll
                    for (int ks = 0; ks < 4; ++ks) if (ks < 2 * mt + 2) VN[mt] = MFMA32(frag_perm(Tb, 72, 32 * mt + r, ks, h), Xp[ks], VN[mt]);
                }
                __builtin_amdgcn_sched_barrier(0);
                if (VAR != 2 && step + 1 < 260) { int rbn; bool fn; dn_step_rb(step + 1, dir, b, rbn, fn); dn_prefetch(pre, P, AB, TP, rbn, dir, vh, kh, opaque_tid() & 255, 2); }
                __builtin_amdgcn_sched_barrier(0);
                bf16x8 VNp[4];
#pragma unroll
                for (int ks = 0; ks < 4; ++ks) VNp[ks] = pack_step(VN[ks >> 1], ks & 1);
#pragma unroll
                for (int mt = 0; mt < 2; ++mt) {
#pragma unroll
                    for (int x = 0; x < 16; ++x) QS[mt][x] *= sc_eg[32 * mt + crow(x, h)];
#pragma unroll
                    for (int ks = 0; ks < 4; ++ks) if (ks < 2 * mt + 2) QS[mt] = MFMA32(frag_perm(Ab, 72, 32 * mt + r, ks, h), VNp[ks], QS[mt]);
                }
                __builtin_amdgcn_sched_barrier(0);
#pragma unroll
                for (int mt = 0; mt < 2; ++mt)
#pragma unroll
                    for (int x = 0; x < 16; ++x) Vb[(32 * mt + crow(x, h)) * 128 + 32 * w + r] = f2bf(QS[mt][x]);
                __builtin_amdgcn_sched_barrier(0);
#pragma unroll
                for (int mt = 0; mt < 2; ++mt)
#pragma unroll
                    for (int x = 0; x < 16; ++x) VN[mt][x] *= sc_tail[32 * mt + crow(x, h)];
#pragma unroll
                for (int ks = 0; ks < 4; ++ks) VNp[ks] = pack_step(VN[ks >> 1], ks & 1);
                __builtin_amdgcn_sched_barrier(0);
                const float dl = sc_dl[0];
#pragma unroll
                for (int kt = 0; kt < 4; ++kt)
#pragma unroll
                    for (int x = 0; x < 16; ++x) S[kt][x] *= dl;
#pragma unroll
                for (int ks = 0; ks < 4; ++ks) {
#pragma unroll
                    for (int kt = 0; kt < 4; ++kt) S[kt] = MFMA32(frag_tr(Kb, 136, 32 * kt, ks, lane), VNp[ks], S[kt]);
                    __builtin_amdgcn_sched_barrier(0);
                }
                if (VAR != 2) {
                    const int rr_ = lane >> 2, c8_ = 8 * (lane & 3);
#pragma unroll
                    for (int v = 0; v < 4; ++v) { const int ip_ = rr_ + 16 * v, i_ = dir ? 63 - ip_ : ip_;
                        u32x4* gp_ = (u32x4*)(OB + (size_t)(row_base + i_) * 2048 + vh * 128 + 32 * w + c8_);
                        u32x4 o = *(const LAS u32x4*)(Vb + ip_ * 128 + 32 * w + c8_);
                        if (!first) { const u32x4 e = gp_[0];
                            o.x = cvtpk_s(bf_lo(o.x) + bf_lo(e.x), bf_hi(o.x) + bf_hi(e.x)); o.y = cvtpk_s(bf_lo(o.y) + bf_lo(e.y), bf_hi(o.y) + bf_hi(e.y));
                            o.z = cvtpk_s(bf_lo(o.z) + bf_lo(e.z), bf_hi(o.z) + bf_hi(e.z)); o.w = cvtpk_s(bf_lo(o.w) + bf_lo(e.w), bf_hi(o.w) + bf_hi(e.w)); }
                        gp_[0] = o; }
                }
            }
            if (step == 1 || step == 131) asm volatile("s_waitcnt vmcnt(0)" ::: "memory");
            BAR_LDS();
        }
    }
}
constexpr int GP_QM = 0, GP_KM = 17408, GP_AB = 34816, GP_LOW = 44032, GP_TOT = 48128, GP_DIR = 49152;
__device__ __forceinline__ void gla_prep_phase(LAS unsigned char* lds, const bf16_t* P, const float* LOW, const float* gw2, const float* gb2, bf16_t* QM, bf16_t* KM, bf16_t* AQ, float* EL, int G) {
    const int tid0 = opaque_tid(), hb = __builtin_amdgcn_readfirstlane(tid0 >> 8);
    for (int itb = blockIdx.x * 2; itb < 4160; itb += 2 * G) {
        const int it = itb + hb, dir = it & 1, head = (it >> 1) & 3, rb = it >> 3;
        const int tq = opaque_tid(), t = tq & 255, w = __builtin_amdgcn_readfirstlane((tq >> 6) & 3), lane = tq & 63, r = lane & 31, h = lane >> 5;
        LAS unsigned char* base = lds + hb * GP_DIR;
        LAS bf16_t* Qm = (LAS bf16_t*)(base + GP_QM); LAS bf16_t* Km = (LAS bf16_t*)(base + GP_KM); LAS bf16_t* Ab = (LAS bf16_t*)(base + GP_AB);
        LAS float* lowS = (LAS float*)(base + GP_LOW); LAS float* tot = (LAS float*)(base + GP_TOT);
        *(LAS f32x4*)(lowS + 4 * t) = *(const f32x4*)(LOW + (size_t)(rb * 64 + (t >> 2)) * 32 + dir * 16 + 4 * (t & 3));
        const int dk = t & 127, half = t >> 7, col = head * 128 + dk;
        float w2c[16];
#pragma unroll
        for (int rr = 0; rr < 16; ++rr) w2c[rr] = gw2[(size_t)(dir * 16 + rr) * 512 + col];
        const float b2 = gb2[dir * 512 + col];
        __syncthreads();
        float bc[32]; float run = 0.f;
#pragma unroll
        for (int n = 0; n < 32; ++n) { const int ip = 32 * half + n, i = dir ? 63 - ip : ip; float s = b2;
#pragma unroll
            for (int rr = 0; rr < 16; ++rr) s += lowS[i * 16 + rr] * w2c[rr];
            run += logsigmoid_f(s) * (1.f / 16.f); bc[n] = run; }
        tot[half * 128 + dk] = run;
        __syncthreads();
        const float t0 = tot[dk], last = t0 + tot[128 + dk], off = half ? t0 : 0.f;
        if (half == 0) EL[(size_t)(dir * 520 + rb) * 512 + col] = last;
        {
            const int i0 = dir ? 63 - 32 * half : 32 * half; const long pstep = dir ? -3072 : 3072;
            const bf16_t* pp = P + (size_t)(rb * 64 + i0) * 3072 + col;
#pragma unroll
            for (int n = 0; n < 32; ++n) { const int ip = 32 * half + n; const float bcv = bc[n] + off;
                const float qv = bf2f(pp[0]), kv = bf2f(pp[512]); pp += pstep;
                Qm[ip * 136 + dk] = f2bf(qv * 0.08838834764831845f * __expf(bcv - last));
                Km[ip * 136 + dk] = f2bf(kv * __expf(last - bcv)); }
        }
        __syncthreads();
        {
            const int ti = w >> 1, tj = w & 1;
            f32x16 acc;
#pragma unroll
            for (int x = 0; x < 16; ++x) acc[x] = 0.f;
            if (!(ti == 0 && tj == 1)) {
#pragma unroll
                for (int ks = 0; ks < 8; ++ks) acc = MFMA32(frag_nat(Qm, 136, 32 * ti + r, ks, h), frag_nat(Km, 136, 32 * tj + r, ks, h), acc);
            }
            const int j = 32 * tj + r;
#pragma unroll
            for (int x = 0; x < 16; ++x) { const int i = 32 * ti + crow(x, h); Ab[i * 72 + j] = f2bf(i >= j ? acc[x] : 0.f); }
            const int r0 = t >> 4, c8 = 8 * (t & 15);
#pragma unroll
            for (int v = 0; v < 4; ++v) { const int row = r0 + 16 * v; const size_t go = ((size_t)dir * MROWS + rb * 64 + row) * 512 + head * 128 + c8;
                *(u32x4*)(QM + go) = *(const LAS u32x4*)(Qm + row * 136 + c8); *(u32x4*)(KM + go) = *(const LAS u32x4*)(Km + row * 136 + c8); }
        }
        __syncthreads();
        {
            bf16_t* dst = AQ + (size_t)it * 4096;
#pragma unroll
            for (int k2 = 0; k2 < 2; ++k2) { const int c = t + 256 * k2, row = c >> 3, cc = c & 7; *(u32x4*)(dst + c * 8) = *(const LAS u32x4*)(Ab + row * 72 + 8 * cc); }
        }
        __syncthreads();
    }
}
constexpr int GL_QM = 0, GL_KM = 17408, GL_VB = 34816, GL_AB = 52224, GL_EL = 61440, GL_DIR = 61952;
struct GlPre { u32x4 q4[4], k4[4], v4[4], a0, a1; float elv; };
__device__ __forceinline__ void gl_prefetch(GlPre& p, const bf16_t* P, const bf16_t* QM, const bf16_t* KM, const bf16_t* AQ, const float* EL, int rb, int dir, int head, int hf, int t) {
    const int r0 = t >> 4, c8 = 8 * (t & 15);
    const bf16_t* aq = AQ + (size_t)((rb * 4 + head) * 2 + dir) * 4096;
#pragma unroll
    for (int v = 0; v < 4; ++v) { const size_t row = (size_t)(rb * 64 + r0 + 16 * v);
        p.q4[v] = *(const u32x4*)(QM + ((size_t)dir * MROWS + row) * 512 + head * 128 + c8);
        p.k4[v] = *(const u32x4*)(KM + ((size_t)dir * MROWS + row) * 512 + head * 128 + c8);
        p.v4[v] = *(const u32x4*)(P + row * 3072 + 1024 + head * 256 + hf * 128 + c8); }
    p.a0 = *(const u32x4*)(aq + t * 8); p.a1 = *(const u32x4*)(aq + (256 + t) * 8);
    p.elv = EL[(size_t)(dir * 520 + rb) * 512 + head * 128 + (t & 127)];
}
__device__ __forceinline__ void gla_scan(LAS unsigned char* lds, const bf16_t* P  , const bf16_t* QM, const bf16_t* KM, const bf16_t* AQ, const float* EL, bf16_t* OB  ) {
    const int tid = opaque_tid(), dir = __builtin_amdgcn_readfirstlane(tid >> 8);
    for (int unit = blockIdx.x; unit < 16; unit += gridDim.x) {
        const int b = unit >> 3, head = (unit >> 1) & 3, hf = unit & 1;
        f32x16 S[4];
#pragma unroll
        for (int kt = 0; kt < 4; ++kt)
#pragma unroll
            for (int x = 0; x < 16; ++x) S[kt][x] = 0.f;
        GlPre pre;
        { int rb0; bool f0; dn_step_rb(0, dir, b, rb0, f0); gl_prefetch(pre, P, QM, KM, AQ, EL, rb0, dir, head, hf, tid & 255); }
        __syncthreads();
        for (int step = 0; step < 260; ++step) {
            const int w = __builtin_amdgcn_readfirstlane((opaque_tid() >> 6) & 3);
            LAS unsigned char* base = lds + dir * GL_DIR;
            LAS bf16_t* Qm = (LAS bf16_t*)(base + GL_QM); LAS bf16_t* Km = (LAS bf16_t*)(base + GL_KM); LAS bf16_t* Vb = (LAS bf16_t*)(base + GL_VB); LAS bf16_t* Ab = (LAS bf16_t*)(base + GL_AB);
            LAS float* el = (LAS float*)(base + GL_EL);
            int rb; bool first; dn_step_rb(step, dir, b, rb, first);
            const int row_base = rb * 64;
            {
                const int tq_ = opaque_tid(), t = tq_ & 255;
                const int r0 = t >> 4, c8 = 8 * (t & 15);
#pragma unroll
                for (int v = 0; v < 4; ++v) { const int i = r0 + 16 * v, ip = dir ? 63 - i : i;
                    *(LAS u32x4*)(Qm + i * 136 + c8) = pre.q4[v]; *(LAS u32x4*)(Km + i * 136 + c8) = pre.k4[v]; *(LAS u32x4*)(Vb + ip * 136 + c8) = pre.v4[v]; }
                { const int c = t, row = c >> 3, cc = c & 7; *(LAS u32x4*)(Ab + row * 72 + 8 * cc) = pre.a0; }
                { const int c = 256 + t, row = c >> 3, cc = c & 7; *(LAS u32x4*)(Ab + row * 72 + 8 * cc) = pre.a1; }
                if (t < 128) el[t] = __expf(pre.elv);
            }
            BAR_LDS();
            if (step + 1 < 260) { int rbn; bool fn; dn_step_rb(step + 1, dir, b, rbn, fn); gl_prefetch(pre, P, QM, KM, AQ, EL, rbn, dir, head, hf, opaque_tid() & 255); }
            __builtin_amdgcn_sched_barrier(0);
            {
                const int tq_ = opaque_tid(), lane = tq_ & 63, r = lane & 31, h = lane >> 5;
#pragma unroll
                for (int kt = 0; kt < 4; ++kt)
#pragma unroll
                    for (int x = 0; x < 16; ++x) S[kt][x] *= el[32 * kt + crow(x, h)];
                bf16x8 Vf[4];
#pragma unroll
                for (int ks = 0; ks < 4; ++ks) Vf[ks] = frag_tr(Vb, 136, 32 * w, ks, lane);
                u32x4 eo[4];
                {
                    const int rr_ = lane >> 2, c8_ = 8 * (lane & 3);
                    if (!first) {
#pragma unroll
                        for (int v = 0; v < 4; ++v) { const int ip_ = rr_ + 16 * v, i_ = dir ? 63 - ip_ : ip_;
                            eo[v] = *(const u32x4*)(OB + (size_t)(row_base + i_) * 1024 + head * 256 + hf * 128 + 32 * w + c8_); }
                    } else {
                        unsigned z0 = 0u; asm volatile("" : "+v"(z0));
#pragma unroll
                        for (int v = 0; v < 4; ++v) eo[v] = (u32x4){z0, z0, z0, z0};
                    }
                }
                f32x16 O[2];
#pragma unroll
                for (int mt = 0; mt < 2; ++mt) {
#pragma unroll
                    for (int x = 0; x < 16; ++x) O[mt][x] = 0.f;
#pragma unroll
                    for (int ks = 0; ks < 4; ++ks) if (ks < 2 * mt + 2) O[mt] = MFMA32(frag_perm(Ab, 72, 32 * mt + r, ks, h), Vf[ks], O[mt]);
                }
                __builtin_amdgcn_sched_barrier(0);
#pragma unroll
                for (int ks = 0; ks < 8; ++ks) {
                    const bf16x8 sp = pack_step(S[ks >> 1], ks & 1);
#pragma unroll
                    for (int mt = 0; mt < 2; ++mt) O[mt] = MFMA32(frag_perm(Qm, 136, 32 * mt + r, ks, h), sp, O[mt]);
                    if (ks & 1) __builtin_amdgcn_sched_barrier(0);
                }
#pragma unroll
                for (int mt = 0; mt < 2; ++mt)
#pragma unroll
                    for (int x = 0; x < 16; ++x) Vb[(32 * mt + crow(x, h)) * 136 + 32 * w + r] = f2bf(O[mt][x]);
                __builtin_amdgcn_sched_barrier(0);
#pragma unroll
                for (int ks = 0; ks < 4; ++ks) {
#pragma unroll
                    for (int kt = 0; kt < 4; ++kt) S[kt] = MFMA32(frag_tr(Km, 136, 32 * kt, ks, lane), Vf[ks], S[kt]);
                    __builtin_amdgcn_sched_barrier(0);
                }
                {
                    const int rr_ = lane >> 2, c8_ = 8 * (lane & 3);
#pragma unroll
                    for (int v = 0; v < 4; ++v) { const int ip_ = rr_ + 16 * v, i_ = dir ? 63 - ip_ : ip_;
                        u32x4* gp_ = (u32x4*)(OB + (size_t)(row_base + i_) * 1024 + head * 256 + hf * 128 + 32 * w + c8_);
                        u32x4 o = *(const LAS u32x4*)(Vb + ip_ * 136 + 32 * w + c8_); const u32x4 e = eo[v];
                        if (!first) {
                            o.x = cvtpk_s(bf_lo(o.x) + bf_lo(e.x), bf_hi(o.x) + bf_hi(e.x)); o.y = cvtpk_s(bf_lo(o.y) + bf_lo(e.y), bf_hi(o.y) + bf_hi(e.y));
                            o.z = cvtpk_s(bf_lo(o.z) + bf_lo(e.z), bf_hi(o.z) + bf_hi(e.z)); o.w = cvtpk_s(bf_lo(o.w) + bf_lo(e.w), bf_hi(o.w) + bf_hi(e.w)); }
                        gp_[0] = o; }
                }
            }
            if (step == 1 || step == 131) asm volatile("s_waitcnt vmcnt(0)" ::: "memory");
            BAR_LDS();
        }
    }
}
typedef __bf16 v2bf_t __attribute__((ext_vector_type(2)));
__device__ __forceinline__ void atomic_add_bf16x8(bf16_t* p, const u32x4 v) {
    asm volatile("global_atomic_pk_add_bf16 %0, %1, off sc1\n\tglobal_atomic_pk_add_bf16 %0, %2, off offset:4 sc1\n\tglobal_atomic_pk_add_bf16 %0, %3, off offset:8 sc1\n\tglobal_atomic_pk_add_bf16 %0, %4, off offset:12 sc1"
                 :: "v"(p), "v"(v.x), "v"(v.y), "v"(v.z), "v"(v.w) : "memory");
}
constexpr int DN3_HGC = 2 * DN_DIR;
__device__ __forceinline__ void dn_scan3(LAS unsigned char* lds, const bf16_t* P, const float* AB, const bf16_t* TP, bf16_t* OB) {
    const int tid0 = opaque_tid(), wv = __builtin_amdgcn_readfirstlane(tid0 >> 6), role = wv >> 2, w = wv & 3;
    for (int unit = blockIdx.x; unit < 64; unit += gridDim.x) {
        const int b = unit >> 5, vh = (unit >> 1) & 15, dir = unit & 1, kh = vh >> 1;
        __syncthreads();
        if (role == 1) {
            if (w < 3) {
                const int qh = w >= 1 ? 1 : 0, khh = w == 2 ? 1 : 0, ti = qh, tj = khh;
                u32x4 q8[8], k8[8]; float gcp;
                {
                    int rb; bool f_; dn_step_rb(0, dir, b, rb, f_);
                    const int lane = opaque_tid() & 63, r0 = lane >> 4, c8 = 8 * (lane & 15);
#pragma unroll
                    for (int v = 0; v < 8; ++v) { const int ipq = 32 * qh + r0 + 4 * v, ipk = 32 * khh + r0 + 4 * v, iq = dir ? 63 - ipq : ipq, ik = dir ? 63 - ipk : ipk;
                        q8[v] = *(const u32x4*)(P + (size_t)(rb * 64 + iq) * 4096 + kh * 128 + c8); k8[v] = *(const u32x4*)(P + (size_t)(rb * 64 + ik) * 4096 + 1024 + kh * 128 + c8); }
                    const int tl = dir ? 63 - lane : lane; gcp = AB[(size_t)(rb * 64 + tl) * 64 + dir * 16 + vh];
                }
                for (int j = 0; j < 260; ++j) {
                    const int lane = opaque_tid() & 63, r = lane & 31, h = lane >> 5, r0 = lane >> 4, c8 = 8 * (lane & 15);
                    LAS unsigned char* base = lds + (j & 1) * DN_DIR;
                    LAS bf16_t* Kb = (LAS bf16_t*)(base + DN_KB); LAS bf16_t* Qb = (LAS bf16_t*)(base + DN_QB); LAS bf16_t* Ab = (LAS bf16_t*)(base + DN_AB);
                    LAS float* hgc = (LAS float*)(lds + DN3_HGC + w * 256);
#pragma unroll
                    for (int v = 0; v < 8; ++v) { *(LAS u32x4*)(Qb + (32 * qh + r0 + 4 * v) * 136 + c8) = q8[v]; *(LAS u32x4*)(Kb + (32 * khh + r0 + 4 * v) * 136 + c8) = k8[v]; }
                    hgc[lane] = gcp;
                    asm volatile("s_waitcnt lgkmcnt(0)" ::: "memory");
                    if (j + 1 < 260) {
                        int rb; bool f_; dn_step_rb(j + 1, dir, b, rb, f_);
#pragma unroll
                        for (int v = 0; v < 8; ++v) { const int ipq = 32 * qh + r0 + 4 * v, ipk = 32 * khh + r0 + 4 * v, iq = dir ? 63 - ipq : ipq, ik = dir ? 63 - ipk : ipk;
                            q8[v] = *(const u32x4*)(P + (size_t)(rb * 64 + iq) * 4096 + kh * 128 + c8); k8[v] = *(const u32x4*)(P + (size_t)(rb * 64 + ik) * 4096 + 1024 + kh * 128 + c8); }
                        const int tl = dir ? 63 - lane : lane; gcp = AB[(size_t)(rb * 64 + tl) * 64 + dir * 16 + vh];
                    }
                    __builtin_amdgcn_sched_barrier(0);
                    {
                        f32x16 qk;
#pragma unroll
                        for (int x = 0; x < 16; ++x) qk[x] = 0.f;
#pragma unroll
                        for (int ks = 0; ks < 8; ++ks) qk = MFMA32(frag_nat(Qb, 136, 32 * ti + r, ks, h), frag_nat(Kb, 136, 32 * tj + r, ks, h), qk);
                        const int jj = 32 * tj + r; const float gj = hgc[jj];
#pragma unroll
                        for (int x = 0; x < 16; ++x) { const int i = 32 * ti + crow(x, h);
                            Ab[i * 72 + jj] = f2bf((i >= jj) ? qk[x] * __expf(hgc[i] - gj) : 0.f); }
                    }
                    BAR_LDS();
                }
                BAR_LDS();
            } else {
                u32x4 v16[16], t6[6]; float gcp, betap;
                {
                    int rb; bool f_; dn_step_rb(0, dir, b, rb, f_);
                    const int lane = opaque_tid() & 63, r0 = lane >> 4, c8 = 8 * (lane & 15);
#pragma unroll
                    for (int v = 0; v < 16; ++v) { const int ip = r0 + 4 * v, i = dir ? 63 - ip : ip; v16[v] = *(const u32x4*)(P + (size_t)(rb * 64 + i) * 4096 + 2048 + vh * 128 + c8); }
                    const bf16_t* tp = TP + (size_t)((rb * 16 + vh) * 2 + dir) * 3072;
#pragma unroll
                    for (int v = 0; v < 6; ++v) t6[v] = *(const u32x4*)(tp + (lane + 64 * v) * 8);
                    const int tl = dir ? 63 - lane : lane; const float* ab = AB + (size_t)(rb * 64 + tl) * 64; gcp = ab[dir * 16 + vh]; betap = ab[32 + dir * 16 + vh];
                }
                for (int j = 0; j < 260; ++j) {
                    const int lane = opaque_tid() & 63, r0 = lane >> 4, c8 = 8 * (lane & 15);
                    LAS unsigned char* base = lds + (j & 1) * DN_DIR;
                    LAS bf16_t* Vb = (LAS bf16_t*)(base + DN_VB); LAS bf16_t* Tb = (LAS bf16_t*)(base + DN_TB);
                    LAS float* sc_beta = (LAS float*)(base + DN_SC); LAS float* sc_gc = sc_beta + 64; LAS float* sc_eg = sc_beta + 128; LAS float* sc_tail = sc_beta + 192; LAS float* sc_dl = sc_beta + 256;
#pragma unroll
                    for (int v = 0; v < 16; ++v) *(LAS u32x4*)(Vb + (r0 + 4 * v) * 128 + c8) = v16[v];
#pragma unroll
                    for (int v = 0; v < 6; ++v) { const int c = lane + 64 * v, blk = c >> 7, rowc = (c & 127) >> 2, cc = c & 3, br = blk ? 1 : 0, bc = blk == 2 ? 1 : 0;
                        *(LAS u32x4*)(Tb + (32 * br + rowc) * 72 + 32 * bc + 8 * cc) = t6[v]; }
                    { const float gc = gcp, gl = __shfl(gc, 63); sc_beta[lane] = betap; sc_gc[lane] = gc; sc_eg[lane] = __expf(gc); sc_tail[lane] = __expf(gl - gc); if (lane == 0) sc_dl[0] = __expf(gl); }
                    if (j + 1 < 260) {
                        int rb; bool f_; dn_step_rb(j + 1, dir, b, rb, f_);
#pragma unroll
                        for (int v = 0; v < 16; ++v) { const int ip = r0 + 4 * v, i = dir ? 63 - ip : ip; v16[v] = *(const u32x4*)(P + (size_t)(rb * 64 + i) * 4096 + 2048 + vh * 128 + c8); }
                        const bf16_t* tp = TP + (size_t)((rb * 16 + vh) * 2 + dir) * 3072;
#pragma unroll
                        for (int v = 0; v < 6; ++v) t6[v] = *(const u32x4*)(tp + (lane + 64 * v) * 8);
                        const int tl = dir ? 63 - lane : lane; const float* ab = AB + (size_t)(rb * 64 + tl) * 64; gcp = ab[dir * 16 + vh]; betap = ab[32 + dir * 16 + vh];
                    }
                    BAR_LDS();
                }
                BAR_LDS();
            }
        } else {
            f32x16 S[4];
#pragma unroll
            for (int kt = 0; kt < 4; ++kt)
#pragma unroll
                for (int x = 0; x < 16; ++x) S[kt][x] = 0.f;
            BAR_LDS();
            for (int step = 0; step < 260; ++step) {
                const int lane = opaque_tid() & 63, r = lane & 31, h = lane >> 5;
                LAS unsigned char* base = lds + (step & 1) * DN_DIR;
                LAS bf16_t* Kb = (LAS bf16_t*)(base + DN_KB); LAS bf16_t* Qb = (LAS bf16_t*)(base + DN_QB); LAS bf16_t* Vb = (LAS bf16_t*)(base + DN_VB);
                LAS bf16_t* Tb = (LAS bf16_t*)(base + DN_TB); LAS bf16_t* Ab = (LAS bf16_t*)(base + DN_AB);
                LAS float* sc_beta = (LAS float*)(base + DN_SC); LAS float* sc_eg = sc_beta + 128; LAS float* sc_tail = sc_beta + 192; LAS float* sc_dl = sc_beta + 256;
                int rb; bool f_; dn_step_rb(step, dir, b, rb, f_);
                f32x16 KS[2], QS[2];
#pragma unroll
                for (int mt = 0; mt < 2; ++mt)
#pragma unroll
                    for (int x = 0; x < 16; ++x) { KS[mt][x] = 0.f; QS[mt][x] = 0.f; }
#pragma unroll
                for (int ks = 0; ks < 8; ++ks) {
                    const bf16x8 sp = pack_step(S[ks >> 1], ks & 1);
#pragma unroll
                    for (int mt = 0; mt < 2; ++mt) { KS[mt] = MFMA32(frag_perm(Kb, 136, 32 * mt + r, ks, h), sp, KS[mt]); QS[mt] = MFMA32(frag_perm(Qb, 136, 32 * mt + r, ks, h), sp, QS[mt]); }
                    if (ks & 1) __builtin_amdgcn_sched_barrier(0);
                }
#pragma unroll
                for (int mt = 0; mt < 2; ++mt)
#pragma unroll
                    for (int x = 0; x < 16; ++x) { const int i = 32 * mt + crow(x, h);
                        KS[mt][x] = sc_beta[i] * (bf2f(Vb[i * 128 + 32 * w + r]) - sc_eg[i] * KS[mt][x]); }
                __builtin_amdgcn_sched_barrier(0);
                bf16x8 Xp[4];
#pragma unroll
                for (int ks = 0; ks < 4; ++ks) Xp[ks] = pack_step(KS[ks >> 1], ks & 1);
                f32x16 VN[2];
#pragma unroll
                for (int mt = 0; mt < 2; ++mt) {
#pragma unroll
                    for (int x = 0; x < 16; ++x) VN[mt][x] = 0.f;
#pragma unroll
                    for (int ks = 0; ks < 4; ++ks) if (ks < 2 * mt + 2) VN[mt] = MFMA32(frag_perm(Tb, 72, 32 * mt + r, ks, h), Xp[ks], VN[mt]);
                }
                __builtin_amdgcn_sched_barrier(0);
                bf16x8 VNp[4];
#pragma unroll
                for (int ks = 0; ks < 4; ++ks) VNp[ks] = pack_step(VN[ks >> 1], ks & 1);
#pragma unroll
                for (int mt = 0; mt < 2; ++mt) {
#pragma unroll
                    for (int x = 0; x < 16; ++x) QS[mt][x] *= sc_eg[32 * mt + crow(x, h)];
#pragma unroll
                    for (int ks = 0; ks < 4; ++ks) if (ks < 2 * mt + 2) QS[mt] = MFMA32(frag_perm(Ab, 72, 32 * mt + r, ks, h), VNp[ks], QS[mt]);
                }
                __builtin_amdgcn_sched_barrier(0);
#pragma unroll
                for (int mt = 0; mt < 2; ++mt)
#pragma unroll
                    for (int x = 0; x < 16; ++x) Vb[(32 * mt + crow(x, h)) * 128 + 32 * w + r] = f2bf(QS[mt][x]);
                __builtin_amdgcn_sched_barrier(0);
#pragma unroll
                for (int mt = 0; mt < 2; ++mt)
#pragma unroll
                    for (int x = 0; x < 16; ++x) VN[mt][x] *= sc_tail[32 * mt + crow(x, h)];
#pragma unroll
                for (int ks = 0; ks < 4; ++ks) VNp[ks] = pack_step(VN[ks >> 1], ks & 1);
                __builtin_amdgcn_sched_barrier(0);
                const float dl = sc_dl[0];
#pragma unroll
                for (int kt = 0; kt < 4; ++kt)
#pragma unroll
                    for (int x = 0; x < 16; ++x) S[kt][x] *= dl;
#pragma unroll
                for (int ks = 0; ks < 4; ++ks) {
#pragma unroll
                    for (int kt = 0; kt < 4; ++kt) S[kt] = MFMA32(frag_tr(Kb, 136, 32 * kt, ks, lane), VNp[ks], S[kt]);
                    __builtin_amdgcn_sched_barrier(0);
                }
                asm volatile("s_waitcnt lgkmcnt(0)" ::: "memory");
                {
                    const int rr_ = lane >> 2, c8_ = 8 * (lane & 3);
#pragma unroll
                    for (int v = 0; v < 4; ++v) { const int ip_ = rr_ + 16 * v, i_ = dir ? 63 - ip_ : ip_;
                        atomic_add_bf16x8(OB + (size_t)(rb * 64 + i_) * 2048 + vh * 128 + 32 * w + c8_, *(const LAS u32x4*)(Vb + ip_ * 128 + 32 * w + c8_)); }
                }
                BAR_LDS();
            }
        }
    }
}
__device__ __forceinline__ void gla_scan3(LAS unsigned char* lds, const bf16_t* P  , const bf16_t* QM, const bf16_t* KM, const bf16_t* AQ, const float* EL, bf16_t* OB  ) {
    const int tid0 = opaque_tid(), wv = __builtin_amdgcn_readfirstlane(tid0 >> 6), role = wv >> 2, w = wv & 3;
    for (int unit = blockIdx.x; unit < 32; unit += gridDim.x) {
        const int b = unit >> 4, head = (unit >> 2) & 3, hf = (unit >> 1) & 1, dir = unit & 1;
        __syncthreads();
        if (role == 1) {
            GlPre pre;
            { int rb0; bool f0; dn_step_rb(0, dir, b, rb0, f0); gl_prefetch(pre, P, QM, KM, AQ, EL, rb0, dir, head, hf, opaque_tid() & 255); }
            for (int j = 0; j < 260; ++j) {
                const int t = opaque_tid() & 255;
                LAS unsigned char* base = lds + (j & 1) * GL_DIR;
                LAS bf16_t* Qm = (LAS bf16_t*)(base + GL_QM); LAS bf16_t* Km = (LAS bf16_t*)(base + GL_KM); LAS bf16_t* Vb = (LAS bf16_t*)(base + GL_VB); LAS bf16_t* Ab = (LAS bf16_t*)(base + GL_AB);
                LAS float* el = (LAS float*)(base + GL_EL);
                const int r0 = t >> 4, c8 = 8 * (t & 15);
#pragma unroll
                for (int v = 0; v < 4; ++v) { const int i = r0 + 16 * v, ip = dir ? 63 - i : i;
                    *(LAS u32x4*)(Qm + i * 136 + c8) = pre.q4[v]; *(LAS u32x4*)(Km + i * 136 + c8) = pre.k4[v]; *(LAS u32x4*)(Vb + ip * 136 + c8) = pre.v4[v]; }
                { const int c = t, row = c >> 3, cc = c & 7; *(LAS u32x4*)(Ab + row * 72 + 8 * cc) = pre.a0; }
                { const int c = 256 + t, row = c >> 3, cc = c & 7; *(LAS u32x4*)(Ab + row * 72 + 8 * cc) = pre.a1; }
                if (t < 128) el[t] = __expf(pre.elv);
                if (j + 1 < 260) { int rbn; bool fn; dn_step_rb(j + 1, dir, b, rbn, fn); gl_prefetch(pre, P, QM, KM, AQ, EL, rbn, dir, head, hf, t); }
                BAR_LDS();
            }
            BAR_LDS();
        } else {
            f32x16 S[4];
#pragma unroll
            for (int kt = 0; kt < 4; ++kt)
#pragma unroll
                for (int x = 0; x < 16; ++x) S[kt][x] = 0.f;
            BAR_LDS();
            for (int step = 0; step < 260; ++step) {
                const int lane = opaque_tid() & 63, r = lane & 31, h = lane >> 5;
                LAS unsigned char* base = lds + (step & 1) * GL_DIR;
                LAS bf16_t* Qm = (LAS bf16_t*)(base + GL_QM); LAS bf16_t* Km = (LAS bf16_t*)(base + GL_KM); LAS bf16_t* Vb = (LAS bf16_t*)(base + GL_VB); LAS bf16_t* Ab = (LAS bf16_t*)(base + GL_AB);
                LAS float* el = (LAS float*)(base + GL_EL);
                int rb; bool f_; dn_step_rb(step, dir, b, rb, f_);
#pragma unroll
                for (int kt = 0; kt < 4; ++kt)
#pragma unroll
                    for (int x = 0; x < 16; ++x) S[kt][x] *= el[32 * kt + crow(x, h)];
                bf16x8 Vf[4];
#pragma unroll
                for (int ks = 0; ks < 4; ++ks) Vf[ks] = frag_tr(Vb, 136, 32 * w, ks, lane);
                f32x16 O[2];
#pragma unroll
                for (int mt = 0; mt < 2; ++mt) {
#pragma unroll
                    for (int x = 0; x < 16; ++x) O[mt][x] = 0.f;
#pragma unroll
                    for (int ks = 0; ks < 4; ++ks) if (ks < 2 * mt + 2) O[mt] = MFMA32(frag_perm(Ab, 72, 32 * mt + r, ks, h), Vf[ks], O[mt]);
                }
                __builtin_amdgcn_sched_barrier(0);
#pragma unroll
                for (int ks = 0; ks < 8; ++ks) {
                    const bf16x8 sp = pack_step(S[ks >> 1], ks & 1);
#pragma unroll
                    for (int mt = 0; mt < 2; ++mt) O[mt] = MFMA32(frag_perm(Qm, 136, 32 * mt + r, ks, h), sp, O[mt]);
                    if (ks & 1) __builtin_amdgcn_sched_barrier(0);
                }
#pragma unroll
                for (int mt = 0; mt < 2; ++mt)
#pragma unroll
                    for (int x = 0; x < 16; ++x) Vb[(32 * mt + crow(x, h)) * 136 + 32 * w + r] = f2bf(O[mt][x]);
                __builtin_amdgcn_sched_barrier(0);
#pragma unroll
                for (int ks = 0; ks < 4; ++ks) {
#pragma unroll
                    for (int kt = 0; kt < 4; ++kt) S[kt] = MFMA32(frag_tr(Km, 136, 32 * kt, ks, lane), Vf[ks], S[kt]);
                    __builtin_amdgcn_sched_barrier(0);
                }
                asm volatile("s_waitcnt lgkmcnt(0)" ::: "memory");
                {
                    const int rr_ = lane >> 2, c8_ = 8 * (lane & 3);
#pragma unroll
                    for (int v = 0; v < 4; ++v) { const int ip_ = rr_ + 16 * v, i_ = dir ? 63 - ip_ : ip_;
                        atomic_add_bf16x8(OB + (size_t)(rb * 64 + i_) * 1024 + head * 256 + hf * 128 + 32 * w + c8_, *(const LAS u32x4*)(Vb + ip_ * 136 + 32 * w + c8_)); }
                }
                BAR_LDS();
            }
        }
    }
}
#define DUP_DN 0
#define DN_VARIANT 0
#define DN_VAR_PARITY0 0
#define DUP_GLA 0
#define DUP_ATT 0
#define DUP_GIN 0
#define DUP_FFN1 0
constexpr unsigned long long pack_ops(const int* ops, int n) { unsigned long long v = 0; for (int i = 0; i < n; ++i) v |= (unsigned long long)ops[i] << (5 * i); return v; }
struct OpList { unsigned long long code; int n; };
constexpr OpList make_list(int mix) {
    int ops[16] = {}; int n = 0;
    ops[n++] = OP_PREP; ops[n++] = OP_GEMM_IN; if (DUP_GIN && mix != 0) ops[n++] = OP_GEMM_IN;
    if (mix == 0) { ops[n++] = OP_DNHALO; ops[n++] = OP_DNCONV; ops[n++] = OP_DNT; ops[n++] = OP_DNSCAN; ops[n++] = OP_DNREDO; ops[n++] = OP_GEMM_Z; }
    else if (mix == 1) { ops[n++] = OP_GLAPREP; ops[n++] = OP_GLASCAN; ops[n++] = OP_GLAGATE; }
    else { ops[n++] = OP_QKROPE; ops[n++] = OP_ATTN; if (DUP_ATT) ops[n++] = OP_ATTN; }
    ops[n++] = OP_GEMM_OUT; ops[n++] = OP_NORM2; ops[n++] = OP_FFN1; if (DUP_FFN1 && mix != 0) ops[n++] = OP_FFN1; ops[n++] = OP_FFN2;
    return OpList{pack_ops(ops, n), n};
}
constexpr OpList L_DN = make_list(0), L_GL = make_list(1), L_AT = make_list(2);
constexpr int NPHASE = 1 + 2 * L_DN.n + L_GL.n + L_AT.n;
__device__ __forceinline__ void decode_phase(int ph, int& layer, int& op) {
    if (ph == 0) { layer = 0; op = OP_MOD; return; }
    int p = ph - 1;
    if (p < L_DN.n) { layer = 0; op = (int)((L_DN.code >> (5 * p)) & 31ull); return; } p -= L_DN.n;
    if (p < L_GL.n) { layer = 1; op = (int)((L_GL.code >> (5 * p)) & 31ull); return; } p -= L_GL.n;
    if (p < L_AT.n) { layer = 2; op = (int)((L_AT.code >> (5 * p)) & 31ull); return; } p -= L_AT.n;
    layer = 3; op = (int)((L_DN.code >> (5 * p)) & 31ull);
}

__global__ void __launch_bounds__(512, 2) mega(Args args) {
    extern __shared__ __attribute__((aligned(16))) unsigned char lds_raw[];
    LAS unsigned char* lds = (LAS unsigned char*)lds_raw;
    cg::grid_group grid = cg::this_grid();
    const int G = gridDim.x, NGW = G * 8;
    unsigned char* ws = args.ws;
    const float* x_in = args.in[0]; const float* c_in = args.in[1]; const float* ctx_in = args.in[2]; const float* cctx_in = args.in[3];
    const float* ada_w = args.in[4]; const float* ada_b = args.in[5]; const float* norm_mix_g = args.in[6]; const float* norm_ffn_g = args.in[7];
    const float* ffn_w1 = args.in[8]; const float* ffn_w2 = args.in[9];
    float* MOD = (float*)(ws + WS_MOD); float* CTXC = (float*)(ws + WS_CTX); bf16_t* H = (bf16_t*)(ws + WS_H); float* ABF = (float*)(ws + WS_AB); float* RSTD = (float*)(ws + WS_RSTD);
    bf16_t* PB = (bf16_t*)(ws + WS_P); float* out = args.out;

    for (int ph = args.ph_lo; ph < args.ph_hi; ++ph) {
        int layer, op; decode_phase(ph, layer, op);
        const int mix = layer % 3, slot = layer / 3;
        const float* modl = MOD + (size_t)layer * 3 * 6144;
        const float* xl = layer == 0 ? x_in : out; const float* xc = layer == 0 ? ctx_in : CTXC;
        if (op == OP_MOD) {
            const int tid = opaque_tid(), lane = tid & 63, wave = __builtin_amdgcn_readfirstlane(tid >> 6); const int gw = blockIdx.x * 8 + wave; (void)lane; (void)gw; (void)tid;
            LAS float* sl = (LAS float*)lds; LAS float* red = sl + 3 * 1024;
            for (int e = tid; e < 3 * 1024; e += 512) { const float v = e < 2048 ? c_in[e] : cctx_in[e - 2048]; sl[e] = silu_f(v); }
            __syncthreads();
            for (int item = blockIdx.x; item < 4 * 96; item += G) {
                const int ly = item / 96, col = (item % 96) * 64 + lane;
                const float* wp = ada_w + ((size_t)ly * 1024 + 128 * wave) * 6144 + col;
                float a0 = 0.f, a1 = 0.f, a2 = 0.f;
#pragma unroll 8
                for (int k = 0; k < 128; ++k) { const float wv = wp[(size_t)k * 6144]; const int kk = 128 * wave + k; a0 += sl[kk] * wv; a1 += sl[1024 + kk] * wv; a2 += sl[2048 + kk] * wv; }
                red[(wave * 3 + 0) * 64 + lane] = a0; red[(wave * 3 + 1) * 64 + lane] = a1; red[(wave * 3 + 2) * 64 + lane] = a2;
                __syncthreads();
                if (tid < 192) { const int m = tid >> 6; float s = ada_b[(size_t)ly * 6144 + col];
#pragma unroll
                    for (int w2 = 0; w2 < 8; ++w2) s += red[(w2 * 3 + m) * 64 + lane];
                    MOD[((size_t)ly * 3 + m) * 6144 + col] = s; }
                __syncthreads();
            }
        } else if (op == OP_PREP) {
            const int tid = opaque_tid(), lane = tid & 63, wave = __builtin_amdgcn_readfirstlane(tid >> 6); const int gw = blockIdx.x * 8 + wave; (void)lane; (void)gw; (void)tid;
            LAS float* scr = (LAS float*)(lds + wave * 16384);
            unsigned z0 = 0u; asm volatile("" : "+v"(z0)); const u32x4 zv = (u32x4){z0, z0, z0, z0};
            bf16_t* wtA = (bf16_t*)(ws + WT_A); bf16_t* wtZ = (bf16_t*)(ws + WT_Z); bf16_t* wtO = (bf16_t*)(ws + WT_O); bf16_t* wt1 = (bf16_t*)(ws + WT_1); bf16_t* wt2 = (bf16_t*)(ws + WT_2);
            if (mix == 0) {
                const float* w_in = args.in[10] + (size_t)slot * 1024 * 6208; const float* w_out = args.in[15] + (size_t)slot * 2048 * 1024;
                transpose_mat(w_in, 6208, 0, 4096, 1024, wtA, 0, scr, gw, NGW, lane);
                transpose_mat(w_in, 6208, 6144, 64, 1024, wtA, 4096, scr, gw, NGW, lane);
                for (size_t e = (size_t)blockIdx.x * 512 + tid; e < (size_t)192 * 1024 * 2 / 16; e += (size_t)G * 512) ((u32x4*)(wtA + (size_t)4160 * 1024))[e] = zv;
            } else if (mix == 1) {
                const float* w_in = args.in[16]; const float* w_out = args.in[20];
                transpose_mat(w_in, 3104, 0, 3104, 1024, wtA, 0, scr, gw, NGW, lane);
                for (size_t e = (size_t)blockIdx.x * 512 + tid; e < (size_t)224 * 1024 * 2 / 16; e += (size_t)G * 512) ((u32x4*)(wtA + (size_t)3104 * 1024))[e] = zv;
                transpose_mat(w_out, 1024, 0, 1024, 1024, wtO, 0, scr, gw, NGW, lane);
            } else {
                const float* w_in = args.in[21]; const float* w_out = args.in[24];
                transpose_mat(w_in, 1536, 0, 1536, 1024, wtA, 0, scr, gw, NGW, lane);
                transpose_mat(w_out, 1024, 0, 1024, 1024, wtO, 0, scr, gw, NGW, lane);
            }
            if (mix != 0) {
                transpose_mat(ffn_w1 + (size_t)layer * 1024 * 4096, 4096, 0, 4096, 1024, wt1, 0, scr, gw, NGW, lane);
                transpose_mat(ffn_w2 + (size_t)layer * 4096 * 1024, 1024, 0, 1024, 4096, wt2, 0, scr, gw, NGW, lane);
            }
            normmod_rows(xl, xc, norm_mix_g + (size_t)layer * 1024, modl, 0, H, gw, NGW, lane);
        } else if (op == OP_DNREDO) {
            const int tid = opaque_tid(), lane = tid & 63, wave = __builtin_amdgcn_readfirstlane(tid >> 6); const int gw = blockIdx.x * 8 + wave; (void)lane; (void)gw; (void)tid;
            LAS float* scr = (LAS float*)(lds + wave * 16384);
            const float* w_in = args.in[10] + (size_t)slot * 1024 * 6208; const float* w_out = args.in[15] + (size_t)slot * 2048 * 1024;
            transpose_mat(w_in, 6208, 4096, 2048, 1024, (bf16_t*)(ws + WT_Z), 0, scr, gw, NGW, lane);
            transpose_mat(w_out, 1024, 0, 1024, 2048, (bf16_t*)(ws + WT_O), 0, scr, gw, NGW, lane);
            transpose_mat(ffn_w1 + (size_t)layer * 1024 * 4096, 4096, 0, 4096, 1024, (bf16_t*)(ws + WT_1), 0, scr, gw, NGW, lane);
            transpose_mat(ffn_w2 + (size_t)layer * 4096 * 1024, 1024, 0, 1024, 4096, (bf16_t*)(ws + WT_2), 0, scr, gw, NGW, lane);
            normmod_rows(xl, xc, norm_mix_g + (size_t)layer * 1024, modl, 0, H, gw, NGW, lane);
            const bf16_t* OB = (const bf16_t*)(ws + WS_O);
            for (int row = gw; row < MROWS; row += NGW) {
                const u32x4* p = (const u32x4*)(OB + (size_t)row * 2048 + 32 * lane); float ss = 0.f;
#pragma unroll
                for (int v = 0; v < 4; ++v) { const u32x4 q = p[v]; const float a0 = bf_lo(q.x), a1 = bf_hi(q.x), a2 = bf_lo(q.y), a3 = bf_hi(q.y), a4 = bf_lo(q.z), a5 = bf_hi(q.z), a6 = bf_lo(q.w), a7 = bf_hi(q.w);
                    ss += (a0 * a0 + a1 * a1) + (a2 * a2 + a3 * a3) + (a4 * a4 + a5 * a5) + (a6 * a6 + a7 * a7); }
                ss += __shfl_xor(ss, 1); ss += __shfl_xor(ss, 2);
                if ((lane & 3) == 0) RSTD[(size_t)row * 16 + (lane >> 2)] = rsqrtf(ss * (1.f / 128.f) + EPS);
            }
        } else if (op == OP_DNHALO) {
            dn_halo_phase(PB, (bf16_t*)(ws + WS_HALO), G);
        } else if (op == OP_DNCONV) {
            dn_conv_phase(PB, (const bf16_t*)(ws + WS_HALO), args.in[11] + (size_t)slot * 4096 * 5, G);
        } else if (op == OP_DNT) {
            dn_t_phase(lds, PB, ABF, (bf16_t*)(ws + WS_TP), args.in[12] + (size_t)slot * 32, args.in[13] + (size_t)slot * 32, G);
            {
                unsigned z0 = 0u; asm volatile("" : "+v"(z0)); const u32x4 zv = (u32x4){z0, z0, z0, z0}; u32x4* zp = (u32x4*)(ws + WS_O);
                for (size_t e = (size_t)blockIdx.x * 512 + opaque_tid(); e < (size_t)MROWS * 2048 * 2 / 16; e += (size_t)G * 512) zp[e] = zv;
            }
        } else if (op == OP_NORM2) {
            const int tid = opaque_tid(), lane = tid & 63, wave = __builtin_amdgcn_readfirstlane(tid >> 6); const int gw = blockIdx.x * 8 + wave; (void)lane; (void)gw; (void)tid;
            normmod_rows(out, CTXC, norm_ffn_g + (size_t)layer * 1024, modl, 3, H, gw, NGW, lane);
        } else if (op == OP_GEMM_IN || op == OP_GEMM_Z || op == OP_GEMM_OUT || op == OP_FFN1 || op == OP_FFN2) {
            pg8::Gemm g; pg8::Epi E;
            E.mode = 0; E.O = PB; E.ldc = 4096; E.tail_pn = -1; E.F = ABF; E.ldf = 64; E.nf = 64; E.rstd = RSTD; E.ng = args.in[14] + (size_t)slot * 128;
            E.src_lat = xl; E.src_ctx = xc; E.dst_lat = out; E.dst_ctx = CTXC; E.mod = modl; E.gidx = 2;
            g.M = MROWS; g.A = H; g.K = 1024;
            bf16_t* OBUF = (bf16_t*)(ws + (mix == 1 ? WS_OGLA : WS_O));
            if (op == OP_GEMM_IN) {
                g.Bt = (const bf16_t*)(ws + WT_A);
                if (mix == 0) { g.N = 4352; E.ldc = 4096; E.tail_pn = 16; E.ldf = 64; E.nf = 64; }
                else if (mix == 1) { g.N = 3328; E.ldc = 3072; E.tail_pn = 12; E.ldf = 32; E.nf = 32; }
                else { g.N = 1536; E.ldc = 1536; }
            } else if (op == OP_GEMM_Z) {
                g.Bt = (const bf16_t*)(ws + WT_Z); g.N = 2048; E.mode = 2; E.O = OBUF; E.ldc = 2048;
            } else if (op == OP_GEMM_OUT) {
                g.A = OBUF; g.K = mix == 0 ? 2048 : 1024; g.Bt = (const bf16_t*)(ws + WT_O); g.N = 1024; E.mode = 3; E.gidx = 2;
            } else if (op == OP_FFN1) {
                g.Bt = (const bf16_t*)(ws + WT_1); g.N = 4096; E.mode = 1; E.ldc = 4096;
            } else {
                g.A = PB; g.K = 4096; g.Bt = (const bf16_t*)(ws + WT_2); g.N = 1024; E.mode = 3; E.gidx = 5; E.src_lat = out; E.src_ctx = CTXC;
            }
            pg8::StaticOrder S; S.init(g.M, g.N, G, (int)blockIdx.x);
#ifndef NO_GEMM
            pg8::gemm_phase<pg8::Epi, pg8::StaticOrder, true, true>(lds, g, S, E);
#endif
        } else if (op == OP_DNSCAN) {
#ifndef NO_DN
            dn_scan3(lds, PB, ABF, (const bf16_t*)(ws + WS_TP), (bf16_t*)(ws + WS_O));
#endif
        } else if (op == OP_GLAPREP) {
            gla_prep_phase(lds, PB, ABF, args.in[17], args.in[18], (bf16_t*)(ws + WS_QM), (bf16_t*)(ws + WS_KM), (bf16_t*)(ws + WS_AQ), (float*)(ws + WS_EL), G);
            {
                unsigned z0 = 0u; asm volatile("" : "+v"(z0)); const u32x4 zv = (u32x4){z0, z0, z0, z0}; u32x4* zp = (u32x4*)(ws + WS_OGLA);
                for (size_t e = (size_t)blockIdx.x * 512 + opaque_tid(); e < (size_t)MROWS * 1024 * 2 / 16; e += (size_t)G * 512) zp[e] = zv;
            }
        } else if (op == OP_GLASCAN) {
#ifndef NO_GLA
            gla_scan3(lds, PB, (const bf16_t*)(ws + WS_QM), (const bf16_t*)(ws + WS_KM), (const bf16_t*)(ws + WS_AQ), (const float*)(ws + WS_EL), (bf16_t*)(ws + WS_OGLA));
#endif
        } else if (op == OP_GLAGATE) {
            const int tid = opaque_tid(), lane = tid & 63, wave = __builtin_amdgcn_readfirstlane(tid >> 6); const int gw = blockIdx.x * 8 + wave; (void)lane; (void)gw; (void)tid;
            bf16_t* OB = (bf16_t*)(ws + WS_OGLA); const float* ng = args.in[19];
            for (int row = gw; row < MROWS; row += NGW) {
                u32x4* p = (u32x4*)(OB + (size_t)row * 1024 + 16 * lane); const u32x4* gp = (const u32x4*)(PB + (size_t)row * 3072 + 2048 + 16 * lane);
                float o[16], z[16]; float ss = 0.f;
#pragma unroll
                for (int v = 0; v < 2; ++v) { const u32x4 q = p[v], gq = gp[v];
                    o[8 * v + 0] = bf_lo(q.x); o[8 * v + 1] = bf_hi(q.x); o[8 * v + 2] = bf_lo(q.y); o[8 * v + 3] = bf_hi(q.y); o[8 * v + 4] = bf_lo(q.z); o[8 * v + 5] = bf_hi(q.z); o[8 * v + 6] = bf_lo(q.w); o[8 * v + 7] = bf_hi(q.w);
                    z[8 * v + 0] = bf_lo(gq.x); z[8 * v + 1] = bf_hi(gq.x); z[8 * v + 2] = bf_lo(gq.y); z[8 * v + 3] = bf_hi(gq.y); z[8 * v + 4] = bf_lo(gq.z); z[8 * v + 5] = bf_hi(gq.z); z[8 * v + 6] = bf_lo(gq.w); z[8 * v + 7] = bf_hi(gq.w); }
#pragma unroll
                for (int e = 0; e < 16; ++e) ss += o[e] * o[e];
                ss += __shfl_xor(ss, 1); ss += __shfl_xor(ss, 2); ss += __shfl_xor(ss, 4); ss += __shfl_xor(ss, 8);
                const float rs = rsqrtf(ss * (1.f / 256.f) + EPS); const int cb = (16 * lane) & 255;
#pragma unroll
                for (int v = 0; v < 2; ++v) { float rr[8];
#pragma unroll
                    for (int e = 0; e < 8; ++e) rr[e] = o[8 * v + e] * rs * ng[cb + 8 * v + e] * silu_f(z[8 * v + e]);
                    u32x4 wv; wv.x = cvtpk_s(rr[0], rr[1]); wv.y = cvtpk_s(rr[2], rr[3]); wv.z = cvtpk_s(rr[4], rr[5]); wv.w = cvtpk_s(rr[6], rr[7]); p[v] = wv; }
            }
        } else if (op == OP_QKROPE) {
            const int tid = opaque_tid(), lane = tid & 63, wave = __builtin_amdgcn_readfirstlane(tid >> 6); const int gw = blockIdx.x * 8 + wave; (void)lane; (void)gw; (void)tid;
            bf16_t* QR = (bf16_t*)(ws + WS_QR); bf16_t* KR = (bf16_t*)(ws + WS_KR); bf16_t* VR = (bf16_t*)(ws + WS_VR);
            const float* qg = args.in[22]; const float* kg = args.in[23];
            const int hf = lane >> 5, j = lane & 31, e1 = 64 * hf + j, e2 = e1 + 32;
            const float inv_freq = exp2f(-(float)(2 * j) * (1.f / 64.f) * 13.287712379549449f);
            const float gq1 = qg[e1], gq2 = qg[e2], gk1 = kg[e1], gk2 = kg[e2];
            for (int row = gw; row < MROWS; row += NGW) {
                const bool lat = row < NLAT; const int b = lat ? row / SEQ : (row - NLAT) / CTXL; const int tpos = lat ? row % SEQ : (row - NLAT) % CTXL;
                float cs = 1.f, sn = 0.f;
                if (lat) { const float pos = (float)(hf == 0 ? tpos / 64 : tpos % 64); const float ang = pos * inv_freq; sn = sinf(ang); cs = cosf(ang); }
                const bf16_t* pr = PB + (size_t)row * 1536; const int kpos = lat ? tpos : SEQ + tpos;
#pragma unroll
                for (int hd = 0; hd < 10; ++hd) {
                    const float x1 = bf2f(pr[hd * 128 + e1]), x2 = bf2f(pr[hd * 128 + e2]);
                    const float rinv = rsqrtf(wave_sum(x1 * x1 + x2 * x2) * (1.f / 128.f) + EPS);
                    const float y1 = x1 * rinv * (hd < 8 ? gq1 : gk1), y2 = x2 * rinv * (hd < 8 ? gq2 : gk2);
                    const float o1 = y1 * cs - y2 * sn, o2 = y1 * sn + y2 * cs;
                    bf16_t* dst = hd < 8 ? QR + (size_t)row * 1024 + hd * 128 : KR + ((size_t)(b * 2 + (hd - 8)) * SKV + kpos) * 128;
                    dst[e1] = f2bf(o1); dst[e2] = f2bf(o2);
                }
#pragma unroll
                for (int kv = 0; kv < 2; ++kv) { bf16_t* dst = VR + ((size_t)(b * 2 + kv) * SKV + kpos) * 128; dst[e1] = pr[1280 + kv * 128 + e1]; dst[e2] = pr[1280 + kv * 128 + e2]; }
            }
        } else if (op == OP_ATTN) {
            const attn::bf16* QR = (const attn::bf16*)(ws + WS_QR); const attn::bf16* KR = (const attn::bf16*)(ws + WS_KR); const attn::bf16* VR = (const attn::bf16*)(ws + WS_VR);
            attn::bf16* OB = (attn::bf16*)(ws + WS_O);
            for (int u = blockIdx.x; u < 1024 + 16; u += G) {
                size_t qoff, koff; int seq;
                if (u < 1024) { const int pair = u >> 8, b = pair >> 1, kvh = pair & 1, hh = (u >> 6) & 3, qb = u & 63, head = kvh * 4 + hh;
                    qoff = ((size_t)b * SEQ + (size_t)qb * 256) * 1024 + head * 128; koff = (size_t)(b * 2 + kvh) * SKV * 128; seq = SKV; }
                else { const int jx = u - 1024, b = jx >> 3, head = jx & 7, kvh = head >> 2;
                    qoff = ((size_t)NLAT + (size_t)b * CTXL) * 1024 + head * 128; koff = ((size_t)(b * 2 + kvh) * SKV + SEQ) * 128; seq = CTXL; }
                __syncthreads();
#ifndef NO_ATT
                attn::attn_dense_body<attn::bf16>(QR + qoff, KR + koff, VR + koff, OB + qoff, seq, (char*)lds_raw);
#endif
            }
        }
        if (ph + 1 < args.ph_hi) grid.sync();
    }
}

#ifndef MK_MULTI
#define MK_MULTI 0
#endif
extern "C" void kernel_launch(void* const* d_in, const int* in_sizes, int n_in, void* d_out, int out_size, void* d_ws, size_t ws_size, hipStream_t stream) {
    static int grid = 0;
    if (grid == 0) {
        if (n_in != 25 || ws_size < WS_END) { fprintf(stderr, "kernel_launch: unexpected n_in %d / ws_size %zu (need %zu)\n", n_in, ws_size, (size_t)WS_END); grid = -1; return; }
        int dev = 0, cus = 0, per_cu = 0;
        hipGetDevice(&dev); hipDeviceGetAttribute(&cus, hipDeviceAttributeMultiprocessorCount, dev);
        if (hipFuncSetAttribute((const void*)mega, hipFuncAttributeMaxDynamicSharedMemorySize, LDS_BYTES) != hipSuccess) { fprintf(stderr, "kernel_launch: hipFuncSetAttribute failed\n"); grid = -1; return; }
        if (hipOccupancyMaxActiveBlocksPerMultiprocessor(&per_cu, (const void*)mega, 512, LDS_BYTES) != hipSuccess || per_cu < 1) { fprintf(stderr, "kernel_launch: occupancy query says %d\n", per_cu); per_cu = 1; }
        (void)hipGetLastError();
        grid = cus * 1;
    }
    if (grid < 0) return;
    Args a{};
    for (int i = 0; i < 25; ++i) a.in[i] = (const float*)d_in[i];
    a.out = (float*)d_out; a.ws = (unsigned char*)d_ws;
#if MK_MULTI
    for (int ph = 0; ph < NPHASE; ++ph) { a.ph_lo = ph; a.ph_hi = ph + 1; hipLaunchKernelGGL(mega, dim3(grid), dim3(512), LDS_BYTES, stream, a); }
#else
    a.ph_lo = 0; a.ph_hi = NPHASE;
    void* kargs[] = {&a};
    hipError_t e = hipLaunchCooperativeKernel((const void*)mega, dim3(grid), dim3(512), kargs, LDS_BYTES, stream);
    if (e != hipSuccess) fprintf(stderr, "cooperative launch failed: %s (grid %d)\n", hipGetErrorString(e), grid);
#endif
}
```

```cpp
#include <hip/hip_runtime.h>
#include <hip/hip_bf16.h>
#include <hip/hip_cooperative_groups.h>
#include <cstdio>
#include <cstdint>
namespace cg = cooperative_groups;
__device__ __forceinline__ int opaque_tid() { int t = threadIdx.x; asm volatile("" : "+v"(t)); return t; }
namespace pg8 {
#define PG8_LAS __attribute__((address_space(3)))
typedef unsigned short bf16_t;
typedef short bf16x8 __attribute__((ext_vector_type(8)));
typedef float f32x4 __attribute__((ext_vector_type(4)));
typedef unsigned u32x4 __attribute__((ext_vector_type(4)));
constexpr int BM = 256, BK = 64, HALF = 128, HTB = HALF * BK * 2  , STAGE_BYTES = 8 * HTB, NXCD = 8, WGM = 8;

__host__ __device__ __forceinline__ int lds_byte(int r, int c) { const int st = (r >> 4) * 2 + (c >> 5), rr = r & 15, cc = c & 31, ob = rr * 64 + cc * 2; return st * 1024 + (ob ^ (((ob >> 9) & 1) << 5)); }
__host__ __device__ __forceinline__ void stage_rc(int b, int& R, int& C) { const int st = b / 1024, sb = b % 1024, swz = sb ^ (((sb >> 9) & 1) << 5); R = (st >> 1) * 16 + swz / 64; C = (st & 1) * 32 + (swz % 64) / 2; }
__host__ __device__ __forceinline__ int perm32(int rho) { const int n = rho >> 4, i = rho & 15; return 8 * (i >> 2) + 4 * n + (i & 3); }

struct Unit { int pm, pn; };
struct Gemm { const bf16_t* A; const bf16_t* Bt; int M, N, K; };

struct StaticOrder {
    int nM, nN, nwg, G, c;
    __host__ __device__ void init(int M, int N, int G_, int c_) { nM = M / BM; nN = N / BM; nwg = nM * nN; G = G_; c = c_; }
    __host__ __device__ bool next(int i, Unit& u) const {
        const long L = (long)i * G + c; if (L >= nwg) return false;
        int wgid = (int)L; { const int q = nwg / NXCD, r = nwg % NXCD, xcd = wgid % NXCD, off = wgid / NXCD; wgid = (xcd < r ? xcd * (q + 1) : r * (q + 1) + (xcd - r) * q) + off; }
        const int nig = WGM * nN, gid = wgid / nig, fm = gid * WGM, gsz = (nM - fm) < WGM ? (nM - fm) : WGM;
        u.pm = fm + ((wgid % nig) % gsz); u.pn = (wgid % nig) / gsz; return true;
    }
    __device__ __forceinline__ void a_ready(const Unit&) const {}
    __device__ __forceinline__ void done(const Unit&) const {}
};

__device__ __forceinline__ unsigned cvt_pk_bf16(float lo, float hi) { unsigned r; asm volatile("v_cvt_pk_bf16_f32 %0, %1, %2" : "=v"(r) : "v"(lo), "v"(hi)); return r; }
typedef float f32x2 __attribute__((ext_vector_type(2)));
typedef float f32x2_t __attribute__((ext_vector_type(2))); typedef __bf16 bf16x2_t __attribute__((ext_vector_type(2)));
__device__ __forceinline__ unsigned cvtpk_s(float lo, float hi) { f32x2_t v = {lo, hi}; bf16x2_t b = __builtin_convertvector(v, bf16x2_t); return __builtin_bit_cast(unsigned, b); }
__device__ __forceinline__ float bf_lo(unsigned w) { return __builtin_bit_cast(float, w << 16); }
__device__ __forceinline__ float bf_hi(unsigned w) { return __builtin_bit_cast(float, w & 0xffff0000u); }
__device__ __forceinline__ float silu_f(float z) { return z / (1.f + __expf(-z)); }
struct Epi {
    static constexpr bool PERM = true, AFTER_DRAIN = false;
    int mode;
    bf16_t* O; int ldc;
    int tail_pn; float* F; int ldf, nf;
    const float* rstd; const float* ng;
    const float* src_lat; const float* src_ctx; float* dst_lat; float* dst_ctx; const float* mod; int gidx;
    __device__ __forceinline__ void operator()(const f32x4 (&acc)[2][2][4][2], const Unit& u, int wr, int wc, int fr, int fq) const {
        const int row0 = u.pm * BM + wr * 64 + fr; const int col0 = u.pn * BM + wc * 32 + 8 * fq;
        if (mode <= 1) {
            if (u.pn == tail_pn) {
                const int c0 = wc * 32 + 8 * fq;
#pragma unroll
                for (int ai = 0; ai < 2; ++ai)
#pragma unroll
                    for (int m = 0; m < 4; ++m)
#pragma unroll
                        for (int bj = 0; bj < 2; ++bj) { const int cc = c0 + bj * HALF;
                            if (cc < nf) { float* p = F + (size_t)(row0 + ai * HALF + m * 16) * ldf + cc; *(f32x4*)p = acc[ai][bj][m][0]; *(f32x4*)(p + 4) = acc[ai][bj][m][1]; } }
            } else {
#pragma unroll
                for (int ai = 0; ai < 2; ++ai)
#pragma unroll
                    for (int m = 0; m < 4; ++m) { bf16_t* rowp = O + (size_t)(row0 + ai * HALF + m * 16) * ldc + col0;
#pragma unroll
                        for (int bj = 0; bj < 2; ++bj) { f32x4 v0 = acc[ai][bj][m][0], v1 = acc[ai][bj][m][1];
                            if (mode == 1) {
#pragma unroll
                                for (int e = 0; e < 4; ++e) { float a = fmaxf(v0[e], 0.f), b = fmaxf(v1[e], 0.f); v0[e] = a * a; v1[e] = b * b; } }
                            u32x4 w; w.x = cvtpk_s(v0[0], v0[1]); w.y = cvtpk_s(v0[2], v0[3]); w.z = cvtpk_s(v1[0], v1[1]); w.w = cvtpk_s(v1[2], v1[3]);
                            *(u32x4*)(rowp + bj * HALF) = w; } }
            }
        } else if (mode == 2) {
            const f32x4 g0 = *(const f32x4*)(ng + (col0 & 127)), g1 = *(const f32x4*)(ng + (col0 & 127) + 4);
#pragma unroll
            for (int ai = 0; ai < 2; ++ai)
#pragma unroll
                for (int m = 0; m < 4; ++m) { const int row = row0 + ai * HALF + m * 16; bf16_t* rowp = O + (size_t)row * ldc + col0;
#pragma unroll
                    for (int bj = 0; bj < 2; ++bj) { const float rs = rstd[(size_t)row * 16 + ((col0 + bj * HALF) >> 7)];
                        const u32x4 ov = *(const u32x4*)(rowp + bj * HALF); const f32x4 z0 = acc[ai][bj][m][0], z1 = acc[ai][bj][m][1];
                        float r[8];
                        r[0] = bf_lo(ov.x) * rs * g0[0] * silu_f(z0[0]); r[1] = bf_hi(ov.x) * rs * g0[1] * silu_f(z0[1]);
                        r[2] = bf_lo(ov.y) * rs * g0[2] * silu_f(z0[2]); r[3] = bf_hi(ov.y) * rs * g0[3] * silu_f(z0[3]);
                        r[4] = bf_lo(ov.z) * rs * g1[0] * silu_f(z1[0]); r[5] = bf_hi(ov.z) * rs * g1[1] * silu_f(z1[1]);
                        r[6] = bf_lo(ov.w) * rs * g1[2] * silu_f(z1[2]); r[7] = bf_hi(ov.w) * rs * g1[3] * silu_f(z1[3]);
                        u32x4 w; w.x = cvtpk_s(r[0], r[1]); w.y = cvtpk_s(r[2], r[3]); w.z = cvtpk_s(r[4], r[5]); w.w = cvtpk_s(r[6], r[7]);
                        *(u32x4*)(rowp + bj * HALF) = w; } }
        } else {
            const int mi = u.pm < 64 ? 0 : (u.pm < 128 ? 1 : 2);
            const float* gate = mod + (size_t)mi * 6144 + (size_t)gidx * 1024;
            const bool lat = u.pm < 128;
            const float* sb = lat ? src_lat : src_ctx - (size_t)32768 * 1024; float* db = lat ? dst_lat : dst_ctx - (size_t)32768 * 1024;
#pragma unroll
            for (int bj = 0; bj < 2; ++bj)
#pragma unroll
                for (int n = 0; n < 2; ++n) { const int c = col0 + bj * HALF + 4 * n; const f32x4 gv = *(const f32x4*)(gate + c);
#pragma unroll
                    for (int ai = 0; ai < 2; ++ai)
#pragma unroll
                        for (int m = 0; m < 4; ++m) { const size_t off = (size_t)(row0 + ai * HALF + m * 16) * 1024 + c;
                            const f32x4 s = *(const f32x4*)(sb + off); *(f32x4*)(db + off) = s + gv * acc[ai][bj][m][n]; } }
        }
    }
};
template <class Epi, class Sched, bool ALIGN_EPI = false, bool SP2 = false>
__device__ __forceinline__ void gemm_phase(PG8_LAS unsigned char* lds, const Gemm g, const Sched& S, const Epi& E) {
    const int tid = opaque_tid(), wid = __builtin_amdgcn_readfirstlane(tid >> 6), lane = tid & 63, wr = wid >> 2, wc = wid & 3, fr = lane & 15, fq = lane >> 4;
    const int K = g.K, nt = K / BK;
    unsigned voffA[2], voffB[2];
#pragma unroll
    for (int i = 0; i < 2; ++i) { int R, C; stage_rc(tid * 16 + i * 8192, R, C); const int Rb = Epi::PERM ? ((R & ~31) + perm32(R & 31)) : R;
        voffA[i] = (unsigned)(R * K + C) * 2u; voffB[i] = (unsigned)(Rb * K + C) * 2u; }
    const size_t kstep = (size_t)(BK * 2);
    const size_t hstep = (size_t)HALF * K * 2;
    const size_t tstep = 2 * hstep;
    const unsigned ldsw = (unsigned)wid * 1024u;
    const int aoff = lds_byte(wr * 64 + fr, fq * 8), boff = lds_byte(wc * 32 + fr, fq * 8);
#define PG8_SA(b, h) (((b) * 2 + (h)) * HTB)
#define PG8_SB(b, h) ((4 + (b) * 2 + (h)) * HTB)
#define PG8_STAGE(bufoff, gbase, voff) do { _Pragma("unroll") for (int _i = 0; _i < 2; ++_i) \
        __builtin_amdgcn_global_load_lds((const unsigned*)((const char*)(gbase) + (voff)[_i]), (PG8_LAS unsigned*)(lds + (bufoff) + ldsw + _i * 8192), 16, 0, 0); } while (0)
#define PG8_LDA(dst, b, h) do { _Pragma("unroll") for (int m = 0; m < 4; ++m) _Pragma("unroll") for (int k = 0; k < 2; ++k) dst[m][k] = *(const PG8_LAS bf16x8*)(lds + PG8_SA(b, h) + aoff + m * 2048 + k * 1024); } while (0)
#define PG8_LDB(dst, b, h) do { _Pragma("unroll") for (int n = 0; n < 2; ++n) _Pragma("unroll") for (int k = 0; k < 2; ++k) dst[n][k] = *(const PG8_LAS bf16x8*)(lds + PG8_SB(b, h) + boff + n * 2048 + k * 1024); } while (0)
#define PG8_MMA(ai, bj, At, Bt) do { __builtin_amdgcn_s_setprio(1); _Pragma("unroll") for (int m = 0; m < 4; ++m) _Pragma("unroll") for (int n = 0; n < 2; ++n) _Pragma("unroll") for (int k = 0; k < 2; ++k) \
        acc[ai][bj][m][n] = __builtin_amdgcn_mfma_f32_16x16x32_bf16(Bt[n][k], At[m][k], acc[ai][bj][m][n], 0, 0, 0); __builtin_amdgcn_s_setprio(0); } while (0)
#define PG8_WAIT_V(n) asm volatile("s_waitcnt vmcnt(" #n ")" ::: "memory")
#define PG8_WAIT_L(n) asm volatile("s_waitcnt lgkmcnt(" #n ")" ::: "memory")
#define PG8_BAR __builtin_amdgcn_s_barrier()
#define PG8_SCHED __builtin_amdgcn_sched_barrier(0)
    Unit cur, nxt; int ui = 0;
    if (!S.next(0, cur)) return;
    f32x4 acc[2][2][4][2];
#pragma unroll
    for (int a = 0; a < 2; ++a)
#pragma unroll
        for (int b = 0; b < 2; ++b)
#pragma unroll
            for (int m = 0; m < 4; ++m)
#pragma unroll
                for (int n = 0; n < 2; ++n) acc[a][b][m][n] = (f32x4){0.f, 0.f, 0.f, 0.f};
    bf16x8 At[4][2], B0[2][2], B1[2][2];
    const char* cA = (const char*)g.A + (size_t)cur.pm * tstep; const char* cB = (const char*)g.Bt + (size_t)cur.pn * tstep;
    S.a_ready(cur);
    if constexpr (SP2) {
        PG8_STAGE(PG8_SB(0, 0), cB, voffB); PG8_STAGE(PG8_SB(0, 1), cB + hstep, voffB); PG8_STAGE(PG8_SA(0, 0), cA, voffA); PG8_STAGE(PG8_SA(0, 1), cA + hstep, voffA);
        if (wr == 1) PG8_BAR;
        PG8_WAIT_V(2); PG8_BAR;
        PG8_STAGE(PG8_SB(1, 0), cB + kstep, voffB); PG8_STAGE(PG8_SA(1, 0), cA + kstep, voffA); PG8_STAGE(PG8_SB(1, 1), cB + hstep + kstep, voffB);
        PG8_WAIT_V(6); PG8_BAR;
    } else {
        PG8_STAGE(PG8_SB(0, 0), cB, voffB); PG8_STAGE(PG8_SA(0, 0), cA, voffA); PG8_STAGE(PG8_SB(0, 1), cB + hstep, voffB); PG8_STAGE(PG8_SA(0, 1), cA + hstep, voffA);
        if (wr == 1) PG8_BAR;
        PG8_WAIT_V(4); PG8_BAR;
        PG8_STAGE(PG8_SB(1, 0), cB + kstep, voffB); PG8_STAGE(PG8_SA(1, 0), cA + kstep, voffA); PG8_STAGE(PG8_SB(1, 1), cB + hstep + kstep, voffB);
        PG8_WAIT_V(6); PG8_BAR;
    }
    for (;;) {
        const bool has_next = S.next(ui + 1, nxt);
        const char* nA = has_next ? (const char*)g.A + (size_t)nxt.pm * tstep : cA; const char* nB = has_next ? (const char*)g.Bt + (size_t)nxt.pn * tstep : cB;
        for (int t = 0; t < nt; t += 2) {
            const bool last = (t == nt - 2);
            const char* a1 = cA + (size_t)(t + 1) * kstep;
            const char* a2 = last ? nA : cA + (size_t)(t + 2) * kstep; const char* b2 = last ? nB : cB + (size_t)(t + 2) * kstep;
            const char* a3 = a2 + kstep; const char* b3 = b2 + kstep;
            if (last && has_next) S.a_ready(nxt);
            if constexpr (SP2) {
            PG8_LDB(B0, 0, 0); PG8_LDB(B1, 0, 1); PG8_SCHED; PG8_LDA(At, 0, 0); PG8_STAGE(PG8_SA(1, 1), a1 + hstep, voffA);
            PG8_WAIT_V(8); PG8_WAIT_L(0); PG8_BAR; PG8_MMA(0, 0, At, B0); PG8_MMA(0, 1, At, B1); PG8_BAR; PG8_SCHED;
            PG8_LDA(At, 0, 1); PG8_STAGE(PG8_SB(0, 0), b2, voffB); PG8_STAGE(PG8_SB(0, 1), b2 + hstep, voffB); PG8_STAGE(PG8_SA(0, 0), a2, voffA);
            PG8_WAIT_V(8); PG8_WAIT_L(0); PG8_BAR; PG8_MMA(1, 0, At, B0); PG8_MMA(1, 1, At, B1); PG8_BAR; PG8_SCHED;
            PG8_LDB(B0, 1, 0); PG8_LDB(B1, 1, 1); PG8_SCHED; PG8_LDA(At, 1, 0); PG8_STAGE(PG8_SA(0, 1), a2 + hstep, voffA);
            PG8_WAIT_V(8); PG8_WAIT_L(0); PG8_BAR; PG8_MMA(0, 0, At, B0); PG8_MMA(0, 1, At, B1); PG8_BAR; PG8_SCHED;
            PG8_LDA(At, 1, 1); PG8_STAGE(PG8_SB(1, 0), b3, voffB); PG8_STAGE(PG8_SB(1, 1), b3 + hstep, voffB); PG8_STAGE(PG8_SA(1, 0), a3, voffA);
            PG8_WAIT_V(8); PG8_WAIT_L(0); PG8_BAR; PG8_MMA(1, 0, At, B0); PG8_MMA(1, 1, At, B1); PG8_BAR; PG8_SCHED;
            } else {
            PG8_LDB(B0, 0, 0); PG8_SCHED; PG8_LDA(At, 0, 0); PG8_STAGE(PG8_SA(1, 1), a1 + hstep, voffA);
            PG8_WAIT_L(8); PG8_BAR; PG8_WAIT_L(0); PG8_MMA(0, 0, At, B0); PG8_BAR; PG8_SCHED;
            PG8_LDB(B1, 0, 1); PG8_STAGE(PG8_SB(0, 0), b2, voffB);
            PG8_BAR; PG8_WAIT_L(0); PG8_MMA(0, 1, At, B1); PG8_BAR;
            PG8_LDA(At, 0, 1); PG8_STAGE(PG8_SA(0, 0), a2, voffA);
            PG8_BAR; PG8_WAIT_L(0); PG8_MMA(1, 0, At, B0); PG8_BAR; PG8_SCHED;
            PG8_STAGE(PG8_SB(0, 1), b2 + hstep, voffB);
            PG8_WAIT_V(6); PG8_BAR; PG8_MMA(1, 1, At, B1); PG8_BAR;
            PG8_LDB(B0, 1, 0); PG8_SCHED; PG8_LDA(At, 1, 0); PG8_STAGE(PG8_SA(0, 1), a2 + hstep, voffA);
            PG8_WAIT_L(8); PG8_BAR; PG8_WAIT_L(0); PG8_MMA(0, 0, At, B0); PG8_BAR; PG8_SCHED;
            PG8_LDB(B1, 1, 1); PG8_STAGE(PG8_SB(1, 0), b3, voffB);
            PG8_BAR; PG8_WAIT_L(0); PG8_MMA(0, 1, At, B1); PG8_BAR;
            PG8_LDA(At, 1, 1); PG8_STAGE(PG8_SA(1, 0), a3, voffA);
            PG8_BAR; PG8_WAIT_L(0); PG8_MMA(1, 0, At, B0); PG8_BAR; PG8_SCHED;
            PG8_STAGE(PG8_SB(1, 1), b3 + hstep, voffB);
            PG8_WAIT_V(6); PG8_BAR; PG8_MMA(1, 1, At, B1); PG8_BAR;
            }
        }
        if constexpr (ALIGN_EPI) { if (wr == 0) PG8_BAR; }
        if constexpr (!Epi::AFTER_DRAIN) { E(acc, cur, wr, wc, fr, fq); S.done(cur); }
        if (!has_next) break;
#pragma unroll
        for (int a = 0; a < 2; ++a)
#pragma unroll
            for (int b = 0; b < 2; ++b)
#pragma unroll
                for (int m = 0; m < 4; ++m)
#pragma unroll
                    for (int n = 0; n < 2; ++n) acc[a][b][m][n] = (f32x4){0.f, 0.f, 0.f, 0.f};
        cur = nxt; cA = nA; cB = nB; ++ui;
        if constexpr (ALIGN_EPI) { if (wr == 1) PG8_BAR; }
    }
    PG8_WAIT_V(0);
    if constexpr (!ALIGN_EPI) { if (wr == 0) PG8_BAR; }
    PG8_BAR;
    if constexpr (Epi::AFTER_DRAIN) { E.fused(acc, cur, wr, wc, fr, fq, lds, wid, lane); S.done(cur); }
#undef PG8_SA
#undef PG8_SB
#undef PG8_STAGE
#undef PG8_LDA
#undef PG8_LDB
#undef PG8_MMA
#undef PG8_WAIT_V
#undef PG8_WAIT_L
#undef PG8_BAR
#undef PG8_SCHED
}
}
namespace attn {
using bf16 = __hip_bfloat16;
constexpr int   D = 128, NW = 8, QBLK = 32, KVBLK = 64;
constexpr float SCALE = 0.088388347648318440f;
constexpr float THR = 8.f;
constexpr int SDEPTH = 2;
constexpr int LDQ = 1024, LDK = 128, LDO = 1024;
constexpr size_t SHM_V = KVBLK * D * 2, SHM_K = KVBLK * D * 2, SHM_ATTN = 2 * SHM_V + 2 * SHM_K + NW * 64 * 4;
using bf16x8 = __attribute__((ext_vector_type(8))) short;
using s16x4  = __attribute__((ext_vector_type(4))) short;
using f32x16 = __attribute__((ext_vector_type(16))) float;
using f32x8  = __attribute__((ext_vector_type(8))) float;
using u32x4  = __attribute__((ext_vector_type(4))) unsigned;
#define KSWZ(row, colB) ((row) * 256 + ((colB) ^ (((row) & 7) << 4)))
#define SBAR() __builtin_amdgcn_sched_barrier(0)
__device__ __forceinline__ int crow(int r, int hi) { return (r & 3) + 8 * (r >> 2) + 4 * hi; }
__device__ __forceinline__ unsigned cvtpk(float lo, float hi) {
  unsigned r; asm volatile("v_cvt_pk_bf16_f32 %0, %1, %2" : "=v"(r) : "v"(lo), "v"(hi)); return r;
}
template <typename TIn> struct Stage;
template <> struct Stage<bf16>  { using T = bf16x8;
  __device__ static __forceinline__ T ld8(const bf16* p) { return *reinterpret_cast<const bf16x8*>(p); }
  __device__ static __forceinline__ bf16x8 tobf(T x) { return x; } };
template <> struct Stage<float> { using T = f32x8;
  __device__ static __forceinline__ T ld8(const float* p) { return *reinterpret_cast<const f32x8*>(p); }
  __device__ static __forceinline__ bf16x8 tobf(T x) {
    u32x4 w = {cvtpk(x[0], x[1]), cvtpk(x[2], x[3]), cvtpk(x[4], x[5]), cvtpk(x[6], x[7])}; return *reinterpret_cast<bf16x8*>(&w); } };

__device__ __forceinline__ void partialSM(f32x16& p0, f32x16& p1, float& m_reg, float& mn, float& alpha) {
  constexpr float C = SCALE * 1.4426950408889634f;
  float pmax = p0[0]; for (int r = 1; r < 16; ++r) pmax = fmaxf(pmax, p0[r]); for (int r = 0; r < 16; ++r) pmax = fmaxf(pmax, p1[r]);
  { auto rr = __builtin_amdgcn_permlane32_swap(__float_as_uint(pmax), __float_as_uint(pmax), false, false);
    pmax = fmaxf(__uint_as_float(rr[0]), __uint_as_float(rr[1])); }
  if (__builtin_expect(__all(pmax - m_reg <= THR / SCALE), 1)) { mn = m_reg; alpha = 1.f; }
  else { mn = fmaxf(m_reg, pmax); alpha = __builtin_amdgcn_exp2f((m_reg - mn) * C); m_reg = mn; }
  float mnC = -mn * C;
  for (int r = 0; r < 16; ++r) p0[r] = fmaf(p0[r], C, mnC); for (int r = 0; r < 16; ++r) p1[r] = fmaf(p1[r], C, mnC);
  for (int r = 0; r < 16; ++r) p0[r] = __builtin_amdgcn_exp2f(p0[r]);
}
__device__ __forceinline__ void finishSM(f32x16& p0, f32x16& p1, float alpha, float& l_reg, bf16x8& pa0, bf16x8& pa1, bf16x8& pa2, bf16x8& pa3) {
  for (int r = 0; r < 16; ++r) p1[r] = __builtin_amdgcn_exp2f(p1[r]);
  float ps = 0; for (int r = 0; r < 16; ++r) ps += p0[r]; for (int r = 0; r < 16; ++r) ps += p1[r];
  { auto rr = __builtin_amdgcn_permlane32_swap(__float_as_uint(ps), __float_as_uint(ps), false, false);
    ps = __uint_as_float(rr[0]) + __uint_as_float(rr[1]); }
  l_reg = l_reg * alpha + ps;
#define PK4(P, BASE, OUT) do { unsigned a0 = cvtpk(P[BASE + 0], P[BASE + 1]), a1 = cvtpk(P[BASE + 2], P[BASE + 3]);   \
    unsigned b0 = cvtpk(P[BASE + 4], P[BASE + 5]), b1 = cvtpk(P[BASE + 6], P[BASE + 7]);                              \
    auto r0 = __builtin_amdgcn_permlane32_swap(a0, b0, false, false); auto r1 = __builtin_amdgcn_permlane32_swap(a1, b1, false, false); \
    u32x4 w = {r0[0], r1[0], r0[1], r1[1]}; OUT = *reinterpret_cast<bf16x8*>(&w); } while (0)
  PK4(p0, 0, pa0); PK4(p0, 8, pa1); PK4(p1, 0, pa2); PK4(p1, 8, pa3);
#undef PK4
}
__device__ __forceinline__ void qkt(f32x16& p0, f32x16& p1, const bf16* Ks, const bf16x8* qr, int r32, int hi) {
  p0 = f32x16{}; p1 = f32x16{};
  for (int d0 = 0; d0 < 8; ++d0) { int cb = (d0 * 16 + hi * 8) * 2;
    bf16x8 b0 = *reinterpret_cast<const bf16x8*>((const char*)Ks + KSWZ(r32, cb));
    bf16x8 b1 = *reinterpret_cast<const bf16x8*>((const char*)Ks + KSWZ(32 + r32, cb));
    p0 = __builtin_amdgcn_mfma_f32_32x32x16_bf16(b0, qr[d0], p0, 0, 0, 0);
    p1 = __builtin_amdgcn_mfma_f32_32x32x16_bf16(b1, qr[d0], p1, 0, 0, 0); }
}
__device__ __forceinline__ int v_st(int k, int c) { const int kk = (k & ~0xC) | ((k & 4) << 1) | ((k & 8) >> 1); return ((kk >> 3) * 4 + (c >> 5)) * 512 + ((kk & 7) * 32 + (c & 31)) * 2; }
__device__ __forceinline__ int v_rd_base(int lane) { return ((lane & 3) << 3) | (((lane >> 2) & 3) << 6) | (((lane >> 4) & 1) << 5) | (((lane >> 5) & 1) << 8); }
constexpr int v_rd_off(int d0, int ks, int half) { return d0 * 512 + ks * 4096 + half * 2048; }
template <int OFF> __device__ __forceinline__ s16x4 tr_read(int vb) {
  s16x4 r; asm volatile("ds_read_b64_tr_b16 %0, %1 offset:%2" : "=&v"(r) : "v"(vb), "i"(OFF) : "memory"); return r;
}
template <int D0> __device__ __forceinline__ void pv_one(f32x16& od, int vb, bf16x8 pa0, bf16x8 pa1, bf16x8 pa2, bf16x8 pa3) {
  const s16x4 l0 = tr_read<v_rd_off(D0, 0, 0)>(vb), h0 = tr_read<v_rd_off(D0, 0, 1)>(vb), l1 = tr_read<v_rd_off(D0, 1, 0)>(vb), h1 = tr_read<v_rd_off(D0, 1, 1)>(vb);
  const s16x4 l2 = tr_read<v_rd_off(D0, 2, 0)>(vb), h2 = tr_read<v_rd_off(D0, 2, 1)>(vb), l3 = tr_read<v_rd_off(D0, 3, 0)>(vb), h3 = tr_read<v_rd_off(D0, 3, 1)>(vb);
  asm volatile("s_waitcnt lgkmcnt(0)" ::: "memory"); SBAR();
#define PK(L, H) (bf16x8){L[0], L[1], L[2], L[3], H[0], H[1], H[2], H[3]}
  od = __builtin_amdgcn_mfma_f32_32x32x16_bf16(pa0, PK(l0, h0), od, 0, 0, 0);
  od = __builtin_amdgcn_mfma_f32_32x32x16_bf16(pa1, PK(l1, h1), od, 0, 0, 0);
  od = __builtin_amdgcn_mfma_f32_32x32x16_bf16(pa2, PK(l2, h2), od, 0, 0, 0);
  od = __builtin_amdgcn_mfma_f32_32x32x16_bf16(pa3, PK(l3, h3), od, 0, 0, 0);
#undef PK
}
__device__ __forceinline__ void pv_d0(f32x16* o, int vb, bf16x8 pa0, bf16x8 pa1, bf16x8 pa2, bf16x8 pa3) {
  pv_one<0>(o[0], vb, pa0, pa1, pa2, pa3); pv_one<1>(o[1], vb, pa0, pa1, pa2, pa3); pv_one<2>(o[2], vb, pa0, pa1, pa2, pa3); pv_one<3>(o[3], vb, pa0, pa1, pa2, pa3);
}

template <typename TQ>
__device__ __forceinline__ void attn_dense_body(const TQ* __restrict__ Qb, const bf16* __restrict__ Kh, const bf16* __restrict__ Vh,
                                                bf16* __restrict__ Ob, int seq, char* lds) {
  using St = Stage<bf16>; using SQ = Stage<TQ>;
  const int tid = opaque_tid(), wid = tid >> 6, lane = tid & 63, r32 = lane & 31, hi = lane >> 5;
  bf16* V_lds = (bf16*)lds; bf16* K_lds = (bf16*)(lds + 2 * SHM_V);
  float* ws = (float*)(lds + 2 * SHM_V + 2 * SHM_K) + wid * 64; float* li_l = ws; float* al_l = ws + 32;
  float m_reg = -1e30f, l_reg = 0; f32x16 o[4] = {}; bf16x8 qr[8];
  const TQ* Qw = Qb + (long)(wid * QBLK + r32) * LDQ + hi * 8;
#pragma unroll
  for (int d0 = 0; d0 < 8; ++d0) qr[d0] = SQ::tobf(SQ::ld8(Qw + d0 * 16));
  const int sr = tid >> 4, sc = (tid & 15) * 8, vst0 = v_st(sr, sc), vst1 = v_st(32 + sr, sc);
  const int vb0 = (int)(uintptr_t)V_lds + v_rd_base(lane);
  struct { typename St::T vs0, vs1, ks0, ks1; } sr_[SDEPTH];
#define SLOAD(i, k0) do { sr_[i].vs0 = St::ld8(&Vh[(long)((k0) + sr) * LDK + sc]); sr_[i].vs1 = St::ld8(&Vh[(long)((k0) + 32 + sr) * LDK + sc]); \
    sr_[i].ks0 = St::ld8(&Kh[(long)((k0) + sr) * LDK + sc]); sr_[i].ks1 = St::ld8(&Kh[(long)((k0) + 32 + sr) * LDK + sc]); } while (0)
#define SWRITE(b, i) do { *(bf16x8*)((char*)V_lds + (b) * SHM_V + vst0) = St::tobf(sr_[i].vs0);          \
    *(bf16x8*)((char*)V_lds + (b) * SHM_V + vst1) = St::tobf(sr_[i].vs1); int kc = sc * 2;               \
    *(bf16x8*)((char*)K_lds + (b) * SHM_K + KSWZ(sr, kc)) = St::tobf(sr_[i].ks0);                       \
    *(bf16x8*)((char*)K_lds + (b) * SHM_K + KSWZ(32 + sr, kc)) = St::tobf(sr_[i].ks1); } while (0)
#define SWAIT() do { if constexpr (SDEPTH == 2) asm volatile("s_waitcnt vmcnt(4)" ::: "memory"); else asm volatile("s_waitcnt vmcnt(0)" ::: "memory"); } while (0)
#define RESC(a) do { if (__any((a) < 1.f)) { if (hi == 0) al_l[r32] = (a); asm volatile("s_waitcnt lgkmcnt(0)" ::: "memory"); \
    for (int d = 0; d < 4; ++d) for (int r = 0; r < 16; ++r) o[d][r] *= al_l[crow(r, hi)]; } } while (0)
  f32x16 pA0, pA1, pB0, pB1; float mnA, mnB, alA, alB; bf16x8 pa0, pa1, pa2, pa3; const int NT = seq / KVBLK;
  constexpr int SE = 0, SO = SDEPTH - 1;
  SLOAD(SE, 0); asm volatile("s_waitcnt vmcnt(0)" ::: "memory"); SWRITE(0, SE); __syncthreads();
  qkt(pA0, pA1, K_lds, qr, r32, hi); partialSM(pA0, pA1, m_reg, mnA, alA);
  SLOAD(SO, KVBLK); if constexpr (SDEPTH == 2) { if (2 < NT) SLOAD(SE, 2 * KVBLK); }
  SWAIT(); SWRITE(1, SO); __syncthreads();
  for (int j = 1; j + 1 < NT; j += 2) {
    SBAR(); qkt(pB0, pB1, (bf16*)((char*)K_lds + SHM_K), qr, r32, hi);
    finishSM(pA0, pA1, alA, l_reg, pa0, pa1, pa2, pa3); SBAR();
    SLOAD(SO, (j + SDEPTH) * KVBLK); SBAR();
    pv_d0(o, vb0, pa0, pa1, pa2, pa3); partialSM(pB0, pB1, m_reg, mnB, alB);
    __syncthreads(); SWAIT(); SWRITE(0, SE);
    RESC(alB); __syncthreads();
    SBAR(); qkt(pA0, pA1, K_lds, qr, r32, hi);
    finishSM(pB0, pB1, alB, l_reg, pa0, pa1, pa2, pa3); SBAR();
    if (SDEPTH == 1 || j + 3 < NT) SLOAD(SE, (j + 1 + SDEPTH) * KVBLK); SBAR();
    pv_d0(o, vb0 + (int)SHM_V, pa0, pa1, pa2, pa3); partialSM(pA0, pA1, m_reg, mnA, alA);
    __syncthreads(); SWAIT(); SWRITE(1, SO);
    RESC(alA); __syncthreads();
  }
  SBAR(); qkt(pB0, pB1, (bf16*)((char*)K_lds + SHM_K), qr, r32, hi);
  finishSM(pA0, pA1, alA, l_reg, pa0, pa1, pa2, pa3); SBAR();
  pv_d0(o, vb0, pa0, pa1, pa2, pa3); partialSM(pB0, pB1, m_reg, mnB, alB);
  __syncthreads(); RESC(alB);
  finishSM(pB0, pB1, alB, l_reg, pa0, pa1, pa2, pa3); SBAR();
  pv_d0(o, vb0 + (int)SHM_V, pa0, pa1, pa2, pa3);
  if (hi == 0) li_l[r32] = l_reg; asm volatile("s_waitcnt lgkmcnt(0)" ::: "memory");
  float rli[16];
#pragma unroll
  for (int r = 0; r < 16; ++r) rli[r] = __builtin_amdgcn_rcpf(li_l[crow(r, hi)]);
  bf16* Ow = Ob + (long)(wid * QBLK) * LDO;
#pragma unroll
  for (int r = 0; r < 16; ++r) { int orow = crow(r, hi);
    for (int d0 = 0; d0 < 4; ++d0) Ow[(long)orow * LDO + d0 * 32 + r32] = __float2bfloat16(o[d0][r] * rli[r]); }
#undef SLOAD
#undef SWRITE
#undef SWAIT
#undef RESC
}

}
#define LAS __attribute__((address_space(3)))
typedef unsigned short bf16_t;
typedef short bf16x8 __attribute__((ext_vector_type(8)));
typedef short s16x4 __attribute__((ext_vector_type(4)));
typedef float f32x4 __attribute__((ext_vector_type(4)));
typedef float f32x16 __attribute__((ext_vector_type(16)));
typedef unsigned u32x4 __attribute__((ext_vector_type(4)));
typedef unsigned u32x2 __attribute__((ext_vector_type(2)));
using pg8::cvtpk_s; using pg8::bf_lo; using pg8::bf_hi; using pg8::silu_f;

constexpr int DM = 1024, SEQ = 16384, CTXL = 256, NLAT = 2 * SEQ, MROWS = NLAT + 2 * CTXL, DFF = 4096;
constexpr float EPS = 1e-6f;
constexpr size_t MiB = 1u << 20;
constexpr size_t WS_MOD = 0, WS_CTX = 1 * MiB, WS_WT = 4 * MiB, WS_H = 41 * MiB, WS_AB = 106 * MiB, WS_RSTD = 115 * MiB, WS_P = 118 * MiB, WS_O = 378 * MiB, WS_END = 508 * MiB;
constexpr size_t WT_A = WS_WT, WT_Z = WS_WT + 9 * MiB, WT_O = WS_WT + 13 * MiB, WT_1 = WS_WT + 17 * MiB, WT_2 = WS_WT + 25 * MiB;
constexpr size_t WS_QM = 313 * MiB, WS_KM = 378 * MiB, WS_OGLA = 443 * MiB, WS_AQ = 41 * MiB, WS_EL = 74 * MiB;
constexpr size_t WS_TP = 4 * MiB, WS_HALO = 378 * MiB;
constexpr size_t WS_QR = 216 * MiB, WS_KR = 281 * MiB, WS_VR = 298 * MiB;
constexpr int SKV = SEQ + CTXL;
constexpr int LDS_BYTES = 155648;
enum { OP_MOD, OP_PREP, OP_GEMM_IN, OP_DNSCAN, OP_DNREDO, OP_GEMM_Z, OP_GEMM_OUT, OP_NORM2, OP_FFN1, OP_FFN2, OP_GLAPREP, OP_GLASCAN, OP_GLAGATE, OP_QKROPE, OP_ATTN, OP_DNHALO, OP_DNCONV, OP_DNT };

struct Args { const float* in[25]; float* out; unsigned char* ws; int ph_lo, ph_hi; };

__device__ __forceinline__ float wave_sum(float v) {
#pragma unroll
    for (int o = 1; o < 64; o <<= 1) v += __shfl_xor(v, o);
    return v;
}
__device__ __forceinline__ float softplus_f(float x) { return x > 20.f ? x : log1pf(__expf(x)); }
__device__ __forceinline__ float logsigmoid_f(float x) { return fminf(x, 0.f) - log1pf(__expf(-fabsf(x))); }
__device__ __forceinline__ bf16_t f2bf(float f) { return (bf16_t)(cvtpk_s(f, 0.f) & 0xffffu); }
__device__ __forceinline__ float bf2f(bf16_t v) { return __builtin_bit_cast(float, (unsigned)v << 16); }

__device__ __forceinline__ void transpose_item(const float* W, int ldw, int c0, int ncols, int K, bf16_t* WT, int row_off, LAS float* scr, int item, int lane) {
    const int nblk = ncols / 32, kb = item / nblk, nb = item % nblk, k0 = 64 * kb, n0 = 32 * nb;
#pragma unroll 8
    for (int i = 0; i < 32; ++i) { const int kk = 2 * i + (lane >> 5); scr[kk * 33 + (lane & 31)] = W[(size_t)(k0 + kk) * ldw + c0 + n0 + (lane & 31)]; }
    asm volatile("s_waitcnt lgkmcnt(0)" ::: "memory");
    const int c = lane & 7;
#pragma unroll
    for (int j = 0; j < 4; ++j) { const int n = (lane >> 3) + 8 * j; const LAS float* s = scr + (8 * c) * 33 + n;
        u32x4 o; o.x = cvtpk_s(s[0 * 33], s[1 * 33]); o.y = cvtpk_s(s[2 * 33], s[3 * 33]); o.z = cvtpk_s(s[4 * 33], s[5 * 33]); o.w = cvtpk_s(s[6 * 33], s[7 * 33]);
        *(u32x4*)(WT + (size_t)(row_off + n0 + n) * K + k0 + 8 * c) = o; }
    asm volatile("s_waitcnt lgkmcnt(0)" ::: "memory");
}
__device__ __forceinline__ void transpose_mat(const float* W, int ldw, int c0, int ncols, int K, bf16_t* WT, int row_off, LAS float* scr, int gw, int NGW, int lane) {
    const int nitems = (K / 64) * (ncols / 32);
    for (int it = gw; it < nitems; it += NGW) transpose_item(W, ldw, c0, ncols, K, WT, row_off, scr, it, lane);
}
__device__ __forceinline__ void normmod_rows(const float* xl, const float* xc, const float* g, const float* modl, int sidx, bf16_t* H, int gw, int NGW, int lane) {
    for (int row = gw; row < MROWS; row += NGW) {
        const float* xr = row < NLAT ? xl + (size_t)row * DM : xc + (size_t)(row - NLAT) * DM;
        const int mi = row < SEQ ? 0 : (row < NLAT ? 1 : 2);
        const float* sh = modl + (size_t)mi * 6144 + (size_t)sidx * 1024; const float* sc = sh + 1024;
        f32x4 v[4]; float ss = 0.f;
#pragma unroll
        for (int j = 0; j < 4; ++j) { v[j] = *(const f32x4*)(xr + 4 * lane + 256 * j); ss += (v[j][0] * v[j][0] + v[j][1] * v[j][1]) + (v[j][2] * v[j][2] + v[j][3] * v[j][3]); }
        const float rinv = rsqrtf(wave_sum(ss) * (1.f / DM) + EPS);
#pragma unroll
        for (int j = 0; j < 4; ++j) { const int c = 4 * lane + 256 * j; const f32x4 gg = *(const f32x4*)(g + c), s1 = *(const f32x4*)(sc + c), s0 = *(const f32x4*)(sh + c);
            f32x4 y;
#pragma unroll
            for (int e = 0; e < 4; ++e) y[e] = v[j][e] * rinv * gg[e] * (1.f + s1[e]) + s0[e];
            u32x2 w; w.x = cvtpk_s(y[0], y[1]); w.y = cvtpk_s(y[2], y[3]); *(u32x2*)(H + (size_t)row * DM + c) = w; }
    }
}
#define BAR_LDS() do { asm volatile("s_waitcnt lgkmcnt(0)" ::: "memory"); __builtin_amdgcn_s_barrier(); asm volatile("" ::: "memory"); } while (0)
__device__ __forceinline__ int crow(int x, int h) { return (x & 3) + 8 * (x >> 2) + 4 * h; }
#define MFMA32(a, b, c) __builtin_amdgcn_mfma_f32_32x32x16_bf16((a), (b), (c), 0, 0, 0)
__device__ __forceinline__ bf16x8 frag_nat(const LAS bf16_t* img, int LD, int row, int ks, int h) { return *(const LAS bf16x8*)(img + row * LD + 16 * ks + 8 * h); }
__device__ __forceinline__ bf16x8 frag_perm(const LAS bf16_t* img, int LD, int row, int ks, int h) {
    const s16x4 lo = *(const LAS s16x4*)(img + row * LD + 16 * ks + 4 * h), hi = *(const LAS s16x4*)(img + row * LD + 16 * ks + 8 + 4 * h);
    return __builtin_shufflevector(lo, hi, 0, 1, 2, 3, 4, 5, 6, 7);
}
__device__ __forceinline__ s16x4 tr4(const LAS bf16_t* p) { return __builtin_bit_cast(s16x4, __builtin_amdgcn_ds_read_tr16_b64_v4i16((LAS s16x4*)p)); }
__device__ __forceinline__ bf16x8 frag_tr(const LAS bf16_t* img, int LD, int m0, int ks, int lane) {
    const int i16 = lane & 15, q = i16 >> 2, p = i16 & 3, blk = (lane >> 4) & 1, h = lane >> 5;
    const LAS bf16_t* a = img + (16 * ks + 4 * h + q) * LD + m0 + 16 * blk + 4 * p;
    const s16x4 lo = tr4(a), hi = tr4(a + 8 * LD);
    return __builtin_shufflevector(lo, hi, 0, 1, 2, 3, 4, 5, 6, 7);
}
__device__ __forceinline__ bf16x8 pack_step(const f32x16& x, int s) {
    u32x4 p; p.x = cvtpk_s(x[8 * s + 0], x[8 * s + 1]); p.y = cvtpk_s(x[8 * s + 2], x[8 * s + 3]); p.z = cvtpk_s(x[8 * s + 4], x[8 * s + 5]); p.w = cvtpk_s(x[8 * s + 6], x[8 * s + 7]);
    return __builtin_bit_cast(bf16x8, p);
}
__device__ __forceinline__ void dn_halo_phase(const bf16_t* P, bf16_t* HALO, int G) {
    const int tid = opaque_tid();
    for (size_t e = (size_t)blockIdx.x * 512 + tid; e < (size_t)520 * 4 * 512; e += (size_t)G * 512) {
        const int c = (int)(e & 511), j = (int)((e >> 9) & 3), rb = (int)(e >> 11);
        const int row = rb * 64 + (j < 2 ? j : 60 + j);
        ((u32x4*)(HALO + ((size_t)rb * 4 + j) * 4096))[c] = ((const u32x4*)(P + (size_t)row * 4096))[c];
    }
}
__device__ __forceinline__ void unpack8(const u32x4 v, float (&f)[8]) { f[0] = bf_lo(v.x); f[1] = bf_hi(v.x); f[2] = bf_lo(v.y); f[3] = bf_hi(v.y); f[4] = bf_lo(v.z); f[5] = bf_hi(v.z); f[6] = bf_lo(v.w); f[7] = bf_hi(v.w); }
__device__ __forceinline__ void dn_conv_phase(bf16_t* P, const bf16_t* HALO, const float* conv_w, int G) {
    const int tid = opaque_tid(), col0 = 8 * tid;
    float cw[8][5];
#pragma unroll
    for (int c = 0; c < 8; ++c)
#pragma unroll
        for (int tap = 0; tap < 5; ++tap) cw[c][tap] = conv_w[(size_t)(col0 + c) * 5 + tap];
    const int kind = col0 < 1024 ? 0 : (col0 < 2048 ? 1 : 2);
    for (int rb = blockIdx.x; rb < 520; rb += G) {
        const int cs = rb < 512 ? (rb & 255) : ((rb - 512) & 3); const bool sfirst = cs == 0, slast = rb < 512 ? cs == 255 : cs == 3;
        const u32x4 zero = (u32x4){0u, 0u, 0u, 0u};
        bf16_t* base = P + (size_t)rb * 64 * 4096 + col0;
        u32x4 w0 = sfirst ? zero : *(const u32x4*)(HALO + ((size_t)(rb - 1) * 4 + 2) * 4096 + col0);
        u32x4 w1 = sfirst ? zero : *(const u32x4*)(HALO + ((size_t)(rb - 1) * 4 + 3) * 4096 + col0);
        u32x4 w2 = *(const u32x4*)(base), w3 = *(const u32x4*)(base + 4096);
#pragma unroll 4
        for (int rr = 0; rr < 64; ++rr) {
            u32x4 w4;
            if (rr + 2 < 64) w4 = *(const u32x4*)(base + (size_t)(rr + 2) * 4096);
            else w4 = slast ? zero : *(const u32x4*)(HALO + ((size_t)(rb + 1) * 4 + (rr + 2 - 64)) * 4096 + col0);
            float x0[8], x1[8], x2[8], x3[8], x4[8], y[8];
            unpack8(w0, x0); unpack8(w1, x1); unpack8(w2, x2); unpack8(w3, x3); unpack8(w4, x4);
            float ss = 0.f;
#pragma unroll
            for (int c = 0; c < 8; ++c) { const float a = x0[c] * cw[c][0] + x1[c] * cw[c][1] + x2[c] * cw[c][2] + x3[c] * cw[c][3] + x4[c] * cw[c][4]; y[c] = silu_f(a); ss += y[c] * y[c]; }
            float sc = 1.f;
            if (kind < 2) { ss += __shfl_xor(ss, 1); ss += __shfl_xor(ss, 2); ss += __shfl_xor(ss, 4); ss += __shfl_xor(ss, 8); sc = rsqrtf(ss + EPS) * (kind == 0 ? 0.08838834764831845f : 1.f); }
            u32x4 o; o.x = cvtpk_s(y[0] * sc, y[1] * sc); o.y = cvtpk_s(y[2] * sc, y[3] * sc); o.z = cvtpk_s(y[4] * sc, y[5] * sc); o.w = cvtpk_s(y[6] * sc, y[7] * sc);
            *(u32x4*)(base + (size_t)rr * 4096) = o;
            w0 = w1; w1 = w2; w2 = w3; w3 = w4;
        }
    }
}
constexpr int DT_KB = 0, DT_R = 17408, DT_SC = 33792, DT_DIR = 34816;
template <int W> __device__ __forceinline__ void dn_solve(const LAS float* Mf, float (&t)[16], int lane) {
    const int j = 16 * W + (lane >> 2), q = lane & 3;
#pragma unroll
    for (int s = 0; s < 16; ++s) t[s] = 0.f;
#pragma unroll
    for (int i = 16 * W; i < 64; ++i) {
        float acc = 0.f;
#pragma unroll
        for (int s = 4 * W; s <= (i - 1) / 4 && i > 16 * W; ++s) acc += Mf[i * 64 + 4 * s + q] * t[s];
        acc += __shfl_xor(acc, 1); acc += __shfl_xor(acc, 2);
        const float val = (i == j ? 1.f : 0.f) - acc;
        if (q == (i & 3)) t[i >> 2] = val;
        asm volatile("" : "+v"(t[0]), "+v"(t[1]), "+v"(t[2]), "+v"(t[3]), "+v"(t[4]), "+v"(t[5]), "+v"(t[6]), "+v"(t[7]), "+v"(t[8]), "+v"(t[9]), "+v"(t[10]), "+v"(t[11]), "+v"(t[12]), "+v"(t[13]), "+v"(t[14]), "+v"(t[15]));
    }
}
__device__ __forceinline__ void dn_t_phase(LAS unsigned char* lds, const bf16_t* P, float* AB, bf16_t* TP, const float* a_log, const float* dt_bias, int G) {
    const int tid0 = opaque_tid(), hb = __builtin_amdgcn_readfirstlane(tid0 >> 8);
    for (int itb = blockIdx.x * 2; itb < 16640; itb += 2 * G) {
        const int it = itb + hb, dir = it & 1, vh = (it >> 1) & 15, rb = it >> 5, kh = vh >> 1;
        const int tq = opaque_tid(), t = tq & 255, w = __builtin_amdgcn_readfirstlane((tq >> 6) & 3), lane = tq & 63, r = lane & 31, h = lane >> 5;
        LAS unsigned char* base = lds + hb * DT_DIR;
        LAS bf16_t* Kb = (LAS bf16_t*)(base + DT_KB); LAS float* Mf = (LAS float*)(base + DT_R); LAS bf16_t* Tb = (LAS bf16_t*)(base + DT_R);
        LAS float* sc_beta = (LAS float*)(base + DT_SC); LAS float* sc_gc = sc_beta + 64;
        {
            const int r0 = t >> 4, c8 = 8 * (t & 15);
#pragma unroll
            for (int v = 0; v < 4; ++v) { const int i = r0 + 16 * v, ip = dir ? 63 - i : i;
                *(LAS u32x4*)(Kb + ip * 136 + c8) = *(const u32x4*)(P + (size_t)(rb * 64 + i) * 4096 + 1024 + kh * 128 + c8); }
            if (t < 64) {
                const int ti = dir ? 63 - t : t; float* ab = AB + (size_t)(rb * 64 + ti) * 64;
                const float av = ab[dir * 16 + vh], bv = ab[32 + dir * 16 + vh];
                const float g = -__expf(a_log[dir * 16 + vh]) * softplus_f(av + dt_bias[dir * 16 + vh]), beta = 1.f / (1.f + __expf(-bv));
                float gc = g;
#pragma unroll
                for (int o = 1; o < 64; o <<= 1) { const float up = __shfl_up(gc, o); if (t >= o) gc += up; }
                sc_beta[t] = beta; sc_gc[t] = gc;
                ab[dir * 16 + vh] = gc; ab[32 + dir * 16 + vh] = beta;
            }
        }
        __syncthreads();
        const int ti = w >> 1, tj = w & 1;
        {
            f32x16 acc;
#pragma unroll
            for (int x = 0; x < 16; ++x) acc[x] = 0.f;
            if (!(ti == 0 && tj == 1)) {
#pragma unroll
                for (int ks = 0; ks < 8; ++ks) acc = MFMA32(frag_nat(Kb, 136, 32 * ti + r, ks, h), frag_nat(Kb, 136, 32 * tj + r, ks, h), acc);
            }
            const int j = 32 * tj + r; const float gj = sc_gc[j];
#pragma unroll
            for (int x = 0; x < 16; ++x) { const int i = 32 * ti + crow(x, h);
                Mf[i * 64 + j] = (i > j) ? sc_beta[i] * acc[x] * __expf(sc_gc[i] - gj) : 0.f; }
        }
        __syncthreads();
        float tc[16];
        if (w == 0) dn_solve<0>(Mf, tc, lane); else if (w == 1) dn_solve<1>(Mf, tc, lane); else if (w == 2) dn_solve<2>(Mf, tc, lane); else dn_solve<3>(Mf, tc, lane);
        __syncthreads();
        {
            const int j = 16 * w + (lane >> 2), q = lane & 3;
#pragma unroll
            for (int s = 0; s < 16; ++s) Tb[(4 * s + q) * 72 + j] = f2bf(tc[s]);
        }
        __syncthreads();
        {
            bf16_t* dst = TP + (size_t)it * 3072;
#pragma unroll
            for (int k2 = 0; k2 < 2; ++k2) { const int c = t + 256 * k2;
                if (c < 384) { const int blk = c >> 7, rowc = (c & 127) >> 2, cc = c & 3, br = blk ? 1 : 0, bc = blk == 2 ? 1 : 0;
                    *(u32x4*)(dst + c * 8) = *(const LAS u32x4*)(Tb + (32 * br + rowc) * 72 + 32 * bc + 8 * cc); } }
        }
        __syncthreads();
    }
}
constexpr int DN_KB = 0, DN_QB = 17408, DN_VB = 34816, DN_TB = 51200, DN_AB = 60416, DN_SC = 69632, DN_DIR = 71168;
__device__ __forceinline__ void dn_step_rb(int step, int dir, int b, int& rb, bool& first) {
    if (step < 4) { const int cidx = dir ? 3 - step : step; rb = 512 + b * 4 + cidx; first = step < 2; }
    else { const int c = step - 4; const int cidx = dir ? 255 - c : c; rb = b * 256 + cidx; first = c < 128; }
}
struct DnPre { u32x4 k4[4], q4[4], v4[4], t0, t1; float gc, beta; };
__device__ __forceinline__ void dn_prefetch(DnPre& p, const bf16_t* P, const float* AB, const bf16_t* TP, int rb, int dir, int vh, int kh, int t, int part) {
    const int r0 = t >> 4, c8 = 8 * (t & 15);
    const bf16_t* prow = P + (size_t)(rb * 64 + r0) * 4096 + c8;
    const bf16_t* tp = TP + (size_t)((rb * 16 + vh) * 2 + dir) * 3072;
    if (part & 1) {
#pragma unroll
        for (int v = 0; v < 4; ++v) { const bf16_t* pr = prow + (size_t)(16 * v) * 4096;
            p.k4[v] = *(const u32x4*)(pr + 1024 + kh * 128); p.q4[v] = *(const u32x4*)(pr + kh * 128); p.v4[v] = *(const u32x4*)(pr + 2048 + vh * 128); }
    }
    if (part & 2) {
        p.t0 = *(const u32x4*)(tp + t * 8); p.t1 = *(const u32x4*)(tp + (256 + (t & 127)) * 8);
        const int ti = dir ? 63 - (t & 63) : (t & 63); const float* ab = AB + (size_t)(rb * 64 + ti) * 64; p.gc = ab[dir * 16 + vh]; p.beta = ab[32 + dir * 16 + vh];
    }
}
template <int VAR> __device__ __forceinline__ void dn_scan(LAS unsigned char* lds, const bf16_t* P, const float* AB, const bf16_t* TP, bf16_t* OB) {
    const int tid = opaque_tid(), dir = __builtin_amdgcn_readfirstlane(tid >> 8);
    for (int unit = blockIdx.x; unit < 32; unit += gridDim.x) {
        const int b = unit >> 4, vh = unit & 15, kh = vh >> 1;
        f32x16 S[4];
#pragma unroll
        for (int kt = 0; kt < 4; ++kt)
#pragma unroll
            for (int x = 0; x < 16; ++x) S[kt][x] = 0.f;
        DnPre pre;
        { int rb0; bool f0; dn_step_rb(0, dir, b, rb0, f0); dn_prefetch(pre, P, AB, TP, rb0, dir, vh, kh, tid & 255, 3); }
        __syncthreads();
        for (int step = 0; step < 260; ++step) {
            const int w = __builtin_amdgcn_readfirstlane((opaque_tid() >> 6) & 3);
            LAS unsigned char* base = lds + dir * DN_DIR;
            LAS bf16_t* Kb = (LAS bf16_t*)(base + DN_KB); LAS bf16_t* Qb = (LAS bf16_t*)(base + DN_QB); LAS bf16_t* Vb = (LAS bf16_t*)(base + DN_VB);
            LAS bf16_t* Tb = (LAS bf16_t*)(base + DN_TB); LAS bf16_t* Ab = (LAS bf16_t*)(base + DN_AB);
            LAS float* sc_beta = (LAS float*)(base + DN_SC); LAS float* sc_gc = sc_beta + 64; LAS float* sc_eg = sc_beta + 128; LAS float* sc_tail = sc_beta + 192; LAS float* sc_dl = sc_beta + 256;
            int rb; bool first; dn_step_rb(step, dir, b, rb, first);
            const int row_base = rb * 64;
            {
                const int tq_ = opaque_tid(), t = tq_ & 255;
                const int r0 = t >> 4, c8 = 8 * (t & 15);
#pragma unroll
                for (int v = 0; v < 4; ++v) { const int i = r0 + 16 * v, ip = dir ? 63 - i : i;
                    *(LAS u32x4*)(Kb + ip * 136 + c8) = pre.k4[v]; *(LAS u32x4*)(Qb + ip * 136 + c8) = pre.q4[v]; *(LAS u32x4*)(Vb + ip * 128 + c8) = pre.v4[v]; }
                { const int c = t, blk = c >> 7, rowc = (c & 127) >> 2, cc = c & 3, br = blk ? 1 : 0; *(LAS u32x4*)(Tb + (32 * br + rowc) * 72 + 8 * cc) = pre.t0; }
                if (t < 128) { const int rowc = t >> 2, cc = t & 3; *(LAS u32x4*)(Tb + (32 + rowc) * 72 + 32 + 8 * cc) = pre.t1; }
                if (t < 64) { const float gc = pre.gc, gl = __shfl(gc, 63); sc_beta[t] = pre.beta; sc_gc[t] = gc; sc_eg[t] = __expf(gc); sc_tail[t] = __expf(gl - gc); if (t == 0) sc_dl[0] = __expf(gl); }
            }
            BAR_LDS();
            {
                const int tq_ = opaque_tid(), lane = tq_ & 63, r = lane & 31, h = lane >> 5;
                const int ti = w >> 1, tj = w & 1;
                if (!(ti == 0 && tj == 1)) {
                    f32x16 qk;
#pragma unroll
                    for (int x = 0; x < 16; ++x) qk[x] = 0.f;
#pragma unroll
                    for (int ks = 0; ks < 8; ++ks) qk = MFMA32(frag_nat(Qb, 136, 32 * ti + r, ks, h), frag_nat(Kb, 136, 32 * tj + r, ks, h), qk);
                    const int jj = 32 * tj + r; const float gj = sc_gc[jj];
#pragma unroll
                    for (int x = 0; x < 16; ++x) { const int i = 32 * ti + crow(x, h);
                        Ab[i * 72 + jj] = f2bf((i >= jj) ? qk[x] * __expf(sc_gc[i] - gj) : 0.f); }
                }
            }
            BAR_LDS();
            if (VAR != 2 && step + 1 < 260) { int rbn; bool fn; dn_step_rb(step + 1, dir, b, rbn, fn); dn_prefetch(pre, P, AB, TP, rbn, dir, vh, kh, opaque_tid() & 255, 1); }
            __builtin_amdgcn_sched_barrier(0);
            if (VAR != 1) {
                const int tq_ = opaque_tid(), lane = tq_ & 63, r = lane & 31, h = lane >> 5;
                f32x16 KS[2], QS[2];
#pragma unroll
                for (int mt = 0; mt < 2; ++mt)
#pragma unroll
                    for (int x = 0; x < 16; ++x) { KS[mt][x] = 0.f; QS[mt][x] = 0.f; }
#pragma unroll
                for (int ks = 0; ks < 8; ++ks) {
                    const bf16x8 sp = pack_step(S[ks >> 1], ks & 1);
#pragma unroll
                    for (int mt = 0; mt < 2; ++mt) { KS[mt] = MFMA32(frag_perm(Kb, 136, 32 * mt + r, ks, h), sp, KS[mt]); QS[mt] = MFMA32(frag_perm(Qb, 136, 32 * mt + r, ks, h), sp, QS[mt]); }
                    if (ks & 1) __builtin_amdgcn_sched_barrier(0);
                }
#pragma unroll
                for (int mt = 0; mt < 2; ++mt)
#pragma unroll
                    for (int x = 0; x < 16; ++x) { const int i = 32 * mt + crow(x, h);
                        KS[mt][x] = sc_beta[i] * (bf2f(Vb[i * 128 + 32 * w + r]) - sc_eg[i] * KS[mt][x]); }
                __builtin_amdgcn_sched_barrier(0);
                bf16x8 Xp[4];
#pragma unroll
                for (int ks = 0; ks < 4; ++ks) Xp[ks] = pack_step(KS[ks >> 1], ks & 1);
                f32x16 VN[2];
#pragma unroll
                for (int mt = 0; mt < 2; ++mt) {
#pragma unroll
                    for (int x = 0; x < 16; ++x) VN[mt][x] = 0.f;
#pragma unroll
                    for (int ks = 0; ks < 4; ++ks) if (ks < 2 * mt + 2) VN[mt] = MFMA32(frag_perm(Tb, 72, 32 * mt + r, ks, h), Xp[ks], VN[mt]);
                }
                __builtin_amdgcn_sched_barrier(0);
                if (VAR != 2 && step + 1 < 260) { int rbn; bool fn; dn_step_rb(step + 1, dir, b, rbn, fn); dn_prefetch(pre, P, AB, TP, rbn, dir, vh, kh, opaque_tid() & 255, 2); }
                __builtin_amdgcn_sched_barrier(0);
                bf16x8 VNp[4];
#pragma unroll
                for (int ks = 0; ks < 4; ++ks) VNp[ks] = pack_step(VN[ks >> 1], ks & 1);
#pragma unroll
                for (int mt = 0; mt < 2; ++mt) {
#pragma unroll
                    for (int x = 0; x < 16; ++x) QS[mt][x] *= sc_eg[32 * mt + crow(x, h)];
#pragma unroll
                    for (int ks = 0; ks < 4; ++ks) if (ks < 2 * mt + 2) QS[mt] = MFMA32(frag_perm(Ab, 72, 32 * mt + r, ks, h), VNp[ks], QS[mt]);
                }
                __builtin_amdgcn_sched_barrier(0);
#pragma unroll
                for (int mt = 0; mt < 2; ++mt)
#pragma unroll
                    for (int x = 0; x < 16; ++x) Vb[(32 * mt + crow(x, h)) * 128 + 32 * w + r] = f2bf(QS[mt][x]);
                __builtin_amdgcn_sched_barrier(0);
#pragma unroll
                for (int mt = 0; mt < 2; ++mt)
#pragma unroll
                    for (int x = 0; x < 16; ++x) VN[mt][x] *= sc_tail[32 * mt + crow(x, h)];
#pragma unroll
                for (int ks = 0; ks < 4; ++ks) VNp[ks] = pack_step(VN[ks >> 1], ks & 1);
                __builtin_amdgcn_sched_barrier(0);
                const float dl = sc_dl[0];
#pragma unroll
                for (int kt = 0; kt < 4; ++kt)
#pragma unroll
                    for (int x = 0; x < 16; ++x) S[kt][x] *= dl;
#pragma unroll
                for (int ks = 0; ks < 4; ++ks) {
#pragma unroll
                    for (int kt = 0; kt < 4; ++kt) S[kt] = MFMA32(frag_tr(Kb, 136, 32 * kt, ks, lane), VNp[ks], S[kt]);
                    __builtin_amdgcn_sched_barrier(0);
                }
                if (VAR != 2) {
                    const int rr_ = lane >> 2, c8_ = 8 * (lane & 3);
#pragma unroll
                    for (int v = 0; v < 4; ++v) { const int ip_ = rr_ + 16 * v, i_ = dir ? 63 - ip_ : ip_;
                        u32x4* gp_ = (u32x4*)(OB + (size_t)(row_base + i_) * 2048 + vh * 128 + 32 * w + c8_);
                        u32x4 o = *(const LAS u32x4*)(Vb + ip_ * 128 + 32 * w + c8_);
                        if (!first) { const u32x4 e = gp_[0];
                            o.x = cvtpk_s(bf_lo(o.x) + bf_lo(e.x), bf_hi(o.x) + bf_hi(e.x)); o.y = cvtpk_s(bf_lo(o.y) + bf_lo(e.y), bf_hi(o.y) + bf_hi(e.y));
                            o.z = cvtpk_s(bf_lo(o.z) + bf_lo(e.z), bf_hi(o.z) + bf_hi(e.z)); o.w = cvtpk_s(bf_lo(o.w) + bf_lo(e.w), bf_hi(o.w) + bf_hi(e.w)); }
                        gp_[0] = o; }
                }
            }
            if (step == 1 || step == 131) asm volatile("s_waitcnt vmcnt(0)" ::: "memory");
            BAR_LDS();
        }
    }
}
constexpr int GP_QM = 0, GP_KM = 17408, GP_AB = 34816, GP_LOW = 44032, GP_TOT = 48128, GP_DIR = 49152;
__device__ __forceinline__ void gla_prep_phase(LAS unsigned char* lds, const bf16_t* P, const float* LOW, const float* gw2, const float* gb2, bf16_t* QM, bf16_t* KM, bf16_t* AQ, float* EL, int G) {
    const int tid0 = opaque_tid(), hb = __builtin_amdgcn_readfirstlane(tid0 >> 8);
    for (int itb = blockIdx.x * 2; itb < 4160; itb += 2 * G) {
        const int it = itb + hb, dir = it & 1, head = (it >> 1) & 3, rb = it >> 3;
        const int tq = opaque_tid(), t = tq & 255, w = __builtin_amdgcn_readfirstlane((tq >> 6) & 3), lane = tq & 63, r = lane & 31, h = lane >> 5;
        LAS unsigned char* base = lds + hb * GP_DIR;
        LAS bf16_t* Qm = (LAS bf16_t*)(base + GP_QM); LAS bf16_t* Km = (LAS bf16_t*)(base + GP_KM); LAS bf16_t* Ab = (LAS bf16_t*)(base + GP_AB);
        LAS float* lowS = (LAS float*)(base + GP_LOW); LAS float* tot = (LAS float*)(base + GP_TOT);
        *(LAS f32x4*)(lowS + 4 * t) = *(const f32x4*)(LOW + (size_t)(rb * 64 + (t >> 2)) * 32 + dir * 16 + 4 * (t & 3));
        const int dk = t & 127, half = t >> 7, col = head * 128 + dk;
        float w2c[16];
#pragma unroll
        for (int rr = 0; rr < 16; ++rr) w2c[rr] = gw2[(size_t)(dir * 16 + rr) * 512 + col];
        const float b2 = gb2[dir * 512 + col];
        __syncthreads();
        float bc[32]; float run = 0.f;
#pragma unroll
        for (int n = 0; n < 32; ++n) { const int ip = 32 * half + n, i = dir ? 63 - ip : ip; float s = b2;
#pragma unroll
            for (int rr = 0; rr < 16; ++rr) s += lowS[i * 16 + rr] * w2c[rr];
            run += logsigmoid_f(s) * (1.f / 16.f); bc[n] = run; }
        tot[half * 128 + dk] = run;
        __syncthreads();
        const float t0 = tot[dk], last = t0 + tot[128 + dk], off = half ? t0 : 0.f;
        if (half == 0) EL[(size_t)(dir * 520 + rb) * 512 + col] = last;
        {
            const int i0 = dir ? 63 - 32 * half : 32 * half; const long pstep = dir ? -3072 : 3072;
            const bf16_t* pp = P + (size_t)(rb * 64 + i0) * 3072 + col;
#pragma unroll
            for (int n = 0; n < 32; ++n) { const int ip = 32 * half + n; const float bcv = bc[n] + off;
                const float qv = bf2f(pp[0]), kv = bf2f(pp[512]); pp += pstep;
                Qm[ip * 136 + dk] = f2bf(qv * 0.08838834764831845f * __expf(bcv - last));
                Km[ip * 136 + dk] = f2bf(kv * __expf(last - bcv)); }
        }
        __syncthreads();
        {
            const int ti = w >> 1, tj = w & 1;
            f32x16 acc;
#pragma unroll
            for (int x = 0; x < 16; ++x) acc[x] = 0.f;
            if (!(ti == 0 && tj == 1)) {
#pragma unroll
                for (int ks = 0; ks < 8; ++ks) acc = MFMA32(frag_nat(Qm, 136, 32 * ti + r, ks, h), frag_nat(Km, 136, 32 * tj + r, ks, h), acc);
            }
            const int j = 32 * tj + r;
#pragma unroll
            for (int x = 0; x < 16; ++x) { const int i = 32 * ti + crow(x, h); Ab[i * 72 + j] = f2bf(i >= j ? acc[x] : 0.f); }
            const int r0 = t >> 4, c8 = 8 * (t & 15);
#pragma unroll
            for (int v = 0; v < 4; ++v) { const int row = r0 + 16 * v; const size_t go = ((size_t)dir * MROWS + rb * 64 + row) * 512 + head * 128 + c8;
                *(u32x4*)(QM + go) = *(const LAS u32x4*)(Qm + row * 136 + c8); *(u32x4*)(KM + go) = *(const LAS u32x4*)(Km + row * 136 + c8); }
        }
        __syncthreads();
        {
            bf16_t* dst = AQ + (size_t)it * 4096;
#pragma unroll
            for (int k2 = 0; k2 < 2; ++k2) { const int c = t + 256 * k2, row = c >> 3, cc = c & 7; *(u32x4*)(dst + c * 8) = *(const LAS u32x4*)(Ab + row * 72 + 8 * cc); }
        }
        __syncthreads();
    }
}
constexpr int GL_QM = 0, GL_KM = 17408, GL_VB = 34816, GL_AB = 52224, GL_EL = 61440, GL_DIR = 61952;
struct GlPre { u32x4 q4[4], k4[4], v4[4], a0, a1; float elv; };
__device__ __forceinline__ void gl_prefetch(GlPre& p, const bf16_t* P, const bf16_t* QM, const bf16_t* KM, const bf16_t* AQ, const float* EL, int rb, int dir, int head, int hf, int t) {
    const int r0 = t >> 4, c8 = 8 * (t & 15);
    const bf16_t* aq = AQ + (size_t)((rb * 4 + head) * 2 + dir) * 4096;
#pragma unroll
    for (int v = 0; v < 4; ++v) { const size_t row = (size_t)(rb * 64 + r0 + 16 * v);
        p.q4[v] = *(const u32x4*)(QM + ((size_t)dir * MROWS + row) * 512 + head * 128 + c8);
        p.k4[v] = *(const u32x4*)(KM + ((size_t)dir * MROWS + row) * 512 + head * 128 + c8);
        p.v4[v] = *(const u32x4*)(P + row * 3072 + 1024 + head * 256 + hf * 128 + c8); }
    p.a0 = *(const u32x4*)(aq + t * 8); p.a1 = *(const u32x4*)(aq + (256 + t) * 8);
    p.elv = EL[(size_t)(dir * 520 + rb) * 512 + head * 128 + (t & 127)];
}
__device__ __forceinline__ void gla_scan(LAS unsigned char* lds, const bf16_t* P  , const bf16_t* QM, const bf16_t* KM, const bf16_t* AQ, const float* EL, bf16_t* OB  ) {
    const int tid = opaque_tid(), dir = __builtin_amdgcn_readfirstlane(tid >> 8);
    for (int unit = blockIdx.x; unit < 16; unit += gridDim.x) {
        const int b = unit >> 3, head = (unit >> 1) & 3, hf = unit & 1;
        f32x16 S[4];
#pragma unroll
        for (int kt = 0; kt < 4; ++kt)
#pragma unroll
            for (int x = 0; x < 16; ++x) S[kt][x] = 0.f;
        GlPre pre;
        { int rb0; bool f0; dn_step_rb(0, dir, b, rb0, f0); gl_prefetch(pre, P, QM, KM, AQ, EL, rb0, dir, head, hf, tid & 255); }
        __syncthreads();
        for (int step = 0; step < 260; ++step) {
            const int w = __builtin_amdgcn_readfirstlane((opaque_tid() >> 6) & 3);
            LAS unsigned char* base = lds + dir * GL_DIR;
            LAS bf16_t* Qm = (LAS bf16_t*)(base + GL_QM); LAS bf16_t* Km = (LAS bf16_t*)(base + GL_KM); LAS bf16_t* Vb = (LAS bf16_t*)(base + GL_VB); LAS bf16_t* Ab = (LAS bf16_t*)(base + GL_AB);
            LAS float* el = (LAS float*)(base + GL_EL);
            int rb; bool first; dn_step_rb(step, dir, b, rb, first);
            const int row_base = rb * 64;
            {
                const int tq_ = opaque_tid(), t = tq_ & 255;
                const int r0 = t >> 4, c8 = 8 * (t & 15);
#pragma unroll
                for (int v = 0; v < 4; ++v) { const int i = r0 + 16 * v, ip = dir ? 63 - i : i;
                    *(LAS u32x4*)(Qm + i * 136 + c8) = pre.q4[v]; *(LAS u32x4*)(Km + i * 136 + c8) = pre.k4[v]; *(LAS u32x4*)(Vb + ip * 136 + c8) = pre.v4[v]; }
                { const int c = t, row = c >> 3, cc = c & 7; *(LAS u32x4*)(Ab + row * 72 + 8 * cc) = pre.a0; }
                { const int c = 256 + t, row = c >> 3, cc = c & 7; *(LAS u32x4*)(Ab + row * 72 + 8 * cc) = pre.a1; }
                if (t < 128) el[t] = __expf(pre.elv);
            }
            BAR_LDS();
            if (step + 1 < 260) { int rbn; bool fn; dn_step_rb(step + 1, dir, b, rbn, fn); gl_prefetch(pre, P, QM, KM, AQ, EL, rbn, dir, head, hf, opaque_tid() & 255); }
            __builtin_amdgcn_sched_barrier(0);
            {
                const int tq_ = opaque_tid(), lane = tq_ & 63, r = lane & 31, h = lane >> 5;
#pragma unroll
                for (int kt = 0; kt < 4; ++kt)
#pragma unroll
                    for (int x = 0; x < 16; ++x) S[kt][x] *= el[32 * kt + crow(x, h)];
                bf16x8 Vf[4];
#pragma unroll
                for (int ks = 0; ks < 4; ++ks) Vf[ks] = frag_tr(Vb, 136, 32 * w, ks, lane);
                u32x4 eo[4];
                {
                    const int rr_ = lane >> 2, c8_ = 8 * (lane & 3);
                    if (!first) {
#pragma unroll
                        for (int v = 0; v < 4; ++v) { const int ip_ = rr_ + 16 * v, i_ = dir ? 63 - ip_ : ip_;
                            eo[v] = *(const u32x4*)(OB + (size_t)(row_base + i_) * 1024 + head * 256 + hf * 128 + 32 * w + c8_); }
                    } else {
                        unsigned z0 = 0u; asm volatile("" : "+v"(z0));
#pragma unroll
                        for (int v = 0; v < 4; ++v) eo[v] = (u32x4){z0, z0, z0, z0};
                    }
                }
                f32x16 O[2];
#pragma unroll
                for (int mt = 0; mt < 2; ++mt) {
#pragma unroll
                    for (int x = 0; x < 16; ++x) O[mt][x] = 0.f;
#pragma unroll
                    for (int ks = 0; ks < 4; ++ks) if (ks < 2 * mt + 2) O[mt] = MFMA32(frag_perm(Ab, 72, 32 * mt + r, ks, h), Vf[ks], O[mt]);
                }
                __builtin_amdgcn_sched_barrier(0);
#pragma unroll
                for (int ks = 0; ks < 8; ++ks) {
                    const bf16x8 sp = pack_step(S[ks >> 1], ks & 1);
#pragma unroll
                    for (int mt = 0; mt < 2; ++mt) O[mt] = MFMA32(frag_perm(Qm, 136, 32 * mt + r, ks, h), sp, O[mt]);
                    if (ks & 1) __builtin_amdgcn_sched_barrier(0);
                }
#pragma unroll
                for (int mt = 0; mt < 2; ++mt)
#pragma unroll
                    for (int x = 0; x < 16; ++x) Vb[(32 * mt + crow(x, h)) * 136 + 32 * w + r] = f2bf(O[mt][x]);
                __builtin_amdgcn_sched_barrier(0);
#pragma unroll
                for (int ks = 0; ks < 4; ++ks) {
#pragma unroll
                    for (int kt = 0; kt < 4; ++kt) S[kt] = MFMA32(frag_tr(Km, 136, 32 * kt, ks, lane), Vf[ks], S[kt]);
                    __builtin_amdgcn_sched_barrier(0);
                }
                {
                    const int rr_ = lane >> 2, c8_ = 8 * (lane & 3);
#pragma unroll
                    for (int v = 0; v < 4; ++v) { const int ip_ = rr_ + 16 * v, i_ = dir ? 63 - ip_ : ip_;
                        u32x4* gp_ = (u32x4*)(OB + (size_t)(row_base + i_) * 1024 + head * 256 + hf * 128 + 32 * w + c8_);
                        u32x4 o = *(const LAS u32x4*)(Vb + ip_ * 136 + 32 * w + c8_); const u32x4 e = eo[v];
                        if (!first) {
                            o.x = cvtpk_s(bf_lo(o.x) + bf_lo(e.x), bf_hi(o.x) + bf_hi(e.x)); o.y = cvtpk_s(bf_lo(o.y) + bf_lo(e.y), bf_hi(o.y) + bf_hi(e.y));
                            o.z = cvtpk_s(bf_lo(o.z) + bf_lo(e.z), bf_hi(o.z) + bf_hi(e.z)); o.w = cvtpk_s(bf_lo(o.w) + bf_lo(e.w), bf_hi(o.w) + bf_hi(e.w)); }
                        gp_[0] = o; }
                }
            }
            if (step == 1 || step == 131) asm volatile("s_waitcnt vmcnt(0)" ::: "memory");
            BAR_LDS();
        }
    }
}
typedef __bf16 v2bf_t __attribute__((ext_vector_type(2)));
__device__ __forceinline__ void atomic_add_bf16x8(bf16_t* p, const u32x4 v) {
    asm volatile("global_atomic_pk_add_bf16 %0, %1, off sc1\n\tglobal_atomic_pk_add_bf16 %0, %2, off offset:4 sc1\n\tglobal_atomic_pk_add_bf16 %0, %3, off offset:8 sc1\n\tglobal_atomic_pk_add_bf16 %0, %4, off offset:12 sc1"
                 :: "v"(p), "v"(v.x), "v"(v.y), "v"(v.z), "v"(v.w) : "memory");
}
constexpr int DN3_HGC = 2 * DN_DIR;
template <int VAR> __device__ __forceinline__ void dn_scan3(LAS unsigned char* lds, const bf16_t* P, const float* AB, const bf16_t* TP, bf16_t* OB) {
    const int tid0 = opaque_tid(), wv = __builtin_amdgcn_readfirstlane(tid0 >> 6), role = wv >> 2, w = wv & 3;
    for (int unit = blockIdx.x; unit < 64; unit += gridDim.x) {
        const int b = unit >> 5, vh = (unit >> 1) & 15, dir = unit & 1, kh = vh >> 1;
        __syncthreads();
        if (role == 1) {
            if (w < 3) {
                const int qh = w >= 1 ? 1 : 0, khh = w == 2 ? 1 : 0, ti = qh, tj = khh;
                u32x4 q8[8], k8[8]; float gcp;
                {
                    int rb; bool f_; dn_step_rb(0, dir, b, rb, f_);
                    const int lane = opaque_tid() & 63, r0 = lane >> 4, c8 = 8 * (lane & 15);
#pragma unroll
                    for (int v = 0; v < 8; ++v) { const int ipq = 32 * qh + r0 + 4 * v, ipk = 32 * khh + r0 + 4 * v, iq = dir ? 63 - ipq : ipq, ik = dir ? 63 - ipk : ipk;
                        q8[v] = *(const u32x4*)(P + (size_t)(rb * 64 + iq) * 4096 + kh * 128 + c8); k8[v] = *(const u32x4*)(P + (size_t)(rb * 64 + ik) * 4096 + 1024 + kh * 128 + c8); }
                    const int tl = dir ? 63 - lane : lane; gcp = AB[(size_t)(rb * 64 + tl) * 64 + dir * 16 + vh];
                }
                for (int j = 0; j < 260; ++j) {
                    const int lane = opaque_tid() & 63, r = lane & 31, h = lane >> 5, r0 = lane >> 4, c8 = 8 * (lane & 15);
                    LAS unsigned char* base = lds + (j & 1) * DN_DIR;
                    LAS bf16_t* Kb = (LAS bf16_t*)(base + DN_KB); LAS bf16_t* Qb = (LAS bf16_t*)(base + DN_QB); LAS bf16_t* Ab = (LAS bf16_t*)(base + DN_AB);
                    LAS float* hgc = (LAS float*)(lds + DN3_HGC + w * 256);
#pragma unroll
                    for (int v = 0; v < 8; ++v) { *(LAS u32x4*)(Qb + (32 * qh + r0 + 4 * v) * 136 + c8) = q8[v]; *(LAS u32x4*)(Kb + (32 * khh + r0 + 4 * v) * 136 + c8) = k8[v]; }
                    hgc[lane] = gcp;
                    asm volatile("s_waitcnt lgkmcnt(0)" ::: "memory");
                    if (j + 1 < 260) {
                        int rb; bool f_; dn_step_rb(j + 1, dir, b, rb, f_);
#pragma unroll
                        for (int v = 0; v < 8; ++v) { const int ipq = 32 * qh + r0 + 4 * v, ipk = 32 * khh + r0 + 4 * v, iq = dir ? 63 - ipq : ipq, ik = dir ? 63 - ipk : ipk;
                            q8[v] = *(const u32x4*)(P + (size_t)(rb * 64 + iq) * 4096 + kh * 128 + c8); k8[v] = *(const u32x4*)(P + (size_t)(rb * 64 + ik) * 4096 + 1024 + kh * 128 + c8); }
                        const int tl = dir ? 63 - lane : lane; gcp = AB[(size_t)(rb * 64 + tl) * 64 + dir * 16 + vh];
                    }
                    __builtin_amdgcn_sched_barrier(0);
                    {
                        f32x16 qk;
#pragma unroll
                        for (int x = 0; x < 16; ++x) qk[x] = 0.f;
#pragma unroll
                        for (int ks = 0; ks < 8; ++ks) qk = MFMA32(frag_nat(Qb, 136, 32 * ti + r, ks, h), frag_nat(Kb, 136, 32 * tj + r, ks, h), qk);
                        const int jj = 32 * tj + r; const float gj = hgc[jj];
#pragma unroll
                        for (int x = 0; x < 16; ++x) { const int i = 32 * ti + crow(x, h);
                            Ab[i * 72 + jj] = f2bf((i >= jj) ? qk[x] * __expf(hgc[i] - gj) : 0.f); }
                    }
                    BAR_LDS();
                }
                BAR_LDS();
            } else {
                u32x4 v16[16], t6[6]; float gcp, betap;
                {
                    int rb; bool f_; dn_step_rb(0, dir, b, rb, f_);
                    const int lane = opaque_tid() & 63, r0 = lane >> 4, c8 = 8 * (lane & 15);
#pragma unroll
                    for (int v = 0; v < 16; ++v) { const int ip = r0 + 4 * v, i = dir ? 63 - ip : ip; v16[v] = *(const u32x4*)(P + (size_t)(rb * 64 + i) * 4096 + 2048 + vh * 128 + c8); }
                    const bf16_t* tp = TP + (size_t)((rb * 16 + vh) * 2 + dir) * 3072;
#pragma unroll
                    for (int v = 0; v < 6; ++v) t6[v] = *(const u32x4*)(tp + (lane + 64 * v) * 8);
                    const int tl = dir ? 63 - lane : lane; const float* ab = AB + (size_t)(rb * 64 + tl) * 64; gcp = ab[dir * 16 + vh]; betap = ab[32 + dir * 16 + vh];
                }
                for (int j = 0; j < 260; ++j) {
                    const int lane = opaque_tid() & 63, r0 = lane >> 4, c8 = 8 * (lane & 15);
                    LAS unsigned char* base = lds + (j & 1) * DN_DIR;
                    LAS bf16_t* Vb = (LAS bf16_t*)(base + DN_VB); LAS bf16_t* Tb = (LAS bf16_t*)(base + DN_TB);
                    LAS float* sc_beta = (LAS float*)(base + DN_SC); LAS float* sc_gc = sc_beta + 64; LAS float* sc_eg = sc_beta + 128; LAS float* sc_tail = sc_beta + 192; LAS float* sc_dl = sc_beta + 256;
#pragma unroll
                    for (int v = 0; v < 16; ++v) *(LAS u32x4*)(Vb + (r0 + 4 * v) * 128 + c8) = v16[v];
#pragma unroll
                    for (int v = 0; v < 6; ++v) { const int c = lane + 64 * v, blk = c >> 7, rowc = (c & 127) >> 2, cc = c & 3, br = blk ? 1 : 0, bc = blk == 2 ? 1 : 0;
                        *(LAS u32x4*)(Tb + (32 * br + rowc) * 72 + 32 * bc + 8 * cc) = t6[v]; }
                    { const float gc = gcp, gl = __shfl(gc, 63); sc_beta[lane] = betap; sc_gc[lane] = gc; sc_eg[lane] = __expf(gc); sc_tail[lane] = __expf(gl - gc); if (lane == 0) sc_dl[0] = __expf(gl); }
                    if (j + 1 < 260) {
                        int rb; bool f_; dn_step_rb(j + 1, dir, b, rb, f_);
#pragma unroll
                        for (int v = 0; v < 16; ++v) { const int ip = r0 + 4 * v, i = dir ? 63 - ip : ip; v16[v] = *(const u32x4*)(P + (size_t)(rb * 64 + i) * 4096 + 2048 + vh * 128 + c8); }
                        const bf16_t* tp = TP + (size_t)((rb * 16 + vh) * 2 + dir) * 3072;
#pragma unroll
                        for (int v = 0; v < 6; ++v) t6[v] = *(const u32x4*)(tp + (lane + 64 * v) * 8);
                        const int tl = dir ? 63 - lane : lane; const float* ab = AB + (size_t)(rb * 64 + tl) * 64; gcp = ab[dir * 16 + vh]; betap = ab[32 + dir * 16 + vh];
                    }
                    BAR_LDS();
                }
                BAR_LDS();
            }
        } else {
            f32x16 S[4];
#pragma unroll
            for (int kt = 0; kt < 4; ++kt)
#pragma unroll
                for (int x = 0; x < 16; ++x) S[kt][x] = 0.f;
            BAR_LDS();
            for (int step = 0; step < 260; ++step) {
                const int lane = opaque_tid() & 63, r = lane & 31, h = lane >> 5;
                LAS unsigned char* base = lds + (step & 1) * DN_DIR;
                LAS bf16_t* Kb = (LAS bf16_t*)(base + DN_KB); LAS bf16_t* Qb = (LAS bf16_t*)(base + DN_QB); LAS bf16_t* Vb = (LAS bf16_t*)(base + DN_VB);
                LAS bf16_t* Tb = (LAS bf16_t*)(base + DN_TB); LAS bf16_t* Ab = (LAS bf16_t*)(base + DN_AB);
                LAS float* sc_beta = (LAS float*)(base + DN_SC); LAS float* sc_eg = sc_beta + 128; LAS float* sc_tail = sc_beta + 192; LAS float* sc_dl = sc_beta + 256;
                int rb; bool f_; dn_step_rb(step, dir, b, rb, f_);
                if (VAR != 2) {
                f32x16 KS[2], QS[2];
#pragma unroll
                for (int mt = 0; mt < 2; ++mt)
#pragma unroll
                    for (int x = 0; x < 16; ++x) { KS[mt][x] = 0.f; QS[mt][x] = 0.f; }
#pragma unroll
                for (int ks = 0; ks < 8; ++ks) {
                    const bf16x8 sp = pack_step(S[ks >> 1], ks & 1);
#pragma unroll
                    for (int mt = 0; mt < 2; ++mt) { KS[mt] = MFMA32(frag_perm(Kb, 136, 32 * mt + r, ks, h), sp, KS[mt]); QS[mt] = MFMA32(frag_perm(Qb, 136, 32 * mt + r, ks, h), sp, QS[mt]); }
                    if (ks & 1) __builtin_amdgcn_sched_barrier(0);
                }
#pragma unroll
                for (int mt = 0; mt < 2; ++mt)
#pragma unroll
                    for (int x = 0; x < 16; ++x) { const int i = 32 * mt + crow(x, h);
                        KS[mt][x] = sc_beta[i] * (bf2f(Vb[i * 128 + 32 * w + r]) - sc_eg[i] * KS[mt][x]); }
                __builtin_amdgcn_sched_barrier(0);
                bf16x8 Xp[4];
#pragma unroll
                for (int ks = 0; ks < 4; ++ks) Xp[ks] = pack_step(KS[ks >> 1], ks & 1);
                f32x16 VN[2];
#pragma unroll
                for (int mt = 0; mt < 2; ++mt) {
#pragma unroll
                    for (int x = 0; x < 16; ++x) VN[mt][x] = 0.f;
#pragma unroll
                    for (int ks = 0; ks < 4; ++ks) if (ks < 2 * mt + 2) VN[mt] = MFMA32(frag_perm(Tb, 72, 32 * mt + r, ks, h), Xp[ks], VN[mt]);
                }
                __builtin_amdgcn_sched_barrier(0);
                bf16x8 VNp[4];
#pragma unroll
                for (int ks = 0; ks < 4; ++ks) VNp[ks] = pack_step(VN[ks >> 1], ks & 1);
#pragma unroll
                for (int mt = 0; mt < 2; ++mt) {
#pragma unroll
                    for (int x = 0; x < 16; ++x) QS[mt][x] *= sc_eg[32 * mt + crow(x, h)];
#pragma unroll
                    for (int ks = 0; ks < 4; ++ks) if (ks < 2 * mt + 2) QS[mt] = MFMA32(frag_perm(Ab, 72, 32 * mt + r, ks, h), VNp[ks], QS[mt]);
                }
                __builtin_amdgcn_sched_barrier(0);
#pragma unroll
                for (int mt = 0; mt < 2; ++mt)
#pragma unroll
                    for (int x = 0; x < 16; ++x) Vb[(32 * mt + crow(x, h)) * 128 + 32 * w + r] = f2bf(QS[mt][x]);
                __builtin_amdgcn_sched_barrier(0);
#pragma unroll
                for (int mt = 0; mt < 2; ++mt)
#pragma unroll
                    for (int x = 0; x < 16; ++x) VN[mt][x] *= sc_tail[32 * mt + crow(x, h)];
#pragma unroll
                for (int ks = 0; ks < 4; ++ks) VNp[ks] = pack_step(VN[ks >> 1], ks & 1);
                __builtin_amdgcn_sched_barrier(0);
                const float dl = sc_dl[0];
#pragma unroll
                for (int kt = 0; kt < 4; ++kt)
#pragma unroll
                    for (int x = 0; x < 16; ++x) S[kt][x] *= dl;
#pragma unroll
                for (int ks = 0; ks < 4; ++ks) {
#pragma unroll
                    for (int kt = 0; kt < 4; ++kt) S[kt] = MFMA32(frag_tr(Kb, 136, 32 * kt, ks, lane), VNp[ks], S[kt]);
                    __builtin_amdgcn_sched_barrier(0);
                }
                }
                asm volatile("s_waitcnt lgkmcnt(0)" ::: "memory");
                if (VAR == 0) {
                    const int rr_ = lane >> 2, c8_ = 8 * (lane & 3);
#pragma unroll
                    for (int v = 0; v < 4; ++v) { const int ip_ = rr_ + 16 * v, i_ = dir ? 63 - ip_ : ip_;
                        atomic_add_bf16x8(OB + (size_t)(rb * 64 + i_) * 2048 + vh * 128 + 32 * w + c8_, *(const LAS u32x4*)(Vb + ip_ * 128 + 32 * w + c8_)); }
                }
                BAR_LDS();
            }
        }
    }
}
__device__ __forceinline__ void gla_scan3(LAS unsigned char* lds, bf16_t* P  , const bf16_t* QM, const bf16_t* KM, const bf16_t* AQ, const float* EL, bf16_t* OB  ) {
    const int tid0 = opaque_tid(), wv = __builtin_amdgcn_readfirstlane(tid0 >> 6), role = wv >> 2, w = wv & 3;
    for (int unit = blockIdx.x; unit < 32; unit += gridDim.x) {
        const int b = unit >> 4, head = (unit >> 2) & 3, hf = (unit >> 1) & 1, dir = unit & 1;
        __syncthreads();
        if (role == 1) {
            GlPre pre;
            { int rb0; bool f0; dn_step_rb(0, dir, b, rb0, f0); gl_prefetch(pre, P, QM, KM, AQ, EL, rb0, dir, head, hf, opaque_tid() & 255); }
            for (int j = 0; j < 260; ++j) {
                const int t = opaque_tid() & 255;
                LAS unsigned char* base = lds + (j & 1) * GL_DIR;
                LAS bf16_t* Qm = (LAS bf16_t*)(base + GL_QM); LAS bf16_t* Km = (LAS bf16_t*)(base + GL_KM); LAS bf16_t* Vb = (LAS bf16_t*)(base + GL_VB); LAS bf16_t* Ab = (LAS bf16_t*)(base + GL_AB);
                LAS float* el = (LAS float*)(base + GL_EL);
                const int r0 = t >> 4, c8 = 8 * (t & 15);
#pragma unroll
                for (int v = 0; v < 4; ++v) { const int i = r0 + 16 * v, ip = dir ? 63 - i : i;
                    *(LAS u32x4*)(Qm + i * 136 + c8) = pre.q4[v]; *(LAS u32x4*)(Km + i * 136 + c8) = pre.k4[v]; *(LAS u32x4*)(Vb + ip * 136 + c8) = pre.v4[v]; }
                { const int c = t, row = c >> 3, cc = c & 7; *(LAS u32x4*)(Ab + row * 72 + 8 * cc) = pre.a0; }
                { const int c = 256 + t, row = c >> 3, cc = c & 7; *(LAS u32x4*)(Ab + row * 72 + 8 * cc) = pre.a1; }
                if (t < 128) el[t] = __expf(pre.elv);
                if (j + 1 < 260) { int rbn; bool fn; dn_step_rb(j + 1, dir, b, rbn, fn); gl_prefetch(pre, P, QM, KM, AQ, EL, rbn, dir, head, hf, t); }
                BAR_LDS();
            }
            BAR_LDS();
        } else {
            f32x16 S[4];
#pragma unroll
            for (int kt = 0; kt < 4; ++kt)
#pragma unroll
                for (int x = 0; x < 16; ++x) S[kt][x] = 0.f;
            BAR_LDS();
            for (int step = 0; step < 260; ++step) {
                const int lane = opaque_tid() & 63, r = lane & 31, h = lane >> 5;
                LAS unsigned char* base = lds + (step & 1) * GL_DIR;
                LAS bf16_t* Qm = (LAS bf16_t*)(base + GL_QM); LAS bf16_t* Km = (LAS bf16_t*)(base + GL_KM); LAS bf16_t* Vb = (LAS bf16_t*)(base + GL_VB); LAS bf16_t* Ab = (LAS bf16_t*)(base + GL_AB);
                LAS float* el = (LAS float*)(base + GL_EL);
                int rb; bool f_; dn_step_rb(step, dir, b, rb, f_);
#pragma unroll
                for (int kt = 0; kt < 4; ++kt)
#pragma unroll
                    for (int x = 0; x < 16; ++x) S[kt][x] *= el[32 * kt + crow(x, h)];
                bf16x8 Vf[4];
#pragma unroll
                for (int ks = 0; ks < 4; ++ks) Vf[ks] = frag_tr(Vb, 136, 32 * w, ks, lane);
                f32x16 O[2];
#pragma unroll
                for (int mt = 0; mt < 2; ++mt) {
#pragma unroll
                    for (int x = 0; x < 16; ++x) O[mt][x] = 0.f;
#pragma unroll
                    for (int ks = 0; ks < 4; ++ks) if (ks < 2 * mt + 2) O[mt] = MFMA32(frag_perm(Ab, 72, 32 * mt + r, ks, h), Vf[ks], O[mt]);
                }
                __builtin_amdgcn_sched_barrier(0);
#pragma unroll
                for (int ks = 0; ks < 8; ++ks) {
                    const bf16x8 sp = pack_step(S[ks >> 1], ks & 1);
#pragma unroll
                    for (int mt = 0; mt < 2; ++mt) O[mt] = MFMA32(frag_perm(Qm, 136, 32 * mt + r, ks, h), sp, O[mt]);
                    if (ks & 1) __builtin_amdgcn_sched_barrier(0);
                }
#pragma unroll
                for (int mt = 0; mt < 2; ++mt)
#pragma unroll
                    for (int x = 0; x < 16; ++x) Vb[(32 * mt + crow(x, h)) * 136 + 32 * w + r] = f2bf(O[mt][x]);
                __builtin_amdgcn_sched_barrier(0);
#pragma unroll
                for (int ks = 0; ks < 4; ++ks) {
#pragma unroll
                    for (int kt = 0; kt < 4; ++kt) S[kt] = MFMA32(frag_tr(Km, 136, 32 * kt, ks, lane), Vf[ks], S[kt]);
                    __builtin_amdgcn_sched_barrier(0);
                }
                asm volatile("s_waitcnt lgkmcnt(0)" ::: "memory");
                {
                    const int rr_ = lane >> 2, c8_ = 8 * (lane & 3);
#pragma unroll
                    for (int v = 0; v < 4; ++v) { const int ip_ = rr_ + 16 * v, i_ = dir ? 63 - ip_ : ip_; const int oc_ = head * 256 + hf * 128 + 32 * w + c8_;
                        bf16_t* dst_ = dir ? P + (size_t)(rb * 64 + i_) * 3072 + oc_ : OB + (size_t)(rb * 64 + i_) * 1024 + oc_;
                        *(u32x4*)dst_ = *(const LAS u32x4*)(Vb + ip_ * 136 + 32 * w + c8_); }
                }
                BAR_LDS();
            }
        }
    }
}
#define DUP_DN 0
#define DN_VARIANT 0
#define DN_VAR_PARITY0 0
#define DUP_GLA 0
#define DUP_ATT 0
#define DUP_GIN 0
#define DUP_FFN1 0
constexpr unsigned long long pack_ops(const int* ops, int n) { unsigned long long v = 0; for (int i = 0; i < n; ++i) v |= (unsigned long long)ops[i] << (5 * i); return v; }
struct OpList { unsigned long long code; int n; };
constexpr OpList make_list(int mix) {
    int ops[16] = {}; int n = 0;
    ops[n++] = OP_PREP; ops[n++] = OP_GEMM_IN; if (DUP_GIN && mix != 0) ops[n++] = OP_GEMM_IN;
    if (mix == 0) { ops[n++] = OP_DNHALO; ops[n++] = OP_DNCONV; ops[n++] = OP_DNT; ops[n++] = OP_DNSCAN; if (DUP_DN) ops[n++] = OP_DNSCAN; ops[n++] = OP_DNREDO; ops[n++] = OP_GEMM_Z; }
    else if (mix == 1) { ops[n++] = OP_GLAPREP; ops[n++] = OP_GLASCAN; ops[n++] = OP_GLAGATE; }
    else { ops[n++] = OP_QKROPE; ops[n++] = OP_ATTN; if (DUP_ATT) ops[n++] = OP_ATTN; }
    ops[n++] = OP_GEMM_OUT; ops[n++] = OP_NORM2; ops[n++] = OP_FFN1; if (DUP_FFN1 && mix != 0) ops[n++] = OP_FFN1; ops[n++] = OP_FFN2;
    return OpList{pack_ops(ops, n), n};
}
constexpr OpList L_DN = make_list(0), L_GL = make_list(1), L_AT = make_list(2);
constexpr int NPHASE = 1 + 2 * L_DN.n + L_GL.n + L_AT.n;
__device__ __forceinline__ void decode_phase(int ph, int& layer, int& op) {
    if (ph == 0) { layer = 0; op = OP_MOD; return; }
    int p = ph - 1;
    if (p < L_DN.n) { layer = 0; op = (int)((L_DN.code >> (5 * p)) & 31ull); return; } p -= L_DN.n;
    if (p < L_GL.n) { layer = 1; op = (int)((L_GL.code >> (5 * p)) & 31ull); return; } p -= L_GL.n;
    if (p < L_AT.n) { layer = 2; op = (int)((L_AT.code >> (5 * p)) & 31ull); return; } p -= L_AT.n;
    layer = 3; op = (int)((L_DN.code >> (5 * p)) & 31ull);
}

__global__ void __launch_bounds__(512, 2) mega(Args args) {
    extern __shared__ __attribute__((aligned(16))) unsigned char lds_raw[];
    LAS unsigned char* lds = (LAS unsigned char*)lds_raw;
    cg::grid_group grid = cg::this_grid();
    const int G = gridDim.x, NGW = G * 8;
    unsigned char* ws = args.ws;
    const float* x_in = args.in[0]; const float* c_in = args.in[1]; const float* ctx_in = args.in[2]; const float* cctx_in = args.in[3];
    const float* ada_w = args.in[4]; const float* ada_b = args.in[5]; const float* norm_mix_g = args.in[6]; const float* norm_ffn_g = args.in[7];
    const float* ffn_w1 = args.in[8]; const float* ffn_w2 = args.in[9];
    float* MOD = (float*)(ws + WS_MOD); float* CTXC = (float*)(ws + WS_CTX); bf16_t* H = (bf16_t*)(ws + WS_H); float* ABF = (float*)(ws + WS_AB); float* RSTD = (float*)(ws + WS_RSTD);
    bf16_t* PB = (bf16_t*)(ws + WS_P); float* out = args.out;

    for (int ph = args.ph_lo; ph < args.ph_hi; ++ph) {
        int layer, op; decode_phase(ph, layer, op);
        const int mix = layer % 3, slot = layer / 3;
        const float* modl = MOD + (size_t)layer * 3 * 6144;
        const float* xl = layer == 0 ? x_in : out; const float* xc = layer == 0 ? ctx_in : CTXC;
        if (op == OP_MOD) {
            const int tid = opaque_tid(), lane = tid & 63, wave = __builtin_amdgcn_readfirstlane(tid >> 6); const int gw = blockIdx.x * 8 + wave; (void)lane; (void)gw; (void)tid;
            LAS float* sl = (LAS float*)lds; LAS float* red = sl + 3 * 1024;
            for (int e = tid; e < 3 * 1024; e += 512) { const float v = e < 2048 ? c_in[e] : cctx_in[e - 2048]; sl[e] = silu_f(v); }
            __syncthreads();
            for (int item = blockIdx.x; item < 4 * 96; item += G) {
                const int ly = item / 96, col = (item % 96) * 64 + lane;
                const float* wp = ada_w + ((size_t)ly * 1024 + 128 * wave) * 6144 + col;
                float a0 = 0.f, a1 = 0.f, a2 = 0.f;
#pragma unroll 8
                for (int k = 0; k < 128; ++k) { const float wv = wp[(size_t)k * 6144]; const int kk = 128 * wave + k; a0 += sl[kk] * wv; a1 += sl[1024 + kk] * wv; a2 += sl[2048 + kk] * wv; }
                red[(wave * 3 + 0) * 64 + lane] = a0; red[(wave * 3 + 1) * 64 + lane] = a1; red[(wave * 3 + 2) * 64 + lane] = a2;
                __syncthreads();
                if (tid < 192) { const int m = tid >> 6; float s = ada_b[(size_t)ly * 6144 + col];
#pragma unroll
                    for (int w2 = 0; w2 < 8; ++w2) s += red[(w2 * 3 + m) * 64 + lane];
                    MOD[((size_t)ly * 3 + m) * 6144 + col] = s; }
                __syncthreads();
            }
        } else if (op == OP_PREP) {
            const int tid = opaque_tid(), lane = tid & 63, wave = __builtin_amdgcn_readfirstlane(tid >> 6); const int gw = blockIdx.x * 8 + wave; (void)lane; (void)gw; (void)tid;
            LAS float* scr = (LAS float*)(lds + wave * 16384);
            unsigned z0 = 0u; asm volatile("" : "+v"(z0)); const u32x4 zv = (u32x4){z0, z0, z0, z0};
            bf16_t* wtA = (bf16_t*)(ws + WT_A); bf16_t* wtZ = (bf16_t*)(ws + WT_Z); bf16_t* wtO = (bf16_t*)(ws + WT_O); bf16_t* wt1 = (bf16_t*)(ws + WT_1); bf16_t* wt2 = (bf16_t*)(ws + WT_2);
            if (mix == 0) {
                const float* w_in = args.in[10] + (size_t)slot * 1024 * 6208; const float* w_out = args.in[15] + (size_t)slot * 2048 * 1024;
                transpose_mat(w_in, 6208, 0, 4096, 1024, wtA, 0, scr, gw, NGW, lane);
                transpose_mat(w_in, 6208, 6144, 64, 1024, wtA, 4096, scr, gw, NGW, lane);
                for (size_t e = (size_t)blockIdx.x * 512 + tid; e < (size_t)192 * 1024 * 2 / 16; e += (size_t)G * 512) ((u32x4*)(wtA + (size_t)4160 * 1024))[e] = zv;
            } else if (mix == 1) {
                const float* w_in = args.in[16]; const float* w_out = args.in[20];
                transpose_mat(w_in, 3104, 0, 3104, 1024, wtA, 0, scr, gw, NGW, lane);
                for (size_t e = (size_t)blockIdx.x * 512 + tid; e < (size_t)224 * 1024 * 2 / 16; e += (size_t)G * 512) ((u32x4*)(wtA + (size_t)3104 * 1024))[e] = zv;
                transpose_mat(w_out, 1024, 0, 1024, 1024, wtO, 0, scr, gw, NGW, lane);
            } else {
                const float* w_in = args.in[21]; const float* w_out = args.in[24];
                transpose_mat(w_in, 1536, 0, 1536, 1024, wtA, 0, scr, gw, NGW, lane);
                transpose_mat(w_out, 1024, 0, 1024, 1024, wtO, 0, scr, gw, NGW, lane);
            }
            if (mix != 0) {
                transpose_mat(ffn_w1 + (size_t)layer * 1024 * 4096, 4096, 0, 4096, 1024, wt1, 0, scr, gw, NGW, lane);
                transpose_mat(ffn_w2 + (size_t)layer * 4096 * 1024, 1024, 0, 1024, 4096, wt2, 0, scr, gw, NGW, lane);
            }
            normmod_rows(xl, xc, norm_mix_g + (size_t)layer * 1024, modl, 0, H, gw, NGW, lane);
        } else if (op == OP_DNREDO) {
            const int tid = opaque_tid(), lane = tid & 63, wave = __builtin_amdgcn_readfirstlane(tid >> 6); const int gw = blockIdx.x * 8 + wave; (void)lane; (void)gw; (void)tid;
            LAS float* scr = (LAS float*)(lds + wave * 16384);
            const float* w_in = args.in[10] + (size_t)slot * 1024 * 6208; const float* w_out = args.in[15] + (size_t)slot * 2048 * 1024;
            transpose_mat(w_in, 6208, 4096, 2048, 1024, (bf16_t*)(ws + WT_Z), 0, scr, gw, NGW, lane);
            transpose_mat(w_out, 1024, 0, 1024, 2048, (bf16_t*)(ws + WT_O), 0, scr, gw, NGW, lane);
            transpose_mat(ffn_w1 + (size_t)layer * 1024 * 4096, 4096, 0, 4096, 1024, (bf16_t*)(ws + WT_1), 0, scr, gw, NGW, lane);
            transpose_mat(ffn_w2 + (size_t)layer * 4096 * 1024, 1024, 0, 1024, 4096, (bf16_t*)(ws + WT_2), 0, scr, gw, NGW, lane);
            normmod_rows(xl, xc, norm_mix_g + (size_t)layer * 1024, modl, 0, H, gw, NGW, lane);
            const bf16_t* OB = (const bf16_t*)(ws + WS_O);
            for (int row = gw; row < MROWS; row += NGW) {
                const u32x4* p = (const u32x4*)(OB + (size_t)row * 2048 + 32 * lane); float ss = 0.f;
#pragma unroll
                for (int v = 0; v < 4; ++v) { const u32x4 q = p[v]; const float a0 = bf_lo(q.x), a1 = bf_hi(q.x), a2 = bf_lo(q.y), a3 = bf_hi(q.y), a4 = bf_lo(q.z), a5 = bf_hi(q.z), a6 = bf_lo(q.w), a7 = bf_hi(q.w);
                    ss += (a0 * a0 + a1 * a1) + (a2 * a2 + a3 * a3) + (a4 * a4 + a5 * a5) + (a6 * a6 + a7 * a7); }
                ss += __shfl_xor(ss, 1); ss += __shfl_xor(ss, 2);
                if ((lane & 3) == 0) RSTD[(size_t)row * 16 + (lane >> 2)] = rsqrtf(ss * (1.f / 128.f) + EPS);
            }
        } else if (op == OP_DNHALO) {
            dn_halo_phase(PB, (bf16_t*)(ws + WS_HALO), G);
        } else if (op == OP_DNCONV) {
            dn_conv_phase(PB, (const bf16_t*)(ws + WS_HALO), args.in[11] + (size_t)slot * 4096 * 5, G);
        } else if (op == OP_DNT) {
            dn_t_phase(lds, PB, ABF, (bf16_t*)(ws + WS_TP), args.in[12] + (size_t)slot * 32, args.in[13] + (size_t)slot * 32, G);
            {
                unsigned z0 = 0u; asm volatile("" : "+v"(z0)); const u32x4 zv = (u32x4){z0, z0, z0, z0}; u32x4* zp = (u32x4*)(ws + WS_O);
                for (size_t e = (size_t)blockIdx.x * 512 + opaque_tid(); e < (size_t)MROWS * 2048 * 2 / 16; e += (size_t)G * 512) zp[e] = zv;
            }
        } else if (op == OP_NORM2) {
            const int tid = opaque_tid(), lane = tid & 63, wave = __builtin_amdgcn_readfirstlane(tid >> 6); const int gw = blockIdx.x * 8 + wave; (void)lane; (void)gw; (void)tid;
            normmod_rows(out, CTXC, norm_ffn_g + (size_t)layer * 1024, modl, 3, H, gw, NGW, lane);
        } else if (op == OP_GEMM_IN || op == OP_GEMM_Z || op == OP_GEMM_OUT || op == OP_FFN1 || op == OP_FFN2) {
            pg8::Gemm g; pg8::Epi E;
            E.mode = 0; E.O = PB; E.ldc = 4096; E.tail_pn = -1; E.F = ABF; E.ldf = 64; E.nf = 64; E.rstd = RSTD; E.ng = args.in[14] + (size_t)slot * 128;
            E.src_lat = xl; E.src_ctx = xc; E.dst_lat = out; E.dst_ctx = CTXC; E.mod = modl; E.gidx = 2;
            g.M = (layer == 3 && op != OP_GEMM_IN) ? NLAT : MROWS; g.A = H; g.K = 1024;
            bf16_t* OBUF = (bf16_t*)(ws + (mix == 1 ? WS_OGLA : WS_O));
            if (op == OP_GEMM_IN) {
                g.Bt = (const bf16_t*)(ws + WT_A);
                if (mix == 0) { g.N = 4352; E.ldc = 4096; E.tail_pn = 16; E.ldf = 64; E.nf = 64; }
                else if (mix == 1) { g.N = 3328; E.ldc = 3072; E.tail_pn = 12; E.ldf = 32; E.nf = 32; }
                else { g.N = 1536; E.ldc = 1536; }
            } else if (op == OP_GEMM_Z) {
                g.Bt = (const bf16_t*)(ws + WT_Z); g.N = 2048; E.mode = 2; E.O = OBUF; E.ldc = 2048;
            } else if (op == OP_GEMM_OUT) {
                g.A = OBUF; g.K = mix == 0 ? 2048 : 1024; g.Bt = (const bf16_t*)(ws + WT_O); g.N = 1024; E.mode = 3; E.gidx = 2;
            } else if (op == OP_FFN1) {
                g.Bt = (const bf16_t*)(ws + WT_1); g.N = 4096; E.mode = 1; E.ldc = 4096;
            } else {
                g.A = PB; g.K = 4096; g.Bt = (const bf16_t*)(ws + WT_2); g.N = 1024; E.mode = 3; E.gidx = 5; E.src_lat = out; E.src_ctx = CTXC;
            }
            pg8::StaticOrder S; S.init(g.M, g.N, G, (int)blockIdx.x);
#ifndef NO_GEMM
            pg8::gemm_phase<pg8::Epi, pg8::StaticOrder, true, true>(lds, g, S, E);
#endif
        } else if (op == OP_DNSCAN) {
#ifndef NO_DN
            if (DN_VARIANT && (ph & 1) == 0) dn_scan3<DN_VARIANT>(lds, PB, ABF, (const bf16_t*)(ws + WS_TP), (bf16_t*)(ws + WS_O)); else dn_scan3<0>(lds, PB, ABF, (const bf16_t*)(ws + WS_TP), (bf16_t*)(ws + WS_O));
#endif
        } else if (op == OP_GLAPREP) {
            gla_prep_phase(lds, PB, ABF, args.in[17], args.in[18], (bf16_t*)(ws + WS_QM), (bf16_t*)(ws + WS_KM), (bf16_t*)(ws + WS_AQ), (float*)(ws + WS_EL), G);
        } else if (op == OP_GLASCAN) {
#ifndef NO_GLA
            gla_scan3(lds, PB, (const bf16_t*)(ws + WS_QM), (const bf16_t*)(ws + WS_KM), (const bf16_t*)(ws + WS_AQ), (const float*)(ws + WS_EL), (bf16_t*)(ws + WS_OGLA));
#endif
        } else if (op == OP_GLAGATE) {
            const int tid = opaque_tid(), lane = tid & 63, wave = __builtin_amdgcn_readfirstlane(tid >> 6); const int gw = blockIdx.x * 8 + wave; (void)lane; (void)gw; (void)tid;
            bf16_t* OB = (bf16_t*)(ws + WS_OGLA); const float* ng = args.in[19];
            for (int row = gw; row < MROWS; row += NGW) {
                u32x4* p = (u32x4*)(OB + (size_t)row * 1024 + 16 * lane); const u32x4* gp = (const u32x4*)(PB + (size_t)row * 3072 + 2048 + 16 * lane); const u32x4* pb2 = (const u32x4*)(PB + (size_t)row * 3072 + 16 * lane);
                float o[16], z[16]; float ss = 0.f;
#pragma unroll
                for (int v = 0; v < 2; ++v) { const u32x4 q = p[v], gq = gp[v], q2 = pb2[v];
                    o[8 * v + 0] = bf_lo(q.x) + bf_lo(q2.x); o[8 * v + 1] = bf_hi(q.x) + bf_hi(q2.x); o[8 * v + 2] = bf_lo(q.y) + bf_lo(q2.y); o[8 * v + 3] = bf_hi(q.y) + bf_hi(q2.y); o[8 * v + 4] = bf_lo(q.z) + bf_lo(q2.z); o[8 * v + 5] = bf_hi(q.z) + bf_hi(q2.z); o[8 * v + 6] = bf_lo(q.w) + bf_lo(q2.w); o[8 * v + 7] = bf_hi(q.w) + bf_hi(q2.w);
                    z[8 * v + 0] = bf_lo(gq.x); z[8 * v + 1] = bf_hi(gq.x); z[8 * v + 2] = bf_lo(gq.y); z[8 * v + 3] = bf_hi(gq.y); z[8 * v + 4] = bf_lo(gq.z); z[8 * v + 5] = bf_hi(gq.z); z[8 * v + 6] = bf_lo(gq.w); z[8 * v + 7] = bf_hi(gq.w); }
#pragma unroll
                for (int e = 0; e < 16; ++e) ss += o[e] * o[e];
                ss += __shfl_xor(ss, 1); ss += __shfl_xor(ss, 2); ss += __shfl_xor(ss, 4); ss += __shfl_xor(ss, 8);
                const float rs = rsqrtf(ss * (1.f / 256.f) + EPS); const int cb = (16 * lane) & 255;
#pragma unroll
                for (int v = 0; v < 2; ++v) { float rr[8];
#pragma unroll
                    for (int e = 0; e < 8; ++e) rr[e] = o[8 * v + e] * rs * ng[cb + 8 * v + e] * silu_f(z[8 * v + e]);
                    u32x4 wv; wv.x = cvtpk_s(rr[0], rr[1]); wv.y = cvtpk_s(rr[2], rr[3]); wv.z = cvtpk_s(rr[4], rr[5]); wv.w = cvtpk_s(rr[6], rr[7]); p[v] = wv; }
            }
        } else if (op == OP_QKROPE) {
            const int tid = opaque_tid(), lane = tid & 63, wave = __builtin_amdgcn_readfirstlane(tid >> 6); const int gw = blockIdx.x * 8 + wave; (void)lane; (void)gw; (void)tid;
            bf16_t* QR = (bf16_t*)(ws + WS_QR); bf16_t* KR = (bf16_t*)(ws + WS_KR); bf16_t* VR = (bf16_t*)(ws + WS_VR);
            const float* qg = args.in[22]; const float* kg = args.in[23];
            const int hf = lane >> 5, j = lane & 31, e1 = 64 * hf + j, e2 = e1 + 32;
            const float inv_freq = exp2f(-(float)(2 * j) * (1.f / 64.f) * 13.287712379549449f);
            const float gq1 = qg[e1], gq2 = qg[e2], gk1 = kg[e1], gk2 = kg[e2];
            for (int row = gw; row < MROWS; row += NGW) {
                const bool lat = row < NLAT; const int b = lat ? row / SEQ : (row - NLAT) / CTXL; const int tpos = lat ? row % SEQ : (row - NLAT) % CTXL;
                float cs = 1.f, sn = 0.f;
                if (lat) { const float pos = (float)(hf == 0 ? tpos / 64 : tpos % 64); const float ang = pos * inv_freq; sn = sinf(ang); cs = cosf(ang); }
                const bf16_t* pr = PB + (size_t)row * 1536; const int kpos = lat ? tpos : SEQ + tpos;
#pragma unroll
                for (int hd = 0; hd < 10; ++hd) {
                    const float x1 = bf2f(pr[hd * 128 + e1]), x2 = bf2f(pr[hd * 128 + e2]);
                    const float rinv = rsqrtf(wave_sum(x1 * x1 + x2 * x2) * (1.f / 128.f) + EPS);
                    const float y1 = x1 * rinv * (hd < 8 ? gq1 : gk1), y2 = x2 * rinv * (hd < 8 ? gq2 : gk2);
                    const float o1 = y1 * cs - y2 * sn, o2 = y1 * sn + y2 * cs;
                    bf16_t* dst = hd < 8 ? QR + (size_t)row * 1024 + hd * 128 : KR + ((size_t)(b * 2 + (hd - 8)) * SKV + kpos) * 128;
                    dst[e1] = f2bf(o1); dst[e2] = f2bf(o2);
                }
#pragma unroll
                for (int kv = 0; kv < 2; ++kv) { bf16_t* dst = VR + ((size_t)(b * 2 + kv) * SKV + kpos) * 128; dst[e1] = pr[1280 + kv * 128 + e1]; dst[e2] = pr[1280 + kv * 128 + e2]; }
            }
        } else if (op == OP_ATTN) {
            const attn::bf16* QR = (const attn::bf16*)(ws + WS_QR); const attn::bf16* KR = (const attn::bf16*)(ws + WS_KR); const attn::bf16* VR = (const attn::bf16*)(ws + WS_VR);
            attn::bf16* OB = (attn::bf16*)(ws + WS_O);
            for (int u = blockIdx.x; u < 1024 + 16; u += G) {
                size_t qoff, koff; int seq;
                if (u < 1024) { const int pair = u >> 8, b = pair >> 1, kvh = pair & 1, hh = (u >> 6) & 3, qb = u & 63, head = kvh * 4 + hh;
                    qoff = ((size_t)b * SEQ + (size_t)qb * 256) * 1024 + head * 128; koff = (size_t)(b * 2 + kvh) * SKV * 128; seq = SKV; }
                else { const int jx = u - 1024, b = jx >> 3, head = jx & 7, kvh = head >> 2;
                    qoff = ((size_t)NLAT + (size_t)b * CTXL) * 1024 + head * 128; koff = ((size_t)(b * 2 + kvh) * SKV + SEQ) * 128; seq = CTXL; }
                __syncthreads();
#ifndef NO_ATT
                attn::attn_dense_body<attn::bf16>(QR + qoff, KR + koff, VR + koff, OB + qoff, seq, (char*)lds_raw);
#endif
            }
        }
        if (ph + 1 < args.ph_hi) grid.sync();
    }
}

#ifndef MK_MULTI
#define MK_MULTI 0
#endif
extern "C" void kernel_launch(void* const* d_in, const int* in_sizes, int n_in, void* d_out, int out_size, void* d_ws, size_t ws_size, hipStream_t stream) {
    static int grid = 0;
    if (grid == 0) {
        if (n_in != 25 || ws_size < WS_END) { fprintf(stderr, "kernel_launch: unexpected n_in %d / ws_size %zu (need %zu)\n", n_in, ws_size, (size_t)WS_END); grid = -1; return; }
        int dev = 0, cus = 0, per_cu = 0;
        hipGetDevice(&dev); hipDeviceGetAttribute(&cus, hipDeviceAttributeMultiprocessorCount, dev);
        if (hipFuncSetAttribute((const void*)mega, hipFuncAttributeMaxDynamicSharedMemorySize, LDS_BYTES) != hipSuccess) { fprintf(stderr, "kernel_launch: hipFuncSetAttribute failed\n"); grid = -1; return; }
        if (hipOccupancyMaxActiveBlocksPerMultiprocessor(&per_cu, (const void*)mega, 512, LDS_BYTES) != hipSuccess || per_cu < 1) { fprintf(stderr, "kernel_launch: occupancy query says %d\n", per_cu); per_cu = 1; }
        (void)hipGetLastError();
        grid = cus * 1;
    }
    if (grid < 0) return;
    Args a{};
    for (int i = 0; i < 25; ++i) a.in[i] = (const float*)d_in[i];
    a.out = (float*)d_out; a.ws = (unsigned char*)d_ws;
#if MK_MULTI
    for (int ph = 0; ph < NPHASE; ++ph) { a.ph_lo = ph; a.ph_hi = ph + 1; hipLaunchKernelGGL(mega, dim3(grid), dim3(512), LDS_BYTES, stream, a); }
#else
    a.ph_lo = 0; a.ph_hi = NPHASE;
    void* kargs[] = {&a};
    hipError_t e = hipLaunchCooperativeKernel((const void*)mega, dim3(grid), dim3(512), kargs, LDS_BYTES, stream);
    if (e != hipSuccess) fprintf(stderr, "cooperative launch failed: %s (grid %d)\n", hipGetErrorString(e), grid);
#endif
}
```

```cpp
#include <hip/hip_runtime.h>
#include <hip/hip_bf16.h>
#include <hip/hip_cooperative_groups.h>
#include <cstdio>
#include <cstdint>
namespace cg = cooperative_groups;
__device__ __forceinline__ int opaque_tid() { int t = threadIdx.x; asm volatile("" : "+v"(t)); return t; }
namespace pg8 {
#define PG8_LAS __attribute__((address_space(3)))
typedef unsigned short bf16_t;
typedef short bf16x8 __attribute__((ext_vector_type(8)));
typedef float f32x4 __attribute__((ext_vector_type(4)));
typedef unsigned u32x4 __attribute__((ext_vector_type(4)));
constexpr int BM = 256, BK = 64, HALF = 128, HTB = HALF * BK * 2  , STAGE_BYTES = 8 * HTB, NXCD = 8, WGM = 8;

__host__ __device__ __forceinline__ int lds_byte(int r, int c) { const int st = (r >> 4) * 2 + (c >> 5), rr = r & 15, cc = c & 31, ob = rr * 64 + cc * 2; return st * 1024 + (ob ^ (((ob >> 9) & 1) << 5)); }
__host__ __device__ __forceinline__ void stage_rc(int b, int& R, int& C) { const int st = b / 1024, sb = b % 1024, swz = sb ^ (((sb >> 9) & 1) << 5); R = (st >> 1) * 16 + swz / 64; C = (st & 1) * 32 + (swz % 64) / 2; }
__host__ __device__ __forceinline__ int perm32(int rho) { const int n = rho >> 4, i = rho & 15; return 8 * (i >> 2) + 4 * n + (i & 3); }

struct Unit { int pm, pn; };
struct Gemm { const bf16_t* A; const bf16_t* Bt; int M, N, K; };

struct StaticOrder {
    int nM, nN, nwg, G, c;
    __host__ __device__ void init(int M, int N, int G_, int c_) { nM = M / BM; nN = N / BM; nwg = nM * nN; G = G_; c = c_; }
    __host__ __device__ bool next(int i, Unit& u) const {
        const long L = (long)i * G + c; if (L >= nwg) return false;
        int wgid = (int)L; { const int q = nwg / NXCD, r = nwg % NXCD, xcd = wgid % NXCD, off = wgid / NXCD; wgid = (xcd < r ? xcd * (q + 1) : r * (q + 1) + (xcd - r) * q) + off; }
        const int nig = WGM * nN, gid = wgid / nig, fm = gid * WGM, gsz = (nM - fm) < WGM ? (nM - fm) : WGM;
        u.pm = fm + ((wgid % nig) % gsz); u.pn = (wgid % nig) / gsz; return true;
    }
    __device__ __forceinline__ void a_ready(const Unit&) const {}
    __device__ __forceinline__ void done(const Unit&) const {}
};

__device__ __forceinline__ unsigned cvt_pk_bf16(float lo, float hi) { unsigned r; asm volatile("v_cvt_pk_bf16_f32 %0, %1, %2" : "=v"(r) : "v"(lo), "v"(hi)); return r; }
typedef float f32x2 __attribute__((ext_vector_type(2)));
typedef float f32x2_t __attribute__((ext_vector_type(2))); typedef __bf16 bf16x2_t __attribute__((ext_vector_type(2)));
__device__ __forceinline__ unsigned cvtpk_s(float lo, float hi) { f32x2_t v = {lo, hi}; bf16x2_t b = __builtin_convertvector(v, bf16x2_t); return __builtin_bit_cast(unsigned, b); }
__device__ __forceinline__ float bf_lo(unsigned w) { return __builtin_bit_cast(float, w << 16); }
__device__ __forceinline__ float bf_hi(unsigned w) { return __builtin_bit_cast(float, w & 0xffff0000u); }
__device__ __forceinline__ float silu_f(float z) { return z / (1.f + __expf(-z)); }
struct Epi {
    static constexpr bool PERM = true, AFTER_DRAIN = false;
    int mode;
    bf16_t* O; int ldc;
    int tail_pn; float* F; int ldf, nf;
    const float* rstd; const float* ng;
    const float* src_lat; const float* src_ctx; float* dst_lat; float* dst_ctx; const float* mod; int gidx;
    __device__ __forceinline__ void operator()(const f32x4 (&acc)[2][2][4][2], const Unit& u, int wr, int wc, int fr, int fq) const {
        const int row0 = u.pm * BM + wr * 64 + fr; const int col0 = u.pn * BM + wc * 32 + 8 * fq;
        if (mode <= 1) {
            if (u.pn == tail_pn) {
                const int c0 = wc * 32 + 8 * fq;
#pragma unroll
                for (int ai = 0; ai < 2; ++ai)
#pragma unroll
                    for (int m = 0; m < 4; ++m)
#pragma unroll
                        for (int bj = 0; bj < 2; ++bj) { const int cc = c0 + bj * HALF;
                            if (cc < nf) { float* p = F + (size_t)(row0 + ai * HALF + m * 16) * ldf + cc; *(f32x4*)p = acc[ai][bj][m][0]; *(f32x4*)(p + 4) = acc[ai][bj][m][1]; } }
            } else {
#pragma unroll
                for (int ai = 0; ai < 2; ++ai)
#pragma unroll
                    for (int m = 0; m < 4; ++m) { bf16_t* rowp = O + (size_t)(row0 + ai * HALF + m * 16) * ldc + col0;
#pragma unroll
                        for (int bj = 0; bj < 2; ++bj) { f32x4 v0 = acc[ai][bj][m][0], v1 = acc[ai][bj][m][1];
                            if (mode == 1) {
#pragma unroll
                                for (int e = 0; e < 4; ++e) { float a = fmaxf(v0[e], 0.f), b = fmaxf(v1[e], 0.f); v0[e] = a * a; v1[e] = b * b; } }
                            u32x4 w; w.x = cvtpk_s(v0[0], v0[1]); w.y = cvtpk_s(v0[2], v0[3]); w.z = cvtpk_s(v1[0], v1[1]); w.w = cvtpk_s(v1[2], v1[3]);
                            *(u32x4*)(rowp + bj * HALF) = w; } }
            }
        } else if (mode == 2) {
            const f32x4 g0 = *(const f32x4*)(ng + (col0 & 127)), g1 = *(const f32x4*)(ng + (col0 & 127) + 4);
#pragma unroll
            for (int ai = 0; ai < 2; ++ai)
#pragma unroll
                for (int m = 0; m < 4; ++m) { const int row = row0 + ai * HALF + m * 16; bf16_t* rowp = O + (size_t)row * ldc + col0;
#pragma unroll
                    for (int bj = 0; bj < 2; ++bj) { const float rs = rstd[(size_t)row * 16 + ((col0 + bj * HALF) >> 7)];
                        const u32x4 ov = *(const u32x4*)(rowp + bj * HALF); const f32x4 z0 = acc[ai][bj][m][0], z1 = acc[ai][bj][m][1];
                        float r[8];
                        r[0] = bf_lo(ov.x) * rs * g0[0] * silu_f(z0[0]); r[1] = bf_hi(ov.x) * rs * g0[1] * silu_f(z0[1]);
                        r[2] = bf_lo(ov.y) * rs * g0[2] * silu_f(z0[2]); r[3] = bf_hi(ov.y) * rs * g0[3] * silu_f(z0[3]);
                        r[4] = bf_lo(ov.z) * rs * g1[0] * silu_f(z1[0]); r[5] = bf_hi(ov.z) * rs * g1[1] * silu_f(z1[1]);
                        r[6] = bf_lo(ov.w) * rs * g1[2] * silu_f(z1[2]); r[7] = bf_hi(ov.w) * rs * g1[3] * silu_f(z1[3]);
                        u32x4 w; w.x = cvtpk_s(r[0], r[1]); w.y = cvtpk_s(r[2], r[3]); w.z = cvtpk_s(r[4], r[5]); w.w = cvtpk_s(r[6], r[7]);
                        *(u32x4*)(rowp + bj * HALF) = w; } }
        } else {
            const int mi = u.pm < 64 ? 0 : (u.pm < 128 ? 1 : 2);
            const float* gate = mod + (size_t)mi * 6144 + (size_t)gidx * 1024;
            const bool lat = u.pm < 128;
            const float* sb = lat ? src_lat : src_ctx - (size_t)32768 * 1024; float* db = lat ? dst_lat : dst_ctx - (size_t)32768 * 1024;
#pragma unroll
            for (int bj = 0; bj < 2; ++bj)
#pragma unroll
                for (int n = 0; n < 2; ++n) { const int c = col0 + bj * HALF + 4 * n; const f32x4 gv = *(const f32x4*)(gate + c);
#pragma unroll
                    for (int ai = 0; ai < 2; ++ai)
#pragma unroll
                        for (int m = 0; m < 4; ++m) { const size_t off = (size_t)(row0 + ai * HALF + m * 16) * 1024 + c;
                            const f32x4 s = *(const f32x4*)(sb + off); *(f32x4*)(db + off) = s + gv * acc[ai][bj][m][n]; } }
        }
    }
};
template <class Epi, class Sched, bool ALIGN_EPI = false, bool SP2 = false>
__device__ __forceinline__ void gemm_phase(PG8_LAS unsigned char* lds, const Gemm g, const Sched& S, const Epi& E) {
    const int tid = opaque_tid(), wid = __builtin_amdgcn_readfirstlane(tid >> 6), lane = tid & 63, wr = wid >> 2, wc = wid & 3, fr = lane & 15, fq = lane >> 4;
    const int K = g.K, nt = K / BK;
    unsigned voffA[2], voffB[2];
#pragma unroll
    for (int i = 0; i < 2; ++i) { int R, C; stage_rc(tid * 16 + i * 8192, R, C); const int Rb = Epi::PERM ? ((R & ~31) + perm32(R & 31)) : R;
        voffA[i] = (unsigned)(R * K + C) * 2u; voffB[i] = (unsigned)(Rb * K + C) * 2u; }
    const size_t kstep = (size_t)(BK * 2);
    const size_t hstep = (size_t)HALF * K * 2;
    const size_t tstep = 2 * hstep;
    const unsigned ldsw = (unsigned)wid * 1024u;
    const int aoff = lds_byte(wr * 64 + fr, fq * 8), boff = lds_byte(wc * 32 + fr, fq * 8);
#define PG8_SA(b, h) (((b) * 2 + (h)) * HTB)
#define PG8_SB(b, h) ((4 + (b) * 2 + (h)) * HTB)
#define PG8_STAGE(bufoff, gbase, voff) do { _Pragma("unroll") for (int _i = 0; _i < 2; ++_i) \
        __builtin_amdgcn_global_load_lds((const unsigned*)((const char*)(gbase) + (voff)[_i]), (PG8_LAS unsigned*)(lds + (bufoff) + ldsw + _i * 8192), 16, 0, 0); } while (0)
#define PG8_LDA(dst, b, h) do { _Pragma("unroll") for (int m = 0; m < 4; ++m) _Pragma("unroll") for (int k = 0; k < 2; ++k) dst[m][k] = *(const PG8_LAS bf16x8*)(lds + PG8_SA(b, h) + aoff + m * 2048 + k * 1024); } while (0)
#define PG8_LDB(dst, b, h) do { _Pragma("unroll") for (int n = 0; n < 2; ++n) _Pragma("unroll") for (int k = 0; k < 2; ++k) dst[n][k] = *(const PG8_LAS bf16x8*)(lds + PG8_SB(b, h) + boff + n * 2048 + k * 1024); } while (0)
#define PG8_MMA(ai, bj, At, Bt) do { __builtin_amdgcn_s_setprio(1); _Pragma("unroll") for (int m = 0; m < 4; ++m) _Pragma("unroll") for (int n = 0; n < 2; ++n) _Pragma("unroll") for (int k = 0; k < 2; ++k) \
        acc[ai][bj][m][n] = __builtin_amdgcn_mfma_f32_16x16x32_bf16(Bt[n][k], At[m][k], acc[ai][bj][m][n], 0, 0, 0); __builtin_amdgcn_s_setprio(0); } while (0)
#define PG8_WAIT_V(n) asm volatile("s_waitcnt vmcnt(" #n ")" ::: "memory")
#define PG8_WAIT_L(n) asm volatile("s_waitcnt lgkmcnt(" #n ")" ::: "memory")
#define PG8_BAR __builtin_amdgcn_s_barrier()
#define PG8_SCHED __builtin_amdgcn_sched_barrier(0)
    Unit cur, nxt; int ui = 0;
    if (!S.next(0, cur)) return;
    f32x4 acc[2][2][4][2];
#pragma unroll
    for (int a = 0; a < 2; ++a)
#pragma unroll
        for (int b = 0; b < 2; ++b)
#pragma unroll
            for (int m = 0; m < 4; ++m)
#pragma unroll
                for (int n = 0; n < 2; ++n) acc[a][b][m][n] = (f32x4){0.f, 0.f, 0.f, 0.f};
    bf16x8 At[4][2], B0[2][2], B1[2][2];
    const char* cA = (const char*)g.A + (size_t)cur.pm * tstep; const char* cB = (const char*)g.Bt + (size_t)cur.pn * tstep;
    S.a_ready(cur);
    if constexpr (SP2) {
        PG8_STAGE(PG8_SB(0, 0), cB, voffB); PG8_STAGE(PG8_SB(0, 1), cB + hstep, voffB); PG8_STAGE(PG8_SA(0, 0), cA, voffA); PG8_STAGE(PG8_SA(0, 1), cA + hstep, voffA);
        if (wr == 1) PG8_BAR;
        PG8_WAIT_V(2); PG8_BAR;
        PG8_STAGE(PG8_SB(1, 0), cB + kstep, voffB); PG8_STAGE(PG8_SA(1, 0), cA + kstep, voffA); PG8_STAGE(PG8_SB(1, 1), cB + hstep + kstep, voffB);
        PG8_WAIT_V(6); PG8_BAR;
    } else {
        PG8_STAGE(PG8_SB(0, 0), cB, voffB); PG8_STAGE(PG8_SA(0, 0), cA, voffA); PG8_STAGE(PG8_SB(0, 1), cB + hstep, voffB); PG8_STAGE(PG8_SA(0, 1), cA + hstep, voffA);
        if (wr == 1) PG8_BAR;
        PG8_WAIT_V(4); PG8_BAR;
        PG8_STAGE(PG8_SB(1, 0), cB + kstep, voffB); PG8_STAGE(PG8_SA(1, 0), cA + kstep, voffA); PG8_STAGE(PG8_SB(1, 1), cB + hstep + kstep, voffB);
        PG8_WAIT_V(6); PG8_BAR;
    }
    for (;;) {
        const bool has_next = S.next(ui + 1, nxt);
        const char* nA = has_next ? (const char*)g.A + (size_t)nxt.pm * tstep : cA; const char* nB = has_next ? (const char*)g.Bt + (size_t)nxt.pn * tstep : cB;
        for (int t = 0; t < nt; t += 2) {
            const bool last = (t == nt - 2);
            const char* a1 = cA + (size_t)(t + 1) * kstep;
            const char* a2 = last ? nA : cA + (size_t)(t + 2) * kstep; const char* b2 = last ? nB : cB + (size_t)(t + 2) * kstep;
            const char* a3 = a2 + kstep; const char* b3 = b2 + kstep;
            if (last && has_next) S.a_ready(nxt);
            if constexpr (SP2) {
            PG8_LDB(B0, 0, 0); PG8_LDB(B1, 0, 1); PG8_SCHED; PG8_LDA(At, 0, 0); PG8_STAGE(PG8_SA(1, 1), a1 + hstep, voffA);
            PG8_WAIT_V(8); PG8_WAIT_L(0); PG8_BAR; PG8_MMA(0, 0, At, B0); PG8_MMA(0, 1, At, B1); PG8_BAR; PG8_SCHED;
            PG8_LDA(At, 0, 1); PG8_STAGE(PG8_SB(0, 0), b2, voffB); PG8_STAGE(PG8_SB(0, 1), b2 + hstep, voffB); PG8_STAGE(PG8_SA(0, 0), a2, voffA);
            PG8_WAIT_V(8); PG8_WAIT_L(0); PG8_BAR; PG8_MMA(1, 0, At, B0); PG8_MMA(1, 1, At, B1); PG8_BAR; PG8_SCHED;
            PG8_LDB(B0, 1, 0); PG8_LDB(B1, 1, 1); PG8_SCHED; PG8_LDA(At, 1, 0); PG8_STAGE(PG8_SA(0, 1), a2 + hstep, voffA);
            PG8_WAIT_V(8); PG8_WAIT_L(0); PG8_BAR; PG8_MMA(0, 0, At, B0); PG8_MMA(0, 1, At, B1); PG8_BAR; PG8_SCHED;
            PG8_LDA(At, 1, 1); PG8_STAGE(PG8_SB(1, 0), b3, voffB); PG8_STAGE(PG8_SB(1, 1), b3 + hstep, voffB); PG8_STAGE(PG8_SA(1, 0), a3, voffA);
            PG8_WAIT_V(8); PG8_WAIT_L(0); PG8_BAR; PG8_MMA(1, 0, At, B0); PG8_MMA(1, 1, At, B1); PG8_BAR; PG8_SCHED;
            } else {
            PG8_LDB(B0, 0, 0); PG8_SCHED; PG8_LDA(At, 0, 0); PG8_STAGE(PG8_SA(1, 1), a1 + hstep, voffA);
            PG8_WAIT_L(8); PG8_BAR; PG8_WAIT_L(0); PG8_MMA(0, 0, At, B0); PG8_BAR; PG8_SCHED;
            PG8_LDB(B1, 0, 1); PG8_STAGE(PG8_SB(0, 0), b2, voffB);
            PG8_BAR; PG8_WAIT_L(0); PG8_MMA(0, 1, At, B1); PG8_BAR;
            PG8_LDA(At, 0, 1); PG8_STAGE(PG8_SA(0, 0), a2, voffA);
            PG8_BAR; PG8_WAIT_L(0); PG8_MMA(1, 0, At, B0); PG8_BAR; PG8_SCHED;
            PG8_STAGE(PG8_SB(0, 1), b2 + hstep, voffB);
            PG8_WAIT_V(6); PG8_BAR; PG8_MMA(1, 1, At, B1); PG8_BAR;
            PG8_LDB(B0, 1, 0); PG8_SCHED; PG8_LDA(At, 1, 0); PG8_STAGE(PG8_SA(0, 1), a2 + hstep, voffA);
            PG8_WAIT_L(8); PG8_BAR; PG8_WAIT_L(0); PG8_MMA(0, 0, At, B0); PG8_BAR; PG8_SCHED;
            PG8_LDB(B1, 1, 1); PG8_STAGE(PG8_SB(1, 0), b3, voffB);
            PG8_BAR; PG8_WAIT_L(0); PG8_MMA(0, 1, At, B1); PG8_BAR;
            PG8_LDA(At, 1, 1); PG8_STAGE(PG8_SA(1, 0), a3, voffA);
            PG8_BAR; PG8_WAIT_L(0); PG8_MMA(1, 0, At, B0); PG8_BAR; PG8_SCHED;
            PG8_STAGE(PG8_SB(1, 1), b3 + hstep, voffB);
            PG8_WAIT_V(6); PG8_BAR; PG8_MMA(1, 1, At, B1); PG8_BAR;
            }
        }
        if constexpr (ALIGN_EPI) { if (wr == 0) PG8_BAR; }
        if constexpr (!Epi::AFTER_DRAIN) { E(acc, cur, wr, wc, fr, fq); S.done(cur); }
        if (!has_next) break;
#pragma unroll
        for (int a = 0; a < 2; ++a)
#pragma unroll
            for (int b = 0; b < 2; ++b)
#pragma unroll
                for (int m = 0; m < 4; ++m)
#pragma unroll
                    for (int n = 0; n < 2; ++n) acc[a][b][m][n] = (f32x4){0.f, 0.f, 0.f, 0.f};
        cur = nxt; cA = nA; cB = nB; ++ui;
        if constexpr (ALIGN_EPI) { if (wr == 1) PG8_BAR; }
    }
    PG8_WAIT_V(0);
    if constexpr (!ALIGN_EPI) { if (wr == 0) PG8_BAR; }
    PG8_BAR;
    if constexpr (Epi::AFTER_DRAIN) { E.fused(acc, cur, wr, wc, fr, fq, lds, wid, lane); S.done(cur); }
#undef PG8_SA
#undef PG8_SB
#undef PG8_STAGE
#undef PG8_LDA
#undef PG8_LDB
#undef PG8_MMA
#undef PG8_WAIT_V
#undef PG8_WAIT_L
#undef PG8_BAR
#undef PG8_SCHED
}
}
namespace attn {
using bf16 = __hip_bfloat16;
constexpr int   D = 128, NW = 8, QBLK = 32, KVBLK = 64;
constexpr float SCALE = 0.088388347648318440f;
constexpr float THR = 8.f;
constexpr int SDEPTH = 2;
constexpr int LDQ = 1024, LDK = 128, LDO = 1024;
constexpr size_t SHM_V = KVBLK * D * 2, SHM_K = KVBLK * D * 2, SHM_ATTN = 2 * SHM_V + 2 * SHM_K + NW * 64 * 4;
using bf16x8 = __attribute__((ext_vector_type(8))) short;
using s16x4  = __attribute__((ext_vector_type(4))) short;
using f32x16 = __attribute__((ext_vector_type(16))) float;
using f32x8  = __attribute__((ext_vector_type(8))) float;
using u32x4  = __attribute__((ext_vector_type(4))) unsigned;
#define KSWZ(row, colB) ((row) * 256 + ((colB) ^ (((row) & 7) << 4)))
#define SBAR() __builtin_amdgcn_sched_barrier(0)
__device__ __forceinline__ int crow(int r, int hi) { return (r & 3) + 8 * (r >> 2) + 4 * hi; }
__device__ __forceinline__ unsigned cvtpk(float lo, float hi) {
  unsigned r; asm volatile("v_cvt_pk_bf16_f32 %0, %1, %2" : "=v"(r) : "v"(lo), "v"(hi)); return r;
}
template <typename TIn> struct Stage;
template <> struct Stage<bf16>  { using T = bf16x8;
  __device__ static __forceinline__ T ld8(const bf16* p) { return *reinterpret_cast<const bf16x8*>(p); }
  __device__ static __forceinline__ bf16x8 tobf(T x) { return x; } };
template <> struct Stage<float> { using T = f32x8;
  __device__ static __forceinline__ T ld8(const float* p) { return *reinterpret_cast<const f32x8*>(p); }
  __device__ static __forceinline__ bf16x8 tobf(T x) {
    u32x4 w = {cvtpk(x[0], x[1]), cvtpk(x[2], x[3]), cvtpk(x[4], x[5]), cvtpk(x[6], x[7])}; return *reinterpret_cast<bf16x8*>(&w); } };

__device__ __forceinline__ void partialSM(f32x16& p0, f32x16& p1, float& m_reg, float& mn, float& alpha) {
  constexpr float C = SCALE * 1.4426950408889634f;
  float pmax = p0[0]; for (int r = 1; r < 16; ++r) pmax = fmaxf(pmax, p0[r]); for (int r = 0; r < 16; ++r) pmax = fmaxf(pmax, p1[r]);
  { auto rr = __builtin_amdgcn_permlane32_swap(__float_as_uint(pmax), __float_as_uint(pmax), false, false);
    pmax = fmaxf(__uint_as_float(rr[0]), __uint_as_float(rr[1])); }
  if (__builtin_expect(__all(pmax - m_reg <= THR / SCALE), 1)) { mn = m_reg; alpha = 1.f; }
  else { mn = fmaxf(m_reg, pmax); alpha = __builtin_amdgcn_exp2f((m_reg - mn) * C); m_reg = mn; }
  float mnC = -mn * C;
  for (int r = 0; r < 16; ++r) p0[r] = fmaf(p0[r], C, mnC); for (int r = 0; r < 16; ++r) p1[r] = fmaf(p1[r], C, mnC);
  for (int r = 0; r < 16; ++r) p0[r] = __builtin_amdgcn_exp2f(p0[r]);
}
__device__ __forceinline__ void finishSM(f32x16& p0, f32x16& p1, float alpha, float& l_reg, bf16x8& pa0, bf16x8& pa1, bf16x8& pa2, bf16x8& pa3) {
  for (int r = 0; r < 16; ++r) p1[r] = __builtin_amdgcn_exp2f(p1[r]);
  float ps = 0; for (int r = 0; r < 16; ++r) ps += p0[r]; for (int r = 0; r < 16; ++r) ps += p1[r];
  { auto rr = __builtin_amdgcn_permlane32_swap(__float_as_uint(ps), __float_as_uint(ps), false, false);
    ps = __uint_as_float(rr[0]) + __uint_as_float(rr[1]); }
  l_reg = l_reg * alpha + ps;
#define PK4(P, BASE, OUT) do { unsigned a0 = cvtpk(P[BASE + 0], P[BASE + 1]), a1 = cvtpk(P[BASE + 2], P[BASE + 3]);   \
    unsigned b0 = cvtpk(P[BASE + 4], P[BASE + 5]), b1 = cvtpk(P[BASE + 6], P[BASE + 7]);                              \
    auto r0 = __builtin_amdgcn_permlane32_swap(a0, b0, false, false); auto r1 = __builtin_amdgcn_permlane32_swap(a1, b1, false, false); \
    u32x4 w = {r0[0], r1[0], r0[1], r1[1]}; OUT = *reinterpret_cast<bf16x8*>(&w); } while (0)
  PK4(p0, 0, pa0); PK4(p0, 8, pa1); PK4(p1, 0, pa2); PK4(p1, 8, pa3);
#undef PK4
}
__device__ __forceinline__ void qkt(f32x16& p0, f32x16& p1, const bf16* Ks, const bf16x8* qr, int r32, int hi) {
  p0 = f32x16{}; p1 = f32x16{};
  for (int d0 = 0; d0 < 8; ++d0) { int cb = (d0 * 16 + hi * 8) * 2;
    bf16x8 b0 = *reinterpret_cast<const bf16x8*>((const char*)Ks + KSWZ(r32, cb));
    bf16x8 b1 = *reinterpret_cast<const bf16x8*>((const char*)Ks + KSWZ(32 + r32, cb));
    p0 = __builtin_amdgcn_mfma_f32_32x32x16_bf16(b0, qr[d0], p0, 0, 0, 0);
    p1 = __builtin_amdgcn_mfma_f32_32x32x16_bf16(b1, qr[d0], p1, 0, 0, 0); }
}
__device__ __forceinline__ int v_st(int k, int c) { const int kk = (k & ~0xC) | ((k & 4) << 1) | ((k & 8) >> 1); return ((kk >> 3) * 4 + (c >> 5)) * 512 + ((kk & 7) * 32 + (c & 31)) * 2; }
__device__ __forceinline__ int v_rd_base(int lane) { return ((lane & 3) << 3) | (((lane >> 2) & 3) << 6) | (((lane >> 4) & 1) << 5) | (((lane >> 5) & 1) << 8); }
constexpr int v_rd_off(int d0, int ks, int half) { return d0 * 512 + ks * 4096 + half * 2048; }
template <int OFF> __device__ __forceinline__ s16x4 tr_read(int vb) {
  s16x4 r; asm volatile("ds_read_b64_tr_b16 %0, %1 offset:%2" : "=&v"(r) : "v"(vb), "i"(OFF) : "memory"); return r;
}
template <int D0> __device__ __forceinline__ void pv_one(f32x16& od, int vb, bf16x8 pa0, bf16x8 pa1, bf16x8 pa2, bf16x8 pa3) {
  const s16x4 l0 = tr_read<v_rd_off(D0, 0, 0)>(vb), h0 = tr_read<v_rd_off(D0, 0, 1)>(vb), l1 = tr_read<v_rd_off(D0, 1, 0)>(vb), h1 = tr_read<v_rd_off(D0, 1, 1)>(vb);
  const s16x4 l2 = tr_read<v_rd_off(D0, 2, 0)>(vb), h2 = tr_read<v_rd_off(D0, 2, 1)>(vb), l3 = tr_read<v_rd_off(D0, 3, 0)>(vb), h3 = tr_read<v_rd_off(D0, 3, 1)>(vb);
  asm volatile("s_waitcnt lgkmcnt(0)" ::: "memory"); SBAR();
#define PK(L, H) (bf16x8){L[0], L[1], L[2], L[3], H[0], H[1], H[2], H[3]}
  od = __builtin_amdgcn_mfma_f32_32x32x16_bf16(pa0, PK(l0, h0), od, 0, 0, 0);
  od = __builtin_amdgcn_mfma_f32_32x32x16_bf16(pa1, PK(l1, h1), od, 0, 0, 0);
  od = __builtin_amdgcn_mfma_f32_32x32x16_bf16(pa2, PK(l2, h2), od, 0, 0, 0);
  od = __builtin_amdgcn_mfma_f32_32x32x16_bf16(pa3, PK(l3, h3), od, 0, 0, 0);
#undef PK
}
__device__ __forceinline__ void pv_d0(f32x16* o, int vb, bf16x8 pa0, bf16x8 pa1, bf16x8 pa2, bf16x8 pa3) {
  pv_one<0>(o[0], vb, pa0, pa1, pa2, pa3); pv_one<1>(o[1], vb, pa0, pa1, pa2, pa3); pv_one<2>(o[2], vb, pa0, pa1, pa2, pa3); pv_one<3>(o[3], vb, pa0, pa1, pa2, pa3);
}

template <typename TQ>
__device__ __forceinline__ void attn_dense_body(const TQ* __restrict__ Qb, const bf16* __restrict__ Kh, const bf16* __restrict__ Vh,
                                                bf16* __restrict__ Ob, int seq, char* lds) {
  using St = Stage<bf16>; using SQ = Stage<TQ>;
  const int tid = opaque_tid(), wid = tid >> 6, lane = tid & 63, r32 = lane & 31, hi = lane >> 5;
  bf16* V_lds = (bf16*)lds; bf16* K_lds = (bf16*)(lds + 2 * SHM_V);
  float* ws = (float*)(lds + 2 * SHM_V + 2 * SHM_K) + wid * 64; float* li_l = ws; float* al_l = ws + 32;
  float m_reg = -1e30f, l_reg = 0; f32x16 o[4] = {}; bf16x8 qr[8];
  const TQ* Qw = Qb + (long)(wid * QBLK + r32) * LDQ + hi * 8;
#pragma unroll
  for (int d0 = 0; d0 < 8; ++d0) qr[d0] = SQ::tobf(SQ::ld8(Qw + d0 * 16));
  const int sr = tid >> 4, sc = (tid & 15) * 8, vst0 = v_st(sr, sc), vst1 = v_st(32 + sr, sc);
  const int vb0 = (int)(uintptr_t)V_lds + v_rd_base(lane);
  struct { typename St::T vs0, vs1, ks0, ks1; } sr_[SDEPTH];
#define SLOAD(i, k0) do { sr_[i].vs0 = St::ld8(&Vh[(long)((k0) + sr) * LDK + sc]); sr_[i].vs1 = St::ld8(&Vh[(long)((k0) + 32 + sr) * LDK + sc]); \
    sr_[i].ks0 = St::ld8(&Kh[(long)((k0) + sr) * LDK + sc]); sr_[i].ks1 = St::ld8(&Kh[(long)((k0) + 32 + sr) * LDK + sc]); } while (0)
#define SWRITE(b, i) do { *(bf16x8*)((char*)V_lds + (b) * SHM_V + vst0) = St::tobf(sr_[i].vs0);          \
    *(bf16x8*)((char*)V_lds + (b) * SHM_V + vst1) = St::tobf(sr_[i].vs1); int kc = sc * 2;               \
    *(bf16x8*)((char*)K_lds + (b) * SHM_K + KSWZ(sr, kc)) = St::tobf(sr_[i].ks0);                       \
    *(bf16x8*)((char*)K_lds + (b) * SHM_K + KSWZ(32 + sr, kc)) = St::tobf(sr_[i].ks1); } while (0)
#define SWAIT() do { if constexpr (SDEPTH == 2) asm volatile("s_waitcnt vmcnt(4)" ::: "memory"); else asm volatile("s_waitcnt vmcnt(0)" ::: "memory"); } while (0)
#define RESC(a) do { if (__any((a) < 1.f)) { if (hi == 0) al_l[r32] = (a); asm volatile("s_waitcnt lgkmcnt(0)" ::: "memory"); \
    for (int d = 0; d < 4; ++d) for (int r = 0; r < 16; ++r) o[d][r] *= al_l[crow(r, hi)]; } } while (0)
  f32x16 pA0, pA1, pB0, pB1; float mnA, mnB, alA, alB; bf16x8 pa0, pa1, pa2, pa3; const int NT = seq / KVBLK;
  constexpr int SE = 0, SO = SDEPTH - 1;
  SLOAD(SE, 0); asm volatile("s_waitcnt vmcnt(0)" ::: "memory"); SWRITE(0, SE); __syncthreads();
  qkt(pA0, pA1, K_lds, qr, r32, hi); partialSM(pA0, pA1, m_reg, mnA, alA);
  SLOAD(SO, KVBLK); if constexpr (SDEPTH == 2) { if (2 < NT) SLOAD(SE, 2 * KVBLK); }
  SWAIT(); SWRITE(1, SO); __syncthreads();
  for (int j = 1; j + 1 < NT; j += 2) {
    SBAR(); qkt(pB0, pB1, (bf16*)((char*)K_lds + SHM_K), qr, r32, hi);
    finishSM(pA0, pA1, alA, l_reg, pa0, pa1, pa2, pa3); SBAR();
    SLOAD(SO, (j + SDEPTH) * KVBLK); SBAR();
    pv_d0(o, vb0, pa0, pa1, pa2, pa3); partialSM(pB0, pB1, m_reg, mnB, alB);
    __syncthreads(); SWAIT(); SWRITE(0, SE);
    RESC(alB); __syncthreads();
    SBAR(); qkt(pA0, pA1, K_lds, qr, r32, hi);
    finishSM(pB0, pB1, alB, l_reg, pa0, pa1, pa2, pa3); SBAR();
    if (SDEPTH == 1 || j + 3 < NT) SLOAD(SE, (j + 1 + SDEPTH) * KVBLK); SBAR();
    pv_d0(o, vb0 + (int)SHM_V, pa0, pa1, pa2, pa3); partialSM(pA0, pA1, m_reg, mnA, alA);
    __syncthreads(); SWAIT(); SWRITE(1, SO);
    RESC(alA); __syncthreads();
  }
  SBAR(); qkt(pB0, pB1, (bf16*)((char*)K_lds + SHM_K), qr, r32, hi);
  finishSM(pA0, pA1, alA, l_reg, pa0, pa1, pa2, pa3); SBAR();
  pv_d0(o, vb0, pa0, pa1, pa2, pa3); partialSM(pB0, pB1, m_reg, mnB, alB);
  __syncthreads(); RESC(alB);
  finishSM(pB0, pB1, alB, l_reg, pa0, pa1, pa2, pa3); SBAR();
  pv_d0(o, vb0 + (int)SHM_V, pa0, pa1, pa2, pa3);
  if (hi == 0) li_l[r32] = l_reg; asm volatile("s_waitcnt lgkmcnt(0)" ::: "memory");
  float rli[16];
#pragma unroll
  for (int r = 0; r < 16; ++r) rli[r] = __builtin_amdgcn_rcpf(li_l[crow(r, hi)]);
  bf16* Ow = Ob + (long)(wid * QBLK) * LDO;
#pragma unroll
  for (int r = 0; r < 16; ++r) { int orow = crow(r, hi);
    for (int d0 = 0; d0 < 4; ++d0) Ow[(long)orow * LDO + d0 * 32 + r32] = __float2bfloat16(o[d0][r] * rli[r]); }
#undef SLOAD
#undef SWRITE
#undef SWAIT
#undef RESC
}

}
#define LAS __attribute__((address_space(3)))
typedef unsigned short bf16_t;
typedef short bf16x8 __attribute__((ext_vector_type(8)));
typedef short s16x4 __attribute__((ext_vector_type(4)));
typedef float f32x4 __attribute__((ext_vector_type(4)));
typedef float f32x16 __attribute__((ext_vector_type(16)));
typedef unsigned u32x4 __attribute__((ext_vector_type(4)));
typedef unsigned u32x2 __attribute__((ext_vector_type(2)));
using pg8::cvtpk_s; using pg8::bf_lo; using pg8::bf_hi; using pg8::silu_f;

constexpr int DM = 1024, SEQ = 16384, CTXL = 256, NLAT = 2 * SEQ, MROWS = NLAT + 2 * CTXL, DFF = 4096;
constexpr float EPS = 1e-6f;
constexpr size_t MiB = 1u << 20;
constexpr size_t WS_BAR = 512 * 1024, WS_BAR_BYTES = 16384;
constexpr size_t WS_MOD = 0, WS_CTX = 1 * MiB, WS_WT = 4 * MiB, WS_H = 41 * MiB, WS_AB = 106 * MiB, WS_RSTD = 115 * MiB, WS_P = 118 * MiB, WS_O = 378 * MiB, WS_END = 508 * MiB;
constexpr size_t WT_A = WS_WT, WT_Z = WS_WT + 9 * MiB, WT_O = WS_WT + 13 * MiB, WT_1 = WS_WT + 17 * MiB, WT_2 = WS_WT + 25 * MiB;
constexpr size_t WS_QM = 313 * MiB, WS_KM = 378 * MiB, WS_OGLA = 443 * MiB, WS_AQ = 41 * MiB, WS_EL = 74 * MiB;
constexpr size_t WS_TP = 4 * MiB, WS_HALO = 378 * MiB;
constexpr size_t WS_QR = 216 * MiB, WS_KR = 281 * MiB, WS_VR = 298 * MiB;
constexpr int SKV = SEQ + CTXL;
constexpr int LDS_BYTES = 155648;
enum { OP_MOD, OP_PREP, OP_GEMM_IN, OP_DNSCAN, OP_DNREDO, OP_GEMM_Z, OP_GEMM_OUT, OP_NORM2, OP_FFN1, OP_FFN2, OP_GLAPREP, OP_GLASCAN, OP_GLAGATE, OP_QKROPE, OP_ATTN, OP_DNHALO, OP_DNCONV, OP_DNT };

struct Args { const float* in[25]; float* out; unsigned char* ws; int ph_lo, ph_hi; };

__device__ __forceinline__ float wave_sum(float v) {
#pragma unroll
    for (int o = 1; o < 64; o <<= 1) v += __shfl_xor(v, o);
    return v;
}
__device__ __forceinline__ float softplus_f(float x) { return x > 20.f ? x : log1pf(__expf(x)); }
__device__ __forceinline__ float logsigmoid_f(float x) { return fminf(x, 0.f) - log1pf(__expf(-fabsf(x))); }
__device__ __forceinline__ bf16_t f2bf(float f) { return (bf16_t)(cvtpk_s(f, 0.f) & 0xffffu); }
__device__ __forceinline__ float bf2f(bf16_t v) { return __builtin_bit_cast(float, (unsigned)v << 16); }

__device__ __forceinline__ void transpose_item(const float* W, int ldw, int c0, int ncols, int K, bf16_t* WT, int row_off, LAS float* scr, int item, int lane) {
    const int nblk = ncols / 32, kb = item / nblk, nb = item % nblk, k0 = 64 * kb, n0 = 32 * nb;
#pragma unroll 8
    for (int i = 0; i < 32; ++i) { const int kk = 2 * i + (lane >> 5); scr[kk * 33 + (lane & 31)] = W[(size_t)(k0 + kk) * ldw + c0 + n0 + (lane & 31)]; }
    asm volatile("s_waitcnt lgkmcnt(0)" ::: "memory");
    const int c = lane & 7;
#pragma unroll
    for (int j = 0; j < 4; ++j) { const int n = (lane >> 3) + 8 * j; const LAS float* s = scr + (8 * c) * 33 + n;
        u32x4 o; o.x = cvtpk_s(s[0 * 33], s[1 * 33]); o.y = cvtpk_s(s[2 * 33], s[3 * 33]); o.z = cvtpk_s(s[4 * 33], s[5 * 33]); o.w = cvtpk_s(s[6 * 33], s[7 * 33]);
        *(u32x4*)(WT + (size_t)(row_off + n0 + n) * K + k0 + 8 * c) = o; }
    asm volatile("s_waitcnt lgkmcnt(0)" ::: "memory");
}
__device__ __forceinline__ void transpose_mat(const float* W, int ldw, int c0, int ncols, int K, bf16_t* WT, int row_off, LAS float* scr, int gw, int NGW, int lane) {
    const int nitems = (K / 64) * (ncols / 32);
    for (int it = gw; it < nitems; it += NGW) transpose_item(W, ldw, c0, ncols, K, WT, row_off, scr, it, lane);
}
__device__ __forceinline__ void normmod_rows(const float* xl, const float* xc, const float* g, const float* modl, int sidx, bf16_t* H, int gw, int NGW, int lane) {
    for (int row = gw; row < MROWS; row += NGW) {
        const float* xr = row < NLAT ? xl + (size_t)row * DM : xc + (size_t)(row - NLAT) * DM;
        const int mi = row < SEQ ? 0 : (row < NLAT ? 1 : 2);
        const float* sh = modl + (size_t)mi * 6144 + (size_t)sidx * 1024; const float* sc = sh + 1024;
        f32x4 v[4]; float ss = 0.f;
#pragma unroll
        for (int j = 0; j < 4; ++j) { v[j] = *(const f32x4*)(xr + 4 * lane + 256 * j); ss += (v[j][0] * v[j][0] + v[j][1] * v[j][1]) + (v[j][2] * v[j][2] + v[j][3] * v[j][3]); }
        const float rinv = rsqrtf(wave_sum(ss) * (1.f / DM) + EPS);
#pragma unroll
        for (int j = 0; j < 4; ++j) { const int c = 4 * lane + 256 * j; const f32x4 gg = *(const f32x4*)(g + c), s1 = *(const f32x4*)(sc + c), s0 = *(const f32x4*)(sh + c);
            f32x4 y;
#pragma unroll
            for (int e = 0; e < 4; ++e) y[e] = v[j][e] * rinv * gg[e] * (1.f + s1[e]) + s0[e];
            u32x2 w; w.x = cvtpk_s(y[0], y[1]); w.y = cvtpk_s(y[2], y[3]); *(u32x2*)(H + (size_t)row * DM + c) = w; }
    }
}
#define BAR_LDS() do { asm volatile("s_waitcnt lgkmcnt(0)" ::: "memory"); __builtin_amdgcn_s_barrier(); asm volatile("" ::: "memory"); } while (0)
__device__ __forceinline__ int crow(int x, int h) { return (x & 3) + 8 * (x >> 2) + 4 * h; }
#define MFMA32(a, b, c) __builtin_amdgcn_mfma_f32_32x32x16_bf16((a), (b), (c), 0, 0, 0)
__device__ __forceinline__ bf16x8 frag_nat(const LAS bf16_t* img, int LD, int row, int ks, int h) { return *(const LAS bf16x8*)(img + row * LD + 16 * ks + 8 * h); }
__device__ __forceinline__ bf16x8 frag_perm(const LAS bf16_t* img, int LD, int row, int ks, int h) {
    const s16x4 lo = *(const LAS s16x4*)(img + row * LD + 16 * ks + 4 * h), hi = *(const LAS s16x4*)(img + row * LD + 16 * ks + 8 + 4 * h);
    return __builtin_shufflevector(lo, hi, 0, 1, 2, 3, 4, 5, 6, 7);
}
__device__ __forceinline__ s16x4 tr4(const LAS bf16_t* p) { return __builtin_bit_cast(s16x4, __builtin_amdgcn_ds_read_tr16_b64_v4i16((LAS s16x4*)p)); }
__device__ __forceinline__ bf16x8 frag_tr(const LAS bf16_t* img, int LD, int m0, int ks, int lane) {
    const int i16 = lane & 15, q = i16 >> 2, p = i16 & 3, blk = (lane >> 4) & 1, h = lane >> 5;
    const LAS bf16_t* a = img + (16 * ks + 4 * h + q) * LD + m0 + 16 * blk + 4 * p;
    const s16x4 lo = tr4(a), hi = tr4(a + 8 * LD);
    return __builtin_shufflevector(lo, hi, 0, 1, 2, 3, 4, 5, 6, 7);
}
__device__ __forceinline__ bf16x8 pack_step(const f32x16& x, int s) {
    u32x4 p; p.x = cvtpk_s(x[8 * s + 0], x[8 * s + 1]); p.y = cvtpk_s(x[8 * s + 2], x[8 * s + 3]); p.z = cvtpk_s(x[8 * s + 4], x[8 * s + 5]); p.w = cvtpk_s(x[8 * s + 6], x[8 * s + 7]);
    return __builtin_bit_cast(bf16x8, p);
}
__device__ __forceinline__ void dn_halo_phase(const bf16_t* P, bf16_t* HALO, int G) {
    const int tid = opaque_tid();
    for (size_t e = (size_t)blockIdx.x * 512 + tid; e < (size_t)520 * 4 * 512; e += (size_t)G * 512) {
        const int c = (int)(e & 511), j = (int)((e >> 9) & 3), rb = (int)(e >> 11);
        const int row = rb * 64 + (j < 2 ? j : 60 + j);
        ((u32x4*)(HALO + ((size_t)rb * 4 + j) * 4096))[c] = ((const u32x4*)(P + (size_t)row * 4096))[c];
    }
}
__device__ __forceinline__ void unpack8(const u32x4 v, float (&f)[8]) { f[0] = bf_lo(v.x); f[1] = bf_hi(v.x); f[2] = bf_lo(v.y); f[3] = bf_hi(v.y); f[4] = bf_lo(v.z); f[5] = bf_hi(v.z); f[6] = bf_lo(v.w); f[7] = bf_hi(v.w); }
__device__ __forceinline__ void dn_conv_phase(bf16_t* P, const bf16_t* HALO, const float* conv_w, int G) {
    const int tid = opaque_tid(), col0 = 8 * tid;
    float cw[8][5];
#pragma unroll
    for (int c = 0; c < 8; ++c)
#pragma unroll
        for (int tap = 0; tap < 5; ++tap) cw[c][tap] = conv_w[(size_t)(col0 + c) * 5 + tap];
    const int kind = col0 < 1024 ? 0 : (col0 < 2048 ? 1 : 2);
    for (int rb = blockIdx.x; rb < 520; rb += G) {
        const int cs = rb < 512 ? (rb & 255) : ((rb - 512) & 3); const bool sfirst = cs == 0, slast = rb < 512 ? cs == 255 : cs == 3;
        const u32x4 zero = (u32x4){0u, 0u, 0u, 0u};
        bf16_t* base = P + (size_t)rb * 64 * 4096 + col0;
        u32x4 w0 = sfirst ? zero : *(const u32x4*)(HALO + ((size_t)(rb - 1) * 4 + 2) * 4096 + col0);
        u32x4 w1 = sfirst ? zero : *(const u32x4*)(HALO + ((size_t)(rb - 1) * 4 + 3) * 4096 + col0);
        u32x4 w2 = *(const u32x4*)(base), w3 = *(const u32x4*)(base + 4096);
#pragma unroll 4
        for (int rr = 0; rr < 64; ++rr) {
            u32x4 w4;
            if (rr + 2 < 64) w4 = *(const u32x4*)(base + (size_t)(rr + 2) * 4096);
            else w4 = slast ? zero : *(const u32x4*)(HALO + ((size_t)(rb + 1) * 4 + (rr + 2 - 64)) * 4096 + col0);
            float x0[8], x1[8], x2[8], x3[8], x4[8], y[8];
            unpack8(w0, x0); unpack8(w1, x1); unpack8(w2, x2); unpack8(w3, x3); unpack8(w4, x4);
            float ss = 0.f;
#pragma unroll
            for (int c = 0; c < 8; ++c) { const float a = x0[c] * cw[c][0] + x1[c] * cw[c][1] + x2[c] * cw[c][2] + x3[c] * cw[c][3] + x4[c] * cw[c][4]; y[c] = silu_f(a); ss += y[c] * y[c]; }
            float sc = 1.f;
            if (kind < 2) { ss += __shfl_xor(ss, 1); ss += __shfl_xor(ss, 2); ss += __shfl_xor(ss, 4); ss += __shfl_xor(ss, 8); sc = rsqrtf(ss + EPS) * (kind == 0 ? 0.08838834764831845f : 1.f); }
            u32x4 o; o.x = cvtpk_s(y[0] * sc, y[1] * sc); o.y = cvtpk_s(y[2] * sc, y[3] * sc); o.z = cvtpk_s(y[4] * sc, y[5] * sc); o.w = cvtpk_s(y[6] * sc, y[7] * sc);
            *(u32x4*)(base + (size_t)rr * 4096) = o;
            w0 = w1; w1 = w2; w2 = w3; w3 = w4;
        }
    }
}
constexpr int DT_KB = 0, DT_R = 17408, DT_SC = 33792, DT_DIR = 34816;
template <int W> __device__ __forceinline__ void dn_solve(const LAS float* Mf, float (&t)[16], int lane) {
    const int j = 16 * W + (lane >> 2), q = lane & 3;
#pragma unroll
    for (int s = 0; s < 16; ++s) t[s] = 0.f;
#pragma unroll
    for (int i = 16 * W; i < 64; ++i) {
        float acc = 0.f;
#pragma unroll
        for (int s = 4 * W; s <= (i - 1) / 4 && i > 16 * W; ++s) acc += Mf[i * 64 + 4 * s + q] * t[s];
        acc += __shfl_xor(acc, 1); acc += __shfl_xor(acc, 2);
        const float val = (i == j ? 1.f : 0.f) - acc;
        if (q == (i & 3)) t[i >> 2] = val;
        asm volatile("" : "+v"(t[0]), "+v"(t[1]), "+v"(t[2]), "+v"(t[3]), "+v"(t[4]), "+v"(t[5]), "+v"(t[6]), "+v"(t[7]), "+v"(t[8]), "+v"(t[9]), "+v"(t[10]), "+v"(t[11]), "+v"(t[12]), "+v"(t[13]), "+v"(t[14]), "+v"(t[15]));
    }
}
__device__ __forceinline__ void dn_t_phase(LAS unsigned char* lds, const bf16_t* P, float* AB, bf16_t* TP, const float* a_log, const float* dt_bias, int G) {
    const int tid0 = opaque_tid(), hb = __builtin_amdgcn_readfirstlane(tid0 >> 8);
    for (int itb = blockIdx.x * 2; itb < 16640; itb += 2 * G) {
        const int it = itb + hb, dir = it & 1, vh = (it >> 1) & 15, rb = it >> 5, kh = vh >> 1;
        const int tq = opaque_tid(), t = tq & 255, w = __builtin_amdgcn_readfirstlane((tq >> 6) & 3), lane = tq & 63, r = lane & 31, h = lane >> 5;
        LAS unsigned char* base = lds + hb * DT_DIR;
        LAS bf16_t* Kb = (LAS bf16_t*)(base + DT_KB); LAS float* Mf = (LAS float*)(base + DT_R); LAS bf16_t* Tb = (LAS bf16_t*)(base + DT_R);
        LAS float* sc_beta = (LAS float*)(base + DT_SC); LAS float* sc_gc = sc_beta + 64;
        {
            const int r0 = t >> 4, c8 = 8 * (t & 15);
#pragma unroll
            for (int v = 0; v < 4; ++v) { const int i = r0 + 16 * v, ip = dir ? 63 - i : i;
                *(LAS u32x4*)(Kb + ip * 136 + c8) = *(const u32x4*)(P + (size_t)(rb * 64 + i) * 4096 + 1024 + kh * 128 + c8); }
            if (t < 64) {
                const int ti = dir ? 63 - t : t; float* ab = AB + (size_t)(rb * 64 + ti) * 64;
                const float av = ab[dir * 16 + vh], bv = ab[32 + dir * 16 + vh];
                const float g = -__expf(a_log[dir * 16 + vh]) * softplus_f(av + dt_bias[dir * 16 + vh]), beta = 1.f / (1.f + __expf(-bv));
                float gc = g;
#pragma unroll
                for (int o = 1; o < 64; o <<= 1) { const float up = __shfl_up(gc, o); if (t >= o) gc += up; }
                sc_beta[t] = beta; sc_gc[t] = gc;
                ab[dir * 16 + vh] = gc; ab[32 + dir * 16 + vh] = beta;
            }
        }
        __syncthreads();
        const int ti = w >> 1, tj = w & 1;
        {
            f32x16 acc;
#pragma unroll
            for (int x = 0; x < 16; ++x) acc[x] = 0.f;
            if (!(ti == 0 && tj == 1)) {
#pragma unroll
                for (int ks = 0; ks < 8; ++ks) acc = MFMA32(frag_nat(Kb, 136, 32 * ti + r, ks, h), frag_nat(Kb, 136, 32 * tj + r, ks, h), acc);
            }
            const int j = 32 * tj + r; const float gj = sc_gc[j];
#pragma unroll
            for (int x = 0; x < 16; ++x) { const int i = 32 * ti + crow(x, h);
                Mf[i * 64 + j] = (i > j) ? sc_beta[i] * acc[x] * __expf(sc_gc[i] - gj) : 0.f; }
        }
        __syncthreads();
        float tc[16];
        if (w == 0) dn_solve<0>(Mf, tc, lane); else if (w == 1) dn_solve<1>(Mf, tc, lane); else if (w == 2) dn_solve<2>(Mf, tc, lane); else dn_solve<3>(Mf, tc, lane);
        __syncthreads();
        {
            const int j = 16 * w + (lane >> 2), q = lane & 3;
#pragma unroll
            for (int s = 0; s < 16; ++s) Tb[(4 * s + q) * 72 + j] = f2bf(tc[s]);
        }
        __syncthreads();
        {
            bf16_t* dst = TP + (size_t)it * 3072;
#pragma unroll
            for (int k2 = 0; k2 < 2; ++k2) { const int c = t + 256 * k2;
                if (c < 384) { const int blk = c >> 7, rowc = (c & 127) >> 2, cc = c & 3, br = blk ? 1 : 0, bc = blk == 2 ? 1 : 0;
                    *(u32x4*)(dst + c * 8) = *(const LAS u32x4*)(Tb + (32 * br + rowc) * 72 + 32 * bc + 8 * cc); } }
        }
        __syncthreads();
    }
}
constexpr int DN_KB = 0, DN_QB = 17408, DN_VB = 34816, DN_TB = 51200, DN_AB = 60416, DN_SC = 69632, DN_DIR = 71168;
__device__ __forceinline__ void dn_step_rb(int step, int dir, int b, int& rb, bool& first) {
    if (step < 4) { const int cidx = dir ? 3 - step : step; rb = 512 + b * 4 + cidx; first = step < 2; }
    else { const int c = step - 4; const int cidx = dir ? 255 - c : c; rb = b * 256 + cidx; first = c < 128; }
}
struct DnPre { u32x4 k4[4], q4[4], v4[4], t0, t1; float gc, beta; };
__device__ __forceinline__ void dn_prefetch(DnPre& p, const bf16_t* P, const float* AB, const bf16_t* TP, int rb, int dir, int vh, int kh, int t, int part) {
    const int r0 = t >> 4, c8 = 8 * (t & 15);
    const bf16_t* prow = P + (size_t)(rb * 64 + r0) * 4096 + c8;
    const bf16_t* tp = TP + (size_t)((rb * 16 + vh) * 2 + dir) * 3072;
    if (part & 1) {
#pragma unroll
        for (int v = 0; v < 4; ++v) { const bf16_t* pr = prow + (size_t)(16 * v) * 4096;
            p.k4[v] = *(const u32x4*)(pr + 1024 + kh * 128); p.q4[v] = *(const u32x4*)(pr + kh * 128); p.v4[v] = *(const u32x4*)(pr + 2048 + vh * 128); }
    }
    if (part & 2) {
        p.t0 = *(const u32x4*)(tp + t * 8); p.t1 = *(const u32x4*)(tp + (256 + (t & 127)) * 8);
        const int ti = dir ? 63 - (t & 63) : (t & 63); const float* ab = AB + (size_t)(rb * 64 + ti) * 64; p.gc = ab[dir * 16 + vh]; p.beta = ab[32 + dir * 16 + vh];
    }
}
template <int VAR> __device__ __forceinline__ void dn_scan(LAS unsigned char* lds, const bf16_t* P, const float* AB, const bf16_t* TP, bf16_t* OB) {
    const int tid = opaque_tid(), dir = __builtin_amdgcn_readfirstlane(tid >> 8);
    for (int unit = blockIdx.x; unit < 32; unit += gridDim.x) {
        const int b = unit >> 4, vh = unit & 15, kh = vh >> 1;
        f32x16 S[4];
#pragma unroll
        for (int kt = 0; kt < 4; ++kt)
#pragma unroll
            for (int x = 0; x < 16; ++x) S[kt][x] = 0.f;
        DnPre pre;
        { int rb0; bool f0; dn_step_rb(0, dir, b, rb0, f0); dn_prefetch(pre, P, AB, TP, rb0, dir, vh, kh, tid & 255, 3); }
        __syncthreads();
        for (int step = 0; step < 260; ++step) {
            const int w = __builtin_amdgcn_readfirstlane((opaque_tid() >> 6) & 3);
            LAS unsigned char* base = lds + dir * DN_DIR;
            LAS bf16_t* Kb = (LAS bf16_t*)(base + DN_KB); LAS bf16_t* Qb = (LAS bf16_t*)(base + DN_QB); LAS bf16_t* Vb = (LAS bf16_t*)(base + DN_VB);
            LAS bf16_t* Tb = (LAS bf16_t*)(base + DN_TB); LAS bf16_t* Ab = (LAS bf16_t*)(base + DN_AB);
            LAS float* sc_beta = (LAS float*)(base + DN_SC); LAS float* sc_gc = sc_beta + 64; LAS float* sc_eg = sc_beta + 128; LAS float* sc_tail = sc_beta + 192; LAS float* sc_dl = sc_beta + 256;
            int rb; bool first; dn_step_rb(step, dir, b, rb, first);
            const int row_base = rb * 64;
            {
                const int tq_ = opaque_tid(), t = tq_ & 255;
                const int r0 = t >> 4, c8 = 8 * (t & 15);
#pragma unroll
                for (int v = 0; v < 4; ++v) { const int i = r0 + 16 * v, ip = dir ? 63 - i : i;
                    *(LAS u32x4*)(Kb + ip * 136 + c8) = pre.k4[v]; *(LAS u32x4*)(Qb + ip * 136 + c8) = pre.q4[v]; *(LAS u32x4*)(Vb + ip * 128 + c8) = pre.v4[v]; }
                { const int c = t, blk = c >> 7, rowc = (c & 127) >> 2, cc = c & 3, br = blk ? 1 : 0; *(LAS u32x4*)(Tb + (32 * br + rowc) * 72 + 8 * cc) = pre.t0; }
                if (t < 128) { const int rowc = t >> 2, cc = t & 3; *(LAS u32x4*)(Tb + (32 + rowc) * 72 + 32 + 8 * cc) = pre.t1; }
                if (t < 64) { const float gc = pre.gc, gl = __shfl(gc, 63); sc_beta[t] = pre.beta; sc_gc[t] = gc; sc_eg[t] = __expf(gc); sc_tail[t] = __expf(gl - gc); if (t == 0) sc_dl[0] = __expf(gl); }
            }
            BAR_LDS();
            {
                const int tq_ = opaque_tid(), lane = tq_ & 63, r = lane & 31, h = lane >> 5;
                const int ti = w >> 1, tj = w & 1;
                if (!(ti == 0 && tj == 1)) {
                    f32x16 qk;
#pragma unroll
                    for (int x = 0; x < 16; ++x) qk[x] = 0.f;
#pragma unroll
                    for (int ks = 0; ks < 8; ++ks) qk = MFMA32(frag_nat(Qb, 136, 32 * ti + r, ks, h), frag_nat(Kb, 136, 32 * tj + r, ks, h), qk);
                    const int jj = 32 * tj + r; const float gj = sc_gc[jj];
#pragma unroll
                    for (int x = 0; x < 16; ++x) { const int i = 32 * ti + crow(x, h);
                        Ab[i * 72 + jj] = f2bf((i >= jj) ? qk[x] * __expf(sc_gc[i] - gj) : 0.f); }
                }
            }
            BAR_LDS();
            if (VAR != 2 && step + 1 < 260) { int rbn; bool fn; dn_step_rb(step + 1, dir, b, rbn, fn); dn_prefetch(pre, P, AB, TP, rbn, dir, vh, kh, opaque_tid() & 255, 1); }
            __builtin_amdgcn_sched_barrier(0);
            if (VAR != 1) {
                const int tq_ = opaque_tid(), lane = tq_ & 63, r = lane & 31, h = lane >> 5;
                f32x16 KS[2], QS[2];
#pragma unroll
                for (int mt = 0; mt < 2; ++mt)
#pragma unroll
                    for (int x = 0; x < 16; ++x) { KS[mt][x] = 0.f; QS[mt][x] = 0.f; }
#pragma unroll
                for (int ks = 0; ks < 8; ++ks) {
                    const bf16x8 sp = pack_step(S[ks >> 1], ks & 1);
#pragma unroll
                    for (int mt = 0; mt < 2; ++mt) { KS[mt] = MFMA32(frag_perm(Kb, 136, 32 * mt + r, ks, h), sp, KS[mt]); QS[mt] = MFMA32(frag_perm(Qb, 136, 32 * mt + r, ks, h), sp, QS[mt]); }
                    if (ks & 1) __builtin_amdgcn_sched_barrier(0);
                }
#pragma unroll
                for (int mt = 0; mt < 2; ++mt)
#pragma unroll
                    for (int x = 0; x < 16; ++x) { const int i = 32 * mt + crow(x, h);
                        KS[mt][x] = sc_beta[i] * (bf2f(Vb[i * 128 + 32 * w + r]) - sc_eg[i] * KS[mt][x]); }
                __builtin_amdgcn_sched_barrier(0);
                bf16x8 Xp[4];
#pragma unroll
                for (int ks = 0; ks < 4; ++ks) Xp[ks] = pack_step(KS[ks >> 1], ks & 1);
                f32x16 VN[2];
#pragma unroll
                for (int mt = 0; mt < 2; ++mt) {
#pragma unroll
                    for (int x = 0; x < 16; ++x) VN[mt][x] = 0.f;
#pragma unroll
                    for (int ks = 0; ks < 4; ++ks) if (ks < 2 * mt + 2) VN[mt] = MFMA32(frag_perm(Tb, 72, 32 * mt + r, ks, h), Xp[ks], VN[mt]);
                }
                __builtin_amdgcn_sched_barrier(0);
                if (VAR != 2 && step + 1 < 260) { int rbn; bool fn; dn_step_rb(step + 1, dir, b, rbn, fn); dn_prefetch(pre, P, AB, TP, rbn, dir, vh, kh, opaque_tid() & 255, 2); }
                __builtin_amdgcn_sched_barrier(0);
                bf16x8 VNp[4];
#pragma unroll
                for (int ks = 0; ks < 4; ++ks) VNp[ks] = pack_step(VN[ks >> 1], ks & 1);
#pragma unroll
                for (int mt = 0; mt < 2; ++mt) {
#pragma unroll
                    for (int x = 0; x < 16; ++x) QS[mt][x] *= sc_eg[32 * mt + crow(x, h)];
#pragma unroll
                    for (int ks = 0; ks < 4; ++ks) if (ks < 2 * mt + 2) QS[mt] = MFMA32(frag_perm(Ab, 72, 32 * mt + r, ks, h), VNp[ks], QS[mt]);
                }
                __builtin_amdgcn_sched_barrier(0);
#pragma unroll
                for (int mt = 0; mt < 2; ++mt)
#pragma unroll
                    for (int x = 0; x < 16; ++x) Vb[(32 * mt + crow(x, h)) * 128 + 32 * w + r] = f2bf(QS[mt][x]);
                __builtin_amdgcn_sched_barrier(0);
#pragma unroll
                for (int mt = 0; mt < 2; ++mt)
#pragma unroll
                    for (int x = 0; x < 16; ++x) VN[mt][x] *= sc_tail[32 * mt + crow(x, h)];
#pragma unroll
                for (int ks = 0; ks < 4; ++ks) VNp[ks] = pack_step(VN[ks >> 1], ks & 1);
                __builtin_amdgcn_sched_barrier(0);
                const float dl = sc_dl[0];
#pragma unroll
                for (int kt = 0; kt < 4; ++kt)
#pragma unroll
                    for (int x = 0; x < 16; ++x) S[kt][x] *= dl;
#pragma unroll
                for (int ks = 0; ks < 4; ++ks) {
#pragma unroll
                    for (int kt = 0; kt < 4; ++kt) S[kt] = MFMA32(frag_tr(Kb, 136, 32 * kt, ks, lane), VNp[ks], S[kt]);
                    __builtin_amdgcn_sched_barrier(0);
                }
                if (VAR != 2) {
                    const int rr_ = lane >> 2, c8_ = 8 * (lane & 3);
#pragma unroll
                    for (int v = 0; v < 4; ++v) { const int ip_ = rr_ + 16 * v, i_ = dir ? 63 - ip_ : ip_;
                        u32x4* gp_ = (u32x4*)(OB + (size_t)(row_base + i_) * 2048 + vh * 128 + 32 * w + c8_);
                        u32x4 o = *(const LAS u32x4*)(Vb + ip_ * 128 + 32 * w + c8_);
                        if (!first) { const u32x4 e = gp_[0];
                            o.x = cvtpk_s(bf_lo(o.x) + bf_lo(e.x), bf_hi(o.x) + bf_hi(e.x)); o.y = cvtpk_s(bf_lo(o.y) + bf_lo(e.y), bf_hi(o.y) + bf_hi(e.y));
                            o.z = cvtpk_s(bf_lo(o.z) + bf_lo(e.z), bf_hi(o.z) + bf_hi(e.z)); o.w = cvtpk_s(bf_lo(o.w) + bf_lo(e.w), bf_hi(o.w) + bf_hi(e.w)); }
                        gp_[0] = o; }
                }
            }
            if (step == 1 || step == 131) asm volatile("s_waitcnt vmcnt(0)" ::: "memory");
            BAR_LDS();
        }
    }
}
constexpr int GP_QM = 0, GP_KM = 17408, GP_AB = 34816, GP_LOW = 44032, GP_TOT = 48128, GP_DIR = 49152;
__device__ __forceinline__ void gla_prep_phase(LAS unsigned char* lds, const bf16_t* P, const float* LOW, const float* gw2, const float* gb2, bf16_t* QM, bf16_t* KM, bf16_t* AQ, float* EL, int G) {
    const int tid0 = opaque_tid(), hb = __builtin_amdgcn_readfirstlane(tid0 >> 8);
    for (int itb = blockIdx.x * 2; itb < 4160; itb += 2 * G) {
        const int it = itb + hb, dir = it & 1, head = (it >> 1) & 3, rb = it >> 3;
        const int tq = opaque_tid(), t = tq & 255, w = __builtin_amdgcn_readfirstlane((tq >> 6) & 3), lane = tq & 63, r = lane & 31, h = lane >> 5;
        LAS unsigned char* base = lds + hb * GP_DIR;
        LAS bf16_t* Qm = (LAS bf16_t*)(base + GP_QM); LAS bf16_t* Km = (LAS bf16_t*)(base + GP_KM); LAS bf16_t* Ab = (LAS bf16_t*)(base + GP_AB);
        LAS float* lowS = (LAS float*)(base + GP_LOW); LAS float* tot = (LAS float*)(base + GP_TOT);
        *(LAS f32x4*)(lowS + 4 * t) = *(const f32x4*)(LOW + (size_t)(rb * 64 + (t >> 2)) * 32 + dir * 16 + 4 * (t & 3));
        const int dk = t & 127, half = t >> 7, col = head * 128 + dk;
        float w2c[16];
#pragma unroll
        for (int rr = 0; rr < 16; ++rr) w2c[rr] = gw2[(size_t)(dir * 16 + rr) * 512 + col];
        const float b2 = gb2[dir * 512 + col];
        __syncthreads();
        float bc[32]; float run = 0.f;
#pragma unroll
        for (int n = 0; n < 32; ++n) { const int ip = 32 * half + n, i = dir ? 63 - ip : ip; float s = b2;
#pragma unroll
            for (int rr = 0; rr < 16; ++rr) s += lowS[i * 16 + rr] * w2c[rr];
            run += logsigmoid_f(s) * (1.f / 16.f); bc[n] = run; }
        tot[half * 128 + dk] = run;
        __syncthreads();
        const float t0 = tot[dk], last = t0 + tot[128 + dk], off = half ? t0 : 0.f;
        if (half == 0) EL[(size_t)(dir * 520 + rb) * 512 + col] = last;
        {
            const int i0 = dir ? 63 - 32 * half : 32 * half; const long pstep = dir ? -3072 : 3072;
            const bf16_t* pp = P + (size_t)(rb * 64 + i0) * 3072 + col;
#pragma unroll
            for (int n = 0; n < 32; ++n) { const int ip = 32 * half + n; const float bcv = bc[n] + off;
                const float qv = bf2f(pp[0]), kv = bf2f(pp[512]); pp += pstep;
                Qm[ip * 136 + dk] = f2bf(qv * 0.08838834764831845f * __expf(bcv - last));
                Km[ip * 136 + dk] = f2bf(kv * __expf(last - bcv)); }
        }
        __syncthreads();
        {
            const int ti = w >> 1, tj = w & 1;
            f32x16 acc;
#pragma unroll
            for (int x = 0; x < 16; ++x) acc[x] = 0.f;
            if (!(ti == 0 && tj == 1)) {
#pragma unroll
                for (int ks = 0; ks < 8; ++ks) acc = MFMA32(frag_nat(Qm, 136, 32 * ti + r, ks, h), frag_nat(Km, 136, 32 * tj + r, ks, h), acc);
            }
            const int j = 32 * tj + r;
#pragma unroll
            for (int x = 0; x < 16; ++x) { const int i = 32 * ti + crow(x, h); Ab[i * 72 + j] = f2bf(i >= j ? acc[x] : 0.f); }
            const int r0 = t >> 4, c8 = 8 * (t & 15);
#pragma unroll
            for (int v = 0; v < 4; ++v) { const int row = r0 + 16 * v; const size_t go = ((size_t)dir * MROWS + rb * 64 + row) * 512 + head * 128 + c8;
                *(u32x4*)(QM + go) = *(const LAS u32x4*)(Qm + row * 136 + c8); *(u32x4*)(KM + go) = *(const LAS u32x4*)(Km + row * 136 + c8); }
        }
        __syncthreads();
        {
            bf16_t* dst = AQ + (size_t)it * 4096;
#pragma unroll
            for (int k2 = 0; k2 < 2; ++k2) { const int c = t + 256 * k2, row = c >> 3, cc = c & 7; *(u32x4*)(dst + c * 8) = *(const LAS u32x4*)(Ab + row * 72 + 8 * cc); }
        }
        __syncthreads();
    }
}
constexpr int GL_QM = 0, GL_KM = 17408, GL_VB = 34816, GL_AB = 52224, GL_EL = 61440, GL_DIR = 61952;
struct GlPre { u32x4 q4[4], k4[4], v4[4], a0, a1; float elv; };
__device__ __forceinline__ void gl_prefetch(GlPre& p, const bf16_t* P, const bf16_t* QM, const bf16_t* KM, const bf16_t* AQ, const float* EL, int rb, int dir, int head, int hf, int t) {
    const int r0 = t >> 4, c8 = 8 * (t & 15);
    const bf16_t* aq = AQ + (size_t)((rb * 4 + head) * 2 + dir) * 4096;
#pragma unroll
    for (int v = 0; v < 4; ++v) { const size_t row = (size_t)(rb * 64 + r0 + 16 * v);
        p.q4[v] = *(const u32x4*)(QM + ((size_t)dir * MROWS + row) * 512 + head * 128 + c8);
        p.k4[v] = *(const u32x4*)(KM + ((size_t)dir * MROWS + row) * 512 + head * 128 + c8);
        p.v4[v] = *(const u32x4*)(P + row * 3072 + 1024 + head * 256 + hf * 128 + c8); }
    p.a0 = *(const u32x4*)(aq + t * 8); p.a1 = *(const u32x4*)(aq + (256 + t) * 8);
    p.elv = EL[(size_t)(dir * 520 + rb) * 512 + head * 128 + (t & 127)];
}
__device__ __forceinline__ void gla_scan(LAS unsigned char* lds, const bf16_t* P  , const bf16_t* QM, const bf16_t* KM, const bf16_t* AQ, const float* EL, bf16_t* OB  ) {
    const int tid = opaque_tid(), dir = __builtin_amdgcn_readfirstlane(tid >> 8);
    for (int unit = blockIdx.x; unit < 16; unit += gridDim.x) {
        const int b = unit >> 3, head = (unit >> 1) & 3, hf = unit & 1;
        f32x16 S[4];
#pragma unroll
        for (int kt = 0; kt < 4; ++kt)
#pragma unroll
            for (int x = 0; x < 16; ++x) S[kt][x] = 0.f;
        GlPre pre;
        { int rb0; bool f0; dn_step_rb(0, dir, b, rb0, f0); gl_prefetch(pre, P, QM, KM, AQ, EL, rb0, dir, head, hf, tid & 255); }
        __syncthreads();
        for (int step = 0; step < 260; ++step) {
            const int w = __builtin_amdgcn_readfirstlane((opaque_tid() >> 6) & 3);
            LAS unsigned char* base = lds + dir * GL_DIR;
            LAS bf16_t* Qm = (LAS bf16_t*)(base + GL_QM); LAS bf16_t* Km = (LAS bf16_t*)(base + GL_KM); LAS bf16_t* Vb = (LAS bf16_t*)(base + GL_VB); LAS bf16_t* Ab = (LAS bf16_t*)(base + GL_AB);
            LAS float* el = (LAS float*)(base + GL_EL);
            int rb; bool first; dn_step_rb(step, dir, b, rb, first);
            const int row_base = rb * 64;
            {
                const int tq_ = opaque_tid(), t = tq_ & 255;
                const int r0 = t >> 4, c8 = 8 * (t & 15);
#pragma unroll
                for (int v = 0; v < 4; ++v) { const int i = r0 + 16 * v, ip = dir ? 63 - i : i;
                    *(LAS u32x4*)(Qm + i * 136 + c8) = pre.q4[v]; *(LAS u32x4*)(Km + i * 136 + c8) = pre.k4[v]; *(LAS u32x4*)(Vb + ip * 136 + c8) = pre.v4[v]; }
                { const int c = t, row = c >> 3, cc = c & 7; *(LAS u32x4*)(Ab + row * 72 + 8 * cc) = pre.a0; }
                { const int c = 256 + t, row = c >> 3, cc = c & 7; *(LAS u32x4*)(Ab + row * 72 + 8 * cc) = pre.a1; }
                if (t < 128) el[t] = __expf(pre.elv);
            }
            BAR_LDS();
            if (step + 1 < 260) { int rbn; bool fn; dn_step_rb(step + 1, dir, b, rbn, fn); gl_prefetch(pre, P, QM, KM, AQ, EL, rbn, dir, head, hf, opaque_tid() & 255); }
            __builtin_amdgcn_sched_barrier(0);
            {
                const int tq_ = opaque_tid(), lane = tq_ & 63, r = lane & 31, h = lane >> 5;
#pragma unroll
                for (int kt = 0; kt < 4; ++kt)
#pragma unroll
                    for (int x = 0; x < 16; ++x) S[kt][x] *= el[32 * kt + crow(x, h)];
                bf16x8 Vf[4];
#pragma unroll
                for (int ks = 0; ks < 4; ++ks) Vf[ks] = frag_tr(Vb, 136, 32 * w, ks, lane);
                u32x4 eo[4];
                {
                    const int rr_ = lane >> 2, c8_ = 8 * (lane & 3);
                    if (!first) {
#pragma unroll
                        for (int v = 0; v < 4; ++v) { const int ip_ = rr_ + 16 * v, i_ = dir ? 63 - ip_ : ip_;
                            eo[v] = *(const u32x4*)(OB + (size_t)(row_base + i_) * 1024 + head * 256 + hf * 128 + 32 * w + c8_); }
                    } else {
                        unsigned z0 = 0u; asm volatile("" : "+v"(z0));
#pragma unroll
                        for (int v = 0; v < 4; ++v) eo[v] = (u32x4){z0, z0, z0, z0};
                    }
                }
                f32x16 O[2];
#pragma unroll
                for (int mt = 0; mt < 2; ++mt) {
#pragma unroll
                    for (int x = 0; x < 16; ++x) O[mt][x] = 0.f;
#pragma unroll
                    for (int ks = 0; ks < 4; ++ks) if (ks < 2 * mt + 2) O[mt] = MFMA32(frag_perm(Ab, 72, 32 * mt + r, ks, h), Vf[ks], O[mt]);
                }
                __builtin_amdgcn_sched_barrier(0);
#pragma unroll
                for (int ks = 0; ks < 8; ++ks) {
                    const bf16x8 sp = pack_step(S[ks >> 1], ks & 1);
#pragma unroll
                    for (int mt = 0; mt < 2; ++mt) O[mt] = MFMA32(frag_perm(Qm, 136, 32 * mt + r, ks, h), sp, O[mt]);
                    if (ks & 1) __builtin_amdgcn_sched_barrier(0);
                }
#pragma unroll
                for (int mt = 0; mt < 2; ++mt)
#pragma unroll
                    for (int x = 0; x < 16; ++x) Vb[(32 * mt + crow(x, h)) * 136 + 32 * w + r] = f2bf(O[mt][x]);
                __builtin_amdgcn_sched_barrier(0);
#pragma unroll
                for (int ks = 0; ks < 4; ++ks) {
#pragma unroll
                    for (int kt = 0; kt < 4; ++kt) S[kt] = MFMA32(frag_tr(Km, 136, 32 * kt, ks, lane), Vf[ks], S[kt]);
                    __builtin_amdgcn_sched_barrier(0);
                }
                {
                    const int rr_ = lane >> 2, c8_ = 8 * (lane & 3);
#pragma unroll
                    for (int v = 0; v < 4; ++v) { const int ip_ = rr_ + 16 * v, i_ = dir ? 63 - ip_ : ip_;
                        u32x4* gp_ = (u32x4*)(OB + (size_t)(row_base + i_) * 1024 + head * 256 + hf * 128 + 32 * w + c8_);
                        u32x4 o = *(const LAS u32x4*)(Vb + ip_ * 136 + 32 * w + c8_); const u32x4 e = eo[v];
                        if (!first) {
                            o.x = cvtpk_s(bf_lo(o.x) + bf_lo(e.x), bf_hi(o.x) + bf_hi(e.x)); o.y = cvtpk_s(bf_lo(o.y) + bf_lo(e.y), bf_hi(o.y) + bf_hi(e.y));
                            o.z = cvtpk_s(bf_lo(o.z) + bf_lo(e.z), bf_hi(o.z) + bf_hi(e.z)); o.w = cvtpk_s(bf_lo(o.w) + bf_lo(e.w), bf_hi(o.w) + bf_hi(e.w)); }
                        gp_[0] = o; }
                }
            }
            if (step == 1 || step == 131) asm volatile("s_waitcnt vmcnt(0)" ::: "memory");
            BAR_LDS();
        }
    }
}
typedef __bf16 v2bf_t __attribute__((ext_vector_type(2)));
__device__ __forceinline__ void atomic_add_bf16x8(bf16_t* p, const u32x4 v) {
    asm volatile("global_atomic_pk_add_bf16 %0, %1, off sc1\n\tglobal_atomic_pk_add_bf16 %0, %2, off offset:4 sc1\n\tglobal_atomic_pk_add_bf16 %0, %3, off offset:8 sc1\n\tglobal_atomic_pk_add_bf16 %0, %4, off offset:12 sc1"
                 :: "v"(p), "v"(v.x), "v"(v.y), "v"(v.z), "v"(v.w) : "memory");
}
constexpr int DN3_HGC = 2 * DN_DIR;
template <int VAR> __device__ __forceinline__ void dn_scan3(LAS unsigned char* lds, const bf16_t* P, const float* AB, const bf16_t* TP, bf16_t* OB) {
    const int tid0 = opaque_tid(), wv = __builtin_amdgcn_readfirstlane(tid0 >> 6), role = wv >> 2, w = wv & 3;
    for (int unit = blockIdx.x; unit < 64; unit += gridDim.x) {
        const int b = unit >> 5, vh = (unit >> 1) & 15, dir = unit & 1, kh = vh >> 1;
        __syncthreads();
        if (role == 1) {
            if (w < 3) {
                const int qh = w >= 1 ? 1 : 0, khh = w == 2 ? 1 : 0, ti = qh, tj = khh;
                u32x4 q8[8], k8[8]; float gcp;
                {
                    int rb; bool f_; dn_step_rb(0, dir, b, rb, f_);
                    const int lane = opaque_tid() & 63, r0 = lane >> 4, c8 = 8 * (lane & 15);
#pragma unroll
                    for (int v = 0; v < 8; ++v) { const int ipq = 32 * qh + r0 + 4 * v, ipk = 32 * khh + r0 + 4 * v, iq = dir ? 63 - ipq : ipq, ik = dir ? 63 - ipk : ipk;
                        q8[v] = *(const u32x4*)(P + (size_t)(rb * 64 + iq) * 4096 + kh * 128 + c8); k8[v] = *(const u32x4*)(P + (size_t)(rb * 64 + ik) * 4096 + 1024 + kh * 128 + c8); }
                    const int tl = dir ? 63 - lane : lane; gcp = AB[(size_t)(rb * 64 + tl) * 64 + dir * 16 + vh];
                }
                for (int j = 0; j < 260; ++j) {
                    const int lane = opaque_tid() & 63, r = lane & 31, h = lane >> 5, r0 = lane >> 4, c8 = 8 * (lane & 15);
                    LAS unsigned char* base = lds + (j & 1) * DN_DIR;
                    LAS bf16_t* Kb = (LAS bf16_t*)(base + DN_KB); LAS bf16_t* Qb = (LAS bf16_t*)(base + DN_QB); LAS bf16_t* Ab = (LAS bf16_t*)(base + DN_AB);
                    LAS float* hgc = (LAS float*)(lds + DN3_HGC + w * 256);
#pragma unroll
                    for (int v = 0; v < 8; ++v) { *(LAS u32x4*)(Qb + (32 * qh + r0 + 4 * v) * 136 + c8) = q8[v]; *(LAS u32x4*)(Kb + (32 * khh + r0 + 4 * v) * 136 + c8) = k8[v]; }
                    hgc[lane] = gcp;
                    asm volatile("s_waitcnt lgkmcnt(0)" ::: "memory");
                    if (j + 1 < 260) {
                        int rb; bool f_; dn_step_rb(j + 1, dir, b, rb, f_);
#pragma unroll
                        for (int v = 0; v < 8; ++v) { const int ipq = 32 * qh + r0 + 4 * v, ipk = 32 * khh + r0 + 4 * v, iq = dir ? 63 - ipq : ipq, ik = dir ? 63 - ipk : ipk;
                            q8[v] = *(const u32x4*)(P + (size_t)(rb * 64 + iq) * 4096 + kh * 128 + c8); k8[v] = *(const u32x4*)(P + (size_t)(rb * 64 + ik) * 4096 + 1024 + kh * 128 + c8); }
                        const int tl = dir ? 63 - lane : lane; gcp = AB[(size_t)(rb * 64 + tl) * 64 + dir * 16 + vh];
                    }
                    __builtin_amdgcn_sched_barrier(0);
                    {
                        f32x16 qk;
#pragma unroll
                        for (int x = 0; x < 16; ++x) qk[x] = 0.f;
#pragma unroll
                        for (int ks = 0; ks < 8; ++ks) qk = MFMA32(frag_nat(Qb, 136, 32 * ti + r, ks, h), frag_nat(Kb, 136, 32 * tj + r, ks, h), qk);
                        const int jj = 32 * tj + r; const float gj = hgc[jj];
#pragma unroll
                        for (int x = 0; x < 16; ++x) { const int i = 32 * ti + crow(x, h);
                            Ab[i * 72 + jj] = f2bf((i >= jj) ? qk[x] * __expf(hgc[i] - gj) : 0.f); }
                    }
                    BAR_LDS();
                }
                BAR_LDS();
            } else {
                u32x4 v16[16], t6[6]; float gcp, betap;
                {
                    int rb; bool f_; dn_step_rb(0, dir, b, rb, f_);
                    const int lane = opaque_tid() & 63, r0 = lane >> 4, c8 = 8 * (lane & 15);
#pragma unroll
                    for (int v = 0; v < 16; ++v) { const int ip = r0 + 4 * v, i = dir ? 63 - ip : ip; v16[v] = *(const u32x4*)(P + (size_t)(rb * 64 + i) * 4096 + 2048 + vh * 128 + c8); }
                    const bf16_t* tp = TP + (size_t)((rb * 16 + vh) * 2 + dir) * 3072;
#pragma unroll
                    for (int v = 0; v < 6; ++v) t6[v] = *(const u32x4*)(tp + (lane + 64 * v) * 8);
                    const int tl = dir ? 63 - lane : lane; const float* ab = AB + (size_t)(rb * 64 + tl) * 64; gcp = ab[dir * 16 + vh]; betap = ab[32 + dir * 16 + vh];
                }
                for (int j = 0; j < 260; ++j) {
                    const int lane = opaque_tid() & 63, r0 = lane >> 4, c8 = 8 * (lane & 15);
                    LAS unsigned char* base = lds + (j & 1) * DN_DIR;
                    LAS bf16_t* Vb = (LAS bf16_t*)(base + DN_VB); LAS bf16_t* Tb = (LAS bf16_t*)(base + DN_TB);
                    LAS float* sc_beta = (LAS float*)(base + DN_SC); LAS float* sc_gc = sc_beta + 64; LAS float* sc_eg = sc_beta + 128; LAS float* sc_tail = sc_beta + 192; LAS float* sc_dl = sc_beta + 256;
#pragma unroll
                    for (int v = 0; v < 16; ++v) *(LAS u32x4*)(Vb + (r0 + 4 * v) * 128 + c8) = v16[v];
#pragma unroll
                    for (int v = 0; v < 6; ++v) { const int c = lane + 64 * v, blk = c >> 7, rowc = (c & 127) >> 2, cc = c & 3, br = blk ? 1 : 0, bc = blk == 2 ? 1 : 0;
                        *(LAS u32x4*)(Tb + (32 * br + rowc) * 72 + 32 * bc + 8 * cc) = t6[v]; }
                    { const float gc = gcp, gl = __shfl(gc, 63); sc_beta[lane] = betap; sc_gc[lane] = gc; sc_eg[lane] = __expf(gc); sc_tail[lane] = __expf(gl - gc); if (lane == 0) sc_dl[0] = __expf(gl); }
                    if (j + 1 < 260) {
                        int rb; bool f_; dn_step_rb(j + 1, dir, b, rb, f_);
#pragma unroll
                        for (int v = 0; v < 16; ++v) { const int ip = r0 + 4 * v, i = dir ? 63 - ip : ip; v16[v] = *(const u32x4*)(P + (size_t)(rb * 64 + i) * 4096 + 2048 + vh * 128 + c8); }
                        const bf16_t* tp = TP + (size_t)((rb * 16 + vh) * 2 + dir) * 3072;
#pragma unroll
                        for (int v = 0; v < 6; ++v) t6[v] = *(const u32x4*)(tp + (lane + 64 * v) * 8);
                        const int tl = dir ? 63 - lane : lane; const float* ab = AB + (size_t)(rb * 64 + tl) * 64; gcp = ab[dir * 16 + vh]; betap = ab[32 + dir * 16 + vh];
                    }
                    BAR_LDS();
                }
                BAR_LDS();
            }
        } else {
            f32x16 S[4];
#pragma unroll
            for (int kt = 0; kt < 4; ++kt)
#pragma unroll
                for (int x = 0; x < 16; ++x) S[kt][x] = 0.f;
            BAR_LDS();
            for (int step = 0; step < 260; ++step) {
                const int lane = opaque_tid() & 63, r = lane & 31, h = lane >> 5;
                LAS unsigned char* base = lds + (step & 1) * DN_DIR;
                LAS bf16_t* Kb = (LAS bf16_t*)(base + DN_KB); LAS bf16_t* Qb = (LAS bf16_t*)(base + DN_QB); LAS bf16_t* Vb = (LAS bf16_t*)(base + DN_VB);
                LAS bf16_t* Tb = (LAS bf16_t*)(base + DN_TB); LAS bf16_t* Ab = (LAS bf16_t*)(base + DN_AB);
                LAS float* sc_beta = (LAS float*)(base + DN_SC); LAS float* sc_eg = sc_beta + 128; LAS float* sc_tail = sc_beta + 192; LAS float* sc_dl = sc_beta + 256;
                int rb; bool f_; dn_step_rb(step, dir, b, rb, f_);
                if (VAR != 2) {
                f32x16 KS[2], QS[2];
#pragma unroll
                for (int mt = 0; mt < 2; ++mt)
#pragma unroll
                    for (int x = 0; x < 16; ++x) { KS[mt][x] = 0.f; QS[mt][x] = 0.f; }
#pragma unroll
                for (int ks = 0; ks < 8; ++ks) {
                    const bf16x8 sp = pack_step(S[ks >> 1], ks & 1);
#pragma unroll
                    for (int mt = 0; mt < 2; ++mt) { KS[mt] = MFMA32(frag_perm(Kb, 136, 32 * mt + r, ks, h), sp, KS[mt]); QS[mt] = MFMA32(frag_perm(Qb, 136, 32 * mt + r, ks, h), sp, QS[mt]); }
                    if (ks & 1) __builtin_amdgcn_sched_barrier(0);
                }
#pragma unroll
                for (int mt = 0; mt < 2; ++mt)
#pragma unroll
                    for (int x = 0; x < 16; ++x) { const int i = 32 * mt + crow(x, h);
                        KS[mt][x] = sc_beta[i] * (bf2f(Vb[i * 128 + 32 * w + r]) - sc_eg[i] * KS[mt][x]); }
                __builtin_amdgcn_sched_barrier(0);
                bf16x8 Xp[4];
#pragma unroll
                for (int ks = 0; ks < 4; ++ks) Xp[ks] = pack_step(KS[ks >> 1], ks & 1);
                f32x16 VN[2];
#pragma unroll
                for (int mt = 0; mt < 2; ++mt) {
#pragma unroll
                    for (int x = 0; x < 16; ++x) VN[mt][x] = 0.f;
#pragma unroll
                    for (int ks = 0; ks < 4; ++ks) if (ks < 2 * mt + 2) VN[mt] = MFMA32(frag_perm(Tb, 72, 32 * mt + r, ks, h), Xp[ks], VN[mt]);
                }
                __builtin_amdgcn_sched_barrier(0);
                bf16x8 VNp[4];
#pragma unroll
                for (int ks = 0; ks < 4; ++ks) VNp[ks] = pack_step(VN[ks >> 1], ks & 1);
#pragma unroll
                for (int mt = 0; mt < 2; ++mt) {
#pragma unroll
                    for (int x = 0; x < 16; ++x) QS[mt][x] *= sc_eg[32 * mt + crow(x, h)];
#pragma unroll
                    for (int ks = 0; ks < 4; ++ks) if (ks < 2 * mt + 2) QS[mt] = MFMA32(frag_perm(Ab, 72, 32 * mt + r, ks, h), VNp[ks], QS[mt]);
                }
                __builtin_amdgcn_sched_barrier(0);
#pragma unroll
                for (int mt = 0; mt < 2; ++mt)
#pragma unroll
                    for (int x = 0; x < 16; ++x) Vb[(32 * mt + crow(x, h)) * 128 + 32 * w + r] = f2bf(QS[mt][x]);
                __builtin_amdgcn_sched_barrier(0);
#pragma unroll
                for (int mt = 0; mt < 2; ++mt)
#pragma unroll
                    for (int x = 0; x < 16; ++x) VN[mt][x] *= sc_tail[32 * mt + crow(x, h)];
#pragma unroll
                for (int ks = 0; ks < 4; ++ks) VNp[ks] = pack_step(VN[ks >> 1], ks & 1);
                __builtin_amdgcn_sched_barrier(0);
                const float dl = sc_dl[0];
#pragma unroll
                for (int kt = 0; kt < 4; ++kt)
#pragma unroll
                    for (int x = 0; x < 16; ++x) S[kt][x] *= dl;
#pragma unroll
                for (int ks = 0; ks < 4; ++ks) {
#pragma unroll
                    for (int kt = 0; kt < 4; ++kt) S[kt] = MFMA32(frag_tr(Kb, 136, 32 * kt, ks, lane), VNp[ks], S[kt]);
                    __builtin_amdgcn_sched_barrier(0);
                }
                }
                asm volatile("s_waitcnt lgkmcnt(0)" ::: "memory");
                if (VAR == 0) {
                    const int rr_ = lane >> 2, c8_ = 8 * (lane & 3);
#pragma unroll
                    for (int v = 0; v < 4; ++v) { const int ip_ = rr_ + 16 * v, i_ = dir ? 63 - ip_ : ip_;
                        atomic_add_bf16x8(OB + (size_t)(rb * 64 + i_) * 2048 + vh * 128 + 32 * w + c8_, *(const LAS u32x4*)(Vb + ip_ * 128 + 32 * w + c8_)); }
                }
                BAR_LDS();
            }
        }
    }
}
__device__ __forceinline__ void gla_scan3(LAS unsigned char* lds, bf16_t* P  , const bf16_t* QM, const bf16_t* KM, const bf16_t* AQ, const float* EL, bf16_t* OB  ) {
    const int tid0 = opaque_tid(), wv = __builtin_amdgcn_readfirstlane(tid0 >> 6), role = wv >> 2, w = wv & 3;
    for (int unit = blockIdx.x; unit < 32; unit += gridDim.x) {
        const int b = unit >> 4, head = (unit >> 2) & 3, hf = (unit >> 1) & 1, dir = unit & 1;
        __syncthreads();
        if (role == 1) {
            GlPre pre;
            { int rb0; bool f0; dn_step_rb(0, dir, b, rb0, f0); gl_prefetch(pre, P, QM, KM, AQ, EL, rb0, dir, head, hf, opaque_tid() & 255); }
            for (int j = 0; j < 260; ++j) {
                const int t = opaque_tid() & 255;
                LAS unsigned char* base = lds + (j & 1) * GL_DIR;
                LAS bf16_t* Qm = (LAS bf16_t*)(base + GL_QM); LAS bf16_t* Km = (LAS bf16_t*)(base + GL_KM); LAS bf16_t* Vb = (LAS bf16_t*)(base + GL_VB); LAS bf16_t* Ab = (LAS bf16_t*)(base + GL_AB);
                LAS float* el = (LAS float*)(base + GL_EL);
                const int r0 = t >> 4, c8 = 8 * (t & 15);
#pragma unroll
                for (int v = 0; v < 4; ++v) { const int i = r0 + 16 * v, ip = dir ? 63 - i : i;
                    *(LAS u32x4*)(Qm + i * 136 + c8) = pre.q4[v]; *(LAS u32x4*)(Km + i * 136 + c8) = pre.k4[v]; *(LAS u32x4*)(Vb + ip * 136 + c8) = pre.v4[v]; }
                { const int c = t, row = c >> 3, cc = c & 7; *(LAS u32x4*)(Ab + row * 72 + 8 * cc) = pre.a0; }
                { const int c = 256 + t, row = c >> 3, cc = c & 7; *(LAS u32x4*)(Ab + row * 72 + 8 * cc) = pre.a1; }
                if (t < 128) el[t] = __expf(pre.elv);
                if (j + 1 < 260) { int rbn; bool fn; dn_step_rb(j + 1, dir, b, rbn, fn); gl_prefetch(pre, P, QM, KM, AQ, EL, rbn, dir, head, hf, t); }
                BAR_LDS();
            }
            BAR_LDS();
        } else {
            f32x16 S[4];
#pragma unroll
            for (int kt = 0; kt < 4; ++kt)
#pragma unroll
                for (int x = 0; x < 16; ++x) S[kt][x] = 0.f;
            BAR_LDS();
            for (int step = 0; step < 260; ++step) {
                const int lane = opaque_tid() & 63, r = lane & 31, h = lane >> 5;
                LAS unsigned char* base = lds + (step & 1) * GL_DIR;
                LAS bf16_t* Qm = (LAS bf16_t*)(base + GL_QM); LAS bf16_t* Km = (LAS bf16_t*)(base + GL_KM); LAS bf16_t* Vb = (LAS bf16_t*)(base + GL_VB); LAS bf16_t* Ab = (LAS bf16_t*)(base + GL_AB);
                LAS float* el = (LAS float*)(base + GL_EL);
                int rb; bool f_; dn_step_rb(step, dir, b, rb, f_);
#pragma unroll
                for (int kt = 0; kt < 4; ++kt)
#pragma unroll
                    for (int x = 0; x < 16; ++x) S[kt][x] *= el[32 * kt + crow(x, h)];
                bf16x8 Vf[4];
#pragma unroll
                for (int ks = 0; ks < 4; ++ks) Vf[ks] = frag_tr(Vb, 136, 32 * w, ks, lane);
                f32x16 O[2];
#pragma unroll
                for (int mt = 0; mt < 2; ++mt) {
#pragma unroll
                    for (int x = 0; x < 16; ++x) O[mt][x] = 0.f;
#pragma unroll
                    for (int ks = 0; ks < 4; ++ks) if (ks < 2 * mt + 2) O[mt] = MFMA32(frag_perm(Ab, 72, 32 * mt + r, ks, h), Vf[ks], O[mt]);
                }
                __builtin_amdgcn_sched_barrier(0);
#pragma unroll
                for (int ks = 0; ks < 8; ++ks) {
                    const bf16x8 sp = pack_step(S[ks >> 1], ks & 1);
#pragma unroll
                    for (int mt = 0; mt < 2; ++mt) O[mt] = MFMA32(frag_perm(Qm, 136, 32 * mt + r, ks, h), sp, O[mt]);
                    if (ks & 1) __builtin_amdgcn_sched_barrier(0);
                }
#pragma unroll
                for (int mt = 0; mt < 2; ++mt)
#pragma unroll
                    for (int x = 0; x < 16; ++x) Vb[(32 * mt + crow(x, h)) * 136 + 32 * w + r] = f2bf(O[mt][x]);
                __builtin_amdgcn_sched_barrier(0);
#pragma unroll
                for (int ks = 0; ks < 4; ++ks) {
#pragma unroll
                    for (int kt = 0; kt < 4; ++kt) S[kt] = MFMA32(frag_tr(Km, 136, 32 * kt, ks, lane), Vf[ks], S[kt]);
                    __builtin_amdgcn_sched_barrier(0);
                }
                asm volatile("s_waitcnt lgkmcnt(0)" ::: "memory");
                {
                    const int rr_ = lane >> 2, c8_ = 8 * (lane & 3);
#pragma unroll
                    for (int v = 0; v < 4; ++v) { const int ip_ = rr_ + 16 * v, i_ = dir ? 63 - ip_ : ip_; const int oc_ = head * 256 + hf * 128 + 32 * w + c8_;
                        bf16_t* dst_ = dir ? P + (size_t)(rb * 64 + i_) * 3072 + oc_ : OB + (size_t)(rb * 64 + i_) * 1024 + oc_;
                        *(u32x4*)dst_ = *(const LAS u32x4*)(Vb + ip_ * 136 + 32 * w + c8_); }
                }
                BAR_LDS();
            }
        }
    }
}
#define XB_TMO      128
#define XB_XCNT(j)  (256  + 64 * (j))
#define XB_XSUB(j)  (1280 + 64 * (j))
#define XB_XGEN(j)  (2304 + 64 * (j))
#define XB_TOP      3328
#define XB_TOPGEN   3392
#define XCD_BAR_WORDS 3456
#define XB_SPIN_CAP (1u << 18)

__device__ __forceinline__ unsigned xb_ld(unsigned* p)              { return __hip_atomic_load(p, __ATOMIC_RELAXED, __HIP_MEMORY_SCOPE_AGENT); }
__device__ __forceinline__ unsigned xb_add(unsigned* p, unsigned v) { return __hip_atomic_fetch_add(p, v, __ATOMIC_RELAXED, __HIP_MEMORY_SCOPE_AGENT); }
__device__ __forceinline__ unsigned xb_xcc_id() { return (unsigned)__builtin_amdgcn_s_getreg((3 << 11) | 20) & 0xFu; }
#define XB_SPIN(cond, bar) do { unsigned _sp = 0; while (cond) { __builtin_amdgcn_s_sleep(1); \
    if ((++_sp & 255u) == 0u) { if (xb_ld(&(bar)[XB_TMO])) break; if (_sp > XB_SPIN_CAP) { atomicAdd(&(bar)[XB_TMO], 1u); break; } } } } while (0)

struct XcdBarrier {
    unsigned* bar; unsigned x;
    volatile LAS unsigned* st;
};

__device__ __forceinline__ XcdBarrier xcd_barrier_post(unsigned* bar, volatile LAS unsigned* st) {
    XcdBarrier b; b.bar = bar; b.x = xb_xcc_id(); b.st = st;
    if (threadIdx.x == 0) (void)xb_add(&bar[XB_XCNT(b.x)], 1u);
    return b;
}
__device__ __forceinline__ void xcd_barrier_complete(unsigned* bar, unsigned x, unsigned& nloc, unsigned& nx) {
    const unsigned G = gridDim.x * gridDim.y * gridDim.z;
    unsigned sum, cnt, mine, sp = 0u;
    for (;;) {
        sum = 0u; cnt = 0u; mine = 0u;
#pragma unroll
        for (unsigned j = 0; j < 16; ++j) { const unsigned c = xb_ld(&bar[XB_XCNT(j)]); sum += c; cnt += (c > 0u) ? 1u : 0u; mine = (j == x) ? c : mine; }
        if (sum == G) break;
        __builtin_amdgcn_s_sleep(1);
        if ((++sp & 255u) == 0u) { if (xb_ld(&bar[XB_TMO])) break; if (sp > XB_SPIN_CAP) { atomicAdd(&bar[XB_TMO], 1u); break; } }
    }
    nloc = mine > 0u ? mine : 1u; nx = cnt > 0u ? cnt : 1u;
}

__device__ __forceinline__ void xcd_barrier(const XcdBarrier& b) {
    asm volatile("s_waitcnt vmcnt(0)" ::: "memory");
    __syncthreads();
    if (threadIdx.x == 0) {
        unsigned* bar = b.bar;
        __builtin_amdgcn_s_waitcnt(0);
        unsigned nloc = b.st[0], nx = b.st[1];
        if (nloc == 0u) { xcd_barrier_complete(bar, b.x, nloc, nx); b.st[0] = nloc; b.st[1] = nx; }
        const unsigned old = xb_add(&bar[XB_XSUB(b.x)], 1u);
        const unsigned gen = old / nloc;
        if (old + 1u == (gen + 1u) * nloc) {
            __builtin_amdgcn_fence(__ATOMIC_RELEASE, "agent");
            asm volatile("s_waitcnt vmcnt(0)" ::: "memory");
            const unsigned og = xb_add(&bar[XB_TOP], 1u);
            const unsigned tg = og / nx;
            if (og + 1u == (tg + 1u) * nx) xb_add(&bar[XB_TOPGEN], 1u);
            else XB_SPIN(xb_ld(&bar[XB_TOPGEN]) == tg, bar);
            __builtin_amdgcn_fence(__ATOMIC_ACQUIRE, "agent");
            xb_add(&bar[XB_XGEN(b.x)], 1u);
            asm volatile("s_waitcnt vmcnt(0)" ::: "memory");
        } else {
            XB_SPIN(xb_ld(&bar[XB_XGEN(b.x)]) == gen, bar);
            __builtin_amdgcn_fence(__ATOMIC_ACQUIRE, "agent");
            asm volatile("s_waitcnt vmcnt(0)" ::: "memory");
        }
    }
    __syncthreads();
}

#define DUP_DN 0
#define DN_VARIANT 0
#define DN_VAR_PARITY0 0
#define DUP_GLA 0
#define DUP_ATT 0
#define DUP_GIN 0
#define DUP_FFN1 0
constexpr unsigned long long pack_ops(const int* ops, int n) { unsigned long long v = 0; for (int i = 0; i < n; ++i) v |= (unsigned long long)ops[i] << (5 * i); return v; }
struct OpList { unsigned long long code; int n; };
constexpr OpList make_list(int mix) {
    int ops[16] = {}; int n = 0;
    ops[n++] = OP_PREP; ops[n++] = OP_GEMM_IN; if (DUP_GIN && mix != 0) ops[n++] = OP_GEMM_IN;
    if (mix == 0) { ops[n++] = OP_DNHALO; ops[n++] = OP_DNCONV; ops[n++] = OP_DNT; ops[n++] = OP_DNSCAN; if (DUP_DN) ops[n++] = OP_DNSCAN; ops[n++] = OP_DNREDO; ops[n++] = OP_GEMM_Z; }
    else if (mix == 1) { ops[n++] = OP_GLAPREP; ops[n++] = OP_GLASCAN; ops[n++] = OP_GLAGATE; }
    else { ops[n++] = OP_QKROPE; ops[n++] = OP_ATTN; if (DUP_ATT) ops[n++] = OP_ATTN; }
    ops[n++] = OP_GEMM_OUT; ops[n++] = OP_NORM2; ops[n++] = OP_FFN1; if (DUP_FFN1 && mix != 0) ops[n++] = OP_FFN1; ops[n++] = OP_FFN2;
    return OpList{pack_ops(ops, n), n};
}
constexpr OpList L_DN = make_list(0), L_GL = make_list(1), L_AT = make_list(2);
constexpr int NPHASE = 1 + 2 * L_DN.n + L_GL.n + L_AT.n;
__device__ __forceinline__ void decode_phase(int ph, int& layer, int& op) {
    if (ph == 0) { layer = 0; op = OP_MOD; return; }
    int p = ph - 1;
    if (p < L_DN.n) { layer = 0; op = (int)((L_DN.code >> (5 * p)) & 31ull); return; } p -= L_DN.n;
    if (p < L_GL.n) { layer = 1; op = (int)((L_GL.code >> (5 * p)) & 31ull); return; } p -= L_GL.n;
    if (p < L_AT.n) { layer = 2; op = (int)((L_AT.code >> (5 * p)) & 31ull); return; } p -= L_AT.n;
    layer = 3; op = (int)((L_DN.code >> (5 * p)) & 31ull);
}

__global__ void __launch_bounds__(512, 2) mega(Args args) {
    extern __shared__ __attribute__((aligned(16))) unsigned char lds_raw[];
    LAS unsigned char* lds = (LAS unsigned char*)lds_raw;
    cg::grid_group grid = cg::this_grid();
    volatile LAS unsigned* xb_st = (volatile LAS unsigned*)(lds + LDS_BYTES - 64);
    if (threadIdx.x < 2) xb_st[threadIdx.x] = 0u;
    __syncthreads();
    const XcdBarrier xbar = xcd_barrier_post((unsigned*)(args.ws + WS_BAR), xb_st);
    const int G = gridDim.x, NGW = G * 8;
    unsigned char* ws = args.ws;
    const float* x_in = args.in[0]; const float* c_in = args.in[1]; const float* ctx_in = args.in[2]; const float* cctx_in = args.in[3];
    const float* ada_w = args.in[4]; const float* ada_b = args.in[5]; const float* norm_mix_g = args.in[6]; const float* norm_ffn_g = args.in[7];
    const float* ffn_w1 = args.in[8]; const float* ffn_w2 = args.in[9];
    float* MOD = (float*)(ws + WS_MOD); float* CTXC = (float*)(ws + WS_CTX); bf16_t* H = (bf16_t*)(ws + WS_H); float* ABF = (float*)(ws + WS_AB); float* RSTD = (float*)(ws + WS_RSTD);
    bf16_t* PB = (bf16_t*)(ws + WS_P); float* out = args.out;

    for (int ph = args.ph_lo; ph < args.ph_hi; ++ph) {
        int layer, op; decode_phase(ph, layer, op);
        const int mix = layer % 3, slot = layer / 3;
        const float* modl = MOD + (size_t)layer * 3 * 6144;
        const float* xl = layer == 0 ? x_in : out; const float* xc = layer == 0 ? ctx_in : CTXC;
        if (op == OP_MOD) {
            const int tid = opaque_tid(), lane = tid & 63, wave = __builtin_amdgcn_readfirstlane(tid >> 6); const int gw = blockIdx.x * 8 + wave; (void)lane; (void)gw; (void)tid;
            LAS float* sl = (LAS float*)lds; LAS float* red = sl + 3 * 1024;
            for (int e = tid; e < 3 * 1024; e += 512) { const float v = e < 2048 ? c_in[e] : cctx_in[e - 2048]; sl[e] = silu_f(v); }
            __syncthreads();
            for (int item = blockIdx.x; item < 4 * 96; item += G) {
                const int ly = item / 96, col = (item % 96) * 64 + lane;
                const float* wp = ada_w + ((size_t)ly * 1024 + 128 * wave) * 6144 + col;
                float a0 = 0.f, a1 = 0.f, a2 = 0.f;
#pragma unroll 8
                for (int k = 0; k < 128; ++k) { const float wv = wp[(size_t)k * 6144]; const int kk = 128 * wave + k; a0 += sl[kk] * wv; a1 += sl[1024 + kk] * wv; a2 += sl[2048 + kk] * wv; }
                red[(wave * 3 + 0) * 64 + lane] = a0; red[(wave * 3 + 1) * 64 + lane] = a1; red[(wave * 3 + 2) * 64 + lane] = a2;
                __syncthreads();
                if (tid < 192) { const int m = tid >> 6; float s = ada_b[(size_t)ly * 6144 + col];
#pragma unroll
                    for (int w2 = 0; w2 < 8; ++w2) s += red[(w2 * 3 + m) * 64 + lane];
                    MOD[((size_t)ly * 3 + m) * 6144 + col] = s; }
                __syncthreads();
            }
        } else if (op == OP_PREP) {
            const int tid = opaque_tid(), lane = tid & 63, wave = __builtin_amdgcn_readfirstlane(tid >> 6); const int gw = blockIdx.x * 8 + wave; (void)lane; (void)gw; (void)tid;
            LAS float* scr = (LAS float*)(lds + wave * 16384);
            unsigned z0 = 0u; asm volatile("" : "+v"(z0)); const u32x4 zv = (u32x4){z0, z0, z0, z0};
            bf16_t* wtA = (bf16_t*)(ws + WT_A); bf16_t* wtZ = (bf16_t*)(ws + WT_Z); bf16_t* wtO = (bf16_t*)(ws + WT_O); bf16_t* wt1 = (bf16_t*)(ws + WT_1); bf16_t* wt2 = (bf16_t*)(ws + WT_2);
            if (mix == 0) {
                const float* w_in = args.in[10] + (size_t)slot * 1024 * 6208; const float* w_out = args.in[15] + (size_t)slot * 2048 * 1024;
                transpose_mat(w_in, 6208, 0, 4096, 1024, wtA, 0, scr, gw, NGW, lane);
                transpose_mat(w_in, 6208, 6144, 64, 1024, wtA, 4096, scr, gw, NGW, lane);
                for (size_t e = (size_t)blockIdx.x * 512 + tid; e < (size_t)192 * 1024 * 2 / 16; e += (size_t)G * 512) ((u32x4*)(wtA + (size_t)4160 * 1024))[e] = zv;
            } else if (mix == 1) {
                const float* w_in = args.in[16]; const float* w_out = args.in[20];
                transpose_mat(w_in, 3104, 0, 3104, 1024, wtA, 0, scr, gw, NGW, lane);
                for (size_t e = (size_t)blockIdx.x * 512 + tid; e < (size_t)224 * 1024 * 2 / 16; e += (size_t)G * 512) ((u32x4*)(wtA + (size_t)3104 * 1024))[e] = zv;
                transpose_mat(w_out, 1024, 0, 1024, 1024, wtO, 0, scr, gw, NGW, lane);
            } else {
                const float* w_in = args.in[21]; const float* w_out = args.in[24];
                transpose_mat(w_in, 1536, 0, 1536, 1024, wtA, 0, scr, gw, NGW, lane);
                transpose_mat(w_out, 1024, 0, 1024, 1024, wtO, 0, scr, gw, NGW, lane);
            }
            if (mix != 0) {
                transpose_mat(ffn_w1 + (size_t)layer * 1024 * 4096, 4096, 0, 4096, 1024, wt1, 0, scr, gw, NGW, lane);
                transpose_mat(ffn_w2 + (size_t)layer * 4096 * 1024, 1024, 0, 1024, 4096, wt2, 0, scr, gw, NGW, lane);
            }
            normmod_rows(xl, xc, norm_mix_g + (size_t)layer * 1024, modl, 0, H, gw, NGW, lane);
        } else if (op == OP_DNREDO) {
            const int tid = opaque_tid(), lane = tid & 63, wave = __builtin_amdgcn_readfirstlane(tid >> 6); const int gw = blockIdx.x * 8 + wave; (void)lane; (void)gw; (void)tid;
            LAS float* scr = (LAS float*)(lds + wave * 16384);
            const float* w_in = args.in[10] + (size_t)slot * 1024 * 6208; const float* w_out = args.in[15] + (size_t)slot * 2048 * 1024;
            transpose_mat(w_in, 6208, 4096, 2048, 1024, (bf16_t*)(ws + WT_Z), 0, scr, gw, NGW, lane);
            transpose_mat(w_out, 1024, 0, 1024, 2048, (bf16_t*)(ws + WT_O), 0, scr, gw, NGW, lane);
            transpose_mat(ffn_w1 + (size_t)layer * 1024 * 4096, 4096, 0, 4096, 1024, (bf16_t*)(ws + WT_1), 0, scr, gw, NGW, lane);
            transpose_mat(ffn_w2 + (size_t)layer * 4096 * 1024, 1024, 0, 1024, 4096, (bf16_t*)(ws + WT_2), 0, scr, gw, NGW, lane);
            normmod_rows(xl, xc, norm_mix_g + (size_t)layer * 1024, modl, 0, H, gw, NGW, lane);
            const bf16_t* OB = (const bf16_t*)(ws + WS_O);
            for (int row = gw; row < MROWS; row += NGW) {
                const u32x4* p = (const u32x4*)(OB + (size_t)row * 2048 + 32 * lane); float ss = 0.f;
#pragma unroll
                for (int v = 0; v < 4; ++v) { const u32x4 q = p[v]; const float a0 = bf_lo(q.x), a1 = bf_hi(q.x), a2 = bf_lo(q.y), a3 = bf_hi(q.y), a4 = bf_lo(q.z), a5 = bf_hi(q.z), a6 = bf_lo(q.w), a7 = bf_hi(q.w);
                    ss += (a0 * a0 + a1 * a1) + (a2 * a2 + a3 * a3) + (a4 * a4 + a5 * a5) + (a6 * a6 + a7 * a7); }
                ss += __shfl_xor(ss, 1); ss += __shfl_xor(ss, 2);
                if ((lane & 3) == 0) RSTD[(size_t)row * 16 + (lane >> 2)] = rsqrtf(ss * (1.f / 128.f) + EPS);
            }
        } else if (op == OP_DNHALO) {
            dn_halo_phase(PB, (bf16_t*)(ws + WS_HALO), G);
        } else if (op == OP_DNCONV) {
            dn_conv_phase(PB, (const bf16_t*)(ws + WS_HALO), args.in[11] + (size_t)slot * 4096 * 5, G);
        } else if (op == OP_DNT) {
            dn_t_phase(lds, PB, ABF, (bf16_t*)(ws + WS_TP), args.in[12] + (size_t)slot * 32, args.in[13] + (size_t)slot * 32, G);
            {
                unsigned z0 = 0u; asm volatile("" : "+v"(z0)); const u32x4 zv = (u32x4){z0, z0, z0, z0}; u32x4* zp = (u32x4*)(ws + WS_O);
                for (size_t e = (size_t)blockIdx.x * 512 + opaque_tid(); e < (size_t)MROWS * 2048 * 2 / 16; e += (size_t)G * 512) zp[e] = zv;
            }
        } else if (op == OP_NORM2) {
            const int tid = opaque_tid(), lane = tid & 63, wave = __builtin_amdgcn_readfirstlane(tid >> 6); const int gw = blockIdx.x * 8 + wave; (void)lane; (void)gw; (void)tid;
            normmod_rows(out, CTXC, norm_ffn_g + (size_t)layer * 1024, modl, 3, H, gw, NGW, lane);
        } else if (op == OP_GEMM_IN || op == OP_GEMM_Z || op == OP_GEMM_OUT || op == OP_FFN1 || op == OP_FFN2) {
            pg8::Gemm g; pg8::Epi E;
            E.mode = 0; E.O = PB; E.ldc = 4096; E.tail_pn = -1; E.F = ABF; E.ldf = 64; E.nf = 64; E.rstd = RSTD; E.ng = args.in[14] + (size_t)slot * 128;
            E.src_lat = xl; E.src_ctx = xc; E.dst_lat = out; E.dst_ctx = CTXC; E.mod = modl; E.gidx = 2;
            g.M = (layer == 3 && op != OP_GEMM_IN) ? NLAT : MROWS; g.A = H; g.K = 1024;
            bf16_t* OBUF = (bf16_t*)(ws + (mix == 1 ? WS_OGLA : WS_O));
            if (op == OP_GEMM_IN) {
                g.Bt = (const bf16_t*)(ws + WT_A);
                if (mix == 0) { g.N = 4352; E.ldc = 4096; E.tail_pn = 16; E.ldf = 64; E.nf = 64; }
                else if (mix == 1) { g.N = 3328; E.ldc = 3072; E.tail_pn = 12; E.ldf = 32; E.nf = 32; }
                else { g.N = 1536; E.ldc = 1536; }
            } else if (op == OP_GEMM_Z) {
                g.Bt = (const bf16_t*)(ws + WT_Z); g.N = 2048; E.mode = 2; E.O = OBUF; E.ldc = 2048;
            } else if (op == OP_GEMM_OUT) {
                g.A = OBUF; g.K = mix == 0 ? 2048 : 1024; g.Bt = (const bf16_t*)(ws + WT_O); g.N = 1024; E.mode = 3; E.gidx = 2;
            } else if (op == OP_FFN1) {
                g.Bt = (const bf16_t*)(ws + WT_1); g.N = 4096; E.mode = 1; E.ldc = 4096;
            } else {
                g.A = PB; g.K = 4096; g.Bt = (const bf16_t*)(ws + WT_2); g.N = 1024; E.mode = 3; E.gidx = 5; E.src_lat = out; E.src_ctx = CTXC;
            }
            pg8::StaticOrder S; S.init(g.M, g.N, G, (int)blockIdx.x);
#ifndef NO_GEMM
            pg8::gemm_phase<pg8::Epi, pg8::StaticOrder, true, true>(lds, g, S, E);
#endif
        } else if (op == OP_DNSCAN) {
#ifndef NO_DN
            if (DN_VARIANT && (ph & 1) == 0) dn_scan3<DN_VARIANT>(lds, PB, ABF, (const bf16_t*)(ws + WS_TP), (bf16_t*)(ws + WS_O)); else dn_scan3<0>(lds, PB, ABF, (const bf16_t*)(ws + WS_TP), (bf16_t*)(ws + WS_O));
#endif
        } else if (op == OP_GLAPREP) {
            gla_prep_phase(lds, PB, ABF, args.in[17], args.in[18], (bf16_t*)(ws + WS_QM), (bf16_t*)(ws + WS_KM), (bf16_t*)(ws + WS_AQ), (float*)(ws + WS_EL), G);
        } else if (op == OP_GLASCAN) {
#ifndef NO_GLA
            gla_scan3(lds, PB, (const bf16_t*)(ws + WS_QM), (const bf16_t*)(ws + WS_KM), (const bf16_t*)(ws + WS_AQ), (const float*)(ws + WS_EL), (bf16_t*)(ws + WS_OGLA));
#endif
        } else if (op == OP_GLAGATE) {
            const int tid = opaque_tid(), lane = tid & 63, wave = __builtin_amdgcn_readfirstlane(tid >> 6); const int gw = blockIdx.x * 8 + wave; (void)lane; (void)gw; (void)tid;
            bf16_t* OB = (bf16_t*)(ws + WS_OGLA); const float* ng = args.in[19];
            for (int row = gw; row < MROWS; row += NGW) {
                u32x4* p = (u32x4*)(OB + (size_t)row * 1024 + 16 * lane); const u32x4* gp = (const u32x4*)(PB + (size_t)row * 3072 + 2048 + 16 * lane); const u32x4* pb2 = (const u32x4*)(PB + (size_t)row * 3072 + 16 * lane);
                float o[16], z[16]; float ss = 0.f;
#pragma unroll
                for (int v = 0; v < 2; ++v) { const u32x4 q = p[v], gq = gp[v], q2 = pb2[v];
                    o[8 * v + 0] = bf_lo(q.x) + bf_lo(q2.x); o[8 * v + 1] = bf_hi(q.x) + bf_hi(q2.x); o[8 * v + 2] = bf_lo(q.y) + bf_lo(q2.y); o[8 * v + 3] = bf_hi(q.y) + bf_hi(q2.y); o[8 * v + 4] = bf_lo(q.z) + bf_lo(q2.z); o[8 * v + 5] = bf_hi(q.z) + bf_hi(q2.z); o[8 * v + 6] = bf_lo(q.w) + bf_lo(q2.w); o[8 * v + 7] = bf_hi(q.w) + bf_hi(q2.w);
                    z[8 * v + 0] = bf_lo(gq.x); z[8 * v + 1] = bf_hi(gq.x); z[8 * v + 2] = bf_lo(gq.y); z[8 * v + 3] = bf_hi(gq.y); z[8 * v + 4] = bf_lo(gq.z); z[8 * v + 5] = bf_hi(gq.z); z[8 * v + 6] = bf_lo(gq.w); z[8 * v + 7] = bf_hi(gq.w); }
#pragma unroll
                for (int e = 0; e < 16; ++e) ss += o[e] * o[e];
                ss += __shfl_xor(ss, 1); ss += __shfl_xor(ss, 2); ss += __shfl_xor(ss, 4); ss += __shfl_xor(ss, 8);
                const float rs = rsqrtf(ss * (1.f / 256.f) + EPS); const int cb = (16 * lane) & 255;
#pragma unroll
                for (int v = 0; v < 2; ++v) { float rr[8];
#pragma unroll
                    for (int e = 0; e < 8; ++e) rr[e] = o[8 * v + e] * rs * ng[cb + 8 * v + e] * silu_f(z[8 * v + e]);
                    u32x4 wv; wv.x = cvtpk_s(rr[0], rr[1]); wv.y = cvtpk_s(rr[2], rr[3]); wv.z = cvtpk_s(rr[4], rr[5]); wv.w = cvtpk_s(rr[6], rr[7]); p[v] = wv; }
            }
        } else if (op == OP_QKROPE) {
            const int tid = opaque_tid(), lane = tid & 63, wave = __builtin_amdgcn_readfirstlane(tid >> 6); const int gw = blockIdx.x * 8 + wave; (void)lane; (void)gw; (void)tid;
            bf16_t* QR = (bf16_t*)(ws + WS_QR); bf16_t* KR = (bf16_t*)(ws + WS_KR); bf16_t* VR = (bf16_t*)(ws + WS_VR);
            const float* qg = args.in[22]; const float* kg = args.in[23];
            const int hf = lane >> 5, j = lane & 31, e1 = 64 * hf + j, e2 = e1 + 32;
            const float inv_freq = exp2f(-(float)(2 * j) * (1.f / 64.f) * 13.287712379549449f);
            const float gq1 = qg[e1], gq2 = qg[e2], gk1 = kg[e1], gk2 = kg[e2];
            for (int row = gw; row < MROWS; row += NGW) {
                const bool lat = row < NLAT; const int b = lat ? row / SEQ : (row - NLAT) / CTXL; const int tpos = lat ? row % SEQ : (row - NLAT) % CTXL;
                float cs = 1.f, sn = 0.f;
                if (lat) { const float pos = (float)(hf == 0 ? tpos / 64 : tpos % 64); const float ang = pos * inv_freq; sn = sinf(ang); cs = cosf(ang); }
                const bf16_t* pr = PB + (size_t)row * 1536; const int kpos = lat ? tpos : SEQ + tpos;
#pragma unroll
                for (int hd = 0; hd < 10; ++hd) {
                    const float x1 = bf2f(pr[hd * 128 + e1]), x2 = bf2f(pr[hd * 128 + e2]);
                    const float rinv = rsqrtf(wave_sum(x1 * x1 + x2 * x2) * (1.f / 128.f) + EPS);
                    const float y1 = x1 * rinv * (hd < 8 ? gq1 : gk1), y2 = x2 * rinv * (hd < 8 ? gq2 : gk2);
                    const float o1 = y1 * cs - y2 * sn, o2 = y1 * sn + y2 * cs;
                    bf16_t* dst = hd < 8 ? QR + (size_t)row * 1024 + hd * 128 : KR + ((size_t)(b * 2 + (hd - 8)) * SKV + kpos) * 128;
                    dst[e1] = f2bf(o1); dst[e2] = f2bf(o2);
                }
#pragma unroll
                for (int kv = 0; kv < 2; ++kv) { bf16_t* dst = VR + ((size_t)(b * 2 + kv) * SKV + kpos) * 128; dst[e1] = pr[1280 + kv * 128 + e1]; dst[e2] = pr[1280 + kv * 128 + e2]; }
            }
        } else if (op == OP_ATTN) {
            const attn::bf16* QR = (const attn::bf16*)(ws + WS_QR); const attn::bf16* KR = (const attn::bf16*)(ws + WS_KR); const attn::bf16* VR = (const attn::bf16*)(ws + WS_VR);
            attn::bf16* OB = (attn::bf16*)(ws + WS_O);
            for (int u = blockIdx.x; u < 1024 + 16; u += G) {
                size_t qoff, koff; int seq;
                if (u < 1024) { const int pair = u >> 8, b = pair >> 1, kvh = pair & 1, hh = (u >> 6) & 3, qb = u & 63, head = kvh * 4 + hh;
                    qoff = ((size_t)b * SEQ + (size_t)qb * 256) * 1024 + head * 128; koff = (size_t)(b * 2 + kvh) * SKV * 128; seq = SKV; }
                else { const int jx = u - 1024, b = jx >> 3, head = jx & 7, kvh = head >> 2;
                    qoff = ((size_t)NLAT + (size_t)b * CTXL) * 1024 + head * 128; koff = ((size_t)(b * 2 + kvh) * SKV + SEQ) * 128; seq = CTXL; }
                __syncthreads();
#ifndef NO_ATT
                attn::attn_dense_body<attn::bf16>(QR + qoff, KR + koff, VR + koff, OB + qoff, seq, (char*)lds_raw);
#endif
            }
        }
        if (ph + 1 < args.ph_hi) { if (ph == 0) grid.sync(); else xcd_barrier(xbar); }
    }
}

#ifndef MK_MULTI
#define MK_MULTI 0
#endif
extern "C" void kernel_launch(void* const* d_in, const int* in_sizes, int n_in, void* d_out, int out_size, void* d_ws, size_t ws_size, hipStream_t stream) {
    static int grid = 0;
    if (grid == 0) {
        if (n_in != 25 || ws_size < WS_END) { fprintf(stderr, "kernel_launch: unexpected n_in %d / ws_size %zu (need %zu)\n", n_in, ws_size, (size_t)WS_END); grid = -1; return; }
        int dev = 0, cus = 0, per_cu = 0;
        hipGetDevice(&dev); hipDeviceGetAttribute(&cus, hipDeviceAttributeMultiprocessorCount, dev);
        if (hipFuncSetAttribute((const void*)mega, hipFuncAttributeMaxDynamicSharedMemorySize, LDS_BYTES) != hipSuccess) { fprintf(stderr, "kernel_launch: hipFuncSetAttribute failed\n"); grid = -1; return; }
        if (hipOccupancyMaxActiveBlocksPerMultiprocessor(&per_cu, (const void*)mega, 512, LDS_BYTES) != hipSuccess || per_cu < 1) { fprintf(stderr, "kernel_launch: occupancy query says %d\n", per_cu); per_cu = 1; }
        (void)hipGetLastError();
        grid = cus * 1;
    }
    if (grid < 0) return;
    if (hipMemsetAsync((char*)d_ws + WS_BAR, 0, WS_BAR_BYTES, stream) != hipSuccess) { fprintf(stderr, "kernel_launch: memset of barrier words failed\n"); return; }
    Args a{};
    for (int i = 0; i < 25; ++i) a.in[i] = (const float*)d_in[i];
    a.out = (float*)d_out; a.ws = (unsigned char*)d_ws;
#if MK_MULTI
    for (int ph = 0; ph < NPHASE; ++ph) { a.ph_lo = ph; a.ph_hi = ph + 1; hipLaunchKernelGGL(mega, dim3(grid), dim3(512), LDS_BYTES, stream, a); }
#else
    a.ph_lo = 0; a.ph_hi = NPHASE;
    void* kargs[] = {&a};
    hipError_t e = hipLaunchCooperativeKernel((const void*)mega, dim3(grid), dim3(512), kargs, LDS_BYTES, stream);
    if (e != hipSuccess) fprintf(stderr, "cooperative launch failed: %s (grid %d)\n", hipGetErrorString(e), grid);
#endif
}
```

```cpp
#include <hip/hip_runtime.h>
#include <hip/hip_bf16.h>
#include <hip/hip_cooperative_groups.h>
#include <cstdio>
#include <cstdint>
namespace cg = cooperative_groups;
__device__ __forceinline__ int opaque_tid() { int t = threadIdx.x; asm volatile("" : "+v"(t)); return t; }
namespace pg8 {
#define PG8_LAS __attribute__((address_space(3)))
typedef unsigned short bf16_t;
typedef short bf16x8 __attribute__((ext_vector_type(8)));
typedef float f32x4 __attribute__((ext_vector_type(4)));
typedef unsigned u32x4 __attribute__((ext_vector_type(4)));
constexpr int BM = 256, BK = 64, HALF = 128, HTB = HALF * BK * 2  , STAGE_BYTES = 8 * HTB, NXCD = 8, WGM = 8;

__host__ __device__ __forceinline__ int lds_byte(int r, int c) { const int st = (r >> 4) * 2 + (c >> 5), rr = r & 15, cc = c & 31, ob = rr * 64 + cc * 2; return st * 1024 + (ob ^ (((ob >> 9) & 1) << 5)); }
__host__ __device__ __forceinline__ void stage_rc(int b, int& R, int& C) { const int st = b / 1024, sb = b % 1024, swz = sb ^ (((sb >> 9) & 1) << 5); R = (st >> 1) * 16 + swz / 64; C = (st & 1) * 32 + (swz % 64) / 2; }
__host__ __device__ __forceinline__ int perm32(int rho) { const int n = rho >> 4, i = rho & 15; return 8 * (i >> 2) + 4 * n + (i & 3); }

struct Unit { int pm, pn; };
struct Gemm { const bf16_t* A; const bf16_t* Bt; int M, N, K; };

struct StaticOrder {
    int nM, nN, nwg, G, c;
    __host__ __device__ void init(int M, int N, int G_, int c_) { nM = M / BM; nN = N / BM; nwg = nM * nN; G = G_; c = c_; }
    __host__ __device__ bool next(int i, Unit& u) const {
        const long L = (long)i * G + c; if (L >= nwg) return false;
        int wgid = (int)L; { const int q = nwg / NXCD, r = nwg % NXCD, xcd = wgid % NXCD, off = wgid / NXCD; wgid = (xcd < r ? xcd * (q + 1) : r * (q + 1) + (xcd - r) * q) + off; }
        const int nig = WGM * nN, gid = wgid / nig, fm = gid * WGM, gsz = (nM - fm) < WGM ? (nM - fm) : WGM;
        u.pm = fm + ((wgid % nig) % gsz); u.pn = (wgid % nig) / gsz; return true;
    }
    __device__ __forceinline__ void a_ready(const Unit&) const {}
    __device__ __forceinline__ void done(const Unit&) const {}
};

__device__ __forceinline__ unsigned cvt_pk_bf16(float lo, float hi) { unsigned r; asm volatile("v_cvt_pk_bf16_f32 %0, %1, %2" : "=v"(r) : "v"(lo), "v"(hi)); return r; }
typedef float f32x2 __attribute__((ext_vector_type(2)));
typedef float f32x2_t __attribute__((ext_vector_type(2))); typedef __bf16 bf16x2_t __attribute__((ext_vector_type(2)));
__device__ __forceinline__ unsigned cvtpk_s(float lo, float hi) { f32x2_t v = {lo, hi}; bf16x2_t b = __builtin_convertvector(v, bf16x2_t); return __builtin_bit_cast(unsigned, b); }
__device__ __forceinline__ float bf_lo(unsigned w) { return __builtin_bit_cast(float, w << 16); }
__device__ __forceinline__ float bf_hi(unsigned w) { return __builtin_bit_cast(float, w & 0xffff0000u); }
__device__ __forceinline__ float silu_f(float z) { return z / (1.f + __expf(-z)); }
struct Epi {
    static constexpr bool PERM = true, AFTER_DRAIN = false;
    int mode;
    bf16_t* O; int ldc;
    int tail_pn; float* F; int ldf, nf;
    const float* rstd; const float* ng;
    const float* src_lat; const float* src_ctx; float* dst_lat; float* dst_ctx; const float* mod; int gidx;
    __device__ __forceinline__ void operator()(const f32x4 (&acc)[2][2][4][2], const Unit& u, int wr, int wc, int fr, int fq) const {
        const int row0 = u.pm * BM + wr * 64 + fr; const int col0 = u.pn * BM + wc * 32 + 8 * fq;
        if (mode <= 1) {
            if (u.pn == tail_pn) {
                const int c0 = wc * 32 + 8 * fq;
#pragma unroll
                for (int ai = 0; ai < 2; ++ai)
#pragma unroll
                    for (int m = 0; m < 4; ++m)
#pragma unroll
                        for (int bj = 0; bj < 2; ++bj) { const int cc = c0 + bj * HALF;
                            if (cc < nf) { float* p = F + (size_t)(row0 + ai * HALF + m * 16) * ldf + cc; *(f32x4*)p = acc[ai][bj][m][0]; *(f32x4*)(p + 4) = acc[ai][bj][m][1]; } }
            } else {
#pragma unroll
                for (int ai = 0; ai < 2; ++ai)
#pragma unroll
                    for (int m = 0; m < 4; ++m) { bf16_t* rowp = O + (size_t)(row0 + ai * HALF + m * 16) * ldc + col0;
#pragma unroll
                        for (int bj = 0; bj < 2; ++bj) { f32x4 v0 = acc[ai][bj][m][0], v1 = acc[ai][bj][m][1];
                            if (mode == 1) {
#pragma unroll
                                for (int e = 0; e < 4; ++e) { float a = fmaxf(v0[e], 0.f), b = fmaxf(v1[e], 0.f); v0[e] = a * a; v1[e] = b * b; } }
                            u32x4 w; w.x = cvtpk_s(v0[0], v0[1]); w.y = cvtpk_s(v0[2], v0[3]); w.z = cvtpk_s(v1[0], v1[1]); w.w = cvtpk_s(v1[2], v1[3]);
                            *(u32x4*)(rowp + bj * HALF) = w; } }
            }
        } else if (mode == 2) {
            const f32x4 g0 = *(const f32x4*)(ng + (col0 & 127)), g1 = *(const f32x4*)(ng + (col0 & 127) + 4);
#pragma unroll
            for (int ai = 0; ai < 2; ++ai)
#pragma unroll
                for (int m = 0; m < 4; ++m) { const int row = row0 + ai * HALF + m * 16; bf16_t* rowp = O + (size_t)row * ldc + col0;
#pragma unroll
                    for (int bj = 0; bj < 2; ++bj) { const float rs = rstd[(size_t)row * 16 + ((col0 + bj * HALF) >> 7)];
                        const u32x4 ov = *(const u32x4*)(rowp + bj * HALF); const f32x4 z0 = acc[ai][bj][m][0], z1 = acc[ai][bj][m][1];
                        float r[8];
                        r[0] = bf_lo(ov.x) * rs * g0[0] * silu_f(z0[0]); r[1] = bf_hi(ov.x) * rs * g0[1] * silu_f(z0[1]);
                        r[2] = bf_lo(ov.y) * rs * g0[2] * silu_f(z0[2]); r[3] = bf_hi(ov.y) * rs * g0[3] * silu_f(z0[3]);
                        r[4] = bf_lo(ov.z) * rs * g1[0] * silu_f(z1[0]); r[5] = bf_hi(ov.z) * rs * g1[1] * silu_f(z1[1]);
                        r[6] = bf_lo(ov.w) * rs * g1[2] * silu_f(z1[2]); r[7] = bf_hi(ov.w) * rs * g1[3] * silu_f(z1[3]);
                        u32x4 w; w.x = cvtpk_s(r[0], r[1]); w.y = cvtpk_s(r[2], r[3]); w.z = cvtpk_s(r[4], r[5]); w.w = cvtpk_s(r[6], r[7]);
                        *(u32x4*)(rowp + bj * HALF) = w; } }
        } else {
            const int mi = u.pm < 64 ? 0 : (u.pm < 128 ? 1 : 2);
            const float* gate = mod + (size_t)mi * 6144 + (size_t)gidx * 1024;
            const bool lat = u.pm < 128;
            const float* sb = lat ? src_lat : src_ctx - (size_t)32768 * 1024; float* db = lat ? dst_lat : dst_ctx - (size_t)32768 * 1024;
#pragma unroll
            for (int bj = 0; bj < 2; ++bj)
#pragma unroll
                for (int n = 0; n < 2; ++n) { const int c = col0 + bj * HALF + 4 * n; const f32x4 gv = *(const f32x4*)(gate + c);
#pragma unroll
                    for (int ai = 0; ai < 2; ++ai)
#pragma unroll
                        for (int m = 0; m < 4; ++m) { const size_t off = (size_t)(row0 + ai * HALF + m * 16) * 1024 + c;
                            const f32x4 s = *(const f32x4*)(sb + off); *(f32x4*)(db + off) = s + gv * acc[ai][bj][m][n]; } }
        }
    }
};
template <class Epi, class Sched, bool ALIGN_EPI = false, bool SP2 = false>
__device__ __forceinline__ void gemm_phase(PG8_LAS unsigned char* lds, const Gemm g, const Sched& S, const Epi& E) {
    const int tid = opaque_tid(), wid = __builtin_amdgcn_readfirstlane(tid >> 6), lane = tid & 63, wr = wid >> 2, wc = wid & 3, fr = lane & 15, fq = lane >> 4;
    const int K = g.K, nt = K / BK;
    unsigned voffA[2], voffB[2];
#pragma unroll
    for (int i = 0; i < 2; ++i) { int R, C; stage_rc(tid * 16 + i * 8192, R, C); const int Rb = Epi::PERM ? ((R & ~31) + perm32(R & 31)) : R;
        voffA[i] = (unsigned)(R * K + C) * 2u; voffB[i] = (unsigned)(Rb * K + C) * 2u; }
    const size_t kstep = (size_t)(BK * 2);
    const size_t hstep = (size_t)HALF * K * 2;
    const size_t tstep = 2 * hstep;
    const unsigned ldsw = (unsigned)wid * 1024u;
    const int aoff = lds_byte(wr * 64 + fr, fq * 8), boff = lds_byte(wc * 32 + fr, fq * 8);
#define PG8_SA(b, h) (((b) * 2 + (h)) * HTB)
#define PG8_SB(b, h) ((4 + (b) * 2 + (h)) * HTB)
#define PG8_STAGE(bufoff, gbase, voff) do { _Pragma("unroll") for (int _i = 0; _i < 2; ++_i) \
        __builtin_amdgcn_global_load_lds((const unsigned*)((const char*)(gbase) + (voff)[_i]), (PG8_LAS unsigned*)(lds + (bufoff) + ldsw + _i * 8192), 16, 0, 0); } while (0)
#define PG8_LDA(dst, b, h) do { _Pragma("unroll") for (int m = 0; m < 4; ++m) _Pragma("unroll") for (int k = 0; k < 2; ++k) dst[m][k] = *(const PG8_LAS bf16x8*)(lds + PG8_SA(b, h) + aoff + m * 2048 + k * 1024); } while (0)
#define PG8_LDB(dst, b, h) do { _Pragma("unroll") for (int n = 0; n < 2; ++n) _Pragma("unroll") for (int k = 0; k < 2; ++k) dst[n][k] = *(const PG8_LAS bf16x8*)(lds + PG8_SB(b, h) + boff + n * 2048 + k * 1024); } while (0)
#define PG8_MMA(ai, bj, At, Bt) do { __builtin_amdgcn_s_setprio(1); _Pragma("unroll") for (int m = 0; m < 4; ++m) _Pragma("unroll") for (int n = 0; n < 2; ++n) _Pragma("unroll") for (int k = 0; k < 2; ++k) \
        acc[ai][bj][m][n] = __builtin_amdgcn_mfma_f32_16x16x32_bf16(Bt[n][k], At[m][k], acc[ai][bj][m][n], 0, 0, 0); __builtin_amdgcn_s_setprio(0); } while (0)
#define PG8_WAIT_V(n) asm volatile("s_waitcnt vmcnt(" #n ")" ::: "memory")
#define PG8_WAIT_L(n) asm volatile("s_waitcnt lgkmcnt(" #n ")" ::: "memory")
#define PG8_BAR __builtin_amdgcn_s_barrier()
#define PG8_SCHED __builtin_amdgcn_sched_barrier(0)
    Unit cur, nxt; int ui = 0;
    if (!S.next(0, cur)) return;
    f32x4 acc[2][2][4][2];
#pragma unroll
    for (int a = 0; a < 2; ++a)
#pragma unroll
        for (int b = 0; b < 2; ++b)
#pragma unroll
            for (int m = 0; m < 4; ++m)
#pragma unroll
                for (int n = 0; n < 2; ++n) acc[a][b][m][n] = (f32x4){0.f, 0.f, 0.f, 0.f};
    bf16x8 At[4][2], B0[2][2], B1[2][2];
    const char* cA = (const char*)g.A + (size_t)cur.pm * tstep; const char* cB = (const char*)g.Bt + (size_t)cur.pn * tstep;
    S.a_ready(cur);
    if constexpr (SP2) {
        PG8_STAGE(PG8_SB(0, 0), cB, voffB); PG8_STAGE(PG8_SB(0, 1), cB + hstep, voffB); PG8_STAGE(PG8_SA(0, 0), cA, voffA); PG8_STAGE(PG8_SA(0, 1), cA + hstep, voffA);
        if (wr == 1) PG8_BAR;
        PG8_WAIT_V(2); PG8_BAR;
        PG8_STAGE(PG8_SB(1, 0), cB + kstep, voffB); PG8_STAGE(PG8_SA(1, 0), cA + kstep, voffA); PG8_STAGE(PG8_SB(1, 1), cB + hstep + kstep, voffB);
        PG8_WAIT_V(6); PG8_BAR;
    } else {
        PG8_STAGE(PG8_SB(0, 0), cB, voffB); PG8_STAGE(PG8_SA(0, 0), cA, voffA); PG8_STAGE(PG8_SB(0, 1), cB + hstep, voffB); PG8_STAGE(PG8_SA(0, 1), cA + hstep, voffA);
        if (wr == 1) PG8_BAR;
        PG8_WAIT_V(4); PG8_BAR;
        PG8_STAGE(PG8_SB(1, 0), cB + kstep, voffB); PG8_STAGE(PG8_SA(1, 0), cA + kstep, voffA); PG8_STAGE(PG8_SB(1, 1), cB + hstep + kstep, voffB);
        PG8_WAIT_V(6); PG8_BAR;
    }
    for (;;) {
        const bool has_next = S.next(ui + 1, nxt);
        const char* nA = has_next ? (const char*)g.A + (size_t)nxt.pm * tstep : cA; const char* nB = has_next ? (const char*)g.Bt + (size_t)nxt.pn * tstep : cB;
        for (int t = 0; t < nt; t += 2) {
            const bool last = (t == nt - 2);
            const char* a1 = cA + (size_t)(t + 1) * kstep;
            const char* a2 = last ? nA : cA + (size_t)(t + 2) * kstep; const char* b2 = last ? nB : cB + (size_t)(t + 2) * kstep;
            const char* a3 = a2 + kstep; const char* b3 = b2 + kstep;
            if (last && has_next) S.a_ready(nxt);
            if constexpr (SP2) {
            PG8_LDB(B0, 0, 0); PG8_LDB(B1, 0, 1); PG8_SCHED; PG8_LDA(At, 0, 0); PG8_STAGE(PG8_SA(1, 1), a1 + hstep, voffA);
            PG8_WAIT_V(8); PG8_WAIT_L(0); PG8_BAR; PG8_MMA(0, 0, At, B0); PG8_MMA(0, 1, At, B1); PG8_BAR; PG8_SCHED;
            PG8_LDA(At, 0, 1); PG8_STAGE(PG8_SB(0, 0), b2, voffB); PG8_STAGE(PG8_SB(0, 1), b2 + hstep, voffB); PG8_STAGE(PG8_SA(0, 0), a2, voffA);
            PG8_WAIT_V(8); PG8_WAIT_L(0); PG8_BAR; PG8_MMA(1, 0, At, B0); PG8_MMA(1, 1, At, B1); PG8_BAR; PG8_SCHED;
            PG8_LDB(B0, 1, 0); PG8_LDB(B1, 1, 1); PG8_SCHED; PG8_LDA(At, 1, 0); PG8_STAGE(PG8_SA(0, 1), a2 + hstep, voffA);
            PG8_WAIT_V(8); PG8_WAIT_L(0); PG8_BAR; PG8_MMA(0, 0, At, B0); PG8_MMA(0, 1, At, B1); PG8_BAR; PG8_SCHED;
            PG8_LDA(At, 1, 1); PG8_STAGE(PG8_SB(1, 0), b3, voffB); PG8_STAGE(PG8_SB(1, 1), b3 + hstep, voffB); PG8_STAGE(PG8_SA(1, 0), a3, voffA);
            PG8_WAIT_V(8); PG8_WAIT_L(0); PG8_BAR; PG8_MMA(1, 0, At, B0); PG8_MMA(1, 1, At, B1); PG8_BAR; PG8_SCHED;
            } else {
            PG8_LDB(B0, 0, 0); PG8_SCHED; PG8_LDA(At, 0, 0); PG8_STAGE(PG8_SA(1, 1), a1 + hstep, voffA);
            PG8_WAIT_L(8); PG8_BAR; PG8_WAIT_L(0); PG8_MMA(0, 0, At, B0); PG8_BAR; PG8_SCHED;
            PG8_LDB(B1, 0, 1); PG8_STAGE(PG8_SB(0, 0), b2, voffB);
            PG8_BAR; PG8_WAIT_L(0); PG8_MMA(0, 1, At, B1); PG8_BAR;
            PG8_LDA(At, 0, 1); PG8_STAGE(PG8_SA(0, 0), a2, voffA);
            PG8_BAR; PG8_WAIT_L(0); PG8_MMA(1, 0, At, B0); PG8_BAR; PG8_SCHED;
            PG8_STAGE(PG8_SB(0, 1), b2 + hstep, voffB);
            PG8_WAIT_V(6); PG8_BAR; PG8_MMA(1, 1, At, B1); PG8_BAR;
            PG8_LDB(B0, 1, 0); PG8_SCHED; PG8_LDA(At, 1, 0); PG8_STAGE(PG8_SA(0, 1), a2 + hstep, voffA);
            PG8_WAIT_L(8); PG8_BAR; PG8_WAIT_L(0); PG8_MMA(0, 0, At, B0); PG8_BAR; PG8_SCHED;
            PG8_LDB(B1, 1, 1); PG8_STAGE(PG8_SB(1, 0), b3, voffB);
            PG8_BAR; PG8_WAIT_L(0); PG8_MMA(0, 1, At, B1); PG8_BAR;
            PG8_LDA(At, 1, 1); PG8_STAGE(PG8_SA(1, 0), a3, voffA);
            PG8_BAR; PG8_WAIT_L(0); PG8_MMA(1, 0, At, B0); PG8_BAR; PG8_SCHED;
            PG8_STAGE(PG8_SB(1, 1), b3 + hstep, voffB);
            PG8_WAIT_V(6); PG8_BAR; PG8_MMA(1, 1, At, B1); PG8_BAR;
            }
        }
        if constexpr (ALIGN_EPI) { if (wr == 0) PG8_BAR; }
        if constexpr (!Epi::AFTER_DRAIN) { E(acc, cur, wr, wc, fr, fq); S.done(cur); }
        if (!has_next) break;
#pragma unroll
        for (int a = 0; a < 2; ++a)
#pragma unroll
            for (int b = 0; b < 2; ++b)
#pragma unroll
                for (int m = 0; m < 4; ++m)
#pragma unroll
                    for (int n = 0; n < 2; ++n) acc[a][b][m][n] = (f32x4){0.f, 0.f, 0.f, 0.f};
        cur = nxt; cA = nA; cB = nB; ++ui;
        if constexpr (ALIGN_EPI) { if (wr == 1) PG8_BAR; }
    }
    PG8_WAIT_V(0);
    if constexpr (!ALIGN_EPI) { if (wr == 0) PG8_BAR; }
    PG8_BAR;
    if constexpr (Epi::AFTER_DRAIN) { E.fused(acc, cur, wr, wc, fr, fq, lds, wid, lane); S.done(cur); }
#undef PG8_SA
#undef PG8_SB
#undef PG8_STAGE
#undef PG8_LDA
#undef PG8_LDB
#undef PG8_MMA
#undef PG8_WAIT_V
#undef PG8_WAIT_L
#undef PG8_BAR
#undef PG8_SCHED
}
}
namespace attn {
using bf16 = __hip_bfloat16;
constexpr int   D = 128, NW = 8, QBLK = 32, KVBLK = 64;
constexpr float SCALE = 0.088388347648318440f;
constexpr float THR = 8.f;
constexpr int SDEPTH = 2;
constexpr int LDQ = 1024, LDK = 128, LDO = 1024;
constexpr size_t SHM_V = KVBLK * D * 2, SHM_K = KVBLK * D * 2, SHM_ATTN = 2 * SHM_V + 2 * SHM_K + NW * 64 * 4;
using bf16x8 = __attribute__((ext_vector_type(8))) short;
using s16x4  = __attribute__((ext_vector_type(4))) short;
using f32x16 = __attribute__((ext_vector_type(16))) float;
using f32x8  = __attribute__((ext_vector_type(8))) float;
using u32x4  = __attribute__((ext_vector_type(4))) unsigned;
#define KSWZ(row, colB) ((row) * 256 + ((colB) ^ (((row) & 7) << 4)))
#define SBAR() __builtin_amdgcn_sched_barrier(0)
__device__ __forceinline__ int crow(int r, int hi) { return (r & 3) + 8 * (r >> 2) + 4 * hi; }
__device__ __forceinline__ unsigned cvtpk(float lo, float hi) {
  unsigned r; asm volatile("v_cvt_pk_bf16_f32 %0, %1, %2" : "=v"(r) : "v"(lo), "v"(hi)); return r;
}
template <typename TIn> struct Stage;
template <> struct Stage<bf16>  { using T = bf16x8;
  __device__ static __forceinline__ T ld8(const bf16* p) { return *reinterpret_cast<const bf16x8*>(p); }
  __device__ static __forceinline__ bf16x8 tobf(T x) { return x; } };
template <> struct Stage<float> { using T = f32x8;
  __device__ static __forceinline__ T ld8(const float* p) { return *reinterpret_cast<const f32x8*>(p); }
  __device__ static __forceinline__ bf16x8 tobf(T x) {
    u32x4 w = {cvtpk(x[0], x[1]), cvtpk(x[2], x[3]), cvtpk(x[4], x[5]), cvtpk(x[6], x[7])}; return *reinterpret_cast<bf16x8*>(&w); } };

__device__ __forceinline__ void partialSM(f32x16& p0, f32x16& p1, float& m_reg, float& mn, float& alpha) {
  constexpr float C = SCALE * 1.4426950408889634f;
  float pmax = p0[0]; for (int r = 1; r < 16; ++r) pmax = fmaxf(pmax, p0[r]); for (int r = 0; r < 16; ++r) pmax = fmaxf(pmax, p1[r]);
  { auto rr = __builtin_amdgcn_permlane32_swap(__float_as_uint(pmax), __float_as_uint(pmax), false, false);
    pmax = fmaxf(__uint_as_float(rr[0]), __uint_as_float(rr[1])); }
  if (__builtin_expect(__all(pmax - m_reg <= THR / SCALE), 1)) { mn = m_reg; alpha = 1.f; }
  else { mn = fmaxf(m_reg, pmax); alpha = __builtin_amdgcn_exp2f((m_reg - mn) * C); m_reg = mn; }
  float mnC = -mn * C;
  for (int r = 0; r < 16; ++r) p0[r] = fmaf(p0[r], C, mnC); for (int r = 0; r < 16; ++r) p1[r] = fmaf(p1[r], C, mnC);
  for (int r = 0; r < 16; ++r) p0[r] = __builtin_amdgcn_exp2f(p0[r]);
}
__device__ __forceinline__ void finishSM(f32x16& p0, f32x16& p1, float alpha, float& l_reg, bf16x8& pa0, bf16x8& pa1, bf16x8& pa2, bf16x8& pa3) {
  for (int r = 0; r < 16; ++r) p1[r] = __builtin_amdgcn_exp2f(p1[r]);
  float ps = 0; for (int r = 0; r < 16; ++r) ps += p0[r]; for (int r = 0; r < 16; ++r) ps += p1[r];
  { auto rr = __builtin_amdgcn_permlane32_swap(__float_as_uint(ps), __float_as_uint(ps), false, false);
    ps = __uint_as_float(rr[0]) + __uint_as_float(rr[1]); }
  l_reg = l_reg * alpha + ps;
#define PK4(P, BASE, OUT) do { unsigned a0 = cvtpk(P[BASE + 0], P[BASE + 1]), a1 = cvtpk(P[BASE + 2], P[BASE + 3]);   \
    unsigned b0 = cvtpk(P[BASE + 4], P[BASE + 5]), b1 = cvtpk(P[BASE + 6], P[BASE + 7]);                              \
    auto r0 = __builtin_amdgcn_permlane32_swap(a0, b0, false, false); auto r1 = __builtin_amdgcn_permlane32_swap(a1, b1, false, false); \
    u32x4 w = {r0[0], r1[0], r0[1], r1[1]}; OUT = *reinterpret_cast<bf16x8*>(&w); } while (0)
  PK4(p0, 0, pa0); PK4(p0, 8, pa1); PK4(p1, 0, pa2); PK4(p1, 8, pa3);
#undef PK4
}
__device__ __forceinline__ void qkt(f32x16& p0, f32x16& p1, const bf16* Ks, const bf16x8* qr, int r32, int hi) {
  p0 = f32x16{}; p1 = f32x16{};
  for (int d0 = 0; d0 < 8; ++d0) { int cb = (d0 * 16 + hi * 8) * 2;
    bf16x8 b0 = *reinterpret_cast<const bf16x8*>((const char*)Ks + KSWZ(r32, cb));
    bf16x8 b1 = *reinterpret_cast<const bf16x8*>((const char*)Ks + KSWZ(32 + r32, cb));
    p0 = __builtin_amdgcn_mfma_f32_32x32x16_bf16(b0, qr[d0], p0, 0, 0, 0);
    p1 = __builtin_amdgcn_mfma_f32_32x32x16_bf16(b1, qr[d0], p1, 0, 0, 0); }
}
__device__ __forceinline__ int v_st(int k, int c) { const int kk = (k & ~0xC) | ((k & 4) << 1) | ((k & 8) >> 1); return ((kk >> 3) * 4 + (c >> 5)) * 512 + ((kk & 7) * 32 + (c & 31)) * 2; }
__device__ __forceinline__ int v_rd_base(int lane) { return ((lane & 3) << 3) | (((lane >> 2) & 3) << 6) | (((lane >> 4) & 1) << 5) | (((lane >> 5) & 1) << 8); }
constexpr int v_rd_off(int d0, int ks, int half) { return d0 * 512 + ks * 4096 + half * 2048; }
template <int OFF> __device__ __forceinline__ s16x4 tr_read(int vb) {
  s16x4 r; asm volatile("ds_read_b64_tr_b16 %0, %1 offset:%2" : "=&v"(r) : "v"(vb), "i"(OFF) : "memory"); return r;
}
template <int D0> __device__ __forceinline__ void pv_one(f32x16& od, int vb, bf16x8 pa0, bf16x8 pa1, bf16x8 pa2, bf16x8 pa3) {
  const s16x4 l0 = tr_read<v_rd_off(D0, 0, 0)>(vb), h0 = tr_read<v_rd_off(D0, 0, 1)>(vb), l1 = tr_read<v_rd_off(D0, 1, 0)>(vb), h1 = tr_read<v_rd_off(D0, 1, 1)>(vb);
  const s16x4 l2 = tr_read<v_rd_off(D0, 2, 0)>(vb), h2 = tr_read<v_rd_off(D0, 2, 1)>(vb), l3 = tr_read<v_rd_off(D0, 3, 0)>(vb), h3 = tr_read<v_rd_off(D0, 3, 1)>(vb);
  asm volatile("s_waitcnt lgkmcnt(0)" ::: "memory"); SBAR();
#define PK(L, H) (bf16x8){L[0], L[1], L[2], L[3], H[0], H[1], H[2], H[3]}
  od = __builtin_amdgcn_mfma_f32_32x32x16_bf16(pa0, PK(l0, h0), od, 0, 0, 0);
  od = __builtin_amdgcn_mfma_f32_32x32x16_bf16(pa1, PK(l1, h1), od, 0, 0, 0);
  od = __builtin_amdgcn_mfma_f32_32x32x16_bf16(pa2, PK(l2, h2), od, 0, 0, 0);
  od = __builtin_amdgcn_mfma_f32_32x32x16_bf16(pa3, PK(l3, h3), od, 0, 0, 0);
#undef PK
}
__device__ __forceinline__ void pv_d0(f32x16* o, int vb, bf16x8 pa0, bf16x8 pa1, bf16x8 pa2, bf16x8 pa3) {
  pv_one<0>(o[0], vb, pa0, pa1, pa2, pa3); pv_one<1>(o[1], vb, pa0, pa1, pa2, pa3); pv_one<2>(o[2], vb, pa0, pa1, pa2, pa3); pv_one<3>(o[3], vb, pa0, pa1, pa2, pa3);
}

template <typename TQ>
__device__ __forceinline__ void attn_dense_body(const TQ* __restrict__ Qb, const bf16* __restrict__ Kh, const bf16* __restrict__ Vh,
                                                bf16* __restrict__ Ob, int seq, char* lds) {
  using St = Stage<bf16>; using SQ = Stage<TQ>;
  const int tid = opaque_tid(), wid = tid >> 6, lane = tid & 63, r32 = lane & 31, hi = lane >> 5;
  bf16* V_lds = (bf16*)lds; bf16* K_lds = (bf16*)(lds + 2 * SHM_V);
  float* ws = (float*)(lds + 2 * SHM_V + 2 * SHM_K) + wid * 64; float* li_l = ws; float* al_l = ws + 32;
  float m_reg = -1e30f, l_reg = 0; f32x16 o[4] = {}; bf16x8 qr[8];
  const TQ* Qw = Qb + (long)(wid * QBLK + r32) * LDQ + hi * 8;
#pragma unroll
  for (int d0 = 0; d0 < 8; ++d0) qr[d0] = SQ::tobf(SQ::ld8(Qw + d0 * 16));
  const int sr = tid >> 4, sc = (tid & 15) * 8, vst0 = v_st(sr, sc), vst1 = v_st(32 + sr, sc);
  const int vb0 = (int)(uintptr_t)V_lds + v_rd_base(lane);
  struct { typename St::T vs0, vs1, ks0, ks1; } sr_[SDEPTH];
#define SLOAD(i, k0) do { sr_[i].vs0 = St::ld8(&Vh[(long)((k0) + sr) * LDK + sc]); sr_[i].vs1 = St::ld8(&Vh[(long)((k0) + 32 + sr) * LDK + sc]); \
    sr_[i].ks0 = St::ld8(&Kh[(long)((k0) + sr) * LDK + sc]); sr_[i].ks1 = St::ld8(&Kh[(long)((k0) + 32 + sr) * LDK + sc]); } while (0)
#define SWRITE(b, i) do { *(bf16x8*)((char*)V_lds + (b) * SHM_V + vst0) = St::tobf(sr_[i].vs0);          \
    *(bf16x8*)((char*)V_lds + (b) * SHM_V + vst1) = St::tobf(sr_[i].vs1); int kc = sc * 2;               \
    *(bf16x8*)((char*)K_lds + (b) * SHM_K + KSWZ(sr, kc)) = St::tobf(sr_[i].ks0);                       \
    *(bf16x8*)((char*)K_lds + (b) * SHM_K + KSWZ(32 + sr, kc)) = St::tobf(sr_[i].ks1); } while (0)
#define SWAIT() do { if constexpr (SDEPTH == 2) asm volatile("s_waitcnt vmcnt(4)" ::: "memory"); else asm volatile("s_waitcnt vmcnt(0)" ::: "memory"); } while (0)
#define RESC(a) do { if (__any((a) < 1.f)) { if (hi == 0) al_l[r32] = (a); asm volatile("s_waitcnt lgkmcnt(0)" ::: "memory"); \
    for (int d = 0; d < 4; ++d) for (int r = 0; r < 16; ++r) o[d][r] *= al_l[crow(r, hi)]; } } while (0)
  f32x16 pA0, pA1, pB0, pB1; float mnA, mnB, alA, alB; bf16x8 pa0, pa1, pa2, pa3; const int NT = seq / KVBLK;
  constexpr int SE = 0, SO = SDEPTH - 1;
  SLOAD(SE, 0); asm volatile("s_waitcnt vmcnt(0)" ::: "memory"); SWRITE(0, SE); __syncthreads();
  qkt(pA0, pA1, K_lds, qr, r32, hi); partialSM(pA0, pA1, m_reg, mnA, alA);
  SLOAD(SO, KVBLK); if constexpr (SDEPTH == 2) { if (2 < NT) SLOAD(SE, 2 * KVBLK); }
  SWAIT(); SWRITE(1, SO); __syncthreads();
  for (int j = 1; j + 1 < NT; j += 2) {
    SBAR(); qkt(pB0, pB1, (bf16*)((char*)K_lds + SHM_K), qr, r32, hi);
    finishSM(pA0, pA1, alA, l_reg, pa0, pa1, pa2, pa3); SBAR();
    SLOAD(SO, (j + SDEPTH) * KVBLK); SBAR();
    pv_d0(o, vb0, pa0, pa1, pa2, pa3); partialSM(pB0, pB1, m_reg, mnB, alB);
    __syncthreads(); SWAIT(); SWRITE(0, SE);
    RESC(alB); __syncthreads();
    SBAR(); qkt(pA0, pA1, K_lds, qr, r32, hi);
    finishSM(pB0, pB1, alB, l_reg, pa0, pa1, pa2, pa3); SBAR();
    if (SDEPTH == 1 || j + 3 < NT) SLOAD(SE, (j + 1 + SDEPTH) * KVBLK); SBAR();
    pv_d0(o, vb0 + (int)SHM_V, pa0, pa1, pa2, pa3); partialSM(pA0, pA1, m_reg, mnA, alA);
    __syncthreads(); SWAIT(); SWRITE(1, SO);
    RESC(alA); __syncthreads();
  }
  SBAR(); qkt(pB0, pB1, (bf16*)((char*)K_lds + SHM_K), qr, r32, hi);
  finishSM(pA0, pA1, alA, l_reg, pa0, pa1, pa2, pa3); SBAR();
  pv_d0(o, vb0, pa0, pa1, pa2, pa3); partialSM(pB0, pB1, m_reg, mnB, alB);
  __syncthreads(); RESC(alB);
  finishSM(pB0, pB1, alB, l_reg, pa0, pa1, pa2, pa3); SBAR();
  pv_d0(o, vb0 + (int)SHM_V, pa0, pa1, pa2, pa3);
  if (hi == 0) li_l[r32] = l_reg; asm volatile("s_waitcnt lgkmcnt(0)" ::: "memory");
  float rli[16];
#pragma unroll
  for (int r = 0; r < 16; ++r) rli[r] = __builtin_amdgcn_rcpf(li_l[crow(r, hi)]);
  bf16* Ow = Ob + (long)(wid * QBLK) * LDO;
#pragma unroll
  for (int r = 0; r < 16; ++r) { int orow = crow(r, hi);
    for (int d0 = 0; d0 < 4; ++d0) Ow[(long)orow * LDO + d0 * 32 + r32] = __float2bfloat16(o[d0][r] * rli[r]); }
#undef SLOAD
#undef SWRITE
#undef SWAIT
#undef RESC
}

}
#define LAS __attribute__((address_space(3)))
typedef unsigned short bf16_t;
typedef short bf16x8 __attribute__((ext_vector_type(8)));
typedef short s16x4 __attribute__((ext_vector_type(4)));
typedef float f32x4 __attribute__((ext_vector_type(4)));
typedef float f32x16 __attribute__((ext_vector_type(16)));
typedef unsigned u32x4 __attribute__((ext_vector_type(4)));
typedef unsigned u32x2 __attribute__((ext_vector_type(2)));
using pg8::cvtpk_s; using pg8::bf_lo; using pg8::bf_hi; using pg8::silu_f;

constexpr int DM = 1024, SEQ = 16384, CTXL = 256, NLAT = 2 * SEQ, MROWS = NLAT + 2 * CTXL, DFF = 4096;
constexpr float EPS = 1e-6f;
constexpr size_t MiB = 1u << 20;
constexpr size_t WS_BAR = 512 * 1024, WS_BAR_BYTES = 16384;
constexpr size_t WS_MOD = 0, WS_CTX = 1 * MiB, WS_WT = 4 * MiB, WS_H = 41 * MiB, WS_AB = 106 * MiB, WS_RSTD = 115 * MiB, WS_P = 118 * MiB, WS_O = 378 * MiB, WS_END = 508 * MiB;
constexpr size_t WT_A = WS_WT, WT_Z = WS_WT + 9 * MiB, WT_O = WS_WT + 13 * MiB, WT_1 = WS_WT + 17 * MiB, WT_2 = WS_WT + 25 * MiB;
constexpr size_t WS_QM = 313 * MiB, WS_KM = 378 * MiB, WS_OGLA = 443 * MiB, WS_AQ = 41 * MiB, WS_EL = 74 * MiB;
constexpr size_t WS_TP = 4 * MiB, WS_HALO = 378 * MiB;
constexpr size_t WS_QR = 216 * MiB, WS_KR = 281 * MiB, WS_VR = 298 * MiB;
constexpr int SKV = SEQ + CTXL;
constexpr int LDS_BYTES = 155648;
enum { OP_MOD, OP_PREP, OP_GEMM_IN, OP_DNSCAN, OP_DNREDO, OP_GEMM_Z, OP_GEMM_OUT, OP_NORM2, OP_FFN1, OP_FFN2, OP_GLAPREP, OP_GLASCAN, OP_GLAGATE, OP_QKROPE, OP_ATTN, OP_DNHALO, OP_DNCONV, OP_DNT };

struct Args { const float* in[25]; float* out; unsigned char* ws; int ph_lo, ph_hi; };

__device__ __forceinline__ float wave_sum(float v) {
#pragma unroll
    for (int o = 1; o < 64; o <<= 1) v += __shfl_xor(v, o);
    return v;
}
__device__ __forceinline__ float softplus_f(float x) { return x > 20.f ? x : log1pf(__expf(x)); }
__device__ __forceinline__ float logsigmoid_f(float x) { return fminf(x, 0.f) - log1pf(__expf(-fabsf(x))); }
__device__ __forceinline__ bf16_t f2bf(float f) { return (bf16_t)(cvtpk_s(f, 0.f) & 0xffffu); }
__device__ __forceinline__ float bf2f(bf16_t v) { return __builtin_bit_cast(float, (unsigned)v << 16); }

__device__ __forceinline__ void transpose_item(const float* W, int ldw, int c0, int ncols, int K, bf16_t* WT, int row_off, LAS float* scr, int item, int lane) {
    const int nblk = ncols / 32, kb = item / nblk, nb = item % nblk, k0 = 64 * kb, n0 = 32 * nb;
#pragma unroll 8
    for (int i = 0; i < 32; ++i) { const int kk = 2 * i + (lane >> 5); scr[kk * 33 + (lane & 31)] = W[(size_t)(k0 + kk) * ldw + c0 + n0 + (lane & 31)]; }
    asm volatile("s_waitcnt lgkmcnt(0)" ::: "memory");
    const int c = lane & 7;
#pragma unroll
    for (int j = 0; j < 4; ++j) { const int n = (lane >> 3) + 8 * j; const LAS float* s = scr + (8 * c) * 33 + n;
        u32x4 o; o.x = cvtpk_s(s[0 * 33], s[1 * 33]); o.y = cvtpk_s(s[2 * 33], s[3 * 33]); o.z = cvtpk_s(s[4 * 33], s[5 * 33]); o.w = cvtpk_s(s[6 * 33], s[7 * 33]);
        *(u32x4*)(WT + (size_t)(row_off + n0 + n) * K + k0 + 8 * c) = o; }
    asm volatile("s_waitcnt lgkmcnt(0)" ::: "memory");
}
__device__ __forceinline__ void transpose_mat(const float* W, int ldw, int c0, int ncols, int K, bf16_t* WT, int row_off, LAS float* scr, int gw, int NGW, int lane) {
    const int nitems = (K / 64) * (ncols / 32);
    for (int it = gw; it < nitems; it += NGW) transpose_item(W, ldw, c0, ncols, K, WT, row_off, scr, it, lane);
}
__device__ __forceinline__ void normmod_rows(const float* xl, const float* xc, const float* g, const float* modl, int sidx, bf16_t* H, int gw, int NGW, int lane) {
    for (int row = gw; row < MROWS; row += NGW) {
        const float* xr = row < NLAT ? xl + (size_t)row * DM : xc + (size_t)(row - NLAT) * DM;
        const int mi = row < SEQ ? 0 : (row < NLAT ? 1 : 2);
        const float* sh = modl + (size_t)mi * 6144 + (size_t)sidx * 1024; const float* sc = sh + 1024;
        f32x4 v[4]; float ss = 0.f;
#pragma unroll
        for (int j = 0; j < 4; ++j) { v[j] = *(const f32x4*)(xr + 4 * lane + 256 * j); ss += (v[j][0] * v[j][0] + v[j][1] * v[j][1]) + (v[j][2] * v[j][2] + v[j][3] * v[j][3]); }
        const float rinv = rsqrtf(wave_sum(ss) * (1.f / DM) + EPS);
#pragma unroll
        for (int j = 0; j < 4; ++j) { const int c = 4 * lane + 256 * j; const f32x4 gg = *(const f32x4*)(g + c), s1 = *(const f32x4*)(sc + c), s0 = *(const f32x4*)(sh + c);
            f32x4 y;
#pragma unroll
            for (int e = 0; e < 4; ++e) y[e] = v[j][e] * rinv * gg[e] * (1.f + s1[e]) + s0[e];
            u32x2 w; w.x = cvtpk_s(y[0], y[1]); w.y = cvtpk_s(y[2], y[3]); *(u32x2*)(H + (size_t)row * DM + c) = w; }
    }
}
#define BAR_LDS() do { asm volatile("s_waitcnt lgkmcnt(0)" ::: "memory"); __builtin_amdgcn_s_barrier(); asm volatile("" ::: "memory"); } while (0)
__device__ __forceinline__ int crow(int x, int h) { return (x & 3) + 8 * (x >> 2) + 4 * h; }
#define MFMA32(a, b, c) __builtin_amdgcn_mfma_f32_32x32x16_bf16((a), (b), (c), 0, 0, 0)
__device__ __forceinline__ bf16x8 frag_nat(const LAS bf16_t* img, int LD, int row, int ks, int h) { return *(const LAS bf16x8*)(img + row * LD + 16 * ks + 8 * h); }
__device__ __forceinline__ bf16x8 frag_perm(const LAS bf16_t* img, int LD, int row, int ks, int h) {
    const s16x4 lo = *(const LAS s16x4*)(img + row * LD + 16 * ks + 4 * h), hi = *(const LAS s16x4*)(img + row * LD + 16 * ks + 8 + 4 * h);
    return __builtin_shufflevector(lo, hi, 0, 1, 2, 3, 4, 5, 6, 7);
}
__device__ __forceinline__ s16x4 tr4(const LAS bf16_t* p) { return __builtin_bit_cast(s16x4, __builtin_amdgcn_ds_read_tr16_b64_v4i16((LAS s16x4*)p)); }
__device__ __forceinline__ bf16x8 frag_tr(const LAS bf16_t* img, int LD, int m0, int ks, int lane) {
    const int i16 = lane & 15, q = i16 >> 2, p = i16 & 3, blk = (lane >> 4) & 1, h = lane >> 5;
    const LAS bf16_t* a = img + (16 * ks + 4 * h + q) * LD + m0 + 16 * blk + 4 * p;
    const s16x4 lo = tr4(a), hi = tr4(a + 8 * LD);
    return __builtin_shufflevector(lo, hi, 0, 1, 2, 3, 4, 5, 6, 7);
}
__device__ __forceinline__ bf16x8 pack_step(const f32x16& x, int s) {
    u32x4 p; p.x = cvtpk_s(x[8 * s + 0], x[8 * s + 1]); p.y = cvtpk_s(x[8 * s + 2], x[8 * s + 3]); p.z = cvtpk_s(x[8 * s + 4], x[8 * s + 5]); p.w = cvtpk_s(x[8 * s + 6], x[8 * s + 7]);
    return __builtin_bit_cast(bf16x8, p);
}
__device__ __forceinline__ void dn_halo_phase(const bf16_t* P, bf16_t* HALO, int G) {
    const int tid = opaque_tid();
    for (size_t e = (size_t)blockIdx.x * 512 + tid; e < (size_t)520 * 4 * 512; e += (size_t)G * 512) {
        const int c = (int)(e & 511), j = (int)((e >> 9) & 3), rb = (int)(e >> 11);
        const int row = rb * 64 + (j < 2 ? j : 60 + j);
        ((u32x4*)(HALO + ((size_t)rb * 4 + j) * 4096))[c] = ((const u32x4*)(P + (size_t)row * 4096))[c];
    }
}
__device__ __forceinline__ void unpack8(const u32x4 v, float (&f)[8]) { f[0] = bf_lo(v.x); f[1] = bf_hi(v.x); f[2] = bf_lo(v.y); f[3] = bf_hi(v.y); f[4] = bf_lo(v.z); f[5] = bf_hi(v.z); f[6] = bf_lo(v.w); f[7] = bf_hi(v.w); }
__device__ __forceinline__ void dn_conv_phase(bf16_t* P, const bf16_t* HALO, const float* conv_w, int G) {
    const int tid = opaque_tid(), col0 = 8 * tid;
    float cw[8][5];
#pragma unroll
    for (int c = 0; c < 8; ++c)
#pragma unroll
        for (int tap = 0; tap < 5; ++tap) cw[c][tap] = conv_w[(size_t)(col0 + c) * 5 + tap];
    const int kind = col0 < 1024 ? 0 : (col0 < 2048 ? 1 : 2);
    for (int rb = blockIdx.x; rb < 520; rb += G) {
        const int cs = rb < 512 ? (rb & 255) : ((rb - 512) & 3); const bool sfirst = cs == 0, slast = rb < 512 ? cs == 255 : cs == 3;
        const u32x4 zero = (u32x4){0u, 0u, 0u, 0u};
        bf16_t* base = P + (size_t)rb * 64 * 4096 + col0;
        u32x4 w0 = sfirst ? zero : *(const u32x4*)(HALO + ((size_t)(rb - 1) * 4 + 2) * 4096 + col0);
        u32x4 w1 = sfirst ? zero : *(const u32x4*)(HALO + ((size_t)(rb - 1) * 4 + 3) * 4096 + col0);
        u32x4 w2 = *(const u32x4*)(base), w3 = *(const u32x4*)(base + 4096);
#pragma unroll 4
        for (int rr = 0; rr < 64; ++rr) {
            u32x4 w4;
            if (rr + 2 < 64) w4 = *(const u32x4*)(base + (size_t)(rr + 2) * 4096);
            else w4 = slast ? zero : *(const u32x4*)(HALO + ((size_t)(rb + 1) * 4 + (rr + 2 - 64)) * 4096 + col0);
            float x0[8], x1[8], x2[8], x3[8], x4[8], y[8];
            unpack8(w0, x0); unpack8(w1, x1); unpack8(w2, x2); unpack8(w3, x3); unpack8(w4, x4);
            float ss = 0.f;
#pragma unroll
            for (int c = 0; c < 8; ++c) { const float a = x0[c] * cw[c][0] + x1[c] * cw[c][1] + x2[c] * cw[c][2] + x3[c] * cw[c][3] + x4[c] * cw[c][4]; y[c] = silu_f(a); ss += y[c] * y[c]; }
            float sc = 1.f;
            if (kind < 2) { ss += __shfl_xor(ss, 1); ss += __shfl_xor(ss, 2); ss += __shfl_xor(ss, 4); ss += __shfl_xor(ss, 8); sc = rsqrtf(ss + EPS) * (kind == 0 ? 0.08838834764831845f : 1.f); }
            u32x4 o; o.x = cvtpk_s(y[0] * sc, y[1] * sc); o.y = cvtpk_s(y[2] * sc, y[3] * sc); o.z = cvtpk_s(y[4] * sc, y[5] * sc); o.w = cvtpk_s(y[6] * sc, y[7] * sc);
            *(u32x4*)(base + (size_t)rr * 4096) = o;
            w0 = w1; w1 = w2; w2 = w3; w3 = w4;
        }
    }
}
constexpr int DT_KB = 0, DT_R = 17408, DT_SC = 33792, DT_DIR = 34816;
template <int W> __device__ __forceinline__ void dn_solve(const LAS float* Mf, float (&t)[16], int lane) {
    const int j = 16 * W + (lane >> 2), q = lane & 3;
#pragma unroll
    for (int s = 0; s < 16; ++s) t[s] = 0.f;
#pragma unroll
    for (int i = 16 * W; i < 64; ++i) {
        float acc = 0.f;
#pragma unroll
        for (int s = 4 * W; s <= (i - 1) / 4 && i > 16 * W; ++s) acc += Mf[i * 64 + 4 * s + q] * t[s];
        acc += __shfl_xor(acc, 1); acc += __shfl_xor(acc, 2);
        const float val = (i == j ? 1.f : 0.f) - acc;
        if (q == (i & 3)) t[i >> 2] = val;
        asm volatile("" : "+v"(t[0]), "+v"(t[1]), "+v"(t[2]), "+v"(t[3]), "+v"(t[4]), "+v"(t[5]), "+v"(t[6]), "+v"(t[7]), "+v"(t[8]), "+v"(t[9]), "+v"(t[10]), "+v"(t[11]), "+v"(t[12]), "+v"(t[13]), "+v"(t[14]), "+v"(t[15]));
    }
}
__device__ __forceinline__ void dn_t_phase(LAS unsigned char* lds, const bf16_t* P, float* AB, bf16_t* TP, const float* a_log, const float* dt_bias, int G) {
    const int tid0 = opaque_tid(), hb = __builtin_amdgcn_readfirstlane(tid0 >> 8);
    for (int itb = blockIdx.x * 2; itb < 16640; itb += 2 * G) {
        const int it = itb + hb, dir = it & 1, vh = (it >> 1) & 15, rb = it >> 5, kh = vh >> 1;
        const int tq = opaque_tid(), t = tq & 255, w = __builtin_amdgcn_readfirstlane((tq >> 6) & 3), lane = tq & 63, r = lane & 31, h = lane >> 5;
        LAS unsigned char* base = lds + hb * DT_DIR;
        LAS bf16_t* Kb = (LAS bf16_t*)(base + DT_KB); LAS float* Mf = (LAS float*)(base + DT_R); LAS bf16_t* Tb = (LAS bf16_t*)(base + DT_R);
        LAS float* sc_beta = (LAS float*)(base + DT_SC); LAS float* sc_gc = sc_beta + 64;
        {
            const int r0 = t >> 4, c8 = 8 * (t & 15);
#pragma unroll
            for (int v = 0; v < 4; ++v) { const int i = r0 + 16 * v, ip = dir ? 63 - i : i;
                *(LAS u32x4*)(Kb + ip * 136 + c8) = *(const u32x4*)(P + (size_t)(rb * 64 + i) * 4096 + 1024 + kh * 128 + c8); }
            if (t < 64) {
                const int ti = dir ? 63 - t : t; float* ab = AB + (size_t)(rb * 64 + ti) * 64;
                const float av = ab[dir * 16 + vh], bv = ab[32 + dir * 16 + vh];
                const float g = -__expf(a_log[dir * 16 + vh]) * softplus_f(av + dt_bias[dir * 16 + vh]), beta = 1.f / (1.f + __expf(-bv));
                float gc = g;
#pragma unroll
                for (int o = 1; o < 64; o <<= 1) { const float up = __shfl_up(gc, o); if (t >= o) gc += up; }
                sc_beta[t] = beta; sc_gc[t] = gc;
                ab[dir * 16 + vh] = gc; ab[32 + dir * 16 + vh] = beta;
            }
        }
        __syncthreads();
        const int ti = w >> 1, tj = w & 1;
        {
            f32x16 acc;
#pragma unroll
            for (int x = 0; x < 16; ++x) acc[x] = 0.f;
            if (!(ti == 0 && tj == 1)) {
#pragma unroll
                for (int ks = 0; ks < 8; ++ks) acc = MFMA32(frag_nat(Kb, 136, 32 * ti + r, ks, h), frag_nat(Kb, 136, 32 * tj + r, ks, h), acc);
            }
            const int j = 32 * tj + r; const float gj = sc_gc[j];
#pragma unroll
            for (int x = 0; x < 16; ++x) { const int i = 32 * ti + crow(x, h);
                Mf[i * 64 + j] = (i > j) ? sc_beta[i] * acc[x] * __expf(sc_gc[i] - gj) : 0.f; }
        }
        __syncthreads();
        float tc[16];
        if (w == 0) dn_solve<0>(Mf, tc, lane); else if (w == 1) dn_solve<1>(Mf, tc, lane); else if (w == 2) dn_solve<2>(Mf, tc, lane); else dn_solve<3>(Mf, tc, lane);
        __syncthreads();
        {
            const int j = 16 * w + (lane >> 2), q = lane & 3;
#pragma unroll
            for (int s = 0; s < 16; ++s) Tb[(4 * s + q) * 72 + j] = f2bf(tc[s]);
        }
        __syncthreads();
        {
            bf16_t* dst = TP + (size_t)it * 3072;
#pragma unroll
            for (int k2 = 0; k2 < 2; ++k2) { const int c = t + 256 * k2;
                if (c < 384) { const int blk = c >> 7, rowc = (c & 127) >> 2, cc = c & 3, br = blk ? 1 : 0, bc = blk == 2 ? 1 : 0;
                    *(u32x4*)(dst + c * 8) = *(const LAS u32x4*)(Tb + (32 * br + rowc) * 72 + 32 * bc + 8 * cc); } }
        }
        __syncthreads();
    }
}
constexpr int DN_KB = 0, DN_QB = 17408, DN_VB = 34816, DN_TB = 51200, DN_AB = 60416, DN_SC = 69632, DN_DIR = 71168;
__device__ __forceinline__ void dn_step_rb(int step, int dir, int b, int& rb, bool& first) {
    if (step < 4) { const int cidx = dir ? 3 - step : step; rb = 512 + b * 4 + cidx; first = step < 2; }
    else { const int c = step - 4; const int cidx = dir ? 255 - c : c; rb = b * 256 + cidx; first = c < 128; }
}
struct DnPre { u32x4 k4[4], q4[4], v4[4], t0, t1; float gc, beta; };
__device__ __forceinline__ void dn_prefetch(DnPre& p, const bf16_t* P, const float* AB, const bf16_t* TP, int rb, int dir, int vh, int kh, int t, int part) {
    const int r0 = t >> 4, c8 = 8 * (t & 15);
    const bf16_t* prow = P + (size_t)(rb * 64 + r0) * 4096 + c8;
    const bf16_t* tp = TP + (size_t)((rb * 16 + vh) * 2 + dir) * 3072;
    if (part & 1) {
#pragma unroll
        for (int v = 0; v < 4; ++v) { const bf16_t* pr = prow + (size_t)(16 * v) * 4096;
            p.k4[v] = *(const u32x4*)(pr + 1024 + kh * 128); p.q4[v] = *(const u32x4*)(pr + kh * 128); p.v4[v] = *(const u32x4*)(pr + 2048 + vh * 128); }
    }
    if (part & 2) {
        p.t0 = *(const u32x4*)(tp + t * 8); p.t1 = *(const u32x4*)(tp + (256 + (t & 127)) * 8);
        const int ti = dir ? 63 - (t & 63) : (t & 63); const float* ab = AB + (size_t)(rb * 64 + ti) * 64; p.gc = ab[dir * 16 + vh]; p.beta = ab[32 + dir * 16 + vh];
    }
}
template <int VAR> __device__ __forceinline__ void dn_scan(LAS unsigned char* lds, const bf16_t* P, const float* AB, const bf16_t* TP, bf16_t* OB) {
    const int tid = opaque_tid(), dir = __builtin_amdgcn_readfirstlane(tid >> 8);
    for (int unit = blockIdx.x; unit < 32; unit += gridDim.x) {
        const int b = unit >> 4, vh = unit & 15, kh = vh >> 1;
        f32x16 S[4];
#pragma unroll
        for (int kt = 0; kt < 4; ++kt)
#pragma unroll
            for (int x = 0; x < 16; ++x) S[kt][x] = 0.f;
        DnPre pre;
        { int rb0; bool f0; dn_step_rb(0, dir, b, rb0, f0); dn_prefetch(pre, P, AB, TP, rb0, dir, vh, kh, tid & 255, 3); }
        __syncthreads();
        for (int step = 0; step < 260; ++step) {
            const int w = __builtin_amdgcn_readfirstlane((opaque_tid() >> 6) & 3);
            LAS unsigned char* base = lds + dir * DN_DIR;
            LAS bf16_t* Kb = (LAS bf16_t*)(base + DN_KB); LAS bf16_t* Qb = (LAS bf16_t*)(base + DN_QB); LAS bf16_t* Vb = (LAS bf16_t*)(base + DN_VB);
            LAS bf16_t* Tb = (LAS bf16_t*)(base + DN_TB); LAS bf16_t* Ab = (LAS bf16_t*)(base + DN_AB);
            LAS float* sc_beta = (LAS float*)(base + DN_SC); LAS float* sc_gc = sc_beta + 64; LAS float* sc_eg = sc_beta + 128; LAS float* sc_tail = sc_beta + 192; LAS float* sc_dl = sc_beta + 256;
            int rb; bool first; dn_step_rb(step, dir, b, rb, first);
            const int row_base = rb * 64;
            {
                const int tq_ = opaque_tid(), t = tq_ & 255;
                const int r0 = t >> 4, c8 = 8 * (t & 15);
#pragma unroll
                for (int v = 0; v < 4; ++v) { const int i = r0 + 16 * v, ip = dir ? 63 - i : i;
                    *(LAS u32x4*)(Kb + ip * 136 + c8) = pre.k4[v]; *(LAS u32x4*)(Qb + ip * 136 + c8) = pre.q4[v]; *(LAS u32x4*)(Vb + ip * 128 + c8) = pre.v4[v]; }
                { const int c = t, blk = c >> 7, rowc = (c & 127) >> 2, cc = c & 3, br = blk ? 1 : 0; *(LAS u32x4*)(Tb + (32 * br + rowc) * 72 + 8 * cc) = pre.t0; }
                if (t < 128) { const int rowc = t >> 2, cc = t & 3; *(LAS u32x4*)(Tb + (32 + rowc) * 72 + 32 + 8 * cc) = pre.t1; }
                if (t < 64) { const float gc = pre.gc, gl = __shfl(gc, 63); sc_beta[t] = pre.beta; sc_gc[t] = gc; sc_eg[t] = __expf(gc); sc_tail[t] = __expf(gl - gc); if (t == 0) sc_dl[0] = __expf(gl); }
            }
            BAR_LDS();
            {
                const int tq_ = opaque_tid(), lane = tq_ & 63, r = lane & 31, h = lane >> 5;
                const int ti = w >> 1, tj = w & 1;
                if (!(ti == 0 && tj == 1)) {
                    f32x16 qk;
#pragma unroll
                    for (int x = 0; x < 16; ++x) qk[x] = 0.f;
#pragma unroll
                    for (int ks = 0; ks < 8; ++ks) qk = MFMA32(frag_nat(Qb, 136, 32 * ti + r, ks, h), frag_nat(Kb, 136, 32 * tj + r, ks, h), qk);
                    const int jj = 32 * tj + r; const float gj = sc_gc[jj];
#pragma unroll
                    for (int x = 0; x < 16; ++x) { const int i = 32 * ti + crow(x, h);
                        Ab[i * 72 + jj] = f2bf((i >= jj) ? qk[x] * __expf(sc_gc[i] - gj) : 0.f); }
                }
            }
            BAR_LDS();
            if (VAR != 2 && step + 1 < 260) { int rbn; bool fn; dn_step_rb(step + 1, dir, b, rbn, fn); dn_prefetch(pre, P, AB, TP, rbn, dir, vh, kh, opaque_tid() & 255, 1); }
            __builtin_amdgcn_sched_barrier(0);
            if (VAR != 1) {
                const int tq_ = opaque_tid(), lane = tq_ & 63, r = lane & 31, h = lane >> 5;
                f32x16 KS[2], QS[2];
#pragma unroll
                for (int mt = 0; mt < 2; ++mt)
#pragma unroll
                    for (int x = 0; x < 16; ++x) { KS[mt][x] = 0.f; QS[mt][x] = 0.f; }
#pragma unroll
                for (int ks = 0; ks < 8; ++ks) {
                    const bf16x8 sp = pack_step(S[ks >> 1], ks & 1);
#pragma unroll
                    for (int mt = 0; mt < 2; ++mt) { KS[mt] = MFMA32(frag_perm(Kb, 136, 32 * mt + r, ks, h), sp, KS[mt]); QS[mt] = MFMA32(frag_perm(Qb, 136, 32 * mt + r, ks, h), sp, QS[mt]); }
                    if (ks & 1) __builtin_amdgcn_sched_barrier(0);
                }
#pragma unroll
                for (int mt = 0; mt < 2; ++mt)
#pragma unroll
                    for (int x = 0; x < 16; ++x) { const int i = 32 * mt + crow(x, h);
                        KS[mt][x] = sc_beta[i] * (bf2f(Vb[i * 128 + 32 * w + r]) - sc_eg[i] * KS[mt][x]); }
                __builtin_amdgcn_sched_barrier(0);
                bf16x8 Xp[4];
#pragma unroll
                for (int ks = 0; ks < 4; ++ks) Xp[ks] = pack_step(KS[ks >> 1], ks & 1);
                f32x16 VN[2];
#pragma unroll
                for (int mt = 0; mt < 2; ++mt) {
#pragma unroll
                    for (int x = 0; x < 16; ++x) VN[mt][x] = 0.f;
#pragma unroll
                    for (int ks = 0; ks < 4; ++ks) if (ks < 2 * mt + 2) VN[mt] = MFMA32(frag_perm(Tb, 72, 32 * mt + r, ks, h), Xp[ks], VN[mt]);
                }
                __builtin_amdgcn_sched_barrier(0);
                if (VAR != 2 && step + 1 < 260) { int rbn; bool fn; dn_step_rb(step + 1, dir, b, rbn, fn); dn_prefetch(pre, P, AB, TP, rbn, dir, vh, kh, opaque_tid() & 255, 2); }
                __builtin_amdgcn_sched_barrier(0);
                bf16x8 VNp[4];
#pragma unroll
                for (int ks = 0; ks < 4; ++ks) VNp[ks] = pack_step(VN[ks >> 1], ks & 1);
#pragma unroll
                for (int mt = 0; mt < 2; ++mt) {
#pragma unroll
                    for (int x = 0; x < 16; ++x) QS[mt][x] *= sc_eg[32 * mt + crow(x, h)];
#pragma unroll
                    for (int ks = 0; ks < 4; ++ks) if (ks < 2 * mt + 2) QS[mt] = MFMA32(frag_perm(Ab, 72, 32 * mt + r, ks, h), VNp[ks], QS[mt]);
                }
                __builtin_amdgcn_sched_barrier(0);
#pragma unroll
                for (int mt = 0; mt < 2; ++mt)
#pragma unroll
                    for (int x = 0; x < 16; ++x) Vb[(32 * mt + crow(x, h)) * 128 + 32 * w + r] = f2bf(QS[mt][x]);
                __builtin_amdgcn_sched_barrier(0);
#pragma unroll
                for (int mt = 0; mt < 2; ++mt)
#pragma unroll
                    for (int x = 0; x < 16; ++x) VN[mt][x] *= sc_tail[32 * mt + crow(x, h)];
#pragma unroll
                for (int ks = 0; ks < 4; ++ks) VNp[ks] = pack_step(VN[ks >> 1], ks & 1);
                __builtin_amdgcn_sched_barrier(0);
                const float dl = sc_dl[0];
#pragma unroll
                for (int kt = 0; kt < 4; ++kt)
#pragma unroll
                    for (int x = 0; x < 16; ++x) S[kt][x] *= dl;
#pragma unroll
                for (int ks = 0; ks < 4; ++ks) {
#pragma unroll
                    for (int kt = 0; kt < 4; ++kt) S[kt] = MFMA32(frag_tr(Kb, 136, 32 * kt, ks, lane), VNp[ks], S[kt]);
                    __builtin_amdgcn_sched_barrier(0);
                }
                if (VAR != 2) {
                    const int rr_ = lane >> 2, c8_ = 8 * (lane & 3);
#pragma unroll
                    for (int v = 0; v < 4; ++v) { const int ip_ = rr_ + 16 * v, i_ = dir ? 63 - ip_ : ip_;
                        u32x4* gp_ = (u32x4*)(OB + (size_t)(row_base + i_) * 2048 + vh * 128 + 32 * w + c8_);
                        u32x4 o = *(const LAS u32x4*)(Vb + ip_ * 128 + 32 * w + c8_);
                        if (!first) { const u32x4 e = gp_[0];
                            o.x = cvtpk_s(bf_lo(o.x) + bf_lo(e.x), bf_hi(o.x) + bf_hi(e.x)); o.y = cvtpk_s(bf_lo(o.y) + bf_lo(e.y), bf_hi(o.y) + bf_hi(e.y));
                            o.z = cvtpk_s(bf_lo(o.z) + bf_lo(e.z), bf_hi(o.z) + bf_hi(e.z)); o.w = cvtpk_s(bf_lo(o.w) + bf_lo(e.w), bf_hi(o.w) + bf_hi(e.w)); }
                        gp_[0] = o; }
                }
            }
            if (step == 1 || step == 131) asm volatile("s_waitcnt vmcnt(0)" ::: "memory");
            BAR_LDS();
        }
    }
}
constexpr int GP_QM = 0, GP_KM = 17408, GP_AB = 34816, GP_LOW = 44032, GP_TOT = 48128, GP_DIR = 49152;
__device__ __forceinline__ void gla_prep_phase(LAS unsigned char* lds, const bf16_t* P, const float* LOW, const float* gw2, const float* gb2, bf16_t* QM, bf16_t* KM, bf16_t* AQ, float* EL, int G) {
    const int tid0 = opaque_tid(), hb = __builtin_amdgcn_readfirstlane(tid0 >> 8);
    for (int itb = blockIdx.x * 2; itb < 4160; itb += 2 * G) {
        const int it = itb + hb, dir = it & 1, head = (it >> 1) & 3, rb = it >> 3;
        const int tq = opaque_tid(), t = tq & 255, w = __builtin_amdgcn_readfirstlane((tq >> 6) & 3), lane = tq & 63, r = lane & 31, h = lane >> 5;
        LAS unsigned char* base = lds + hb * GP_DIR;
        LAS bf16_t* Qm = (LAS bf16_t*)(base + GP_QM); LAS bf16_t* Km = (LAS bf16_t*)(base + GP_KM); LAS bf16_t* Ab = (LAS bf16_t*)(base + GP_AB);
        LAS float* lowS = (LAS float*)(base + GP_LOW); LAS float* tot = (LAS float*)(base + GP_TOT);
        *(LAS f32x4*)(lowS + 4 * t) = *(const f32x4*)(LOW + (size_t)(rb * 64 + (t >> 2)) * 32 + dir * 16 + 4 * (t & 3));
        const int dk = t & 127, half = t >> 7, col = head * 128 + dk;
        float w2c[16];
#pragma unroll
        for (int rr = 0; rr < 16; ++rr) w2c[rr] = gw2[(size_t)(dir * 16 + rr) * 512 + col];
        const float b2 = gb2[dir * 512 + col];
        __syncthreads();
        float bc[32]; float run = 0.f;
#pragma unroll
        for (int n = 0; n < 32; ++n) { const int ip = 32 * half + n, i = dir ? 63 - ip : ip; float s = b2;
#pragma unroll
            for (int rr = 0; rr < 16; ++rr) s += lowS[i * 16 + rr] * w2c[rr];
            run += logsigmoid_f(s) * (1.f / 16.f); bc[n] = run; }
        tot[half * 128 + dk] = run;
        __syncthreads();
        const float t0 = tot[dk], last = t0 + tot[128 + dk], off = half ? t0 : 0.f;
        if (half == 0) EL[(size_t)(dir * 520 + rb) * 512 + col] = last;
        {
            const int i0 = dir ? 63 - 32 * half : 32 * half; const long pstep = dir ? -3072 : 3072;
            const bf16_t* pp = P + (size_t)(rb * 64 + i0) * 3072 + col;
#pragma unroll
            for (int n = 0; n < 32; ++n) { const int ip = 32 * half + n; const float bcv = bc[n] + off;
                const float qv = bf2f(pp[0]), kv = bf2f(pp[512]); pp += pstep;
                Qm[ip * 136 + dk] = f2bf(qv * 0.08838834764831845f * __expf(bcv - last));
                Km[ip * 136 + dk] = f2bf(kv * __expf(last - bcv)); }
        }
        __syncthreads();
        {
            const int ti = w >> 1, tj = w & 1;
            f32x16 acc;
#pragma unroll
            for (int x = 0; x < 16; ++x) acc[x] = 0.f;
            if (!(ti == 0 && tj == 1)) {
#pragma unroll
                for (int ks = 0; ks < 8; ++ks) acc = MFMA32(frag_nat(Qm, 136, 32 * ti + r, ks, h), frag_nat(Km, 136, 32 * tj + r, ks, h), acc);
            }
            const int j = 32 * tj + r;
#pragma unroll
            for (int x = 0; x < 16; ++x) { const int i = 32 * ti + crow(x, h); Ab[i * 72 + j] = f2bf(i >= j ? acc[x] : 0.f); }
            const int r0 = t >> 4, c8 = 8 * (t & 15);
#pragma unroll
            for (int v = 0; v < 4; ++v) { const int row = r0 + 16 * v; const size_t go = ((size_t)dir * MROWS + rb * 64 + row) * 512 + head * 128 + c8;
                *(u32x4*)(QM + go) = *(const LAS u32x4*)(Qm + row * 136 + c8); *(u32x4*)(KM + go) = *(const LAS u32x4*)(Km + row * 136 + c8); }
        }
        __syncthreads();
        {
            bf16_t* dst = AQ + (size_t)it * 4096;
#pragma unroll
            for (int k2 = 0; k2 < 2; ++k2) { const int c = t + 256 * k2, row = c >> 3, cc = c & 7; *(u32x4*)(dst + c * 8) = *(const LAS u32x4*)(Ab + row * 72 + 8 * cc); }
        }
        __syncthreads();
    }
}
constexpr int GL_QM = 0, GL_KM = 17408, GL_VB = 34816, GL_AB = 52224, GL_EL = 61440, GL_DIR = 61952;
struct GlPre { u32x4 q4[4], k4[4], v4[4], a0, a1; float elv; };
__device__ __forceinline__ void gl_prefetch(GlPre& p, const bf16_t* P, const bf16_t* QM, const bf16_t* KM, const bf16_t* AQ, const float* EL, int rb, int dir, int head, int hf, int t) {
    const int r0 = t >> 4, c8 = 8 * (t & 15);
    const bf16_t* aq = AQ + (size_t)((rb * 4 + head) * 2 + dir) * 4096;
#pragma unroll
    for (int v = 0; v < 4; ++v) { const size_t row = (size_t)(rb * 64 + r0 + 16 * v);
        p.q4[v] = *(const u32x4*)(QM + ((size_t)dir * MROWS + row) * 512 + head * 128 + c8);
        p.k4[v] = *(const u32x4*)(KM + ((size_t)dir * MROWS + row) * 512 + head * 128 + c8);
        p.v4[v] = *(const u32x4*)(P + row * 3072 + 1024 + head * 256 + hf * 128 + c8); }
    p.a0 = *(const u32x4*)(aq + t * 8); p.a1 = *(const u32x4*)(aq + (256 + t) * 8);
    p.elv = EL[(size_t)(dir * 520 + rb) * 512 + head * 128 + (t & 127)];
}
__device__ __forceinline__ void gla_scan(LAS unsigned char* lds, const bf16_t* P  , const bf16_t* QM, const bf16_t* KM, const bf16_t* AQ, const float* EL, bf16_t* OB  ) {
    const int tid = opaque_tid(), dir = __builtin_amdgcn_readfirstlane(tid >> 8);
    for (int unit = blockIdx.x; unit < 16; unit += gridDim.x) {
        const int b = unit >> 3, head = (unit >> 1) & 3, hf = unit & 1;
        f32x16 S[4];
#pragma unroll
        for (int kt = 0; kt < 4; ++kt)
#pragma unroll
            for (int x = 0; x < 16; ++x) S[kt][x] = 0.f;
        GlPre pre;
        { int rb0; bool f0; dn_step_rb(0, dir, b, rb0, f0); gl_prefetch(pre, P, QM, KM, AQ, EL, rb0, dir, head, hf, tid & 255); }
        __syncthreads();
        for (int step = 0; step < 260; ++step) {
            const int w = __builtin_amdgcn_readfirstlane((opaque_tid() >> 6) & 3);
            LAS unsigned char* base = lds + dir * GL_DIR;
            LAS bf16_t* Qm = (LAS bf16_t*)(base + GL_QM); LAS bf16_t* Km = (LAS bf16_t*)(base + GL_KM); LAS bf16_t* Vb = (LAS bf16_t*)(base + GL_VB); LAS bf16_t* Ab = (LAS bf16_t*)(base + GL_AB);
            LAS float* el = (LAS float*)(base + GL_EL);
            int rb; bool first; dn_step_rb(step, dir, b, rb, first);
            const int row_base = rb * 64;
            {
                const int tq_ = opaque_tid(), t = tq_ & 255;
                const int r0 = t >> 4, c8 = 8 * (t & 15);
#pragma unroll
                for (int v = 0; v < 4; ++v) { const int i = r0 + 16 * v, ip = dir ? 63 - i : i;
                    *(LAS u32x4*)(Qm + i * 136 + c8) = pre.q4[v]; *(LAS u32x4*)(Km + i * 136 + c8) = pre.k4[v]; *(LAS u32x4*)(Vb + ip * 136 + c8) = pre.v4[v]; }
                { const int c = t, row = c >> 3, cc = c & 7; *(LAS u32x4*)(Ab + row * 72 + 8 * cc) = pre.a0; }
                { const int c = 256 + t, row = c >> 3, cc = c & 7; *(LAS u32x4*)(Ab + row * 72 + 8 * cc) = pre.a1; }
                if (t < 128) el[t] = __expf(pre.elv);
            }
            BAR_LDS();
            if (step + 1 < 260) { int rbn; bool fn; dn_step_rb(step + 1, dir, b, rbn, fn); gl_prefetch(pre, P, QM, KM, AQ, EL, rbn, dir, head, hf, opaque_tid() & 255); }
            __builtin_amdgcn_sched_barrier(0);
            {
                const int tq_ = opaque_tid(), lane = tq_ & 63, r = lane & 31, h = lane >> 5;
#pragma unroll
                for (int kt = 0; kt < 4; ++kt)
#pragma unroll
                    for (int x = 0; x < 16; ++x) S[kt][x] *= el[32 * kt + crow(x, h)];
                bf16x8 Vf[4];
#pragma unroll
                for (int ks = 0; ks < 4; ++ks) Vf[ks] = frag_tr(Vb, 136, 32 * w, ks, lane);
                u32x4 eo[4];
                {
                    const int rr_ = lane >> 2, c8_ = 8 * (lane & 3);
                    if (!first) {
#pragma unroll
                        for (int v = 0; v < 4; ++v) { const int ip_ = rr_ + 16 * v, i_ = dir ? 63 - ip_ : ip_;
                            eo[v] = *(const u32x4*)(OB + (size_t)(row_base + i_) * 1024 + head * 256 + hf * 128 + 32 * w + c8_); }
                    } else {
                        unsigned z0 = 0u; asm volatile("" : "+v"(z0));
#pragma unroll
                        for (int v = 0; v < 4; ++v) eo[v] = (u32x4){z0, z0, z0, z0};
                    }
                }
                f32x16 O[2];
#pragma unroll
                for (int mt = 0; mt < 2; ++mt) {
#pragma unroll
                    for (int x = 0; x < 16; ++x) O[mt][x] = 0.f;
#pragma unroll
                    for (int ks = 0; ks < 4; ++ks) if (ks < 2 * mt + 2) O[mt] = MFMA32(frag_perm(Ab, 72, 32 * mt + r, ks, h), Vf[ks], O[mt]);
                }
                __builtin_amdgcn_sched_barrier(0);
#pragma unroll
                for (int ks = 0; ks < 8; ++ks) {
                    const bf16x8 sp = pack_step(S[ks >> 1], ks & 1);
#pragma unroll
                    for (int mt = 0; mt < 2; ++mt) O[mt] = MFMA32(frag_perm(Qm, 136, 32 * mt + r, ks, h), sp, O[mt]);
                    if (ks & 1) __builtin_amdgcn_sched_barrier(0);
                }
#pragma unroll
                for (int mt = 0; mt < 2; ++mt)
#pragma unroll
                    for (int x = 0; x < 16; ++x) Vb[(32 * mt + crow(x, h)) * 136 + 32 * w + r] = f2bf(O[mt][x]);
                __builtin_amdgcn_sched_barrier(0);
#pragma unroll
                for (int ks = 0; ks < 4; ++ks) {
#pragma unroll
                    for (int kt = 0; kt < 4; ++kt) S[kt] = MFMA32(frag_tr(Km, 136, 32 * kt, ks, lane), Vf[ks], S[kt]);
                    __builtin_amdgcn_sched_barrier(0);
                }
                {
                    const int rr_ = lane >> 2, c8_ = 8 * (lane & 3);
#pragma unroll
                    for (int v = 0; v < 4; ++v) { const int ip_ = rr_ + 16 * v, i_ = dir ? 63 - ip_ : ip_;
                        u32x4* gp_ = (u32x4*)(OB + (size_t)(row_base + i_) * 1024 + head * 256 + hf * 128 + 32 * w + c8_);
                        u32x4 o = *(const LAS u32x4*)(Vb + ip_ * 136 + 32 * w + c8_); const u32x4 e = eo[v];
                        if (!first) {
                            o.x = cvtpk_s(bf_lo(o.x) + bf_lo(e.x), bf_hi(o.x) + bf_hi(e.x)); o.y = cvtpk_s(bf_lo(o.y) + bf_lo(e.y), bf_hi(o.y) + bf_hi(e.y));
                            o.z = cvtpk_s(bf_lo(o.z) + bf_lo(e.z), bf_hi(o.z) + bf_hi(e.z)); o.w = cvtpk_s(bf_lo(o.w) + bf_lo(e.w), bf_hi(o.w) + bf_hi(e.w)); }
                        gp_[0] = o; }
                }
            }
            if (step == 1 || step == 131) asm volatile("s_waitcnt vmcnt(0)" ::: "memory");
            BAR_LDS();
        }
    }
}
typedef __bf16 v2bf_t __attribute__((ext_vector_type(2)));
__device__ __forceinline__ void atomic_add_bf16x8(bf16_t* p, const u32x4 v) {
    asm volatile("global_atomic_pk_add_bf16 %0, %1, off sc1\n\tglobal_atomic_pk_add_bf16 %0, %2, off offset:4 sc1\n\tglobal_atomic_pk_add_bf16 %0, %3, off offset:8 sc1\n\tglobal_atomic_pk_add_bf16 %0, %4, off offset:12 sc1"
                 :: "v"(p), "v"(v.x), "v"(v.y), "v"(v.z), "v"(v.w) : "memory");
}
constexpr int DN3_HGC = 2 * DN_DIR;
template <int VAR> __device__ __forceinline__ void dn_scan3(LAS unsigned char* lds, const bf16_t* P, const float* AB, const bf16_t* TP, bf16_t* OB) {
    const int tid0 = opaque_tid(), wv = __builtin_amdgcn_readfirstlane(tid0 >> 6), role = wv >> 2, w = wv & 3;
    for (int unit = blockIdx.x; unit < 64; unit += gridDim.x) {
        const int b = unit >> 5, vh = (unit >> 1) & 15, dir = unit & 1, kh = vh >> 1;
        __syncthreads();
        if (role == 1) {
            if (w < 3) {
                const int qh = w >= 1 ? 1 : 0, khh = w == 2 ? 1 : 0, ti = qh, tj = khh;
                u32x4 q8[8], k8[8]; float gcp;
                {
                    int rb; bool f_; dn_step_rb(0, dir, b, rb, f_);
                    const int lane = opaque_tid() & 63, r0 = lane >> 4, c8 = 8 * (lane & 15);
#pragma unroll
                    for (int v = 0; v < 8; ++v) { const int ipq = 32 * qh + r0 + 4 * v, ipk = 32 * khh + r0 + 4 * v, iq = dir ? 63 - ipq : ipq, ik = dir ? 63 - ipk : ipk;
                        q8[v] = *(const u32x4*)(P + (size_t)(rb * 64 + iq) * 4096 + kh * 128 + c8); k8[v] = *(const u32x4*)(P + (size_t)(rb * 64 + ik) * 4096 + 1024 + kh * 128 + c8); }
                    const int tl = dir ? 63 - lane : lane; gcp = AB[(size_t)(rb * 64 + tl) * 64 + dir * 16 + vh];
                }
                for (int j = 0; j < 260; ++j) {
                    const int lane = opaque_tid() & 63, r = lane & 31, h = lane >> 5, r0 = lane >> 4, c8 = 8 * (lane & 15);
                    LAS unsigned char* base = lds + (j & 1) * DN_DIR;
                    LAS bf16_t* Kb = (LAS bf16_t*)(base + DN_KB); LAS bf16_t* Qb = (LAS bf16_t*)(base + DN_QB); LAS bf16_t* Ab = (LAS bf16_t*)(base + DN_AB);
                    LAS float* hgc = (LAS float*)(lds + DN3_HGC + w * 256);
#pragma unroll
                    for (int v = 0; v < 8; ++v) { *(LAS u32x4*)(Qb + (32 * qh + r0 + 4 * v) * 136 + c8) = q8[v]; *(LAS u32x4*)(Kb + (32 * khh + r0 + 4 * v) * 136 + c8) = k8[v]; }
                    hgc[lane] = gcp;
                    asm volatile("s_waitcnt lgkmcnt(0)" ::: "memory");
                    if (j + 1 < 260) {
                        int rb; bool f_; dn_step_rb(j + 1, dir, b, rb, f_);
#pragma unroll
                        for (int v = 0; v < 8; ++v) { const int ipq = 32 * qh + r0 + 4 * v, ipk = 32 * khh + r0 + 4 * v, iq = dir ? 63 - ipq : ipq, ik = dir ? 63 - ipk : ipk;
                            q8[v] = *(const u32x4*)(P + (size_t)(rb * 64 + iq) * 4096 + kh * 128 + c8); k8[v] = *(const u32x4*)(P + (size_t)(rb * 64 + ik) * 4096 + 1024 + kh * 128 + c8); }
                        const int tl = dir ? 63 - lane : lane; gcp = AB[(size_t)(rb * 64 + tl) * 64 + dir * 16 + vh];
                    }
                    __builtin_amdgcn_sched_barrier(0);
                    {
                        f32x16 qk;
#pragma unroll
                        for (int x = 0; x < 16; ++x) qk[x] = 0.f;
#pragma unroll
                        for (int ks = 0; ks < 8; ++ks) qk = MFMA32(frag_nat(Qb, 136, 32 * ti + r, ks, h), frag_nat(Kb, 136, 32 * tj + r, ks, h), qk);
                        const int jj = 32 * tj + r; const float gj = hgc[jj];
#pragma unroll
                        for (int x = 0; x < 16; ++x) { const int i = 32 * ti + crow(x, h);
                            Ab[i * 72 + jj] = f2bf((i >= jj) ? qk[x] * __expf(hgc[i] - gj) : 0.f); }
                    }
                    BAR_LDS();
                }
                BAR_LDS();
            } else {
                u32x4 v16[16], t6[6]; float gcp, betap;
                {
                    int rb; bool f_; dn_step_rb(0, dir, b, rb, f_);
                    const int lane = opaque_tid() & 63, r0 = lane >> 4, c8 = 8 * (lane & 15);
#pragma unroll
                    for (int v = 0; v < 16; ++v) { const int ip = r0 + 4 * v, i = dir ? 63 - ip : ip; v16[v] = *(const u32x4*)(P + (size_t)(rb * 64 + i) * 4096 + 2048 + vh * 128 + c8); }
                    const bf16_t* tp = TP + (size_t)((rb * 16 + vh) * 2 + dir) * 3072;
#pragma unroll
                    for (int v = 0; v < 6; ++v) t6[v] = *(const u32x4*)(tp + (lane + 64 * v) * 8);
                    const int tl = dir ? 63 - lane : lane; const float* ab = AB + (size_t)(rb * 64 + tl) * 64; gcp = ab[dir * 16 + vh]; betap = ab[32 + dir * 16 + vh];
                }
                for (int j = 0; j < 260; ++j) {
                    const int lane = opaque_tid() & 63, r0 = lane >> 4, c8 = 8 * (lane & 15);
                    LAS unsigned char* base = lds + (j & 1) * DN_DIR;
                    LAS bf16_t* Vb = (LAS bf16_t*)(base + DN_VB); LAS bf16_t* Tb = (LAS bf16_t*)(base + DN_TB);
                    LAS float* sc_beta = (LAS float*)(base + DN_SC); LAS float* sc_gc = sc_beta + 64; LAS float* sc_eg = sc_beta + 128; LAS float* sc_tail = sc_beta + 192; LAS float* sc_dl = sc_beta + 256;
                    if (j >= 2) {
                        int rbo; bool fo_; dn_step_rb(j - 2, dir, b, rbo, fo_);
#pragma unroll
                        for (int v = 0; v < 16; ++v) { const int ip_ = r0 + 4 * v, i_ = dir ? 63 - ip_ : ip_;
                            atomic_add_bf16x8(OB + (size_t)(rbo * 64 + i_) * 2048 + vh * 128 + c8, *(const LAS u32x4*)(Vb + ip_ * 128 + c8)); }
                        asm volatile("s_waitcnt lgkmcnt(0)" ::: "memory");
                    }
#pragma unroll
                    for (int v = 0; v < 16; ++v) *(LAS u32x4*)(Vb + (r0 + 4 * v) * 128 + c8) = v16[v];
#pragma unroll
                    for (int v = 0; v < 6; ++v) { const int c = lane + 64 * v, blk = c >> 7, rowc = (c & 127) >> 2, cc = c & 3, br = blk ? 1 : 0, bc = blk == 2 ? 1 : 0;
                        *(LAS u32x4*)(Tb + (32 * br + rowc) * 72 + 32 * bc + 8 * cc) = t6[v]; }
                    { const float gc = gcp, gl = __shfl(gc, 63); sc_beta[lane] = betap; sc_gc[lane] = gc; sc_eg[lane] = __expf(gc); sc_tail[lane] = __expf(gl - gc); if (lane == 0) sc_dl[0] = __expf(gl); }
                    if (j + 1 < 260) {
                        int rb; bool f_; dn_step_rb(j + 1, dir, b, rb, f_);
#pragma unroll
                        for (int v = 0; v < 16; ++v) { const int ip = r0 + 4 * v, i = dir ? 63 - ip : ip; v16[v] = *(const u32x4*)(P + (size_t)(rb * 64 + i) * 4096 + 2048 + vh * 128 + c8); }
                        const bf16_t* tp = TP + (size_t)((rb * 16 + vh) * 2 + dir) * 3072;
#pragma unroll
                        for (int v = 0; v < 6; ++v) t6[v] = *(const u32x4*)(tp + (lane + 64 * v) * 8);
                        const int tl = dir ? 63 - lane : lane; const float* ab = AB + (size_t)(rb * 64 + tl) * 64; gcp = ab[dir * 16 + vh]; betap = ab[32 + dir * 16 + vh];
                    }
                    BAR_LDS();
                }
                {
                    const int lane = opaque_tid() & 63, r0 = lane >> 4, c8 = 8 * (lane & 15);
#pragma unroll 1
                    for (int jj = 258; jj < 260; ++jj) {
                        if (jj == 259) BAR_LDS();
                        LAS bf16_t* Vb = (LAS bf16_t*)(lds + (jj & 1) * DN_DIR + DN_VB);
                        int rbo; bool fo_; dn_step_rb(jj, dir, b, rbo, fo_);
#pragma unroll
                        for (int v = 0; v < 16; ++v) { const int ip_ = r0 + 4 * v, i_ = dir ? 63 - ip_ : ip_;
                            atomic_add_bf16x8(OB + (size_t)(rbo * 64 + i_) * 2048 + vh * 128 + c8, *(const LAS u32x4*)(Vb + ip_ * 128 + c8)); }
                    }
                }
            }
        } else {
            f32x16 S[4];
#pragma unroll
            for (int kt = 0; kt < 4; ++kt)
#pragma unroll
                for (int x = 0; x < 16; ++x) S[kt][x] = 0.f;
            BAR_LDS();
            for (int step = 0; step < 260; ++step) {
                const int lane = opaque_tid() & 63, r = lane & 31, h = lane >> 5;
                LAS unsigned char* base = lds + (step & 1) * DN_DIR;
                LAS bf16_t* Kb = (LAS bf16_t*)(base + DN_KB); LAS bf16_t* Qb = (LAS bf16_t*)(base + DN_QB); LAS bf16_t* Vb = (LAS bf16_t*)(base + DN_VB);
                LAS bf16_t* Tb = (LAS bf16_t*)(base + DN_TB); LAS bf16_t* Ab = (LAS bf16_t*)(base + DN_AB);
                LAS float* sc_beta = (LAS float*)(base + DN_SC); LAS float* sc_eg = sc_beta + 128; LAS float* sc_tail = sc_beta + 192; LAS float* sc_dl = sc_beta + 256;
                int rb; bool f_; dn_step_rb(step, dir, b, rb, f_);
                if (VAR != 2) {
                f32x16 KS[2], QS[2];
#pragma unroll
                for (int mt = 0; mt < 2; ++mt)
#pragma unroll
                    for (int x = 0; x < 16; ++x) { KS[mt][x] = 0.f; QS[mt][x] = 0.f; }
#pragma unroll
                for (int ks = 0; ks < 8; ++ks) {
                    const bf16x8 sp = pack_step(S[ks >> 1], ks & 1);
#pragma unroll
                    for (int mt = 0; mt < 2; ++mt) { KS[mt] = MFMA32(frag_perm(Kb, 136, 32 * mt + r, ks, h), sp, KS[mt]); QS[mt] = MFMA32(frag_perm(Qb, 136, 32 * mt + r, ks, h), sp, QS[mt]); }
                    if (ks & 1) __builtin_amdgcn_sched_barrier(0);
                }
#pragma unroll
                for (int mt = 0; mt < 2; ++mt)
#pragma unroll
                    for (int x = 0; x < 16; ++x) { const int i = 32 * mt + crow(x, h);
                        KS[mt][x] = sc_beta[i] * (bf2f(Vb[i * 128 + 32 * w + r]) - sc_eg[i] * KS[mt][x]); }
                __builtin_amdgcn_sched_barrier(0);
                bf16x8 Xp[4];
#pragma unroll
                for (int ks = 0; ks < 4; ++ks) Xp[ks] = pack_step(KS[ks >> 1], ks & 1);
                f32x16 VN[2];
#pragma unroll
                for (int mt = 0; mt < 2; ++mt) {
#pragma unroll
                    for (int x = 0; x < 16; ++x) VN[mt][x] = 0.f;
#pragma unroll
                    for (int ks = 0; ks < 4; ++ks) if (ks < 2 * mt + 2) VN[mt] = MFMA32(frag_perm(Tb, 72, 32 * mt + r, ks, h), Xp[ks], VN[mt]);
                }
                __builtin_amdgcn_sched_barrier(0);
                bf16x8 VNp[4];
#pragma unroll
                for (int ks = 0; ks < 4; ++ks) VNp[ks] = pack_step(VN[ks >> 1], ks & 1);
#pragma unroll
                for (int mt = 0; mt < 2; ++mt) {
#pragma unroll
                    for (int x = 0; x < 16; ++x) QS[mt][x] *= sc_eg[32 * mt + crow(x, h)];
#pragma unroll
                    for (int ks = 0; ks < 4; ++ks) if (ks < 2 * mt + 2) QS[mt] = MFMA32(frag_perm(Ab, 72, 32 * mt + r, ks, h), VNp[ks], QS[mt]);
                }
                __builtin_amdgcn_sched_barrier(0);
#pragma unroll
                for (int mt = 0; mt < 2; ++mt)
#pragma unroll
                    for (int x = 0; x < 16; ++x) Vb[(32 * mt + crow(x, h)) * 128 + 32 * w + r] = f2bf(QS[mt][x]);
                __builtin_amdgcn_sched_barrier(0);
#pragma unroll
                for (int mt = 0; mt < 2; ++mt)
#pragma unroll
                    for (int x = 0; x < 16; ++x) VN[mt][x] *= sc_tail[32 * mt + crow(x, h)];
#pragma unroll
                for (int ks = 0; ks < 4; ++ks) VNp[ks] = pack_step(VN[ks >> 1], ks & 1);
                __builtin_amdgcn_sched_barrier(0);
                const float dl = sc_dl[0];
#pragma unroll
                for (int kt = 0; kt < 4; ++kt)
#pragma unroll
                    for (int x = 0; x < 16; ++x) S[kt][x] *= dl;
#pragma unroll
                for (int ks = 0; ks < 4; ++ks) {
#pragma unroll
                    for (int kt = 0; kt < 4; ++kt) S[kt] = MFMA32(frag_tr(Kb, 136, 32 * kt, ks, lane), VNp[ks], S[kt]);
                    __builtin_amdgcn_sched_barrier(0);
                }
                }
                BAR_LDS();
            }
        }
    }
}
__device__ __forceinline__ void gla_scan3(LAS unsigned char* lds, bf16_t* P  , const bf16_t* QM, const bf16_t* KM, const bf16_t* AQ, const float* EL, bf16_t* OB  ) {
    const int tid0 = opaque_tid(), wv = __builtin_amdgcn_readfirstlane(tid0 >> 6), role = wv >> 2, w = wv & 3;
    for (int unit = blockIdx.x; unit < 32; unit += gridDim.x) {
        const int b = unit >> 4, head = (unit >> 2) & 3, hf = (unit >> 1) & 1, dir = unit & 1;
        __syncthreads();
        if (role == 1) {
            GlPre pre;
            { int rb0; bool f0; dn_step_rb(0, dir, b, rb0, f0); gl_prefetch(pre, P, QM, KM, AQ, EL, rb0, dir, head, hf, opaque_tid() & 255); }
            for (int j = 0; j < 260; ++j) {
                const int t = opaque_tid() & 255;
                LAS unsigned char* base = lds + (j & 1) * GL_DIR;
                LAS bf16_t* Qm = (LAS bf16_t*)(base + GL_QM); LAS bf16_t* Km = (LAS bf16_t*)(base + GL_KM); LAS bf16_t* Vb = (LAS bf16_t*)(base + GL_VB); LAS bf16_t* Ab = (LAS bf16_t*)(base + GL_AB);
                LAS float* el = (LAS float*)(base + GL_EL);
                const int r0 = t >> 4, c8 = 8 * (t & 15);
#pragma unroll
                for (int v = 0; v < 4; ++v) { const int i = r0 + 16 * v, ip = dir ? 63 - i : i;
                    *(LAS u32x4*)(Qm + i * 136 + c8) = pre.q4[v]; *(LAS u32x4*)(Km + i * 136 + c8) = pre.k4[v]; *(LAS u32x4*)(Vb + ip * 136 + c8) = pre.v4[v]; }
                { const int c = t, row = c >> 3, cc = c & 7; *(LAS u32x4*)(Ab + row * 72 + 8 * cc) = pre.a0; }
                { const int c = 256 + t, row = c >> 3, cc = c & 7; *(LAS u32x4*)(Ab + row * 72 + 8 * cc) = pre.a1; }
                if (t < 128) el[t] = __expf(pre.elv);
                if (j + 1 < 260) { int rbn; bool fn; dn_step_rb(j + 1, dir, b, rbn, fn); gl_prefetch(pre, P, QM, KM, AQ, EL, rbn, dir, head, hf, t); }
                BAR_LDS();
            }
            BAR_LDS();
        } else {
            f32x16 S[4];
#pragma unroll
            for (int kt = 0; kt < 4; ++kt)
#pragma unroll
                for (int x = 0; x < 16; ++x) S[kt][x] = 0.f;
            BAR_LDS();
            for (int step = 0; step < 260; ++step) {
                const int lane = opaque_tid() & 63, r = lane & 31, h = lane >> 5;
                LAS unsigned char* base = lds + (step & 1) * GL_DIR;
                LAS bf16_t* Qm = (LAS bf16_t*)(base + GL_QM); LAS bf16_t* Km = (LAS bf16_t*)(base + GL_KM); LAS bf16_t* Vb = (LAS bf16_t*)(base + GL_VB); LAS bf16_t* Ab = (LAS bf16_t*)(base + GL_AB);
                LAS float* el = (LAS float*)(base + GL_EL);
                int rb; bool f_; dn_step_rb(step, dir, b, rb, f_);
#pragma unroll
                for (int kt = 0; kt < 4; ++kt)
#pragma unroll
                    for (int x = 0; x < 16; ++x) S[kt][x] *= el[32 * kt + crow(x, h)];
                bf16x8 Vf[4];
#pragma unroll
                for (int ks = 0; ks < 4; ++ks) Vf[ks] = frag_tr(Vb, 136, 32 * w, ks, lane);
                f32x16 O[2];
#pragma unroll
                for (int mt = 0; mt < 2; ++mt) {
#pragma unroll
                    for (int x = 0; x < 16; ++x) O[mt][x] = 0.f;
#pragma unroll
                    for (int ks = 0; ks < 4; ++ks) if (ks < 2 * mt + 2) O[mt] = MFMA32(frag_perm(Ab, 72, 32 * mt + r, ks, h), Vf[ks], O[mt]);
                }
                __builtin_amdgcn_sched_barrier(0);
#pragma unroll
                for (int ks = 0; ks < 8; ++ks) {
                    const bf16x8 sp = pack_step(S[ks >> 1], ks & 1);
#pragma unroll
                    for (int mt = 0; mt < 2; ++mt) O[mt] = MFMA32(frag_perm(Qm, 136, 32 * mt + r, ks, h), sp, O[mt]);
                    if (ks & 1) __builtin_amdgcn_sched_barrier(0);
                }
#pragma unroll
                for (int mt = 0; mt < 2; ++mt)
#pragma unroll
                    for (int x = 0; x < 16; ++x) Vb[(32 * mt + crow(x, h)) * 136 + 32 * w + r] = f2bf(O[mt][x]);
                __builtin_amdgcn_sched_barrier(0);
#pragma unroll
                for (int ks = 0; ks < 4; ++ks) {
#pragma unroll
                    for (int kt = 0; kt < 4; ++kt) S[kt] = MFMA32(frag_tr(Km, 136, 32 * kt, ks, lane), Vf[ks], S[kt]);
                    __builtin_amdgcn_sched_barrier(0);
                }
                asm volatile("s_waitcnt lgkmcnt(0)" ::: "memory");
                {
                    const int rr_ = lane >> 2, c8_ = 8 * (lane & 3);
#pragma unroll
                    for (int v = 0; v < 4; ++v) { const int ip_ = rr_ + 16 * v, i_ = dir ? 63 - ip_ : ip_; const int oc_ = head * 256 + hf * 128 + 32 * w + c8_;
                        bf16_t* dst_ = dir ? P + (size_t)(rb * 64 + i_) * 3072 + oc_ : OB + (size_t)(rb * 64 + i_) * 1024 + oc_;
                        *(u32x4*)dst_ = *(const LAS u32x4*)(Vb + ip_ * 136 + 32 * w + c8_); }
                }
                BAR_LDS();
            }
        }
    }
}
#define XB_TMO      128
#define XB_XCNT(j)  (256  + 64 * (j))
#define XB_XSUB(j)  (1280 + 64 * (j))
#define XB_XGEN(j)  (2304 + 64 * (j))
#define XB_TOP      3328
#define XB_TOPGEN   3392
#define XCD_BAR_WORDS 3456
#define XB_SPIN_CAP (1u << 18)

__device__ __forceinline__ unsigned xb_ld(unsigned* p)              { return __hip_atomic_load(p, __ATOMIC_RELAXED, __HIP_MEMORY_SCOPE_AGENT); }
__device__ __forceinline__ unsigned xb_add(unsigned* p, unsigned v) { return __hip_atomic_fetch_add(p, v, __ATOMIC_RELAXED, __HIP_MEMORY_SCOPE_AGENT); }
__device__ __forceinline__ unsigned xb_xcc_id() { return (unsigned)__builtin_amdgcn_s_getreg((3 << 11) | 20) & 0xFu; }
#define XB_SPIN(cond, bar) do { unsigned _sp = 0; while (cond) { __builtin_amdgcn_s_sleep(1); \
    if ((++_sp & 255u) == 0u) { if (xb_ld(&(bar)[XB_TMO])) break; if (_sp > XB_SPIN_CAP) { atomicAdd(&(bar)[XB_TMO], 1u); break; } } } } while (0)

struct XcdBarrier {
    unsigned* bar; unsigned x;
    volatile LAS unsigned* st;
};

__device__ __forceinline__ XcdBarrier xcd_barrier_post(unsigned* bar, volatile LAS unsigned* st) {
    XcdBarrier b; b.bar = bar; b.x = xb_xcc_id(); b.st = st;
    if (threadIdx.x == 0) (void)xb_add(&bar[XB_XCNT(b.x)], 1u);
    return b;
}
__device__ __forceinline__ void xcd_barrier_complete(unsigned* bar, unsigned x, unsigned& nloc, unsigned& nx) {
    const unsigned G = gridDim.x * gridDim.y * gridDim.z;
    unsigned sum, cnt, mine, sp = 0u;
    for (;;) {
        sum = 0u; cnt = 0u; mine = 0u;
#pragma unroll
        for (unsigned j = 0; j < 16; ++j) { const unsigned c = xb_ld(&bar[XB_XCNT(j)]); sum += c; cnt += (c > 0u) ? 1u : 0u; mine = (j == x) ? c : mine; }
        if (sum == G) break;
        __builtin_amdgcn_s_sleep(1);
        if ((++sp & 255u) == 0u) { if (xb_ld(&bar[XB_TMO])) break; if (sp > XB_SPIN_CAP) { atomicAdd(&bar[XB_TMO], 1u); break; } }
    }
    nloc = mine > 0u ? mine : 1u; nx = cnt > 0u ? cnt : 1u;
}

__device__ __forceinline__ void xcd_barrier(const XcdBarrier& b) {
    asm volatile("s_waitcnt vmcnt(0)" ::: "memory");
    __syncthreads();
    if (threadIdx.x == 0) {
        unsigned* bar = b.bar;
        __builtin_amdgcn_s_waitcnt(0);
        unsigned nloc = b.st[0], nx = b.st[1];
        if (nloc == 0u) { xcd_barrier_complete(bar, b.x, nloc, nx); b.st[0] = nloc; b.st[1] = nx; }
        const unsigned old = xb_add(&bar[XB_XSUB(b.x)], 1u);
        const unsigned gen = old / nloc;
        if (old + 1u == (gen + 1u) * nloc) {
            __builtin_amdgcn_fence(__ATOMIC_RELEASE, "agent");
            asm volatile("s_waitcnt vmcnt(0)" ::: "memory");
            const unsigned og = xb_add(&bar[XB_TOP], 1u);
            const unsigned tg = og / nx;
            if (og + 1u == (tg + 1u) * nx) xb_add(&bar[XB_TOPGEN], 1u);
            else XB_SPIN(xb_ld(&bar[XB_TOPGEN]) == tg, bar);
            __builtin_amdgcn_fence(__ATOMIC_ACQUIRE, "agent");
            xb_add(&bar[XB_XGEN(b.x)], 1u);
            asm volatile("s_waitcnt vmcnt(0)" ::: "memory");
        } else {
            XB_SPIN(xb_ld(&bar[XB_XGEN(b.x)]) == gen, bar);
            __builtin_amdgcn_fence(__ATOMIC_ACQUIRE, "agent");
            asm volatile("s_waitcnt vmcnt(0)" ::: "memory");
        }
    }
    __syncthreads();
}

#define DUP_DN 0
#define DN_VARIANT 0
#define DN_VAR_PARITY0 0
#define DUP_GLA 0
#define DUP_ATT 0
#define DUP_GIN 0
#define DUP_FFN1 0
constexpr unsigned long long pack_ops(const int* ops, int n) { unsigned long long v = 0; for (int i = 0; i < n; ++i) v |= (unsigned long long)ops[i] << (5 * i); return v; }
struct OpList { unsigned long long code; int n; };
constexpr OpList make_list(int mix) {
    int ops[16] = {}; int n = 0;
    ops[n++] = OP_PREP; ops[n++] = OP_GEMM_IN; if (DUP_GIN && mix != 0) ops[n++] = OP_GEMM_IN;
    if (mix == 0) { ops[n++] = OP_DNHALO; ops[n++] = OP_DNCONV; ops[n++] = OP_DNT; ops[n++] = OP_DNSCAN; if (DUP_DN) ops[n++] = OP_DNSCAN; ops[n++] = OP_DNREDO; ops[n++] = OP_GEMM_Z; }
    else if (mix == 1) { ops[n++] = OP_GLAPREP; ops[n++] = OP_GLASCAN; ops[n++] = OP_GLAGATE; }
    else { ops[n++] = OP_QKROPE; ops[n++] = OP_ATTN; if (DUP_ATT) ops[n++] = OP_ATTN; }
    ops[n++] = OP_GEMM_OUT; ops[n++] = OP_NORM2; ops[n++] = OP_FFN1; if (DUP_FFN1 && mix != 0) ops[n++] = OP_FFN1; ops[n++] = OP_FFN2;
    return OpList{pack_ops(ops, n), n};
}
constexpr OpList L_DN = make_list(0), L_GL = make_list(1), L_AT = make_list(2);
constexpr int NPHASE = 1 + 2 * L_DN.n + L_GL.n + L_AT.n;
__device__ __forceinline__ void decode_phase(int ph, int& layer, int& op) {
    if (ph == 0) { layer = 0; op = OP_MOD; return; }
    int p = ph - 1;
    if (p < L_DN.n) { layer = 0; op = (int)((L_DN.code >> (5 * p)) & 31ull); return; } p -= L_DN.n;
    if (p < L_GL.n) { layer = 1; op = (int)((L_GL.code >> (5 * p)) & 31ull); return; } p -= L_GL.n;
    if (p < L_AT.n) { layer = 2; op = (int)((L_AT.code >> (5 * p)) & 31ull); return; } p -= L_AT.n;
    layer = 3; op = (int)((L_DN.code >> (5 * p)) & 31ull);
}

__global__ void __launch_bounds__(512, 2) mega(Args args) {
    extern __shared__ __attribute__((aligned(16))) unsigned char lds_raw[];
    LAS unsigned char* lds = (LAS unsigned char*)lds_raw;
    cg::grid_group grid = cg::this_grid();
    volatile LAS unsigned* xb_st = (volatile LAS unsigned*)(lds + LDS_BYTES - 64);
    if (threadIdx.x < 2) xb_st[threadIdx.x] = 0u;
    __syncthreads();
    const XcdBarrier xbar = xcd_barrier_post((unsigned*)(args.ws + WS_BAR), xb_st);
    const int G = gridDim.x, NGW = G * 8;
    unsigned char* ws = args.ws;
    const float* x_in = args.in[0]; const float* c_in = args.in[1]; const float* ctx_in = args.in[2]; const float* cctx_in = args.in[3];
    const float* ada_w = args.in[4]; const float* ada_b = args.in[5]; const float* norm_mix_g = args.in[6]; const float* norm_ffn_g = args.in[7];
    const float* ffn_w1 = args.in[8]; const float* ffn_w2 = args.in[9];
    float* MOD = (float*)(ws + WS_MOD); float* CTXC = (float*)(ws + WS_CTX); bf16_t* H = (bf16_t*)(ws + WS_H); float* ABF = (float*)(ws + WS_AB); float* RSTD = (float*)(ws + WS_RSTD);
    bf16_t* PB = (bf16_t*)(ws + WS_P); float* out = args.out;

    for (int ph = args.ph_lo; ph < args.ph_hi; ++ph) {
        int layer, op; decode_phase(ph, layer, op);
        const int mix = layer % 3, slot = layer / 3;
        const float* modl = MOD + (size_t)layer * 3 * 6144;
        const float* xl = layer == 0 ? x_in : out; const float* xc = layer == 0 ? ctx_in : CTXC;
        if (op == OP_MOD) {
            const int tid = opaque_tid(), lane = tid & 63, wave = __builtin_amdgcn_readfirstlane(tid >> 6); const int gw = blockIdx.x * 8 + wave; (void)lane; (void)gw; (void)tid;
            LAS float* sl = (LAS float*)lds; LAS float* red = sl + 3 * 1024;
            for (int e = tid; e < 3 * 1024; e += 512) { const float v = e < 2048 ? c_in[e] : cctx_in[e - 2048]; sl[e] = silu_f(v); }
            __syncthreads();
            for (int item = blockIdx.x; item < 4 * 96; item += G) {
                const int ly = item / 96, col = (item % 96) * 64 + lane;
                const float* wp = ada_w + ((size_t)ly * 1024 + 128 * wave) * 6144 + col;
                float a0 = 0.f, a1 = 0.f, a2 = 0.f;
#pragma unroll 8
                for (int k = 0; k < 128; ++k) { const float wv = wp[(size_t)k * 6144]; const int kk = 128 * wave + k; a0 += sl[kk] * wv; a1 += sl[1024 + kk] * wv; a2 += sl[2048 + kk] * wv; }
                red[(wave * 3 + 0) * 64 + lane] = a0; red[(wave * 3 + 1) * 64 + lane] = a1; red[(wave * 3 + 2) * 64 + lane] = a2;
                __syncthreads();
                if (tid < 192) { const int m = tid >> 6; float s = ada_b[(size_t)ly * 6144 + col];
#pragma unroll
                    for (int w2 = 0; w2 < 8; ++w2) s += red[(w2 * 3 + m) * 64 + lane];
                    MOD[((size_t)ly * 3 + m) * 6144 + col] = s; }
                __syncthreads();
            }
        } else if (op == OP_PREP) {
            const int tid = opaque_tid(), lane = tid & 63, wave = __builtin_amdgcn_readfirstlane(tid >> 6); const int gw = blockIdx.x * 8 + wave; (void)lane; (void)gw; (void)tid;
            LAS float* scr = (LAS float*)(lds + wave * 16384);
            unsigned z0 = 0u; asm volatile("" : "+v"(z0)); const u32x4 zv = (u32x4){z0, z0, z0, z0};
            bf16_t* wtA = (bf16_t*)(ws + WT_A); bf16_t* wtZ = (bf16_t*)(ws + WT_Z); bf16_t* wtO = (bf16_t*)(ws + WT_O); bf16_t* wt1 = (bf16_t*)(ws + WT_1); bf16_t* wt2 = (bf16_t*)(ws + WT_2);
            if (mix == 0) {
                const float* w_in = args.in[10] + (size_t)slot * 1024 * 6208; const float* w_out = args.in[15] + (size_t)slot * 2048 * 1024;
                transpose_mat(w_in, 6208, 0, 4096, 1024, wtA, 0, scr, gw, NGW, lane);
                transpose_mat(w_in, 6208, 6144, 64, 1024, wtA, 4096, scr, gw, NGW, lane);
                for (size_t e = (size_t)blockIdx.x * 512 + tid; e < (size_t)192 * 1024 * 2 / 16; e += (size_t)G * 512) ((u32x4*)(wtA + (size_t)4160 * 1024))[e] = zv;
            } else if (mix == 1) {
                const float* w_in = args.in[16]; const float* w_out = args.in[20];
                transpose_mat(w_in, 3104, 0, 3104, 1024, wtA, 0, scr, gw, NGW, lane);
                for (size_t e = (size_t)blockIdx.x * 512 + tid; e < (size_t)224 * 1024 * 2 / 16; e += (size_t)G * 512) ((u32x4*)(wtA + (size_t)3104 * 1024))[e] = zv;
                transpose_mat(w_out, 1024, 0, 1024, 1024, wtO, 0, scr, gw, NGW, lane);
            } else {
                const float* w_in = args.in[21]; const float* w_out = args.in[24];
                transpose_mat(w_in, 1536, 0, 1536, 1024, wtA, 0, scr, gw, NGW, lane);
                transpose_mat(w_out, 1024, 0, 1024, 1024, wtO, 0, scr, gw, NGW, lane);
            }
            if (mix != 0) {
                transpose_mat(ffn_w1 + (size_t)layer * 1024 * 4096, 4096, 0, 4096, 1024, wt1, 0, scr, gw, NGW, lane);
                transpose_mat(ffn_w2 + (size_t)layer * 4096 * 1024, 1024, 0, 1024, 4096, wt2, 0, scr, gw, NGW, lane);
            }
            normmod_rows(xl, xc, norm_mix_g + (size_t)layer * 1024, modl, 0, H, gw, NGW, lane);
        } else if (op == OP_DNREDO) {
            const int tid = opaque_tid(), lane = tid & 63, wave = __builtin_amdgcn_readfirstlane(tid >> 6); const int gw = blockIdx.x * 8 + wave; (void)lane; (void)gw; (void)tid;
            LAS float* scr = (LAS float*)(lds + wave * 16384);
            const float* w_in = args.in[10] + (size_t)slot * 1024 * 6208; const float* w_out = args.in[15] + (size_t)slot * 2048 * 1024;
            transpose_mat(w_in, 6208, 4096, 2048, 1024, (bf16_t*)(ws + WT_Z), 0, scr, gw, NGW, lane);
            transpose_mat(w_out, 1024, 0, 1024, 2048, (bf16_t*)(ws + WT_O), 0, scr, gw, NGW, lane);
            transpose_mat(ffn_w1 + (size_t)layer * 1024 * 4096, 4096, 0, 4096, 1024, (bf16_t*)(ws + WT_1), 0, scr, gw, NGW, lane);
            transpose_mat(ffn_w2 + (size_t)layer * 4096 * 1024, 1024, 0, 1024, 4096, (bf16_t*)(ws + WT_2), 0, scr, gw, NGW, lane);
            normmod_rows(xl, xc, norm_mix_g + (size_t)layer * 1024, modl, 0, H, gw, NGW, lane);
            const bf16_t* OB = (const bf16_t*)(ws + WS_O);
            for (int row = gw; row < MROWS; row += NGW) {
                const u32x4* p = (const u32x4*)(OB + (size_t)row * 2048 + 32 * lane); float ss = 0.f;
#pragma unroll
                for (int v = 0; v < 4; ++v) { const u32x4 q = p[v]; const float a0 = bf_lo(q.x), a1 = bf_hi(q.x), a2 = bf_lo(q.y), a3 = bf_hi(q.y), a4 = bf_lo(q.z), a5 = bf_hi(q.z), a6 = bf_lo(q.w), a7 = bf_hi(q.w);
                    ss += (a0 * a0 + a1 * a1) + (a2 * a2 + a3 * a3) + (a4 * a4 + a5 * a5) + (a6 * a6 + a7 * a7); }
                ss += __shfl_xor(ss, 1); ss += __shfl_xor(ss, 2);
                if ((lane & 3) == 0) RSTD[(size_t)row * 16 + (lane >> 2)] = rsqrtf(ss * (1.f / 128.f) + EPS);
            }
        } else if (op == OP_DNHALO) {
            dn_halo_phase(PB, (bf16_t*)(ws + WS_HALO), G);
        } else if (op == OP_DNCONV) {
            dn_conv_phase(PB, (const bf16_t*)(ws + WS_HALO), args.in[11] + (size_t)slot * 4096 * 5, G);
        } else if (op == OP_DNT) {
            dn_t_phase(lds, PB, ABF, (bf16_t*)(ws + WS_TP), args.in[12] + (size_t)slot * 32, args.in[13] + (size_t)slot * 32, G);
            {
                unsigned z0 = 0u; asm volatile("" : "+v"(z0)); const u32x4 zv = (u32x4){z0, z0, z0, z0}; u32x4* zp = (u32x4*)(ws + WS_O);
                for (size_t e = (size_t)blockIdx.x * 512 + opaque_tid(); e < (size_t)MROWS * 2048 * 2 / 16; e += (size_t)G * 512) zp[e] = zv;
            }
        } else if (op == OP_NORM2) {
            const int tid = opaque_tid(), lane = tid & 63, wave = __builtin_amdgcn_readfirstlane(tid >> 6); const int gw = blockIdx.x * 8 + wave; (void)lane; (void)gw; (void)tid;
            normmod_rows(out, CTXC, norm_ffn_g + (size_t)layer * 1024, modl, 3, H, gw, NGW, lane);
        } else if (op == OP_GEMM_IN || op == OP_GEMM_Z || op == OP_GEMM_OUT || op == OP_FFN1 || op == OP_FFN2) {
            pg8::Gemm g; pg8::Epi E;
            E.mode = 0; E.O = PB; E.ldc = 4096; E.tail_pn = -1; E.F = ABF; E.ldf = 64; E.nf = 64; E.rstd = RSTD; E.ng = args.in[14] + (size_t)slot * 128;
            E.src_lat = xl; E.src_ctx = xc; E.dst_lat = out; E.dst_ctx = CTXC; E.mod = modl; E.gidx = 2;
            g.M = (layer == 3 && op != OP_GEMM_IN) ? NLAT : MROWS; g.A = H; g.K = 1024;
            bf16_t* OBUF = (bf16_t*)(ws + (mix == 1 ? WS_OGLA : WS_O));
            if (op == OP_GEMM_IN) {
                g.Bt = (const bf16_t*)(ws + WT_A);
                if (mix == 0) { g.N = 4352; E.ldc = 4096; E.tail_pn = 16; E.ldf = 64; E.nf = 64; }
                else if (mix == 1) { g.N = 3328; E.ldc = 3072; E.tail_pn = 12; E.ldf = 32; E.nf = 32; }
                else { g.N = 1536; E.ldc = 1536; }
            } else if (op == OP_GEMM_Z) {
                g.Bt = (const bf16_t*)(ws + WT_Z); g.N = 2048; E.mode = 2; E.O = OBUF; E.ldc = 2048;
            } else if (op == OP_GEMM_OUT) {
                g.A = OBUF; g.K = mix == 0 ? 2048 : 1024; g.Bt = (const bf16_t*)(ws + WT_O); g.N = 1024; E.mode = 3; E.gidx = 2;
            } else if (op == OP_FFN1) {
                g.Bt = (const bf16_t*)(ws + WT_1); g.N = 4096; E.mode = 1; E.ldc = 4096;
            } else {
                g.A = PB; g.K = 4096; g.Bt = (const bf16_t*)(ws + WT_2); g.N = 1024; E.mode = 3; E.gidx = 5; E.src_lat = out; E.src_ctx = CTXC;
            }
            pg8::StaticOrder S; S.init(g.M, g.N, G, (int)blockIdx.x);
#ifndef NO_GEMM
            pg8::gemm_phase<pg8::Epi, pg8::StaticOrder, true, true>(lds, g, S, E);
#endif
        } else if (op == OP_DNSCAN) {
#ifndef NO_DN
            if (DN_VARIANT && (ph & 1) == 0) dn_scan3<DN_VARIANT>(lds, PB, ABF, (const bf16_t*)(ws + WS_TP), (bf16_t*)(ws + WS_O)); else dn_scan3<0>(lds, PB, ABF, (const bf16_t*)(ws + WS_TP), (bf16_t*)(ws + WS_O));
#endif
        } else if (op == OP_GLAPREP) {
            gla_prep_phase(lds, PB, ABF, args.in[17], args.in[18], (bf16_t*)(ws + WS_QM), (bf16_t*)(ws + WS_KM), (bf16_t*)(ws + WS_AQ), (float*)(ws + WS_EL), G);
        } else if (op == OP_GLASCAN) {
#ifndef NO_GLA
            gla_scan3(lds, PB, (const bf16_t*)(ws + WS_QM), (const bf16_t*)(ws + WS_KM), (const bf16_t*)(ws + WS_AQ), (const float*)(ws + WS_EL), (bf16_t*)(ws + WS_OGLA));
#endif
        } else if (op == OP_GLAGATE) {
            const int tid = opaque_tid(), lane = tid & 63, wave = __builtin_amdgcn_readfirstlane(tid >> 6); const int gw = blockIdx.x * 8 + wave; (void)lane; (void)gw; (void)tid;
            bf16_t* OB = (bf16_t*)(ws + WS_OGLA); const float* ng = args.in[19];
            for (int row = gw; row < MROWS; row += NGW) {
                u32x4* p = (u32x4*)(OB + (size_t)row * 1024 + 16 * lane); const u32x4* gp = (const u32x4*)(PB + (size_t)row * 3072 + 2048 + 16 * lane); const u32x4* pb2 = (const u32x4*)(PB + (size_t)row * 3072 + 16 * lane);
                float o[16], z[16]; float ss = 0.f;
#pragma unroll
                for (int v = 0; v < 2; ++v) { const u32x4 q = p[v], gq = gp[v], q2 = pb2[v];
                    o[8 * v + 0] = bf_lo(q.x) + bf_lo(q2.x); o[8 * v + 1] = bf_hi(q.x) + bf_hi(q2.x); o[8 * v + 2] = bf_lo(q.y) + bf_lo(q2.y); o[8 * v + 3] = bf_hi(q.y) + bf_hi(q2.y); o[8 * v + 4] = bf_lo(q.z) + bf_lo(q2.z); o[8 * v + 5] = bf_hi(q.z) + bf_hi(q2.z); o[8 * v + 6] = bf_lo(q.w) + bf_lo(q2.w); o[8 * v + 7] = bf_hi(q.w) + bf_hi(q2.w);
                    z[8 * v + 0] = bf_lo(gq.x); z[8 * v + 1] = bf_hi(gq.x); z[8 * v + 2] = bf_lo(gq.y); z[8 * v + 3] = bf_hi(gq.y); z[8 * v + 4] = bf_lo(gq.z); z[8 * v + 5] = bf_hi(gq.z); z[8 * v + 6] = bf_lo(gq.w); z[8 * v + 7] = bf_hi(gq.w); }
#pragma unroll
                for (int e = 0; e < 16; ++e) ss += o[e] * o[e];
                ss += __shfl_xor(ss, 1); ss += __shfl_xor(ss, 2); ss += __shfl_xor(ss, 4); ss += __shfl_xor(ss, 8);
                const float rs = rsqrtf(ss * (1.f / 256.f) + EPS); const int cb = (16 * lane) & 255;
#pragma unroll
                for (int v = 0; v < 2; ++v) { float rr[8];
#pragma unroll
                    for (int e = 0; e < 8; ++e) rr[e] = o[8 * v + e] * rs * ng[cb + 8 * v + e] * silu_f(z[8 * v + e]);
                    u32x4 wv; wv.x = cvtpk_s(rr[0], rr[1]); wv.y = cvtpk_s(rr[2], rr[3]); wv.z = cvtpk_s(rr[4], rr[5]); wv.w = cvtpk_s(rr[6], rr[7]); p[v] = wv; }
            }
        } else if (op == OP_QKROPE) {
            const int tid = opaque_tid(), lane = tid & 63, wave = __builtin_amdgcn_readfirstlane(tid >> 6); const int gw = blockIdx.x * 8 + wave; (void)lane; (void)gw; (void)tid;
            bf16_t* QR = (bf16_t*)(ws + WS_QR); bf16_t* KR = (bf16_t*)(ws + WS_KR); bf16_t* VR = (bf16_t*)(ws + WS_VR);
            const float* qg = args.in[22]; const float* kg = args.in[23];
            const int hf = lane >> 5, j = lane & 31, e1 = 64 * hf + j, e2 = e1 + 32;
            const float inv_freq = exp2f(-(float)(2 * j) * (1.f / 64.f) * 13.287712379549449f);
            const float gq1 = qg[e1], gq2 = qg[e2], gk1 = kg[e1], gk2 = kg[e2];
            for (int row = gw; row < MROWS; row += NGW) {
                const bool lat = row < NLAT; const int b = lat ? row / SEQ : (row - NLAT) / CTXL; const int tpos = lat ? row % SEQ : (row - NLAT) % CTXL;
                float cs = 1.f, sn = 0.f;
                if (lat) { const float pos = (float)(hf == 0 ? tpos / 64 : tpos % 64); const float ang = pos * inv_freq; sn = sinf(ang); cs = cosf(ang); }
                const bf16_t* pr = PB + (size_t)row * 1536; const int kpos = lat ? tpos : SEQ + tpos;
#pragma unroll
                for (int hd = 0; hd < 10; ++hd) {
                    const float x1 = bf2f(pr[hd * 128 + e1]), x2 = bf2f(pr[hd * 128 + e2]);
                    const float rinv = rsqrtf(wave_sum(x1 * x1 + x2 * x2) * (1.f / 128.f) + EPS);
                    const float y1 = x1 * rinv * (hd < 8 ? gq1 : gk1), y2 = x2 * rinv * (hd < 8 ? gq2 : gk2);
                    const float o1 = y1 * cs - y2 * sn, o2 = y1 * sn + y2 * cs;
                    bf16_t* dst = hd < 8 ? QR + (size_t)row * 1024 + hd * 128 : KR + ((size_t)(b * 2 + (hd - 8)) * SKV + kpos) * 128;
                    dst[e1] = f2bf(o1); dst[e2] = f2bf(o2);
                }
#pragma unroll
                for (int kv = 0; kv < 2; ++kv) { bf16_t* dst = VR + ((size_t)(b * 2 + kv) * SKV + kpos) * 128; dst[e1] = pr[1280 + kv * 128 + e1]; dst[e2] = pr[1280 + kv * 128 + e2]; }
            }
        } else if (op == OP_ATTN) {
            const attn::bf16* QR = (const attn::bf16*)(ws + WS_QR); const attn::bf16* KR = (const attn::bf16*)(ws + WS_KR); const attn::bf16* VR = (const attn::bf16*)(ws + WS_VR);
            attn::bf16* OB = (attn::bf16*)(ws + WS_O);
            for (int u = blockIdx.x; u < 1024 + 16; u += G) {
                size_t qoff, koff; int seq;
                if (u < 1024) { const int pair = u >> 8, b = pair >> 1, kvh = pair & 1, hh = (u >> 6) & 3, qb = u & 63, head = kvh * 4 + hh;
                    qoff = ((size_t)b * SEQ + (size_t)qb * 256) * 1024 + head * 128; koff = (size_t)(b * 2 + kvh) * SKV * 128; seq = SKV; }
                else { const int jx = u - 1024, b = jx >> 3, head = jx & 7, kvh = head >> 2;
                    qoff = ((size_t)NLAT + (size_t)b * CTXL) * 1024 + head * 128; koff = ((size_t)(b * 2 + kvh) * SKV + SEQ) * 128; seq = CTXL; }
                __syncthreads();
#ifndef NO_ATT
                attn::attn_dense_body<attn::bf16>(QR + qoff, KR + koff, VR + koff, OB + qoff, seq, (char*)lds_raw);
#endif
            }
        }
        if (ph + 1 < args.ph_hi) { if (ph == 0) grid.sync(); else xcd_barrier(xbar); }
    }
}

#ifndef MK_MULTI
#define MK_MULTI 0
#endif
extern "C" void kernel_launch(void* const* d_in, const int* in_sizes, int n_in, void* d_out, int out_size, void* d_ws, size_t ws_size, hipStream_t stream) {
    static int grid = 0;
    if (grid == 0) {
        if (n_in != 25 || ws_size < WS_END) { fprintf(stderr, "kernel_launch: unexpected n_in %d / ws_size %zu (need %zu)\n", n_in, ws_size, (size_t)WS_END); grid = -1; return; }
        int dev = 0, cus = 0, per_cu = 0;
        hipGetDevice(&dev); hipDeviceGetAttribute(&cus, hipDeviceAttributeMultiprocessorCount, dev);
        if (hipFuncSetAttribute((const void*)mega, hipFuncAttributeMaxDynamicSharedMemorySize, LDS_BYTES) != hipSuccess) { fprintf(stderr, "kernel_launch: hipFuncSetAttribute failed\n"); grid = -1; return; }
        if (hipOccupancyMaxActiveBlocksPerMultiprocessor(&per_cu, (const void*)mega, 512, LDS_BYTES) != hipSuccess || per_cu < 1) { fprintf(stderr, "kernel_launch: occupancy query says %d\n", per_cu); per_cu = 1; }
        (void)hipGetLastError();
        grid = cus * 1;
    }
    if (grid < 0) return;
    if (hipMemsetAsync((char*)d_ws + WS_BAR, 0, WS_BAR_BYTES, stream) != hipSuccess) { fprintf(stderr, "kernel_launch: memset of barrier words failed\n"); return; }
    Args a{};
    for (int i = 0; i < 25; ++i) a.in[i] = (const float*)d_in[i];
    a.out = (float*)d_out; a.ws = (unsigned char*)d_ws;
#if MK_MULTI
    for (int ph = 0; ph < NPHASE; ++ph) { a.ph_lo = ph; a.ph_hi = ph + 1; hipLaunchKernelGGL(mega, dim3(grid), dim3(512), LDS_BYTES, stream, a); }
#else
    a.ph_lo = 0; a.ph_hi = NPHASE;
    void* kargs[] = {&a};
    hipError_t e = hipLaunchCooperativeKernel((const void*)mega, dim3(grid), dim3(512), kargs, LDS_BYTES, stream);
    if (e != hipSuccess) fprintf(stderr, "cooperative launch failed: %s (grid %d)\n", hipGetErrorString(e), grid);
#endif
}
```

```cpp
#include <hip/hip_runtime.h>
#include <hip/hip_bf16.h>
#include <hip/hip_cooperative_groups.h>
#include <cstdio>
#include <cstdint>
namespace cg = cooperative_groups;
__device__ __forceinline__ int opaque_tid() { int t = threadIdx.x; asm volatile("" : "+v"(t)); return t; }
namespace pg8 {
#define PG8_LAS __attribute__((address_space(3)))
typedef unsigned short bf16_t;
typedef short bf16x8 __attribute__((ext_vector_type(8)));
typedef float f32x4 __attribute__((ext_vector_type(4)));
typedef unsigned u32x4 __attribute__((ext_vector_type(4)));
constexpr int BM = 256, BK = 64, HALF = 128, HTB = HALF * BK * 2  , STAGE_BYTES = 8 * HTB, NXCD = 8, WGM = 8;

__host__ __device__ __forceinline__ int lds_byte(int r, int c) { const int st = (r >> 4) * 2 + (c >> 5), rr = r & 15, cc = c & 31, ob = rr * 64 + cc * 2; return st * 1024 + (ob ^ (((ob >> 9) & 1) << 5)); }
__host__ __device__ __forceinline__ void stage_rc(int b, int& R, int& C) { const int st = b / 1024, sb = b % 1024, swz = sb ^ (((sb >> 9) & 1) << 5); R = (st >> 1) * 16 + swz / 64; C = (st & 1) * 32 + (swz % 64) / 2; }
__host__ __device__ __forceinline__ int perm32(int rho) { const int n = rho >> 4, i = rho & 15; return 8 * (i >> 2) + 4 * n + (i & 3); }

struct Unit { int pm, pn; };
struct Gemm { const bf16_t* A; const bf16_t* Bt; int M, N, K; };

struct StaticOrder {
    int nM, nN, nwg, G, c;
    __host__ __device__ void init(int M, int N, int G_, int c_) { nM = M / BM; nN = N / BM; nwg = nM * nN; G = G_; c = c_; }
    __host__ __device__ bool next(int i, Unit& u) const {
        const long L = (long)i * G + c; if (L >= nwg) return false;
        int wgid = (int)L; { const int q = nwg / NXCD, r = nwg % NXCD, xcd = wgid % NXCD, off = wgid / NXCD; wgid = (xcd < r ? xcd * (q + 1) : r * (q + 1) + (xcd - r) * q) + off; }
        const int nig = WGM * nN, gid = wgid / nig, fm = gid * WGM, gsz = (nM - fm) < WGM ? (nM - fm) : WGM;
        u.pm = fm + ((wgid % nig) % gsz); u.pn = (wgid % nig) / gsz; return true;
    }
    __device__ __forceinline__ void a_ready(const Unit&) const {}
    __device__ __forceinline__ void done(const Unit&) const {}
};

__device__ __forceinline__ unsigned cvt_pk_bf16(float lo, float hi) { unsigned r; asm volatile("v_cvt_pk_bf16_f32 %0, %1, %2" : "=v"(r) : "v"(lo), "v"(hi)); return r; }
typedef float f32x2 __attribute__((ext_vector_type(2)));
typedef float f32x2_t __attribute__((ext_vector_type(2))); typedef __bf16 bf16x2_t __attribute__((ext_vector_type(2)));
__device__ __forceinline__ unsigned cvtpk_s(float lo, float hi) { f32x2_t v = {lo, hi}; bf16x2_t b = __builtin_convertvector(v, bf16x2_t); return __builtin_bit_cast(unsigned, b); }
__device__ __forceinline__ float bf_lo(unsigned w) { return __builtin_bit_cast(float, w << 16); }
__device__ __forceinline__ float bf_hi(unsigned w) { return __builtin_bit_cast(float, w & 0xffff0000u); }
__device__ __forceinline__ float silu_f(float z) { return z / (1.f + __expf(-z)); }
struct Epi {
    static constexpr bool PERM = true, AFTER_DRAIN = false;
    int mode;
    bf16_t* O; int ldc;
    int tail_pn; float* F; int ldf, nf;
    const float* rstd; const float* ng;
    const float* src_lat; const float* src_ctx; float* dst_lat; float* dst_ctx; const float* mod; int gidx;
    __device__ __forceinline__ void operator()(const f32x4 (&acc)[2][2][4][2], const Unit& u, int wr, int wc, int fr, int fq) const {
        const int row0 = u.pm * BM + wr * 64 + fr; const int col0 = u.pn * BM + wc * 32 + 8 * fq;
        if (mode <= 1) {
            if (u.pn == tail_pn) {
                const int c0 = wc * 32 + 8 * fq;
#pragma unroll
                for (int ai = 0; ai < 2; ++ai)
#pragma unroll
                    for (int m = 0; m < 4; ++m)
#pragma unroll
                        for (int bj = 0; bj < 2; ++bj) { const int cc = c0 + bj * HALF;
                            if (cc < nf) { float* p = F + (size_t)(row0 + ai * HALF + m * 16) * ldf + cc; *(f32x4*)p = acc[ai][bj][m][0]; *(f32x4*)(p + 4) = acc[ai][bj][m][1]; } }
            } else {
#pragma unroll
                for (int ai = 0; ai < 2; ++ai)
#pragma unroll
                    for (int m = 0; m < 4; ++m) { bf16_t* rowp = O + (size_t)(row0 + ai * HALF + m * 16) * ldc + col0;
#pragma unroll
                        for (int bj = 0; bj < 2; ++bj) { f32x4 v0 = acc[ai][bj][m][0], v1 = acc[ai][bj][m][1];
                            if (mode == 1) {
#pragma unroll
                                for (int e = 0; e < 4; ++e) { float a = fmaxf(v0[e], 0.f), b = fmaxf(v1[e], 0.f); v0[e] = a * a; v1[e] = b * b; } }
                            u32x4 w; w.x = cvtpk_s(v0[0], v0[1]); w.y = cvtpk_s(v0[2], v0[3]); w.z = cvtpk_s(v1[0], v1[1]); w.w = cvtpk_s(v1[2], v1[3]);
                            *(u32x4*)(rowp + bj * HALF) = w; } }
            }
        } else if (mode == 2) {
            const f32x4 g0 = *(const f32x4*)(ng + (col0 & 127)), g1 = *(const f32x4*)(ng + (col0 & 127) + 4);
#pragma unroll
            for (int ai = 0; ai < 2; ++ai)
#pragma unroll
                for (int m = 0; m < 4; ++m) { const int row = row0 + ai * HALF + m * 16; bf16_t* rowp = O + (size_t)row * ldc + col0;
#pragma unroll
                    for (int bj = 0; bj < 2; ++bj) { const float rs = rstd[(size_t)row * 16 + ((col0 + bj * HALF) >> 7)];
                        const u32x4 ov = *(const u32x4*)(rowp + bj * HALF); const f32x4 z0 = acc[ai][bj][m][0], z1 = acc[ai][bj][m][1];
                        float r[8];
                        r[0] = bf_lo(ov.x) * rs * g0[0] * silu_f(z0[0]); r[1] = bf_hi(ov.x) * rs * g0[1] * silu_f(z0[1]);
                        r[2] = bf_lo(ov.y) * rs * g0[2] * silu_f(z0[2]); r[3] = bf_hi(ov.y) * rs * g0[3] * silu_f(z0[3]);
                        r[4] = bf_lo(ov.z) * rs * g1[0] * silu_f(z1[0]); r[5] = bf_hi(ov.z) * rs * g1[1] * silu_f(z1[1]);
                        r[6] = bf_lo(ov.w) * rs * g1[2] * silu_f(z1[2]); r[7] = bf_hi(ov.w) * rs * g1[3] * silu_f(z1[3]);
                        u32x4 w; w.x = cvtpk_s(r[0], r[1]); w.y = cvtpk_s(r[2], r[3]); w.z = cvtpk_s(r[4], r[5]); w.w = cvtpk_s(r[6], r[7]);
                        *(u32x4*)(rowp + bj * HALF) = w; } }
        } else {
            const int mi = u.pm < 64 ? 0 : (u.pm < 128 ? 1 : 2);
            const float* gate = mod + (size_t)mi * 6144 + (size_t)gidx * 1024;
            const bool lat = u.pm < 128;
            const float* sb = lat ? src_lat : src_ctx - (size_t)32768 * 1024; float* db = lat ? dst_lat : dst_ctx - (size_t)32768 * 1024;
#pragma unroll
            for (int bj = 0; bj < 2; ++bj)
#pragma unroll
                for (int n = 0; n < 2; ++n) { const int c = col0 + bj * HALF + 4 * n; const f32x4 gv = *(const f32x4*)(gate + c);
#pragma unroll
                    for (int ai = 0; ai < 2; ++ai)
#pragma unroll
                        for (int m = 0; m < 4; ++m) { const size_t off = (size_t)(row0 + ai * HALF + m * 16) * 1024 + c;
                            const f32x4 s = *(const f32x4*)(sb + off); *(f32x4*)(db + off) = s + gv * acc[ai][bj][m][n]; } }
        }
    }
};
template <class Epi, class Sched, bool ALIGN_EPI = false, bool SP2 = false>
__device__ __forceinline__ void gemm_phase(PG8_LAS unsigned char* lds, const Gemm g, const Sched& S, const Epi& E) {
    const int tid = opaque_tid(), wid = __builtin_amdgcn_readfirstlane(tid >> 6), lane = tid & 63, wr = wid >> 2, wc = wid & 3, fr = lane & 15, fq = lane >> 4;
    const int K = g.K, nt = K / BK;
    unsigned voffA[2], voffB[2];
#pragma unroll
    for (int i = 0; i < 2; ++i) { int R, C; stage_rc(tid * 16 + i * 8192, R, C); const int Rb = Epi::PERM ? ((R & ~31) + perm32(R & 31)) : R;
        voffA[i] = (unsigned)(R * K + C) * 2u; voffB[i] = (unsigned)(Rb * K + C) * 2u; }
    const size_t kstep = (size_t)(BK * 2);
    const size_t hstep = (size_t)HALF * K * 2;
    const size_t tstep = 2 * hstep;
    const unsigned ldsw = (unsigned)wid * 1024u;
    const int aoff = lds_byte(wr * 64 + fr, fq * 8), boff = lds_byte(wc * 32 + fr, fq * 8);
#define PG8_SA(b, h) (((b) * 2 + (h)) * HTB)
#define PG8_SB(b, h) ((4 + (b) * 2 + (h)) * HTB)
#define PG8_STAGE(bufoff, gbase, voff) do { _Pragma("unroll") for (int _i = 0; _i < 2; ++_i) \
        __builtin_amdgcn_global_load_lds((const unsigned*)((const char*)(gbase) + (voff)[_i]), (PG8_LAS unsigned*)(lds + (bufoff) + ldsw + _i * 8192), 16, 0, 0); } while (0)
#define PG8_LDA(dst, b, h) do { _Pragma("unroll") for (int m = 0; m < 4; ++m) _Pragma("unroll") for (int k = 0; k < 2; ++k) dst[m][k] = *(const PG8_LAS bf16x8*)(lds + PG8_SA(b, h) + aoff + m * 2048 + k * 1024); } while (0)
#define PG8_LDB(dst, b, h) do { _Pragma("unroll") for (int n = 0; n < 2; ++n) _Pragma("unroll") for (int k = 0; k < 2; ++k) dst[n][k] = *(const PG8_LAS bf16x8*)(lds + PG8_SB(b, h) + boff + n * 2048 + k * 1024); } while (0)
#define PG8_MMA(ai, bj, At, Bt) do { __builtin_amdgcn_s_setprio(1); _Pragma("unroll") for (int m = 0; m < 4; ++m) _Pragma("unroll") for (int n = 0; n < 2; ++n) _Pragma("unroll") for (int k = 0; k < 2; ++k) \
        acc[ai][bj][m][n] = __builtin_amdgcn_mfma_f32_16x16x32_bf16(Bt[n][k], At[m][k], acc[ai][bj][m][n], 0, 0, 0); __builtin_amdgcn_s_setprio(0); } while (0)
#define PG8_WAIT_V(n) asm volatile("s_waitcnt vmcnt(" #n ")" ::: "memory")
#define PG8_WAIT_L(n) asm volatile("s_waitcnt lgkmcnt(" #n ")" ::: "memory")
#define PG8_BAR __builtin_amdgcn_s_barrier()
#define PG8_SCHED __builtin_amdgcn_sched_barrier(0)
    Unit cur, nxt; int ui = 0;
    if (!S.next(0, cur)) return;
    f32x4 acc[2][2][4][2];
#pragma unroll
    for (int a = 0; a < 2; ++a)
#pragma unroll
        for (int b = 0; b < 2; ++b)
#pragma unroll
            for (int m = 0; m < 4; ++m)
#pragma unroll
                for (int n = 0; n < 2; ++n) acc[a][b][m][n] = (f32x4){0.f, 0.f, 0.f, 0.f};
    bf16x8 At[4][2], B0[2][2], B1[2][2];
    const char* cA = (const char*)g.A + (size_t)cur.pm * tstep; const char* cB = (const char*)g.Bt + (size_t)cur.pn * tstep;
    S.a_ready(cur);
    if constexpr (SP2) {
        PG8_STAGE(PG8_SB(0, 0), cB, voffB); PG8_STAGE(PG8_SB(0, 1), cB + hstep, voffB); PG8_STAGE(PG8_SA(0, 0), cA, voffA); PG8_STAGE(PG8_SA(0, 1), cA + hstep, voffA);
        if (wr == 1) PG8_BAR;
        PG8_WAIT_V(2); PG8_BAR;
        PG8_STAGE(PG8_SB(1, 0), cB + kstep, voffB); PG8_STAGE(PG8_SA(1, 0), cA + kstep, voffA); PG8_STAGE(PG8_SB(1, 1), cB + hstep + kstep, voffB);
        PG8_WAIT_V(6); PG8_BAR;
    } else {
        PG8_STAGE(PG8_SB(0, 0), cB, voffB); PG8_STAGE(PG8_SA(0, 0), cA, voffA); PG8_STAGE(PG8_SB(0, 1), cB + hstep, voffB); PG8_STAGE(PG8_SA(0, 1), cA + hstep, voffA);
        if (wr == 1) PG8_BAR;
        PG8_WAIT_V(4); PG8_BAR;
        PG8_STAGE(PG8_SB(1, 0), cB + kstep, voffB); PG8_STAGE(PG8_SA(1, 0), cA + kstep, voffA); PG8_STAGE(PG8_SB(1, 1), cB + hstep + kstep, voffB);
        PG8_WAIT_V(6); PG8_BAR;
    }
    for (;;) {
        const bool has_next = S.next(ui + 1, nxt);
        const char* nA = has_next ? (const char*)g.A + (size_t)nxt.pm * tstep : cA; const char* nB = has_next ? (const char*)g.Bt + (size_t)nxt.pn * tstep : cB;
        for (int t = 0; t < nt; t += 2) {
            const bool last = (t == nt - 2);
            const char* a1 = cA + (size_t)(t + 1) * kstep;
            const char* a2 = last ? nA : cA + (size_t)(t + 2) * kstep; const char* b2 = last ? nB : cB + (size_t)(t + 2) * kstep;
            const char* a3 = a2 + kstep; const char* b3 = b2 + kstep;
            if (last && has_next) S.a_ready(nxt);
            if constexpr (SP2) {
            PG8_LDB(B0, 0, 0); PG8_LDB(B1, 0, 1); PG8_SCHED; PG8_LDA(At, 0, 0); PG8_STAGE(PG8_SA(1, 1), a1 + hstep, voffA);
            PG8_WAIT_V(8); PG8_WAIT_L(0); PG8_BAR; PG8_MMA(0, 0, At, B0); PG8_MMA(0, 1, At, B1); PG8_BAR; PG8_SCHED;
            PG8_LDA(At, 0, 1); PG8_STAGE(PG8_SB(0, 0), b2, voffB); PG8_STAGE(PG8_SB(0, 1), b2 + hstep, voffB); PG8_STAGE(PG8_SA(0, 0), a2, voffA);
            PG8_WAIT_V(8); PG8_WAIT_L(0); PG8_BAR; PG8_MMA(1, 0, At, B0); PG8_MMA(1, 1, At, B1); PG8_BAR; PG8_SCHED;
            PG8_LDB(B0, 1, 0); PG8_LDB(B1, 1, 1); PG8_SCHED; PG8_LDA(At, 1, 0); PG8_STAGE(PG8_SA(0, 1), a2 + hstep, voffA);
            PG8_WAIT_V(8); PG8_WAIT_L(0); PG8_BAR; PG8_MMA(0, 0, At, B0); PG8_MMA(0, 1, At, B1); PG8_BAR; PG8_SCHED;
            PG8_LDA(At, 1, 1); PG8_STAGE(PG8_SB(1, 0), b3, voffB); PG8_STAGE(PG8_SB(1, 1), b3 + hstep, voffB); PG8_STAGE(PG8_SA(1, 0), a3, voffA);
            PG8_WAIT_V(8); PG8_WAIT_L(0); PG8_BAR; PG8_MMA(1, 0, At, B0); PG8_MMA(1, 1, At, B1); PG8_BAR; PG8_SCHED;
            } else {
            PG8_LDB(B0, 0, 0); PG8_SCHED; PG8_LDA(At, 0, 0); PG8_STAGE(PG8_SA(1, 1), a1 + hstep, voffA);
            PG8_WAIT_L(8); PG8_BAR; PG8_WAIT_L(0); PG8_MMA(0, 0, At, B0); PG8_BAR; PG8_SCHED;
            PG8_LDB(B1, 0, 1); PG8_STAGE(PG8_SB(0, 0), b2, voffB);
            PG8_BAR; PG8_WAIT_L(0); PG8_MMA(0, 1, At, B1); PG8_BAR;
            PG8_LDA(At, 0, 1); PG8_STAGE(PG8_SA(0, 0), a2, voffA);
            PG8_BAR; PG8_WAIT_L(0); PG8_MMA(1, 0, At, B0); PG8_BAR; PG8_SCHED;
            PG8_STAGE(PG8_SB(0, 1), b2 + hstep, voffB);
            PG8_WAIT_V(6); PG8_BAR; PG8_MMA(1, 1, At, B1); PG8_BAR;
            PG8_LDB(B0, 1, 0); PG8_SCHED; PG8_LDA(At, 1, 0); PG8_STAGE(PG8_SA(0, 1), a2 + hstep, voffA);
            PG8_WAIT_L(8); PG8_BAR; PG8_WAIT_L(0); PG8_MMA(0, 0, At, B0); PG8_BAR; PG8_SCHED;
            PG8_LDB(B1, 1, 1); PG8_STAGE(PG8_SB(1, 0), b3, voffB);
            PG8_BAR; PG8_WAIT_L(0); PG8_MMA(0, 1, At, B1); PG8_BAR;
            PG8_LDA(At, 1, 1); PG8_STAGE(PG8_SA(1, 0), a3, voffA);
            PG8_BAR; PG8_WAIT_L(0); PG8_MMA(1, 0, At, B0); PG8_BAR; PG8_SCHED;
            PG8_STAGE(PG8_SB(1, 1), b3 + hstep, voffB);
            PG8_WAIT_V(6); PG8_BAR; PG8_MMA(1, 1, At, B1); PG8_BAR;
            }
        }
        if constexpr (ALIGN_EPI) { if (wr == 0) PG8_BAR; }
        if constexpr (!Epi::AFTER_DRAIN) { E(acc, cur, wr, wc, fr, fq); S.done(cur); }
        if (!has_next) break;
#pragma unroll
        for (int a = 0; a < 2; ++a)
#pragma unroll
            for (int b = 0; b < 2; ++b)
#pragma unroll
                for (int m = 0; m < 4; ++m)
#pragma unroll
                    for (int n = 0; n < 2; ++n) acc[a][b][m][n] = (f32x4){0.f, 0.f, 0.f, 0.f};
        cur = nxt; cA = nA; cB = nB; ++ui;
        if constexpr (ALIGN_EPI) { if (wr == 1) PG8_BAR; }
    }
    PG8_WAIT_V(0);
    if constexpr (!ALIGN_EPI) { if (wr == 0) PG8_BAR; }
    PG8_BAR;
    if constexpr (Epi::AFTER_DRAIN) { E.fused(acc, cur, wr, wc, fr, fq, lds, wid, lane); S.done(cur); }
#undef PG8_SA
#undef PG8_SB
#undef PG8_STAGE
#undef PG8_LDA
#undef PG8_LDB
#undef PG8_MMA
#undef PG8_WAIT_V
#undef PG8_WAIT_L
#undef PG8_BAR
#undef PG8_SCHED
}
}
namespace attn {
using bf16 = __hip_bfloat16;
constexpr int   D = 128, NW = 8, QBLK = 32, KVBLK = 64;
constexpr float SCALE = 0.088388347648318440f;
constexpr float THR = 8.f;
constexpr int SDEPTH = 2;
constexpr int LDQ = 1024, LDK = 128, LDO = 1024;
constexpr size_t SHM_V = KVBLK * D * 2, SHM_K = KVBLK * D * 2, SHM_ATTN = 2 * SHM_V + 2 * SHM_K + NW * 64 * 4;
using bf16x8 = __attribute__((ext_vector_type(8))) short;
using s16x4  = __attribute__((ext_vector_type(4))) short;
using f32x16 = __attribute__((ext_vector_type(16))) float;
using f32x8  = __attribute__((ext_vector_type(8))) float;
using u32x4  = __attribute__((ext_vector_type(4))) unsigned;
#define KSWZ(row, colB) ((row) * 256 + ((colB) ^ (((row) & 7) << 4)))
#define SBAR() __builtin_amdgcn_sched_barrier(0)
__device__ __forceinline__ int crow(int r, int hi) { return (r & 3) + 8 * (r >> 2) + 4 * hi; }
__device__ __forceinline__ unsigned cvtpk(float lo, float hi) {
  unsigned r; asm volatile("v_cvt_pk_bf16_f32 %0, %1, %2" : "=v"(r) : "v"(lo), "v"(hi)); return r;
}
template <typename TIn> struct Stage;
template <> struct Stage<bf16>  { using T = bf16x8;
  __device__ static __forceinline__ T ld8(const bf16* p) { return *reinterpret_cast<const bf16x8*>(p); }
  __device__ static __forceinline__ bf16x8 tobf(T x) { return x; } };
template <> struct Stage<float> { using T = f32x8;
  __device__ static __forceinline__ T ld8(const float* p) { return *reinterpret_cast<const f32x8*>(p); }
  __device__ static __forceinline__ bf16x8 tobf(T x) {
    u32x4 w = {cvtpk(x[0], x[1]), cvtpk(x[2], x[3]), cvtpk(x[4], x[5]), cvtpk(x[6], x[7])}; return *reinterpret_cast<bf16x8*>(&w); } };

__device__ __forceinline__ void partialSM(f32x16& p0, f32x16& p1, float& m_reg, float& mn, float& alpha) {
  constexpr float C = SCALE * 1.4426950408889634f;
  float pmax = p0[0]; for (int r = 1; r < 16; ++r) pmax = fmaxf(pmax, p0[r]); for (int r = 0; r < 16; ++r) pmax = fmaxf(pmax, p1[r]);
  { auto rr = __builtin_amdgcn_permlane32_swap(__float_as_uint(pmax), __float_as_uint(pmax), false, false);
    pmax = fmaxf(__uint_as_float(rr[0]), __uint_as_float(rr[1])); }
  if (__builtin_expect(__all(pmax - m_reg <= THR / SCALE), 1)) { mn = m_reg; alpha = 1.f; }
  else { mn = fmaxf(m_reg, pmax); alpha = __builtin_amdgcn_exp2f((m_reg - mn) * C); m_reg = mn; }
  float mnC = -mn * C;
  for (int r = 0; r < 16; ++r) p0[r] = fmaf(p0[r], C, mnC); for (int r = 0; r < 16; ++r) p1[r] = fmaf(p1[r], C, mnC);
  for (int r = 0; r < 16; ++r) p0[r] = __builtin_amdgcn_exp2f(p0[r]);
}
__device__ __forceinline__ void finishSM(f32x16& p0, f32x16& p1, float alpha, float& l_reg, bf16x8& pa0, bf16x8& pa1, bf16x8& pa2, bf16x8& pa3) {
  for (int r = 0; r < 16; ++r) p1[r] = __builtin_amdgcn_exp2f(p1[r]);
  float ps = 0; for (int r = 0; r < 16; ++r) ps += p0[r]; for (int r = 0; r < 16; ++r) ps += p1[r];
  { auto rr = __builtin_amdgcn_permlane32_swap(__float_as_uint(ps), __float_as_uint(ps), false, false);
    ps = __uint_as_float(rr[0]) + __uint_as_float(rr[1]); }
  l_reg = l_reg * alpha + ps;
#define PK4(P, BASE, OUT) do { unsigned a0 = cvtpk(P[BASE + 0], P[BASE + 1]), a1 = cvtpk(P[BASE + 2], P[BASE + 3]);   \
    unsigned b0 = cvtpk(P[BASE + 4], P[BASE + 5]), b1 = cvtpk(P[BASE + 6], P[BASE + 7]);                              \
    auto r0 = __builtin_amdgcn_permlane32_swap(a0, b0, false, false); auto r1 = __builtin_amdgcn_permlane32_swap(a1, b1, false, false); \
    u32x4 w = {r0[0], r1[0], r0[1], r1[1]}; OUT = *reinterpret_cast<bf16x8*>(&w); } while (0)
  PK4(p0, 0, pa0); PK4(p0, 8, pa1); PK4(p1, 0, pa2); PK4(p1, 8, pa3);
#undef PK4
}
__device__ __forceinline__ void qkt(f32x16& p0, f32x16& p1, const bf16* Ks, const bf16x8* qr, int r32, int hi) {
  p0 = f32x16{}; p1 = f32x16{};
  for (int d0 = 0; d0 < 8; ++d0) { int cb = (d0 * 16 + hi * 8) * 2;
    bf16x8 b0 = *reinterpret_cast<const bf16x8*>((const char*)Ks + KSWZ(r32, cb));
    bf16x8 b1 = *reinterpret_cast<const bf16x8*>((const char*)Ks + KSWZ(32 + r32, cb));
    p0 = __builtin_amdgcn_mfma_f32_32x32x16_bf16(b0, qr[d0], p0, 0, 0, 0);
    p1 = __builtin_amdgcn_mfma_f32_32x32x16_bf16(b1, qr[d0], p1, 0, 0, 0); }
}
__device__ __forceinline__ int v_st(int k, int c) { const int kk = (k & ~0xC) | ((k & 4) << 1) | ((k & 8) >> 1); return ((kk >> 3) * 4 + (c >> 5)) * 512 + ((kk & 7) * 32 + (c & 31)) * 2; }
__device__ __forceinline__ int v_rd_base(int lane) { return ((lane & 3) << 3) | (((lane >> 2) & 3) << 6) | (((lane >> 4) & 1) << 5) | (((lane >> 5) & 1) << 8); }
constexpr int v_rd_off(int d0, int ks, int half) { return d0 * 512 + ks * 4096 + half * 2048; }
template <int OFF> __device__ __forceinline__ s16x4 tr_read(int vb) {
  s16x4 r; asm volatile("ds_read_b64_tr_b16 %0, %1 offset:%2" : "=&v"(r) : "v"(vb), "i"(OFF) : "memory"); return r;
}
template <int D0> __device__ __forceinline__ void pv_one(f32x16& od, int vb, bf16x8 pa0, bf16x8 pa1, bf16x8 pa2, bf16x8 pa3) {
  const s16x4 l0 = tr_read<v_rd_off(D0, 0, 0)>(vb), h0 = tr_read<v_rd_off(D0, 0, 1)>(vb), l1 = tr_read<v_rd_off(D0, 1, 0)>(vb), h1 = tr_read<v_rd_off(D0, 1, 1)>(vb);
  const s16x4 l2 = tr_read<v_rd_off(D0, 2, 0)>(vb), h2 = tr_read<v_rd_off(D0, 2, 1)>(vb), l3 = tr_read<v_rd_off(D0, 3, 0)>(vb), h3 = tr_read<v_rd_off(D0, 3, 1)>(vb);
  asm volatile("s_waitcnt lgkmcnt(0)" ::: "memory"); SBAR();
#define PK(L, H) (bf16x8){L[0], L[1], L[2], L[3], H[0], H[1], H[2], H[3]}
  od = __builtin_amdgcn_mfma_f32_32x32x16_bf16(pa0, PK(l0, h0), od, 0, 0, 0);
  od = __builtin_amdgcn_mfma_f32_32x32x16_bf16(pa1, PK(l1, h1), od, 0, 0, 0);
  od = __builtin_amdgcn_mfma_f32_32x32x16_bf16(pa2, PK(l2, h2), od, 0, 0, 0);
  od = __builtin_amdgcn_mfma_f32_32x32x16_bf16(pa3, PK(l3, h3), od, 0, 0, 0);
#undef PK
}
__device__ __forceinline__ void pv_d0(f32x16* o, int vb, bf16x8 pa0, bf16x8 pa1, bf16x8 pa2, bf16x8 pa3) {
  pv_one<0>(o[0], vb, pa0, pa1, pa2, pa3); pv_one<1>(o[1], vb, pa0, pa1, pa2, pa3); pv_one<2>(o[2], vb, pa0, pa1, pa2, pa3); pv_one<3>(o[3], vb, pa0, pa1, pa2, pa3);
}

template <typename TQ>
__device__ __forceinline__ void attn_dense_body(const TQ* __restrict__ Qb, const bf16* __restrict__ Kh, const bf16* __restrict__ Vh,
                                                bf16* __restrict__ Ob, int seq, char* lds) {
  using St = Stage<bf16>; using SQ = Stage<TQ>;
  const int tid = opaque_tid(), wid = tid >> 6, lane = tid & 63, r32 = lane & 31, hi = lane >> 5;
  bf16* V_lds = (bf16*)lds; bf16* K_lds = (bf16*)(lds + 2 * SHM_V);
  float* ws = (float*)(lds + 2 * SHM_V + 2 * SHM_K) + wid * 64; float* li_l = ws; float* al_l = ws + 32;
  float m_reg = -1e30f, l_reg = 0; f32x16 o[4] = {}; bf16x8 qr[8];
  const TQ* Qw = Qb + (long)(wid * QBLK + r32) * LDQ + hi * 8;
#pragma unroll
  for (int d0 = 0; d0 < 8; ++d0) qr[d0] = SQ::tobf(SQ::ld8(Qw + d0 * 16));
  const int sr = tid >> 4, sc = (tid & 15) * 8, vst0 = v_st(sr, sc), vst1 = v_st(32 + sr, sc);
  const int vb0 = (int)(uintptr_t)V_lds + v_rd_base(lane);
  struct { typename St::T vs0, vs1, ks0, ks1; } sr_[SDEPTH];
#define SLOAD(i, k0) do { sr_[i].vs0 = St::ld8(&Vh[(long)((k0) + sr) * LDK + sc]); sr_[i].vs1 = St::ld8(&Vh[(long)((k0) + 32 + sr) * LDK + sc]); \
    sr_[i].ks0 = St::ld8(&Kh[(long)((k0) + sr) * LDK + sc]); sr_[i].ks1 = St::ld8(&Kh[(long)((k0) + 32 + sr) * LDK + sc]); } while (0)
#define SWRITE(b, i) do { *(bf16x8*)((char*)V_lds + (b) * SHM_V + vst0) = St::tobf(sr_[i].vs0);          \
    *(bf16x8*)((char*)V_lds + (b) * SHM_V + vst1) = St::tobf(sr_[i].vs1); int kc = sc * 2;               \
    *(bf16x8*)((char*)K_lds + (b) * SHM_K + KSWZ(sr, kc)) = St::tobf(sr_[i].ks0);                       \
    *(bf16x8*)((char*)K_lds + (b) * SHM_K + KSWZ(32 + sr, kc)) = St::tobf(sr_[i].ks1); } while (0)
#define SWAIT() do { if constexpr (SDEPTH == 2) asm volatile("s_waitcnt vmcnt(4)" ::: "memory"); else asm volatile("s_waitcnt vmcnt(0)" ::: "memory"); } while (0)
#define RESC(a) do { if (__any((a) < 1.f)) { if (hi == 0) al_l[r32] = (a); asm volatile("s_waitcnt lgkmcnt(0)" ::: "memory"); \
    for (int d = 0; d < 4; ++d) for (int r = 0; r < 16; ++r) o[d][r] *= al_l[crow(r, hi)]; } } while (0)
  f32x16 pA0, pA1, pB0, pB1; float mnA, mnB, alA, alB; bf16x8 pa0, pa1, pa2, pa3; const int NT = seq / KVBLK;
  constexpr int SE = 0, SO = SDEPTH - 1;
  SLOAD(SE, 0); asm volatile("s_waitcnt vmcnt(0)" ::: "memory"); SWRITE(0, SE); __syncthreads();
  qkt(pA0, pA1, K_lds, qr, r32, hi); partialSM(pA0, pA1, m_reg, mnA, alA);
  SLOAD(SO, KVBLK); if constexpr (SDEPTH == 2) { if (2 < NT) SLOAD(SE, 2 * KVBLK); }
  SWAIT(); SWRITE(1, SO); __syncthreads();
  for (int j = 1; j + 1 < NT; j += 2) {
    SBAR(); qkt(pB0, pB1, (bf16*)((char*)K_lds + SHM_K), qr, r32, hi);
    finishSM(pA0, pA1, alA, l_reg, pa0, pa1, pa2, pa3); SBAR();
    SLOAD(SO, (j + SDEPTH) * KVBLK); SBAR();
    pv_d0(o, vb0, pa0, pa1, pa2, pa3); partialSM(pB0, pB1, m_reg, mnB, alB);
    __syncthreads(); SWAIT(); SWRITE(0, SE);
    RESC(alB); __syncthreads();
    SBAR(); qkt(pA0, pA1, K_lds, qr, r32, hi);
    finishSM(pB0, pB1, alB, l_reg, pa0, pa1, pa2, pa3); SBAR();
    if (SDEPTH == 1 || j + 3 < NT) SLOAD(SE, (j + 1 + SDEPTH) * KVBLK); SBAR();
    pv_d0(o, vb0 + (int)SHM_V, pa0, pa1, pa2, pa3); partialSM(pA0, pA1, m_reg, mnA, alA);
    __syncthreads(); SWAIT(); SWRITE(1, SO);
    RESC(alA); __syncthreads();
  }
  SBAR(); qkt(pB0, pB1, (bf16*)((char*)K_lds + SHM_K), qr, r32, hi);
  finishSM(pA0, pA1, alA, l_reg, pa0, pa1, pa2, pa3); SBAR();
  pv_d0(o, vb0, pa0, pa1, pa2, pa3); partialSM(pB0, pB1, m_reg, mnB, alB);
  __syncthreads(); RESC(alB);
  finishSM(pB0, pB1, alB, l_reg, pa0, pa1, pa2, pa3); SBAR();
  pv_d0(o, vb0 + (int)SHM_V, pa0, pa1, pa2, pa3);
  if (hi == 0) li_l[r32] = l_reg; asm volatile("s_waitcnt lgkmcnt(0)" ::: "memory");
  float rli[16];
#pragma unroll
  for (int r = 0; r < 16; ++r) rli[r] = __builtin_amdgcn_rcpf(li_l[crow(r, hi)]);
  bf16* Ow = Ob + (long)(wid * QBLK) * LDO;
#pragma unroll
  for (int r = 0; r < 16; ++r) { int orow = crow(r, hi);
    for (int d0 = 0; d0 < 4; ++d0) Ow[(long)orow * LDO + d0 * 32 + r32] = __float2bfloat16(o[d0][r] * rli[r]); }
#undef SLOAD
#undef SWRITE
#undef SWAIT
#undef RESC
}

}
#define LAS __attribute__((address_space(3)))
typedef unsigned short bf16_t;
typedef short bf16x8 __attribute__((ext_vector_type(8)));
typedef short s16x4 __attribute__((ext_vector_type(4)));
typedef float f32x4 __attribute__((ext_vector_type(4)));
typedef float f32x16 __attribute__((ext_vector_type(16)));
typedef unsigned u32x4 __attribute__((ext_vector_type(4)));
typedef unsigned u32x2 __attribute__((ext_vector_type(2)));
using pg8::cvtpk_s; using pg8::bf_lo; using pg8::bf_hi; using pg8::silu_f;

constexpr int DM = 1024, SEQ = 16384, CTXL = 256, NLAT = 2 * SEQ, MROWS = NLAT + 2 * CTXL, DFF = 4096;
constexpr float EPS = 1e-6f;
constexpr size_t MiB = 1u << 20;
constexpr size_t WS_BAR = 512 * 1024, WS_BAR_BYTES = 16384;
constexpr size_t WS_MOD = 0, WS_CTX = 1 * MiB, WS_WT = 4 * MiB, WS_H = 41 * MiB, WS_AB = 106 * MiB, WS_RSTD = 115 * MiB, WS_P = 118 * MiB, WS_O = 378 * MiB, WS_END = 508 * MiB;
constexpr size_t WT_A = WS_WT, WT_Z = WS_WT + 9 * MiB, WT_O = WS_WT + 13 * MiB, WT_1 = WS_WT + 17 * MiB, WT_2 = WS_WT + 25 * MiB;
constexpr size_t WS_QM = 313 * MiB, WS_KM = 378 * MiB, WS_OGLA = 443 * MiB, WS_AQ = 41 * MiB, WS_EL = 74 * MiB;
constexpr size_t WS_TP = 4 * MiB, WS_HALO = 378 * MiB;
constexpr size_t WS_QR = 216 * MiB, WS_KR = 281 * MiB, WS_VR = 298 * MiB;
constexpr int SKV = SEQ + CTXL;
constexpr int LDS_BYTES = 155648;
enum { OP_MOD, OP_PREP, OP_GEMM_IN, OP_DNSCAN, OP_DNREDO, OP_GEMM_Z, OP_GEMM_OUT, OP_NORM2, OP_FFN1, OP_FFN2, OP_GLAPREP, OP_GLASCAN, OP_GLAGATE, OP_QKROPE, OP_ATTN, OP_DNHALO, OP_DNCONV, OP_DNT };

struct Args { const float* in[25]; float* out; unsigned char* ws; int ph_lo, ph_hi; };

__device__ __forceinline__ float wave_sum(float v) {
#pragma unroll
    for (int o = 1; o < 64; o <<= 1) v += __shfl_xor(v, o);
    return v;
}
__device__ __forceinline__ float softplus_f(float x) { return x > 20.f ? x : log1pf(__expf(x)); }
__device__ __forceinline__ float logsigmoid_f(float x) { return fminf(x, 0.f) - log1pf(__expf(-fabsf(x))); }
__device__ __forceinline__ bf16_t f2bf(float f) { return (bf16_t)(cvtpk_s(f, 0.f) & 0xffffu); }
__device__ __forceinline__ float bf2f(bf16_t v) { return __builtin_bit_cast(float, (unsigned)v << 16); }

__device__ __forceinline__ void transpose_item(const float* W, int ldw, int c0, int ncols, int K, bf16_t* WT, int row_off, LAS float* scr, int item, int lane) {
    const int nblk = ncols / 32, kb = item / nblk, nb = item % nblk, k0 = 64 * kb, n0 = 32 * nb;
#pragma unroll 8
    for (int i = 0; i < 32; ++i) { const int kk = 2 * i + (lane >> 5); scr[kk * 33 + (lane & 31)] = W[(size_t)(k0 + kk) * ldw + c0 + n0 + (lane & 31)]; }
    asm volatile("s_waitcnt lgkmcnt(0)" ::: "memory");
    const int c = lane & 7;
#pragma unroll
    for (int j = 0; j < 4; ++j) { const int n = (lane >> 3) + 8 * j; const LAS float* s = scr + (8 * c) * 33 + n;
        u32x4 o; o.x = cvtpk_s(s[0 * 33], s[1 * 33]); o.y = cvtpk_s(s[2 * 33], s[3 * 33]); o.z = cvtpk_s(s[4 * 33], s[5 * 33]); o.w = cvtpk_s(s[6 * 33], s[7 * 33]);
        *(u32x4*)(WT + (size_t)(row_off + n0 + n) * K + k0 + 8 * c) = o; }
    asm volatile("s_waitcnt lgkmcnt(0)" ::: "memory");
}
__device__ __forceinline__ void transpose_mat(const float* W, int ldw, int c0, int ncols, int K, bf16_t* WT, int row_off, LAS float* scr, int gw, int NGW, int lane) {
    const int nitems = (K / 64) * (ncols / 32);
    for (int it = gw; it < nitems; it += NGW) transpose_item(W, ldw, c0, ncols, K, WT, row_off, scr, it, lane);
}
__device__ __forceinline__ void normmod_rows(const float* xl, const float* xc, const float* g, const float* modl, int sidx, bf16_t* H, int gw, int NGW, int lane) {
    for (int row0 = gw; row0 < MROWS; row0 += 2 * NGW) {
        const int row1 = row0 + NGW; const bool has1 = row1 < MROWS; const int rows[2] = {row0, has1 ? row1 : row0};
        f32x4 v[2][4]; float ss[2] = {0.f, 0.f};
#pragma unroll
        for (int q = 0; q < 2; ++q) { const int row = rows[q]; const float* xr = row < NLAT ? xl + (size_t)row * DM : xc + (size_t)(row - NLAT) * DM;
#pragma unroll
            for (int j = 0; j < 4; ++j) v[q][j] = *(const f32x4*)(xr + 4 * lane + 256 * j); }
#pragma unroll
        for (int q = 0; q < 2; ++q)
#pragma unroll
            for (int j = 0; j < 4; ++j) ss[q] += (v[q][j][0] * v[q][j][0] + v[q][j][1] * v[q][j][1]) + (v[q][j][2] * v[q][j][2] + v[q][j][3] * v[q][j][3]);
#pragma unroll
        for (int q = 0; q < 2; ++q) {
            if (q == 1 && !has1) break;
            const int row = rows[q]; const int mi = row < SEQ ? 0 : (row < NLAT ? 1 : 2);
            const float* sh = modl + (size_t)mi * 6144 + (size_t)sidx * 1024; const float* sc = sh + 1024;
            const float rinv = rsqrtf(wave_sum(ss[q]) * (1.f / DM) + EPS);
#pragma unroll
            for (int j = 0; j < 4; ++j) { const int c = 4 * lane + 256 * j; const f32x4 gg = *(const f32x4*)(g + c), s1 = *(const f32x4*)(sc + c), s0 = *(const f32x4*)(sh + c);
                f32x4 y;
#pragma unroll
                for (int e = 0; e < 4; ++e) y[e] = v[q][j][e] * rinv * gg[e] * (1.f + s1[e]) + s0[e];
                u32x2 w; w.x = cvtpk_s(y[0], y[1]); w.y = cvtpk_s(y[2], y[3]); *(u32x2*)(H + (size_t)row * DM + c) = w; }
        }
    }
}
#define BAR_LDS() do { asm volatile("s_waitcnt lgkmcnt(0)" ::: "memory"); __builtin_amdgcn_s_barrier(); asm volatile("" ::: "memory"); } while (0)
__device__ __forceinline__ int crow(int x, int h) { return (x & 3) + 8 * (x >> 2) + 4 * h; }
#define MFMA32(a, b, c) __builtin_amdgcn_mfma_f32_32x32x16_bf16((a), (b), (c), 0, 0, 0)
__device__ __forceinline__ bf16x8 frag_nat(const LAS bf16_t* img, int LD, int row, int ks, int h) { return *(const LAS bf16x8*)(img + row * LD + 16 * ks + 8 * h); }
__device__ __forceinline__ bf16x8 frag_perm(const LAS bf16_t* img, int LD, int row, int ks, int h) {
    const s16x4 lo = *(const LAS s16x4*)(img + row * LD + 16 * ks + 4 * h), hi = *(const LAS s16x4*)(img + row * LD + 16 * ks + 8 + 4 * h);
    return __builtin_shufflevector(lo, hi, 0, 1, 2, 3, 4, 5, 6, 7);
}
__device__ __forceinline__ s16x4 tr4(const LAS bf16_t* p) { return __builtin_bit_cast(s16x4, __builtin_amdgcn_ds_read_tr16_b64_v4i16((LAS s16x4*)p)); }
__device__ __forceinline__ bf16x8 frag_tr(const LAS bf16_t* img, int LD, int m0, int ks, int lane) {
    const int i16 = lane & 15, q = i16 >> 2, p = i16 & 3, blk = (lane >> 4) & 1, h = lane >> 5;
    const LAS bf16_t* a = img + (16 * ks + 4 * h + q) * LD + m0 + 16 * blk + 4 * p;
    const s16x4 lo = tr4(a), hi = tr4(a + 8 * LD);
    return __builtin_shufflevector(lo, hi, 0, 1, 2, 3, 4, 5, 6, 7);
}
__device__ __forceinline__ bf16x8 pack_step(const f32x16& x, int s) {
    u32x4 p; p.x = cvtpk_s(x[8 * s + 0], x[8 * s + 1]); p.y = cvtpk_s(x[8 * s + 2], x[8 * s + 3]); p.z = cvtpk_s(x[8 * s + 4], x[8 * s + 5]); p.w = cvtpk_s(x[8 * s + 6], x[8 * s + 7]);
    return __builtin_bit_cast(bf16x8, p);
}
__device__ __forceinline__ void dn_halo_phase(const bf16_t* P, bf16_t* HALO, int G) {
    const int tid = opaque_tid();
    for (size_t e = (size_t)blockIdx.x * 512 + tid; e < (size_t)520 * 4 * 512; e += (size_t)G * 512) {
        const int c = (int)(e & 511), j = (int)((e >> 9) & 3), rb = (int)(e >> 11);
        const int row = rb * 64 + (j < 2 ? j : 60 + j);
        ((u32x4*)(HALO + ((size_t)rb * 4 + j) * 4096))[c] = ((const u32x4*)(P + (size_t)row * 4096))[c];
    }
}
__device__ __forceinline__ void unpack8(const u32x4 v, float (&f)[8]) { f[0] = bf_lo(v.x); f[1] = bf_hi(v.x); f[2] = bf_lo(v.y); f[3] = bf_hi(v.y); f[4] = bf_lo(v.z); f[5] = bf_hi(v.z); f[6] = bf_lo(v.w); f[7] = bf_hi(v.w); }
__device__ __forceinline__ void dn_conv_phase(bf16_t* P, const bf16_t* HALO, const float* conv_w, int G) {
    const int tid = opaque_tid(), col0 = 8 * tid;
    float cw[8][5];
#pragma unroll
    for (int c = 0; c < 8; ++c)
#pragma unroll
        for (int tap = 0; tap < 5; ++tap) cw[c][tap] = conv_w[(size_t)(col0 + c) * 5 + tap];
    const int kind = col0 < 1024 ? 0 : (col0 < 2048 ? 1 : 2);
    for (int rb = blockIdx.x; rb < 520; rb += G) {
        const int cs = rb < 512 ? (rb & 255) : ((rb - 512) & 3); const bool sfirst = cs == 0, slast = rb < 512 ? cs == 255 : cs == 3;
        const u32x4 zero = (u32x4){0u, 0u, 0u, 0u};
        bf16_t* base = P + (size_t)rb * 64 * 4096 + col0;
        u32x4 w0 = sfirst ? zero : *(const u32x4*)(HALO + ((size_t)(rb - 1) * 4 + 2) * 4096 + col0);
        u32x4 w1 = sfirst ? zero : *(const u32x4*)(HALO + ((size_t)(rb - 1) * 4 + 3) * 4096 + col0);
        u32x4 w2 = *(const u32x4*)(base), w3 = *(const u32x4*)(base + 4096);
#pragma unroll 4
        for (int rr = 0; rr < 64; ++rr) {
            u32x4 w4;
            if (rr + 2 < 64) w4 = *(const u32x4*)(base + (size_t)(rr + 2) * 4096);
            else w4 = slast ? zero : *(const u32x4*)(HALO + ((size_t)(rb + 1) * 4 + (rr + 2 - 64)) * 4096 + col0);
            float x0[8], x1[8], x2[8], x3[8], x4[8], y[8];
            unpack8(w0, x0); unpack8(w1, x1); unpack8(w2, x2); unpack8(w3, x3); unpack8(w4, x4);
            float ss = 0.f;
#pragma unroll
            for (int c = 0; c < 8; ++c) { const float a = x0[c] * cw[c][0] + x1[c] * cw[c][1] + x2[c] * cw[c][2] + x3[c] * cw[c][3] + x4[c] * cw[c][4]; y[c] = silu_f(a); ss += y[c] * y[c]; }
            float sc = 1.f;
            if (kind < 2) { ss += __shfl_xor(ss, 1); ss += __shfl_xor(ss, 2); ss += __shfl_xor(ss, 4); ss += __shfl_xor(ss, 8); sc = rsqrtf(ss + EPS) * (kind == 0 ? 0.08838834764831845f : 1.f); }
            u32x4 o; o.x = cvtpk_s(y[0] * sc, y[1] * sc); o.y = cvtpk_s(y[2] * sc, y[3] * sc); o.z = cvtpk_s(y[4] * sc, y[5] * sc); o.w = cvtpk_s(y[6] * sc, y[7] * sc);
            *(u32x4*)(base + (size_t)rr * 4096) = o;
            w0 = w1; w1 = w2; w2 = w3; w3 = w4;
        }
    }
}
constexpr int DT_KB = 0, DT_R = 17408, DT_SC = 33792, DT_DIR = 34816;
template <int W> __device__ __forceinline__ void dn_solve(const LAS float* Mf, float (&t)[16], int lane) {
    const int j = 16 * W + (lane >> 2), q = lane & 3;
#pragma unroll
    for (int s = 0; s < 16; ++s) t[s] = 0.f;
#pragma unroll
    for (int i = 16 * W; i < 64; ++i) {
        float acc = 0.f;
#pragma unroll
        for (int s = 4 * W; s <= (i - 1) / 4 && i > 16 * W; ++s) acc += Mf[i * 64 + 4 * s + q] * t[s];
        acc += __shfl_xor(acc, 1); acc += __shfl_xor(acc, 2);
        const float val = (i == j ? 1.f : 0.f) - acc;
        if (q == (i & 3)) t[i >> 2] = val;
        asm volatile("" : "+v"(t[0]), "+v"(t[1]), "+v"(t[2]), "+v"(t[3]), "+v"(t[4]), "+v"(t[5]), "+v"(t[6]), "+v"(t[7]), "+v"(t[8]), "+v"(t[9]), "+v"(t[10]), "+v"(t[11]), "+v"(t[12]), "+v"(t[13]), "+v"(t[14]), "+v"(t[15]));
    }
}
__device__ __forceinline__ void dn_t_phase(LAS unsigned char* lds, const bf16_t* P, float* AB, bf16_t* TP, const float* a_log, const float* dt_bias, int G) {
    const int tid0 = opaque_tid(), hb = __builtin_amdgcn_readfirstlane(tid0 >> 8);
    u32x4 pk4[4]; float pav = 0.f, pbv = 0.f;
    {
        const int it = blockIdx.x * 2 + hb;
        if (it < 16640) { const int dir = it & 1, vh = (it >> 1) & 15, rb = it >> 5, kh = vh >> 1, t = tid0 & 255, r0 = t >> 4, c8 = 8 * (t & 15);
#pragma unroll
            for (int v = 0; v < 4; ++v) pk4[v] = *(const u32x4*)(P + (size_t)(rb * 64 + r0 + 16 * v) * 4096 + 1024 + kh * 128 + c8);
            const int ti = dir ? 63 - (t & 63) : (t & 63); const float* ab = AB + (size_t)(rb * 64 + ti) * 64; pav = ab[dir * 16 + vh]; pbv = ab[32 + dir * 16 + vh]; }
    }
    for (int itb = blockIdx.x * 2; itb < 16640; itb += 2 * G) {
        const int it = itb + hb, dir = it & 1, vh = (it >> 1) & 15, rb = it >> 5, kh = vh >> 1;
        const int tq = opaque_tid(), t = tq & 255, w = __builtin_amdgcn_readfirstlane((tq >> 6) & 3), lane = tq & 63, r = lane & 31, h = lane >> 5;
        LAS unsigned char* base = lds + hb * DT_DIR;
        LAS bf16_t* Kb = (LAS bf16_t*)(base + DT_KB); LAS float* Mf = (LAS float*)(base + DT_R); LAS bf16_t* Tb = (LAS bf16_t*)(base + DT_R);
        LAS float* sc_beta = (LAS float*)(base + DT_SC); LAS float* sc_gc = sc_beta + 64;
        {
            const int r0 = t >> 4, c8 = 8 * (t & 15);
#pragma unroll
            for (int v = 0; v < 4; ++v) { const int i = r0 + 16 * v, ip = dir ? 63 - i : i;
                *(LAS u32x4*)(Kb + ip * 136 + c8) = pk4[v]; }
            if (t < 64) {
                const int ti = dir ? 63 - t : t; float* ab = AB + (size_t)(rb * 64 + ti) * 64;
                const float av = pav, bv = pbv;
                const float g = -__expf(a_log[dir * 16 + vh]) * softplus_f(av + dt_bias[dir * 16 + vh]), beta = 1.f / (1.f + __expf(-bv));
                float gc = g;
#pragma unroll
                for (int o = 1; o < 64; o <<= 1) { const float up = __shfl_up(gc, o); if (t >= o) gc += up; }
                sc_beta[t] = beta; sc_gc[t] = gc;
                ab[dir * 16 + vh] = gc; ab[32 + dir * 16 + vh] = beta;
            }
        }
        BAR_LDS();
        {
            const int itn = it + 2 * G;
            if (itn < 16640) { const int dirn = itn & 1, vhn = (itn >> 1) & 15, rbn = itn >> 5, khn = vhn >> 1, r0 = t >> 4, c8 = 8 * (t & 15);
#pragma unroll
                for (int v = 0; v < 4; ++v) pk4[v] = *(const u32x4*)(P + (size_t)(rbn * 64 + r0 + 16 * v) * 4096 + 1024 + khn * 128 + c8);
                const int tin = dirn ? 63 - (t & 63) : (t & 63); const float* abn = AB + (size_t)(rbn * 64 + tin) * 64; pav = abn[dirn * 16 + vhn]; pbv = abn[32 + dirn * 16 + vhn]; }
        }
        const int ti = w >> 1, tj = w & 1;
        {
            f32x16 acc;
#pragma unroll
            for (int x = 0; x < 16; ++x) acc[x] = 0.f;
            if (!(ti == 0 && tj == 1)) {
#pragma unroll
                for (int ks = 0; ks < 8; ++ks) acc = MFMA32(frag_nat(Kb, 136, 32 * ti + r, ks, h), frag_nat(Kb, 136, 32 * tj + r, ks, h), acc);
            }
            const int j = 32 * tj + r; const float gj = sc_gc[j];
#pragma unroll
            for (int x = 0; x < 16; ++x) { const int i = 32 * ti + crow(x, h);
                Mf[i * 64 + j] = (i > j) ? sc_beta[i] * acc[x] * __expf(sc_gc[i] - gj) : 0.f; }
        }
        BAR_LDS();
        float tc[16];
        if (w == 0) dn_solve<0>(Mf, tc, lane); else if (w == 1) dn_solve<1>(Mf, tc, lane); else if (w == 2) dn_solve<2>(Mf, tc, lane); else dn_solve<3>(Mf, tc, lane);
        BAR_LDS();
        {
            const int j = 16 * w + (lane >> 2), q = lane & 3;
#pragma unroll
            for (int s = 0; s < 16; ++s) Tb[(4 * s + q) * 72 + j] = f2bf(tc[s]);
        }
        BAR_LDS();
        {
            bf16_t* dst = TP + (size_t)it * 3072;
#pragma unroll
            for (int k2 = 0; k2 < 2; ++k2) { const int c = t + 256 * k2;
                if (c < 384) { const int blk = c >> 7, rowc = (c & 127) >> 2, cc = c & 3, br = blk ? 1 : 0, bc = blk == 2 ? 1 : 0;
                    *(u32x4*)(dst + c * 8) = *(const LAS u32x4*)(Tb + (32 * br + rowc) * 72 + 32 * bc + 8 * cc); } }
        }
        BAR_LDS();
    }
}
constexpr int DN_KB = 0, DN_QB = 17408, DN_VB = 34816, DN_TB = 51200, DN_AB = 60416, DN_SC = 69632, DN_DIR = 71168;
__device__ __forceinline__ void dn_step_rb(int step, int dir, int b, int& rb, bool& first) {
    if (step < 4) { const int cidx = dir ? 3 - step : step; rb = 512 + b * 4 + cidx; first = step < 2; }
    else { const int c = step - 4; const int cidx = dir ? 255 - c : c; rb = b * 256 + cidx; first = c < 128; }
}
struct DnPre { u32x4 k4[4], q4[4], v4[4], t0, t1; float gc, beta; };
__device__ __forceinline__ void dn_prefetch(DnPre& p, const bf16_t* P, const float* AB, const bf16_t* TP, int rb, int dir, int vh, int kh, int t, int part) {
    const int r0 = t >> 4, c8 = 8 * (t & 15);
    const bf16_t* prow = P + (size_t)(rb * 64 + r0) * 4096 + c8;
    const bf16_t* tp = TP + (size_t)((rb * 16 + vh) * 2 + dir) * 3072;
    if (part & 1) {
#pragma unroll
        for (int v = 0; v < 4; ++v) { const bf16_t* pr = prow + (size_t)(16 * v) * 4096;
            p.k4[v] = *(const u32x4*)(pr + 1024 + kh * 128); p.q4[v] = *(const u32x4*)(pr + kh * 128); p.v4[v] = *(const u32x4*)(pr + 2048 + vh * 128); }
    }
    if (part & 2) {
        p.t0 = *(const u32x4*)(tp + t * 8); p.t1 = *(const u32x4*)(tp + (256 + (t & 127)) * 8);
        const int ti = dir ? 63 - (t & 63) : (t & 63); const float* ab = AB + (size_t)(rb * 64 + ti) * 64; p.gc = ab[dir * 16 + vh]; p.beta = ab[32 + dir * 16 + vh];
    }
}
template <int VAR> __device__ __forceinline__ void dn_scan(LAS unsigned char* lds, const bf16_t* P, const float* AB, const bf16_t* TP, bf16_t* OB) {
    const int tid = opaque_tid(), dir = __builtin_amdgcn_readfirstlane(tid >> 8);
    for (int unit = blockIdx.x; unit < 32; unit += gridDim.x) {
        const int b = unit >> 4, vh = unit & 15, kh = vh >> 1;
        f32x16 S[4];
#pragma unroll
        for (int kt = 0; kt < 4; ++kt)
#pragma unroll
            for (int x = 0; x < 16; ++x) S[kt][x] = 0.f;
        DnPre pre;
        { int rb0; bool f0; dn_step_rb(0, dir, b, rb0, f0); dn_prefetch(pre, P, AB, TP, rb0, dir, vh, kh, tid & 255, 3); }
        __syncthreads();
        for (int step = 0; step < 260; ++step) {
            const int w = __builtin_amdgcn_readfirstlane((opaque_tid() >> 6) & 3);
            LAS unsigned char* base = lds + dir * DN_DIR;
            LAS bf16_t* Kb = (LAS bf16_t*)(base + DN_KB); LAS bf16_t* Qb = (LAS bf16_t*)(base + DN_QB); LAS bf16_t* Vb = (LAS bf16_t*)(base + DN_VB);
            LAS bf16_t* Tb = (LAS bf16_t*)(base + DN_TB); LAS bf16_t* Ab = (LAS bf16_t*)(base + DN_AB);
            LAS float* sc_beta = (LAS float*)(base + DN_SC); LAS float* sc_gc = sc_beta + 64; LAS float* sc_eg = sc_beta + 128; LAS float* sc_tail = sc_beta + 192; LAS float* sc_dl = sc_beta + 256;
            int rb; bool first; dn_step_rb(step, dir, b, rb, first);
            const int row_base = rb * 64;
            {
                const int tq_ = opaque_tid(), t = tq_ & 255;
                const int r0 = t >> 4, c8 = 8 * (t & 15);
#pragma unroll
                for (int v = 0; v < 4; ++v) { const int i = r0 + 16 * v, ip = dir ? 63 - i : i;
                    *(LAS u32x4*)(Kb + ip * 136 + c8) = pre.k4[v]; *(LAS u32x4*)(Qb + ip * 136 + c8) = pre.q4[v]; *(LAS u32x4*)(Vb + ip * 128 + c8) = pre.v4[v]; }
                { const int c = t, blk = c >> 7, rowc = (c & 127) >> 2, cc = c & 3, br = blk ? 1 : 0; *(LAS u32x4*)(Tb + (32 * br + rowc) * 72 + 8 * cc) = pre.t0; }
                if (t < 128) { const int rowc = t >> 2, cc = t & 3; *(LAS u32x4*)(Tb + (32 + rowc) * 72 + 32 + 8 * cc) = pre.t1; }
                if (t < 64) { const float gc = pre.gc, gl = __shfl(gc, 63); sc_beta[t] = pre.beta; sc_gc[t] = gc; sc_eg[t] = __expf(gc); sc_tail[t] = __expf(gl - gc); if (t == 0) sc_dl[0] = __expf(gl); }
            }
            BAR_LDS();
            {
                const int tq_ = opaque_tid(), lane = tq_ & 63, r = lane & 31, h = lane >> 5;
                const int ti = w >> 1, tj = w & 1;
                if (!(ti == 0 && tj == 1)) {
                    f32x16 qk;
#pragma unroll
                    for (int x = 0; x < 16; ++x) qk[x] = 0.f;
#pragma unroll
                    for (int ks = 0; ks < 8; ++ks) qk = MFMA32(frag_nat(Qb, 136, 32 * ti + r, ks, h), frag_nat(Kb, 136, 32 * tj + r, ks, h), qk);
                    const int jj = 32 * tj + r; const float gj = sc_gc[jj];
#pragma unroll
                    for (int x = 0; x < 16; ++x) { const int i = 32 * ti + crow(x, h);
                        Ab[i * 72 + jj] = f2bf((i >= jj) ? qk[x] * __expf(sc_gc[i] - gj) : 0.f); }
                }
            }
            BAR_LDS();
            if (VAR != 2 && step + 1 < 260) { int rbn; bool fn; dn_step_rb(step + 1, dir, b, rbn, fn); dn_prefetch(pre, P, AB, TP, rbn, dir, vh, kh, opaque_tid() & 255, 1); }
            __builtin_amdgcn_sched_barrier(0);
            if (VAR != 1) {
                const int tq_ = opaque_tid(), lane = tq_ & 63, r = lane & 31, h = lane >> 5;
                f32x16 KS[2], QS[2];
#pragma unroll
                for (int mt = 0; mt < 2; ++mt)
#pragma unroll
                    for (int x = 0; x < 16; ++x) { KS[mt][x] = 0.f; QS[mt][x] = 0.f; }
#pragma unroll
                for (int ks = 0; ks < 8; ++ks) {
                    const bf16x8 sp = pack_step(S[ks >> 1], ks & 1);
#pragma unroll
                    for (int mt = 0; mt < 2; ++mt) { KS[mt] = MFMA32(frag_perm(Kb, 136, 32 * mt + r, ks, h), sp, KS[mt]); QS[mt] = MFMA32(frag_perm(Qb, 136, 32 * mt + r, ks, h), sp, QS[mt]); }
                    if (ks & 1) __builtin_amdgcn_sched_barrier(0);
                }
#pragma unroll
                for (int mt = 0; mt < 2; ++mt)
#pragma unroll
                    for (int x = 0; x < 16; ++x) { const int i = 32 * mt + crow(x, h);
                        KS[mt][x] = sc_beta[i] * (bf2f(Vb[i * 128 + 32 * w + r]) - sc_eg[i] * KS[mt][x]); }
                __builtin_amdgcn_sched_barrier(0);
                bf16x8 Xp[4];
#pragma unroll
                for (int ks = 0; ks < 4; ++ks) Xp[ks] = pack_step(KS[ks >> 1], ks & 1);
                f32x16 VN[2];
#pragma unroll
                for (int mt = 0; mt < 2; ++mt) {
#pragma unroll
                    for (int x = 0; x < 16; ++x) VN[mt][x] = 0.f;
#pragma unroll
                    for (int ks = 0; ks < 4; ++ks) if (ks < 2 * mt + 2) VN[mt] = MFMA32(frag_perm(Tb, 72, 32 * mt + r, ks, h), Xp[ks], VN[mt]);
                }
                __builtin_amdgcn_sched_barrier(0);
                if (VAR != 2 && step + 1 < 260) { int rbn; bool fn; dn_step_rb(step + 1, dir, b, rbn, fn); dn_prefetch(pre, P, AB, TP, rbn, dir, vh, kh, opaque_tid() & 255, 2); }
                __builtin_amdgcn_sched_barrier(0);
                bf16x8 VNp[4];
#pragma unroll
                for (int ks = 0; ks < 4; ++ks) VNp[ks] = pack_step(VN[ks >> 1], ks & 1);
#pragma unroll
                for (int mt = 0; mt < 2; ++mt) {
#pragma unroll
                    for (int x = 0; x < 16; ++x) QS[mt][x] *= sc_eg[32 * mt + crow(x, h)];
#pragma unroll
                    for (int ks = 0; ks < 4; ++ks) if (ks < 2 * mt + 2) QS[mt] = MFMA32(frag_perm(Ab, 72, 32 * mt + r, ks, h), VNp[ks], QS[mt]);
                }
                __builtin_amdgcn_sched_barrier(0);
#pragma unroll
                for (int mt = 0; mt < 2; ++mt)
#pragma unroll
                    for (int x = 0; x < 16; ++x) Vb[(32 * mt + crow(x, h)) * 128 + 32 * w + r] = f2bf(QS[mt][x]);
                __builtin_amdgcn_sched_barrier(0);
#pragma unroll
                for (int mt = 0; mt < 2; ++mt)
#pragma unroll
                    for (int x = 0; x < 16; ++x) VN[mt][x] *= sc_tail[32 * mt + crow(x, h)];
#pragma unroll
                for (int ks = 0; ks < 4; ++ks) VNp[ks] = pack_step(VN[ks >> 1], ks & 1);
                __builtin_amdgcn_sched_barrier(0);
                const float dl = sc_dl[0];
#pragma unroll
                for (int kt = 0; kt < 4; ++kt)
#pragma unroll
                    for (int x = 0; x < 16; ++x) S[kt][x] *= dl;
#pragma unroll
                for (int ks = 0; ks < 4; ++ks) {
#pragma unroll
                    for (int kt = 0; kt < 4; ++kt) S[kt] = MFMA32(frag_tr(Kb, 136, 32 * kt, ks, lane), VNp[ks], S[kt]);
                    __builtin_amdgcn_sched_barrier(0);
                }
                if (VAR != 2) {
                    const int rr_ = lane >> 2, c8_ = 8 * (lane & 3);
#pragma unroll
                    for (int v = 0; v < 4; ++v) { const int ip_ = rr_ + 16 * v, i_ = dir ? 63 - ip_ : ip_;
                        u32x4* gp_ = (u32x4*)(OB + (size_t)(row_base + i_) * 2048 + vh * 128 + 32 * w + c8_);
                        u32x4 o = *(const LAS u32x4*)(Vb + ip_ * 128 + 32 * w + c8_);
                        if (!first) { const u32x4 e = gp_[0];
                            o.x = cvtpk_s(bf_lo(o.x) + bf_lo(e.x), bf_hi(o.x) + bf_hi(e.x)); o.y = cvtpk_s(bf_lo(o.y) + bf_lo(e.y), bf_hi(o.y) + bf_hi(e.y));
                            o.z = cvtpk_s(bf_lo(o.z) + bf_lo(e.z), bf_hi(o.z) + bf_hi(e.z)); o.w = cvtpk_s(bf_lo(o.w) + bf_lo(e.w), bf_hi(o.w) + bf_hi(e.w)); }
                        gp_[0] = o; }
                }
            }
            if (step == 1 || step == 131) asm volatile("s_waitcnt vmcnt(0)" ::: "memory");
            BAR_LDS();
        }
    }
}
constexpr int GP_QM = 0, GP_KM = 17408, GP_AB = 34816, GP_LOW = 44032, GP_TOT = 48128, GP_DIR = 49152;
__device__ __forceinline__ void gla_prep_phase(LAS unsigned char* lds, const bf16_t* P, const float* LOW, const float* gw2, const float* gb2, bf16_t* QM, bf16_t* KM, bf16_t* AQ, float* EL, int G) {
    const int tid0 = opaque_tid(), hb = __builtin_amdgcn_readfirstlane(tid0 >> 8);
    for (int itb = blockIdx.x * 2; itb < 4160; itb += 2 * G) {
        const int it = itb + hb, dir = it & 1, head = (it >> 1) & 3, rb = it >> 3;
        const int tq = opaque_tid(), t = tq & 255, w = __builtin_amdgcn_readfirstlane((tq >> 6) & 3), lane = tq & 63, r = lane & 31, h = lane >> 5;
        LAS unsigned char* base = lds + hb * GP_DIR;
        LAS bf16_t* Qm = (LAS bf16_t*)(base + GP_QM); LAS bf16_t* Km = (LAS bf16_t*)(base + GP_KM); LAS bf16_t* Ab = (LAS bf16_t*)(base + GP_AB);
        LAS float* lowS = (LAS float*)(base + GP_LOW); LAS float* tot = (LAS float*)(base + GP_TOT);
        *(LAS f32x4*)(lowS + 4 * t) = *(const f32x4*)(LOW + (size_t)(rb * 64 + (t >> 2)) * 32 + dir * 16 + 4 * (t & 3));
        const int dk = t & 127, half = t >> 7, col = head * 128 + dk;
        float w2c[16];
#pragma unroll
        for (int rr = 0; rr < 16; ++rr) w2c[rr] = gw2[(size_t)(dir * 16 + rr) * 512 + col];
        const float b2 = gb2[dir * 512 + col];
        __syncthreads();
        float bc[32]; float run = 0.f;
#pragma unroll
        for (int n = 0; n < 32; ++n) { const int ip = 32 * half + n, i = dir ? 63 - ip : ip; float s = b2;
#pragma unroll
            for (int rr = 0; rr < 16; ++rr) s += lowS[i * 16 + rr] * w2c[rr];
            run += logsigmoid_f(s) * (1.f / 16.f); bc[n] = run; }
        tot[half * 128 + dk] = run;
        __syncthreads();
        const float t0 = tot[dk], last = t0 + tot[128 + dk], off = half ? t0 : 0.f;
        if (half == 0) EL[(size_t)(dir * 520 + rb) * 512 + col] = last;
        {
            const int i0 = dir ? 63 - 32 * half : 32 * half; const long pstep = dir ? -3072 : 3072;
            const bf16_t* pp = P + (size_t)(rb * 64 + i0) * 3072 + col;
#pragma unroll
            for (int n = 0; n < 32; ++n) { const int ip = 32 * half + n; const float bcv = bc[n] + off;
                const float qv = bf2f(pp[0]), kv = bf2f(pp[512]); pp += pstep;
                Qm[ip * 136 + dk] = f2bf(qv * 0.08838834764831845f * __expf(bcv - last));
                Km[ip * 136 + dk] = f2bf(kv * __expf(last - bcv)); }
        }
        __syncthreads();
        {
            const int ti = w >> 1, tj = w & 1;
            f32x16 acc;
#pragma unroll
            for (int x = 0; x < 16; ++x) acc[x] = 0.f;
            if (!(ti == 0 && tj == 1)) {
#pragma unroll
                for (int ks = 0; ks < 8; ++ks) acc = MFMA32(frag_nat(Qm, 136, 32 * ti + r, ks, h), frag_nat(Km, 136, 32 * tj + r, ks, h), acc);
            }
            const int j = 32 * tj + r;
#pragma unroll
            for (int x = 0; x < 16; ++x) { const int i = 32 * ti + crow(x, h); Ab[i * 72 + j] = f2bf(i >= j ? acc[x] : 0.f); }
            const int r0 = t >> 4, c8 = 8 * (t & 15);
#pragma unroll
            for (int v = 0; v < 4; ++v) { const int row = r0 + 16 * v; const size_t go = ((size_t)dir * MROWS + rb * 64 + row) * 512 + head * 128 + c8;
                *(u32x4*)(QM + go) = *(const LAS u32x4*)(Qm + row * 136 + c8); *(u32x4*)(KM + go) = *(const LAS u32x4*)(Km + row * 136 + c8); }
        }
        __syncthreads();
        {
            bf16_t* dst = AQ + (size_t)it * 4096;
#pragma unroll
            for (int k2 = 0; k2 < 2; ++k2) { const int c = t + 256 * k2, row = c >> 3, cc = c & 7; *(u32x4*)(dst + c * 8) = *(const LAS u32x4*)(Ab + row * 72 + 8 * cc); }
        }
        __syncthreads();
    }
}
constexpr int GL_QM = 0, GL_KM = 17408, GL_VB = 34816, GL_AB = 52224, GL_EL = 61440, GL_DIR = 61952;
struct GlPre { u32x4 q4[4], k4[4], v4[4], a0, a1; float elv; };
__device__ __forceinline__ void gl_prefetch(GlPre& p, const bf16_t* P, const bf16_t* QM, const bf16_t* KM, const bf16_t* AQ, const float* EL, int rb, int dir, int head, int hf, int t) {
    const int r0 = t >> 4, c8 = 8 * (t & 15);
    const bf16_t* aq = AQ + (size_t)((rb * 4 + head) * 2 + dir) * 4096;
#pragma unroll
    for (int v = 0; v < 4; ++v) { const size_t row = (size_t)(rb * 64 + r0 + 16 * v);
        p.q4[v] = *(const u32x4*)(QM + ((size_t)dir * MROWS + row) * 512 + head * 128 + c8);
        p.k4[v] = *(const u32x4*)(KM + ((size_t)dir * MROWS + row) * 512 + head * 128 + c8);
        p.v4[v] = *(const u32x4*)(P + row * 3072 + 1024 + head * 256 + hf * 128 + c8); }
    p.a0 = *(const u32x4*)(aq + t * 8); p.a1 = *(const u32x4*)(aq + (256 + t) * 8);
    p.elv = EL[(size_t)(dir * 520 + rb) * 512 + head * 128 + (t & 127)];
}
__device__ __forceinline__ void gla_scan(LAS unsigned char* lds, const bf16_t* P  , const bf16_t* QM, const bf16_t* KM, const bf16_t* AQ, const float* EL, bf16_t* OB  ) {
    const int tid = opaque_tid(), dir = __builtin_amdgcn_readfirstlane(tid >> 8);
    for (int unit = blockIdx.x; unit < 16; unit += gridDim.x) {
        const int b = unit >> 3, head = (unit >> 1) & 3, hf = unit & 1;
        f32x16 S[4];
#pragma unroll
        for (int kt = 0; kt < 4; ++kt)
#pragma unroll
            for (int x = 0; x < 16; ++x) S[kt][x] = 0.f;
        GlPre pre;
        { int rb0; bool f0; dn_step_rb(0, dir, b, rb0, f0); gl_prefetch(pre, P, QM, KM, AQ, EL, rb0, dir, head, hf, tid & 255); }
        __syncthreads();
        for (int step = 0; step < 260; ++step) {
            const int w = __builtin_amdgcn_readfirstlane((opaque_tid() >> 6) & 3);
            LAS unsigned char* base = lds + dir * GL_DIR;
            LAS bf16_t* Qm = (LAS bf16_t*)(base + GL_QM); LAS bf16_t* Km = (LAS bf16_t*)(base + GL_KM); LAS bf16_t* Vb = (LAS bf16_t*)(base + GL_VB); LAS bf16_t* Ab = (LAS bf16_t*)(base + GL_AB);
            LAS float* el = (LAS float*)(base + GL_EL);
            int rb; bool first; dn_step_rb(step, dir, b, rb, first);
            const int row_base = rb * 64;
            {
                const int tq_ = opaque_tid(), t = tq_ & 255;
                const int r0 = t >> 4, c8 = 8 * (t & 15);
#pragma unroll
                for (int v = 0; v < 4; ++v) { const int i = r0 + 16 * v, ip = dir ? 63 - i : i;
                    *(LAS u32x4*)(Qm + i * 136 + c8) = pre.q4[v]; *(LAS u32x4*)(Km + i * 136 + c8) = pre.k4[v]; *(LAS u32x4*)(Vb + ip * 136 + c8) = pre.v4[v]; }
                { const int c = t, row = c >> 3, cc = c & 7; *(LAS u32x4*)(Ab + row * 72 + 8 * cc) = pre.a0; }
                { const int c = 256 + t, row = c >> 3, cc = c & 7; *(LAS u32x4*)(Ab + row * 72 + 8 * cc) = pre.a1; }
                if (t < 128) el[t] = __expf(pre.elv);
            }
            BAR_LDS();
            if (step + 1 < 260) { int rbn; bool fn; dn_step_rb(step + 1, dir, b, rbn, fn); gl_prefetch(pre, P, QM, KM, AQ, EL, rbn, dir, head, hf, opaque_tid() & 255); }
            __builtin_amdgcn_sched_barrier(0);
            {
                const int tq_ = opaque_tid(), lane = tq_ & 63, r = lane & 31, h = lane >> 5;
#pragma unroll
                for (int kt = 0; kt < 4; ++kt)
#pragma unroll
                    for (int x = 0; x < 16; ++x) S[kt][x] *= el[32 * kt + crow(x, h)];
                bf16x8 Vf[4];
#pragma unroll
                for (int ks = 0; ks < 4; ++ks) Vf[ks] = frag_tr(Vb, 136, 32 * w, ks, lane);
                u32x4 eo[4];
                {
                    const int rr_ = lane >> 2, c8_ = 8 * (lane & 3);
                    if (!first) {
#pragma unroll
                        for (int v = 0; v < 4; ++v) { const int ip_ = rr_ + 16 * v, i_ = dir ? 63 - ip_ : ip_;
                            eo[v] = *(const u32x4*)(OB + (size_t)(row_base + i_) * 1024 + head * 256 + hf * 128 + 32 * w + c8_); }
                    } else {
                        unsigned z0 = 0u; asm volatile("" : "+v"(z0));
#pragma unroll
                        for (int v = 0; v < 4; ++v) eo[v] = (u32x4){z0, z0, z0, z0};
                    }
                }
                f32x16 O[2];
#pragma unroll
                for (int mt = 0; mt < 2; ++mt) {
#pragma unroll
                    for (int x = 0; x < 16; ++x) O[mt][x] = 0.f;
#pragma unroll
                    for (int ks = 0; ks < 4; ++ks) if (ks < 2 * mt + 2) O[mt] = MFMA32(frag_perm(Ab, 72, 32 * mt + r, ks, h), Vf[ks], O[mt]);
                }
                __builtin_amdgcn_sched_barrier(0);
#pragma unroll
                for (int ks = 0; ks < 8; ++ks) {
                    const bf16x8 sp = pack_step(S[ks >> 1], ks & 1);
#pragma unroll
                    for (int mt = 0; mt < 2; ++mt) O[mt] = MFMA32(frag_perm(Qm, 136, 32 * mt + r, ks, h), sp, O[mt]);
                    if (ks & 1) __builtin_amdgcn_sched_barrier(0);
                }
#pragma unroll
                for (int mt = 0; mt < 2; ++mt)
#pragma unroll
                    for (int x = 0; x < 16; ++x) Vb[(32 * mt + crow(x, h)) * 136 + 32 * w + r] = f2bf(O[mt][x]);
                __builtin_amdgcn_sched_barrier(0);
#pragma unroll
                for (int ks = 0; ks < 4; ++ks) {
#pragma unroll
                    for (int kt = 0; kt < 4; ++kt) S[kt] = MFMA32(frag_tr(Km, 136, 32 * kt, ks, lane), Vf[ks], S[kt]);
                    __builtin_amdgcn_sched_barrier(0);
                }
                {
                    const int rr_ = lane >> 2, c8_ = 8 * (lane & 3);
#pragma unroll
                    for (int v = 0; v < 4; ++v) { const int ip_ = rr_ + 16 * v, i_ = dir ? 63 - ip_ : ip_;
                        u32x4* gp_ = (u32x4*)(OB + (size_t)(row_base + i_) * 1024 + head * 256 + hf * 128 + 32 * w + c8_);
                        u32x4 o = *(const LAS u32x4*)(Vb + ip_ * 136 + 32 * w + c8_); const u32x4 e = eo[v];
                        if (!first) {
                            o.x = cvtpk_s(bf_lo(o.x) + bf_lo(e.x), bf_hi(o.x) + bf_hi(e.x)); o.y = cvtpk_s(bf_lo(o.y) + bf_lo(e.y), bf_hi(o.y) + bf_hi(e.y));
                            o.z = cvtpk_s(bf_lo(o.z) + bf_lo(e.z), bf_hi(o.z) + bf_hi(e.z)); o.w = cvtpk_s(bf_lo(o.w) + bf_lo(e.w), bf_hi(o.w) + bf_hi(e.w)); }
                        gp_[0] = o; }
                }
            }
            if (step == 1 || step == 131) asm volatile("s_waitcnt vmcnt(0)" ::: "memory");
            BAR_LDS();
        }
    }
}
typedef __bf16 v2bf_t __attribute__((ext_vector_type(2)));
__device__ __forceinline__ void atomic_add_bf16x8(bf16_t* p, const u32x4 v) {
    asm volatile("global_atomic_pk_add_bf16 %0, %1, off sc1\n\tglobal_atomic_pk_add_bf16 %0, %2, off offset:4 sc1\n\tglobal_atomic_pk_add_bf16 %0, %3, off offset:8 sc1\n\tglobal_atomic_pk_add_bf16 %0, %4, off offset:12 sc1"
                 :: "v"(p), "v"(v.x), "v"(v.y), "v"(v.z), "v"(v.w) : "memory");
}
constexpr int DN3_HGC = 2 * DN_DIR;
template <int VAR> __device__ __forceinline__ void dn_scan3(LAS unsigned char* lds, const bf16_t* P, const float* AB, const bf16_t* TP, bf16_t* OB) {
    const int tid0 = opaque_tid(), wv = __builtin_amdgcn_readfirstlane(tid0 >> 6), role = wv >> 2, w = wv & 3;
    for (int unit = blockIdx.x; unit < 64; unit += gridDim.x) {
        const int b = unit >> 5, vh = (unit >> 1) & 15, dir = unit & 1, kh = vh >> 1;
        __syncthreads();
        if (role == 1) {
            if (w < 3) {
                const int qh = w >= 1 ? 1 : 0, khh = w == 2 ? 1 : 0, ti = qh, tj = khh;
                u32x4 q8[8], k8[8]; float gcp;
                {
                    int rb; bool f_; dn_step_rb(0, dir, b, rb, f_);
                    const int lane = opaque_tid() & 63, r0 = lane >> 4, c8 = 8 * (lane & 15);
#pragma unroll
                    for (int v = 0; v < 8; ++v) { const int ipq = 32 * qh + r0 + 4 * v, ipk = 32 * khh + r0 + 4 * v, iq = dir ? 63 - ipq : ipq, ik = dir ? 63 - ipk : ipk;
                        q8[v] = *(const u32x4*)(P + (size_t)(rb * 64 + iq) * 4096 + kh * 128 + c8); k8[v] = *(const u32x4*)(P + (size_t)(rb * 64 + ik) * 4096 + 1024 + kh * 128 + c8); }
                    const int tl = dir ? 63 - lane : lane; gcp = AB[(size_t)(rb * 64 + tl) * 64 + dir * 16 + vh];
                }
                for (int j = 0; j < 260; ++j) {
                    const int lane = opaque_tid() & 63, r = lane & 31, h = lane >> 5, r0 = lane >> 4, c8 = 8 * (lane & 15);
                    LAS unsigned char* base = lds + (j & 1) * DN_DIR;
                    LAS bf16_t* Kb = (LAS bf16_t*)(base + DN_KB); LAS bf16_t* Qb = (LAS bf16_t*)(base + DN_QB); LAS bf16_t* Ab = (LAS bf16_t*)(base + DN_AB);
                    LAS float* hgc = (LAS float*)(lds + DN3_HGC + w * 256);
#pragma unroll
                    for (int v = 0; v < 8; ++v) { *(LAS u32x4*)(Qb + (32 * qh + r0 + 4 * v) * 136 + c8) = q8[v]; *(LAS u32x4*)(Kb + (32 * khh + r0 + 4 * v) * 136 + c8) = k8[v]; }
                    hgc[lane] = gcp;
                    asm volatile("s_waitcnt lgkmcnt(0)" ::: "memory");
                    if (j + 1 < 260) {
                        int rb; bool f_; dn_step_rb(j + 1, dir, b, rb, f_);
#pragma unroll
                        for (int v = 0; v < 8; ++v) { const int ipq = 32 * qh + r0 + 4 * v, ipk = 32 * khh + r0 + 4 * v, iq = dir ? 63 - ipq : ipq, ik = dir ? 63 - ipk : ipk;
                            q8[v] = *(const u32x4*)(P + (size_t)(rb * 64 + iq) * 4096 + kh * 128 + c8); k8[v] = *(const u32x4*)(P + (size_t)(rb * 64 + ik) * 4096 + 1024 + kh * 128 + c8); }
                        const int tl = dir ? 63 - lane : lane; gcp = AB[(size_t)(rb * 64 + tl) * 64 + dir * 16 + vh];
                    }
                    __builtin_amdgcn_sched_barrier(0);
                    {
                        f32x16 qk;
#pragma unroll
                        for (int x = 0; x < 16; ++x) qk[x] = 0.f;
#pragma unroll
                        for (int ks = 0; ks < 8; ++ks) qk = MFMA32(frag_nat(Qb, 136, 32 * ti + r, ks, h), frag_nat(Kb, 136, 32 * tj + r, ks, h), qk);
                        const int jj = 32 * tj + r; const float gj = hgc[jj];
#pragma unroll
                        for (int x = 0; x < 16; ++x) { const int i = 32 * ti + crow(x, h);
                            Ab[i * 72 + jj] = f2bf((i >= jj) ? qk[x] * __expf(hgc[i] - gj) : 0.f); }
                    }
                    BAR_LDS();
                }
                BAR_LDS();
            } else {
                u32x4 v16[16], t6[6]; float gcp, betap;
                {
                    int rb; bool f_; dn_step_rb(0, dir, b, rb, f_);
                    const int lane = opaque_tid() & 63, r0 = lane >> 4, c8 = 8 * (lane & 15);
#pragma unroll
                    for (int v = 0; v < 16; ++v) { const int ip = r0 + 4 * v, i = dir ? 63 - ip : ip; v16[v] = *(const u32x4*)(P + (size_t)(rb * 64 + i) * 4096 + 2048 + vh * 128 + c8); }
                    const bf16_t* tp = TP + (size_t)((rb * 16 + vh) * 2 + dir) * 3072;
#pragma unroll
                    for (int v = 0; v < 6; ++v) t6[v] = *(const u32x4*)(tp + (lane + 64 * v) * 8);
                    const int tl = dir ? 63 - lane : lane; const float* ab = AB + (size_t)(rb * 64 + tl) * 64; gcp = ab[dir * 16 + vh]; betap = ab[32 + dir * 16 + vh];
                }
                for (int j = 0; j < 260; ++j) {
                    const int lane = opaque_tid() & 63, r0 = lane >> 4, c8 = 8 * (lane & 15);
                    LAS unsigned char* base = lds + (j & 1) * DN_DIR;
                    LAS bf16_t* Vb = (LAS bf16_t*)(base + DN_VB); LAS bf16_t* Tb = (LAS bf16_t*)(base + DN_TB);
                    LAS float* sc_beta = (LAS float*)(base + DN_SC); LAS float* sc_gc = sc_beta + 64; LAS float* sc_eg = sc_beta + 128; LAS float* sc_tail = sc_beta + 192; LAS float* sc_dl = sc_beta + 256;
                    if (j >= 2) {
                        int rbo; bool fo_; dn_step_rb(j - 2, dir, b, rbo, fo_);
#pragma unroll
                        for (int v = 0; v < 16; ++v) { const int ip_ = r0 + 4 * v, i_ = dir ? 63 - ip_ : ip_;
                            atomic_add_bf16x8(OB + (size_t)(rbo * 64 + i_) * 2048 + vh * 128 + c8, *(const LAS u32x4*)(Vb + ip_ * 128 + c8)); }
                        asm volatile("s_waitcnt lgkmcnt(0)" ::: "memory");
                    }
#pragma unroll
                    for (int v = 0; v < 16; ++v) *(LAS u32x4*)(Vb + (r0 + 4 * v) * 128 + c8) = v16[v];
#pragma unroll
                    for (int v = 0; v < 6; ++v) { const int c = lane + 64 * v, blk = c >> 7, rowc = (c & 127) >> 2, cc = c & 3, br = blk ? 1 : 0, bc = blk == 2 ? 1 : 0;
                        *(LAS u32x4*)(Tb + (32 * br + rowc) * 72 + 32 * bc + 8 * cc) = t6[v]; }
                    { const float gc = gcp, gl = __shfl(gc, 63); sc_beta[lane] = betap; sc_gc[lane] = gc; sc_eg[lane] = __expf(gc); sc_tail[lane] = __expf(gl - gc); if (lane == 0) sc_dl[0] = __expf(gl); }
                    if (j + 1 < 260) {
                        int rb; bool f_; dn_step_rb(j + 1, dir, b, rb, f_);
#pragma unroll
                        for (int v = 0; v < 16; ++v) { const int ip = r0 + 4 * v, i = dir ? 63 - ip : ip; v16[v] = *(const u32x4*)(P + (size_t)(rb * 64 + i) * 4096 + 2048 + vh * 128 + c8); }
                        const bf16_t* tp = TP + (size_t)((rb * 16 + vh) * 2 + dir) * 3072;
#pragma unroll
                        for (int v = 0; v < 6; ++v) t6[v] = *(const u32x4*)(tp + (lane + 64 * v) * 8);
                        const int tl = dir ? 63 - lane : lane; const float* ab = AB + (size_t)(rb * 64 + tl) * 64; gcp = ab[dir * 16 + vh]; betap = ab[32 + dir * 16 + vh];
                    }
                    BAR_LDS();
                }
                {
                    const int lane = opaque_tid() & 63, r0 = lane >> 4, c8 = 8 * (lane & 15);
#pragma unroll 1
                    for (int jj = 258; jj < 260; ++jj) {
                        if (jj == 259) BAR_LDS();
                        LAS bf16_t* Vb = (LAS bf16_t*)(lds + (jj & 1) * DN_DIR + DN_VB);
                        int rbo; bool fo_; dn_step_rb(jj, dir, b, rbo, fo_);
#pragma unroll
                        for (int v = 0; v < 16; ++v) { const int ip_ = r0 + 4 * v, i_ = dir ? 63 - ip_ : ip_;
                            atomic_add_bf16x8(OB + (size_t)(rbo * 64 + i_) * 2048 + vh * 128 + c8, *(const LAS u32x4*)(Vb + ip_ * 128 + c8)); }
                    }
                }
            }
        } else {
            f32x16 S[4];
#pragma unroll
            for (int kt = 0; kt < 4; ++kt)
#pragma unroll
                for (int x = 0; x < 16; ++x) S[kt][x] = 0.f;
            BAR_LDS();
            for (int step = 0; step < 260; ++step) {
                const int lane = opaque_tid() & 63, r = lane & 31, h = lane >> 5;
                LAS unsigned char* base = lds + (step & 1) * DN_DIR;
                LAS bf16_t* Kb = (LAS bf16_t*)(base + DN_KB); LAS bf16_t* Qb = (LAS bf16_t*)(base + DN_QB); LAS bf16_t* Vb = (LAS bf16_t*)(base + DN_VB);
                LAS bf16_t* Tb = (LAS bf16_t*)(base + DN_TB); LAS bf16_t* Ab = (LAS bf16_t*)(base + DN_AB);
                LAS float* sc_beta = (LAS float*)(base + DN_SC); LAS float* sc_eg = sc_beta + 128; LAS float* sc_tail = sc_beta + 192; LAS float* sc_dl = sc_beta + 256;
                int rb; bool f_; dn_step_rb(step, dir, b, rb, f_);
                if (VAR != 2) {
                f32x16 KS[2], QS[2];
#pragma unroll
                for (int mt = 0; mt < 2; ++mt)
#pragma unroll
                    for (int x = 0; x < 16; ++x) { KS[mt][x] = 0.f; QS[mt][x] = 0.f; }
#pragma unroll
                for (int ks = 0; ks < 8; ++ks) {
                    const bf16x8 sp = pack_step(S[ks >> 1], ks & 1);
#pragma unroll
                    for (int mt = 0; mt < 2; ++mt) { KS[mt] = MFMA32(frag_perm(Kb, 136, 32 * mt + r, ks, h), sp, KS[mt]); QS[mt] = MFMA32(frag_perm(Qb, 136, 32 * mt + r, ks, h), sp, QS[mt]); }
                    if (ks & 1) __builtin_amdgcn_sched_barrier(0);
                }
#pragma unroll
                for (int mt = 0; mt < 2; ++mt)
#pragma unroll
                    for (int x = 0; x < 16; ++x) { const int i = 32 * mt + crow(x, h);
                        KS[mt][x] = sc_beta[i] * (bf2f(Vb[i * 128 + 32 * w + r]) - sc_eg[i] * KS[mt][x]); }
                __builtin_amdgcn_sched_barrier(0);
                bf16x8 Xp[4];
#pragma unroll
                for (int ks = 0; ks < 4; ++ks) Xp[ks] = pack_step(KS[ks >> 1], ks & 1);
                f32x16 VN[2];
#pragma unroll
                for (int mt = 0; mt < 2; ++mt) {
#pragma unroll
                    for (int x = 0; x < 16; ++x) VN[mt][x] = 0.f;
#pragma unroll
                    for (int ks = 0; ks < 4; ++ks) if (ks < 2 * mt + 2) VN[mt] = MFMA32(frag_perm(Tb, 72, 32 * mt + r, ks, h), Xp[ks], VN[mt]);
                }
                __builtin_amdgcn_sched_barrier(0);
                bf16x8 VNp[4];
#pragma unroll
                for (int ks = 0; ks < 4; ++ks) VNp[ks] = pack_step(VN[ks >> 1], ks & 1);
#pragma unroll
                for (int mt = 0; mt < 2; ++mt) {
#pragma unroll
                    for (int x = 0; x < 16; ++x) QS[mt][x] *= sc_eg[32 * mt + crow(x, h)];
#pragma unroll
                    for (int ks = 0; ks < 4; ++ks) if (ks < 2 * mt + 2) QS[mt] = MFMA32(frag_perm(Ab, 72, 32 * mt + r, ks, h), VNp[ks], QS[mt]);
                }
                __builtin_amdgcn_sched_barrier(0);
#pragma unroll
                for (int mt = 0; mt < 2; ++mt)
#pragma unroll
                    for (int x = 0; x < 16; ++x) Vb[(32 * mt + crow(x, h)) * 128 + 32 * w + r] = f2bf(QS[mt][x]);
                __builtin_amdgcn_sched_barrier(0);
#pragma unroll
                for (int mt = 0; mt < 2; ++mt)
#pragma unroll
                    for (int x = 0; x < 16; ++x) VN[mt][x] *= sc_tail[32 * mt + crow(x, h)];
#pragma unroll
                for (int ks = 0; ks < 4; ++ks) VNp[ks] = pack_step(VN[ks >> 1], ks & 1);
                __builtin_amdgcn_sched_barrier(0);
                const float dl = sc_dl[0];
#pragma unroll
                for (int kt = 0; kt < 4; ++kt)
#pragma unroll
                    for (int x = 0; x < 16; ++x) S[kt][x] *= dl;
#pragma unroll
                for (int ks = 0; ks < 4; ++ks) {
#pragma unroll
                    for (int kt = 0; kt < 4; ++kt) S[kt] = MFMA32(frag_tr(Kb, 136, 32 * kt, ks, lane), VNp[ks], S[kt]);
                    __builtin_amdgcn_sched_barrier(0);
                }
                }
                BAR_LDS();
            }
        }
    }
}
__device__ __forceinline__ void gla_scan3(LAS unsigned char* lds, bf16_t* P  , const bf16_t* QM, const bf16_t* KM, const bf16_t* AQ, const float* EL, bf16_t* OB  ) {
    const int tid0 = opaque_tid(), wv = __builtin_amdgcn_readfirstlane(tid0 >> 6), role = wv >> 2, w = wv & 3;
    for (int unit = blockIdx.x; unit < 32; unit += gridDim.x) {
        const int b = unit >> 4, head = (unit >> 2) & 3, hf = (unit >> 1) & 1, dir = unit & 1;
        __syncthreads();
        if (role == 1) {
            GlPre pre;
            { int rb0; bool f0; dn_step_rb(0, dir, b, rb0, f0); gl_prefetch(pre, P, QM, KM, AQ, EL, rb0, dir, head, hf, opaque_tid() & 255); }
            for (int j = 0; j < 260; ++j) {
                const int t = opaque_tid() & 255;
                LAS unsigned char* base = lds + (j & 1) * GL_DIR;
                LAS bf16_t* Qm = (LAS bf16_t*)(base + GL_QM); LAS bf16_t* Km = (LAS bf16_t*)(base + GL_KM); LAS bf16_t* Vb = (LAS bf16_t*)(base + GL_VB); LAS bf16_t* Ab = (LAS bf16_t*)(base + GL_AB);
                LAS float* el = (LAS float*)(base + GL_EL);
                const int r0 = t >> 4, c8 = 8 * (t & 15);
#pragma unroll
                for (int v = 0; v < 4; ++v) { const int i = r0 + 16 * v, ip = dir ? 63 - i : i;
                    *(LAS u32x4*)(Qm + i * 136 + c8) = pre.q4[v]; *(LAS u32x4*)(Km + i * 136 + c8) = pre.k4[v]; *(LAS u32x4*)(Vb + ip * 136 + c8) = pre.v4[v]; }
                { const int c = t, row = c >> 3, cc = c & 7; *(LAS u32x4*)(Ab + row * 72 + 8 * cc) = pre.a0; }
                { const int c = 256 + t, row = c >> 3, cc = c & 7; *(LAS u32x4*)(Ab + row * 72 + 8 * cc) = pre.a1; }
                if (t < 128) el[t] = __expf(pre.elv);
                if (j + 1 < 260) { int rbn; bool fn; dn_step_rb(j + 1, dir, b, rbn, fn); gl_prefetch(pre, P, QM, KM, AQ, EL, rbn, dir, head, hf, t); }
                BAR_LDS();
            }
            BAR_LDS();
        } else {
            f32x16 S[4];
#pragma unroll
            for (int kt = 0; kt < 4; ++kt)
#pragma unroll
                for (int x = 0; x < 16; ++x) S[kt][x] = 0.f;
            BAR_LDS();
            for (int step = 0; step < 260; ++step) {
                const int lane = opaque_tid() & 63, r = lane & 31, h = lane >> 5;
                LAS unsigned char* base = lds + (step & 1) * GL_DIR;
                LAS bf16_t* Qm = (LAS bf16_t*)(base + GL_QM); LAS bf16_t* Km = (LAS bf16_t*)(base + GL_KM); LAS bf16_t* Vb = (LAS bf16_t*)(base + GL_VB); LAS bf16_t* Ab = (LAS bf16_t*)(base + GL_AB);
                LAS float* el = (LAS float*)(base + GL_EL);
                int rb; bool f_; dn_step_rb(step, dir, b, rb, f_);
#pragma unroll
                for (int kt = 0; kt < 4; ++kt)
#pragma unroll
                    for (int x = 0; x < 16; ++x) S[kt][x] *= el[32 * kt + crow(x, h)];
                bf16x8 Vf[4];
#pragma unroll
                for (int ks = 0; ks < 4; ++ks) Vf[ks] = frag_tr(Vb, 136, 32 * w, ks, lane);
                f32x16 O[2];
#pragma unroll
                for (int mt = 0; mt < 2; ++mt) {
#pragma unroll
                    for (int x = 0; x < 16; ++x) O[mt][x] = 0.f;
#pragma unroll
                    for (int ks = 0; ks < 4; ++ks) if (ks < 2 * mt + 2) O[mt] = MFMA32(frag_perm(Ab, 72, 32 * mt + r, ks, h), Vf[ks], O[mt]);
                }
                __builtin_amdgcn_sched_barrier(0);
#pragma unroll
                for (int ks = 0; ks < 8; ++ks) {
                    const bf16x8 sp = pack_step(S[ks >> 1], ks & 1);
#pragma unroll
                    for (int mt = 0; mt < 2; ++mt) O[mt] = MFMA32(frag_perm(Qm, 136, 32 * mt + r, ks, h), sp, O[mt]);
                    if (ks & 1) __builtin_amdgcn_sched_barrier(0);
                }
#pragma unroll
                for (int mt = 0; mt < 2; ++mt)
#pragma unroll
                    for (int x = 0; x < 16; ++x) Vb[(32 * mt + crow(x, h)) * 136 + 32 * w + r] = f2bf(O[mt][x]);
                __builtin_amdgcn_sched_barrier(0);
#pragma unroll
                for (int ks = 0; ks < 4; ++ks) {
#pragma unroll
                    for (int kt = 0; kt < 4; ++kt) S[kt] = MFMA32(frag_tr(Km, 136, 32 * kt, ks, lane), Vf[ks], S[kt]);
                    __builtin_amdgcn_sched_barrier(0);
                }
                asm volatile("s_waitcnt lgkmcnt(0)" ::: "memory");
                {
                    const int rr_ = lane >> 2, c8_ = 8 * (lane & 3);
#pragma unroll
                    for (int v = 0; v < 4; ++v) { const int ip_ = rr_ + 16 * v, i_ = dir ? 63 - ip_ : ip_; const int oc_ = head * 256 + hf * 128 + 32 * w + c8_;
                        bf16_t* dst_ = dir ? P + (size_t)(rb * 64 + i_) * 3072 + oc_ : OB + (size_t)(rb * 64 + i_) * 1024 + oc_;
                        *(u32x4*)dst_ = *(const LAS u32x4*)(Vb + ip_ * 136 + 32 * w + c8_); }
                }
                BAR_LDS();
            }
        }
    }
}
#define XB_TMO      128
#define XB_XCNT(j)  (256  + 64 * (j))
#define XB_XSUB(j)  (1280 + 64 * (j))
#define XB_XGEN(j)  (2304 + 64 * (j))
#define XB_TOP      3328
#define XB_TOPGEN   3392
#define XCD_BAR_WORDS 3456
#define XB_SPIN_CAP (1u << 18)

__device__ __forceinline__ unsigned xb_ld(unsigned* p)              { return __hip_atomic_load(p, __ATOMIC_RELAXED, __HIP_MEMORY_SCOPE_AGENT); }
__device__ __forceinline__ unsigned xb_add(unsigned* p, unsigned v) { return __hip_atomic_fetch_add(p, v, __ATOMIC_RELAXED, __HIP_MEMORY_SCOPE_AGENT); }
__device__ __forceinline__ unsigned xb_xcc_id() { return (unsigned)__builtin_amdgcn_s_getreg((3 << 11) | 20) & 0xFu; }
#define XB_SPIN(cond, bar) do { unsigned _sp = 0; while (cond) { __builtin_amdgcn_s_sleep(1); \
    if ((++_sp & 255u) == 0u) { if (xb_ld(&(bar)[XB_TMO])) break; if (_sp > XB_SPIN_CAP) { atomicAdd(&(bar)[XB_TMO], 1u); break; } } } } while (0)

struct XcdBarrier {
    unsigned* bar; unsigned x;
    volatile LAS unsigned* st;
};

__device__ __forceinline__ XcdBarrier xcd_barrier_post(unsigned* bar, volatile LAS unsigned* st) {
    XcdBarrier b; b.bar = bar; b.x = xb_xcc_id(); b.st = st;
    if (threadIdx.x == 0) (void)xb_add(&bar[XB_XCNT(b.x)], 1u);
    return b;
}
__device__ __forceinline__ void xcd_barrier_complete(unsigned* bar, unsigned x, unsigned& nloc, unsigned& nx) {
    const unsigned G = gridDim.x * gridDim.y * gridDim.z;
    unsigned sum, cnt, mine, sp = 0u;
    for (;;) {
        sum = 0u; cnt = 0u; mine = 0u;
#pragma unroll
        for (unsigned j = 0; j < 16; ++j) { const unsigned c = xb_ld(&bar[XB_XCNT(j)]); sum += c; cnt += (c > 0u) ? 1u : 0u; mine = (j == x) ? c : mine; }
        if (sum == G) break;
        __builtin_amdgcn_s_sleep(1);
        if ((++sp & 255u) == 0u) { if (xb_ld(&bar[XB_TMO])) break; if (sp > XB_SPIN_CAP) { atomicAdd(&bar[XB_TMO], 1u); break; } }
    }
    nloc = mine > 0u ? mine : 1u; nx = cnt > 0u ? cnt : 1u;
}

__device__ __forceinline__ void xcd_barrier(const XcdBarrier& b) {
    asm volatile("s_waitcnt vmcnt(0)" ::: "memory");
    __syncthreads();
    if (threadIdx.x == 0) {
        unsigned* bar = b.bar;
        __builtin_amdgcn_s_waitcnt(0);
        unsigned nloc = b.st[0], nx = b.st[1];
        if (nloc == 0u) { xcd_barrier_complete(bar, b.x, nloc, nx); b.st[0] = nloc; b.st[1] = nx; }
        const unsigned old = xb_add(&bar[XB_XSUB(b.x)], 1u);
        const unsigned gen = old / nloc;
        if (old + 1u == (gen + 1u) * nloc) {
            __builtin_amdgcn_fence(__ATOMIC_RELEASE, "agent");
            asm volatile("s_waitcnt vmcnt(0)" ::: "memory");
            const unsigned og = xb_add(&bar[XB_TOP], 1u);
            const unsigned tg = og / nx;
            if (og + 1u == (tg + 1u) * nx) xb_add(&bar[XB_TOPGEN], 1u);
            else XB_SPIN(xb_ld(&bar[XB_TOPGEN]) == tg, bar);
            __builtin_amdgcn_fence(__ATOMIC_ACQUIRE, "agent");
            xb_add(&bar[XB_XGEN(b.x)], 1u);
            asm volatile("s_waitcnt vmcnt(0)" ::: "memory");
        } else {
            XB_SPIN(xb_ld(&bar[XB_XGEN(b.x)]) == gen, bar);
            __builtin_amdgcn_fence(__ATOMIC_ACQUIRE, "agent");
            asm volatile("s_waitcnt vmcnt(0)" ::: "memory");
        }
    }
    __syncthreads();
}

#define DUP_DN 0
#define DN_VARIANT 0
#define DN_VAR_PARITY0 0
#define DUP_GLA 0
#define DUP_ATT 0
#define DUP_GIN 0
#define DUP_FFN1 0
constexpr unsigned long long pack_ops(const int* ops, int n) { unsigned long long v = 0; for (int i = 0; i < n; ++i) v |= (unsigned long long)ops[i] << (5 * i); return v; }
struct OpList { unsigned long long code; int n; };
constexpr OpList make_list(int mix) {
    int ops[16] = {}; int n = 0;
    ops[n++] = OP_PREP; ops[n++] = OP_GEMM_IN; if (DUP_GIN && mix != 0) ops[n++] = OP_GEMM_IN;
    if (mix == 0) { ops[n++] = OP_DNHALO; ops[n++] = OP_DNCONV; ops[n++] = OP_DNT; ops[n++] = OP_DNSCAN; if (DUP_DN) ops[n++] = OP_DNSCAN; ops[n++] = OP_DNREDO; ops[n++] = OP_GEMM_Z; }
    else if (mix == 1) { ops[n++] = OP_GLAPREP; ops[n++] = OP_GLASCAN; ops[n++] = OP_GLAGATE; }
    else { ops[n++] = OP_QKROPE; ops[n++] = OP_ATTN; if (DUP_ATT) ops[n++] = OP_ATTN; }
    ops[n++] = OP_GEMM_OUT; ops[n++] = OP_NORM2; ops[n++] = OP_FFN1; if (DUP_FFN1 && mix != 0) ops[n++] = OP_FFN1; ops[n++] = OP_FFN2;
    return OpList{pack_ops(ops, n), n};
}
constexpr OpList L_DN = make_list(0), L_GL = make_list(1), L_AT = make_list(2);
constexpr int NPHASE = 1 + 2 * L_DN.n + L_GL.n + L_AT.n;
__device__ __forceinline__ void decode_phase(int ph, int& layer, int& op) {
    if (ph == 0) { layer = 0; op = OP_MOD; return; }
    int p = ph - 1;
    if (p < L_DN.n) { layer = 0; op = (int)((L_DN.code >> (5 * p)) & 31ull); return; } p -= L_DN.n;
    if (p < L_GL.n) { layer = 1; op = (int)((L_GL.code >> (5 * p)) & 31ull); return; } p -= L_GL.n;
    if (p < L_AT.n) { layer = 2; op = (int)((L_AT.code >> (5 * p)) & 31ull); return; } p -= L_AT.n;
    layer = 3; op = (int)((L_DN.code >> (5 * p)) & 31ull);
}

__global__ void __launch_bounds__(512, 2) mega(Args args) {
    extern __shared__ __attribute__((aligned(16))) unsigned char lds_raw[];
    LAS unsigned char* lds = (LAS unsigned char*)lds_raw;
    cg::grid_group grid = cg::this_grid();
    volatile LAS unsigned* xb_st = (volatile LAS unsigned*)(lds + LDS_BYTES - 64);
    if (threadIdx.x < 2) xb_st[threadIdx.x] = 0u;
    __syncthreads();
    const XcdBarrier xbar = xcd_barrier_post((unsigned*)(args.ws + WS_BAR), xb_st);
    const int G = gridDim.x, NGW = G * 8;
    unsigned char* ws = args.ws;
    const float* x_in = args.in[0]; const float* c_in = args.in[1]; const float* ctx_in = args.in[2]; const float* cctx_in = args.in[3];
    const float* ada_w = args.in[4]; const float* ada_b = args.in[5]; const float* norm_mix_g = args.in[6]; const float* norm_ffn_g = args.in[7];
    const float* ffn_w1 = args.in[8]; const float* ffn_w2 = args.in[9];
    float* MOD = (float*)(ws + WS_MOD); float* CTXC = (float*)(ws + WS_CTX); bf16_t* H = (bf16_t*)(ws + WS_H); float* ABF = (float*)(ws + WS_AB); float* RSTD = (float*)(ws + WS_RSTD);
    bf16_t* PB = (bf16_t*)(ws + WS_P); float* out = args.out;

    for (int ph = args.ph_lo; ph < args.ph_hi; ++ph) {
        int layer, op; decode_phase(ph, layer, op);
        const int mix = layer % 3, slot = layer / 3;
        const float* modl = MOD + (size_t)layer * 3 * 6144;
        const float* xl = layer == 0 ? x_in : out; const float* xc = layer == 0 ? ctx_in : CTXC;
        if (op == OP_MOD) {
            const int tid = opaque_tid(), lane = tid & 63, wave = __builtin_amdgcn_readfirstlane(tid >> 6); const int gw = blockIdx.x * 8 + wave; (void)lane; (void)gw; (void)tid;
            LAS float* sl = (LAS float*)lds; LAS float* red = sl + 3 * 1024;
            for (int e = tid; e < 3 * 1024; e += 512) { const float v = e < 2048 ? c_in[e] : cctx_in[e - 2048]; sl[e] = silu_f(v); }
            __syncthreads();
            for (int item = blockIdx.x; item < 4 * 96; item += G) {
                const int ly = item / 96, col = (item % 96) * 64 + lane;
                const float* wp = ada_w + ((size_t)ly * 1024 + 128 * wave) * 6144 + col;
                float a0 = 0.f, a1 = 0.f, a2 = 0.f;
#pragma unroll 8
                for (int k = 0; k < 128; ++k) { const float wv = wp[(size_t)k * 6144]; const int kk = 128 * wave + k; a0 += sl[kk] * wv; a1 += sl[1024 + kk] * wv; a2 += sl[2048 + kk] * wv; }
                red[(wave * 3 + 0) * 64 + lane] = a0; red[(wave * 3 + 1) * 64 + lane] = a1; red[(wave * 3 + 2) * 64 + lane] = a2;
                __syncthreads();
                if (tid < 192) { const int m = tid >> 6; float s = ada_b[(size_t)ly * 6144 + col];
#pragma unroll
                    for (int w2 = 0; w2 < 8; ++w2) s += red[(w2 * 3 + m) * 64 + lane];
                    MOD[((size_t)ly * 3 + m) * 6144 + col] = s; }
                __syncthreads();
            }
        } else if (op == OP_PREP) {
            const int tid = opaque_tid(), lane = tid & 63, wave = __builtin_amdgcn_readfirstlane(tid >> 6); const int gw = blockIdx.x * 8 + wave; (void)lane; (void)gw; (void)tid;
            LAS float* scr = (LAS float*)(lds + wave * 16384);
            unsigned z0 = 0u; asm volatile("" : "+v"(z0)); const u32x4 zv = (u32x4){z0, z0, z0, z0};
            bf16_t* wtA = (bf16_t*)(ws + WT_A); bf16_t* wtZ = (bf16_t*)(ws + WT_Z); bf16_t* wtO = (bf16_t*)(ws + WT_O); bf16_t* wt1 = (bf16_t*)(ws + WT_1); bf16_t* wt2 = (bf16_t*)(ws + WT_2);
            if (mix == 0) {
                const float* w_in = args.in[10] + (size_t)slot * 1024 * 6208; const float* w_out = args.in[15] + (size_t)slot * 2048 * 1024;
                transpose_mat(w_in, 6208, 0, 4096, 1024, wtA, 0, scr, gw, NGW, lane);
                transpose_mat(w_in, 6208, 6144, 64, 1024, wtA, 4096, scr, gw, NGW, lane);
                for (size_t e = (size_t)blockIdx.x * 512 + tid; e < (size_t)192 * 1024 * 2 / 16; e += (size_t)G * 512) ((u32x4*)(wtA + (size_t)4160 * 1024))[e] = zv;
            } else if (mix == 1) {
                const float* w_in = args.in[16]; const float* w_out = args.in[20];
                transpose_mat(w_in, 3104, 0, 3104, 1024, wtA, 0, scr, gw, NGW, lane);
                for (size_t e = (size_t)blockIdx.x * 512 + tid; e < (size_t)224 * 1024 * 2 / 16; e += (size_t)G * 512) ((u32x4*)(wtA + (size_t)3104 * 1024))[e] = zv;
                transpose_mat(w_out, 1024, 0, 1024, 1024, wtO, 0, scr, gw, NGW, lane);
            } else {
                const float* w_in = args.in[21]; const float* w_out = args.in[24];
                transpose_mat(w_in, 1536, 0, 1536, 1024, wtA, 0, scr, gw, NGW, lane);
                transpose_mat(w_out, 1024, 0, 1024, 1024, wtO, 0, scr, gw, NGW, lane);
            }
            if (mix != 0) {
                transpose_mat(ffn_w1 + (size_t)layer * 1024 * 4096, 4096, 0, 4096, 1024, wt1, 0, scr, gw, NGW, lane);
                transpose_mat(ffn_w2 + (size_t)layer * 4096 * 1024, 1024, 0, 1024, 4096, wt2, 0, scr, gw, NGW, lane);
            }
            normmod_rows(xl, xc, norm_mix_g + (size_t)layer * 1024, modl, 0, H, gw, NGW, lane);
        } else if (op == OP_DNREDO) {
            const int tid = opaque_tid(), lane = tid & 63, wave = __builtin_amdgcn_readfirstlane(tid >> 6); const int gw = blockIdx.x * 8 + wave; (void)lane; (void)gw; (void)tid;
            LAS float* scr = (LAS float*)(lds + wave * 16384);
            const float* w_in = args.in[10] + (size_t)slot * 1024 * 6208; const float* w_out = args.in[15] + (size_t)slot * 2048 * 1024;
            transpose_mat(w_in, 6208, 4096, 2048, 1024, (bf16_t*)(ws + WT_Z), 0, scr, gw, NGW, lane);
            transpose_mat(w_out, 1024, 0, 1024, 2048, (bf16_t*)(ws + WT_O), 0, scr, gw, NGW, lane);
            transpose_mat(ffn_w1 + (size_t)layer * 1024 * 4096, 4096, 0, 4096, 1024, (bf16_t*)(ws + WT_1), 0, scr, gw, NGW, lane);
            transpose_mat(ffn_w2 + (size_t)layer * 4096 * 1024, 1024, 0, 1024, 4096, (bf16_t*)(ws + WT_2), 0, scr, gw, NGW, lane);
            normmod_rows(xl, xc, norm_mix_g + (size_t)layer * 1024, modl, 0, H, gw, NGW, lane);
            const bf16_t* OB = (const bf16_t*)(ws + WS_O);
            for (int row = gw; row < MROWS; row += NGW) {
                const u32x4* p = (const u32x4*)(OB + (size_t)row * 2048 + 32 * lane); float ss = 0.f;
#pragma unroll
                for (int v = 0; v < 4; ++v) { const u32x4 q = p[v]; const float a0 = bf_lo(q.x), a1 = bf_hi(q.x), a2 = bf_lo(q.y), a3 = bf_hi(q.y), a4 = bf_lo(q.z), a5 = bf_hi(q.z), a6 = bf_lo(q.w), a7 = bf_hi(q.w);
                    ss += (a0 * a0 + a1 * a1) + (a2 * a2 + a3 * a3) + (a4 * a4 + a5 * a5) + (a6 * a6 + a7 * a7); }
                ss += __shfl_xor(ss, 1); ss += __shfl_xor(ss, 2);
                if ((lane & 3) == 0) RSTD[(size_t)row * 16 + (lane >> 2)] = rsqrtf(ss * (1.f / 128.f) + EPS);
            }
        } else if (op == OP_DNHALO) {
            dn_halo_phase(PB, (bf16_t*)(ws + WS_HALO), G);
        } else if (op == OP_DNCONV) {
            dn_conv_phase(PB, (const bf16_t*)(ws + WS_HALO), args.in[11] + (size_t)slot * 4096 * 5, G);
        } else if (op == OP_DNT) {
            dn_t_phase(lds, PB, ABF, (bf16_t*)(ws + WS_TP), args.in[12] + (size_t)slot * 32, args.in[13] + (size_t)slot * 32, G);
            {
                unsigned z0 = 0u; asm volatile("" : "+v"(z0)); const u32x4 zv = (u32x4){z0, z0, z0, z0}; u32x4* zp = (u32x4*)(ws + WS_O);
                for (size_t e = (size_t)blockIdx.x * 512 + opaque_tid(); e < (size_t)MROWS * 2048 * 2 / 16; e += (size_t)G * 512) zp[e] = zv;
            }
        } else if (op == OP_NORM2) {
            const int tid = opaque_tid(), lane = tid & 63, wave = __builtin_amdgcn_readfirstlane(tid >> 6); const int gw = blockIdx.x * 8 + wave; (void)lane; (void)gw; (void)tid;
            normmod_rows(out, CTXC, norm_ffn_g + (size_t)layer * 1024, modl, 3, H, gw, NGW, lane);
        } else if (op == OP_GEMM_IN || op == OP_GEMM_Z || op == OP_GEMM_OUT || op == OP_FFN1 || op == OP_FFN2) {
            pg8::Gemm g; pg8::Epi E;
            E.mode = 0; E.O = PB; E.ldc = 4096; E.tail_pn = -1; E.F = ABF; E.ldf = 64; E.nf = 64; E.rstd = RSTD; E.ng = args.in[14] + (size_t)slot * 128;
            E.src_lat = xl; E.src_ctx = xc; E.dst_lat = out; E.dst_ctx = CTXC; E.mod = modl; E.gidx = 2;
            g.M = (layer == 3 && op != OP_GEMM_IN) ? NLAT : MROWS; g.A = H; g.K = 1024;
            bf16_t* OBUF = (bf16_t*)(ws + (mix == 1 ? WS_OGLA : WS_O));
            if (op == OP_GEMM_IN) {
                g.Bt = (const bf16_t*)(ws + WT_A);
                if (mix == 0) { g.N = 4352; E.ldc = 4096; E.tail_pn = 16; E.ldf = 64; E.nf = 64; }
                else if (mix == 1) { g.N = 3328; E.ldc = 3072; E.tail_pn = 12; E.ldf = 32; E.nf = 32; }
                else { g.N = 1536; E.ldc = 1536; }
            } else if (op == OP_GEMM_Z) {
                g.Bt = (const bf16_t*)(ws + WT_Z); g.N = 2048; E.mode = 2; E.O = OBUF; E.ldc = 2048;
            } else if (op == OP_GEMM_OUT) {
                g.A = OBUF; g.K = mix == 0 ? 2048 : 1024; g.Bt = (const bf16_t*)(ws + WT_O); g.N = 1024; E.mode = 3; E.gidx = 2;
            } else if (op == OP_FFN1) {
                g.Bt = (const bf16_t*)(ws + WT_1); g.N = 4096; E.mode = 1; E.ldc = 4096;
            } else {
                g.A = PB; g.K = 4096; g.Bt = (const bf16_t*)(ws + WT_2); g.N = 1024; E.mode = 3; E.gidx = 5; E.src_lat = out; E.src_ctx = CTXC;
            }
            pg8::StaticOrder S; S.init(g.M, g.N, G, (int)blockIdx.x);
#ifndef NO_GEMM
            pg8::gemm_phase<pg8::Epi, pg8::StaticOrder, true, true>(lds, g, S, E);
#endif
        } else if (op == OP_DNSCAN) {
#ifndef NO_DN
            if (DN_VARIANT && (ph & 1) == 0) dn_scan3<DN_VARIANT>(lds, PB, ABF, (const bf16_t*)(ws + WS_TP), (bf16_t*)(ws + WS_O)); else dn_scan3<0>(lds, PB, ABF, (const bf16_t*)(ws + WS_TP), (bf16_t*)(ws + WS_O));
#endif
        } else if (op == OP_GLAPREP) {
            gla_prep_phase(lds, PB, ABF, args.in[17], args.in[18], (bf16_t*)(ws + WS_QM), (bf16_t*)(ws + WS_KM), (bf16_t*)(ws + WS_AQ), (float*)(ws + WS_EL), G);
        } else if (op == OP_GLASCAN) {
#ifndef NO_GLA
            gla_scan3(lds, PB, (const bf16_t*)(ws + WS_QM), (const bf16_t*)(ws + WS_KM), (const bf16_t*)(ws + WS_AQ), (const float*)(ws + WS_EL), (bf16_t*)(ws + WS_OGLA));
#endif
        } else if (op == OP_GLAGATE) {
            const int tid = opaque_tid(), lane = tid & 63, wave = __builtin_amdgcn_readfirstlane(tid >> 6); const int gw = blockIdx.x * 8 + wave; (void)lane; (void)gw; (void)tid;
            bf16_t* OB = (bf16_t*)(ws + WS_OGLA); const float* ng = args.in[19];
            for (int row = gw; row < MROWS; row += NGW) {
                u32x4* p = (u32x4*)(OB + (size_t)row * 1024 + 16 * lane); const u32x4* gp = (const u32x4*)(PB + (size_t)row * 3072 + 2048 + 16 * lane); const u32x4* pb2 = (const u32x4*)(PB + (size_t)row * 3072 + 16 * lane);
                float o[16], z[16]; float ss = 0.f;
#pragma unroll
                for (int v = 0; v < 2; ++v) { const u32x4 q = p[v], gq = gp[v], q2 = pb2[v];
                    o[8 * v + 0] = bf_lo(q.x) + bf_lo(q2.x); o[8 * v + 1] = bf_hi(q.x) + bf_hi(q2.x); o[8 * v + 2] = bf_lo(q.y) + bf_lo(q2.y); o[8 * v + 3] = bf_hi(q.y) + bf_hi(q2.y); o[8 * v + 4] = bf_lo(q.z) + bf_lo(q2.z); o[8 * v + 5] = bf_hi(q.z) + bf_hi(q2.z); o[8 * v + 6] = bf_lo(q.w) + bf_lo(q2.w); o[8 * v + 7] = bf_hi(q.w) + bf_hi(q2.w);
                    z[8 * v + 0] = bf_lo(gq.x); z[8 * v + 1] = bf_hi(gq.x); z[8 * v + 2] = bf_lo(gq.y); z[8 * v + 3] = bf_hi(gq.y); z[8 * v + 4] = bf_lo(gq.z); z[8 * v + 5] = bf_hi(gq.z); z[8 * v + 6] = bf_lo(gq.w); z[8 * v + 7] = bf_hi(gq.w); }
#pragma unroll
                for (int e = 0; e < 16; ++e) ss += o[e] * o[e];
                ss += __shfl_xor(ss, 1); ss += __shfl_xor(ss, 2); ss += __shfl_xor(ss, 4); ss += __shfl_xor(ss, 8);
                const float rs = rsqrtf(ss * (1.f / 256.f) + EPS); const int cb = (16 * lane) & 255;
#pragma unroll
                for (int v = 0; v < 2; ++v) { float rr[8];
#pragma unroll
                    for (int e = 0; e < 8; ++e) rr[e] = o[8 * v + e] * rs * ng[cb + 8 * v + e] * silu_f(z[8 * v + e]);
                    u32x4 wv; wv.x = cvtpk_s(rr[0], rr[1]); wv.y = cvtpk_s(rr[2], rr[3]); wv.z = cvtpk_s(rr[4], rr[5]); wv.w = cvtpk_s(rr[6], rr[7]); p[v] = wv; }
            }
        } else if (op == OP_QKROPE) {
            const int tid = opaque_tid(), lane = tid & 63, wave = __builtin_amdgcn_readfirstlane(tid >> 6); const int gw = blockIdx.x * 8 + wave; (void)lane; (void)gw; (void)tid;
            bf16_t* QR = (bf16_t*)(ws + WS_QR); bf16_t* KR = (bf16_t*)(ws + WS_KR); bf16_t* VR = (bf16_t*)(ws + WS_VR);
            const float* qg = args.in[22]; const float* kg = args.in[23];
            const int hf = lane >> 5, j = lane & 31, e1 = 64 * hf + j, e2 = e1 + 32;
            const float inv_freq = exp2f(-(float)(2 * j) * (1.f / 64.f) * 13.287712379549449f);
            const float gq1 = qg[e1], gq2 = qg[e2], gk1 = kg[e1], gk2 = kg[e2];
            for (int row = gw; row < MROWS; row += NGW) {
                const bool lat = row < NLAT; const int b = lat ? row / SEQ : (row - NLAT) / CTXL; const int tpos = lat ? row % SEQ : (row - NLAT) % CTXL;
                float cs = 1.f, sn = 0.f;
                if (lat) { const float pos = (float)(hf == 0 ? tpos / 64 : tpos % 64); const float ang = pos * inv_freq; sn = sinf(ang); cs = cosf(ang); }
                const bf16_t* pr = PB + (size_t)row * 1536; const int kpos = lat ? tpos : SEQ + tpos;
#pragma unroll
                for (int hd = 0; hd < 10; ++hd) {
                    const float x1 = bf2f(pr[hd * 128 + e1]), x2 = bf2f(pr[hd * 128 + e2]);
                    const float rinv = rsqrtf(wave_sum(x1 * x1 + x2 * x2) * (1.f / 128.f) + EPS);
                    const float y1 = x1 * rinv * (hd < 8 ? gq1 : gk1), y2 = x2 * rinv * (hd < 8 ? gq2 : gk2);
                    const float o1 = y1 * cs - y2 * sn, o2 = y1 * sn + y2 * cs;
                    bf16_t* dst = hd < 8 ? QR + (size_t)row * 1024 + hd * 128 : KR + ((size_t)(b * 2 + (hd - 8)) * SKV + kpos) * 128;
                    dst[e1] = f2bf(o1); dst[e2] = f2bf(o2);
                }
#pragma unroll
                for (int kv = 0; kv < 2; ++kv) { bf16_t* dst = VR + ((size_t)(b * 2 + kv) * SKV + kpos) * 128; dst[e1] = pr[1280 + kv * 128 + e1]; dst[e2] = pr[1280 + kv * 128 + e2]; }
            }
        } else if (op == OP_ATTN) {
            const attn::bf16* QR = (const attn::bf16*)(ws + WS_QR); const attn::bf16* KR = (const attn::bf16*)(ws + WS_KR); const attn::bf16* VR = (const attn::bf16*)(ws + WS_VR);
            attn::bf16* OB = (attn::bf16*)(ws + WS_O);
            for (int u = blockIdx.x; u < 1024 + 16; u += G) {
                size_t qoff, koff; int seq;
                if (u < 1024) { const int pair = u >> 8, b = pair >> 1, kvh = pair & 1, hh = (u >> 6) & 3, qb = u & 63, head = kvh * 4 + hh;
                    qoff = ((size_t)b * SEQ + (size_t)qb * 256) * 1024 + head * 128; koff = (size_t)(b * 2 + kvh) * SKV * 128; seq = SKV; }
                else { const int jx = u - 1024, b = jx >> 3, head = jx & 7, kvh = head >> 2;
                    qoff = ((size_t)NLAT + (size_t)b * CTXL) * 1024 + head * 128; koff = ((size_t)(b * 2 + kvh) * SKV + SEQ) * 128; seq = CTXL; }
                __syncthreads();
#ifndef NO_ATT
                attn::attn_dense_body<attn::bf16>(QR + qoff, KR + koff, VR + koff, OB + qoff, seq, (char*)lds_raw);
#endif
            }
        }
        if (ph + 1 < args.ph_hi) { if (ph == 0) grid.sync(); else xcd_barrier(xbar); }
    }
}

#ifndef MK_MULTI
#define MK_MULTI 0
#endif
extern "C" void kernel_launch(void* const* d_in, const int* in_sizes, int n_in, void* d_out, int out_size, void* d_ws, size_t ws_size, hipStream_t stream) {
    static int grid = 0;
    if (grid == 0) {
        if (n_in != 25 || ws_size < WS_END) { fprintf(stderr, "kernel_launch: unexpected n_in %d / ws_size %zu (need %zu)\n", n_in, ws_size, (size_t)WS_END); grid = -1; return; }
        int dev = 0, cus = 0, per_cu = 0;
        hipGetDevice(&dev); hipDeviceGetAttribute(&cus, hipDeviceAttributeMultiprocessorCount, dev);
        if (hipFuncSetAttribute((const void*)mega, hipFuncAttributeMaxDynamicSharedMemorySize, LDS_BYTES) != hipSuccess) { fprintf(stderr, "kernel_launch: hipFuncSetAttribute failed\n"); grid = -1; return; }
        if (hipOccupancyMaxActiveBlocksPerMultiprocessor(&per_cu, (const void*)mega, 512, LDS_BYTES) != hipSuccess || per_cu < 1) { fprintf(stderr, "kernel_launch: occupancy query says %d\n", per_cu); per_cu = 1; }
        (void)hipGetLastError();
        grid = cus * 1;
    }
    if (grid < 0) return;
    if (hipMemsetAsync((char*)d_ws + WS_BAR, 0, WS_BAR_BYTES, stream) != hipSuccess) { fprintf(stderr, "kernel_launch: memset of barrier words failed\n"); return; }
    Args a{};
    for (int i = 0; i < 25; ++i) a.in[i] = (const float*)d_in[i];
    a.out = (float*)d_out; a.ws = (unsigned char*)d_ws;
#if MK_MULTI
    for (int ph = 0; ph < NPHASE; ++ph) { a.ph_lo = ph; a.ph_hi = ph + 1; hipLaunchKernelGGL(mega, dim3(grid), dim3(512), LDS_BYTES, stream, a); }
#else
    a.ph_lo = 0; a.ph_hi = NPHASE;
    void* kargs[] = {&a};
    hipError_t e = hipLaunchCooperativeKernel((const void*)mega, dim3(grid), dim3(512), kargs, LDS_BYTES, stream);
    if (e != hipSuccess) fprintf(stderr, "cooperative launch failed: %s (grid %d)\n", hipGetErrorString(e), grid);
#endif
}
```

```cpp
#include <hip/hip_runtime.h>
#include <hip/hip_bf16.h>
#include <hip/hip_cooperative_groups.h>
#include <cstdio>
#include <cstdint>
namespace cg = cooperative_groups;
__device__ __forceinline__ int opaque_tid() { int t = threadIdx.x; asm volatile("" : "+v"(t)); return t; }
namespace pg8 {
#define PG8_LAS __attribute__((address_space(3)))
typedef unsigned short bf16_t;
typedef short bf16x8 __attribute__((ext_vector_type(8)));
typedef float f32x4 __attribute__((ext_vector_type(4)));
typedef unsigned u32x4 __attribute__((ext_vector_type(4)));
constexpr int BM = 256, BK = 64, HALF = 128, HTB = HALF * BK * 2  , STAGE_BYTES = 8 * HTB, NXCD = 8, WGM = 8;

__host__ __device__ __forceinline__ int lds_byte(int r, int c) { const int st = (r >> 4) * 2 + (c >> 5), rr = r & 15, cc = c & 31, ob = rr * 64 + cc * 2; return st * 1024 + (ob ^ (((ob >> 9) & 1) << 5)); }
__host__ __device__ __forceinline__ void stage_rc(int b, int& R, int& C) { const int st = b / 1024, sb = b % 1024, swz = sb ^ (((sb >> 9) & 1) << 5); R = (st >> 1) * 16 + swz / 64; C = (st & 1) * 32 + (swz % 64) / 2; }
__host__ __device__ __forceinline__ int perm32(int rho) { const int n = rho >> 4, i = rho & 15; return 8 * (i >> 2) + 4 * n + (i & 3); }

struct Unit { int pm, pn; };
struct Gemm { const bf16_t* A; const bf16_t* Bt; int M, N, K; };

struct StaticOrder {
    int nM, nN, nwg, G, c;
    __host__ __device__ void init(int M, int N, int G_, int c_) { nM = M / BM; nN = N / BM; nwg = nM * nN; G = G_; c = c_; }
    __host__ __device__ bool next(int i, Unit& u) const {
        const long L = (long)i * G + c; if (L >= nwg) return false;
        int wgid = (int)L; { const int q = nwg / NXCD, r = nwg % NXCD, xcd = wgid % NXCD, off = wgid / NXCD; wgid = (xcd < r ? xcd * (q + 1) : r * (q + 1) + (xcd - r) * q) + off; }
        const int nig = WGM * nN, gid = wgid / nig, fm = gid * WGM, gsz = (nM - fm) < WGM ? (nM - fm) : WGM;
        u.pm = fm + ((wgid % nig) % gsz); u.pn = (wgid % nig) / gsz; return true;
    }
    __device__ __forceinline__ void a_ready(const Unit&) const {}
    __device__ __forceinline__ void done(const Unit&) const {}
};

__device__ __forceinline__ unsigned cvt_pk_bf16(float lo, float hi) { unsigned r; asm volatile("v_cvt_pk_bf16_f32 %0, %1, %2" : "=v"(r) : "v"(lo), "v"(hi)); return r; }
typedef float f32x2 __attribute__((ext_vector_type(2)));
typedef float f32x2_t __attribute__((ext_vector_type(2))); typedef __bf16 bf16x2_t __attribute__((ext_vector_type(2)));
__device__ __forceinline__ unsigned cvtpk_s(float lo, float hi) { f32x2_t v = {lo, hi}; bf16x2_t b = __builtin_convertvector(v, bf16x2_t); return __builtin_bit_cast(unsigned, b); }
__device__ __forceinline__ float bf_lo(unsigned w) { return __builtin_bit_cast(float, w << 16); }
__device__ __forceinline__ float bf_hi(unsigned w) { return __builtin_bit_cast(float, w & 0xffff0000u); }
__device__ __forceinline__ float silu_f(float z) { return z / (1.f + __expf(-z)); }
struct Epi {
    static constexpr bool PERM = true, AFTER_DRAIN = false;
    int mode;
    bf16_t* O; int ldc;
    int tail_pn; float* F; int ldf, nf;
    bf16_t* halo;
    const float* rstd; const float* ng;
    const float* src_lat; const float* src_ctx; float* dst_lat; float* dst_ctx; const float* mod; int gidx;
    __device__ __forceinline__ void operator()(const f32x4 (&acc)[2][2][4][2], const Unit& u, int wr, int wc, int fr, int fq) const {
        const int row0 = u.pm * BM + wr * 64 + fr; const int col0 = u.pn * BM + wc * 32 + 8 * fq;
        if (mode <= 1) {
            if (u.pn == tail_pn) {
                const int c0 = wc * 32 + 8 * fq;
#pragma unroll
                for (int ai = 0; ai < 2; ++ai)
#pragma unroll
                    for (int m = 0; m < 4; ++m)
#pragma unroll
                        for (int bj = 0; bj < 2; ++bj) { const int cc = c0 + bj * HALF;
                            if (cc < nf) { float* p = F + (size_t)(row0 + ai * HALF + m * 16) * ldf + cc; *(f32x4*)p = acc[ai][bj][m][0]; *(f32x4*)(p + 4) = acc[ai][bj][m][1]; } }
            } else {
#pragma unroll
                for (int ai = 0; ai < 2; ++ai)
#pragma unroll
                    for (int m = 0; m < 4; ++m) { bf16_t* rowp = O + (size_t)(row0 + ai * HALF + m * 16) * ldc + col0;
#pragma unroll
                        for (int bj = 0; bj < 2; ++bj) { f32x4 v0 = acc[ai][bj][m][0], v1 = acc[ai][bj][m][1];
                            if (mode == 1) {
#pragma unroll
                                for (int e = 0; e < 4; ++e) { float a = fmaxf(v0[e], 0.f), b = fmaxf(v1[e], 0.f); v0[e] = a * a; v1[e] = b * b; } }
                            u32x4 w; w.x = cvtpk_s(v0[0], v0[1]); w.y = cvtpk_s(v0[2], v0[3]); w.z = cvtpk_s(v1[0], v1[1]); w.w = cvtpk_s(v1[2], v1[3]);
                            *(u32x4*)(rowp + bj * HALF) = w;
                            if (halo && ((m == 0 && fr < 2) || (m == 3 && fr >= 14))) { const int row = row0 + ai * HALF + m * 16; const int j = m == 0 ? fr : fr - 12;
                                *(u32x4*)(halo + ((size_t)(row >> 6) * 4 + j) * ldc + col0 + bj * HALF) = w; } } }
            }
        } else if (mode == 2) {
            const f32x4 g0 = *(const f32x4*)(ng + (col0 & 127)), g1 = *(const f32x4*)(ng + (col0 & 127) + 4);
#pragma unroll
            for (int ai = 0; ai < 2; ++ai)
#pragma unroll
                for (int m = 0; m < 4; ++m) { const int row = row0 + ai * HALF + m * 16; bf16_t* rowp = O + (size_t)row * ldc + col0;
#pragma unroll
                    for (int bj = 0; bj < 2; ++bj) { const float rs = rstd[(size_t)row * 16 + ((col0 + bj * HALF) >> 7)];
                        const u32x4 ov = *(const u32x4*)(rowp + bj * HALF); const f32x4 z0 = acc[ai][bj][m][0], z1 = acc[ai][bj][m][1];
                        float r[8];
                        r[0] = bf_lo(ov.x) * rs * g0[0] * silu_f(z0[0]); r[1] = bf_hi(ov.x) * rs * g0[1] * silu_f(z0[1]);
                        r[2] = bf_lo(ov.y) * rs * g0[2] * silu_f(z0[2]); r[3] = bf_hi(ov.y) * rs * g0[3] * silu_f(z0[3]);
                        r[4] = bf_lo(ov.z) * rs * g1[0] * silu_f(z1[0]); r[5] = bf_hi(ov.z) * rs * g1[1] * silu_f(z1[1]);
                        r[6] = bf_lo(ov.w) * rs * g1[2] * silu_f(z1[2]); r[7] = bf_hi(ov.w) * rs * g1[3] * silu_f(z1[3]);
                        u32x4 w; w.x = cvtpk_s(r[0], r[1]); w.y = cvtpk_s(r[2], r[3]); w.z = cvtpk_s(r[4], r[5]); w.w = cvtpk_s(r[6], r[7]);
                        *(u32x4*)(rowp + bj * HALF) = w; } }
        } else {
            const int mi = u.pm < 64 ? 0 : (u.pm < 128 ? 1 : 2);
            const float* gate = mod + (size_t)mi * 6144 + (size_t)gidx * 1024;
            const bool lat = u.pm < 128;
            const float* sb = lat ? src_lat : src_ctx - (size_t)32768 * 1024; float* db = lat ? dst_lat : dst_ctx - (size_t)32768 * 1024;
#pragma unroll
            for (int bj = 0; bj < 2; ++bj)
#pragma unroll
                for (int n = 0; n < 2; ++n) { const int c = col0 + bj * HALF + 4 * n; const f32x4 gv = *(const f32x4*)(gate + c);
#pragma unroll
                    for (int ai = 0; ai < 2; ++ai)
#pragma unroll
                        for (int m = 0; m < 4; ++m) { const size_t off = (size_t)(row0 + ai * HALF + m * 16) * 1024 + c;
                            const f32x4 s = *(const f32x4*)(sb + off); *(f32x4*)(db + off) = s + gv * acc[ai][bj][m][n]; } }
        }
    }
};
template <class Epi, class Sched, bool ALIGN_EPI = false, bool SP2 = false>
__device__ __forceinline__ void gemm_phase(PG8_LAS unsigned char* lds, const Gemm g, const Sched& S, const Epi& E) {
    const int tid = opaque_tid(), wid = __builtin_amdgcn_readfirstlane(tid >> 6), lane = tid & 63, wr = wid >> 2, wc = wid & 3, fr = lane & 15, fq = lane >> 4;
    const int K = g.K, nt = K / BK;
    unsigned voffA[2], voffB[2];
#pragma unroll
    for (int i = 0; i < 2; ++i) { int R, C; stage_rc(tid * 16 + i * 8192, R, C); const int Rb = Epi::PERM ? ((R & ~31) + perm32(R & 31)) : R;
        voffA[i] = (unsigned)(R * K + C) * 2u; voffB[i] = (unsigned)(Rb * K + C) * 2u; }
    const size_t kstep = (size_t)(BK * 2);
    const size_t hstep = (size_t)HALF * K * 2;
    const size_t tstep = 2 * hstep;
    const unsigned ldsw = (unsigned)wid * 1024u;
    const int aoff = lds_byte(wr * 64 + fr, fq * 8), boff = lds_byte(wc * 32 + fr, fq * 8);
#define PG8_SA(b, h) (((b) * 2 + (h)) * HTB)
#define PG8_SB(b, h) ((4 + (b) * 2 + (h)) * HTB)
#define PG8_STAGE(bufoff, gbase, voff) do { _Pragma("unroll") for (int _i = 0; _i < 2; ++_i) \
        __builtin_amdgcn_global_load_lds((const unsigned*)((const char*)(gbase) + (voff)[_i]), (PG8_LAS unsigned*)(lds + (bufoff) + ldsw + _i * 8192), 16, 0, 0); } while (0)
#define PG8_LDA(dst, b, h) do { _Pragma("unroll") for (int m = 0; m < 4; ++m) _Pragma("unroll") for (int k = 0; k < 2; ++k) dst[m][k] = *(const PG8_LAS bf16x8*)(lds + PG8_SA(b, h) + aoff + m * 2048 + k * 1024); } while (0)
#define PG8_LDB(dst, b, h) do { _Pragma("unroll") for (int n = 0; n < 2; ++n) _Pragma("unroll") for (int k = 0; k < 2; ++k) dst[n][k] = *(const PG8_LAS bf16x8*)(lds + PG8_SB(b, h) + boff + n * 2048 + k * 1024); } while (0)
#define PG8_MMA(ai, bj, At, Bt) do { __builtin_amdgcn_s_setprio(1); _Pragma("unroll") for (int m = 0; m < 4; ++m) _Pragma("unroll") for (int n = 0; n < 2; ++n) _Pragma("unroll") for (int k = 0; k < 2; ++k) \
        acc[ai][bj][m][n] = __builtin_amdgcn_mfma_f32_16x16x32_bf16(Bt[n][k], At[m][k], acc[ai][bj][m][n], 0, 0, 0); __builtin_amdgcn_s_setprio(0); } while (0)
#define PG8_WAIT_V(n) asm volatile("s_waitcnt vmcnt(" #n ")" ::: "memory")
#define PG8_WAIT_L(n) asm volatile("s_waitcnt lgkmcnt(" #n ")" ::: "memory")
#define PG8_BAR __builtin_amdgcn_s_barrier()
#define PG8_SCHED __builtin_amdgcn_sched_barrier(0)
    Unit cur, nxt; int ui = 0;
    if (!S.next(0, cur)) return;
    f32x4 acc[2][2][4][2];
#pragma unroll
    for (int a = 0; a < 2; ++a)
#pragma unroll
        for (int b = 0; b < 2; ++b)
#pragma unroll
            for (int m = 0; m < 4; ++m)
#pragma unroll
                for (int n = 0; n < 2; ++n) acc[a][b][m][n] = (f32x4){0.f, 0.f, 0.f, 0.f};
    bf16x8 At[4][2], B0[2][2], B1[2][2];
    const char* cA = (const char*)g.A + (size_t)cur.pm * tstep; const char* cB = (const char*)g.Bt + (size_t)cur.pn * tstep;
    S.a_ready(cur);
    if constexpr (SP2) {
        PG8_STAGE(PG8_SB(0, 0), cB, voffB); PG8_STAGE(PG8_SB(0, 1), cB + hstep, voffB); PG8_STAGE(PG8_SA(0, 0), cA, voffA); PG8_STAGE(PG8_SA(0, 1), cA + hstep, voffA);
        if (wr == 1) PG8_BAR;
        PG8_WAIT_V(2); PG8_BAR;
        PG8_STAGE(PG8_SB(1, 0), cB + kstep, voffB); PG8_STAGE(PG8_SA(1, 0), cA + kstep, voffA); PG8_STAGE(PG8_SB(1, 1), cB + hstep + kstep, voffB);
        PG8_WAIT_V(6); PG8_BAR;
    } else {
        PG8_STAGE(PG8_SB(0, 0), cB, voffB); PG8_STAGE(PG8_SA(0, 0), cA, voffA); PG8_STAGE(PG8_SB(0, 1), cB + hstep, voffB); PG8_STAGE(PG8_SA(0, 1), cA + hstep, voffA);
        if (wr == 1) PG8_BAR;
        PG8_WAIT_V(4); PG8_BAR;
        PG8_STAGE(PG8_SB(1, 0), cB + kstep, voffB); PG8_STAGE(PG8_SA(1, 0), cA + kstep, voffA); PG8_STAGE(PG8_SB(1, 1), cB + hstep + kstep, voffB);
        PG8_WAIT_V(6); PG8_BAR;
    }
    for (;;) {
        const bool has_next = S.next(ui + 1, nxt);
        const char* nA = has_next ? (const char*)g.A + (size_t)nxt.pm * tstep : cA; const char* nB = has_next ? (const char*)g.Bt + (size_t)nxt.pn * tstep : cB;
        for (int t = 0; t < nt; t += 2) {
            const bool last = (t == nt - 2);
            const char* a1 = cA + (size_t)(t + 1) * kstep;
            const char* a2 = last ? nA : cA + (size_t)(t + 2) * kstep; const char* b2 = last ? nB : cB + (size_t)(t + 2) * kstep;
            const char* a3 = a2 + kstep; const char* b3 = b2 + kstep;
            if (last && has_next) S.a_ready(nxt);
            if constexpr (SP2) {
            PG8_LDB(B0, 0, 0); PG8_LDB(B1, 0, 1); PG8_SCHED; PG8_LDA(At, 0, 0); PG8_STAGE(PG8_SA(1, 1), a1 + hstep, voffA);
            PG8_WAIT_V(8); PG8_WAIT_L(0); PG8_BAR; PG8_MMA(0, 0, At, B0); PG8_MMA(0, 1, At, B1); PG8_BAR; PG8_SCHED;
            PG8_LDA(At, 0, 1); PG8_STAGE(PG8_SB(0, 0), b2, voffB); PG8_STAGE(PG8_SB(0, 1), b2 + hstep, voffB); PG8_STAGE(PG8_SA(0, 0), a2, voffA);
            PG8_WAIT_V(8); PG8_WAIT_L(0); PG8_BAR; PG8_MMA(1, 0, At, B0); PG8_MMA(1, 1, At, B1); PG8_BAR; PG8_SCHED;
            PG8_LDB(B0, 1, 0); PG8_LDB(B1, 1, 1); PG8_SCHED; PG8_LDA(At, 1, 0); PG8_STAGE(PG8_SA(0, 1), a2 + hstep, voffA);
            PG8_WAIT_V(8); PG8_WAIT_L(0); PG8_BAR; PG8_MMA(0, 0, At, B0); PG8_MMA(0, 1, At, B1); PG8_BAR; PG8_SCHED;
            PG8_LDA(At, 1, 1); PG8_STAGE(PG8_SB(1, 0), b3, voffB); PG8_STAGE(PG8_SB(1, 1), b3 + hstep, voffB); PG8_STAGE(PG8_SA(1, 0), a3, voffA);
            PG8_WAIT_V(8); PG8_WAIT_L(0); PG8_BAR; PG8_MMA(1, 0, At, B0); PG8_MMA(1, 1, At, B1); PG8_BAR; PG8_SCHED;
            } else {
            PG8_LDB(B0, 0, 0); PG8_SCHED; PG8_LDA(At, 0, 0); PG8_STAGE(PG8_SA(1, 1), a1 + hstep, voffA);
            PG8_WAIT_L(8); PG8_BAR; PG8_WAIT_L(0); PG8_MMA(0, 0, At, B0); PG8_BAR; PG8_SCHED;
            PG8_LDB(B1, 0, 1); PG8_STAGE(PG8_SB(0, 0), b2, voffB);
            PG8_BAR; PG8_WAIT_L(0); PG8_MMA(0, 1, At, B1); PG8_BAR;
            PG8_LDA(At, 0, 1); PG8_STAGE(PG8_SA(0, 0), a2, voffA);
            PG8_BAR; PG8_WAIT_L(0); PG8_MMA(1, 0, At, B0); PG8_BAR; PG8_SCHED;
            PG8_STAGE(PG8_SB(0, 1), b2 + hstep, voffB);
            PG8_WAIT_V(6); PG8_BAR; PG8_MMA(1, 1, At, B1); PG8_BAR;
            PG8_LDB(B0, 1, 0); PG8_SCHED; PG8_LDA(At, 1, 0); PG8_STAGE(PG8_SA(0, 1), a2 + hstep, voffA);
            PG8_WAIT_L(8); PG8_BAR; PG8_WAIT_L(0); PG8_MMA(0, 0, At, B0); PG8_BAR; PG8_SCHED;
            PG8_LDB(B1, 1, 1); PG8_STAGE(PG8_SB(1, 0), b3, voffB);
            PG8_BAR; PG8_WAIT_L(0); PG8_MMA(0, 1, At, B1); PG8_BAR;
            PG8_LDA(At, 1, 1); PG8_STAGE(PG8_SA(1, 0), a3, voffA);
            PG8_BAR; PG8_WAIT_L(0); PG8_MMA(1, 0, At, B0); PG8_BAR; PG8_SCHED;
            PG8_STAGE(PG8_SB(1, 1), b3 + hstep, voffB);
            PG8_WAIT_V(6); PG8_BAR; PG8_MMA(1, 1, At, B1); PG8_BAR;
            }
        }
        if constexpr (ALIGN_EPI) { if (wr == 0) PG8_BAR; }
        if constexpr (!Epi::AFTER_DRAIN) { E(acc, cur, wr, wc, fr, fq); S.done(cur); }
        if (!has_next) break;
#pragma unroll
        for (int a = 0; a < 2; ++a)
#pragma unroll
            for (int b = 0; b < 2; ++b)
#pragma unroll
                for (int m = 0; m < 4; ++m)
#pragma unroll
                    for (int n = 0; n < 2; ++n) acc[a][b][m][n] = (f32x4){0.f, 0.f, 0.f, 0.f};
        cur = nxt; cA = nA; cB = nB; ++ui;
        if constexpr (ALIGN_EPI) { if (wr == 1) PG8_BAR; }
    }
    PG8_WAIT_V(0);
    if constexpr (!ALIGN_EPI) { if (wr == 0) PG8_BAR; }
    PG8_BAR;
    if constexpr (Epi::AFTER_DRAIN) { E.fused(acc, cur, wr, wc, fr, fq, lds, wid, lane); S.done(cur); }
#undef PG8_SA
#undef PG8_SB
#undef PG8_STAGE
#undef PG8_LDA
#undef PG8_LDB
#undef PG8_MMA
#undef PG8_WAIT_V
#undef PG8_WAIT_L
#undef PG8_BAR
#undef PG8_SCHED
}
}
namespace attn {
using bf16 = __hip_bfloat16;
constexpr int   D = 128, NW = 8, QBLK = 32, KVBLK = 64;
constexpr float SCALE = 0.088388347648318440f;
constexpr float THR = 8.f;
constexpr int SDEPTH = 2;
constexpr int LDQ = 1024, LDK = 128, LDO = 1024;
constexpr size_t SHM_V = KVBLK * D * 2, SHM_K = KVBLK * D * 2, SHM_ATTN = 2 * SHM_V + 2 * SHM_K + NW * 64 * 4;
using bf16x8 = __attribute__((ext_vector_type(8))) short;
using s16x4  = __attribute__((ext_vector_type(4))) short;
using f32x16 = __attribute__((ext_vector_type(16))) float;
using f32x8  = __attribute__((ext_vector_type(8))) float;
using u32x4  = __attribute__((ext_vector_type(4))) unsigned;
#define KSWZ(row, colB) ((row) * 256 + ((colB) ^ (((row) & 7) << 4)))
#define SBAR() __builtin_amdgcn_sched_barrier(0)
__device__ __forceinline__ int crow(int r, int hi) { return (r & 3) + 8 * (r >> 2) + 4 * hi; }
__device__ __forceinline__ unsigned cvtpk(float lo, float hi) {
  unsigned r; asm volatile("v_cvt_pk_bf16_f32 %0, %1, %2" : "=v"(r) : "v"(lo), "v"(hi)); return r;
}
template <typename TIn> struct Stage;
template <> struct Stage<bf16>  { using T = bf16x8;
  __device__ static __forceinline__ T ld8(const bf16* p) { return *reinterpret_cast<const bf16x8*>(p); }
  __device__ static __forceinline__ bf16x8 tobf(T x) { return x; } };
template <> struct Stage<float> { using T = f32x8;
  __device__ static __forceinline__ T ld8(const float* p) { return *reinterpret_cast<const f32x8*>(p); }
  __device__ static __forceinline__ bf16x8 tobf(T x) {
    u32x4 w = {cvtpk(x[0], x[1]), cvtpk(x[2], x[3]), cvtpk(x[4], x[5]), cvtpk(x[6], x[7])}; return *reinterpret_cast<bf16x8*>(&w); } };

__device__ __forceinline__ void partialSM(f32x16& p0, f32x16& p1, float& m_reg, float& mn, float& alpha) {
  constexpr float C = SCALE * 1.4426950408889634f;
  float pmax = p0[0]; for (int r = 1; r < 16; ++r) pmax = fmaxf(pmax, p0[r]); for (int r = 0; r < 16; ++r) pmax = fmaxf(pmax, p1[r]);
  { auto rr = __builtin_amdgcn_permlane32_swap(__float_as_uint(pmax), __float_as_uint(pmax), false, false);
    pmax = fmaxf(__uint_as_float(rr[0]), __uint_as_float(rr[1])); }
  if (__builtin_expect(__all(pmax - m_reg <= THR / SCALE), 1)) { mn = m_reg; alpha = 1.f; }
  else { mn = fmaxf(m_reg, pmax); alpha = __builtin_amdgcn_exp2f((m_reg - mn) * C); m_reg = mn; }
  float mnC = -mn * C;
  for (int r = 0; r < 16; ++r) p0[r] = fmaf(p0[r], C, mnC); for (int r = 0; r < 16; ++r) p1[r] = fmaf(p1[r], C, mnC);
  for (int r = 0; r < 16; ++r) p0[r] = __builtin_amdgcn_exp2f(p0[r]);
}
__device__ __forceinline__ void finishSM(f32x16& p0, f32x16& p1, float alpha, float& l_reg, bf16x8& pa0, bf16x8& pa1, bf16x8& pa2, bf16x8& pa3) {
  for (int r = 0; r < 16; ++r) p1[r] = __builtin_amdgcn_exp2f(p1[r]);
  float ps = 0; for (int r = 0; r < 16; ++r) ps += p0[r]; for (int r = 0; r < 16; ++r) ps += p1[r];
  { auto rr = __builtin_amdgcn_permlane32_swap(__float_as_uint(ps), __float_as_uint(ps), false, false);
    ps = __uint_as_float(rr[0]) + __uint_as_float(rr[1]); }
  l_reg = l_reg * alpha + ps;
#define PK4(P, BASE, OUT) do { unsigned a0 = cvtpk(P[BASE + 0], P[BASE + 1]), a1 = cvtpk(P[BASE + 2], P[BASE + 3]);   \
    unsigned b0 = cvtpk(P[BASE + 4], P[BASE + 5]), b1 = cvtpk(P[BASE + 6], P[BASE + 7]);                              \
    auto r0 = __builtin_amdgcn_permlane32_swap(a0, b0, false, false); auto r1 = __builtin_amdgcn_permlane32_swap(a1, b1, false, false); \
    u32x4 w = {r0[0], r1[0], r0[1], r1[1]}; OUT = *reinterpret_cast<bf16x8*>(&w); } while (0)
  PK4(p0, 0, pa0); PK4(p0, 8, pa1); PK4(p1, 0, pa2); PK4(p1, 8, pa3);
#undef PK4
}
__device__ __forceinline__ void qkt(f32x16& p0, f32x16& p1, const bf16* Ks, const bf16x8* qr, int r32, int hi) {
  p0 = f32x16{}; p1 = f32x16{};
  for (int d0 = 0; d0 < 8; ++d0) { int cb = (d0 * 16 + hi * 8) * 2;
    bf16x8 b0 = *reinterpret_cast<const bf16x8*>((const char*)Ks + KSWZ(r32, cb));
    bf16x8 b1 = *reinterpret_cast<const bf16x8*>((const char*)Ks + KSWZ(32 + r32, cb));
    p0 = __builtin_amdgcn_mfma_f32_32x32x16_bf16(b0, qr[d0], p0, 0, 0, 0);
    p1 = __builtin_amdgcn_mfma_f32_32x32x16_bf16(b1, qr[d0], p1, 0, 0, 0); }
}
__device__ __forceinline__ int v_st(int k, int c) { const int kk = (k & ~0xC) | ((k & 4) << 1) | ((k & 8) >> 1); return ((kk >> 3) * 4 + (c >> 5)) * 512 + ((kk & 7) * 32 + (c & 31)) * 2; }
__device__ __forceinline__ int v_rd_base(int lane) { return ((lane & 3) << 3) | (((lane >> 2) & 3) << 6) | (((lane >> 4) & 1) << 5) | (((lane >> 5) & 1) << 8); }
constexpr int v_rd_off(int d0, int ks, int half) { return d0 * 512 + ks * 4096 + half * 2048; }
template <int OFF> __device__ __forceinline__ s16x4 tr_read(int vb) {
  s16x4 r; asm volatile("ds_read_b64_tr_b16 %0, %1 offset:%2" : "=&v"(r) : "v"(vb), "i"(OFF) : "memory"); return r;
}
template <int D0> __device__ __forceinline__ void pv_one(f32x16& od, int vb, bf16x8 pa0, bf16x8 pa1, bf16x8 pa2, bf16x8 pa3) {
  const s16x4 l0 = tr_read<v_rd_off(D0, 0, 0)>(vb), h0 = tr_read<v_rd_off(D0, 0, 1)>(vb), l1 = tr_read<v_rd_off(D0, 1, 0)>(vb), h1 = tr_read<v_rd_off(D0, 1, 1)>(vb);
  const s16x4 l2 = tr_read<v_rd_off(D0, 2, 0)>(vb), h2 = tr_read<v_rd_off(D0, 2, 1)>(vb), l3 = tr_read<v_rd_off(D0, 3, 0)>(vb), h3 = tr_read<v_rd_off(D0, 3, 1)>(vb);
  asm volatile("s_waitcnt lgkmcnt(0)" ::: "memory"); SBAR();
#define PK(L, H) (bf16x8){L[0], L[1], L[2], L[3], H[0], H[1], H[2], H[3]}
  od = __builtin_amdgcn_mfma_f32_32x32x16_bf16(pa0, PK(l0, h0), od, 0, 0, 0);
  od = __builtin_amdgcn_mfma_f32_32x32x16_bf16(pa1, PK(l1, h1), od, 0, 0, 0);
  od = __builtin_amdgcn_mfma_f32_32x32x16_bf16(pa2, PK(l2, h2), od, 0, 0, 0);
  od = __builtin_amdgcn_mfma_f32_32x32x16_bf16(pa3, PK(l3, h3), od, 0, 0, 0);
#undef PK
}
__device__ __forceinline__ void pv_d0(f32x16* o, int vb, bf16x8 pa0, bf16x8 pa1, bf16x8 pa2, bf16x8 pa3) {
  pv_one<0>(o[0], vb, pa0, pa1, pa2, pa3); pv_one<1>(o[1], vb, pa0, pa1, pa2, pa3); pv_one<2>(o[2], vb, pa0, pa1, pa2, pa3); pv_one<3>(o[3], vb, pa0, pa1, pa2, pa3);
}

template <typename TQ>
__device__ __forceinline__ void attn_dense_body(const TQ* __restrict__ Qb, const bf16* __restrict__ Kh, const bf16* __restrict__ Vh,
                                                bf16* __restrict__ Ob, int seq, char* lds) {
  using St = Stage<bf16>; using SQ = Stage<TQ>;
  const int tid = opaque_tid(), wid = tid >> 6, lane = tid & 63, r32 = lane & 31, hi = lane >> 5;
  bf16* V_lds = (bf16*)lds; bf16* K_lds = (bf16*)(lds + 2 * SHM_V);
  float* ws = (float*)(lds + 2 * SHM_V + 2 * SHM_K) + wid * 64; float* li_l = ws; float* al_l = ws + 32;
  float m_reg = -1e30f, l_reg = 0; f32x16 o[4] = {}; bf16x8 qr[8];
  const TQ* Qw = Qb + (long)(wid * QBLK + r32) * LDQ + hi * 8;
#pragma unroll
  for (int d0 = 0; d0 < 8; ++d0) qr[d0] = SQ::tobf(SQ::ld8(Qw + d0 * 16));
  const int sr = tid >> 4, sc = (tid & 15) * 8, vst0 = v_st(sr, sc), vst1 = v_st(32 + sr, sc);
  const int vb0 = (int)(uintptr_t)V_lds + v_rd_base(lane);
  struct { typename St::T vs0, vs1, ks0, ks1; } sr_[SDEPTH];
#define SLOAD(i, k0) do { sr_[i].vs0 = St::ld8(&Vh[(long)((k0) + sr) * LDK + sc]); sr_[i].vs1 = St::ld8(&Vh[(long)((k0) + 32 + sr) * LDK + sc]); \
    sr_[i].ks0 = St::ld8(&Kh[(long)((k0) + sr) * LDK + sc]); sr_[i].ks1 = St::ld8(&Kh[(long)((k0) + 32 + sr) * LDK + sc]); } while (0)
#define SWRITE(b, i) do { *(bf16x8*)((char*)V_lds + (b) * SHM_V + vst0) = St::tobf(sr_[i].vs0);          \
    *(bf16x8*)((char*)V_lds + (b) * SHM_V + vst1) = St::tobf(sr_[i].vs1); int kc = sc * 2;               \
    *(bf16x8*)((char*)K_lds + (b) * SHM_K + KSWZ(sr, kc)) = St::tobf(sr_[i].ks0);                       \
    *(bf16x8*)((char*)K_lds + (b) * SHM_K + KSWZ(32 + sr, kc)) = St::tobf(sr_[i].ks1); } while (0)
#define SWAIT() do { if constexpr (SDEPTH == 2) asm volatile("s_waitcnt vmcnt(4)" ::: "memory"); else asm volatile("s_waitcnt vmcnt(0)" ::: "memory"); } while (0)
#define RESC(a) do { if (__any((a) < 1.f)) { if (hi == 0) al_l[r32] = (a); asm volatile("s_waitcnt lgkmcnt(0)" ::: "memory"); \
    for (int d = 0; d < 4; ++d) for (int r = 0; r < 16; ++r) o[d][r] *= al_l[crow(r, hi)]; } } while (0)
  f32x16 pA0, pA1, pB0, pB1; float mnA, mnB, alA, alB; bf16x8 pa0, pa1, pa2, pa3; const int NT = seq / KVBLK;
  constexpr int SE = 0, SO = SDEPTH - 1;
  SLOAD(SE, 0); asm volatile("s_waitcnt vmcnt(0)" ::: "memory"); SWRITE(0, SE); __syncthreads();
  qkt(pA0, pA1, K_lds, qr, r32, hi); partialSM(pA0, pA1, m_reg, mnA, alA);
  SLOAD(SO, KVBLK); if constexpr (SDEPTH == 2) { if (2 < NT) SLOAD(SE, 2 * KVBLK); }
  SWAIT(); SWRITE(1, SO); __syncthreads();
  for (int j = 1; j + 1 < NT; j += 2) {
    SBAR(); qkt(pB0, pB1, (bf16*)((char*)K_lds + SHM_K), qr, r32, hi);
    finishSM(pA0, pA1, alA, l_reg, pa0, pa1, pa2, pa3); SBAR();
    SLOAD(SO, (j + SDEPTH) * KVBLK); SBAR();
    pv_d0(o, vb0, pa0, pa1, pa2, pa3); partialSM(pB0, pB1, m_reg, mnB, alB);
    __syncthreads(); SWAIT(); SWRITE(0, SE);
    RESC(alB); __syncthreads();
    SBAR(); qkt(pA0, pA1, K_lds, qr, r32, hi);
    finishSM(pB0, pB1, alB, l_reg, pa0, pa1, pa2, pa3); SBAR();
    if (SDEPTH == 1 || j + 3 < NT) SLOAD(SE, (j + 1 + SDEPTH) * KVBLK); SBAR();
    pv_d0(o, vb0 + (int)SHM_V, pa0, pa1, pa2, pa3); partialSM(pA0, pA1, m_reg, mnA, alA);
    __syncthreads(); SWAIT(); SWRITE(1, SO);
    RESC(alA); __syncthreads();
  }
  SBAR(); qkt(pB0, pB1, (bf16*)((char*)K_lds + SHM_K), qr, r32, hi);
  finishSM(pA0, pA1, alA, l_reg, pa0, pa1, pa2, pa3); SBAR();
  pv_d0(o, vb0, pa0, pa1, pa2, pa3); partialSM(pB0, pB1, m_reg, mnB, alB);
  __syncthreads(); RESC(alB);
  finishSM(pB0, pB1, alB, l_reg, pa0, pa1, pa2, pa3); SBAR();
  pv_d0(o, vb0 + (int)SHM_V, pa0, pa1, pa2, pa3);
  if (hi == 0) li_l[r32] = l_reg; asm volatile("s_waitcnt lgkmcnt(0)" ::: "memory");
  float rli[16];
#pragma unroll
  for (int r = 0; r < 16; ++r) rli[r] = __builtin_amdgcn_rcpf(li_l[crow(r, hi)]);
  bf16* Ow = Ob + (long)(wid * QBLK) * LDO;
#pragma unroll
  for (int r = 0; r < 16; ++r) { int orow = crow(r, hi);
    for (int d0 = 0; d0 < 4; ++d0) Ow[(long)orow * LDO + d0 * 32 + r32] = __float2bfloat16(o[d0][r] * rli[r]); }
#undef SLOAD
#undef SWRITE
#undef SWAIT
#undef RESC
}

}
#define LAS __attribute__((address_space(3)))
typedef unsigned short bf16_t;
typedef short bf16x8 __attribute__((ext_vector_type(8)));
typedef short s16x4 __attribute__((ext_vector_type(4)));
typedef float f32x4 __attribute__((ext_vector_type(4)));
typedef float f32x16 __attribute__((ext_vector_type(16)));
typedef unsigned u32x4 __attribute__((ext_vector_type(4)));
typedef unsigned u32x2 __attribute__((ext_vector_type(2)));
using pg8::cvtpk_s; using pg8::bf_lo; using pg8::bf_hi; using pg8::silu_f;

constexpr int DM = 1024, SEQ = 16384, CTXL = 256, NLAT = 2 * SEQ, MROWS = NLAT + 2 * CTXL, DFF = 4096;
constexpr float EPS = 1e-6f;
constexpr size_t MiB = 1u << 20;
constexpr size_t WS_BAR = 512 * 1024, WS_BAR_BYTES = 16384;
constexpr size_t WS_MOD = 0, WS_CTX = 1 * MiB, WS_WT = 4 * MiB, WS_H = 41 * MiB, WS_AB = 106 * MiB, WS_RSTD = 115 * MiB, WS_P = 118 * MiB, WS_O = 378 * MiB, WS_END = 508 * MiB;
constexpr size_t WT_A = WS_WT, WT_Z = WS_WT + 9 * MiB, WT_O = WS_WT + 13 * MiB, WT_1 = WS_WT + 17 * MiB, WT_2 = WS_WT + 25 * MiB;
constexpr size_t WS_QM = 313 * MiB, WS_KM = 378 * MiB, WS_OGLA = 443 * MiB, WS_AQ = 41 * MiB, WS_EL = 74 * MiB;
constexpr size_t WS_TP = 4 * MiB, WS_HALO = 378 * MiB;
constexpr size_t WS_QR = 216 * MiB, WS_KR = 281 * MiB, WS_VR = 298 * MiB;
constexpr int SKV = SEQ + CTXL;
constexpr int LDS_BYTES = 155648;
enum { OP_MOD, OP_PREP, OP_GEMM_IN, OP_DNSCAN, OP_DNREDO, OP_GEMM_Z, OP_GEMM_OUT, OP_NORM2, OP_FFN1, OP_FFN2, OP_GLAPREP, OP_GLASCAN, OP_GLAGATE, OP_QKROPE, OP_ATTN, OP_DNHALO, OP_DNCONV, OP_DNT };

struct Args { const float* in[25]; float* out; unsigned char* ws; int ph_lo, ph_hi; };

__device__ __forceinline__ float wave_sum(float v) {
#pragma unroll
    for (int o = 1; o < 64; o <<= 1) v += __shfl_xor(v, o);
    return v;
}
__device__ __forceinline__ float softplus_f(float x) { return x > 20.f ? x : log1pf(__expf(x)); }
__device__ __forceinline__ float logsigmoid_f(float x) { return fminf(x, 0.f) - log1pf(__expf(-fabsf(x))); }
__device__ __forceinline__ bf16_t f2bf(float f) { return (bf16_t)(cvtpk_s(f, 0.f) & 0xffffu); }
__device__ __forceinline__ float bf2f(bf16_t v) { return __builtin_bit_cast(float, (unsigned)v << 16); }

__device__ __forceinline__ void transpose_item(const float* W, int ldw, int c0, int ncols, int K, bf16_t* WT, int row_off, LAS float* scr, int item, int lane) {
    const int nblk = ncols / 32, kb = item / nblk, nb = item % nblk, k0 = 64 * kb, n0 = 32 * nb;
#pragma unroll 8
    for (int i = 0; i < 32; ++i) { const int kk = 2 * i + (lane >> 5); scr[kk * 33 + (lane & 31)] = W[(size_t)(k0 + kk) * ldw + c0 + n0 + (lane & 31)]; }
    asm volatile("s_waitcnt lgkmcnt(0)" ::: "memory");
    const int c = lane & 7;
#pragma unroll
    for (int j = 0; j < 4; ++j) { const int n = (lane >> 3) + 8 * j; const LAS float* s = scr + (8 * c) * 33 + n;
        u32x4 o; o.x = cvtpk_s(s[0 * 33], s[1 * 33]); o.y = cvtpk_s(s[2 * 33], s[3 * 33]); o.z = cvtpk_s(s[4 * 33], s[5 * 33]); o.w = cvtpk_s(s[6 * 33], s[7 * 33]);
        *(u32x4*)(WT + (size_t)(row_off + n0 + n) * K + k0 + 8 * c) = o; }
    asm volatile("s_waitcnt lgkmcnt(0)" ::: "memory");
}
__device__ __forceinline__ void transpose_mat(const float* W, int ldw, int c0, int ncols, int K, bf16_t* WT, int row_off, LAS float* scr, int gw, int NGW, int lane) {
    const int nitems = (K / 64) * (ncols / 32);
    for (int it = gw; it < nitems; it += NGW) transpose_item(W, ldw, c0, ncols, K, WT, row_off, scr, it, lane);
}
__device__ __forceinline__ void normmod_rows(const float* xl, const float* xc, const float* g, const float* modl, int sidx, bf16_t* H, int gw, int NGW, int lane) {
    for (int row0 = gw; row0 < MROWS; row0 += 2 * NGW) {
        const int row1 = row0 + NGW; const bool has1 = row1 < MROWS; const int rows[2] = {row0, has1 ? row1 : row0};
        f32x4 v[2][4]; float ss[2] = {0.f, 0.f};
#pragma unroll
        for (int q = 0; q < 2; ++q) { const int row = rows[q]; const float* xr = row < NLAT ? xl + (size_t)row * DM : xc + (size_t)(row - NLAT) * DM;
#pragma unroll
            for (int j = 0; j < 4; ++j) v[q][j] = *(const f32x4*)(xr + 4 * lane + 256 * j); }
#pragma unroll
        for (int q = 0; q < 2; ++q)
#pragma unroll
            for (int j = 0; j < 4; ++j) ss[q] += (v[q][j][0] * v[q][j][0] + v[q][j][1] * v[q][j][1]) + (v[q][j][2] * v[q][j][2] + v[q][j][3] * v[q][j][3]);
#pragma unroll
        for (int q = 0; q < 2; ++q) {
            if (q == 1 && !has1) break;
            const int row = rows[q]; const int mi = row < SEQ ? 0 : (row < NLAT ? 1 : 2);
            const float* sh = modl + (size_t)mi * 6144 + (size_t)sidx * 1024; const float* sc = sh + 1024;
            const float rinv = rsqrtf(wave_sum(ss[q]) * (1.f / DM) + EPS);
#pragma unroll
            for (int j = 0; j < 4; ++j) { const int c = 4 * lane + 256 * j; const f32x4 gg = *(const f32x4*)(g + c), s1 = *(const f32x4*)(sc + c), s0 = *(const f32x4*)(sh + c);
                f32x4 y;
#pragma unroll
                for (int e = 0; e < 4; ++e) y[e] = v[q][j][e] * rinv * gg[e] * (1.f + s1[e]) + s0[e];
                u32x2 w; w.x = cvtpk_s(y[0], y[1]); w.y = cvtpk_s(y[2], y[3]); *(u32x2*)(H + (size_t)row * DM + c) = w; }
        }
    }
}
#define BAR_LDS() do { asm volatile("s_waitcnt lgkmcnt(0)" ::: "memory"); __builtin_amdgcn_s_barrier(); asm volatile("" ::: "memory"); } while (0)
__device__ __forceinline__ int crow(int x, int h) { return (x & 3) + 8 * (x >> 2) + 4 * h; }
#define MFMA32(a, b, c) __builtin_amdgcn_mfma_f32_32x32x16_bf16((a), (b), (c), 0, 0, 0)
__device__ __forceinline__ bf16x8 frag_nat(const LAS bf16_t* img, int LD, int row, int ks, int h) { return *(const LAS bf16x8*)(img + row * LD + 16 * ks + 8 * h); }
__device__ __forceinline__ bf16x8 frag_perm(const LAS bf16_t* img, int LD, int row, int ks, int h) {
    const s16x4 lo = *(const LAS s16x4*)(img + row * LD + 16 * ks + 4 * h), hi = *(const LAS s16x4*)(img + row * LD + 16 * ks + 8 + 4 * h);
    return __builtin_shufflevector(lo, hi, 0, 1, 2, 3, 4, 5, 6, 7);
}
__device__ __forceinline__ s16x4 tr4(const LAS bf16_t* p) { return __builtin_bit_cast(s16x4, __builtin_amdgcn_ds_read_tr16_b64_v4i16((LAS s16x4*)p)); }
__device__ __forceinline__ bf16x8 frag_tr(const LAS bf16_t* img, int LD, int m0, int ks, int lane) {
    const int i16 = lane & 15, q = i16 >> 2, p = i16 & 3, blk = (lane >> 4) & 1, h = lane >> 5;
    const LAS bf16_t* a = img + (16 * ks + 4 * h + q) * LD + m0 + 16 * blk + 4 * p;
    const s16x4 lo = tr4(a), hi = tr4(a + 8 * LD);
    return __builtin_shufflevector(lo, hi, 0, 1, 2, 3, 4, 5, 6, 7);
}
__device__ __forceinline__ bf16x8 pack_step(const f32x16& x, int s) {
    u32x4 p; p.x = cvtpk_s(x[8 * s + 0], x[8 * s + 1]); p.y = cvtpk_s(x[8 * s + 2], x[8 * s + 3]); p.z = cvtpk_s(x[8 * s + 4], x[8 * s + 5]); p.w = cvtpk_s(x[8 * s + 6], x[8 * s + 7]);
    return __builtin_bit_cast(bf16x8, p);
}
__device__ __forceinline__ void dn_halo_phase(const bf16_t* P, bf16_t* HALO, int G) {
    const int tid = opaque_tid();
    for (size_t e = (size_t)blockIdx.x * 512 + tid; e < (size_t)520 * 4 * 512; e += (size_t)G * 512) {
        const int c = (int)(e & 511), j = (int)((e >> 9) & 3), rb = (int)(e >> 11);
        const int row = rb * 64 + (j < 2 ? j : 60 + j);
        ((u32x4*)(HALO + ((size_t)rb * 4 + j) * 4096))[c] = ((const u32x4*)(P + (size_t)row * 4096))[c];
    }
}
__device__ __forceinline__ void unpack8(const u32x4 v, float (&f)[8]) { f[0] = bf_lo(v.x); f[1] = bf_hi(v.x); f[2] = bf_lo(v.y); f[3] = bf_hi(v.y); f[4] = bf_lo(v.z); f[5] = bf_hi(v.z); f[6] = bf_lo(v.w); f[7] = bf_hi(v.w); }
__device__ __forceinline__ void dn_conv_phase(bf16_t* P, const bf16_t* HALO, const float* conv_w, int G) {
    const int tid = opaque_tid(), col0 = 8 * tid;
    float cw[8][5];
#pragma unroll
    for (int c = 0; c < 8; ++c)
#pragma unroll
        for (int tap = 0; tap < 5; ++tap) cw[c][tap] = conv_w[(size_t)(col0 + c) * 5 + tap];
    const int kind = col0 < 1024 ? 0 : (col0 < 2048 ? 1 : 2);
    for (int rb = blockIdx.x; rb < 520; rb += G) {
        const int cs = rb < 512 ? (rb & 255) : ((rb - 512) & 3); const bool sfirst = cs == 0, slast = rb < 512 ? cs == 255 : cs == 3;
        const u32x4 zero = (u32x4){0u, 0u, 0u, 0u};
        bf16_t* base = P + (size_t)rb * 64 * 4096 + col0;
        u32x4 w0 = sfirst ? zero : *(const u32x4*)(HALO + ((size_t)(rb - 1) * 4 + 2) * 4096 + col0);
        u32x4 w1 = sfirst ? zero : *(const u32x4*)(HALO + ((size_t)(rb - 1) * 4 + 3) * 4096 + col0);
        u32x4 w2 = *(const u32x4*)(base), w3 = *(const u32x4*)(base + 4096);
#pragma unroll 4
        for (int rr = 0; rr < 64; ++rr) {
            u32x4 w4;
            if (rr + 2 < 64) w4 = *(const u32x4*)(base + (size_t)(rr + 2) * 4096);
            else w4 = slast ? zero : *(const u32x4*)(HALO + ((size_t)(rb + 1) * 4 + (rr + 2 - 64)) * 4096 + col0);
            float x0[8], x1[8], x2[8], x3[8], x4[8], y[8];
            unpack8(w0, x0); unpack8(w1, x1); unpack8(w2, x2); unpack8(w3, x3); unpack8(w4, x4);
            float ss = 0.f;
#pragma unroll
            for (int c = 0; c < 8; ++c) { const float a = x0[c] * cw[c][0] + x1[c] * cw[c][1] + x2[c] * cw[c][2] + x3[c] * cw[c][3] + x4[c] * cw[c][4]; y[c] = silu_f(a); ss += y[c] * y[c]; }
            float sc = 1.f;
            if (kind < 2) { ss += __shfl_xor(ss, 1); ss += __shfl_xor(ss, 2); ss += __shfl_xor(ss, 4); ss += __shfl_xor(ss, 8); sc = rsqrtf(ss + EPS) * (kind == 0 ? 0.08838834764831845f : 1.f); }
            u32x4 o; o.x = cvtpk_s(y[0] * sc, y[1] * sc); o.y = cvtpk_s(y[2] * sc, y[3] * sc); o.z = cvtpk_s(y[4] * sc, y[5] * sc); o.w = cvtpk_s(y[6] * sc, y[7] * sc);
            *(u32x4*)(base + (size_t)rr * 4096) = o;
            w0 = w1; w1 = w2; w2 = w3; w3 = w4;
        }
    }
}
constexpr int DT_KB = 0, DT_R = 17408, DT_SC = 33792, DT_DIR = 34816;
template <int W> __device__ __forceinline__ void dn_solve(const LAS float* Mf, float (&t)[16], int lane) {
    const int j = 16 * W + (lane >> 2), q = lane & 3;
#pragma unroll
    for (int s = 0; s < 16; ++s) t[s] = 0.f;
#pragma unroll
    for (int i = 16 * W; i < 64; ++i) {
        float acc = 0.f;
#pragma unroll
        for (int s = 4 * W; s <= (i - 1) / 4 && i > 16 * W; ++s) acc += Mf[i * 64 + 4 * s + q] * t[s];
        acc += __shfl_xor(acc, 1); acc += __shfl_xor(acc, 2);
        const float val = (i == j ? 1.f : 0.f) - acc;
        if (q == (i & 3)) t[i >> 2] = val;
        asm volatile("" : "+v"(t[0]), "+v"(t[1]), "+v"(t[2]), "+v"(t[3]), "+v"(t[4]), "+v"(t[5]), "+v"(t[6]), "+v"(t[7]), "+v"(t[8]), "+v"(t[9]), "+v"(t[10]), "+v"(t[11]), "+v"(t[12]), "+v"(t[13]), "+v"(t[14]), "+v"(t[15]));
    }
}
__device__ __forceinline__ void dn_t_phase(LAS unsigned char* lds, const bf16_t* P, float* AB, bf16_t* TP, const float* a_log, const float* dt_bias, int G) {
    const int tid0 = opaque_tid(), hb = __builtin_amdgcn_readfirstlane(tid0 >> 8);
    u32x4 pk4[4]; float pav = 0.f, pbv = 0.f;
    {
        const int it = blockIdx.x * 2 + hb;
        if (it < 16640) { const int dir = it & 1, vh = (it >> 1) & 15, rb = it >> 5, kh = vh >> 1, t = tid0 & 255, r0 = t >> 4, c8 = 8 * (t & 15);
#pragma unroll
            for (int v = 0; v < 4; ++v) pk4[v] = *(const u32x4*)(P + (size_t)(rb * 64 + r0 + 16 * v) * 4096 + 1024 + kh * 128 + c8);
            const int ti = dir ? 63 - (t & 63) : (t & 63); const float* ab = AB + (size_t)(rb * 64 + ti) * 64; pav = ab[dir * 16 + vh]; pbv = ab[32 + dir * 16 + vh]; }
    }
    for (int itb = blockIdx.x * 2; itb < 16640; itb += 2 * G) {
        const int it = itb + hb, dir = it & 1, vh = (it >> 1) & 15, rb = it >> 5, kh = vh >> 1;
        const int tq = opaque_tid(), t = tq & 255, w = __builtin_amdgcn_readfirstlane((tq >> 6) & 3), lane = tq & 63, r = lane & 31, h = lane >> 5;
        LAS unsigned char* base = lds + hb * DT_DIR;
        LAS bf16_t* Kb = (LAS bf16_t*)(base + DT_KB); LAS float* Mf = (LAS float*)(base + DT_R); LAS bf16_t* Tb = (LAS bf16_t*)(base + DT_R);
        LAS float* sc_beta = (LAS float*)(base + DT_SC); LAS float* sc_gc = sc_beta + 64;
        {
            const int r0 = t >> 4, c8 = 8 * (t & 15);
#pragma unroll
            for (int v = 0; v < 4; ++v) { const int i = r0 + 16 * v, ip = dir ? 63 - i : i;
                *(LAS u32x4*)(Kb + ip * 136 + c8) = pk4[v]; }
            if (t < 64) {
                const int ti = dir ? 63 - t : t; float* ab = AB + (size_t)(rb * 64 + ti) * 64;
                const float av = pav, bv = pbv;
                const float g = -__expf(a_log[dir * 16 + vh]) * softplus_f(av + dt_bias[dir * 16 + vh]), beta = 1.f / (1.f + __expf(-bv));
                float gc = g;
#pragma unroll
                for (int o = 1; o < 64; o <<= 1) { const float up = __shfl_up(gc, o); if (t >= o) gc += up; }
                sc_beta[t] = beta; sc_gc[t] = gc;
                ab[dir * 16 + vh] = gc; ab[32 + dir * 16 + vh] = beta;
            }
        }
        BAR_LDS();
        {
            const int itn = it + 2 * G;
            if (itn < 16640) { const int dirn = itn & 1, vhn = (itn >> 1) & 15, rbn = itn >> 5, khn = vhn >> 1, r0 = t >> 4, c8 = 8 * (t & 15);
#pragma unroll
                for (int v = 0; v < 4; ++v) pk4[v] = *(const u32x4*)(P + (size_t)(rbn * 64 + r0 + 16 * v) * 4096 + 1024 + khn * 128 + c8);
                const int tin = dirn ? 63 - (t & 63) : (t & 63); const float* abn = AB + (size_t)(rbn * 64 + tin) * 64; pav = abn[dirn * 16 + vhn]; pbv = abn[32 + dirn * 16 + vhn]; }
        }
        const int ti = w >> 1, tj = w & 1;
        {
            f32x16 acc;
#pragma unroll
            for (int x = 0; x < 16; ++x) acc[x] = 0.f;
            if (!(ti == 0 && tj == 1)) {
#pragma unroll
                for (int ks = 0; ks < 8; ++ks) acc = MFMA32(frag_nat(Kb, 136, 32 * ti + r, ks, h), frag_nat(Kb, 136, 32 * tj + r, ks, h), acc);
            }
            const int j = 32 * tj + r; const float gj = sc_gc[j];
#pragma unroll
            for (int x = 0; x < 16; ++x) { const int i = 32 * ti + crow(x, h);
                Mf[i * 64 + j] = (i > j) ? sc_beta[i] * acc[x] * __expf(sc_gc[i] - gj) : 0.f; }
        }
        BAR_LDS();
        float tc[16];
        if (w == 0) dn_solve<0>(Mf, tc, lane); else if (w == 1) dn_solve<1>(Mf, tc, lane); else if (w == 2) dn_solve<2>(Mf, tc, lane); else dn_solve<3>(Mf, tc, lane);
        BAR_LDS();
        {
            const int j = 16 * w + (lane >> 2), q = lane & 3;
#pragma unroll
            for (int s = 0; s < 16; ++s) Tb[(4 * s + q) * 72 + j] = f2bf(tc[s]);
        }
        BAR_LDS();
        {
            bf16_t* dst = TP + (size_t)it * 3072;
#pragma unroll
            for (int k2 = 0; k2 < 2; ++k2) { const int c = t + 256 * k2;
                if (c < 384) { const int blk = c >> 7, rowc = (c & 127) >> 2, cc = c & 3, br = blk ? 1 : 0, bc = blk == 2 ? 1 : 0;
                    *(u32x4*)(dst + c * 8) = *(const LAS u32x4*)(Tb + (32 * br + rowc) * 72 + 32 * bc + 8 * cc); } }
        }
        BAR_LDS();
    }
}
constexpr int DN_KB = 0, DN_QB = 17408, DN_VB = 34816, DN_TB = 51200, DN_AB = 60416, DN_SC = 69632, DN_DIR = 71168;
__device__ __forceinline__ void dn_step_rb(int step, int dir, int b, int& rb, bool& first) {
    if (step < 4) { const int cidx = dir ? 3 - step : step; rb = 512 + b * 4 + cidx; first = step < 2; }
    else { const int c = step - 4; const int cidx = dir ? 255 - c : c; rb = b * 256 + cidx; first = c < 128; }
}
struct DnPre { u32x4 k4[4], q4[4], v4[4], t0, t1; float gc, beta; };
__device__ __forceinline__ void dn_prefetch(DnPre& p, const bf16_t* P, const float* AB, const bf16_t* TP, int rb, int dir, int vh, int kh, int t, int part) {
    const int r0 = t >> 4, c8 = 8 * (t & 15);
    const bf16_t* prow = P + (size_t)(rb * 64 + r0) * 4096 + c8;
    const bf16_t* tp = TP + (size_t)((rb * 16 + vh) * 2 + dir) * 3072;
    if (part & 1) {
#pragma unroll
        for (int v = 0; v < 4; ++v) { const bf16_t* pr = prow + (size_t)(16 * v) * 4096;
            p.k4[v] = *(const u32x4*)(pr + 1024 + kh * 128); p.q4[v] = *(const u32x4*)(pr + kh * 128); p.v4[v] = *(const u32x4*)(pr + 2048 + vh * 128); }
    }
    if (part & 2) {
        p.t0 = *(const u32x4*)(tp + t * 8); p.t1 = *(const u32x4*)(tp + (256 + (t & 127)) * 8);
        const int ti = dir ? 63 - (t & 63) : (t & 63); const float* ab = AB + (size_t)(rb * 64 + ti) * 64; p.gc = ab[dir * 16 + vh]; p.beta = ab[32 + dir * 16 + vh];
    }
}
template <int VAR> __device__ __forceinline__ void dn_scan(LAS unsigned char* lds, const bf16_t* P, const float* AB, const bf16_t* TP, bf16_t* OB) {
    const int tid = opaque_tid(), dir = __builtin_amdgcn_readfirstlane(tid >> 8);
    for (int unit = blockIdx.x; unit < 32; unit += gridDim.x) {
        const int b = unit >> 4, vh = unit & 15, kh = vh >> 1;
        f32x16 S[4];
#pragma unroll
        for (int kt = 0; kt < 4; ++kt)
#pragma unroll
            for (int x = 0; x < 16; ++x) S[kt][x] = 0.f;
        DnPre pre;
        { int rb0; bool f0; dn_step_rb(0, dir, b, rb0, f0); dn_prefetch(pre, P, AB, TP, rb0, dir, vh, kh, tid & 255, 3); }
        __syncthreads();
        for (int step = 0; step < 260; ++step) {
            const int w = __builtin_amdgcn_readfirstlane((opaque_tid() >> 6) & 3);
            LAS unsigned char* base = lds + dir * DN_DIR;
            LAS bf16_t* Kb = (LAS bf16_t*)(base + DN_KB); LAS bf16_t* Qb = (LAS bf16_t*)(base + DN_QB); LAS bf16_t* Vb = (LAS bf16_t*)(base + DN_VB);
            LAS bf16_t* Tb = (LAS bf16_t*)(base + DN_TB); LAS bf16_t* Ab = (LAS bf16_t*)(base + DN_AB);
            LAS float* sc_beta = (LAS float*)(base + DN_SC); LAS float* sc_gc = sc_beta + 64; LAS float* sc_eg = sc_beta + 128; LAS float* sc_tail = sc_beta + 192; LAS float* sc_dl = sc_beta + 256;
            int rb; bool first; dn_step_rb(step, dir, b, rb, first);
            const int row_base = rb * 64;
            {
                const int tq_ = opaque_tid(), t = tq_ & 255;
                const int r0 = t >> 4, c8 = 8 * (t & 15);
#pragma unroll
                for (int v = 0; v < 4; ++v) { const int i = r0 + 16 * v, ip = dir ? 63 - i : i;
                    *(LAS u32x4*)(Kb + ip * 136 + c8) = pre.k4[v]; *(LAS u32x4*)(Qb + ip * 136 + c8) = pre.q4[v]; *(LAS u32x4*)(Vb + ip * 128 + c8) = pre.v4[v]; }
                { const int c = t, blk = c >> 7, rowc = (c & 127) >> 2, cc = c & 3, br = blk ? 1 : 0; *(LAS u32x4*)(Tb + (32 * br + rowc) * 72 + 8 * cc) = pre.t0; }
                if (t < 128) { const int rowc = t >> 2, cc = t & 3; *(LAS u32x4*)(Tb + (32 + rowc) * 72 + 32 + 8 * cc) = pre.t1; }
                if (t < 64) { const float gc = pre.gc, gl = __shfl(gc, 63); sc_beta[t] = pre.beta; sc_gc[t] = gc; sc_eg[t] = __expf(gc); sc_tail[t] = __expf(gl - gc); if (t == 0) sc_dl[0] = __expf(gl); }
            }
            BAR_LDS();
            {
                const int tq_ = opaque_tid(), lane = tq_ & 63, r = lane & 31, h = lane >> 5;
                const int ti = w >> 1, tj = w & 1;
                if (!(ti == 0 && tj == 1)) {
                    f32x16 qk;
#pragma unroll
                    for (int x = 0; x < 16; ++x) qk[x] = 0.f;
#pragma unroll
                    for (int ks = 0; ks < 8; ++ks) qk = MFMA32(frag_nat(Qb, 136, 32 * ti + r, ks, h), frag_nat(Kb, 136, 32 * tj + r, ks, h), qk);
                    const int jj = 32 * tj + r; const float gj = sc_gc[jj];
#pragma unroll
                    for (int x = 0; x < 16; ++x) { const int i = 32 * ti + crow(x, h);
                        Ab[i * 72 + jj] = f2bf((i >= jj) ? qk[x] * __expf(sc_gc[i] - gj) : 0.f); }
                }
            }
            BAR_LDS();
            if (VAR != 2 && step + 1 < 260) { int rbn; bool fn; dn_step_rb(step + 1, dir, b, rbn, fn); dn_prefetch(pre, P, AB, TP, rbn, dir, vh, kh, opaque_tid() & 255, 1); }
            __builtin_amdgcn_sched_barrier(0);
            if (VAR != 1) {
                const int tq_ = opaque_tid(), lane = tq_ & 63, r = lane & 31, h = lane >> 5;
                f32x16 KS[2], QS[2];
#pragma unroll
                for (int mt = 0; mt < 2; ++mt)
#pragma unroll
                    for (int x = 0; x < 16; ++x) { KS[mt][x] = 0.f; QS[mt][x] = 0.f; }
#pragma unroll
                for (int ks = 0; ks < 8; ++ks) {
                    const bf16x8 sp = pack_step(S[ks >> 1], ks & 1);
#pragma unroll
                    for (int mt = 0; mt < 2; ++mt) { KS[mt] = MFMA32(frag_perm(Kb, 136, 32 * mt + r, ks, h), sp, KS[mt]); QS[mt] = MFMA32(frag_perm(Qb, 136, 32 * mt + r, ks, h), sp, QS[mt]); }
                    if (ks & 1) __builtin_amdgcn_sched_barrier(0);
                }
#pragma unroll
                for (int mt = 0; mt < 2; ++mt)
#pragma unroll
                    for (int x = 0; x < 16; ++x) { const int i = 32 * mt + crow(x, h);
                        KS[mt][x] = sc_beta[i] * (bf2f(Vb[i * 128 + 32 * w + r]) - sc_eg[i] * KS[mt][x]); }
                __builtin_amdgcn_sched_barrier(0);
                bf16x8 Xp[4];
#pragma unroll
                for (int ks = 0; ks < 4; ++ks) Xp[ks] = pack_step(KS[ks >> 1], ks & 1);
                f32x16 VN[2];
#pragma unroll
                for (int mt = 0; mt < 2; ++mt) {
#pragma unroll
                    for (int x = 0; x < 16; ++x) VN[mt][x] = 0.f;
#pragma unroll
                    for (int ks = 0; ks < 4; ++ks) if (ks < 2 * mt + 2) VN[mt] = MFMA32(frag_perm(Tb, 72, 32 * mt + r, ks, h), Xp[ks], VN[mt]);
                }
                __builtin_amdgcn_sched_barrier(0);
                if (VAR != 2 && step + 1 < 260) { int rbn; bool fn; dn_step_rb(step + 1, dir, b, rbn, fn); dn_prefetch(pre, P, AB, TP, rbn, dir, vh, kh, opaque_tid() & 255, 2); }
                __builtin_amdgcn_sched_barrier(0);
                bf16x8 VNp[4];
#pragma unroll
                for (int ks = 0; ks < 4; ++ks) VNp[ks] = pack_step(VN[ks >> 1], ks & 1);
#pragma unroll
                for (int mt = 0; mt < 2; ++mt) {
#pragma unroll
                    for (int x = 0; x < 16; ++x) QS[mt][x] *= sc_eg[32 * mt + crow(x, h)];
#pragma unroll
                    for (int ks = 0; ks < 4; ++ks) if (ks < 2 * mt + 2) QS[mt] = MFMA32(frag_perm(Ab, 72, 32 * mt + r, ks, h), VNp[ks], QS[mt]);
                }
                __builtin_amdgcn_sched_barrier(0);
#pragma unroll
                for (int mt = 0; mt < 2; ++mt)
#pragma unroll
                    for (int x = 0; x < 16; ++x) Vb[(32 * mt + crow(x, h)) * 128 + 32 * w + r] = f2bf(QS[mt][x]);
                __builtin_amdgcn_sched_barrier(0);
#pragma unroll
                for (int mt = 0; mt < 2; ++mt)
#pragma unroll
                    for (int x = 0; x < 16; ++x) VN[mt][x] *= sc_tail[32 * mt + crow(x, h)];
#pragma unroll
                for (int ks = 0; ks < 4; ++ks) VNp[ks] = pack_step(VN[ks >> 1], ks & 1);
                __builtin_amdgcn_sched_barrier(0);
                const float dl = sc_dl[0];
#pragma unroll
                for (int kt = 0; kt < 4; ++kt)
#pragma unroll
                    for (int x = 0; x < 16; ++x) S[kt][x] *= dl;
#pragma unroll
                for (int ks = 0; ks < 4; ++ks) {
#pragma unroll
                    for (int kt = 0; kt < 4; ++kt) S[kt] = MFMA32(frag_tr(Kb, 136, 32 * kt, ks, lane), VNp[ks], S[kt]);
                    __builtin_amdgcn_sched_barrier(0);
                }
                if (VAR != 2) {
                    const int rr_ = lane >> 2, c8_ = 8 * (lane & 3);
#pragma unroll
                    for (int v = 0; v < 4; ++v) { const int ip_ = rr_ + 16 * v, i_ = dir ? 63 - ip_ : ip_;
                        u32x4* gp_ = (u32x4*)(OB + (size_t)(row_base + i_) * 2048 + vh * 128 + 32 * w + c8_);
                        u32x4 o = *(const LAS u32x4*)(Vb + ip_ * 128 + 32 * w + c8_);
                        if (!first) { const u32x4 e = gp_[0];
                            o.x = cvtpk_s(bf_lo(o.x) + bf_lo(e.x), bf_hi(o.x) + bf_hi(e.x)); o.y = cvtpk_s(bf_lo(o.y) + bf_lo(e.y), bf_hi(o.y) + bf_hi(e.y));
                            o.z = cvtpk_s(bf_lo(o.z) + bf_lo(e.z), bf_hi(o.z) + bf_hi(e.z)); o.w = cvtpk_s(bf_lo(o.w) + bf_lo(e.w), bf_hi(o.w) + bf_hi(e.w)); }
                        gp_[0] = o; }
                }
            }
            if (step == 1 || step == 131) asm volatile("s_waitcnt vmcnt(0)" ::: "memory");
            BAR_LDS();
        }
    }
}
constexpr int GP_QM = 0, GP_KM = 17408, GP_AB = 34816, GP_LOW = 44032, GP_TOT = 48128, GP_DIR = 49152;
__device__ __forceinline__ void gla_prep_phase(LAS unsigned char* lds, const bf16_t* P, const float* LOW, const float* gw2, const float* gb2, bf16_t* QM, bf16_t* KM, bf16_t* AQ, float* EL, int G) {
    const int tid0 = opaque_tid(), hb = __builtin_amdgcn_readfirstlane(tid0 >> 8);
    for (int itb = blockIdx.x * 2; itb < 4160; itb += 2 * G) {
        const int it = itb + hb, dir = it & 1, head = (it >> 1) & 3, rb = it >> 3;
        const int tq = opaque_tid(), t = tq & 255, w = __builtin_amdgcn_readfirstlane((tq >> 6) & 3), lane = tq & 63, r = lane & 31, h = lane >> 5;
        LAS unsigned char* base = lds + hb * GP_DIR;
        LAS bf16_t* Qm = (LAS bf16_t*)(base + GP_QM); LAS bf16_t* Km = (LAS bf16_t*)(base + GP_KM); LAS bf16_t* Ab = (LAS bf16_t*)(base + GP_AB);
        LAS float* lowS = (LAS float*)(base + GP_LOW); LAS float* tot = (LAS float*)(base + GP_TOT);
        *(LAS f32x4*)(lowS + 4 * t) = *(const f32x4*)(LOW + (size_t)(rb * 64 + (t >> 2)) * 32 + dir * 16 + 4 * (t & 3));
        const int dk = t & 127, half = t >> 7, col = head * 128 + dk;
        float w2c[16];
#pragma unroll
        for (int rr = 0; rr < 16; ++rr) w2c[rr] = gw2[(size_t)(dir * 16 + rr) * 512 + col];
        const float b2 = gb2[dir * 512 + col];
        __syncthreads();
        float bc[32]; float run = 0.f;
#pragma unroll
        for (int n = 0; n < 32; ++n) { const int ip = 32 * half + n, i = dir ? 63 - ip : ip; float s = b2;
#pragma unroll
            for (int rr = 0; rr < 16; ++rr) s += lowS[i * 16 + rr] * w2c[rr];
            run += logsigmoid_f(s) * (1.f / 16.f); bc[n] = run; }
        tot[half * 128 + dk] = run;
        __syncthreads();
        const float t0 = tot[dk], last = t0 + tot[128 + dk], off = half ? t0 : 0.f;
        if (half == 0) EL[(size_t)(dir * 520 + rb) * 512 + col] = last;
        {
            const int i0 = dir ? 63 - 32 * half : 32 * half; const long pstep = dir ? -3072 : 3072;
            const bf16_t* pp = P + (size_t)(rb * 64 + i0) * 3072 + col;
#pragma unroll
            for (int n = 0; n < 32; ++n) { const int ip = 32 * half + n; const float bcv = bc[n] + off;
                const float qv = bf2f(pp[0]), kv = bf2f(pp[512]); pp += pstep;
                Qm[ip * 136 + dk] = f2bf(qv * 0.08838834764831845f * __expf(bcv - last));
                Km[ip * 136 + dk] = f2bf(kv * __expf(last - bcv)); }
        }
        __syncthreads();
        {
            const int ti = w >> 1, tj = w & 1;
            f32x16 acc;
#pragma unroll
            for (int x = 0; x < 16; ++x) acc[x] = 0.f;
            if (!(ti == 0 && tj == 1)) {
#pragma unroll
                for (int ks = 0; ks < 8; ++ks) acc = MFMA32(frag_nat(Qm, 136, 32 * ti + r, ks, h), frag_nat(Km, 136, 32 * tj + r, ks, h), acc);
            }
            const int j = 32 * tj + r;
#pragma unroll
            for (int x = 0; x < 16; ++x) { const int i = 32 * ti + crow(x, h); Ab[i * 72 + j] = f2bf(i >= j ? acc[x] : 0.f); }
            const int r0 = t >> 4, c8 = 8 * (t & 15);
#pragma unroll
            for (int v = 0; v < 4; ++v) { const int row = r0 + 16 * v; const size_t go = ((size_t)dir * MROWS + rb * 64 + row) * 512 + head * 128 + c8;
                *(u32x4*)(QM + go) = *(const LAS u32x4*)(Qm + row * 136 + c8); *(u32x4*)(KM + go) = *(const LAS u32x4*)(Km + row * 136 + c8); }
        }
        __syncthreads();
        {
            bf16_t* dst = AQ + (size_t)it * 4096;
#pragma unroll
            for (int k2 = 0; k2 < 2; ++k2) { const int c = t + 256 * k2, row = c >> 3, cc = c & 7; *(u32x4*)(dst + c * 8) = *(const LAS u32x4*)(Ab + row * 72 + 8 * cc); }
        }
        __syncthreads();
    }
}
constexpr int GL_QM = 0, GL_KM = 17408, GL_VB = 34816, GL_AB = 52224, GL_EL = 61440, GL_DIR = 61952;
struct GlPre { u32x4 q4[4], k4[4], v4[4], a0, a1; float elv; };
__device__ __forceinline__ void gl_prefetch(GlPre& p, const bf16_t* P, const bf16_t* QM, const bf16_t* KM, const bf16_t* AQ, const float* EL, int rb, int dir, int head, int hf, int t) {
    const int r0 = t >> 4, c8 = 8 * (t & 15);
    const bf16_t* aq = AQ + (size_t)((rb * 4 + head) * 2 + dir) * 4096;
#pragma unroll
    for (int v = 0; v < 4; ++v) { const size_t row = (size_t)(rb * 64 + r0 + 16 * v);
        p.q4[v] = *(const u32x4*)(QM + ((size_t)dir * MROWS + row) * 512 + head * 128 + c8);
        p.k4[v] = *(const u32x4*)(KM + ((size_t)dir * MROWS + row) * 512 + head * 128 + c8);
        p.v4[v] = *(const u32x4*)(P + row * 3072 + 1024 + head * 256 + hf * 128 + c8); }
    p.a0 = *(const u32x4*)(aq + t * 8); p.a1 = *(const u32x4*)(aq + (256 + t) * 8);
    p.elv = EL[(size_t)(dir * 520 + rb) * 512 + head * 128 + (t & 127)];
}
__device__ __forceinline__ void gla_scan(LAS unsigned char* lds, const bf16_t* P  , const bf16_t* QM, const bf16_t* KM, const bf16_t* AQ, const float* EL, bf16_t* OB  ) {
    const int tid = opaque_tid(), dir = __builtin_amdgcn_readfirstlane(tid >> 8);
    for (int unit = blockIdx.x; unit < 16; unit += gridDim.x) {
        const int b = unit >> 3, head = (unit >> 1) & 3, hf = unit & 1;
        f32x16 S[4];
#pragma unroll
        for (int kt = 0; kt < 4; ++kt)
#pragma unroll
            for (int x = 0; x < 16; ++x) S[kt][x] = 0.f;
        GlPre pre;
        { int rb0; bool f0; dn_step_rb(0, dir, b, rb0, f0); gl_prefetch(pre, P, QM, KM, AQ, EL, rb0, dir, head, hf, tid & 255); }
        __syncthreads();
        for (int step = 0; step < 260; ++step) {
            const int w = __builtin_amdgcn_readfirstlane((opaque_tid() >> 6) & 3);
            LAS unsigned char* base = lds + dir * GL_DIR;
            LAS bf16_t* Qm = (LAS bf16_t*)(base + GL_QM); LAS bf16_t* Km = (LAS bf16_t*)(base + GL_KM); LAS bf16_t* Vb = (LAS bf16_t*)(base + GL_VB); LAS bf16_t* Ab = (LAS bf16_t*)(base + GL_AB);
            LAS float* el = (LAS float*)(base + GL_EL);
            int rb; bool first; dn_step_rb(step, dir, b, rb, first);
            const int row_base = rb * 64;
            {
                const int tq_ = opaque_tid(), t = tq_ & 255;
                const int r0 = t >> 4, c8 = 8 * (t & 15);
#pragma unroll
                for (int v = 0; v < 4; ++v) { const int i = r0 + 16 * v, ip = dir ? 63 - i : i;
                    *(LAS u32x4*)(Qm + i * 136 + c8) = pre.q4[v]; *(LAS u32x4*)(Km + i * 136 + c8) = pre.k4[v]; *(LAS u32x4*)(Vb + ip * 136 + c8) = pre.v4[v]; }
                { const int c = t, row = c >> 3, cc = c & 7; *(LAS u32x4*)(Ab + row * 72 + 8 * cc) = pre.a0; }
                { const int c = 256 + t, row = c >> 3, cc = c & 7; *(LAS u32x4*)(Ab + row * 72 + 8 * cc) = pre.a1; }
                if (t < 128) el[t] = __expf(pre.elv);
            }
            BAR_LDS();
            if (step + 1 < 260) { int rbn; bool fn; dn_step_rb(step + 1, dir, b, rbn, fn); gl_prefetch(pre, P, QM, KM, AQ, EL, rbn, dir, head, hf, opaque_tid() & 255); }
            __builtin_amdgcn_sched_barrier(0);
            {
                const int tq_ = opaque_tid(), lane = tq_ & 63, r = lane & 31, h = lane >> 5;
#pragma unroll
                for (int kt = 0; kt < 4; ++kt)
#pragma unroll
                    for (int x = 0; x < 16; ++x) S[kt][x] *= el[32 * kt + crow(x, h)];
                bf16x8 Vf[4];
#pragma unroll
                for (int ks = 0; ks < 4; ++ks) Vf[ks] = frag_tr(Vb, 136, 32 * w, ks, lane);
                u32x4 eo[4];
                {
                    const int rr_ = lane >> 2, c8_ = 8 * (lane & 3);
                    if (!first) {
#pragma unroll
                        for (int v = 0; v < 4; ++v) { const int ip_ = rr_ + 16 * v, i_ = dir ? 63 - ip_ : ip_;
                            eo[v] = *(const u32x4*)(OB + (size_t)(row_base + i_) * 1024 + head * 256 + hf * 128 + 32 * w + c8_); }
                    } else {
                        unsigned z0 = 0u; asm volatile("" : "+v"(z0));
#pragma unroll
                        for (int v = 0; v < 4; ++v) eo[v] = (u32x4){z0, z0, z0, z0};
                    }
                }
                f32x16 O[2];
#pragma unroll
                for (int mt = 0; mt < 2; ++mt) {
#pragma unroll
                    for (int x = 0; x < 16; ++x) O[mt][x] = 0.f;
#pragma unroll
                    for (int ks = 0; ks < 4; ++ks) if (ks < 2 * mt + 2) O[mt] = MFMA32(frag_perm(Ab, 72, 32 * mt + r, ks, h), Vf[ks], O[mt]);
                }
                __builtin_amdgcn_sched_barrier(0);
#pragma unroll
                for (int ks = 0; ks < 8; ++ks) {
                    const bf16x8 sp = pack_step(S[ks >> 1], ks & 1);
#pragma unroll
                    for (int mt = 0; mt < 2; ++mt) O[mt] = MFMA32(frag_perm(Qm, 136, 32 * mt + r, ks, h), sp, O[mt]);
                    if (ks & 1) __builtin_amdgcn_sched_barrier(0);
                }
#pragma unroll
                for (int mt = 0; mt < 2; ++mt)
#pragma unroll
                    for (int x = 0; x < 16; ++x) Vb[(32 * mt + crow(x, h)) * 136 + 32 * w + r] = f2bf(O[mt][x]);
                __builtin_amdgcn_sched_barrier(0);
#pragma unroll
                for (int ks = 0; ks < 4; ++ks) {
#pragma unroll
                    for (int kt = 0; kt < 4; ++kt) S[kt] = MFMA32(frag_tr(Km, 136, 32 * kt, ks, lane), Vf[ks], S[kt]);
                    __builtin_amdgcn_sched_barrier(0);
                }
                {
                    const int rr_ = lane >> 2, c8_ = 8 * (lane & 3);
#pragma unroll
                    for (int v = 0; v < 4; ++v) { const int ip_ = rr_ + 16 * v, i_ = dir ? 63 - ip_ : ip_;
                        u32x4* gp_ = (u32x4*)(OB + (size_t)(row_base + i_) * 1024 + head * 256 + hf * 128 + 32 * w + c8_);
                        u32x4 o = *(const LAS u32x4*)(Vb + ip_ * 136 + 32 * w + c8_); const u32x4 e = eo[v];
                        if (!first) {
                            o.x = cvtpk_s(bf_lo(o.x) + bf_lo(e.x), bf_hi(o.x) + bf_hi(e.x)); o.y = cvtpk_s(bf_lo(o.y) + bf_lo(e.y), bf_hi(o.y) + bf_hi(e.y));
                            o.z = cvtpk_s(bf_lo(o.z) + bf_lo(e.z), bf_hi(o.z) + bf_hi(e.z)); o.w = cvtpk_s(bf_lo(o.w) + bf_lo(e.w), bf_hi(o.w) + bf_hi(e.w)); }
                        gp_[0] = o; }
                }
            }
            if (step == 1 || step == 131) asm volatile("s_waitcnt vmcnt(0)" ::: "memory");
            BAR_LDS();
        }
    }
}
typedef __bf16 v2bf_t __attribute__((ext_vector_type(2)));
__device__ __forceinline__ void atomic_add_bf16x8(bf16_t* p, const u32x4 v) {
    asm volatile("global_atomic_pk_add_bf16 %0, %1, off sc1\n\tglobal_atomic_pk_add_bf16 %0, %2, off offset:4 sc1\n\tglobal_atomic_pk_add_bf16 %0, %3, off offset:8 sc1\n\tglobal_atomic_pk_add_bf16 %0, %4, off offset:12 sc1"
                 :: "v"(p), "v"(v.x), "v"(v.y), "v"(v.z), "v"(v.w) : "memory");
}
constexpr int DN3_HGC = 2 * DN_DIR;
template <int VAR> __device__ __forceinline__ void dn_scan3(LAS unsigned char* lds, const bf16_t* P, const float* AB, const bf16_t* TP, bf16_t* OB) {
    const int tid0 = opaque_tid(), wv = __builtin_amdgcn_readfirstlane(tid0 >> 6), role = wv >> 2, w = wv & 3;
    for (int unit = blockIdx.x; unit < 64; unit += gridDim.x) {
        const int b = unit >> 5, vh = (unit >> 1) & 15, dir = unit & 1, kh = vh >> 1;
        __syncthreads();
        if (role == 1) {
            if (w < 3) {
                const int qh = w >= 1 ? 1 : 0, khh = w == 2 ? 1 : 0, ti = qh, tj = khh;
                u32x4 q8[8], k8[8]; float gcp;
                {
                    int rb; bool f_; dn_step_rb(0, dir, b, rb, f_);
                    const int lane = opaque_tid() & 63, r0 = lane >> 4, c8 = 8 * (lane & 15);
#pragma unroll
                    for (int v = 0; v < 8; ++v) { const int ipq = 32 * qh + r0 + 4 * v, ipk = 32 * khh + r0 + 4 * v, iq = dir ? 63 - ipq : ipq, ik = dir ? 63 - ipk : ipk;
                        q8[v] = *(const u32x4*)(P + (size_t)(rb * 64 + iq) * 4096 + kh * 128 + c8); k8[v] = *(const u32x4*)(P + (size_t)(rb * 64 + ik) * 4096 + 1024 + kh * 128 + c8); }
                    const int tl = dir ? 63 - lane : lane; gcp = AB[(size_t)(rb * 64 + tl) * 64 + dir * 16 + vh];
                }
                for (int j = 0; j < 260; ++j) {
                    const int lane = opaque_tid() & 63, r = lane & 31, h = lane >> 5, r0 = lane >> 4, c8 = 8 * (lane & 15);
                    LAS unsigned char* base = lds + (j & 1) * DN_DIR;
                    LAS bf16_t* Kb = (LAS bf16_t*)(base + DN_KB); LAS bf16_t* Qb = (LAS bf16_t*)(base + DN_QB); LAS bf16_t* Ab = (LAS bf16_t*)(base + DN_AB);
                    LAS float* hgc = (LAS float*)(lds + DN3_HGC + w * 256);
#pragma unroll
                    for (int v = 0; v < 8; ++v) { *(LAS u32x4*)(Qb + (32 * qh + r0 + 4 * v) * 136 + c8) = q8[v]; *(LAS u32x4*)(Kb + (32 * khh + r0 + 4 * v) * 136 + c8) = k8[v]; }
                    hgc[lane] = gcp;
                    asm volatile("s_waitcnt lgkmcnt(0)" ::: "memory");
                    if (j + 1 < 260) {
                        int rb; bool f_; dn_step_rb(j + 1, dir, b, rb, f_);
#pragma unroll
                        for (int v = 0; v < 8; ++v) { const int ipq = 32 * qh + r0 + 4 * v, ipk = 32 * khh + r0 + 4 * v, iq = dir ? 63 - ipq : ipq, ik = dir ? 63 - ipk : ipk;
                            q8[v] = *(const u32x4*)(P + (size_t)(rb * 64 + iq) * 4096 + kh * 128 + c8); k8[v] = *(const u32x4*)(P + (size_t)(rb * 64 + ik) * 4096 + 1024 + kh * 128 + c8); }
                        const int tl = dir ? 63 - lane : lane; gcp = AB[(size_t)(rb * 64 + tl) * 64 + dir * 16 + vh];
                    }
                    __builtin_amdgcn_sched_barrier(0);
                    {
                        f32x16 qk;
#pragma unroll
                        for (int x = 0; x < 16; ++x) qk[x] = 0.f;
#pragma unroll
                        for (int ks = 0; ks < 8; ++ks) qk = MFMA32(frag_nat(Qb, 136, 32 * ti + r, ks, h), frag_nat(Kb, 136, 32 * tj + r, ks, h), qk);
                        const int jj = 32 * tj + r; const float gj = hgc[jj];
#pragma unroll
                        for (int x = 0; x < 16; ++x) { const int i = 32 * ti + crow(x, h);
                            Ab[i * 72 + jj] = f2bf((i >= jj) ? qk[x] * __expf(hgc[i] - gj) : 0.f); }
                    }
                    BAR_LDS();
                }
                BAR_LDS();
            } else {
                u32x4 v16[16], t6[6]; float gcp, betap;
                {
                    int rb; bool f_; dn_step_rb(0, dir, b, rb, f_);
                    const int lane = opaque_tid() & 63, r0 = lane >> 4, c8 = 8 * (lane & 15);
#pragma unroll
                    for (int v = 0; v < 16; ++v) { const int ip = r0 + 4 * v, i = dir ? 63 - ip : ip; v16[v] = *(const u32x4*)(P + (size_t)(rb * 64 + i) * 4096 + 2048 + vh * 128 + c8); }
                    const bf16_t* tp = TP + (size_t)((rb * 16 + vh) * 2 + dir) * 3072;
#pragma unroll
                    for (int v = 0; v < 6; ++v) t6[v] = *(const u32x4*)(tp + (lane + 64 * v) * 8);
                    const int tl = dir ? 63 - lane : lane; const float* ab = AB + (size_t)(rb * 64 + tl) * 64; gcp = ab[dir * 16 + vh]; betap = ab[32 + dir * 16 + vh];
                }
                for (int j = 0; j < 260; ++j) {
                    const int lane = opaque_tid() & 63, r0 = lane >> 4, c8 = 8 * (lane & 15);
                    LAS unsigned char* base = lds + (j & 1) * DN_DIR;
                    LAS bf16_t* Vb = (LAS bf16_t*)(base + DN_VB); LAS bf16_t* Tb = (LAS bf16_t*)(base + DN_TB);
                    LAS float* sc_beta = (LAS float*)(base + DN_SC); LAS float* sc_gc = sc_beta + 64; LAS float* sc_eg = sc_beta + 128; LAS float* sc_tail = sc_beta + 192; LAS float* sc_dl = sc_beta + 256;
                    if (j >= 2) {
                        int rbo; bool fo_; dn_step_rb(j - 2, dir, b, rbo, fo_);
#pragma unroll
                        for (int v = 0; v < 16; ++v) { const int ip_ = r0 + 4 * v, i_ = dir ? 63 - ip_ : ip_;
                            atomic_add_bf16x8(OB + (size_t)(rbo * 64 + i_) * 2048 + vh * 128 + c8, *(const LAS u32x4*)(Vb + ip_ * 128 + c8)); }
                        asm volatile("s_waitcnt lgkmcnt(0)" ::: "memory");
                    }
#pragma unroll
                    for (int v = 0; v < 16; ++v) *(LAS u32x4*)(Vb + (r0 + 4 * v) * 128 + c8) = v16[v];
#pragma unroll
                    for (int v = 0; v < 6; ++v) { const int c = lane + 64 * v, blk = c >> 7, rowc = (c & 127) >> 2, cc = c & 3, br = blk ? 1 : 0, bc = blk == 2 ? 1 : 0;
                        *(LAS u32x4*)(Tb + (32 * br + rowc) * 72 + 32 * bc + 8 * cc) = t6[v]; }
                    { const float gc = gcp, gl = __shfl(gc, 63); sc_beta[lane] = betap; sc_gc[lane] = gc; sc_eg[lane] = __expf(gc); sc_tail[lane] = __expf(gl - gc); if (lane == 0) sc_dl[0] = __expf(gl); }
                    if (j + 1 < 260) {
                        int rb; bool f_; dn_step_rb(j + 1, dir, b, rb, f_);
#pragma unroll
                        for (int v = 0; v < 16; ++v) { const int ip = r0 + 4 * v, i = dir ? 63 - ip : ip; v16[v] = *(const u32x4*)(P + (size_t)(rb * 64 + i) * 4096 + 2048 + vh * 128 + c8); }
                        const bf16_t* tp = TP + (size_t)((rb * 16 + vh) * 2 + dir) * 3072;
#pragma unroll
                        for (int v = 0; v < 6; ++v) t6[v] = *(const u32x4*)(tp + (lane + 64 * v) * 8);
                        const int tl = dir ? 63 - lane : lane; const float* ab = AB + (size_t)(rb * 64 + tl) * 64; gcp = ab[dir * 16 + vh]; betap = ab[32 + dir * 16 + vh];
                    }
                    BAR_LDS();
                }
                {
                    const int lane = opaque_tid() & 63, r0 = lane >> 4, c8 = 8 * (lane & 15);
#pragma unroll 1
                    for (int jj = 258; jj < 260; ++jj) {
                        if (jj == 259) BAR_LDS();
                        LAS bf16_t* Vb = (LAS bf16_t*)(lds + (jj & 1) * DN_DIR + DN_VB);
                        int rbo; bool fo_; dn_step_rb(jj, dir, b, rbo, fo_);
#pragma unroll
                        for (int v = 0; v < 16; ++v) { const int ip_ = r0 + 4 * v, i_ = dir ? 63 - ip_ : ip_;
                            atomic_add_bf16x8(OB + (size_t)(rbo * 64 + i_) * 2048 + vh * 128 + c8, *(const LAS u32x4*)(Vb + ip_ * 128 + c8)); }
                    }
                }
            }
        } else {
            f32x16 S[4];
#pragma unroll
            for (int kt = 0; kt < 4; ++kt)
#pragma unroll
                for (int x = 0; x < 16; ++x) S[kt][x] = 0.f;
            BAR_LDS();
            for (int step = 0; step < 260; ++step) {
                const int lane = opaque_tid() & 63, r = lane & 31, h = lane >> 5;
                LAS unsigned char* base = lds + (step & 1) * DN_DIR;
                LAS bf16_t* Kb = (LAS bf16_t*)(base + DN_KB); LAS bf16_t* Qb = (LAS bf16_t*)(base + DN_QB); LAS bf16_t* Vb = (LAS bf16_t*)(base + DN_VB);
                LAS bf16_t* Tb = (LAS bf16_t*)(base + DN_TB); LAS bf16_t* Ab = (LAS bf16_t*)(base + DN_AB);
                LAS float* sc_beta = (LAS float*)(base + DN_SC); LAS float* sc_eg = sc_beta + 128; LAS float* sc_tail = sc_beta + 192; LAS float* sc_dl = sc_beta + 256;
                int rb; bool f_; dn_step_rb(step, dir, b, rb, f_);
                if (VAR != 2) {
                f32x16 KS[2], QS[2];
#pragma unroll
                for (int mt = 0; mt < 2; ++mt)
#pragma unroll
                    for (int x = 0; x < 16; ++x) { KS[mt][x] = 0.f; QS[mt][x] = 0.f; }
#pragma unroll
                for (int ks = 0; ks < 8; ++ks) {
                    const bf16x8 sp = pack_step(S[ks >> 1], ks & 1);
#pragma unroll
                    for (int mt = 0; mt < 2; ++mt) { KS[mt] = MFMA32(frag_perm(Kb, 136, 32 * mt + r, ks, h), sp, KS[mt]); QS[mt] = MFMA32(frag_perm(Qb, 136, 32 * mt + r, ks, h), sp, QS[mt]); }
                }
#pragma unroll
                for (int mt = 0; mt < 2; ++mt)
#pragma unroll
                    for (int g4 = 0; g4 < 4; ++g4) { const int i0 = 32 * mt + 8 * g4 + 4 * h;
                        const f32x4 bv = *(const LAS f32x4*)(sc_beta + i0), ev = *(const LAS f32x4*)(sc_eg + i0);
#pragma unroll
                        for (int e = 0; e < 4; ++e) { const int x = 4 * g4 + e; KS[mt][x] = bv[e] * (bf2f(Vb[(i0 + e) * 128 + 32 * w + r]) - ev[e] * KS[mt][x]); } }
                bf16x8 Xp[4];
#pragma unroll
                for (int ks = 0; ks < 4; ++ks) Xp[ks] = pack_step(KS[ks >> 1], ks & 1);
                f32x16 VN[2];
#pragma unroll
                for (int mt = 0; mt < 2; ++mt) {
#pragma unroll
                    for (int x = 0; x < 16; ++x) VN[mt][x] = 0.f;
#pragma unroll
                    for (int ks = 0; ks < 4; ++ks) if (ks < 2 * mt + 2) VN[mt] = MFMA32(frag_perm(Tb, 72, 32 * mt + r, ks, h), Xp[ks], VN[mt]);
                }
                bf16x8 VNp[4];
#pragma unroll
                for (int ks = 0; ks < 4; ++ks) VNp[ks] = pack_step(VN[ks >> 1], ks & 1);
#pragma unroll
                for (int mt = 0; mt < 2; ++mt) {
#pragma unroll
                    for (int g4 = 0; g4 < 4; ++g4) { const f32x4 ev = *(const LAS f32x4*)(sc_eg + 32 * mt + 8 * g4 + 4 * h);
#pragma unroll
                        for (int e = 0; e < 4; ++e) QS[mt][4 * g4 + e] *= ev[e]; }
#pragma unroll
                    for (int ks = 0; ks < 4; ++ks) if (ks < 2 * mt + 2) QS[mt] = MFMA32(frag_perm(Ab, 72, 32 * mt + r, ks, h), VNp[ks], QS[mt]);
                }
#pragma unroll
                for (int mt = 0; mt < 2; ++mt)
#pragma unroll
                    for (int x = 0; x < 16; ++x) Vb[(32 * mt + crow(x, h)) * 128 + 32 * w + r] = f2bf(QS[mt][x]);
#pragma unroll
                for (int mt = 0; mt < 2; ++mt)
#pragma unroll
                    for (int g4 = 0; g4 < 4; ++g4) { const f32x4 tv = *(const LAS f32x4*)(sc_tail + 32 * mt + 8 * g4 + 4 * h);
#pragma unroll
                        for (int e = 0; e < 4; ++e) VN[mt][4 * g4 + e] *= tv[e]; }
#pragma unroll
                for (int ks = 0; ks < 4; ++ks) VNp[ks] = pack_step(VN[ks >> 1], ks & 1);
                const float dl = sc_dl[0];
#pragma unroll
                for (int kt = 0; kt < 4; ++kt)
#pragma unroll
                    for (int x = 0; x < 16; ++x) S[kt][x] *= dl;
#pragma unroll
                for (int ks = 0; ks < 4; ++ks) {
#pragma unroll
                    for (int kt = 0; kt < 4; ++kt) S[kt] = MFMA32(frag_tr(Kb, 136, 32 * kt, ks, lane), VNp[ks], S[kt]);
                }
                }
                BAR_LDS();
            }
        }
    }
}
__device__ __forceinline__ void gla_scan3(LAS unsigned char* lds, bf16_t* P  , const bf16_t* QM, const bf16_t* KM, const bf16_t* AQ, const float* EL, bf16_t* OB  ) {
    const int tid0 = opaque_tid(), wv = __builtin_amdgcn_readfirstlane(tid0 >> 6), role = wv >> 2, w = wv & 3;
    for (int unit = blockIdx.x; unit < 32; unit += gridDim.x) {
        const int b = unit >> 4, head = (unit >> 2) & 3, hf = (unit >> 1) & 1, dir = unit & 1;
        __syncthreads();
        if (role == 1) {
            GlPre pre;
            { int rb0; bool f0; dn_step_rb(0, dir, b, rb0, f0); gl_prefetch(pre, P, QM, KM, AQ, EL, rb0, dir, head, hf, opaque_tid() & 255); }
            for (int j = 0; j < 260; ++j) {
                const int t = opaque_tid() & 255;
                LAS unsigned char* base = lds + (j & 1) * GL_DIR;
                LAS bf16_t* Qm = (LAS bf16_t*)(base + GL_QM); LAS bf16_t* Km = (LAS bf16_t*)(base + GL_KM); LAS bf16_t* Vb = (LAS bf16_t*)(base + GL_VB); LAS bf16_t* Ab = (LAS bf16_t*)(base + GL_AB);
                LAS float* el = (LAS float*)(base + GL_EL);
                const int r0 = t >> 4, c8 = 8 * (t & 15);
#pragma unroll
                for (int v = 0; v < 4; ++v) { const int i = r0 + 16 * v, ip = dir ? 63 - i : i;
                    *(LAS u32x4*)(Qm + i * 136 + c8) = pre.q4[v]; *(LAS u32x4*)(Km + i * 136 + c8) = pre.k4[v]; *(LAS u32x4*)(Vb + ip * 136 + c8) = pre.v4[v]; }
                { const int c = t, row = c >> 3, cc = c & 7; *(LAS u32x4*)(Ab + row * 72 + 8 * cc) = pre.a0; }
                { const int c = 256 + t, row = c >> 3, cc = c & 7; *(LAS u32x4*)(Ab + row * 72 + 8 * cc) = pre.a1; }
                if (t < 128) el[t] = __expf(pre.elv);
                if (j + 1 < 260) { int rbn; bool fn; dn_step_rb(j + 1, dir, b, rbn, fn); gl_prefetch(pre, P, QM, KM, AQ, EL, rbn, dir, head, hf, t); }
                BAR_LDS();
            }
            BAR_LDS();
        } else {
            f32x16 S[4];
#pragma unroll
            for (int kt = 0; kt < 4; ++kt)
#pragma unroll
                for (int x = 0; x < 16; ++x) S[kt][x] = 0.f;
            BAR_LDS();
            for (int step = 0; step < 260; ++step) {
                const int lane = opaque_tid() & 63, r = lane & 31, h = lane >> 5;
                LAS unsigned char* base = lds + (step & 1) * GL_DIR;
                LAS bf16_t* Qm = (LAS bf16_t*)(base + GL_QM); LAS bf16_t* Km = (LAS bf16_t*)(base + GL_KM); LAS bf16_t* Vb = (LAS bf16_t*)(base + GL_VB); LAS bf16_t* Ab = (LAS bf16_t*)(base + GL_AB);
                LAS float* el = (LAS float*)(base + GL_EL);
                int rb; bool f_; dn_step_rb(step, dir, b, rb, f_);
#pragma unroll
                for (int kt = 0; kt < 4; ++kt)
#pragma unroll
                    for (int g4 = 0; g4 < 4; ++g4) { const f32x4 ev = *(const LAS f32x4*)(el + 32 * kt + 8 * g4 + 4 * h);
#pragma unroll
                        for (int e = 0; e < 4; ++e) S[kt][4 * g4 + e] *= ev[e]; }
                bf16x8 Vf[4];
#pragma unroll
                for (int ks = 0; ks < 4; ++ks) Vf[ks] = frag_tr(Vb, 136, 32 * w, ks, lane);
                f32x16 O[2];
#pragma unroll
                for (int mt = 0; mt < 2; ++mt) {
#pragma unroll
                    for (int x = 0; x < 16; ++x) O[mt][x] = 0.f;
#pragma unroll
                    for (int ks = 0; ks < 4; ++ks) if (ks < 2 * mt + 2) O[mt] = MFMA32(frag_perm(Ab, 72, 32 * mt + r, ks, h), Vf[ks], O[mt]);
                }
                __builtin_amdgcn_sched_barrier(0);
#pragma unroll
                for (int ks = 0; ks < 8; ++ks) {
                    const bf16x8 sp = pack_step(S[ks >> 1], ks & 1);
#pragma unroll
                    for (int mt = 0; mt < 2; ++mt) O[mt] = MFMA32(frag_perm(Qm, 136, 32 * mt + r, ks, h), sp, O[mt]);
                    if (ks & 1) __builtin_amdgcn_sched_barrier(0);
                }
#pragma unroll
                for (int mt = 0; mt < 2; ++mt)
#pragma unroll
                    for (int x = 0; x < 16; ++x) Vb[(32 * mt + crow(x, h)) * 136 + 32 * w + r] = f2bf(O[mt][x]);
                __builtin_amdgcn_sched_barrier(0);
#pragma unroll
                for (int ks = 0; ks < 4; ++ks) {
#pragma unroll
                    for (int kt = 0; kt < 4; ++kt) S[kt] = MFMA32(frag_tr(Km, 136, 32 * kt, ks, lane), Vf[ks], S[kt]);
                    __builtin_amdgcn_sched_barrier(0);
                }
                asm volatile("s_waitcnt lgkmcnt(0)" ::: "memory");
                {
                    const int rr_ = lane >> 2, c8_ = 8 * (lane & 3);
#pragma unroll
                    for (int v = 0; v < 4; ++v) { const int ip_ = rr_ + 16 * v, i_ = dir ? 63 - ip_ : ip_; const int oc_ = head * 256 + hf * 128 + 32 * w + c8_;
                        bf16_t* dst_ = dir ? P + (size_t)(rb * 64 + i_) * 3072 + oc_ : OB + (size_t)(rb * 64 + i_) * 1024 + oc_;
                        *(u32x4*)dst_ = *(const LAS u32x4*)(Vb + ip_ * 136 + 32 * w + c8_); }
                }
                BAR_LDS();
            }
        }
    }
}
#define XB_TMO      128
#define XB_XCNT(j)  (256  + 64 * (j))
#define XB_XSUB(j)  (1280 + 64 * (j))
#define XB_XGEN(j)  (2304 + 64 * (j))
#define XB_TOP      3328
#define XB_TOPGEN   3392
#define XCD_BAR_WORDS 3456
#define XB_SPIN_CAP (1u << 23)

__device__ __forceinline__ unsigned xb_ld(unsigned* p)              { return __hip_atomic_load(p, __ATOMIC_RELAXED, __HIP_MEMORY_SCOPE_AGENT); }
__device__ __forceinline__ unsigned xb_add(unsigned* p, unsigned v) { return __hip_atomic_fetch_add(p, v, __ATOMIC_RELAXED, __HIP_MEMORY_SCOPE_AGENT); }
__device__ __forceinline__ unsigned xb_xcc_id() { return (unsigned)__builtin_amdgcn_s_getreg((3 << 11) | 20) & 0xFu; }
#define XB_SPIN(cond, bar) do { unsigned _sp = 0; while (cond) { __builtin_amdgcn_s_sleep(1); \
    if ((++_sp & 255u) == 0u) { if (xb_ld(&(bar)[XB_TMO])) break; if (_sp > XB_SPIN_CAP) { atomicAdd(&(bar)[XB_TMO], 1u); break; } } } } while (0)

struct XcdBarrier {
    unsigned* bar; unsigned x;
    volatile LAS unsigned* st;
};

__device__ __forceinline__ XcdBarrier xcd_barrier_post(unsigned* bar, volatile LAS unsigned* st) {
    XcdBarrier b; b.bar = bar; b.x = xb_xcc_id(); b.st = st;
    if (threadIdx.x == 0) (void)xb_add(&bar[XB_XCNT(b.x)], 1u);
    return b;
}
__device__ __forceinline__ void xcd_barrier_complete(unsigned* bar, unsigned x, unsigned& nloc, unsigned& nx) {
    const unsigned G = gridDim.x * gridDim.y * gridDim.z;
    unsigned sum, cnt, mine, sp = 0u;
    for (;;) {
        sum = 0u; cnt = 0u; mine = 0u;
#pragma unroll
        for (unsigned j = 0; j < 16; ++j) { const unsigned c = xb_ld(&bar[XB_XCNT(j)]); sum += c; cnt += (c > 0u) ? 1u : 0u; mine = (j == x) ? c : mine; }
        if (sum == G) break;
        __builtin_amdgcn_s_sleep(1);
        if ((++sp & 255u) == 0u) { if (xb_ld(&bar[XB_TMO])) break; if (sp > XB_SPIN_CAP) { atomicAdd(&bar[XB_TMO], 1u); break; } }
    }
    nloc = mine > 0u ? mine : 1u; nx = cnt > 0u ? cnt : 1u;
}

__device__ __forceinline__ void xcd_barrier(const XcdBarrier& b) {
    asm volatile("s_waitcnt vmcnt(0)" ::: "memory");
    __syncthreads();
    if (threadIdx.x == 0) {
        unsigned* bar = b.bar;
        __builtin_amdgcn_s_waitcnt(0);
        unsigned nloc = b.st[0], nx = b.st[1];
        if (nloc == 0u) { xcd_barrier_complete(bar, b.x, nloc, nx); b.st[0] = nloc; b.st[1] = nx; }
        const unsigned old = xb_add(&bar[XB_XSUB(b.x)], 1u);
        const unsigned gen = old / nloc;
        if (old + 1u == (gen + 1u) * nloc) {
            __builtin_amdgcn_fence(__ATOMIC_RELEASE, "agent");
            asm volatile("s_waitcnt vmcnt(0)" ::: "memory");
            const unsigned og = xb_add(&bar[XB_TOP], 1u);
            const unsigned tg = og / nx;
            if (og + 1u == (tg + 1u) * nx) xb_add(&bar[XB_TOPGEN], 1u);
            else XB_SPIN(xb_ld(&bar[XB_TOPGEN]) == tg, bar);
            __builtin_amdgcn_fence(__ATOMIC_ACQUIRE, "agent");
            xb_add(&bar[XB_XGEN(b.x)], 1u);
            asm volatile("s_waitcnt vmcnt(0)" ::: "memory");
        } else {
            XB_SPIN(xb_ld(&bar[XB_XGEN(b.x)]) == gen, bar);
            __builtin_amdgcn_fence(__ATOMIC_ACQUIRE, "agent");
            asm volatile("s_waitcnt vmcnt(0)" ::: "memory");
        }
    }
    __syncthreads();
}

#define DUP_DN 0
#define DN_VARIANT 0
#define DN_VAR_PARITY0 0
#define DUP_GLA 0
#define DUP_ATT 0
#define DUP_GIN 0
#define DUP_FFN1 0
constexpr unsigned long long pack_ops(const int* ops, int n) { unsigned long long v = 0; for (int i = 0; i < n; ++i) v |= (unsigned long long)ops[i] << (5 * i); return v; }
struct OpList { unsigned long long code; int n; };
constexpr OpList make_list(int mix) {
    int ops[16] = {}; int n = 0;
    ops[n++] = OP_PREP; ops[n++] = OP_GEMM_IN; if (DUP_GIN && mix != 0) ops[n++] = OP_GEMM_IN;
    if (mix == 0) { ops[n++] = OP_DNCONV; ops[n++] = OP_DNT; ops[n++] = OP_DNSCAN; if (DUP_DN) ops[n++] = OP_DNSCAN; ops[n++] = OP_DNREDO; ops[n++] = OP_GEMM_Z; }
    else if (mix == 1) { ops[n++] = OP_GLAPREP; ops[n++] = OP_GLASCAN; ops[n++] = OP_GLAGATE; }
    else { ops[n++] = OP_QKROPE; ops[n++] = OP_ATTN; if (DUP_ATT) ops[n++] = OP_ATTN; }
    ops[n++] = OP_GEMM_OUT; ops[n++] = OP_NORM2; ops[n++] = OP_FFN1; if (DUP_FFN1 && mix != 0) ops[n++] = OP_FFN1; ops[n++] = OP_FFN2;
    return OpList{pack_ops(ops, n), n};
}
constexpr OpList L_DN = make_list(0), L_GL = make_list(1), L_AT = make_list(2);
constexpr int NPHASE = 1 + 2 * L_DN.n + L_GL.n + L_AT.n;
__device__ __forceinline__ void decode_phase(int ph, int& layer, int& op) {
    if (ph == 0) { layer = 0; op = OP_MOD; return; }
    int p = ph - 1;
    if (p < L_DN.n) { layer = 0; op = (int)((L_DN.code >> (5 * p)) & 31ull); return; } p -= L_DN.n;
    if (p < L_GL.n) { layer = 1; op = (int)((L_GL.code >> (5 * p)) & 31ull); return; } p -= L_GL.n;
    if (p < L_AT.n) { layer = 2; op = (int)((L_AT.code >> (5 * p)) & 31ull); return; } p -= L_AT.n;
    layer = 3; op = (int)((L_DN.code >> (5 * p)) & 31ull);
}

__global__ void __launch_bounds__(512, 2) mega(Args args) {
    extern __shared__ __attribute__((aligned(16))) unsigned char lds_raw[];
    LAS unsigned char* lds = (LAS unsigned char*)lds_raw;
    cg::grid_group grid = cg::this_grid();
    volatile LAS unsigned* xb_st = (volatile LAS unsigned*)(lds + LDS_BYTES - 64);
    if (threadIdx.x < 2) xb_st[threadIdx.x] = 0u;
    __syncthreads();
    const XcdBarrier xbar = xcd_barrier_post((unsigned*)(args.ws + WS_BAR), xb_st);
    const int G = gridDim.x, NGW = G * 8;
    unsigned char* ws = args.ws;
    const float* x_in = args.in[0]; const float* c_in = args.in[1]; const float* ctx_in = args.in[2]; const float* cctx_in = args.in[3];
    const float* ada_w = args.in[4]; const float* ada_b = args.in[5]; const float* norm_mix_g = args.in[6]; const float* norm_ffn_g = args.in[7];
    const float* ffn_w1 = args.in[8]; const float* ffn_w2 = args.in[9];
    float* MOD = (float*)(ws + WS_MOD); float* CTXC = (float*)(ws + WS_CTX); bf16_t* H = (bf16_t*)(ws + WS_H); float* ABF = (float*)(ws + WS_AB); float* RSTD = (float*)(ws + WS_RSTD);
    bf16_t* PB = (bf16_t*)(ws + WS_P); float* out = args.out;

    for (int ph = args.ph_lo; ph < args.ph_hi; ++ph) {
        int layer, op; decode_phase(ph, layer, op);
        const int mix = layer % 3, slot = layer / 3;
        const float* modl = MOD + (size_t)layer * 3 * 6144;
        const float* xl = layer == 0 ? x_in : out; const float* xc = layer == 0 ? ctx_in : CTXC;
        if (op == OP_MOD) {
            const int tid = opaque_tid(), lane = tid & 63, wave = __builtin_amdgcn_readfirstlane(tid >> 6); const int gw = blockIdx.x * 8 + wave; (void)lane; (void)gw; (void)tid;
            LAS float* sl = (LAS float*)lds; LAS float* red = sl + 3 * 1024;
            for (int e = tid; e < 3 * 1024; e += 512) { const float v = e < 2048 ? c_in[e] : cctx_in[e - 2048]; sl[e] = silu_f(v); }
            __syncthreads();
            for (int item = blockIdx.x; item < 4 * 96; item += G) {
                const int ly = item / 96, col = (item % 96) * 64 + lane;
                const float* wp = ada_w + ((size_t)ly * 1024 + 128 * wave) * 6144 + col;
                float a0 = 0.f, a1 = 0.f, a2 = 0.f;
#pragma unroll 8
                for (int k = 0; k < 128; ++k) { const float wv = wp[(size_t)k * 6144]; const int kk = 128 * wave + k; a0 += sl[kk] * wv; a1 += sl[1024 + kk] * wv; a2 += sl[2048 + kk] * wv; }
                red[(wave * 3 + 0) * 64 + lane] = a0; red[(wave * 3 + 1) * 64 + lane] = a1; red[(wave * 3 + 2) * 64 + lane] = a2;
                __syncthreads();
                if (tid < 192) { const int m = tid >> 6; float s = ada_b[(size_t)ly * 6144 + col];
#pragma unroll
                    for (int w2 = 0; w2 < 8; ++w2) s += red[(w2 * 3 + m) * 64 + lane];
                    MOD[((size_t)ly * 3 + m) * 6144 + col] = s; }
                __syncthreads();
            }
        } else if (op == OP_PREP) {
            const int tid = opaque_tid(), lane = tid & 63, wave = __builtin_amdgcn_readfirstlane(tid >> 6); const int gw = blockIdx.x * 8 + wave; (void)lane; (void)gw; (void)tid;
            LAS float* scr = (LAS float*)(lds + wave * 16384);
            unsigned z0 = 0u; asm volatile("" : "+v"(z0)); const u32x4 zv = (u32x4){z0, z0, z0, z0};
            bf16_t* wtA = (bf16_t*)(ws + WT_A); bf16_t* wtZ = (bf16_t*)(ws + WT_Z); bf16_t* wtO = (bf16_t*)(ws + WT_O); bf16_t* wt1 = (bf16_t*)(ws + WT_1); bf16_t* wt2 = (bf16_t*)(ws + WT_2);
            if (mix == 0) {
                const float* w_in = args.in[10] + (size_t)slot * 1024 * 6208; const float* w_out = args.in[15] + (size_t)slot * 2048 * 1024;
                transpose_mat(w_in, 6208, 0, 4096, 1024, wtA, 0, scr, gw, NGW, lane);
                transpose_mat(w_in, 6208, 6144, 64, 1024, wtA, 4096, scr, gw, NGW, lane);
                for (size_t e = (size_t)blockIdx.x * 512 + tid; e < (size_t)192 * 1024 * 2 / 16; e += (size_t)G * 512) ((u32x4*)(wtA + (size_t)4160 * 1024))[e] = zv;
            } else if (mix == 1) {
                const float* w_in = args.in[16]; const float* w_out = args.in[20];
                transpose_mat(w_in, 3104, 0, 3104, 1024, wtA, 0, scr, gw, NGW, lane);
                for (size_t e = (size_t)blockIdx.x * 512 + tid; e < (size_t)224 * 1024 * 2 / 16; e += (size_t)G * 512) ((u32x4*)(wtA + (size_t)3104 * 1024))[e] = zv;
                transpose_mat(w_out, 1024, 0, 1024, 1024, wtO, 0, scr, gw, NGW, lane);
            } else {
                const float* w_in = args.in[21]; const float* w_out = args.in[24];
                transpose_mat(w_in, 1536, 0, 1536, 1024, wtA, 0, scr, gw, NGW, lane);
                transpose_mat(w_out, 1024, 0, 1024, 1024, wtO, 0, scr, gw, NGW, lane);
            }
            if (mix != 0) {
                transpose_mat(ffn_w1 + (size_t)layer * 1024 * 4096, 4096, 0, 4096, 1024, wt1, 0, scr, gw, NGW, lane);
                transpose_mat(ffn_w2 + (size_t)layer * 4096 * 1024, 1024, 0, 1024, 4096, wt2, 0, scr, gw, NGW, lane);
            }
            normmod_rows(xl, xc, norm_mix_g + (size_t)layer * 1024, modl, 0, H, gw, NGW, lane);
        } else if (op == OP_DNREDO) {
            const int tid = opaque_tid(), lane = tid & 63, wave = __builtin_amdgcn_readfirstlane(tid >> 6); const int gw = blockIdx.x * 8 + wave; (void)lane; (void)gw; (void)tid;
            LAS float* scr = (LAS float*)(lds + wave * 16384);
            const float* w_in = args.in[10] + (size_t)slot * 1024 * 6208; const float* w_out = args.in[15] + (size_t)slot * 2048 * 1024;
            transpose_mat(w_in, 6208, 4096, 2048, 1024, (bf16_t*)(ws + WT_Z), 0, scr, gw, NGW, lane);
            transpose_mat(w_out, 1024, 0, 1024, 2048, (bf16_t*)(ws + WT_O), 0, scr, gw, NGW, lane);
            transpose_mat(ffn_w1 + (size_t)layer * 1024 * 4096, 4096, 0, 4096, 1024, (bf16_t*)(ws + WT_1), 0, scr, gw, NGW, lane);
            transpose_mat(ffn_w2 + (size_t)layer * 4096 * 1024, 1024, 0, 1024, 4096, (bf16_t*)(ws + WT_2), 0, scr, gw, NGW, lane);
            normmod_rows(xl, xc, norm_mix_g + (size_t)layer * 1024, modl, 0, H, gw, NGW, lane);
            const bf16_t* OB = (const bf16_t*)(ws + WS_O);
            for (int row = gw; row < MROWS; row += NGW) {
                const u32x4* p = (const u32x4*)(OB + (size_t)row * 2048 + 32 * lane); float ss = 0.f;
#pragma unroll
                for (int v = 0; v < 4; ++v) { const u32x4 q = p[v]; const float a0 = bf_lo(q.x), a1 = bf_hi(q.x), a2 = bf_lo(q.y), a3 = bf_hi(q.y), a4 = bf_lo(q.z), a5 = bf_hi(q.z), a6 = bf_lo(q.w), a7 = bf_hi(q.w);
                    ss += (a0 * a0 + a1 * a1) + (a2 * a2 + a3 * a3) + (a4 * a4 + a5 * a5) + (a6 * a6 + a7 * a7); }
                ss += __shfl_xor(ss, 1); ss += __shfl_xor(ss, 2);
                if ((lane & 3) == 0) RSTD[(size_t)row * 16 + (lane >> 2)] = rsqrtf(ss * (1.f / 128.f) + EPS);
            }
        } else if (op == OP_DNHALO) {
            dn_halo_phase(PB, (bf16_t*)(ws + WS_HALO), G);
        } else if (op == OP_DNCONV) {
            dn_conv_phase(PB, (const bf16_t*)(ws + WS_HALO), args.in[11] + (size_t)slot * 4096 * 5, G);
        } else if (op == OP_DNT) {
            dn_t_phase(lds, PB, ABF, (bf16_t*)(ws + WS_TP), args.in[12] + (size_t)slot * 32, args.in[13] + (size_t)slot * 32, G);
            {
                unsigned z0 = 0u; asm volatile("" : "+v"(z0)); const u32x4 zv = (u32x4){z0, z0, z0, z0}; u32x4* zp = (u32x4*)(ws + WS_O);
                for (size_t e = (size_t)blockIdx.x * 512 + opaque_tid(); e < (size_t)MROWS * 2048 * 2 / 16; e += (size_t)G * 512) zp[e] = zv;
            }
        } else if (op == OP_NORM2) {
            const int tid = opaque_tid(), lane = tid & 63, wave = __builtin_amdgcn_readfirstlane(tid >> 6); const int gw = blockIdx.x * 8 + wave; (void)lane; (void)gw; (void)tid;
            normmod_rows(out, CTXC, norm_ffn_g + (size_t)layer * 1024, modl, 3, H, gw, NGW, lane);
        } else if (op == OP_GEMM_IN || op == OP_GEMM_Z || op == OP_GEMM_OUT || op == OP_FFN1 || op == OP_FFN2) {
            pg8::Gemm g; pg8::Epi E;
            E.mode = 0; E.O = PB; E.ldc = 4096; E.tail_pn = -1; E.halo = nullptr; E.F = ABF; E.ldf = 64; E.nf = 64; E.rstd = RSTD; E.ng = args.in[14] + (size_t)slot * 128;
            E.src_lat = xl; E.src_ctx = xc; E.dst_lat = out; E.dst_ctx = CTXC; E.mod = modl; E.gidx = 2;
            g.M = (layer == 3 && op != OP_GEMM_IN) ? NLAT : MROWS; g.A = H; g.K = 1024;
            bf16_t* OBUF = (bf16_t*)(ws + (mix == 1 ? WS_OGLA : WS_O));
            if (op == OP_GEMM_IN) {
                g.Bt = (const bf16_t*)(ws + WT_A);
                if (mix == 0) { g.N = 4352; E.ldc = 4096; E.tail_pn = 16; E.ldf = 64; E.nf = 64; E.halo = (bf16_t*)(ws + WS_HALO); }
                else if (mix == 1) { g.N = 3328; E.ldc = 3072; E.tail_pn = 12; E.ldf = 32; E.nf = 32; }
                else { g.N = 1536; E.ldc = 1536; }
            } else if (op == OP_GEMM_Z) {
                g.Bt = (const bf16_t*)(ws + WT_Z); g.N = 2048; E.mode = 2; E.O = OBUF; E.ldc = 2048;
            } else if (op == OP_GEMM_OUT) {
                g.A = OBUF; g.K = mix == 0 ? 2048 : 1024; g.Bt = (const bf16_t*)(ws + WT_O); g.N = 1024; E.mode = 3; E.gidx = 2;
            } else if (op == OP_FFN1) {
                g.Bt = (const bf16_t*)(ws + WT_1); g.N = 4096; E.mode = 1; E.ldc = 4096;
            } else {
                g.A = PB; g.K = 4096; g.Bt = (const bf16_t*)(ws + WT_2); g.N = 1024; E.mode = 3; E.gidx = 5; E.src_lat = out; E.src_ctx = CTXC;
            }
            pg8::StaticOrder S; S.init(g.M, g.N, G, (int)blockIdx.x);
#ifndef NO_GEMM
            pg8::gemm_phase<pg8::Epi, pg8::StaticOrder, true, true>(lds, g, S, E);
#endif
        } else if (op == OP_DNSCAN) {
#ifndef NO_DN
            if (DN_VARIANT && (ph & 1) == 0) dn_scan3<DN_VARIANT>(lds, PB, ABF, (const bf16_t*)(ws + WS_TP), (bf16_t*)(ws + WS_O)); else dn_scan3<0>(lds, PB, ABF, (const bf16_t*)(ws + WS_TP), (bf16_t*)(ws + WS_O));
#endif
        } else if (op == OP_GLAPREP) {
            gla_prep_phase(lds, PB, ABF, args.in[17], args.in[18], (bf16_t*)(ws + WS_QM), (bf16_t*)(ws + WS_KM), (bf16_t*)(ws + WS_AQ), (float*)(ws + WS_EL), G);
        } else if (op == OP_GLASCAN) {
#ifndef NO_GLA
            gla_scan3(lds, PB, (const bf16_t*)(ws + WS_QM), (const bf16_t*)(ws + WS_KM), (const bf16_t*)(ws + WS_AQ), (const float*)(ws + WS_EL), (bf16_t*)(ws + WS_OGLA));
#endif
        } else if (op == OP_GLAGATE) {
            const int tid = opaque_tid(), lane = tid & 63, wave = __builtin_amdgcn_readfirstlane(tid >> 6); const int gw = blockIdx.x * 8 + wave; (void)lane; (void)gw; (void)tid;
            bf16_t* OB = (bf16_t*)(ws + WS_OGLA); const float* ng = args.in[19];
            for (int row = gw; row < MROWS; row += NGW) {
                u32x4* p = (u32x4*)(OB + (size_t)row * 1024 + 16 * lane); const u32x4* gp = (const u32x4*)(PB + (size_t)row * 3072 + 2048 + 16 * lane); const u32x4* pb2 = (const u32x4*)(PB + (size_t)row * 3072 + 16 * lane);
                float o[16], z[16]; float ss = 0.f;
#pragma unroll
                for (int v = 0; v < 2; ++v) { const u32x4 q = p[v], gq = gp[v], q2 = pb2[v];
                    o[8 * v + 0] = bf_lo(q.x) + bf_lo(q2.x); o[8 * v + 1] = bf_hi(q.x) + bf_hi(q2.x); o[8 * v + 2] = bf_lo(q.y) + bf_lo(q2.y); o[8 * v + 3] = bf_hi(q.y) + bf_hi(q2.y); o[8 * v + 4] = bf_lo(q.z) + bf_lo(q2.z); o[8 * v + 5] = bf_hi(q.z) + bf_hi(q2.z); o[8 * v + 6] = bf_lo(q.w) + bf_lo(q2.w); o[8 * v + 7] = bf_hi(q.w) + bf_hi(q2.w);
                    z[8 * v + 0] = bf_lo(gq.x); z[8 * v + 1] = bf_hi(gq.x); z[8 * v + 2] = bf_lo(gq.y); z[8 * v + 3] = bf_hi(gq.y); z[8 * v + 4] = bf_lo(gq.z); z[8 * v + 5] = bf_hi(gq.z); z[8 * v + 6] = bf_lo(gq.w); z[8 * v + 7] = bf_hi(gq.w); }
#pragma unroll
                for (int e = 0; e < 16; ++e) ss += o[e] * o[e];
                ss += __shfl_xor(ss, 1); ss += __shfl_xor(ss, 2); ss += __shfl_xor(ss, 4); ss += __shfl_xor(ss, 8);
                const float rs = rsqrtf(ss * (1.f / 256.f) + EPS); const int cb = (16 * lane) & 255;
#pragma unroll
                for (int v = 0; v < 2; ++v) { float rr[8];
#pragma unroll
                    for (int e = 0; e < 8; ++e) rr[e] = o[8 * v + e] * rs * ng[cb + 8 * v + e] * silu_f(z[8 * v + e]);
                    u32x4 wv; wv.x = cvtpk_s(rr[0], rr[1]); wv.y = cvtpk_s(rr[2], rr[3]); wv.z = cvtpk_s(rr[4], rr[5]); wv.w = cvtpk_s(rr[6], rr[7]); p[v] = wv; }
            }
        } else if (op == OP_QKROPE) {
            const int tid = opaque_tid(), lane = tid & 63, wave = __builtin_amdgcn_readfirstlane(tid >> 6); const int gw = blockIdx.x * 8 + wave; (void)lane; (void)gw; (void)tid;
            bf16_t* QR = (bf16_t*)(ws + WS_QR); bf16_t* KR = (bf16_t*)(ws + WS_KR); bf16_t* VR = (bf16_t*)(ws + WS_VR);
            const float* qg = args.in[22]; const float* kg = args.in[23];
            const int hf = lane >> 5, j = lane & 31, e1 = 64 * hf + j, e2 = e1 + 32;
            const float inv_freq = exp2f(-(float)(2 * j) * (1.f / 64.f) * 13.287712379549449f);
            const float gq1 = qg[e1], gq2 = qg[e2], gk1 = kg[e1], gk2 = kg[e2];
            for (int row = gw; row < MROWS; row += NGW) {
                const bool lat = row < NLAT; const int b = lat ? row / SEQ : (row - NLAT) / CTXL; const int tpos = lat ? row % SEQ : (row - NLAT) % CTXL;
                float cs = 1.f, sn = 0.f;
                if (lat) { const float pos = (float)(hf == 0 ? tpos / 64 : tpos % 64); const float ang = pos * inv_freq; sn = sinf(ang); cs = cosf(ang); }
                const bf16_t* pr = PB + (size_t)row * 1536; const int kpos = lat ? tpos : SEQ + tpos;
#pragma unroll
                for (int hd = 0; hd < 10; ++hd) {
                    const float x1 = bf2f(pr[hd * 128 + e1]), x2 = bf2f(pr[hd * 128 + e2]);
                    const float rinv = rsqrtf(wave_sum(x1 * x1 + x2 * x2) * (1.f / 128.f) + EPS);
                    const float y1 = x1 * rinv * (hd < 8 ? gq1 : gk1), y2 = x2 * rinv * (hd < 8 ? gq2 : gk2);
                    const float o1 = y1 * cs - y2 * sn, o2 = y1 * sn + y2 * cs;
                    bf16_t* dst = hd < 8 ? QR + (size_t)row * 1024 + hd * 128 : KR + ((size_t)(b * 2 + (hd - 8)) * SKV + kpos) * 128;
                    dst[e1] = f2bf(o1); dst[e2] = f2bf(o2);
                }
#pragma unroll
                for (int kv = 0; kv < 2; ++kv) { bf16_t* dst = VR + ((size_t)(b * 2 + kv) * SKV + kpos) * 128; dst[e1] = pr[1280 + kv * 128 + e1]; dst[e2] = pr[1280 + kv * 128 + e2]; }
            }
        } else if (op == OP_ATTN) {
            const attn::bf16* QR = (const attn::bf16*)(ws + WS_QR); const attn::bf16* KR = (const attn::bf16*)(ws + WS_KR); const attn::bf16* VR = (const attn::bf16*)(ws + WS_VR);
            attn::bf16* OB = (attn::bf16*)(ws + WS_O);
            for (int u = blockIdx.x; u < 1024 + 16; u += G) {
                size_t qoff, koff; int seq;
                if (u < 1024) { const int pair = u >> 8, b = pair >> 1, kvh = pair & 1, hh = (u >> 6) & 3, qb = u & 63, head = kvh * 4 + hh;
                    qoff = ((size_t)b * SEQ + (size_t)qb * 256) * 1024 + head * 128; koff = (size_t)(b * 2 + kvh) * SKV * 128; seq = SKV; }
                else { const int jx = u - 1024, b = jx >> 3, head = jx & 7, kvh = head >> 2;
                    qoff = ((size_t)NLAT + (size_t)b * CTXL) * 1024 + head * 128; koff = ((size_t)(b * 2 + kvh) * SKV + SEQ) * 128; seq = CTXL; }
                __syncthreads();
#ifndef NO_ATT
                attn::attn_dense_body<attn::bf16>(QR + qoff, KR + koff, VR + koff, OB + qoff, seq, (char*)lds_raw);
#endif
            }
        }
        if (ph + 1 < args.ph_hi) { if (ph == 0) grid.sync(); else xcd_barrier(xbar); }
    }
}

#ifndef MK_MULTI
#define MK_MULTI 0
#endif
extern "C" void kernel_launch(void* const* d_in, const int* in_sizes, int n_in, void* d_out, int out_size, void* d_ws, size_t ws_size, hipStream_t stream) {
    static int grid = 0;
    if (grid == 0) {
        if (n_in != 25 || ws_size < WS_END) { fprintf(stderr, "kernel_launch: unexpected n_in %d / ws_size %zu (need %zu)\n", n_in, ws_size, (size_t)WS_END); grid = -1; return; }
        int dev = 0, cus = 0, per_cu = 0;
        hipGetDevice(&dev); hipDeviceGetAttribute(&cus, hipDeviceAttributeMultiprocessorCount, dev);
        if (hipFuncSetAttribute((const void*)mega, hipFuncAttributeMaxDynamicSharedMemorySize, LDS_BYTES) != hipSuccess) { fprintf(stderr, "kernel_launch: hipFuncSetAttribute failed\n"); grid = -1; return; }
        if (hipOccupancyMaxActiveBlocksPerMultiprocessor(&per_cu, (const void*)mega, 512, LDS_BYTES) != hipSuccess || per_cu < 1) { fprintf(stderr, "kernel_launch: occupancy query says %d\n", per_cu); per_cu = 1; }
        (void)hipGetLastError();
        grid = cus * 1;
    }
    if (grid < 0) return;
    if (hipMemsetAsync((char*)d_ws + WS_BAR, 0, WS_BAR_BYTES, stream) != hipSuccess) { fprintf(stderr, "kernel_launch: memset of barrier words failed\n"); return; }
    Args a{};
    for (int i = 0; i < 25; ++i) a.in[i] = (const float*)d_in[i];
    a.out = (float*)d_out; a.ws = (unsigned char*)d_ws;
#if MK_MULTI
    for (int ph = 0; ph < NPHASE; ++ph) { a.ph_lo = ph; a.ph_hi = ph + 1; hipLaunchKernelGGL(mega, dim3(grid), dim3(512), LDS_BYTES, stream, a); }
#else
    a.ph_lo = 0; a.ph_hi = NPHASE;
    void* kargs[] = {&a};
    hipError_t e = hipLaunchCooperativeKernel((const void*)mega, dim3(grid), dim3(512), kargs, LDS_BYTES, stream);
    if (e != hipSuccess) fprintf(stderr, "cooperative launch failed: %s (grid %d)\n", hipGetErrorString(e), grid);
#endif
}
```

```cpp
#include <hip/hip_runtime.h>
#include <hip/hip_bf16.h>
#include <hip/hip_cooperative_groups.h>
#include <cstdio>
#include <cstdint>
namespace cg = cooperative_groups;
__device__ __forceinline__ int opaque_tid() { int t = threadIdx.x; asm volatile("" : "+v"(t)); return t; }
namespace pg8 {
#define PG8_LAS __attribute__((address_space(3)))
typedef unsigned short bf16_t;
typedef short bf16x8 __attribute__((ext_vector_type(8)));
typedef float f32x4 __attribute__((ext_vector_type(4)));
typedef unsigned u32x4 __attribute__((ext_vector_type(4)));
constexpr int BM = 256, BK = 64, HALF = 128, HTB = HALF * BK * 2  , STAGE_BYTES = 8 * HTB, NXCD = 8, WGM = 8;

__host__ __device__ __forceinline__ int lds_byte(int r, int c) { const int st = (r >> 4) * 2 + (c >> 5), rr = r & 15, cc = c & 31, ob = rr * 64 + cc * 2; return st * 1024 + (ob ^ (((ob >> 9) & 1) << 5)); }
__host__ __device__ __forceinline__ void stage_rc(int b, int& R, int& C) { const int st = b / 1024, sb = b % 1024, swz = sb ^ (((sb >> 9) & 1) << 5); R = (st >> 1) * 16 + swz / 64; C = (st & 1) * 32 + (swz % 64) / 2; }
__host__ __device__ __forceinline__ int perm32(int rho) { const int n = rho >> 4, i = rho & 15; return 8 * (i >> 2) + 4 * n + (i & 3); }

struct Unit { int pm, pn; };
struct Gemm { const bf16_t* A; const bf16_t* Bt; int M, N, K; };

struct StaticOrder {
    int nM, nN, nwg, G, c;
    __host__ __device__ void init(int M, int N, int G_, int c_) { nM = M / BM; nN = N / BM; nwg = nM * nN; G = G_; c = c_; }
    __host__ __device__ bool next(int i, Unit& u) const {
        const long L = (long)i * G + c; if (L >= nwg) return false;
        int wgid = (int)L; { const int q = nwg / NXCD, r = nwg % NXCD, xcd = wgid % NXCD, off = wgid / NXCD; wgid = (xcd < r ? xcd * (q + 1) : r * (q + 1) + (xcd - r) * q) + off; }
        const int nig = WGM * nN, gid = wgid / nig, fm = gid * WGM, gsz = (nM - fm) < WGM ? (nM - fm) : WGM;
        u.pm = fm + ((wgid % nig) % gsz); u.pn = (wgid % nig) / gsz; return true;
    }
    __device__ __forceinline__ void a_ready(const Unit&) const {}
    __device__ __forceinline__ void done(const Unit&) const {}
};

__device__ __forceinline__ unsigned cvt_pk_bf16(float lo, float hi) { unsigned r; asm volatile("v_cvt_pk_bf16_f32 %0, %1, %2" : "=v"(r) : "v"(lo), "v"(hi)); return r; }
typedef float f32x2 __attribute__((ext_vector_type(2)));
typedef float f32x2_t __attribute__((ext_vector_type(2))); typedef __bf16 bf16x2_t __attribute__((ext_vector_type(2)));
__device__ __forceinline__ unsigned cvtpk_s(float lo, float hi) { f32x2_t v = {lo, hi}; bf16x2_t b = __builtin_convertvector(v, bf16x2_t); return __builtin_bit_cast(unsigned, b); }
__device__ __forceinline__ float bf_lo(unsigned w) { return __builtin_bit_cast(float, w << 16); }
__device__ __forceinline__ float bf_hi(unsigned w) { return __builtin_bit_cast(float, w & 0xffff0000u); }
__device__ __forceinline__ float silu_f(float z) { return z / (1.f + __expf(-z)); }
struct Epi {
    static constexpr bool PERM = true, AFTER_DRAIN = false;
    int mode;
    bf16_t* O; int ldc;
    int tail_pn; float* F; int ldf, nf;
    bf16_t* halo;
    const float* rstd; const float* ng;
    const float* src_lat; const float* src_ctx; float* dst_lat; float* dst_ctx; const float* mod; int gidx;
    __device__ __forceinline__ void operator()(const f32x4 (&acc)[2][2][4][2], const Unit& u, int wr, int wc, int fr, int fq) const {
        const int row0 = u.pm * BM + wr * 64 + fr; const int col0 = u.pn * BM + wc * 32 + 8 * fq;
        if (mode <= 1) {
            if (u.pn == tail_pn) {
                const int c0 = wc * 32 + 8 * fq;
#pragma unroll
                for (int ai = 0; ai < 2; ++ai)
#pragma unroll
                    for (int m = 0; m < 4; ++m)
#pragma unroll
                        for (int bj = 0; bj < 2; ++bj) { const int cc = c0 + bj * HALF;
                            if (cc < nf) { float* p = F + (size_t)(row0 + ai * HALF + m * 16) * ldf + cc; *(f32x4*)p = acc[ai][bj][m][0]; *(f32x4*)(p + 4) = acc[ai][bj][m][1]; } }
            } else {
#pragma unroll
                for (int ai = 0; ai < 2; ++ai)
#pragma unroll
                    for (int m = 0; m < 4; ++m) { bf16_t* rowp = O + (size_t)(row0 + ai * HALF + m * 16) * ldc + col0;
#pragma unroll
                        for (int bj = 0; bj < 2; ++bj) { f32x4 v0 = acc[ai][bj][m][0], v1 = acc[ai][bj][m][1];
                            if (mode == 1) {
#pragma unroll
                                for (int e = 0; e < 4; ++e) { float a = fmaxf(v0[e], 0.f), b = fmaxf(v1[e], 0.f); v0[e] = a * a; v1[e] = b * b; } }
                            u32x4 w; w.x = cvtpk_s(v0[0], v0[1]); w.y = cvtpk_s(v0[2], v0[3]); w.z = cvtpk_s(v1[0], v1[1]); w.w = cvtpk_s(v1[2], v1[3]);
                            *(u32x4*)(rowp + bj * HALF) = w;
                            if (halo && ((m == 0 && fr < 2) || (m == 3 && fr >= 14))) { const int row = row0 + ai * HALF + m * 16; const int j = m == 0 ? fr : fr - 12;
                                *(u32x4*)(halo + ((size_t)(row >> 6) * 4 + j) * ldc + col0 + bj * HALF) = w; } } }
            }
        } else if (mode == 2) {
            const f32x4 g0 = *(const f32x4*)(ng + (col0 & 127)), g1 = *(const f32x4*)(ng + (col0 & 127) + 4);
#pragma unroll
            for (int ai = 0; ai < 2; ++ai)
#pragma unroll
                for (int m = 0; m < 4; ++m) { const int row = row0 + ai * HALF + m * 16; bf16_t* rowp = O + (size_t)row * ldc + col0;
#pragma unroll
                    for (int bj = 0; bj < 2; ++bj) { const float rs = rstd[(size_t)row * 16 + ((col0 + bj * HALF) >> 7)];
                        const u32x4 ov = *(const u32x4*)(rowp + bj * HALF); const f32x4 z0 = acc[ai][bj][m][0], z1 = acc[ai][bj][m][1];
                        float r[8];
                        r[0] = bf_lo(ov.x) * rs * g0[0] * silu_f(z0[0]); r[1] = bf_hi(ov.x) * rs * g0[1] * silu_f(z0[1]);
                        r[2] = bf_lo(ov.y) * rs * g0[2] * silu_f(z0[2]); r[3] = bf_hi(ov.y) * rs * g0[3] * silu_f(z0[3]);
                        r[4] = bf_lo(ov.z) * rs * g1[0] * silu_f(z1[0]); r[5] = bf_hi(ov.z) * rs * g1[1] * silu_f(z1[1]);
                        r[6] = bf_lo(ov.w) * rs * g1[2] * silu_f(z1[2]); r[7] = bf_hi(ov.w) * rs * g1[3] * silu_f(z1[3]);
                        u32x4 w; w.x = cvtpk_s(r[0], r[1]); w.y = cvtpk_s(r[2], r[3]); w.z = cvtpk_s(r[4], r[5]); w.w = cvtpk_s(r[6], r[7]);
                        *(u32x4*)(rowp + bj * HALF) = w; } }
        } else {
            const int mi = u.pm < 64 ? 0 : (u.pm < 128 ? 1 : 2);
            const float* gate = mod + (size_t)mi * 6144 + (size_t)gidx * 1024;
            const bool lat = u.pm < 128;
            const float* sb = lat ? src_lat : src_ctx - (size_t)32768 * 1024; float* db = lat ? dst_lat : dst_ctx - (size_t)32768 * 1024;
#pragma unroll
            for (int bj = 0; bj < 2; ++bj)
#pragma unroll
                for (int n = 0; n < 2; ++n) { const int c = col0 + bj * HALF + 4 * n; const f32x4 gv = *(const f32x4*)(gate + c);
#pragma unroll
                    for (int ai = 0; ai < 2; ++ai)
#pragma unroll
                        for (int m = 0; m < 4; ++m) { const size_t off = (size_t)(row0 + ai * HALF + m * 16) * 1024 + c;
                            const f32x4 s = *(const f32x4*)(sb + off); *(f32x4*)(db + off) = s + gv * acc[ai][bj][m][n]; } }
        }
    }
};
template <class Epi, class Sched, bool ALIGN_EPI = false, bool SP2 = false>
__device__ __forceinline__ void gemm_phase(PG8_LAS unsigned char* lds, const Gemm g, const Sched& S, const Epi& E) {
    const int tid = opaque_tid(), wid = __builtin_amdgcn_readfirstlane(tid >> 6), lane = tid & 63, wr = wid >> 2, wc = wid & 3, fr = lane & 15, fq = lane >> 4;
    const int K = g.K, nt = K / BK;
    unsigned voffA[2], voffB[2];
#pragma unroll
    for (int i = 0; i < 2; ++i) { int R, C; stage_rc(tid * 16 + i * 8192, R, C); const int Rb = Epi::PERM ? ((R & ~31) + perm32(R & 31)) : R;
        voffA[i] = (unsigned)(R * K + C) * 2u; voffB[i] = (unsigned)(Rb * K + C) * 2u; }
    const size_t kstep = (size_t)(BK * 2);
    const size_t hstep = (size_t)HALF * K * 2;
    const size_t tstep = 2 * hstep;
    const unsigned ldsw = (unsigned)wid * 1024u;
    const int aoff = lds_byte(wr * 64 + fr, fq * 8), boff = lds_byte(wc * 32 + fr, fq * 8);
#define PG8_SA(b, h) (((b) * 2 + (h)) * HTB)
#define PG8_SB(b, h) ((4 + (b) * 2 + (h)) * HTB)
#define PG8_STAGE(bufoff, gbase, voff) do { _Pragma("unroll") for (int _i = 0; _i < 2; ++_i) \
        __builtin_amdgcn_global_load_lds((const unsigned*)((const char*)(gbase) + (voff)[_i]), (PG8_LAS unsigned*)(lds + (bufoff) + ldsw + _i * 8192), 16, 0, 0); } while (0)
#define PG8_LDA(dst, b, h) do { _Pragma("unroll") for (int m = 0; m < 4; ++m) _Pragma("unroll") for (int k = 0; k < 2; ++k) dst[m][k] = *(const PG8_LAS bf16x8*)(lds + PG8_SA(b, h) + aoff + m * 2048 + k * 1024); } while (0)
#define PG8_LDB(dst, b, h) do { _Pragma("unroll") for (int n = 0; n < 2; ++n) _Pragma("unroll") for (int k = 0; k < 2; ++k) dst[n][k] = *(const PG8_LAS bf16x8*)(lds + PG8_SB(b, h) + boff + n * 2048 + k * 1024); } while (0)
#define PG8_MMA(ai, bj, At, Bt) do { __builtin_amdgcn_s_setprio(1); _Pragma("unroll") for (int m = 0; m < 4; ++m) _Pragma("unroll") for (int n = 0; n < 2; ++n) _Pragma("unroll") for (int k = 0; k < 2; ++k) \
        acc[ai][bj][m][n] = __builtin_amdgcn_mfma_f32_16x16x32_bf16(Bt[n][k], At[m][k], acc[ai][bj][m][n], 0, 0, 0); __builtin_amdgcn_s_setprio(0); } while (0)
#define PG8_WAIT_V(n) asm volatile("s_waitcnt vmcnt(" #n ")" ::: "memory")
#define PG8_WAIT_L(n) asm volatile("s_waitcnt lgkmcnt(" #n ")" ::: "memory")
#define PG8_BAR __builtin_amdgcn_s_barrier()
#define PG8_SCHED __builtin_amdgcn_sched_barrier(0)
    Unit cur, nxt; int ui = 0;
    if (!S.next(0, cur)) return;
    f32x4 acc[2][2][4][2];
#pragma unroll
    for (int a = 0; a < 2; ++a)
#pragma unroll
        for (int b = 0; b < 2; ++b)
#pragma unroll
            for (int m = 0; m < 4; ++m)
#pragma unroll
                for (int n = 0; n < 2; ++n) acc[a][b][m][n] = (f32x4){0.f, 0.f, 0.f, 0.f};
    bf16x8 At[4][2], B0[2][2], B1[2][2];
    const char* cA = (const char*)g.A + (size_t)cur.pm * tstep; const char* cB = (const char*)g.Bt + (size_t)cur.pn * tstep;
    S.a_ready(cur);
    if constexpr (SP2) {
        PG8_STAGE(PG8_SB(0, 0), cB, voffB); PG8_STAGE(PG8_SB(0, 1), cB + hstep, voffB); PG8_STAGE(PG8_SA(0, 0), cA, voffA); PG8_STAGE(PG8_SA(0, 1), cA + hstep, voffA);
        if (wr == 1) PG8_BAR;
        PG8_WAIT_V(2); PG8_BAR;
        PG8_STAGE(PG8_SB(1, 0), cB + kstep, voffB); PG8_STAGE(PG8_SA(1, 0), cA + kstep, voffA); PG8_STAGE(PG8_SB(1, 1), cB + hstep + kstep, voffB);
        PG8_WAIT_V(6); PG8_BAR;
    } else {
        PG8_STAGE(PG8_SB(0, 0), cB, voffB); PG8_STAGE(PG8_SA(0, 0), cA, voffA); PG8_STAGE(PG8_SB(0, 1), cB + hstep, voffB); PG8_STAGE(PG8_SA(0, 1), cA + hstep, voffA);
        if (wr == 1) PG8_BAR;
        PG8_WAIT_V(4); PG8_BAR;
        PG8_STAGE(PG8_SB(1, 0), cB + kstep, voffB); PG8_STAGE(PG8_SA(1, 0), cA + kstep, voffA); PG8_STAGE(PG8_SB(1, 1), cB + hstep + kstep, voffB);
        PG8_WAIT_V(6); PG8_BAR;
    }
    for (;;) {
        const bool has_next = S.next(ui + 1, nxt);
        const char* nA = has_next ? (const char*)g.A + (size_t)nxt.pm * tstep : cA; const char* nB = has_next ? (const char*)g.Bt + (size_t)nxt.pn * tstep : cB;
        for (int t = 0; t < nt; t += 2) {
            const bool last = (t == nt - 2);
            const char* a1 = cA + (size_t)(t + 1) * kstep;
            const char* a2 = last ? nA : cA + (size_t)(t + 2) * kstep; const char* b2 = last ? nB : cB + (size_t)(t + 2) * kstep;
            const char* a3 = a2 + kstep; const char* b3 = b2 + kstep;
            if (last && has_next) S.a_ready(nxt);
            if constexpr (SP2) {
            PG8_LDB(B0, 0, 0); PG8_LDB(B1, 0, 1); PG8_SCHED; PG8_LDA(At, 0, 0); PG8_STAGE(PG8_SA(1, 1), a1 + hstep, voffA);
            PG8_WAIT_V(8); PG8_WAIT_L(0); PG8_BAR; PG8_MMA(0, 0, At, B0); PG8_MMA(0, 1, At, B1); PG8_BAR; PG8_SCHED;
            PG8_LDA(At, 0, 1); PG8_STAGE(PG8_SB(0, 0), b2, voffB); PG8_STAGE(PG8_SB(0, 1), b2 + hstep, voffB); PG8_STAGE(PG8_SA(0, 0), a2, voffA);
            PG8_WAIT_V(8); PG8_WAIT_L(0); PG8_BAR; PG8_MMA(1, 0, At, B0); PG8_MMA(1, 1, At, B1); PG8_BAR; PG8_SCHED;
            PG8_LDB(B0, 1, 0); PG8_LDB(B1, 1, 1); PG8_SCHED; PG8_LDA(At, 1, 0); PG8_STAGE(PG8_SA(0, 1), a2 + hstep, voffA);
            PG8_WAIT_V(8); PG8_WAIT_L(0); PG8_BAR; PG8_MMA(0, 0, At, B0); PG8_MMA(0, 1, At, B1); PG8_BAR; PG8_SCHED;
            PG8_LDA(At, 1, 1); PG8_STAGE(PG8_SB(1, 0), b3, voffB); PG8_STAGE(PG8_SB(1, 1), b3 + hstep, voffB); PG8_STAGE(PG8_SA(1, 0), a3, voffA);
            PG8_WAIT_V(8); PG8_WAIT_L(0); PG8_BAR; PG8_MMA(1, 0, At, B0); PG8_MMA(1, 1, At, B1); PG8_BAR; PG8_SCHED;
            } else {
            PG8_LDB(B0, 0, 0); PG8_SCHED; PG8_LDA(At, 0, 0); PG8_STAGE(PG8_SA(1, 1), a1 + hstep, voffA);
            PG8_WAIT_L(8); PG8_BAR; PG8_WAIT_L(0); PG8_MMA(0, 0, At, B0); PG8_BAR; PG8_SCHED;
            PG8_LDB(B1, 0, 1); PG8_STAGE(PG8_SB(0, 0), b2, voffB);
            PG8_BAR; PG8_WAIT_L(0); PG8_MMA(0, 1, At, B1); PG8_BAR;
            PG8_LDA(At, 0, 1); PG8_STAGE(PG8_SA(0, 0), a2, voffA);
            PG8_BAR; PG8_WAIT_L(0); PG8_MMA(1, 0, At, B0); PG8_BAR; PG8_SCHED;
            PG8_STAGE(PG8_SB(0, 1), b2 + hstep, voffB);
            PG8_WAIT_V(6); PG8_BAR; PG8_MMA(1, 1, At, B1); PG8_BAR;
            PG8_LDB(B0, 1, 0); PG8_SCHED; PG8_LDA(At, 1, 0); PG8_STAGE(PG8_SA(0, 1), a2 + hstep, voffA);
            PG8_WAIT_L(8); PG8_BAR; PG8_WAIT_L(0); PG8_MMA(0, 0, At, B0); PG8_BAR; PG8_SCHED;
            PG8_LDB(B1, 1, 1); PG8_STAGE(PG8_SB(1, 0), b3, voffB);
            PG8_BAR; PG8_WAIT_L(0); PG8_MMA(0, 1, At, B1); PG8_BAR;
            PG8_LDA(At, 1, 1); PG8_STAGE(PG8_SA(1, 0), a3, voffA);
            PG8_BAR; PG8_WAIT_L(0); PG8_MMA(1, 0, At, B0); PG8_BAR; PG8_SCHED;
            PG8_STAGE(PG8_SB(1, 1), b3 + hstep, voffB);
            PG8_WAIT_V(6); PG8_BAR; PG8_MMA(1, 1, At, B1); PG8_BAR;
            }
        }
        if constexpr (ALIGN_EPI) { if (wr == 0) PG8_BAR; }
        if constexpr (!Epi::AFTER_DRAIN) { E(acc, cur, wr, wc, fr, fq); S.done(cur); }
        if (!has_next) break;
#pragma unroll
        for (int a = 0; a < 2; ++a)
#pragma unroll
            for (int b = 0; b < 2; ++b)
#pragma unroll
                for (int m = 0; m < 4; ++m)
#pragma unroll
                    for (int n = 0; n < 2; ++n) acc[a][b][m][n] = (f32x4){0.f, 0.f, 0.f, 0.f};
        cur = nxt; cA = nA; cB = nB; ++ui;
        if constexpr (ALIGN_EPI) { if (wr == 1) PG8_BAR; }
    }
    PG8_WAIT_V(0);
    if constexpr (!ALIGN_EPI) { if (wr == 0) PG8_BAR; }
    PG8_BAR;
    if constexpr (Epi::AFTER_DRAIN) { E.fused(acc, cur, wr, wc, fr, fq, lds, wid, lane); S.done(cur); }
#undef PG8_SA
#undef PG8_SB
#undef PG8_STAGE
#undef PG8_LDA
#undef PG8_LDB
#undef PG8_MMA
#undef PG8_WAIT_V
#undef PG8_WAIT_L
#undef PG8_BAR
#undef PG8_SCHED
}
}
namespace attn {
using bf16 = __hip_bfloat16;
constexpr int   D = 128, NW = 8, QBLK = 32, KVBLK = 64;
constexpr float SCALE = 0.088388347648318440f;
constexpr float THR = 8.f;
constexpr int SDEPTH = 2;
constexpr int LDQ = 1024, LDK = 128, LDO = 1024;
constexpr size_t SHM_V = KVBLK * D * 2, SHM_K = KVBLK * D * 2, SHM_ATTN = 2 * SHM_V + 2 * SHM_K + NW * 64 * 4;
using bf16x8 = __attribute__((ext_vector_type(8))) short;
using s16x4  = __attribute__((ext_vector_type(4))) short;
using f32x16 = __attribute__((ext_vector_type(16))) float;
using f32x8  = __attribute__((ext_vector_type(8))) float;
using u32x4  = __attribute__((ext_vector_type(4))) unsigned;
#define KSWZ(row, colB) ((row) * 256 + ((colB) ^ (((row) & 7) << 4)))
#define SBAR() __builtin_amdgcn_sched_barrier(0)
__device__ __forceinline__ int crow(int r, int hi) { return (r & 3) + 8 * (r >> 2) + 4 * hi; }
__device__ __forceinline__ unsigned cvtpk(float lo, float hi) {
  unsigned r; asm volatile("v_cvt_pk_bf16_f32 %0, %1, %2" : "=v"(r) : "v"(lo), "v"(hi)); return r;
}
template <typename TIn> struct Stage;
template <> struct Stage<bf16>  { using T = bf16x8;
  __device__ static __forceinline__ T ld8(const bf16* p) { return *reinterpret_cast<const bf16x8*>(p); }
  __device__ static __forceinline__ bf16x8 tobf(T x) { return x; } };
template <> struct Stage<float> { using T = f32x8;
  __device__ static __forceinline__ T ld8(const float* p) { return *reinterpret_cast<const f32x8*>(p); }
  __device__ static __forceinline__ bf16x8 tobf(T x) {
    u32x4 w = {cvtpk(x[0], x[1]), cvtpk(x[2], x[3]), cvtpk(x[4], x[5]), cvtpk(x[6], x[7])}; return *reinterpret_cast<bf16x8*>(&w); } };

__device__ __forceinline__ void partialSM(f32x16& p0, f32x16& p1, float& m_reg, float& mn, float& alpha) {
  constexpr float C = SCALE * 1.4426950408889634f;
  float pmax = p0[0]; for (int r = 1; r < 16; ++r) pmax = fmaxf(pmax, p0[r]); for (int r = 0; r < 16; ++r) pmax = fmaxf(pmax, p1[r]);
  { auto rr = __builtin_amdgcn_permlane32_swap(__float_as_uint(pmax), __float_as_uint(pmax), false, false);
    pmax = fmaxf(__uint_as_float(rr[0]), __uint_as_float(rr[1])); }
  if (__builtin_expect(__all(pmax - m_reg <= THR / SCALE), 1)) { mn = m_reg; alpha = 1.f; }
  else { mn = fmaxf(m_reg, pmax); alpha = __builtin_amdgcn_exp2f((m_reg - mn) * C); m_reg = mn; }
  float mnC = -mn * C;
  for (int r = 0; r < 16; ++r) p0[r] = fmaf(p0[r], C, mnC); for (int r = 0; r < 16; ++r) p1[r] = fmaf(p1[r], C, mnC);
  for (int r = 0; r < 16; ++r) p0[r] = __builtin_amdgcn_exp2f(p0[r]);
}
__device__ __forceinline__ void finishSM(f32x16& p0, f32x16& p1, float alpha, float& l_reg, bf16x8& pa0, bf16x8& pa1, bf16x8& pa2, bf16x8& pa3) {
  for (int r = 0; r < 16; ++r) p1[r] = __builtin_amdgcn_exp2f(p1[r]);
  float ps = 0; for (int r = 0; r < 16; ++r) ps += p0[r]; for (int r = 0; r < 16; ++r) ps += p1[r];
  { auto rr = __builtin_amdgcn_permlane32_swap(__float_as_uint(ps), __float_as_uint(ps), false, false);
    ps = __uint_as_float(rr[0]) + __uint_as_float(rr[1]); }
  l_reg = l_reg * alpha + ps;
#define PK4(P, BASE, OUT) do { unsigned a0 = cvtpk(P[BASE + 0], P[BASE + 1]), a1 = cvtpk(P[BASE + 2], P[BASE + 3]);   \
    unsigned b0 = cvtpk(P[BASE + 4], P[BASE + 5]), b1 = cvtpk(P[BASE + 6], P[BASE + 7]);                              \
    auto r0 = __builtin_amdgcn_permlane32_swap(a0, b0, false, false); auto r1 = __builtin_amdgcn_permlane32_swap(a1, b1, false, false); \
    u32x4 w = {r0[0], r1[0], r0[1], r1[1]}; OUT = *reinterpret_cast<bf16x8*>(&w); } while (0)
  PK4(p0, 0, pa0); PK4(p0, 8, pa1); PK4(p1, 0, pa2); PK4(p1, 8, pa3);
#undef PK4
}
__device__ __forceinline__ void qkt(f32x16& p0, f32x16& p1, const bf16* Ks, const bf16x8* qr, int r32, int hi) {
  p0 = f32x16{}; p1 = f32x16{};
  for (int d0 = 0; d0 < 8; ++d0) { int cb = (d0 * 16 + hi * 8) * 2;
    bf16x8 b0 = *reinterpret_cast<const bf16x8*>((const char*)Ks + KSWZ(r32, cb));
    bf16x8 b1 = *reinterpret_cast<const bf16x8*>((const char*)Ks + KSWZ(32 + r32, cb));
    p0 = __builtin_amdgcn_mfma_f32_32x32x16_bf16(b0, qr[d0], p0, 0, 0, 0);
    p1 = __builtin_amdgcn_mfma_f32_32x32x16_bf16(b1, qr[d0], p1, 0, 0, 0); }
}
__device__ __forceinline__ int v_st(int k, int c) { const int kk = (k & ~0xC) | ((k & 4) << 1) | ((k & 8) >> 1); return ((kk >> 3) * 4 + (c >> 5)) * 512 + ((kk & 7) * 32 + (c & 31)) * 2; }
__device__ __forceinline__ int v_rd_base(int lane) { return ((lane & 3) << 3) | (((lane >> 2) & 3) << 6) | (((lane >> 4) & 1) << 5) | (((lane >> 5) & 1) << 8); }
constexpr int v_rd_off(int d0, int ks, int half) { return d0 * 512 + ks * 4096 + half * 2048; }
template <int OFF> __device__ __forceinline__ s16x4 tr_read(int vb) {
  s16x4 r; asm volatile("ds_read_b64_tr_b16 %0, %1 offset:%2" : "=&v"(r) : "v"(vb), "i"(OFF) : "memory"); return r;
}
template <int D0> __device__ __forceinline__ void pv_one(f32x16& od, int vb, bf16x8 pa0, bf16x8 pa1, bf16x8 pa2, bf16x8 pa3) {
  const s16x4 l0 = tr_read<v_rd_off(D0, 0, 0)>(vb), h0 = tr_read<v_rd_off(D0, 0, 1)>(vb), l1 = tr_read<v_rd_off(D0, 1, 0)>(vb), h1 = tr_read<v_rd_off(D0, 1, 1)>(vb);
  const s16x4 l2 = tr_read<v_rd_off(D0, 2, 0)>(vb), h2 = tr_read<v_rd_off(D0, 2, 1)>(vb), l3 = tr_read<v_rd_off(D0, 3, 0)>(vb), h3 = tr_read<v_rd_off(D0, 3, 1)>(vb);
  asm volatile("s_waitcnt lgkmcnt(0)" ::: "memory"); SBAR();
#define PK(L, H) (bf16x8){L[0], L[1], L[2], L[3], H[0], H[1], H[2], H[3]}
  od = __builtin_amdgcn_mfma_f32_32x32x16_bf16(pa0, PK(l0, h0), od, 0, 0, 0);
  od = __builtin_amdgcn_mfma_f32_32x32x16_bf16(pa1, PK(l1, h1), od, 0, 0, 0);
  od = __builtin_amdgcn_mfma_f32_32x32x16_bf16(pa2, PK(l2, h2), od, 0, 0, 0);
  od = __builtin_amdgcn_mfma_f32_32x32x16_bf16(pa3, PK(l3, h3), od, 0, 0, 0);
#undef PK
}
__device__ __forceinline__ void pv_d0(f32x16* o, int vb, bf16x8 pa0, bf16x8 pa1, bf16x8 pa2, bf16x8 pa3) {
  pv_one<0>(o[0], vb, pa0, pa1, pa2, pa3); pv_one<1>(o[1], vb, pa0, pa1, pa2, pa3); pv_one<2>(o[2], vb, pa0, pa1, pa2, pa3); pv_one<3>(o[3], vb, pa0, pa1, pa2, pa3);
}

template <typename TQ>
__device__ __forceinline__ void attn_dense_body(const TQ* __restrict__ Qb, const bf16* __restrict__ Kh, const bf16* __restrict__ Vh,
                                                bf16* __restrict__ Ob, int seq, char* lds) {
  using St = Stage<bf16>; using SQ = Stage<TQ>;
  const int tid = opaque_tid(), wid = tid >> 6, lane = tid & 63, r32 = lane & 31, hi = lane >> 5;
  bf16* V_lds = (bf16*)lds; bf16* K_lds = (bf16*)(lds + 2 * SHM_V);
  float* ws = (float*)(lds + 2 * SHM_V + 2 * SHM_K) + wid * 64; float* li_l = ws; float* al_l = ws + 32;
  float m_reg = -1e30f, l_reg = 0; f32x16 o[4] = {}; bf16x8 qr[8];
  const TQ* Qw = Qb + (long)(wid * QBLK + r32) * LDQ + hi * 8;
#pragma unroll
  for (int d0 = 0; d0 < 8; ++d0) qr[d0] = SQ::tobf(SQ::ld8(Qw + d0 * 16));
  const int sr = tid >> 4, sc = (tid & 15) * 8, vst0 = v_st(sr, sc), vst1 = v_st(32 + sr, sc);
  const int vb0 = (int)(uintptr_t)V_lds + v_rd_base(lane);
  struct { typename St::T vs0, vs1, ks0, ks1; } sr_[SDEPTH];
#define SLOAD(i, k0) do { sr_[i].vs0 = St::ld8(&Vh[(long)((k0) + sr) * LDK + sc]); sr_[i].vs1 = St::ld8(&Vh[(long)((k0) + 32 + sr) * LDK + sc]); \
    sr_[i].ks0 = St::ld8(&Kh[(long)((k0) + sr) * LDK + sc]); sr_[i].ks1 = St::ld8(&Kh[(long)((k0) + 32 + sr) * LDK + sc]); } while (0)
#define SWRITE(b, i) do { *(bf16x8*)((char*)V_lds + (b) * SHM_V + vst0) = St::tobf(sr_[i].vs0);          \
    *(bf16x8*)((char*)V_lds + (b) * SHM_V + vst1) = St::tobf(sr_[i].vs1); int kc = sc * 2;               \
    *(bf16x8*)((char*)K_lds + (b) * SHM_K + KSWZ(sr, kc)) = St::tobf(sr_[i].ks0);                       \
    *(bf16x8*)((char*)K_lds + (b) * SHM_K + KSWZ(32 + sr, kc)) = St::tobf(sr_[i].ks1); } while (0)
#define SWAIT() do { if constexpr (SDEPTH == 2) asm volatile("s_waitcnt vmcnt(4)" ::: "memory"); else asm volatile("s_waitcnt vmcnt(0)" ::: "memory"); } while (0)
#define RESC(a) do { if (__any((a) < 1.f)) { if (hi == 0) al_l[r32] = (a); asm volatile("s_waitcnt lgkmcnt(0)" ::: "memory"); \
    for (int d = 0; d < 4; ++d) for (int r = 0; r < 16; ++r) o[d][r] *= al_l[crow(r, hi)]; } } while (0)
  f32x16 pA0, pA1, pB0, pB1; float mnA, mnB, alA, alB; bf16x8 pa0, pa1, pa2, pa3; const int NT = seq / KVBLK;
  constexpr int SE = 0, SO = SDEPTH - 1;
  SLOAD(SE, 0); asm volatile("s_waitcnt vmcnt(0)" ::: "memory"); SWRITE(0, SE); __syncthreads();
  qkt(pA0, pA1, K_lds, qr, r32, hi); partialSM(pA0, pA1, m_reg, mnA, alA);
  SLOAD(SO, KVBLK); if constexpr (SDEPTH == 2) { if (2 < NT) SLOAD(SE, 2 * KVBLK); }
  SWAIT(); SWRITE(1, SO); __syncthreads();
  for (int j = 1; j + 1 < NT; j += 2) {
    SBAR(); qkt(pB0, pB1, (bf16*)((char*)K_lds + SHM_K), qr, r32, hi);
    finishSM(pA0, pA1, alA, l_reg, pa0, pa1, pa2, pa3); SBAR();
    SLOAD(SO, (j + SDEPTH) * KVBLK); SBAR();
    pv_d0(o, vb0, pa0, pa1, pa2, pa3); partialSM(pB0, pB1, m_reg, mnB, alB);
    __syncthreads(); SWAIT(); SWRITE(0, SE);
    RESC(alB); __syncthreads();
    SBAR(); qkt(pA0, pA1, K_lds, qr, r32, hi);
    finishSM(pB0, pB1, alB, l_reg, pa0, pa1, pa2, pa3); SBAR();
    if (SDEPTH == 1 || j + 3 < NT) SLOAD(SE, (j + 1 + SDEPTH) * KVBLK); SBAR();
    pv_d0(o, vb0 + (int)SHM_V, pa0, pa1, pa2, pa3); partialSM(pA0, pA1, m_reg, mnA, alA);
    __syncthreads(); SWAIT(); SWRITE(1, SO);
    RESC(alA); __syncthreads();
  }
  SBAR(); qkt(pB0, pB1, (bf16*)((char*)K_lds + SHM_K), qr, r32, hi);
  finishSM(pA0, pA1, alA, l_reg, pa0, pa1, pa2, pa3); SBAR();
  pv_d0(o, vb0, pa0, pa1, pa2, pa3); partialSM(pB0, pB1, m_reg, mnB, alB);
  __syncthreads(); RESC(alB);
  finishSM(pB0, pB1, alB, l_reg, pa0, pa1, pa2, pa3); SBAR();
  pv_d0(o, vb0 + (int)SHM_V, pa0, pa1, pa2, pa3);
  if (hi == 0) li_l[r32] = l_reg; asm volatile("s_waitcnt lgkmcnt(0)" ::: "memory");
  float rli[16];
#pragma unroll
  for (int r = 0; r < 16; ++r) rli[r] = __builtin_amdgcn_rcpf(li_l[crow(r, hi)]);
  bf16* Ow = Ob + (long)(wid * QBLK) * LDO;
#pragma unroll
  for (int r = 0; r < 16; ++r) { int orow = crow(r, hi);
    for (int d0 = 0; d0 < 4; ++d0) Ow[(long)orow * LDO + d0 * 32 + r32] = __float2bfloat16(o[d0][r] * rli[r]); }
#undef SLOAD
#undef SWRITE
#undef SWAIT
#undef RESC
}

}
#define LAS __attribute__((address_space(3)))
typedef unsigned short bf16_t;
typedef short bf16x8 __attribute__((ext_vector_type(8)));
typedef short s16x4 __attribute__((ext_vector_type(4)));
typedef float f32x4 __attribute__((ext_vector_type(4)));
typedef float f32x16 __attribute__((ext_vector_type(16)));
typedef unsigned u32x4 __attribute__((ext_vector_type(4)));
typedef unsigned u32x2 __attribute__((ext_vector_type(2)));
using pg8::cvtpk_s; using pg8::bf_lo; using pg8::bf_hi; using pg8::silu_f;

constexpr int DM = 1024, SEQ = 16384, CTXL = 256, NLAT = 2 * SEQ, MROWS = NLAT + 2 * CTXL, DFF = 4096;
constexpr float EPS = 1e-6f;
constexpr size_t MiB = 1u << 20;
constexpr size_t WS_BAR = 512 * 1024, WS_BAR_BYTES = 16384;
constexpr size_t WS_MOD = 0, WS_CTX = 1 * MiB, WS_WT = 4 * MiB, WS_H = 41 * MiB, WS_AB = 106 * MiB, WS_RSTD = 115 * MiB, WS_P = 118 * MiB, WS_O = 378 * MiB, WS_END = 508 * MiB;
constexpr size_t WT_A = WS_WT, WT_Z = WS_WT + 9 * MiB, WT_O = WS_WT + 13 * MiB, WT_1 = WS_WT + 17 * MiB, WT_2 = WS_WT + 25 * MiB;
constexpr size_t WS_QM = 313 * MiB, WS_KM = 378 * MiB, WS_OGLA = 443 * MiB, WS_AQ = 41 * MiB, WS_EL = 74 * MiB;
constexpr size_t WS_TP = 4 * MiB, WS_HALO = 378 * MiB;
constexpr size_t WS_QR = 216 * MiB, WS_KR = 281 * MiB, WS_VR = 298 * MiB;
constexpr int SKV = SEQ + CTXL;
constexpr int LDS_BYTES = 155648;
enum { OP_MOD, OP_PREP, OP_GEMM_IN, OP_DNSCAN, OP_DNREDO, OP_GEMM_Z, OP_GEMM_OUT, OP_NORM2, OP_FFN1, OP_FFN2, OP_GLAPREP, OP_GLASCAN, OP_GLAGATE, OP_QKROPE, OP_ATTN, OP_DNHALO, OP_DNCONV, OP_DNT };

struct Args { const float* in[25]; float* out; unsigned char* ws; int ph_lo, ph_hi; };

__device__ __forceinline__ float wave_sum(float v) {
#pragma unroll
    for (int o = 1; o < 64; o <<= 1) v += __shfl_xor(v, o);
    return v;
}
__device__ __forceinline__ float softplus_f(float x) { return x > 20.f ? x : log1pf(__expf(x)); }
__device__ __forceinline__ float logsigmoid_f(float x) { return fminf(x, 0.f) - log1pf(__expf(-fabsf(x))); }
__device__ __forceinline__ bf16_t f2bf(float f) { return (bf16_t)(cvtpk_s(f, 0.f) & 0xffffu); }
__device__ __forceinline__ float bf2f(bf16_t v) { return __builtin_bit_cast(float, (unsigned)v << 16); }

__device__ __forceinline__ void transpose_item(const float* W, int ldw, int c0, int ncols, int K, bf16_t* WT, int row_off, LAS float* scr, int item, int lane) {
    const int nblk = ncols / 32, kb = item / nblk, nb = item % nblk, k0 = 64 * kb, n0 = 32 * nb;
    {
        const int kr = lane >> 3, n4 = 4 * (lane & 7); f32x4 v[8];
#pragma unroll
        for (int i = 0; i < 8; ++i) v[i] = *(const f32x4*)(W + (size_t)(k0 + kr + 8 * i) * ldw + c0 + n0 + n4);
#pragma unroll
        for (int i = 0; i < 8; ++i) { LAS float* d = scr + (kr + 8 * i) * 33 + n4; d[0] = v[i][0]; d[1] = v[i][1]; d[2] = v[i][2]; d[3] = v[i][3]; }
    }
    asm volatile("s_waitcnt lgkmcnt(0)" ::: "memory");
    const int c = lane & 7;
#pragma unroll
    for (int j = 0; j < 4; ++j) { const int n = (lane >> 3) + 8 * j; const LAS float* s = scr + (8 * c) * 33 + n;
        u32x4 o; o.x = cvtpk_s(s[0 * 33], s[1 * 33]); o.y = cvtpk_s(s[2 * 33], s[3 * 33]); o.z = cvtpk_s(s[4 * 33], s[5 * 33]); o.w = cvtpk_s(s[6 * 33], s[7 * 33]);
        *(u32x4*)(WT + (size_t)(row_off + n0 + n) * K + k0 + 8 * c) = o; }
    asm volatile("s_waitcnt lgkmcnt(0)" ::: "memory");
}
__device__ __forceinline__ void transpose_mat(const float* W, int ldw, int c0, int ncols, int K, bf16_t* WT, int row_off, LAS float* scr, int gw, int NGW, int lane) {
    const int nitems = (K / 64) * (ncols / 32);
    for (int it = gw; it < nitems; it += NGW) transpose_item(W, ldw, c0, ncols, K, WT, row_off, scr, it, lane);
}
__device__ __forceinline__ void normmod_rows(const float* xl, const float* xc, const float* g, const float* modl, int sidx, bf16_t* H, int gw, int NGW, int lane) {
    for (int row0 = gw; row0 < MROWS; row0 += 2 * NGW) {
        const int row1 = row0 + NGW; const bool has1 = row1 < MROWS; const int rows[2] = {row0, has1 ? row1 : row0};
        f32x4 v[2][4]; float ss[2] = {0.f, 0.f};
#pragma unroll
        for (int q = 0; q < 2; ++q) { const int row = rows[q]; const float* xr = row < NLAT ? xl + (size_t)row * DM : xc + (size_t)(row - NLAT) * DM;
#pragma unroll
            for (int j = 0; j < 4; ++j) v[q][j] = *(const f32x4*)(xr + 4 * lane + 256 * j); }
#pragma unroll
        for (int q = 0; q < 2; ++q)
#pragma unroll
            for (int j = 0; j < 4; ++j) ss[q] += (v[q][j][0] * v[q][j][0] + v[q][j][1] * v[q][j][1]) + (v[q][j][2] * v[q][j][2] + v[q][j][3] * v[q][j][3]);
#pragma unroll
        for (int q = 0; q < 2; ++q) {
            if (q == 1 && !has1) break;
            const int row = rows[q]; const int mi = row < SEQ ? 0 : (row < NLAT ? 1 : 2);
            const float* sh = modl + (size_t)mi * 6144 + (size_t)sidx * 1024; const float* sc = sh + 1024;
            const float rinv = rsqrtf(wave_sum(ss[q]) * (1.f / DM) + EPS);
#pragma unroll
            for (int j = 0; j < 4; ++j) { const int c = 4 * lane + 256 * j; const f32x4 gg = *(const f32x4*)(g + c), s1 = *(const f32x4*)(sc + c), s0 = *(const f32x4*)(sh + c);
                f32x4 y;
#pragma unroll
                for (int e = 0; e < 4; ++e) y[e] = v[q][j][e] * rinv * gg[e] * (1.f + s1[e]) + s0[e];
                u32x2 w; w.x = cvtpk_s(y[0], y[1]); w.y = cvtpk_s(y[2], y[3]); *(u32x2*)(H + (size_t)row * DM + c) = w; }
        }
    }
}
#define BAR_LDS() do { asm volatile("s_waitcnt lgkmcnt(0)" ::: "memory"); __builtin_amdgcn_s_barrier(); asm volatile("" ::: "memory"); } while (0)
__device__ __forceinline__ int crow(int x, int h) { return (x & 3) + 8 * (x >> 2) + 4 * h; }
#define MFMA32(a, b, c) __builtin_amdgcn_mfma_f32_32x32x16_bf16((a), (b), (c), 0, 0, 0)
__device__ __forceinline__ bf16x8 frag_nat(const LAS bf16_t* img, int LD, int row, int ks, int h) { return *(const LAS bf16x8*)(img + row * LD + 16 * ks + 8 * h); }
__device__ __forceinline__ bf16x8 frag_perm(const LAS bf16_t* img, int LD, int row, int ks, int h) {
    const s16x4 lo = *(const LAS s16x4*)(img + row * LD + 16 * ks + 4 * h), hi = *(const LAS s16x4*)(img + row * LD + 16 * ks + 8 + 4 * h);
    return __builtin_shufflevector(lo, hi, 0, 1, 2, 3, 4, 5, 6, 7);
}
__device__ __forceinline__ s16x4 tr4(const LAS bf16_t* p) { return __builtin_bit_cast(s16x4, __builtin_amdgcn_ds_read_tr16_b64_v4i16((LAS s16x4*)p)); }
__device__ __forceinline__ bf16x8 frag_tr(const LAS bf16_t* img, int LD, int m0, int ks, int lane) {
    const int i16 = lane & 15, q = i16 >> 2, p = i16 & 3, blk = (lane >> 4) & 1, h = lane >> 5;
    const LAS bf16_t* a = img + (16 * ks + 4 * h + q) * LD + m0 + 16 * blk + 4 * p;
    const s16x4 lo = tr4(a), hi = tr4(a + 8 * LD);
    return __builtin_shufflevector(lo, hi, 0, 1, 2, 3, 4, 5, 6, 7);
}
__device__ __forceinline__ bf16x8 pack_step(const f32x16& x, int s) {
    u32x4 p; p.x = cvtpk_s(x[8 * s + 0], x[8 * s + 1]); p.y = cvtpk_s(x[8 * s + 2], x[8 * s + 3]); p.z = cvtpk_s(x[8 * s + 4], x[8 * s + 5]); p.w = cvtpk_s(x[8 * s + 6], x[8 * s + 7]);
    return __builtin_bit_cast(bf16x8, p);
}
__device__ __forceinline__ void dn_halo_phase(const bf16_t* P, bf16_t* HALO, int G) {
    const int tid = opaque_tid();
    for (size_t e = (size_t)blockIdx.x * 512 + tid; e < (size_t)520 * 4 * 512; e += (size_t)G * 512) {
        const int c = (int)(e & 511), j = (int)((e >> 9) & 3), rb = (int)(e >> 11);
        const int row = rb * 64 + (j < 2 ? j : 60 + j);
        ((u32x4*)(HALO + ((size_t)rb * 4 + j) * 4096))[c] = ((const u32x4*)(P + (size_t)row * 4096))[c];
    }
}
__device__ __forceinline__ void unpack8(const u32x4 v, float (&f)[8]) { f[0] = bf_lo(v.x); f[1] = bf_hi(v.x); f[2] = bf_lo(v.y); f[3] = bf_hi(v.y); f[4] = bf_lo(v.z); f[5] = bf_hi(v.z); f[6] = bf_lo(v.w); f[7] = bf_hi(v.w); }
__device__ __forceinline__ void dn_conv_phase(bf16_t* P, const bf16_t* HALO, const float* conv_w, int G) {
    const int tid = opaque_tid(), col0 = 8 * tid;
    float cw[8][5];
#pragma unroll
    for (int c = 0; c < 8; ++c)
#pragma unroll
        for (int tap = 0; tap < 5; ++tap) cw[c][tap] = conv_w[(size_t)(col0 + c) * 5 + tap];
    const int kind = col0 < 1024 ? 0 : (col0 < 2048 ? 1 : 2);
    for (int rb = blockIdx.x; rb < 520; rb += G) {
        const int cs = rb < 512 ? (rb & 255) : ((rb - 512) & 3); const bool sfirst = cs == 0, slast = rb < 512 ? cs == 255 : cs == 3;
        const u32x4 zero = (u32x4){0u, 0u, 0u, 0u};
        bf16_t* base = P + (size_t)rb * 64 * 4096 + col0;
        u32x4 w0 = sfirst ? zero : *(const u32x4*)(HALO + ((size_t)(rb - 1) * 4 + 2) * 4096 + col0);
        u32x4 w1 = sfirst ? zero : *(const u32x4*)(HALO + ((size_t)(rb - 1) * 4 + 3) * 4096 + col0);
        u32x4 w2 = *(const u32x4*)(base), w3 = *(const u32x4*)(base + 4096);
#pragma unroll 4
        for (int rr = 0; rr < 64; ++rr) {
            u32x4 w4;
            if (rr + 2 < 64) w4 = *(const u32x4*)(base + (size_t)(rr + 2) * 4096);
            else w4 = slast ? zero : *(const u32x4*)(HALO + ((size_t)(rb + 1) * 4 + (rr + 2 - 64)) * 4096 + col0);
            float x0[8], x1[8], x2[8], x3[8], x4[8], y[8];
            unpack8(w0, x0); unpack8(w1, x1); unpack8(w2, x2); unpack8(w3, x3); unpack8(w4, x4);
            float ss = 0.f;
#pragma unroll
            for (int c = 0; c < 8; ++c) { const float a = x0[c] * cw[c][0] + x1[c] * cw[c][1] + x2[c] * cw[c][2] + x3[c] * cw[c][3] + x4[c] * cw[c][4]; y[c] = silu_f(a); ss += y[c] * y[c]; }
            float sc = 1.f;
            if (kind < 2) { ss += __shfl_xor(ss, 1); ss += __shfl_xor(ss, 2); ss += __shfl_xor(ss, 4); ss += __shfl_xor(ss, 8); sc = rsqrtf(ss + EPS) * (kind == 0 ? 0.08838834764831845f : 1.f); }
            u32x4 o; o.x = cvtpk_s(y[0] * sc, y[1] * sc); o.y = cvtpk_s(y[2] * sc, y[3] * sc); o.z = cvtpk_s(y[4] * sc, y[5] * sc); o.w = cvtpk_s(y[6] * sc, y[7] * sc);
            *(u32x4*)(base + (size_t)rr * 4096) = o;
            w0 = w1; w1 = w2; w2 = w3; w3 = w4;
        }
    }
}
constexpr int DT_KB = 0, DT_R = 17408, DT_SC = 33792, DT_DIR = 34816;
template <int W> __device__ __forceinline__ void dn_solve(const LAS float* Mf, float (&t)[16], int lane) {
    const int j = 16 * W + (lane >> 2), q = lane & 3;
#pragma unroll
    for (int s = 0; s < 16; ++s) t[s] = 0.f;
#pragma unroll
    for (int i = 16 * W; i < 64; ++i) {
        float acc = 0.f;
#pragma unroll
        for (int s = 4 * W; s <= (i - 1) / 4 && i > 16 * W; ++s) acc += Mf[i * 64 + 4 * s + q] * t[s];
        acc += __shfl_xor(acc, 1); acc += __shfl_xor(acc, 2);
        const float val = (i == j ? 1.f : 0.f) - acc;
        if (q == (i & 3)) t[i >> 2] = val;
        asm volatile("" : "+v"(t[0]), "+v"(t[1]), "+v"(t[2]), "+v"(t[3]), "+v"(t[4]), "+v"(t[5]), "+v"(t[6]), "+v"(t[7]), "+v"(t[8]), "+v"(t[9]), "+v"(t[10]), "+v"(t[11]), "+v"(t[12]), "+v"(t[13]), "+v"(t[14]), "+v"(t[15]));
    }
}
__device__ __forceinline__ void dn_t_phase(LAS unsigned char* lds, const bf16_t* P, float* AB, bf16_t* TP, const float* a_log, const float* dt_bias, int G) {
    const int tid0 = opaque_tid(), hb = __builtin_amdgcn_readfirstlane(tid0 >> 8);
    u32x4 pk4[4]; float pav = 0.f, pbv = 0.f;
    {
        const int it = blockIdx.x * 2 + hb;
        if (it < 16640) { const int dir = it & 1, vh = (it >> 1) & 15, rb = it >> 5, kh = vh >> 1, t = tid0 & 255, r0 = t >> 4, c8 = 8 * (t & 15);
#pragma unroll
            for (int v = 0; v < 4; ++v) pk4[v] = *(const u32x4*)(P + (size_t)(rb * 64 + r0 + 16 * v) * 4096 + 1024 + kh * 128 + c8);
            const int ti = dir ? 63 - (t & 63) : (t & 63); const float* ab = AB + (size_t)(rb * 64 + ti) * 64; pav = ab[dir * 16 + vh]; pbv = ab[32 + dir * 16 + vh]; }
    }
    for (int itb = blockIdx.x * 2; itb < 16640; itb += 2 * G) {
        const int it = itb + hb, dir = it & 1, vh = (it >> 1) & 15, rb = it >> 5, kh = vh >> 1;
        const int tq = opaque_tid(), t = tq & 255, w = __builtin_amdgcn_readfirstlane((tq >> 6) & 3), lane = tq & 63, r = lane & 31, h = lane >> 5;
        LAS unsigned char* base = lds + hb * DT_DIR;
        LAS bf16_t* Kb = (LAS bf16_t*)(base + DT_KB); LAS float* Mf = (LAS float*)(base + DT_R); LAS bf16_t* Tb = (LAS bf16_t*)(base + DT_R);
        LAS float* sc_beta = (LAS float*)(base + DT_SC); LAS float* sc_gc = sc_beta + 64;
        {
            const int r0 = t >> 4, c8 = 8 * (t & 15);
#pragma unroll
            for (int v = 0; v < 4; ++v) { const int i = r0 + 16 * v, ip = dir ? 63 - i : i;
                *(LAS u32x4*)(Kb + ip * 136 + c8) = pk4[v]; }
            if (t < 64) {
                const int ti = dir ? 63 - t : t; float* ab = AB + (size_t)(rb * 64 + ti) * 64;
                const float av = pav, bv = pbv;
                const float g = -__expf(a_log[dir * 16 + vh]) * softplus_f(av + dt_bias[dir * 16 + vh]), beta = 1.f / (1.f + __expf(-bv));
                float gc = g;
#pragma unroll
                for (int o = 1; o < 64; o <<= 1) { const float up = __shfl_up(gc, o); if (t >= o) gc += up; }
                sc_beta[t] = beta; sc_gc[t] = gc;
                ab[dir * 16 + vh] = gc; ab[32 + dir * 16 + vh] = beta;
            }
        }
        BAR_LDS();
        {
            const int itn = it + 2 * G;
            if (itn < 16640) { const int dirn = itn & 1, vhn = (itn >> 1) & 15, rbn = itn >> 5, khn = vhn >> 1, r0 = t >> 4, c8 = 8 * (t & 15);
#pragma unroll
                for (int v = 0; v < 4; ++v) pk4[v] = *(const u32x4*)(P + (size_t)(rbn * 64 + r0 + 16 * v) * 4096 + 1024 + khn * 128 + c8);
                const int tin = dirn ? 63 - (t & 63) : (t & 63); const float* abn = AB + (size_t)(rbn * 64 + tin) * 64; pav = abn[dirn * 16 + vhn]; pbv = abn[32 + dirn * 16 + vhn]; }
        }
        const int ti = w >> 1, tj = w & 1;
        {
            f32x16 acc;
#pragma unroll
            for (int x = 0; x < 16; ++x) acc[x] = 0.f;
            if (!(ti == 0 && tj == 1)) {
#pragma unroll
                for (int ks = 0; ks < 8; ++ks) acc = MFMA32(frag_nat(Kb, 136, 32 * ti + r, ks, h), frag_nat(Kb, 136, 32 * tj + r, ks, h), acc);
            }
            const int j = 32 * tj + r; const float gj = sc_gc[j];
#pragma unroll
            for (int x = 0; x < 16; ++x) { const int i = 32 * ti + crow(x, h);
                Mf[i * 64 + j] = (i > j) ? sc_beta[i] * acc[x] * __expf(sc_gc[i] - gj) : 0.f; }
        }
        BAR_LDS();
        float tc[16];
        if (w == 0) dn_solve<0>(Mf, tc, lane); else if (w == 1) dn_solve<1>(Mf, tc, lane); else if (w == 2) dn_solve<2>(Mf, tc, lane); else dn_solve<3>(Mf, tc, lane);
        BAR_LDS();
        {
            const int j = 16 * w + (lane >> 2), q = lane & 3;
#pragma unroll
            for (int s = 0; s < 16; ++s) Tb[(4 * s + q) * 72 + j] = f2bf(tc[s]);
        }
        BAR_LDS();
        {
            bf16_t* dst = TP + (size_t)it * 3072;
#pragma unroll
            for (int k2 = 0; k2 < 2; ++k2) { const int c = t + 256 * k2;
                if (c < 384) { const int blk = c >> 7, rowc = (c & 127) >> 2, cc = c & 3, br = blk ? 1 : 0, bc = blk == 2 ? 1 : 0;
                    *(u32x4*)(dst + c * 8) = *(const LAS u32x4*)(Tb + (32 * br + rowc) * 72 + 32 * bc + 8 * cc); } }
        }
        BAR_LDS();
    }
}
constexpr int DN_KB = 0, DN_QB = 17408, DN_VB = 34816, DN_TB = 51200, DN_AB = 60416, DN_SC = 69632, DN_DIR = 71168;
__device__ __forceinline__ void dn_step_rb(int step, int dir, int b, int& rb, bool& first) {
    if (step < 4) { const int cidx = dir ? 3 - step : step; rb = 512 + b * 4 + cidx; first = step < 2; }
    else { const int c = step - 4; const int cidx = dir ? 255 - c : c; rb = b * 256 + cidx; first = c < 128; }
}
struct DnPre { u32x4 k4[4], q4[4], v4[4], t0, t1; float gc, beta; };
__device__ __forceinline__ void dn_prefetch(DnPre& p, const bf16_t* P, const float* AB, const bf16_t* TP, int rb, int dir, int vh, int kh, int t, int part) {
    const int r0 = t >> 4, c8 = 8 * (t & 15);
    const bf16_t* prow = P + (size_t)(rb * 64 + r0) * 4096 + c8;
    const bf16_t* tp = TP + (size_t)((rb * 16 + vh) * 2 + dir) * 3072;
    if (part & 1) {
#pragma unroll
        for (int v = 0; v < 4; ++v) { const bf16_t* pr = prow + (size_t)(16 * v) * 4096;
            p.k4[v] = *(const u32x4*)(pr + 1024 + kh * 128); p.q4[v] = *(const u32x4*)(pr + kh * 128); p.v4[v] = *(const u32x4*)(pr + 2048 + vh * 128); }
    }
    if (part & 2) {
        p.t0 = *(const u32x4*)(tp + t * 8); p.t1 = *(const u32x4*)(tp + (256 + (t & 127)) * 8);
        const int ti = dir ? 63 - (t & 63) : (t & 63); const float* ab = AB + (size_t)(rb * 64 + ti) * 64; p.gc = ab[dir * 16 + vh]; p.beta = ab[32 + dir * 16 + vh];
    }
}
template <int VAR> __device__ __forceinline__ void dn_scan(LAS unsigned char* lds, const bf16_t* P, const float* AB, const bf16_t* TP, bf16_t* OB) {
    const int tid = opaque_tid(), dir = __builtin_amdgcn_readfirstlane(tid >> 8);
    for (int unit = blockIdx.x; unit < 32; unit += gridDim.x) {
        const int b = unit >> 4, vh = unit & 15, kh = vh >> 1;
        f32x16 S[4];
#pragma unroll
        for (int kt = 0; kt < 4; ++kt)
#pragma unroll
            for (int x = 0; x < 16; ++x) S[kt][x] = 0.f;
        DnPre pre;
        { int rb0; bool f0; dn_step_rb(0, dir, b, rb0, f0); dn_prefetch(pre, P, AB, TP, rb0, dir, vh, kh, tid & 255, 3); }
        __syncthreads();
        for (int step = 0; step < 260; ++step) {
            const int w = __builtin_amdgcn_readfirstlane((opaque_tid() >> 6) & 3);
            LAS unsigned char* base = lds + dir * DN_DIR;
            LAS bf16_t* Kb = (LAS bf16_t*)(base + DN_KB); LAS bf16_t* Qb = (LAS bf16_t*)(base + DN_QB); LAS bf16_t* Vb = (LAS bf16_t*)(base + DN_VB);
            LAS bf16_t* Tb = (LAS bf16_t*)(base + DN_TB); LAS bf16_t* Ab = (LAS bf16_t*)(base + DN_AB);
            LAS float* sc_beta = (LAS float*)(base + DN_SC); LAS float* sc_gc = sc_beta + 64; LAS float* sc_eg = sc_beta + 128; LAS float* sc_tail = sc_beta + 192; LAS float* sc_dl = sc_beta + 256;
            int rb; bool first; dn_step_rb(step, dir, b, rb, first);
            const int row_base = rb * 64;
            {
                const int tq_ = opaque_tid(), t = tq_ & 255;
                const int r0 = t >> 4, c8 = 8 * (t & 15);
#pragma unroll
                for (int v = 0; v < 4; ++v) { const int i = r0 + 16 * v, ip = dir ? 63 - i : i;
                    *(LAS u32x4*)(Kb + ip * 136 + c8) = pre.k4[v]; *(LAS u32x4*)(Qb + ip * 136 + c8) = pre.q4[v]; *(LAS u32x4*)(Vb + ip * 128 + c8) = pre.v4[v]; }
                { const int c = t, blk = c >> 7, rowc = (c & 127) >> 2, cc = c & 3, br = blk ? 1 : 0; *(LAS u32x4*)(Tb + (32 * br + rowc) * 72 + 8 * cc) = pre.t0; }
                if (t < 128) { const int rowc = t >> 2, cc = t & 3; *(LAS u32x4*)(Tb + (32 + rowc) * 72 + 32 + 8 * cc) = pre.t1; }
                if (t < 64) { const float gc = pre.gc, gl = __shfl(gc, 63); sc_beta[t] = pre.beta; sc_gc[t] = gc; sc_eg[t] = __expf(gc); sc_tail[t] = __expf(gl - gc); if (t == 0) sc_dl[0] = __expf(gl); }
            }
            BAR_LDS();
            {
                const int tq_ = opaque_tid(), lane = tq_ & 63, r = lane & 31, h = lane >> 5;
                const int ti = w >> 1, tj = w & 1;
                if (!(ti == 0 && tj == 1)) {
                    f32x16 qk;
#pragma unroll
                    for (int x = 0; x < 16; ++x) qk[x] = 0.f;
#pragma unroll
                    for (int ks = 0; ks < 8; ++ks) qk = MFMA32(frag_nat(Qb, 136, 32 * ti + r, ks, h), frag_nat(Kb, 136, 32 * tj + r, ks, h), qk);
                    const int jj = 32 * tj + r; const float gj = sc_gc[jj];
#pragma unroll
                    for (int x = 0; x < 16; ++x) { const int i = 32 * ti + crow(x, h);
                        Ab[i * 72 + jj] = f2bf((i >= jj) ? qk[x] * __expf(sc_gc[i] - gj) : 0.f); }
                }
            }
            BAR_LDS();
            if (VAR != 2 && step + 1 < 260) { int rbn; bool fn; dn_step_rb(step + 1, dir, b, rbn, fn); dn_prefetch(pre, P, AB, TP, rbn, dir, vh, kh, opaque_tid() & 255, 1); }
            __builtin_amdgcn_sched_barrier(0);
            if (VAR != 1) {
                const int tq_ = opaque_tid(), lane = tq_ & 63, r = lane & 31, h = lane >> 5;
                f32x16 KS[2], QS[2];
#pragma unroll
                for (int mt = 0; mt < 2; ++mt)
#pragma unroll
                    for (int x = 0; x < 16; ++x) { KS[mt][x] = 0.f; QS[mt][x] = 0.f; }
#pragma unroll
                for (int ks = 0; ks < 8; ++ks) {
                    const bf16x8 sp = pack_step(S[ks >> 1], ks & 1);
#pragma unroll
                    for (int mt = 0; mt < 2; ++mt) { KS[mt] = MFMA32(frag_perm(Kb, 136, 32 * mt + r, ks, h), sp, KS[mt]); QS[mt] = MFMA32(frag_perm(Qb, 136, 32 * mt + r, ks, h), sp, QS[mt]); }
                    if (ks & 1) __builtin_amdgcn_sched_barrier(0);
                }
#pragma unroll
                for (int mt = 0; mt < 2; ++mt)
#pragma unroll
                    for (int x = 0; x < 16; ++x) { const int i = 32 * mt + crow(x, h);
                        KS[mt][x] = sc_beta[i] * (bf2f(Vb[i * 128 + 32 * w + r]) - sc_eg[i] * KS[mt][x]); }
                __builtin_amdgcn_sched_barrier(0);
                bf16x8 Xp[4];
#pragma unroll
                for (int ks = 0; ks < 4; ++ks) Xp[ks] = pack_step(KS[ks >> 1], ks & 1);
                f32x16 VN[2];
#pragma unroll
                for (int mt = 0; mt < 2; ++mt) {
#pragma unroll
                    for (int x = 0; x < 16; ++x) VN[mt][x] = 0.f;
#pragma unroll
                    for (int ks = 0; ks < 4; ++ks) if (ks < 2 * mt + 2) VN[mt] = MFMA32(frag_perm(Tb, 72, 32 * mt + r, ks, h), Xp[ks], VN[mt]);
                }
                __builtin_amdgcn_sched_barrier(0);
                if (VAR != 2 && step + 1 < 260) { int rbn; bool fn; dn_step_rb(step + 1, dir, b, rbn, fn); dn_prefetch(pre, P, AB, TP, rbn, dir, vh, kh, opaque_tid() & 255, 2); }
                __builtin_amdgcn_sched_barrier(0);
                bf16x8 VNp[4];
#pragma unroll
                for (int ks = 0; ks < 4; ++ks) VNp[ks] = pack_step(VN[ks >> 1], ks & 1);
#pragma unroll
                for (int mt = 0; mt < 2; ++mt) {
#pragma unroll
                    for (int x = 0; x < 16; ++x) QS[mt][x] *= sc_eg[32 * mt + crow(x, h)];
#pragma unroll
                    for (int ks = 0; ks < 4; ++ks) if (ks < 2 * mt + 2) QS[mt] = MFMA32(frag_perm(Ab, 72, 32 * mt + r, ks, h), VNp[ks], QS[mt]);
                }
                __builtin_amdgcn_sched_barrier(0);
#pragma unroll
                for (int mt = 0; mt < 2; ++mt)
#pragma unroll
                    for (int x = 0; x < 16; ++x) Vb[(32 * mt + crow(x, h)) * 128 + 32 * w + r] = f2bf(QS[mt][x]);
                __builtin_amdgcn_sched_barrier(0);
#pragma unroll
                for (int mt = 0; mt < 2; ++mt)
#pragma unroll
                    for (int x = 0; x < 16; ++x) VN[mt][x] *= sc_tail[32 * mt + crow(x, h)];
#pragma unroll
                for (int ks = 0; ks < 4; ++ks) VNp[ks] = pack_step(VN[ks >> 1], ks & 1);
                __builtin_amdgcn_sched_barrier(0);
                const float dl = sc_dl[0];
#pragma unroll
                for (int kt = 0; kt < 4; ++kt)
#pragma unroll
                    for (int x = 0; x < 16; ++x) S[kt][x] *= dl;
#pragma unroll
                for (int ks = 0; ks < 4; ++ks) {
#pragma unroll
                    for (int kt = 0; kt < 4; ++kt) S[kt] = MFMA32(frag_tr(Kb, 136, 32 * kt, ks, lane), VNp[ks], S[kt]);
                    __builtin_amdgcn_sched_barrier(0);
                }
                if (VAR != 2) {
                    const int rr_ = lane >> 2, c8_ = 8 * (lane & 3);
#pragma unroll
                    for (int v = 0; v < 4; ++v) { const int ip_ = rr_ + 16 * v, i_ = dir ? 63 - ip_ : ip_;
                        u32x4* gp_ = (u32x4*)(OB + (size_t)(row_base + i_) * 2048 + vh * 128 + 32 * w + c8_);
                        u32x4 o = *(const LAS u32x4*)(Vb + ip_ * 128 + 32 * w + c8_);
                        if (!first) { const u32x4 e = gp_[0];
                            o.x = cvtpk_s(bf_lo(o.x) + bf_lo(e.x), bf_hi(o.x) + bf_hi(e.x)); o.y = cvtpk_s(bf_lo(o.y) + bf_lo(e.y), bf_hi(o.y) + bf_hi(e.y));
                            o.z = cvtpk_s(bf_lo(o.z) + bf_lo(e.z), bf_hi(o.z) + bf_hi(e.z)); o.w = cvtpk_s(bf_lo(o.w) + bf_lo(e.w), bf_hi(o.w) + bf_hi(e.w)); }
                        gp_[0] = o; }
                }
            }
            if (step == 1 || step == 131) asm volatile("s_waitcnt vmcnt(0)" ::: "memory");
            BAR_LDS();
        }
    }
}
constexpr int GP_QM = 0, GP_KM = 17408, GP_AB = 34816, GP_LOW = 44032, GP_TOT = 48128, GP_DIR = 49152;
__device__ __forceinline__ void gla_prep_phase(LAS unsigned char* lds, const bf16_t* P, const float* LOW, const float* gw2, const float* gb2, bf16_t* QM, bf16_t* KM, bf16_t* AQ, float* EL, int G) {
    const int tid0 = opaque_tid(), hb = __builtin_amdgcn_readfirstlane(tid0 >> 8);
    for (int itb = blockIdx.x * 2; itb < 4160; itb += 2 * G) {
        const int it = itb + hb, dir = it & 1, head = (it >> 1) & 3, rb = it >> 3;
        const int tq = opaque_tid(), t = tq & 255, w = __builtin_amdgcn_readfirstlane((tq >> 6) & 3), lane = tq & 63, r = lane & 31, h = lane >> 5;
        LAS unsigned char* base = lds + hb * GP_DIR;
        LAS bf16_t* Qm = (LAS bf16_t*)(base + GP_QM); LAS bf16_t* Km = (LAS bf16_t*)(base + GP_KM); LAS bf16_t* Ab = (LAS bf16_t*)(base + GP_AB);
        LAS float* lowS = (LAS float*)(base + GP_LOW); LAS float* tot = (LAS float*)(base + GP_TOT);
        *(LAS f32x4*)(lowS + 4 * t) = *(const f32x4*)(LOW + (size_t)(rb * 64 + (t >> 2)) * 32 + dir * 16 + 4 * (t & 3));
        const int dk = t & 127, half = t >> 7, col = head * 128 + dk;
        float w2c[16];
#pragma unroll
        for (int rr = 0; rr < 16; ++rr) w2c[rr] = gw2[(size_t)(dir * 16 + rr) * 512 + col];
        const float b2 = gb2[dir * 512 + col];
        __syncthreads();
        float bc[32]; float run = 0.f;
#pragma unroll
        for (int n = 0; n < 32; ++n) { const int ip = 32 * half + n, i = dir ? 63 - ip : ip; float s = b2;
#pragma unroll
            for (int rr = 0; rr < 16; ++rr) s += lowS[i * 16 + rr] * w2c[rr];
            run += logsigmoid_f(s) * (1.f / 16.f); bc[n] = run; }
        tot[half * 128 + dk] = run;
        __syncthreads();
        const float t0 = tot[dk], last = t0 + tot[128 + dk], off = half ? t0 : 0.f;
        if (half == 0) EL[(size_t)(dir * 520 + rb) * 512 + col] = last;
        {
            const int i0 = dir ? 63 - 32 * half : 32 * half; const long pstep = dir ? -3072 : 3072;
            const bf16_t* pp = P + (size_t)(rb * 64 + i0) * 3072 + col;
#pragma unroll
            for (int n = 0; n < 32; ++n) { const int ip = 32 * half + n; const float bcv = bc[n] + off;
                const float qv = bf2f(pp[0]), kv = bf2f(pp[512]); pp += pstep;
                Qm[ip * 136 + dk] = f2bf(qv * 0.08838834764831845f * __expf(bcv - last));
                Km[ip * 136 + dk] = f2bf(kv * __expf(last - bcv)); }
        }
        __syncthreads();
        {
            const int ti = w >> 1, tj = w & 1;
            f32x16 acc;
#pragma unroll
            for (int x = 0; x < 16; ++x) acc[x] = 0.f;
            if (!(ti == 0 && tj == 1)) {
#pragma unroll
                for (int ks = 0; ks < 8; ++ks) acc = MFMA32(frag_nat(Qm, 136, 32 * ti + r, ks, h), frag_nat(Km, 136, 32 * tj + r, ks, h), acc);
            }
            const int j = 32 * tj + r;
#pragma unroll
            for (int x = 0; x < 16; ++x) { const int i = 32 * ti + crow(x, h); Ab[i * 72 + j] = f2bf(i >= j ? acc[x] : 0.f); }
            const int r0 = t >> 4, c8 = 8 * (t & 15);
#pragma unroll
            for (int v = 0; v < 4; ++v) { const int row = r0 + 16 * v; const size_t go = ((size_t)dir * MROWS + rb * 64 + row) * 512 + head * 128 + c8;
                *(u32x4*)(QM + go) = *(const LAS u32x4*)(Qm + row * 136 + c8); *(u32x4*)(KM + go) = *(const LAS u32x4*)(Km + row * 136 + c8); }
        }
        __syncthreads();
        {
            bf16_t* dst = AQ + (size_t)it * 4096;
#pragma unroll
            for (int k2 = 0; k2 < 2; ++k2) { const int c = t + 256 * k2, row = c >> 3, cc = c & 7; *(u32x4*)(dst + c * 8) = *(const LAS u32x4*)(Ab + row * 72 + 8 * cc); }
        }
        __syncthreads();
    }
}
constexpr int GL_QM = 0, GL_KM = 17408, GL_VB = 34816, GL_AB = 52224, GL_EL = 61440, GL_DIR = 61952;
struct GlPre { u32x4 q4[4], k4[4], v4[4], a0, a1; float elv; };
__device__ __forceinline__ void gl_prefetch(GlPre& p, const bf16_t* P, const bf16_t* QM, const bf16_t* KM, const bf16_t* AQ, const float* EL, int rb, int dir, int head, int hf, int t) {
    const int r0 = t >> 4, c8 = 8 * (t & 15);
    const bf16_t* aq = AQ + (size_t)((rb * 4 + head) * 2 + dir) * 4096;
#pragma unroll
    for (int v = 0; v < 4; ++v) { const size_t row = (size_t)(rb * 64 + r0 + 16 * v);
        p.q4[v] = *(const u32x4*)(QM + ((size_t)dir * MROWS + row) * 512 + head * 128 + c8);
        p.k4[v] = *(const u32x4*)(KM + ((size_t)dir * MROWS + row) * 512 + head * 128 + c8);
        p.v4[v] = *(const u32x4*)(P + row * 3072 + 1024 + head * 256 + hf * 128 + c8); }
    p.a0 = *(const u32x4*)(aq + t * 8); p.a1 = *(const u32x4*)(aq + (256 + t) * 8);
    p.elv = EL[(size_t)(dir * 520 + rb) * 512 + head * 128 + (t & 127)];
}
__device__ __forceinline__ void gla_scan(LAS unsigned char* lds, const bf16_t* P  , const bf16_t* QM, const bf16_t* KM, const bf16_t* AQ, const float* EL, bf16_t* OB  ) {
    const int tid = opaque_tid(), dir = __builtin_amdgcn_readfirstlane(tid >> 8);
    for (int unit = blockIdx.x; unit < 16; unit += gridDim.x) {
        const int b = unit >> 3, head = (unit >> 1) & 3, hf = unit & 1;
        f32x16 S[4];
#pragma unroll
        for (int kt = 0; kt < 4; ++kt)
#pragma unroll
            for (int x = 0; x < 16; ++x) S[kt][x] = 0.f;
        GlPre pre;
        { int rb0; bool f0; dn_step_rb(0, dir, b, rb0, f0); gl_prefetch(pre, P, QM, KM, AQ, EL, rb0, dir, head, hf, tid & 255); }
        __syncthreads();
        for (int step = 0; step < 260; ++step) {
            const int w = __builtin_amdgcn_readfirstlane((opaque_tid() >> 6) & 3);
            LAS unsigned char* base = lds + dir * GL_DIR;
            LAS bf16_t* Qm = (LAS bf16_t*)(base + GL_QM); LAS bf16_t* Km = (LAS bf16_t*)(base + GL_KM); LAS bf16_t* Vb = (LAS bf16_t*)(base + GL_VB); LAS bf16_t* Ab = (LAS bf16_t*)(base + GL_AB);
            LAS float* el = (LAS float*)(base + GL_EL);
            int rb; bool first; dn_step_rb(step, dir, b, rb, first);
            const int row_base = rb * 64;
            {
                const int tq_ = opaque_tid(), t = tq_ & 255;
                const int r0 = t >> 4, c8 = 8 * (t & 15);
#pragma unroll
                for (int v = 0; v < 4; ++v) { const int i = r0 + 16 * v, ip = dir ? 63 - i : i;
                    *(LAS u32x4*)(Qm + i * 136 + c8) = pre.q4[v]; *(LAS u32x4*)(Km + i * 136 + c8) = pre.k4[v]; *(LAS u32x4*)(Vb + ip * 136 + c8) = pre.v4[v]; }
                { const int c = t, row = c >> 3, cc = c & 7; *(LAS u32x4*)(Ab + row * 72 + 8 * cc) = pre.a0; }
                { const int c = 256 + t, row = c >> 3, cc = c & 7; *(LAS u32x4*)(Ab + row * 72 + 8 * cc) = pre.a1; }
                if (t < 128) el[t] = __expf(pre.elv);
            }
            BAR_LDS();
            if (step + 1 < 260) { int rbn; bool fn; dn_step_rb(step + 1, dir, b, rbn, fn); gl_prefetch(pre, P, QM, KM, AQ, EL, rbn, dir, head, hf, opaque_tid() & 255); }
            __builtin_amdgcn_sched_barrier(0);
            {
                const int tq_ = opaque_tid(), lane = tq_ & 63, r = lane & 31, h = lane >> 5;
#pragma unroll
                for (int kt = 0; kt < 4; ++kt)
#pragma unroll
                    for (int x = 0; x < 16; ++x) S[kt][x] *= el[32 * kt + crow(x, h)];
                bf16x8 Vf[4];
#pragma unroll
                for (int ks = 0; ks < 4; ++ks) Vf[ks] = frag_tr(Vb, 136, 32 * w, ks, lane);
                u32x4 eo[4];
                {
                    const int rr_ = lane >> 2, c8_ = 8 * (lane & 3);
                    if (!first) {
#pragma unroll
                        for (int v = 0; v < 4; ++v) { const int ip_ = rr_ + 16 * v, i_ = dir ? 63 - ip_ : ip_;
                            eo[v] = *(const u32x4*)(OB + (size_t)(row_base + i_) * 1024 + head * 256 + hf * 128 + 32 * w + c8_); }
                    } else {
                        unsigned z0 = 0u; asm volatile("" : "+v"(z0));
#pragma unroll
                        for (int v = 0; v < 4; ++v) eo[v] = (u32x4){z0, z0, z0, z0};
                    }
                }
                f32x16 O[2];
#pragma unroll
                for (int mt = 0; mt < 2; ++mt) {
#pragma unroll
                    for (int x = 0; x < 16; ++x) O[mt][x] = 0.f;
#pragma unroll
                    for (int ks = 0; ks < 4; ++ks) if (ks < 2 * mt + 2) O[mt] = MFMA32(frag_perm(Ab, 72, 32 * mt + r, ks, h), Vf[ks], O[mt]);
                }
                __builtin_amdgcn_sched_barrier(0);
#pragma unroll
                for (int ks = 0; ks < 8; ++ks) {
                    const bf16x8 sp = pack_step(S[ks >> 1], ks & 1);
#pragma unroll
                    for (int mt = 0; mt < 2; ++mt) O[mt] = MFMA32(frag_perm(Qm, 136, 32 * mt + r, ks, h), sp, O[mt]);
                    if (ks & 1) __builtin_amdgcn_sched_barrier(0);
                }
#pragma unroll
                for (int mt = 0; mt < 2; ++mt)
#pragma unroll
                    for (int x = 0; x < 16; ++x) Vb[(32 * mt + crow(x, h)) * 136 + 32 * w + r] = f2bf(O[mt][x]);
                __builtin_amdgcn_sched_barrier(0);
#pragma unroll
                for (int ks = 0; ks < 4; ++ks) {
#pragma unroll
                    for (int kt = 0; kt < 4; ++kt) S[kt] = MFMA32(frag_tr(Km, 136, 32 * kt, ks, lane), Vf[ks], S[kt]);
                    __builtin_amdgcn_sched_barrier(0);
                }
                {
                    const int rr_ = lane >> 2, c8_ = 8 * (lane & 3);
#pragma unroll
                    for (int v = 0; v < 4; ++v) { const int ip_ = rr_ + 16 * v, i_ = dir ? 63 - ip_ : ip_;
                        u32x4* gp_ = (u32x4*)(OB + (size_t)(row_base + i_) * 1024 + head * 256 + hf * 128 + 32 * w + c8_);
                        u32x4 o = *(const LAS u32x4*)(Vb + ip_ * 136 + 32 * w + c8_); const u32x4 e = eo[v];
                        if (!first) {
                            o.x = cvtpk_s(bf_lo(o.x) + bf_lo(e.x), bf_hi(o.x) + bf_hi(e.x)); o.y = cvtpk_s(bf_lo(o.y) + bf_lo(e.y), bf_hi(o.y) + bf_hi(e.y));
                            o.z = cvtpk_s(bf_lo(o.z) + bf_lo(e.z), bf_hi(o.z) + bf_hi(e.z)); o.w = cvtpk_s(bf_lo(o.w) + bf_lo(e.w), bf_hi(o.w) + bf_hi(e.w)); }
                        gp_[0] = o; }
                }
            }
            if (step == 1 || step == 131) asm volatile("s_waitcnt vmcnt(0)" ::: "memory");
            BAR_LDS();
        }
    }
}
typedef __bf16 v2bf_t __attribute__((ext_vector_type(2)));
__device__ __forceinline__ void atomic_add_bf16x8(bf16_t* p, const u32x4 v) {
    asm volatile("global_atomic_pk_add_bf16 %0, %1, off sc1\n\tglobal_atomic_pk_add_bf16 %0, %2, off offset:4 sc1\n\tglobal_atomic_pk_add_bf16 %0, %3, off offset:8 sc1\n\tglobal_atomic_pk_add_bf16 %0, %4, off offset:12 sc1"
                 :: "v"(p), "v"(v.x), "v"(v.y), "v"(v.z), "v"(v.w) : "memory");
}
constexpr int DN3_HGC = 2 * DN_DIR;
template <int VAR> __device__ __forceinline__ void dn_scan3(LAS unsigned char* lds, const bf16_t* P, const float* AB, const bf16_t* TP, bf16_t* OB) {
    const int tid0 = opaque_tid(), wv = __builtin_amdgcn_readfirstlane(tid0 >> 6), role = wv >> 2, w = wv & 3;
    for (int unit = blockIdx.x; unit < 64; unit += gridDim.x) {
        const int b = unit >> 5, vh = (unit >> 1) & 15, dir = unit & 1, kh = vh >> 1;
        __syncthreads();
        if (role == 1) {
            if (w < 3) {
                const int qh = w >= 1 ? 1 : 0, khh = w == 2 ? 1 : 0, ti = qh, tj = khh;
                u32x4 q8[8], k8[8]; float gcp;
                {
                    int rb; bool f_; dn_step_rb(0, dir, b, rb, f_);
                    const int lane = opaque_tid() & 63, r0 = lane >> 4, c8 = 8 * (lane & 15);
#pragma unroll
                    for (int v = 0; v < 8; ++v) { const int ipq = 32 * qh + r0 + 4 * v, ipk = 32 * khh + r0 + 4 * v, iq = dir ? 63 - ipq : ipq, ik = dir ? 63 - ipk : ipk;
                        q8[v] = *(const u32x4*)(P + (size_t)(rb * 64 + iq) * 4096 + kh * 128 + c8); k8[v] = *(const u32x4*)(P + (size_t)(rb * 64 + ik) * 4096 + 1024 + kh * 128 + c8); }
                    const int tl = dir ? 63 - lane : lane; gcp = AB[(size_t)(rb * 64 + tl) * 64 + dir * 16 + vh];
                }
                for (int j = 0; j < 260; ++j) {
                    const int lane = opaque_tid() & 63, r = lane & 31, h = lane >> 5, r0 = lane >> 4, c8 = 8 * (lane & 15);
                    LAS unsigned char* base = lds + (j & 1) * DN_DIR;
                    LAS bf16_t* Kb = (LAS bf16_t*)(base + DN_KB); LAS bf16_t* Qb = (LAS bf16_t*)(base + DN_QB); LAS bf16_t* Ab = (LAS bf16_t*)(base + DN_AB);
                    LAS float* hgc = (LAS float*)(lds + DN3_HGC + w * 256);
#pragma unroll
                    for (int v = 0; v < 8; ++v) { *(LAS u32x4*)(Qb + (32 * qh + r0 + 4 * v) * 136 + c8) = q8[v]; *(LAS u32x4*)(Kb + (32 * khh + r0 + 4 * v) * 136 + c8) = k8[v]; }
                    hgc[lane] = gcp;
                    asm volatile("s_waitcnt lgkmcnt(0)" ::: "memory");
                    if (j + 1 < 260) {
                        int rb; bool f_; dn_step_rb(j + 1, dir, b, rb, f_);
#pragma unroll
                        for (int v = 0; v < 8; ++v) { const int ipq = 32 * qh + r0 + 4 * v, ipk = 32 * khh + r0 + 4 * v, iq = dir ? 63 - ipq : ipq, ik = dir ? 63 - ipk : ipk;
                            q8[v] = *(const u32x4*)(P + (size_t)(rb * 64 + iq) * 4096 + kh * 128 + c8); k8[v] = *(const u32x4*)(P + (size_t)(rb * 64 + ik) * 4096 + 1024 + kh * 128 + c8); }
                        const int tl = dir ? 63 - lane : lane; gcp = AB[(size_t)(rb * 64 + tl) * 64 + dir * 16 + vh];
                    }
                    __builtin_amdgcn_sched_barrier(0);
                    {
                        f32x16 qk;
#pragma unroll
                        for (int x = 0; x < 16; ++x) qk[x] = 0.f;
#pragma unroll
                        for (int ks = 0; ks < 8; ++ks) qk = MFMA32(frag_nat(Qb, 136, 32 * ti + r, ks, h), frag_nat(Kb, 136, 32 * tj + r, ks, h), qk);
                        const int jj = 32 * tj + r; const float gj = hgc[jj];
#pragma unroll
                        for (int x = 0; x < 16; ++x) { const int i = 32 * ti + crow(x, h);
                            Ab[i * 72 + jj] = f2bf((i >= jj) ? qk[x] * __expf(hgc[i] - gj) : 0.f); }
                    }
                    BAR_LDS();
                }
                BAR_LDS();
            } else {
                u32x4 v16[16], t6[6]; float gcp, betap;
                {
                    int rb; bool f_; dn_step_rb(0, dir, b, rb, f_);
                    const int lane = opaque_tid() & 63, r0 = lane >> 4, c8 = 8 * (lane & 15);
#pragma unroll
                    for (int v = 0; v < 16; ++v) { const int ip = r0 + 4 * v, i = dir ? 63 - ip : ip; v16[v] = *(const u32x4*)(P + (size_t)(rb * 64 + i) * 4096 + 2048 + vh * 128 + c8); }
                    const bf16_t* tp = TP + (size_t)((rb * 16 + vh) * 2 + dir) * 3072;
#pragma unroll
                    for (int v = 0; v < 6; ++v) t6[v] = *(const u32x4*)(tp + (lane + 64 * v) * 8);
                    const int tl = dir ? 63 - lane : lane; const float* ab = AB + (size_t)(rb * 64 + tl) * 64; gcp = ab[dir * 16 + vh]; betap = ab[32 + dir * 16 + vh];
                }
                for (int j = 0; j < 260; ++j) {
                    const int lane = opaque_tid() & 63, r0 = lane >> 4, c8 = 8 * (lane & 15);
                    LAS unsigned char* base = lds + (j & 1) * DN_DIR;
                    LAS bf16_t* Vb = (LAS bf16_t*)(base + DN_VB); LAS bf16_t* Tb = (LAS bf16_t*)(base + DN_TB);
                    LAS float* sc_beta = (LAS float*)(base + DN_SC); LAS float* sc_gc = sc_beta + 64; LAS float* sc_eg = sc_beta + 128; LAS float* sc_tail = sc_beta + 192; LAS float* sc_dl = sc_beta + 256;
                    if (j >= 2) {
                        int rbo; bool fo_; dn_step_rb(j - 2, dir, b, rbo, fo_);
#pragma unroll
                        for (int v = 0; v < 16; ++v) { const int ip_ = r0 + 4 * v, i_ = dir ? 63 - ip_ : ip_;
                            atomic_add_bf16x8(OB + (size_t)(rbo * 64 + i_) * 2048 + vh * 128 + c8, *(const LAS u32x4*)(Vb + ip_ * 128 + c8)); }
                        asm volatile("s_waitcnt lgkmcnt(0)" ::: "memory");
                    }
#pragma unroll
                    for (int v = 0; v < 16; ++v) *(LAS u32x4*)(Vb + (r0 + 4 * v) * 128 + c8) = v16[v];
#pragma unroll
                    for (int v = 0; v < 6; ++v) { const int c = lane + 64 * v, blk = c >> 7, rowc = (c & 127) >> 2, cc = c & 3, br = blk ? 1 : 0, bc = blk == 2 ? 1 : 0;
                        *(LAS u32x4*)(Tb + (32 * br + rowc) * 72 + 32 * bc + 8 * cc) = t6[v]; }
                    { const float gc = gcp, gl = __shfl(gc, 63); sc_beta[lane] = betap; sc_gc[lane] = gc; sc_eg[lane] = __expf(gc); sc_tail[lane] = __expf(gl - gc); if (lane == 0) sc_dl[0] = __expf(gl); }
                    if (j + 1 < 260) {
                        int rb; bool f_; dn_step_rb(j + 1, dir, b, rb, f_);
#pragma unroll
                        for (int v = 0; v < 16; ++v) { const int ip = r0 + 4 * v, i = dir ? 63 - ip : ip; v16[v] = *(const u32x4*)(P + (size_t)(rb * 64 + i) * 4096 + 2048 + vh * 128 + c8); }
                        const bf16_t* tp = TP + (size_t)((rb * 16 + vh) * 2 + dir) * 3072;
#pragma unroll
                        for (int v = 0; v < 6; ++v) t6[v] = *(const u32x4*)(tp + (lane + 64 * v) * 8);
                        const int tl = dir ? 63 - lane : lane; const float* ab = AB + (size_t)(rb * 64 + tl) * 64; gcp = ab[dir * 16 + vh]; betap = ab[32 + dir * 16 + vh];
                    }
                    BAR_LDS();
                }
                {
                    const int lane = opaque_tid() & 63, r0 = lane >> 4, c8 = 8 * (lane & 15);
#pragma unroll 1
                    for (int jj = 258; jj < 260; ++jj) {
                        if (jj == 259) BAR_LDS();
                        LAS bf16_t* Vb = (LAS bf16_t*)(lds + (jj & 1) * DN_DIR + DN_VB);
                        int rbo; bool fo_; dn_step_rb(jj, dir, b, rbo, fo_);
#pragma unroll
                        for (int v = 0; v < 16; ++v) { const int ip_ = r0 + 4 * v, i_ = dir ? 63 - ip_ : ip_;
                            atomic_add_bf16x8(OB + (size_t)(rbo * 64 + i_) * 2048 + vh * 128 + c8, *(const LAS u32x4*)(Vb + ip_ * 128 + c8)); }
                    }
                }
            }
        } else {
            f32x16 S[4];
#pragma unroll
            for (int kt = 0; kt < 4; ++kt)
#pragma unroll
                for (int x = 0; x < 16; ++x) S[kt][x] = 0.f;
            BAR_LDS();
            for (int step = 0; step < 260; ++step) {
                const int lane = opaque_tid() & 63, r = lane & 31, h = lane >> 5;
                LAS unsigned char* base = lds + (step & 1) * DN_DIR;
                LAS bf16_t* Kb = (LAS bf16_t*)(base + DN_KB); LAS bf16_t* Qb = (LAS bf16_t*)(base + DN_QB); LAS bf16_t* Vb = (LAS bf16_t*)(base + DN_VB);
                LAS bf16_t* Tb = (LAS bf16_t*)(base + DN_TB); LAS bf16_t* Ab = (LAS bf16_t*)(base + DN_AB);
                LAS float* sc_beta = (LAS float*)(base + DN_SC); LAS float* sc_eg = sc_beta + 128; LAS float* sc_tail = sc_beta + 192; LAS float* sc_dl = sc_beta + 256;
                int rb; bool f_; dn_step_rb(step, dir, b, rb, f_);
                if (VAR != 2) {
                f32x16 KS[2], QS[2];
#pragma unroll
                for (int mt = 0; mt < 2; ++mt)
#pragma unroll
                    for (int x = 0; x < 16; ++x) { KS[mt][x] = 0.f; QS[mt][x] = 0.f; }
#pragma unroll
                for (int ks = 0; ks < 8; ++ks) {
                    const bf16x8 sp = pack_step(S[ks >> 1], ks & 1);
#pragma unroll
                    for (int mt = 0; mt < 2; ++mt) { KS[mt] = MFMA32(frag_perm(Kb, 136, 32 * mt + r, ks, h), sp, KS[mt]); QS[mt] = MFMA32(frag_perm(Qb, 136, 32 * mt + r, ks, h), sp, QS[mt]); }
                }
#pragma unroll
                for (int mt = 0; mt < 2; ++mt)
#pragma unroll
                    for (int g4 = 0; g4 < 4; ++g4) { const int i0 = 32 * mt + 8 * g4 + 4 * h;
                        const f32x4 bv = *(const LAS f32x4*)(sc_beta + i0), ev = *(const LAS f32x4*)(sc_eg + i0);
#pragma unroll
                        for (int e = 0; e < 4; ++e) { const int x = 4 * g4 + e; KS[mt][x] = bv[e] * (bf2f(Vb[(i0 + e) * 128 + 32 * w + r]) - ev[e] * KS[mt][x]); } }
                bf16x8 Xp[4];
#pragma unroll
                for (int ks = 0; ks < 4; ++ks) Xp[ks] = pack_step(KS[ks >> 1], ks & 1);
                f32x16 VN[2];
#pragma unroll
                for (int mt = 0; mt < 2; ++mt) {
#pragma unroll
                    for (int x = 0; x < 16; ++x) VN[mt][x] = 0.f;
#pragma unroll
                    for (int ks = 0; ks < 4; ++ks) if (ks < 2 * mt + 2) VN[mt] = MFMA32(frag_perm(Tb, 72, 32 * mt + r, ks, h), Xp[ks], VN[mt]);
                }
                bf16x8 VNp[4];
#pragma unroll
                for (int ks = 0; ks < 4; ++ks) VNp[ks] = pack_step(VN[ks >> 1], ks & 1);
#pragma unroll
                for (int mt = 0; mt < 2; ++mt) {
#pragma unroll
                    for (int g4 = 0; g4 < 4; ++g4) { const f32x4 ev = *(const LAS f32x4*)(sc_eg + 32 * mt + 8 * g4 + 4 * h);
#pragma unroll
                        for (int e = 0; e < 4; ++e) QS[mt][4 * g4 + e] *= ev[e]; }
#pragma unroll
                    for (int ks = 0; ks < 4; ++ks) if (ks < 2 * mt + 2) QS[mt] = MFMA32(frag_perm(Ab, 72, 32 * mt + r, ks, h), VNp[ks], QS[mt]);
                }
#pragma unroll
                for (int mt = 0; mt < 2; ++mt)
#pragma unroll
                    for (int x = 0; x < 16; ++x) Vb[(32 * mt + crow(x, h)) * 128 + 32 * w + r] = f2bf(QS[mt][x]);
#pragma unroll
                for (int mt = 0; mt < 2; ++mt)
#pragma unroll
                    for (int g4 = 0; g4 < 4; ++g4) { const f32x4 tv = *(const LAS f32x4*)(sc_tail + 32 * mt + 8 * g4 + 4 * h);
#pragma unroll
                        for (int e = 0; e < 4; ++e) VN[mt][4 * g4 + e] *= tv[e]; }
#pragma unroll
                for (int ks = 0; ks < 4; ++ks) VNp[ks] = pack_step(VN[ks >> 1], ks & 1);
                const float dl = sc_dl[0];
#pragma unroll
                for (int kt = 0; kt < 4; ++kt)
#pragma unroll
                    for (int x = 0; x < 16; ++x) S[kt][x] *= dl;
#pragma unroll
                for (int ks = 0; ks < 4; ++ks) {
#pragma unroll
                    for (int kt = 0; kt < 4; ++kt) S[kt] = MFMA32(frag_tr(Kb, 136, 32 * kt, ks, lane), VNp[ks], S[kt]);
                }
                }
                BAR_LDS();
            }
        }
    }
}
__device__ __forceinline__ void gla_scan3(LAS unsigned char* lds, bf16_t* P  , const bf16_t* QM, const bf16_t* KM, const bf16_t* AQ, const float* EL, bf16_t* OB  ) {
    const int tid0 = opaque_tid(), wv = __builtin_amdgcn_readfirstlane(tid0 >> 6), role = wv >> 2, w = wv & 3;
    for (int unit = blockIdx.x; unit < 32; unit += gridDim.x) {
        const int b = unit >> 4, head = (unit >> 2) & 3, hf = (unit >> 1) & 1, dir = unit & 1;
        __syncthreads();
        if (role == 1) {
            GlPre pre;
            { int rb0; bool f0; dn_step_rb(0, dir, b, rb0, f0); gl_prefetch(pre, P, QM, KM, AQ, EL, rb0, dir, head, hf, opaque_tid() & 255); }
            for (int j = 0; j < 260; ++j) {
                const int t = opaque_tid() & 255;
                LAS unsigned char* base = lds + (j & 1) * GL_DIR;
                LAS bf16_t* Qm = (LAS bf16_t*)(base + GL_QM); LAS bf16_t* Km = (LAS bf16_t*)(base + GL_KM); LAS bf16_t* Vb = (LAS bf16_t*)(base + GL_VB); LAS bf16_t* Ab = (LAS bf16_t*)(base + GL_AB);
                LAS float* el = (LAS float*)(base + GL_EL);
                const int r0 = t >> 4, c8 = 8 * (t & 15);
#pragma unroll
                for (int v = 0; v < 4; ++v) { const int i = r0 + 16 * v, ip = dir ? 63 - i : i;
                    *(LAS u32x4*)(Qm + i * 136 + c8) = pre.q4[v]; *(LAS u32x4*)(Km + i * 136 + c8) = pre.k4[v]; *(LAS u32x4*)(Vb + ip * 136 + c8) = pre.v4[v]; }
                { const int c = t, row = c >> 3, cc = c & 7; *(LAS u32x4*)(Ab + row * 72 + 8 * cc) = pre.a0; }
                { const int c = 256 + t, row = c >> 3, cc = c & 7; *(LAS u32x4*)(Ab + row * 72 + 8 * cc) = pre.a1; }
                if (t < 128) el[t] = __expf(pre.elv);
                if (j + 1 < 260) { int rbn; bool fn; dn_step_rb(j + 1, dir, b, rbn, fn); gl_prefetch(pre, P, QM, KM, AQ, EL, rbn, dir, head, hf, t); }
                BAR_LDS();
            }
            BAR_LDS();
        } else {
            f32x16 S[4];
#pragma unroll
            for (int kt = 0; kt < 4; ++kt)
#pragma unroll
                for (int x = 0; x < 16; ++x) S[kt][x] = 0.f;
            BAR_LDS();
            for (int step = 0; step < 260; ++step) {
                const int lane = opaque_tid() & 63, r = lane & 31, h = lane >> 5;
                LAS unsigned char* base = lds + (step & 1) * GL_DIR;
                LAS bf16_t* Qm = (LAS bf16_t*)(base + GL_QM); LAS bf16_t* Km = (LAS bf16_t*)(base + GL_KM); LAS bf16_t* Vb = (LAS bf16_t*)(base + GL_VB); LAS bf16_t* Ab = (LAS bf16_t*)(base + GL_AB);
                LAS float* el = (LAS float*)(base + GL_EL);
                int rb; bool f_; dn_step_rb(step, dir, b, rb, f_);
#pragma unroll
                for (int kt = 0; kt < 4; ++kt)
#pragma unroll
                    for (int g4 = 0; g4 < 4; ++g4) { const f32x4 ev = *(const LAS f32x4*)(el + 32 * kt + 8 * g4 + 4 * h);
#pragma unroll
                        for (int e = 0; e < 4; ++e) S[kt][4 * g4 + e] *= ev[e]; }
                bf16x8 Vf[4];
#pragma unroll
                for (int ks = 0; ks < 4; ++ks) Vf[ks] = frag_tr(Vb, 136, 32 * w, ks, lane);
                f32x16 O[2];
#pragma unroll
                for (int mt = 0; mt < 2; ++mt) {
#pragma unroll
                    for (int x = 0; x < 16; ++x) O[mt][x] = 0.f;
#pragma unroll
                    for (int ks = 0; ks < 4; ++ks) if (ks < 2 * mt + 2) O[mt] = MFMA32(frag_perm(Ab, 72, 32 * mt + r, ks, h), Vf[ks], O[mt]);
                }
                __builtin_amdgcn_sched_barrier(0);
#pragma unroll
                for (int ks = 0; ks < 8; ++ks) {
                    const bf16x8 sp = pack_step(S[ks >> 1], ks & 1);
#pragma unroll
                    for (int mt = 0; mt < 2; ++mt) O[mt] = MFMA32(frag_perm(Qm, 136, 32 * mt + r, ks, h), sp, O[mt]);
                    if (ks & 1) __builtin_amdgcn_sched_barrier(0);
                }
#pragma unroll
                for (int mt = 0; mt < 2; ++mt)
#pragma unroll
                    for (int x = 0; x < 16; ++x) Vb[(32 * mt + crow(x, h)) * 136 + 32 * w + r] = f2bf(O[mt][x]);
                __builtin_amdgcn_sched_barrier(0);
#pragma unroll
                for (int ks = 0; ks < 4; ++ks) {
#pragma unroll
                    for (int kt = 0; kt < 4; ++kt) S[kt] = MFMA32(frag_tr(Km, 136, 32 * kt, ks, lane), Vf[ks], S[kt]);
                    __builtin_amdgcn_sched_barrier(0);
                }
                asm volatile("s_waitcnt lgkmcnt(0)" ::: "memory");
                {
                    const int rr_ = lane >> 2, c8_ = 8 * (lane & 3);
#pragma unroll
                    for (int v = 0; v < 4; ++v) { const int ip_ = rr_ + 16 * v, i_ = dir ? 63 - ip_ : ip_; const int oc_ = head * 256 + hf * 128 + 32 * w + c8_;
                        bf16_t* dst_ = dir ? P + (size_t)(rb * 64 + i_) * 3072 + oc_ : OB + (size_t)(rb * 64 + i_) * 1024 + oc_;
                        *(u32x4*)dst_ = *(const LAS u32x4*)(Vb + ip_ * 136 + 32 * w + c8_); }
                }
                BAR_LDS();
            }
        }
    }
}
#define XB_TMO      128
#define XB_XCNT(j)  (256  + 64 * (j))
#define XB_XSUB(j)  (1280 + 64 * (j))
#define XB_XGEN(j)  (2304 + 64 * (j))
#define XB_TOP      3328
#define XB_TOPGEN   3392
#define XCD_BAR_WORDS 3456
#define XB_SPIN_CAP (1u << 23)

__device__ __forceinline__ unsigned xb_ld(unsigned* p)              { return __hip_atomic_load(p, __ATOMIC_RELAXED, __HIP_MEMORY_SCOPE_AGENT); }
__device__ __forceinline__ unsigned xb_add(unsigned* p, unsigned v) { return __hip_atomic_fetch_add(p, v, __ATOMIC_RELAXED, __HIP_MEMORY_SCOPE_AGENT); }
__device__ __forceinline__ unsigned xb_xcc_id() { return (unsigned)__builtin_amdgcn_s_getreg((3 << 11) | 20) & 0xFu; }
#define XB_SPIN(cond, bar) do { unsigned _sp = 0; while (cond) { __builtin_amdgcn_s_sleep(1); \
    if ((++_sp & 255u) == 0u) { if (xb_ld(&(bar)[XB_TMO])) break; if (_sp > XB_SPIN_CAP) { atomicAdd(&(bar)[XB_TMO], 1u); break; } } } } while (0)

struct XcdBarrier {
    unsigned* bar; unsigned x;
    volatile LAS unsigned* st;
};

__device__ __forceinline__ XcdBarrier xcd_barrier_post(unsigned* bar, volatile LAS unsigned* st) {
    XcdBarrier b; b.bar = bar; b.x = xb_xcc_id(); b.st = st;
    if (threadIdx.x == 0) (void)xb_add(&bar[XB_XCNT(b.x)], 1u);
    return b;
}
__device__ __forceinline__ void xcd_barrier_complete(unsigned* bar, unsigned x, unsigned& nloc, unsigned& nx) {
    const unsigned G = gridDim.x * gridDim.y * gridDim.z;
    unsigned sum, cnt, mine, sp = 0u;
    for (;;) {
        sum = 0u; cnt = 0u; mine = 0u;
#pragma unroll
        for (unsigned j = 0; j < 16; ++j) { const unsigned c = xb_ld(&bar[XB_XCNT(j)]); sum += c; cnt += (c > 0u) ? 1u : 0u; mine = (j == x) ? c : mine; }
        if (sum == G) break;
        __builtin_amdgcn_s_sleep(1);
        if ((++sp & 255u) == 0u) { if (xb_ld(&bar[XB_TMO])) break; if (sp > XB_SPIN_CAP) { atomicAdd(&bar[XB_TMO], 1u); break; } }
    }
    nloc = mine > 0u ? mine : 1u; nx = cnt > 0u ? cnt : 1u;
}

__device__ __forceinline__ void xcd_barrier(const XcdBarrier& b) {
    asm volatile("s_waitcnt vmcnt(0)" ::: "memory");
    __syncthreads();
    if (threadIdx.x == 0) {
        unsigned* bar = b.bar;
        __builtin_amdgcn_s_waitcnt(0);
        unsigned nloc = b.st[0], nx = b.st[1];
        if (nloc == 0u) { xcd_barrier_complete(bar, b.x, nloc, nx); b.st[0] = nloc; b.st[1] = nx; }
        const unsigned old = xb_add(&bar[XB_XSUB(b.x)], 1u);
        const unsigned gen = old / nloc;
        if (old + 1u == (gen + 1u) * nloc) {
            __builtin_amdgcn_fence(__ATOMIC_RELEASE, "agent");
            asm volatile("s_waitcnt vmcnt(0)" ::: "memory");
            const unsigned og = xb_add(&bar[XB_TOP], 1u);
            const unsigned tg = og / nx;
            if (og + 1u == (tg + 1u) * nx) xb_add(&bar[XB_TOPGEN], 1u);
            else XB_SPIN(xb_ld(&bar[XB_TOPGEN]) == tg, bar);
            __builtin_amdgcn_fence(__ATOMIC_ACQUIRE, "agent");
            xb_add(&bar[XB_XGEN(b.x)], 1u);
            asm volatile("s_waitcnt vmcnt(0)" ::: "memory");
        } else {
            XB_SPIN(xb_ld(&bar[XB_XGEN(b.x)]) == gen, bar);
            __builtin_amdgcn_fence(__ATOMIC_ACQUIRE, "agent");
            asm volatile("s_waitcnt vmcnt(0)" ::: "memory");
        }
    }
    __syncthreads();
}

#define DUP_DN 0
#define DN_VARIANT 0
#define DN_VAR_PARITY0 0
#define DUP_GLA 0
#define DUP_ATT 0
#define DUP_GIN 0
#define DUP_FFN1 0
constexpr unsigned long long pack_ops(const int* ops, int n) { unsigned long long v = 0; for (int i = 0; i < n; ++i) v |= (unsigned long long)ops[i] << (5 * i); return v; }
struct OpList { unsigned long long code; int n; };
constexpr OpList make_list(int mix) {
    int ops[16] = {}; int n = 0;
    ops[n++] = OP_PREP; ops[n++] = OP_GEMM_IN; if (DUP_GIN && mix != 0) ops[n++] = OP_GEMM_IN;
    if (mix == 0) { ops[n++] = OP_DNCONV; ops[n++] = OP_DNT; ops[n++] = OP_DNSCAN; if (DUP_DN) ops[n++] = OP_DNSCAN; ops[n++] = OP_DNREDO; ops[n++] = OP_GEMM_Z; }
    else if (mix == 1) { ops[n++] = OP_GLAPREP; ops[n++] = OP_GLASCAN; ops[n++] = OP_GLAGATE; }
    else { ops[n++] = OP_QKROPE; ops[n++] = OP_ATTN; if (DUP_ATT) ops[n++] = OP_ATTN; }
    ops[n++] = OP_GEMM_OUT; ops[n++] = OP_NORM2; ops[n++] = OP_FFN1; if (DUP_FFN1 && mix != 0) ops[n++] = OP_FFN1; ops[n++] = OP_FFN2;
    return OpList{pack_ops(ops, n), n};
}
constexpr OpList L_DN = make_list(0), L_GL = make_list(1), L_AT = make_list(2);
constexpr int NPHASE = 1 + 2 * L_DN.n + L_GL.n + L_AT.n;
__device__ __forceinline__ void decode_phase(int ph, int& layer, int& op) {
    if (ph == 0) { layer = 0; op = OP_MOD; return; }
    int p = ph - 1;
    if (p < L_DN.n) { layer = 0; op = (int)((L_DN.code >> (5 * p)) & 31ull); return; } p -= L_DN.n;
    if (p < L_GL.n) { layer = 1; op = (int)((L_GL.code >> (5 * p)) & 31ull); return; } p -= L_GL.n;
    if (p < L_AT.n) { layer = 2; op = (int)((L_AT.code >> (5 * p)) & 31ull); return; } p -= L_AT.n;
    layer = 3; op = (int)((L_DN.code >> (5 * p)) & 31ull);
}

__global__ void __launch_bounds__(512, 2) mega(Args args) {
    extern __shared__ __attribute__((aligned(16))) unsigned char lds_raw[];
    LAS unsigned char* lds = (LAS unsigned char*)lds_raw;
    cg::grid_group grid = cg::this_grid();
    volatile LAS unsigned* xb_st = (volatile LAS unsigned*)(lds + LDS_BYTES - 64);
    if (threadIdx.x < 2) xb_st[threadIdx.x] = 0u;
    __syncthreads();
    const XcdBarrier xbar = xcd_barrier_post((unsigned*)(args.ws + WS_BAR), xb_st);
    const int G = gridDim.x, NGW = G * 8;
    unsigned char* ws = args.ws;
    const float* x_in = args.in[0]; const float* c_in = args.in[1]; const float* ctx_in = args.in[2]; const float* cctx_in = args.in[3];
    const float* ada_w = args.in[4]; const float* ada_b = args.in[5]; const float* norm_mix_g = args.in[6]; const float* norm_ffn_g = args.in[7];
    const float* ffn_w1 = args.in[8]; const float* ffn_w2 = args.in[9];
    float* MOD = (float*)(ws + WS_MOD); float* CTXC = (float*)(ws + WS_CTX); bf16_t* H = (bf16_t*)(ws + WS_H); float* ABF = (float*)(ws + WS_AB); float* RSTD = (float*)(ws + WS_RSTD);
    bf16_t* PB = (bf16_t*)(ws + WS_P); float* out = args.out;

    for (int ph = args.ph_lo; ph < args.ph_hi; ++ph) {
        int layer, op; decode_phase(ph, layer, op);
        const int mix = layer % 3, slot = layer / 3;
        const float* modl = MOD + (size_t)layer * 3 * 6144;
        const float* xl = layer == 0 ? x_in : out; const float* xc = layer == 0 ? ctx_in : CTXC;
        if (op == OP_MOD) {
            const int tid = opaque_tid(), lane = tid & 63, wave = __builtin_amdgcn_readfirstlane(tid >> 6); const int gw = blockIdx.x * 8 + wave; (void)lane; (void)gw; (void)tid;
            LAS float* sl = (LAS float*)lds; LAS float* red = sl + 3 * 1024;
            for (int e = tid; e < 3 * 1024; e += 512) { const float v = e < 2048 ? c_in[e] : cctx_in[e - 2048]; sl[e] = silu_f(v); }
            __syncthreads();
            for (int item = blockIdx.x; item < 4 * 96; item += G) {
                const int ly = item / 96, col = (item % 96) * 64 + lane;
                const float* wp = ada_w + ((size_t)ly * 1024 + 128 * wave) * 6144 + col;
                float a0 = 0.f, a1 = 0.f, a2 = 0.f;
#pragma unroll 8
                for (int k = 0; k < 128; ++k) { const float wv = wp[(size_t)k * 6144]; const int kk = 128 * wave + k; a0 += sl[kk] * wv; a1 += sl[1024 + kk] * wv; a2 += sl[2048 + kk] * wv; }
                red[(wave * 3 + 0) * 64 + lane] = a0; red[(wave * 3 + 1) * 64 + lane] = a1; red[(wave * 3 + 2) * 64 + lane] = a2;
                __syncthreads();
                if (tid < 192) { const int m = tid >> 6; float s = ada_b[(size_t)ly * 6144 + col];
#pragma unroll
                    for (int w2 = 0; w2 < 8; ++w2) s += red[(w2 * 3 + m) * 64 + lane];
                    MOD[((size_t)ly * 3 + m) * 6144 + col] = s; }
                __syncthreads();
            }
        } else if (op == OP_PREP) {
            const int tid = opaque_tid(), lane = tid & 63, wave = __builtin_amdgcn_readfirstlane(tid >> 6); const int gw = blockIdx.x * 8 + wave; (void)lane; (void)gw; (void)tid;
            LAS float* scr = (LAS float*)(lds + wave * 16384);
            unsigned z0 = 0u; asm volatile("" : "+v"(z0)); const u32x4 zv = (u32x4){z0, z0, z0, z0};
            bf16_t* wtA = (bf16_t*)(ws + WT_A); bf16_t* wtZ = (bf16_t*)(ws + WT_Z); bf16_t* wtO = (bf16_t*)(ws + WT_O); bf16_t* wt1 = (bf16_t*)(ws + WT_1); bf16_t* wt2 = (bf16_t*)(ws + WT_2);
            if (mix == 0) {
                const float* w_in = args.in[10] + (size_t)slot * 1024 * 6208; const float* w_out = args.in[15] + (size_t)slot * 2048 * 1024;
                transpose_mat(w_in, 6208, 0, 4096, 1024, wtA, 0, scr, gw, NGW, lane);
                transpose_mat(w_in, 6208, 6144, 64, 1024, wtA, 4096, scr, gw, NGW, lane);
                for (size_t e = (size_t)blockIdx.x * 512 + tid; e < (size_t)192 * 1024 * 2 / 16; e += (size_t)G * 512) ((u32x4*)(wtA + (size_t)4160 * 1024))[e] = zv;
            } else if (mix == 1) {
                const float* w_in = args.in[16]; const float* w_out = args.in[20];
                transpose_mat(w_in, 3104, 0, 3104, 1024, wtA, 0, scr, gw, NGW, lane);
                for (size_t e = (size_t)blockIdx.x * 512 + tid; e < (size_t)224 * 1024 * 2 / 16; e += (size_t)G * 512) ((u32x4*)(wtA + (size_t)3104 * 1024))[e] = zv;
                transpose_mat(w_out, 1024, 0, 1024, 1024, wtO, 0, scr, gw, NGW, lane);
            } else {
                const float* w_in = args.in[21]; const float* w_out = args.in[24];
                transpose_mat(w_in, 1536, 0, 1536, 1024, wtA, 0, scr, gw, NGW, lane);
                transpose_mat(w_out, 1024, 0, 1024, 1024, wtO, 0, scr, gw, NGW, lane);
            }
            if (mix != 0) {
                transpose_mat(ffn_w1 + (size_t)layer * 1024 * 4096, 4096, 0, 4096, 1024, wt1, 0, scr, gw, NGW, lane);
                transpose_mat(ffn_w2 + (size_t)layer * 4096 * 1024, 1024, 0, 1024, 4096, wt2, 0, scr, gw, NGW, lane);
            }
            normmod_rows(xl, xc, norm_mix_g + (size_t)layer * 1024, modl, 0, H, gw, NGW, lane);
        } else if (op == OP_DNREDO) {
            const int tid = opaque_tid(), lane = tid & 63, wave = __builtin_amdgcn_readfirstlane(tid >> 6); const int gw = blockIdx.x * 8 + wave; (void)lane; (void)gw; (void)tid;
            LAS float* scr = (LAS float*)(lds + wave * 16384);
            const float* w_in = args.in[10] + (size_t)slot * 1024 * 6208; const float* w_out = args.in[15] + (size_t)slot * 2048 * 1024;
            transpose_mat(w_in, 6208, 4096, 2048, 1024, (bf16_t*)(ws + WT_Z), 0, scr, gw, NGW, lane);
            transpose_mat(w_out, 1024, 0, 1024, 2048, (bf16_t*)(ws + WT_O), 0, scr, gw, NGW, lane);
            transpose_mat(ffn_w1 + (size_t)layer * 1024 * 4096, 4096, 0, 4096, 1024, (bf16_t*)(ws + WT_1), 0, scr, gw, NGW, lane);
            transpose_mat(ffn_w2 + (size_t)layer * 4096 * 1024, 1024, 0, 1024, 4096, (bf16_t*)(ws + WT_2), 0, scr, gw, NGW, lane);
            normmod_rows(xl, xc, norm_mix_g + (size_t)layer * 1024, modl, 0, H, gw, NGW, lane);
            const bf16_t* OB = (const bf16_t*)(ws + WS_O);
            for (int row = gw; row < MROWS; row += NGW) {
                const u32x4* p = (const u32x4*)(OB + (size_t)row * 2048 + 32 * lane); float ss = 0.f;
#pragma unroll
                for (int v = 0; v < 4; ++v) { const u32x4 q = p[v]; const float a0 = bf_lo(q.x), a1 = bf_hi(q.x), a2 = bf_lo(q.y), a3 = bf_hi(q.y), a4 = bf_lo(q.z), a5 = bf_hi(q.z), a6 = bf_lo(q.w), a7 = bf_hi(q.w);
                    ss += (a0 * a0 + a1 * a1) + (a2 * a2 + a3 * a3) + (a4 * a4 + a5 * a5) + (a6 * a6 + a7 * a7); }
                ss += __shfl_xor(ss, 1); ss += __shfl_xor(ss, 2);
                if ((lane & 3) == 0) RSTD[(size_t)row * 16 + (lane >> 2)] = rsqrtf(ss * (1.f / 128.f) + EPS);
            }
        } else if (op == OP_DNHALO) {
            dn_halo_phase(PB, (bf16_t*)(ws + WS_HALO), G);
        } else if (op == OP_DNCONV) {
            dn_conv_phase(PB, (const bf16_t*)(ws + WS_HALO), args.in[11] + (size_t)slot * 4096 * 5, G);
        } else if (op == OP_DNT) {
            dn_t_phase(lds, PB, ABF, (bf16_t*)(ws + WS_TP), args.in[12] + (size_t)slot * 32, args.in[13] + (size_t)slot * 32, G);
            {
                unsigned z0 = 0u; asm volatile("" : "+v"(z0)); const u32x4 zv = (u32x4){z0, z0, z0, z0}; u32x4* zp = (u32x4*)(ws + WS_O);
                for (size_t e = (size_t)blockIdx.x * 512 + opaque_tid(); e < (size_t)MROWS * 2048 * 2 / 16; e += (size_t)G * 512) zp[e] = zv;
            }
        } else if (op == OP_NORM2) {
            const int tid = opaque_tid(), lane = tid & 63, wave = __builtin_amdgcn_readfirstlane(tid >> 6); const int gw = blockIdx.x * 8 + wave; (void)lane; (void)gw; (void)tid;
            normmod_rows(out, CTXC, norm_ffn_g + (size_t)layer * 1024, modl, 3, H, gw, NGW, lane);
        } else if (op == OP_GEMM_IN || op == OP_GEMM_Z || op == OP_GEMM_OUT || op == OP_FFN1 || op == OP_FFN2) {
            pg8::Gemm g; pg8::Epi E;
            E.mode = 0; E.O = PB; E.ldc = 4096; E.tail_pn = -1; E.halo = nullptr; E.F = ABF; E.ldf = 64; E.nf = 64; E.rstd = RSTD; E.ng = args.in[14] + (size_t)slot * 128;
            E.src_lat = xl; E.src_ctx = xc; E.dst_lat = out; E.dst_ctx = CTXC; E.mod = modl; E.gidx = 2;
            g.M = (layer == 3 && op != OP_GEMM_IN) ? NLAT : MROWS; g.A = H; g.K = 1024;
            bf16_t* OBUF = (bf16_t*)(ws + (mix == 1 ? WS_OGLA : WS_O));
            if (op == OP_GEMM_IN) {
                g.Bt = (const bf16_t*)(ws + WT_A);
                if (mix == 0) { g.N = 4352; E.ldc = 4096; E.tail_pn = 16; E.ldf = 64; E.nf = 64; E.halo = (bf16_t*)(ws + WS_HALO); }
                else if (mix == 1) { g.N = 3328; E.ldc = 3072; E.tail_pn = 12; E.ldf = 32; E.nf = 32; }
                else { g.N = 1536; E.ldc = 1536; }
            } else if (op == OP_GEMM_Z) {
                g.Bt = (const bf16_t*)(ws + WT_Z); g.N = 2048; E.mode = 2; E.O = OBUF; E.ldc = 2048;
            } else if (op == OP_GEMM_OUT) {
                g.A = OBUF; g.K = mix == 0 ? 2048 : 1024; g.Bt = (const bf16_t*)(ws + WT_O); g.N = 1024; E.mode = 3; E.gidx = 2;
            } else if (op == OP_FFN1) {
                g.Bt = (const bf16_t*)(ws + WT_1); g.N = 4096; E.mode = 1; E.ldc = 4096;
            } else {
                g.A = PB; g.K = 4096; g.Bt = (const bf16_t*)(ws + WT_2); g.N = 1024; E.mode = 3; E.gidx = 5; E.src_lat = out; E.src_ctx = CTXC;
            }
            pg8::StaticOrder S; S.init(g.M, g.N, G, (int)blockIdx.x);
#ifndef NO_GEMM
            pg8::gemm_phase<pg8::Epi, pg8::StaticOrder, true, true>(lds, g, S, E);
#endif
        } else if (op == OP_DNSCAN) {
#ifndef NO_DN
            if (DN_VARIANT && (ph & 1) == 0) dn_scan3<DN_VARIANT>(lds, PB, ABF, (const bf16_t*)(ws + WS_TP), (bf16_t*)(ws + WS_O)); else dn_scan3<0>(lds, PB, ABF, (const bf16_t*)(ws + WS_TP), (bf16_t*)(ws + WS_O));
#endif
        } else if (op == OP_GLAPREP) {
            gla_prep_phase(lds, PB, ABF, args.in[17], args.in[18], (bf16_t*)(ws + WS_QM), (bf16_t*)(ws + WS_KM), (bf16_t*)(ws + WS_AQ), (float*)(ws + WS_EL), G);
        } else if (op == OP_GLASCAN) {
#ifndef NO_GLA
            gla_scan3(lds, PB, (const bf16_t*)(ws + WS_QM), (const bf16_t*)(ws + WS_KM), (const bf16_t*)(ws + WS_AQ), (const float*)(ws + WS_EL), (bf16_t*)(ws + WS_OGLA));
#endif
        } else if (op == OP_GLAGATE) {
            const int tid = opaque_tid(), lane = tid & 63, wave = __builtin_amdgcn_readfirstlane(tid >> 6); const int gw = blockIdx.x * 8 + wave; (void)lane; (void)gw; (void)tid;
            bf16_t* OB = (bf16_t*)(ws + WS_OGLA); const float* ng = args.in[19];
            for (int row = gw; row < MROWS; row += NGW) {
                u32x4* p = (u32x4*)(OB + (size_t)row * 1024 + 16 * lane); const u32x4* gp = (const u32x4*)(PB + (size_t)row * 3072 + 2048 + 16 * lane); const u32x4* pb2 = (const u32x4*)(PB + (size_t)row * 3072 + 16 * lane);
                float o[16], z[16]; float ss = 0.f;
#pragma unroll
                for (int v = 0; v < 2; ++v) { const u32x4 q = p[v], gq = gp[v], q2 = pb2[v];
                    o[8 * v + 0] = bf_lo(q.x) + bf_lo(q2.x); o[8 * v + 1] = bf_hi(q.x) + bf_hi(q2.x); o[8 * v + 2] = bf_lo(q.y) + bf_lo(q2.y); o[8 * v + 3] = bf_hi(q.y) + bf_hi(q2.y); o[8 * v + 4] = bf_lo(q.z) + bf_lo(q2.z); o[8 * v + 5] = bf_hi(q.z) + bf_hi(q2.z); o[8 * v + 6] = bf_lo(q.w) + bf_lo(q2.w); o[8 * v + 7] = bf_hi(q.w) + bf_hi(q2.w);
                    z[8 * v + 0] = bf_lo(gq.x); z[8 * v + 1] = bf_hi(gq.x); z[8 * v + 2] = bf_lo(gq.y); z[8 * v + 3] = bf_hi(gq.y); z[8 * v + 4] = bf_lo(gq.z); z[8 * v + 5] = bf_hi(gq.z); z[8 * v + 6] = bf_lo(gq.w); z[8 * v + 7] = bf_hi(gq.w); }
#pragma unroll
                for (int e = 0; e < 16; ++e) ss += o[e] * o[e];
                ss += __shfl_xor(ss, 1); ss += __shfl_xor(ss, 2); ss += __shfl_xor(ss, 4); ss += __shfl_xor(ss, 8);
                const float rs = rsqrtf(ss * (1.f / 256.f) + EPS); const int cb = (16 * lane) & 255;
#pragma unroll
                for (int v = 0; v < 2; ++v) { float rr[8];
#pragma unroll
                    for (int e = 0; e < 8; ++e) rr[e] = o[8 * v + e] * rs * ng[cb + 8 * v + e] * silu_f(z[8 * v + e]);
                    u32x4 wv; wv.x = cvtpk_s(rr[0], rr[1]); wv.y = cvtpk_s(rr[2], rr[3]); wv.z = cvtpk_s(rr[4], rr[5]); wv.w = cvtpk_s(rr[6], rr[7]); p[v] = wv; }
            }
        } else if (op == OP_QKROPE) {
            const int tid = opaque_tid(), lane = tid & 63, wave = __builtin_amdgcn_readfirstlane(tid >> 6); const int gw = blockIdx.x * 8 + wave; (void)lane; (void)gw; (void)tid;
            bf16_t* QR = (bf16_t*)(ws + WS_QR); bf16_t* KR = (bf16_t*)(ws + WS_KR); bf16_t* VR = (bf16_t*)(ws + WS_VR);
            const float* qg = args.in[22]; const float* kg = args.in[23];
            const int hf = lane >> 5, j = lane & 31, e1 = 64 * hf + j, e2 = e1 + 32;
            const float inv_freq = exp2f(-(float)(2 * j) * (1.f / 64.f) * 13.287712379549449f);
            const float gq1 = qg[e1], gq2 = qg[e2], gk1 = kg[e1], gk2 = kg[e2];
            for (int rowa = gw; rowa < MROWS; rowa += 2 * NGW) {
                float x1[2][10], x2[2][10]; unsigned short va[2][4]; int rws[2]; rws[0] = rowa; rws[1] = rowa + NGW < MROWS ? rowa + NGW : rowa;
#pragma unroll
                for (int q = 0; q < 2; ++q) { const bf16_t* pr = PB + (size_t)rws[q] * 1536;
#pragma unroll
                    for (int hd = 0; hd < 10; ++hd) { x1[q][hd] = bf2f(pr[hd * 128 + e1]); x2[q][hd] = bf2f(pr[hd * 128 + e2]); }
                    va[q][0] = pr[1280 + e1]; va[q][1] = pr[1280 + e2]; va[q][2] = pr[1408 + e1]; va[q][3] = pr[1408 + e2]; }
#pragma unroll
                for (int q = 0; q < 2; ++q) {
                    if (q == 1 && rowa + NGW >= MROWS) break;
                    const int row = rws[q];
                    const bool lat = row < NLAT; const int b = lat ? row / SEQ : (row - NLAT) / CTXL; const int tpos = lat ? row % SEQ : (row - NLAT) % CTXL;
                    float cs = 1.f, sn = 0.f;
                    if (lat) { const float pos = (float)(hf == 0 ? tpos / 64 : tpos % 64); const float ang = pos * inv_freq; sn = sinf(ang); cs = cosf(ang); }
                    const int kpos = lat ? tpos : SEQ + tpos;
#pragma unroll
                    for (int hd = 0; hd < 10; ++hd) {
                        const float a1 = x1[q][hd], a2 = x2[q][hd];
                        const float rinv = rsqrtf(wave_sum(a1 * a1 + a2 * a2) * (1.f / 128.f) + EPS);
                        const float y1 = a1 * rinv * (hd < 8 ? gq1 : gk1), y2 = a2 * rinv * (hd < 8 ? gq2 : gk2);
                        const float o1 = y1 * cs - y2 * sn, o2 = y1 * sn + y2 * cs;
                        bf16_t* dst = hd < 8 ? QR + (size_t)row * 1024 + hd * 128 : KR + ((size_t)(b * 2 + (hd - 8)) * SKV + kpos) * 128;
                        dst[e1] = f2bf(o1); dst[e2] = f2bf(o2);
                    }
#pragma unroll
                    for (int kv = 0; kv < 2; ++kv) { bf16_t* dst = VR + ((size_t)(b * 2 + kv) * SKV + kpos) * 128; dst[e1] = va[q][2 * kv]; dst[e2] = va[q][2 * kv + 1]; }
                }
            }
        } else if (op == OP_ATTN) {
            const attn::bf16* QR = (const attn::bf16*)(ws + WS_QR); const attn::bf16* KR = (const attn::bf16*)(ws + WS_KR); const attn::bf16* VR = (const attn::bf16*)(ws + WS_VR);
            attn::bf16* OB = (attn::bf16*)(ws + WS_O);
            for (int u = blockIdx.x; u < 1024 + 16; u += G) {
                size_t qoff, koff; int seq;
                if (u < 1024) { const int pair = u >> 8, b = pair >> 1, kvh = pair & 1, hh = (u >> 6) & 3, qb = u & 63, head = kvh * 4 + hh;
                    qoff = ((size_t)b * SEQ + (size_t)qb * 256) * 1024 + head * 128; koff = (size_t)(b * 2 + kvh) * SKV * 128; seq = SKV; }
                else { const int jx = u - 1024, b = jx >> 3, head = jx & 7, kvh = head >> 2;
                    qoff = ((size_t)NLAT + (size_t)b * CTXL) * 1024 + head * 128; koff = ((size_t)(b * 2 + kvh) * SKV + SEQ) * 128; seq = CTXL; }
                __syncthreads();
#ifndef NO_ATT
                attn::attn_dense_body<attn::bf16>(QR + qoff, KR + koff, VR + koff, OB + qoff, seq, (char*)lds_raw);
#endif
            }
        }
        if (ph + 1 < args.ph_hi) { if (ph == 0) grid.sync(); else xcd_barrier(xbar); }
    }
}

#ifndef MK_MULTI
#define MK_MULTI 0
#endif
extern "C" void kernel_launch(void* const* d_in, const int* in_sizes, int n_in, void* d_out, int out_size, void* d_ws, size_t ws_size, hipStream_t stream) {
    static int grid = 0;
    if (grid == 0) {
        if (n_in != 25 || ws_size < WS_END) { fprintf(stderr, "kernel_launch: unexpected n_in %d / ws_size %zu (need %zu)\n", n_in, ws_size, (size_t)WS_END); grid = -1; return; }
        int dev = 0, cus = 0, per_cu = 0;
        hipGetDevice(&dev); hipDeviceGetAttribute(&cus, hipDeviceAttributeMultiprocessorCount, dev);
        if (hipFuncSetAttribute((const void*)mega, hipFuncAttributeMaxDynamicSharedMemorySize, LDS_BYTES) != hipSuccess) { fprintf(stderr, "kernel_launch: hipFuncSetAttribute failed\n"); grid = -1; return; }
        if (hipOccupancyMaxActiveBlocksPerMultiprocessor(&per_cu, (const void*)mega, 512, LDS_BYTES) != hipSuccess || per_cu < 1) { fprintf(stderr, "kernel_launch: occupancy query says %d\n", per_cu); per_cu = 1; }
        (void)hipGetLastError();
        grid = cus * 1;
    }
    if (grid < 0) return;
    if (hipMemsetAsync((char*)d_ws + WS_BAR, 0, WS_BAR_BYTES, stream) != hipSuccess) { fprintf(stderr, "kernel_launch: memset of barrier words failed\n"); return; }
    Args a{};
    for (int i = 0; i < 25; ++i) a.in[i] = (const float*)d_in[i];
    a.out = (float*)d_out; a.ws = (unsigned char*)d_ws;
#if MK_MULTI
    for (int ph = 0; ph < NPHASE; ++ph) { a.ph_lo = ph; a.ph_hi = ph + 1; hipLaunchKernelGGL(mega, dim3(grid), dim3(512), LDS_BYTES, stream, a); }
#else
    a.ph_lo = 0; a.ph_hi = NPHASE;
    void* kargs[] = {&a};
    hipError_t e = hipLaunchCooperativeKernel((const void*)mega, dim3(grid), dim3(512), kargs, LDS_BYTES, stream);
    if (e != hipSuccess) fprintf(stderr, "cooperative launch failed: %s (grid %d)\n", hipGetErrorString(e), grid);
#endif
}
```

```cpp
#include <hip/hip_runtime.h>
#include <hip/hip_bf16.h>
#include <hip/hip_cooperative_groups.h>
#include <cstdio>
#include <cstdint>
namespace cg = cooperative_groups;
__device__ __forceinline__ int opaque_tid() { int t = threadIdx.x; asm volatile("" : "+v"(t)); return t; }
namespace pg8 {
#define PG8_LAS __attribute__((address_space(3)))
typedef unsigned short bf16_t;
typedef short bf16x8 __attribute__((ext_vector_type(8)));
typedef float f32x4 __attribute__((ext_vector_type(4)));
typedef unsigned u32x4 __attribute__((ext_vector_type(4)));
constexpr int BM = 256, BK = 64, HALF = 128, HTB = HALF * BK * 2  , STAGE_BYTES = 8 * HTB, NXCD = 8, WGM = 8;

__host__ __device__ __forceinline__ int lds_byte(int r, int c) { const int st = (r >> 4) * 2 + (c >> 5), rr = r & 15, cc = c & 31, ob = rr * 64 + cc * 2; return st * 1024 + (ob ^ (((ob >> 9) & 1) << 5)); }
__host__ __device__ __forceinline__ void stage_rc(int b, int& R, int& C) { const int st = b / 1024, sb = b % 1024, swz = sb ^ (((sb >> 9) & 1) << 5); R = (st >> 1) * 16 + swz / 64; C = (st & 1) * 32 + (swz % 64) / 2; }
__host__ __device__ __forceinline__ int perm32(int rho) { const int n = rho >> 4, i = rho & 15; return 8 * (i >> 2) + 4 * n + (i & 3); }

struct Unit { int pm, pn; };
struct Gemm { const bf16_t* A; const bf16_t* Bt; int M, N, K; };

struct StaticOrder {
    int nM, nN, nwg, G, c;
    __host__ __device__ void init(int M, int N, int G_, int c_) { nM = M / BM; nN = N / BM; nwg = nM * nN; G = G_; c = c_; }
    __host__ __device__ bool next(int i, Unit& u) const {
        const long L = (long)i * G + c; if (L >= nwg) return false;
        int wgid = (int)L; { const int q = nwg / NXCD, r = nwg % NXCD, xcd = wgid % NXCD, off = wgid / NXCD; wgid = (xcd < r ? xcd * (q + 1) : r * (q + 1) + (xcd - r) * q) + off; }
        const int nig = WGM * nN, gid = wgid / nig, fm = gid * WGM, gsz = (nM - fm) < WGM ? (nM - fm) : WGM;
        u.pm = fm + ((wgid % nig) % gsz); u.pn = (wgid % nig) / gsz; return true;
    }
    __device__ __forceinline__ void a_ready(const Unit&) const {}
    __device__ __forceinline__ void done(const Unit&) const {}
};

__device__ __forceinline__ unsigned cvt_pk_bf16(float lo, float hi) { unsigned r; asm volatile("v_cvt_pk_bf16_f32 %0, %1, %2" : "=v"(r) : "v"(lo), "v"(hi)); return r; }
typedef float f32x2 __attribute__((ext_vector_type(2)));
typedef float f32x2_t __attribute__((ext_vector_type(2))); typedef __bf16 bf16x2_t __attribute__((ext_vector_type(2)));
__device__ __forceinline__ unsigned cvtpk_s(float lo, float hi) { f32x2_t v = {lo, hi}; bf16x2_t b = __builtin_convertvector(v, bf16x2_t); return __builtin_bit_cast(unsigned, b); }
__device__ __forceinline__ float bf_lo(unsigned w) { return __builtin_bit_cast(float, w << 16); }
__device__ __forceinline__ float bf_hi(unsigned w) { return __builtin_bit_cast(float, w & 0xffff0000u); }
__device__ __forceinline__ float silu_f(float z) { return z / (1.f + __expf(-z)); }
struct Epi {
    static constexpr bool PERM = true, AFTER_DRAIN = false;
    int mode;
    bf16_t* O; int ldc;
    int tail_pn; float* F; int ldf, nf;
    bf16_t* halo;
    const float* rstd; const float* ng;
    const float* src_lat; const float* src_ctx; float* dst_lat; float* dst_ctx; const float* mod; int gidx;
    __device__ __forceinline__ void operator()(const f32x4 (&acc)[2][2][4][2], const Unit& u, int wr, int wc, int fr, int fq) const {
        const int row0 = u.pm * BM + wr * 64 + fr; const int col0 = u.pn * BM + wc * 32 + 8 * fq;
        if (mode <= 1) {
            if (u.pn == tail_pn) {
                const int c0 = wc * 32 + 8 * fq;
#pragma unroll
                for (int ai = 0; ai < 2; ++ai)
#pragma unroll
                    for (int m = 0; m < 4; ++m)
#pragma unroll
                        for (int bj = 0; bj < 2; ++bj) { const int cc = c0 + bj * HALF;
                            if (cc < nf) { float* p = F + (size_t)(row0 + ai * HALF + m * 16) * ldf + cc; *(f32x4*)p = acc[ai][bj][m][0]; *(f32x4*)(p + 4) = acc[ai][bj][m][1]; } }
            } else {
#pragma unroll
                for (int ai = 0; ai < 2; ++ai)
#pragma unroll
                    for (int m = 0; m < 4; ++m) { bf16_t* rowp = O + (size_t)(row0 + ai * HALF + m * 16) * ldc + col0;
#pragma unroll
                        for (int bj = 0; bj < 2; ++bj) { f32x4 v0 = acc[ai][bj][m][0], v1 = acc[ai][bj][m][1];
                            if (mode == 1) {
#pragma unroll
                                for (int e = 0; e < 4; ++e) { float a = fmaxf(v0[e], 0.f), b = fmaxf(v1[e], 0.f); v0[e] = a * a; v1[e] = b * b; } }
                            u32x4 w; w.x = cvtpk_s(v0[0], v0[1]); w.y = cvtpk_s(v0[2], v0[3]); w.z = cvtpk_s(v1[0], v1[1]); w.w = cvtpk_s(v1[2], v1[3]);
                            *(u32x4*)(rowp + bj * HALF) = w;
                            if (halo && ((m == 0 && fr < 2) || (m == 3 && fr >= 14))) { const int row = row0 + ai * HALF + m * 16; const int j = m == 0 ? fr : fr - 12;
                                *(u32x4*)(halo + ((size_t)(row >> 6) * 4 + j) * ldc + col0 + bj * HALF) = w; } } }
            }
        } else if (mode == 2) {
            const f32x4 g0 = *(const f32x4*)(ng + (col0 & 127)), g1 = *(const f32x4*)(ng + (col0 & 127) + 4);
#pragma unroll
            for (int ai = 0; ai < 2; ++ai)
#pragma unroll
                for (int m = 0; m < 4; ++m) { const int row = row0 + ai * HALF + m * 16; bf16_t* rowp = O + (size_t)row * ldc + col0;
#pragma unroll
                    for (int bj = 0; bj < 2; ++bj) { const float rs = rstd[(size_t)row * 16 + ((col0 + bj * HALF) >> 7)];
                        const u32x4 ov = *(const u32x4*)(rowp + bj * HALF); const f32x4 z0 = acc[ai][bj][m][0], z1 = acc[ai][bj][m][1];
                        float r[8];
                        r[0] = bf_lo(ov.x) * rs * g0[0] * silu_f(z0[0]); r[1] = bf_hi(ov.x) * rs * g0[1] * silu_f(z0[1]);
                        r[2] = bf_lo(ov.y) * rs * g0[2] * silu_f(z0[2]); r[3] = bf_hi(ov.y) * rs * g0[3] * silu_f(z0[3]);
                        r[4] = bf_lo(ov.z) * rs * g1[0] * silu_f(z1[0]); r[5] = bf_hi(ov.z) * rs * g1[1] * silu_f(z1[1]);
                        r[6] = bf_lo(ov.w) * rs * g1[2] * silu_f(z1[2]); r[7] = bf_hi(ov.w) * rs * g1[3] * silu_f(z1[3]);
                        u32x4 w; w.x = cvtpk_s(r[0], r[1]); w.y = cvtpk_s(r[2], r[3]); w.z = cvtpk_s(r[4], r[5]); w.w = cvtpk_s(r[6], r[7]);
                        *(u32x4*)(rowp + bj * HALF) = w; } }
        } else {
            const int mi = u.pm < 64 ? 0 : (u.pm < 128 ? 1 : 2);
            const float* gate = mod + (size_t)mi * 6144 + (size_t)gidx * 1024;
            const bool lat = u.pm < 128;
            const float* sb = lat ? src_lat : src_ctx - (size_t)32768 * 1024; float* db = lat ? dst_lat : dst_ctx - (size_t)32768 * 1024;
#pragma unroll
            for (int bj = 0; bj < 2; ++bj)
#pragma unroll
                for (int n = 0; n < 2; ++n) { const int c = col0 + bj * HALF + 4 * n; const f32x4 gv = *(const f32x4*)(gate + c);
#pragma unroll
                    for (int ai = 0; ai < 2; ++ai)
#pragma unroll
                        for (int m = 0; m < 4; ++m) { const size_t off = (size_t)(row0 + ai * HALF + m * 16) * 1024 + c;
                            const f32x4 s = *(const f32x4*)(sb + off); *(f32x4*)(db + off) = s + gv * acc[ai][bj][m][n]; } }
        }
    }
};
template <class Epi, class Sched, bool ALIGN_EPI = false, bool SP2 = false>
__device__ __forceinline__ void gemm_phase(PG8_LAS unsigned char* lds, const Gemm g, const Sched& S, const Epi& E) {
    const int tid = opaque_tid(), wid = __builtin_amdgcn_readfirstlane(tid >> 6), lane = tid & 63, wr = wid >> 2, wc = wid & 3, fr = lane & 15, fq = lane >> 4;
    const int K = g.K, nt = K / BK;
    unsigned voffA[2], voffB[2];
#pragma unroll
    for (int i = 0; i < 2; ++i) { int R, C; stage_rc(tid * 16 + i * 8192, R, C); const int Rb = Epi::PERM ? ((R & ~31) + perm32(R & 31)) : R;
        voffA[i] = (unsigned)(R * K + C) * 2u; voffB[i] = (unsigned)(Rb * K + C) * 2u; }
    const size_t kstep = (size_t)(BK * 2);
    const size_t hstep = (size_t)HALF * K * 2;
    const size_t tstep = 2 * hstep;
    const unsigned ldsw = (unsigned)wid * 1024u;
    const int aoff = lds_byte(wr * 64 + fr, fq * 8), boff = lds_byte(wc * 32 + fr, fq * 8);
#define PG8_SA(b, h) (((b) * 2 + (h)) * HTB)
#define PG8_SB(b, h) ((4 + (b) * 2 + (h)) * HTB)
#define PG8_STAGE(bufoff, gbase, voff) do { _Pragma("unroll") for (int _i = 0; _i < 2; ++_i) \
        __builtin_amdgcn_global_load_lds((const unsigned*)((const char*)(gbase) + (voff)[_i]), (PG8_LAS unsigned*)(lds + (bufoff) + ldsw + _i * 8192), 16, 0, 0); } while (0)
#define PG8_LDA(dst, b, h) do { _Pragma("unroll") for (int m = 0; m < 4; ++m) _Pragma("unroll") for (int k = 0; k < 2; ++k) dst[m][k] = *(const PG8_LAS bf16x8*)(lds + PG8_SA(b, h) + aoff + m * 2048 + k * 1024); } while (0)
#define PG8_LDB(dst, b, h) do { _Pragma("unroll") for (int n = 0; n < 2; ++n) _Pragma("unroll") for (int k = 0; k < 2; ++k) dst[n][k] = *(const PG8_LAS bf16x8*)(lds + PG8_SB(b, h) + boff + n * 2048 + k * 1024); } while (0)
#define PG8_MMA(ai, bj, At, Bt) do { __builtin_amdgcn_s_setprio(1); _Pragma("unroll") for (int m = 0; m < 4; ++m) _Pragma("unroll") for (int n = 0; n < 2; ++n) _Pragma("unroll") for (int k = 0; k < 2; ++k) \
        acc[ai][bj][m][n] = __builtin_amdgcn_mfma_f32_16x16x32_bf16(Bt[n][k], At[m][k], acc[ai][bj][m][n], 0, 0, 0); __builtin_amdgcn_s_setprio(0); } while (0)
#define PG8_WAIT_V(n) asm volatile("s_waitcnt vmcnt(" #n ")" ::: "memory")
#define PG8_WAIT_L(n) asm volatile("s_waitcnt lgkmcnt(" #n ")" ::: "memory")
#define PG8_BAR __builtin_amdgcn_s_barrier()
#define PG8_SCHED __builtin_amdgcn_sched_barrier(0)
    Unit cur, nxt; int ui = 0;
    if (!S.next(0, cur)) return;
    f32x4 acc[2][2][4][2];
#pragma unroll
    for (int a = 0; a < 2; ++a)
#pragma unroll
        for (int b = 0; b < 2; ++b)
#pragma unroll
            for (int m = 0; m < 4; ++m)
#pragma unroll
                for (int n = 0; n < 2; ++n) acc[a][b][m][n] = (f32x4){0.f, 0.f, 0.f, 0.f};
    bf16x8 At[4][2], B0[2][2], B1[2][2];
    const char* cA = (const char*)g.A + (size_t)cur.pm * tstep; const char* cB = (const char*)g.Bt + (size_t)cur.pn * tstep;
    S.a_ready(cur);
    if constexpr (SP2) {
        PG8_STAGE(PG8_SB(0, 0), cB, voffB); PG8_STAGE(PG8_SB(0, 1), cB + hstep, voffB); PG8_STAGE(PG8_SA(0, 0), cA, voffA); PG8_STAGE(PG8_SA(0, 1), cA + hstep, voffA);
        if (wr == 1) PG8_BAR;
        PG8_WAIT_V(2); PG8_BAR;
        PG8_STAGE(PG8_SB(1, 0), cB + kstep, voffB); PG8_STAGE(PG8_SA(1, 0), cA + kstep, voffA); PG8_STAGE(PG8_SB(1, 1), cB + hstep + kstep, voffB);
        PG8_WAIT_V(6); PG8_BAR;
    } else {
        PG8_STAGE(PG8_SB(0, 0), cB, voffB); PG8_STAGE(PG8_SA(0, 0), cA, voffA); PG8_STAGE(PG8_SB(0, 1), cB + hstep, voffB); PG8_STAGE(PG8_SA(0, 1), cA + hstep, voffA);
        if (wr == 1) PG8_BAR;
        PG8_WAIT_V(4); PG8_BAR;
        PG8_STAGE(PG8_SB(1, 0), cB + kstep, voffB); PG8_STAGE(PG8_SA(1, 0), cA + kstep, voffA); PG8_STAGE(PG8_SB(1, 1), cB + hstep + kstep, voffB);
        PG8_WAIT_V(6); PG8_BAR;
    }
    for (;;) {
        const bool has_next = S.next(ui + 1, nxt);
        const char* nA = has_next ? (const char*)g.A + (size_t)nxt.pm * tstep : cA; const char* nB = has_next ? (const char*)g.Bt + (size_t)nxt.pn * tstep : cB;
        for (int t = 0; t < nt; t += 2) {
            const bool last = (t == nt - 2);
            const char* a1 = cA + (size_t)(t + 1) * kstep;
            const char* a2 = last ? nA : cA + (size_t)(t + 2) * kstep; const char* b2 = last ? nB : cB + (size_t)(t + 2) * kstep;
            const char* a3 = a2 + kstep; const char* b3 = b2 + kstep;
            if (last && has_next) S.a_ready(nxt);
            if constexpr (SP2) {
            PG8_LDB(B0, 0, 0); PG8_LDB(B1, 0, 1); PG8_SCHED; PG8_LDA(At, 0, 0); PG8_STAGE(PG8_SA(1, 1), a1 + hstep, voffA);
            PG8_WAIT_V(8); PG8_WAIT_L(0); PG8_BAR; PG8_MMA(0, 0, At, B0); PG8_MMA(0, 1, At, B1); PG8_BAR; PG8_SCHED;
            PG8_LDA(At, 0, 1); PG8_STAGE(PG8_SB(0, 0), b2, voffB); PG8_STAGE(PG8_SB(0, 1), b2 + hstep, voffB); PG8_STAGE(PG8_SA(0, 0), a2, voffA);
            PG8_WAIT_V(8); PG8_WAIT_L(0); PG8_BAR; PG8_MMA(1, 0, At, B0); PG8_MMA(1, 1, At, B1); PG8_BAR; PG8_SCHED;
            PG8_LDB(B0, 1, 0); PG8_LDB(B1, 1, 1); PG8_SCHED; PG8_LDA(At, 1, 0); PG8_STAGE(PG8_SA(0, 1), a2 + hstep, voffA);
            PG8_WAIT_V(8); PG8_WAIT_L(0); PG8_BAR; PG8_MMA(0, 0, At, B0); PG8_MMA(0, 1, At, B1); PG8_BAR; PG8_SCHED;
            PG8_LDA(At, 1, 1); PG8_STAGE(PG8_SB(1, 0), b3, voffB); PG8_STAGE(PG8_SB(1, 1), b3 + hstep, voffB); PG8_STAGE(PG8_SA(1, 0), a3, voffA);
            PG8_WAIT_V(8); PG8_WAIT_L(0); PG8_BAR; PG8_MMA(1, 0, At, B0); PG8_MMA(1, 1, At, B1); PG8_BAR; PG8_SCHED;
            } else {
            PG8_LDB(B0, 0, 0); PG8_SCHED; PG8_LDA(At, 0, 0); PG8_STAGE(PG8_SA(1, 1), a1 + hstep, voffA);
            PG8_WAIT_L(8); PG8_BAR; PG8_WAIT_L(0); PG8_MMA(0, 0, At, B0); PG8_BAR; PG8_SCHED;
            PG8_LDB(B1, 0, 1); PG8_STAGE(PG8_SB(0, 0), b2, voffB);
            PG8_BAR; PG8_WAIT_L(0); PG8_MMA(0, 1, At, B1); PG8_BAR;
            PG8_LDA(At, 0, 1); PG8_STAGE(PG8_SA(0, 0), a2, voffA);
            PG8_BAR; PG8_WAIT_L(0); PG8_MMA(1, 0, At, B0); PG8_BAR; PG8_SCHED;
            PG8_STAGE(PG8_SB(0, 1), b2 + hstep, voffB);
            PG8_WAIT_V(6); PG8_BAR; PG8_MMA(1, 1, At, B1); PG8_BAR;
            PG8_LDB(B0, 1, 0); PG8_SCHED; PG8_LDA(At, 1, 0); PG8_STAGE(PG8_SA(0, 1), a2 + hstep, voffA);
            PG8_WAIT_L(8); PG8_BAR; PG8_WAIT_L(0); PG8_MMA(0, 0, At, B0); PG8_BAR; PG8_SCHED;
            PG8_LDB(B1, 1, 1); PG8_STAGE(PG8_SB(1, 0), b3, voffB);
            PG8_BAR; PG8_WAIT_L(0); PG8_MMA(0, 1, At, B1); PG8_BAR;
            PG8_LDA(At, 1, 1); PG8_STAGE(PG8_SA(1, 0), a3, voffA);
            PG8_BAR; PG8_WAIT_L(0); PG8_MMA(1, 0, At, B0); PG8_BAR; PG8_SCHED;
            PG8_STAGE(PG8_SB(1, 1), b3 + hstep, voffB);
            PG8_WAIT_V(6); PG8_BAR; PG8_MMA(1, 1, At, B1); PG8_BAR;
            }
        }
        if constexpr (ALIGN_EPI) { if (wr == 0) PG8_BAR; }
        if constexpr (!Epi::AFTER_DRAIN) { E(acc, cur, wr, wc, fr, fq); S.done(cur); }
        if (!has_next) break;
#pragma unroll
        for (int a = 0; a < 2; ++a)
#pragma unroll
            for (int b = 0; b < 2; ++b)
#pragma unroll
                for (int m = 0; m < 4; ++m)
#pragma unroll
                    for (int n = 0; n < 2; ++n) acc[a][b][m][n] = (f32x4){0.f, 0.f, 0.f, 0.f};
        cur = nxt; cA = nA; cB = nB; ++ui;
        if constexpr (ALIGN_EPI) { if (wr == 1) PG8_BAR; }
    }
    PG8_WAIT_V(0);
    if constexpr (!ALIGN_EPI) { if (wr == 0) PG8_BAR; }
    PG8_BAR;
    if constexpr (Epi::AFTER_DRAIN) { E.fused(acc, cur, wr, wc, fr, fq, lds, wid, lane); S.done(cur); }
#undef PG8_SA
#undef PG8_SB
#undef PG8_STAGE
#undef PG8_LDA
#undef PG8_LDB
#undef PG8_MMA
#undef PG8_WAIT_V
#undef PG8_WAIT_L
#undef PG8_BAR
#undef PG8_SCHED
}
}
namespace attn {
using bf16 = __hip_bfloat16;
constexpr int   D = 128, NW = 8, QBLK = 32, KVBLK = 64;
constexpr float SCALE = 0.088388347648318440f;
constexpr float THR = 8.f;
constexpr int SDEPTH = 2;
constexpr int LDQ = 1024, LDK = 128, LDO = 1024;
constexpr size_t SHM_V = KVBLK * D * 2, SHM_K = KVBLK * D * 2, SHM_ATTN = 2 * SHM_V + 2 * SHM_K + NW * 64 * 4;
using bf16x8 = __attribute__((ext_vector_type(8))) short;
using s16x4  = __attribute__((ext_vector_type(4))) short;
using f32x16 = __attribute__((ext_vector_type(16))) float;
using f32x8  = __attribute__((ext_vector_type(8))) float;
using u32x4  = __attribute__((ext_vector_type(4))) unsigned;
#define KSWZ(row, colB) ((row) * 256 + ((colB) ^ (((row) & 7) << 4)))
#define SBAR() __builtin_amdgcn_sched_barrier(0)
__device__ __forceinline__ int crow(int r, int hi) { return (r & 3) + 8 * (r >> 2) + 4 * hi; }
__device__ __forceinline__ unsigned cvtpk(float lo, float hi) {
  unsigned r; asm volatile("v_cvt_pk_bf16_f32 %0, %1, %2" : "=v"(r) : "v"(lo), "v"(hi)); return r;
}
template <typename TIn> struct Stage;
template <> struct Stage<bf16>  { using T = bf16x8;
  __device__ static __forceinline__ T ld8(const bf16* p) { return *reinterpret_cast<const bf16x8*>(p); }
  __device__ static __forceinline__ bf16x8 tobf(T x) { return x; } };
template <> struct Stage<float> { using T = f32x8;
  __device__ static __forceinline__ T ld8(const float* p) { return *reinterpret_cast<const f32x8*>(p); }
  __device__ static __forceinline__ bf16x8 tobf(T x) {
    u32x4 w = {cvtpk(x[0], x[1]), cvtpk(x[2], x[3]), cvtpk(x[4], x[5]), cvtpk(x[6], x[7])}; return *reinterpret_cast<bf16x8*>(&w); } };

__device__ __forceinline__ void partialSM(f32x16& p0, f32x16& p1, float& m_reg, float& mn, float& alpha) {
  constexpr float C = SCALE * 1.4426950408889634f;
  float pmax = p0[0]; for (int r = 1; r < 16; ++r) pmax = fmaxf(pmax, p0[r]); for (int r = 0; r < 16; ++r) pmax = fmaxf(pmax, p1[r]);
  { auto rr = __builtin_amdgcn_permlane32_swap(__float_as_uint(pmax), __float_as_uint(pmax), false, false);
    pmax = fmaxf(__uint_as_float(rr[0]), __uint_as_float(rr[1])); }
  if (__builtin_expect(__all(pmax - m_reg <= THR / SCALE), 1)) { mn = m_reg; alpha = 1.f; }
  else { mn = fmaxf(m_reg, pmax); alpha = __builtin_amdgcn_exp2f((m_reg - mn) * C); m_reg = mn; }
  float mnC = -mn * C;
  for (int r = 0; r < 16; ++r) p0[r] = fmaf(p0[r], C, mnC); for (int r = 0; r < 16; ++r) p1[r] = fmaf(p1[r], C, mnC);
  for (int r = 0; r < 16; ++r) p0[r] = __builtin_amdgcn_exp2f(p0[r]);
}
__device__ __forceinline__ void finishSM(f32x16& p0, f32x16& p1, float alpha, float& l_reg, bf16x8& pa0, bf16x8& pa1, bf16x8& pa2, bf16x8& pa3) {
  for (int r = 0; r < 16; ++r) p1[r] = __builtin_amdgcn_exp2f(p1[r]);
  float ps = 0; for (int r = 0; r < 16; ++r) ps += p0[r]; for (int r = 0; r < 16; ++r) ps += p1[r];
  { auto rr = __builtin_amdgcn_permlane32_swap(__float_as_uint(ps), __float_as_uint(ps), false, false);
    ps = __uint_as_float(rr[0]) + __uint_as_float(rr[1]); }
  l_reg = l_reg * alpha + ps;
#define PK4(P, BASE, OUT) do { unsigned a0 = cvtpk(P[BASE + 0], P[BASE + 1]), a1 = cvtpk(P[BASE + 2], P[BASE + 3]);   \
    unsigned b0 = cvtpk(P[BASE + 4], P[BASE + 5]), b1 = cvtpk(P[BASE + 6], P[BASE + 7]);                              \
    auto r0 = __builtin_amdgcn_permlane32_swap(a0, b0, false, false); auto r1 = __builtin_amdgcn_permlane32_swap(a1, b1, false, false); \
    u32x4 w = {r0[0], r1[0], r0[1], r1[1]}; OUT = *reinterpret_cast<bf16x8*>(&w); } while (0)
  PK4(p0, 0, pa0); PK4(p0, 8, pa1); PK4(p1, 0, pa2); PK4(p1, 8, pa3);
#undef PK4
}
__device__ __forceinline__ void qkt(f32x16& p0, f32x16& p1, const bf16* Ks, const bf16x8* qr, int r32, int hi) {
  p0 = f32x16{}; p1 = f32x16{};
  for (int d0 = 0; d0 < 8; ++d0) { int cb = (d0 * 16 + hi * 8) * 2;
    bf16x8 b0 = *reinterpret_cast<const bf16x8*>((const char*)Ks + KSWZ(r32, cb));
    bf16x8 b1 = *reinterpret_cast<const bf16x8*>((const char*)Ks + KSWZ(32 + r32, cb));
    p0 = __builtin_amdgcn_mfma_f32_32x32x16_bf16(b0, qr[d0], p0, 0, 0, 0);
    p1 = __builtin_amdgcn_mfma_f32_32x32x16_bf16(b1, qr[d0], p1, 0, 0, 0); }
}
__device__ __forceinline__ int v_st(int k, int c) { const int kk = (k & ~0xC) | ((k & 4) << 1) | ((k & 8) >> 1); return ((kk >> 3) * 4 + (c >> 5)) * 512 + ((kk & 7) * 32 + (c & 31)) * 2; }
__device__ __forceinline__ int v_rd_base(int lane) { return ((lane & 3) << 3) | (((lane >> 2) & 3) << 6) | (((lane >> 4) & 1) << 5) | (((lane >> 5) & 1) << 8); }
constexpr int v_rd_off(int d0, int ks, int half) { return d0 * 512 + ks * 4096 + half * 2048; }
template <int OFF> __device__ __forceinline__ s16x4 tr_read(int vb) {
  s16x4 r; asm volatile("ds_read_b64_tr_b16 %0, %1 offset:%2" : "=&v"(r) : "v"(vb), "i"(OFF) : "memory"); return r;
}
template <int D0> __device__ __forceinline__ void pv_one(f32x16& od, int vb, bf16x8 pa0, bf16x8 pa1, bf16x8 pa2, bf16x8 pa3) {
  const s16x4 l0 = tr_read<v_rd_off(D0, 0, 0)>(vb), h0 = tr_read<v_rd_off(D0, 0, 1)>(vb), l1 = tr_read<v_rd_off(D0, 1, 0)>(vb), h1 = tr_read<v_rd_off(D0, 1, 1)>(vb);
  const s16x4 l2 = tr_read<v_rd_off(D0, 2, 0)>(vb), h2 = tr_read<v_rd_off(D0, 2, 1)>(vb), l3 = tr_read<v_rd_off(D0, 3, 0)>(vb), h3 = tr_read<v_rd_off(D0, 3, 1)>(vb);
  asm volatile("s_waitcnt lgkmcnt(0)" ::: "memory"); SBAR();
#define PK(L, H) (bf16x8){L[0], L[1], L[2], L[3], H[0], H[1], H[2], H[3]}
  od = __builtin_amdgcn_mfma_f32_32x32x16_bf16(pa0, PK(l0, h0), od, 0, 0, 0);
  od = __builtin_amdgcn_mfma_f32_32x32x16_bf16(pa1, PK(l1, h1), od, 0, 0, 0);
  od = __builtin_amdgcn_mfma_f32_32x32x16_bf16(pa2, PK(l2, h2), od, 0, 0, 0);
  od = __builtin_amdgcn_mfma_f32_32x32x16_bf16(pa3, PK(l3, h3), od, 0, 0, 0);
#undef PK
}
__device__ __forceinline__ void pv_d0(f32x16* o, int vb, bf16x8 pa0, bf16x8 pa1, bf16x8 pa2, bf16x8 pa3) {
  pv_one<0>(o[0], vb, pa0, pa1, pa2, pa3); pv_one<1>(o[1], vb, pa0, pa1, pa2, pa3); pv_one<2>(o[2], vb, pa0, pa1, pa2, pa3); pv_one<3>(o[3], vb, pa0, pa1, pa2, pa3);
}

template <typename TQ>
__device__ __forceinline__ void attn_dense_body(const TQ* __restrict__ Qb, const bf16* __restrict__ Kh, const bf16* __restrict__ Vh,
                                                bf16* __restrict__ Ob, int seq, char* lds) {
  using St = Stage<bf16>; using SQ = Stage<TQ>;
  const int tid = opaque_tid(), wid = tid >> 6, lane = tid & 63, r32 = lane & 31, hi = lane >> 5;
  bf16* V_lds = (bf16*)lds; bf16* K_lds = (bf16*)(lds + 2 * SHM_V);
  float* ws = (float*)(lds + 2 * SHM_V + 2 * SHM_K) + wid * 64; float* li_l = ws; float* al_l = ws + 32;
  float m_reg = -1e30f, l_reg = 0; f32x16 o[4] = {}; bf16x8 qr[8];
  const TQ* Qw = Qb + (long)(wid * QBLK + r32) * LDQ + hi * 8;
#pragma unroll
  for (int d0 = 0; d0 < 8; ++d0) qr[d0] = SQ::tobf(SQ::ld8(Qw + d0 * 16));
  const int sr = tid >> 4, sc = (tid & 15) * 8, vst0 = v_st(sr, sc), vst1 = v_st(32 + sr, sc);
  const int vb0 = (int)(uintptr_t)V_lds + v_rd_base(lane);
  struct { typename St::T vs0, vs1, ks0, ks1; } sr_[SDEPTH];
#define SLOAD(i, k0) do { sr_[i].vs0 = St::ld8(&Vh[(long)((k0) + sr) * LDK + sc]); sr_[i].vs1 = St::ld8(&Vh[(long)((k0) + 32 + sr) * LDK + sc]); \
    sr_[i].ks0 = St::ld8(&Kh[(long)((k0) + sr) * LDK + sc]); sr_[i].ks1 = St::ld8(&Kh[(long)((k0) + 32 + sr) * LDK + sc]); } while (0)
#define SWRITE(b, i) do { *(bf16x8*)((char*)V_lds + (b) * SHM_V + vst0) = St::tobf(sr_[i].vs0);          \
    *(bf16x8*)((char*)V_lds + (b) * SHM_V + vst1) = St::tobf(sr_[i].vs1); int kc = sc * 2;               \
    *(bf16x8*)((char*)K_lds + (b) * SHM_K + KSWZ(sr, kc)) = St::tobf(sr_[i].ks0);                       \
    *(bf16x8*)((char*)K_lds + (b) * SHM_K + KSWZ(32 + sr, kc)) = St::tobf(sr_[i].ks1); } while (0)
#define SWAIT() do { if constexpr (SDEPTH == 2) asm volatile("s_waitcnt vmcnt(4)" ::: "memory"); else asm volatile("s_waitcnt vmcnt(0)" ::: "memory"); } while (0)
#define RESC(a) do { if (__any((a) < 1.f)) { if (hi == 0) al_l[r32] = (a); asm volatile("s_waitcnt lgkmcnt(0)" ::: "memory"); \
    for (int d = 0; d < 4; ++d) for (int r = 0; r < 16; ++r) o[d][r] *= al_l[crow(r, hi)]; } } while (0)
  f32x16 pA0, pA1, pB0, pB1; float mnA, mnB, alA, alB; bf16x8 pa0, pa1, pa2, pa3; const int NT = seq / KVBLK;
  constexpr int SE = 0, SO = SDEPTH - 1;
  SLOAD(SE, 0); asm volatile("s_waitcnt vmcnt(0)" ::: "memory"); SWRITE(0, SE); __syncthreads();
  qkt(pA0, pA1, K_lds, qr, r32, hi); partialSM(pA0, pA1, m_reg, mnA, alA);
  SLOAD(SO, KVBLK); if constexpr (SDEPTH == 2) { if (2 < NT) SLOAD(SE, 2 * KVBLK); }
  SWAIT(); SWRITE(1, SO); __syncthreads();
  for (int j = 1; j + 1 < NT; j += 2) {
    SBAR(); qkt(pB0, pB1, (bf16*)((char*)K_lds + SHM_K), qr, r32, hi);
    finishSM(pA0, pA1, alA, l_reg, pa0, pa1, pa2, pa3); SBAR();
    SLOAD(SO, (j + SDEPTH) * KVBLK); SBAR();
    pv_d0(o, vb0, pa0, pa1, pa2, pa3); partialSM(pB0, pB1, m_reg, mnB, alB);
    __syncthreads(); SWAIT(); SWRITE(0, SE);
    RESC(alB); __syncthreads();
    SBAR(); qkt(pA0, pA1, K_lds, qr, r32, hi);
    finishSM(pB0, pB1, alB, l_reg, pa0, pa1, pa2, pa3); SBAR();
    if (SDEPTH == 1 || j + 3 < NT) SLOAD(SE, (j + 1 + SDEPTH) * KVBLK); SBAR();
    pv_d0(o, vb0 + (int)SHM_V, pa0, pa1, pa2, pa3); partialSM(pA0, pA1, m_reg, mnA, alA);
    __syncthreads(); SWAIT(); SWRITE(1, SO);
    RESC(alA); __syncthreads();
  }
  SBAR(); qkt(pB0, pB1, (bf16*)((char*)K_lds + SHM_K), qr, r32, hi);
  finishSM(pA0, pA1, alA, l_reg, pa0, pa1, pa2, pa3); SBAR();
  pv_d0(o, vb0, pa0, pa1, pa2, pa3); partialSM(pB0, pB1, m_reg, mnB, alB);
  __syncthreads(); RESC(alB);
  finishSM(pB0, pB1, alB, l_reg, pa0, pa1, pa2, pa3); SBAR();
  pv_d0(o, vb0 + (int)SHM_V, pa0, pa1, pa2, pa3);
  if (hi == 0) li_l[r32] = l_reg; asm volatile("s_waitcnt lgkmcnt(0)" ::: "memory");
  float rli[16];
#pragma unroll
  for (int r = 0; r < 16; ++r) rli[r] = __builtin_amdgcn_rcpf(li_l[crow(r, hi)]);
  bf16* Ow = Ob + (long)(wid * QBLK) * LDO;
#pragma unroll
  for (int r = 0; r < 16; ++r) { int orow = crow(r, hi);
    for (int d0 = 0; d0 < 4; ++d0) Ow[(long)orow * LDO + d0 * 32 + r32] = __float2bfloat16(o[d0][r] * rli[r]); }
#undef SLOAD
#undef SWRITE
#undef SWAIT
#undef RESC
}

}
#define LAS __attribute__((address_space(3)))
typedef unsigned short bf16_t;
typedef short bf16x8 __attribute__((ext_vector_type(8)));
typedef short s16x4 __attribute__((ext_vector_type(4)));
typedef float f32x4 __attribute__((ext_vector_type(4)));
typedef float f32x16 __attribute__((ext_vector_type(16)));
typedef unsigned u32x4 __attribute__((ext_vector_type(4)));
typedef unsigned u32x2 __attribute__((ext_vector_type(2)));
using pg8::cvtpk_s; using pg8::bf_lo; using pg8::bf_hi; using pg8::silu_f;

constexpr int DM = 1024, SEQ = 16384, CTXL = 256, NLAT = 2 * SEQ, MROWS = NLAT + 2 * CTXL, DFF = 4096;
constexpr float EPS = 1e-6f;
constexpr size_t MiB = 1u << 20;
constexpr size_t WS_BAR = 512 * 1024, WS_BAR_BYTES = 16384;
constexpr size_t WS_MOD = 0, WS_CTX = 1 * MiB, WS_WT = 4 * MiB, WS_H = 41 * MiB, WS_AB = 106 * MiB, WS_RSTD = 115 * MiB, WS_P = 118 * MiB, WS_O = 378 * MiB, WS_END = 508 * MiB;
constexpr size_t WT_A = WS_WT, WT_Z = WS_WT + 9 * MiB, WT_O = WS_WT + 13 * MiB, WT_1 = WS_WT + 17 * MiB, WT_2 = WS_WT + 25 * MiB;
constexpr size_t WS_QM = 313 * MiB, WS_KM = 378 * MiB, WS_OGLA = 443 * MiB, WS_AQ = 41 * MiB, WS_EL = 74 * MiB;
constexpr size_t WS_SEND = 77 * MiB, WS_DSUM = 93 * MiB;
constexpr size_t WS_TP = 4 * MiB, WS_HALO = 378 * MiB;
constexpr size_t WS_QR = 216 * MiB, WS_KR = 281 * MiB, WS_VR = 298 * MiB;
constexpr int SKV = SEQ + CTXL;
constexpr int LDS_BYTES = 155648;
enum { OP_MOD, OP_PREP, OP_GEMM_IN, OP_DNSCAN, OP_DNREDO, OP_GEMM_Z, OP_GEMM_OUT, OP_NORM2, OP_FFN1, OP_FFN2, OP_GLAPREP, OP_GLASCAN, OP_GLAGATE, OP_QKROPE, OP_ATTN, OP_DNHALO, OP_DNCONV, OP_DNT, OP_GLASTATE };

struct Args { const float* in[25]; float* out; unsigned char* ws; int ph_lo, ph_hi; };

__device__ __forceinline__ float wave_sum(float v) {
#pragma unroll
    for (int o = 1; o < 64; o <<= 1) v += __shfl_xor(v, o);
    return v;
}
__device__ __forceinline__ float softplus_f(float x) { return x > 20.f ? x : log1pf(__expf(x)); }
__device__ __forceinline__ float logsigmoid_f(float x) { return fminf(x, 0.f) - log1pf(__expf(-fabsf(x))); }
__device__ __forceinline__ bf16_t f2bf(float f) { return (bf16_t)(cvtpk_s(f, 0.f) & 0xffffu); }
__device__ __forceinline__ float bf2f(bf16_t v) { return __builtin_bit_cast(float, (unsigned)v << 16); }

__device__ __forceinline__ void transpose_item(const float* W, int ldw, int c0, int ncols, int K, bf16_t* WT, int row_off, LAS float* scr, int item, int lane) {
    const int nblk = ncols / 32, kb = item / nblk, nb = item % nblk, k0 = 64 * kb, n0 = 32 * nb;
    {
        const int kr = lane >> 3, n4 = 4 * (lane & 7); f32x4 v[8];
#pragma unroll
        for (int i = 0; i < 8; ++i) v[i] = *(const f32x4*)(W + (size_t)(k0 + kr + 8 * i) * ldw + c0 + n0 + n4);
#pragma unroll
        for (int i = 0; i < 8; ++i) { LAS float* d = scr + (kr + 8 * i) * 33 + n4; d[0] = v[i][0]; d[1] = v[i][1]; d[2] = v[i][2]; d[3] = v[i][3]; }
    }
    asm volatile("s_waitcnt lgkmcnt(0)" ::: "memory");
    const int c = lane & 7;
#pragma unroll
    for (int j = 0; j < 4; ++j) { const int n = (lane >> 3) + 8 * j; const LAS float* s = scr + (8 * c) * 33 + n;
        u32x4 o; o.x = cvtpk_s(s[0 * 33], s[1 * 33]); o.y = cvtpk_s(s[2 * 33], s[3 * 33]); o.z = cvtpk_s(s[4 * 33], s[5 * 33]); o.w = cvtpk_s(s[6 * 33], s[7 * 33]);
        *(u32x4*)(WT + (size_t)(row_off + n0 + n) * K + k0 + 8 * c) = o; }
    asm volatile("s_waitcnt lgkmcnt(0)" ::: "memory");
}
__device__ __forceinline__ void transpose_mat(const float* W, int ldw, int c0, int ncols, int K, bf16_t* WT, int row_off, LAS float* scr, int gw, int NGW, int lane) {
    const int nitems = (K / 64) * (ncols / 32);
    for (int it = gw; it < nitems; it += NGW) transpose_item(W, ldw, c0, ncols, K, WT, row_off, scr, it, lane);
}
__device__ __forceinline__ void normmod_rows(const float* xl, const float* xc, const float* g, const float* modl, int sidx, bf16_t* H, int gw, int NGW, int lane) {
    for (int row0 = gw; row0 < MROWS; row0 += 2 * NGW) {
        const int row1 = row0 + NGW; const bool has1 = row1 < MROWS; const int rows[2] = {row0, has1 ? row1 : row0};
        f32x4 v[2][4]; float ss[2] = {0.f, 0.f};
#pragma unroll
        for (int q = 0; q < 2; ++q) { const int row = rows[q]; const float* xr = row < NLAT ? xl + (size_t)row * DM : xc + (size_t)(row - NLAT) * DM;
#pragma unroll
            for (int j = 0; j < 4; ++j) v[q][j] = *(const f32x4*)(xr + 4 * lane + 256 * j); }
#pragma unroll
        for (int q = 0; q < 2; ++q)
#pragma unroll
            for (int j = 0; j < 4; ++j) ss[q] += (v[q][j][0] * v[q][j][0] + v[q][j][1] * v[q][j][1]) + (v[q][j][2] * v[q][j][2] + v[q][j][3] * v[q][j][3]);
#pragma unroll
        for (int q = 0; q < 2; ++q) {
            if (q == 1 && !has1) break;
            const int row = rows[q]; const int mi = row < SEQ ? 0 : (row < NLAT ? 1 : 2);
            const float* sh = modl + (size_t)mi * 6144 + (size_t)sidx * 1024; const float* sc = sh + 1024;
            const float rinv = rsqrtf(wave_sum(ss[q]) * (1.f / DM) + EPS);
#pragma unroll
            for (int j = 0; j < 4; ++j) { const int c = 4 * lane + 256 * j; const f32x4 gg = *(const f32x4*)(g + c), s1 = *(const f32x4*)(sc + c), s0 = *(const f32x4*)(sh + c);
                f32x4 y;
#pragma unroll
                for (int e = 0; e < 4; ++e) y[e] = v[q][j][e] * rinv * gg[e] * (1.f + s1[e]) + s0[e];
                u32x2 w; w.x = cvtpk_s(y[0], y[1]); w.y = cvtpk_s(y[2], y[3]); *(u32x2*)(H + (size_t)row * DM + c) = w; }
        }
    }
}
#define BAR_LDS() do { asm volatile("s_waitcnt lgkmcnt(0)" ::: "memory"); __builtin_amdgcn_s_barrier(); asm volatile("" ::: "memory"); } while (0)
__device__ __forceinline__ int crow(int x, int h) { return (x & 3) + 8 * (x >> 2) + 4 * h; }
#define MFMA32(a, b, c) __builtin_amdgcn_mfma_f32_32x32x16_bf16((a), (b), (c), 0, 0, 0)
__device__ __forceinline__ bf16x8 frag_nat(const LAS bf16_t* img, int LD, int row, int ks, int h) { return *(const LAS bf16x8*)(img + row * LD + 16 * ks + 8 * h); }
__device__ __forceinline__ bf16x8 frag_perm(const LAS bf16_t* img, int LD, int row, int ks, int h) {
    const s16x4 lo = *(const LAS s16x4*)(img + row * LD + 16 * ks + 4 * h), hi = *(const LAS s16x4*)(img + row * LD + 16 * ks + 8 + 4 * h);
    return __builtin_shufflevector(lo, hi, 0, 1, 2, 3, 4, 5, 6, 7);
}
__device__ __forceinline__ s16x4 tr4(const LAS bf16_t* p) { return __builtin_bit_cast(s16x4, __builtin_amdgcn_ds_read_tr16_b64_v4i16((LAS s16x4*)p)); }
__device__ __forceinline__ bf16x8 frag_tr(const LAS bf16_t* img, int LD, int m0, int ks, int lane) {
    const int i16 = lane & 15, q = i16 >> 2, p = i16 & 3, blk = (lane >> 4) & 1, h = lane >> 5;
    const LAS bf16_t* a = img + (16 * ks + 4 * h + q) * LD + m0 + 16 * blk + 4 * p;
    const s16x4 lo = tr4(a), hi = tr4(a + 8 * LD);
    return __builtin_shufflevector(lo, hi, 0, 1, 2, 3, 4, 5, 6, 7);
}
__device__ __forceinline__ bf16x8 pack_step(const f32x16& x, int s) {
    u32x4 p; p.x = cvtpk_s(x[8 * s + 0], x[8 * s + 1]); p.y = cvtpk_s(x[8 * s + 2], x[8 * s + 3]); p.z = cvtpk_s(x[8 * s + 4], x[8 * s + 5]); p.w = cvtpk_s(x[8 * s + 6], x[8 * s + 7]);
    return __builtin_bit_cast(bf16x8, p);
}
__device__ __forceinline__ void dn_halo_phase(const bf16_t* P, bf16_t* HALO, int G) {
    const int tid = opaque_tid();
    for (size_t e = (size_t)blockIdx.x * 512 + tid; e < (size_t)520 * 4 * 512; e += (size_t)G * 512) {
        const int c = (int)(e & 511), j = (int)((e >> 9) & 3), rb = (int)(e >> 11);
        const int row = rb * 64 + (j < 2 ? j : 60 + j);
        ((u32x4*)(HALO + ((size_t)rb * 4 + j) * 4096))[c] = ((const u32x4*)(P + (size_t)row * 4096))[c];
    }
}
__device__ __forceinline__ void unpack8(const u32x4 v, float (&f)[8]) { f[0] = bf_lo(v.x); f[1] = bf_hi(v.x); f[2] = bf_lo(v.y); f[3] = bf_hi(v.y); f[4] = bf_lo(v.z); f[5] = bf_hi(v.z); f[6] = bf_lo(v.w); f[7] = bf_hi(v.w); }
__device__ __forceinline__ void dn_conv_phase(bf16_t* P, const bf16_t* HALO, const float* conv_w, int G) {
    const int tid = opaque_tid(), col0 = 8 * tid;
    float cw[8][5];
#pragma unroll
    for (int c = 0; c < 8; ++c)
#pragma unroll
        for (int tap = 0; tap < 5; ++tap) cw[c][tap] = conv_w[(size_t)(col0 + c) * 5 + tap];
    const int kind = col0 < 1024 ? 0 : (col0 < 2048 ? 1 : 2);
    for (int rb = blockIdx.x; rb < 520; rb += G) {
        const int cs = rb < 512 ? (rb & 255) : ((rb - 512) & 3); const bool sfirst = cs == 0, slast = rb < 512 ? cs == 255 : cs == 3;
        const u32x4 zero = (u32x4){0u, 0u, 0u, 0u};
        bf16_t* base = P + (size_t)rb * 64 * 4096 + col0;
        u32x4 w0 = sfirst ? zero : *(const u32x4*)(HALO + ((size_t)(rb - 1) * 4 + 2) * 4096 + col0);
        u32x4 w1 = sfirst ? zero : *(const u32x4*)(HALO + ((size_t)(rb - 1) * 4 + 3) * 4096 + col0);
        u32x4 w2 = *(const u32x4*)(base), w3 = *(const u32x4*)(base + 4096);
#pragma unroll 4
        for (int rr = 0; rr < 64; ++rr) {
            u32x4 w4;
            if (rr + 2 < 64) w4 = *(const u32x4*)(base + (size_t)(rr + 2) * 4096);
            else w4 = slast ? zero : *(const u32x4*)(HALO + ((size_t)(rb + 1) * 4 + (rr + 2 - 64)) * 4096 + col0);
            float x0[8], x1[8], x2[8], x3[8], x4[8], y[8];
            unpack8(w0, x0); unpack8(w1, x1); unpack8(w2, x2); unpack8(w3, x3); unpack8(w4, x4);
            float ss = 0.f;
#pragma unroll
            for (int c = 0; c < 8; ++c) { const float a = x0[c] * cw[c][0] + x1[c] * cw[c][1] + x2[c] * cw[c][2] + x3[c] * cw[c][3] + x4[c] * cw[c][4]; y[c] = silu_f(a); ss += y[c] * y[c]; }
            float sc = 1.f;
            if (kind < 2) { ss += __shfl_xor(ss, 1); ss += __shfl_xor(ss, 2); ss += __shfl_xor(ss, 4); ss += __shfl_xor(ss, 8); sc = rsqrtf(ss + EPS) * (kind == 0 ? 0.08838834764831845f : 1.f); }
            u32x4 o; o.x = cvtpk_s(y[0] * sc, y[1] * sc); o.y = cvtpk_s(y[2] * sc, y[3] * sc); o.z = cvtpk_s(y[4] * sc, y[5] * sc); o.w = cvtpk_s(y[6] * sc, y[7] * sc);
            *(u32x4*)(base + (size_t)rr * 4096) = o;
            w0 = w1; w1 = w2; w2 = w3; w3 = w4;
        }
    }
}
constexpr int DT_KB = 0, DT_R = 17408, DT_SC = 33792, DT_DIR = 34816;
template <int W> __device__ __forceinline__ void dn_solve(const LAS float* Mf, float (&t)[16], int lane) {
    const int j = 16 * W + (lane >> 2), q = lane & 3;
#pragma unroll
    for (int s = 0; s < 16; ++s) t[s] = 0.f;
#pragma unroll
    for (int i = 16 * W; i < 64; ++i) {
        float acc = 0.f;
#pragma unroll
        for (int s = 4 * W; s <= (i - 1) / 4 && i > 16 * W; ++s) acc += Mf[i * 64 + 4 * s + q] * t[s];
        acc += __shfl_xor(acc, 1); acc += __shfl_xor(acc, 2);
        const float val = (i == j ? 1.f : 0.f) - acc;
        if (q == (i & 3)) t[i >> 2] = val;
        asm volatile("" : "+v"(t[0]), "+v"(t[1]), "+v"(t[2]), "+v"(t[3]), "+v"(t[4]), "+v"(t[5]), "+v"(t[6]), "+v"(t[7]), "+v"(t[8]), "+v"(t[9]), "+v"(t[10]), "+v"(t[11]), "+v"(t[12]), "+v"(t[13]), "+v"(t[14]), "+v"(t[15]));
    }
}
__device__ __forceinline__ void dn_t_phase(LAS unsigned char* lds, const bf16_t* P, float* AB, bf16_t* TP, const float* a_log, const float* dt_bias, int G) {
    const int tid0 = opaque_tid(), hb = __builtin_amdgcn_readfirstlane(tid0 >> 8);
    u32x4 pk4[4]; float pav = 0.f, pbv = 0.f;
    {
        const int it = blockIdx.x * 2 + hb;
        if (it < 16640) { const int dir = it & 1, vh = (it >> 1) & 15, rb = it >> 5, kh = vh >> 1, t = tid0 & 255, r0 = t >> 4, c8 = 8 * (t & 15);
#pragma unroll
            for (int v = 0; v < 4; ++v) pk4[v] = *(const u32x4*)(P + (size_t)(rb * 64 + r0 + 16 * v) * 4096 + 1024 + kh * 128 + c8);
            const int ti = dir ? 63 - (t & 63) : (t & 63); const float* ab = AB + (size_t)(rb * 64 + ti) * 64; pav = ab[dir * 16 + vh]; pbv = ab[32 + dir * 16 + vh]; }
    }
    for (int itb = blockIdx.x * 2; itb < 16640; itb += 2 * G) {
        const int it = itb + hb, dir = it & 1, vh = (it >> 1) & 15, rb = it >> 5, kh = vh >> 1;
        const int tq = opaque_tid(), t = tq & 255, w = __builtin_amdgcn_readfirstlane((tq >> 6) & 3), lane = tq & 63, r = lane & 31, h = lane >> 5;
        LAS unsigned char* base = lds + hb * DT_DIR;
        LAS bf16_t* Kb = (LAS bf16_t*)(base + DT_KB); LAS float* Mf = (LAS float*)(base + DT_R); LAS bf16_t* Tb = (LAS bf16_t*)(base + DT_R);
        LAS float* sc_beta = (LAS float*)(base + DT_SC); LAS float* sc_gc = sc_beta + 64;
        {
            const int r0 = t >> 4, c8 = 8 * (t & 15);
#pragma unroll
            for (int v = 0; v < 4; ++v) { const int i = r0 + 16 * v, ip = dir ? 63 - i : i;
                *(LAS u32x4*)(Kb + ip * 136 + c8) = pk4[v]; }
            if (t < 64) {
                const int ti = dir ? 63 - t : t; float* ab = AB + (size_t)(rb * 64 + ti) * 64;
                const float av = pav, bv = pbv;
                const float g = -__expf(a_log[dir * 16 + vh]) * softplus_f(av + dt_bias[dir * 16 + vh]), beta = 1.f / (1.f + __expf(-bv));
                float gc = g;
#pragma unroll
                for (int o = 1; o < 64; o <<= 1) { const float up = __shfl_up(gc, o); if (t >= o) gc += up; }
                sc_beta[t] = beta; sc_gc[t] = gc;
                ab[dir * 16 + vh] = gc; ab[32 + dir * 16 + vh] = beta;
            }
        }
        BAR_LDS();
        {
            const int itn = it + 2 * G;
            if (itn < 16640) { const int dirn = itn & 1, vhn = (itn >> 1) & 15, rbn = itn >> 5, khn = vhn >> 1, r0 = t >> 4, c8 = 8 * (t & 15);
#pragma unroll
                for (int v = 0; v < 4; ++v) pk4[v] = *(const u32x4*)(P + (size_t)(rbn * 64 + r0 + 16 * v) * 4096 + 1024 + khn * 128 + c8);
                const int tin = dirn ? 63 - (t & 63) : (t & 63); const float* abn = AB + (size_t)(rbn * 64 + tin) * 64; pav = abn[dirn * 16 + vhn]; pbv = abn[32 + dirn * 16 + vhn]; }
        }
        const int ti = w >> 1, tj = w & 1;
        {
            f32x16 acc;
#pragma unroll
            for (int x = 0; x < 16; ++x) acc[x] = 0.f;
            if (!(ti == 0 && tj == 1)) {
#pragma unroll
                for (int ks = 0; ks < 8; ++ks) acc = MFMA32(frag_nat(Kb, 136, 32 * ti + r, ks, h), frag_nat(Kb, 136, 32 * tj + r, ks, h), acc);
            }
            const int j = 32 * tj + r; const float gj = sc_gc[j];
#pragma unroll
            for (int x = 0; x < 16; ++x) { const int i = 32 * ti + crow(x, h);
                Mf[i * 64 + j] = (i > j) ? sc_beta[i] * acc[x] * __expf(sc_gc[i] - gj) : 0.f; }
        }
        BAR_LDS();
        float tc[16];
        if (w == 0) dn_solve<0>(Mf, tc, lane); else if (w == 1) dn_solve<1>(Mf, tc, lane); else if (w == 2) dn_solve<2>(Mf, tc, lane); else dn_solve<3>(Mf, tc, lane);
        BAR_LDS();
        {
            const int j = 16 * w + (lane >> 2), q = lane & 3;
#pragma unroll
            for (int s = 0; s < 16; ++s) Tb[(4 * s + q) * 72 + j] = f2bf(tc[s]);
        }
        BAR_LDS();
        {
            bf16_t* dst = TP + (size_t)it * 3072;
#pragma unroll
            for (int k2 = 0; k2 < 2; ++k2) { const int c = t + 256 * k2;
                if (c < 384) { const int blk = c >> 7, rowc = (c & 127) >> 2, cc = c & 3, br = blk ? 1 : 0, bc = blk == 2 ? 1 : 0;
                    *(u32x4*)(dst + c * 8) = *(const LAS u32x4*)(Tb + (32 * br + rowc) * 72 + 32 * bc + 8 * cc); } }
        }
        BAR_LDS();
    }
}
constexpr int DN_KB = 0, DN_QB = 17408, DN_VB = 34816, DN_TB = 51200, DN_AB = 60416, DN_SC = 69632, DN_DIR = 71168;
__device__ __forceinline__ void dn_step_rb(int step, int dir, int b, int& rb, bool& first) {
    if (step < 4) { const int cidx = dir ? 3 - step : step; rb = 512 + b * 4 + cidx; first = step < 2; }
    else { const int c = step - 4; const int cidx = dir ? 255 - c : c; rb = b * 256 + cidx; first = c < 128; }
}
struct DnPre { u32x4 k4[4], q4[4], v4[4], t0, t1; float gc, beta; };
__device__ __forceinline__ void dn_prefetch(DnPre& p, const bf16_t* P, const float* AB, const bf16_t* TP, int rb, int dir, int vh, int kh, int t, int part) {
    const int r0 = t >> 4, c8 = 8 * (t & 15);
    const bf16_t* prow = P + (size_t)(rb * 64 + r0) * 4096 + c8;
    const bf16_t* tp = TP + (size_t)((rb * 16 + vh) * 2 + dir) * 3072;
    if (part & 1) {
#pragma unroll
        for (int v = 0; v < 4; ++v) { const bf16_t* pr = prow + (size_t)(16 * v) * 4096;
            p.k4[v] = *(const u32x4*)(pr + 1024 + kh * 128); p.q4[v] = *(const u32x4*)(pr + kh * 128); p.v4[v] = *(const u32x4*)(pr + 2048 + vh * 128); }
    }
    if (part & 2) {
        p.t0 = *(const u32x4*)(tp + t * 8); p.t1 = *(const u32x4*)(tp + (256 + (t & 127)) * 8);
        const int ti = dir ? 63 - (t & 63) : (t & 63); const float* ab = AB + (size_t)(rb * 64 + ti) * 64; p.gc = ab[dir * 16 + vh]; p.beta = ab[32 + dir * 16 + vh];
    }
}
template <int VAR> __device__ __forceinline__ void dn_scan(LAS unsigned char* lds, const bf16_t* P, const float* AB, const bf16_t* TP, bf16_t* OB) {
    const int tid = opaque_tid(), dir = __builtin_amdgcn_readfirstlane(tid >> 8);
    for (int unit = blockIdx.x; unit < 32; unit += gridDim.x) {
        const int b = unit >> 4, vh = unit & 15, kh = vh >> 1;
        f32x16 S[4];
#pragma unroll
        for (int kt = 0; kt < 4; ++kt)
#pragma unroll
            for (int x = 0; x < 16; ++x) S[kt][x] = 0.f;
        DnPre pre;
        { int rb0; bool f0; dn_step_rb(0, dir, b, rb0, f0); dn_prefetch(pre, P, AB, TP, rb0, dir, vh, kh, tid & 255, 3); }
        __syncthreads();
        for (int step = 0; step < 260; ++step) {
            const int w = __builtin_amdgcn_readfirstlane((opaque_tid() >> 6) & 3);
            LAS unsigned char* base = lds + dir * DN_DIR;
            LAS bf16_t* Kb = (LAS bf16_t*)(base + DN_KB); LAS bf16_t* Qb = (LAS bf16_t*)(base + DN_QB); LAS bf16_t* Vb = (LAS bf16_t*)(base + DN_VB);
            LAS bf16_t* Tb = (LAS bf16_t*)(base + DN_TB); LAS bf16_t* Ab = (LAS bf16_t*)(base + DN_AB);
            LAS float* sc_beta = (LAS float*)(base + DN_SC); LAS float* sc_gc = sc_beta + 64; LAS float* sc_eg = sc_beta + 128; LAS float* sc_tail = sc_beta + 192; LAS float* sc_dl = sc_beta + 256;
            int rb; bool first; dn_step_rb(step, dir, b, rb, first);
            const int row_base = rb * 64;
            {
                const int tq_ = opaque_tid(), t = tq_ & 255;
                const int r0 = t >> 4, c8 = 8 * (t & 15);
#pragma unroll
                for (int v = 0; v < 4; ++v) { const int i = r0 + 16 * v, ip = dir ? 63 - i : i;
                    *(LAS u32x4*)(Kb + ip * 136 + c8) = pre.k4[v]; *(LAS u32x4*)(Qb + ip * 136 + c8) = pre.q4[v]; *(LAS u32x4*)(Vb + ip * 128 + c8) = pre.v4[v]; }
                { const int c = t, blk = c >> 7, rowc = (c & 127) >> 2, cc = c & 3, br = blk ? 1 : 0; *(LAS u32x4*)(Tb + (32 * br + rowc) * 72 + 8 * cc) = pre.t0; }
                if (t < 128) { const int rowc = t >> 2, cc = t & 3; *(LAS u32x4*)(Tb + (32 + rowc) * 72 + 32 + 8 * cc) = pre.t1; }
                if (t < 64) { const float gc = pre.gc, gl = __shfl(gc, 63); sc_beta[t] = pre.beta; sc_gc[t] = gc; sc_eg[t] = __expf(gc); sc_tail[t] = __expf(gl - gc); if (t == 0) sc_dl[0] = __expf(gl); }
            }
            BAR_LDS();
            {
                const int tq_ = opaque_tid(), lane = tq_ & 63, r = lane & 31, h = lane >> 5;
                const int ti = w >> 1, tj = w & 1;
                if (!(ti == 0 && tj == 1)) {
                    f32x16 qk;
#pragma unroll
                    for (int x = 0; x < 16; ++x) qk[x] = 0.f;
#pragma unroll
                    for (int ks = 0; ks < 8; ++ks) qk = MFMA32(frag_nat(Qb, 136, 32 * ti + r, ks, h), frag_nat(Kb, 136, 32 * tj + r, ks, h), qk);
                    const int jj = 32 * tj + r; const float gj = sc_gc[jj];
#pragma unroll
                    for (int x = 0; x < 16; ++x) { const int i = 32 * ti + crow(x, h);
                        Ab[i * 72 + jj] = f2bf((i >= jj) ? qk[x] * __expf(sc_gc[i] - gj) : 0.f); }
                }
            }
            BAR_LDS();
            if (VAR != 2 && step + 1 < 260) { int rbn; bool fn; dn_step_rb(step + 1, dir, b, rbn, fn); dn_prefetch(pre, P, AB, TP, rbn, dir, vh, kh, opaque_tid() & 255, 1); }
            __builtin_amdgcn_sched_barrier(0);
            if (VAR != 1) {
                const int tq_ = opaque_tid(), lane = tq_ & 63, r = lane & 31, h = lane >> 5;
                f32x16 KS[2], QS[2];
#pragma unroll
                for (int mt = 0; mt < 2; ++mt)
#pragma unroll
                    for (int x = 0; x < 16; ++x) { KS[mt][x] = 0.f; QS[mt][x] = 0.f; }
#pragma unroll
                for (int ks = 0; ks < 8; ++ks) {
                    const bf16x8 sp = pack_step(S[ks >> 1], ks & 1);
#pragma unroll
                    for (int mt = 0; mt < 2; ++mt) { KS[mt] = MFMA32(frag_perm(Kb, 136, 32 * mt + r, ks, h), sp, KS[mt]); QS[mt] = MFMA32(frag_perm(Qb, 136, 32 * mt + r, ks, h), sp, QS[mt]); }
                    if (ks & 1) __builtin_amdgcn_sched_barrier(0);
                }
#pragma unroll
                for (int mt = 0; mt < 2; ++mt)
#pragma unroll
                    for (int x = 0; x < 16; ++x) { const int i = 32 * mt + crow(x, h);
                        KS[mt][x] = sc_beta[i] * (bf2f(Vb[i * 128 + 32 * w + r]) - sc_eg[i] * KS[mt][x]); }
                __builtin_amdgcn_sched_barrier(0);
                bf16x8 Xp[4];
#pragma unroll
                for (int ks = 0; ks < 4; ++ks) Xp[ks] = pack_step(KS[ks >> 1], ks & 1);
                f32x16 VN[2];
#pragma unroll
                for (int mt = 0; mt < 2; ++mt) {
#pragma unroll
                    for (int x = 0; x < 16; ++x) VN[mt][x] = 0.f;
#pragma unroll
                    for (int ks = 0; ks < 4; ++ks) if (ks < 2 * mt + 2) VN[mt] = MFMA32(frag_perm(Tb, 72, 32 * mt + r, ks, h), Xp[ks], VN[mt]);
                }
                __builtin_amdgcn_sched_barrier(0);
                if (VAR != 2 && step + 1 < 260) { int rbn; bool fn; dn_step_rb(step + 1, dir, b, rbn, fn); dn_prefetch(pre, P, AB, TP, rbn, dir, vh, kh, opaque_tid() & 255, 2); }
                __builtin_amdgcn_sched_barrier(0);
                bf16x8 VNp[4];
#pragma unroll
                for (int ks = 0; ks < 4; ++ks) VNp[ks] = pack_step(VN[ks >> 1], ks & 1);
#pragma unroll
                for (int mt = 0; mt < 2; ++mt) {
#pragma unroll
                    for (int x = 0; x < 16; ++x) QS[mt][x] *= sc_eg[32 * mt + crow(x, h)];
#pragma unroll
                    for (int ks = 0; ks < 4; ++ks) if (ks < 2 * mt + 2) QS[mt] = MFMA32(frag_perm(Ab, 72, 32 * mt + r, ks, h), VNp[ks], QS[mt]);
                }
                __builtin_amdgcn_sched_barrier(0);
#pragma unroll
                for (int mt = 0; mt < 2; ++mt)
#pragma unroll
                    for (int x = 0; x < 16; ++x) Vb[(32 * mt + crow(x, h)) * 128 + 32 * w + r] = f2bf(QS[mt][x]);
                __builtin_amdgcn_sched_barrier(0);
#pragma unroll
                for (int mt = 0; mt < 2; ++mt)
#pragma unroll
                    for (int x = 0; x < 16; ++x) VN[mt][x] *= sc_tail[32 * mt + crow(x, h)];
#pragma unroll
                for (int ks = 0; ks < 4; ++ks) VNp[ks] = pack_step(VN[ks >> 1], ks & 1);
                __builtin_amdgcn_sched_barrier(0);
                const float dl = sc_dl[0];
#pragma unroll
                for (int kt = 0; kt < 4; ++kt)
#pragma unroll
                    for (int x = 0; x < 16; ++x) S[kt][x] *= dl;
#pragma unroll
                for (int ks = 0; ks < 4; ++ks) {
#pragma unroll
                    for (int kt = 0; kt < 4; ++kt) S[kt] = MFMA32(frag_tr(Kb, 136, 32 * kt, ks, lane), VNp[ks], S[kt]);
                    __builtin_amdgcn_sched_barrier(0);
                }
                if (VAR != 2) {
                    const int rr_ = lane >> 2, c8_ = 8 * (lane & 3);
#pragma unroll
                    for (int v = 0; v < 4; ++v) { const int ip_ = rr_ + 16 * v, i_ = dir ? 63 - ip_ : ip_;
                        u32x4* gp_ = (u32x4*)(OB + (size_t)(row_base + i_) * 2048 + vh * 128 + 32 * w + c8_);
                        u32x4 o = *(const LAS u32x4*)(Vb + ip_ * 128 + 32 * w + c8_);
                        if (!first) { const u32x4 e = gp_[0];
                            o.x = cvtpk_s(bf_lo(o.x) + bf_lo(e.x), bf_hi(o.x) + bf_hi(e.x)); o.y = cvtpk_s(bf_lo(o.y) + bf_lo(e.y), bf_hi(o.y) + bf_hi(e.y));
                            o.z = cvtpk_s(bf_lo(o.z) + bf_lo(e.z), bf_hi(o.z) + bf_hi(e.z)); o.w = cvtpk_s(bf_lo(o.w) + bf_lo(e.w), bf_hi(o.w) + bf_hi(e.w)); }
                        gp_[0] = o; }
                }
            }
            if (step == 1 || step == 131) asm volatile("s_waitcnt vmcnt(0)" ::: "memory");
            BAR_LDS();
        }
    }
}
constexpr int GP_QM = 0, GP_KM = 17408, GP_AB = 34816, GP_LOW = 44032, GP_TOT = 48128, GP_DIR = 49152;
__device__ __forceinline__ void gla_prep_phase(LAS unsigned char* lds, const bf16_t* P, const float* LOW, const float* gw2, const float* gb2, bf16_t* QM, bf16_t* KM, bf16_t* AQ, float* EL, int G) {
    const int tid0 = opaque_tid(), hb = __builtin_amdgcn_readfirstlane(tid0 >> 8);
    for (int itb = blockIdx.x * 2; itb < 4160; itb += 2 * G) {
        const int it = itb + hb, dir = it & 1, head = (it >> 1) & 3, rb = it >> 3;
        const int tq = opaque_tid(), t = tq & 255, w = __builtin_amdgcn_readfirstlane((tq >> 6) & 3), lane = tq & 63, r = lane & 31, h = lane >> 5;
        LAS unsigned char* base = lds + hb * GP_DIR;
        LAS bf16_t* Qm = (LAS bf16_t*)(base + GP_QM); LAS bf16_t* Km = (LAS bf16_t*)(base + GP_KM); LAS bf16_t* Ab = (LAS bf16_t*)(base + GP_AB);
        LAS float* lowS = (LAS float*)(base + GP_LOW); LAS float* tot = (LAS float*)(base + GP_TOT);
        *(LAS f32x4*)(lowS + 4 * t) = *(const f32x4*)(LOW + (size_t)(rb * 64 + (t >> 2)) * 32 + dir * 16 + 4 * (t & 3));
        const int dk = t & 127, half = t >> 7, col = head * 128 + dk;
        float w2c[16];
#pragma unroll
        for (int rr = 0; rr < 16; ++rr) w2c[rr] = gw2[(size_t)(dir * 16 + rr) * 512 + col];
        const float b2 = gb2[dir * 512 + col];
        __syncthreads();
        float bc[32]; float run = 0.f;
#pragma unroll
        for (int n = 0; n < 32; ++n) { const int ip = 32 * half + n, i = dir ? 63 - ip : ip; float s = b2;
#pragma unroll
            for (int rr = 0; rr < 16; ++rr) s += lowS[i * 16 + rr] * w2c[rr];
            run += logsigmoid_f(s) * (1.f / 16.f); bc[n] = run; }
        tot[half * 128 + dk] = run;
        __syncthreads();
        const float t0 = tot[dk], last = t0 + tot[128 + dk], off = half ? t0 : 0.f;
        if (half == 0) EL[(size_t)(dir * 520 + rb) * 512 + col] = last;
        {
            const int i0 = dir ? 63 - 32 * half : 32 * half; const long pstep = dir ? -3072 : 3072;
            const bf16_t* pp = P + (size_t)(rb * 64 + i0) * 3072 + col;
#pragma unroll
            for (int n = 0; n < 32; ++n) { const int ip = 32 * half + n; const float bcv = bc[n] + off;
                const float qv = bf2f(pp[0]), kv = bf2f(pp[512]); pp += pstep;
                Qm[ip * 136 + dk] = f2bf(qv * 0.08838834764831845f * __expf(bcv - last));
                Km[ip * 136 + dk] = f2bf(kv * __expf(last - bcv)); }
        }
        __syncthreads();
        {
            const int ti = w >> 1, tj = w & 1;
            f32x16 acc;
#pragma unroll
            for (int x = 0; x < 16; ++x) acc[x] = 0.f;
            if (!(ti == 0 && tj == 1)) {
#pragma unroll
                for (int ks = 0; ks < 8; ++ks) acc = MFMA32(frag_nat(Qm, 136, 32 * ti + r, ks, h), frag_nat(Km, 136, 32 * tj + r, ks, h), acc);
            }
            const int j = 32 * tj + r;
#pragma unroll
            for (int x = 0; x < 16; ++x) { const int i = 32 * ti + crow(x, h); Ab[i * 72 + j] = f2bf(i >= j ? acc[x] : 0.f); }
            const int r0 = t >> 4, c8 = 8 * (t & 15);
#pragma unroll
            for (int v = 0; v < 4; ++v) { const int row = r0 + 16 * v; const size_t go = ((size_t)dir * MROWS + rb * 64 + row) * 512 + head * 128 + c8;
                *(u32x4*)(QM + go) = *(const LAS u32x4*)(Qm + row * 136 + c8); *(u32x4*)(KM + go) = *(const LAS u32x4*)(Km + row * 136 + c8); }
        }
        __syncthreads();
        {
            bf16_t* dst = AQ + (size_t)it * 4096;
#pragma unroll
            for (int k2 = 0; k2 < 2; ++k2) { const int c = t + 256 * k2, row = c >> 3, cc = c & 7; *(u32x4*)(dst + c * 8) = *(const LAS u32x4*)(Ab + row * 72 + 8 * cc); }
        }
        __syncthreads();
    }
}
constexpr int GL_QM = 0, GL_KM = 17408, GL_VB = 34816, GL_AB = 52224, GL_EL = 61440, GL_DIR = 61952;
struct GlPre { u32x4 q4[4], k4[4], v4[4], a0, a1; float elv; };
__device__ __forceinline__ void gl_prefetch(GlPre& p, const bf16_t* P, const bf16_t* QM, const bf16_t* KM, const bf16_t* AQ, const float* EL, int rb, int dir, int head, int hf, int t) {
    const int r0 = t >> 4, c8 = 8 * (t & 15);
    const bf16_t* aq = AQ + (size_t)((rb * 4 + head) * 2 + dir) * 4096;
#pragma unroll
    for (int v = 0; v < 4; ++v) { const size_t row = (size_t)(rb * 64 + r0 + 16 * v);
        p.q4[v] = *(const u32x4*)(QM + ((size_t)dir * MROWS + row) * 512 + head * 128 + c8);
        p.k4[v] = *(const u32x4*)(KM + ((size_t)dir * MROWS + row) * 512 + head * 128 + c8);
        p.v4[v] = *(const u32x4*)(P + row * 3072 + 1024 + head * 256 + hf * 128 + c8); }
    p.a0 = *(const u32x4*)(aq + t * 8); p.a1 = *(const u32x4*)(aq + (256 + t) * 8);
    p.elv = EL[(size_t)(dir * 520 + rb) * 512 + head * 128 + (t & 127)];
}
__device__ __forceinline__ void gla_scan(LAS unsigned char* lds, const bf16_t* P  , const bf16_t* QM, const bf16_t* KM, const bf16_t* AQ, const float* EL, bf16_t* OB  ) {
    const int tid = opaque_tid(), dir = __builtin_amdgcn_readfirstlane(tid >> 8);
    for (int unit = blockIdx.x; unit < 16; unit += gridDim.x) {
        const int b = unit >> 3, head = (unit >> 1) & 3, hf = unit & 1;
        f32x16 S[4];
#pragma unroll
        for (int kt = 0; kt < 4; ++kt)
#pragma unroll
            for (int x = 0; x < 16; ++x) S[kt][x] = 0.f;
        GlPre pre;
        { int rb0; bool f0; dn_step_rb(0, dir, b, rb0, f0); gl_prefetch(pre, P, QM, KM, AQ, EL, rb0, dir, head, hf, tid & 255); }
        __syncthreads();
        for (int step = 0; step < 260; ++step) {
            const int w = __builtin_amdgcn_readfirstlane((opaque_tid() >> 6) & 3);
            LAS unsigned char* base = lds + dir * GL_DIR;
            LAS bf16_t* Qm = (LAS bf16_t*)(base + GL_QM); LAS bf16_t* Km = (LAS bf16_t*)(base + GL_KM); LAS bf16_t* Vb = (LAS bf16_t*)(base + GL_VB); LAS bf16_t* Ab = (LAS bf16_t*)(base + GL_AB);
            LAS float* el = (LAS float*)(base + GL_EL);
            int rb; bool first; dn_step_rb(step, dir, b, rb, first);
            const int row_base = rb * 64;
            {
                const int tq_ = opaque_tid(), t = tq_ & 255;
                const int r0 = t >> 4, c8 = 8 * (t & 15);
#pragma unroll
                for (int v = 0; v < 4; ++v) { const int i = r0 + 16 * v, ip = dir ? 63 - i : i;
                    *(LAS u32x4*)(Qm + i * 136 + c8) = pre.q4[v]; *(LAS u32x4*)(Km + i * 136 + c8) = pre.k4[v]; *(LAS u32x4*)(Vb + ip * 136 + c8) = pre.v4[v]; }
                { const int c = t, row = c >> 3, cc = c & 7; *(LAS u32x4*)(Ab + row * 72 + 8 * cc) = pre.a0; }
                { const int c = 256 + t, row = c >> 3, cc = c & 7; *(LAS u32x4*)(Ab + row * 72 + 8 * cc) = pre.a1; }
                if (t < 128) el[t] = __expf(pre.elv);
            }
            BAR_LDS();
            if (step + 1 < 260) { int rbn; bool fn; dn_step_rb(step + 1, dir, b, rbn, fn); gl_prefetch(pre, P, QM, KM, AQ, EL, rbn, dir, head, hf, opaque_tid() & 255); }
            __builtin_amdgcn_sched_barrier(0);
            {
                const int tq_ = opaque_tid(), lane = tq_ & 63, r = lane & 31, h = lane >> 5;
#pragma unroll
                for (int kt = 0; kt < 4; ++kt)
#pragma unroll
                    for (int x = 0; x < 16; ++x) S[kt][x] *= el[32 * kt + crow(x, h)];
                bf16x8 Vf[4];
#pragma unroll
                for (int ks = 0; ks < 4; ++ks) Vf[ks] = frag_tr(Vb, 136, 32 * w, ks, lane);
                u32x4 eo[4];
                {
                    const int rr_ = lane >> 2, c8_ = 8 * (lane & 3);
                    if (!first) {
#pragma unroll
                        for (int v = 0; v < 4; ++v) { const int ip_ = rr_ + 16 * v, i_ = dir ? 63 - ip_ : ip_;
                            eo[v] = *(const u32x4*)(OB + (size_t)(row_base + i_) * 1024 + head * 256 + hf * 128 + 32 * w + c8_); }
                    } else {
                        unsigned z0 = 0u; asm volatile("" : "+v"(z0));
#pragma unroll
                        for (int v = 0; v < 4; ++v) eo[v] = (u32x4){z0, z0, z0, z0};
                    }
                }
                f32x16 O[2];
#pragma unroll
                for (int mt = 0; mt < 2; ++mt) {
#pragma unroll
                    for (int x = 0; x < 16; ++x) O[mt][x] = 0.f;
#pragma unroll
                    for (int ks = 0; ks < 4; ++ks) if (ks < 2 * mt + 2) O[mt] = MFMA32(frag_perm(Ab, 72, 32 * mt + r, ks, h), Vf[ks], O[mt]);
                }
                __builtin_amdgcn_sched_barrier(0);
#pragma unroll
                for (int ks = 0; ks < 8; ++ks) {
                    const bf16x8 sp = pack_step(S[ks >> 1], ks & 1);
#pragma unroll
                    for (int mt = 0; mt < 2; ++mt) O[mt] = MFMA32(frag_perm(Qm, 136, 32 * mt + r, ks, h), sp, O[mt]);
                    if (ks & 1) __builtin_amdgcn_sched_barrier(0);
                }
#pragma unroll
                for (int mt = 0; mt < 2; ++mt)
#pragma unroll
                    for (int x = 0; x < 16; ++x) Vb[(32 * mt + crow(x, h)) * 136 + 32 * w + r] = f2bf(O[mt][x]);
                __builtin_amdgcn_sched_barrier(0);
#pragma unroll
                for (int ks = 0; ks < 4; ++ks) {
#pragma unroll
                    for (int kt = 0; kt < 4; ++kt) S[kt] = MFMA32(frag_tr(Km, 136, 32 * kt, ks, lane), Vf[ks], S[kt]);
                    __builtin_amdgcn_sched_barrier(0);
                }
                {
                    const int rr_ = lane >> 2, c8_ = 8 * (lane & 3);
#pragma unroll
                    for (int v = 0; v < 4; ++v) { const int ip_ = rr_ + 16 * v, i_ = dir ? 63 - ip_ : ip_;
                        u32x4* gp_ = (u32x4*)(OB + (size_t)(row_base + i_) * 1024 + head * 256 + hf * 128 + 32 * w + c8_);
                        u32x4 o = *(const LAS u32x4*)(Vb + ip_ * 136 + 32 * w + c8_); const u32x4 e = eo[v];
                        if (!first) {
                            o.x = cvtpk_s(bf_lo(o.x) + bf_lo(e.x), bf_hi(o.x) + bf_hi(e.x)); o.y = cvtpk_s(bf_lo(o.y) + bf_lo(e.y), bf_hi(o.y) + bf_hi(e.y));
                            o.z = cvtpk_s(bf_lo(o.z) + bf_lo(e.z), bf_hi(o.z) + bf_hi(e.z)); o.w = cvtpk_s(bf_lo(o.w) + bf_lo(e.w), bf_hi(o.w) + bf_hi(e.w)); }
                        gp_[0] = o; }
                }
            }
            if (step == 1 || step == 131) asm volatile("s_waitcnt vmcnt(0)" ::: "memory");
            BAR_LDS();
        }
    }
}
typedef __bf16 v2bf_t __attribute__((ext_vector_type(2)));
__device__ __forceinline__ void atomic_add_bf16x8(bf16_t* p, const u32x4 v) {
    asm volatile("global_atomic_pk_add_bf16 %0, %1, off sc1\n\tglobal_atomic_pk_add_bf16 %0, %2, off offset:4 sc1\n\tglobal_atomic_pk_add_bf16 %0, %3, off offset:8 sc1\n\tglobal_atomic_pk_add_bf16 %0, %4, off offset:12 sc1"
                 :: "v"(p), "v"(v.x), "v"(v.y), "v"(v.z), "v"(v.w) : "memory");
}
constexpr int DN3_HGC = 2 * DN_DIR;
template <int VAR> __device__ __forceinline__ void dn_scan3(LAS unsigned char* lds, const bf16_t* P, const float* AB, const bf16_t* TP, bf16_t* OB) {
    const int tid0 = opaque_tid(), wv = __builtin_amdgcn_readfirstlane(tid0 >> 6), role = wv >> 2, w = wv & 3;
    for (int unit = blockIdx.x; unit < 64; unit += gridDim.x) {
        const int b = unit >> 5, vh = (unit >> 1) & 15, dir = unit & 1, kh = vh >> 1;
        __syncthreads();
        if (role == 1) {
            if (w < 3) {
                const int qh = w >= 1 ? 1 : 0, khh = w == 2 ? 1 : 0, ti = qh, tj = khh;
                u32x4 q8[8], k8[8]; float gcp;
                {
                    int rb; bool f_; dn_step_rb(0, dir, b, rb, f_);
                    const int lane = opaque_tid() & 63, r0 = lane >> 4, c8 = 8 * (lane & 15);
#pragma unroll
                    for (int v = 0; v < 8; ++v) { const int ipq = 32 * qh + r0 + 4 * v, ipk = 32 * khh + r0 + 4 * v, iq = dir ? 63 - ipq : ipq, ik = dir ? 63 - ipk : ipk;
                        q8[v] = *(const u32x4*)(P + (size_t)(rb * 64 + iq) * 4096 + kh * 128 + c8); k8[v] = *(const u32x4*)(P + (size_t)(rb * 64 + ik) * 4096 + 1024 + kh * 128 + c8); }
                    const int tl = dir ? 63 - lane : lane; gcp = AB[(size_t)(rb * 64 + tl) * 64 + dir * 16 + vh];
                }
                for (int j = 0; j < 260; ++j) {
                    const int lane = opaque_tid() & 63, r = lane & 31, h = lane >> 5, r0 = lane >> 4, c8 = 8 * (lane & 15);
                    LAS unsigned char* base = lds + (j & 1) * DN_DIR;
                    LAS bf16_t* Kb = (LAS bf16_t*)(base + DN_KB); LAS bf16_t* Qb = (LAS bf16_t*)(base + DN_QB); LAS bf16_t* Ab = (LAS bf16_t*)(base + DN_AB);
                    LAS float* hgc = (LAS float*)(lds + DN3_HGC + w * 256);
#pragma unroll
                    for (int v = 0; v < 8; ++v) { *(LAS u32x4*)(Qb + (32 * qh + r0 + 4 * v) * 136 + c8) = q8[v]; *(LAS u32x4*)(Kb + (32 * khh + r0 + 4 * v) * 136 + c8) = k8[v]; }
                    hgc[lane] = gcp;
                    asm volatile("s_waitcnt lgkmcnt(0)" ::: "memory");
                    if (j + 1 < 260) {
                        int rb; bool f_; dn_step_rb(j + 1, dir, b, rb, f_);
#pragma unroll
                        for (int v = 0; v < 8; ++v) { const int ipq = 32 * qh + r0 + 4 * v, ipk = 32 * khh + r0 + 4 * v, iq = dir ? 63 - ipq : ipq, ik = dir ? 63 - ipk : ipk;
                            q8[v] = *(const u32x4*)(P + (size_t)(rb * 64 + iq) * 4096 + kh * 128 + c8); k8[v] = *(const u32x4*)(P + (size_t)(rb * 64 + ik) * 4096 + 1024 + kh * 128 + c8); }
                        const int tl = dir ? 63 - lane : lane; gcp = AB[(size_t)(rb * 64 + tl) * 64 + dir * 16 + vh];
                    }
                    __builtin_amdgcn_sched_barrier(0);
                    {
                        f32x16 qk;
#pragma unroll
                        for (int x = 0; x < 16; ++x) qk[x] = 0.f;
#pragma unroll
                        for (int ks = 0; ks < 8; ++ks) qk = MFMA32(frag_nat(Qb, 136, 32 * ti + r, ks, h), frag_nat(Kb, 136, 32 * tj + r, ks, h), qk);
                        const int jj = 32 * tj + r; const float gj = hgc[jj];
#pragma unroll
                        for (int x = 0; x < 16; ++x) { const int i = 32 * ti + crow(x, h);
                            Ab[i * 72 + jj] = f2bf((i >= jj) ? qk[x] * __expf(hgc[i] - gj) : 0.f); }
                    }
                    BAR_LDS();
                }
                BAR_LDS();
            } else {
                u32x4 v16[16], t6[6]; float gcp, betap;
                {
                    int rb; bool f_; dn_step_rb(0, dir, b, rb, f_);
                    const int lane = opaque_tid() & 63, r0 = lane >> 4, c8 = 8 * (lane & 15);
#pragma unroll
                    for (int v = 0; v < 16; ++v) { const int ip = r0 + 4 * v, i = dir ? 63 - ip : ip; v16[v] = *(const u32x4*)(P + (size_t)(rb * 64 + i) * 4096 + 2048 + vh * 128 + c8); }
                    const bf16_t* tp = TP + (size_t)((rb * 16 + vh) * 2 + dir) * 3072;
#pragma unroll
                    for (int v = 0; v < 6; ++v) t6[v] = *(const u32x4*)(tp + (lane + 64 * v) * 8);
                    const int tl = dir ? 63 - lane : lane; const float* ab = AB + (size_t)(rb * 64 + tl) * 64; gcp = ab[dir * 16 + vh]; betap = ab[32 + dir * 16 + vh];
                }
                for (int j = 0; j < 260; ++j) {
                    const int lane = opaque_tid() & 63, r0 = lane >> 4, c8 = 8 * (lane & 15);
                    LAS unsigned char* base = lds + (j & 1) * DN_DIR;
                    LAS bf16_t* Vb = (LAS bf16_t*)(base + DN_VB); LAS bf16_t* Tb = (LAS bf16_t*)(base + DN_TB);
                    LAS float* sc_beta = (LAS float*)(base + DN_SC); LAS float* sc_gc = sc_beta + 64; LAS float* sc_eg = sc_beta + 128; LAS float* sc_tail = sc_beta + 192; LAS float* sc_dl = sc_beta + 256;
                    if (j >= 2) {
                        int rbo; bool fo_; dn_step_rb(j - 2, dir, b, rbo, fo_);
#pragma unroll
                        for (int v = 0; v < 16; ++v) { const int ip_ = r0 + 4 * v, i_ = dir ? 63 - ip_ : ip_;
                            atomic_add_bf16x8(OB + (size_t)(rbo * 64 + i_) * 2048 + vh * 128 + c8, *(const LAS u32x4*)(Vb + ip_ * 128 + c8)); }
                        asm volatile("s_waitcnt lgkmcnt(0)" ::: "memory");
                    }
#pragma unroll
                    for (int v = 0; v < 16; ++v) *(LAS u32x4*)(Vb + (r0 + 4 * v) * 128 + c8) = v16[v];
#pragma unroll
                    for (int v = 0; v < 6; ++v) { const int c = lane + 64 * v, blk = c >> 7, rowc = (c & 127) >> 2, cc = c & 3, br = blk ? 1 : 0, bc = blk == 2 ? 1 : 0;
                        *(LAS u32x4*)(Tb + (32 * br + rowc) * 72 + 32 * bc + 8 * cc) = t6[v]; }
                    { const float gc = gcp, gl = __shfl(gc, 63); sc_beta[lane] = betap; sc_gc[lane] = gc; sc_eg[lane] = __expf(gc); sc_tail[lane] = __expf(gl - gc); if (lane == 0) sc_dl[0] = __expf(gl); }
                    if (j + 1 < 260) {
                        int rb; bool f_; dn_step_rb(j + 1, dir, b, rb, f_);
#pragma unroll
                        for (int v = 0; v < 16; ++v) { const int ip = r0 + 4 * v, i = dir ? 63 - ip : ip; v16[v] = *(const u32x4*)(P + (size_t)(rb * 64 + i) * 4096 + 2048 + vh * 128 + c8); }
                        const bf16_t* tp = TP + (size_t)((rb * 16 + vh) * 2 + dir) * 3072;
#pragma unroll
                        for (int v = 0; v < 6; ++v) t6[v] = *(const u32x4*)(tp + (lane + 64 * v) * 8);
                        const int tl = dir ? 63 - lane : lane; const float* ab = AB + (size_t)(rb * 64 + tl) * 64; gcp = ab[dir * 16 + vh]; betap = ab[32 + dir * 16 + vh];
                    }
                    BAR_LDS();
                }
                {
                    const int lane = opaque_tid() & 63, r0 = lane >> 4, c8 = 8 * (lane & 15);
#pragma unroll 1
                    for (int jj = 258; jj < 260; ++jj) {
                        if (jj == 259) BAR_LDS();
                        LAS bf16_t* Vb = (LAS bf16_t*)(lds + (jj & 1) * DN_DIR + DN_VB);
                        int rbo; bool fo_; dn_step_rb(jj, dir, b, rbo, fo_);
#pragma unroll
                        for (int v = 0; v < 16; ++v) { const int ip_ = r0 + 4 * v, i_ = dir ? 63 - ip_ : ip_;
                            atomic_add_bf16x8(OB + (size_t)(rbo * 64 + i_) * 2048 + vh * 128 + c8, *(const LAS u32x4*)(Vb + ip_ * 128 + c8)); }
                    }
                }
            }
        } else {
            f32x16 S[4];
#pragma unroll
            for (int kt = 0; kt < 4; ++kt)
#pragma unroll
                for (int x = 0; x < 16; ++x) S[kt][x] = 0.f;
            BAR_LDS();
            for (int step = 0; step < 260; ++step) {
                const int lane = opaque_tid() & 63, r = lane & 31, h = lane >> 5;
                LAS unsigned char* base = lds + (step & 1) * DN_DIR;
                LAS bf16_t* Kb = (LAS bf16_t*)(base + DN_KB); LAS bf16_t* Qb = (LAS bf16_t*)(base + DN_QB); LAS bf16_t* Vb = (LAS bf16_t*)(base + DN_VB);
                LAS bf16_t* Tb = (LAS bf16_t*)(base + DN_TB); LAS bf16_t* Ab = (LAS bf16_t*)(base + DN_AB);
                LAS float* sc_beta = (LAS float*)(base + DN_SC); LAS float* sc_eg = sc_beta + 128; LAS float* sc_tail = sc_beta + 192; LAS float* sc_dl = sc_beta + 256;
                int rb; bool f_; dn_step_rb(step, dir, b, rb, f_);
                if (VAR != 2) {
                f32x16 KS[2], QS[2];
#pragma unroll
                for (int mt = 0; mt < 2; ++mt)
#pragma unroll
                    for (int x = 0; x < 16; ++x) { KS[mt][x] = 0.f; QS[mt][x] = 0.f; }
#pragma unroll
                for (int ks = 0; ks < 8; ++ks) {
                    const bf16x8 sp = pack_step(S[ks >> 1], ks & 1);
#pragma unroll
                    for (int mt = 0; mt < 2; ++mt) { KS[mt] = MFMA32(frag_perm(Kb, 136, 32 * mt + r, ks, h), sp, KS[mt]); QS[mt] = MFMA32(frag_perm(Qb, 136, 32 * mt + r, ks, h), sp, QS[mt]); }
                }
#pragma unroll
                for (int mt = 0; mt < 2; ++mt)
#pragma unroll
                    for (int g4 = 0; g4 < 4; ++g4) { const int i0 = 32 * mt + 8 * g4 + 4 * h;
                        const f32x4 bv = *(const LAS f32x4*)(sc_beta + i0), ev = *(const LAS f32x4*)(sc_eg + i0);
#pragma unroll
                        for (int e = 0; e < 4; ++e) { const int x = 4 * g4 + e; KS[mt][x] = bv[e] * (bf2f(Vb[(i0 + e) * 128 + 32 * w + r]) - ev[e] * KS[mt][x]); } }
                bf16x8 Xp[4];
#pragma unroll
                for (int ks = 0; ks < 4; ++ks) Xp[ks] = pack_step(KS[ks >> 1], ks & 1);
                f32x16 VN[2];
#pragma unroll
                for (int mt = 0; mt < 2; ++mt) {
#pragma unroll
                    for (int x = 0; x < 16; ++x) VN[mt][x] = 0.f;
#pragma unroll
                    for (int ks = 0; ks < 4; ++ks) if (ks < 2 * mt + 2) VN[mt] = MFMA32(frag_perm(Tb, 72, 32 * mt + r, ks, h), Xp[ks], VN[mt]);
                }
                bf16x8 VNp[4];
#pragma unroll
                for (int ks = 0; ks < 4; ++ks) VNp[ks] = pack_step(VN[ks >> 1], ks & 1);
#pragma unroll
                for (int mt = 0; mt < 2; ++mt) {
#pragma unroll
                    for (int g4 = 0; g4 < 4; ++g4) { const f32x4 ev = *(const LAS f32x4*)(sc_eg + 32 * mt + 8 * g4 + 4 * h);
#pragma unroll
                        for (int e = 0; e < 4; ++e) QS[mt][4 * g4 + e] *= ev[e]; }
#pragma unroll
                    for (int ks = 0; ks < 4; ++ks) if (ks < 2 * mt + 2) QS[mt] = MFMA32(frag_perm(Ab, 72, 32 * mt + r, ks, h), VNp[ks], QS[mt]);
                }
#pragma unroll
                for (int mt = 0; mt < 2; ++mt)
#pragma unroll
                    for (int x = 0; x < 16; ++x) Vb[(32 * mt + crow(x, h)) * 128 + 32 * w + r] = f2bf(QS[mt][x]);
#pragma unroll
                for (int mt = 0; mt < 2; ++mt)
#pragma unroll
                    for (int g4 = 0; g4 < 4; ++g4) { const f32x4 tv = *(const LAS f32x4*)(sc_tail + 32 * mt + 8 * g4 + 4 * h);
#pragma unroll
                        for (int e = 0; e < 4; ++e) VN[mt][4 * g4 + e] *= tv[e]; }
#pragma unroll
                for (int ks = 0; ks < 4; ++ks) VNp[ks] = pack_step(VN[ks >> 1], ks & 1);
                const float dl = sc_dl[0];
#pragma unroll
                for (int kt = 0; kt < 4; ++kt)
#pragma unroll
                    for (int x = 0; x < 16; ++x) S[kt][x] *= dl;
#pragma unroll
                for (int ks = 0; ks < 4; ++ks) {
#pragma unroll
                    for (int kt = 0; kt < 4; ++kt) S[kt] = MFMA32(frag_tr(Kb, 136, 32 * kt, ks, lane), VNp[ks], S[kt]);
                }
                }
                BAR_LDS();
            }
        }
    }
}
constexpr int GLA_NG = 8, GLA_SG = 33;
template <int PASS>
__device__ __forceinline__ void gla_scan3(LAS unsigned char* lds, bf16_t* P  , const bf16_t* QM, const bf16_t* KM, const bf16_t* AQ, const float* EL, bf16_t* OB  , float* SEND, float* DSUM) {
    const int tid0 = opaque_tid(), wv = __builtin_amdgcn_readfirstlane(tid0 >> 6), role = wv >> 2, w = wv & 3;
    for (int unit = blockIdx.x; unit < 32 * GLA_NG; unit += gridDim.x) {
        const int g = unit & (GLA_NG - 1), bu = unit >> 3;
        const int b = bu >> 4, head = (bu >> 2) & 3, hf = (bu >> 1) & 1, dir = bu & 1;
        if (PASS == 0 && g == GLA_NG - 1) continue;
        const int lo = GLA_SG * g, hi = (lo + GLA_SG < 260) ? lo + GLA_SG : 260;
        const int seq = (b * 4 + head) * 2 + dir;
        __syncthreads();
        if (role == 1) {
            GlPre pre; float dsum = 0.f;
            { int rb0; bool f0; dn_step_rb(lo, dir, b, rb0, f0); gl_prefetch(pre, P, QM, KM, AQ, EL, rb0, dir, head, hf, opaque_tid() & 255); }
            for (int j = lo; j < hi; ++j) {
                const int t = opaque_tid() & 255;
                LAS unsigned char* base = lds + ((j - lo) & 1) * GL_DIR;
                LAS bf16_t* Qm = (LAS bf16_t*)(base + GL_QM); LAS bf16_t* Km = (LAS bf16_t*)(base + GL_KM); LAS bf16_t* Vb = (LAS bf16_t*)(base + GL_VB); LAS bf16_t* Ab = (LAS bf16_t*)(base + GL_AB);
                LAS float* el = (LAS float*)(base + GL_EL);
                const int r0 = t >> 4, c8 = 8 * (t & 15);
#pragma unroll
                for (int v = 0; v < 4; ++v) { const int i = r0 + 16 * v, ip = dir ? 63 - i : i;
                    *(LAS u32x4*)(Qm + i * 136 + c8) = pre.q4[v]; *(LAS u32x4*)(Km + i * 136 + c8) = pre.k4[v]; *(LAS u32x4*)(Vb + ip * 136 + c8) = pre.v4[v]; }
                { const int c = t, row = c >> 3, cc = c & 7; *(LAS u32x4*)(Ab + row * 72 + 8 * cc) = pre.a0; }
                { const int c = 256 + t, row = c >> 3, cc = c & 7; *(LAS u32x4*)(Ab + row * 72 + 8 * cc) = pre.a1; }
                if (t < 128) el[t] = __expf(pre.elv);
                dsum += pre.elv;
                if (j + 1 < hi) { int rbn; bool fn; dn_step_rb(j + 1, dir, b, rbn, fn); gl_prefetch(pre, P, QM, KM, AQ, EL, rbn, dir, head, hf, t); }
                BAR_LDS();
            }
            if (PASS == 0 && hf == 0) { const int t = opaque_tid() & 255; if (t < 128) DSUM[(size_t)(seq * GLA_NG + g) * 128 + t] = dsum; }
            BAR_LDS();
        } else {
            f32x16 S[4];
#pragma unroll
            for (int kt = 0; kt < 4; ++kt)
#pragma unroll
                for (int x = 0; x < 16; ++x) S[kt][x] = 0.f;
            if (PASS == 1) {
                const int lane = opaque_tid() & 63, r = lane & 31, h = lane >> 5;
                for (int gp = 0; gp < g; ++gp) {
                    const float* se = SEND + (size_t)(seq * GLA_NG + gp) * 128 * 256 + hf * 128 + 32 * w + r; const float* ds = DSUM + (size_t)(seq * GLA_NG + gp) * 128;
#pragma unroll
                    for (int kt = 0; kt < 4; ++kt)
#pragma unroll
                        for (int x = 0; x < 16; ++x) { const int dk = 32 * kt + crow(x, h); S[kt][x] = __expf(ds[dk]) * S[kt][x] + se[(size_t)dk * 256]; }
                }
            }
            BAR_LDS();
            for (int step = lo; step < hi; ++step) {
                const int lane = opaque_tid() & 63, r = lane & 31, h = lane >> 5;
                LAS unsigned char* base = lds + ((step - lo) & 1) * GL_DIR;
                LAS bf16_t* Qm = (LAS bf16_t*)(base + GL_QM); LAS bf16_t* Km = (LAS bf16_t*)(base + GL_KM); LAS bf16_t* Vb = (LAS bf16_t*)(base + GL_VB); LAS bf16_t* Ab = (LAS bf16_t*)(base + GL_AB);
                LAS float* el = (LAS float*)(base + GL_EL);
                int rb; bool f_; dn_step_rb(step, dir, b, rb, f_);
#pragma unroll
                for (int kt = 0; kt < 4; ++kt)
#pragma unroll
                    for (int g4 = 0; g4 < 4; ++g4) { const f32x4 ev = *(const LAS f32x4*)(el + 32 * kt + 8 * g4 + 4 * h);
#pragma unroll
                        for (int e = 0; e < 4; ++e) S[kt][4 * g4 + e] *= ev[e]; }
                bf16x8 Vf[4];
#pragma unroll
                for (int ks = 0; ks < 4; ++ks) Vf[ks] = frag_tr(Vb, 136, 32 * w, ks, lane);
                if (PASS == 1) {
                    f32x16 O[2];
#pragma unroll
                    for (int mt = 0; mt < 2; ++mt) {
#pragma unroll
                        for (int x = 0; x < 16; ++x) O[mt][x] = 0.f;
#pragma unroll
                        for (int ks = 0; ks < 4; ++ks) if (ks < 2 * mt + 2) O[mt] = MFMA32(frag_perm(Ab, 72, 32 * mt + r, ks, h), Vf[ks], O[mt]);
                    }
#pragma unroll
                    for (int ks = 0; ks < 8; ++ks) {
                        const bf16x8 sp = pack_step(S[ks >> 1], ks & 1);
#pragma unroll
                        for (int mt = 0; mt < 2; ++mt) O[mt] = MFMA32(frag_perm(Qm, 136, 32 * mt + r, ks, h), sp, O[mt]);
                    }
#pragma unroll
                    for (int mt = 0; mt < 2; ++mt)
#pragma unroll
                        for (int x = 0; x < 16; ++x) Vb[(32 * mt + crow(x, h)) * 136 + 32 * w + r] = f2bf(O[mt][x]);
                }
#pragma unroll
                for (int ks = 0; ks < 4; ++ks) {
#pragma unroll
                    for (int kt = 0; kt < 4; ++kt) S[kt] = MFMA32(frag_tr(Km, 136, 32 * kt, ks, lane), Vf[ks], S[kt]);
                }
                if (PASS == 1) {
                    asm volatile("s_waitcnt lgkmcnt(0)" ::: "memory");
                    const int rr_ = lane >> 2, c8_ = 8 * (lane & 3);
#pragma unroll
                    for (int v = 0; v < 4; ++v) { const int ip_ = rr_ + 16 * v, i_ = dir ? 63 - ip_ : ip_; const int oc_ = head * 256 + hf * 128 + 32 * w + c8_;
                        bf16_t* dst_ = dir ? P + (size_t)(rb * 64 + i_) * 3072 + oc_ : OB + (size_t)(rb * 64 + i_) * 1024 + oc_;
                        *(u32x4*)dst_ = *(const LAS u32x4*)(Vb + ip_ * 136 + 32 * w + c8_); }
                }
                BAR_LDS();
            }
            if (PASS == 0) {
                const int lane = opaque_tid() & 63, r = lane & 31, h = lane >> 5;
                float* se = SEND + (size_t)(seq * GLA_NG + g) * 128 * 256 + hf * 128 + 32 * w + r;
#pragma unroll
                for (int kt = 0; kt < 4; ++kt)
#pragma unroll
                    for (int x = 0; x < 16; ++x) se[(size_t)(32 * kt + crow(x, h)) * 256] = S[kt][x];
            }
        }
    }
}
#define XB_TMO      128
#define XB_XCNT(j)  (256  + 64 * (j))
#define XB_XSUB(j)  (1280 + 64 * (j))
#define XB_XGEN(j)  (2304 + 64 * (j))
#define XB_TOP      3328
#define XB_TOPGEN   3392
#define XCD_BAR_WORDS 3456
#define XB_SPIN_CAP (1u << 23)

__device__ __forceinline__ unsigned xb_ld(unsigned* p)              { return __hip_atomic_load(p, __ATOMIC_RELAXED, __HIP_MEMORY_SCOPE_AGENT); }
__device__ __forceinline__ unsigned xb_add(unsigned* p, unsigned v) { return __hip_atomic_fetch_add(p, v, __ATOMIC_RELAXED, __HIP_MEMORY_SCOPE_AGENT); }
__device__ __forceinline__ unsigned xb_xcc_id() { return (unsigned)__builtin_amdgcn_s_getreg((3 << 11) | 20) & 0xFu; }
#define XB_SPIN(cond, bar) do { unsigned _sp = 0; while (cond) { __builtin_amdgcn_s_sleep(1); \
    if ((++_sp & 255u) == 0u) { if (xb_ld(&(bar)[XB_TMO])) break; if (_sp > XB_SPIN_CAP) { atomicAdd(&(bar)[XB_TMO], 1u); break; } } } } while (0)

struct XcdBarrier {
    unsigned* bar; unsigned x;
    volatile LAS unsigned* st;
};

__device__ __forceinline__ XcdBarrier xcd_barrier_post(unsigned* bar, volatile LAS unsigned* st) {
    XcdBarrier b; b.bar = bar; b.x = xb_xcc_id(); b.st = st;
    if (threadIdx.x == 0) (void)xb_add(&bar[XB_XCNT(b.x)], 1u);
    return b;
}
__device__ __forceinline__ void xcd_barrier_complete(unsigned* bar, unsigned x, unsigned& nloc, unsigned& nx) {
    const unsigned G = gridDim.x * gridDim.y * gridDim.z;
    unsigned sum, cnt, mine, sp = 0u;
    for (;;) {
        sum = 0u; cnt = 0u; mine = 0u;
#pragma unroll
        for (unsigned j = 0; j < 16; ++j) { const unsigned c = xb_ld(&bar[XB_XCNT(j)]); sum += c; cnt += (c > 0u) ? 1u : 0u; mine = (j == x) ? c : mine; }
        if (sum == G) break;
        __builtin_amdgcn_s_sleep(1);
        if ((++sp & 255u) == 0u) { if (xb_ld(&bar[XB_TMO])) break; if (sp > XB_SPIN_CAP) { atomicAdd(&bar[XB_TMO], 1u); break; } }
    }
    nloc = mine > 0u ? mine : 1u; nx = cnt > 0u ? cnt : 1u;
}

__device__ __forceinline__ void xcd_barrier(const XcdBarrier& b) {
    asm volatile("s_waitcnt vmcnt(0)" ::: "memory");
    __syncthreads();
    if (threadIdx.x == 0) {
        unsigned* bar = b.bar;
        __builtin_amdgcn_s_waitcnt(0);
        unsigned nloc = b.st[0], nx = b.st[1];
        if (nloc == 0u) { xcd_barrier_complete(bar, b.x, nloc, nx); b.st[0] = nloc; b.st[1] = nx; }
        const unsigned old = xb_add(&bar[XB_XSUB(b.x)], 1u);
        const unsigned gen = old / nloc;
        if (old + 1u == (gen + 1u) * nloc) {
            __builtin_amdgcn_fence(__ATOMIC_RELEASE, "agent");
            asm volatile("s_waitcnt vmcnt(0)" ::: "memory");
            const unsigned og = xb_add(&bar[XB_TOP], 1u);
            const unsigned tg = og / nx;
            if (og + 1u == (tg + 1u) * nx) xb_add(&bar[XB_TOPGEN], 1u);
            else XB_SPIN(xb_ld(&bar[XB_TOPGEN]) == tg, bar);
            __builtin_amdgcn_fence(__ATOMIC_ACQUIRE, "agent");
            xb_add(&bar[XB_XGEN(b.x)], 1u);
            asm volatile("s_waitcnt vmcnt(0)" ::: "memory");
        } else {
            XB_SPIN(xb_ld(&bar[XB_XGEN(b.x)]) == gen, bar);
            __builtin_amdgcn_fence(__ATOMIC_ACQUIRE, "agent");
            asm volatile("s_waitcnt vmcnt(0)" ::: "memory");
        }
    }
    __syncthreads();
}

#define DUP_DN 0
#define DN_VARIANT 0
#define DN_VAR_PARITY0 0
#define DUP_GLA 0
#define DUP_ATT 0
#define DUP_GIN 0
#define DUP_FFN1 0
constexpr unsigned long long pack_ops(const int* ops, int n) { unsigned long long v = 0; for (int i = 0; i < n; ++i) v |= (unsigned long long)ops[i] << (5 * i); return v; }
struct OpList { unsigned long long code; int n; };
constexpr OpList make_list(int mix) {
    int ops[16] = {}; int n = 0;
    ops[n++] = OP_PREP; ops[n++] = OP_GEMM_IN; if (DUP_GIN && mix != 0) ops[n++] = OP_GEMM_IN;
    if (mix == 0) { ops[n++] = OP_DNCONV; ops[n++] = OP_DNT; ops[n++] = OP_DNSCAN; if (DUP_DN) ops[n++] = OP_DNSCAN; ops[n++] = OP_DNREDO; ops[n++] = OP_GEMM_Z; }
    else if (mix == 1) { ops[n++] = OP_GLAPREP; ops[n++] = OP_GLASTATE; ops[n++] = OP_GLASCAN; ops[n++] = OP_GLAGATE; }
    else { ops[n++] = OP_QKROPE; ops[n++] = OP_ATTN; if (DUP_ATT) ops[n++] = OP_ATTN; }
    ops[n++] = OP_GEMM_OUT; ops[n++] = OP_NORM2; ops[n++] = OP_FFN1; if (DUP_FFN1 && mix != 0) ops[n++] = OP_FFN1; ops[n++] = OP_FFN2;
    return OpList{pack_ops(ops, n), n};
}
constexpr OpList L_DN = make_list(0), L_GL = make_list(1), L_AT = make_list(2);
constexpr int NPHASE = 1 + 2 * L_DN.n + L_GL.n + L_AT.n;
__device__ __forceinline__ void decode_phase(int ph, int& layer, int& op) {
    if (ph == 0) { layer = 0; op = OP_MOD; return; }
    int p = ph - 1;
    if (p < L_DN.n) { layer = 0; op = (int)((L_DN.code >> (5 * p)) & 31ull); return; } p -= L_DN.n;
    if (p < L_GL.n) { layer = 1; op = (int)((L_GL.code >> (5 * p)) & 31ull); return; } p -= L_GL.n;
    if (p < L_AT.n) { layer = 2; op = (int)((L_AT.code >> (5 * p)) & 31ull); return; } p -= L_AT.n;
    layer = 3; op = (int)((L_DN.code >> (5 * p)) & 31ull);
}

__global__ void __launch_bounds__(512, 2) mega(Args args) {
    extern __shared__ __attribute__((aligned(16))) unsigned char lds_raw[];
    LAS unsigned char* lds = (LAS unsigned char*)lds_raw;
    cg::grid_group grid = cg::this_grid();
    volatile LAS unsigned* xb_st = (volatile LAS unsigned*)(lds + LDS_BYTES - 64);
    if (threadIdx.x < 2) xb_st[threadIdx.x] = 0u;
    __syncthreads();
    const XcdBarrier xbar = xcd_barrier_post((unsigned*)(args.ws + WS_BAR), xb_st);
    const int G = gridDim.x, NGW = G * 8;
    unsigned char* ws = args.ws;
    const float* x_in = args.in[0]; const float* c_in = args.in[1]; const float* ctx_in = args.in[2]; const float* cctx_in = args.in[3];
    const float* ada_w = args.in[4]; const float* ada_b = args.in[5]; const float* norm_mix_g = args.in[6]; const float* norm_ffn_g = args.in[7];
    const float* ffn_w1 = args.in[8]; const float* ffn_w2 = args.in[9];
    float* MOD = (float*)(ws + WS_MOD); float* CTXC = (float*)(ws + WS_CTX); bf16_t* H = (bf16_t*)(ws + WS_H); float* ABF = (float*)(ws + WS_AB); float* RSTD = (float*)(ws + WS_RSTD);
    bf16_t* PB = (bf16_t*)(ws + WS_P); float* out = args.out;

    for (int ph = args.ph_lo; ph < args.ph_hi; ++ph) {
        int layer, op; decode_phase(ph, layer, op);
        const int mix = layer % 3, slot = layer / 3;
        const float* modl = MOD + (size_t)layer * 3 * 6144;
        const float* xl = layer == 0 ? x_in : out; const float* xc = layer == 0 ? ctx_in : CTXC;
        if (op == OP_MOD) {
            const int tid = opaque_tid(), lane = tid & 63, wave = __builtin_amdgcn_readfirstlane(tid >> 6); const int gw = blockIdx.x * 8 + wave; (void)lane; (void)gw; (void)tid;
            LAS float* sl = (LAS float*)lds; LAS float* red = sl + 3 * 1024;
            for (int e = tid; e < 3 * 1024; e += 512) { const float v = e < 2048 ? c_in[e] : cctx_in[e - 2048]; sl[e] = silu_f(v); }
            __syncthreads();
            for (int item = blockIdx.x; item < 4 * 96; item += G) {
                const int ly = item / 96, col = (item % 96) * 64 + lane;
                const float* wp = ada_w + ((size_t)ly * 1024 + 128 * wave) * 6144 + col;
                float a0 = 0.f, a1 = 0.f, a2 = 0.f;
#pragma unroll 8
                for (int k = 0; k < 128; ++k) { const float wv = wp[(size_t)k * 6144]; const int kk = 128 * wave + k; a0 += sl[kk] * wv; a1 += sl[1024 + kk] * wv; a2 += sl[2048 + kk] * wv; }
                red[(wave * 3 + 0) * 64 + lane] = a0; red[(wave * 3 + 1) * 64 + lane] = a1; red[(wave * 3 + 2) * 64 + lane] = a2;
                __syncthreads();
                if (tid < 192) { const int m = tid >> 6; float s = ada_b[(size_t)ly * 6144 + col];
#pragma unroll
                    for (int w2 = 0; w2 < 8; ++w2) s += red[(w2 * 3 + m) * 64 + lane];
                    MOD[((size_t)ly * 3 + m) * 6144 + col] = s; }
                __syncthreads();
            }
        } else if (op == OP_PREP) {
            const int tid = opaque_tid(), lane = tid & 63, wave = __builtin_amdgcn_readfirstlane(tid >> 6); const int gw = blockIdx.x * 8 + wave; (void)lane; (void)gw; (void)tid;
            LAS float* scr = (LAS float*)(lds + wave * 16384);
            unsigned z0 = 0u; asm volatile("" : "+v"(z0)); const u32x4 zv = (u32x4){z0, z0, z0, z0};
            bf16_t* wtA = (bf16_t*)(ws + WT_A); bf16_t* wtZ = (bf16_t*)(ws + WT_Z); bf16_t* wtO = (bf16_t*)(ws + WT_O); bf16_t* wt1 = (bf16_t*)(ws + WT_1); bf16_t* wt2 = (bf16_t*)(ws + WT_2);
            if (mix == 0) {
                const float* w_in = args.in[10] + (size_t)slot * 1024 * 6208; const float* w_out = args.in[15] + (size_t)slot * 2048 * 1024;
                transpose_mat(w_in, 6208, 0, 4096, 1024, wtA, 0, scr, gw, NGW, lane);
                transpose_mat(w_in, 6208, 6144, 64, 1024, wtA, 4096, scr, gw, NGW, lane);
                for (size_t e = (size_t)blockIdx.x * 512 + tid; e < (size_t)192 * 1024 * 2 / 16; e += (size_t)G * 512) ((u32x4*)(wtA + (size_t)4160 * 1024))[e] = zv;
            } else if (mix == 1) {
                const float* w_in = args.in[16]; const float* w_out = args.in[20];
                transpose_mat(w_in, 3104, 0, 3104, 1024, wtA, 0, scr, gw, NGW, lane);
                for (size_t e = (size_t)blockIdx.x * 512 + tid; e < (size_t)224 * 1024 * 2 / 16; e += (size_t)G * 512) ((u32x4*)(wtA + (size_t)3104 * 1024))[e] = zv;
                transpose_mat(w_out, 1024, 0, 1024, 1024, wtO, 0, scr, gw, NGW, lane);
            } else {
                const float* w_in = args.in[21]; const float* w_out = args.in[24];
                transpose_mat(w_in, 1536, 0, 1536, 1024, wtA, 0, scr, gw, NGW, lane);
                transpose_mat(w_out, 1024, 0, 1024, 1024, wtO, 0, scr, gw, NGW, lane);
            }
            if (mix != 0) {
                transpose_mat(ffn_w1 + (size_t)layer * 1024 * 4096, 4096, 0, 4096, 1024, wt1, 0, scr, gw, NGW, lane);
                transpose_mat(ffn_w2 + (size_t)layer * 4096 * 1024, 1024, 0, 1024, 4096, wt2, 0, scr, gw, NGW, lane);
            }
            normmod_rows(xl, xc, norm_mix_g + (size_t)layer * 1024, modl, 0, H, gw, NGW, lane);
        } else if (op == OP_DNREDO) {
            const int tid = opaque_tid(), lane = tid & 63, wave = __builtin_amdgcn_readfirstlane(tid >> 6); const int gw = blockIdx.x * 8 + wave; (void)lane; (void)gw; (void)tid;
            LAS float* scr = (LAS float*)(lds + wave * 16384);
            const float* w_in = args.in[10] + (size_t)slot * 1024 * 6208; const float* w_out = args.in[15] + (size_t)slot * 2048 * 1024;
            transpose_mat(w_in, 6208, 4096, 2048, 1024, (bf16_t*)(ws + WT_Z), 0, scr, gw, NGW, lane);
            transpose_mat(w_out, 1024, 0, 1024, 2048, (bf16_t*)(ws + WT_O), 0, scr, gw, NGW, lane);
            transpose_mat(ffn_w1 + (size_t)layer * 1024 * 4096, 4096, 0, 4096, 1024, (bf16_t*)(ws + WT_1), 0, scr, gw, NGW, lane);
            transpose_mat(ffn_w2 + (size_t)layer * 4096 * 1024, 1024, 0, 1024, 4096, (bf16_t*)(ws + WT_2), 0, scr, gw, NGW, lane);
            normmod_rows(xl, xc, norm_mix_g + (size_t)layer * 1024, modl, 0, H, gw, NGW, lane);
            const bf16_t* OB = (const bf16_t*)(ws + WS_O);
            for (int row = gw; row < MROWS; row += NGW) {
                const u32x4* p = (const u32x4*)(OB + (size_t)row * 2048 + 32 * lane); float ss = 0.f;
#pragma unroll
                for (int v = 0; v < 4; ++v) { const u32x4 q = p[v]; const float a0 = bf_lo(q.x), a1 = bf_hi(q.x), a2 = bf_lo(q.y), a3 = bf_hi(q.y), a4 = bf_lo(q.z), a5 = bf_hi(q.z), a6 = bf_lo(q.w), a7 = bf_hi(q.w);
                    ss += (a0 * a0 + a1 * a1) + (a2 * a2 + a3 * a3) + (a4 * a4 + a5 * a5) + (a6 * a6 + a7 * a7); }
                ss += __shfl_xor(ss, 1); ss += __shfl_xor(ss, 2);
                if ((lane & 3) == 0) RSTD[(size_t)row * 16 + (lane >> 2)] = rsqrtf(ss * (1.f / 128.f) + EPS);
            }
        } else if (op == OP_DNHALO) {
            dn_halo_phase(PB, (bf16_t*)(ws + WS_HALO), G);
        } else if (op == OP_DNCONV) {
            dn_conv_phase(PB, (const bf16_t*)(ws + WS_HALO), args.in[11] + (size_t)slot * 4096 * 5, G);
        } else if (op == OP_DNT) {
            dn_t_phase(lds, PB, ABF, (bf16_t*)(ws + WS_TP), args.in[12] + (size_t)slot * 32, args.in[13] + (size_t)slot * 32, G);
            {
                unsigned z0 = 0u; asm volatile("" : "+v"(z0)); const u32x4 zv = (u32x4){z0, z0, z0, z0}; u32x4* zp = (u32x4*)(ws + WS_O);
                for (size_t e = (size_t)blockIdx.x * 512 + opaque_tid(); e < (size_t)MROWS * 2048 * 2 / 16; e += (size_t)G * 512) zp[e] = zv;
            }
        } else if (op == OP_NORM2) {
            const int tid = opaque_tid(), lane = tid & 63, wave = __builtin_amdgcn_readfirstlane(tid >> 6); const int gw = blockIdx.x * 8 + wave; (void)lane; (void)gw; (void)tid;
            normmod_rows(out, CTXC, norm_ffn_g + (size_t)layer * 1024, modl, 3, H, gw, NGW, lane);
        } else if (op == OP_GEMM_IN || op == OP_GEMM_Z || op == OP_GEMM_OUT || op == OP_FFN1 || op == OP_FFN2) {
            pg8::Gemm g; pg8::Epi E;
            E.mode = 0; E.O = PB; E.ldc = 4096; E.tail_pn = -1; E.halo = nullptr; E.F = ABF; E.ldf = 64; E.nf = 64; E.rstd = RSTD; E.ng = args.in[14] + (size_t)slot * 128;
            E.src_lat = xl; E.src_ctx = xc; E.dst_lat = out; E.dst_ctx = CTXC; E.mod = modl; E.gidx = 2;
            g.M = (layer == 3 && op != OP_GEMM_IN) ? NLAT : MROWS; g.A = H; g.K = 1024;
            bf16_t* OBUF = (bf16_t*)(ws + (mix == 1 ? WS_OGLA : WS_O));
            if (op == OP_GEMM_IN) {
                g.Bt = (const bf16_t*)(ws + WT_A);
                if (mix == 0) { g.N = 4352; E.ldc = 4096; E.tail_pn = 16; E.ldf = 64; E.nf = 64; E.halo = (bf16_t*)(ws + WS_HALO); }
                else if (mix == 1) { g.N = 3328; E.ldc = 3072; E.tail_pn = 12; E.ldf = 32; E.nf = 32; }
                else { g.N = 1536; E.ldc = 1536; }
            } else if (op == OP_GEMM_Z) {
                g.Bt = (const bf16_t*)(ws + WT_Z); g.N = 2048; E.mode = 2; E.O = OBUF; E.ldc = 2048;
            } else if (op == OP_GEMM_OUT) {
                g.A = OBUF; g.K = mix == 0 ? 2048 : 1024; g.Bt = (const bf16_t*)(ws + WT_O); g.N = 1024; E.mode = 3; E.gidx = 2;
            } else if (op == OP_FFN1) {
                g.Bt = (const bf16_t*)(ws + WT_1); g.N = 4096; E.mode = 1; E.ldc = 4096;
            } else {
                g.A = PB; g.K = 4096; g.Bt = (const bf16_t*)(ws + WT_2); g.N = 1024; E.mode = 3; E.gidx = 5; E.src_lat = out; E.src_ctx = CTXC;
            }
            pg8::StaticOrder S; S.init(g.M, g.N, G, (int)blockIdx.x);
#ifndef NO_GEMM
            pg8::gemm_phase<pg8::Epi, pg8::StaticOrder, true, true>(lds, g, S, E);
#endif
        } else if (op == OP_DNSCAN) {
#ifndef NO_DN
            if (DN_VARIANT && (ph & 1) == 0) dn_scan3<DN_VARIANT>(lds, PB, ABF, (const bf16_t*)(ws + WS_TP), (bf16_t*)(ws + WS_O)); else dn_scan3<0>(lds, PB, ABF, (const bf16_t*)(ws + WS_TP), (bf16_t*)(ws + WS_O));
#endif
        } else if (op == OP_GLAPREP) {
            gla_prep_phase(lds, PB, ABF, args.in[17], args.in[18], (bf16_t*)(ws + WS_QM), (bf16_t*)(ws + WS_KM), (bf16_t*)(ws + WS_AQ), (float*)(ws + WS_EL), G);
        } else if (op == OP_GLASTATE) {
            gla_scan3<0>(lds, PB, (const bf16_t*)(ws + WS_QM), (const bf16_t*)(ws + WS_KM), (const bf16_t*)(ws + WS_AQ), (const float*)(ws + WS_EL), (bf16_t*)(ws + WS_OGLA), (float*)(ws + WS_SEND), (float*)(ws + WS_DSUM));
        } else if (op == OP_GLASCAN) {
#ifndef NO_GLA
            gla_scan3<1>(lds, PB, (const bf16_t*)(ws + WS_QM), (const bf16_t*)(ws + WS_KM), (const bf16_t*)(ws + WS_AQ), (const float*)(ws + WS_EL), (bf16_t*)(ws + WS_OGLA), (float*)(ws + WS_SEND), (float*)(ws + WS_DSUM));
#endif
        } else if (op == OP_GLAGATE) {
            const int tid = opaque_tid(), lane = tid & 63, wave = __builtin_amdgcn_readfirstlane(tid >> 6); const int gw = blockIdx.x * 8 + wave; (void)lane; (void)gw; (void)tid;
            bf16_t* OB = (bf16_t*)(ws + WS_OGLA); const float* ng = args.in[19];
            for (int row = gw; row < MROWS; row += NGW) {
                u32x4* p = (u32x4*)(OB + (size_t)row * 1024 + 16 * lane); const u32x4* gp = (const u32x4*)(PB + (size_t)row * 3072 + 2048 + 16 * lane); const u32x4* pb2 = (const u32x4*)(PB + (size_t)row * 3072 + 16 * lane);
                float o[16], z[16]; float ss = 0.f;
#pragma unroll
                for (int v = 0; v < 2; ++v) { const u32x4 q = p[v], gq = gp[v], q2 = pb2[v];
                    o[8 * v + 0] = bf_lo(q.x) + bf_lo(q2.x); o[8 * v + 1] = bf_hi(q.x) + bf_hi(q2.x); o[8 * v + 2] = bf_lo(q.y) + bf_lo(q2.y); o[8 * v + 3] = bf_hi(q.y) + bf_hi(q2.y); o[8 * v + 4] = bf_lo(q.z) + bf_lo(q2.z); o[8 * v + 5] = bf_hi(q.z) + bf_hi(q2.z); o[8 * v + 6] = bf_lo(q.w) + bf_lo(q2.w); o[8 * v + 7] = bf_hi(q.w) + bf_hi(q2.w);
                    z[8 * v + 0] = bf_lo(gq.x); z[8 * v + 1] = bf_hi(gq.x); z[8 * v + 2] = bf_lo(gq.y); z[8 * v + 3] = bf_hi(gq.y); z[8 * v + 4] = bf_lo(gq.z); z[8 * v + 5] = bf_hi(gq.z); z[8 * v + 6] = bf_lo(gq.w); z[8 * v + 7] = bf_hi(gq.w); }
#pragma unroll
                for (int e = 0; e < 16; ++e) ss += o[e] * o[e];
                ss += __shfl_xor(ss, 1); ss += __shfl_xor(ss, 2); ss += __shfl_xor(ss, 4); ss += __shfl_xor(ss, 8);
                const float rs = rsqrtf(ss * (1.f / 256.f) + EPS); const int cb = (16 * lane) & 255;
#pragma unroll
                for (int v = 0; v < 2; ++v) { float rr[8];
#pragma unroll
                    for (int e = 0; e < 8; ++e) rr[e] = o[8 * v + e] * rs * ng[cb + 8 * v + e] * silu_f(z[8 * v + e]);
                    u32x4 wv; wv.x = cvtpk_s(rr[0], rr[1]); wv.y = cvtpk_s(rr[2], rr[3]); wv.z = cvtpk_s(rr[4], rr[5]); wv.w = cvtpk_s(rr[6], rr[7]); p[v] = wv; }
            }
        } else if (op == OP_QKROPE) {
            const int tid = opaque_tid(), lane = tid & 63, wave = __builtin_amdgcn_readfirstlane(tid >> 6); const int gw = blockIdx.x * 8 + wave; (void)lane; (void)gw; (void)tid;
            bf16_t* QR = (bf16_t*)(ws + WS_QR); bf16_t* KR = (bf16_t*)(ws + WS_KR); bf16_t* VR = (bf16_t*)(ws + WS_VR);
            const float* qg = args.in[22]; const float* kg = args.in[23];
            const int hf = lane >> 5, j = lane & 31, e1 = 64 * hf + j, e2 = e1 + 32;
            const float inv_freq = exp2f(-(float)(2 * j) * (1.f / 64.f) * 13.287712379549449f);
            const float gq1 = qg[e1], gq2 = qg[e2], gk1 = kg[e1], gk2 = kg[e2];
            for (int rowa = gw; rowa < MROWS; rowa += 2 * NGW) {
                float x1[2][10], x2[2][10]; unsigned short va[2][4]; int rws[2]; rws[0] = rowa; rws[1] = rowa + NGW < MROWS ? rowa + NGW : rowa;
#pragma unroll
                for (int q = 0; q < 2; ++q) { const bf16_t* pr = PB + (size_t)rws[q] * 1536;
#pragma unroll
                    for (int hd = 0; hd < 10; ++hd) { x1[q][hd] = bf2f(pr[hd * 128 + e1]); x2[q][hd] = bf2f(pr[hd * 128 + e2]); }
                    va[q][0] = pr[1280 + e1]; va[q][1] = pr[1280 + e2]; va[q][2] = pr[1408 + e1]; va[q][3] = pr[1408 + e2]; }
#pragma unroll
                for (int q = 0; q < 2; ++q) {
                    if (q == 1 && rowa + NGW >= MROWS) break;
                    const int row = rws[q];
                    const bool lat = row < NLAT; const int b = lat ? row / SEQ : (row - NLAT) / CTXL; const int tpos = lat ? row % SEQ : (row - NLAT) % CTXL;
                    float cs = 1.f, sn = 0.f;
                    if (lat) { const float pos = (float)(hf == 0 ? tpos / 64 : tpos % 64); const float ang = pos * inv_freq; sn = sinf(ang); cs = cosf(ang); }
                    const int kpos = lat ? tpos : SEQ + tpos;
#pragma unroll
                    for (int hd = 0; hd < 10; ++hd) {
                        const float a1 = x1[q][hd], a2 = x2[q][hd];
                        const float rinv = rsqrtf(wave_sum(a1 * a1 + a2 * a2) * (1.f / 128.f) + EPS);
                        const float y1 = a1 * rinv * (hd < 8 ? gq1 : gk1), y2 = a2 * rinv * (hd < 8 ? gq2 : gk2);
                        const float o1 = y1 * cs - y2 * sn, o2 = y1 * sn + y2 * cs;
                        bf16_t* dst = hd < 8 ? QR + (size_t)row * 1024 + hd * 128 : KR + ((size_t)(b * 2 + (hd - 8)) * SKV + kpos) * 128;
                        dst[e1] = f2bf(o1); dst[e2] = f2bf(o2);
                    }
#pragma unroll
                    for (int kv = 0; kv < 2; ++kv) { bf16_t* dst = VR + ((size_t)(b * 2 + kv) * SKV + kpos) * 128; dst[e1] = va[q][2 * kv]; dst[e2] = va[q][2 * kv + 1]; }
                }
            }
        } else if (op == OP_ATTN) {
            const attn::bf16* QR = (const attn::bf16*)(ws + WS_QR); const attn::bf16* KR = (const attn::bf16*)(ws + WS_KR); const attn::bf16* VR = (const attn::bf16*)(ws + WS_VR);
            attn::bf16* OB = (attn::bf16*)(ws + WS_O);
            for (int u = blockIdx.x; u < 1024 + 16; u += G) {
                size_t qoff, koff; int seq;
                if (u < 1024) { const int pair = u >> 8, b = pair >> 1, kvh = pair & 1, hh = (u >> 6) & 3, qb = u & 63, head = kvh * 4 + hh;
                    qoff = ((size_t)b * SEQ + (size_t)qb * 256) * 1024 + head * 128; koff = (size_t)(b * 2 + kvh) * SKV * 128; seq = SKV; }
                else { const int jx = u - 1024, b = jx >> 3, head = jx & 7, kvh = head >> 2;
                    qoff = ((size_t)NLAT + (size_t)b * CTXL) * 1024 + head * 128; koff = ((size_t)(b * 2 + kvh) * SKV + SEQ) * 128; seq = CTXL; }
                __syncthreads();
#ifndef NO_ATT
                attn::attn_dense_body<attn::bf16>(QR + qoff, KR + koff, VR + koff, OB + qoff, seq, (char*)lds_raw);
#endif
            }
        }
        if (ph + 1 < args.ph_hi) { if (ph == 0) grid.sync(); else xcd_barrier(xbar); }
    }
}

#ifndef MK_MULTI
#define MK_MULTI 0
#endif
extern "C" void kernel_launch(void* const* d_in, const int* in_sizes, int n_in, void* d_out, int out_size, void* d_ws, size_t ws_size, hipStream_t stream) {
    static int grid = 0;
    if (grid == 0) {
        if (n_in != 25 || ws_size < WS_END) { fprintf(stderr, "kernel_launch: unexpected n_in %d / ws_size %zu (need %zu)\n", n_in, ws_size, (size_t)WS_END); grid = -1; return; }
        int dev = 0, cus = 0, per_cu = 0;
        hipGetDevice(&dev); hipDeviceGetAttribute(&cus, hipDeviceAttributeMultiprocessorCount, dev);
        if (hipFuncSetAttribute((const void*)mega, hipFuncAttributeMaxDynamicSharedMemorySize, LDS_BYTES) != hipSuccess) { fprintf(stderr, "kernel_launch: hipFuncSetAttribute failed\n"); grid = -1; return; }
        if (hipOccupancyMaxActiveBlocksPerMultiprocessor(&per_cu, (const void*)mega, 512, LDS_BYTES) != hipSuccess || per_cu < 1) { fprintf(stderr, "kernel_launch: occupancy query says %d\n", per_cu); per_cu = 1; }
        (void)hipGetLastError();
        grid = cus * 1;
    }
    if (grid < 0) return;
    if (hipMemsetAsync((char*)d_ws + WS_BAR, 0, WS_BAR_BYTES, stream) != hipSuccess) { fprintf(stderr, "kernel_launch: memset of barrier words failed\n"); return; }
    Args a{};
    for (int i = 0; i < 25; ++i) a.in[i] = (const float*)d_in[i];
    a.out = (float*)d_out; a.ws = (unsigned char*)d_ws;
#if MK_MULTI
    for (int ph = 0; ph < NPHASE; ++ph) { a.ph_lo = ph; a.ph_hi = ph + 1; hipLaunchKernelGGL(mega, dim3(grid), dim3(512), LDS_BYTES, stream, a); }
#else
    a.ph_lo = 0; a.ph_hi = NPHASE;
    void* kargs[] = {&a};
    hipError_t e = hipLaunchCooperativeKernel((const void*)mega, dim3(grid), dim3(512), kargs, LDS_BYTES, stream);
    if (e != hipSuccess) fprintf(stderr, "cooperative launch failed: %s (grid %d)\n", hipGetErrorString(e), grid);
#endif
}
```

```cpp
#include <hip/hip_runtime.h>
#include <hip/hip_bf16.h>
#include <hip/hip_cooperative_groups.h>
#include <cstdio>
#include <cstdint>
namespace cg = cooperative_groups;
__device__ __forceinline__ int opaque_tid() { int t = threadIdx.x; asm volatile("" : "+v"(t)); return t; }
namespace pg8 {
#define PG8_LAS __attribute__((address_space(3)))
typedef unsigned short bf16_t;
typedef short bf16x8 __attribute__((ext_vector_type(8)));
typedef float f32x4 __attribute__((ext_vector_type(4)));
typedef unsigned u32x4 __attribute__((ext_vector_type(4)));
constexpr int BM = 256, BK = 64, HALF = 128, HTB = HALF * BK * 2  , STAGE_BYTES = 8 * HTB, NXCD = 8, WGM = 8;

__host__ __device__ __forceinline__ int lds_byte(int r, int c) { const int st = (r >> 4) * 2 + (c >> 5), rr = r & 15, cc = c & 31, ob = rr * 64 + cc * 2; return st * 1024 + (ob ^ (((ob >> 9) & 1) << 5)); }
__host__ __device__ __forceinline__ void stage_rc(int b, int& R, int& C) { const int st = b / 1024, sb = b % 1024, swz = sb ^ (((sb >> 9) & 1) << 5); R = (st >> 1) * 16 + swz / 64; C = (st & 1) * 32 + (swz % 64) / 2; }
__host__ __device__ __forceinline__ int perm32(int rho) { const int n = rho >> 4, i = rho & 15; return 8 * (i >> 2) + 4 * n + (i & 3); }

struct Unit { int pm, pn, k0, nt; };
struct Gemm { const bf16_t* A; const bf16_t* Bt; int M, N, K; };

struct StaticOrder {
    int nM, nN, nwg, G, c, ntf, NS, nMc;
    __host__ __device__ void init(int M, int N, int G_, int c_, int ntf_, int NS_ = 1, int nMc_ = 0) { nM = M / BM; nN = N / BM; nwg = nM * nN; G = G_; c = c_; ntf = ntf_; NS = NS_; nMc = nMc_; }
    __host__ __device__ bool next(int i, Unit& u) const {
        const long L = (long)i * G + c;
        if (L >= (long)nwg + (long)nMc * nN * NS) return false;
        int pm, pn, k0 = 0, ntu = ntf;
        if (L >= nwg) { const int s_ = (int)(L - nwg), sl = s_ % NS, rest = s_ / NS; pn = rest % nN; pm = nM + rest / nN; ntu = ntf / NS; k0 = sl * ntu; }
        else {
            int wgid = (int)L; { const int q = nwg / NXCD, r = nwg % NXCD, xcd = wgid % NXCD, off = wgid / NXCD; wgid = (xcd < r ? xcd * (q + 1) : r * (q + 1) + (xcd - r) * q) + off; }
            const int nig = WGM * nN, gid = wgid / nig, fm = gid * WGM, gsz = (nM - fm) < WGM ? (nM - fm) : WGM;
            pm = fm + ((wgid % nig) % gsz); pn = (wgid % nig) / gsz;
        }
        u.pm = pm; u.pn = pn; u.k0 = k0; u.nt = ntu; return true;
    }
    __device__ __forceinline__ void a_ready(const Unit&) const {}
    __device__ __forceinline__ void done(const Unit&) const {}
};

__device__ __forceinline__ unsigned cvt_pk_bf16(float lo, float hi) { unsigned r; asm volatile("v_cvt_pk_bf16_f32 %0, %1, %2" : "=v"(r) : "v"(lo), "v"(hi)); return r; }
typedef float f32x2 __attribute__((ext_vector_type(2)));
typedef float f32x2_t __attribute__((ext_vector_type(2))); typedef __bf16 bf16x2_t __attribute__((ext_vector_type(2)));
__device__ __forceinline__ unsigned cvtpk_s(float lo, float hi) { f32x2_t v = {lo, hi}; bf16x2_t b = __builtin_convertvector(v, bf16x2_t); return __builtin_bit_cast(unsigned, b); }
__device__ __forceinline__ float bf_lo(unsigned w) { return __builtin_bit_cast(float, w << 16); }
__device__ __forceinline__ float bf_hi(unsigned w) { return __builtin_bit_cast(float, w & 0xffff0000u); }
__device__ __forceinline__ float silu_f(float z) { return z / (1.f + __expf(-z)); }
struct Epi {
    static constexpr bool PERM = true, AFTER_DRAIN = false;
    int mode;
    bf16_t* O; int ldc;
    int tail_pn; float* F; int ldf, nf;
    bf16_t* halo;
    const float* rstd; const float* ng;
    const float* src_lat; const float* src_ctx; float* dst_lat; float* dst_ctx; const float* mod; int gidx;
    float* part; int ntf;
    __device__ __forceinline__ void operator()(const f32x4 (&acc)[2][2][4][2], const Unit& u, int wr, int wc, int fr, int fq) const {
        const int row0 = u.pm * BM + wr * 64 + fr; const int col0 = u.pn * BM + wc * 32 + 8 * fq;
        if (mode == 3 && u.nt != ntf) {
            float* pb = part + ((size_t)(u.k0 / u.nt) * 512 - 32768) * 1024;
#pragma unroll
            for (int ai = 0; ai < 2; ++ai)
#pragma unroll
                for (int m = 0; m < 4; ++m)
#pragma unroll
                    for (int bj = 0; bj < 2; ++bj) { float* p = pb + (size_t)(row0 + ai * HALF + m * 16) * 1024 + col0 + bj * HALF; *(f32x4*)p = acc[ai][bj][m][0]; *(f32x4*)(p + 4) = acc[ai][bj][m][1]; }
            return;
        }
        if (mode <= 1) {
            if (u.pn == tail_pn) {
                const int c0 = wc * 32 + 8 * fq;
#pragma unroll
                for (int ai = 0; ai < 2; ++ai)
#pragma unroll
                    for (int m = 0; m < 4; ++m)
#pragma unroll
                        for (int bj = 0; bj < 2; ++bj) { const int cc = c0 + bj * HALF;
                            if (cc < nf) { float* p = F + (size_t)(row0 + ai * HALF + m * 16) * ldf + cc; *(f32x4*)p = acc[ai][bj][m][0]; *(f32x4*)(p + 4) = acc[ai][bj][m][1]; } }
            } else {
#pragma unroll
                for (int ai = 0; ai < 2; ++ai)
#pragma unroll
                    for (int m = 0; m < 4; ++m) { bf16_t* rowp = O + (size_t)(row0 + ai * HALF + m * 16) * ldc + col0;
#pragma unroll
                        for (int bj = 0; bj < 2; ++bj) { f32x4 v0 = acc[ai][bj][m][0], v1 = acc[ai][bj][m][1];
                            if (mode == 1) {
#pragma unroll
                                for (int e = 0; e < 4; ++e) { float a = fmaxf(v0[e], 0.f), b = fmaxf(v1[e], 0.f); v0[e] = a * a; v1[e] = b * b; } }
                            u32x4 w; w.x = cvtpk_s(v0[0], v0[1]); w.y = cvtpk_s(v0[2], v0[3]); w.z = cvtpk_s(v1[0], v1[1]); w.w = cvtpk_s(v1[2], v1[3]);
                            *(u32x4*)(rowp + bj * HALF) = w;
                            if (halo && ((m == 0 && fr < 2) || (m == 3 && fr >= 14))) { const int row = row0 + ai * HALF + m * 16; const int j = m == 0 ? fr : fr - 12;
                                *(u32x4*)(halo + ((size_t)(row >> 6) * 4 + j) * ldc + col0 + bj * HALF) = w; } } }
            }
        } else if (mode == 2) {
            const f32x4 g0 = *(const f32x4*)(ng + (col0 & 127)), g1 = *(const f32x4*)(ng + (col0 & 127) + 4);
#pragma unroll
            for (int ai = 0; ai < 2; ++ai)
#pragma unroll
                for (int m = 0; m < 4; ++m) { const int row = row0 + ai * HALF + m * 16; bf16_t* rowp = O + (size_t)row * ldc + col0;
#pragma unroll
                    for (int bj = 0; bj < 2; ++bj) { const float rs = rstd[(size_t)row * 16 + ((col0 + bj * HALF) >> 7)];
                        const u32x4 ov = *(const u32x4*)(rowp + bj * HALF); const f32x4 z0 = acc[ai][bj][m][0], z1 = acc[ai][bj][m][1];
                        float r[8];
                        r[0] = bf_lo(ov.x) * rs * g0[0] * silu_f(z0[0]); r[1] = bf_hi(ov.x) * rs * g0[1] * silu_f(z0[1]);
                        r[2] = bf_lo(ov.y) * rs * g0[2] * silu_f(z0[2]); r[3] = bf_hi(ov.y) * rs * g0[3] * silu_f(z0[3]);
                        r[4] = bf_lo(ov.z) * rs * g1[0] * silu_f(z1[0]); r[5] = bf_hi(ov.z) * rs * g1[1] * silu_f(z1[1]);
                        r[6] = bf_lo(ov.w) * rs * g1[2] * silu_f(z1[2]); r[7] = bf_hi(ov.w) * rs * g1[3] * silu_f(z1[3]);
                        u32x4 w; w.x = cvtpk_s(r[0], r[1]); w.y = cvtpk_s(r[2], r[3]); w.z = cvtpk_s(r[4], r[5]); w.w = cvtpk_s(r[6], r[7]);
                        *(u32x4*)(rowp + bj * HALF) = w; } }
        } else {
            const int mi = u.pm < 64 ? 0 : (u.pm < 128 ? 1 : 2);
            const float* gate = mod + (size_t)mi * 6144 + (size_t)gidx * 1024;
            const bool lat = u.pm < 128;
            const float* sb = lat ? src_lat : src_ctx - (size_t)32768 * 1024; float* db = lat ? dst_lat : dst_ctx - (size_t)32768 * 1024;
#pragma unroll
            for (int bj = 0; bj < 2; ++bj)
#pragma unroll
                for (int n = 0; n < 2; ++n) { const int c = col0 + bj * HALF + 4 * n; const f32x4 gv = *(const f32x4*)(gate + c);
#pragma unroll
                    for (int ai = 0; ai < 2; ++ai)
#pragma unroll
                        for (int m = 0; m < 4; ++m) { const size_t off = (size_t)(row0 + ai * HALF + m * 16) * 1024 + c;
                            const f32x4 s = *(const f32x4*)(sb + off); *(f32x4*)(db + off) = s + gv * acc[ai][bj][m][n]; } }
        }
    }
};
template <class Epi, class Sched, bool ALIGN_EPI = false, bool SP2 = false>
__device__ __forceinline__ void gemm_phase(PG8_LAS unsigned char* lds, const Gemm g, const Sched& S, const Epi& E) {
    const int tid = opaque_tid(), wid = __builtin_amdgcn_readfirstlane(tid >> 6), lane = tid & 63, wr = wid >> 2, wc = wid & 3, fr = lane & 15, fq = lane >> 4;
    const int K = g.K;
    unsigned voffA[2], voffB[2];
#pragma unroll
    for (int i = 0; i < 2; ++i) { int R, C; stage_rc(tid * 16 + i * 8192, R, C); const int Rb = Epi::PERM ? ((R & ~31) + perm32(R & 31)) : R;
        voffA[i] = (unsigned)(R * K + C) * 2u; voffB[i] = (unsigned)(Rb * K + C) * 2u; }
    const size_t kstep = (size_t)(BK * 2);
    const size_t hstep = (size_t)HALF * K * 2;
    const size_t tstep = 2 * hstep;
    const unsigned ldsw = (unsigned)wid * 1024u;
    const int aoff = lds_byte(wr * 64 + fr, fq * 8), boff = lds_byte(wc * 32 + fr, fq * 8);
#define PG8_SA(b, h) (((b) * 2 + (h)) * HTB)
#define PG8_SB(b, h) ((4 + (b) * 2 + (h)) * HTB)
#define PG8_STAGE(bufoff, gbase, voff) do { _Pragma("unroll") for (int _i = 0; _i < 2; ++_i) \
        __builtin_amdgcn_global_load_lds((const unsigned*)((const char*)(gbase) + (voff)[_i]), (PG8_LAS unsigned*)(lds + (bufoff) + ldsw + _i * 8192), 16, 0, 0); } while (0)
#define PG8_LDA(dst, b, h) do { _Pragma("unroll") for (int m = 0; m < 4; ++m) _Pragma("unroll") for (int k = 0; k < 2; ++k) dst[m][k] = *(const PG8_LAS bf16x8*)(lds + PG8_SA(b, h) + aoff + m * 2048 + k * 1024); } while (0)
#define PG8_LDB(dst, b, h) do { _Pragma("unroll") for (int n = 0; n < 2; ++n) _Pragma("unroll") for (int k = 0; k < 2; ++k) dst[n][k] = *(const PG8_LAS bf16x8*)(lds + PG8_SB(b, h) + boff + n * 2048 + k * 1024); } while (0)
#define PG8_MMA(ai, bj, At, Bt) do { __builtin_amdgcn_s_setprio(1); _Pragma("unroll") for (int m = 0; m < 4; ++m) _Pragma("unroll") for (int n = 0; n < 2; ++n) _Pragma("unroll") for (int k = 0; k < 2; ++k) \
        acc[ai][bj][m][n] = __builtin_amdgcn_mfma_f32_16x16x32_bf16(Bt[n][k], At[m][k], acc[ai][bj][m][n], 0, 0, 0); __builtin_amdgcn_s_setprio(0); } while (0)
#define PG8_WAIT_V(n) asm volatile("s_waitcnt vmcnt(" #n ")" ::: "memory")
#define PG8_WAIT_L(n) asm volatile("s_waitcnt lgkmcnt(" #n ")" ::: "memory")
#define PG8_BAR __builtin_amdgcn_s_barrier()
#define PG8_SCHED __builtin_amdgcn_sched_barrier(0)
    Unit cur, nxt; int ui = 0;
    if (!S.next(0, cur)) return;
    f32x4 acc[2][2][4][2];
#pragma unroll
    for (int a = 0; a < 2; ++a)
#pragma unroll
        for (int b = 0; b < 2; ++b)
#pragma unroll
            for (int m = 0; m < 4; ++m)
#pragma unroll
                for (int n = 0; n < 2; ++n) acc[a][b][m][n] = (f32x4){0.f, 0.f, 0.f, 0.f};
    bf16x8 At[4][2], B0[2][2], B1[2][2];
    const char* cA = (const char*)g.A + (size_t)cur.pm * tstep + (size_t)cur.k0 * kstep; const char* cB = (const char*)g.Bt + (size_t)cur.pn * tstep + (size_t)cur.k0 * kstep;
    S.a_ready(cur);
    if constexpr (SP2) {
        PG8_STAGE(PG8_SB(0, 0), cB, voffB); PG8_STAGE(PG8_SB(0, 1), cB + hstep, voffB); PG8_STAGE(PG8_SA(0, 0), cA, voffA); PG8_STAGE(PG8_SA(0, 1), cA + hstep, voffA);
        if (wr == 1) PG8_BAR;
        PG8_WAIT_V(2); PG8_BAR;
        PG8_STAGE(PG8_SB(1, 0), cB + kstep, voffB); PG8_STAGE(PG8_SA(1, 0), cA + kstep, voffA); PG8_STAGE(PG8_SB(1, 1), cB + hstep + kstep, voffB);
        PG8_WAIT_V(6); PG8_BAR;
    } else {
        PG8_STAGE(PG8_SB(0, 0), cB, voffB); PG8_STAGE(PG8_SA(0, 0), cA, voffA); PG8_STAGE(PG8_SB(0, 1), cB + hstep, voffB); PG8_STAGE(PG8_SA(0, 1), cA + hstep, voffA);
        if (wr == 1) PG8_BAR;
        PG8_WAIT_V(4); PG8_BAR;
        PG8_STAGE(PG8_SB(1, 0), cB + kstep, voffB); PG8_STAGE(PG8_SA(1, 0), cA + kstep, voffA); PG8_STAGE(PG8_SB(1, 1), cB + hstep + kstep, voffB);
        PG8_WAIT_V(6); PG8_BAR;
    }
    for (;;) {
        const bool has_next = S.next(ui + 1, nxt);
        const char* nA = has_next ? (const char*)g.A + (size_t)nxt.pm * tstep + (size_t)nxt.k0 * kstep : cA; const char* nB = has_next ? (const char*)g.Bt + (size_t)nxt.pn * tstep + (size_t)nxt.k0 * kstep : cB;
        const int nt = cur.nt;
        for (int t = 0; t < nt; t += 2) {
            const bool last = (t == nt - 2);
            const char* a1 = cA + (size_t)(t + 1) * kstep;
            const char* a2 = last ? nA : cA + (size_t)(t + 2) * kstep; const char* b2 = last ? nB : cB + (size_t)(t + 2) * kstep;
            const char* a3 = a2 + kstep; const char* b3 = b2 + kstep;
            if (last && has_next) S.a_ready(nxt);
            if constexpr (SP2) {
            PG8_LDB(B0, 0, 0); PG8_LDB(B1, 0, 1); PG8_SCHED; PG8_LDA(At, 0, 0); PG8_STAGE(PG8_SA(1, 1), a1 + hstep, voffA);
            PG8_WAIT_V(8); PG8_WAIT_L(0); PG8_BAR; PG8_MMA(0, 0, At, B0); PG8_MMA(0, 1, At, B1); PG8_BAR; PG8_SCHED;
            PG8_LDA(At, 0, 1); PG8_STAGE(PG8_SB(0, 0), b2, voffB); PG8_STAGE(PG8_SB(0, 1), b2 + hstep, voffB); PG8_STAGE(PG8_SA(0, 0), a2, voffA);
            PG8_WAIT_V(8); PG8_WAIT_L(0); PG8_BAR; PG8_MMA(1, 0, At, B0); PG8_MMA(1, 1, At, B1); PG8_BAR; PG8_SCHED;
            PG8_LDB(B0, 1, 0); PG8_LDB(B1, 1, 1); PG8_SCHED; PG8_LDA(At, 1, 0); PG8_STAGE(PG8_SA(0, 1), a2 + hstep, voffA);
            PG8_WAIT_V(8); PG8_WAIT_L(0); PG8_BAR; PG8_MMA(0, 0, At, B0); PG8_MMA(0, 1, At, B1); PG8_BAR; PG8_SCHED;
            PG8_LDA(At, 1, 1); PG8_STAGE(PG8_SB(1, 0), b3, voffB); PG8_STAGE(PG8_SB(1, 1), b3 + hstep, voffB); PG8_STAGE(PG8_SA(1, 0), a3, voffA);
            PG8_WAIT_V(8); PG8_WAIT_L(0); PG8_BAR; PG8_MMA(1, 0, At, B0); PG8_MMA(1, 1, At, B1); PG8_BAR; PG8_SCHED;
            } else {
            PG8_LDB(B0, 0, 0); PG8_SCHED; PG8_LDA(At, 0, 0); PG8_STAGE(PG8_SA(1, 1), a1 + hstep, voffA);
            PG8_WAIT_L(8); PG8_BAR; PG8_WAIT_L(0); PG8_MMA(0, 0, At, B0); PG8_BAR; PG8_SCHED;
            PG8_LDB(B1, 0, 1); PG8_STAGE(PG8_SB(0, 0), b2, voffB);
            PG8_BAR; PG8_WAIT_L(0); PG8_MMA(0, 1, At, B1); PG8_BAR;
            PG8_LDA(At, 0, 1); PG8_STAGE(PG8_SA(0, 0), a2, voffA);
            PG8_BAR; PG8_WAIT_L(0); PG8_MMA(1, 0, At, B0); PG8_BAR; PG8_SCHED;
            PG8_STAGE(PG8_SB(0, 1), b2 + hstep, voffB);
            PG8_WAIT_V(6); PG8_BAR; PG8_MMA(1, 1, At, B1); PG8_BAR;
            PG8_LDB(B0, 1, 0); PG8_SCHED; PG8_LDA(At, 1, 0); PG8_STAGE(PG8_SA(0, 1), a2 + hstep, voffA);
            PG8_WAIT_L(8); PG8_BAR; PG8_WAIT_L(0); PG8_MMA(0, 0, At, B0); PG8_BAR; PG8_SCHED;
            PG8_LDB(B1, 1, 1); PG8_STAGE(PG8_SB(1, 0), b3, voffB);
            PG8_BAR; PG8_WAIT_L(0); PG8_MMA(0, 1, At, B1); PG8_BAR;
            PG8_LDA(At, 1, 1); PG8_STAGE(PG8_SA(1, 0), a3, voffA);
            PG8_BAR; PG8_WAIT_L(0); PG8_MMA(1, 0, At, B0); PG8_BAR; PG8_SCHED;
            PG8_STAGE(PG8_SB(1, 1), b3 + hstep, voffB);
            PG8_WAIT_V(6); PG8_BAR; PG8_MMA(1, 1, At, B1); PG8_BAR;
            }
        }
        if constexpr (ALIGN_EPI) { if (wr == 0) PG8_BAR; }
        if constexpr (!Epi::AFTER_DRAIN) { E(acc, cur, wr, wc, fr, fq); S.done(cur); }
        if (!has_next) break;
#pragma unroll
        for (int a = 0; a < 2; ++a)
#pragma unroll
            for (int b = 0; b < 2; ++b)
#pragma unroll
                for (int m = 0; m < 4; ++m)
#pragma unroll
                    for (int n = 0; n < 2; ++n) acc[a][b][m][n] = (f32x4){0.f, 0.f, 0.f, 0.f};
        cur = nxt; cA = nA; cB = nB; ++ui;
        if constexpr (ALIGN_EPI) { if (wr == 1) PG8_BAR; }
    }
    PG8_WAIT_V(0);
    if constexpr (!ALIGN_EPI) { if (wr == 0) PG8_BAR; }
    PG8_BAR;
    if constexpr (Epi::AFTER_DRAIN) { E.fused(acc, cur, wr, wc, fr, fq, lds, wid, lane); S.done(cur); }
#undef PG8_SA
#undef PG8_SB
#undef PG8_STAGE
#undef PG8_LDA
#undef PG8_LDB
#undef PG8_MMA
#undef PG8_WAIT_V
#undef PG8_WAIT_L
#undef PG8_BAR
#undef PG8_SCHED
}
}
namespace attn {
using bf16 = __hip_bfloat16;
constexpr int   D = 128, NW = 8, QBLK = 32, KVBLK = 64;
constexpr float SCALE = 0.088388347648318440f;
constexpr float THR = 8.f;
constexpr int SDEPTH = 2;
constexpr int LDQ = 1024, LDK = 128, LDO = 1024;
constexpr size_t SHM_V = KVBLK * D * 2, SHM_K = KVBLK * D * 2, SHM_ATTN = 2 * SHM_V + 2 * SHM_K + NW * 64 * 4;
using bf16x8 = __attribute__((ext_vector_type(8))) short;
using s16x4  = __attribute__((ext_vector_type(4))) short;
using f32x16 = __attribute__((ext_vector_type(16))) float;
using f32x8  = __attribute__((ext_vector_type(8))) float;
using u32x4  = __attribute__((ext_vector_type(4))) unsigned;
#define KSWZ(row, colB) ((row) * 256 + ((colB) ^ (((row) & 7) << 4)))
#define SBAR() __builtin_amdgcn_sched_barrier(0)
__device__ __forceinline__ int crow(int r, int hi) { return (r & 3) + 8 * (r >> 2) + 4 * hi; }
__device__ __forceinline__ unsigned cvtpk(float lo, float hi) {
  unsigned r; asm volatile("v_cvt_pk_bf16_f32 %0, %1, %2" : "=v"(r) : "v"(lo), "v"(hi)); return r;
}
template <typename TIn> struct Stage;
template <> struct Stage<bf16>  { using T = bf16x8;
  __device__ static __forceinline__ T ld8(const bf16* p) { return *reinterpret_cast<const bf16x8*>(p); }
  __device__ static __forceinline__ bf16x8 tobf(T x) { return x; } };
template <> struct Stage<float> { using T = f32x8;
  __device__ static __forceinline__ T ld8(const float* p) { return *reinterpret_cast<const f32x8*>(p); }
  __device__ static __forceinline__ bf16x8 tobf(T x) {
    u32x4 w = {cvtpk(x[0], x[1]), cvtpk(x[2], x[3]), cvtpk(x[4], x[5]), cvtpk(x[6], x[7])}; return *reinterpret_cast<bf16x8*>(&w); } };

__device__ __forceinline__ void partialSM(f32x16& p0, f32x16& p1, float& m_reg, float& mn, float& alpha) {
  constexpr float C = SCALE * 1.4426950408889634f;
  float pmax = p0[0]; for (int r = 1; r < 16; ++r) pmax = fmaxf(pmax, p0[r]); for (int r = 0; r < 16; ++r) pmax = fmaxf(pmax, p1[r]);
  { auto rr = __builtin_amdgcn_permlane32_swap(__float_as_uint(pmax), __float_as_uint(pmax), false, false);
    pmax = fmaxf(__uint_as_float(rr[0]), __uint_as_float(rr[1])); }
  if (__builtin_expect(__all(pmax - m_reg <= THR / SCALE), 1)) { mn = m_reg; alpha = 1.f; }
  else { mn = fmaxf(m_reg, pmax); alpha = __builtin_amdgcn_exp2f((m_reg - mn) * C); m_reg = mn; }
  float mnC = -mn * C;
  for (int r = 0; r < 16; ++r) p0[r] = fmaf(p0[r], C, mnC); for (int r = 0; r < 16; ++r) p1[r] = fmaf(p1[r], C, mnC);
  for (int r = 0; r < 16; ++r) p0[r] = __builtin_amdgcn_exp2f(p0[r]);
}
__device__ __forceinline__ void finishSM(f32x16& p0, f32x16& p1, float alpha, float& l_reg, bf16x8& pa0, bf16x8& pa1, bf16x8& pa2, bf16x8& pa3) {
  for (int r = 0; r < 16; ++r) p1[r] = __builtin_amdgcn_exp2f(p1[r]);
  float ps = 0; for (int r = 0; r < 16; ++r) ps += p0[r]; for (int r = 0; r < 16; ++r) ps += p1[r];
  { auto rr = __builtin_amdgcn_permlane32_swap(__float_as_uint(ps), __float_as_uint(ps), false, false);
    ps = __uint_as_float(rr[0]) + __uint_as_float(rr[1]); }
  l_reg = l_reg * alpha + ps;
#define PK4(P, BASE, OUT) do { unsigned a0 = cvtpk(P[BASE + 0], P[BASE + 1]), a1 = cvtpk(P[BASE + 2], P[BASE + 3]);   \
    unsigned b0 = cvtpk(P[BASE + 4], P[BASE + 5]), b1 = cvtpk(P[BASE + 6], P[BASE + 7]);                              \
    auto r0 = __builtin_amdgcn_permlane32_swap(a0, b0, false, false); auto r1 = __builtin_amdgcn_permlane32_swap(a1, b1, false, false); \
    u32x4 w = {r0[0], r1[0], r0[1], r1[1]}; OUT = *reinterpret_cast<bf16x8*>(&w); } while (0)
  PK4(p0, 0, pa0); PK4(p0, 8, pa1); PK4(p1, 0, pa2); PK4(p1, 8, pa3);
#undef PK4
}
__device__ __forceinline__ void qkt(f32x16& p0, f32x16& p1, const bf16* Ks, const bf16x8* qr, int r32, int hi) {
  p0 = f32x16{}; p1 = f32x16{};
  for (int d0 = 0; d0 < 8; ++d0) { int cb = (d0 * 16 + hi * 8) * 2;
    bf16x8 b0 = *reinterpret_cast<const bf16x8*>((const char*)Ks + KSWZ(r32, cb));
    bf16x8 b1 = *reinterpret_cast<const bf16x8*>((const char*)Ks + KSWZ(32 + r32, cb));
    p0 = __builtin_amdgcn_mfma_f32_32x32x16_bf16(b0, qr[d0], p0, 0, 0, 0);
    p1 = __builtin_amdgcn_mfma_f32_32x32x16_bf16(b1, qr[d0], p1, 0, 0, 0); }
}
__device__ __forceinline__ int v_st(int k, int c) { const int kk = (k & ~0xC) | ((k & 4) << 1) | ((k & 8) >> 1); return ((kk >> 3) * 4 + (c >> 5)) * 512 + ((kk & 7) * 32 + (c & 31)) * 2; }
__device__ __forceinline__ int v_rd_base(int lane) { return ((lane & 3) << 3) | (((lane >> 2) & 3) << 6) | (((lane >> 4) & 1) << 5) | (((lane >> 5) & 1) << 8); }
constexpr int v_rd_off(int d0, int ks, int half) { return d0 * 512 + ks * 4096 + half * 2048; }
template <int OFF> __device__ __forceinline__ s16x4 tr_read(int vb) {
  s16x4 r; asm volatile("ds_read_b64_tr_b16 %0, %1 offset:%2" : "=&v"(r) : "v"(vb), "i"(OFF) : "memory"); return r;
}
template <int D0> __device__ __forceinline__ void pv_one(f32x16& od, int vb, bf16x8 pa0, bf16x8 pa1, bf16x8 pa2, bf16x8 pa3) {
  const s16x4 l0 = tr_read<v_rd_off(D0, 0, 0)>(vb), h0 = tr_read<v_rd_off(D0, 0, 1)>(vb), l1 = tr_read<v_rd_off(D0, 1, 0)>(vb), h1 = tr_read<v_rd_off(D0, 1, 1)>(vb);
  const s16x4 l2 = tr_read<v_rd_off(D0, 2, 0)>(vb), h2 = tr_read<v_rd_off(D0, 2, 1)>(vb), l3 = tr_read<v_rd_off(D0, 3, 0)>(vb), h3 = tr_read<v_rd_off(D0, 3, 1)>(vb);
  asm volatile("s_waitcnt lgkmcnt(0)" ::: "memory"); SBAR();
#define PK(L, H) (bf16x8){L[0], L[1], L[2], L[3], H[0], H[1], H[2], H[3]}
  od = __builtin_amdgcn_mfma_f32_32x32x16_bf16(pa0, PK(l0, h0), od, 0, 0, 0);
  od = __builtin_amdgcn_mfma_f32_32x32x16_bf16(pa1, PK(l1, h1), od, 0, 0, 0);
  od = __builtin_amdgcn_mfma_f32_32x32x16_bf16(pa2, PK(l2, h2), od, 0, 0, 0);
  od = __builtin_amdgcn_mfma_f32_32x32x16_bf16(pa3, PK(l3, h3), od, 0, 0, 0);
#undef PK
}
__device__ __forceinline__ void pv_d0(f32x16* o, int vb, bf16x8 pa0, bf16x8 pa1, bf16x8 pa2, bf16x8 pa3) {
  pv_one<0>(o[0], vb, pa0, pa1, pa2, pa3); pv_one<1>(o[1], vb, pa0, pa1, pa2, pa3); pv_one<2>(o[2], vb, pa0, pa1, pa2, pa3); pv_one<3>(o[3], vb, pa0, pa1, pa2, pa3);
}

template <typename TQ>
__device__ __forceinline__ void attn_dense_body(const TQ* __restrict__ Qb, const bf16* __restrict__ Kh, const bf16* __restrict__ Vh,
                                                bf16* __restrict__ Ob, int seq, char* lds) {
  using St = Stage<bf16>; using SQ = Stage<TQ>;
  const int tid = opaque_tid(), wid = tid >> 6, lane = tid & 63, r32 = lane & 31, hi = lane >> 5;
  bf16* V_lds = (bf16*)lds; bf16* K_lds = (bf16*)(lds + 2 * SHM_V);
  float* ws = (float*)(lds + 2 * SHM_V + 2 * SHM_K) + wid * 64; float* li_l = ws; float* al_l = ws + 32;
  float m_reg = -1e30f, l_reg = 0; f32x16 o[4] = {}; bf16x8 qr[8];
  const TQ* Qw = Qb + (long)(wid * QBLK + r32) * LDQ + hi * 8;
#pragma unroll
  for (int d0 = 0; d0 < 8; ++d0) qr[d0] = SQ::tobf(SQ::ld8(Qw + d0 * 16));
  const int sr = tid >> 4, sc = (tid & 15) * 8, vst0 = v_st(sr, sc), vst1 = v_st(32 + sr, sc);
  const int vb0 = (int)(uintptr_t)V_lds + v_rd_base(lane);
  struct { typename St::T vs0, vs1, ks0, ks1; } sr_[SDEPTH];
#define SLOAD(i, k0) do { sr_[i].vs0 = St::ld8(&Vh[(long)((k0) + sr) * LDK + sc]); sr_[i].vs1 = St::ld8(&Vh[(long)((k0) + 32 + sr) * LDK + sc]); \
    sr_[i].ks0 = St::ld8(&Kh[(long)((k0) + sr) * LDK + sc]); sr_[i].ks1 = St::ld8(&Kh[(long)((k0) + 32 + sr) * LDK + sc]); } while (0)
#define SWRITE(b, i) do { *(bf16x8*)((char*)V_lds + (b) * SHM_V + vst0) = St::tobf(sr_[i].vs0);          \
    *(bf16x8*)((char*)V_lds + (b) * SHM_V + vst1) = St::tobf(sr_[i].vs1); int kc = sc * 2;               \
    *(bf16x8*)((char*)K_lds + (b) * SHM_K + KSWZ(sr, kc)) = St::tobf(sr_[i].ks0);                       \
    *(bf16x8*)((char*)K_lds + (b) * SHM_K + KSWZ(32 + sr, kc)) = St::tobf(sr_[i].ks1); } while (0)
#define SWAIT() do { if constexpr (SDEPTH == 2) asm volatile("s_waitcnt vmcnt(4)" ::: "memory"); else asm volatile("s_waitcnt vmcnt(0)" ::: "memory"); } while (0)
#define RESC(a) do { if (__any((a) < 1.f)) { if (hi == 0) al_l[r32] = (a); asm volatile("s_waitcnt lgkmcnt(0)" ::: "memory"); \
    for (int d = 0; d < 4; ++d) for (int r = 0; r < 16; ++r) o[d][r] *= al_l[crow(r, hi)]; } } while (0)
  f32x16 pA0, pA1, pB0, pB1; float mnA, mnB, alA, alB; bf16x8 pa0, pa1, pa2, pa3; const int NT = seq / KVBLK;
  constexpr int SE = 0, SO = SDEPTH - 1;
  SLOAD(SE, 0); asm volatile("s_waitcnt vmcnt(0)" ::: "memory"); SWRITE(0, SE); __syncthreads();
  qkt(pA0, pA1, K_lds, qr, r32, hi); partialSM(pA0, pA1, m_reg, mnA, alA);
  SLOAD(SO, KVBLK); if constexpr (SDEPTH == 2) { if (2 < NT) SLOAD(SE, 2 * KVBLK); }
  SWAIT(); SWRITE(1, SO); __syncthreads();
  for (int j = 1; j + 1 < NT; j += 2) {
    SBAR(); qkt(pB0, pB1, (bf16*)((char*)K_lds + SHM_K), qr, r32, hi);
    finishSM(pA0, pA1, alA, l_reg, pa0, pa1, pa2, pa3); SBAR();
    SLOAD(SO, (j + SDEPTH) * KVBLK); SBAR();
    pv_d0(o, vb0, pa0, pa1, pa2, pa3); partialSM(pB0, pB1, m_reg, mnB, alB);
    __syncthreads(); SWAIT(); SWRITE(0, SE);
    RESC(alB); __syncthreads();
    SBAR(); qkt(pA0, pA1, K_lds, qr, r32, hi);
    finishSM(pB0, pB1, alB, l_reg, pa0, pa1, pa2, pa3); SBAR();
    if (SDEPTH == 1 || j + 3 < NT) SLOAD(SE, (j + 1 + SDEPTH) * KVBLK); SBAR();
    pv_d0(o, vb0 + (int)SHM_V, pa0, pa1, pa2, pa3); partialSM(pA0, pA1, m_reg, mnA, alA);
    __syncthreads(); SWAIT(); SWRITE(1, SO);
    RESC(alA); __syncthreads();
  }
  SBAR(); qkt(pB0, pB1, (bf16*)((char*)K_lds + SHM_K), qr, r32, hi);
  finishSM(pA0, pA1, alA, l_reg, pa0, pa1, pa2, pa3); SBAR();
  pv_d0(o, vb0, pa0, pa1, pa2, pa3); partialSM(pB0, pB1, m_reg, mnB, alB);
  __syncthreads(); RESC(alB);
  finishSM(pB0, pB1, alB, l_reg, pa0, pa1, pa2, pa3); SBAR();
  pv_d0(o, vb0 + (int)SHM_V, pa0, pa1, pa2, pa3);
  if (hi == 0) li_l[r32] = l_reg; asm volatile("s_waitcnt lgkmcnt(0)" ::: "memory");
  float rli[16];
#pragma unroll
  for (int r = 0; r < 16; ++r) rli[r] = __builtin_amdgcn_rcpf(li_l[crow(r, hi)]);
  bf16* Ow = Ob + (long)(wid * QBLK) * LDO;
#pragma unroll
  for (int r = 0; r < 16; ++r) { int orow = crow(r, hi);
    for (int d0 = 0; d0 < 4; ++d0) Ow[(long)orow * LDO + d0 * 32 + r32] = __float2bfloat16(o[d0][r] * rli[r]); }
#undef SLOAD
#undef SWRITE
#undef SWAIT
#undef RESC
}

}
#define LAS __attribute__((address_space(3)))
typedef unsigned short bf16_t;
typedef short bf16x8 __attribute__((ext_vector_type(8)));
typedef short s16x4 __attribute__((ext_vector_type(4)));
typedef float f32x4 __attribute__((ext_vector_type(4)));
typedef float f32x16 __attribute__((ext_vector_type(16)));
typedef unsigned u32x4 __attribute__((ext_vector_type(4)));
typedef unsigned u32x2 __attribute__((ext_vector_type(2)));
using pg8::cvtpk_s; using pg8::bf_lo; using pg8::bf_hi; using pg8::silu_f;

constexpr int DM = 1024, SEQ = 16384, CTXL = 256, NLAT = 2 * SEQ, MROWS = NLAT + 2 * CTXL, DFF = 4096;
constexpr float EPS = 1e-6f;
constexpr size_t MiB = 1u << 20;
constexpr size_t WS_BAR = 512 * 1024, WS_BAR_BYTES = 16384;
constexpr size_t WS_MOD = 0, WS_CTX = 1 * MiB, WS_WT = 4 * MiB, WS_H = 41 * MiB, WS_AB = 106 * MiB, WS_RSTD = 115 * MiB, WS_P = 118 * MiB, WS_O = 378 * MiB, WS_END = 508 * MiB;
constexpr size_t WT_A = WS_WT, WT_Z = WS_WT + 9 * MiB, WT_O = WS_WT + 13 * MiB, WT_1 = WS_WT + 17 * MiB, WT_2 = WS_WT + 25 * MiB;
constexpr size_t WS_QM = 313 * MiB, WS_KM = 378 * MiB, WS_OGLA = 443 * MiB, WS_AQ = 41 * MiB, WS_EL = 74 * MiB;
constexpr size_t WS_SEND = 77 * MiB, WS_DSUM = 93 * MiB;
constexpr size_t WS_TP = 4 * MiB, WS_HALO = 378 * MiB;
constexpr size_t WS_QR = 216 * MiB, WS_KR = 281 * MiB, WS_VR = 298 * MiB;
constexpr int SKV = SEQ + CTXL;
constexpr int LDS_BYTES = 155648;
enum { OP_MOD, OP_PREP, OP_GEMM_IN, OP_DNSCAN, OP_DNREDO, OP_GEMM_Z, OP_GEMM_OUT, OP_NORM2, OP_FFN1, OP_FFN2, OP_GLAPREP, OP_GLASCAN, OP_GLAGATE, OP_QKROPE, OP_ATTN, OP_DNHALO, OP_DNCONV, OP_DNT, OP_GLASTATE };

struct Args { const float* in[25]; float* out; unsigned char* ws; int ph_lo, ph_hi; };

__device__ __forceinline__ float wave_sum(float v) {
#pragma unroll
    for (int o = 1; o < 64; o <<= 1) v += __shfl_xor(v, o);
    return v;
}
__device__ __forceinline__ float softplus_f(float x) { return x > 20.f ? x : log1pf(__expf(x)); }
__device__ __forceinline__ float logsigmoid_f(float x) { return fminf(x, 0.f) - log1pf(__expf(-fabsf(x))); }
__device__ __forceinline__ bf16_t f2bf(float f) { return (bf16_t)(cvtpk_s(f, 0.f) & 0xffffu); }
__device__ __forceinline__ float bf2f(bf16_t v) { return __builtin_bit_cast(float, (unsigned)v << 16); }

__device__ __forceinline__ void transpose_item(const float* W, int ldw, int c0, int ncols, int K, bf16_t* WT, int row_off, LAS float* scr, int item, int lane) {
    const int nblk = ncols / 32, kb = item / nblk, nb = item % nblk, k0 = 64 * kb, n0 = 32 * nb;
    {
        const int kr = lane >> 3, n4 = 4 * (lane & 7); f32x4 v[8];
#pragma unroll
        for (int i = 0; i < 8; ++i) v[i] = *(const f32x4*)(W + (size_t)(k0 + kr + 8 * i) * ldw + c0 + n0 + n4);
#pragma unroll
        for (int i = 0; i < 8; ++i) { LAS float* d = scr + (kr + 8 * i) * 33 + n4; d[0] = v[i][0]; d[1] = v[i][1]; d[2] = v[i][2]; d[3] = v[i][3]; }
    }
    asm volatile("s_waitcnt lgkmcnt(0)" ::: "memory");
    const int c = lane & 7;
#pragma unroll
    for (int j = 0; j < 4; ++j) { const int n = (lane >> 3) + 8 * j; const LAS float* s = scr + (8 * c) * 33 + n;
        u32x4 o; o.x = cvtpk_s(s[0 * 33], s[1 * 33]); o.y = cvtpk_s(s[2 * 33], s[3 * 33]); o.z = cvtpk_s(s[4 * 33], s[5 * 33]); o.w = cvtpk_s(s[6 * 33], s[7 * 33]);
        *(u32x4*)(WT + (size_t)(row_off + n0 + n) * K + k0 + 8 * c) = o; }
    asm volatile("s_waitcnt lgkmcnt(0)" ::: "memory");
}
__device__ __forceinline__ void transpose_mat(const float* W, int ldw, int c0, int ncols, int K, bf16_t* WT, int row_off, LAS float* scr, int gw, int NGW, int lane) {
    const int nitems = (K / 64) * (ncols / 32);
    for (int it = gw; it < nitems; it += NGW) transpose_item(W, ldw, c0, ncols, K, WT, row_off, scr, it, lane);
}
__device__ __forceinline__ void normmod_rows(const float* xl, const float* xc, const float* g, const float* modl, int sidx, bf16_t* H, int gw, int NGW, int lane,
                                             const float* part = nullptr, const float* pgate = nullptr, float* ctx_dst = nullptr) {
    for (int row0 = gw; row0 < MROWS; row0 += 2 * NGW) {
        const int row1 = row0 + NGW; const bool has1 = row1 < MROWS; const int rows[2] = {row0, has1 ? row1 : row0};
        f32x4 v[2][4]; float ss[2] = {0.f, 0.f};
#pragma unroll
        for (int q = 0; q < 2; ++q) { const int row = rows[q]; const float* xr = row < NLAT ? xl + (size_t)row * DM : xc + (size_t)(row - NLAT) * DM;
#pragma unroll
            for (int j = 0; j < 4; ++j) v[q][j] = *(const f32x4*)(xr + 4 * lane + 256 * j);
            if (part && row >= NLAT) {
#pragma unroll
                for (int j = 0; j < 4; ++j) { const int c = 4 * lane + 256 * j; const size_t po = (size_t)(row - NLAT) * 1024 + c;
                    const f32x4 ps = (*(const f32x4*)(part + po) + *(const f32x4*)(part + po + (size_t)512 * 1024)) + (*(const f32x4*)(part + po + (size_t)2 * 512 * 1024) + *(const f32x4*)(part + po + (size_t)3 * 512 * 1024));
                    v[q][j] = v[q][j] + *(const f32x4*)(pgate + c) * ps;
                    if (!(q == 1 && !has1)) *(f32x4*)(ctx_dst + (size_t)(row - NLAT) * 1024 + c) = v[q][j]; }
            } }
#pragma unroll
        for (int q = 0; q < 2; ++q)
#pragma unroll
            for (int j = 0; j < 4; ++j) ss[q] += (v[q][j][0] * v[q][j][0] + v[q][j][1] * v[q][j][1]) + (v[q][j][2] * v[q][j][2] + v[q][j][3] * v[q][j][3]);
#pragma unroll
        for (int q = 0; q < 2; ++q) {
            if (q == 1 && !has1) break;
            const int row = rows[q]; const int mi = row < SEQ ? 0 : (row < NLAT ? 1 : 2);
            const float* sh = modl + (size_t)mi * 6144 + (size_t)sidx * 1024; const float* sc = sh + 1024;
            const float rinv = rsqrtf(wave_sum(ss[q]) * (1.f / DM) + EPS);
#pragma unroll
            for (int j = 0; j < 4; ++j) { const int c = 4 * lane + 256 * j; const f32x4 gg = *(const f32x4*)(g + c), s1 = *(const f32x4*)(sc + c), s0 = *(const f32x4*)(sh + c);
                f32x4 y;
#pragma unroll
                for (int e = 0; e < 4; ++e) y[e] = v[q][j][e] * rinv * gg[e] * (1.f + s1[e]) + s0[e];
                u32x2 w; w.x = cvtpk_s(y[0], y[1]); w.y = cvtpk_s(y[2], y[3]); *(u32x2*)(H + (size_t)row * DM + c) = w; }
        }
    }
}
#define BAR_LDS() do { asm volatile("s_waitcnt lgkmcnt(0)" ::: "memory"); __builtin_amdgcn_s_barrier(); asm volatile("" ::: "memory"); } while (0)
__device__ __forceinline__ int crow(int x, int h) { return (x & 3) + 8 * (x >> 2) + 4 * h; }
#define MFMA32(a, b, c) __builtin_amdgcn_mfma_f32_32x32x16_bf16((a), (b), (c), 0, 0, 0)
__device__ __forceinline__ bf16x8 frag_nat(const LAS bf16_t* img, int LD, int row, int ks, int h) { return *(const LAS bf16x8*)(img + row * LD + 16 * ks + 8 * h); }
__device__ __forceinline__ bf16x8 frag_perm(const LAS bf16_t* img, int LD, int row, int ks, int h) {
    const s16x4 lo = *(const LAS s16x4*)(img + row * LD + 16 * ks + 4 * h), hi = *(const LAS s16x4*)(img + row * LD + 16 * ks + 8 + 4 * h);
    return __builtin_shufflevector(lo, hi, 0, 1, 2, 3, 4, 5, 6, 7);
}
__device__ __forceinline__ s16x4 tr4(const LAS bf16_t* p) { return __builtin_bit_cast(s16x4, __builtin_amdgcn_ds_read_tr16_b64_v4i16((LAS s16x4*)p)); }
__device__ __forceinline__ bf16x8 frag_tr(const LAS bf16_t* img, int LD, int m0, int ks, int lane) {
    const int i16 = lane & 15, q = i16 >> 2, p = i16 & 3, blk = (lane >> 4) & 1, h = lane >> 5;
    const LAS bf16_t* a = img + (16 * ks + 4 * h + q) * LD + m0 + 16 * blk + 4 * p;
    const s16x4 lo = tr4(a), hi = tr4(a + 8 * LD);
    return __builtin_shufflevector(lo, hi, 0, 1, 2, 3, 4, 5, 6, 7);
}
__device__ __forceinline__ bf16x8 pack_step(const f32x16& x, int s) {
    u32x4 p; p.x = cvtpk_s(x[8 * s + 0], x[8 * s + 1]); p.y = cvtpk_s(x[8 * s + 2], x[8 * s + 3]); p.z = cvtpk_s(x[8 * s + 4], x[8 * s + 5]); p.w = cvtpk_s(x[8 * s + 6], x[8 * s + 7]);
    return __builtin_bit_cast(bf16x8, p);
}
__device__ __forceinline__ void dn_halo_phase(const bf16_t* P, bf16_t* HALO, int G) {
    const int tid = opaque_tid();
    for (size_t e = (size_t)blockIdx.x * 512 + tid; e < (size_t)520 * 4 * 512; e += (size_t)G * 512) {
        const int c = (int)(e & 511), j = (int)((e >> 9) & 3), rb = (int)(e >> 11);
        const int row = rb * 64 + (j < 2 ? j : 60 + j);
        ((u32x4*)(HALO + ((size_t)rb * 4 + j) * 4096))[c] = ((const u32x4*)(P + (size_t)row * 4096))[c];
    }
}
__device__ __forceinline__ void unpack8(const u32x4 v, float (&f)[8]) { f[0] = bf_lo(v.x); f[1] = bf_hi(v.x); f[2] = bf_lo(v.y); f[3] = bf_hi(v.y); f[4] = bf_lo(v.z); f[5] = bf_hi(v.z); f[6] = bf_lo(v.w); f[7] = bf_hi(v.w); }
__device__ __forceinline__ void dn_conv_phase(bf16_t* P, const bf16_t* HALO, const float* conv_w, int G) {
    const int tid = opaque_tid(), col0 = 8 * tid;
    float cw[8][5];
#pragma unroll
    for (int c = 0; c < 8; ++c)
#pragma unroll
        for (int tap = 0; tap < 5; ++tap) cw[c][tap] = conv_w[(size_t)(col0 + c) * 5 + tap];
    const int kind = col0 < 1024 ? 0 : (col0 < 2048 ? 1 : 2);
    for (int rb = blockIdx.x; rb < 520; rb += G) {
        const int cs = rb < 512 ? (rb & 255) : ((rb - 512) & 3); const bool sfirst = cs == 0, slast = rb < 512 ? cs == 255 : cs == 3;
        const u32x4 zero = (u32x4){0u, 0u, 0u, 0u};
        bf16_t* base = P + (size_t)rb * 64 * 4096 + col0;
        u32x4 w0 = sfirst ? zero : *(const u32x4*)(HALO + ((size_t)(rb - 1) * 4 + 2) * 4096 + col0);
        u32x4 w1 = sfirst ? zero : *(const u32x4*)(HALO + ((size_t)(rb - 1) * 4 + 3) * 4096 + col0);
        u32x4 w2 = *(const u32x4*)(base), w3 = *(const u32x4*)(base + 4096);
#pragma unroll 4
        for (int rr = 0; rr < 64; ++rr) {
            u32x4 w4;
            if (rr + 2 < 64) w4 = *(const u32x4*)(base + (size_t)(rr + 2) * 4096);
            else w4 = slast ? zero : *(const u32x4*)(HALO + ((size_t)(rb + 1) * 4 + (rr + 2 - 64)) * 4096 + col0);
            float x0[8], x1[8], x2[8], x3[8], x4[8], y[8];
            unpack8(w0, x0); unpack8(w1, x1); unpack8(w2, x2); unpack8(w3, x3); unpack8(w4, x4);
            float ss = 0.f;
#pragma unroll
            for (int c = 0; c < 8; ++c) { const float a = x0[c] * cw[c][0] + x1[c] * cw[c][1] + x2[c] * cw[c][2] + x3[c] * cw[c][3] + x4[c] * cw[c][4]; y[c] = silu_f(a); ss += y[c] * y[c]; }
            float sc = 1.f;
            if (kind < 2) { ss += __shfl_xor(ss, 1); ss += __shfl_xor(ss, 2); ss += __shfl_xor(ss, 4); ss += __shfl_xor(ss, 8); sc = rsqrtf(ss + EPS) * (kind == 0 ? 0.08838834764831845f : 1.f); }
            u32x4 o; o.x = cvtpk_s(y[0] * sc, y[1] * sc); o.y = cvtpk_s(y[2] * sc, y[3] * sc); o.z = cvtpk_s(y[4] * sc, y[5] * sc); o.w = cvtpk_s(y[6] * sc, y[7] * sc);
            *(u32x4*)(base + (size_t)rr * 4096) = o;
            w0 = w1; w1 = w2; w2 = w3; w3 = w4;
        }
    }
}
constexpr int DT_KB = 0, DT_R = 17408, DT_SC = 33792, DT_DIR = 34816;
template <int W> __device__ __forceinline__ void dn_solve(const LAS float* Mf, float (&t)[16], int lane) {
    const int j = 16 * W + (lane >> 2), q = lane & 3;
#pragma unroll
    for (int s = 0; s < 16; ++s) t[s] = 0.f;
#pragma unroll
    for (int i = 16 * W; i < 64; ++i) {
        float acc = 0.f;
#pragma unroll
        for (int s = 4 * W; s <= (i - 1) / 4 && i > 16 * W; ++s) acc += Mf[i * 64 + 4 * s + q] * t[s];
        acc += __shfl_xor(acc, 1); acc += __shfl_xor(acc, 2);
        const float val = (i == j ? 1.f : 0.f) - acc;
        if (q == (i & 3)) t[i >> 2] = val;
        asm volatile("" : "+v"(t[0]), "+v"(t[1]), "+v"(t[2]), "+v"(t[3]), "+v"(t[4]), "+v"(t[5]), "+v"(t[6]), "+v"(t[7]), "+v"(t[8]), "+v"(t[9]), "+v"(t[10]), "+v"(t[11]), "+v"(t[12]), "+v"(t[13]), "+v"(t[14]), "+v"(t[15]));
    }
}
__device__ __forceinline__ void dn_t_phase(LAS unsigned char* lds, const bf16_t* P, float* AB, bf16_t* TP, const float* a_log, const float* dt_bias, int G) {
    const int tid0 = opaque_tid(), hb = __builtin_amdgcn_readfirstlane(tid0 >> 8);
    u32x4 pk4[4]; float pav = 0.f, pbv = 0.f;
    {
        const int it = blockIdx.x * 2 + hb;
        if (it < 16640) { const int dir = it & 1, vh = (it >> 1) & 15, rb = it >> 5, kh = vh >> 1, t = tid0 & 255, r0 = t >> 4, c8 = 8 * (t & 15);
#pragma unroll
            for (int v = 0; v < 4; ++v) pk4[v] = *(const u32x4*)(P + (size_t)(rb * 64 + r0 + 16 * v) * 4096 + 1024 + kh * 128 + c8);
            const int ti = dir ? 63 - (t & 63) : (t & 63); const float* ab = AB + (size_t)(rb * 64 + ti) * 64; pav = ab[dir * 16 + vh]; pbv = ab[32 + dir * 16 + vh]; }
    }
    for (int itb = blockIdx.x * 2; itb < 16640; itb += 2 * G) {
        const int it = itb + hb, dir = it & 1, vh = (it >> 1) & 15, rb = it >> 5, kh = vh >> 1;
        const int tq = opaque_tid(), t = tq & 255, w = __builtin_amdgcn_readfirstlane((tq >> 6) & 3), lane = tq & 63, r = lane & 31, h = lane >> 5;
        LAS unsigned char* base = lds + hb * DT_DIR;
        LAS bf16_t* Kb = (LAS bf16_t*)(base + DT_KB); LAS float* Mf = (LAS float*)(base + DT_R); LAS bf16_t* Tb = (LAS bf16_t*)(base + DT_R);
        LAS float* sc_beta = (LAS float*)(base + DT_SC); LAS float* sc_gc = sc_beta + 64;
        {
            const int r0 = t >> 4, c8 = 8 * (t & 15);
#pragma unroll
            for (int v = 0; v < 4; ++v) { const int i = r0 + 16 * v, ip = dir ? 63 - i : i;
                *(LAS u32x4*)(Kb + ip * 136 + c8) = pk4[v]; }
            if (t < 64) {
                const int ti = dir ? 63 - t : t; float* ab = AB + (size_t)(rb * 64 + ti) * 64;
                const float av = pav, bv = pbv;
                const float g = -__expf(a_log[dir * 16 + vh]) * softplus_f(av + dt_bias[dir * 16 + vh]), beta = 1.f / (1.f + __expf(-bv));
                float gc = g;
#pragma unroll
                for (int o = 1; o < 64; o <<= 1) { const float up = __shfl_up(gc, o); if (t >= o) gc += up; }
                sc_beta[t] = beta; sc_gc[t] = gc;
                ab[dir * 16 + vh] = gc; ab[32 + dir * 16 + vh] = beta;
            }
        }
        BAR_LDS();
        {
            const int itn = it + 2 * G;
            if (itn < 16640) { const int dirn = itn & 1, vhn = (itn >> 1) & 15, rbn = itn >> 5, khn = vhn >> 1, r0 = t >> 4, c8 = 8 * (t & 15);
#pragma unroll
                for (int v = 0; v < 4; ++v) pk4[v] = *(const u32x4*)(P + (size_t)(rbn * 64 + r0 + 16 * v) * 4096 + 1024 + khn * 128 + c8);
                const int tin = dirn ? 63 - (t & 63) : (t & 63); const float* abn = AB + (size_t)(rbn * 64 + tin) * 64; pav = abn[dirn * 16 + vhn]; pbv = abn[32 + dirn * 16 + vhn]; }
        }
        const int ti = w >> 1, tj = w & 1;
        {
            f32x16 acc;
#pragma unroll
            for (int x = 0; x < 16; ++x) acc[x] = 0.f;
            if (!(ti == 0 && tj == 1)) {
#pragma unroll
                for (int ks = 0; ks < 8; ++ks) acc = MFMA32(frag_nat(Kb, 136, 32 * ti + r, ks, h), frag_nat(Kb, 136, 32 * tj + r, ks, h), acc);
            }
            const int j = 32 * tj + r; const float gj = sc_gc[j];
#pragma unroll
            for (int x = 0; x < 16; ++x) { const int i = 32 * ti + crow(x, h);
                Mf[i * 64 + j] = (i > j) ? sc_beta[i] * acc[x] * __expf(sc_gc[i] - gj) : 0.f; }
        }
        BAR_LDS();
        float tc[16];
        if (w == 0) dn_solve<0>(Mf, tc, lane); else if (w == 1) dn_solve<1>(Mf, tc, lane); else if (w == 2) dn_solve<2>(Mf, tc, lane); else dn_solve<3>(Mf, tc, lane);
        BAR_LDS();
        {
            const int j = 16 * w + (lane >> 2), q = lane & 3;
#pragma unroll
            for (int s = 0; s < 16; ++s) Tb[(4 * s + q) * 72 + j] = f2bf(tc[s]);
        }
        BAR_LDS();
        {
            bf16_t* dst = TP + (size_t)it * 3072;
#pragma unroll
            for (int k2 = 0; k2 < 2; ++k2) { const int c = t + 256 * k2;
                if (c < 384) { const int blk = c >> 7, rowc = (c & 127) >> 2, cc = c & 3, br = blk ? 1 : 0, bc = blk == 2 ? 1 : 0;
                    *(u32x4*)(dst + c * 8) = *(const LAS u32x4*)(Tb + (32 * br + rowc) * 72 + 32 * bc + 8 * cc); } }
        }
        BAR_LDS();
    }
}
constexpr int DN_KB = 0, DN_QB = 17408, DN_VB = 34816, DN_TB = 51200, DN_AB = 60416, DN_SC = 69632, DN_DIR = 71168;
__device__ __forceinline__ void dn_step_rb(int step, int dir, int b, int& rb, bool& first) {
    if (step < 4) { const int cidx = dir ? 3 - step : step; rb = 512 + b * 4 + cidx; first = step < 2; }
    else { const int c = step - 4; const int cidx = dir ? 255 - c : c; rb = b * 256 + cidx; first = c < 128; }
}
struct DnPre { u32x4 k4[4], q4[4], v4[4], t0, t1; float gc, beta; };
__device__ __forceinline__ void dn_prefetch(DnPre& p, const bf16_t* P, const float* AB, const bf16_t* TP, int rb, int dir, int vh, int kh, int t, int part) {
    const int r0 = t >> 4, c8 = 8 * (t & 15);
    const bf16_t* prow = P + (size_t)(rb * 64 + r0) * 4096 + c8;
    const bf16_t* tp = TP + (size_t)((rb * 16 + vh) * 2 + dir) * 3072;
    if (part & 1) {
#pragma unroll
        for (int v = 0; v < 4; ++v) { const bf16_t* pr = prow + (size_t)(16 * v) * 4096;
            p.k4[v] = *(const u32x4*)(pr + 1024 + kh * 128); p.q4[v] = *(const u32x4*)(pr + kh * 128); p.v4[v] = *(const u32x4*)(pr + 2048 + vh * 128); }
    }
    if (part & 2) {
        p.t0 = *(const u32x4*)(tp + t * 8); p.t1 = *(const u32x4*)(tp + (256 + (t & 127)) * 8);
        const int ti = dir ? 63 - (t & 63) : (t & 63); const float* ab = AB + (size_t)(rb * 64 + ti) * 64; p.gc = ab[dir * 16 + vh]; p.beta = ab[32 + dir * 16 + vh];
    }
}
template <int VAR> __device__ __forceinline__ void dn_scan(LAS unsigned char* lds, const bf16_t* P, const float* AB, const bf16_t* TP, bf16_t* OB) {
    const int tid = opaque_tid(), dir = __builtin_amdgcn_readfirstlane(tid >> 8);
    for (int unit = blockIdx.x; unit < 32; unit += gridDim.x) {
        const int b = unit >> 4, vh = unit & 15, kh = vh >> 1;
        f32x16 S[4];
#pragma unroll
        for (int kt = 0; kt < 4; ++kt)
#pragma unroll
            for (int x = 0; x < 16; ++x) S[kt][x] = 0.f;
        DnPre pre;
        { int rb0; bool f0; dn_step_rb(0, dir, b, rb0, f0); dn_prefetch(pre, P, AB, TP, rb0, dir, vh, kh, tid & 255, 3); }
        __syncthreads();
        for (int step = 0; step < 260; ++step) {
            const int w = __builtin_amdgcn_readfirstlane((opaque_tid() >> 6) & 3);
            LAS unsigned char* base = lds + dir * DN_DIR;
            LAS bf16_t* Kb = (LAS bf16_t*)(base + DN_KB); LAS bf16_t* Qb = (LAS bf16_t*)(base + DN_QB); LAS bf16_t* Vb = (LAS bf16_t*)(base + DN_VB);
            LAS bf16_t* Tb = (LAS bf16_t*)(base + DN_TB); LAS bf16_t* Ab = (LAS bf16_t*)(base + DN_AB);
            LAS float* sc_beta = (LAS float*)(base + DN_SC); LAS float* sc_gc = sc_beta + 64; LAS float* sc_eg = sc_beta + 128; LAS float* sc_tail = sc_beta + 192; LAS float* sc_dl = sc_beta + 256;
            int rb; bool first; dn_step_rb(step, dir, b, rb, first);
            const int row_base = rb * 64;
            {
                const int tq_ = opaque_tid(), t = tq_ & 255;
                const int r0 = t >> 4, c8 = 8 * (t & 15);
#pragma unroll
                for (int v = 0; v < 4; ++v) { const int i = r0 + 16 * v, ip = dir ? 63 - i : i;
                    *(LAS u32x4*)(Kb + ip * 136 + c8) = pre.k4[v]; *(LAS u32x4*)(Qb + ip * 136 + c8) = pre.q4[v]; *(LAS u32x4*)(Vb + ip * 128 + c8) = pre.v4[v]; }
                { const int c = t, blk = c >> 7, rowc = (c & 127) >> 2, cc = c & 3, br = blk ? 1 : 0; *(LAS u32x4*)(Tb + (32 * br + rowc) * 72 + 8 * cc) = pre.t0; }
                if (t < 128) { const int rowc = t >> 2, cc = t & 3; *(LAS u32x4*)(Tb + (32 + rowc) * 72 + 32 + 8 * cc) = pre.t1; }
                if (t < 64) { const float gc = pre.gc, gl = __shfl(gc, 63); sc_beta[t] = pre.beta; sc_gc[t] = gc; sc_eg[t] = __expf(gc); sc_tail[t] = __expf(gl - gc); if (t == 0) sc_dl[0] = __expf(gl); }
            }
            BAR_LDS();
            {
                const int tq_ = opaque_tid(), lane = tq_ & 63, r = lane & 31, h = lane >> 5;
                const int ti = w >> 1, tj = w & 1;
                if (!(ti == 0 && tj == 1)) {
                    f32x16 qk;
#pragma unroll
                    for (int x = 0; x < 16; ++x) qk[x] = 0.f;
#pragma unroll
                    for (int ks = 0; ks < 8; ++ks) qk = MFMA32(frag_nat(Qb, 136, 32 * ti + r, ks, h), frag_nat(Kb, 136, 32 * tj + r, ks, h), qk);
                    const int jj = 32 * tj + r; const float gj = sc_gc[jj];
#pragma unroll
                    for (int x = 0; x < 16; ++x) { const int i = 32 * ti + crow(x, h);
                        Ab[i * 72 + jj] = f2bf((i >= jj) ? qk[x] * __expf(sc_gc[i] - gj) : 0.f); }
                }
            }
            BAR_LDS();
            if (VAR != 2 && step + 1 < 260) { int rbn; bool fn; dn_step_rb(step + 1, dir, b, rbn, fn); dn_prefetch(pre, P, AB, TP, rbn, dir, vh, kh, opaque_tid() & 255, 1); }
            __builtin_amdgcn_sched_barrier(0);
            if (VAR != 1) {
                const int tq_ = opaque_tid(), lane = tq_ & 63, r = lane & 31, h = lane >> 5;
                f32x16 KS[2], QS[2];
#pragma unroll
                for (int mt = 0; mt < 2; ++mt)
#pragma unroll
                    for (int x = 0; x < 16; ++x) { KS[mt][x] = 0.f; QS[mt][x] = 0.f; }
#pragma unroll
                for (int ks = 0; ks < 8; ++ks) {
                    const bf16x8 sp = pack_step(S[ks >> 1], ks & 1);
#pragma unroll
                    for (int mt = 0; mt < 2; ++mt) { KS[mt] = MFMA32(frag_perm(Kb, 136, 32 * mt + r, ks, h), sp, KS[mt]); QS[mt] = MFMA32(frag_perm(Qb, 136, 32 * mt + r, ks, h), sp, QS[mt]); }
                    if (ks & 1) __builtin_amdgcn_sched_barrier(0);
                }
#pragma unroll
                for (int mt = 0; mt < 2; ++mt)
#pragma unroll
                    for (int x = 0; x < 16; ++x) { const int i = 32 * mt + crow(x, h);
                        KS[mt][x] = sc_beta[i] * (bf2f(Vb[i * 128 + 32 * w + r]) - sc_eg[i] * KS[mt][x]); }
                __builtin_amdgcn_sched_barrier(0);
                bf16x8 Xp[4];
#pragma unroll
                for (int ks = 0; ks < 4; ++ks) Xp[ks] = pack_step(KS[ks >> 1], ks & 1);
                f32x16 VN[2];
#pragma unroll
                for (int mt = 0; mt < 2; ++mt) {
#pragma unroll
                    for (int x = 0; x < 16; ++x) VN[mt][x] = 0.f;
#pragma unroll
                    for (int ks = 0; ks < 4; ++ks) if (ks < 2 * mt + 2) VN[mt] = MFMA32(frag_perm(Tb, 72, 32 * mt + r, ks, h), Xp[ks], VN[mt]);
                }
                __builtin_amdgcn_sched_barrier(0);
                if (VAR != 2 && step + 1 < 260) { int rbn; bool fn; dn_step_rb(step + 1, dir, b, rbn, fn); dn_prefetch(pre, P, AB, TP, rbn, dir, vh, kh, opaque_tid() & 255, 2); }
                __builtin_amdgcn_sched_barrier(0);
                bf16x8 VNp[4];
#pragma unroll
                for (int ks = 0; ks < 4; ++ks) VNp[ks] = pack_step(VN[ks >> 1], ks & 1);
#pragma unroll
                for (int mt = 0; mt < 2; ++mt) {
#pragma unroll
                    for (int x = 0; x < 16; ++x) QS[mt][x] *= sc_eg[32 * mt + crow(x, h)];
#pragma unroll
                    for (int ks = 0; ks < 4; ++ks) if (ks < 2 * mt + 2) QS[mt] = MFMA32(frag_perm(Ab, 72, 32 * mt + r, ks, h), VNp[ks], QS[mt]);
                }
                __builtin_amdgcn_sched_barrier(0);
#pragma unroll
                for (int mt = 0; mt < 2; ++mt)
#pragma unroll
                    for (int x = 0; x < 16; ++x) Vb[(32 * mt + crow(x, h)) * 128 + 32 * w + r] = f2bf(QS[mt][x]);
                __builtin_amdgcn_sched_barrier(0);
#pragma unroll
                for (int mt = 0; mt < 2; ++mt)
#pragma unroll
                    for (int x = 0; x < 16; ++x) VN[mt][x] *= sc_tail[32 * mt + crow(x, h)];
#pragma unroll
                for (int ks = 0; ks < 4; ++ks) VNp[ks] = pack_step(VN[ks >> 1], ks & 1);
                __builtin_amdgcn_sched_barrier(0);
                const float dl = sc_dl[0];
#pragma unroll
                for (int kt = 0; kt < 4; ++kt)
#pragma unroll
                    for (int x = 0; x < 16; ++x) S[kt][x] *= dl;
#pragma unroll
                for (int ks = 0; ks < 4; ++ks) {
#pragma unroll
                    for (int kt = 0; kt < 4; ++kt) S[kt] = MFMA32(frag_tr(Kb, 136, 32 * kt, ks, lane), VNp[ks], S[kt]);
                    __builtin_amdgcn_sched_barrier(0);
                }
                if (VAR != 2) {
                    const int rr_ = lane >> 2, c8_ = 8 * (lane & 3);
#pragma unroll
                    for (int v = 0; v < 4; ++v) { const int ip_ = rr_ + 16 * v, i_ = dir ? 63 - ip_ : ip_;
                        u32x4* gp_ = (u32x4*)(OB + (size_t)(row_base + i_) * 2048 + vh * 128 + 32 * w + c8_);
                        u32x4 o = *(const LAS u32x4*)(Vb + ip_ * 128 + 32 * w + c8_);
                        if (!first) { const u32x4 e = gp_[0];
                            o.x = cvtpk_s(bf_lo(o.x) + bf_lo(e.x), bf_hi(o.x) + bf_hi(e.x)); o.y = cvtpk_s(bf_lo(o.y) + bf_lo(e.y), bf_hi(o.y) + bf_hi(e.y));
                            o.z = cvtpk_s(bf_lo(o.z) + bf_lo(e.z), bf_hi(o.z) + bf_hi(e.z)); o.w = cvtpk_s(bf_lo(o.w) + bf_lo(e.w), bf_hi(o.w) + bf_hi(e.w)); }
                        gp_[0] = o; }
                }
            }
            if (step == 1 || step == 131) asm volatile("s_waitcnt vmcnt(0)" ::: "memory");
            BAR_LDS();
        }
    }
}
constexpr int GP_QM = 0, GP_KM = 17408, GP_AB = 34816, GP_LOW = 44032, GP_TOT = 48128, GP_DIR = 49152;
__device__ __forceinline__ void gla_prep_phase(LAS unsigned char* lds, const bf16_t* P, const float* LOW, const float* gw2, const float* gb2, bf16_t* QM, bf16_t* KM, bf16_t* AQ, float* EL, int G) {
    const int tid0 = opaque_tid(), hb = __builtin_amdgcn_readfirstlane(tid0 >> 8);
    for (int itb = blockIdx.x * 2; itb < 4160; itb += 2 * G) {
        const int it = itb + hb, dir = it & 1, head = (it >> 1) & 3, rb = it >> 3;
        const int tq = opaque_tid(), t = tq & 255, w = __builtin_amdgcn_readfirstlane((tq >> 6) & 3), lane = tq & 63, r = lane & 31, h = lane >> 5;
        LAS unsigned char* base = lds + hb * GP_DIR;
        LAS bf16_t* Qm = (LAS bf16_t*)(base + GP_QM); LAS bf16_t* Km = (LAS bf16_t*)(base + GP_KM); LAS bf16_t* Ab = (LAS bf16_t*)(base + GP_AB);
        LAS float* lowS = (LAS float*)(base + GP_LOW); LAS float* tot = (LAS float*)(base + GP_TOT);
        *(LAS f32x4*)(lowS + 4 * t) = *(const f32x4*)(LOW + (size_t)(rb * 64 + (t >> 2)) * 32 + dir * 16 + 4 * (t & 3));
        const int dk = t & 127, half = t >> 7, col = head * 128 + dk;
        float w2c[16];
#pragma unroll
        for (int rr = 0; rr < 16; ++rr) w2c[rr] = gw2[(size_t)(dir * 16 + rr) * 512 + col];
        const float b2 = gb2[dir * 512 + col];
        __syncthreads();
        float bc[32]; float run = 0.f;
#pragma unroll
        for (int n = 0; n < 32; ++n) { const int ip = 32 * half + n, i = dir ? 63 - ip : ip; float s = b2;
#pragma unroll
            for (int rr = 0; rr < 16; ++rr) s += lowS[i * 16 + rr] * w2c[rr];
            run += logsigmoid_f(s) * (1.f / 16.f); bc[n] = run; }
        tot[half * 128 + dk] = run;
        __syncthreads();
        const float t0 = tot[dk], last = t0 + tot[128 + dk], off = half ? t0 : 0.f;
        if (half == 0) EL[(size_t)(dir * 520 + rb) * 512 + col] = last;
        {
            const int i0 = dir ? 63 - 32 * half : 32 * half; const long pstep = dir ? -3072 : 3072;
            const bf16_t* pp = P + (size_t)(rb * 64 + i0) * 3072 + col;
#pragma unroll
            for (int n = 0; n < 32; ++n) { const int ip = 32 * half + n; const float bcv = bc[n] + off;
                const float qv = bf2f(pp[0]), kv = bf2f(pp[512]); pp += pstep;
                Qm[ip * 136 + dk] = f2bf(qv * 0.08838834764831845f * __expf(bcv - last));
                Km[ip * 136 + dk] = f2bf(kv * __expf(last - bcv)); }
        }
        __syncthreads();
        {
            const int ti = w >> 1, tj = w & 1;
            f32x16 acc;
#pragma unroll
            for (int x = 0; x < 16; ++x) acc[x] = 0.f;
            if (!(ti == 0 && tj == 1)) {
#pragma unroll
                for (int ks = 0; ks < 8; ++ks) acc = MFMA32(frag_nat(Qm, 136, 32 * ti + r, ks, h), frag_nat(Km, 136, 32 * tj + r, ks, h), acc);
            }
            const int j = 32 * tj + r;
#pragma unroll
            for (int x = 0; x < 16; ++x) { const int i = 32 * ti + crow(x, h); Ab[i * 72 + j] = f2bf(i >= j ? acc[x] : 0.f); }
            const int r0 = t >> 4, c8 = 8 * (t & 15);
#pragma unroll
            for (int v = 0; v < 4; ++v) { const int row = r0 + 16 * v; const size_t go = ((size_t)dir * MROWS + rb * 64 + row) * 512 + head * 128 + c8;
                *(u32x4*)(QM + go) = *(const LAS u32x4*)(Qm + row * 136 + c8); *(u32x4*)(KM + go) = *(const LAS u32x4*)(Km + row * 136 + c8); }
        }
        __syncthreads();
        {
            bf16_t* dst = AQ + (size_t)it * 4096;
#pragma unroll
            for (int k2 = 0; k2 < 2; ++k2) { const int c = t + 256 * k2, row = c >> 3, cc = c & 7; *(u32x4*)(dst + c * 8) = *(const LAS u32x4*)(Ab + row * 72 + 8 * cc); }
        }
        __syncthreads();
    }
}
constexpr int GL_QM = 0, GL_KM = 17408, GL_VB = 34816, GL_AB = 52224, GL_EL = 61440, GL_DIR = 61952;
struct GlPre { u32x4 q4[4], k4[4], v4[4], a0, a1; float elv; };
__device__ __forceinline__ void gl_prefetch(GlPre& p, const bf16_t* P, const bf16_t* QM, const bf16_t* KM, const bf16_t* AQ, const float* EL, int rb, int dir, int head, int hf, int t) {
    const int r0 = t >> 4, c8 = 8 * (t & 15);
    const bf16_t* aq = AQ + (size_t)((rb * 4 + head) * 2 + dir) * 4096;
#pragma unroll
    for (int v = 0; v < 4; ++v) { const size_t row = (size_t)(rb * 64 + r0 + 16 * v);
        p.q4[v] = *(const u32x4*)(QM + ((size_t)dir * MROWS + row) * 512 + head * 128 + c8);
        p.k4[v] = *(const u32x4*)(KM + ((size_t)dir * MROWS + row) * 512 + head * 128 + c8);
        p.v4[v] = *(const u32x4*)(P + row * 3072 + 1024 + head * 256 + hf * 128 + c8); }
    p.a0 = *(const u32x4*)(aq + t * 8); p.a1 = *(const u32x4*)(aq + (256 + t) * 8);
    p.elv = EL[(size_t)(dir * 520 + rb) * 512 + head * 128 + (t & 127)];
}
__device__ __forceinline__ void gla_scan(LAS unsigned char* lds, const bf16_t* P  , const bf16_t* QM, const bf16_t* KM, const bf16_t* AQ, const float* EL, bf16_t* OB  ) {
    const int tid = opaque_tid(), dir = __builtin_amdgcn_readfirstlane(tid >> 8);
    for (int unit = blockIdx.x; unit < 16; unit += gridDim.x) {
        const int b = unit >> 3, head = (unit >> 1) & 3, hf = unit & 1;
        f32x16 S[4];
#pragma unroll
        for (int kt = 0; kt < 4; ++kt)
#pragma unroll
            for (int x = 0; x < 16; ++x) S[kt][x] = 0.f;
        GlPre pre;
        { int rb0; bool f0; dn_step_rb(0, dir, b, rb0, f0); gl_prefetch(pre, P, QM, KM, AQ, EL, rb0, dir, head, hf, tid & 255); }
        __syncthreads();
        for (int step = 0; step < 260; ++step) {
            const int w = __builtin_amdgcn_readfirstlane((opaque_tid() >> 6) & 3);
            LAS unsigned char* base = lds + dir * GL_DIR;
            LAS bf16_t* Qm = (LAS bf16_t*)(base + GL_QM); LAS bf16_t* Km = (LAS bf16_t*)(base + GL_KM); LAS bf16_t* Vb = (LAS bf16_t*)(base + GL_VB); LAS bf16_t* Ab = (LAS bf16_t*)(base + GL_AB);
            LAS float* el = (LAS float*)(base + GL_EL);
            int rb; bool first; dn_step_rb(step, dir, b, rb, first);
            const int row_base = rb * 64;
            {
                const int tq_ = opaque_tid(), t = tq_ & 255;
                const int r0 = t >> 4, c8 = 8 * (t & 15);
#pragma unroll
                for (int v = 0; v < 4; ++v) { const int i = r0 + 16 * v, ip = dir ? 63 - i : i;
                    *(LAS u32x4*)(Qm + i * 136 + c8) = pre.q4[v]; *(LAS u32x4*)(Km + i * 136 + c8) = pre.k4[v]; *(LAS u32x4*)(Vb + ip * 136 + c8) = pre.v4[v]; }
                { const int c = t, row = c >> 3, cc = c & 7; *(LAS u32x4*)(Ab + row * 72 + 8 * cc) = pre.a0; }
                { const int c = 256 + t, row = c >> 3, cc = c & 7; *(LAS u32x4*)(Ab + row * 72 + 8 * cc) = pre.a1; }
                if (t < 128) el[t] = __expf(pre.elv);
            }
            BAR_LDS();
            if (step + 1 < 260) { int rbn; bool fn; dn_step_rb(step + 1, dir, b, rbn, fn); gl_prefetch(pre, P, QM, KM, AQ, EL, rbn, dir, head, hf, opaque_tid() & 255); }
            __builtin_amdgcn_sched_barrier(0);
            {
                const int tq_ = opaque_tid(), lane = tq_ & 63, r = lane & 31, h = lane >> 5;
#pragma unroll
                for (int kt = 0; kt < 4; ++kt)
#pragma unroll
                    for (int x = 0; x < 16; ++x) S[kt][x] *= el[32 * kt + crow(x, h)];
                bf16x8 Vf[4];
#pragma unroll
                for (int ks = 0; ks < 4; ++ks) Vf[ks] = frag_tr(Vb, 136, 32 * w, ks, lane);
                u32x4 eo[4];
                {
                    const int rr_ = lane >> 2, c8_ = 8 * (lane & 3);
                    if (!first) {
#pragma unroll
                        for (int v = 0; v < 4; ++v) { const int ip_ = rr_ + 16 * v, i_ = dir ? 63 - ip_ : ip_;
                            eo[v] = *(const u32x4*)(OB + (size_t)(row_base + i_) * 1024 + head * 256 + hf * 128 + 32 * w + c8_); }
                    } else {
                        unsigned z0 = 0u; asm volatile("" : "+v"(z0));
#pragma unroll
                        for (int v = 0; v < 4; ++v) eo[v] = (u32x4){z0, z0, z0, z0};
                    }
                }
                f32x16 O[2];
#pragma unroll
                for (int mt = 0; mt < 2; ++mt) {
#pragma unroll
                    for (int x = 0; x < 16; ++x) O[mt][x] = 0.f;
#pragma unroll
                    for (int ks = 0; ks < 4; ++ks) if (ks < 2 * mt + 2) O[mt] = MFMA32(frag_perm(Ab, 72, 32 * mt + r, ks, h), Vf[ks], O[mt]);
                }
                __builtin_amdgcn_sched_barrier(0);
#pragma unroll
                for (int ks = 0; ks < 8; ++ks) {
                    const bf16x8 sp = pack_step(S[ks >> 1], ks & 1);
#pragma unroll
                    for (int mt = 0; mt < 2; ++mt) O[mt] = MFMA32(frag_perm(Qm, 136, 32 * mt + r, ks, h), sp, O[mt]);
                    if (ks & 1) __builtin_amdgcn_sched_barrier(0);
                }
#pragma unroll
                for (int mt = 0; mt < 2; ++mt)
#pragma unroll
                    for (int x = 0; x < 16; ++x) Vb[(32 * mt + crow(x, h)) * 136 + 32 * w + r] = f2bf(O[mt][x]);
                __builtin_amdgcn_sched_barrier(0);
#pragma unroll
                for (int ks = 0; ks < 4; ++ks) {
#pragma unroll
                    for (int kt = 0; kt < 4; ++kt) S[kt] = MFMA32(frag_tr(Km, 136, 32 * kt, ks, lane), Vf[ks], S[kt]);
                    __builtin_amdgcn_sched_barrier(0);
                }
                {
                    const int rr_ = lane >> 2, c8_ = 8 * (lane & 3);
#pragma unroll
                    for (int v = 0; v < 4; ++v) { const int ip_ = rr_ + 16 * v, i_ = dir ? 63 - ip_ : ip_;
                        u32x4* gp_ = (u32x4*)(OB + (size_t)(row_base + i_) * 1024 + head * 256 + hf * 128 + 32 * w + c8_);
                        u32x4 o = *(const LAS u32x4*)(Vb + ip_ * 136 + 32 * w + c8_); const u32x4 e = eo[v];
                        if (!first) {
                            o.x = cvtpk_s(bf_lo(o.x) + bf_lo(e.x), bf_hi(o.x) + bf_hi(e.x)); o.y = cvtpk_s(bf_lo(o.y) + bf_lo(e.y), bf_hi(o.y) + bf_hi(e.y));
                            o.z = cvtpk_s(bf_lo(o.z) + bf_lo(e.z), bf_hi(o.z) + bf_hi(e.z)); o.w = cvtpk_s(bf_lo(o.w) + bf_lo(e.w), bf_hi(o.w) + bf_hi(e.w)); }
                        gp_[0] = o; }
                }
            }
            if (step == 1 || step == 131) asm volatile("s_waitcnt vmcnt(0)" ::: "memory");
            BAR_LDS();
        }
    }
}
typedef __bf16 v2bf_t __attribute__((ext_vector_type(2)));
__device__ __forceinline__ void atomic_add_bf16x8(bf16_t* p, const u32x4 v) {
    asm volatile("global_atomic_pk_add_bf16 %0, %1, off sc1\n\tglobal_atomic_pk_add_bf16 %0, %2, off offset:4 sc1\n\tglobal_atomic_pk_add_bf16 %0, %3, off offset:8 sc1\n\tglobal_atomic_pk_add_bf16 %0, %4, off offset:12 sc1"
                 :: "v"(p), "v"(v.x), "v"(v.y), "v"(v.z), "v"(v.w) : "memory");
}
constexpr int DN3_HGC = 2 * DN_DIR;
template <int VAR> __device__ __forceinline__ void dn_scan3(LAS unsigned char* lds, const bf16_t* P, const float* AB, const bf16_t* TP, bf16_t* OB) {
    const int tid0 = opaque_tid(), wv = __builtin_amdgcn_readfirstlane(tid0 >> 6), role = wv >> 2, w = wv & 3;
    for (int unit = blockIdx.x; unit < 64; unit += gridDim.x) {
        const int b = unit >> 5, vh = (unit >> 1) & 15, dir = unit & 1, kh = vh >> 1;
        __syncthreads();
        if (role == 1) {
            if (w < 3) {
                const int qh = w >= 1 ? 1 : 0, khh = w == 2 ? 1 : 0, ti = qh, tj = khh;
                u32x4 q8[8], k8[8]; float gcp;
                {
                    int rb; bool f_; dn_step_rb(0, dir, b, rb, f_);
                    const int lane = opaque_tid() & 63, r0 = lane >> 4, c8 = 8 * (lane & 15);
#pragma unroll
                    for (int v = 0; v < 8; ++v) { const int ipq = 32 * qh + r0 + 4 * v, ipk = 32 * khh + r0 + 4 * v, iq = dir ? 63 - ipq : ipq, ik = dir ? 63 - ipk : ipk;
                        q8[v] = *(const u32x4*)(P + (size_t)(rb * 64 + iq) * 4096 + kh * 128 + c8); k8[v] = *(const u32x4*)(P + (size_t)(rb * 64 + ik) * 4096 + 1024 + kh * 128 + c8); }
                    const int tl = dir ? 63 - lane : lane; gcp = AB[(size_t)(rb * 64 + tl) * 64 + dir * 16 + vh];
                }
                for (int j = 0; j < 260; ++j) {
                    const int lane = opaque_tid() & 63, r = lane & 31, h = lane >> 5, r0 = lane >> 4, c8 = 8 * (lane & 15);
                    LAS unsigned char* base = lds + (j & 1) * DN_DIR;
                    LAS bf16_t* Kb = (LAS bf16_t*)(base + DN_KB); LAS bf16_t* Qb = (LAS bf16_t*)(base + DN_QB); LAS bf16_t* Ab = (LAS bf16_t*)(base + DN_AB);
                    LAS float* hgc = (LAS float*)(lds + DN3_HGC + w * 256);
#pragma unroll
                    for (int v = 0; v < 8; ++v) { *(LAS u32x4*)(Qb + (32 * qh + r0 + 4 * v) * 136 + c8) = q8[v]; *(LAS u32x4*)(Kb + (32 * khh + r0 + 4 * v) * 136 + c8) = k8[v]; }
                    hgc[lane] = gcp;
                    asm volatile("s_waitcnt lgkmcnt(0)" ::: "memory");
                    if (j + 1 < 260) {
                        int rb; bool f_; dn_step_rb(j + 1, dir, b, rb, f_);
#pragma unroll
                        for (int v = 0; v < 8; ++v) { const int ipq = 32 * qh + r0 + 4 * v, ipk = 32 * khh + r0 + 4 * v, iq = dir ? 63 - ipq : ipq, ik = dir ? 63 - ipk : ipk;
                            q8[v] = *(const u32x4*)(P + (size_t)(rb * 64 + iq) * 4096 + kh * 128 + c8); k8[v] = *(const u32x4*)(P + (size_t)(rb * 64 + ik) * 4096 + 1024 + kh * 128 + c8); }
                        const int tl = dir ? 63 - lane : lane; gcp = AB[(size_t)(rb * 64 + tl) * 64 + dir * 16 + vh];
                    }
                    __builtin_amdgcn_sched_barrier(0);
                    {
                        f32x16 qk;
#pragma unroll
                        for (int x = 0; x < 16; ++x) qk[x] = 0.f;
#pragma unroll
                        for (int ks = 0; ks < 8; ++ks) qk = MFMA32(frag_nat(Qb, 136, 32 * ti + r, ks, h), frag_nat(Kb, 136, 32 * tj + r, ks, h), qk);
                        const int jj = 32 * tj + r; const float gj = hgc[jj];
#pragma unroll
                        for (int x = 0; x < 16; ++x) { const int i = 32 * ti + crow(x, h);
                            Ab[i * 72 + jj] = f2bf((i >= jj) ? qk[x] * __expf(hgc[i] - gj) : 0.f); }
                    }
                    BAR_LDS();
                }
                BAR_LDS();
            } else {
                u32x4 v16[16], t6[6]; float gcp, betap;
                {
                    int rb; bool f_; dn_step_rb(0, dir, b, rb, f_);
                    const int lane = opaque_tid() & 63, r0 = lane >> 4, c8 = 8 * (lane & 15);
#pragma unroll
                    for (int v = 0; v < 16; ++v) { const int ip = r0 + 4 * v, i = dir ? 63 - ip : ip; v16[v] = *(const u32x4*)(P + (size_t)(rb * 64 + i) * 4096 + 2048 + vh * 128 + c8); }
                    const bf16_t* tp = TP + (size_t)((rb * 16 + vh) * 2 + dir) * 3072;
#pragma unroll
                    for (int v = 0; v < 6; ++v) t6[v] = *(const u32x4*)(tp + (lane + 64 * v) * 8);
                    const int tl = dir ? 63 - lane : lane; const float* ab = AB + (size_t)(rb * 64 + tl) * 64; gcp = ab[dir * 16 + vh]; betap = ab[32 + dir * 16 + vh];
                }
                for (int j = 0; j < 260; ++j) {
                    const int lane = opaque_tid() & 63, r0 = lane >> 4, c8 = 8 * (lane & 15);
                    LAS unsigned char* base = lds + (j & 1) * DN_DIR;
                    LAS bf16_t* Vb = (LAS bf16_t*)(base + DN_VB); LAS bf16_t* Tb = (LAS bf16_t*)(base + DN_TB);
                    LAS float* sc_beta = (LAS float*)(base + DN_SC); LAS float* sc_gc = sc_beta + 64; LAS float* sc_eg = sc_beta + 128; LAS float* sc_tail = sc_beta + 192; LAS float* sc_dl = sc_beta + 256;
                    if (j >= 2) {
                        int rbo; bool fo_; dn_step_rb(j - 2, dir, b, rbo, fo_);
#pragma unroll
                        for (int v = 0; v < 16; ++v) { const int ip_ = r0 + 4 * v, i_ = dir ? 63 - ip_ : ip_;
                            atomic_add_bf16x8(OB + (size_t)(rbo * 64 + i_) * 2048 + vh * 128 + c8, *(const LAS u32x4*)(Vb + ip_ * 128 + c8)); }
                        asm volatile("s_waitcnt lgkmcnt(0)" ::: "memory");
                    }
#pragma unroll
                    for (int v = 0; v < 16; ++v) *(LAS u32x4*)(Vb + (r0 + 4 * v) * 128 + c8) = v16[v];
#pragma unroll
                    for (int v = 0; v < 6; ++v) { const int c = lane + 64 * v, blk = c >> 7, rowc = (c & 127) >> 2, cc = c & 3, br = blk ? 1 : 0, bc = blk == 2 ? 1 : 0;
                        *(LAS u32x4*)(Tb + (32 * br + rowc) * 72 + 32 * bc + 8 * cc) = t6[v]; }
                    { const float gc = gcp, gl = __shfl(gc, 63); sc_beta[lane] = betap; sc_gc[lane] = gc; sc_eg[lane] = __expf(gc); sc_tail[lane] = __expf(gl - gc); if (lane == 0) sc_dl[0] = __expf(gl); }
                    if (j + 1 < 260) {
                        int rb; bool f_; dn_step_rb(j + 1, dir, b, rb, f_);
#pragma unroll
                        for (int v = 0; v < 16; ++v) { const int ip = r0 + 4 * v, i = dir ? 63 - ip : ip; v16[v] = *(const u32x4*)(P + (size_t)(rb * 64 + i) * 4096 + 2048 + vh * 128 + c8); }
                        const bf16_t* tp = TP + (size_t)((rb * 16 + vh) * 2 + dir) * 3072;
#pragma unroll
                        for (int v = 0; v < 6; ++v) t6[v] = *(const u32x4*)(tp + (lane + 64 * v) * 8);
                        const int tl = dir ? 63 - lane : lane; const float* ab = AB + (size_t)(rb * 64 + tl) * 64; gcp = ab[dir * 16 + vh]; betap = ab[32 + dir * 16 + vh];
                    }
                    BAR_LDS();
                }
                {
                    const int lane = opaque_tid() & 63, r0 = lane >> 4, c8 = 8 * (lane & 15);
#pragma unroll 1
                    for (int jj = 258; jj < 260; ++jj) {
                        if (jj == 259) BAR_LDS();
                        LAS bf16_t* Vb = (LAS bf16_t*)(lds + (jj & 1) * DN_DIR + DN_VB);
                        int rbo; bool fo_; dn_step_rb(jj, dir, b, rbo, fo_);
#pragma unroll
                        for (int v = 0; v < 16; ++v) { const int ip_ = r0 + 4 * v, i_ = dir ? 63 - ip_ : ip_;
                            atomic_add_bf16x8(OB + (size_t)(rbo * 64 + i_) * 2048 + vh * 128 + c8, *(const LAS u32x4*)(Vb + ip_ * 128 + c8)); }
                    }
                }
            }
        } else {
            f32x16 S[4];
#pragma unroll
            for (int kt = 0; kt < 4; ++kt)
#pragma unroll
                for (int x = 0; x < 16; ++x) S[kt][x] = 0.f;
            BAR_LDS();
            for (int step = 0; step < 260; ++step) {
                const int lane = opaque_tid() & 63, r = lane & 31, h = lane >> 5;
                LAS unsigned char* base = lds + (step & 1) * DN_DIR;
                LAS bf16_t* Kb = (LAS bf16_t*)(base + DN_KB); LAS bf16_t* Qb = (LAS bf16_t*)(base + DN_QB); LAS bf16_t* Vb = (LAS bf16_t*)(base + DN_VB);
                LAS bf16_t* Tb = (LAS bf16_t*)(base + DN_TB); LAS bf16_t* Ab = (LAS bf16_t*)(base + DN_AB);
                LAS float* sc_beta = (LAS float*)(base + DN_SC); LAS float* sc_eg = sc_beta + 128; LAS float* sc_tail = sc_beta + 192; LAS float* sc_dl = sc_beta + 256;
                int rb; bool f_; dn_step_rb(step, dir, b, rb, f_);
                if (VAR != 2) {
                f32x16 KS[2], QS[2];
#pragma unroll
                for (int mt = 0; mt < 2; ++mt)
#pragma unroll
                    for (int x = 0; x < 16; ++x) { KS[mt][x] = 0.f; QS[mt][x] = 0.f; }
#pragma unroll
                for (int ks = 0; ks < 8; ++ks) {
                    const bf16x8 sp = pack_step(S[ks >> 1], ks & 1);
#pragma unroll
                    for (int mt = 0; mt < 2; ++mt) { KS[mt] = MFMA32(frag_perm(Kb, 136, 32 * mt + r, ks, h), sp, KS[mt]); QS[mt] = MFMA32(frag_perm(Qb, 136, 32 * mt + r, ks, h), sp, QS[mt]); }
                }
#pragma unroll
                for (int mt = 0; mt < 2; ++mt)
#pragma unroll
                    for (int g4 = 0; g4 < 4; ++g4) { const int i0 = 32 * mt + 8 * g4 + 4 * h;
                        const f32x4 bv = *(const LAS f32x4*)(sc_beta + i0), ev = *(const LAS f32x4*)(sc_eg + i0);
#pragma unroll
                        for (int e = 0; e < 4; ++e) { const int x = 4 * g4 + e; KS[mt][x] = bv[e] * (bf2f(Vb[(i0 + e) * 128 + 32 * w + r]) - ev[e] * KS[mt][x]); } }
                bf16x8 Xp[4];
#pragma unroll
                for (int ks = 0; ks < 4; ++ks) Xp[ks] = pack_step(KS[ks >> 1], ks & 1);
                f32x16 VN[2];
#pragma unroll
                for (int mt = 0; mt < 2; ++mt) {
#pragma unroll
                    for (int x = 0; x < 16; ++x) VN[mt][x] = 0.f;
#pragma unroll
                    for (int ks = 0; ks < 4; ++ks) if (ks < 2 * mt + 2) VN[mt] = MFMA32(frag_perm(Tb, 72, 32 * mt + r, ks, h), Xp[ks], VN[mt]);
                }
                bf16x8 VNp[4];
#pragma unroll
                for (int ks = 0; ks < 4; ++ks) VNp[ks] = pack_step(VN[ks >> 1], ks & 1);
#pragma unroll
                for (int mt = 0; mt < 2; ++mt) {
#pragma unroll
                    for (int g4 = 0; g4 < 4; ++g4) { const f32x4 ev = *(const LAS f32x4*)(sc_eg + 32 * mt + 8 * g4 + 4 * h);
#pragma unroll
                        for (int e = 0; e < 4; ++e) QS[mt][4 * g4 + e] *= ev[e]; }
#pragma unroll
                    for (int ks = 0; ks < 4; ++ks) if (ks < 2 * mt + 2) QS[mt] = MFMA32(frag_perm(Ab, 72, 32 * mt + r, ks, h), VNp[ks], QS[mt]);
                }
#pragma unroll
                for (int mt = 0; mt < 2; ++mt)
#pragma unroll
                    for (int x = 0; x < 16; ++x) Vb[(32 * mt + crow(x, h)) * 128 + 32 * w + r] = f2bf(QS[mt][x]);
#pragma unroll
                for (int mt = 0; mt < 2; ++mt)
#pragma unroll
                    for (int g4 = 0; g4 < 4; ++g4) { const f32x4 tv = *(const LAS f32x4*)(sc_tail + 32 * mt + 8 * g4 + 4 * h);
#pragma unroll
                        for (int e = 0; e < 4; ++e) VN[mt][4 * g4 + e] *= tv[e]; }
#pragma unroll
                for (int ks = 0; ks < 4; ++ks) VNp[ks] = pack_step(VN[ks >> 1], ks & 1);
                const float dl = sc_dl[0];
#pragma unroll
                for (int kt = 0; kt < 4; ++kt)
#pragma unroll
                    for (int x = 0; x < 16; ++x) S[kt][x] *= dl;
#pragma unroll
                for (int ks = 0; ks < 4; ++ks) {
#pragma unroll
                    for (int kt = 0; kt < 4; ++kt) S[kt] = MFMA32(frag_tr(Kb, 136, 32 * kt, ks, lane), VNp[ks], S[kt]);
                }
                }
                BAR_LDS();
            }
        }
    }
}
constexpr int GLA_NG = 8, GLA_SG = 33;
template <int PASS>
__device__ __forceinline__ void gla_scan3(LAS unsigned char* lds, bf16_t* P  , const bf16_t* QM, const bf16_t* KM, const bf16_t* AQ, const float* EL, bf16_t* OB  , float* SEND, float* DSUM) {
    const int tid0 = opaque_tid(), wv = __builtin_amdgcn_readfirstlane(tid0 >> 6), role = wv >> 2, w = wv & 3;
    for (int unit = blockIdx.x; unit < 32 * GLA_NG; unit += gridDim.x) {
        const int g = unit & (GLA_NG - 1), bu = unit >> 3;
        const int b = bu >> 4, head = (bu >> 2) & 3, hf = (bu >> 1) & 1, dir = bu & 1;
        if (PASS == 0 && g == GLA_NG - 1) continue;
        const int lo = GLA_SG * g, hi = (lo + GLA_SG < 260) ? lo + GLA_SG : 260;
        const int seq = (b * 4 + head) * 2 + dir;
        __syncthreads();
        if (role == 1) {
            GlPre pre; float dsum = 0.f;
            { int rb0; bool f0; dn_step_rb(lo, dir, b, rb0, f0); gl_prefetch(pre, P, QM, KM, AQ, EL, rb0, dir, head, hf, opaque_tid() & 255); }
            for (int j = lo; j < hi; ++j) {
                const int t = opaque_tid() & 255;
                LAS unsigned char* base = lds + ((j - lo) & 1) * GL_DIR;
                LAS bf16_t* Qm = (LAS bf16_t*)(base + GL_QM); LAS bf16_t* Km = (LAS bf16_t*)(base + GL_KM); LAS bf16_t* Vb = (LAS bf16_t*)(base + GL_VB); LAS bf16_t* Ab = (LAS bf16_t*)(base + GL_AB);
                LAS float* el = (LAS float*)(base + GL_EL);
                const int r0 = t >> 4, c8 = 8 * (t & 15);
#pragma unroll
                for (int v = 0; v < 4; ++v) { const int i = r0 + 16 * v, ip = dir ? 63 - i : i;
                    *(LAS u32x4*)(Qm + i * 136 + c8) = pre.q4[v]; *(LAS u32x4*)(Km + i * 136 + c8) = pre.k4[v]; *(LAS u32x4*)(Vb + ip * 136 + c8) = pre.v4[v]; }
                { const int c = t, row = c >> 3, cc = c & 7; *(LAS u32x4*)(Ab + row * 72 + 8 * cc) = pre.a0; }
                { const int c = 256 + t, row = c >> 3, cc = c & 7; *(LAS u32x4*)(Ab + row * 72 + 8 * cc) = pre.a1; }
                if (t < 128) el[t] = __expf(pre.elv);
                dsum += pre.elv;
                if (j + 1 < hi) { int rbn; bool fn; dn_step_rb(j + 1, dir, b, rbn, fn); gl_prefetch(pre, P, QM, KM, AQ, EL, rbn, dir, head, hf, t); }
                BAR_LDS();
            }
            if (PASS == 0 && hf == 0) { const int t = opaque_tid() & 255; if (t < 128) DSUM[(size_t)(seq * GLA_NG + g) * 128 + t] = dsum; }
            BAR_LDS();
        } else {
            f32x16 S[4];
#pragma unroll
            for (int kt = 0; kt < 4; ++kt)
#pragma unroll
                for (int x = 0; x < 16; ++x) S[kt][x] = 0.f;
            if (PASS == 1) {
                const int lane = opaque_tid() & 63, r = lane & 31, h = lane >> 5;
                for (int gp = 0; gp < g; ++gp) {
                    const float* se = SEND + (size_t)(seq * GLA_NG + gp) * 128 * 256 + hf * 128 + 32 * w + r; const float* ds = DSUM + (size_t)(seq * GLA_NG + gp) * 128;
#pragma unroll
                    for (int kt = 0; kt < 4; ++kt)
#pragma unroll
                        for (int x = 0; x < 16; ++x) { const int dk = 32 * kt + crow(x, h); S[kt][x] = __expf(ds[dk]) * S[kt][x] + se[(size_t)dk * 256]; }
                }
            }
            BAR_LDS();
            for (int step = lo; step < hi; ++step) {
                const int lane = opaque_tid() & 63, r = lane & 31, h = lane >> 5;
                LAS unsigned char* base = lds + ((step - lo) & 1) * GL_DIR;
                LAS bf16_t* Qm = (LAS bf16_t*)(base + GL_QM); LAS bf16_t* Km = (LAS bf16_t*)(base + GL_KM); LAS bf16_t* Vb = (LAS bf16_t*)(base + GL_VB); LAS bf16_t* Ab = (LAS bf16_t*)(base + GL_AB);
                LAS float* el = (LAS float*)(base + GL_EL);
                int rb; bool f_; dn_step_rb(step, dir, b, rb, f_);
#pragma unroll
                for (int kt = 0; kt < 4; ++kt)
#pragma unroll
                    for (int g4 = 0; g4 < 4; ++g4) { const f32x4 ev = *(const LAS f32x4*)(el + 32 * kt + 8 * g4 + 4 * h);
#pragma unroll
                        for (int e = 0; e < 4; ++e) S[kt][4 * g4 + e] *= ev[e]; }
                bf16x8 Vf[4];
#pragma unroll
                for (int ks = 0; ks < 4; ++ks) Vf[ks] = frag_tr(Vb, 136, 32 * w, ks, lane);
                if (PASS == 1) {
                    f32x16 O[2];
#pragma unroll
                    for (int mt = 0; mt < 2; ++mt) {
#pragma unroll
                        for (int x = 0; x < 16; ++x) O[mt][x] = 0.f;
#pragma unroll
                        for (int ks = 0; ks < 4; ++ks) if (ks < 2 * mt + 2) O[mt] = MFMA32(frag_perm(Ab, 72, 32 * mt + r, ks, h), Vf[ks], O[mt]);
                    }
#pragma unroll
                    for (int ks = 0; ks < 8; ++ks) {
                        const bf16x8 sp = pack_step(S[ks >> 1], ks & 1);
#pragma unroll
                        for (int mt = 0; mt < 2; ++mt) O[mt] = MFMA32(frag_perm(Qm, 136, 32 * mt + r, ks, h), sp, O[mt]);
                    }
#pragma unroll
                    for (int mt = 0; mt < 2; ++mt)
#pragma unroll
                        for (int x = 0; x < 16; ++x) Vb[(32 * mt + crow(x, h)) * 136 + 32 * w + r] = f2bf(O[mt][x]);
                }
#pragma unroll
                for (int ks = 0; ks < 4; ++ks) {
#pragma unroll
                    for (int kt = 0; kt < 4; ++kt) S[kt] = MFMA32(frag_tr(Km, 136, 32 * kt, ks, lane), Vf[ks], S[kt]);
                }
                if (PASS == 1) {
                    asm volatile("s_waitcnt lgkmcnt(0)" ::: "memory");
                    const int rr_ = lane >> 2, c8_ = 8 * (lane & 3);
#pragma unroll
                    for (int v = 0; v < 4; ++v) { const int ip_ = rr_ + 16 * v, i_ = dir ? 63 - ip_ : ip_; const int oc_ = head * 256 + hf * 128 + 32 * w + c8_;
                        bf16_t* dst_ = dir ? P + (size_t)(rb * 64 + i_) * 3072 + oc_ : OB + (size_t)(rb * 64 + i_) * 1024 + oc_;
                        *(u32x4*)dst_ = *(const LAS u32x4*)(Vb + ip_ * 136 + 32 * w + c8_); }
                }
                BAR_LDS();
            }
            if (PASS == 0) {
                const int lane = opaque_tid() & 63, r = lane & 31, h = lane >> 5;
                float* se = SEND + (size_t)(seq * GLA_NG + g) * 128 * 256 + hf * 128 + 32 * w + r;
#pragma unroll
                for (int kt = 0; kt < 4; ++kt)
#pragma unroll
                    for (int x = 0; x < 16; ++x) se[(size_t)(32 * kt + crow(x, h)) * 256] = S[kt][x];
            }
        }
    }
}
#define XB_TMO      128
#define XB_XCNT(j)  (256  + 64 * (j))
#define XB_XSUB(j)  (1280 + 64 * (j))
#define XB_XGEN(j)  (2304 + 64 * (j))
#define XB_TOP      3328
#define XB_TOPGEN   3392
#define XCD_BAR_WORDS 3456
#define XB_SPIN_CAP (1u << 23)

__device__ __forceinline__ unsigned xb_ld(unsigned* p)              { return __hip_atomic_load(p, __ATOMIC_RELAXED, __HIP_MEMORY_SCOPE_AGENT); }
__device__ __forceinline__ unsigned xb_add(unsigned* p, unsigned v) { return __hip_atomic_fetch_add(p, v, __ATOMIC_RELAXED, __HIP_MEMORY_SCOPE_AGENT); }
__device__ __forceinline__ unsigned xb_xcc_id() { return (unsigned)__builtin_amdgcn_s_getreg((3 << 11) | 20) & 0xFu; }
#define XB_SPIN(cond, bar) do { unsigned _sp = 0; while (cond) { __builtin_amdgcn_s_sleep(1); \
    if ((++_sp & 255u) == 0u) { if (xb_ld(&(bar)[XB_TMO])) break; if (_sp > XB_SPIN_CAP) { atomicAdd(&(bar)[XB_TMO], 1u); break; } } } } while (0)

struct XcdBarrier {
    unsigned* bar; unsigned x;
    volatile LAS unsigned* st;
};

__device__ __forceinline__ XcdBarrier xcd_barrier_post(unsigned* bar, volatile LAS unsigned* st) {
    XcdBarrier b; b.bar = bar; b.x = xb_xcc_id(); b.st = st;
    if (threadIdx.x == 0) (void)xb_add(&bar[XB_XCNT(b.x)], 1u);
    return b;
}
__device__ __forceinline__ void xcd_barrier_complete(unsigned* bar, unsigned x, unsigned& nloc, unsigned& nx) {
    const unsigned G = gridDim.x * gridDim.y * gridDim.z;
    unsigned sum, cnt, mine, sp = 0u;
    for (;;) {
        sum = 0u; cnt = 0u; mine = 0u;
#pragma unroll
        for (unsigned j = 0; j < 16; ++j) { const unsigned c = xb_ld(&bar[XB_XCNT(j)]); sum += c; cnt += (c > 0u) ? 1u : 0u; mine = (j == x) ? c : mine; }
        if (sum == G) break;
        __builtin_amdgcn_s_sleep(1);
        if ((++sp & 255u) == 0u) { if (xb_ld(&bar[XB_TMO])) break; if (sp > XB_SPIN_CAP) { atomicAdd(&bar[XB_TMO], 1u); break; } }
    }
    nloc = mine > 0u ? mine : 1u; nx = cnt > 0u ? cnt : 1u;
}

__device__ __forceinline__ void xcd_barrier(const XcdBarrier& b) {
    asm volatile("s_waitcnt vmcnt(0)" ::: "memory");
    __syncthreads();
    if (threadIdx.x == 0) {
        unsigned* bar = b.bar;
        __builtin_amdgcn_s_waitcnt(0);
        unsigned nloc = b.st[0], nx = b.st[1];
        if (nloc == 0u) { xcd_barrier_complete(bar, b.x, nloc, nx); b.st[0] = nloc; b.st[1] = nx; }
        const unsigned old = xb_add(&bar[XB_XSUB(b.x)], 1u);
        const unsigned gen = old / nloc;
        if (old + 1u == (gen + 1u) * nloc) {
            __builtin_amdgcn_fence(__ATOMIC_RELEASE, "agent");
            asm volatile("s_waitcnt vmcnt(0)" ::: "memory");
            const unsigned og = xb_add(&bar[XB_TOP], 1u);
            const unsigned tg = og / nx;
            if (og + 1u == (tg + 1u) * nx) xb_add(&bar[XB_TOPGEN], 1u);
            else XB_SPIN(xb_ld(&bar[XB_TOPGEN]) == tg, bar);
            __builtin_amdgcn_fence(__ATOMIC_ACQUIRE, "agent");
            xb_add(&bar[XB_XGEN(b.x)], 1u);
            asm volatile("s_waitcnt vmcnt(0)" ::: "memory");
        } else {
            XB_SPIN(xb_ld(&bar[XB_XGEN(b.x)]) == gen, bar);
            __builtin_amdgcn_fence(__ATOMIC_ACQUIRE, "agent");
            asm volatile("s_waitcnt vmcnt(0)" ::: "memory");
        }
    }
    __syncthreads();
}

#define DUP_DN 0
#define DN_VARIANT 0
#define DN_VAR_PARITY0 0
#define DUP_GLA 0
#define DUP_ATT 0
#define DUP_GIN 0
#define DUP_FFN1 0
constexpr unsigned long long pack_ops(const int* ops, int n) { unsigned long long v = 0; for (int i = 0; i < n; ++i) v |= (unsigned long long)ops[i] << (5 * i); return v; }
struct OpList { unsigned long long code; int n; };
constexpr OpList make_list(int mix) {
    int ops[16] = {}; int n = 0;
    ops[n++] = OP_PREP; ops[n++] = OP_GEMM_IN; if (DUP_GIN && mix != 0) ops[n++] = OP_GEMM_IN;
    if (mix == 0) { ops[n++] = OP_DNCONV; ops[n++] = OP_DNT; ops[n++] = OP_DNSCAN; if (DUP_DN) ops[n++] = OP_DNSCAN; ops[n++] = OP_DNREDO; ops[n++] = OP_GEMM_Z; }
    else if (mix == 1) { ops[n++] = OP_GLAPREP; ops[n++] = OP_GLASTATE; ops[n++] = OP_GLASCAN; ops[n++] = OP_GLAGATE; }
    else { ops[n++] = OP_QKROPE; ops[n++] = OP_ATTN; if (DUP_ATT) ops[n++] = OP_ATTN; }
    ops[n++] = OP_GEMM_OUT; ops[n++] = OP_NORM2; ops[n++] = OP_FFN1; if (DUP_FFN1 && mix != 0) ops[n++] = OP_FFN1; ops[n++] = OP_FFN2;
    return OpList{pack_ops(ops, n), n};
}
constexpr OpList L_DN = make_list(0), L_GL = make_list(1), L_AT = make_list(2);
constexpr int NPHASE = 1 + 2 * L_DN.n + L_GL.n + L_AT.n;
__device__ __forceinline__ void decode_phase(int ph, int& layer, int& op) {
    if (ph == 0) { layer = 0; op = OP_MOD; return; }
    int p = ph - 1;
    if (p < L_DN.n) { layer = 0; op = (int)((L_DN.code >> (5 * p)) & 31ull); return; } p -= L_DN.n;
    if (p < L_GL.n) { layer = 1; op = (int)((L_GL.code >> (5 * p)) & 31ull); return; } p -= L_GL.n;
    if (p < L_AT.n) { layer = 2; op = (int)((L_AT.code >> (5 * p)) & 31ull); return; } p -= L_AT.n;
    layer = 3; op = (int)((L_DN.code >> (5 * p)) & 31ull);
}

__global__ void __launch_bounds__(512, 2) mega(Args args) {
    extern __shared__ __attribute__((aligned(16))) unsigned char lds_raw[];
    LAS unsigned char* lds = (LAS unsigned char*)lds_raw;
    cg::grid_group grid = cg::this_grid();
    volatile LAS unsigned* xb_st = (volatile LAS unsigned*)(lds + LDS_BYTES - 64);
    if (threadIdx.x < 2) xb_st[threadIdx.x] = 0u;
    __syncthreads();
    const XcdBarrier xbar = xcd_barrier_post((unsigned*)(args.ws + WS_BAR), xb_st);
    const int G = gridDim.x, NGW = G * 8;
    unsigned char* ws = args.ws;
    const float* x_in = args.in[0]; const float* c_in = args.in[1]; const float* ctx_in = args.in[2]; const float* cctx_in = args.in[3];
    const float* ada_w = args.in[4]; const float* ada_b = args.in[5]; const float* norm_mix_g = args.in[6]; const float* norm_ffn_g = args.in[7];
    const float* ffn_w1 = args.in[8]; const float* ffn_w2 = args.in[9];
    float* MOD = (float*)(ws + WS_MOD); float* CTXC = (float*)(ws + WS_CTX); bf16_t* H = (bf16_t*)(ws + WS_H); float* ABF = (float*)(ws + WS_AB); float* RSTD = (float*)(ws + WS_RSTD);
    bf16_t* PB = (bf16_t*)(ws + WS_P); float* out = args.out;

    for (int ph = args.ph_lo; ph < args.ph_hi; ++ph) {
        int layer, op; decode_phase(ph, layer, op);
        const int mix = layer % 3, slot = layer / 3;
        const float* modl = MOD + (size_t)layer * 3 * 6144;
        const float* xl = layer == 0 ? x_in : out; const float* xc = layer == 0 ? ctx_in : CTXC;
        if (op == OP_MOD) {
            const int tid = opaque_tid(), lane = tid & 63, wave = __builtin_amdgcn_readfirstlane(tid >> 6); const int gw = blockIdx.x * 8 + wave; (void)lane; (void)gw; (void)tid;
            LAS float* sl = (LAS float*)lds; LAS float* red = sl + 3 * 1024;
            for (int e = tid; e < 3 * 1024; e += 512) { const float v = e < 2048 ? c_in[e] : cctx_in[e - 2048]; sl[e] = silu_f(v); }
            __syncthreads();
            for (int item = blockIdx.x; item < 4 * 96; item += G) {
                const int ly = item / 96, col = (item % 96) * 64 + lane;
                const float* wp = ada_w + ((size_t)ly * 1024 + 128 * wave) * 6144 + col;
                float a0 = 0.f, a1 = 0.f, a2 = 0.f;
#pragma unroll 8
                for (int k = 0; k < 128; ++k) { const float wv = wp[(size_t)k * 6144]; const int kk = 128 * wave + k; a0 += sl[kk] * wv; a1 += sl[1024 + kk] * wv; a2 += sl[2048 + kk] * wv; }
                red[(wave * 3 + 0) * 64 + lane] = a0; red[(wave * 3 + 1) * 64 + lane] = a1; red[(wave * 3 + 2) * 64 + lane] = a2;
                __syncthreads();
                if (tid < 192) { const int m = tid >> 6; float s = ada_b[(size_t)ly * 6144 + col];
#pragma unroll
                    for (int w2 = 0; w2 < 8; ++w2) s += red[(w2 * 3 + m) * 64 + lane];
                    MOD[((size_t)ly * 3 + m) * 6144 + col] = s; }
                __syncthreads();
            }
        } else if (op == OP_PREP) {
            const int tid = opaque_tid(), lane = tid & 63, wave = __builtin_amdgcn_readfirstlane(tid >> 6); const int gw = blockIdx.x * 8 + wave; (void)lane; (void)gw; (void)tid;
            LAS float* scr = (LAS float*)(lds + wave * 16384);
            unsigned z0 = 0u; asm volatile("" : "+v"(z0)); const u32x4 zv = (u32x4){z0, z0, z0, z0};
            bf16_t* wtA = (bf16_t*)(ws + WT_A); bf16_t* wtZ = (bf16_t*)(ws + WT_Z); bf16_t* wtO = (bf16_t*)(ws + WT_O); bf16_t* wt1 = (bf16_t*)(ws + WT_1); bf16_t* wt2 = (bf16_t*)(ws + WT_2);
            if (mix == 0) {
                const float* w_in = args.in[10] + (size_t)slot * 1024 * 6208; const float* w_out = args.in[15] + (size_t)slot * 2048 * 1024;
                transpose_mat(w_in, 6208, 0, 4096, 1024, wtA, 0, scr, gw, NGW, lane);
                transpose_mat(w_in, 6208, 6144, 64, 1024, wtA, 4096, scr, gw, NGW, lane);
                for (size_t e = (size_t)blockIdx.x * 512 + tid; e < (size_t)192 * 1024 * 2 / 16; e += (size_t)G * 512) ((u32x4*)(wtA + (size_t)4160 * 1024))[e] = zv;
            } else if (mix == 1) {
                const float* w_in = args.in[16]; const float* w_out = args.in[20];
                transpose_mat(w_in, 3104, 0, 3104, 1024, wtA, 0, scr, gw, NGW, lane);
                for (size_t e = (size_t)blockIdx.x * 512 + tid; e < (size_t)224 * 1024 * 2 / 16; e += (size_t)G * 512) ((u32x4*)(wtA + (size_t)3104 * 1024))[e] = zv;
                transpose_mat(w_out, 1024, 0, 1024, 1024, wtO, 0, scr, gw, NGW, lane);
            } else {
                const float* w_in = args.in[21]; const float* w_out = args.in[24];
                transpose_mat(w_in, 1536, 0, 1536, 1024, wtA, 0, scr, gw, NGW, lane);
                transpose_mat(w_out, 1024, 0, 1024, 1024, wtO, 0, scr, gw, NGW, lane);
            }
            if (mix != 0) {
                transpose_mat(ffn_w1 + (size_t)layer * 1024 * 4096, 4096, 0, 4096, 1024, wt1, 0, scr, gw, NGW, lane);
                transpose_mat(ffn_w2 + (size_t)layer * 4096 * 1024, 1024, 0, 1024, 4096, wt2, 0, scr, gw, NGW, lane);
            }
            if (layer >= 1) normmod_rows(xl, xc, norm_mix_g + (size_t)layer * 1024, modl, 0, H, gw, NGW, lane, ABF, MOD + ((size_t)(layer - 1) * 3 + 2) * 6144 + 5 * 1024, CTXC);
            else normmod_rows(xl, xc, norm_mix_g + (size_t)layer * 1024, modl, 0, H, gw, NGW, lane);
        } else if (op == OP_DNREDO) {
            const int tid = opaque_tid(), lane = tid & 63, wave = __builtin_amdgcn_readfirstlane(tid >> 6); const int gw = blockIdx.x * 8 + wave; (void)lane; (void)gw; (void)tid;
            LAS float* scr = (LAS float*)(lds + wave * 16384);
            const float* w_in = args.in[10] + (size_t)slot * 1024 * 6208; const float* w_out = args.in[15] + (size_t)slot * 2048 * 1024;
            transpose_mat(w_in, 6208, 4096, 2048, 1024, (bf16_t*)(ws + WT_Z), 0, scr, gw, NGW, lane);
            transpose_mat(w_out, 1024, 0, 1024, 2048, (bf16_t*)(ws + WT_O), 0, scr, gw, NGW, lane);
            transpose_mat(ffn_w1 + (size_t)layer * 1024 * 4096, 4096, 0, 4096, 1024, (bf16_t*)(ws + WT_1), 0, scr, gw, NGW, lane);
            transpose_mat(ffn_w2 + (size_t)layer * 4096 * 1024, 1024, 0, 1024, 4096, (bf16_t*)(ws + WT_2), 0, scr, gw, NGW, lane);
            normmod_rows(xl, xc, norm_mix_g + (size_t)layer * 1024, modl, 0, H, gw, NGW, lane);
            const bf16_t* OB = (const bf16_t*)(ws + WS_O);
            for (int row = gw; row < MROWS; row += NGW) {
                const u32x4* p = (const u32x4*)(OB + (size_t)row * 2048 + 32 * lane); float ss = 0.f;
#pragma unroll
                for (int v = 0; v < 4; ++v) { const u32x4 q = p[v]; const float a0 = bf_lo(q.x), a1 = bf_hi(q.x), a2 = bf_lo(q.y), a3 = bf_hi(q.y), a4 = bf_lo(q.z), a5 = bf_hi(q.z), a6 = bf_lo(q.w), a7 = bf_hi(q.w);
                    ss += (a0 * a0 + a1 * a1) + (a2 * a2 + a3 * a3) + (a4 * a4 + a5 * a5) + (a6 * a6 + a7 * a7); }
                ss += __shfl_xor(ss, 1); ss += __shfl_xor(ss, 2);
                if ((lane & 3) == 0) RSTD[(size_t)row * 16 + (lane >> 2)] = rsqrtf(ss * (1.f / 128.f) + EPS);
            }
        } else if (op == OP_DNHALO) {
            dn_halo_phase(PB, (bf16_t*)(ws + WS_HALO), G);
        } else if (op == OP_DNCONV) {
            dn_conv_phase(PB, (const bf16_t*)(ws + WS_HALO), args.in[11] + (size_t)slot * 4096 * 5, G);
        } else if (op == OP_DNT) {
            dn_t_phase(lds, PB, ABF, (bf16_t*)(ws + WS_TP), args.in[12] + (size_t)slot * 32, args.in[13] + (size_t)slot * 32, G);
            {
                unsigned z0 = 0u; asm volatile("" : "+v"(z0)); const u32x4 zv = (u32x4){z0, z0, z0, z0}; u32x4* zp = (u32x4*)(ws + WS_O);
                for (size_t e = (size_t)blockIdx.x * 512 + opaque_tid(); e < (size_t)MROWS * 2048 * 2 / 16; e += (size_t)G * 512) zp[e] = zv;
            }
        } else if (op == OP_NORM2) {
            const int tid = opaque_tid(), lane = tid & 63, wave = __builtin_amdgcn_readfirstlane(tid >> 6); const int gw = blockIdx.x * 8 + wave; (void)lane; (void)gw; (void)tid;
            if (layer < 3) normmod_rows(out, xc, norm_ffn_g + (size_t)layer * 1024, modl, 3, H, gw, NGW, lane, ABF, modl + (size_t)2 * 6144 + 2 * 1024, CTXC);
            else normmod_rows(out, CTXC, norm_ffn_g + (size_t)layer * 1024, modl, 3, H, gw, NGW, lane);
        } else if (op == OP_GEMM_IN || op == OP_GEMM_Z || op == OP_GEMM_OUT || op == OP_FFN1 || op == OP_FFN2) {
            pg8::Gemm g; pg8::Epi E;
            E.mode = 0; E.O = PB; E.ldc = 4096; E.tail_pn = -1; E.halo = nullptr; E.F = ABF; E.ldf = 64; E.nf = 64; E.rstd = RSTD; E.ng = args.in[14] + (size_t)slot * 128;
            E.src_lat = xl; E.src_ctx = xc; E.dst_lat = out; E.dst_ctx = CTXC; E.mod = modl; E.gidx = 2;
            g.M = (layer == 3 && op != OP_GEMM_IN) ? NLAT : MROWS; g.A = H; g.K = 1024;
            bf16_t* OBUF = (bf16_t*)(ws + (mix == 1 ? WS_OGLA : WS_O));
            if (op == OP_GEMM_IN) {
                g.Bt = (const bf16_t*)(ws + WT_A);
                if (mix == 0) { g.N = 4352; E.ldc = 4096; E.tail_pn = 16; E.ldf = 64; E.nf = 64; E.halo = (bf16_t*)(ws + WS_HALO); }
                else if (mix == 1) { g.N = 3328; E.ldc = 3072; E.tail_pn = 12; E.ldf = 32; E.nf = 32; }
                else { g.N = 1536; E.ldc = 1536; }
            } else if (op == OP_GEMM_Z) {
                g.Bt = (const bf16_t*)(ws + WT_Z); g.N = 2048; E.mode = 2; E.O = OBUF; E.ldc = 2048;
            } else if (op == OP_GEMM_OUT) {
                g.A = OBUF; g.K = mix == 0 ? 2048 : 1024; g.Bt = (const bf16_t*)(ws + WT_O); g.N = 1024; E.mode = 3; E.gidx = 2;
            } else if (op == OP_FFN1) {
                g.Bt = (const bf16_t*)(ws + WT_1); g.N = 4096; E.mode = 1; E.ldc = 4096;
            } else {
                g.A = PB; g.K = 4096; g.Bt = (const bf16_t*)(ws + WT_2); g.N = 1024; E.mode = 3; E.gidx = 5; E.src_lat = out; E.src_ctx = CTXC;
            }
            const bool splitc = (E.mode == 3 && layer < 3);
            E.part = ABF; E.ntf = g.K / 64;
            pg8::StaticOrder S; if (splitc) S.init(NLAT, g.N, G, (int)blockIdx.x, g.K / 64, 4, 2); else S.init(g.M, g.N, G, (int)blockIdx.x, g.K / 64);
#ifndef NO_GEMM
            pg8::gemm_phase<pg8::Epi, pg8::StaticOrder, true, true>(lds, g, S, E);
#endif
        } else if (op == OP_DNSCAN) {
#ifndef NO_DN
            if (DN_VARIANT && (ph & 1) == 0) dn_scan3<DN_VARIANT>(lds, PB, ABF, (const bf16_t*)(ws + WS_TP), (bf16_t*)(ws + WS_O)); else dn_scan3<0>(lds, PB, ABF, (const bf16_t*)(ws + WS_TP), (bf16_t*)(ws + WS_O));
#endif
        } else if (op == OP_GLAPREP) {
            gla_prep_phase(lds, PB, ABF, args.in[17], args.in[18], (bf16_t*)(ws + WS_QM), (bf16_t*)(ws + WS_KM), (bf16_t*)(ws + WS_AQ), (float*)(ws + WS_EL), G);
        } else if (op == OP_GLASTATE) {
            gla_scan3<0>(lds, PB, (const bf16_t*)(ws + WS_QM), (const bf16_t*)(ws + WS_KM), (const bf16_t*)(ws + WS_AQ), (const float*)(ws + WS_EL), (bf16_t*)(ws + WS_OGLA), (float*)(ws + WS_SEND), (float*)(ws + WS_DSUM));
        } else if (op == OP_GLASCAN) {
#ifndef NO_GLA
            gla_scan3<1>(lds, PB, (const bf16_t*)(ws + WS_QM), (const bf16_t*)(ws + WS_KM), (const bf16_t*)(ws + WS_AQ), (const float*)(ws + WS_EL), (bf16_t*)(ws + WS_OGLA), (float*)(ws + WS_SEND), (float*)(ws + WS_DSUM));
#endif
        } else if (op == OP_GLAGATE) {
            const int tid = opaque_tid(), lane = tid & 63, wave = __builtin_amdgcn_readfirstlane(tid >> 6); const int gw = blockIdx.x * 8 + wave; (void)lane; (void)gw; (void)tid;
            bf16_t* OB = (bf16_t*)(ws + WS_OGLA); const float* ng = args.in[19];
            for (int row = gw; row < MROWS; row += NGW) {
                u32x4* p = (u32x4*)(OB + (size_t)row * 1024 + 16 * lane); const u32x4* gp = (const u32x4*)(PB + (size_t)row * 3072 + 2048 + 16 * lane); const u32x4* pb2 = (const u32x4*)(PB + (size_t)row * 3072 + 16 * lane);
                float o[16], z[16]; float ss = 0.f;
#pragma unroll
                for (int v = 0; v < 2; ++v) { const u32x4 q = p[v], gq = gp[v], q2 = pb2[v];
                    o[8 * v + 0] = bf_lo(q.x) + bf_lo(q2.x); o[8 * v + 1] = bf_hi(q.x) + bf_hi(q2.x); o[8 * v + 2] = bf_lo(q.y) + bf_lo(q2.y); o[8 * v + 3] = bf_hi(q.y) + bf_hi(q2.y); o[8 * v + 4] = bf_lo(q.z) + bf_lo(q2.z); o[8 * v + 5] = bf_hi(q.z) + bf_hi(q2.z); o[8 * v + 6] = bf_lo(q.w) + bf_lo(q2.w); o[8 * v + 7] = bf_hi(q.w) + bf_hi(q2.w);
                    z[8 * v + 0] = bf_lo(gq.x); z[8 * v + 1] = bf_hi(gq.x); z[8 * v + 2] = bf_lo(gq.y); z[8 * v + 3] = bf_hi(gq.y); z[8 * v + 4] = bf_lo(gq.z); z[8 * v + 5] = bf_hi(gq.z); z[8 * v + 6] = bf_lo(gq.w); z[8 * v + 7] = bf_hi(gq.w); }
#pragma unroll
                for (int e = 0; e < 16; ++e) ss += o[e] * o[e];
                ss += __shfl_xor(ss, 1); ss += __shfl_xor(ss, 2); ss += __shfl_xor(ss, 4); ss += __shfl_xor(ss, 8);
                const float rs = rsqrtf(ss * (1.f / 256.f) + EPS); const int cb = (16 * lane) & 255;
#pragma unroll
                for (int v = 0; v < 2; ++v) { float rr[8];
#pragma unroll
                    for (int e = 0; e < 8; ++e) rr[e] = o[8 * v + e] * rs * ng[cb + 8 * v + e] * silu_f(z[8 * v + e]);
                    u32x4 wv; wv.x = cvtpk_s(rr[0], rr[1]); wv.y = cvtpk_s(rr[2], rr[3]); wv.z = cvtpk_s(rr[4], rr[5]); wv.w = cvtpk_s(rr[6], rr[7]); p[v] = wv; }
            }
        } else if (op == OP_QKROPE) {
            const int tid = opaque_tid(), lane = tid & 63, wave = __builtin_amdgcn_readfirstlane(tid >> 6); const int gw = blockIdx.x * 8 + wave; (void)lane; (void)gw; (void)tid;
            bf16_t* QR = (bf16_t*)(ws + WS_QR); bf16_t* KR = (bf16_t*)(ws + WS_KR); bf16_t* VR = (bf16_t*)(ws + WS_VR);
            const float* qg = args.in[22]; const float* kg = args.in[23];
            const int hf = lane >> 5, j = lane & 31, e1 = 64 * hf + j, e2 = e1 + 32;
            const float inv_freq = exp2f(-(float)(2 * j) * (1.f / 64.f) * 13.287712379549449f);
            const float gq1 = qg[e1], gq2 = qg[e2], gk1 = kg[e1], gk2 = kg[e2];
            for (int rowa = gw; rowa < MROWS; rowa += 2 * NGW) {
                float x1[2][10], x2[2][10]; unsigned short va[2][4]; int rws[2]; rws[0] = rowa; rws[1] = rowa + NGW < MROWS ? rowa + NGW : rowa;
#pragma unroll
                for (int q = 0; q < 2; ++q) { const bf16_t* pr = PB + (size_t)rws[q] * 1536;
#pragma unroll
                    for (int hd = 0; hd < 10; ++hd) { x1[q][hd] = bf2f(pr[hd * 128 + e1]); x2[q][hd] = bf2f(pr[hd * 128 + e2]); }
                    va[q][0] = pr[1280 + e1]; va[q][1] = pr[1280 + e2]; va[q][2] = pr[1408 + e1]; va[q][3] = pr[1408 + e2]; }
#pragma unroll
                for (int q = 0; q < 2; ++q) {
                    if (q == 1 && rowa + NGW >= MROWS) break;
                    const int row = rws[q];
                    const bool lat = row < NLAT; const int b = lat ? row / SEQ : (row - NLAT) / CTXL; const int tpos = lat ? row % SEQ : (row - NLAT) % CTXL;
                    float cs = 1.f, sn = 0.f;
                    if (lat) { const float pos = (float)(hf == 0 ? tpos / 64 : tpos % 64); const float ang = pos * inv_freq; sn = sinf(ang); cs = cosf(ang); }
                    const int kpos = lat ? tpos : SEQ + tpos;
#pragma unroll
                    for (int hd = 0; hd < 10; ++hd) {
                        const float a1 = x1[q][hd], a2 = x2[q][hd];
                        const float rinv = rsqrtf(wave_sum(a1 * a1 + a2 * a2) * (1.f / 128.f) + EPS);
                        const float y1 = a1 * rinv * (hd < 8 ? gq1 : gk1), y2 = a2 * rinv * (hd < 8 ? gq2 : gk2);
                        const float o1 = y1 * cs - y2 * sn, o2 = y1 * sn + y2 * cs;
                        bf16_t* dst = hd < 8 ? QR + (size_t)row * 1024 + hd * 128 : KR + ((size_t)(b * 2 + (hd - 8)) * SKV + kpos) * 128;
                        dst[e1] = f2bf(o1); dst[e2] = f2bf(o2);
                    }
#pragma unroll
                    for (int kv = 0; kv < 2; ++kv) { bf16_t* dst = VR + ((size_t)(b * 2 + kv) * SKV + kpos) * 128; dst[e1] = va[q][2 * kv]; dst[e2] = va[q][2 * kv + 1]; }
                }
            }
        } else if (op == OP_ATTN) {
            const attn::bf16* QR = (const attn::bf16*)(ws + WS_QR); const attn::bf16* KR = (const attn::bf16*)(ws + WS_KR); const attn::bf16* VR = (const attn::bf16*)(ws + WS_VR);
            attn::bf16* OB = (attn::bf16*)(ws + WS_O);
            for (int u = blockIdx.x; u < 1024 + 16; u += G) {
                size_t qoff, koff; int seq;
                if (u < 1024) { const int pair = u >> 8, b = pair >> 1, kvh = pair & 1, hh = (u >> 6) & 3, qb = u & 63, head = kvh * 4 + hh;
                    qoff = ((size_t)b * SEQ + (size_t)qb * 256) * 1024 + head * 128; koff = (size_t)(b * 2 + kvh) * SKV * 128; seq = SKV; }
                else { const int jx = u - 1024, b = jx >> 3, head = jx & 7, kvh = head >> 2;
                    qoff = ((size_t)NLAT + (size_t)b * CTXL) * 1024 + head * 128; koff = ((size_t)(b * 2 + kvh) * SKV + SEQ) * 128; seq = CTXL; }
                __syncthreads();
#ifndef NO_ATT
                attn::attn_dense_body<attn::bf16>(QR + qoff, KR + koff, VR + koff, OB + qoff, seq, (char*)lds_raw);
#endif
            }
        }
        if (ph + 1 < args.ph_hi) { if (ph == 0) grid.sync(); else xcd_barrier(xbar); }
    }
}

#ifndef MK_MULTI
#define MK_MULTI 0
#endif
extern "C" void kernel_launch(void* const* d_in, const int* in_sizes, int n_in, void* d_out, int out_size, void* d_ws, size_t ws_size, hipStream_t stream) {
    static int grid = 0;
    if (grid == 0) {
        if (n_in != 25 || ws_size < WS_END) { fprintf(stderr, "kernel_launch: unexpected n_in %d / ws_size %zu (need %zu)\n", n_in, ws_size, (size_t)WS_END); grid = -1; return; }
        int dev = 0, cus = 0, per_cu = 0;
        hipGetDevice(&dev); hipDeviceGetAttribute(&cus, hipDeviceAttributeMultiprocessorCount, dev);
        if (hipFuncSetAttribute((const void*)mega, hipFuncAttributeMaxDynamicSharedMemorySize, LDS_BYTES) != hipSuccess) { fprintf(stderr, "kernel_launch: hipFuncSetAttribute failed\n"); grid = -1; return; }
        if (hipOccupancyMaxActiveBlocksPerMultiprocessor(&per_cu, (const void*)mega, 512, LDS_BYTES) != hipSuccess || per_cu < 1) { fprintf(stderr, "kernel_launch: occupancy query says %d\n", per_cu); per_cu = 1; }
        (void)hipGetLastError();
        grid = cus * 1;
    }
    if (grid < 0) return;
    if (hipMemsetAsync((char*)d_ws + WS_BAR, 0, WS_BAR_BYTES, stream) != hipSuccess) { fprintf(stderr, "kernel_launch: memset of barrier words failed\n"); return; }
    Args a{};
    for (int i = 0; i < 25; ++i) a.in[i] = (const float*)d_in[i];
    a.out = (float*)d_out; a.ws = (unsigned char*)d_ws;
#if MK_MULTI
    for (int ph = 0; ph < NPHASE; ++ph) { a.ph_lo = ph; a.ph_hi = ph + 1; hipLaunchKernelGGL(mega, dim3(grid), dim3(512), LDS_BYTES, stream, a); }
#else
    a.ph_lo = 0; a.ph_hi = NPHASE;
    void* kargs[] = {&a};
    hipError_t e = hipLaunchCooperativeKernel((const void*)mega, dim3(grid), dim3(512), kargs, LDS_BYTES, stream);
    if (e != hipSuccess) fprintf(stderr, "cooperative launch failed: %s (grid %d)\n", hipGetErrorString(e), grid);
#endif
}
```

```cpp
#include <hip/hip_runtime.h>
#include <hip/hip_bf16.h>
#include <hip/hip_cooperative_groups.h>
#include <cstdio>
#include <cstdint>
namespace cg = cooperative_groups;
__device__ __forceinline__ int opaque_tid() { int t = threadIdx.x; asm volatile("" : "+v"(t)); return t; }
namespace pg8 {
#define PG8_LAS __attribute__((address_space(3)))
typedef unsigned short bf16_t;
typedef short bf16x8 __attribute__((ext_vector_type(8)));
typedef float f32x4 __attribute__((ext_vector_type(4)));
typedef unsigned u32x4 __attribute__((ext_vector_type(4)));
constexpr int BM = 256, BK = 64, HALF = 128, HTB = HALF * BK * 2  , STAGE_BYTES = 8 * HTB, NXCD = 8, WGM = 8;

__host__ __device__ __forceinline__ int lds_byte(int r, int c) { const int st = (r >> 4) * 2 + (c >> 5), rr = r & 15, cc = c & 31, ob = rr * 64 + cc * 2; return st * 1024 + (ob ^ (((ob >> 9) & 1) << 5)); }
__host__ __device__ __forceinline__ void stage_rc(int b, int& R, int& C) { const int st = b / 1024, sb = b % 1024, swz = sb ^ (((sb >> 9) & 1) << 5); R = (st >> 1) * 16 + swz / 64; C = (st & 1) * 32 + (swz % 64) / 2; }
__host__ __device__ __forceinline__ int perm32(int rho) { const int n = rho >> 4, i = rho & 15; return 8 * (i >> 2) + 4 * n + (i & 3); }

struct Unit { int pm, pn, k0, nt; };
struct Gemm { const bf16_t* A; const bf16_t* Bt; int M, N, K; };

struct StaticOrder {
    int nM, nN, nwg, G, c, ntf, NS, nMc;
    __host__ __device__ void init(int M, int N, int G_, int c_, int ntf_, int NS_ = 1, int nMc_ = 0) { nM = M / BM; nN = N / BM; nwg = nM * nN; G = G_; c = c_; ntf = ntf_; NS = NS_; nMc = nMc_; }
    __host__ __device__ bool next(int i, Unit& u) const {
        const long L = (long)i * G + c;
        if (L >= (long)nwg + (long)nMc * nN * NS) return false;
        int pm, pn, k0 = 0, ntu = ntf;
        if (L >= nwg) { const int s_ = (int)(L - nwg), sl = s_ % NS, rest = s_ / NS; pn = rest % nN; pm = nM + rest / nN; ntu = ntf / NS; k0 = sl * ntu; }
        else {
            int wgid = (int)L; { const int q = nwg / NXCD, r = nwg % NXCD, xcd = wgid % NXCD, off = wgid / NXCD; wgid = (xcd < r ? xcd * (q + 1) : r * (q + 1) + (xcd - r) * q) + off; }
            const int nig = WGM * nN, gid = wgid / nig, fm = gid * WGM, gsz = (nM - fm) < WGM ? (nM - fm) : WGM;
            pm = fm + ((wgid % nig) % gsz); pn = (wgid % nig) / gsz;
        }
        u.pm = pm; u.pn = pn; u.k0 = k0; u.nt = ntu; return true;
    }
    __device__ __forceinline__ void a_ready(const Unit&) const {}
    __device__ __forceinline__ void done(const Unit&) const {}
};

__device__ __forceinline__ unsigned cvt_pk_bf16(float lo, float hi) { unsigned r; asm volatile("v_cvt_pk_bf16_f32 %0, %1, %2" : "=v"(r) : "v"(lo), "v"(hi)); return r; }
typedef float f32x2 __attribute__((ext_vector_type(2)));
typedef float f32x2_t __attribute__((ext_vector_type(2))); typedef __bf16 bf16x2_t __attribute__((ext_vector_type(2)));
__device__ __forceinline__ unsigned cvtpk_s(float lo, float hi) { f32x2_t v = {lo, hi}; bf16x2_t b = __builtin_convertvector(v, bf16x2_t); return __builtin_bit_cast(unsigned, b); }
__device__ __forceinline__ float bf_lo(unsigned w) { return __builtin_bit_cast(float, w << 16); }
__device__ __forceinline__ float bf_hi(unsigned w) { return __builtin_bit_cast(float, w & 0xffff0000u); }
__device__ __forceinline__ float silu_f(float z) { return z / (1.f + __expf(-z)); }
struct Epi {
    static constexpr bool PERM = true, AFTER_DRAIN = false;
    int mode;
    bf16_t* O; int ldc;
    int tail_pn; float* F; int ldf, nf;
    bf16_t* halo;
    const float* rstd; const float* ng;
    const float* src_lat; const float* src_ctx; float* dst_lat; float* dst_ctx; const float* mod; int gidx;
    float* part; int ntf;
    __device__ __forceinline__ void operator()(const f32x4 (&acc)[2][2][4][2], const Unit& u, int wr, int wc, int fr, int fq) const {
        const int row0 = u.pm * BM + wr * 64 + fr; const int col0 = u.pn * BM + wc * 32 + 8 * fq;
        if (mode == 3 && u.nt != ntf) {
            float* pb = part + ((size_t)(u.k0 / u.nt) * 512 - 32768) * 1024;
#pragma unroll
            for (int ai = 0; ai < 2; ++ai)
#pragma unroll
                for (int m = 0; m < 4; ++m)
#pragma unroll
                    for (int bj = 0; bj < 2; ++bj) { float* p = pb + (size_t)(row0 + ai * HALF + m * 16) * 1024 + col0 + bj * HALF; *(f32x4*)p = acc[ai][bj][m][0]; *(f32x4*)(p + 4) = acc[ai][bj][m][1]; }
            return;
        }
        if (mode <= 1) {
            if (u.pn == tail_pn) {
                const int c0 = wc * 32 + 8 * fq;
#pragma unroll
                for (int ai = 0; ai < 2; ++ai)
#pragma unroll
                    for (int m = 0; m < 4; ++m)
#pragma unroll
                        for (int bj = 0; bj < 2; ++bj) { const int cc = c0 + bj * HALF;
                            if (cc < nf) { float* p = F + (size_t)(row0 + ai * HALF + m * 16) * ldf + cc; *(f32x4*)p = acc[ai][bj][m][0]; *(f32x4*)(p + 4) = acc[ai][bj][m][1]; } }
            } else {
#pragma unroll
                for (int ai = 0; ai < 2; ++ai)
#pragma unroll
                    for (int m = 0; m < 4; ++m) { bf16_t* rowp = O + (size_t)(row0 + ai * HALF + m * 16) * ldc + col0;
#pragma unroll
                        for (int bj = 0; bj < 2; ++bj) { f32x4 v0 = acc[ai][bj][m][0], v1 = acc[ai][bj][m][1];
                            if (mode == 1) {
#pragma unroll
                                for (int e = 0; e < 4; ++e) { float a = fmaxf(v0[e], 0.f), b = fmaxf(v1[e], 0.f); v0[e] = a * a; v1[e] = b * b; } }
                            u32x4 w; w.x = cvtpk_s(v0[0], v0[1]); w.y = cvtpk_s(v0[2], v0[3]); w.z = cvtpk_s(v1[0], v1[1]); w.w = cvtpk_s(v1[2], v1[3]);
                            *(u32x4*)(rowp + bj * HALF) = w;
                            if (halo && ((m == 0 && fr < 2) || (m == 3 && fr >= 14))) { const int row = row0 + ai * HALF + m * 16; const int j = m == 0 ? fr : fr - 12;
                                *(u32x4*)(halo + ((size_t)(row >> 6) * 4 + j) * ldc + col0 + bj * HALF) = w; } } }
            }
        } else if (mode == 2) {
            const f32x4 g0 = *(const f32x4*)(ng + (col0 & 127)), g1 = *(const f32x4*)(ng + (col0 & 127) + 4);
#pragma unroll
            for (int ai = 0; ai < 2; ++ai)
#pragma unroll
                for (int m = 0; m < 4; ++m) { const int row = row0 + ai * HALF + m * 16; bf16_t* rowp = O + (size_t)row * ldc + col0;
#pragma unroll
                    for (int bj = 0; bj < 2; ++bj) { const float rs = rstd[(size_t)row * 16 + ((col0 + bj * HALF) >> 7)];
                        const u32x4 ov = *(const u32x4*)(rowp + bj * HALF); const f32x4 z0 = acc[ai][bj][m][0], z1 = acc[ai][bj][m][1];
                        float r[8];
                        r[0] = bf_lo(ov.x) * rs * g0[0] * silu_f(z0[0]); r[1] = bf_hi(ov.x) * rs * g0[1] * silu_f(z0[1]);
                        r[2] = bf_lo(ov.y) * rs * g0[2] * silu_f(z0[2]); r[3] = bf_hi(ov.y) * rs * g0[3] * silu_f(z0[3]);
                        r[4] = bf_lo(ov.z) * rs * g1[0] * silu_f(z1[0]); r[5] = bf_hi(ov.z) * rs * g1[1] * silu_f(z1[1]);
                        r[6] = bf_lo(ov.w) * rs * g1[2] * silu_f(z1[2]); r[7] = bf_hi(ov.w) * rs * g1[3] * silu_f(z1[3]);
                        u32x4 w; w.x = cvtpk_s(r[0], r[1]); w.y = cvtpk_s(r[2], r[3]); w.z = cvtpk_s(r[4], r[5]); w.w = cvtpk_s(r[6], r[7]);
                        *(u32x4*)(rowp + bj * HALF) = w; } }
        } else {
            const int mi = u.pm < 64 ? 0 : (u.pm < 128 ? 1 : 2);
            const float* gate = mod + (size_t)mi * 6144 + (size_t)gidx * 1024;
            const bool lat = u.pm < 128;
            const float* sb = lat ? src_lat : src_ctx - (size_t)32768 * 1024; float* db = lat ? dst_lat : dst_ctx - (size_t)32768 * 1024;
#pragma unroll
            for (int bj = 0; bj < 2; ++bj)
#pragma unroll
                for (int n = 0; n < 2; ++n) { const int c = col0 + bj * HALF + 4 * n; const f32x4 gv = *(const f32x4*)(gate + c);
#pragma unroll
                    for (int ai = 0; ai < 2; ++ai)
#pragma unroll
                        for (int m = 0; m < 4; ++m) { const size_t off = (size_t)(row0 + ai * HALF + m * 16) * 1024 + c;
                            const f32x4 s = *(const f32x4*)(sb + off); *(f32x4*)(db + off) = s + gv * acc[ai][bj][m][n]; } }
        }
    }
};
template <class Epi, class Sched, bool ALIGN_EPI = false, bool SP2 = false>
__device__ __forceinline__ void gemm_phase(PG8_LAS unsigned char* lds, const Gemm g, const Sched& S, const Epi& E) {
    const int tid = opaque_tid(), wid = __builtin_amdgcn_readfirstlane(tid >> 6), lane = tid & 63, wr = wid >> 2, wc = wid & 3, fr = lane & 15, fq = lane >> 4;
    const int K = g.K;
    unsigned voffA[2], voffB[2];
#pragma unroll
    for (int i = 0; i < 2; ++i) { int R, C; stage_rc(tid * 16 + i * 8192, R, C); const int Rb = Epi::PERM ? ((R & ~31) + perm32(R & 31)) : R;
        voffA[i] = (unsigned)(R * K + C) * 2u; voffB[i] = (unsigned)(Rb * K + C) * 2u; }
    const size_t kstep = (size_t)(BK * 2);
    const size_t hstep = (size_t)HALF * K * 2;
    const size_t tstep = 2 * hstep;
    const unsigned ldsw = (unsigned)wid * 1024u;
    const int aoff = lds_byte(wr * 64 + fr, fq * 8), boff = lds_byte(wc * 32 + fr, fq * 8);
#define PG8_SA(b, h) (((b) * 2 + (h)) * HTB)
#define PG8_SB(b, h) ((4 + (b) * 2 + (h)) * HTB)
#define PG8_STAGE(bufoff, gbase, voff) do { _Pragma("unroll") for (int _i = 0; _i < 2; ++_i) \
        __builtin_amdgcn_global_load_lds((const unsigned*)((const char*)(gbase) + (voff)[_i]), (PG8_LAS unsigned*)(lds + (bufoff) + ldsw + _i * 8192), 16, 0, 0); } while (0)
#define PG8_LDA(dst, b, h) do { _Pragma("unroll") for (int m = 0; m < 4; ++m) _Pragma("unroll") for (int k = 0; k < 2; ++k) dst[m][k] = *(const PG8_LAS bf16x8*)(lds + PG8_SA(b, h) + aoff + m * 2048 + k * 1024); } while (0)
#define PG8_LDB(dst, b, h) do { _Pragma("unroll") for (int n = 0; n < 2; ++n) _Pragma("unroll") for (int k = 0; k < 2; ++k) dst[n][k] = *(const PG8_LAS bf16x8*)(lds + PG8_SB(b, h) + boff + n * 2048 + k * 1024); } while (0)
#define PG8_MMA(ai, bj, At, Bt) do { __builtin_amdgcn_s_setprio(1); _Pragma("unroll") for (int m = 0; m < 4; ++m) _Pragma("unroll") for (int n = 0; n < 2; ++n) _Pragma("unroll") for (int k = 0; k < 2; ++k) \
        acc[ai][bj][m][n] = __builtin_amdgcn_mfma_f32_16x16x32_bf16(Bt[n][k], At[m][k], acc[ai][bj][m][n], 0, 0, 0); __builtin_amdgcn_s_setprio(0); } while (0)
#define PG8_WAIT_V(n) asm volatile("s_waitcnt vmcnt(" #n ")" ::: "memory")
#define PG8_WAIT_L(n) asm volatile("s_waitcnt lgkmcnt(" #n ")" ::: "memory")
#define PG8_BAR __builtin_amdgcn_s_barrier()
#define PG8_SCHED __builtin_amdgcn_sched_barrier(0)
    Unit cur, nxt; int ui = 0;
    if (!S.next(0, cur)) return;
    f32x4 acc[2][2][4][2];
#pragma unroll
    for (int a = 0; a < 2; ++a)
#pragma unroll
        for (int b = 0; b < 2; ++b)
#pragma unroll
            for (int m = 0; m < 4; ++m)
#pragma unroll
                for (int n = 0; n < 2; ++n) acc[a][b][m][n] = (f32x4){0.f, 0.f, 0.f, 0.f};
    bf16x8 At[4][2], B0[2][2], B1[2][2];
    const char* cA = (const char*)g.A + (size_t)cur.pm * tstep + (size_t)cur.k0 * kstep; const char* cB = (const char*)g.Bt + (size_t)cur.pn * tstep + (size_t)cur.k0 * kstep;
    S.a_ready(cur);
    if constexpr (SP2) {
        PG8_STAGE(PG8_SB(0, 0), cB, voffB); PG8_STAGE(PG8_SB(0, 1), cB + hstep, voffB); PG8_STAGE(PG8_SA(0, 0), cA, voffA); PG8_STAGE(PG8_SA(0, 1), cA + hstep, voffA);
        if (wr == 1) PG8_BAR;
        PG8_WAIT_V(2); PG8_BAR;
        PG8_STAGE(PG8_SB(1, 0), cB + kstep, voffB); PG8_STAGE(PG8_SA(1, 0), cA + kstep, voffA); PG8_STAGE(PG8_SB(1, 1), cB + hstep + kstep, voffB);
        PG8_WAIT_V(6); PG8_BAR;
    } else {
        PG8_STAGE(PG8_SB(0, 0), cB, voffB); PG8_STAGE(PG8_SA(0, 0), cA, voffA); PG8_STAGE(PG8_SB(0, 1), cB + hstep, voffB); PG8_STAGE(PG8_SA(0, 1), cA + hstep, voffA);
        if (wr == 1) PG8_BAR;
        PG8_WAIT_V(4); PG8_BAR;
        PG8_STAGE(PG8_SB(1, 0), cB + kstep, voffB); PG8_STAGE(PG8_SA(1, 0), cA + kstep, voffA); PG8_STAGE(PG8_SB(1, 1), cB + hstep + kstep, voffB);
        PG8_WAIT_V(6); PG8_BAR;
    }
    for (;;) {
        const bool has_next = S.next(ui + 1, nxt);
        const char* nA = has_next ? (const char*)g.A + (size_t)nxt.pm * tstep + (size_t)nxt.k0 * kstep : cA; const char* nB = has_next ? (const char*)g.Bt + (size_t)nxt.pn * tstep + (size_t)nxt.k0 * kstep : cB;
        const int nt = cur.nt;
        for (int t = 0; t < nt; t += 2) {
            const bool last = (t == nt - 2);
            const char* a1 = cA + (size_t)(t + 1) * kstep;
            const char* a2 = last ? nA : cA + (size_t)(t + 2) * kstep; const char* b2 = last ? nB : cB + (size_t)(t + 2) * kstep;
            const char* a3 = a2 + kstep; const char* b3 = b2 + kstep;
            if (last && has_next) S.a_ready(nxt);
            if constexpr (SP2) {
            PG8_LDB(B0, 0, 0); PG8_LDB(B1, 0, 1); PG8_SCHED; PG8_LDA(At, 0, 0); PG8_STAGE(PG8_SA(1, 1), a1 + hstep, voffA);
            PG8_WAIT_V(8); PG8_WAIT_L(0); PG8_BAR; PG8_MMA(0, 0, At, B0); PG8_MMA(0, 1, At, B1); PG8_BAR; PG8_SCHED;
            PG8_LDA(At, 0, 1); PG8_STAGE(PG8_SB(0, 0), b2, voffB); PG8_STAGE(PG8_SB(0, 1), b2 + hstep, voffB); PG8_STAGE(PG8_SA(0, 0), a2, voffA);
            PG8_WAIT_V(8); PG8_WAIT_L(0); PG8_BAR; PG8_MMA(1, 0, At, B0); PG8_MMA(1, 1, At, B1); PG8_BAR; PG8_SCHED;
            PG8_LDB(B0, 1, 0); PG8_LDB(B1, 1, 1); PG8_SCHED; PG8_LDA(At, 1, 0); PG8_STAGE(PG8_SA(0, 1), a2 + hstep, voffA);
            PG8_WAIT_V(8); PG8_WAIT_L(0); PG8_BAR; PG8_MMA(0, 0, At, B0); PG8_MMA(0, 1, At, B1); PG8_BAR; PG8_SCHED;
            PG8_LDA(At, 1, 1); PG8_STAGE(PG8_SB(1, 0), b3, voffB); PG8_STAGE(PG8_SB(1, 1), b3 + hstep, voffB); PG8_STAGE(PG8_SA(1, 0), a3, voffA);
            PG8_WAIT_V(8); PG8_WAIT_L(0); PG8_BAR; PG8_MMA(1, 0, At, B0); PG8_MMA(1, 1, At, B1); PG8_BAR; PG8_SCHED;
            } else {
            PG8_LDB(B0, 0, 0); PG8_SCHED; PG8_LDA(At, 0, 0); PG8_STAGE(PG8_SA(1, 1), a1 + hstep, voffA);
            PG8_WAIT_L(8); PG8_BAR; PG8_WAIT_L(0); PG8_MMA(0, 0, At, B0); PG8_BAR; PG8_SCHED;
            PG8_LDB(B1, 0, 1); PG8_STAGE(PG8_SB(0, 0), b2, voffB);
            PG8_BAR; PG8_WAIT_L(0); PG8_MMA(0, 1, At, B1); PG8_BAR;
            PG8_LDA(At, 0, 1); PG8_STAGE(PG8_SA(0, 0), a2, voffA);
            PG8_BAR; PG8_WAIT_L(0); PG8_MMA(1, 0, At, B0); PG8_BAR; PG8_SCHED;
            PG8_STAGE(PG8_SB(0, 1), b2 + hstep, voffB);
            PG8_WAIT_V(6); PG8_BAR; PG8_MMA(1, 1, At, B1); PG8_BAR;
            PG8_LDB(B0, 1, 0); PG8_SCHED; PG8_LDA(At, 1, 0); PG8_STAGE(PG8_SA(0, 1), a2 + hstep, voffA);
            PG8_WAIT_L(8); PG8_BAR; PG8_WAIT_L(0); PG8_MMA(0, 0, At, B0); PG8_BAR; PG8_SCHED;
            PG8_LDB(B1, 1, 1); PG8_STAGE(PG8_SB(1, 0), b3, voffB);
            PG8_BAR; PG8_WAIT_L(0); PG8_MMA(0, 1, At, B1); PG8_BAR;
            PG8_LDA(At, 1, 1); PG8_STAGE(PG8_SA(1, 0), a3, voffA);
            PG8_BAR; PG8_WAIT_L(0); PG8_MMA(1, 0, At, B0); PG8_BAR; PG8_SCHED;
            PG8_STAGE(PG8_SB(1, 1), b3 + hstep, voffB);
            PG8_WAIT_V(6); PG8_BAR; PG8_MMA(1, 1, At, B1); PG8_BAR;
            }
        }
        if constexpr (ALIGN_EPI) { if (wr == 0) PG8_BAR; }
        if constexpr (!Epi::AFTER_DRAIN) { E(acc, cur, wr, wc, fr, fq); S.done(cur); }
        if (!has_next) break;
#pragma unroll
        for (int a = 0; a < 2; ++a)
#pragma unroll
            for (int b = 0; b < 2; ++b)
#pragma unroll
                for (int m = 0; m < 4; ++m)
#pragma unroll
                    for (int n = 0; n < 2; ++n) acc[a][b][m][n] = (f32x4){0.f, 0.f, 0.f, 0.f};
        cur = nxt; cA = nA; cB = nB; ++ui;
        if constexpr (ALIGN_EPI) { if (wr == 1) PG8_BAR; }
    }
    PG8_WAIT_V(0);
    if constexpr (!ALIGN_EPI) { if (wr == 0) PG8_BAR; }
    PG8_BAR;
    if constexpr (Epi::AFTER_DRAIN) { E.fused(acc, cur, wr, wc, fr, fq, lds, wid, lane); S.done(cur); }
#undef PG8_SA
#undef PG8_SB
#undef PG8_STAGE
#undef PG8_LDA
#undef PG8_LDB
#undef PG8_MMA
#undef PG8_WAIT_V
#undef PG8_WAIT_L
#undef PG8_BAR
#undef PG8_SCHED
}
}
namespace attn {
using bf16 = __hip_bfloat16;
constexpr int   D = 128, NW = 8, QBLK = 32, KVBLK = 64;
constexpr float SCALE = 0.088388347648318440f;
constexpr float THR = 8.f;
constexpr int SDEPTH = 2;
constexpr int LDQ = 1024, LDK = 128, LDO = 1024;
constexpr size_t SHM_V = KVBLK * D * 2, SHM_K = KVBLK * D * 2, SHM_ATTN = 2 * SHM_V + 2 * SHM_K + NW * 64 * 4;
using bf16x8 = __attribute__((ext_vector_type(8))) short;
using s16x4  = __attribute__((ext_vector_type(4))) short;
using f32x16 = __attribute__((ext_vector_type(16))) float;
using f32x8  = __attribute__((ext_vector_type(8))) float;
using u32x4  = __attribute__((ext_vector_type(4))) unsigned;
#define KSWZ(row, colB) ((row) * 256 + ((colB) ^ (((row) & 7) << 4)))
#define SBAR() __builtin_amdgcn_sched_barrier(0)
__device__ __forceinline__ int crow(int r, int hi) { return (r & 3) + 8 * (r >> 2) + 4 * hi; }
__device__ __forceinline__ unsigned cvtpk(float lo, float hi) {
  unsigned r; asm volatile("v_cvt_pk_bf16_f32 %0, %1, %2" : "=v"(r) : "v"(lo), "v"(hi)); return r;
}
template <typename TIn> struct Stage;
template <> struct Stage<bf16>  { using T = bf16x8;
  __device__ static __forceinline__ T ld8(const bf16* p) { return *reinterpret_cast<const bf16x8*>(p); }
  __device__ static __forceinline__ bf16x8 tobf(T x) { return x; } };
template <> struct Stage<float> { using T = f32x8;
  __device__ static __forceinline__ T ld8(const float* p) { return *reinterpret_cast<const f32x8*>(p); }
  __device__ static __forceinline__ bf16x8 tobf(T x) {
    u32x4 w = {cvtpk(x[0], x[1]), cvtpk(x[2], x[3]), cvtpk(x[4], x[5]), cvtpk(x[6], x[7])}; return *reinterpret_cast<bf16x8*>(&w); } };

__device__ __forceinline__ void partialSM(f32x16& p0, f32x16& p1, float& m_reg, float& mn, float& alpha) {
  constexpr float C = SCALE * 1.4426950408889634f;
  float pmax = p0[0]; for (int r = 1; r < 16; ++r) pmax = fmaxf(pmax, p0[r]); for (int r = 0; r < 16; ++r) pmax = fmaxf(pmax, p1[r]);
  { auto rr = __builtin_amdgcn_permlane32_swap(__float_as_uint(pmax), __float_as_uint(pmax), false, false);
    pmax = fmaxf(__uint_as_float(rr[0]), __uint_as_float(rr[1])); }
  if (__builtin_expect(__all(pmax - m_reg <= THR / SCALE), 1)) { mn = m_reg; alpha = 1.f; }
  else { mn = fmaxf(m_reg, pmax); alpha = __builtin_amdgcn_exp2f((m_reg - mn) * C); m_reg = mn; }
  float mnC = -mn * C;
  for (int r = 0; r < 16; ++r) p0[r] = fmaf(p0[r], C, mnC); for (int r = 0; r < 16; ++r) p1[r] = fmaf(p1[r], C, mnC);
  for (int r = 0; r < 16; ++r) p0[r] = __builtin_amdgcn_exp2f(p0[r]);
}
__device__ __forceinline__ void finishSM(f32x16& p0, f32x16& p1, float alpha, float& l_reg, bf16x8& pa0, bf16x8& pa1, bf16x8& pa2, bf16x8& pa3) {
  for (int r = 0; r < 16; ++r) p1[r] = __builtin_amdgcn_exp2f(p1[r]);
  float ps = 0; for (int r = 0; r < 16; ++r) ps += p0[r]; for (int r = 0; r < 16; ++r) ps += p1[r];
  { auto rr = __builtin_amdgcn_permlane32_swap(__float_as_uint(ps), __float_as_uint(ps), false, false);
    ps = __uint_as_float(rr[0]) + __uint_as_float(rr[1]); }
  l_reg = l_reg * alpha + ps;
#define PK4(P, BASE, OUT) do { unsigned a0 = cvtpk(P[BASE + 0], P[BASE + 1]), a1 = cvtpk(P[BASE + 2], P[BASE + 3]);   \
    unsigned b0 = cvtpk(P[BASE + 4], P[BASE + 5]), b1 = cvtpk(P[BASE + 6], P[BASE + 7]);                              \
    auto r0 = __builtin_amdgcn_permlane32_swap(a0, b0, false, false); auto r1 = __builtin_amdgcn_permlane32_swap(a1, b1, false, false); \
    u32x4 w = {r0[0], r1[0], r0[1], r1[1]}; OUT = *reinterpret_cast<bf16x8*>(&w); } while (0)
  PK4(p0, 0, pa0); PK4(p0, 8, pa1); PK4(p1, 0, pa2); PK4(p1, 8, pa3);
#undef PK4
}
__device__ __forceinline__ void qkt(f32x16& p0, f32x16& p1, const bf16* Ks, const bf16x8* qr, int r32, int hi) {
  p0 = f32x16{}; p1 = f32x16{};
  for (int d0 = 0; d0 < 8; ++d0) { int cb = (d0 * 16 + hi * 8) * 2;
    bf16x8 b0 = *reinterpret_cast<const bf16x8*>((const char*)Ks + KSWZ(r32, cb));
    bf16x8 b1 = *reinterpret_cast<const bf16x8*>((const char*)Ks + KSWZ(32 + r32, cb));
    p0 = __builtin_amdgcn_mfma_f32_32x32x16_bf16(b0, qr[d0], p0, 0, 0, 0);
    p1 = __builtin_amdgcn_mfma_f32_32x32x16_bf16(b1, qr[d0], p1, 0, 0, 0); }
}
__device__ __forceinline__ int v_st(int k, int c) { const int kk = (k & ~0xC) | ((k & 4) << 1) | ((k & 8) >> 1); return ((kk >> 3) * 4 + (c >> 5)) * 512 + ((kk & 7) * 32 + (c & 31)) * 2; }
__device__ __forceinline__ int v_rd_base(int lane) { return ((lane & 3) << 3) | (((lane >> 2) & 3) << 6) | (((lane >> 4) & 1) << 5) | (((lane >> 5) & 1) << 8); }
constexpr int v_rd_off(int d0, int ks, int half) { return d0 * 512 + ks * 4096 + half * 2048; }
template <int OFF> __device__ __forceinline__ s16x4 tr_read(int vb) {
  s16x4 r; asm volatile("ds_read_b64_tr_b16 %0, %1 offset:%2" : "=&v"(r) : "v"(vb), "i"(OFF) : "memory"); return r;
}
template <int D0> __device__ __forceinline__ void pv_one(f32x16& od, int vb, bf16x8 pa0, bf16x8 pa1, bf16x8 pa2, bf16x8 pa3) {
  const s16x4 l0 = tr_read<v_rd_off(D0, 0, 0)>(vb), h0 = tr_read<v_rd_off(D0, 0, 1)>(vb), l1 = tr_read<v_rd_off(D0, 1, 0)>(vb), h1 = tr_read<v_rd_off(D0, 1, 1)>(vb);
  const s16x4 l2 = tr_read<v_rd_off(D0, 2, 0)>(vb), h2 = tr_read<v_rd_off(D0, 2, 1)>(vb), l3 = tr_read<v_rd_off(D0, 3, 0)>(vb), h3 = tr_read<v_rd_off(D0, 3, 1)>(vb);
  asm volatile("s_waitcnt lgkmcnt(0)" ::: "memory"); SBAR();
#define PK(L, H) (bf16x8){L[0], L[1], L[2], L[3], H[0], H[1], H[2], H[3]}
  od = __builtin_amdgcn_mfma_f32_32x32x16_bf16(pa0, PK(l0, h0), od, 0, 0, 0);
  od = __builtin_amdgcn_mfma_f32_32x32x16_bf16(pa1, PK(l1, h1), od, 0, 0, 0);
  od = __builtin_amdgcn_mfma_f32_32x32x16_bf16(pa2, PK(l2, h2), od, 0, 0, 0);
  od = __builtin_amdgcn_mfma_f32_32x32x16_bf16(pa3, PK(l3, h3), od, 0, 0, 0);
#undef PK
}
__device__ __forceinline__ void pv_d0(f32x16* o, int vb, bf16x8 pa0, bf16x8 pa1, bf16x8 pa2, bf16x8 pa3) {
  pv_one<0>(o[0], vb, pa0, pa1, pa2, pa3); pv_one<1>(o[1], vb, pa0, pa1, pa2, pa3); pv_one<2>(o[2], vb, pa0, pa1, pa2, pa3); pv_one<3>(o[3], vb, pa0, pa1, pa2, pa3);
}

template <typename TQ>
__device__ __forceinline__ void attn_dense_body(const TQ* __restrict__ Qb, const bf16* __restrict__ Kh, const bf16* __restrict__ Vh,
                                                bf16* __restrict__ Ob, int seq, char* lds) {
  using St = Stage<bf16>; using SQ = Stage<TQ>;
  const int tid = opaque_tid(), wid = tid >> 6, lane = tid & 63, r32 = lane & 31, hi = lane >> 5;
  bf16* V_lds = (bf16*)lds; bf16* K_lds = (bf16*)(lds + 2 * SHM_V);
  float* ws = (float*)(lds + 2 * SHM_V + 2 * SHM_K) + wid * 64; float* li_l = ws; float* al_l = ws + 32;
  float m_reg = -1e30f, l_reg = 0; f32x16 o[4] = {}; bf16x8 qr[8];
  const TQ* Qw = Qb + (long)(wid * QBLK + r32) * LDQ + hi * 8;
#pragma unroll
  for (int d0 = 0; d0 < 8; ++d0) qr[d0] = SQ::tobf(SQ::ld8(Qw + d0 * 16));
  const int sr = tid >> 4, sc = (tid & 15) * 8, vst0 = v_st(sr, sc), vst1 = v_st(32 + sr, sc);
  const int vb0 = (int)(uintptr_t)V_lds + v_rd_base(lane);
  struct { typename St::T vs0, vs1, ks0, ks1; } sr_[SDEPTH];
#define SLOAD(i, k0) do { sr_[i].vs0 = St::ld8(&Vh[(long)((k0) + sr) * LDK + sc]); sr_[i].vs1 = St::ld8(&Vh[(long)((k0) + 32 + sr) * LDK + sc]); \
    sr_[i].ks0 = St::ld8(&Kh[(long)((k0) + sr) * LDK + sc]); sr_[i].ks1 = St::ld8(&Kh[(long)((k0) + 32 + sr) * LDK + sc]); } while (0)
#define SWRITE(b, i) do { *(bf16x8*)((char*)V_lds + (b) * SHM_V + vst0) = St::tobf(sr_[i].vs0);          \
    *(bf16x8*)((char*)V_lds + (b) * SHM_V + vst1) = St::tobf(sr_[i].vs1); int kc = sc * 2;               \
    *(bf16x8*)((char*)K_lds + (b) * SHM_K + KSWZ(sr, kc)) = St::tobf(sr_[i].ks0);                       \
    *(bf16x8*)((char*)K_lds + (b) * SHM_K + KSWZ(32 + sr, kc)) = St::tobf(sr_[i].ks1); } while (0)
#define SWAIT() do { if constexpr (SDEPTH == 2) asm volatile("s_waitcnt vmcnt(4)" ::: "memory"); else asm volatile("s_waitcnt vmcnt(0)" ::: "memory"); } while (0)
#define RESC(a) do { if (__any((a) < 1.f)) { if (hi == 0) al_l[r32] = (a); asm volatile("s_waitcnt lgkmcnt(0)" ::: "memory"); \
    for (int d = 0; d < 4; ++d) for (int r = 0; r < 16; ++r) o[d][r] *= al_l[crow(r, hi)]; } } while (0)
  f32x16 pA0, pA1, pB0, pB1; float mnA, mnB, alA, alB; bf16x8 pa0, pa1, pa2, pa3; const int NT = seq / KVBLK;
  constexpr int SE = 0, SO = SDEPTH - 1;
  SLOAD(SE, 0); asm volatile("s_waitcnt vmcnt(0)" ::: "memory"); SWRITE(0, SE); __syncthreads();
  qkt(pA0, pA1, K_lds, qr, r32, hi); partialSM(pA0, pA1, m_reg, mnA, alA);
  SLOAD(SO, KVBLK); if constexpr (SDEPTH == 2) { if (2 < NT) SLOAD(SE, 2 * KVBLK); }
  SWAIT(); SWRITE(1, SO); __syncthreads();
  for (int j = 1; j + 1 < NT; j += 2) {
    SBAR(); qkt(pB0, pB1, (bf16*)((char*)K_lds + SHM_K), qr, r32, hi);
    finishSM(pA0, pA1, alA, l_reg, pa0, pa1, pa2, pa3); SBAR();
    SLOAD(SO, (j + SDEPTH) * KVBLK); SBAR();
    pv_d0(o, vb0, pa0, pa1, pa2, pa3); partialSM(pB0, pB1, m_reg, mnB, alB);
    __syncthreads(); SWAIT(); SWRITE(0, SE);
    RESC(alB); __syncthreads();
    SBAR(); qkt(pA0, pA1, K_lds, qr, r32, hi);
    finishSM(pB0, pB1, alB, l_reg, pa0, pa1, pa2, pa3); SBAR();
    if (SDEPTH == 1 || j + 3 < NT) SLOAD(SE, (j + 1 + SDEPTH) * KVBLK); SBAR();
    pv_d0(o, vb0 + (int)SHM_V, pa0, pa1, pa2, pa3); partialSM(pA0, pA1, m_reg, mnA, alA);
    __syncthreads(); SWAIT(); SWRITE(1, SO);
    RESC(alA); __syncthreads();
  }
  SBAR(); qkt(pB0, pB1, (bf16*)((char*)K_lds + SHM_K), qr, r32, hi);
  finishSM(pA0, pA1, alA, l_reg, pa0, pa1, pa2, pa3); SBAR();
  pv_d0(o, vb0, pa0, pa1, pa2, pa3); partialSM(pB0, pB1, m_reg, mnB, alB);
  __syncthreads(); RESC(alB);
  finishSM(pB0, pB1, alB, l_reg, pa0, pa1, pa2, pa3); SBAR();
  pv_d0(o, vb0 + (int)SHM_V, pa0, pa1, pa2, pa3);
  if (hi == 0) li_l[r32] = l_reg; asm volatile("s_waitcnt lgkmcnt(0)" ::: "memory");
  float rli[16];
#pragma unroll
  for (int r = 0; r < 16; ++r) rli[r] = __builtin_amdgcn_rcpf(li_l[crow(r, hi)]);
  bf16* Ow = Ob + (long)(wid * QBLK) * LDO;
#pragma unroll
  for (int r = 0; r < 16; ++r) { int orow = crow(r, hi);
    for (int d0 = 0; d0 < 4; ++d0) Ow[(long)orow * LDO + d0 * 32 + r32] = __float2bfloat16(o[d0][r] * rli[r]); }
#undef SLOAD
#undef SWRITE
#undef SWAIT
#undef RESC
}

}
#define LAS __attribute__((address_space(3)))
typedef unsigned short bf16_t;
typedef short bf16x8 __attribute__((ext_vector_type(8)));
typedef short s16x4 __attribute__((ext_vector_type(4)));
typedef float f32x4 __attribute__((ext_vector_type(4)));
typedef float f32x16 __attribute__((ext_vector_type(16)));
typedef unsigned u32x4 __attribute__((ext_vector_type(4)));
typedef unsigned u32x2 __attribute__((ext_vector_type(2)));
using pg8::cvtpk_s; using pg8::bf_lo; using pg8::bf_hi; using pg8::silu_f;

constexpr int DM = 1024, SEQ = 16384, CTXL = 256, NLAT = 2 * SEQ, MROWS = NLAT + 2 * CTXL, DFF = 4096;
constexpr float EPS = 1e-6f;
constexpr size_t MiB = 1u << 20;
constexpr size_t WS_BAR = 512 * 1024, WS_BAR_BYTES = 16384;
constexpr size_t WS_MOD = 0, WS_CTX = 1 * MiB, WS_WT = 4 * MiB, WS_H = 41 * MiB, WS_AB = 106 * MiB, WS_RSTD = 115 * MiB, WS_P = 118 * MiB, WS_O = 378 * MiB, WS_END = 508 * MiB;
constexpr size_t WT_A = WS_WT, WT_Z = WS_WT + 9 * MiB, WT_O = WS_WT + 13 * MiB, WT_1 = WS_WT + 17 * MiB, WT_2 = WS_WT + 25 * MiB;
constexpr size_t WS_QM = 313 * MiB, WS_KM = 378 * MiB, WS_OGLA = 443 * MiB, WS_AQ = 41 * MiB, WS_EL = 74 * MiB;
constexpr size_t WS_SEND = 77 * MiB, WS_DSUM = 93 * MiB;
constexpr size_t WS_TP = 4 * MiB, WS_HALO = 378 * MiB;
constexpr size_t WS_QR = 216 * MiB, WS_KR = 281 * MiB, WS_VR = 298 * MiB;
constexpr int SKV = SEQ + CTXL;
constexpr int LDS_BYTES = 155648;
enum { OP_MOD, OP_PREP, OP_GEMM_IN, OP_DNSCAN, OP_DNREDO, OP_GEMM_Z, OP_GEMM_OUT, OP_NORM2, OP_FFN1, OP_FFN2, OP_GLAPREP, OP_GLASCAN, OP_GLAGATE, OP_QKROPE, OP_ATTN, OP_DNHALO, OP_DNCONV, OP_DNT, OP_GLASTATE };

struct Args { const float* in[25]; float* out; unsigned char* ws; int ph_lo, ph_hi; };

__device__ __forceinline__ float wave_sum(float v) {
#pragma unroll
    for (int o = 1; o < 64; o <<= 1) v += __shfl_xor(v, o);
    return v;
}
__device__ __forceinline__ float softplus_f(float x) { return x > 20.f ? x : log1pf(__expf(x)); }
__device__ __forceinline__ float logsigmoid_f(float x) { return fminf(x, 0.f) - log1pf(__expf(-fabsf(x))); }
__device__ __forceinline__ bf16_t f2bf(float f) { return (bf16_t)(cvtpk_s(f, 0.f) & 0xffffu); }
__device__ __forceinline__ float bf2f(bf16_t v) { return __builtin_bit_cast(float, (unsigned)v << 16); }

__device__ __forceinline__ void transpose_item(const float* W, int ldw, int c0, int ncols, int K, bf16_t* WT, int row_off, LAS float* scr, int item, int lane) {
    const int nblk = ncols / 32, kb = item / nblk, nb = item % nblk, k0 = 64 * kb, n0 = 32 * nb;
    {
        const int kr = lane >> 3, n4 = 4 * (lane & 7); f32x4 v[8];
#pragma unroll
        for (int i = 0; i < 8; ++i) v[i] = *(const f32x4*)(W + (size_t)(k0 + kr + 8 * i) * ldw + c0 + n0 + n4);
#pragma unroll
        for (int i = 0; i < 8; ++i) { LAS float* d = scr + (kr + 8 * i) * 33 + n4; d[0] = v[i][0]; d[1] = v[i][1]; d[2] = v[i][2]; d[3] = v[i][3]; }
    }
    asm volatile("s_waitcnt lgkmcnt(0)" ::: "memory");
    const int c = lane & 7;
#pragma unroll
    for (int j = 0; j < 4; ++j) { const int n = (lane >> 3) + 8 * j; const LAS float* s = scr + (8 * c) * 33 + n;
        u32x4 o; o.x = cvtpk_s(s[0 * 33], s[1 * 33]); o.y = cvtpk_s(s[2 * 33], s[3 * 33]); o.z = cvtpk_s(s[4 * 33], s[5 * 33]); o.w = cvtpk_s(s[6 * 33], s[7 * 33]);
        *(u32x4*)(WT + (size_t)(row_off + n0 + n) * K + k0 + 8 * c) = o; }
    asm volatile("s_waitcnt lgkmcnt(0)" ::: "memory");
}
__device__ __forceinline__ void transpose_mat(const float* W, int ldw, int c0, int ncols, int K, bf16_t* WT, int row_off, LAS float* scr, int gw, int NGW, int lane) {
    const int nitems = (K / 64) * (ncols / 32);
    for (int it = gw; it < nitems; it += NGW) transpose_item(W, ldw, c0, ncols, K, WT, row_off, scr, it, lane);
}
__device__ __forceinline__ void normmod_rows(const float* xl, const float* xc, const float* g, const float* modl, int sidx, bf16_t* H, int gw, int NGW, int lane,
                                             const float* part = nullptr, const float* pgate = nullptr, float* ctx_dst = nullptr, int pns = 4) {
    for (int row0 = gw; row0 < MROWS; row0 += 2 * NGW) {
        const int row1 = row0 + NGW; const bool has1 = row1 < MROWS; const int rows[2] = {row0, has1 ? row1 : row0};
        f32x4 v[2][4]; float ss[2] = {0.f, 0.f};
#pragma unroll
        for (int q = 0; q < 2; ++q) { const int row = rows[q]; const float* xr = row < NLAT ? xl + (size_t)row * DM : xc + (size_t)(row - NLAT) * DM;
#pragma unroll
            for (int j = 0; j < 4; ++j) v[q][j] = *(const f32x4*)(xr + 4 * lane + 256 * j);
            if (part && row >= NLAT) {
#pragma unroll
                for (int j = 0; j < 4; ++j) { const int c = 4 * lane + 256 * j; const size_t po = (size_t)(row - NLAT) * 1024 + c;
                    f32x4 ps = *(const f32x4*)(part + po);
#pragma unroll
                    for (int sl_ = 1; sl_ < 8; ++sl_) if (sl_ < pns) ps += *(const f32x4*)(part + po + (size_t)sl_ * 512 * 1024);
                    v[q][j] = v[q][j] + *(const f32x4*)(pgate + c) * ps;
                    if (!(q == 1 && !has1)) *(f32x4*)(ctx_dst + (size_t)(row - NLAT) * 1024 + c) = v[q][j]; }
            } }
#pragma unroll
        for (int q = 0; q < 2; ++q)
#pragma unroll
            for (int j = 0; j < 4; ++j) ss[q] += (v[q][j][0] * v[q][j][0] + v[q][j][1] * v[q][j][1]) + (v[q][j][2] * v[q][j][2] + v[q][j][3] * v[q][j][3]);
#pragma unroll
        for (int q = 0; q < 2; ++q) {
            if (q == 1 && !has1) break;
            const int row = rows[q]; const int mi = row < SEQ ? 0 : (row < NLAT ? 1 : 2);
            const float* sh = modl + (size_t)mi * 6144 + (size_t)sidx * 1024; const float* sc = sh + 1024;
            const float rinv = rsqrtf(wave_sum(ss[q]) * (1.f / DM) + EPS);
#pragma unroll
            for (int j = 0; j < 4; ++j) { const int c = 4 * lane + 256 * j; const f32x4 gg = *(const f32x4*)(g + c), s1 = *(const f32x4*)(sc + c), s0 = *(const f32x4*)(sh + c);
                f32x4 y;
#pragma unroll
                for (int e = 0; e < 4; ++e) y[e] = v[q][j][e] * rinv * gg[e] * (1.f + s1[e]) + s0[e];
                u32x2 w; w.x = cvtpk_s(y[0], y[1]); w.y = cvtpk_s(y[2], y[3]); *(u32x2*)(H + (size_t)row * DM + c) = w; }
        }
    }
}
#define BAR_LDS() do { asm volatile("s_waitcnt lgkmcnt(0)" ::: "memory"); __builtin_amdgcn_s_barrier(); asm volatile("" ::: "memory"); } while (0)
__device__ __forceinline__ int crow(int x, int h) { return (x & 3) + 8 * (x >> 2) + 4 * h; }
#define MFMA32(a, b, c) __builtin_amdgcn_mfma_f32_32x32x16_bf16((a), (b), (c), 0, 0, 0)
__device__ __forceinline__ bf16x8 frag_nat(const LAS bf16_t* img, int LD, int row, int ks, int h) { return *(const LAS bf16x8*)(img + row * LD + 16 * ks + 8 * h); }
__device__ __forceinline__ bf16x8 frag_perm(const LAS bf16_t* img, int LD, int row, int ks, int h) {
    const s16x4 lo = *(const LAS s16x4*)(img + row * LD + 16 * ks + 4 * h), hi = *(const LAS s16x4*)(img + row * LD + 16 * ks + 8 + 4 * h);
    return __builtin_shufflevector(lo, hi, 0, 1, 2, 3, 4, 5, 6, 7);
}
__device__ __forceinline__ s16x4 tr4(const LAS bf16_t* p) { return __builtin_bit_cast(s16x4, __builtin_amdgcn_ds_read_tr16_b64_v4i16((LAS s16x4*)p)); }
__device__ __forceinline__ bf16x8 frag_tr(const LAS bf16_t* img, int LD, int m0, int ks, int lane) {
    const int i16 = lane & 15, q = i16 >> 2, p = i16 & 3, blk = (lane >> 4) & 1, h = lane >> 5;
    const LAS bf16_t* a = img + (16 * ks + 4 * h + q) * LD + m0 + 16 * blk + 4 * p;
    const s16x4 lo = tr4(a), hi = tr4(a + 8 * LD);
    return __builtin_shufflevector(lo, hi, 0, 1, 2, 3, 4, 5, 6, 7);
}
__device__ __forceinline__ bf16x8 pack_step(const f32x16& x, int s) {
    u32x4 p; p.x = cvtpk_s(x[8 * s + 0], x[8 * s + 1]); p.y = cvtpk_s(x[8 * s + 2], x[8 * s + 3]); p.z = cvtpk_s(x[8 * s + 4], x[8 * s + 5]); p.w = cvtpk_s(x[8 * s + 6], x[8 * s + 7]);
    return __builtin_bit_cast(bf16x8, p);
}
__device__ __forceinline__ void dn_halo_phase(const bf16_t* P, bf16_t* HALO, int G) {
    const int tid = opaque_tid();
    for (size_t e = (size_t)blockIdx.x * 512 + tid; e < (size_t)520 * 4 * 512; e += (size_t)G * 512) {
        const int c = (int)(e & 511), j = (int)((e >> 9) & 3), rb = (int)(e >> 11);
        const int row = rb * 64 + (j < 2 ? j : 60 + j);
        ((u32x4*)(HALO + ((size_t)rb * 4 + j) * 4096))[c] = ((const u32x4*)(P + (size_t)row * 4096))[c];
    }
}
__device__ __forceinline__ void unpack8(const u32x4 v, float (&f)[8]) { f[0] = bf_lo(v.x); f[1] = bf_hi(v.x); f[2] = bf_lo(v.y); f[3] = bf_hi(v.y); f[4] = bf_lo(v.z); f[5] = bf_hi(v.z); f[6] = bf_lo(v.w); f[7] = bf_hi(v.w); }
__device__ __forceinline__ void dn_conv_phase(bf16_t* P, const bf16_t* HALO, const float* conv_w, int G) {
    const int tid = opaque_tid(), col0 = 8 * tid;
    float cw[8][5];
#pragma unroll
    for (int c = 0; c < 8; ++c)
#pragma unroll
        for (int tap = 0; tap < 5; ++tap) cw[c][tap] = conv_w[(size_t)(col0 + c) * 5 + tap];
    const int kind = col0 < 1024 ? 0 : (col0 < 2048 ? 1 : 2);
    for (int rb = blockIdx.x; rb < 520; rb += G) {
        const int cs = rb < 512 ? (rb & 255) : ((rb - 512) & 3); const bool sfirst = cs == 0, slast = rb < 512 ? cs == 255 : cs == 3;
        const u32x4 zero = (u32x4){0u, 0u, 0u, 0u};
        bf16_t* base = P + (size_t)rb * 64 * 4096 + col0;
        u32x4 w0 = sfirst ? zero : *(const u32x4*)(HALO + ((size_t)(rb - 1) * 4 + 2) * 4096 + col0);
        u32x4 w1 = sfirst ? zero : *(const u32x4*)(HALO + ((size_t)(rb - 1) * 4 + 3) * 4096 + col0);
        u32x4 w2 = *(const u32x4*)(base), w3 = *(const u32x4*)(base + 4096);
#pragma unroll 4
        for (int rr = 0; rr < 64; ++rr) {
            u32x4 w4;
            if (rr + 2 < 64) w4 = *(const u32x4*)(base + (size_t)(rr + 2) * 4096);
            else w4 = slast ? zero : *(const u32x4*)(HALO + ((size_t)(rb + 1) * 4 + (rr + 2 - 64)) * 4096 + col0);
            float x0[8], x1[8], x2[8], x3[8], x4[8], y[8];
            unpack8(w0, x0); unpack8(w1, x1); unpack8(w2, x2); unpack8(w3, x3); unpack8(w4, x4);
            float ss = 0.f;
#pragma unroll
            for (int c = 0; c < 8; ++c) { const float a = x0[c] * cw[c][0] + x1[c] * cw[c][1] + x2[c] * cw[c][2] + x3[c] * cw[c][3] + x4[c] * cw[c][4]; y[c] = silu_f(a); ss += y[c] * y[c]; }
            float sc = 1.f;
            if (kind < 2) { ss += __shfl_xor(ss, 1); ss += __shfl_xor(ss, 2); ss += __shfl_xor(ss, 4); ss += __shfl_xor(ss, 8); sc = rsqrtf(ss + EPS) * (kind == 0 ? 0.08838834764831845f : 1.f); }
            u32x4 o; o.x = cvtpk_s(y[0] * sc, y[1] * sc); o.y = cvtpk_s(y[2] * sc, y[3] * sc); o.z = cvtpk_s(y[4] * sc, y[5] * sc); o.w = cvtpk_s(y[6] * sc, y[7] * sc);
            *(u32x4*)(base + (size_t)rr * 4096) = o;
            w0 = w1; w1 = w2; w2 = w3; w3 = w4;
        }
    }
}
constexpr int DT_KB = 0, DT_R = 17408, DT_SC = 33792, DT_DIR = 34816;
template <int W> __device__ __forceinline__ void dn_solve(const LAS float* Mf, float (&t)[16], int lane) {
    const int j = 16 * W + (lane >> 2), q = lane & 3;
#pragma unroll
    for (int s = 0; s < 16; ++s) t[s] = 0.f;
#pragma unroll
    for (int i = 16 * W; i < 64; ++i) {
        float acc = 0.f;
#pragma unroll
        for (int s = 4 * W; s <= (i - 1) / 4 && i > 16 * W; ++s) acc += Mf[i * 64 + 4 * s + q] * t[s];
        acc += __shfl_xor(acc, 1); acc += __shfl_xor(acc, 2);
        const float val = (i == j ? 1.f : 0.f) - acc;
        if (q == (i & 3)) t[i >> 2] = val;
        asm volatile("" : "+v"(t[0]), "+v"(t[1]), "+v"(t[2]), "+v"(t[3]), "+v"(t[4]), "+v"(t[5]), "+v"(t[6]), "+v"(t[7]), "+v"(t[8]), "+v"(t[9]), "+v"(t[10]), "+v"(t[11]), "+v"(t[12]), "+v"(t[13]), "+v"(t[14]), "+v"(t[15]));
    }
}
__device__ __forceinline__ void dn_t_phase(LAS unsigned char* lds, const bf16_t* P, float* AB, bf16_t* TP, const float* a_log, const float* dt_bias, int G) {
    const int tid0 = opaque_tid(), hb = __builtin_amdgcn_readfirstlane(tid0 >> 8);
    u32x4 pk4[4]; float pav = 0.f, pbv = 0.f;
    {
        const int it = blockIdx.x * 2 + hb;
        if (it < 16640) { const int dir = it & 1, vh = (it >> 1) & 15, rb = it >> 5, kh = vh >> 1, t = tid0 & 255, r0 = t >> 4, c8 = 8 * (t & 15);
#pragma unroll
            for (int v = 0; v < 4; ++v) pk4[v] = *(const u32x4*)(P + (size_t)(rb * 64 + r0 + 16 * v) * 4096 + 1024 + kh * 128 + c8);
            const int ti = dir ? 63 - (t & 63) : (t & 63); const float* ab = AB + (size_t)(rb * 64 + ti) * 64; pav = ab[dir * 16 + vh]; pbv = ab[32 + dir * 16 + vh]; }
    }
    for (int itb = blockIdx.x * 2; itb < 16640; itb += 2 * G) {
        const int it = itb + hb, dir = it & 1, vh = (it >> 1) & 15, rb = it >> 5, kh = vh >> 1;
        const int tq = opaque_tid(), t = tq & 255, w = __builtin_amdgcn_readfirstlane((tq >> 6) & 3), lane = tq & 63, r = lane & 31, h = lane >> 5;
        LAS unsigned char* base = lds + hb * DT_DIR;
        LAS bf16_t* Kb = (LAS bf16_t*)(base + DT_KB); LAS float* Mf = (LAS float*)(base + DT_R); LAS bf16_t* Tb = (LAS bf16_t*)(base + DT_R);
        LAS float* sc_beta = (LAS float*)(base + DT_SC); LAS float* sc_gc = sc_beta + 64;
        {
            const int r0 = t >> 4, c8 = 8 * (t & 15);
#pragma unroll
            for (int v = 0; v < 4; ++v) { const int i = r0 + 16 * v, ip = dir ? 63 - i : i;
                *(LAS u32x4*)(Kb + ip * 136 + c8) = pk4[v]; }
            if (t < 64) {
                const int ti = dir ? 63 - t : t; float* ab = AB + (size_t)(rb * 64 + ti) * 64;
                const float av = pav, bv = pbv;
                const float g = -__expf(a_log[dir * 16 + vh]) * softplus_f(av + dt_bias[dir * 16 + vh]), beta = 1.f / (1.f + __expf(-bv));
                float gc = g;
#pragma unroll
                for (int o = 1; o < 64; o <<= 1) { const float up = __shfl_up(gc, o); if (t >= o) gc += up; }
                sc_beta[t] = beta; sc_gc[t] = gc;
                ab[dir * 16 + vh] = gc; ab[32 + dir * 16 + vh] = beta;
            }
        }
        BAR_LDS();
        {
            const int itn = it + 2 * G;
            if (itn < 16640) { const int dirn = itn & 1, vhn = (itn >> 1) & 15, rbn = itn >> 5, khn = vhn >> 1, r0 = t >> 4, c8 = 8 * (t & 15);
#pragma unroll
                for (int v = 0; v < 4; ++v) pk4[v] = *(const u32x4*)(P + (size_t)(rbn * 64 + r0 + 16 * v) * 4096 + 1024 + khn * 128 + c8);
                const int tin = dirn ? 63 - (t & 63) : (t & 63); const float* abn = AB + (size_t)(rbn * 64 + tin) * 64; pav = abn[dirn * 16 + vhn]; pbv = abn[32 + dirn * 16 + vhn]; }
        }
        const int ti = w >> 1, tj = w & 1;
        {
            f32x16 acc;
#pragma unroll
            for (int x = 0; x < 16; ++x) acc[x] = 0.f;
            if (!(ti == 0 && tj == 1)) {
#pragma unroll
                for (int ks = 0; ks < 8; ++ks) acc = MFMA32(frag_nat(Kb, 136, 32 * ti + r, ks, h), frag_nat(Kb, 136, 32 * tj + r, ks, h), acc);
            }
            const int j = 32 * tj + r; const float gj = sc_gc[j];
#pragma unroll
            for (int x = 0; x < 16; ++x) { const int i = 32 * ti + crow(x, h);
                Mf[i * 64 + j] = (i > j) ? sc_beta[i] * acc[x] * __expf(sc_gc[i] - gj) : 0.f; }
        }
        BAR_LDS();
        float tc[16];
        if (w == 0) dn_solve<0>(Mf, tc, lane); else if (w == 1) dn_solve<1>(Mf, tc, lane); else if (w == 2) dn_solve<2>(Mf, tc, lane); else dn_solve<3>(Mf, tc, lane);
        BAR_LDS();
        {
            const int j = 16 * w + (lane >> 2), q = lane & 3;
#pragma unroll
            for (int s = 0; s < 16; ++s) Tb[(4 * s + q) * 72 + j] = f2bf(tc[s]);
        }
        BAR_LDS();
        {
            bf16_t* dst = TP + (size_t)it * 3072;
#pragma unroll
            for (int k2 = 0; k2 < 2; ++k2) { const int c = t + 256 * k2;
                if (c < 384) { const int blk = c >> 7, rowc = (c & 127) >> 2, cc = c & 3, br = blk ? 1 : 0, bc = blk == 2 ? 1 : 0;
                    *(u32x4*)(dst + c * 8) = *(const LAS u32x4*)(Tb + (32 * br + rowc) * 72 + 32 * bc + 8 * cc); } }
        }
        BAR_LDS();
    }
}
constexpr int DN_KB = 0, DN_QB = 17408, DN_VB = 34816, DN_TB = 51200, DN_AB = 60416, DN_SC = 69632, DN_DIR = 71168;
__device__ __forceinline__ void dn_step_rb(int step, int dir, int b, int& rb, bool& first) {
    if (step < 4) { const int cidx = dir ? 3 - step : step; rb = 512 + b * 4 + cidx; first = step < 2; }
    else { const int c = step - 4; const int cidx = dir ? 255 - c : c; rb = b * 256 + cidx; first = c < 128; }
}
struct DnPre { u32x4 k4[4], q4[4], v4[4], t0, t1; float gc, beta; };
__device__ __forceinline__ void dn_prefetch(DnPre& p, const bf16_t* P, const float* AB, const bf16_t* TP, int rb, int dir, int vh, int kh, int t, int part) {
    const int r0 = t >> 4, c8 = 8 * (t & 15);
    const bf16_t* prow = P + (size_t)(rb * 64 + r0) * 4096 + c8;
    const bf16_t* tp = TP + (size_t)((rb * 16 + vh) * 2 + dir) * 3072;
    if (part & 1) {
#pragma unroll
        for (int v = 0; v < 4; ++v) { const bf16_t* pr = prow + (size_t)(16 * v) * 4096;
            p.k4[v] = *(const u32x4*)(pr + 1024 + kh * 128); p.q4[v] = *(const u32x4*)(pr + kh * 128); p.v4[v] = *(const u32x4*)(pr + 2048 + vh * 128); }
    }
    if (part & 2) {
        p.t0 = *(const u32x4*)(tp + t * 8); p.t1 = *(const u32x4*)(tp + (256 + (t & 127)) * 8);
        const int ti = dir ? 63 - (t & 63) : (t & 63); const float* ab = AB + (size_t)(rb * 64 + ti) * 64; p.gc = ab[dir * 16 + vh]; p.beta = ab[32 + dir * 16 + vh];
    }
}
template <int VAR> __device__ __forceinline__ void dn_scan(LAS unsigned char* lds, const bf16_t* P, const float* AB, const bf16_t* TP, bf16_t* OB) {
    const int tid = opaque_tid(), dir = __builtin_amdgcn_readfirstlane(tid >> 8);
    for (int unit = blockIdx.x; unit < 32; unit += gridDim.x) {
        const int b = unit >> 4, vh = unit & 15, kh = vh >> 1;
        f32x16 S[4];
#pragma unroll
        for (int kt = 0; kt < 4; ++kt)
#pragma unroll
            for (int x = 0; x < 16; ++x) S[kt][x] = 0.f;
        DnPre pre;
        { int rb0; bool f0; dn_step_rb(0, dir, b, rb0, f0); dn_prefetch(pre, P, AB, TP, rb0, dir, vh, kh, tid & 255, 3); }
        __syncthreads();
        for (int step = 0; step < 260; ++step) {
            const int w = __builtin_amdgcn_readfirstlane((opaque_tid() >> 6) & 3);
            LAS unsigned char* base = lds + dir * DN_DIR;
            LAS bf16_t* Kb = (LAS bf16_t*)(base + DN_KB); LAS bf16_t* Qb = (LAS bf16_t*)(base + DN_QB); LAS bf16_t* Vb = (LAS bf16_t*)(base + DN_VB);
            LAS bf16_t* Tb = (LAS bf16_t*)(base + DN_TB); LAS bf16_t* Ab = (LAS bf16_t*)(base + DN_AB);
            LAS float* sc_beta = (LAS float*)(base + DN_SC); LAS float* sc_gc = sc_beta + 64; LAS float* sc_eg = sc_beta + 128; LAS float* sc_tail = sc_beta + 192; LAS float* sc_dl = sc_beta + 256;
            int rb; bool first; dn_step_rb(step, dir, b, rb, first);
            const int row_base = rb * 64;
            {
                const int tq_ = opaque_tid(), t = tq_ & 255;
                const int r0 = t >> 4, c8 = 8 * (t & 15);
#pragma unroll
                for (int v = 0; v < 4; ++v) { const int i = r0 + 16 * v, ip = dir ? 63 - i : i;
                    *(LAS u32x4*)(Kb + ip * 136 + c8) = pre.k4[v]; *(LAS u32x4*)(Qb + ip * 136 + c8) = pre.q4[v]; *(LAS u32x4*)(Vb + ip * 128 + c8) = pre.v4[v]; }
                { const int c = t, blk = c >> 7, rowc = (c & 127) >> 2, cc = c & 3, br = blk ? 1 : 0; *(LAS u32x4*)(Tb + (32 * br + rowc) * 72 + 8 * cc) = pre.t0; }
                if (t < 128) { const int rowc = t >> 2, cc = t & 3; *(LAS u32x4*)(Tb + (32 + rowc) * 72 + 32 + 8 * cc) = pre.t1; }
                if (t < 64) { const float gc = pre.gc, gl = __shfl(gc, 63); sc_beta[t] = pre.beta; sc_gc[t] = gc; sc_eg[t] = __expf(gc); sc_tail[t] = __expf(gl - gc); if (t == 0) sc_dl[0] = __expf(gl); }
            }
            BAR_LDS();
            {
                const int tq_ = opaque_tid(), lane = tq_ & 63, r = lane & 31, h = lane >> 5;
                const int ti = w >> 1, tj = w & 1;
                if (!(ti == 0 && tj == 1)) {
                    f32x16 qk;
#pragma unroll
                    for (int x = 0; x < 16; ++x) qk[x] = 0.f;
#pragma unroll
                    for (int ks = 0; ks < 8; ++ks) qk = MFMA32(frag_nat(Qb, 136, 32 * ti + r, ks, h), frag_nat(Kb, 136, 32 * tj + r, ks, h), qk);
                    const int jj = 32 * tj + r; const float gj = sc_gc[jj];
#pragma unroll
                    for (int x = 0; x < 16; ++x) { const int i = 32 * ti + crow(x, h);
                        Ab[i * 72 + jj] = f2bf((i >= jj) ? qk[x] * __expf(sc_gc[i] - gj) : 0.f); }
                }
            }
            BAR_LDS();
            if (VAR != 2 && step + 1 < 260) { int rbn; bool fn; dn_step_rb(step + 1, dir, b, rbn, fn); dn_prefetch(pre, P, AB, TP, rbn, dir, vh, kh, opaque_tid() & 255, 1); }
            __builtin_amdgcn_sched_barrier(0);
            if (VAR != 1) {
                const int tq_ = opaque_tid(), lane = tq_ & 63, r = lane & 31, h = lane >> 5;
                f32x16 KS[2], QS[2];
#pragma unroll
                for (int mt = 0; mt < 2; ++mt)
#pragma unroll
                    for (int x = 0; x < 16; ++x) { KS[mt][x] = 0.f; QS[mt][x] = 0.f; }
#pragma unroll
                for (int ks = 0; ks < 8; ++ks) {
                    const bf16x8 sp = pack_step(S[ks >> 1], ks & 1);
#pragma unroll
                    for (int mt = 0; mt < 2; ++mt) { KS[mt] = MFMA32(frag_perm(Kb, 136, 32 * mt + r, ks, h), sp, KS[mt]); QS[mt] = MFMA32(frag_perm(Qb, 136, 32 * mt + r, ks, h), sp, QS[mt]); }
                    if (ks & 1) __builtin_amdgcn_sched_barrier(0);
                }
#pragma unroll
                for (int mt = 0; mt < 2; ++mt)
#pragma unroll
                    for (int x = 0; x < 16; ++x) { const int i = 32 * mt + crow(x, h);
                        KS[mt][x] = sc_beta[i] * (bf2f(Vb[i * 128 + 32 * w + r]) - sc_eg[i] * KS[mt][x]); }
                __builtin_amdgcn_sched_barrier(0);
                bf16x8 Xp[4];
#pragma unroll
                for (int ks = 0; ks < 4; ++ks) Xp[ks] = pack_step(KS[ks >> 1], ks & 1);
                f32x16 VN[2];
#pragma unroll
                for (int mt = 0; mt < 2; ++mt) {
#pragma unroll
                    for (int x = 0; x < 16; ++x) VN[mt][x] = 0.f;
#pragma unroll
                    for (int ks = 0; ks < 4; ++ks) if (ks < 2 * mt + 2) VN[mt] = MFMA32(frag_perm(Tb, 72, 32 * mt + r, ks, h), Xp[ks], VN[mt]);
                }
                __builtin_amdgcn_sched_barrier(0);
                if (VAR != 2 && step + 1 < 260) { int rbn; bool fn; dn_step_rb(step + 1, dir, b, rbn, fn); dn_prefetch(pre, P, AB, TP, rbn, dir, vh, kh, opaque_tid() & 255, 2); }
                __builtin_amdgcn_sched_barrier(0);
                bf16x8 VNp[4];
#pragma unroll
                for (int ks = 0; ks < 4; ++ks) VNp[ks] = pack_step(VN[ks >> 1], ks & 1);
#pragma unroll
                for (int mt = 0; mt < 2; ++mt) {
#pragma unroll
                    for (int x = 0; x < 16; ++x) QS[mt][x] *= sc_eg[32 * mt + crow(x, h)];
#pragma unroll
                    for (int ks = 0; ks < 4; ++ks) if (ks < 2 * mt + 2) QS[mt] = MFMA32(frag_perm(Ab, 72, 32 * mt + r, ks, h), VNp[ks], QS[mt]);
                }
                __builtin_amdgcn_sched_barrier(0);
#pragma unroll
                for (int mt = 0; mt < 2; ++mt)
#pragma unroll
                    for (int x = 0; x < 16; ++x) Vb[(32 * mt + crow(x, h)) * 128 + 32 * w + r] = f2bf(QS[mt][x]);
                __builtin_amdgcn_sched_barrier(0);
#pragma unroll
                for (int mt = 0; mt < 2; ++mt)
#pragma unroll
                    for (int x = 0; x < 16; ++x) VN[mt][x] *= sc_tail[32 * mt + crow(x, h)];
#pragma unroll
                for (int ks = 0; ks < 4; ++ks) VNp[ks] = pack_step(VN[ks >> 1], ks & 1);
                __builtin_amdgcn_sched_barrier(0);
                const float dl = sc_dl[0];
#pragma unroll
                for (int kt = 0; kt < 4; ++kt)
#pragma unroll
                    for (int x = 0; x < 16; ++x) S[kt][x] *= dl;
#pragma unroll
                for (int ks = 0; ks < 4; ++ks) {
#pragma unroll
                    for (int kt = 0; kt < 4; ++kt) S[kt] = MFMA32(frag_tr(Kb, 136, 32 * kt, ks, lane), VNp[ks], S[kt]);
                    __builtin_amdgcn_sched_barrier(0);
                }
                if (VAR != 2) {
                    const int rr_ = lane >> 2, c8_ = 8 * (lane & 3);
#pragma unroll
                    for (int v = 0; v < 4; ++v) { const int ip_ = rr_ + 16 * v, i_ = dir ? 63 - ip_ : ip_;
                        u32x4* gp_ = (u32x4*)(OB + (size_t)(row_base + i_) * 2048 + vh * 128 + 32 * w + c8_);
                        u32x4 o = *(const LAS u32x4*)(Vb + ip_ * 128 + 32 * w + c8_);
                        if (!first) { const u32x4 e = gp_[0];
                            o.x = cvtpk_s(bf_lo(o.x) + bf_lo(e.x), bf_hi(o.x) + bf_hi(e.x)); o.y = cvtpk_s(bf_lo(o.y) + bf_lo(e.y), bf_hi(o.y) + bf_hi(e.y));
                            o.z = cvtpk_s(bf_lo(o.z) + bf_lo(e.z), bf_hi(o.z) + bf_hi(e.z)); o.w = cvtpk_s(bf_lo(o.w) + bf_lo(e.w), bf_hi(o.w) + bf_hi(e.w)); }
                        gp_[0] = o; }
                }
            }
            if (step == 1 || step == 131) asm volatile("s_waitcnt vmcnt(0)" ::: "memory");
            BAR_LDS();
        }
    }
}
constexpr int GP_QM = 0, GP_KM = 17408, GP_AB = 34816, GP_LOW = 44032, GP_TOT = 48128, GP_DIR = 49152;
__device__ __forceinline__ void gla_prep_phase(LAS unsigned char* lds, const bf16_t* P, const float* LOW, const float* gw2, const float* gb2, bf16_t* QM, bf16_t* KM, bf16_t* AQ, float* EL, int G) {
    const int tid0 = opaque_tid(), hb = __builtin_amdgcn_readfirstlane(tid0 >> 8);
    for (int itb = blockIdx.x * 2; itb < 4160; itb += 2 * G) {
        const int it = itb + hb, dir = it & 1, head = (it >> 1) & 3, rb = it >> 3;
        const int tq = opaque_tid(), t = tq & 255, w = __builtin_amdgcn_readfirstlane((tq >> 6) & 3), lane = tq & 63, r = lane & 31, h = lane >> 5;
        LAS unsigned char* base = lds + hb * GP_DIR;
        LAS bf16_t* Qm = (LAS bf16_t*)(base + GP_QM); LAS bf16_t* Km = (LAS bf16_t*)(base + GP_KM); LAS bf16_t* Ab = (LAS bf16_t*)(base + GP_AB);
        LAS float* lowS = (LAS float*)(base + GP_LOW); LAS float* tot = (LAS float*)(base + GP_TOT);
        *(LAS f32x4*)(lowS + 4 * t) = *(const f32x4*)(LOW + (size_t)(rb * 64 + (t >> 2)) * 32 + dir * 16 + 4 * (t & 3));
        const int dk = t & 127, half = t >> 7, col = head * 128 + dk;
        float w2c[16];
#pragma unroll
        for (int rr = 0; rr < 16; ++rr) w2c[rr] = gw2[(size_t)(dir * 16 + rr) * 512 + col];
        const float b2 = gb2[dir * 512 + col];
        __syncthreads();
        float bc[32]; float run = 0.f;
#pragma unroll
        for (int n = 0; n < 32; ++n) { const int ip = 32 * half + n, i = dir ? 63 - ip : ip; float s = b2;
#pragma unroll
            for (int rr = 0; rr < 16; ++rr) s += lowS[i * 16 + rr] * w2c[rr];
            run += logsigmoid_f(s) * (1.f / 16.f); bc[n] = run; }
        tot[half * 128 + dk] = run;
        __syncthreads();
        const float t0 = tot[dk], last = t0 + tot[128 + dk], off = half ? t0 : 0.f;
        if (half == 0) EL[(size_t)(dir * 520 + rb) * 512 + col] = last;
        {
            const int i0 = dir ? 63 - 32 * half : 32 * half; const long pstep = dir ? -3072 : 3072;
            const bf16_t* pp = P + (size_t)(rb * 64 + i0) * 3072 + col;
#pragma unroll
            for (int n = 0; n < 32; ++n) { const int ip = 32 * half + n; const float bcv = bc[n] + off;
                const float qv = bf2f(pp[0]), kv = bf2f(pp[512]); pp += pstep;
                Qm[ip * 136 + dk] = f2bf(qv * 0.08838834764831845f * __expf(bcv - last));
                Km[ip * 136 + dk] = f2bf(kv * __expf(last - bcv)); }
        }
        __syncthreads();
        {
            const int ti = w >> 1, tj = w & 1;
            f32x16 acc;
#pragma unroll
            for (int x = 0; x < 16; ++x) acc[x] = 0.f;
            if (!(ti == 0 && tj == 1)) {
#pragma unroll
                for (int ks = 0; ks < 8; ++ks) acc = MFMA32(frag_nat(Qm, 136, 32 * ti + r, ks, h), frag_nat(Km, 136, 32 * tj + r, ks, h), acc);
            }
            const int j = 32 * tj + r;
#pragma unroll
            for (int x = 0; x < 16; ++x) { const int i = 32 * ti + crow(x, h); Ab[i * 72 + j] = f2bf(i >= j ? acc[x] : 0.f); }
            const int r0 = t >> 4, c8 = 8 * (t & 15);
#pragma unroll
            for (int v = 0; v < 4; ++v) { const int row = r0 + 16 * v; const size_t go = ((size_t)dir * MROWS + rb * 64 + row) * 512 + head * 128 + c8;
                *(u32x4*)(QM + go) = *(const LAS u32x4*)(Qm + row * 136 + c8); *(u32x4*)(KM + go) = *(const LAS u32x4*)(Km + row * 136 + c8); }
        }
        __syncthreads();
        {
            bf16_t* dst = AQ + (size_t)it * 4096;
#pragma unroll
            for (int k2 = 0; k2 < 2; ++k2) { const int c = t + 256 * k2, row = c >> 3, cc = c & 7; *(u32x4*)(dst + c * 8) = *(const LAS u32x4*)(Ab + row * 72 + 8 * cc); }
        }
        __syncthreads();
    }
}
constexpr int GL_QM = 0, GL_KM = 17408, GL_VB = 34816, GL_AB = 52224, GL_EL = 61440, GL_DIR = 61952;
struct GlPre { u32x4 q4[4], k4[4], v4[4], a0, a1; float elv; };
__device__ __forceinline__ void gl_prefetch(GlPre& p, const bf16_t* P, const bf16_t* QM, const bf16_t* KM, const bf16_t* AQ, const float* EL, int rb, int dir, int head, int hf, int t) {
    const int r0 = t >> 4, c8 = 8 * (t & 15);
    const bf16_t* aq = AQ + (size_t)((rb * 4 + head) * 2 + dir) * 4096;
#pragma unroll
    for (int v = 0; v < 4; ++v) { const size_t row = (size_t)(rb * 64 + r0 + 16 * v);
        p.q4[v] = *(const u32x4*)(QM + ((size_t)dir * MROWS + row) * 512 + head * 128 + c8);
        p.k4[v] = *(const u32x4*)(KM + ((size_t)dir * MROWS + row) * 512 + head * 128 + c8);
        p.v4[v] = *(const u32x4*)(P + row * 3072 + 1024 + head * 256 + hf * 128 + c8); }
    p.a0 = *(const u32x4*)(aq + t * 8); p.a1 = *(const u32x4*)(aq + (256 + t) * 8);
    p.elv = EL[(size_t)(dir * 520 + rb) * 512 + head * 128 + (t & 127)];
}
__device__ __forceinline__ void gla_scan(LAS unsigned char* lds, const bf16_t* P  , const bf16_t* QM, const bf16_t* KM, const bf16_t* AQ, const float* EL, bf16_t* OB  ) {
    const int tid = opaque_tid(), dir = __builtin_amdgcn_readfirstlane(tid >> 8);
    for (int unit = blockIdx.x; unit < 16; unit += gridDim.x) {
        const int b = unit >> 3, head = (unit >> 1) & 3, hf = unit & 1;
        f32x16 S[4];
#pragma unroll
        for (int kt = 0; kt < 4; ++kt)
#pragma unroll
            for (int x = 0; x < 16; ++x) S[kt][x] = 0.f;
        GlPre pre;
        { int rb0; bool f0; dn_step_rb(0, dir, b, rb0, f0); gl_prefetch(pre, P, QM, KM, AQ, EL, rb0, dir, head, hf, tid & 255); }
        __syncthreads();
        for (int step = 0; step < 260; ++step) {
            const int w = __builtin_amdgcn_readfirstlane((opaque_tid() >> 6) & 3);
            LAS unsigned char* base = lds + dir * GL_DIR;
            LAS bf16_t* Qm = (LAS bf16_t*)(base + GL_QM); LAS bf16_t* Km = (LAS bf16_t*)(base + GL_KM); LAS bf16_t* Vb = (LAS bf16_t*)(base + GL_VB); LAS bf16_t* Ab = (LAS bf16_t*)(base + GL_AB);
            LAS float* el = (LAS float*)(base + GL_EL);
            int rb; bool first; dn_step_rb(step, dir, b, rb, first);
            const int row_base = rb * 64;
            {
                const int tq_ = opaque_tid(), t = tq_ & 255;
                const int r0 = t >> 4, c8 = 8 * (t & 15);
#pragma unroll
                for (int v = 0; v < 4; ++v) { const int i = r0 + 16 * v, ip = dir ? 63 - i : i;
                    *(LAS u32x4*)(Qm + i * 136 + c8) = pre.q4[v]; *(LAS u32x4*)(Km + i * 136 + c8) = pre.k4[v]; *(LAS u32x4*)(Vb + ip * 136 + c8) = pre.v4[v]; }
                { const int c = t, row = c >> 3, cc = c & 7; *(LAS u32x4*)(Ab + row * 72 + 8 * cc) = pre.a0; }
                { const int c = 256 + t, row = c >> 3, cc = c & 7; *(LAS u32x4*)(Ab + row * 72 + 8 * cc) = pre.a1; }
                if (t < 128) el[t] = __expf(pre.elv);
            }
            BAR_LDS();
            if (step + 1 < 260) { int rbn; bool fn; dn_step_rb(step + 1, dir, b, rbn, fn); gl_prefetch(pre, P, QM, KM, AQ, EL, rbn, dir, head, hf, opaque_tid() & 255); }
            __builtin_amdgcn_sched_barrier(0);
            {
                const int tq_ = opaque_tid(), lane = tq_ & 63, r = lane & 31, h = lane >> 5;
#pragma unroll
                for (int kt = 0; kt < 4; ++kt)
#pragma unroll
                    for (int x = 0; x < 16; ++x) S[kt][x] *= el[32 * kt + crow(x, h)];
                bf16x8 Vf[4];
#pragma unroll
                for (int ks = 0; ks < 4; ++ks) Vf[ks] = frag_tr(Vb, 136, 32 * w, ks, lane);
                u32x4 eo[4];
                {
                    const int rr_ = lane >> 2, c8_ = 8 * (lane & 3);
                    if (!first) {
#pragma unroll
                        for (int v = 0; v < 4; ++v) { const int ip_ = rr_ + 16 * v, i_ = dir ? 63 - ip_ : ip_;
                            eo[v] = *(const u32x4*)(OB + (size_t)(row_base + i_) * 1024 + head * 256 + hf * 128 + 32 * w + c8_); }
                    } else {
                        unsigned z0 = 0u; asm volatile("" : "+v"(z0));
#pragma unroll
                        for (int v = 0; v < 4; ++v) eo[v] = (u32x4){z0, z0, z0, z0};
                    }
                }
                f32x16 O[2];
#pragma unroll
                for (int mt = 0; mt < 2; ++mt) {
#pragma unroll
                    for (int x = 0; x < 16; ++x) O[mt][x] = 0.f;
#pragma unroll
                    for (int ks = 0; ks < 4; ++ks) if (ks < 2 * mt + 2) O[mt] = MFMA32(frag_perm(Ab, 72, 32 * mt + r, ks, h), Vf[ks], O[mt]);
                }
                __builtin_amdgcn_sched_barrier(0);
#pragma unroll
                for (int ks = 0; ks < 8; ++ks) {
                    const bf16x8 sp = pack_step(S[ks >> 1], ks & 1);
#pragma unroll
                    for (int mt = 0; mt < 2; ++mt) O[mt] = MFMA32(frag_perm(Qm, 136, 32 * mt + r, ks, h), sp, O[mt]);
                    if (ks & 1) __builtin_amdgcn_sched_barrier(0);
                }
#pragma unroll
                for (int mt = 0; mt < 2; ++mt)
#pragma unroll
                    for (int x = 0; x < 16; ++x) Vb[(32 * mt + crow(x, h)) * 136 + 32 * w + r] = f2bf(O[mt][x]);
                __builtin_amdgcn_sched_barrier(0);
#pragma unroll
                for (int ks = 0; ks < 4; ++ks) {
#pragma unroll
                    for (int kt = 0; kt < 4; ++kt) S[kt] = MFMA32(frag_tr(Km, 136, 32 * kt, ks, lane), Vf[ks], S[kt]);
                    __builtin_amdgcn_sched_barrier(0);
                }
                {
                    const int rr_ = lane >> 2, c8_ = 8 * (lane & 3);
#pragma unroll
                    for (int v = 0; v < 4; ++v) { const int ip_ = rr_ + 16 * v, i_ = dir ? 63 - ip_ : ip_;
                        u32x4* gp_ = (u32x4*)(OB + (size_t)(row_base + i_) * 1024 + head * 256 + hf * 128 + 32 * w + c8_);
                        u32x4 o = *(const LAS u32x4*)(Vb + ip_ * 136 + 32 * w + c8_); const u32x4 e = eo[v];
                        if (!first) {
                            o.x = cvtpk_s(bf_lo(o.x) + bf_lo(e.x), bf_hi(o.x) + bf_hi(e.x)); o.y = cvtpk_s(bf_lo(o.y) + bf_lo(e.y), bf_hi(o.y) + bf_hi(e.y));
                            o.z = cvtpk_s(bf_lo(o.z) + bf_lo(e.z), bf_hi(o.z) + bf_hi(e.z)); o.w = cvtpk_s(bf_lo(o.w) + bf_lo(e.w), bf_hi(o.w) + bf_hi(e.w)); }
                        gp_[0] = o; }
                }
            }
            if (step == 1 || step == 131) asm volatile("s_waitcnt vmcnt(0)" ::: "memory");
            BAR_LDS();
        }
    }
}
typedef __bf16 v2bf_t __attribute__((ext_vector_type(2)));
__device__ __forceinline__ void atomic_add_bf16x8(bf16_t* p, const u32x4 v) {
    asm volatile("global_atomic_pk_add_bf16 %0, %1, off sc1\n\tglobal_atomic_pk_add_bf16 %0, %2, off offset:4 sc1\n\tglobal_atomic_pk_add_bf16 %0, %3, off offset:8 sc1\n\tglobal_atomic_pk_add_bf16 %0, %4, off offset:12 sc1"
                 :: "v"(p), "v"(v.x), "v"(v.y), "v"(v.z), "v"(v.w) : "memory");
}
constexpr int DN3_HGC = 2 * DN_DIR;
template <int VAR> __device__ __forceinline__ void dn_scan3(LAS unsigned char* lds, const bf16_t* P, const float* AB, const bf16_t* TP, bf16_t* OB) {
    const int tid0 = opaque_tid(), wv = __builtin_amdgcn_readfirstlane(tid0 >> 6), role = wv >> 2, w = wv & 3;
    for (int unit = blockIdx.x; unit < 64; unit += gridDim.x) {
        const int b = unit >> 5, vh = (unit >> 1) & 15, dir = unit & 1, kh = vh >> 1;
        __syncthreads();
        if (role == 1) {
            if (w < 3) {
                const int qh = w >= 1 ? 1 : 0, khh = w == 2 ? 1 : 0, ti = qh, tj = khh;
                u32x4 q8[8], k8[8]; float gcp;
                {
                    int rb; bool f_; dn_step_rb(0, dir, b, rb, f_);
                    const int lane = opaque_tid() & 63, r0 = lane >> 4, c8 = 8 * (lane & 15);
#pragma unroll
                    for (int v = 0; v < 8; ++v) { const int ipq = 32 * qh + r0 + 4 * v, ipk = 32 * khh + r0 + 4 * v, iq = dir ? 63 - ipq : ipq, ik = dir ? 63 - ipk : ipk;
                        q8[v] = *(const u32x4*)(P + (size_t)(rb * 64 + iq) * 4096 + kh * 128 + c8); k8[v] = *(const u32x4*)(P + (size_t)(rb * 64 + ik) * 4096 + 1024 + kh * 128 + c8); }
                    const int tl = dir ? 63 - lane : lane; gcp = AB[(size_t)(rb * 64 + tl) * 64 + dir * 16 + vh];
                }
                for (int j = 0; j < 260; ++j) {
                    const int lane = opaque_tid() & 63, r = lane & 31, h = lane >> 5, r0 = lane >> 4, c8 = 8 * (lane & 15);
                    LAS unsigned char* base = lds + (j & 1) * DN_DIR;
                    LAS bf16_t* Kb = (LAS bf16_t*)(base + DN_KB); LAS bf16_t* Qb = (LAS bf16_t*)(base + DN_QB); LAS bf16_t* Ab = (LAS bf16_t*)(base + DN_AB);
                    LAS float* hgc = (LAS float*)(lds + DN3_HGC + w * 256);
#pragma unroll
                    for (int v = 0; v < 8; ++v) { *(LAS u32x4*)(Qb + (32 * qh + r0 + 4 * v) * 136 + c8) = q8[v]; *(LAS u32x4*)(Kb + (32 * khh + r0 + 4 * v) * 136 + c8) = k8[v]; }
                    hgc[lane] = gcp;
                    asm volatile("s_waitcnt lgkmcnt(0)" ::: "memory");
                    if (j + 1 < 260) {
                        int rb; bool f_; dn_step_rb(j + 1, dir, b, rb, f_);
#pragma unroll
                        for (int v = 0; v < 8; ++v) { const int ipq = 32 * qh + r0 + 4 * v, ipk = 32 * khh + r0 + 4 * v, iq = dir ? 63 - ipq : ipq, ik = dir ? 63 - ipk : ipk;
                            q8[v] = *(const u32x4*)(P + (size_t)(rb * 64 + iq) * 4096 + kh * 128 + c8); k8[v] = *(const u32x4*)(P + (size_t)(rb * 64 + ik) * 4096 + 1024 + kh * 128 + c8); }
                        const int tl = dir ? 63 - lane : lane; gcp = AB[(size_t)(rb * 64 + tl) * 64 + dir * 16 + vh];
                    }
                    __builtin_amdgcn_sched_barrier(0);
                    {
                        f32x16 qk;
#pragma unroll
                        for (int x = 0; x < 16; ++x) qk[x] = 0.f;
#pragma unroll
                        for (int ks = 0; ks < 8; ++ks) qk = MFMA32(frag_nat(Qb, 136, 32 * ti + r, ks, h), frag_nat(Kb, 136, 32 * tj + r, ks, h), qk);
                        const int jj = 32 * tj + r; const float gj = hgc[jj];
#pragma unroll
                        for (int x = 0; x < 16; ++x) { const int i = 32 * ti + crow(x, h);
                            Ab[i * 72 + jj] = f2bf((i >= jj) ? qk[x] * __expf(hgc[i] - gj) : 0.f); }
                    }
                    BAR_LDS();
                }
                BAR_LDS();
            } else {
                u32x4 v16[16], t6[6]; float gcp, betap;
                {
                    int rb; bool f_; dn_step_rb(0, dir, b, rb, f_);
                    const int lane = opaque_tid() & 63, r0 = lane >> 4, c8 = 8 * (lane & 15);
#pragma unroll
                    for (int v = 0; v < 16; ++v) { const int ip = r0 + 4 * v, i = dir ? 63 - ip : ip; v16[v] = *(const u32x4*)(P + (size_t)(rb * 64 + i) * 4096 + 2048 + vh * 128 + c8); }
                    const bf16_t* tp = TP + (size_t)((rb * 16 + vh) * 2 + dir) * 3072;
#pragma unroll
                    for (int v = 0; v < 6; ++v) t6[v] = *(const u32x4*)(tp + (lane + 64 * v) * 8);
                    const int tl = dir ? 63 - lane : lane; const float* ab = AB + (size_t)(rb * 64 + tl) * 64; gcp = ab[dir * 16 + vh]; betap = ab[32 + dir * 16 + vh];
                }
                for (int j = 0; j < 260; ++j) {
                    const int lane = opaque_tid() & 63, r0 = lane >> 4, c8 = 8 * (lane & 15);
                    LAS unsigned char* base = lds + (j & 1) * DN_DIR;
                    LAS bf16_t* Vb = (LAS bf16_t*)(base + DN_VB); LAS bf16_t* Tb = (LAS bf16_t*)(base + DN_TB);
                    LAS float* sc_beta = (LAS float*)(base + DN_SC); LAS float* sc_gc = sc_beta + 64; LAS float* sc_eg = sc_beta + 128; LAS float* sc_tail = sc_beta + 192; LAS float* sc_dl = sc_beta + 256;
                    if (j >= 2) {
                        int rbo; bool fo_; dn_step_rb(j - 2, dir, b, rbo, fo_);
#pragma unroll
                        for (int v = 0; v < 16; ++v) { const int ip_ = r0 + 4 * v, i_ = dir ? 63 - ip_ : ip_;
                            atomic_add_bf16x8(OB + (size_t)(rbo * 64 + i_) * 2048 + vh * 128 + c8, *(const LAS u32x4*)(Vb + ip_ * 128 + c8)); }
                        asm volatile("s_waitcnt lgkmcnt(0)" ::: "memory");
                    }
#pragma unroll
                    for (int v = 0; v < 16; ++v) *(LAS u32x4*)(Vb + (r0 + 4 * v) * 128 + c8) = v16[v];
#pragma unroll
                    for (int v = 0; v < 6; ++v) { const int c = lane + 64 * v, blk = c >> 7, rowc = (c & 127) >> 2, cc = c & 3, br = blk ? 1 : 0, bc = blk == 2 ? 1 : 0;
                        *(LAS u32x4*)(Tb + (32 * br + rowc) * 72 + 32 * bc + 8 * cc) = t6[v]; }
                    { const float gc = gcp, gl = __shfl(gc, 63); sc_beta[lane] = betap; sc_gc[lane] = gc; sc_eg[lane] = __expf(gc); sc_tail[lane] = __expf(gl - gc); if (lane == 0) sc_dl[0] = __expf(gl); }
                    if (j + 1 < 260) {
                        int rb; bool f_; dn_step_rb(j + 1, dir, b, rb, f_);
#pragma unroll
                        for (int v = 0; v < 16; ++v) { const int ip = r0 + 4 * v, i = dir ? 63 - ip : ip; v16[v] = *(const u32x4*)(P + (size_t)(rb * 64 + i) * 4096 + 2048 + vh * 128 + c8); }
                        const bf16_t* tp = TP + (size_t)((rb * 16 + vh) * 2 + dir) * 3072;
#pragma unroll
                        for (int v = 0; v < 6; ++v) t6[v] = *(const u32x4*)(tp + (lane + 64 * v) * 8);
                        const int tl = dir ? 63 - lane : lane; const float* ab = AB + (size_t)(rb * 64 + tl) * 64; gcp = ab[dir * 16 + vh]; betap = ab[32 + dir * 16 + vh];
                    }
                    BAR_LDS();
                }
                {
                    const int lane = opaque_tid() & 63, r0 = lane >> 4, c8 = 8 * (lane & 15);
#pragma unroll 1
                    for (int jj = 258; jj < 260; ++jj) {
                        if (jj == 259) BAR_LDS();
                        LAS bf16_t* Vb = (LAS bf16_t*)(lds + (jj & 1) * DN_DIR + DN_VB);
                        int rbo; bool fo_; dn_step_rb(jj, dir, b, rbo, fo_);
#pragma unroll
                        for (int v = 0; v < 16; ++v) { const int ip_ = r0 + 4 * v, i_ = dir ? 63 - ip_ : ip_;
                            atomic_add_bf16x8(OB + (size_t)(rbo * 64 + i_) * 2048 + vh * 128 + c8, *(const LAS u32x4*)(Vb + ip_ * 128 + c8)); }
                    }
                }
            }
        } else {
            f32x16 S[4];
#pragma unroll
            for (int kt = 0; kt < 4; ++kt)
#pragma unroll
                for (int x = 0; x < 16; ++x) S[kt][x] = 0.f;
            BAR_LDS();
            for (int step = 0; step < 260; ++step) {
                const int lane = opaque_tid() & 63, r = lane & 31, h = lane >> 5;
                LAS unsigned char* base = lds + (step & 1) * DN_DIR;
                LAS bf16_t* Kb = (LAS bf16_t*)(base + DN_KB); LAS bf16_t* Qb = (LAS bf16_t*)(base + DN_QB); LAS bf16_t* Vb = (LAS bf16_t*)(base + DN_VB);
                LAS bf16_t* Tb = (LAS bf16_t*)(base + DN_TB); LAS bf16_t* Ab = (LAS bf16_t*)(base + DN_AB);
                LAS float* sc_beta = (LAS float*)(base + DN_SC); LAS float* sc_eg = sc_beta + 128; LAS float* sc_tail = sc_beta + 192; LAS float* sc_dl = sc_beta + 256;
                int rb; bool f_; dn_step_rb(step, dir, b, rb, f_);
                if (VAR != 2) {
                f32x16 KS[2], QS[2];
#pragma unroll
                for (int mt = 0; mt < 2; ++mt)
#pragma unroll
                    for (int x = 0; x < 16; ++x) { KS[mt][x] = 0.f; QS[mt][x] = 0.f; }
#pragma unroll
                for (int ks = 0; ks < 8; ++ks) {
                    const bf16x8 sp = pack_step(S[ks >> 1], ks & 1);
#pragma unroll
                    for (int mt = 0; mt < 2; ++mt) { KS[mt] = MFMA32(frag_perm(Kb, 136, 32 * mt + r, ks, h), sp, KS[mt]); QS[mt] = MFMA32(frag_perm(Qb, 136, 32 * mt + r, ks, h), sp, QS[mt]); }
                }
#pragma unroll
                for (int mt = 0; mt < 2; ++mt)
#pragma unroll
                    for (int g4 = 0; g4 < 4; ++g4) { const int i0 = 32 * mt + 8 * g4 + 4 * h;
                        const f32x4 bv = *(const LAS f32x4*)(sc_beta + i0), ev = *(const LAS f32x4*)(sc_eg + i0);
#pragma unroll
                        for (int e = 0; e < 4; ++e) { const int x = 4 * g4 + e; KS[mt][x] = bv[e] * (bf2f(Vb[(i0 + e) * 128 + 32 * w + r]) - ev[e] * KS[mt][x]); } }
                bf16x8 Xp[4];
#pragma unroll
                for (int ks = 0; ks < 4; ++ks) Xp[ks] = pack_step(KS[ks >> 1], ks & 1);
                f32x16 VN[2];
#pragma unroll
                for (int mt = 0; mt < 2; ++mt) {
#pragma unroll
                    for (int x = 0; x < 16; ++x) VN[mt][x] = 0.f;
#pragma unroll
                    for (int ks = 0; ks < 4; ++ks) if (ks < 2 * mt + 2) VN[mt] = MFMA32(frag_perm(Tb, 72, 32 * mt + r, ks, h), Xp[ks], VN[mt]);
                }
                bf16x8 VNp[4];
#pragma unroll
                for (int ks = 0; ks < 4; ++ks) VNp[ks] = pack_step(VN[ks >> 1], ks & 1);
#pragma unroll
                for (int mt = 0; mt < 2; ++mt) {
#pragma unroll
                    for (int g4 = 0; g4 < 4; ++g4) { const f32x4 ev = *(const LAS f32x4*)(sc_eg + 32 * mt + 8 * g4 + 4 * h);
#pragma unroll
                        for (int e = 0; e < 4; ++e) QS[mt][4 * g4 + e] *= ev[e]; }
#pragma unroll
                    for (int ks = 0; ks < 4; ++ks) if (ks < 2 * mt + 2) QS[mt] = MFMA32(frag_perm(Ab, 72, 32 * mt + r, ks, h), VNp[ks], QS[mt]);
                }
#pragma unroll
                for (int mt = 0; mt < 2; ++mt)
#pragma unroll
                    for (int x = 0; x < 16; ++x) Vb[(32 * mt + crow(x, h)) * 128 + 32 * w + r] = f2bf(QS[mt][x]);
#pragma unroll
                for (int mt = 0; mt < 2; ++mt)
#pragma unroll
                    for (int g4 = 0; g4 < 4; ++g4) { const f32x4 tv = *(const LAS f32x4*)(sc_tail + 32 * mt + 8 * g4 + 4 * h);
#pragma unroll
                        for (int e = 0; e < 4; ++e) VN[mt][4 * g4 + e] *= tv[e]; }
#pragma unroll
                for (int ks = 0; ks < 4; ++ks) VNp[ks] = pack_step(VN[ks >> 1], ks & 1);
                const float dl = sc_dl[0];
#pragma unroll
                for (int kt = 0; kt < 4; ++kt)
#pragma unroll
                    for (int x = 0; x < 16; ++x) S[kt][x] *= dl;
#pragma unroll
                for (int ks = 0; ks < 4; ++ks) {
#pragma unroll
                    for (int kt = 0; kt < 4; ++kt) S[kt] = MFMA32(frag_tr(Kb, 136, 32 * kt, ks, lane), VNp[ks], S[kt]);
                }
                }
                BAR_LDS();
            }
        }
    }
}
constexpr int GLA_NG = 8, GLA_SG = 33;
template <int PASS>
__device__ __forceinline__ void gla_scan3(LAS unsigned char* lds, bf16_t* P  , const bf16_t* QM, const bf16_t* KM, const bf16_t* AQ, const float* EL, bf16_t* OB  , float* SEND, float* DSUM) {
    const int tid0 = opaque_tid(), wv = __builtin_amdgcn_readfirstlane(tid0 >> 6), role = wv >> 2, w = wv & 3;
    for (int unit = blockIdx.x; unit < 32 * GLA_NG; unit += gridDim.x) {
        const int g = unit & (GLA_NG - 1), bu = unit >> 3;
        const int b = bu >> 4, head = (bu >> 2) & 3, hf = (bu >> 1) & 1, dir = bu & 1;
        if (PASS == 0 && g == GLA_NG - 1) continue;
        const int lo = GLA_SG * g, hi = (lo + GLA_SG < 260) ? lo + GLA_SG : 260;
        const int seq = (b * 4 + head) * 2 + dir;
        __syncthreads();
        if (role == 1) {
            GlPre pre; float dsum = 0.f;
            { int rb0; bool f0; dn_step_rb(lo, dir, b, rb0, f0); gl_prefetch(pre, P, QM, KM, AQ, EL, rb0, dir, head, hf, opaque_tid() & 255); }
            for (int j = lo; j < hi; ++j) {
                const int t = opaque_tid() & 255;
                LAS unsigned char* base = lds + ((j - lo) & 1) * GL_DIR;
                LAS bf16_t* Qm = (LAS bf16_t*)(base + GL_QM); LAS bf16_t* Km = (LAS bf16_t*)(base + GL_KM); LAS bf16_t* Vb = (LAS bf16_t*)(base + GL_VB); LAS bf16_t* Ab = (LAS bf16_t*)(base + GL_AB);
                LAS float* el = (LAS float*)(base + GL_EL);
                const int r0 = t >> 4, c8 = 8 * (t & 15);
#pragma unroll
                for (int v = 0; v < 4; ++v) { const int i = r0 + 16 * v, ip = dir ? 63 - i : i;
                    *(LAS u32x4*)(Qm + i * 136 + c8) = pre.q4[v]; *(LAS u32x4*)(Km + i * 136 + c8) = pre.k4[v]; *(LAS u32x4*)(Vb + ip * 136 + c8) = pre.v4[v]; }
                { const int c = t, row = c >> 3, cc = c & 7; *(LAS u32x4*)(Ab + row * 72 + 8 * cc) = pre.a0; }
                { const int c = 256 + t, row = c >> 3, cc = c & 7; *(LAS u32x4*)(Ab + row * 72 + 8 * cc) = pre.a1; }
                if (t < 128) el[t] = __expf(pre.elv);
                dsum += pre.elv;
                if (j + 1 < hi) { int rbn; bool fn; dn_step_rb(j + 1, dir, b, rbn, fn); gl_prefetch(pre, P, QM, KM, AQ, EL, rbn, dir, head, hf, t); }
                BAR_LDS();
            }
            if (PASS == 0 && hf == 0) { const int t = opaque_tid() & 255; if (t < 128) DSUM[(size_t)(seq * GLA_NG + g) * 128 + t] = dsum; }
            BAR_LDS();
        } else {
            f32x16 S[4];
#pragma unroll
            for (int kt = 0; kt < 4; ++kt)
#pragma unroll
                for (int x = 0; x < 16; ++x) S[kt][x] = 0.f;
            if (PASS == 1) {
                const int lane = opaque_tid() & 63, r = lane & 31, h = lane >> 5;
                for (int gp = 0; gp < g; ++gp) {
                    const float* se = SEND + (size_t)(seq * GLA_NG + gp) * 128 * 256 + hf * 128 + 32 * w + r; const float* ds = DSUM + (size_t)(seq * GLA_NG + gp) * 128;
#pragma unroll
                    for (int kt = 0; kt < 4; ++kt)
#pragma unroll
                        for (int x = 0; x < 16; ++x) { const int dk = 32 * kt + crow(x, h); S[kt][x] = __expf(ds[dk]) * S[kt][x] + se[(size_t)dk * 256]; }
                }
            }
            BAR_LDS();
            for (int step = lo; step < hi; ++step) {
                const int lane = opaque_tid() & 63, r = lane & 31, h = lane >> 5;
                LAS unsigned char* base = lds + ((step - lo) & 1) * GL_DIR;
                LAS bf16_t* Qm = (LAS bf16_t*)(base + GL_QM); LAS bf16_t* Km = (LAS bf16_t*)(base + GL_KM); LAS bf16_t* Vb = (LAS bf16_t*)(base + GL_VB); LAS bf16_t* Ab = (LAS bf16_t*)(base + GL_AB);
                LAS float* el = (LAS float*)(base + GL_EL);
                int rb; bool f_; dn_step_rb(step, dir, b, rb, f_);
#pragma unroll
                for (int kt = 0; kt < 4; ++kt)
#pragma unroll
                    for (int g4 = 0; g4 < 4; ++g4) { const f32x4 ev = *(const LAS f32x4*)(el + 32 * kt + 8 * g4 + 4 * h);
#pragma unroll
                        for (int e = 0; e < 4; ++e) S[kt][4 * g4 + e] *= ev[e]; }
                bf16x8 Vf[4];
#pragma unroll
                for (int ks = 0; ks < 4; ++ks) Vf[ks] = frag_tr(Vb, 136, 32 * w, ks, lane);
                if (PASS == 1) {
                    f32x16 O[2];
#pragma unroll
                    for (int mt = 0; mt < 2; ++mt) {
#pragma unroll
                        for (int x = 0; x < 16; ++x) O[mt][x] = 0.f;
#pragma unroll
                        for (int ks = 0; ks < 4; ++ks) if (ks < 2 * mt + 2) O[mt] = MFMA32(frag_perm(Ab, 72, 32 * mt + r, ks, h), Vf[ks], O[mt]);
                    }
#pragma unroll
                    for (int ks = 0; ks < 8; ++ks) {
                        const bf16x8 sp = pack_step(S[ks >> 1], ks & 1);
#pragma unroll
                        for (int mt = 0; mt < 2; ++mt) O[mt] = MFMA32(frag_perm(Qm, 136, 32 * mt + r, ks, h), sp, O[mt]);
                    }
#pragma unroll
                    for (int mt = 0; mt < 2; ++mt)
#pragma unroll
                        for (int x = 0; x < 16; ++x) Vb[(32 * mt + crow(x, h)) * 136 + 32 * w + r] = f2bf(O[mt][x]);
                }
#pragma unroll
                for (int ks = 0; ks < 4; ++ks) {
#pragma unroll
                    for (int kt = 0; kt < 4; ++kt) S[kt] = MFMA32(frag_tr(Km, 136, 32 * kt, ks, lane), Vf[ks], S[kt]);
                }
                if (PASS == 1) {
                    asm volatile("s_waitcnt lgkmcnt(0)" ::: "memory");
                    const int rr_ = lane >> 2, c8_ = 8 * (lane & 3);
#pragma unroll
                    for (int v = 0; v < 4; ++v) { const int ip_ = rr_ + 16 * v, i_ = dir ? 63 - ip_ : ip_; const int oc_ = head * 256 + hf * 128 + 32 * w + c8_;
                        bf16_t* dst_ = dir ? P + (size_t)(rb * 64 + i_) * 3072 + oc_ : OB + (size_t)(rb * 64 + i_) * 1024 + oc_;
                        *(u32x4*)dst_ = *(const LAS u32x4*)(Vb + ip_ * 136 + 32 * w + c8_); }
                }
                BAR_LDS();
            }
            if (PASS == 0) {
                const int lane = opaque_tid() & 63, r = lane & 31, h = lane >> 5;
                float* se = SEND + (size_t)(seq * GLA_NG + g) * 128 * 256 + hf * 128 + 32 * w + r;
#pragma unroll
                for (int kt = 0; kt < 4; ++kt)
#pragma unroll
                    for (int x = 0; x < 16; ++x) se[(size_t)(32 * kt + crow(x, h)) * 256] = S[kt][x];
            }
        }
    }
}
#define XB_TMO      128
#define XB_XCNT(j)  (256  + 64 * (j))
#define XB_XSUB(j)  (1280 + 64 * (j))
#define XB_XGEN(j)  (2304 + 64 * (j))
#define XB_TOP      3328
#define XB_TOPGEN   3392
#define XCD_BAR_WORDS 3456
#define XB_SPIN_CAP (1u << 23)

__device__ __forceinline__ unsigned xb_ld(unsigned* p)              { return __hip_atomic_load(p, __ATOMIC_RELAXED, __HIP_MEMORY_SCOPE_AGENT); }
__device__ __forceinline__ unsigned xb_add(unsigned* p, unsigned v) { return __hip_atomic_fetch_add(p, v, __ATOMIC_RELAXED, __HIP_MEMORY_SCOPE_AGENT); }
__device__ __forceinline__ unsigned xb_xcc_id() { return (unsigned)__builtin_amdgcn_s_getreg((3 << 11) | 20) & 0xFu; }
#define XB_SPIN(cond, bar) do { unsigned _sp = 0; while (cond) { __builtin_amdgcn_s_sleep(1); \
    if ((++_sp & 255u) == 0u) { if (xb_ld(&(bar)[XB_TMO])) break; if (_sp > XB_SPIN_CAP) { atomicAdd(&(bar)[XB_TMO], 1u); break; } } } } while (0)

struct XcdBarrier {
    unsigned* bar; unsigned x;
    volatile LAS unsigned* st;
};

__device__ __forceinline__ XcdBarrier xcd_barrier_post(unsigned* bar, volatile LAS unsigned* st) {
    XcdBarrier b; b.bar = bar; b.x = xb_xcc_id(); b.st = st;
    if (threadIdx.x == 0) (void)xb_add(&bar[XB_XCNT(b.x)], 1u);
    return b;
}
__device__ __forceinline__ void xcd_barrier_complete(unsigned* bar, unsigned x, unsigned& nloc, unsigned& nx) {
    const unsigned G = gridDim.x * gridDim.y * gridDim.z;
    unsigned sum, cnt, mine, sp = 0u;
    for (;;) {
        sum = 0u; cnt = 0u; mine = 0u;
#pragma unroll
        for (unsigned j = 0; j < 16; ++j) { const unsigned c = xb_ld(&bar[XB_XCNT(j)]); sum += c; cnt += (c > 0u) ? 1u : 0u; mine = (j == x) ? c : mine; }
        if (sum == G) break;
        __builtin_amdgcn_s_sleep(1);
        if ((++sp & 255u) == 0u) { if (xb_ld(&bar[XB_TMO])) break; if (sp > XB_SPIN_CAP) { atomicAdd(&bar[XB_TMO], 1u); break; } }
    }
    nloc = mine > 0u ? mine : 1u; nx = cnt > 0u ? cnt : 1u;
}

__device__ __forceinline__ void xcd_barrier(const XcdBarrier& b) {
    asm volatile("s_waitcnt vmcnt(0)" ::: "memory");
    __syncthreads();
    if (threadIdx.x == 0) {
        unsigned* bar = b.bar;
        __builtin_amdgcn_s_waitcnt(0);
        unsigned nloc = b.st[0], nx = b.st[1];
        if (nloc == 0u) { xcd_barrier_complete(bar, b.x, nloc, nx); b.st[0] = nloc; b.st[1] = nx; }
        const unsigned old = xb_add(&bar[XB_XSUB(b.x)], 1u);
        const unsigned gen = old / nloc;
        if (old + 1u == (gen + 1u) * nloc) {
            __builtin_amdgcn_fence(__ATOMIC_RELEASE, "agent");
            asm volatile("s_waitcnt vmcnt(0)" ::: "memory");
            const unsigned og = xb_add(&bar[XB_TOP], 1u);
            const unsigned tg = og / nx;
            if (og + 1u == (tg + 1u) * nx) xb_add(&bar[XB_TOPGEN], 1u);
            else XB_SPIN(xb_ld(&bar[XB_TOPGEN]) == tg, bar);
            __builtin_amdgcn_fence(__ATOMIC_ACQUIRE, "agent");
            xb_add(&bar[XB_XGEN(b.x)], 1u);
            asm volatile("s_waitcnt vmcnt(0)" ::: "memory");
        } else {
            XB_SPIN(xb_ld(&bar[XB_XGEN(b.x)]) == gen, bar);
            __builtin_amdgcn_fence(__ATOMIC_ACQUIRE, "agent");
            asm volatile("s_waitcnt vmcnt(0)" ::: "memory");
        }
    }
    __syncthreads();
}

#define DUP_DN 0
#define DN_VARIANT 0
#define DN_VAR_PARITY0 0
#define DUP_GLA 0
#define DUP_ATT 0
#define DUP_GIN 0
#define DUP_FFN1 0
constexpr unsigned long long pack_ops(const int* ops, int n) { unsigned long long v = 0; for (int i = 0; i < n; ++i) v |= (unsigned long long)ops[i] << (5 * i); return v; }
struct OpList { unsigned long long code; int n; };
constexpr OpList make_list(int mix) {
    int ops[16] = {}; int n = 0;
    ops[n++] = OP_PREP; ops[n++] = OP_GEMM_IN; if (DUP_GIN && mix != 0) ops[n++] = OP_GEMM_IN;
    if (mix == 0) { ops[n++] = OP_DNCONV; ops[n++] = OP_DNT; ops[n++] = OP_DNSCAN; if (DUP_DN) ops[n++] = OP_DNSCAN; ops[n++] = OP_DNREDO; ops[n++] = OP_GEMM_Z; }
    else if (mix == 1) { ops[n++] = OP_GLAPREP; ops[n++] = OP_GLASTATE; ops[n++] = OP_GLASCAN; ops[n++] = OP_GLAGATE; }
    else { ops[n++] = OP_QKROPE; ops[n++] = OP_ATTN; if (DUP_ATT) ops[n++] = OP_ATTN; }
    ops[n++] = OP_GEMM_OUT; ops[n++] = OP_NORM2; ops[n++] = OP_FFN1; if (DUP_FFN1 && mix != 0) ops[n++] = OP_FFN1; ops[n++] = OP_FFN2;
    return OpList{pack_ops(ops, n), n};
}
constexpr OpList L_DN = make_list(0), L_GL = make_list(1), L_AT = make_list(2);
constexpr int NPHASE = 1 + 2 * L_DN.n + L_GL.n + L_AT.n;
__device__ __forceinline__ void decode_phase(int ph, int& layer, int& op) {
    if (ph == 0) { layer = 0; op = OP_MOD; return; }
    int p = ph - 1;
    if (p < L_DN.n) { layer = 0; op = (int)((L_DN.code >> (5 * p)) & 31ull); return; } p -= L_DN.n;
    if (p < L_GL.n) { layer = 1; op = (int)((L_GL.code >> (5 * p)) & 31ull); return; } p -= L_GL.n;
    if (p < L_AT.n) { layer = 2; op = (int)((L_AT.code >> (5 * p)) & 31ull); return; } p -= L_AT.n;
    layer = 3; op = (int)((L_DN.code >> (5 * p)) & 31ull);
}

__global__ void __launch_bounds__(512, 2) mega(Args args) {
    extern __shared__ __attribute__((aligned(16))) unsigned char lds_raw[];
    LAS unsigned char* lds = (LAS unsigned char*)lds_raw;
    cg::grid_group grid = cg::this_grid();
    volatile LAS unsigned* xb_st = (volatile LAS unsigned*)(lds + LDS_BYTES - 64);
    if (threadIdx.x < 2) xb_st[threadIdx.x] = 0u;
    __syncthreads();
    const XcdBarrier xbar = xcd_barrier_post((unsigned*)(args.ws + WS_BAR), xb_st);
    const int G = gridDim.x, NGW = G * 8;
    unsigned char* ws = args.ws;
    const float* x_in = args.in[0]; const float* c_in = args.in[1]; const float* ctx_in = args.in[2]; const float* cctx_in = args.in[3];
    const float* ada_w = args.in[4]; const float* ada_b = args.in[5]; const float* norm_mix_g = args.in[6]; const float* norm_ffn_g = args.in[7];
    const float* ffn_w1 = args.in[8]; const float* ffn_w2 = args.in[9];
    float* MOD = (float*)(ws + WS_MOD); float* CTXC = (float*)(ws + WS_CTX); bf16_t* H = (bf16_t*)(ws + WS_H); float* ABF = (float*)(ws + WS_AB); float* RSTD = (float*)(ws + WS_RSTD);
    bf16_t* PB = (bf16_t*)(ws + WS_P); float* out = args.out;

    for (int ph = args.ph_lo; ph < args.ph_hi; ++ph) {
        int layer, op; decode_phase(ph, layer, op);
        const int mix = layer % 3, slot = layer / 3;
        const float* modl = MOD + (size_t)layer * 3 * 6144;
        const float* xl = layer == 0 ? x_in : out; const float* xc = layer == 0 ? ctx_in : CTXC;
        if (op == OP_MOD) {
            const int tid = opaque_tid(), lane = tid & 63, wave = __builtin_amdgcn_readfirstlane(tid >> 6);
            LAS float* sl = (LAS float*)lds; LAS float* red = sl + 3 * 1024;
            for (int e = tid; e < 3 * 1024; e += 512) { const float v = e < 2048 ? c_in[e] : cctx_in[e - 2048]; sl[e] = silu_f(v); }
            __syncthreads();
            for (int item = blockIdx.x; item < 4 * 24; item += G) {
                const int ly = item / 24, cb = (item % 24) * 256;
                const float* wp = ada_w + ((size_t)ly * 1024 + 128 * wave) * 6144 + cb + 4 * lane;
                f32x4 a0 = {0.f, 0.f, 0.f, 0.f}, a1 = a0, a2 = a0;
#pragma unroll 8
                for (int k = 0; k < 128; ++k) { const f32x4 wv = *(const f32x4*)(wp + (size_t)k * 6144); const int kk = 128 * wave + k; a0 += sl[kk] * wv; a1 += sl[1024 + kk] * wv; a2 += sl[2048 + kk] * wv; }
                *(LAS f32x4*)(red + (wave * 3 + 0) * 256 + 4 * lane) = a0; *(LAS f32x4*)(red + (wave * 3 + 1) * 256 + 4 * lane) = a1; *(LAS f32x4*)(red + (wave * 3 + 2) * 256 + 4 * lane) = a2;
                __syncthreads();
                for (int idx = tid; idx < 768; idx += 512) { const int m = idx >> 8, cc = idx & 255; float sacc = ada_b[(size_t)ly * 6144 + cb + cc];
#pragma unroll
                    for (int w2 = 0; w2 < 8; ++w2) sacc += red[(w2 * 3 + m) * 256 + cc];
                    MOD[((size_t)ly * 3 + m) * 6144 + cb + cc] = sacc; }
                __syncthreads();
            }
        } else if (op == OP_PREP) {
            const int tid = opaque_tid(), lane = tid & 63, wave = __builtin_amdgcn_readfirstlane(tid >> 6); const int gw = blockIdx.x * 8 + wave; (void)lane; (void)gw; (void)tid;
            LAS float* scr = (LAS float*)(lds + wave * 16384);
            unsigned z0 = 0u; asm volatile("" : "+v"(z0)); const u32x4 zv = (u32x4){z0, z0, z0, z0};
            bf16_t* wtA = (bf16_t*)(ws + WT_A); bf16_t* wtZ = (bf16_t*)(ws + WT_Z); bf16_t* wtO = (bf16_t*)(ws + WT_O); bf16_t* wt1 = (bf16_t*)(ws + WT_1); bf16_t* wt2 = (bf16_t*)(ws + WT_2);
            if (mix == 0) {
                const float* w_in = args.in[10] + (size_t)slot * 1024 * 6208; const float* w_out = args.in[15] + (size_t)slot * 2048 * 1024;
                transpose_mat(w_in, 6208, 0, 4096, 1024, wtA, 0, scr, gw, NGW, lane);
                transpose_mat(w_in, 6208, 6144, 64, 1024, wtA, 4096, scr, gw, NGW, lane);
                for (size_t e = (size_t)blockIdx.x * 512 + tid; e < (size_t)192 * 1024 * 2 / 16; e += (size_t)G * 512) ((u32x4*)(wtA + (size_t)4160 * 1024))[e] = zv;
            } else if (mix == 1) {
                const float* w_in = args.in[16]; const float* w_out = args.in[20];
                transpose_mat(w_in, 3104, 0, 3104, 1024, wtA, 0, scr, gw, NGW, lane);
                for (size_t e = (size_t)blockIdx.x * 512 + tid; e < (size_t)224 * 1024 * 2 / 16; e += (size_t)G * 512) ((u32x4*)(wtA + (size_t)3104 * 1024))[e] = zv;
                transpose_mat(w_out, 1024, 0, 1024, 1024, wtO, 0, scr, gw, NGW, lane);
            } else {
                const float* w_in = args.in[21]; const float* w_out = args.in[24];
                transpose_mat(w_in, 1536, 0, 1536, 1024, wtA, 0, scr, gw, NGW, lane);
                transpose_mat(w_out, 1024, 0, 1024, 1024, wtO, 0, scr, gw, NGW, lane);
            }
            if (mix != 0) {
                transpose_mat(ffn_w1 + (size_t)layer * 1024 * 4096, 4096, 0, 4096, 1024, wt1, 0, scr, gw, NGW, lane);
                transpose_mat(ffn_w2 + (size_t)layer * 4096 * 1024, 1024, 0, 1024, 4096, wt2, 0, scr, gw, NGW, lane);
            }
            if (layer >= 1) normmod_rows(xl, xc, norm_mix_g + (size_t)layer * 1024, modl, 0, H, gw, NGW, lane, (const float*)(ws + WS_O), MOD + ((size_t)(layer - 1) * 3 + 2) * 6144 + 5 * 1024, CTXC, 8);
            else normmod_rows(xl, xc, norm_mix_g + (size_t)layer * 1024, modl, 0, H, gw, NGW, lane);
        } else if (op == OP_DNREDO) {
            const int tid = opaque_tid(), lane = tid & 63, wave = __builtin_amdgcn_readfirstlane(tid >> 6); const int gw = blockIdx.x * 8 + wave; (void)lane; (void)gw; (void)tid;
            LAS float* scr = (LAS float*)(lds + wave * 16384);
            const float* w_in = args.in[10] + (size_t)slot * 1024 * 6208; const float* w_out = args.in[15] + (size_t)slot * 2048 * 1024;
            transpose_mat(w_in, 6208, 4096, 2048, 1024, (bf16_t*)(ws + WT_Z), 0, scr, gw, NGW, lane);
            transpose_mat(w_out, 1024, 0, 1024, 2048, (bf16_t*)(ws + WT_O), 0, scr, gw, NGW, lane);
            transpose_mat(ffn_w1 + (size_t)layer * 1024 * 4096, 4096, 0, 4096, 1024, (bf16_t*)(ws + WT_1), 0, scr, gw, NGW, lane);
            transpose_mat(ffn_w2 + (size_t)layer * 4096 * 1024, 1024, 0, 1024, 4096, (bf16_t*)(ws + WT_2), 0, scr, gw, NGW, lane);
            normmod_rows(xl, xc, norm_mix_g + (size_t)layer * 1024, modl, 0, H, gw, NGW, lane);
            const bf16_t* OB = (const bf16_t*)(ws + WS_O);
            for (int row = gw; row < MROWS; row += NGW) {
                const u32x4* p = (const u32x4*)(OB + (size_t)row * 2048 + 32 * lane); float ss = 0.f;
#pragma unroll
                for (int v = 0; v < 4; ++v) { const u32x4 q = p[v]; const float a0 = bf_lo(q.x), a1 = bf_hi(q.x), a2 = bf_lo(q.y), a3 = bf_hi(q.y), a4 = bf_lo(q.z), a5 = bf_hi(q.z), a6 = bf_lo(q.w), a7 = bf_hi(q.w);
                    ss += (a0 * a0 + a1 * a1) + (a2 * a2 + a3 * a3) + (a4 * a4 + a5 * a5) + (a6 * a6 + a7 * a7); }
                ss += __shfl_xor(ss, 1); ss += __shfl_xor(ss, 2);
                if ((lane & 3) == 0) RSTD[(size_t)row * 16 + (lane >> 2)] = rsqrtf(ss * (1.f / 128.f) + EPS);
            }
        } else if (op == OP_DNHALO) {
            dn_halo_phase(PB, (bf16_t*)(ws + WS_HALO), G);
        } else if (op == OP_DNCONV) {
            dn_conv_phase(PB, (const bf16_t*)(ws + WS_HALO), args.in[11] + (size_t)slot * 4096 * 5, G);
        } else if (op == OP_DNT) {
            dn_t_phase(lds, PB, ABF, (bf16_t*)(ws + WS_TP), args.in[12] + (size_t)slot * 32, args.in[13] + (size_t)slot * 32, G);
            {
                unsigned z0 = 0u; asm volatile("" : "+v"(z0)); const u32x4 zv = (u32x4){z0, z0, z0, z0}; u32x4* zp = (u32x4*)(ws + WS_O);
                for (size_t e = (size_t)blockIdx.x * 512 + opaque_tid(); e < (size_t)MROWS * 2048 * 2 / 16; e += (size_t)G * 512) zp[e] = zv;
            }
        } else if (op == OP_NORM2) {
            const int tid = opaque_tid(), lane = tid & 63, wave = __builtin_amdgcn_readfirstlane(tid >> 6); const int gw = blockIdx.x * 8 + wave; (void)lane; (void)gw; (void)tid;
            if (layer < 3) normmod_rows(out, xc, norm_ffn_g + (size_t)layer * 1024, modl, 3, H, gw, NGW, lane, ABF, modl + (size_t)2 * 6144 + 2 * 1024, CTXC);
            else normmod_rows(out, CTXC, norm_ffn_g + (size_t)layer * 1024, modl, 3, H, gw, NGW, lane);
        } else if (op == OP_GEMM_IN || op == OP_GEMM_Z || op == OP_GEMM_OUT || op == OP_FFN1 || op == OP_FFN2) {
            pg8::Gemm g; pg8::Epi E;
            E.mode = 0; E.O = PB; E.ldc = 4096; E.tail_pn = -1; E.halo = nullptr; E.F = ABF; E.ldf = 64; E.nf = 64; E.rstd = RSTD; E.ng = args.in[14] + (size_t)slot * 128;
            E.src_lat = xl; E.src_ctx = xc; E.dst_lat = out; E.dst_ctx = CTXC; E.mod = modl; E.gidx = 2;
            g.M = (layer == 3 && op != OP_GEMM_IN) ? NLAT : MROWS; g.A = H; g.K = 1024;
            bf16_t* OBUF = (bf16_t*)(ws + (mix == 1 ? WS_OGLA : WS_O));
            if (op == OP_GEMM_IN) {
                g.Bt = (const bf16_t*)(ws + WT_A);
                if (mix == 0) { g.N = 4352; E.ldc = 4096; E.tail_pn = 16; E.ldf = 64; E.nf = 64; E.halo = (bf16_t*)(ws + WS_HALO); }
                else if (mix == 1) { g.N = 3328; E.ldc = 3072; E.tail_pn = 12; E.ldf = 32; E.nf = 32; }
                else { g.N = 1536; E.ldc = 1536; }
            } else if (op == OP_GEMM_Z) {
                g.Bt = (const bf16_t*)(ws + WT_Z); g.N = 2048; E.mode = 2; E.O = OBUF; E.ldc = 2048;
            } else if (op == OP_GEMM_OUT) {
                g.A = OBUF; g.K = mix == 0 ? 2048 : 1024; g.Bt = (const bf16_t*)(ws + WT_O); g.N = 1024; E.mode = 3; E.gidx = 2;
            } else if (op == OP_FFN1) {
                g.Bt = (const bf16_t*)(ws + WT_1); g.N = 4096; E.mode = 1; E.ldc = 4096;
            } else {
                g.A = PB; g.K = 4096; g.Bt = (const bf16_t*)(ws + WT_2); g.N = 1024; E.mode = 3; E.gidx = 5; E.src_lat = out; E.src_ctx = CTXC;
            }
            const bool splitc = (E.mode == 3 && layer < 3);
            const int nsl = (op == OP_FFN2) ? 8 : 4;
            E.part = (op == OP_FFN2) ? (float*)(ws + WS_O) : ABF; E.ntf = g.K / 64;
            pg8::StaticOrder S; if (splitc) S.init(NLAT, g.N, G, (int)blockIdx.x, g.K / 64, nsl, 2); else S.init(g.M, g.N, G, (int)blockIdx.x, g.K / 64);
#ifndef NO_GEMM
            pg8::gemm_phase<pg8::Epi, pg8::StaticOrder, true, true>(lds, g, S, E);
#endif
        } else if (op == OP_DNSCAN) {
#ifndef NO_DN
            if (DN_VARIANT && (ph & 1) == 0) dn_scan3<DN_VARIANT>(lds, PB, ABF, (const bf16_t*)(ws + WS_TP), (bf16_t*)(ws + WS_O)); else dn_scan3<0>(lds, PB, ABF, (const bf16_t*)(ws + WS_TP), (bf16_t*)(ws + WS_O));
#endif
        } else if (op == OP_GLAPREP) {
            gla_prep_phase(lds, PB, ABF, args.in[17], args.in[18], (bf16_t*)(ws + WS_QM), (bf16_t*)(ws + WS_KM), (bf16_t*)(ws + WS_AQ), (float*)(ws + WS_EL), G);
        } else if (op == OP_GLASTATE) {
            gla_scan3<0>(lds, PB, (const bf16_t*)(ws + WS_QM), (const bf16_t*)(ws + WS_KM), (const bf16_t*)(ws + WS_AQ), (const float*)(ws + WS_EL), (bf16_t*)(ws + WS_OGLA), (float*)(ws + WS_SEND), (float*)(ws + WS_DSUM));
        } else if (op == OP_GLASCAN) {
#ifndef NO_GLA
            gla_scan3<1>(lds, PB, (const bf16_t*)(ws + WS_QM), (const bf16_t*)(ws + WS_KM), (const bf16_t*)(ws + WS_AQ), (const float*)(ws + WS_EL), (bf16_t*)(ws + WS_OGLA), (float*)(ws + WS_SEND), (float*)(ws + WS_DSUM));
#endif
        } else if (op == OP_GLAGATE) {
            const int tid = opaque_tid(), lane = tid & 63, wave = __builtin_amdgcn_readfirstlane(tid >> 6); const int gw = blockIdx.x * 8 + wave; (void)lane; (void)gw; (void)tid;
            bf16_t* OB = (bf16_t*)(ws + WS_OGLA); const float* ng = args.in[19];
            for (int row = gw; row < MROWS; row += NGW) {
                u32x4* p = (u32x4*)(OB + (size_t)row * 1024 + 16 * lane); const u32x4* gp = (const u32x4*)(PB + (size_t)row * 3072 + 2048 + 16 * lane); const u32x4* pb2 = (const u32x4*)(PB + (size_t)row * 3072 + 16 * lane);
                float o[16], z[16]; float ss = 0.f;
#pragma unroll
                for (int v = 0; v < 2; ++v) { const u32x4 q = p[v], gq = gp[v], q2 = pb2[v];
                    o[8 * v + 0] = bf_lo(q.x) + bf_lo(q2.x); o[8 * v + 1] = bf_hi(q.x) + bf_hi(q2.x); o[8 * v + 2] = bf_lo(q.y) + bf_lo(q2.y); o[8 * v + 3] = bf_hi(q.y) + bf_hi(q2.y); o[8 * v + 4] = bf_lo(q.z) + bf_lo(q2.z); o[8 * v + 5] = bf_hi(q.z) + bf_hi(q2.z); o[8 * v + 6] = bf_lo(q.w) + bf_lo(q2.w); o[8 * v + 7] = bf_hi(q.w) + bf_hi(q2.w);
                    z[8 * v + 0] = bf_lo(gq.x); z[8 * v + 1] = bf_hi(gq.x); z[8 * v + 2] = bf_lo(gq.y); z[8 * v + 3] = bf_hi(gq.y); z[8 * v + 4] = bf_lo(gq.z); z[8 * v + 5] = bf_hi(gq.z); z[8 * v + 6] = bf_lo(gq.w); z[8 * v + 7] = bf_hi(gq.w); }
#pragma unroll
                for (int e = 0; e < 16; ++e) ss += o[e] * o[e];
                ss += __shfl_xor(ss, 1); ss += __shfl_xor(ss, 2); ss += __shfl_xor(ss, 4); ss += __shfl_xor(ss, 8);
                const float rs = rsqrtf(ss * (1.f / 256.f) + EPS); const int cb = (16 * lane) & 255;
#pragma unroll
                for (int v = 0; v < 2; ++v) { float rr[8];
#pragma unroll
                    for (int e = 0; e < 8; ++e) rr[e] = o[8 * v + e] * rs * ng[cb + 8 * v + e] * silu_f(z[8 * v + e]);
                    u32x4 wv; wv.x = cvtpk_s(rr[0], rr[1]); wv.y = cvtpk_s(rr[2], rr[3]); wv.z = cvtpk_s(rr[4], rr[5]); wv.w = cvtpk_s(rr[6], rr[7]); p[v] = wv; }
            }
        } else if (op == OP_QKROPE) {
            const int tid = opaque_tid(), lane = tid & 63, wave = __builtin_amdgcn_readfirstlane(tid >> 6); const int gw = blockIdx.x * 8 + wave; (void)lane; (void)gw; (void)tid;
            bf16_t* QR = (bf16_t*)(ws + WS_QR); bf16_t* KR = (bf16_t*)(ws + WS_KR); bf16_t* VR = (bf16_t*)(ws + WS_VR);
            const float* qg = args.in[22]; const float* kg = args.in[23];
            const int hf = lane >> 5, j = lane & 31, e1 = 64 * hf + j, e2 = e1 + 32;
            const float inv_freq = exp2f(-(float)(2 * j) * (1.f / 64.f) * 13.287712379549449f);
            const float gq1 = qg[e1], gq2 = qg[e2], gk1 = kg[e1], gk2 = kg[e2];
            for (int rowa = gw; rowa < MROWS; rowa += 2 * NGW) {
                float x1[2][10], x2[2][10]; unsigned short va[2][4]; int rws[2]; rws[0] = rowa; rws[1] = rowa + NGW < MROWS ? rowa + NGW : rowa;
#pragma unroll
                for (int q = 0; q < 2; ++q) { const bf16_t* pr = PB + (size_t)rws[q] * 1536;
#pragma unroll
                    for (int hd = 0; hd < 10; ++hd) { x1[q][hd] = bf2f(pr[hd * 128 + e1]); x2[q][hd] = bf2f(pr[hd * 128 + e2]); }
                    va[q][0] = pr[1280 + e1]; va[q][1] = pr[1280 + e2]; va[q][2] = pr[1408 + e1]; va[q][3] = pr[1408 + e2]; }
#pragma unroll
                for (int q = 0; q < 2; ++q) {
                    if (q == 1 && rowa + NGW >= MROWS) break;
                    const int row = rws[q];
                    const bool lat = row < NLAT; const int b = lat ? row / SEQ : (row - NLAT) / CTXL; const int tpos = lat ? row % SEQ : (row - NLAT) % CTXL;
                    float cs = 1.f, sn = 0.f;
                    if (lat) { const float pos = (float)(hf == 0 ? tpos / 64 : tpos % 64); const float ang = pos * inv_freq; sn = sinf(ang); cs = cosf(ang); }
                    const int kpos = lat ? tpos : SEQ + tpos;
#pragma unroll
                    for (int hd = 0; hd < 10; ++hd) {
                        const float a1 = x1[q][hd], a2 = x2[q][hd];
                        const float rinv = rsqrtf(wave_sum(a1 * a1 + a2 * a2) * (1.f / 128.f) + EPS);
                        const float y1 = a1 * rinv * (hd < 8 ? gq1 : gk1), y2 = a2 * rinv * (hd < 8 ? gq2 : gk2);
                        const float o1 = y1 * cs - y2 * sn, o2 = y1 * sn + y2 * cs;
                        bf16_t* dst = hd < 8 ? QR + (size_t)row * 1024 + hd * 128 : KR + ((size_t)(b * 2 + (hd - 8)) * SKV + kpos) * 128;
                        dst[e1] = f2bf(o1); dst[e2] = f2bf(o2);
                    }
#pragma unroll
                    for (int kv = 0; kv < 2; ++kv) { bf16_t* dst = VR + ((size_t)(b * 2 + kv) * SKV + kpos) * 128; dst[e1] = va[q][2 * kv]; dst[e2] = va[q][2 * kv + 1]; }
                }
            }
        } else if (op == OP_ATTN) {
            const attn::bf16* QR = (const attn::bf16*)(ws + WS_QR); const attn::bf16* KR = (const attn::bf16*)(ws + WS_KR); const attn::bf16* VR = (const attn::bf16*)(ws + WS_VR);
            attn::bf16* OB = (attn::bf16*)(ws + WS_O);
            for (int u = blockIdx.x; u < 1024 + 16; u += G) {
                size_t qoff, koff; int seq;
                if (u < 1024) { const int pair = u >> 8, b = pair >> 1, kvh = pair & 1, hh = (u >> 6) & 3, qb = u & 63, head = kvh * 4 + hh;
                    qoff = ((size_t)b * SEQ + (size_t)qb * 256) * 1024 + head * 128; koff = (size_t)(b * 2 + kvh) * SKV * 128; seq = SKV; }
                else { const int jx = u - 1024, b = jx >> 3, head = jx & 7, kvh = head >> 2;
                    qoff = ((size_t)NLAT + (size_t)b * CTXL) * 1024 + head * 128; koff = ((size_t)(b * 2 + kvh) * SKV + SEQ) * 128; seq = CTXL; }
                __syncthreads();
#ifndef NO_ATT
                attn::attn_dense_body<attn::bf16>(QR + qoff, KR + koff, VR + koff, OB + qoff, seq, (char*)lds_raw);
#endif
            }
        }
        if (ph + 1 < args.ph_hi) { if (args.ph_lo < 0) grid.sync(); else xcd_barrier(xbar); }
    }
}

#ifndef MK_MULTI
#define MK_MULTI 0
#endif
extern "C" void kernel_launch(void* const* d_in, const int* in_sizes, int n_in, void* d_out, int out_size, void* d_ws, size_t ws_size, hipStream_t stream) {
    static int grid = 0;
    if (grid == 0) {
        if (n_in != 25 || ws_size < WS_END) { fprintf(stderr, "kernel_launch: unexpected n_in %d / ws_size %zu (need %zu)\n", n_in, ws_size, (size_t)WS_END); grid = -1; return; }
        int dev = 0, cus = 0, per_cu = 0;
        hipGetDevice(&dev); hipDeviceGetAttribute(&cus, hipDeviceAttributeMultiprocessorCount, dev);
        if (hipFuncSetAttribute((const void*)mega, hipFuncAttributeMaxDynamicSharedMemorySize, LDS_BYTES) != hipSuccess) { fprintf(stderr, "kernel_launch: hipFuncSetAttribute failed\n"); grid = -1; return; }
        if (hipOccupancyMaxActiveBlocksPerMultiprocessor(&per_cu, (const void*)mega, 512, LDS_BYTES) != hipSuccess || per_cu < 1) { fprintf(stderr, "kernel_launch: occupancy query says %d\n", per_cu); per_cu = 1; }
        (void)hipGetLastError();
        grid = cus * 1;
    }
    if (grid < 0) return;
    if (hipMemsetAsync((char*)d_ws + WS_BAR, 0, WS_BAR_BYTES, stream) != hipSuccess) { fprintf(stderr, "kernel_launch: memset of barrier words failed\n"); return; }
    Args a{};
    for (int i = 0; i < 25; ++i) a.in[i] = (const float*)d_in[i];
    a.out = (float*)d_out; a.ws = (unsigned char*)d_ws;
#if MK_MULTI
    for (int ph = 0; ph < NPHASE; ++ph) { a.ph_lo = ph; a.ph_hi = ph + 1; hipLaunchKernelGGL(mega, dim3(grid), dim3(512), LDS_BYTES, stream, a); }
#else
    a.ph_lo = 0; a.ph_hi = NPHASE;
    void* kargs[] = {&a};
    hipError_t e = hipLaunchCooperativeKernel((const void*)mega, dim3(grid), dim3(512), kargs, LDS_BYTES, stream);
    if (e != hipSuccess) fprintf(stderr, "cooperative launch failed: %s (grid %d)\n", hipGetErrorString(e), grid);
#endif
}
```
